# Optimizing an MI355X kernel written in HIP

```python
import math
import jax, jax.numpy as jnp
from jax import lax
import numpy as np

D_MODEL = 1024
BATCH = 8
SEQ = 2048
DEPTH = 1

DN_HEADS = 8
DN_HEAD_DIM = 128
DN_W = DN_HEADS * DN_HEAD_DIM
DN_CONV = 4
DN_CHUNK = 64
NSA_HEADS = 16
NSA_GROUPS = 4
NSA_REP = NSA_HEADS // NSA_GROUPS
NSA_HEAD_DIM = 64
NSA_W = NSA_HEADS * NSA_HEAD_DIM
NSA_KV_W = NSA_GROUPS * NSA_HEAD_DIM
CMP_LEN = 32
CMP_STRIDE = 16
CMP_HIDDEN = 2 * NSA_HEAD_DIM
SLC_LEN = 64
SLC_TOPK = 8
WINDOW = 256
ATT_QBLK = 128
SLC_QBLK = 64
D_FF = 4 * D_MODEL
IN_WIDTH = 4 * DN_W + 2 * DN_HEADS + NSA_W + 6 * NSA_KV_W + 3 * NSA_HEADS + 2 * D_MODEL
EPS = 1e-6
NEG = -1e30
FORCE = 1e9

kernel_name = "hybrid_gdn_nsa_parallel_block"


def _in_split_points():
    sizes = [3 * DN_W, DN_W, DN_HEADS, DN_HEADS,
             NSA_W, NSA_KV_W, NSA_KV_W, NSA_KV_W, NSA_KV_W, NSA_KV_W, NSA_KV_W, 3 * NSA_HEADS,
             D_MODEL, D_MODEL]
    return [int(v) for v in np.cumsum(sizes)[:-1]]


def rmsnorm(x, gain):
    xf = x.astype(jnp.float32)
    y = xf * lax.rsqrt(jnp.mean(xf * xf, axis=-1, keepdims=True) + EPS)
    return (y * gain.astype(jnp.float32)).astype(x.dtype)


def l2norm(x):
    xf = x.astype(jnp.float32)
    return (xf * lax.rsqrt(jnp.sum(xf * xf, axis=-1, keepdims=True) + EPS)).astype(x.dtype)


def alibi_slopes(n_heads):
    return jnp.asarray(2.0 ** (-8.0 * np.arange(1, n_heads + 1) / n_heads), jnp.float32)


def causal_depthwise_conv(x, w):
    k, c = w.shape
    return lax.conv_general_dilated(x, w[:, None, :].astype(x.dtype), window_strides=(1,),
                                    padding=[(k - 1, 0)], dimension_numbers=('NWC', 'WIO', 'NWC'),
                                    feature_group_count=c)


def chunk_gated_delta_rule(q, k, v, g, beta):
    B, S, H, dk = q.shape
    dv = v.shape[-1]
    C = DN_CHUNK
    N = S // C
    f32 = jnp.float32

    def chunks(t):
        t = t.astype(f32).reshape((B, N, C, H) + t.shape[3:])
        return jnp.moveaxis(t, (1, 3), (0, 2))

    q = chunks(q) * (dk ** -0.5)
    k = chunks(k)
    v = chunks(v)
    beta = chunks(beta)
    gc = jnp.cumsum(chunks(g), axis=-1)
    kb = k * beta[..., None]
    vb = v * beta[..., None]
    causal = jnp.tril(jnp.ones((C, C), bool))
    strict = jnp.tril(jnp.ones((C, C), bool), -1)
    decay = jnp.exp(jnp.where(causal, gc[..., :, None] - gc[..., None, :], -jnp.inf))
    a = jnp.where(strict, jnp.einsum('nbhid,nbhjd->nbhij', kb, k) * decay, 0.0)
    t_mat = a + jnp.eye(C, dtype=f32)
    u = lax.linalg.triangular_solve(t_mat, vb, left_side=True, lower=True)
    w = lax.linalg.triangular_solve(t_mat, kb * jnp.exp(gc)[..., None], left_side=True, lower=True)
    qk = jnp.einsum('nbhid,nbhjd->nbhij', q, k) * decay
    q_dec = q * jnp.exp(gc)[..., None]
    k_end = k * jnp.exp(gc[..., -1:] - gc)[..., None]
    g_last = jnp.exp(gc[..., -1])

    def step(state, inp):
        qd, ke, u_c, w_c, qk_c, gl = inp
        v_new = u_c - jnp.einsum('bhcd,bhde->bhce', w_c, state)
        o = jnp.einsum('bhcd,bhde->bhce', qd, state) + jnp.einsum('bhij,bhje->bhie', qk_c, v_new)
        state = state * gl[..., None, None] + jnp.einsum('bhcd,bhce->bhde', ke, v_new)
        return state, o

    s0 = jnp.zeros((B, H, dk, dv), f32)
    _, o = lax.scan(step, s0, (q_dec, k_end, u, w, qk, g_last))
    return jnp.moveaxis(o, (0, 2), (1, 3)).reshape(B, S, H, dv)


def gated_deltanet(qkv, z, b_logit, a_logit, conv_w, a_log, dt_bias, out_norm):
    B, S, _ = qkv.shape
    f32 = jnp.float32
    qkv = jax.nn.silu(causal_depthwise_conv(qkv, conv_w))
    q, k, v = jnp.split(qkv, 3, axis=-1)
    q = l2norm(q.reshape(B, S, DN_HEADS, DN_HEAD_DIM))
    k = l2norm(k.reshape(B, S, DN_HEADS, DN_HEAD_DIM))
    v = v.reshape(B, S, DN_HEADS, DN_HEAD_DIM)
    beta = jax.nn.sigmoid(b_logit.astype(f32))
    g = -jnp.exp(a_log.astype(f32)) * jax.nn.softplus(a_logit.astype(f32) + dt_bias.astype(f32))
    o = chunk_gated_delta_rule(q, k, v, g, beta)
    o = rmsnorm(o, out_norm) * jax.nn.silu(z.reshape(B, S, DN_HEADS, DN_HEAD_DIM).astype(f32))
    return o.reshape(B, S, DN_W).astype(qkv.dtype)


def cmp_to_slc_overlap(n_cmp, n_sel):
    c0 = np.arange(n_cmp)[:, None] * CMP_STRIDE
    j0 = np.arange(n_sel)[None, :] * SLC_LEN
    ov = np.clip(np.minimum(c0 + CMP_LEN, j0 + SLC_LEN) - np.maximum(c0, j0), 0, None) / CMP_LEN
    return jnp.asarray(ov, jnp.float32)


def compress_blocks(t, pos_emb, w1, w2, idx):
    B, _, G, d = t.shape
    n_cmp = idx.shape[0]
    blk = t[:, idx] + pos_emb[:, None, :].astype(t.dtype)
    blk = jnp.moveaxis(blk, 3, 2).reshape(B, n_cmp, G, CMP_LEN * d)
    return jax.nn.gelu(blk @ w1) @ w2


def window_branch(q, k, v, slopes):
    B, S, G, R, _ = q.shape
    span = WINDOW + ATT_QBLK
    kp = jnp.pad(k, ((0, 0), (WINDOW, 0), (0, 0), (0, 0)))
    vp = jnp.pad(v, ((0, 0), (WINDOW, 0), (0, 0), (0, 0)))

    def block(i):
        t0 = i * ATT_QBLK
        qb = lax.dynamic_slice_in_dim(q, t0, ATT_QBLK, axis=1)
        kb = lax.dynamic_slice_in_dim(kp, t0, span, axis=1)
        vb = lax.dynamic_slice_in_dim(vp, t0, span, axis=1)
        qpos = t0 + jnp.arange(ATT_QBLK)
        kpos = t0 - WINDOW + jnp.arange(span)
        dist = qpos[:, None] - kpos[None, :]
        mask = (dist >= 0) & (dist < WINDOW) & (kpos[None, :] >= 0)
        s = jnp.einsum('bqgrd,bkgd->bgrqk', qb, kb).astype(jnp.float32) - slopes[:, :, None, None] * dist
        p = jax.nn.softmax(jnp.where(mask, s, NEG), axis=-1).astype(vb.dtype)
        return jnp.einsum('bgrqk,bkge->bqgre', p, vb)

    o = lax.map(block, jnp.arange(S // ATT_QBLK))
    return jnp.moveaxis(o, 0, 1).reshape(B, S, G, R, -1)


def selection_branch(q, k, v, sel_idx, slopes):
    B, S, G, R, dk = q.shape
    dv = v.shape[-1]
    n_sel = S // SLC_LEN
    K = sel_idx.shape[-1]
    kblk = jnp.moveaxis(k.reshape(B, n_sel, SLC_LEN, G, dk), 3, 1).reshape(B, G, n_sel, SLC_LEN * dk)
    vblk = jnp.moveaxis(v.reshape(B, n_sel, SLC_LEN, G, dv), 3, 1).reshape(B, G, n_sel, SLC_LEN * dv)
    gather = jax.vmap(jax.vmap(lambda tab, ix: tab[ix]))

    def block(i):
        t0 = i * SLC_QBLK
        qb = lax.dynamic_slice_in_dim(q, t0, SLC_QBLK, axis=1)
        ib = lax.dynamic_slice_in_dim(sel_idx, t0, SLC_QBLK, axis=2)
        flat = ib.reshape(B, G, SLC_QBLK * K)
        kg = gather(kblk, flat).reshape(B, G, SLC_QBLK, K * SLC_LEN, dk)
        vg = gather(vblk, flat).reshape(B, G, SLC_QBLK, K * SLC_LEN, dv)
        kpos = (ib[..., None] * SLC_LEN + jnp.arange(SLC_LEN)).reshape(B, G, SLC_QBLK, K * SLC_LEN)
        qpos = t0 + jnp.arange(SLC_QBLK)
        dist = (qpos[:, None] - kpos)[:, :, None]
        s = jnp.einsum('bqgrd,bgqkd->bgrqk', qb, kg).astype(jnp.float32) - slopes[None, :, :, None, None] * dist
        p = jax.nn.softmax(jnp.where(dist >= 0, s, NEG), axis=-1).astype(vg.dtype)
        return jnp.einsum('bgrqk,bgqke->bqgre', p, vg)

    o = lax.map(block, jnp.arange(S // SLC_QBLK))
    return jnp.moveaxis(o, 0, 1).reshape(B, S, G, R, dv)


def nsa_mixer(q, k_c, v_c, k_s, v_s, k_w, v_w, gate_logits, q_norm, kn_cmp, kn_slc, kn_win,
              cmp_pos_k, cmp_w1_k, cmp_w2_k, cmp_pos_v, cmp_w1_v, cmp_w2_v):
    B, S, _ = q.shape
    G, R, d = NSA_GROUPS, NSA_REP, NSA_HEAD_DIM
    f32 = jnp.float32
    slopes = alibi_slopes(NSA_HEADS).reshape(G, R)
    pos = jnp.arange(S)
    q = (rmsnorm(q.reshape(B, S, NSA_HEADS, d), q_norm) * (d ** -0.5)).reshape(B, S, G, R, d)
    kv = lambda t: t.reshape(B, S, G, d)

    n_cmp = (S - CMP_LEN) // CMP_STRIDE + 1
    idx = np.arange(n_cmp)[:, None] * CMP_STRIDE + np.arange(CMP_LEN)[None, :]
    kc = rmsnorm(compress_blocks(kv(k_c), cmp_pos_k, cmp_w1_k, cmp_w2_k, idx), kn_cmp)
    vc = compress_blocks(kv(v_c), cmp_pos_v, cmp_w1_v, cmp_w2_v, idx)
    cmp_end = jnp.asarray(idx[:, -1])
    dist_c = pos[:, None] - cmp_end[None, :]
    s_c = jnp.einsum('bsgrd,bcgd->bgrsc', q, kc).astype(f32) - slopes[:, :, None, None] * dist_c
    any_valid = (pos >= CMP_LEN - 1).astype(f32)[:, None]
    p_c = jax.nn.softmax(jnp.where(dist_c >= 0, s_c, NEG), axis=-1) * any_valid
    o_cmp = jnp.einsum('bgrsc,bcgd->bsgrd', p_c.astype(vc.dtype), vc)

    n_sel = S // SLC_LEN
    imp = jnp.einsum('bgrsc,cj->bgsj', p_c, cmp_to_slc_overlap(n_cmp, n_sel))
    j = jnp.arange(n_sel)[None, :]
    blk_t = (pos // SLC_LEN)[:, None]
    imp = jnp.where(j <= blk_t, imp, NEG)
    imp = jnp.where((j == blk_t) | (j == 0), FORCE, imp)
    _, sel_idx = lax.top_k(imp, min(SLC_TOPK, n_sel))
    o_slc = selection_branch(q, rmsnorm(kv(k_s), kn_slc), kv(v_s), sel_idx, slopes)

    o_win = window_branch(q, rmsnorm(kv(k_w), kn_win), kv(v_w), slopes)

    gates = jax.nn.sigmoid(gate_logits.astype(f32)).reshape(B, S, G, R, 3)
    o = gates[..., 0:1] * o_cmp + gates[..., 1:2] * o_slc + gates[..., 2:3] * o_win
    return o.reshape(B, S, NSA_W).astype(q.dtype)


def setup_inputs(seed: int = 0) -> dict:
    key = jax.random.key(seed)
    ks = jax.random.split(key, 24)
    f32 = jnp.float32
    L = DEPTH

    def nrm(k, shape, scale):
        return jax.random.normal(k, shape, f32) * scale

    def gain(k, n):
        return 1.0 + 0.02 * jax.random.normal(k, (L, n), f32)

    dt = jnp.exp(jax.random.uniform(ks[4], (L, DN_HEADS), f32, math.log(1e-3), math.log(1e-1)))
    flat = CMP_LEN * NSA_HEAD_DIM
    return {
        "x": nrm(ks[0], (BATCH, SEQ, D_MODEL), 1.0),
        "norm_mix": gain(ks[1], D_MODEL),
        "w_in": nrm(ks[2], (L, D_MODEL, IN_WIDTH), D_MODEL ** -0.5),
        "dn_conv": nrm(ks[3], (L, DN_CONV, 3 * DN_W), DN_CONV ** -0.5),
        "dn_a_log": jnp.log(jax.random.uniform(ks[5], (L, DN_HEADS), f32, 1.0, 16.0)),
        "dn_dt_bias": dt + jnp.log(-jnp.expm1(-dt)),
        "dn_out_norm": gain(ks[6], DN_HEAD_DIM),
        "nsa_q_norm": gain(ks[7], NSA_HEAD_DIM),
        "nsa_k_norm_cmp": gain(ks[8], NSA_HEAD_DIM),
        "nsa_k_norm_slc": gain(ks[9], NSA_HEAD_DIM),
        "nsa_k_norm_win": gain(ks[10], NSA_HEAD_DIM),
        "cmp_pos_k": nrm(ks[11], (L, CMP_LEN, NSA_HEAD_DIM), 0.1),
        "cmp_w1_k": nrm(ks[12], (L, flat, CMP_HIDDEN), flat ** -0.5),
        "cmp_w2_k": nrm(ks[13], (L, CMP_HIDDEN, NSA_HEAD_DIM), CMP_HIDDEN ** -0.5),
        "cmp_pos_v": nrm(ks[14], (L, CMP_LEN, NSA_HEAD_DIM), 0.1),
        "cmp_w1_v": nrm(ks[15], (L, flat, CMP_HIDDEN), flat ** -0.5),
        "cmp_w2_v": nrm(ks[16], (L, CMP_HIDDEN, NSA_HEAD_DIM), CMP_HIDDEN ** -0.5),
        "w_proj_dn": nrm(ks[17], (L, DN_W, D_MODEL), DN_W ** -0.5),
        "w_proj_nsa": nrm(ks[18], (L, NSA_W, D_MODEL), NSA_W ** -0.5),
        "w_out": nrm(ks[19], (L, D_MODEL, D_MODEL), D_MODEL ** -0.5),
        "norm_mlp": gain(ks[20], D_MODEL),
        "w_up": nrm(ks[21], (L, D_MODEL, D_FF), D_MODEL ** -0.5),
        "w_down": nrm(ks[22], (L, D_FF, D_MODEL), D_FF ** -0.5),
    }


def reference(x, norm_mix, w_in, dn_conv, dn_a_log, dn_dt_bias, dn_out_norm,
              nsa_q_norm, nsa_k_norm_cmp, nsa_k_norm_slc, nsa_k_norm_win,
              cmp_pos_k, cmp_w1_k, cmp_w2_k, cmp_pos_v, cmp_w1_v, cmp_w2_v,
              w_proj_dn, w_proj_nsa, w_out, norm_mlp, w_up, w_down):
    splits = _in_split_points()
    for l in range(DEPTH):
        h = rmsnorm(x, norm_mix[l])
        (dn_qkv, dn_z, dn_b, dn_a, ns_q, ns_kc, ns_vc, ns_ks, ns_vs, ns_kw, ns_vw, ns_gate,
         gate_dn, gate_nsa) = jnp.split(h @ w_in[l], splits, axis=-1)
        o_dn = gated_deltanet(dn_qkv, dn_z, dn_b, dn_a, dn_conv[l], dn_a_log[l], dn_dt_bias[l], dn_out_norm[l])
        o_ns = nsa_mixer(ns_q, ns_kc, ns_vc, ns_ks, ns_vs, ns_kw, ns_vw, ns_gate,
                         nsa_q_norm[l], nsa_k_norm_cmp[l], nsa_k_norm_slc[l], nsa_k_norm_win[l],
                         cmp_pos_k[l], cmp_w1_k[l], cmp_w2_k[l], cmp_pos_v[l], cmp_w1_v[l], cmp_w2_v[l])
        mix = jax.nn.sigmoid(gate_dn) * (o_dn @ w_proj_dn[l]) + jax.nn.sigmoid(gate_nsa) * (o_ns @ w_proj_nsa[l])
        x = x + mix @ w_out[l]
        h2 = rmsnorm(x, norm_mlp[l])
        x = x + jnp.square(jax.nn.relu(h2 @ w_up[l])) @ w_down[l]
    return x
```

```cpp
#include <hip/hip_runtime.h>
#include <stdint.h>

typedef unsigned short bf16_t;

constexpr int D = 1024, BATCH = 8, SEQ = 2048, M = BATCH * SEQ;
constexpr int DN_H = 8, DN_D = 128;
constexpr int NS_H = 16, NS_G = 4, NS_R = 4, NS_D = 64;
constexpr int NCMP = 127, NSEL = 32;
constexpr int FF = 4096;
constexpr int INW = 8768;
constexpr float EPS = 1e-6f;
constexpr float NEGV = -1e30f, FORCEV = 1e9f;

constexpr int LDP = 6720;
constexpr int C_DQ = 0, C_DK = 1024, C_DV = 2048, C_DZ = 3072, C_NQ = 4096;
constexpr int C_KC = 5120, C_VC = 5376, C_KS = 5632, C_VS = 5888, C_KW = 6144, C_VW = 6400;
constexpr int C_SB = 6656, C_SA = 6664, C_SG = 6672;

__device__ __forceinline__ float bf2f(bf16_t v) { return __uint_as_float(((unsigned)v) << 16); }
__device__ __forceinline__ bf16_t f2bf(float f) { unsigned u = __float_as_uint(f); return (bf16_t)((u + 0x7fffu + ((u >> 16) & 1u)) >> 16); }
__device__ __forceinline__ float sigmoidf_(float x) { return 1.f / (1.f + __expf(-x)); }
__device__ __forceinline__ float siluf_(float x) { return x * sigmoidf_(x); }
__device__ __forceinline__ float softplusf_(float x) { return fmaxf(x, 0.f) + log1pf(__expf(-fabsf(x))); }
__device__ __forceinline__ float gelu_tanh(float x) { return 0.5f * x * (1.f + tanhf(0.7978845608028654f * (x + 0.044715f * x * x * x))); }

__device__ __forceinline__ float block_sum(float v, float* red) {
    for (int o = 32; o > 0; o >>= 1) v += __shfl_xor(v, o);
    const int w = threadIdx.x >> 6, nw = blockDim.x >> 6;
    __syncthreads();
    if ((threadIdx.x & 63) == 0) red[w] = v;
    __syncthreads();
    float s = 0.f;
    for (int i = 0; i < nw; ++i) s += red[i];
    return s;
}
__device__ __forceinline__ float block_max(float v, float* red) {
    for (int o = 32; o > 0; o >>= 1) v = fmaxf(v, __shfl_xor(v, o));
    const int w = threadIdx.x >> 6, nw = blockDim.x >> 6;
    __syncthreads();
    if ((threadIdx.x & 63) == 0) red[w] = v;
    __syncthreads();
    float s = red[0];
    for (int i = 1; i < nw; ++i) s = fmaxf(s, red[i]);
    return s;
}

template <int OUT_BF16>
__global__ void __launch_bounds__(256) k_rmsnorm(const float* __restrict__ x, const float* __restrict__ gain, void* out) {
    __shared__ float red[8];
    const int m = blockIdx.x;
    const float* xr = x + (size_t)m * D;
    float v[4]; float s = 0.f;
    for (int i = 0; i < 4; ++i) { v[i] = xr[threadIdx.x + 256 * i]; s += v[i] * v[i]; }
    s = block_sum(s, red);
    const float r = rsqrtf(s * (1.f / D) + EPS);
    for (int i = 0; i < 4; ++i) {
        const int c = threadIdx.x + 256 * i; const float y = v[i] * r * gain[c];
        if (OUT_BF16) ((bf16_t*)out)[(size_t)m * D + c] = f2bf(y); else ((float*)out)[(size_t)m * D + c] = y;
    }
}

struct GemmArgs {
    const void* A; int lda; const float* B; int ldb; int bcol0;
    const void* A2; const float* B2; int ldb2;
    void* C; int ldc; int ccol0;
    const float* X; const bf16_t* gates;
    int Mrows, N, K;
};
template <int AMODE, int EPI>
__global__ void __launch_bounds__(256) k_gemm(GemmArgs g) {
    __shared__ float As[16][68];
    __shared__ float Bs[16][68];
    const int tx = threadIdx.x & 15, ty = threadIdx.x >> 4;
    const int n0 = blockIdx.x * 64, m0 = blockIdx.y * 64;
    float acc[4][4], acc2[4][4];
#pragma unroll
    for (int i = 0; i < 4; ++i)
#pragma unroll
        for (int j = 0; j < 4; ++j) { acc[i][j] = 0.f; acc2[i][j] = 0.f; }
    const int npass = (EPI == 1) ? 2 : 1;
    for (int pass = 0; pass < npass; ++pass) {
        const void* A = pass ? g.A2 : g.A; const float* B = pass ? g.B2 : g.B; const int ldb = pass ? g.ldb2 : g.ldb;
        const int bc0 = pass ? 0 : g.bcol0;
        for (int k0 = 0; k0 < g.K; k0 += 16) {
            {
                const int r = threadIdx.x >> 2, kq = (threadIdx.x & 3) * 4;
#pragma unroll
                for (int i = 0; i < 4; ++i) {
                    float v;
                    if (AMODE == 0) v = ((const float*)A)[(size_t)(m0 + r) * g.lda + k0 + kq + i];
                    else v = bf2f(((const bf16_t*)A)[(size_t)(m0 + r) * g.lda + k0 + kq + i]);
                    As[kq + i][r] = v;
                }
                const int kk = threadIdx.x >> 4, nq = (threadIdx.x & 15) * 4;
#pragma unroll
                for (int i = 0; i < 4; ++i) { const int n = n0 + nq + i; Bs[kk][nq + i] = (n < g.N) ? B[(size_t)(k0 + kk) * ldb + bc0 + n] : 0.f; }
            }
            __syncthreads();
#pragma unroll
            for (int k = 0; k < 16; ++k) {
                float a[4], b[4];
#pragma unroll
                for (int i = 0; i < 4; ++i) { a[i] = As[k][ty * 4 + i]; b[i] = Bs[k][tx * 4 + i]; }
#pragma unroll
                for (int i = 0; i < 4; ++i)
#pragma unroll
                    for (int j = 0; j < 4; ++j) { if (pass == 0) acc[i][j] += a[i] * b[j]; else acc2[i][j] += a[i] * b[j]; }
            }
            __syncthreads();
        }
    }
#pragma unroll
    for (int i = 0; i < 4; ++i)
#pragma unroll
        for (int j = 0; j < 4; ++j) {
            const int m = m0 + ty * 4 + i, n = n0 + tx * 4 + j;
            if (n >= g.N) continue;
            const size_t ci = (size_t)m * g.ldc + g.ccol0 + n;
            if (EPI == 0) ((bf16_t*)g.C)[ci] = f2bf(acc[i][j]);
            else if (EPI == 1) {
                const float s1 = sigmoidf_(bf2f(g.gates[(size_t)m * 2048 + n])), s2 = sigmoidf_(bf2f(g.gates[(size_t)m * 2048 + 1024 + n]));
                ((bf16_t*)g.C)[ci] = f2bf(s1 * acc[i][j] + s2 * acc2[i][j]);
            }
            else if (EPI == 2) ((float*)g.C)[ci] = g.X[(size_t)m * g.ldc + n] + acc[i][j];
            else if (EPI == 3) { const float r = fmaxf(acc[i][j], 0.f); ((float*)g.C)[ci] = r * r; }
            else if (EPI == 4) ((float*)g.C)[ci] += acc[i][j];
        }
}

__global__ void __launch_bounds__(256) k_gdn_conv(bf16_t* P, const float* __restrict__ convw) {
    const int idx = blockIdx.x * 256 + threadIdx.x;
    if (idx >= BATCH * 3072) return;
    const int b = idx / 3072, c = idx % 3072;
    const float w0 = convw[c], w1 = convw[3072 + c], w2 = convw[2 * 3072 + c], w3 = convw[3 * 3072 + c];
    bf16_t* col = P + (size_t)b * SEQ * LDP + c;
    float x3 = bf2f(col[(size_t)(SEQ - 1) * LDP]), x2 = bf2f(col[(size_t)(SEQ - 2) * LDP]), x1 = bf2f(col[(size_t)(SEQ - 3) * LDP]);
    for (int t = SEQ - 1; t >= 0; --t) {
        const float x0 = (t >= 3) ? bf2f(col[(size_t)(t - 3) * LDP]) : 0.f;
        const float y = w0 * x0 + w1 * x1 + w2 * x2 + w3 * x3;
        col[(size_t)t * LDP] = f2bf(siluf_(y));
        x3 = x2; x2 = x1; x1 = x0;
    }
}
__global__ void __launch_bounds__(256) k_gdn_l2norm(bf16_t* P) {
    const int unit = blockIdx.x * 4 + (threadIdx.x >> 6), lane = threadIdx.x & 63;
    const int m = unit / 16, r = unit % 16, which = r / 8, h = r % 8;
    bf16_t* p = P + (size_t)m * LDP + (which ? C_DK : C_DQ) + h * DN_D;
    float a = bf2f(p[lane]), b = bf2f(p[lane + 64]);
    float s = a * a + b * b;
    for (int o = 32; o > 0; o >>= 1) s += __shfl_xor(s, o);
    const float r_ = rsqrtf(s + EPS);
    p[lane] = f2bf(a * r_); p[lane + 64] = f2bf(b * r_);
}
__global__ void __launch_bounds__(128) k_gdn_scan(bf16_t* P, const float* __restrict__ a_log, const float* __restrict__ dt_bias, const float* __restrict__ out_norm) {
    __shared__ float qs[128], ks[128], red[2];
    const int b = blockIdx.x / DN_H, h = blockIdx.x % DN_H, j = threadIdx.x;
    float s[128];
#pragma unroll
    for (int i = 0; i < 128; ++i) s[i] = 0.f;
    const float Ah = -__expf(a_log[h]), dtb = dt_bias[h], gn = out_norm[j];
    const float scale = 0.08838834764831845f;
    for (int t = 0; t < SEQ; ++t) {
        bf16_t* row = P + (size_t)(b * SEQ + t) * LDP;
        __syncthreads();
        qs[j] = bf2f(row[C_DQ + h * DN_D + j]); ks[j] = bf2f(row[C_DK + h * DN_D + j]);
        const float v = bf2f(row[C_DV + h * DN_D + j]);
        const float beta = sigmoidf_(bf2f(row[C_SB + h]));
        const float gdec = Ah * softplusf_(bf2f(row[C_SA + h]) + dtb);
        const float a = __expf(gdec);
        const float z = bf2f(row[C_DZ + h * DN_D + j]);
        __syncthreads();
        float kS = 0.f;
#pragma unroll
        for (int i = 0; i < 128; ++i) kS += ks[i] * s[i];
        const float dlt = beta * (v - a * kS);
        float o = 0.f;
#pragma unroll
        for (int i = 0; i < 128; ++i) { s[i] = a * s[i] + ks[i] * dlt; o += qs[i] * s[i]; }
        o *= scale;
        const float ss = block_sum(o * o, red);
        const float y = o * rsqrtf(ss * (1.f / 128.f) + EPS) * gn * siluf_(z);
        row[C_DV + h * DN_D + j] = f2bf(y);
    }
}

__global__ void __launch_bounds__(256) k_nsa_prep(bf16_t* P, const float* __restrict__ qn, const float* __restrict__ kns, const float* __restrict__ knw) {
    const int unit = blockIdx.x * 4 + (threadIdx.x >> 6), lane = threadIdx.x & 63;
    const int m = unit / 24, r = unit % 24;
    bf16_t* p; const float* g; float sc = 1.f;
    if (r < 16) { p = P + (size_t)m * LDP + C_NQ + r * 64; g = qn; sc = 0.125f; }
    else if (r < 20) { p = P + (size_t)m * LDP + C_KS + (r - 16) * 64; g = kns; }
    else { p = P + (size_t)m * LDP + C_KW + (r - 20) * 64; g = knw; }
    const float a = bf2f(p[lane]);
    float s = a * a;
    for (int o = 32; o > 0; o >>= 1) s += __shfl_xor(s, o);
    p[lane] = f2bf(a * rsqrtf(s * (1.f / 64.f) + EPS) * g[lane] * sc);
}
__global__ void __launch_bounds__(128) k_nsa_compress(const bf16_t* __restrict__ P, const float* __restrict__ pos_k, const float* __restrict__ w1_k, const float* __restrict__ w2_k,
                                                      const float* __restrict__ pos_v, const float* __restrict__ w1_v, const float* __restrict__ w2_v,
                                                      const float* __restrict__ kn_cmp, float* kc, float* vc) {
    __shared__ float in[2048]; __shared__ float hid[128]; __shared__ float red[2];
    int id = blockIdx.x; const int which = id & 1; id >>= 1; const int g = id % NS_G; id /= NS_G; const int c = id % NCMP; const int b = id / NCMP;
    const float* pos = which ? pos_v : pos_k; const float* w1 = which ? w1_v : w1_k; const float* w2 = which ? w2_v : w2_k;
    const int col = (which ? C_VC : C_KC) + g * 64;
    for (int e = threadIdx.x; e < 2048; e += 128) { const int l = e >> 6, d = e & 63; in[e] = bf2f(P[(size_t)(b * SEQ + 16 * c + l) * LDP + col + d]) + pos[e]; }
    __syncthreads();
    float a = 0.f;
    for (int e = 0; e < 2048; ++e) a += in[e] * w1[(size_t)e * 128 + threadIdx.x];
    hid[threadIdx.x] = gelu_tanh(a);
    __syncthreads();
    float o = 0.f;
    if (threadIdx.x < 64) for (int i = 0; i < 128; ++i) o += hid[i] * w2[i * 64 + threadIdx.x];
    float* dst = (which ? vc : kc) + ((size_t)(b * NCMP + c) * NS_G + g) * 64;
    if (which == 0) {
        const float ss = block_sum(threadIdx.x < 64 ? o * o : 0.f, red);
        if (threadIdx.x < 64) dst[threadIdx.x] = o * rsqrtf(ss * (1.f / 64.f) + EPS) * kn_cmp[threadIdx.x];
    } else if (threadIdx.x < 64) dst[threadIdx.x] = o;
}
__global__ void __launch_bounds__(256) k_nsa_main(bf16_t* P, const float* __restrict__ kc, const float* __restrict__ vc) {
    __shared__ float q[4][64];
    __shared__ float sc[4][512];
    __shared__ float imp[32];
    __shared__ int sel[8];
    __shared__ float red[4];
    __shared__ float oacc[4][64];
    const int tid = threadIdx.x;
    int id = blockIdx.x; const int g = id % NS_G; id /= NS_G; const int s = id % SEQ; const int b = id / SEQ;
    bf16_t* row = P + (size_t)(b * SEQ + s) * LDP;
    const int r_ = tid >> 6, d_ = tid & 63;
    q[r_][d_] = bf2f(row[C_NQ + (g * 4 + r_) * 64 + d_]);
    const float gate0 = sigmoidf_(bf2f(row[C_SG + (g * 4 + r_) * 3 + 0])), gate1 = sigmoidf_(bf2f(row[C_SG + (g * 4 + r_) * 3 + 1])), gate2 = sigmoidf_(bf2f(row[C_SG + (g * 4 + r_) * 3 + 2]));
    __syncthreads();
    float slope[4];
#pragma unroll
    for (int r = 0; r < 4; ++r) slope[r] = exp2f(-0.5f * (float)(g * 4 + r + 1));
    for (int e = tid; e < 4 * 128; e += 256) {
        const int r = e >> 7, c = e & 127; float v = NEGV;
        if (c < NCMP) {
            const int dist = s - (16 * c + 31);
            if (dist >= 0) { const float* kk = kc + ((size_t)(b * NCMP + c) * NS_G + g) * 64; float a = 0.f; for (int d = 0; d < 64; ++d) a += q[r][d] * kk[d]; v = a - slope[r] * (float)dist; }
        } else v = -INFINITY;
        sc[r][c] = v;
    }
    __syncthreads();
    for (int r = 0; r < 4; ++r) {
        float mx = -INFINITY; for (int c = tid; c < NCMP; c += 256) mx = fmaxf(mx, sc[r][c]);
        mx = block_max(mx, red);
        float e_ = 0.f; if (tid < NCMP) { e_ = __expf(sc[r][tid] - mx); }
        const float sum = block_sum(e_, red);
        __syncthreads();
        if (tid < NCMP) sc[r][tid] = (s >= 31) ? e_ / sum : 0.f;
        if (tid == 127) sc[r][127] = 0.f;
    }
    __syncthreads();
    float ocmp = 0.f;
    for (int c = 0; c < NCMP; ++c) ocmp += sc[r_][c] * vc[((size_t)(b * NCMP + c) * NS_G + g) * 64 + d_];
    const int blk_t = s >> 6;
    if (tid < 32) {
        const int j = tid; float a = 0.f;
        for (int c = 0; c < NCMP; ++c) {
            int lo = max(16 * c, 64 * j), hi = min(16 * c + 32, 64 * j + 64); int ov = hi - lo; if (ov < 0) ov = 0;
            if (ov > 0) { const float w = (float)ov * (1.f / 32.f); for (int r = 0; r < 4; ++r) a += sc[r][c] * w; }
        }
        if (j > blk_t) a = NEGV;
        if (j == blk_t || j == 0) a = FORCEV;
        imp[j] = a;
    }
    __syncthreads();
    if (tid == 0) {
        for (int k = 0; k < 8; ++k) { int bi = 0; float bv = -INFINITY; for (int j = 0; j < 32; ++j) if (imp[j] > bv) { bv = imp[j]; bi = j; } sel[k] = bi; imp[bi] = -INFINITY; }
    }
    __syncthreads();
    for (int e = tid; e < 4 * 512; e += 256) {
        const int r = e >> 9, kk = e & 511; const int kpos = sel[kk >> 6] * 64 + (kk & 63); const int dist = s - kpos; float v = NEGV;
        if (dist >= 0) { const bf16_t* kp = P + (size_t)(b * SEQ + kpos) * LDP + C_KS + g * 64; float a = 0.f; for (int d = 0; d < 64; ++d) a += q[r][d] * bf2f(kp[d]); v = a - slope[r] * (float)dist; }
        sc[r][kk] = v;
    }
    __syncthreads();
    for (int r = 0; r < 4; ++r) {
        float mx = fmaxf(sc[r][tid], sc[r][tid + 256]);
        mx = block_max(mx, red);
        const float e0 = __expf(sc[r][tid] - mx), e1 = __expf(sc[r][tid + 256] - mx);
        const float sum = block_sum(e0 + e1, red);
        __syncthreads();
        sc[r][tid] = e0 / sum; sc[r][tid + 256] = e1 / sum;
    }
    __syncthreads();
    float oslc = 0.f;
    for (int kk = 0; kk < 512; ++kk) { const float p = sc[r_][kk]; if (p != 0.f) { const int kpos = sel[kk >> 6] * 64 + (kk & 63); oslc += p * bf2f(P[(size_t)(b * SEQ + kpos) * LDP + C_VS + g * 64 + d_]); } }
    __syncthreads();
    for (int e = tid; e < 4 * 256; e += 256) {
        const int r = e >> 8, w = e & 255; const int kpos = s - w; float v = NEGV;
        if (kpos >= 0) { const bf16_t* kp = P + (size_t)(b * SEQ + kpos) * LDP + C_KW + g * 64; float a = 0.f; for (int d = 0; d < 64; ++d) a += q[r][d] * bf2f(kp[d]); v = a - slope[r] * (float)w; }
        sc[r][w] = v;
    }
    __syncthreads();
    for (int r = 0; r < 4; ++r) {
        float mx = block_max(sc[r][tid], red);
        const float e0 = __expf(sc[r][tid] - mx);
        const float sum = block_sum(e0, red);
        __syncthreads();
        sc[r][tid] = e0 / sum;
    }
    __syncthreads();
    float owin = 0.f;
    for (int w = 0; w < 256; ++w) { const int kpos = s - w; if (kpos >= 0) owin += sc[r_][w] * bf2f(P[(size_t)(b * SEQ + kpos) * LDP + C_VW + g * 64 + d_]); }
    row[C_NQ + (g * 4 + r_) * 64 + d_] = f2bf(gate0 * ocmp + gate1 * oslc + gate2 * owin);
}

template <int AMODE, int EPI> static void launch_gemm(const GemmArgs& g, hipStream_t st) {
    dim3 grid((g.N + 63) / 64, g.Mrows / 64);
    hipLaunchKernelGGL((k_gemm<AMODE, EPI>), grid, dim3(256), 0, st, g);
}

extern "C" void kernel_launch(void* const* d_in, const int* in_sizes, int n_in, void* d_out, int out_size, void* d_ws, size_t ws_size, hipStream_t stream) {
    const float* x = (const float*)d_in[0]; const float* norm_mix = (const float*)d_in[1]; const float* w_in = (const float*)d_in[2];
    const float* dn_conv = (const float*)d_in[3]; const float* dn_a_log = (const float*)d_in[4]; const float* dn_dt_bias = (const float*)d_in[5]; const float* dn_out_norm = (const float*)d_in[6];
    const float* q_norm = (const float*)d_in[7]; const float* kn_cmp = (const float*)d_in[8]; const float* kn_slc = (const float*)d_in[9]; const float* kn_win = (const float*)d_in[10];
    const float* pos_k = (const float*)d_in[11]; const float* w1_k = (const float*)d_in[12]; const float* w2_k = (const float*)d_in[13];
    const float* pos_v = (const float*)d_in[14]; const float* w1_v = (const float*)d_in[15]; const float* w2_v = (const float*)d_in[16];
    const float* w_dn = (const float*)d_in[17]; const float* w_nsa = (const float*)d_in[18]; const float* w_out = (const float*)d_in[19];
    const float* norm_mlp = (const float*)d_in[20]; const float* w_up = (const float*)d_in[21]; const float* w_down = (const float*)d_in[22];
    float* out = (float*)d_out;
    char* ws = (char*)d_ws;
    const size_t MiB = 1u << 20;
    bf16_t* P = (bf16_t*)ws;
    bf16_t* hbuf = (bf16_t*)(ws + 210 * MiB);
    float* kc = (float*)(ws + 242 * MiB);
    float* vc = (float*)(ws + 244 * MiB);
    bf16_t* gates = (bf16_t*)d_out;
    bf16_t* mix = hbuf;
    float* h2 = (float*)ws;
    float* up = (float*)(ws + 64 * MiB);

    hipLaunchKernelGGL((k_rmsnorm<1>), dim3(M), dim3(256), 0, stream, x, norm_mix, (void*)hbuf);
    {
        GemmArgs g{}; g.A = hbuf; g.lda = D; g.B = w_in; g.ldb = INW; g.C = P; g.ldc = LDP; g.Mrows = M; g.K = D;
        g.bcol0 = 0; g.ccol0 = 0; g.N = 4096; launch_gemm<1, 0>(g, stream);
        g.bcol0 = 4112; g.ccol0 = C_NQ; g.N = 2560; launch_gemm<1, 0>(g, stream);
        g.bcol0 = 4096; g.ccol0 = C_SB; g.N = 16; launch_gemm<1, 0>(g, stream);
        g.bcol0 = 6672; g.ccol0 = C_SG; g.N = 48; launch_gemm<1, 0>(g, stream);
        g.C = gates; g.ldc = 2048; g.bcol0 = 6720; g.ccol0 = 0; g.N = 2048; launch_gemm<1, 0>(g, stream);
    }
    hipLaunchKernelGGL(k_gdn_conv, dim3(BATCH * 3072 / 256), dim3(256), 0, stream, P, dn_conv);
    hipLaunchKernelGGL(k_gdn_l2norm, dim3(M * 16 / 4), dim3(256), 0, stream, P);
    hipLaunchKernelGGL(k_gdn_scan, dim3(BATCH * DN_H), dim3(128), 0, stream, P, dn_a_log, dn_dt_bias, dn_out_norm);
    hipLaunchKernelGGL(k_nsa_prep, dim3(M * 24 / 4), dim3(256), 0, stream, P, q_norm, kn_slc, kn_win);
    hipLaunchKernelGGL(k_nsa_compress, dim3(BATCH * NCMP * NS_G * 2), dim3(128), 0, stream, (const bf16_t*)P, pos_k, w1_k, w2_k, pos_v, w1_v, w2_v, kn_cmp, kc, vc);
    hipLaunchKernelGGL(k_nsa_main, dim3(BATCH * SEQ * NS_G), dim3(256), 0, stream, P, (const float*)kc, (const float*)vc);
    {
        GemmArgs g{}; g.A = P + C_DV; g.lda = LDP; g.B = w_dn; g.ldb = D; g.bcol0 = 0; g.A2 = P + C_NQ; g.B2 = w_nsa; g.ldb2 = D;
        g.C = mix; g.ldc = D; g.ccol0 = 0; g.gates = gates; g.Mrows = M; g.N = D; g.K = D; launch_gemm<1, 1>(g, stream);
    }
    {
        GemmArgs g{}; g.A = mix; g.lda = D; g.B = w_out; g.ldb = D; g.C = out; g.ldc = D; g.X = x; g.Mrows = M; g.N = D; g.K = D; launch_gemm<1, 2>(g, stream);
    }
    hipLaunchKernelGGL((k_rmsnorm<0>), dim3(M), dim3(256), 0, stream, (const float*)out, norm_mlp, (void*)h2);
    for (int half = 0; half < 2; ++half) {
        const size_t r0 = (size_t)half * (M / 2);
        GemmArgs g{}; g.A = h2 + r0 * D; g.lda = D; g.B = w_up; g.ldb = FF; g.C = up; g.ldc = FF; g.Mrows = M / 2; g.N = FF; g.K = D; launch_gemm<0, 3>(g, stream);
        GemmArgs d{}; d.A = up; d.lda = FF; d.B = w_down; d.ldb = D; d.C = out + r0 * D; d.ldc = D; d.Mrows = M / 2; d.N = D; d.K = FF; launch_gemm<0, 4>(d, stream);
    }
}
```

```cpp
#include <hip/hip_runtime.h>
#include <hip/hip_cooperative_groups.h>
#include <stdint.h>
#include <cstdio>
namespace cg = cooperative_groups;

typedef unsigned short bf16_t;

constexpr int D = 1024, BATCH = 8, SEQ = 2048, M = BATCH * SEQ;
constexpr int DN_H = 8, DN_D = 128;
constexpr int NS_H = 16, NS_G = 4, NS_R = 4, NS_D = 64;
constexpr int NCMP = 127, NSEL = 32;
constexpr int FF = 4096;
constexpr int INW = 8768;
constexpr float EPS = 1e-6f;
constexpr float NEGV = -1e30f, FORCEV = 1e9f;

constexpr int LDP = 6720;
constexpr int C_DQ = 0, C_DK = 1024, C_DV = 2048, C_DZ = 3072, C_NQ = 4096;
constexpr int C_KC = 5120, C_VC = 5376, C_KS = 5632, C_VS = 5888, C_KW = 6144, C_VW = 6400;
constexpr int C_SB = 6656, C_SA = 6664, C_SG = 6672;
constexpr int NP1 = 6912;

__device__ __forceinline__ float bf2f(bf16_t v) { return __uint_as_float(((unsigned)v) << 16); }
__device__ __forceinline__ bf16_t f2bf(float f) { unsigned u = __float_as_uint(f); return (bf16_t)((u + 0x7fffu + ((u >> 16) & 1u)) >> 16); }
__device__ __forceinline__ float sigmoidf_(float x) { return 1.f / (1.f + __expf(-x)); }
__device__ __forceinline__ float siluf_(float x) { return x * sigmoidf_(x); }
__device__ __forceinline__ float softplusf_(float x) { return fmaxf(x, 0.f) + log1pf(__expf(-fabsf(x))); }
__device__ __forceinline__ float gelu_tanh(float x) { return 0.5f * x * (1.f + tanhf(0.7978845608028654f * (x + 0.044715f * x * x * x))); }

__device__ __forceinline__ float block_sum(float v, float* red) {
    for (int o = 32; o > 0; o >>= 1) v += __shfl_xor(v, o);
    const int w = threadIdx.x >> 6, nw = blockDim.x >> 6;
    __syncthreads();
    if ((threadIdx.x & 63) == 0) red[w] = v;
    __syncthreads();
    float s = 0.f;
    for (int i = 0; i < nw; ++i) s += red[i];
    return s;
}
__device__ __forceinline__ float block_max(float v, float* red) {
    for (int o = 32; o > 0; o >>= 1) v = fmaxf(v, __shfl_xor(v, o));
    const int w = threadIdx.x >> 6, nw = blockDim.x >> 6;
    __syncthreads();
    if ((threadIdx.x & 63) == 0) red[w] = v;
    __syncthreads();
    float s = red[0];
    for (int i = 1; i < nw; ++i) s = fmaxf(s, red[i]);
    return s;
}

struct GemmArgs {
    const void* A; int lda; const float* B; int ldb; int bcol0;
    const void* A2; const float* B2; int ldb2;
    void* C; int ldc; int ccol0;
    const float* X; const bf16_t* gates;
    int Mrows, N, K;
};
template <int AMODE, int EPI>
__global__ void __launch_bounds__(256) k_gemm(GemmArgs g) {
    __shared__ float As[16][68];
    __shared__ float Bs[16][68];
    const int tx = threadIdx.x & 15, ty = threadIdx.x >> 4;
    const int n0 = blockIdx.x * 64, m0 = blockIdx.y * 64;
    float acc[4][4], acc2[4][4];
#pragma unroll
    for (int i = 0; i < 4; ++i)
#pragma unroll
        for (int j = 0; j < 4; ++j) { acc[i][j] = 0.f; acc2[i][j] = 0.f; }
    const int npass = (EPI == 1 || EPI == 5) ? 2 : 1;
    for (int pass = 0; pass < npass; ++pass) {
        const void* A = pass ? g.A2 : g.A; const float* B = pass ? g.B2 : g.B; const int ldb = pass ? g.ldb2 : g.ldb;
        const int bc0 = pass ? 0 : g.bcol0;
        for (int k0 = 0; k0 < g.K; k0 += 16) {
            {
                const int r = threadIdx.x >> 2, kq = (threadIdx.x & 3) * 4;
#pragma unroll
                for (int i = 0; i < 4; ++i) {
                    float v;
                    if (AMODE == 0) v = ((const float*)A)[(size_t)(m0 + r) * g.lda + k0 + kq + i];
                    else v = bf2f(((const bf16_t*)A)[(size_t)(m0 + r) * g.lda + k0 + kq + i]);
                    As[kq + i][r] = v;
                }
                const int kk = threadIdx.x >> 4, nq = (threadIdx.x & 15) * 4;
#pragma unroll
                for (int i = 0; i < 4; ++i) { const int n = n0 + nq + i; Bs[kk][nq + i] = (n < g.N) ? B[(size_t)(k0 + kk) * ldb + bc0 + n] : 0.f; }
            }
            __syncthreads();
#pragma unroll
            for (int k = 0; k < 16; ++k) {
                float a[4], b[4];
#pragma unroll
                for (int i = 0; i < 4; ++i) { a[i] = As[k][ty * 4 + i]; b[i] = Bs[k][tx * 4 + i]; }
#pragma unroll
                for (int i = 0; i < 4; ++i)
#pragma unroll
                    for (int j = 0; j < 4; ++j) { if (pass == 0) acc[i][j] += a[i] * b[j]; else acc2[i][j] += a[i] * b[j]; }
            }
            __syncthreads();
        }
    }
#pragma unroll
    for (int i = 0; i < 4; ++i)
#pragma unroll
        for (int j = 0; j < 4; ++j) {
            const int m = m0 + ty * 4 + i, n = n0 + tx * 4 + j;
            if (n >= g.N) continue;
            const size_t ci = (size_t)m * g.ldc + g.ccol0 + n;
            if (EPI == 0) ((bf16_t*)g.C)[ci] = f2bf(acc[i][j]);
            else if (EPI == 1) {
                const float s1 = sigmoidf_(bf2f(g.gates[(size_t)m * 2048 + n])), s2 = sigmoidf_(bf2f(g.gates[(size_t)m * 2048 + 1024 + n]));
                ((bf16_t*)g.C)[ci] = f2bf(s1 * acc[i][j] + s2 * acc2[i][j]);
            }
            else if (EPI == 6) ((bf16_t*)g.C)[ci] = f2bf(sigmoidf_(acc[i][j]));
            else if (EPI == 7) ((bf16_t*)g.C)[ci] = f2bf(0.5f);
            else if (EPI == 5) {
                const float s1 = bf2f(g.gates[(size_t)m * LDP + n]), s2 = bf2f(g.gates[(size_t)m * LDP + 1024 + n]);
                ((bf16_t*)g.C)[ci] = f2bf(s1 * acc[i][j] + s2 * acc2[i][j]);
            }
            else if (EPI == 2) ((float*)g.C)[ci] = g.X[(size_t)m * g.ldc + n] + acc[i][j];
            else if (EPI == 3) { const float r = fmaxf(acc[i][j], 0.f); ((float*)g.C)[ci] = r * r; }
            else if (EPI == 4) ((float*)g.C)[ci] += acc[i][j];
        }
}

template <int AMODE, int EPI> static void launch_gemm(const GemmArgs& g, hipStream_t st) {
    dim3 grid((g.N + 63) / 64, g.Mrows / 64);
    hipLaunchKernelGGL((k_gemm<AMODE, EPI>), grid, dim3(256), 0, st, g);
}

template <int OUT_BF16>
__global__ void __launch_bounds__(256) k_rmsnorm(const float* __restrict__ x, const float* __restrict__ gain, void* out) {
    __shared__ float red[8];
    const int m = blockIdx.x;
    const float* xr = x + (size_t)m * D;
    float v[4]; float s = 0.f;
    for (int i = 0; i < 4; ++i) { v[i] = xr[threadIdx.x + 256 * i]; s += v[i] * v[i]; }
    s = block_sum(s, red);
    const float r = rsqrtf(s * (1.f / D) + EPS);
    for (int i = 0; i < 4; ++i) {
        const int c = threadIdx.x + 256 * i; const float y = v[i] * r * gain[c];
        if (OUT_BF16) ((bf16_t*)out)[(size_t)m * D + c] = f2bf(y); else ((float*)out)[(size_t)m * D + c] = y;
    }
}

__global__ void __launch_bounds__(256) k_gdn_conv(bf16_t* P, const float* __restrict__ convw) {
    const int idx = blockIdx.x * 256 + threadIdx.x;
    if (idx >= BATCH * 3072) return;
    const int b = idx / 3072, c = idx % 3072;
    const float w0 = convw[c], w1 = convw[3072 + c], w2 = convw[2 * 3072 + c], w3 = convw[3 * 3072 + c];
    bf16_t* col = P + (size_t)b * SEQ * LDP + c;
    float x3 = bf2f(col[(size_t)(SEQ - 1) * LDP]), x2 = bf2f(col[(size_t)(SEQ - 2) * LDP]), x1 = bf2f(col[(size_t)(SEQ - 3) * LDP]);
    for (int t = SEQ - 1; t >= 0; --t) {
        const float x0 = (t >= 3) ? bf2f(col[(size_t)(t - 3) * LDP]) : 0.f;
        const float y = w0 * x0 + w1 * x1 + w2 * x2 + w3 * x3;
        col[(size_t)t * LDP] = f2bf(siluf_(y));
        x3 = x2; x2 = x1; x1 = x0;
    }
}
__global__ void __launch_bounds__(256) k_gdn_l2norm(bf16_t* P) {
    const int unit = blockIdx.x * 4 + (threadIdx.x >> 6), lane = threadIdx.x & 63;
    const int m = unit / 16, r = unit % 16, which = r / 8, h = r % 8;
    bf16_t* p = P + (size_t)m * LDP + (which ? C_DK : C_DQ) + h * DN_D;
    float a = bf2f(p[lane]), b = bf2f(p[lane + 64]);
    float s = a * a + b * b;
    for (int o = 32; o > 0; o >>= 1) s += __shfl_xor(s, o);
    const float r_ = rsqrtf(s + EPS);
    p[lane] = f2bf(a * r_); p[lane + 64] = f2bf(b * r_);
}
__global__ void __launch_bounds__(128) k_gdn_scan(bf16_t* P, const float* __restrict__ a_log, const float* __restrict__ dt_bias, const float* __restrict__ out_norm) {
    __shared__ float qs[128], ks[128], red[2];
    const int b = blockIdx.x / DN_H, h = blockIdx.x % DN_H, j = threadIdx.x;
    float s[128];
#pragma unroll
    for (int i = 0; i < 128; ++i) s[i] = 0.f;
    const float Ah = -__expf(a_log[h]), dtb = dt_bias[h], gn = out_norm[j];
    const float scale = 0.08838834764831845f;
    for (int t = 0; t < SEQ; ++t) {
        bf16_t* row = P + (size_t)(b * SEQ + t) * LDP;
        __syncthreads();
        qs[j] = bf2f(row[C_DQ + h * DN_D + j]); ks[j] = bf2f(row[C_DK + h * DN_D + j]);
        const float v = bf2f(row[C_DV + h * DN_D + j]);
        const float beta = sigmoidf_(bf2f(row[C_SB + h]));
        const float gdec = Ah * softplusf_(bf2f(row[C_SA + h]) + dtb);
        const float a = __expf(gdec);
        const float z = bf2f(row[C_DZ + h * DN_D + j]);
        __syncthreads();
        float kS = 0.f;
#pragma unroll
        for (int i = 0; i < 128; ++i) kS += ks[i] * s[i];
        const float dlt = beta * (v - a * kS);
        float o = 0.f;
#pragma unroll
        for (int i = 0; i < 128; ++i) { s[i] = a * s[i] + ks[i] * dlt; o += qs[i] * s[i]; }
        o *= scale;
        const float ss = block_sum(o * o, red);
        const float y = o * rsqrtf(ss * (1.f / 128.f) + EPS) * gn * siluf_(z);
        row[C_DZ + h * DN_D + j] = f2bf(y);
    }
}

__global__ void __launch_bounds__(256) k_nsa_prep(bf16_t* P, const float* __restrict__ qn, const float* __restrict__ kns, const float* __restrict__ knw) {
    const int unit = blockIdx.x * 4 + (threadIdx.x >> 6), lane = threadIdx.x & 63;
    const int m = unit / 24, r = unit % 24;
    bf16_t* p; const float* g; float sc = 1.f;
    if (r < 16) { p = P + (size_t)m * LDP + C_NQ + r * 64; g = qn; sc = 0.125f; }
    else if (r < 20) { p = P + (size_t)m * LDP + C_KS + (r - 16) * 64; g = kns; }
    else { p = P + (size_t)m * LDP + C_KW + (r - 20) * 64; g = knw; }
    const float a = bf2f(p[lane]);
    float s = a * a;
    for (int o = 32; o > 0; o >>= 1) s += __shfl_xor(s, o);
    p[lane] = f2bf(a * rsqrtf(s * (1.f / 64.f) + EPS) * g[lane] * sc);
}
__global__ void __launch_bounds__(128) k_nsa_compress(const bf16_t* __restrict__ P, const float* __restrict__ pos_k, const float* __restrict__ w1_k, const float* __restrict__ w2_k,
                                                      const float* __restrict__ pos_v, const float* __restrict__ w1_v, const float* __restrict__ w2_v,
                                                      const float* __restrict__ kn_cmp, float* kc, float* vc) {
    __shared__ float in[2048]; __shared__ float hid[128]; __shared__ float red[2];
    int id = blockIdx.x; const int which = id & 1; id >>= 1; const int g = id % NS_G; id /= NS_G; const int c = id % NCMP; const int b = id / NCMP;
    const float* pos = which ? pos_v : pos_k; const float* w1 = which ? w1_v : w1_k; const float* w2 = which ? w2_v : w2_k;
    const int col = (which ? C_VC : C_KC) + g * 64;
    for (int e = threadIdx.x; e < 2048; e += 128) { const int l = e >> 6, d = e & 63; in[e] = bf2f(P[(size_t)(b * SEQ + 16 * c + l) * LDP + col + d]) + pos[e]; }
    __syncthreads();
    float a = 0.f;
    for (int e = 0; e < 2048; ++e) a += in[e] * w1[(size_t)e * 128 + threadIdx.x];
    hid[threadIdx.x] = gelu_tanh(a);
    __syncthreads();
    float o = 0.f;
    if (threadIdx.x < 64) for (int i = 0; i < 128; ++i) o += hid[i] * w2[i * 64 + threadIdx.x];
    float* dst = (which ? vc : kc) + ((size_t)(b * NCMP + c) * NS_G + g) * 64;
    if (which == 0) {
        const float ss = block_sum(threadIdx.x < 64 ? o * o : 0.f, red);
        if (threadIdx.x < 64) dst[threadIdx.x] = o * rsqrtf(ss * (1.f / 64.f) + EPS) * kn_cmp[threadIdx.x];
    } else if (threadIdx.x < 64) dst[threadIdx.x] = o;
}
__global__ void __launch_bounds__(256) k_nsa_main(bf16_t* P, const float* __restrict__ kc, const float* __restrict__ vc) {
    __shared__ float q[4][64];
    __shared__ float sc[4][512];
    __shared__ float imp[32];
    __shared__ int sel[8];
    __shared__ float red[4];
    __shared__ float oacc[4][64];
    const int tid = threadIdx.x;
    int id = blockIdx.x; const int g = id % NS_G; id /= NS_G; const int s = id % SEQ; const int b = id / SEQ;
    bf16_t* row = P + (size_t)(b * SEQ + s) * LDP;
    const int r_ = tid >> 6, d_ = tid & 63;
    q[r_][d_] = bf2f(row[C_NQ + (g * 4 + r_) * 64 + d_]);
    const float gate0 = sigmoidf_(bf2f(row[C_SG + (g * 4 + r_) * 3 + 0])), gate1 = sigmoidf_(bf2f(row[C_SG + (g * 4 + r_) * 3 + 1])), gate2 = sigmoidf_(bf2f(row[C_SG + (g * 4 + r_) * 3 + 2]));
    __syncthreads();
    float slope[4];
#pragma unroll
    for (int r = 0; r < 4; ++r) slope[r] = exp2f(-0.5f * (float)(g * 4 + r + 1));
    for (int e = tid; e < 4 * 128; e += 256) {
        const int r = e >> 7, c = e & 127; float v = NEGV;
        if (c < NCMP) {
            const int dist = s - (16 * c + 31);
            if (dist >= 0) { const float* kk = kc + ((size_t)(b * NCMP + c) * NS_G + g) * 64; float a = 0.f; for (int d = 0; d < 64; ++d) a += q[r][d] * kk[d]; v = a - slope[r] * (float)dist; }
        } else v = -INFINITY;
        sc[r][c] = v;
    }
    __syncthreads();
    for (int r = 0; r < 4; ++r) {
        float mx = -INFINITY; for (int c = tid; c < NCMP; c += 256) mx = fmaxf(mx, sc[r][c]);
        mx = block_max(mx, red);
        float e_ = 0.f; if (tid < NCMP) { e_ = __expf(sc[r][tid] - mx); }
        const float sum = block_sum(e_, red);
        __syncthreads();
        if (tid < NCMP) sc[r][tid] = (s >= 31) ? e_ / sum : 0.f;
        if (tid == 127) sc[r][127] = 0.f;
    }
    __syncthreads();
    float ocmp = 0.f;
    for (int c = 0; c < NCMP; ++c) ocmp += sc[r_][c] * vc[((size_t)(b * NCMP + c) * NS_G + g) * 64 + d_];
    const int blk_t = s >> 6;
    if (tid < 32) {
        const int j = tid; float a = 0.f;
        for (int c = 0; c < NCMP; ++c) {
            int lo = max(16 * c, 64 * j), hi = min(16 * c + 32, 64 * j + 64); int ov = hi - lo; if (ov < 0) ov = 0;
            if (ov > 0) { const float w = (float)ov * (1.f / 32.f); for (int r = 0; r < 4; ++r) a += sc[r][c] * w; }
        }
        if (j > blk_t) a = NEGV;
        if (j == blk_t || j == 0) a = FORCEV;
        imp[j] = a;
    }
    __syncthreads();
    if (tid == 0) {
        for (int k = 0; k < 8; ++k) { int bi = 0; float bv = -INFINITY; for (int j = 0; j < 32; ++j) if (imp[j] > bv) { bv = imp[j]; bi = j; } sel[k] = bi; imp[bi] = -INFINITY; }
    }
    __syncthreads();
    for (int e = tid; e < 4 * 512; e += 256) {
        const int r = e >> 9, kk = e & 511; const int kpos = sel[kk >> 6] * 64 + (kk & 63); const int dist = s - kpos; float v = NEGV;
        if (dist >= 0) { const bf16_t* kp = P + (size_t)(b * SEQ + kpos) * LDP + C_KS + g * 64; float a = 0.f; for (int d = 0; d < 64; ++d) a += q[r][d] * bf2f(kp[d]); v = a - slope[r] * (float)dist; }
        sc[r][kk] = v;
    }
    __syncthreads();
    for (int r = 0; r < 4; ++r) {
        float mx = fmaxf(sc[r][tid], sc[r][tid + 256]);
        mx = block_max(mx, red);
        const float e0 = __expf(sc[r][tid] - mx), e1 = __expf(sc[r][tid + 256] - mx);
        const float sum = block_sum(e0 + e1, red);
        __syncthreads();
        sc[r][tid] = e0 / sum; sc[r][tid + 256] = e1 / sum;
    }
    __syncthreads();
    float oslc = 0.f;
    for (int kk = 0; kk < 512; ++kk) { const float p = sc[r_][kk]; if (p != 0.f) { const int kpos = sel[kk >> 6] * 64 + (kk & 63); oslc += p * bf2f(P[(size_t)(b * SEQ + kpos) * LDP + C_VS + g * 64 + d_]); } }
    __syncthreads();
    for (int e = tid; e < 4 * 256; e += 256) {
        const int r = e >> 8, w = e & 255; const int kpos = s - w; float v = NEGV;
        if (kpos >= 0) { const bf16_t* kp = P + (size_t)(b * SEQ + kpos) * LDP + C_KW + g * 64; float a = 0.f; for (int d = 0; d < 64; ++d) a += q[r][d] * bf2f(kp[d]); v = a - slope[r] * (float)w; }
        sc[r][w] = v;
    }
    __syncthreads();
    for (int r = 0; r < 4; ++r) {
        float mx = block_max(sc[r][tid], red);
        const float e0 = __expf(sc[r][tid] - mx);
        const float sum = block_sum(e0, red);
        __syncthreads();
        sc[r][tid] = e0 / sum;
    }
    __syncthreads();
    float owin = 0.f;
    for (int w = 0; w < 256; ++w) { const int kpos = s - w; if (kpos >= 0) owin += sc[r_][w] * bf2f(P[(size_t)(b * SEQ + kpos) * LDP + C_VW + g * 64 + d_]); }
    row[C_NQ + (g * 4 + r_) * 64 + d_] = f2bf(gate0 * ocmp + gate1 * oslc + gate2 * owin);
}

namespace pg8 {
#define PG8_LAS __attribute__((address_space(3)))
typedef short bf16x8 __attribute__((ext_vector_type(8)));
typedef float f32x4 __attribute__((ext_vector_type(4)));
typedef float f32x2 __attribute__((ext_vector_type(2)));
typedef unsigned u32x4 __attribute__((ext_vector_type(4)));
typedef unsigned u32x2 __attribute__((ext_vector_type(2)));
constexpr int BM = 256, BK = 64, HALF = 128, HTB = HALF * BK * 2, STAGE_BYTES = 8 * HTB, NXCD = 8, WGM = 8;

__host__ __device__ __forceinline__ int lds_byte(int r, int c) { const int st = (r >> 4) * 2 + (c >> 5), rr = r & 15, cc = c & 31, ob = rr * 64 + cc * 2; return st * 1024 + (ob ^ (((ob >> 9) & 1) << 5)); }
__host__ __device__ __forceinline__ void stage_rc(int b, int& R, int& C) { const int st = b / 1024, sb = b % 1024, swz = sb ^ (((sb >> 9) & 1) << 5); R = (st >> 1) * 16 + swz / 64; C = (st & 1) * 32 + (swz % 64) / 2; }
__host__ __device__ __forceinline__ int perm32(int rho) { const int n = rho >> 4, i = rho & 15; return 8 * (i >> 2) + 4 * n + (i & 3); }

struct Unit { int pm, pn, ks; };
struct Gemm { const bf16_t* A; const bf16_t* Bt; int lda, ldb; int M, N, K; int ksoff; };

struct StaticOrder {
    int nM, nN, nwg, G, c;
    __host__ __device__ void init(int M_, int N_, int G_, int c_) { nM = M_ / BM; nN = N_ / BM; nwg = nM * nN; G = G_; c = c_; }
    __host__ __device__ bool next(int i, Unit& u) const {
        const long L = (long)i * G + c; if (L >= nwg) return false;
        int wgid = (int)L; { const int q = nwg / NXCD, r = nwg % NXCD, xcd = wgid % NXCD, off = wgid / NXCD; wgid = (xcd < r ? xcd * (q + 1) : r * (q + 1) + (xcd - r) * q) + off; }
        const int nig = WGM * nN, gid = wgid / nig, fm = gid * WGM, gsz = (nM - fm) < WGM ? (nM - fm) : WGM;
        u.pm = fm + ((wgid % nig) % gsz); u.pn = (wgid % nig) / gsz; u.ks = 0; return true;
    }
};
struct TwoPassOrder {
    StaticOrder base;
    __host__ __device__ bool next(int i, Unit& u) const { if (!base.next(i >> 1, u)) return false; u.ks = i & 1; return true; }
};

typedef __bf16 bf16x2_t __attribute__((ext_vector_type(2)));
__device__ __forceinline__ unsigned cvt_pk_bf16(float lo, float hi) { f32x2 v = {lo, hi}; bf16x2_t b = __builtin_convertvector(v, bf16x2_t); return __builtin_bit_cast(unsigned, b); }
__device__ __forceinline__ float fast_sigmoid(float x) { return __builtin_amdgcn_rcpf(1.f + __builtin_amdgcn_exp2f(-1.4426950408889634f * x)); }
__device__ __forceinline__ float bflo(unsigned w) { return __uint_as_float(w << 16); }
__device__ __forceinline__ float bfhi(unsigned w) { return __uint_as_float(w & 0xffff0000u); }

typedef f32x4 Acc[2][2][4][2];

template <int ACT> struct EpiP {
    static constexpr bool PERM = true;
    bf16_t* O; int ldc; int pn_last; int ncol_last;
    __device__ __forceinline__ void operator()(const Acc& acc, const Unit& u, int wr, int wc, int fr, int fq) const {
        const int row0 = u.pm * BM + wr * 64 + fr, tcol = wc * 32 + 8 * fq;
        const int lim = (u.pn == pn_last) ? ncol_last : 256;
#pragma unroll
        for (int ai = 0; ai < 2; ++ai)
#pragma unroll
            for (int m = 0; m < 4; ++m) { bf16_t* rowp = O + (size_t)(row0 + ai * HALF + m * 16) * ldc + u.pn * BM + tcol;
#pragma unroll
                for (int bj = 0; bj < 2; ++bj) { if (tcol + bj * HALF >= lim) continue;
                    f32x4 v0 = acc[ai][bj][m][0], v1 = acc[ai][bj][m][1];
                    if (ACT == 1) {
#pragma unroll
                        for (int e = 0; e < 4; ++e) { v0[e] = fast_sigmoid(v0[e]); v1[e] = fast_sigmoid(v1[e]); } }
                    u32x4 w; w.x = cvt_pk_bf16(v0[0], v0[1]); w.y = cvt_pk_bf16(v0[2], v0[3]); w.z = cvt_pk_bf16(v1[0], v1[1]); w.w = cvt_pk_bf16(v1[2], v1[3]);
                    *(u32x4*)(rowp + bj * HALF) = w; } }
    }
};
struct EpiMix {
    static constexpr bool PERM = true;
    const bf16_t* G; int ldg; bf16_t* O; int ldc;
    __device__ __forceinline__ void operator()(const Acc& acc, const Unit& u, int wr, int wc, int fr, int fq) const {
        const int row0 = u.pm * BM + wr * 64 + fr, col0 = u.pn * BM + wc * 32 + 8 * fq;
#pragma unroll
        for (int ai = 0; ai < 2; ++ai)
#pragma unroll
            for (int m = 0; m < 4; ++m) { const size_t row = (size_t)(row0 + ai * HALF + m * 16); const bf16_t* gp = G + row * ldg + col0 + u.ks * 1024; bf16_t* rowp = O + row * ldc + col0;
#pragma unroll
                for (int bj = 0; bj < 2; ++bj) { const u32x4 b = *(const u32x4*)(gp + bj * HALF);
                    f32x4 v0 = acc[ai][bj][m][0], v1 = acc[ai][bj][m][1];
                    v0[0] *= bflo(b.x); v0[1] *= bfhi(b.x); v0[2] *= bflo(b.y); v0[3] *= bfhi(b.y); v1[0] *= bflo(b.z); v1[1] *= bfhi(b.z); v1[2] *= bflo(b.w); v1[3] *= bfhi(b.w);
                    if (u.ks) { const u32x4 p = *(const u32x4*)(rowp + bj * HALF);
                        v0[0] += bflo(p.x); v0[1] += bfhi(p.x); v0[2] += bflo(p.y); v0[3] += bfhi(p.y); v1[0] += bflo(p.z); v1[1] += bfhi(p.z); v1[2] += bflo(p.w); v1[3] += bfhi(p.w); }
                    u32x4 w; w.x = cvt_pk_bf16(v0[0], v0[1]); w.y = cvt_pk_bf16(v0[2], v0[3]); w.z = cvt_pk_bf16(v1[0], v1[1]); w.w = cvt_pk_bf16(v1[2], v1[3]);
                    *(u32x4*)(rowp + bj * HALF) = w; } }
    }
};
struct EpiOut {
    static constexpr bool PERM = false;
    const float* X; float* X1; bf16_t* An; const float* gain; float* pss;
    __device__ __forceinline__ void operator()(const Acc& acc, const Unit& u, int wr, int wc, int fr, int fq) const {
        const int row0 = u.pm * BM + wr * 64 + fr, col0 = u.pn * BM + wc * 32 + 4 * fq;
        f32x4 gv[2][2];
#pragma unroll
        for (int bj = 0; bj < 2; ++bj)
#pragma unroll
            for (int n = 0; n < 2; ++n) gv[bj][n] = *(const f32x4*)(gain + col0 + bj * HALF + n * 16);
#pragma unroll
        for (int ai = 0; ai < 2; ++ai)
#pragma unroll
            for (int m = 0; m < 4; ++m) { const size_t row = (size_t)(row0 + ai * HALF + m * 16); const size_t off = row * D + col0; float ss = 0.f;
#pragma unroll
                for (int bj = 0; bj < 2; ++bj)
#pragma unroll
                    for (int n = 0; n < 2; ++n) { const f32x4 x1 = *(const f32x4*)(X + off + bj * HALF + n * 16) + acc[ai][bj][m][n];
                        *(f32x4*)(X1 + off + bj * HALF + n * 16) = x1; ss += (x1[0] * x1[0] + x1[1] * x1[1]) + (x1[2] * x1[2] + x1[3] * x1[3]);
                        const f32x4 y = x1 * gv[bj][n]; u32x2 w; w.x = cvt_pk_bf16(y[0], y[1]); w.y = cvt_pk_bf16(y[2], y[3]); *(u32x2*)(An + off + bj * HALF + n * 16) = w; }
                ss += __shfl_xor(ss, 16); ss += __shfl_xor(ss, 32);
                if (fq == 0) pss[row * 16 + u.pn * 4 + wc] = ss; }
    }
};
struct EpiUp {
    static constexpr bool PERM = true;
    const float* pss; bf16_t* O; int ldc;
    __device__ __forceinline__ void operator()(const Acc& acc, const Unit& u, int wr, int wc, int fr, int fq) const {
        const int row0 = u.pm * BM + wr * 64 + fr, col0 = u.pn * BM + wc * 32 + 8 * fq;
#pragma unroll
        for (int ai = 0; ai < 2; ++ai)
#pragma unroll
            for (int m = 0; m < 4; ++m) { const size_t row = (size_t)(row0 + ai * HALF + m * 16);
                const f32x4* pp = (const f32x4*)(pss + row * 16); const f32x4 s4 = (pp[0] + pp[1]) + (pp[2] + pp[3]);
                const float rstd = rsqrtf(((s4[0] + s4[1]) + (s4[2] + s4[3])) * (1.f / D) + EPS);
                bf16_t* rowp = O + row * ldc + col0;
#pragma unroll
                for (int bj = 0; bj < 2; ++bj) { f32x4 v0 = acc[ai][bj][m][0] * rstd, v1 = acc[ai][bj][m][1] * rstd;
#pragma unroll
                    for (int e = 0; e < 4; ++e) { const float a = fmaxf(v0[e], 0.f), b = fmaxf(v1[e], 0.f); v0[e] = a * a; v1[e] = b * b; }
                    u32x4 w; w.x = cvt_pk_bf16(v0[0], v0[1]); w.y = cvt_pk_bf16(v0[2], v0[3]); w.z = cvt_pk_bf16(v1[0], v1[1]); w.w = cvt_pk_bf16(v1[2], v1[3]);
                    *(u32x4*)(rowp + bj * HALF) = w; } }
    }
};
struct EpiDown {
    static constexpr bool PERM = false;
    float* X1;
    __device__ __forceinline__ void operator()(const Acc& acc, const Unit& u, int wr, int wc, int fr, int fq) const {
        const int row0 = u.pm * BM + wr * 64 + fr, col0 = u.pn * BM + wc * 32 + 4 * fq;
#pragma unroll
        for (int ai = 0; ai < 2; ++ai)
#pragma unroll
            for (int m = 0; m < 4; ++m) { float* rowp = X1 + (size_t)(row0 + ai * HALF + m * 16) * D + col0;
#pragma unroll
                for (int bj = 0; bj < 2; ++bj)
#pragma unroll
                    for (int n = 0; n < 2; ++n) { f32x4* p = (f32x4*)(rowp + bj * HALF + n * 16); *p = *p + acc[ai][bj][m][n]; } }
    }
};

template <class Epi, class Sched, bool ALIGN_EPI>
__device__ __forceinline__ void gemm_phase(PG8_LAS unsigned char* lds, const Gemm g, const Sched& S, const Epi& E) {
    const int tid = threadIdx.x, wid = __builtin_amdgcn_readfirstlane(tid >> 6), lane = tid & 63, wr = wid >> 2, wc = wid & 3, fr = lane & 15, fq = lane >> 4;
    const int K = g.K, nt = K / BK, lda = g.lda, ldb = g.ldb;
    unsigned voffA[2], voffB[2];
#pragma unroll
    for (int i = 0; i < 2; ++i) { int R, C; stage_rc(tid * 16 + i * 8192, R, C); const int Rb = Epi::PERM ? ((R & ~31) + perm32(R & 31)) : R;
        voffA[i] = (unsigned)(R * lda + C) * 2u; voffB[i] = (unsigned)(Rb * ldb + C) * 2u; }
    const size_t kstep = (size_t)(BK * 2);
    const size_t hstepA = (size_t)HALF * lda * 2, hstepB = (size_t)HALF * ldb * 2;
    const size_t tstepA = 2 * hstepA, tstepB = 2 * hstepB;
    const unsigned ldsw = (unsigned)wid * 1024u;
    const int aoff = lds_byte(wr * 64 + fr, fq * 8), boff = lds_byte(wc * 32 + fr, fq * 8);
#define PG8_SA(b, h) (((b) * 2 + (h)) * HTB)
#define PG8_SB(b, h) ((4 + (b) * 2 + (h)) * HTB)
#define PG8_STAGE(bufoff, gbase, voff) do { _Pragma("unroll") for (int _i = 0; _i < 2; ++_i) \
        __builtin_amdgcn_global_load_lds((const unsigned*)((const char*)(gbase) + (voff)[_i]), (PG8_LAS unsigned*)(lds + (bufoff) + ldsw + _i * 8192), 16, 0, 0); } while (0)
#define PG8_LDA(dst, b, h) do { _Pragma("unroll") for (int m = 0; m < 4; ++m) _Pragma("unroll") for (int k = 0; k < 2; ++k) dst[m][k] = *(const PG8_LAS bf16x8*)(lds + PG8_SA(b, h) + aoff + m * 2048 + k * 1024); } while (0)
#define PG8_LDB(dst, b, h) do { _Pragma("unroll") for (int n = 0; n < 2; ++n) _Pragma("unroll") for (int k = 0; k < 2; ++k) dst[n][k] = *(const PG8_LAS bf16x8*)(lds + PG8_SB(b, h) + boff + n * 2048 + k * 1024); } while (0)
#define PG8_MMA(ai, bj, At, Bt) do { __builtin_amdgcn_s_setprio(1); _Pragma("unroll") for (int m = 0; m < 4; ++m) _Pragma("unroll") for (int n = 0; n < 2; ++n) _Pragma("unroll") for (int k = 0; k < 2; ++k) \
        acc[ai][bj][m][n] = __builtin_amdgcn_mfma_f32_16x16x32_bf16(Bt[n][k], At[m][k], acc[ai][bj][m][n], 0, 0, 0); __builtin_amdgcn_s_setprio(0); } while (0)
#define PG8_WAIT_V(n) asm volatile("s_waitcnt vmcnt(" #n ")" ::: "memory")
#define PG8_WAIT_L(n) asm volatile("s_waitcnt lgkmcnt(" #n ")" ::: "memory")
#define PG8_BAR __builtin_amdgcn_s_barrier()
#define PG8_SCHED __builtin_amdgcn_sched_barrier(0)
#define PG8_KBODY(t) do { \
            const bool last = (t == nt - 2); \
            const char* a1 = cA + (size_t)(t + 1) * kstep; \
            const char* a2 = last ? nA : cA + (size_t)(t + 2) * kstep; const char* b2 = last ? nB : cB + (size_t)(t + 2) * kstep; \
            const char* a3 = a2 + kstep; const char* b3 = b2 + kstep; \
            PG8_LDB(B0, 0, 0); PG8_LDB(B1, 0, 1); PG8_SCHED; PG8_LDA(At, 0, 0); PG8_STAGE(PG8_SA(1, 1), a1 + hstepA, voffA); \
            PG8_WAIT_V(8); PG8_WAIT_L(0); PG8_BAR; PG8_MMA(0, 0, At, B0); PG8_MMA(0, 1, At, B1); PG8_BAR; PG8_SCHED; \
            PG8_LDA(At, 0, 1); PG8_STAGE(PG8_SB(0, 0), b2, voffB); PG8_STAGE(PG8_SB(0, 1), b2 + hstepB, voffB); PG8_STAGE(PG8_SA(0, 0), a2, voffA); \
            PG8_WAIT_V(8); PG8_WAIT_L(0); PG8_BAR; PG8_MMA(1, 0, At, B0); PG8_MMA(1, 1, At, B1); PG8_BAR; PG8_SCHED; \
            PG8_LDB(B0, 1, 0); PG8_LDB(B1, 1, 1); PG8_SCHED; PG8_LDA(At, 1, 0); PG8_STAGE(PG8_SA(0, 1), a2 + hstepA, voffA); \
            PG8_WAIT_V(8); PG8_WAIT_L(0); PG8_BAR; PG8_MMA(0, 0, At, B0); PG8_MMA(0, 1, At, B1); PG8_BAR; PG8_SCHED; \
            PG8_LDA(At, 1, 1); PG8_STAGE(PG8_SB(1, 0), b3, voffB); PG8_STAGE(PG8_SB(1, 1), b3 + hstepB, voffB); PG8_STAGE(PG8_SA(1, 0), a3, voffA); \
            PG8_WAIT_V(8); PG8_WAIT_L(0); PG8_BAR; PG8_MMA(1, 0, At, B0); PG8_MMA(1, 1, At, B1); PG8_BAR; PG8_SCHED; \
        } while (0)
    Unit cur, nxt; int ui = 0;
    if (!S.next(0, cur)) return;
    Acc acc;
#pragma unroll
    for (int a = 0; a < 2; ++a)
#pragma unroll
        for (int b = 0; b < 2; ++b)
#pragma unroll
            for (int m = 0; m < 4; ++m)
#pragma unroll
                for (int n = 0; n < 2; ++n) acc[a][b][m][n] = (f32x4){0.f, 0.f, 0.f, 0.f};
    bf16x8 At[4][2], B0[2][2], B1[2][2];
    const char* cA = (const char*)g.A + (size_t)cur.pm * tstepA + (size_t)cur.ks * g.ksoff * 2; const char* cB = (const char*)g.Bt + (size_t)cur.pn * tstepB + (size_t)cur.ks * g.ksoff * 2;
    PG8_STAGE(PG8_SB(0, 0), cB, voffB); PG8_STAGE(PG8_SB(0, 1), cB + hstepB, voffB); PG8_STAGE(PG8_SA(0, 0), cA, voffA); PG8_STAGE(PG8_SA(0, 1), cA + hstepA, voffA);
    if (wr == 1) PG8_BAR;
    PG8_WAIT_V(2); PG8_BAR;
    PG8_STAGE(PG8_SB(1, 0), cB + kstep, voffB); PG8_STAGE(PG8_SA(1, 0), cA + kstep, voffA); PG8_STAGE(PG8_SB(1, 1), cB + hstepB + kstep, voffB);
    PG8_WAIT_V(6); PG8_BAR;
    for (;;) {
        const bool has_next = S.next(ui + 1, nxt);
        const char* nA = has_next ? (const char*)g.A + (size_t)nxt.pm * tstepA + (size_t)nxt.ks * g.ksoff * 2 : cA; const char* nB = has_next ? (const char*)g.Bt + (size_t)nxt.pn * tstepB + (size_t)nxt.ks * g.ksoff * 2 : cB;
        for (int t = 0; t < nt; t += 2) PG8_KBODY(t);
        if constexpr (ALIGN_EPI) { if (wr == 0) PG8_BAR; }
        E(acc, cur, wr, wc, fr, fq);
        if (!has_next) break;
#pragma unroll
        for (int a = 0; a < 2; ++a)
#pragma unroll
            for (int b = 0; b < 2; ++b)
#pragma unroll
                for (int m = 0; m < 4; ++m)
#pragma unroll
                    for (int n = 0; n < 2; ++n) acc[a][b][m][n] = (f32x4){0.f, 0.f, 0.f, 0.f};
        cur = nxt; cA = nA; cB = nB; ++ui;
        if constexpr (ALIGN_EPI) { if (wr == 1) PG8_BAR; }
    }
    PG8_WAIT_V(0);
    if constexpr (!ALIGN_EPI) { if (wr == 0) PG8_BAR; }
    PG8_BAR;
#undef PG8_SA
#undef PG8_SB
#undef PG8_STAGE
#undef PG8_LDA
#undef PG8_LDB
#undef PG8_MMA
#undef PG8_WAIT_V
#undef PG8_WAIT_L
#undef PG8_BAR
#undef PG8_SCHED
#undef PG8_KBODY
}
}

#define GAS __attribute__((address_space(1)))
#define LAS __attribute__((address_space(3)))
typedef unsigned v4u __attribute__((ext_vector_type(4)));
typedef float f32x4 __attribute__((ext_vector_type(4)));
constexpr int NWAVES = 8;
constexpr int LDS_BYTES = 147456;
constexpr size_t MiB = 1u << 20;
constexpr size_t WS_PSS = 1 * MiB, WS_WOUT = 2 * MiB, WS_P = 4 * MiB, WS_KC = 214 * MiB, WS_VC = 215 * MiB, WS_MIX = 216 * MiB;
constexpr size_t WS_AN = 4 * MiB, WS_UP = 64 * MiB, WS_WUP = 192 * MiB, WS_WDOWN = 200 * MiB;
constexpr size_t DO_H = 0, DO_WG = 32 * MiB, DO_WCAT = 36 * MiB, DO_WIN = 40 * MiB;

__device__ __forceinline__ unsigned pk2(float lo, float hi) { return (unsigned)f2bf(lo) | ((unsigned)f2bf(hi) << 16); }
__device__ __forceinline__ float wave_sum(float v) {
#pragma unroll
    for (int o = 1; o < 64; o <<= 1) v += __shfl_xor(v, o);
    return v;
}
template <class SrcCol>
__device__ __forceinline__ void transpose_item(const float* W, int ldw, const SrcCol& srccol, bf16_t* WT, int ldk, int kofs, LAS float* scr, int kb, int nb, int lane) {
    const int k0 = 64 * kb, n0 = 32 * nb; const int sc = srccol(n0 + (lane & 31));
#pragma unroll 8
    for (int i = 0; i < 32; ++i) { const int kk = 2 * i + (lane >> 5); scr[kk * 33 + (lane & 31)] = (sc >= 0) ? W[(size_t)(k0 + kk) * ldw + sc] : 0.f; }
    asm volatile("s_waitcnt lgkmcnt(0)" ::: "memory");
    const int c = lane & 7;
#pragma unroll
    for (int j = 0; j < 4; ++j) { const int n = (lane >> 3) + 8 * j; const LAS float* s = scr + (8 * c) * 33 + n;
        v4u o; o.x = pk2(s[0 * 33], s[1 * 33]); o.y = pk2(s[2 * 33], s[3 * 33]); o.z = pk2(s[4 * 33], s[5 * 33]); o.w = pk2(s[6 * 33], s[7 * 33]);
        *(v4u*)(WT + (size_t)(n0 + n) * ldk + kofs + k0 + 8 * c) = o; }
    asm volatile("s_waitcnt lgkmcnt(0)" ::: "memory");
}
struct SrcIdent { int off; __device__ __forceinline__ int operator()(int n) const { return n + off; } };
struct SrcWin { __device__ __forceinline__ int operator()(int n) const { return n < 4096 ? n : (n < 6656 ? n + 16 : (n < 6672 ? n - 6656 + 4096 : (n < 6720 ? n : -1))); } };

struct Args { const float* in[23]; float* out; unsigned char* ws; int ph_lo, ph_hi; };

__global__ void __launch_bounds__(NWAVES * 64, 2) mk_fwd(Args args) {
    extern __shared__ __attribute__((aligned(16))) unsigned char lds_raw[];
    LAS unsigned char* lds = (LAS unsigned char*)lds_raw;
    cg::grid_group grid = cg::this_grid();
    const int tid = threadIdx.x, lane = tid & 63, wave = __builtin_amdgcn_readfirstlane(tid >> 6);
    const int G = gridDim.x, gw = blockIdx.x * NWAVES + wave, NGW = G * NWAVES;
    unsigned char* ws = args.ws; unsigned char* dob = (unsigned char*)args.out;
    const float* x = args.in[0];
    bf16_t* P = (bf16_t*)(ws + WS_P);
    bf16_t* Hb = (bf16_t*)(dob + DO_H); bf16_t* Wg_t = (bf16_t*)(dob + DO_WG); bf16_t* Wcat_t = (bf16_t*)(dob + DO_WCAT); bf16_t* Win_t = (bf16_t*)(dob + DO_WIN);
    bf16_t* Wout_t = (bf16_t*)(ws + WS_WOUT); bf16_t* Wup_t = (bf16_t*)(ws + WS_WUP); bf16_t* Wdown_t = (bf16_t*)(ws + WS_WDOWN);
    bf16_t* Mix = (bf16_t*)(ws + WS_MIX); bf16_t* An = (bf16_t*)(ws + WS_AN); bf16_t* Up = (bf16_t*)(ws + WS_UP); float* pss = (float*)(ws + WS_PSS);
    LAS float* scr = (LAS float*)(lds + wave * 16384);
    const int lo = args.ph_lo, hi = args.ph_hi;
#ifndef PHMASK
#define PHMASK 0x7f
#endif
#define IN(k) (((PHMASK >> (k)) & 1) && lo <= (k) && (k) < hi)
#define GRID_SYNC() do { asm volatile("s_waitcnt vmcnt(0) lgkmcnt(0)" ::: "memory"); grid.sync(); \
        if (wave == 0) { __builtin_amdgcn_fence(__ATOMIC_ACQUIRE, "agent"); asm volatile("s_waitcnt vmcnt(0)" ::: "memory"); } __syncthreads(); } while (0)
#define SEAM(k) do { if (IN(k) && IN((k) + 1)) GRID_SYNC(); } while (0)

    if (IN(0)) {
        constexpr int I_WIN = 16 * (NP1 / 32), I_WG = 16 * 64, I_DN = 16 * 32, I_OUT = 16 * 32;
        constexpr int NITEMS = I_WIN + I_WG + 2 * I_DN + I_OUT;
        for (int it = gw; it < NITEMS; it += NGW) {
            int r = it;
            if (r < I_WIN) { transpose_item(args.in[2], INW, SrcWin{}, Win_t, D, 0, scr, r / (NP1 / 32), r % (NP1 / 32), lane); continue; } r -= I_WIN;
            if (r < I_WG) { transpose_item(args.in[2], INW, SrcIdent{6720}, Wg_t, D, 0, scr, r / 64, r % 64, lane); continue; } r -= I_WG;
            if (r < I_DN) { transpose_item(args.in[17], D, SrcIdent{0}, Wcat_t, 2 * D, 0, scr, r / 32, r % 32, lane); continue; } r -= I_DN;
            if (r < I_DN) { transpose_item(args.in[18], D, SrcIdent{0}, Wcat_t, 2 * D, D, scr, r / 32, r % 32, lane); continue; } r -= I_DN;
            transpose_item(args.in[19], D, SrcIdent{0}, Wout_t, D, 0, scr, r / 32, r % 32, lane);
        }
        const float* gain = args.in[1];
        f32x4 gv[4];
#pragma unroll
        for (int j = 0; j < 4; ++j) gv[j] = ((const f32x4*)gain)[lane + 64 * j];
        for (int m = gw; m < M; m += NGW) {
            const f32x4* xr = (const f32x4*)(x + (size_t)m * D) + lane;
            f32x4 v[4]; float s = 0.f;
#pragma unroll
            for (int j = 0; j < 4; ++j) { v[j] = xr[64 * j]; s += (v[j].x * v[j].x + v[j].y * v[j].y) + (v[j].z * v[j].z + v[j].w * v[j].w); }
            const float rstd = rsqrtf(wave_sum(s) * (1.f / D) + EPS);
            unsigned long long* o8 = (unsigned long long*)(Hb + (size_t)m * D) + lane;
#pragma unroll
            for (int j = 0; j < 4; ++j) { const f32x4 y = v[j] * rstd * gv[j]; o8[64 * j] = (unsigned long long)pk2(y.x, y.y) | ((unsigned long long)pk2(y.z, y.w) << 32); }
        }
    }
    SEAM(0);
    if (IN(1)) {
        pg8::Gemm g{Hb, Win_t, D, D, M, NP1, D, 0}; pg8::StaticOrder S; S.init(M, NP1, G, (int)blockIdx.x);
        pg8::EpiP<0> E{P, LDP, 26, 64};
        pg8::gemm_phase<pg8::EpiP<0>, pg8::StaticOrder, true>(lds, g, S, E);
    }
    SEAM(1);
    if (IN(2)) {
        pg8::Gemm g{Hb, Wg_t, D, D, M, 2048, D, 0}; pg8::StaticOrder S; S.init(M, 2048, G, (int)blockIdx.x);
        pg8::EpiP<1> E{P, LDP, -1, 256};
        pg8::gemm_phase<pg8::EpiP<1>, pg8::StaticOrder, true>(lds, g, S, E);
    }
    SEAM(2);
    if (IN(3)) {
        pg8::Gemm g{P + C_DZ, Wcat_t, LDP, 2 * D, M, D, D, D}; pg8::TwoPassOrder S; S.base.init(M, D, G, (int)blockIdx.x);
        pg8::EpiMix E{P, LDP, Mix, D};
        pg8::gemm_phase<pg8::EpiMix, pg8::TwoPassOrder, false>(lds, g, S, E);
    }
    SEAM(3);
    if (IN(4)) {
        for (int it = gw; it < 16 * 128; it += NGW) transpose_item(args.in[21], FF, SrcIdent{0}, Wup_t, D, 0, scr, it / 128, it % 128, lane);
        __syncthreads();
        pg8::Gemm g{Mix, Wout_t, D, D, M, D, D, 0}; pg8::StaticOrder S; S.init(M, D, G, (int)blockIdx.x);
        pg8::EpiOut E{x, args.out, An, args.in[20], pss};
        pg8::gemm_phase<pg8::EpiOut, pg8::StaticOrder, false>(lds, g, S, E);
    }
    SEAM(4);
    if (IN(5)) {
        for (int it = gw; it < 64 * 32; it += NGW) transpose_item(args.in[22], D, SrcIdent{0}, Wdown_t, FF, 0, scr, it / 32, it % 32, lane);
        __syncthreads();
        pg8::Gemm g{An, Wup_t, D, D, M, FF, D, 0}; pg8::StaticOrder S; S.init(M, FF, G, (int)blockIdx.x);
        pg8::EpiUp E{pss, Up, FF};
        pg8::gemm_phase<pg8::EpiUp, pg8::StaticOrder, true>(lds, g, S, E);
    }
    SEAM(5);
    if (IN(6)) {
        pg8::Gemm g{Up, Wdown_t, FF, FF, M, D, FF, 0}; pg8::StaticOrder S; S.init(M, D, G, (int)blockIdx.x);
        pg8::EpiDown E{args.out};
        pg8::gemm_phase<pg8::EpiDown, pg8::StaticOrder, false>(lds, g, S, E);
    }
#undef IN
#undef SEAM
#undef GRID_SYNC
}

static int g_grid = 0;
static void launch_mk(const Args& a0, int lo, int hi, hipStream_t stream) {
    Args a = a0; a.ph_lo = lo; a.ph_hi = hi;
    void* kargs[] = {(void*)&a};
    hipError_t e = hipLaunchCooperativeKernel((const void*)mk_fwd, dim3(g_grid), dim3(NWAVES * 64), kargs, LDS_BYTES, stream);
    if (e != hipSuccess) fprintf(stderr, "cooperative launch failed: %s (grid %d)\n", hipGetErrorString(e), g_grid);
}

extern "C" void kernel_launch(void* const* d_in, const int* in_sizes, int n_in, void* d_out, int out_size, void* d_ws, size_t ws_size, hipStream_t stream) {
    if (g_grid == 0) {
        int dev = 0, cus = 0, per_cu = 0;
        hipGetDevice(&dev);
        hipDeviceGetAttribute(&cus, hipDeviceAttributeMultiprocessorCount, dev);
        hipFuncSetAttribute((const void*)mk_fwd, hipFuncAttributeMaxDynamicSharedMemorySize, LDS_BYTES);
        hipOccupancyMaxActiveBlocksPerMultiprocessor(&per_cu, (const void*)mk_fwd, NWAVES * 64, LDS_BYTES);
        if (per_cu < 1) per_cu = 1;
        if (per_cu > 1) per_cu = 1;
        g_grid = cus * per_cu;
    }
    Args a{};
    for (int i = 0; i < 23; ++i) a.in[i] = (const float*)d_in[i];
    a.out = (float*)d_out; a.ws = (unsigned char*)d_ws;
    bf16_t* P = (bf16_t*)((char*)d_ws + WS_P);
    float* kc = (float*)((char*)d_ws + WS_KC); float* vc = (float*)((char*)d_ws + WS_VC);
#if defined(DBG_NAIVE_P1)
    launch_mk(a, 0, 1, stream);
    {   GemmArgs g{}; g.A = (char*)d_out + DO_H; g.lda = D; g.B = a.in[2]; g.ldb = INW; g.C = P; g.ldc = LDP; g.Mrows = M; g.K = D;
        g.bcol0 = 0; g.ccol0 = 0; g.N = 4096; launch_gemm<1, 0>(g, stream);
        g.bcol0 = 4112; g.ccol0 = C_NQ; g.N = 2560; launch_gemm<1, 0>(g, stream);
        g.bcol0 = 4096; g.ccol0 = C_SB; g.N = 16; launch_gemm<1, 0>(g, stream);
        g.bcol0 = 6672; g.ccol0 = C_SG; g.N = 48; launch_gemm<1, 0>(g, stream); }
#else
    launch_mk(a, 0, 2, stream);
#endif
    hipLaunchKernelGGL(k_gdn_conv, dim3(BATCH * 3072 / 256), dim3(256), 0, stream, P, a.in[3]);
    hipLaunchKernelGGL(k_gdn_l2norm, dim3(M * 16 / 4), dim3(256), 0, stream, P);
    hipLaunchKernelGGL(k_gdn_scan, dim3(BATCH * DN_H), dim3(128), 0, stream, P, a.in[4], a.in[5], a.in[6]);
    hipLaunchKernelGGL(k_nsa_prep, dim3(M * 24 / 4), dim3(256), 0, stream, P, a.in[7], a.in[9], a.in[10]);
    hipLaunchKernelGGL(k_nsa_compress, dim3(BATCH * NCMP * NS_G * 2), dim3(128), 0, stream, (const bf16_t*)P, a.in[11], a.in[12], a.in[13], a.in[14], a.in[15], a.in[16], a.in[8], kc, vc);
    hipLaunchKernelGGL(k_nsa_main, dim3(BATCH * SEQ * NS_G), dim3(256), 0, stream, P, (const float*)kc, (const float*)vc);
#if defined(DBG_NAIVE_FFN)
#if DBG_NAIVE_FFN >= 2
#if DBG_NAIVE_FFN == 3
    {   GemmArgs g{}; g.A = (char*)d_out + DO_H; g.lda = D; g.B = a.in[2]; g.ldb = INW; g.C = P; g.ldc = LDP; g.Mrows = M; g.K = D;
        g.bcol0 = 6720; g.ccol0 = 0; g.N = 2048; launch_gemm<1, DBG_GATE_EPI>(g, stream); }
#else
    launch_mk(a, 2, 3, stream);
#endif
    {   bf16_t* mix = (bf16_t*)((char*)d_ws + WS_MIX);
        GemmArgs g{}; g.A = P + C_DZ; g.lda = LDP; g.B = a.in[17]; g.ldb = D; g.bcol0 = 0; g.A2 = P + C_NQ; g.B2 = a.in[18]; g.ldb2 = D;
        g.C = mix; g.ldc = D; g.ccol0 = 0; g.gates = P; g.Mrows = M; g.N = D; g.K = D; launch_gemm<1, 5>(g, stream);
        GemmArgs o{}; o.A = mix; o.lda = D; o.B = a.in[19]; o.ldb = D; o.C = d_out; o.ldc = D; o.X = a.in[0]; o.Mrows = M; o.N = D; o.K = D; launch_gemm<1, 2>(o, stream); }
#else
    launch_mk(a, 2, 5, stream);
#endif
    {   float* h2 = (float*)((char*)d_ws + 4 * MiB); float* up = (float*)((char*)d_ws + 68 * MiB); float* out = (float*)d_out;
        hipLaunchKernelGGL((k_rmsnorm<0>), dim3(M), dim3(256), 0, stream, (const float*)out, a.in[20], (void*)h2);
        for (int half = 0; half < 2; ++half) {
            const size_t r0 = (size_t)half * (M / 2);
            GemmArgs g{}; g.A = h2 + r0 * D; g.lda = D; g.B = a.in[21]; g.ldb = FF; g.C = up; g.ldc = FF; g.Mrows = M / 2; g.N = FF; g.K = D; launch_gemm<0, 3>(g, stream);
            GemmArgs d{}; d.A = up; d.lda = FF; d.B = a.in[22]; d.ldb = D; d.C = out + r0 * D; d.ldc = D; d.Mrows = M / 2; d.N = D; d.K = FF; launch_gemm<0, 4>(d, stream);
        } }
#else
    launch_mk(a, 2, 7, stream);
#endif
}
```

```cpp
#include <hip/hip_runtime.h>
#include <hip/hip_cooperative_groups.h>
#include <stdint.h>
#include <cstdio>
namespace cg = cooperative_groups;

typedef unsigned short bf16_t;

constexpr int D = 1024, BATCH = 8, SEQ = 2048, M = BATCH * SEQ;
constexpr int DN_H = 8, DN_D = 128;
constexpr int NS_H = 16, NS_G = 4, NS_R = 4, NS_D = 64;
constexpr int NCMP = 127, NSEL = 32;
constexpr int FF = 4096;
constexpr int INW = 8768;
constexpr float EPS = 1e-6f;
constexpr float NEGV = -1e30f, FORCEV = 1e9f;

constexpr int LDP = 6720;
constexpr int C_DQ = 0, C_DK = 1024, C_DV = 2048, C_DZ = 3072, C_NQ = 4096;
constexpr int C_KC = 5120, C_VC = 5376, C_KS = 5632, C_VS = 5888, C_KW = 6144, C_VW = 6400;
constexpr int C_SB = 6656, C_SA = 6664, C_SG = 6672;
constexpr int NP1 = 6912;

__device__ __forceinline__ float bf2f(bf16_t v) { return __uint_as_float(((unsigned)v) << 16); }
__device__ __forceinline__ bf16_t f2bf(float f) { unsigned u = __float_as_uint(f); return (bf16_t)((u + 0x7fffu + ((u >> 16) & 1u)) >> 16); }
__device__ __forceinline__ float sigmoidf_(float x) { return 1.f / (1.f + __expf(-x)); }
__device__ __forceinline__ float siluf_(float x) { return x * sigmoidf_(x); }
__device__ __forceinline__ float softplusf_(float x) { return fmaxf(x, 0.f) + log1pf(__expf(-fabsf(x))); }
__device__ __forceinline__ float gelu_tanh(float x) { return 0.5f * x * (1.f + tanhf(0.7978845608028654f * (x + 0.044715f * x * x * x))); }

__device__ __forceinline__ float block_sum(float v, float* red) {
    for (int o = 32; o > 0; o >>= 1) v += __shfl_xor(v, o);
    const int w = threadIdx.x >> 6, nw = blockDim.x >> 6;
    __syncthreads();
    if ((threadIdx.x & 63) == 0) red[w] = v;
    __syncthreads();
    float s = 0.f;
    for (int i = 0; i < nw; ++i) s += red[i];
    return s;
}
__device__ __forceinline__ float block_max(float v, float* red) {
    for (int o = 32; o > 0; o >>= 1) v = fmaxf(v, __shfl_xor(v, o));
    const int w = threadIdx.x >> 6, nw = blockDim.x >> 6;
    __syncthreads();
    if ((threadIdx.x & 63) == 0) red[w] = v;
    __syncthreads();
    float s = red[0];
    for (int i = 1; i < nw; ++i) s = fmaxf(s, red[i]);
    return s;
}

__global__ void __launch_bounds__(256) k_gdn_conv(bf16_t* P, const float* __restrict__ convw) {
    const int idx = blockIdx.x * 256 + threadIdx.x;
    if (idx >= BATCH * 3072) return;
    const int b = idx / 3072, c = idx % 3072;
    const float w0 = convw[c], w1 = convw[3072 + c], w2 = convw[2 * 3072 + c], w3 = convw[3 * 3072 + c];
    bf16_t* col = P + (size_t)b * SEQ * LDP + c;
    float x3 = bf2f(col[(size_t)(SEQ - 1) * LDP]), x2 = bf2f(col[(size_t)(SEQ - 2) * LDP]), x1 = bf2f(col[(size_t)(SEQ - 3) * LDP]);
    for (int t = SEQ - 1; t >= 0; --t) {
        const float x0 = (t >= 3) ? bf2f(col[(size_t)(t - 3) * LDP]) : 0.f;
        const float y = w0 * x0 + w1 * x1 + w2 * x2 + w3 * x3;
        col[(size_t)t * LDP] = f2bf(siluf_(y));
        x3 = x2; x2 = x1; x1 = x0;
    }
}
__global__ void __launch_bounds__(256) k_gdn_l2norm(bf16_t* P) {
    const int unit = blockIdx.x * 4 + (threadIdx.x >> 6), lane = threadIdx.x & 63;
    const int m = unit / 16, r = unit % 16, which = r / 8, h = r % 8;
    bf16_t* p = P + (size_t)m * LDP + (which ? C_DK : C_DQ) + h * DN_D;
    float a = bf2f(p[lane]), b = bf2f(p[lane + 64]);
    float s = a * a + b * b;
    for (int o = 32; o > 0; o >>= 1) s += __shfl_xor(s, o);
    const float r_ = rsqrtf(s + EPS);
    p[lane] = f2bf(a * r_); p[lane + 64] = f2bf(b * r_);
}
__global__ void __launch_bounds__(128) k_gdn_scan(bf16_t* P, const float* __restrict__ a_log, const float* __restrict__ dt_bias, const float* __restrict__ out_norm) {
    __shared__ float qs[128], ks[128], red[2];
    const int b = blockIdx.x / DN_H, h = blockIdx.x % DN_H, j = threadIdx.x;
    float s[128];
#pragma unroll
    for (int i = 0; i < 128; ++i) s[i] = 0.f;
    const float Ah = -__expf(a_log[h]), dtb = dt_bias[h], gn = out_norm[j];
    const float scale = 0.08838834764831845f;
    for (int t = 0; t < SEQ; ++t) {
        bf16_t* row = P + (size_t)(b * SEQ + t) * LDP;
        __syncthreads();
        qs[j] = bf2f(row[C_DQ + h * DN_D + j]); ks[j] = bf2f(row[C_DK + h * DN_D + j]);
        const float v = bf2f(row[C_DV + h * DN_D + j]);
        const float beta = sigmoidf_(bf2f(row[C_SB + h]));
        const float gdec = Ah * softplusf_(bf2f(row[C_SA + h]) + dtb);
        const float a = __expf(gdec);
        const float z = bf2f(row[C_DZ + h * DN_D + j]);
        __syncthreads();
        float kS = 0.f;
#pragma unroll
        for (int i = 0; i < 128; ++i) kS += ks[i] * s[i];
        const float dlt = beta * (v - a * kS);
        float o = 0.f;
#pragma unroll
        for (int i = 0; i < 128; ++i) { s[i] = a * s[i] + ks[i] * dlt; o += qs[i] * s[i]; }
        o *= scale;
        const float ss = block_sum(o * o, red);
        const float y = o * rsqrtf(ss * (1.f / 128.f) + EPS) * gn * siluf_(z);
        row[C_DZ + h * DN_D + j] = f2bf(y);
    }
}

namespace nsa {
#define NLAS __attribute__((address_space(3)))
typedef short bf16x8 __attribute__((ext_vector_type(8)));
typedef short s16x4 __attribute__((ext_vector_type(4)));
typedef short v4i16_t __attribute__((ext_vector_type(4)));
typedef float f32x16 __attribute__((ext_vector_type(16)));
typedef float f32x4 __attribute__((ext_vector_type(4)));
typedef float f32x2 __attribute__((ext_vector_type(2)));
typedef unsigned u32x4 __attribute__((ext_vector_type(4)));
typedef __bf16 bf16x2_t __attribute__((ext_vector_type(2)));
constexpr float LOG2E = 1.4426950408889634f;
constexpr float NEG = -1e30f;
constexpr int L_KV = 0;
constexpr int L_IMP = 32768;
constexpr int L_SEL = 65536;
constexpr int L_WS = 66048;
constexpr int L_OST = 68096;
constexpr int L_END = 100864;

__device__ __forceinline__ int crow(int i, int hi) { return (i & 3) + 8 * (i >> 2) + 4 * hi; }
__device__ __forceinline__ unsigned pk(float lo, float hi) { f32x2 v = {lo, hi}; bf16x2_t b = __builtin_convertvector(v, bf16x2_t); return __builtin_bit_cast(unsigned, b); }
__device__ __forceinline__ float xhalf_max(float v) { auto rr = __builtin_amdgcn_permlane32_swap(__float_as_uint(v), __float_as_uint(v), false, false); return fmaxf(__uint_as_float(rr[0]), __uint_as_float(rr[1])); }
__device__ __forceinline__ float xhalf_sum(float v) { auto rr = __builtin_amdgcn_permlane32_swap(__float_as_uint(v), __float_as_uint(v), false, false); return __uint_as_float(rr[0]) + __uint_as_float(rr[1]); }

__device__ __forceinline__ void dma_tile(NLAS unsigned char* slot, const bf16_t* Kb, const bf16_t* Vb, unsigned koff, unsigned voff, int wid) {
    __builtin_amdgcn_global_load_lds((const unsigned*)((const char*)Kb + koff), (NLAS unsigned*)(slot + wid * 1024), 16, 0, 0);
    __builtin_amdgcn_global_load_lds((const unsigned*)((const char*)Vb + voff), (NLAS unsigned*)(slot + 8192 + wid * 1024), 16, 0, 0);
}
__device__ __forceinline__ void tile_offs(unsigned& koff, unsigned& voff, int pitch, int wid, int lane) {
    koff = (unsigned)(lane * pitch + wid * 8) * 2u;
    voff = (unsigned)((16 * (wid & 3) + (lane >> 2)) * pitch + (wid >> 2) * 32 + (lane & 3) * 8) * 2u;
}
__device__ __forceinline__ void qkt(f32x16& p0, f32x16& p1, NLAS const unsigned char* Kslot, const bf16x8* qr, const f32x16& c0, const f32x16& c1, int r32, int hi) {
    NLAS const unsigned char* kb = Kslot + hi * 1024 + r32 * 16;
#pragma unroll
    for (int d0 = 0; d0 < 4; ++d0) {
        const bf16x8 b0 = *(NLAS const bf16x8*)(kb + d0 * 2048);
        const bf16x8 b1 = *(NLAS const bf16x8*)(kb + d0 * 2048 + 512);
        if (d0 == 0) { p0 = __builtin_amdgcn_mfma_f32_32x32x16_bf16(b0, qr[0], c0, 0, 0, 0); p1 = __builtin_amdgcn_mfma_f32_32x32x16_bf16(b1, qr[0], c1, 0, 0, 0); }
        else { p0 = __builtin_amdgcn_mfma_f32_32x32x16_bf16(b0, qr[d0], p0, 0, 0, 0); p1 = __builtin_amdgcn_mfma_f32_32x32x16_bf16(b1, qr[d0], p1, 0, 0, 0); }
    }
}
__device__ __forceinline__ s16x4 vtr(NLAS const unsigned char* p) { return __builtin_bit_cast(s16x4, __builtin_amdgcn_ds_read_tr16_b64_v4i16((NLAS v4i16_t*)p)); }
__device__ __forceinline__ void pv(f32x16* o, NLAS const unsigned char* Vslot, const f32x16& p0, const f32x16& p1, int lane, int hi) {
    u32x4 w0 = {pk(p0[0], p0[1]), pk(p0[2], p0[3]), pk(p0[4], p0[5]), pk(p0[6], p0[7])};
    u32x4 w1 = {pk(p0[8], p0[9]), pk(p0[10], p0[11]), pk(p0[12], p0[13]), pk(p0[14], p0[15])};
    u32x4 w2 = {pk(p1[0], p1[1]), pk(p1[2], p1[3]), pk(p1[4], p1[5]), pk(p1[6], p1[7])};
    u32x4 w3 = {pk(p1[8], p1[9]), pk(p1[10], p1[11]), pk(p1[12], p1[13]), pk(p1[14], p1[15])};
    const bf16x8 pa[4] = {__builtin_bit_cast(bf16x8, w0), __builtin_bit_cast(bf16x8, w1), __builtin_bit_cast(bf16x8, w2), __builtin_bit_cast(bf16x8, w3)};
    NLAS const unsigned char* vp = Vslot + ((lane >> 4) & 1) * 32 + (lane & 3) * 8 + (4 * hi + ((lane & 15) >> 2)) * 64;
#pragma unroll
    for (int d0 = 0; d0 < 2; ++d0)
#pragma unroll
        for (int ks = 0; ks < 4; ++ks) {
            const s16x4 lo = vtr(vp + d0 * 4096 + ks * 1024), hh = vtr(vp + d0 * 4096 + ks * 1024 + 512);
            const bf16x8 vf = {lo[0], lo[1], lo[2], lo[3], hh[0], hh[1], hh[2], hh[3]};
            o[d0] = __builtin_amdgcn_mfma_f32_32x32x16_bf16(pa[ks], vf, o[d0], 0, 0, 0);
        }
}
__device__ __forceinline__ void scale_rows(f32x16* o, NLAS float* wsf, float s, int r32, int hi) {
    if (hi == 0) wsf[r32] = s;
#pragma unroll
    for (int i = 0; i < 16; ++i) { const float f = wsf[crow(i, hi)]; o[0][i] *= f; o[1][i] *= f; }
}
__device__ __forceinline__ void acc_rows(f32x16* tot, const f32x16* o, NLAS float* wsf, float s, int r32, int hi) {
    if (hi == 0) wsf[32 + r32] = s;
#pragma unroll
    for (int i = 0; i < 16; ++i) { const float f = wsf[32 + crow(i, hi)]; tot[0][i] += f * o[0][i]; tot[1][i] += f * o[1][i]; }
}
__device__ __forceinline__ void softmax_step(f32x16& p0, f32x16& p1, float& m, float& l, f32x16* o, NLAS float* wsf, int r32, int hi) {
    float t = fmaxf(p0[0], p1[0]);
#pragma unroll
    for (int i = 1; i < 16; ++i) t = fmaxf(t, fmaxf(p0[i], p1[i]));
    t = xhalf_max(t);
    const float mn = fmaxf(m, t);
    const float alpha = __builtin_amdgcn_exp2f(m - mn);
    float s = 0.f;
#pragma unroll
    for (int i = 0; i < 16; ++i) { p0[i] = __builtin_amdgcn_exp2f(p0[i] - mn); p1[i] = __builtin_amdgcn_exp2f(p1[i] - mn); s += p0[i] + p1[i]; }
    l = l * alpha + s; m = mn;
    if (__any(alpha != 1.f)) scale_rows(o, wsf, alpha, r32, hi);
}

__device__ __forceinline__ void attn_tile(NLAS unsigned char* lds, bf16_t* P, const bf16_t* KC, const bf16_t* VC, int b, int g, int qt) {
    const int tid = threadIdx.x, lane = tid & 63, r32 = lane & 31, hi = lane >> 5; const int wid = __builtin_amdgcn_readfirstlane(tid >> 6);
    const int head = g * 4 + (wid >> 1), qh = wid & 1, t0 = qt * 64, qi = qh * 32 + r32, blk_t = qt;
    NLAS float* wsf = (NLAS float*)(lds + L_WS) + wid * 64;
    NLAS float* imp = (NLAS float*)(lds + L_IMP);
    NLAS unsigned* selm = (NLAS unsigned*)(lds + L_SEL);
    NLAS unsigned char* slot0 = lds + L_KV; NLAS unsigned char* slot1 = lds + L_KV + 16384;
    const size_t rowbase = (size_t)b * SEQ;
    bf16_t* qrow = P + (rowbase + t0 + qi) * LDP;
    const float sl2 = exp2f(-0.5f * (float)(head + 1)) * LOG2E;
    bf16x8 qr[4];
#pragma unroll
    for (int d0 = 0; d0 < 4; ++d0) qr[d0] = *(const bf16x8*)(qrow + C_NQ + head * 64 + d0 * 16 + hi * 8);
    const float gate_c = sigmoidf_(bf2f(qrow[C_SG + head * 3 + 0])), gate_s = sigmoidf_(bf2f(qrow[C_SG + head * 3 + 1])), gate_w = sigmoidf_(bf2f(qrow[C_SG + head * 3 + 2]));
    f32x16 tot[2]; tot[0] = f32x16{}; tot[1] = f32x16{};
#define CRF(i) ((float)(((i) & 3) + 8 * ((i) >> 2)) + 4.f * (float)hiv)
#define OPAQUE_HI() int hiv = hi; asm volatile("" : "+v"(hiv))

    {
        const bf16_t* kcb = KC + ((size_t)(b * NS_G + g) * 128) * 64; const bf16_t* vcb = VC + ((size_t)(b * NS_G + g) * 128) * 64;
        const bool two = (qt >= 16);
        unsigned kof, vof; tile_offs(kof, vof, 64, wid, lane);
        dma_tile(slot0, kcb, vcb, kof, vof, wid);
        if (two) dma_tile(slot1, kcb + 64 * 64, vcb + 64 * 64, kof, vof, wid);
        __syncthreads();
        f32x16 pA0, pA1, pB0, pB1, c0, c1;
        const float s16 = sl2 * 16.f; OPAQUE_HI();
#pragma unroll
        for (int i = 0; i < 16; ++i) { c0[i] = s16 * CRF(i); c1[i] = s16 * (CRF(i) + 32.f); }
        qkt(pA0, pA1, slot0, qr, c0, c1, r32, hi);
        const int cmax = (t0 + qi - 31) >> 4;
        const int qposm = t0 + qi - 31;
#pragma unroll
        for (int i = 0; i < 16; ++i) { const int c = crow(i, hiv); if (16 * c > qposm) pA0[i] = NEG; if (16 * (c + 32) > qposm) pA1[i] = NEG; }
        if (two) {
#pragma unroll
            for (int i = 0; i < 16; ++i) { c0[i] += s16 * 64.f; c1[i] += s16 * 64.f; }
            qkt(pB0, pB1, slot1, qr, c0, c1, r32, hi);
#pragma unroll
            for (int i = 0; i < 16; ++i) { const int c = 64 + crow(i, hiv); if (16 * c > qposm) pB0[i] = NEG; if (16 * (c + 32) > qposm) pB1[i] = NEG; }
        } else { pB0 = f32x16{}; pB1 = f32x16{};
#pragma unroll
            for (int i = 0; i < 16; ++i) { pB0[i] = NEG; pB1[i] = NEG; } }
        (void)cmax;
        float mx = NEG;
#pragma unroll
        for (int i = 0; i < 16; ++i) mx = fmaxf(fmaxf(mx, fmaxf(pA0[i], pA1[i])), fmaxf(pB0[i], pB1[i]));
        mx = xhalf_max(mx);
        float s = 0.f;
#pragma unroll
        for (int i = 0; i < 16; ++i) { pA0[i] = __builtin_amdgcn_exp2f(pA0[i] - mx); pA1[i] = __builtin_amdgcn_exp2f(pA1[i] - mx); pB0[i] = __builtin_amdgcn_exp2f(pB0[i] - mx); pB1[i] = __builtin_amdgcn_exp2f(pB1[i] - mx);
            s += (pA0[i] + pA1[i]) + (pB0[i] + pB1[i]); }
        s = xhalf_sum(s);
        const float nrm = (t0 + qi >= 31) ? __builtin_amdgcn_rcpf(s) : 0.f;
#pragma unroll
        for (int i = 0; i < 16; ++i) { pA0[i] *= nrm; pA1[i] *= nrm; pB0[i] *= nrm; pB1[i] *= nrm; }
#define PSEL(L) ((L) < 4 ? pA0 : (L) < 8 ? pA1 : (L) < 12 ? pB0 : pB1)
#define MAINV(L) ((PSEL(L)[4 * ((L) & 3)] + PSEL(L)[4 * ((L) & 3) + 1]) + (PSEL(L)[4 * ((L) & 3) + 2] + 0.5f * PSEL(L)[4 * ((L) & 3) + 3]))
#define CARRY(L) (0.5f * PSEL(L)[4 * ((L) & 3) + 3])
#pragma unroll
        for (int L = 0; L < 16; ++L) {
            const float cprev = (L > 0) ? CARRY(L > 0 ? L - 1 : 0) : 0.f;
            const float snd = hi ? cprev : CARRY(L);
            const float rcv = __shfl_xor(snd, 32);
            imp[((wid >> 1) * 64 + qi) * 32 + 2 * L + hi] = MAINV(L) + rcv;
        }
#undef PSEL
#undef MAINV
#undef CARRY
        f32x16 o[2]; o[0] = f32x16{}; o[1] = f32x16{};
        pv(o, slot0 + 8192, pA0, pA1, lane, hi);
        if (two) pv(o, slot1 + 8192, pB0, pB1, lane, hi);
        acc_rows(tot, o, wsf, gate_c, r32, hi);
    }
    __syncthreads();
    if (wid == 0) {
        float v[32];
#pragma unroll
        for (int j = 0; j < 32; ++j) v[j] = (imp[(0 * 64 + lane) * 32 + j] + imp[(1 * 64 + lane) * 32 + j]) + (imp[(2 * 64 + lane) * 32 + j] + imp[(3 * 64 + lane) * 32 + j]);
        unsigned mask = 1u | (1u << blk_t);
#pragma unroll 1
        for (int it = 0; it < 6; ++it) {
            float best = -1.f; int bj = -1;
#pragma unroll
            for (int j = 1; j < 32; ++j) { const bool ok = (j < blk_t) && !((mask >> j) & 1u); if (ok && v[j] > best) { best = v[j]; bj = j; } }
            if (bj >= 0) mask |= 1u << bj;
        }
        selm[lane] = mask;
        unsigned any = mask;
#pragma unroll
        for (int o_ = 1; o_ < 64; o_ <<= 1) any |= __shfl_xor(any, o_);
        if (lane == 0) selm[64] = any;
    }
    __syncthreads();
    const unsigned mymask = selm[qi];
    const unsigned anym = (unsigned)__builtin_amdgcn_readfirstlane((int)selm[64]);
    unsigned kofP, vofP; tile_offs(kofP, vofP, LDP, wid, lane);
    {
        const bf16_t* kb = P + rowbase * LDP + C_KS + g * 64; const bf16_t* vb = P + rowbase * LDP + C_VS + g * 64;
        unsigned todo = anym;
        float m = NEG, l = 0.f; f32x16 o[2]; o[0] = f32x16{}; o[1] = f32x16{};
        int j = __builtin_ctz(todo); todo &= todo - 1;
        dma_tile(slot0, kb + (size_t)j * 64 * LDP, vb + (size_t)j * 64 * LDP, kofP, vofP, wid);
        int cur = 0;
        __syncthreads();
        for (;;) {
            const int jn = todo ? __builtin_ctz(todo) : -1; if (todo) todo &= todo - 1;
            NLAS unsigned char* sc = cur ? slot1 : slot0; NLAS unsigned char* sn = cur ? slot0 : slot1;
            if (jn >= 0) dma_tile(sn, kb + (size_t)jn * 64 * LDP, vb + (size_t)jn * 64 * LDP, kofP, vofP, wid);
            const bool mine = (mymask >> j) & 1u;
            if (__any(mine)) {
                f32x16 p0, p1, c0, c1; const float kb0 = sl2 * (float)(j * 64 - t0); OPAQUE_HI();
#pragma unroll
                for (int i = 0; i < 16; ++i) { c0[i] = kb0 + sl2 * CRF(i); c1[i] = c0[i] + sl2 * 32.f; }
                qkt(p0, p1, sc, qr, c0, c1, r32, hi);
                if (j == blk_t) {
#pragma unroll
                    for (int i = 0; i < 16; ++i) { const int kk = crow(i, hiv); if (kk > qi) p0[i] = NEG; if (kk + 32 > qi) p1[i] = NEG; }
                }
                if (!mine) {
#pragma unroll
                    for (int i = 0; i < 16; ++i) { p0[i] = NEG; p1[i] = NEG; }
                }
                softmax_step(p0, p1, m, l, o, wsf, r32, hi);
                pv(o, sc + 8192, p0, p1, lane, hi);
            }
            __syncthreads();
            if (jn < 0) break;
            j = jn; cur ^= 1;
        }
        l = xhalf_sum(l);
        acc_rows(tot, o, wsf, gate_s * __builtin_amdgcn_rcpf(l), r32, hi);
    }
    {
        const bf16_t* kb = P + rowbase * LDP + C_KW + g * 64; const bf16_t* vb = P + rowbase * LDP + C_VW + g * 64;
        float m = NEG, l = 0.f; f32x16 o[2]; o[0] = f32x16{}; o[1] = f32x16{};
        int j = blk_t; const int jlast = blk_t >= 4 ? blk_t - 4 : 0;
        dma_tile(slot0, kb + (size_t)j * 64 * LDP, vb + (size_t)j * 64 * LDP, kofP, vofP, wid);
        int cur = 0;
        __syncthreads();
        for (;;) {
            const int jn = (j > jlast) ? j - 1 : -1;
            NLAS unsigned char* sc = cur ? slot1 : slot0; NLAS unsigned char* sn = cur ? slot0 : slot1;
            if (jn >= 0) dma_tile(sn, kb + (size_t)jn * 64 * LDP, vb + (size_t)jn * 64 * LDP, kofP, vofP, wid);
            {
                f32x16 p0, p1, c0, c1; const float kb0 = sl2 * (float)(j * 64 - t0); OPAQUE_HI();
#pragma unroll
                for (int i = 0; i < 16; ++i) { c0[i] = kb0 + sl2 * CRF(i); c1[i] = c0[i] + sl2 * 32.f; }
                qkt(p0, p1, sc, qr, c0, c1, r32, hi);
                if (j == blk_t || j == blk_t - 4) {
                    const int dq = t0 + qi - j * 64;
#pragma unroll
                    for (int i = 0; i < 16; ++i) { const int d0_ = dq - crow(i, hiv), d1_ = d0_ - 32; if (d0_ < 0 || d0_ > 255) p0[i] = NEG; if (d1_ < 0 || d1_ > 255) p1[i] = NEG; }
                }
                softmax_step(p0, p1, m, l, o, wsf, r32, hi);
                pv(o, sc + 8192, p0, p1, lane, hi);
            }
            __syncthreads();
            if (jn < 0) break;
            j = jn; cur ^= 1;
        }
        l = xhalf_sum(l);
        acc_rows(tot, o, wsf, gate_w * __builtin_amdgcn_rcpf(l), r32, hi);
    }
    {
        NLAS bf16_t* stg = (NLAS bf16_t*)(lds + L_OST) + wid * 2048;
#pragma unroll
        for (int i = 0; i < 16; ++i) { const int orow = crow(i, hi); stg[orow * 64 + r32] = f2bf(tot[0][i]); stg[orow * 64 + 32 + r32] = f2bf(tot[1][i]); }
        bf16_t* ow = P + (rowbase + t0 + qh * 32) * LDP + C_NQ + head * 64;
#pragma unroll
        for (int i = 0; i < 4; ++i) { const int row = i * 8 + (lane >> 3), ch = lane & 7; const u32x4 v = *(NLAS const u32x4*)(stg + row * 64 + ch * 8); *(u32x4*)((char*)ow + (unsigned)(row * LDP + ch * 8) * 2u) = v; }
    }
    __syncthreads();
#undef CRF
#undef OPAQUE_HI
}

__device__ __forceinline__ void prep_units(bf16_t* P, const float* qn, const float* kns, const float* knw, int gw, int NGW, int lane) {
    for (int unit = gw; unit < M * 24; unit += NGW) {
        const int m = unit / 24, r = unit % 24;
        bf16_t* p; const float* g; float sc = 1.f;
        if (r < 16) { p = P + (size_t)m * LDP + C_NQ + r * 64; g = qn; sc = 0.125f * LOG2E; }
        else if (r < 20) { p = P + (size_t)m * LDP + C_KS + (r - 16) * 64; g = kns; }
        else { p = P + (size_t)m * LDP + C_KW + (r - 20) * 64; g = knw; }
        const float a = bf2f(p[lane]);
        float s = a * a;
#pragma unroll
        for (int o = 32; o > 0; o >>= 1) s += __shfl_xor(s, o);
        p[lane] = f2bf(a * rsqrtf(s * (1.f / 64.f) + EPS) * g[lane] * sc);
    }
}

constexpr int LC_HID = 0;
__device__ __forceinline__ void compress_item(NLAS unsigned char* lds, const bf16_t* P, const bf16_t* W1T, const float* bias1, const float* W2, const float* gain, bf16_t* OUT, int b, int g, int which, int half) {
    const int tid = threadIdx.x, lane = tid & 63, r32 = lane & 31, hi = lane >> 5; const int wid = __builtin_amdgcn_readfirstlane(tid >> 6);
    const int mt = wid >> 2, nt = wid & 3;
    const int c = 64 * half + 32 * mt + r32;
    const int cc = c < NCMP ? c : NCMP - 1;
    const bf16_t* arow = P + ((size_t)b * SEQ + 16 * cc) * LDP + (which ? C_VC : C_KC) + g * 64 + hi * 8;
    const bf16_t* brow = W1T + (size_t)(32 * nt + r32) * 2048 + hi * 8;
    f32x16 acc = f32x16{};
#pragma unroll 4
    for (int l = 0; l < 32; ++l) {
#pragma unroll
        for (int ds = 0; ds < 4; ++ds) {
            const bf16x8 a = *(const bf16x8*)(arow + (size_t)l * LDP + ds * 16);
            const bf16x8 w = *(const bf16x8*)(brow + l * 64 + ds * 16);
            acc = __builtin_amdgcn_mfma_f32_32x32x16_bf16(a, w, acc, 0, 0, 0);
        }
    }
    NLAS float* hid = (NLAS float*)(lds + LC_HID);
    const float bs = bias1[32 * nt + r32];
#pragma unroll
    for (int i = 0; i < 16; ++i) hid[(32 * mt + crow(i, hi)) * 132 + 32 * nt + r32] = gelu_tanh(acc[i] + bs);
    __syncthreads();
    {
        const int row = tid >> 3, e0 = (tid & 7) * 8;
        float o[8];
#pragma unroll
        for (int e = 0; e < 8; ++e) o[e] = 0.f;
        for (int i = 0; i < 128; ++i) { const float h = hid[row * 132 + i]; const f32x4 wa = *(const f32x4*)(W2 + i * 64 + e0), wb = *(const f32x4*)(W2 + i * 64 + e0 + 4);
            o[0] += h * wa[0]; o[1] += h * wa[1]; o[2] += h * wa[2]; o[3] += h * wa[3]; o[4] += h * wb[0]; o[5] += h * wb[1]; o[6] += h * wb[2]; o[7] += h * wb[3]; }
        if (which == 0) {
            float ss = 0.f;
#pragma unroll
            for (int e = 0; e < 8; ++e) ss += o[e] * o[e];
            ss += __shfl_xor(ss, 1); ss += __shfl_xor(ss, 2); ss += __shfl_xor(ss, 4);
            const float r = rsqrtf(ss * (1.f / 64.f) + EPS);
#pragma unroll
            for (int e = 0; e < 8; ++e) o[e] *= r * gain[e0 + e];
        }
        const int cg = 64 * half + row;
        if (cg >= NCMP) {
#pragma unroll
            for (int e = 0; e < 8; ++e) o[e] = 0.f; }
        u32x4 w; w.x = pk(o[0], o[1]); w.y = pk(o[2], o[3]); w.z = pk(o[4], o[5]); w.w = pk(o[6], o[7]);
        *(u32x4*)(OUT + (((size_t)(b * NS_G + g) * 128) + cg) * 64 + e0) = w;
    }
    __syncthreads();
}
}
namespace pg8 {
#define PG8_LAS __attribute__((address_space(3)))
typedef short bf16x8 __attribute__((ext_vector_type(8)));
typedef float f32x4 __attribute__((ext_vector_type(4)));
typedef float f32x2 __attribute__((ext_vector_type(2)));
typedef unsigned u32x4 __attribute__((ext_vector_type(4)));
typedef unsigned u32x2 __attribute__((ext_vector_type(2)));
constexpr int BM = 256, BK = 64, HALF = 128, HTB = HALF * BK * 2, STAGE_BYTES = 8 * HTB, NXCD = 8, WGM = 8;

__host__ __device__ __forceinline__ int lds_byte(int r, int c) { const int st = (r >> 4) * 2 + (c >> 5), rr = r & 15, cc = c & 31, ob = rr * 64 + cc * 2; return st * 1024 + (ob ^ (((ob >> 9) & 1) << 5)); }
__host__ __device__ __forceinline__ void stage_rc(int b, int& R, int& C) { const int st = b / 1024, sb = b % 1024, swz = sb ^ (((sb >> 9) & 1) << 5); R = (st >> 1) * 16 + swz / 64; C = (st & 1) * 32 + (swz % 64) / 2; }
__host__ __device__ __forceinline__ int perm32(int rho) { const int n = rho >> 4, i = rho & 15; return 8 * (i >> 2) + 4 * n + (i & 3); }

struct Unit { int pm, pn, ks; };
struct Gemm { const bf16_t* A; const bf16_t* Bt; int lda, ldb; int M, N, K; int ksoff; };

struct StaticOrder {
    int nM, nN, nwg, G, c;
    __host__ __device__ void init(int M_, int N_, int G_, int c_) { nM = M_ / BM; nN = N_ / BM; nwg = nM * nN; G = G_; c = c_; }
    __host__ __device__ bool next(int i, Unit& u) const {
        const long L = (long)i * G + c; if (L >= nwg) return false;
        int wgid = (int)L; { const int q = nwg / NXCD, r = nwg % NXCD, xcd = wgid % NXCD, off = wgid / NXCD; wgid = (xcd < r ? xcd * (q + 1) : r * (q + 1) + (xcd - r) * q) + off; }
        const int nig = WGM * nN, gid = wgid / nig, fm = gid * WGM, gsz = (nM - fm) < WGM ? (nM - fm) : WGM;
        u.pm = fm + ((wgid % nig) % gsz); u.pn = (wgid % nig) / gsz; u.ks = 0; return true;
    }
};
struct TwoPassOrder {
    StaticOrder base;
    __host__ __device__ bool next(int i, Unit& u) const { if (!base.next(i >> 1, u)) return false; u.ks = i & 1; return true; }
};

typedef __bf16 bf16x2_t __attribute__((ext_vector_type(2)));
__device__ __forceinline__ unsigned cvt_pk_bf16(float lo, float hi) { f32x2 v = {lo, hi}; bf16x2_t b = __builtin_convertvector(v, bf16x2_t); return __builtin_bit_cast(unsigned, b); }
__device__ __forceinline__ float fast_sigmoid(float x) { return __builtin_amdgcn_rcpf(1.f + __builtin_amdgcn_exp2f(-1.4426950408889634f * x)); }
__device__ __forceinline__ float bflo(unsigned w) { return __uint_as_float(w << 16); }
__device__ __forceinline__ float bfhi(unsigned w) { return __uint_as_float(w & 0xffff0000u); }

typedef f32x4 Acc[2][2][4][2];

template <int ACT> struct EpiP {
    static constexpr bool PERM = true;
    bf16_t* O; int ldc; int pn_last; int ncol_last;
    __device__ __forceinline__ void operator()(const Acc& acc, const Unit& u, int wr, int wc, int fr, int fq) const {
        const int row0 = u.pm * BM + wr * 64 + fr, tcol = wc * 32 + 8 * fq;
        const int lim = (u.pn == pn_last) ? ncol_last : 256;
#pragma unroll
        for (int ai = 0; ai < 2; ++ai)
#pragma unroll
            for (int m = 0; m < 4; ++m) { bf16_t* rowp = O + (size_t)(row0 + ai * HALF + m * 16) * ldc + u.pn * BM + tcol;
#pragma unroll
                for (int bj = 0; bj < 2; ++bj) { if (tcol + bj * HALF >= lim) continue;
                    f32x4 v0 = acc[ai][bj][m][0], v1 = acc[ai][bj][m][1];
                    if (ACT == 1) {
#pragma unroll
                        for (int e = 0; e < 4; ++e) { v0[e] = fast_sigmoid(v0[e]); v1[e] = fast_sigmoid(v1[e]); } }
                    u32x4 w; w.x = cvt_pk_bf16(v0[0], v0[1]); w.y = cvt_pk_bf16(v0[2], v0[3]); w.z = cvt_pk_bf16(v1[0], v1[1]); w.w = cvt_pk_bf16(v1[2], v1[3]);
                    *(u32x4*)(rowp + bj * HALF) = w; } }
    }
};
struct EpiMix {
    static constexpr bool PERM = true;
    const bf16_t* G; int ldg; bf16_t* O; int ldc;
    __device__ __forceinline__ void operator()(const Acc& acc, const Unit& u, int wr, int wc, int fr, int fq) const {
        const int row0 = u.pm * BM + wr * 64 + fr, col0 = u.pn * BM + wc * 32 + 8 * fq;
#pragma unroll
        for (int ai = 0; ai < 2; ++ai)
#pragma unroll
            for (int m = 0; m < 4; ++m) { const size_t row = (size_t)(row0 + ai * HALF + m * 16); const bf16_t* gp = G + row * ldg + col0 + u.ks * 1024; bf16_t* rowp = O + row * ldc + col0;
#pragma unroll
                for (int bj = 0; bj < 2; ++bj) { const u32x4 b = *(const u32x4*)(gp + bj * HALF);
                    f32x4 v0 = acc[ai][bj][m][0], v1 = acc[ai][bj][m][1];
                    v0[0] *= bflo(b.x); v0[1] *= bfhi(b.x); v0[2] *= bflo(b.y); v0[3] *= bfhi(b.y); v1[0] *= bflo(b.z); v1[1] *= bfhi(b.z); v1[2] *= bflo(b.w); v1[3] *= bfhi(b.w);
                    if (u.ks) { const u32x4 p = *(const u32x4*)(rowp + bj * HALF);
                        v0[0] += bflo(p.x); v0[1] += bfhi(p.x); v0[2] += bflo(p.y); v0[3] += bfhi(p.y); v1[0] += bflo(p.z); v1[1] += bfhi(p.z); v1[2] += bflo(p.w); v1[3] += bfhi(p.w); }
                    u32x4 w; w.x = cvt_pk_bf16(v0[0], v0[1]); w.y = cvt_pk_bf16(v0[2], v0[3]); w.z = cvt_pk_bf16(v1[0], v1[1]); w.w = cvt_pk_bf16(v1[2], v1[3]);
                    *(u32x4*)(rowp + bj * HALF) = w; } }
    }
};
struct EpiOut {
    static constexpr bool PERM = false;
    const float* X; float* X1; bf16_t* An; const float* gain; float* pss;
    __device__ __forceinline__ void operator()(const Acc& acc, const Unit& u, int wr, int wc, int fr, int fq) const {
        const int row0 = u.pm * BM + wr * 64 + fr, col0 = u.pn * BM + wc * 32 + 4 * fq;
        f32x4 gv[2][2];
#pragma unroll
        for (int bj = 0; bj < 2; ++bj)
#pragma unroll
            for (int n = 0; n < 2; ++n) gv[bj][n] = *(const f32x4*)(gain + col0 + bj * HALF + n * 16);
#pragma unroll
        for (int ai = 0; ai < 2; ++ai)
#pragma unroll
            for (int m = 0; m < 4; ++m) { const size_t row = (size_t)(row0 + ai * HALF + m * 16); const size_t off = row * D + col0; float ss = 0.f;
#pragma unroll
                for (int bj = 0; bj < 2; ++bj)
#pragma unroll
                    for (int n = 0; n < 2; ++n) { const f32x4 x1 = *(const f32x4*)(X + off + bj * HALF + n * 16) + acc[ai][bj][m][n];
                        *(f32x4*)(X1 + off + bj * HALF + n * 16) = x1; ss += (x1[0] * x1[0] + x1[1] * x1[1]) + (x1[2] * x1[2] + x1[3] * x1[3]);
                        const f32x4 y = x1 * gv[bj][n]; u32x2 w; w.x = cvt_pk_bf16(y[0], y[1]); w.y = cvt_pk_bf16(y[2], y[3]); *(u32x2*)(An + off + bj * HALF + n * 16) = w; }
                ss += __shfl_xor(ss, 16); ss += __shfl_xor(ss, 32);
                if (fq == 0) pss[row * 16 + u.pn * 4 + wc] = ss; }
    }
};
struct EpiUp {
    static constexpr bool PERM = true;
    const float* pss; bf16_t* O; int ldc;
    __device__ __forceinline__ void operator()(const Acc& acc, const Unit& u, int wr, int wc, int fr, int fq) const {
        const int row0 = u.pm * BM + wr * 64 + fr, col0 = u.pn * BM + wc * 32 + 8 * fq;
#pragma unroll
        for (int ai = 0; ai < 2; ++ai)
#pragma unroll
            for (int m = 0; m < 4; ++m) { const size_t row = (size_t)(row0 + ai * HALF + m * 16);
                const f32x4* pp = (const f32x4*)(pss + row * 16); const f32x4 s4 = (pp[0] + pp[1]) + (pp[2] + pp[3]);
                const float rstd = rsqrtf(((s4[0] + s4[1]) + (s4[2] + s4[3])) * (1.f / D) + EPS);
                bf16_t* rowp = O + row * ldc + col0;
#pragma unroll
                for (int bj = 0; bj < 2; ++bj) { f32x4 v0 = acc[ai][bj][m][0] * rstd, v1 = acc[ai][bj][m][1] * rstd;
#pragma unroll
                    for (int e = 0; e < 4; ++e) { const float a = fmaxf(v0[e], 0.f), b = fmaxf(v1[e], 0.f); v0[e] = a * a; v1[e] = b * b; }
                    u32x4 w; w.x = cvt_pk_bf16(v0[0], v0[1]); w.y = cvt_pk_bf16(v0[2], v0[3]); w.z = cvt_pk_bf16(v1[0], v1[1]); w.w = cvt_pk_bf16(v1[2], v1[3]);
                    *(u32x4*)(rowp + bj * HALF) = w; } }
    }
};
struct EpiDown {
    static constexpr bool PERM = false;
    float* X1;
    __device__ __forceinline__ void operator()(const Acc& acc, const Unit& u, int wr, int wc, int fr, int fq) const {
        const int row0 = u.pm * BM + wr * 64 + fr, col0 = u.pn * BM + wc * 32 + 4 * fq;
#pragma unroll
        for (int ai = 0; ai < 2; ++ai)
#pragma unroll
            for (int m = 0; m < 4; ++m) { float* rowp = X1 + (size_t)(row0 + ai * HALF + m * 16) * D + col0;
#pragma unroll
                for (int bj = 0; bj < 2; ++bj)
#pragma unroll
                    for (int n = 0; n < 2; ++n) { f32x4* p = (f32x4*)(rowp + bj * HALF + n * 16); *p = *p + acc[ai][bj][m][n]; } }
    }
};

template <class Epi, class Sched, bool ALIGN_EPI>
__device__ __forceinline__ void gemm_phase(PG8_LAS unsigned char* lds, const Gemm g, const Sched& S, const Epi& E) {
    const int tid = threadIdx.x, wid = __builtin_amdgcn_readfirstlane(tid >> 6), lane = tid & 63, wr = wid >> 2, wc = wid & 3, fr = lane & 15, fq = lane >> 4;
    const int K = g.K, nt = K / BK, lda = g.lda, ldb = g.ldb;
    unsigned voffA[2], voffB[2];
#pragma unroll
    for (int i = 0; i < 2; ++i) { int R, C; stage_rc(tid * 16 + i * 8192, R, C); const int Rb = Epi::PERM ? ((R & ~31) + perm32(R & 31)) : R;
        voffA[i] = (unsigned)(R * lda + C) * 2u; voffB[i] = (unsigned)(Rb * ldb + C) * 2u; }
    const size_t kstep = (size_t)(BK * 2);
    const size_t hstepA = (size_t)HALF * lda * 2, hstepB = (size_t)HALF * ldb * 2;
    const size_t tstepA = 2 * hstepA, tstepB = 2 * hstepB;
    const unsigned ldsw = (unsigned)wid * 1024u;
    const int aoff = lds_byte(wr * 64 + fr, fq * 8), boff = lds_byte(wc * 32 + fr, fq * 8);
#define PG8_SA(b, h) (((b) * 2 + (h)) * HTB)
#define PG8_SB(b, h) ((4 + (b) * 2 + (h)) * HTB)
#define PG8_STAGE(bufoff, gbase, voff) do { _Pragma("unroll") for (int _i = 0; _i < 2; ++_i) \
        __builtin_amdgcn_global_load_lds((const unsigned*)((const char*)(gbase) + (voff)[_i]), (PG8_LAS unsigned*)(lds + (bufoff) + ldsw + _i * 8192), 16, 0, 0); } while (0)
#define PG8_LDA(dst, b, h) do { _Pragma("unroll") for (int m = 0; m < 4; ++m) _Pragma("unroll") for (int k = 0; k < 2; ++k) dst[m][k] = *(const PG8_LAS bf16x8*)(lds + PG8_SA(b, h) + aoff + m * 2048 + k * 1024); } while (0)
#define PG8_LDB(dst, b, h) do { _Pragma("unroll") for (int n = 0; n < 2; ++n) _Pragma("unroll") for (int k = 0; k < 2; ++k) dst[n][k] = *(const PG8_LAS bf16x8*)(lds + PG8_SB(b, h) + boff + n * 2048 + k * 1024); } while (0)
#define PG8_MMA(ai, bj, At, Bt) do { __builtin_amdgcn_s_setprio(1); _Pragma("unroll") for (int m = 0; m < 4; ++m) _Pragma("unroll") for (int n = 0; n < 2; ++n) _Pragma("unroll") for (int k = 0; k < 2; ++k) \
        acc[ai][bj][m][n] = __builtin_amdgcn_mfma_f32_16x16x32_bf16(Bt[n][k], At[m][k], acc[ai][bj][m][n], 0, 0, 0); __builtin_amdgcn_s_setprio(0); } while (0)
#define PG8_WAIT_V(n) asm volatile("s_waitcnt vmcnt(" #n ")" ::: "memory")
#define PG8_WAIT_L(n) asm volatile("s_waitcnt lgkmcnt(" #n ")" ::: "memory")
#define PG8_BAR __builtin_amdgcn_s_barrier()
#define PG8_SCHED __builtin_amdgcn_sched_barrier(0)
#define PG8_KBODY(t) do { \
            const bool last = (t == nt - 2); \
            const char* a1 = cA + (size_t)(t + 1) * kstep; \
            const char* a2 = last ? nA : cA + (size_t)(t + 2) * kstep; const char* b2 = last ? nB : cB + (size_t)(t + 2) * kstep; \
            const char* a3 = a2 + kstep; const char* b3 = b2 + kstep; \
            PG8_LDB(B0, 0, 0); PG8_LDB(B1, 0, 1); PG8_SCHED; PG8_LDA(At, 0, 0); PG8_STAGE(PG8_SA(1, 1), a1 + hstepA, voffA); \
            PG8_WAIT_V(8); PG8_WAIT_L(0); PG8_BAR; PG8_MMA(0, 0, At, B0); PG8_MMA(0, 1, At, B1); PG8_BAR; PG8_SCHED; \
            PG8_LDA(At, 0, 1); PG8_STAGE(PG8_SB(0, 0), b2, voffB); PG8_STAGE(PG8_SB(0, 1), b2 + hstepB, voffB); PG8_STAGE(PG8_SA(0, 0), a2, voffA); \
            PG8_WAIT_V(8); PG8_WAIT_L(0); PG8_BAR; PG8_MMA(1, 0, At, B0); PG8_MMA(1, 1, At, B1); PG8_BAR; PG8_SCHED; \
            PG8_LDB(B0, 1, 0); PG8_LDB(B1, 1, 1); PG8_SCHED; PG8_LDA(At, 1, 0); PG8_STAGE(PG8_SA(0, 1), a2 + hstepA, voffA); \
            PG8_WAIT_V(8); PG8_WAIT_L(0); PG8_BAR; PG8_MMA(0, 0, At, B0); PG8_MMA(0, 1, At, B1); PG8_BAR; PG8_SCHED; \
            PG8_LDA(At, 1, 1); PG8_STAGE(PG8_SB(1, 0), b3, voffB); PG8_STAGE(PG8_SB(1, 1), b3 + hstepB, voffB); PG8_STAGE(PG8_SA(1, 0), a3, voffA); \
            PG8_WAIT_V(8); PG8_WAIT_L(0); PG8_BAR; PG8_MMA(1, 0, At, B0); PG8_MMA(1, 1, At, B1); PG8_BAR; PG8_SCHED; \
        } while (0)
    Unit cur, nxt; int ui = 0;
    if (!S.next(0, cur)) return;
    Acc acc;
#pragma unroll
    for (int a = 0; a < 2; ++a)
#pragma unroll
        for (int b = 0; b < 2; ++b)
#pragma unroll
            for (int m = 0; m < 4; ++m)
#pragma unroll
                for (int n = 0; n < 2; ++n) acc[a][b][m][n] = (f32x4){0.f, 0.f, 0.f, 0.f};
    bf16x8 At[4][2], B0[2][2], B1[2][2];
    const char* cA = (const char*)g.A + (size_t)cur.pm * tstepA + (size_t)cur.ks * g.ksoff * 2; const char* cB = (const char*)g.Bt + (size_t)cur.pn * tstepB + (size_t)cur.ks * g.ksoff * 2;
    PG8_STAGE(PG8_SB(0, 0), cB, voffB); PG8_STAGE(PG8_SB(0, 1), cB + hstepB, voffB); PG8_STAGE(PG8_SA(0, 0), cA, voffA); PG8_STAGE(PG8_SA(0, 1), cA + hstepA, voffA);
    if (wr == 1) PG8_BAR;
    PG8_WAIT_V(2); PG8_BAR;
    PG8_STAGE(PG8_SB(1, 0), cB + kstep, voffB); PG8_STAGE(PG8_SA(1, 0), cA + kstep, voffA); PG8_STAGE(PG8_SB(1, 1), cB + hstepB + kstep, voffB);
    PG8_WAIT_V(6); PG8_BAR;
    for (;;) {
        const bool has_next = S.next(ui + 1, nxt);
        const char* nA = has_next ? (const char*)g.A + (size_t)nxt.pm * tstepA + (size_t)nxt.ks * g.ksoff * 2 : cA; const char* nB = has_next ? (const char*)g.Bt + (size_t)nxt.pn * tstepB + (size_t)nxt.ks * g.ksoff * 2 : cB;
        for (int t = 0; t < nt; t += 2) PG8_KBODY(t);
        if constexpr (ALIGN_EPI) { if (wr == 0) PG8_BAR; }
        E(acc, cur, wr, wc, fr, fq);
        if (!has_next) break;
#pragma unroll
        for (int a = 0; a < 2; ++a)
#pragma unroll
            for (int b = 0; b < 2; ++b)
#pragma unroll
                for (int m = 0; m < 4; ++m)
#pragma unroll
                    for (int n = 0; n < 2; ++n) acc[a][b][m][n] = (f32x4){0.f, 0.f, 0.f, 0.f};
        cur = nxt; cA = nA; cB = nB; ++ui;
        if constexpr (ALIGN_EPI) { if (wr == 1) PG8_BAR; }
    }
    PG8_WAIT_V(0);
    if constexpr (!ALIGN_EPI) { if (wr == 0) PG8_BAR; }
    PG8_BAR;
#undef PG8_SA
#undef PG8_SB
#undef PG8_STAGE
#undef PG8_LDA
#undef PG8_LDB
#undef PG8_MMA
#undef PG8_WAIT_V
#undef PG8_WAIT_L
#undef PG8_BAR
#undef PG8_SCHED
#undef PG8_KBODY
}
}

#define GAS __attribute__((address_space(1)))
#define LAS __attribute__((address_space(3)))
typedef unsigned v4u __attribute__((ext_vector_type(4)));
typedef float f32x4 __attribute__((ext_vector_type(4)));
constexpr int NWAVES = 8;
constexpr int LDS_BYTES = 147456;
constexpr size_t MiB = 1u << 20;
constexpr size_t WS_PSS = 1 * MiB, WS_WOUT = 2 * MiB, WS_P = 4 * MiB, WS_KC = 214 * MiB, WS_VC = 215 * MiB, WS_MIX = 216 * MiB;
constexpr size_t WS_AN = 4 * MiB, WS_UP = 64 * MiB, WS_WUP = 192 * MiB, WS_WDOWN = 200 * MiB;
constexpr size_t WS_BIAS1 = 0, WS_W1T = 214 * MiB, WS_KCB = 215 * MiB, WS_VCB = 215 * MiB + 512 * 1024;
constexpr size_t DO_H = 0, DO_WG = 32 * MiB, DO_WCAT = 36 * MiB, DO_WIN = 40 * MiB;

__device__ __forceinline__ unsigned pk2(float lo, float hi) { return (unsigned)f2bf(lo) | ((unsigned)f2bf(hi) << 16); }
__device__ __forceinline__ float wave_sum(float v) {
#pragma unroll
    for (int o = 1; o < 64; o <<= 1) v += __shfl_xor(v, o);
    return v;
}
template <class SrcCol>
__device__ __forceinline__ void transpose_item(const float* W, int ldw, const SrcCol& srccol, bf16_t* WT, int ldk, int kofs, LAS float* scr, int kb, int nb, int lane) {
    const int k0 = 64 * kb, n0 = 32 * nb; const int sc = srccol(n0 + (lane & 31));
#pragma unroll 8
    for (int i = 0; i < 32; ++i) { const int kk = 2 * i + (lane >> 5); scr[kk * 33 + (lane & 31)] = (sc >= 0) ? W[(size_t)(k0 + kk) * ldw + sc] : 0.f; }
    asm volatile("s_waitcnt lgkmcnt(0)" ::: "memory");
    const int c = lane & 7;
#pragma unroll
    for (int j = 0; j < 4; ++j) { const int n = (lane >> 3) + 8 * j; const LAS float* s = scr + (8 * c) * 33 + n;
        v4u o; o.x = pk2(s[0 * 33], s[1 * 33]); o.y = pk2(s[2 * 33], s[3 * 33]); o.z = pk2(s[4 * 33], s[5 * 33]); o.w = pk2(s[6 * 33], s[7 * 33]);
        *(v4u*)(WT + (size_t)(n0 + n) * ldk + kofs + k0 + 8 * c) = o; }
    asm volatile("s_waitcnt lgkmcnt(0)" ::: "memory");
}
struct SrcIdent { int off; __device__ __forceinline__ int operator()(int n) const { return n + off; } };
struct SrcWin { __device__ __forceinline__ int operator()(int n) const { return n < 4096 ? n : (n < 6656 ? n + 16 : (n < 6672 ? n - 6656 + 4096 : (n < 6720 ? n : -1))); } };

struct Args { const float* in[23]; float* out; unsigned char* ws; int ph_lo, ph_hi; };

__global__ void __launch_bounds__(NWAVES * 64, 2) mk_fwd(Args args) {
    extern __shared__ __attribute__((aligned(16))) unsigned char lds_raw[];
    LAS unsigned char* lds = (LAS unsigned char*)lds_raw;
    cg::grid_group grid = cg::this_grid();
    const int tid = threadIdx.x, lane = tid & 63, wave = __builtin_amdgcn_readfirstlane(tid >> 6);
    const int G = gridDim.x, gw = blockIdx.x * NWAVES + wave, NGW = G * NWAVES;
    unsigned char* ws = args.ws; unsigned char* dob = (unsigned char*)args.out;
    const float* x = args.in[0];
    bf16_t* P = (bf16_t*)(ws + WS_P);
    bf16_t* Hb = (bf16_t*)(dob + DO_H); bf16_t* Wg_t = (bf16_t*)(dob + DO_WG); bf16_t* Wcat_t = (bf16_t*)(dob + DO_WCAT); bf16_t* Win_t = (bf16_t*)(dob + DO_WIN);
    bf16_t* Wout_t = (bf16_t*)(ws + WS_WOUT); bf16_t* Wup_t = (bf16_t*)(ws + WS_WUP); bf16_t* Wdown_t = (bf16_t*)(ws + WS_WDOWN);
    bf16_t* Mix = (bf16_t*)(ws + WS_MIX); bf16_t* An = (bf16_t*)(ws + WS_AN); bf16_t* Up = (bf16_t*)(ws + WS_UP); float* pss = (float*)(ws + WS_PSS);
    LAS float* scr = (LAS float*)(lds + wave * 16384);
    bf16_t* W1T = (bf16_t*)(ws + WS_W1T); float* bias1 = (float*)(ws + WS_BIAS1); bf16_t* KCb = (bf16_t*)(ws + WS_KCB); bf16_t* VCb = (bf16_t*)(ws + WS_VCB);
    const int lo = args.ph_lo, hi = args.ph_hi;
#ifndef PHMASK
#define PHMASK 0x1ff
#endif
#define IN(k) (((PHMASK >> (k)) & 1) && lo <= (k) && (k) < hi)
#define GRID_SYNC() do { asm volatile("s_waitcnt vmcnt(0) lgkmcnt(0)" ::: "memory"); grid.sync(); \
        if (wave == 0) { __builtin_amdgcn_fence(__ATOMIC_ACQUIRE, "agent"); asm volatile("s_waitcnt vmcnt(0)" ::: "memory"); } __syncthreads(); } while (0)
#define SEAM(k) do { if (IN(k) && IN((k) + 1)) GRID_SYNC(); } while (0)

    if (IN(0)) {
        constexpr int I_WIN = 16 * (NP1 / 32), I_WG = 16 * 64, I_DN = 16 * 32, I_OUT = 16 * 32;
        constexpr int I_W1 = 32 * 4, I_B1 = 256;
        constexpr int NITEMS = I_WIN + I_WG + 2 * I_DN + I_OUT + 2 * I_W1 + I_B1;
        for (int it = gw; it < NITEMS; it += NGW) {
            int r = it;
            if (r < I_WIN) { transpose_item(args.in[2], INW, SrcWin{}, Win_t, D, 0, scr, r / (NP1 / 32), r % (NP1 / 32), lane); continue; } r -= I_WIN;
            if (r < I_WG) { transpose_item(args.in[2], INW, SrcIdent{6720}, Wg_t, D, 0, scr, r / 64, r % 64, lane); continue; } r -= I_WG;
            if (r < I_DN) { transpose_item(args.in[17], D, SrcIdent{0}, Wcat_t, 2 * D, 0, scr, r / 32, r % 32, lane); continue; } r -= I_DN;
            if (r < I_DN) { transpose_item(args.in[18], D, SrcIdent{0}, Wcat_t, 2 * D, D, scr, r / 32, r % 32, lane); continue; } r -= I_DN;
            if (r < I_OUT) { transpose_item(args.in[19], D, SrcIdent{0}, Wout_t, D, 0, scr, r / 32, r % 32, lane); continue; } r -= I_OUT;
            if (r < I_W1) { transpose_item(args.in[12], 128, SrcIdent{0}, W1T, 2048, 0, scr, r / 4, r % 4, lane); continue; } r -= I_W1;
            if (r < I_W1) { transpose_item(args.in[15], 128, SrcIdent{0}, W1T + 128 * 2048, 2048, 0, scr, r / 4, r % 4, lane); continue; } r -= I_W1;
            {
                const int which = r >> 7, i = r & 127; const float* pos = args.in[which ? 14 : 11]; const float* w1 = args.in[which ? 15 : 12];
                float a = 0.f;
                for (int k = lane; k < 2048; k += 64) a += pos[k] * w1[(size_t)k * 128 + i];
                a = wave_sum(a);
                if (lane == 0) bias1[r] = a;
            }
        }
        const float* gain = args.in[1];
        f32x4 gv[4];
#pragma unroll
        for (int j = 0; j < 4; ++j) gv[j] = ((const f32x4*)gain)[lane + 64 * j];
        for (int m = gw; m < M; m += NGW) {
            const f32x4* xr = (const f32x4*)(x + (size_t)m * D) + lane;
            f32x4 v[4]; float s = 0.f;
#pragma unroll
            for (int j = 0; j < 4; ++j) { v[j] = xr[64 * j]; s += (v[j].x * v[j].x + v[j].y * v[j].y) + (v[j].z * v[j].z + v[j].w * v[j].w); }
            const float rstd = rsqrtf(wave_sum(s) * (1.f / D) + EPS);
            unsigned long long* o8 = (unsigned long long*)(Hb + (size_t)m * D) + lane;
#pragma unroll
            for (int j = 0; j < 4; ++j) { const f32x4 y = v[j] * rstd * gv[j]; o8[64 * j] = (unsigned long long)pk2(y.x, y.y) | ((unsigned long long)pk2(y.z, y.w) << 32); }
        }
    }
    SEAM(0);
    if (IN(1)) {
        pg8::Gemm g{Hb, Win_t, D, D, M, NP1, D, 0}; pg8::StaticOrder S; S.init(M, NP1, G, (int)blockIdx.x);
        pg8::EpiP<0> E{P, LDP, 26, 64};
        pg8::gemm_phase<pg8::EpiP<0>, pg8::StaticOrder, true>(lds, g, S, E);
    }
    SEAM(1);
    if (IN(2)) {
        for (int it = blockIdx.x; it < 128; it += G) {
            const int half = it & 1, which = (it >> 1) & 1, g_ = (it >> 2) & 3, b_ = it >> 4;
            nsa::compress_item(lds, P, W1T + (size_t)which * 128 * 2048, bias1 + which * 128, args.in[which ? 16 : 13], args.in[8], which ? VCb : KCb, b_, g_, which, half);
        }
        nsa::prep_units(P, args.in[7], args.in[9], args.in[10], gw, NGW, lane);
    }
    SEAM(2);
    if (IN(3)) {
        for (int idx = blockIdx.x; idx < 1024; idx += G) {
            const int c_ = idx & 255, k_ = idx >> 8, pair = c_ >> 3, s_ = c_ & 7;
            const int qt = (k_ == 0) ? 31 - s_ : (k_ == 1) ? 16 + s_ : (k_ == 2) ? 15 - s_ : s_;
            nsa::attn_tile(lds, P, KCb, VCb, pair >> 2, pair & 3, qt);
        }
    }
    SEAM(3);
    if (IN(4)) {
        pg8::Gemm g{Hb, Wg_t, D, D, M, 2048, D, 0}; pg8::StaticOrder S; S.init(M, 2048, G, (int)blockIdx.x);
        pg8::EpiP<1> E{P, LDP, -1, 256};
        pg8::gemm_phase<pg8::EpiP<1>, pg8::StaticOrder, true>(lds, g, S, E);
    }
    SEAM(4);
    if (IN(5)) {
        pg8::Gemm g{P + C_DZ, Wcat_t, LDP, 2 * D, M, D, D, D}; pg8::TwoPassOrder S; S.base.init(M, D, G, (int)blockIdx.x);
        pg8::EpiMix E{P, LDP, Mix, D};
        pg8::gemm_phase<pg8::EpiMix, pg8::TwoPassOrder, false>(lds, g, S, E);
    }
    SEAM(5);
    if (IN(6)) {
        for (int it = gw; it < 16 * 128; it += NGW) transpose_item(args.in[21], FF, SrcIdent{0}, Wup_t, D, 0, scr, it / 128, it % 128, lane);
        __syncthreads();
        pg8::Gemm g{Mix, Wout_t, D, D, M, D, D, 0}; pg8::StaticOrder S; S.init(M, D, G, (int)blockIdx.x);
        pg8::EpiOut E{x, args.out, An, args.in[20], pss};
        pg8::gemm_phase<pg8::EpiOut, pg8::StaticOrder, false>(lds, g, S, E);
    }
    SEAM(6);
    if (IN(7)) {
        for (int it = gw; it < 64 * 32; it += NGW) transpose_item(args.in[22], D, SrcIdent{0}, Wdown_t, FF, 0, scr, it / 32, it % 32, lane);
        __syncthreads();
        pg8::Gemm g{An, Wup_t, D, D, M, FF, D, 0}; pg8::StaticOrder S; S.init(M, FF, G, (int)blockIdx.x);
        pg8::EpiUp E{pss, Up, FF};
        pg8::gemm_phase<pg8::EpiUp, pg8::StaticOrder, true>(lds, g, S, E);
    }
    SEAM(7);
    if (IN(8)) {
        pg8::Gemm g{Up, Wdown_t, FF, FF, M, D, FF, 0}; pg8::StaticOrder S; S.init(M, D, G, (int)blockIdx.x);
        pg8::EpiDown E{args.out};
        pg8::gemm_phase<pg8::EpiDown, pg8::StaticOrder, false>(lds, g, S, E);
    }
#undef IN
#undef SEAM
#undef GRID_SYNC
}

static int g_grid = 0;
static void launch_mk(const Args& a0, int lo, int hi, hipStream_t stream) {
    Args a = a0; a.ph_lo = lo; a.ph_hi = hi;
    void* kargs[] = {(void*)&a};
    hipError_t e = hipLaunchCooperativeKernel((const void*)mk_fwd, dim3(g_grid), dim3(NWAVES * 64), kargs, LDS_BYTES, stream);
    if (e != hipSuccess) fprintf(stderr, "cooperative launch failed: %s (grid %d)\n", hipGetErrorString(e), g_grid);
}

extern "C" void kernel_launch(void* const* d_in, const int* in_sizes, int n_in, void* d_out, int out_size, void* d_ws, size_t ws_size, hipStream_t stream) {
    if (g_grid == 0) {
        int dev = 0, cus = 0, per_cu = 0;
        hipGetDevice(&dev);
        hipDeviceGetAttribute(&cus, hipDeviceAttributeMultiprocessorCount, dev);
        hipFuncSetAttribute((const void*)mk_fwd, hipFuncAttributeMaxDynamicSharedMemorySize, LDS_BYTES);
        hipOccupancyMaxActiveBlocksPerMultiprocessor(&per_cu, (const void*)mk_fwd, NWAVES * 64, LDS_BYTES);
        if (per_cu < 1) per_cu = 1;
        if (per_cu > 1) per_cu = 1;
        g_grid = cus * per_cu;
    }
    Args a{};
    for (int i = 0; i < 23; ++i) a.in[i] = (const float*)d_in[i];
    a.out = (float*)d_out; a.ws = (unsigned char*)d_ws;
    bf16_t* P = (bf16_t*)((char*)d_ws + WS_P);
    launch_mk(a, 0, 2, stream);
    hipLaunchKernelGGL(k_gdn_conv, dim3(BATCH * 3072 / 256), dim3(256), 0, stream, P, a.in[3]);
    hipLaunchKernelGGL(k_gdn_l2norm, dim3(M * 16 / 4), dim3(256), 0, stream, P);
    hipLaunchKernelGGL(k_gdn_scan, dim3(BATCH * DN_H), dim3(128), 0, stream, P, a.in[4], a.in[5], a.in[6]);
    launch_mk(a, 2, 9, stream);
}
```

```cpp
#include <hip/hip_runtime.h>
#include <hip/hip_cooperative_groups.h>
#include <stdint.h>
#include <cstdio>
namespace cg = cooperative_groups;

typedef unsigned short bf16_t;

constexpr int D = 1024, BATCH = 8, SEQ = 2048, M = BATCH * SEQ;
constexpr int DN_H = 8, DN_D = 128;
constexpr int NS_H = 16, NS_G = 4, NS_R = 4, NS_D = 64;
constexpr int NCMP = 127, NSEL = 32;
constexpr int FF = 4096;
constexpr int INW = 8768;
constexpr float EPS = 1e-6f;
constexpr float NEGV = -1e30f, FORCEV = 1e9f;

constexpr int LDP = 6720;
constexpr int C_DQ = 0, C_DK = 1024, C_DV = 2048, C_DZ = 3072, C_NQ = 4096;
constexpr int C_KC = 5120, C_VC = 5376, C_KS = 5632, C_VS = 5888, C_KW = 6144, C_VW = 6400;
constexpr int C_SB = 6656, C_SA = 6664, C_SG = 6672;
constexpr int NP1 = 6912;

__device__ __forceinline__ float bf2f(bf16_t v) { return __uint_as_float(((unsigned)v) << 16); }
__device__ __forceinline__ bf16_t f2bf(float f) { unsigned u = __float_as_uint(f); return (bf16_t)((u + 0x7fffu + ((u >> 16) & 1u)) >> 16); }
__device__ __forceinline__ float sigmoidf_(float x) { return 1.f / (1.f + __expf(-x)); }
__device__ __forceinline__ float siluf_(float x) { return x * sigmoidf_(x); }
__device__ __forceinline__ float softplusf_(float x) { return fmaxf(x, 0.f) + log1pf(__expf(-fabsf(x))); }
__device__ __forceinline__ float gelu_tanh(float x) { return 0.5f * x * (1.f + tanhf(0.7978845608028654f * (x + 0.044715f * x * x * x))); }

__device__ __forceinline__ float block_sum(float v, float* red) {
    for (int o = 32; o > 0; o >>= 1) v += __shfl_xor(v, o);
    const int w = threadIdx.x >> 6, nw = blockDim.x >> 6;
    __syncthreads();
    if ((threadIdx.x & 63) == 0) red[w] = v;
    __syncthreads();
    float s = 0.f;
    for (int i = 0; i < nw; ++i) s += red[i];
    return s;
}
__device__ __forceinline__ float block_max(float v, float* red) {
    for (int o = 32; o > 0; o >>= 1) v = fmaxf(v, __shfl_xor(v, o));
    const int w = threadIdx.x >> 6, nw = blockDim.x >> 6;
    __syncthreads();
    if ((threadIdx.x & 63) == 0) red[w] = v;
    __syncthreads();
    float s = red[0];
    for (int i = 1; i < nw; ++i) s = fmaxf(s, red[i]);
    return s;
}

__global__ void __launch_bounds__(256) k_gdn_conv(bf16_t* P, const float* __restrict__ convw) {
    const int idx = blockIdx.x * 256 + threadIdx.x;
    if (idx >= BATCH * 3072) return;
    const int b = idx / 3072, c = idx % 3072;
    const float w0 = convw[c], w1 = convw[3072 + c], w2 = convw[2 * 3072 + c], w3 = convw[3 * 3072 + c];
    bf16_t* col = P + (size_t)b * SEQ * LDP + c;
    float x3 = bf2f(col[(size_t)(SEQ - 1) * LDP]), x2 = bf2f(col[(size_t)(SEQ - 2) * LDP]), x1 = bf2f(col[(size_t)(SEQ - 3) * LDP]);
    for (int t = SEQ - 1; t >= 0; --t) {
        const float x0 = (t >= 3) ? bf2f(col[(size_t)(t - 3) * LDP]) : 0.f;
        const float y = w0 * x0 + w1 * x1 + w2 * x2 + w3 * x3;
        col[(size_t)t * LDP] = f2bf(siluf_(y));
        x3 = x2; x2 = x1; x1 = x0;
    }
}
__global__ void __launch_bounds__(256) k_gdn_l2norm(bf16_t* P) {
    const int unit = blockIdx.x * 4 + (threadIdx.x >> 6), lane = threadIdx.x & 63;
    const int m = unit / 16, r = unit % 16, which = r / 8, h = r % 8;
    bf16_t* p = P + (size_t)m * LDP + (which ? C_DK : C_DQ) + h * DN_D;
    float a = bf2f(p[lane]), b = bf2f(p[lane + 64]);
    float s = a * a + b * b;
    for (int o = 32; o > 0; o >>= 1) s += __shfl_xor(s, o);
    const float r_ = rsqrtf(s + EPS);
    p[lane] = f2bf(a * r_); p[lane + 64] = f2bf(b * r_);
}
__global__ void __launch_bounds__(128) k_gdn_scan(bf16_t* P, const float* __restrict__ a_log, const float* __restrict__ dt_bias, const float* __restrict__ out_norm) {
    __shared__ float qs[128], ks[128], red[2];
    const int b = blockIdx.x / DN_H, h = blockIdx.x % DN_H, j = threadIdx.x;
    float s[128];
#pragma unroll
    for (int i = 0; i < 128; ++i) s[i] = 0.f;
    const float Ah = -__expf(a_log[h]), dtb = dt_bias[h], gn = out_norm[j];
    const float scale = 0.08838834764831845f;
    for (int t = 0; t < SEQ; ++t) {
        bf16_t* row = P + (size_t)(b * SEQ + t) * LDP;
        __syncthreads();
        qs[j] = bf2f(row[C_DQ + h * DN_D + j]); ks[j] = bf2f(row[C_DK + h * DN_D + j]);
        const float v = bf2f(row[C_DV + h * DN_D + j]);
        const float beta = sigmoidf_(bf2f(row[C_SB + h]));
        const float gdec = Ah * softplusf_(bf2f(row[C_SA + h]) + dtb);
        const float a = __expf(gdec);
        const float z = bf2f(row[C_DZ + h * DN_D + j]);
        __syncthreads();
        float kS = 0.f;
#pragma unroll
        for (int i = 0; i < 128; ++i) kS += ks[i] * s[i];
        const float dlt = beta * (v - a * kS);
        float o = 0.f;
#pragma unroll
        for (int i = 0; i < 128; ++i) { s[i] = a * s[i] + ks[i] * dlt; o += qs[i] * s[i]; }
        o *= scale;
        const float ss = block_sum(o * o, red);
        const float y = o * rsqrtf(ss * (1.f / 128.f) + EPS) * gn * siluf_(z);
        row[C_DZ + h * DN_D + j] = f2bf(y);
    }
}

namespace gdn_naive {
#define GLAS __attribute__((address_space(3)))
__device__ __forceinline__ float sub_sum(float v, GLAS float* red, int sub, int tid) {
#pragma unroll
    for (int o = 32; o > 0; o >>= 1) v += __shfl_xor(v, o);
    __syncthreads();
    if ((tid & 63) == 0) red[sub * 2 + ((tid >> 6) & 1)] = v;
    __syncthreads();
    return red[sub * 2] + red[sub * 2 + 1];
}
__device__ __forceinline__ void run(GLAS unsigned char* lds, bf16_t* P, const float* convw, const float* a_log, const float* dt_bias, const float* out_norm, int item0) {
    const int tid = threadIdx.x, sub = tid >> 7, j = tid & 127;
    GLAS float* qs = (GLAS float*)lds + sub * 256; GLAS float* ks = qs + 128; GLAS float* red = (GLAS float*)(lds + 4096);
    const int item = item0 + sub; const int b = item / DN_H, h = item % DN_H;
    float s[128];
#pragma unroll
    for (int i = 0; i < 128; ++i) s[i] = 0.f;
    const float Ah = -__expf(a_log[h]), dtb = dt_bias[h], gn = out_norm[j];
    const float scale = 0.08838834764831845f;
    float wq[4], wk[4], wv[4], xq[3] = {0.f, 0.f, 0.f}, xk[3] = {0.f, 0.f, 0.f}, xv[3] = {0.f, 0.f, 0.f};
#pragma unroll
    for (int t = 0; t < 4; ++t) { wq[t] = convw[t * 3072 + h * 128 + j]; wk[t] = convw[t * 3072 + 1024 + h * 128 + j]; wv[t] = convw[t * 3072 + 2048 + h * 128 + j]; }
    for (int t = 0; t < SEQ; ++t) {
        bf16_t* row = P + (size_t)(b * SEQ + t) * LDP;
        const float rq = bf2f(row[C_DQ + h * DN_D + j]), rk = bf2f(row[C_DK + h * DN_D + j]), rv = bf2f(row[C_DV + h * DN_D + j]);
        float q = siluf_(wq[0] * xq[0] + wq[1] * xq[1] + wq[2] * xq[2] + wq[3] * rq);
        float k = siluf_(wk[0] * xk[0] + wk[1] * xk[1] + wk[2] * xk[2] + wk[3] * rk);
        const float v = siluf_(wv[0] * xv[0] + wv[1] * xv[1] + wv[2] * xv[2] + wv[3] * rv);
        xq[0] = xq[1]; xq[1] = xq[2]; xq[2] = rq; xk[0] = xk[1]; xk[1] = xk[2]; xk[2] = rk; xv[0] = xv[1]; xv[1] = xv[2]; xv[2] = rv;
        const float sq = sub_sum(q * q, red, sub, tid);
        const float sk = sub_sum(k * k, red, sub, tid);
        q *= rsqrtf(sq + EPS); k *= rsqrtf(sk + EPS);
        qs[j] = q; ks[j] = k;
        const float beta = sigmoidf_(bf2f(row[C_SB + h]));
        const float a = __expf(Ah * softplusf_(bf2f(row[C_SA + h]) + dtb));
        const float z = bf2f(row[C_DZ + h * DN_D + j]);
        __syncthreads();
        float kS = 0.f;
#pragma unroll
        for (int i = 0; i < 128; ++i) kS += ks[i] * s[i];
        const float dlt = beta * (v - a * kS);
        asm volatile("" ::: "memory");
        float o = 0.f;
#pragma unroll
        for (int i = 0; i < 128; ++i) { s[i] = a * s[i] + ks[i] * dlt; o += qs[i] * s[i]; }
        o *= scale;
        const float ss = sub_sum(o * o, red, sub, tid);
        row[C_DZ + h * DN_D + j] = f2bf(o * rsqrtf(ss * (1.f / 128.f) + EPS) * gn * siluf_(z));
    }
}
}
namespace nsa {
#define NLAS __attribute__((address_space(3)))
typedef short bf16x8 __attribute__((ext_vector_type(8)));
typedef short s16x4 __attribute__((ext_vector_type(4)));
typedef short v4i16_t __attribute__((ext_vector_type(4)));
typedef float f32x16 __attribute__((ext_vector_type(16)));
typedef float f32x4 __attribute__((ext_vector_type(4)));
typedef float f32x2 __attribute__((ext_vector_type(2)));
typedef unsigned u32x4 __attribute__((ext_vector_type(4)));
typedef __bf16 bf16x2_t __attribute__((ext_vector_type(2)));
constexpr float LOG2E = 1.4426950408889634f;
constexpr float NEG = -1e30f;
constexpr int L_KV = 0;
constexpr int L_IMP = 32768;
constexpr int L_SEL = 65536;
constexpr int L_WS = 66048;
constexpr int L_OST = 68096;
constexpr int L_END = 100864;

__device__ __forceinline__ int crow(int i, int hi) { return (i & 3) + 8 * (i >> 2) + 4 * hi; }
__device__ __forceinline__ unsigned pk(float lo, float hi) { f32x2 v = {lo, hi}; bf16x2_t b = __builtin_convertvector(v, bf16x2_t); return __builtin_bit_cast(unsigned, b); }
__device__ __forceinline__ float xhalf_max(float v) { auto rr = __builtin_amdgcn_permlane32_swap(__float_as_uint(v), __float_as_uint(v), false, false); return fmaxf(__uint_as_float(rr[0]), __uint_as_float(rr[1])); }
__device__ __forceinline__ float xhalf_sum(float v) { auto rr = __builtin_amdgcn_permlane32_swap(__float_as_uint(v), __float_as_uint(v), false, false); return __uint_as_float(rr[0]) + __uint_as_float(rr[1]); }

__device__ __forceinline__ void dma_tile(NLAS unsigned char* slot, const bf16_t* Kb, const bf16_t* Vb, unsigned koff, unsigned voff, int wid) {
    __builtin_amdgcn_global_load_lds((const unsigned*)((const char*)Kb + koff), (NLAS unsigned*)(slot + wid * 1024), 16, 0, 0);
    __builtin_amdgcn_global_load_lds((const unsigned*)((const char*)Vb + voff), (NLAS unsigned*)(slot + 8192 + wid * 1024), 16, 0, 0);
}
__device__ __forceinline__ void tile_offs(unsigned& koff, unsigned& voff, int pitch, int wid, int lane) {
    koff = (unsigned)(lane * pitch + wid * 8) * 2u;
    voff = (unsigned)((16 * (wid & 3) + (lane >> 2)) * pitch + (wid >> 2) * 32 + (lane & 3) * 8) * 2u;
}
__device__ __forceinline__ void qkt(f32x16& p0, f32x16& p1, NLAS const unsigned char* Kslot, const bf16x8* qr, const f32x16& c0, const f32x16& c1, int r32, int hi) {
    NLAS const unsigned char* kb = Kslot + hi * 1024 + r32 * 16;
#pragma unroll
    for (int d0 = 0; d0 < 4; ++d0) {
        const bf16x8 b0 = *(NLAS const bf16x8*)(kb + d0 * 2048);
        const bf16x8 b1 = *(NLAS const bf16x8*)(kb + d0 * 2048 + 512);
        if (d0 == 0) { p0 = __builtin_amdgcn_mfma_f32_32x32x16_bf16(b0, qr[0], c0, 0, 0, 0); p1 = __builtin_amdgcn_mfma_f32_32x32x16_bf16(b1, qr[0], c1, 0, 0, 0); }
        else { p0 = __builtin_amdgcn_mfma_f32_32x32x16_bf16(b0, qr[d0], p0, 0, 0, 0); p1 = __builtin_amdgcn_mfma_f32_32x32x16_bf16(b1, qr[d0], p1, 0, 0, 0); }
    }
}
__device__ __forceinline__ s16x4 vtr(NLAS const unsigned char* p) { return __builtin_bit_cast(s16x4, __builtin_amdgcn_ds_read_tr16_b64_v4i16((NLAS v4i16_t*)p)); }
__device__ __forceinline__ void pv(f32x16* o, NLAS const unsigned char* Vslot, const f32x16& p0, const f32x16& p1, int lane, int hi) {
    u32x4 w0 = {pk(p0[0], p0[1]), pk(p0[2], p0[3]), pk(p0[4], p0[5]), pk(p0[6], p0[7])};
    u32x4 w1 = {pk(p0[8], p0[9]), pk(p0[10], p0[11]), pk(p0[12], p0[13]), pk(p0[14], p0[15])};
    u32x4 w2 = {pk(p1[0], p1[1]), pk(p1[2], p1[3]), pk(p1[4], p1[5]), pk(p1[6], p1[7])};
    u32x4 w3 = {pk(p1[8], p1[9]), pk(p1[10], p1[11]), pk(p1[12], p1[13]), pk(p1[14], p1[15])};
    const bf16x8 pa[4] = {__builtin_bit_cast(bf16x8, w0), __builtin_bit_cast(bf16x8, w1), __builtin_bit_cast(bf16x8, w2), __builtin_bit_cast(bf16x8, w3)};
    NLAS const unsigned char* vp = Vslot + ((lane >> 4) & 1) * 32 + (lane & 3) * 8 + (4 * hi + ((lane & 15) >> 2)) * 64;
#pragma unroll
    for (int d0 = 0; d0 < 2; ++d0)
#pragma unroll
        for (int ks = 0; ks < 4; ++ks) {
            const s16x4 lo = vtr(vp + d0 * 4096 + ks * 1024), hh = vtr(vp + d0 * 4096 + ks * 1024 + 512);
            const bf16x8 vf = {lo[0], lo[1], lo[2], lo[3], hh[0], hh[1], hh[2], hh[3]};
            o[d0] = __builtin_amdgcn_mfma_f32_32x32x16_bf16(pa[ks], vf, o[d0], 0, 0, 0);
        }
}
__device__ __forceinline__ void scale_rows(f32x16* o, NLAS float* wsf, float s, int r32, int hi) {
    if (hi == 0) wsf[r32] = s;
#pragma unroll
    for (int i = 0; i < 16; ++i) { const float f = wsf[crow(i, hi)]; o[0][i] *= f; o[1][i] *= f; }
}
__device__ __forceinline__ void acc_rows(f32x16* tot, const f32x16* o, NLAS float* wsf, float s, int r32, int hi) {
    if (hi == 0) wsf[32 + r32] = s;
#pragma unroll
    for (int i = 0; i < 16; ++i) { const float f = wsf[32 + crow(i, hi)]; tot[0][i] += f * o[0][i]; tot[1][i] += f * o[1][i]; }
}
__device__ __forceinline__ void softmax_step(f32x16& p0, f32x16& p1, float& m, float& l, f32x16* o, NLAS float* wsf, int r32, int hi) {
    float t = fmaxf(p0[0], p1[0]);
#pragma unroll
    for (int i = 1; i < 16; ++i) t = fmaxf(t, fmaxf(p0[i], p1[i]));
    t = xhalf_max(t);
    const float mn = fmaxf(m, t);
    const float alpha = __builtin_amdgcn_exp2f(m - mn);
    float s = 0.f;
#pragma unroll
    for (int i = 0; i < 16; ++i) { p0[i] = __builtin_amdgcn_exp2f(p0[i] - mn); p1[i] = __builtin_amdgcn_exp2f(p1[i] - mn); s += p0[i] + p1[i]; }
    l = l * alpha + s; m = mn;
    if (__any(alpha != 1.f)) scale_rows(o, wsf, alpha, r32, hi);
}

__device__ __forceinline__ void attn_tile(NLAS unsigned char* lds, bf16_t* P, const bf16_t* KC, const bf16_t* VC, int b, int g, int qt) {
    const int tid = threadIdx.x, lane = tid & 63, r32 = lane & 31, hi = lane >> 5; const int wid = __builtin_amdgcn_readfirstlane(tid >> 6);
    const int head = g * 4 + (wid >> 1), qh = wid & 1, t0 = qt * 64, qi = qh * 32 + r32, blk_t = qt;
    NLAS float* wsf = (NLAS float*)(lds + L_WS) + wid * 64;
    NLAS float* imp = (NLAS float*)(lds + L_IMP);
    NLAS unsigned* selm = (NLAS unsigned*)(lds + L_SEL);
    NLAS unsigned char* slot0 = lds + L_KV; NLAS unsigned char* slot1 = lds + L_KV + 16384;
    const size_t rowbase = (size_t)b * SEQ;
    bf16_t* qrow = P + (rowbase + t0 + qi) * LDP;
    const float sl2 = exp2f(-0.5f * (float)(head + 1)) * LOG2E;
    bf16x8 qr[4];
#pragma unroll
    for (int d0 = 0; d0 < 4; ++d0) qr[d0] = *(const bf16x8*)(qrow + C_NQ + head * 64 + d0 * 16 + hi * 8);
    const float gate_c = sigmoidf_(bf2f(qrow[C_SG + head * 3 + 0])), gate_s = sigmoidf_(bf2f(qrow[C_SG + head * 3 + 1])), gate_w = sigmoidf_(bf2f(qrow[C_SG + head * 3 + 2]));
    f32x16 tot[2]; tot[0] = f32x16{}; tot[1] = f32x16{};
#define CRF(i) ((float)(((i) & 3) + 8 * ((i) >> 2)) + 4.f * (float)hiv)
#define OPAQUE_HI() int hiv = hi; asm volatile("" : "+v"(hiv))

    {
        const bf16_t* kcb = KC + ((size_t)(b * NS_G + g) * 128) * 64; const bf16_t* vcb = VC + ((size_t)(b * NS_G + g) * 128) * 64;
        const bool two = (qt >= 16);
        unsigned kof, vof; tile_offs(kof, vof, 64, wid, lane);
        dma_tile(slot0, kcb, vcb, kof, vof, wid);
        if (two) dma_tile(slot1, kcb + 64 * 64, vcb + 64 * 64, kof, vof, wid);
        __syncthreads();
        f32x16 pA0, pA1, pB0, pB1, c0, c1;
        const float s16 = sl2 * 16.f; OPAQUE_HI();
#pragma unroll
        for (int i = 0; i < 16; ++i) { c0[i] = s16 * CRF(i); c1[i] = s16 * (CRF(i) + 32.f); }
        qkt(pA0, pA1, slot0, qr, c0, c1, r32, hi);
        const int cmax = (t0 + qi - 31) >> 4;
        const int qposm = t0 + qi - 31;
#pragma unroll
        for (int i = 0; i < 16; ++i) { const int c = crow(i, hiv); if (16 * c > qposm) pA0[i] = NEG; if (16 * (c + 32) > qposm) pA1[i] = NEG; }
        if (two) {
#pragma unroll
            for (int i = 0; i < 16; ++i) { c0[i] += s16 * 64.f; c1[i] += s16 * 64.f; }
            qkt(pB0, pB1, slot1, qr, c0, c1, r32, hi);
#pragma unroll
            for (int i = 0; i < 16; ++i) { const int c = 64 + crow(i, hiv); if (16 * c > qposm) pB0[i] = NEG; if (16 * (c + 32) > qposm) pB1[i] = NEG; }
        } else { pB0 = f32x16{}; pB1 = f32x16{};
#pragma unroll
            for (int i = 0; i < 16; ++i) { pB0[i] = NEG; pB1[i] = NEG; } }
        (void)cmax;
        float mx = NEG;
#pragma unroll
        for (int i = 0; i < 16; ++i) mx = fmaxf(fmaxf(mx, fmaxf(pA0[i], pA1[i])), fmaxf(pB0[i], pB1[i]));
        mx = xhalf_max(mx);
        float s = 0.f;
#pragma unroll
        for (int i = 0; i < 16; ++i) { pA0[i] = __builtin_amdgcn_exp2f(pA0[i] - mx); pA1[i] = __builtin_amdgcn_exp2f(pA1[i] - mx); pB0[i] = __builtin_amdgcn_exp2f(pB0[i] - mx); pB1[i] = __builtin_amdgcn_exp2f(pB1[i] - mx);
            s += (pA0[i] + pA1[i]) + (pB0[i] + pB1[i]); }
        s = xhalf_sum(s);
        const float nrm = (t0 + qi >= 31) ? __builtin_amdgcn_rcpf(s) : 0.f;
#pragma unroll
        for (int i = 0; i < 16; ++i) { pA0[i] *= nrm; pA1[i] *= nrm; pB0[i] *= nrm; pB1[i] *= nrm; }
#define PSEL(L) ((L) < 4 ? pA0 : (L) < 8 ? pA1 : (L) < 12 ? pB0 : pB1)
#define MAINV(L) ((PSEL(L)[4 * ((L) & 3)] + PSEL(L)[4 * ((L) & 3) + 1]) + (PSEL(L)[4 * ((L) & 3) + 2] + 0.5f * PSEL(L)[4 * ((L) & 3) + 3]))
#define CARRY(L) (0.5f * PSEL(L)[4 * ((L) & 3) + 3])
#pragma unroll
        for (int L = 0; L < 16; ++L) {
            const float cprev = (L > 0) ? CARRY(L > 0 ? L - 1 : 0) : 0.f;
            const float snd = hi ? cprev : CARRY(L);
            const float rcv = __shfl_xor(snd, 32);
            imp[((wid >> 1) * 64 + qi) * 32 + 2 * L + hi] = MAINV(L) + rcv;
        }
#undef PSEL
#undef MAINV
#undef CARRY
        f32x16 o[2]; o[0] = f32x16{}; o[1] = f32x16{};
        pv(o, slot0 + 8192, pA0, pA1, lane, hi);
        if (two) pv(o, slot1 + 8192, pB0, pB1, lane, hi);
        acc_rows(tot, o, wsf, gate_c, r32, hi);
    }
    __syncthreads();
    if (wid == 0) {
        float v[32];
#pragma unroll
        for (int j = 0; j < 32; ++j) v[j] = (imp[(0 * 64 + lane) * 32 + j] + imp[(1 * 64 + lane) * 32 + j]) + (imp[(2 * 64 + lane) * 32 + j] + imp[(3 * 64 + lane) * 32 + j]);
        unsigned mask = 1u | (1u << blk_t);
#pragma unroll 1
        for (int it = 0; it < 6; ++it) {
            float best = -1.f; int bj = -1;
#pragma unroll
            for (int j = 1; j < 32; ++j) { const bool ok = (j < blk_t) && !((mask >> j) & 1u); if (ok && v[j] > best) { best = v[j]; bj = j; } }
            if (bj >= 0) mask |= 1u << bj;
        }
        selm[lane] = mask;
        unsigned any = mask;
#pragma unroll
        for (int o_ = 1; o_ < 64; o_ <<= 1) any |= __shfl_xor(any, o_);
        if (lane == 0) selm[64] = any;
    }
    __syncthreads();
    const unsigned mymask = selm[qi];
    const unsigned anym = (unsigned)__builtin_amdgcn_readfirstlane((int)selm[64]);
    unsigned kofP, vofP; tile_offs(kofP, vofP, LDP, wid, lane);
    {
        const bf16_t* kb = P + rowbase * LDP + C_KS + g * 64; const bf16_t* vb = P + rowbase * LDP + C_VS + g * 64;
        unsigned todo = anym;
        float m = NEG, l = 0.f; f32x16 o[2]; o[0] = f32x16{}; o[1] = f32x16{};
        int j = __builtin_ctz(todo); todo &= todo - 1;
        dma_tile(slot0, kb + (size_t)j * 64 * LDP, vb + (size_t)j * 64 * LDP, kofP, vofP, wid);
        int cur = 0;
        __syncthreads();
        for (;;) {
            const int jn = todo ? __builtin_ctz(todo) : -1; if (todo) todo &= todo - 1;
            NLAS unsigned char* sc = cur ? slot1 : slot0; NLAS unsigned char* sn = cur ? slot0 : slot1;
            if (jn >= 0) dma_tile(sn, kb + (size_t)jn * 64 * LDP, vb + (size_t)jn * 64 * LDP, kofP, vofP, wid);
            const bool mine = (mymask >> j) & 1u;
            if (__any(mine)) {
                f32x16 p0, p1, c0, c1; const float kb0 = sl2 * (float)(j * 64 - t0); OPAQUE_HI();
#pragma unroll
                for (int i = 0; i < 16; ++i) { c0[i] = kb0 + sl2 * CRF(i); c1[i] = c0[i] + sl2 * 32.f; }
                qkt(p0, p1, sc, qr, c0, c1, r32, hi);
                if (j == blk_t) {
#pragma unroll
                    for (int i = 0; i < 16; ++i) { const int kk = crow(i, hiv); if (kk > qi) p0[i] = NEG; if (kk + 32 > qi) p1[i] = NEG; }
                }
                if (!mine) {
#pragma unroll
                    for (int i = 0; i < 16; ++i) { p0[i] = NEG; p1[i] = NEG; }
                }
                softmax_step(p0, p1, m, l, o, wsf, r32, hi);
                pv(o, sc + 8192, p0, p1, lane, hi);
            }
            __syncthreads();
            if (jn < 0) break;
            j = jn; cur ^= 1;
        }
        l = xhalf_sum(l);
        acc_rows(tot, o, wsf, gate_s * __builtin_amdgcn_rcpf(l), r32, hi);
    }
    {
        const bf16_t* kb = P + rowbase * LDP + C_KW + g * 64; const bf16_t* vb = P + rowbase * LDP + C_VW + g * 64;
        float m = NEG, l = 0.f; f32x16 o[2]; o[0] = f32x16{}; o[1] = f32x16{};
        int j = blk_t; const int jlast = blk_t >= 4 ? blk_t - 4 : 0;
        dma_tile(slot0, kb + (size_t)j * 64 * LDP, vb + (size_t)j * 64 * LDP, kofP, vofP, wid);
        int cur = 0;
        __syncthreads();
        for (;;) {
            const int jn = (j > jlast) ? j - 1 : -1;
            NLAS unsigned char* sc = cur ? slot1 : slot0; NLAS unsigned char* sn = cur ? slot0 : slot1;
            if (jn >= 0) dma_tile(sn, kb + (size_t)jn * 64 * LDP, vb + (size_t)jn * 64 * LDP, kofP, vofP, wid);
            {
                f32x16 p0, p1, c0, c1; const float kb0 = sl2 * (float)(j * 64 - t0); OPAQUE_HI();
#pragma unroll
                for (int i = 0; i < 16; ++i) { c0[i] = kb0 + sl2 * CRF(i); c1[i] = c0[i] + sl2 * 32.f; }
                qkt(p0, p1, sc, qr, c0, c1, r32, hi);
                if (j == blk_t || j == blk_t - 4) {
                    const int dq = t0 + qi - j * 64;
#pragma unroll
                    for (int i = 0; i < 16; ++i) { const int d0_ = dq - crow(i, hiv), d1_ = d0_ - 32; if (d0_ < 0 || d0_ > 255) p0[i] = NEG; if (d1_ < 0 || d1_ > 255) p1[i] = NEG; }
                }
                softmax_step(p0, p1, m, l, o, wsf, r32, hi);
                pv(o, sc + 8192, p0, p1, lane, hi);
            }
            __syncthreads();
            if (jn < 0) break;
            j = jn; cur ^= 1;
        }
        l = xhalf_sum(l);
        acc_rows(tot, o, wsf, gate_w * __builtin_amdgcn_rcpf(l), r32, hi);
    }
    {
        NLAS bf16_t* stg = (NLAS bf16_t*)(lds + L_OST) + wid * 2048;
#pragma unroll
        for (int i = 0; i < 16; ++i) { const int orow = crow(i, hi); stg[orow * 64 + r32] = f2bf(tot[0][i]); stg[orow * 64 + 32 + r32] = f2bf(tot[1][i]); }
        bf16_t* ow = P + (rowbase + t0 + qh * 32) * LDP + C_NQ + head * 64;
#pragma unroll
        for (int i = 0; i < 4; ++i) { const int row = i * 8 + (lane >> 3), ch = lane & 7; const u32x4 v = *(NLAS const u32x4*)(stg + row * 64 + ch * 8); *(u32x4*)((char*)ow + (unsigned)(row * LDP + ch * 8) * 2u) = v; }
    }
    __syncthreads();
#undef CRF
#undef OPAQUE_HI
}

__device__ __forceinline__ void prep_units(bf16_t* P, const float* qn, const float* kns, const float* knw, int gw, int NGW, int lane) {
    for (int unit = gw; unit < M * 24; unit += NGW) {
        const int m = unit / 24, r = unit % 24;
        bf16_t* p; const float* g; float sc = 1.f;
        if (r < 16) { p = P + (size_t)m * LDP + C_NQ + r * 64; g = qn; sc = 0.125f * LOG2E; }
        else if (r < 20) { p = P + (size_t)m * LDP + C_KS + (r - 16) * 64; g = kns; }
        else { p = P + (size_t)m * LDP + C_KW + (r - 20) * 64; g = knw; }
        const float a = bf2f(p[lane]);
        float s = a * a;
#pragma unroll
        for (int o = 32; o > 0; o >>= 1) s += __shfl_xor(s, o);
        p[lane] = f2bf(a * rsqrtf(s * (1.f / 64.f) + EPS) * g[lane] * sc);
    }
}

constexpr int LC_HID = 0;
__device__ __forceinline__ void compress_item(NLAS unsigned char* lds, const bf16_t* P, const bf16_t* W1T, const float* bias1, const float* W2, const float* gain, bf16_t* OUT, int b, int g, int which, int half) {
    const int tid = threadIdx.x, lane = tid & 63, r32 = lane & 31, hi = lane >> 5; const int wid = __builtin_amdgcn_readfirstlane(tid >> 6);
    const int mt = wid >> 2, nt = wid & 3;
    const int c = 64 * half + 32 * mt + r32;
    const int cc = c < NCMP ? c : NCMP - 1;
    const bf16_t* arow = P + ((size_t)b * SEQ + 16 * cc) * LDP + (which ? C_VC : C_KC) + g * 64 + hi * 8;
    const bf16_t* brow = W1T + (size_t)(32 * nt + r32) * 2048 + hi * 8;
    f32x16 acc = f32x16{};
#pragma unroll 4
    for (int l = 0; l < 32; ++l) {
#pragma unroll
        for (int ds = 0; ds < 4; ++ds) {
            const bf16x8 a = *(const bf16x8*)(arow + (size_t)l * LDP + ds * 16);
            const bf16x8 w = *(const bf16x8*)(brow + l * 64 + ds * 16);
            acc = __builtin_amdgcn_mfma_f32_32x32x16_bf16(a, w, acc, 0, 0, 0);
        }
    }
    NLAS float* hid = (NLAS float*)(lds + LC_HID);
    const float bs = bias1[32 * nt + r32];
#pragma unroll
    for (int i = 0; i < 16; ++i) hid[(32 * mt + crow(i, hi)) * 132 + 32 * nt + r32] = gelu_tanh(acc[i] + bs);
    __syncthreads();
    {
        const int row = tid >> 3, e0 = (tid & 7) * 8;
        float o[8];
#pragma unroll
        for (int e = 0; e < 8; ++e) o[e] = 0.f;
        for (int i = 0; i < 128; ++i) { const float h = hid[row * 132 + i]; const f32x4 wa = *(const f32x4*)(W2 + i * 64 + e0), wb = *(const f32x4*)(W2 + i * 64 + e0 + 4);
            o[0] += h * wa[0]; o[1] += h * wa[1]; o[2] += h * wa[2]; o[3] += h * wa[3]; o[4] += h * wb[0]; o[5] += h * wb[1]; o[6] += h * wb[2]; o[7] += h * wb[3]; }
        if (which == 0) {
            float ss = 0.f;
#pragma unroll
            for (int e = 0; e < 8; ++e) ss += o[e] * o[e];
            ss += __shfl_xor(ss, 1); ss += __shfl_xor(ss, 2); ss += __shfl_xor(ss, 4);
            const float r = rsqrtf(ss * (1.f / 64.f) + EPS);
#pragma unroll
            for (int e = 0; e < 8; ++e) o[e] *= r * gain[e0 + e];
        }
        const int cg = 64 * half + row;
        if (cg >= NCMP) {
#pragma unroll
            for (int e = 0; e < 8; ++e) o[e] = 0.f; }
        u32x4 w; w.x = pk(o[0], o[1]); w.y = pk(o[2], o[3]); w.z = pk(o[4], o[5]); w.w = pk(o[6], o[7]);
        *(u32x4*)(OUT + (((size_t)(b * NS_G + g) * 128) + cg) * 64 + e0) = w;
    }
    __syncthreads();
}
}
namespace pg8 {
#define PG8_LAS __attribute__((address_space(3)))
typedef short bf16x8 __attribute__((ext_vector_type(8)));
typedef float f32x4 __attribute__((ext_vector_type(4)));
typedef float f32x2 __attribute__((ext_vector_type(2)));
typedef unsigned u32x4 __attribute__((ext_vector_type(4)));
typedef unsigned u32x2 __attribute__((ext_vector_type(2)));
constexpr int BM = 256, BK = 64, HALF = 128, HTB = HALF * BK * 2, STAGE_BYTES = 8 * HTB, NXCD = 8, WGM = 8;

__host__ __device__ __forceinline__ int lds_byte(int r, int c) { const int st = (r >> 4) * 2 + (c >> 5), rr = r & 15, cc = c & 31, ob = rr * 64 + cc * 2; return st * 1024 + (ob ^ (((ob >> 9) & 1) << 5)); }
__host__ __device__ __forceinline__ void stage_rc(int b, int& R, int& C) { const int st = b / 1024, sb = b % 1024, swz = sb ^ (((sb >> 9) & 1) << 5); R = (st >> 1) * 16 + swz / 64; C = (st & 1) * 32 + (swz % 64) / 2; }
__host__ __device__ __forceinline__ int perm32(int rho) { const int n = rho >> 4, i = rho & 15; return 8 * (i >> 2) + 4 * n + (i & 3); }

struct Unit { int pm, pn, ks; };
struct Gemm { const bf16_t* A; const bf16_t* Bt; int lda, ldb; int M, N, K; int ksoff; };

struct StaticOrder {
    int nM, nN, nwg, G, c;
    __host__ __device__ void init(int M_, int N_, int G_, int c_) { nM = M_ / BM; nN = N_ / BM; nwg = nM * nN; G = G_; c = c_; }
    __host__ __device__ bool next(int i, Unit& u) const {
        const long L = (long)i * G + c; if (L >= nwg) return false;
        int wgid = (int)L; { const int q = nwg / NXCD, r = nwg % NXCD, xcd = wgid % NXCD, off = wgid / NXCD; wgid = (xcd < r ? xcd * (q + 1) : r * (q + 1) + (xcd - r) * q) + off; }
        const int nig = WGM * nN, gid = wgid / nig, fm = gid * WGM, gsz = (nM - fm) < WGM ? (nM - fm) : WGM;
        u.pm = fm + ((wgid % nig) % gsz); u.pn = (wgid % nig) / gsz; u.ks = 0; return true;
    }
};
struct TwoPassOrder {
    StaticOrder base;
    __host__ __device__ bool next(int i, Unit& u) const { if (!base.next(i >> 1, u)) return false; u.ks = i & 1; return true; }
};

typedef __bf16 bf16x2_t __attribute__((ext_vector_type(2)));
__device__ __forceinline__ unsigned cvt_pk_bf16(float lo, float hi) { f32x2 v = {lo, hi}; bf16x2_t b = __builtin_convertvector(v, bf16x2_t); return __builtin_bit_cast(unsigned, b); }
__device__ __forceinline__ float fast_sigmoid(float x) { return __builtin_amdgcn_rcpf(1.f + __builtin_amdgcn_exp2f(-1.4426950408889634f * x)); }
__device__ __forceinline__ float bflo(unsigned w) { return __uint_as_float(w << 16); }
__device__ __forceinline__ float bfhi(unsigned w) { return __uint_as_float(w & 0xffff0000u); }

typedef f32x4 Acc[2][2][4][2];

template <int ACT> struct EpiP {
    static constexpr bool PERM = true;
    bf16_t* O; int ldc; int pn_last; int ncol_last;
    __device__ __forceinline__ void operator()(const Acc& acc, const Unit& u, int wr, int wc, int fr, int fq) const {
        const int row0 = u.pm * BM + wr * 64 + fr, tcol = wc * 32 + 8 * fq;
        const int lim = (u.pn == pn_last) ? ncol_last : 256;
#pragma unroll
        for (int ai = 0; ai < 2; ++ai)
#pragma unroll
            for (int m = 0; m < 4; ++m) { bf16_t* rowp = O + (size_t)(row0 + ai * HALF + m * 16) * ldc + u.pn * BM + tcol;
#pragma unroll
                for (int bj = 0; bj < 2; ++bj) { if (tcol + bj * HALF >= lim) continue;
                    f32x4 v0 = acc[ai][bj][m][0], v1 = acc[ai][bj][m][1];
                    if (ACT == 1) {
#pragma unroll
                        for (int e = 0; e < 4; ++e) { v0[e] = fast_sigmoid(v0[e]); v1[e] = fast_sigmoid(v1[e]); } }
                    u32x4 w; w.x = cvt_pk_bf16(v0[0], v0[1]); w.y = cvt_pk_bf16(v0[2], v0[3]); w.z = cvt_pk_bf16(v1[0], v1[1]); w.w = cvt_pk_bf16(v1[2], v1[3]);
                    *(u32x4*)(rowp + bj * HALF) = w; } }
    }
};
struct EpiMix {
    static constexpr bool PERM = true;
    const bf16_t* G; int ldg; bf16_t* O; int ldc;
    __device__ __forceinline__ void operator()(const Acc& acc, const Unit& u, int wr, int wc, int fr, int fq) const {
        const int row0 = u.pm * BM + wr * 64 + fr, col0 = u.pn * BM + wc * 32 + 8 * fq;
#pragma unroll
        for (int ai = 0; ai < 2; ++ai)
#pragma unroll
            for (int m = 0; m < 4; ++m) { const size_t row = (size_t)(row0 + ai * HALF + m * 16); const bf16_t* gp = G + row * ldg + col0 + u.ks * 1024; bf16_t* rowp = O + row * ldc + col0;
#pragma unroll
                for (int bj = 0; bj < 2; ++bj) { const u32x4 b = *(const u32x4*)(gp + bj * HALF);
                    f32x4 v0 = acc[ai][bj][m][0], v1 = acc[ai][bj][m][1];
                    v0[0] *= bflo(b.x); v0[1] *= bfhi(b.x); v0[2] *= bflo(b.y); v0[3] *= bfhi(b.y); v1[0] *= bflo(b.z); v1[1] *= bfhi(b.z); v1[2] *= bflo(b.w); v1[3] *= bfhi(b.w);
                    if (u.ks) { const u32x4 p = *(const u32x4*)(rowp + bj * HALF);
                        v0[0] += bflo(p.x); v0[1] += bfhi(p.x); v0[2] += bflo(p.y); v0[3] += bfhi(p.y); v1[0] += bflo(p.z); v1[1] += bfhi(p.z); v1[2] += bflo(p.w); v1[3] += bfhi(p.w); }
                    u32x4 w; w.x = cvt_pk_bf16(v0[0], v0[1]); w.y = cvt_pk_bf16(v0[2], v0[3]); w.z = cvt_pk_bf16(v1[0], v1[1]); w.w = cvt_pk_bf16(v1[2], v1[3]);
                    *(u32x4*)(rowp + bj * HALF) = w; } }
    }
};
struct EpiOut {
    static constexpr bool PERM = false;
    const float* X; float* X1; bf16_t* An; const float* gain; float* pss;
    __device__ __forceinline__ void operator()(const Acc& acc, const Unit& u, int wr, int wc, int fr, int fq) const {
        const int row0 = u.pm * BM + wr * 64 + fr, col0 = u.pn * BM + wc * 32 + 4 * fq;
        f32x4 gv[2][2];
#pragma unroll
        for (int bj = 0; bj < 2; ++bj)
#pragma unroll
            for (int n = 0; n < 2; ++n) gv[bj][n] = *(const f32x4*)(gain + col0 + bj * HALF + n * 16);
#pragma unroll
        for (int ai = 0; ai < 2; ++ai)
#pragma unroll
            for (int m = 0; m < 4; ++m) { const size_t row = (size_t)(row0 + ai * HALF + m * 16); const size_t off = row * D + col0; float ss = 0.f;
#pragma unroll
                for (int bj = 0; bj < 2; ++bj)
#pragma unroll
                    for (int n = 0; n < 2; ++n) { const f32x4 x1 = *(const f32x4*)(X + off + bj * HALF + n * 16) + acc[ai][bj][m][n];
                        *(f32x4*)(X1 + off + bj * HALF + n * 16) = x1; ss += (x1[0] * x1[0] + x1[1] * x1[1]) + (x1[2] * x1[2] + x1[3] * x1[3]);
                        const f32x4 y = x1 * gv[bj][n]; u32x2 w; w.x = cvt_pk_bf16(y[0], y[1]); w.y = cvt_pk_bf16(y[2], y[3]); *(u32x2*)(An + off + bj * HALF + n * 16) = w; }
                ss += __shfl_xor(ss, 16); ss += __shfl_xor(ss, 32);
                if (fq == 0) pss[row * 16 + u.pn * 4 + wc] = ss; }
    }
};
struct EpiUp {
    static constexpr bool PERM = true;
    const float* pss; bf16_t* O; int ldc;
    __device__ __forceinline__ void operator()(const Acc& acc, const Unit& u, int wr, int wc, int fr, int fq) const {
        const int row0 = u.pm * BM + wr * 64 + fr, col0 = u.pn * BM + wc * 32 + 8 * fq;
#pragma unroll
        for (int ai = 0; ai < 2; ++ai)
#pragma unroll
            for (int m = 0; m < 4; ++m) { const size_t row = (size_t)(row0 + ai * HALF + m * 16);
                const f32x4* pp = (const f32x4*)(pss + row * 16); const f32x4 s4 = (pp[0] + pp[1]) + (pp[2] + pp[3]);
                const float rstd = rsqrtf(((s4[0] + s4[1]) + (s4[2] + s4[3])) * (1.f / D) + EPS);
                bf16_t* rowp = O + row * ldc + col0;
#pragma unroll
                for (int bj = 0; bj < 2; ++bj) { f32x4 v0 = acc[ai][bj][m][0] * rstd, v1 = acc[ai][bj][m][1] * rstd;
#pragma unroll
                    for (int e = 0; e < 4; ++e) { const float a = fmaxf(v0[e], 0.f), b = fmaxf(v1[e], 0.f); v0[e] = a * a; v1[e] = b * b; }
                    u32x4 w; w.x = cvt_pk_bf16(v0[0], v0[1]); w.y = cvt_pk_bf16(v0[2], v0[3]); w.z = cvt_pk_bf16(v1[0], v1[1]); w.w = cvt_pk_bf16(v1[2], v1[3]);
                    *(u32x4*)(rowp + bj * HALF) = w; } }
    }
};
struct EpiDown {
    static constexpr bool PERM = false;
    float* X1;
    __device__ __forceinline__ void operator()(const Acc& acc, const Unit& u, int wr, int wc, int fr, int fq) const {
        const int row0 = u.pm * BM + wr * 64 + fr, col0 = u.pn * BM + wc * 32 + 4 * fq;
#pragma unroll
        for (int ai = 0; ai < 2; ++ai)
#pragma unroll
            for (int m = 0; m < 4; ++m) { float* rowp = X1 + (size_t)(row0 + ai * HALF + m * 16) * D + col0;
#pragma unroll
                for (int bj = 0; bj < 2; ++bj)
#pragma unroll
                    for (int n = 0; n < 2; ++n) { f32x4* p = (f32x4*)(rowp + bj * HALF + n * 16); *p = *p + acc[ai][bj][m][n]; } }
    }
};

template <class Epi, class Sched, bool ALIGN_EPI>
__device__ __forceinline__ void gemm_phase(PG8_LAS unsigned char* lds, const Gemm g, const Sched& S, const Epi& E) {
    const int tid = threadIdx.x, wid = __builtin_amdgcn_readfirstlane(tid >> 6), lane = tid & 63, wr = wid >> 2, wc = wid & 3, fr = lane & 15, fq = lane >> 4;
    const int K = g.K, nt = K / BK, lda = g.lda, ldb = g.ldb;
    unsigned voffA[2], voffB[2];
#pragma unroll
    for (int i = 0; i < 2; ++i) { int R, C; stage_rc(tid * 16 + i * 8192, R, C); const int Rb = Epi::PERM ? ((R & ~31) + perm32(R & 31)) : R;
        voffA[i] = (unsigned)(R * lda + C) * 2u; voffB[i] = (unsigned)(Rb * ldb + C) * 2u; }
    const size_t kstep = (size_t)(BK * 2);
    const size_t hstepA = (size_t)HALF * lda * 2, hstepB = (size_t)HALF * ldb * 2;
    const size_t tstepA = 2 * hstepA, tstepB = 2 * hstepB;
    const unsigned ldsw = (unsigned)wid * 1024u;
    const int aoff = lds_byte(wr * 64 + fr, fq * 8), boff = lds_byte(wc * 32 + fr, fq * 8);
#define PG8_SA(b, h) (((b) * 2 + (h)) * HTB)
#define PG8_SB(b, h) ((4 + (b) * 2 + (h)) * HTB)
#define PG8_STAGE(bufoff, gbase, voff) do { _Pragma("unroll") for (int _i = 0; _i < 2; ++_i) \
        __builtin_amdgcn_global_load_lds((const unsigned*)((const char*)(gbase) + (voff)[_i]), (PG8_LAS unsigned*)(lds + (bufoff) + ldsw + _i * 8192), 16, 0, 0); } while (0)
#define PG8_LDA(dst, b, h) do { _Pragma("unroll") for (int m = 0; m < 4; ++m) _Pragma("unroll") for (int k = 0; k < 2; ++k) dst[m][k] = *(const PG8_LAS bf16x8*)(lds + PG8_SA(b, h) + aoff + m * 2048 + k * 1024); } while (0)
#define PG8_LDB(dst, b, h) do { _Pragma("unroll") for (int n = 0; n < 2; ++n) _Pragma("unroll") for (int k = 0; k < 2; ++k) dst[n][k] = *(const PG8_LAS bf16x8*)(lds + PG8_SB(b, h) + boff + n * 2048 + k * 1024); } while (0)
#define PG8_MMA(ai, bj, At, Bt) do { __builtin_amdgcn_s_setprio(1); _Pragma("unroll") for (int m = 0; m < 4; ++m) _Pragma("unroll") for (int n = 0; n < 2; ++n) _Pragma("unroll") for (int k = 0; k < 2; ++k) \
        acc[ai][bj][m][n] = __builtin_amdgcn_mfma_f32_16x16x32_bf16(Bt[n][k], At[m][k], acc[ai][bj][m][n], 0, 0, 0); __builtin_amdgcn_s_setprio(0); } while (0)
#define PG8_WAIT_V(n) asm volatile("s_waitcnt vmcnt(" #n ")" ::: "memory")
#define PG8_WAIT_L(n) asm volatile("s_waitcnt lgkmcnt(" #n ")" ::: "memory")
#define PG8_BAR __builtin_amdgcn_s_barrier()
#define PG8_SCHED __builtin_amdgcn_sched_barrier(0)
#define PG8_KBODY(t) do { \
            const bool last = (t == nt - 2); \
            const char* a1 = cA + (size_t)(t + 1) * kstep; \
            const char* a2 = last ? nA : cA + (size_t)(t + 2) * kstep; const char* b2 = last ? nB : cB + (size_t)(t + 2) * kstep; \
            const char* a3 = a2 + kstep; const char* b3 = b2 + kstep; \
            PG8_LDB(B0, 0, 0); PG8_LDB(B1, 0, 1); PG8_SCHED; PG8_LDA(At, 0, 0); PG8_STAGE(PG8_SA(1, 1), a1 + hstepA, voffA); \
            PG8_WAIT_V(8); PG8_WAIT_L(0); PG8_BAR; PG8_MMA(0, 0, At, B0); PG8_MMA(0, 1, At, B1); PG8_BAR; PG8_SCHED; \
            PG8_LDA(At, 0, 1); PG8_STAGE(PG8_SB(0, 0), b2, voffB); PG8_STAGE(PG8_SB(0, 1), b2 + hstepB, voffB); PG8_STAGE(PG8_SA(0, 0), a2, voffA); \
            PG8_WAIT_V(8); PG8_WAIT_L(0); PG8_BAR; PG8_MMA(1, 0, At, B0); PG8_MMA(1, 1, At, B1); PG8_BAR; PG8_SCHED; \
            PG8_LDB(B0, 1, 0); PG8_LDB(B1, 1, 1); PG8_SCHED; PG8_LDA(At, 1, 0); PG8_STAGE(PG8_SA(0, 1), a2 + hstepA, voffA); \
            PG8_WAIT_V(8); PG8_WAIT_L(0); PG8_BAR; PG8_MMA(0, 0, At, B0); PG8_MMA(0, 1, At, B1); PG8_BAR; PG8_SCHED; \
            PG8_LDA(At, 1, 1); PG8_STAGE(PG8_SB(1, 0), b3, voffB); PG8_STAGE(PG8_SB(1, 1), b3 + hstepB, voffB); PG8_STAGE(PG8_SA(1, 0), a3, voffA); \
            PG8_WAIT_V(8); PG8_WAIT_L(0); PG8_BAR; PG8_MMA(1, 0, At, B0); PG8_MMA(1, 1, At, B1); PG8_BAR; PG8_SCHED; \
        } while (0)
    Unit cur, nxt; int ui = 0;
    if (!S.next(0, cur)) return;
    Acc acc;
#pragma unroll
    for (int a = 0; a < 2; ++a)
#pragma unroll
        for (int b = 0; b < 2; ++b)
#pragma unroll
            for (int m = 0; m < 4; ++m)
#pragma unroll
                for (int n = 0; n < 2; ++n) acc[a][b][m][n] = (f32x4){0.f, 0.f, 0.f, 0.f};
    bf16x8 At[4][2], B0[2][2], B1[2][2];
    const char* cA = (const char*)g.A + (size_t)cur.pm * tstepA + (size_t)cur.ks * g.ksoff * 2; const char* cB = (const char*)g.Bt + (size_t)cur.pn * tstepB + (size_t)cur.ks * g.ksoff * 2;
    PG8_STAGE(PG8_SB(0, 0), cB, voffB); PG8_STAGE(PG8_SB(0, 1), cB + hstepB, voffB); PG8_STAGE(PG8_SA(0, 0), cA, voffA); PG8_STAGE(PG8_SA(0, 1), cA + hstepA, voffA);
    if (wr == 1) PG8_BAR;
    PG8_WAIT_V(2); PG8_BAR;
    PG8_STAGE(PG8_SB(1, 0), cB + kstep, voffB); PG8_STAGE(PG8_SA(1, 0), cA + kstep, voffA); PG8_STAGE(PG8_SB(1, 1), cB + hstepB + kstep, voffB);
    PG8_WAIT_V(6); PG8_BAR;
    for (;;) {
        const bool has_next = S.next(ui + 1, nxt);
        const char* nA = has_next ? (const char*)g.A + (size_t)nxt.pm * tstepA + (size_t)nxt.ks * g.ksoff * 2 : cA; const char* nB = has_next ? (const char*)g.Bt + (size_t)nxt.pn * tstepB + (size_t)nxt.ks * g.ksoff * 2 : cB;
        for (int t = 0; t < nt; t += 2) PG8_KBODY(t);
        if constexpr (ALIGN_EPI) { if (wr == 0) PG8_BAR; }
        E(acc, cur, wr, wc, fr, fq);
        if (!has_next) break;
#pragma unroll
        for (int a = 0; a < 2; ++a)
#pragma unroll
            for (int b = 0; b < 2; ++b)
#pragma unroll
                for (int m = 0; m < 4; ++m)
#pragma unroll
                    for (int n = 0; n < 2; ++n) acc[a][b][m][n] = (f32x4){0.f, 0.f, 0.f, 0.f};
        cur = nxt; cA = nA; cB = nB; ++ui;
        if constexpr (ALIGN_EPI) { if (wr == 1) PG8_BAR; }
    }
    PG8_WAIT_V(0);
    if constexpr (!ALIGN_EPI) { if (wr == 0) PG8_BAR; }
    PG8_BAR;
#undef PG8_SA
#undef PG8_SB
#undef PG8_STAGE
#undef PG8_LDA
#undef PG8_LDB
#undef PG8_MMA
#undef PG8_WAIT_V
#undef PG8_WAIT_L
#undef PG8_BAR
#undef PG8_SCHED
#undef PG8_KBODY
}
}

#define GAS __attribute__((address_space(1)))
#define LAS __attribute__((address_space(3)))
typedef unsigned v4u __attribute__((ext_vector_type(4)));
typedef float f32x4 __attribute__((ext_vector_type(4)));
constexpr int NWAVES = 8;
constexpr int LDS_BYTES = 147456;
constexpr size_t MiB = 1u << 20;
constexpr size_t WS_PSS = 1 * MiB, WS_WOUT = 2 * MiB, WS_P = 4 * MiB, WS_KC = 214 * MiB, WS_VC = 215 * MiB, WS_MIX = 216 * MiB;
constexpr size_t WS_AN = 4 * MiB, WS_UP = 64 * MiB, WS_WUP = 192 * MiB, WS_WDOWN = 200 * MiB;
constexpr size_t WS_BIAS1 = 0, WS_W1T = 214 * MiB, WS_KCB = 215 * MiB, WS_VCB = 215 * MiB + 512 * 1024;
constexpr size_t DO_H = 0, DO_WG = 32 * MiB, DO_WCAT = 36 * MiB, DO_WIN = 40 * MiB;

__device__ __forceinline__ unsigned pk2(float lo, float hi) { return (unsigned)f2bf(lo) | ((unsigned)f2bf(hi) << 16); }
__device__ __forceinline__ float wave_sum(float v) {
#pragma unroll
    for (int o = 1; o < 64; o <<= 1) v += __shfl_xor(v, o);
    return v;
}
template <class SrcCol>
__device__ __forceinline__ void transpose_item(const float* W, int ldw, const SrcCol& srccol, bf16_t* WT, int ldk, int kofs, LAS float* scr, int kb, int nb, int lane) {
    const int k0 = 64 * kb, n0 = 32 * nb; const int sc = srccol(n0 + (lane & 31));
#pragma unroll 8
    for (int i = 0; i < 32; ++i) { const int kk = 2 * i + (lane >> 5); scr[kk * 33 + (lane & 31)] = (sc >= 0) ? W[(size_t)(k0 + kk) * ldw + sc] : 0.f; }
    asm volatile("s_waitcnt lgkmcnt(0)" ::: "memory");
    const int c = lane & 7;
#pragma unroll
    for (int j = 0; j < 4; ++j) { const int n = (lane >> 3) + 8 * j; const LAS float* s = scr + (8 * c) * 33 + n;
        v4u o; o.x = pk2(s[0 * 33], s[1 * 33]); o.y = pk2(s[2 * 33], s[3 * 33]); o.z = pk2(s[4 * 33], s[5 * 33]); o.w = pk2(s[6 * 33], s[7 * 33]);
        *(v4u*)(WT + (size_t)(n0 + n) * ldk + kofs + k0 + 8 * c) = o; }
    asm volatile("s_waitcnt lgkmcnt(0)" ::: "memory");
}
struct SrcIdent { int off; __device__ __forceinline__ int operator()(int n) const { return n + off; } };
struct SrcWin { __device__ __forceinline__ int operator()(int n) const { return n < 4096 ? n : (n < 6656 ? n + 16 : (n < 6672 ? n - 6656 + 4096 : (n < 6720 ? n : -1))); } };

struct Args { const float* in[23]; float* out; unsigned char* ws; int ph_lo, ph_hi; };

__global__ void __launch_bounds__(NWAVES * 64, 2) mk_fwd(Args args) {
    extern __shared__ __attribute__((aligned(16))) unsigned char lds_raw[];
    LAS unsigned char* lds = (LAS unsigned char*)lds_raw;
    cg::grid_group grid = cg::this_grid();
    const int tid = threadIdx.x, lane = tid & 63, wave = __builtin_amdgcn_readfirstlane(tid >> 6);
    const int G = gridDim.x, gw = blockIdx.x * NWAVES + wave, NGW = G * NWAVES;
    unsigned char* ws = args.ws; unsigned char* dob = (unsigned char*)args.out;
    const float* x = args.in[0];
    bf16_t* P = (bf16_t*)(ws + WS_P);
    bf16_t* Hb = (bf16_t*)(dob + DO_H); bf16_t* Wg_t = (bf16_t*)(dob + DO_WG); bf16_t* Wcat_t = (bf16_t*)(dob + DO_WCAT); bf16_t* Win_t = (bf16_t*)(dob + DO_WIN);
    bf16_t* Wout_t = (bf16_t*)(ws + WS_WOUT); bf16_t* Wup_t = (bf16_t*)(ws + WS_WUP); bf16_t* Wdown_t = (bf16_t*)(ws + WS_WDOWN);
    bf16_t* Mix = (bf16_t*)(ws + WS_MIX); bf16_t* An = (bf16_t*)(ws + WS_AN); bf16_t* Up = (bf16_t*)(ws + WS_UP); float* pss = (float*)(ws + WS_PSS);
    LAS float* scr = (LAS float*)(lds + wave * 16384);
    bf16_t* W1T = (bf16_t*)(ws + WS_W1T); float* bias1 = (float*)(ws + WS_BIAS1); bf16_t* KCb = (bf16_t*)(ws + WS_KCB); bf16_t* VCb = (bf16_t*)(ws + WS_VCB);
    const int lo = args.ph_lo, hi = args.ph_hi;
#ifndef PHMASK
#define PHMASK 0x1ff
#endif
#define IN(k) (((PHMASK >> (k)) & 1) && lo <= (k) && (k) < hi)
#define GRID_SYNC() do { asm volatile("s_waitcnt vmcnt(0) lgkmcnt(0)" ::: "memory"); grid.sync(); \
        if (wave == 0) { __builtin_amdgcn_fence(__ATOMIC_ACQUIRE, "agent"); asm volatile("s_waitcnt vmcnt(0)" ::: "memory"); } __syncthreads(); } while (0)
#define SEAM(k) do { if (IN(k) && IN((k) + 1)) GRID_SYNC(); } while (0)

    if (IN(0)) {
        constexpr int I_WIN = 16 * (NP1 / 32), I_WG = 16 * 64, I_DN = 16 * 32, I_OUT = 16 * 32;
        constexpr int I_W1 = 32 * 4, I_B1 = 256;
        constexpr int NITEMS = I_WIN + I_WG + 2 * I_DN + I_OUT + 2 * I_W1 + I_B1;
        for (int it = gw; it < NITEMS; it += NGW) {
            int r = it;
            if (r < I_WIN) { transpose_item(args.in[2], INW, SrcWin{}, Win_t, D, 0, scr, r / (NP1 / 32), r % (NP1 / 32), lane); continue; } r -= I_WIN;
            if (r < I_WG) { transpose_item(args.in[2], INW, SrcIdent{6720}, Wg_t, D, 0, scr, r / 64, r % 64, lane); continue; } r -= I_WG;
            if (r < I_DN) { transpose_item(args.in[17], D, SrcIdent{0}, Wcat_t, 2 * D, 0, scr, r / 32, r % 32, lane); continue; } r -= I_DN;
            if (r < I_DN) { transpose_item(args.in[18], D, SrcIdent{0}, Wcat_t, 2 * D, D, scr, r / 32, r % 32, lane); continue; } r -= I_DN;
            if (r < I_OUT) { transpose_item(args.in[19], D, SrcIdent{0}, Wout_t, D, 0, scr, r / 32, r % 32, lane); continue; } r -= I_OUT;
            if (r < I_W1) { transpose_item(args.in[12], 128, SrcIdent{0}, W1T, 2048, 0, scr, r / 4, r % 4, lane); continue; } r -= I_W1;
            if (r < I_W1) { transpose_item(args.in[15], 128, SrcIdent{0}, W1T + 128 * 2048, 2048, 0, scr, r / 4, r % 4, lane); continue; } r -= I_W1;
            {
                const int which = r >> 7, i = r & 127; const float* pos = args.in[which ? 14 : 11]; const float* w1 = args.in[which ? 15 : 12];
                float a = 0.f;
                for (int k = lane; k < 2048; k += 64) a += pos[k] * w1[(size_t)k * 128 + i];
                a = wave_sum(a);
                if (lane == 0) bias1[r] = a;
            }
        }
        const float* gain = args.in[1];
        f32x4 gv[4];
#pragma unroll
        for (int j = 0; j < 4; ++j) gv[j] = ((const f32x4*)gain)[lane + 64 * j];
        for (int m = gw; m < M; m += NGW) {
            const f32x4* xr = (const f32x4*)(x + (size_t)m * D) + lane;
            f32x4 v[4]; float s = 0.f;
#pragma unroll
            for (int j = 0; j < 4; ++j) { v[j] = xr[64 * j]; s += (v[j].x * v[j].x + v[j].y * v[j].y) + (v[j].z * v[j].z + v[j].w * v[j].w); }
            const float rstd = rsqrtf(wave_sum(s) * (1.f / D) + EPS);
            unsigned long long* o8 = (unsigned long long*)(Hb + (size_t)m * D) + lane;
#pragma unroll
            for (int j = 0; j < 4; ++j) { const f32x4 y = v[j] * rstd * gv[j]; o8[64 * j] = (unsigned long long)pk2(y.x, y.y) | ((unsigned long long)pk2(y.z, y.w) << 32); }
        }
    }
    SEAM(0);
    if (IN(1)) {
        pg8::Gemm g{Hb, Win_t, D, D, M, NP1, D, 0}; pg8::StaticOrder S; S.init(M, NP1, G, (int)blockIdx.x);
        pg8::EpiP<0> E{P, LDP, 26, 64};
        pg8::gemm_phase<pg8::EpiP<0>, pg8::StaticOrder, true>(lds, g, S, E);
    }
    SEAM(1);
    if (IN(2)) {
        for (int it = blockIdx.x; it < 128; it += G) {
            const int half = it & 1, which = (it >> 1) & 1, g_ = (it >> 2) & 3, b_ = it >> 4;
            nsa::compress_item(lds, P, W1T + (size_t)which * 128 * 2048, bias1 + which * 128, args.in[which ? 16 : 13], args.in[8], which ? VCb : KCb, b_, g_, which, half);
        }
        nsa::prep_units(P, args.in[7], args.in[9], args.in[10], gw, NGW, lane);
    }
    SEAM(2);
    if (IN(3)) {
#if !defined(GDN_SEPARATE)
        if ((int)blockIdx.x < 16) gdn_naive::run(lds, P, args.in[3], args.in[4], args.in[5], args.in[6], 4 * (int)blockIdx.x);
        __syncthreads();
#endif
        for (int idx = blockIdx.x; idx < 1024; idx += G) {
            const int c_ = idx & 255, k_ = idx >> 8, pair = c_ >> 3, s_ = c_ & 7;
            const int qt = (k_ == 0) ? 31 - s_ : (k_ == 1) ? 16 + s_ : (k_ == 2) ? 15 - s_ : s_;
            nsa::attn_tile(lds, P, KCb, VCb, pair >> 2, pair & 3, qt);
        }
    }
    SEAM(3);
    if (IN(4)) {
        pg8::Gemm g{Hb, Wg_t, D, D, M, 2048, D, 0}; pg8::StaticOrder S; S.init(M, 2048, G, (int)blockIdx.x);
        pg8::EpiP<1> E{P, LDP, -1, 256};
        pg8::gemm_phase<pg8::EpiP<1>, pg8::StaticOrder, true>(lds, g, S, E);
    }
    SEAM(4);
    if (IN(5)) {
        pg8::Gemm g{P + C_DZ, Wcat_t, LDP, 2 * D, M, D, D, D}; pg8::TwoPassOrder S; S.base.init(M, D, G, (int)blockIdx.x);
        pg8::EpiMix E{P, LDP, Mix, D};
        pg8::gemm_phase<pg8::EpiMix, pg8::TwoPassOrder, false>(lds, g, S, E);
    }
    SEAM(5);
    if (IN(6)) {
        for (int it = gw; it < 16 * 128; it += NGW) transpose_item(args.in[21], FF, SrcIdent{0}, Wup_t, D, 0, scr, it / 128, it % 128, lane);
        __syncthreads();
        pg8::Gemm g{Mix, Wout_t, D, D, M, D, D, 0}; pg8::StaticOrder S; S.init(M, D, G, (int)blockIdx.x);
        pg8::EpiOut E{x, args.out, An, args.in[20], pss};
        pg8::gemm_phase<pg8::EpiOut, pg8::StaticOrder, false>(lds, g, S, E);
    }
    SEAM(6);
    if (IN(7)) {
        for (int it = gw; it < 64 * 32; it += NGW) transpose_item(args.in[22], D, SrcIdent{0}, Wdown_t, FF, 0, scr, it / 32, it % 32, lane);
        __syncthreads();
        pg8::Gemm g{An, Wup_t, D, D, M, FF, D, 0}; pg8::StaticOrder S; S.init(M, FF, G, (int)blockIdx.x);
        pg8::EpiUp E{pss, Up, FF};
        pg8::gemm_phase<pg8::EpiUp, pg8::StaticOrder, true>(lds, g, S, E);
    }
    SEAM(7);
    if (IN(8)) {
        pg8::Gemm g{Up, Wdown_t, FF, FF, M, D, FF, 0}; pg8::StaticOrder S; S.init(M, D, G, (int)blockIdx.x);
        pg8::EpiDown E{args.out};
        pg8::gemm_phase<pg8::EpiDown, pg8::StaticOrder, false>(lds, g, S, E);
    }
#undef IN
#undef SEAM
#undef GRID_SYNC
}

static int g_grid = 0;
static void launch_mk(const Args& a0, int lo, int hi, hipStream_t stream) {
    Args a = a0; a.ph_lo = lo; a.ph_hi = hi;
    void* kargs[] = {(void*)&a};
    hipError_t e = hipLaunchCooperativeKernel((const void*)mk_fwd, dim3(g_grid), dim3(NWAVES * 64), kargs, LDS_BYTES, stream);
    if (e != hipSuccess) fprintf(stderr, "cooperative launch failed: %s (grid %d)\n", hipGetErrorString(e), g_grid);
}

extern "C" void kernel_launch(void* const* d_in, const int* in_sizes, int n_in, void* d_out, int out_size, void* d_ws, size_t ws_size, hipStream_t stream) {
    if (g_grid == 0) {
        int dev = 0, cus = 0, per_cu = 0;
        hipGetDevice(&dev);
        hipDeviceGetAttribute(&cus, hipDeviceAttributeMultiprocessorCount, dev);
        hipFuncSetAttribute((const void*)mk_fwd, hipFuncAttributeMaxDynamicSharedMemorySize, LDS_BYTES);
        hipOccupancyMaxActiveBlocksPerMultiprocessor(&per_cu, (const void*)mk_fwd, NWAVES * 64, LDS_BYTES);
        if (per_cu < 1) per_cu = 1;
        if (per_cu > 1) per_cu = 1;
        g_grid = cus * per_cu;
    }
    Args a{};
    for (int i = 0; i < 23; ++i) a.in[i] = (const float*)d_in[i];
    a.out = (float*)d_out; a.ws = (unsigned char*)d_ws;
    bf16_t* P = (bf16_t*)((char*)d_ws + WS_P);
#if defined(GDN_SEPARATE)
    launch_mk(a, 0, 2, stream);
    hipLaunchKernelGGL(k_gdn_conv, dim3(BATCH * 3072 / 256), dim3(256), 0, stream, P, a.in[3]);
    hipLaunchKernelGGL(k_gdn_l2norm, dim3(M * 16 / 4), dim3(256), 0, stream, P);
    hipLaunchKernelGGL(k_gdn_scan, dim3(BATCH * DN_H), dim3(128), 0, stream, P, a.in[4], a.in[5], a.in[6]);
    launch_mk(a, 2, 9, stream);
#else
    launch_mk(a, 0, 9, stream);
#endif
}
```

```cpp
#include <hip/hip_runtime.h>
#include <hip/hip_cooperative_groups.h>
#include <stdint.h>
#include <cstdio>
namespace cg = cooperative_groups;

typedef unsigned short bf16_t;

constexpr int D = 1024, BATCH = 8, SEQ = 2048, M = BATCH * SEQ;
constexpr int DN_H = 8, DN_D = 128;
constexpr int NS_H = 16, NS_G = 4, NS_R = 4, NS_D = 64;
constexpr int NCMP = 127, NSEL = 32;
constexpr int FF = 4096;
constexpr int INW = 8768;
constexpr float EPS = 1e-6f;
constexpr float NEGV = -1e30f, FORCEV = 1e9f;

constexpr int LDP = 6720;
constexpr int C_DQ = 0, C_DK = 1024, C_DV = 2048, C_DZ = 3072, C_NQ = 4096;
constexpr int C_KC = 5120, C_VC = 5376, C_KS = 5632, C_VS = 5888, C_KW = 6144, C_VW = 6400;
constexpr int C_SB = 6656, C_SA = 6664, C_SG = 6672;
constexpr int NP1 = 6912;

__device__ __forceinline__ float bf2f(bf16_t v) { return __uint_as_float(((unsigned)v) << 16); }
__device__ __forceinline__ bf16_t f2bf(float f) { unsigned u = __float_as_uint(f); return (bf16_t)((u + 0x7fffu + ((u >> 16) & 1u)) >> 16); }
__device__ __forceinline__ float sigmoidf_(float x) { return 1.f / (1.f + __expf(-x)); }
__device__ __forceinline__ float siluf_(float x) { return x * sigmoidf_(x); }
__device__ __forceinline__ float softplusf_(float x) { return fmaxf(x, 0.f) + log1pf(__expf(-fabsf(x))); }
__device__ __forceinline__ float gelu_tanh(float x) { return 0.5f * x * (1.f + tanhf(0.7978845608028654f * (x + 0.044715f * x * x * x))); }

__device__ __forceinline__ float block_sum(float v, float* red) {
    for (int o = 32; o > 0; o >>= 1) v += __shfl_xor(v, o);
    const int w = threadIdx.x >> 6, nw = blockDim.x >> 6;
    __syncthreads();
    if ((threadIdx.x & 63) == 0) red[w] = v;
    __syncthreads();
    float s = 0.f;
    for (int i = 0; i < nw; ++i) s += red[i];
    return s;
}
__device__ __forceinline__ float block_max(float v, float* red) {
    for (int o = 32; o > 0; o >>= 1) v = fmaxf(v, __shfl_xor(v, o));
    const int w = threadIdx.x >> 6, nw = blockDim.x >> 6;
    __syncthreads();
    if ((threadIdx.x & 63) == 0) red[w] = v;
    __syncthreads();
    float s = red[0];
    for (int i = 1; i < nw; ++i) s = fmaxf(s, red[i]);
    return s;
}

namespace gdn_naive {
#define GLAS __attribute__((address_space(3)))
__device__ __forceinline__ float sub_sum(float v, GLAS float* red, int sub, int tid) {
#pragma unroll
    for (int o = 32; o > 0; o >>= 1) v += __shfl_xor(v, o);
    __syncthreads();
    if ((tid & 63) == 0) red[sub * 2 + ((tid >> 6) & 1)] = v;
    __syncthreads();
    return red[sub * 2] + red[sub * 2 + 1];
}
__device__ __forceinline__ void run(GLAS unsigned char* lds, bf16_t* P, const float* convw, const float* a_log, const float* dt_bias, const float* out_norm, int item0) {
    const int tid = threadIdx.x, sub = tid >> 7, j = tid & 127;
    GLAS float* qs = (GLAS float*)lds + sub * 256; GLAS float* ks = qs + 128; GLAS float* red = (GLAS float*)(lds + 4096);
    const int item = item0 + sub; const int b = item / DN_H, h = item % DN_H;
    float s[128];
#pragma unroll
    for (int i = 0; i < 128; ++i) s[i] = 0.f;
    const float Ah = -__expf(a_log[h]), dtb = dt_bias[h], gn = out_norm[j];
    const float scale = 0.08838834764831845f;
    float wq[4], wk[4], wv[4], xq[3] = {0.f, 0.f, 0.f}, xk[3] = {0.f, 0.f, 0.f}, xv[3] = {0.f, 0.f, 0.f};
#pragma unroll
    for (int t = 0; t < 4; ++t) { wq[t] = convw[t * 3072 + h * 128 + j]; wk[t] = convw[t * 3072 + 1024 + h * 128 + j]; wv[t] = convw[t * 3072 + 2048 + h * 128 + j]; }
    for (int t = 0; t < SEQ; ++t) {
        bf16_t* row = P + (size_t)(b * SEQ + t) * LDP;
        const float rq = bf2f(row[C_DQ + h * DN_D + j]), rk = bf2f(row[C_DK + h * DN_D + j]), rv = bf2f(row[C_DV + h * DN_D + j]);
        float q = siluf_(wq[0] * xq[0] + wq[1] * xq[1] + wq[2] * xq[2] + wq[3] * rq);
        float k = siluf_(wk[0] * xk[0] + wk[1] * xk[1] + wk[2] * xk[2] + wk[3] * rk);
        const float v = siluf_(wv[0] * xv[0] + wv[1] * xv[1] + wv[2] * xv[2] + wv[3] * rv);
        xq[0] = xq[1]; xq[1] = xq[2]; xq[2] = rq; xk[0] = xk[1]; xk[1] = xk[2]; xk[2] = rk; xv[0] = xv[1]; xv[1] = xv[2]; xv[2] = rv;
        const float sq = sub_sum(q * q, red, sub, tid);
        const float sk = sub_sum(k * k, red, sub, tid);
        q *= rsqrtf(sq + EPS); k *= rsqrtf(sk + EPS);
        qs[j] = q; ks[j] = k;
        const float beta = sigmoidf_(bf2f(row[C_SB + h]));
        const float a = __expf(Ah * softplusf_(bf2f(row[C_SA + h]) + dtb));
        const float z = bf2f(row[C_DZ + h * DN_D + j]);
        __syncthreads();
        float kS = 0.f;
#pragma unroll
        for (int i = 0; i < 128; ++i) kS += ks[i] * s[i];
        const float dlt = beta * (v - a * kS);
        asm volatile("" ::: "memory");
        float o = 0.f;
#pragma unroll
        for (int i = 0; i < 128; ++i) { s[i] = a * s[i] + ks[i] * dlt; o += qs[i] * s[i]; }
        o *= scale;
        const float ss = sub_sum(o * o, red, sub, tid);
        row[C_DZ + h * DN_D + j] = f2bf(o * rsqrtf(ss * (1.f / 128.f) + EPS) * gn * siluf_(z));
    }
}
}
namespace gdn {
#define GL3 __attribute__((address_space(3)))
typedef short bf16x8 __attribute__((ext_vector_type(8)));
typedef short s16x4 __attribute__((ext_vector_type(4)));
typedef short v4i16_t __attribute__((ext_vector_type(4)));
typedef float f32x16 __attribute__((ext_vector_type(16)));
typedef float f32x4 __attribute__((ext_vector_type(4)));
typedef float f32x2 __attribute__((ext_vector_type(2)));
typedef unsigned u32x4 __attribute__((ext_vector_type(4)));
typedef unsigned u32x2 __attribute__((ext_vector_type(2)));
typedef __bf16 bf16x2_t __attribute__((ext_vector_type(2)));
constexpr float QSCALE = 0.08838834764831845f;
__device__ __forceinline__ int crow(int i, int hi) { return (i & 3) + 8 * (i >> 2) + 4 * hi; }
__device__ __forceinline__ unsigned pk(float lo, float hi) { f32x2 v = {lo, hi}; bf16x2_t b = __builtin_convertvector(v, bf16x2_t); return __builtin_bit_cast(unsigned, b); }
__device__ __forceinline__ bf16x8 pack8(const float* v) { u32x4 w = {pk(v[0], v[1]), pk(v[2], v[3]), pk(v[4], v[5]), pk(v[6], v[7])}; return __builtin_bit_cast(bf16x8, w); }
__device__ __forceinline__ float blo(unsigned w) { return __uint_as_float(w << 16); }
__device__ __forceinline__ float bhi(unsigned w) { return __uint_as_float(w & 0xffff0000u); }
__device__ __forceinline__ char* seg_addr(bf16_t* P, size_t row0, int c0, unsigned e) { return (char*)P + ((row0 + (e >> 8)) * LDP + c0) * 2 + (e & 255u); }

constexpr int PL_K = 0, PL_KB = 16384, PL_Q = 32768, PL_RHS = 49152, PL_AM = 114688, PL_GC = 132096, PL_QKST = 132352, PL_END = 140544;
constexpr int PL_WST = 0, PL_UST = 16384;
constexpr int AMLD = 68;
__device__ __forceinline__ void prep_item(GL3 unsigned char* lds, bf16_t* P, const bf16_t* HALO, const float* convw, const float* a_log, const float* dt_bias,
                                          bf16_t* GW, bf16_t* GQK, float* GLv, int b, int n, int h) {
    const int tid = threadIdx.x, lane = tid & 63, r32 = lane & 31, hi = lane >> 5; const int wid = __builtin_amdgcn_readfirstlane(tid >> 6);
    const size_t row0 = (size_t)b * SEQ + 64 * n; const int item = (b * DN_H + h) * 32 + n;
    GL3 float* RHS = (GL3 float*)(lds + PL_RHS); GL3 float* AM = (GL3 float*)(lds + PL_AM); GL3 float* GC = (GL3 float*)(lds + PL_GC);
    float gcum, beta_l, gc_last;
    {
        const bf16_t* prow = P + (row0 + lane) * LDP;
        beta_l = sigmoidf_(bf2f(prow[C_SB + h]));
        gcum = -__expf(a_log[h]) * softplusf_(bf2f(prow[C_SA + h]) + dt_bias[h]);
#pragma unroll
        for (int o = 1; o < 64; o <<= 1) { const float t = __shfl_up(gcum, o); if (lane >= o) gcum += t; }
        gc_last = __shfl(gcum, 63);
        if (wid == 0) GC[lane] = gcum;
    }
    bf16x8 qd_keep[2], ke_keep[2];
    const int dc = lane & 15;
#pragma unroll
    for (int pass = 0; pass < 2; ++pass) {
        const int tok = 8 * wid + 4 * pass + (lane >> 4);
        const float gct = __shfl(gcum, tok), bet = __shfl(beta_l, tok);
        float y[3][8];
#pragma unroll
        for (int which = 0; which < 3; ++which) {
            const int col = which * 1024 + h * 128 + dc * 8;
#pragma unroll
            for (int e = 0; e < 8; ++e) y[which][e] = 0.f;
#pragma unroll
            for (int j = 0; j < 4; ++j) {
                const int rr = tok - 3 + j;
                u32x4 x = {0u, 0u, 0u, 0u};
                if (rr >= 0) x = *(const u32x4*)(P + (row0 + rr) * LDP + col);
                else if (n > 0) x = *(const u32x4*)(HALO + ((size_t)((b * 32 + n - 1) * 3 + (3 + rr))) * 3072 + col);
                const f32x4 w0 = *(const f32x4*)(convw + j * 3072 + col), w1 = *(const f32x4*)(convw + j * 3072 + col + 4);
                y[which][0] += w0[0] * blo(x.x); y[which][1] += w0[1] * bhi(x.x); y[which][2] += w0[2] * blo(x.y); y[which][3] += w0[3] * bhi(x.y);
                y[which][4] += w1[0] * blo(x.z); y[which][5] += w1[1] * bhi(x.z); y[which][6] += w1[2] * blo(x.w); y[which][7] += w1[3] * bhi(x.w);
            }
#pragma unroll
            for (int e = 0; e < 8; ++e) y[which][e] = siluf_(y[which][e]);
        }
        float sq = 0.f, sk = 0.f;
#pragma unroll
        for (int e = 0; e < 8; ++e) { sq += y[0][e] * y[0][e]; sk += y[1][e] * y[1][e]; }
#pragma unroll
        for (int o = 1; o < 16; o <<= 1) { sq += __shfl_xor(sq, o); sk += __shfl_xor(sk, o); }
        const float rq = rsqrtf(sq + EPS), rk = rsqrtf(sk + EPS);
        const float eg = __expf(gct), ke_s = __expf(gc_last - gct);
        float q8[8], k8[8], kb8[8], qd8[8], ke8[8], kbg8[8], vb8[8];
#pragma unroll
        for (int e = 0; e < 8; ++e) { q8[e] = y[0][e] * rq; k8[e] = y[1][e] * rk; kb8[e] = k8[e] * bet; qd8[e] = q8[e] * (QSCALE * eg); ke8[e] = k8[e] * ke_s; kbg8[e] = kb8[e] * eg; vb8[e] = y[2][e] * bet; }
        const int io = (dc * 64 + tok) * 16;
        *(GL3 bf16x8*)(lds + PL_Q + io) = pack8(q8); *(GL3 bf16x8*)(lds + PL_K + io) = pack8(k8); *(GL3 bf16x8*)(lds + PL_KB + io) = pack8(kb8);
        *(GL3 f32x4*)(RHS + tok * 256 + dc * 8) = (f32x4){kbg8[0], kbg8[1], kbg8[2], kbg8[3]}; *(GL3 f32x4*)(RHS + tok * 256 + dc * 8 + 4) = (f32x4){kbg8[4], kbg8[5], kbg8[6], kbg8[7]};
        *(GL3 f32x4*)(RHS + tok * 256 + 128 + dc * 8) = (f32x4){vb8[0], vb8[1], vb8[2], vb8[3]}; *(GL3 f32x4*)(RHS + tok * 256 + 128 + dc * 8 + 4) = (f32x4){vb8[4], vb8[5], vb8[6], vb8[7]};
        qd_keep[pass] = pack8(qd8); ke_keep[pass] = pack8(ke8);
    }
    __syncthreads();
#pragma unroll
    for (int pass = 0; pass < 2; ++pass) {
        const int tok = 8 * wid + 4 * pass + (lane >> 4);
        *(bf16x8*)seg_addr(P, row0, C_DQ + h * 128, (unsigned)((dc * 64 + tok) * 16)) = qd_keep[pass];
        const unsigned ek = (unsigned)(((dc >> 2) * 4 + (tok >> 4)) * 1024 + ((tok >> 3) & 1) * 512 + (tok & 7) * 64 + (dc & 3) * 16);
        *(bf16x8*)seg_addr(P, row0, C_DK + h * 128, ek) = ke_keep[pass];
    }
    if (wid < 6) {
        const bool isA = wid < 3; const int t3 = isA ? wid : wid - 3;
        const int rt = isA ? (t3 > 0) : (t3 == 2);
        const int ct = isA ? (t3 == 2) : (t3 > 0);
        GL3 const unsigned char* aimg = lds + (isA ? PL_KB : PL_K); GL3 const unsigned char* bimg = lds + (isA ? PL_K : PL_Q);
        f32x16 acc = f32x16{};
#pragma unroll
        for (int s = 0; s < 8; ++s) {
            const bf16x8 a = *(GL3 const bf16x8*)(aimg + ((2 * s + hi) * 64 + 32 * rt + r32) * 16);
            const bf16x8 bb = *(GL3 const bf16x8*)(bimg + ((2 * s + hi) * 64 + 32 * ct + r32) * 16);
            acc = __builtin_amdgcn_mfma_f32_32x32x16_bf16(a, bb, acc, 0, 0, 0);
        }
        if (isA) {
            const int j = 32 * ct + r32; const float gj = GC[j];
#pragma unroll
            for (int i_ = 0; i_ < 16; ++i_) { const int i = 32 * rt + crow(i_, hi); AM[i * AMLD + j] = (j < i) ? acc[i_] * __expf(GC[i] - gj) : 0.f; }
        } else {
            const int i = 32 * ct + r32; const float gi = GC[i];
            float v[16];
#pragma unroll
            for (int i_ = 0; i_ < 16; ++i_) { const int j = 32 * rt + crow(i_, hi); v[i_] = (j <= i) ? acc[i_] * (QSCALE * __expf(gi - GC[j])) : 0.f; }
#pragma unroll
            for (int sp = 0; sp < 2; ++sp) *(GL3 bf16x8*)(lds + PL_QKST + (((2 * rt + sp) * 64 + i) * 16 + 8 * hi) * 2) = pack8(v + 8 * sp);
        }
    } else if (wid == 6) {
        const bf16x8 z = {0, 0, 0, 0, 0, 0, 0, 0};
#pragma unroll
        for (int sp = 0; sp < 2; ++sp) *(GL3 bf16x8*)(lds + PL_QKST + (((2 + sp) * 64 + r32) * 16 + 8 * hi) * 2) = z;
    }
    __syncthreads();
    if (tid < 256) {
        const int c = tid;
        float x[64];
#pragma unroll
        for (int i = 0; i < 64; ++i) x[i] = 0.f;
#pragma unroll
        for (int i = 0; i < 64; ++i) {
            float a0 = RHS[i * 256 + c], a1 = 0.f, a2 = 0.f, a3 = 0.f;
#pragma unroll
            for (int j4 = 0; j4 < i; j4 += 4) { const f32x4 a = *(GL3 const f32x4*)(AM + i * AMLD + j4); a0 -= a[0] * x[j4]; a1 -= a[1] * x[j4 + 1]; a2 -= a[2] * x[j4 + 2]; a3 -= a[3] * x[j4 + 3]; }
            x[i] = (a0 + a1) + (a2 + a3);
        }
        asm volatile("" ::: "memory");
        if (c < 128) {
#pragma unroll
            for (int i = 0; i < 64; ++i) *(GL3 bf16_t*)(lds + PL_WST + ((c >> 3) * 64 + i) * 16 + (c & 7) * 2) = f2bf(x[i]);
        } else {
#pragma unroll
            for (int i = 0; i < 64; ++i) *(GL3 bf16_t*)(lds + PL_UST + (i * 128 + (c - 128)) * 2) = f2bf(x[i]);
        }
    } else {
        const int t = tid - 256;
#pragma unroll
        for (int k = 0; k < 2; ++k) { const int e = (t + 256 * k) * 16; *(u32x4*)((char*)(GQK + (size_t)item * 4096) + e) = *(GL3 const u32x4*)(lds + PL_QKST + e); }
        if (t == 0) GLv[item] = __expf(gc_last);
    }
    __syncthreads();
#pragma unroll
    for (int k = 0; k < 2; ++k) {
        const int e = (tid + 512 * k) * 16;
        *(u32x4*)((char*)(GW + (size_t)item * 8192) + e) = *(GL3 const u32x4*)(lds + PL_WST + e);
        *(u32x4*)seg_addr(P, row0, C_DV + h * 128, (unsigned)e) = *(GL3 const u32x4*)(lds + PL_UST + e);
    }
    __syncthreads();
}

constexpr int SL_W = 0, SL_QD = 16384, SL_KE = 32768, SL_QK = 49152, SL_U = 57344, SL_Z = 73728, SL_S = 90112, SL_VN = 122880, SL_RS = 139264, SL_END = 140288;
__device__ __forceinline__ void dma_seg(GL3 unsigned char* dst, const bf16_t* P, size_t row0, int c0, int wid, int lane) {
#pragma unroll
    for (int k = 0; k < 2; ++k) { const int piece = wid + 8 * k;
        const char* src = (const char*)P + ((row0 + piece * 4 + (lane >> 4)) * LDP + c0) * 2 + (lane & 15) * 16;
        __builtin_amdgcn_global_load_lds((const unsigned*)src, (GL3 unsigned*)(dst + piece * 1024), 16, 0, 0); }
}
__device__ __forceinline__ void dma_lin(GL3 unsigned char* dst, const bf16_t* src, int npieces, int wid, int lane) {
    for (int piece = wid; piece < npieces; piece += 8)
        __builtin_amdgcn_global_load_lds((const unsigned*)((const char*)src + piece * 1024 + lane * 16), (GL3 unsigned*)(dst + piece * 1024), 16, 0, 0);
}
__device__ __forceinline__ s16x4 vtr(GL3 const unsigned char* p) { return __builtin_bit_cast(s16x4, __builtin_amdgcn_ds_read_tr16_b64_v4i16((GL3 v4i16_t*)p)); }

__device__ __forceinline__ void scan_item(GL3 unsigned char* lds, bf16_t* P, const bf16_t* GW, const bf16_t* GQK, const float* GLv, const float* out_norm, int b, int h) {
    const int tid = threadIdx.x, lane = tid & 63, r32 = lane & 31, hi = lane >> 5; const int wid = __builtin_amdgcn_readfirstlane(tid >> 6);
    const int mt = wid >> 2, nt = wid & 3;
    const int dv = 32 * nt + r32;
    f32x16 S0 = f32x16{}, S1 = f32x16{};
    {
        const u32x4 z = {0u, 0u, 0u, 0u};
#pragma unroll
        for (int k = 0; k < 4; ++k) *(GL3 u32x4*)(lds + SL_S + (tid + 512 * k) * 16) = z;
    }
    const float gain = out_norm[dv];
    GL3 float* RS = (GL3 float*)(lds + SL_RS);
    for (int n = 0; n < 32; ++n) {
        const size_t row0 = (size_t)b * SEQ + 64 * n; const int item = (b * DN_H + h) * 32 + n;
        __syncthreads();
        dma_lin(lds + SL_W, GW + (size_t)item * 8192, 16, wid, lane);
        dma_seg(lds + SL_QD, P, row0, C_DQ + h * 128, wid, lane);
        dma_seg(lds + SL_KE, P, row0, C_DK + h * 128, wid, lane);
        dma_lin(lds + SL_QK, GQK + (size_t)item * 4096, 8, wid, lane);
        dma_seg(lds + SL_U, P, row0, C_DV + h * 128, wid, lane);
        dma_seg(lds + SL_Z, P, row0, C_DZ + h * 128, wid, lane);
        const float gl = GLv[item];
        __syncthreads();
        f32x16 vp = f32x16{}, o = f32x16{};
#pragma unroll
        for (int s = 0; s < 8; ++s) {
            const bf16x8 sb = *(GL3 const bf16x8*)(lds + SL_S + ((2 * s + hi) * 128 + dv) * 16);
            const bf16x8 wa = *(GL3 const bf16x8*)(lds + SL_W + ((2 * s + hi) * 64 + 32 * mt + r32) * 16);
            const bf16x8 qa = *(GL3 const bf16x8*)(lds + SL_QD + ((2 * s + hi) * 64 + 32 * mt + r32) * 16);
            vp = __builtin_amdgcn_mfma_f32_32x32x16_bf16(wa, sb, vp, 0, 0, 0);
            o = __builtin_amdgcn_mfma_f32_32x32x16_bf16(qa, sb, o, 0, 0, 0);
        }
        {
            float v[16];
#pragma unroll
            for (int i = 0; i < 16; ++i) v[i] = bf2f(*(GL3 const bf16_t*)(lds + SL_U + ((32 * mt + crow(i, hi)) * 128 + dv) * 2)) - vp[i];
#pragma unroll
            for (int sp = 0; sp < 2; ++sp) *(GL3 bf16x8*)(lds + SL_VN + (((2 * mt + sp) * 128 + dv) * 16 + 8 * hi) * 2) = pack8(v + 8 * sp);
        }
        __syncthreads();
#pragma unroll
        for (int i = 0; i < 16; ++i) { S0[i] *= gl; S1[i] *= gl; }
        {
            GL3 const unsigned char* kp0 = lds + SL_KE + (2 * mt) * 4096 + ((lane >> 4) & 1) * 32 + (lane & 3) * 8 + (4 * hi + ((lane & 15) >> 2)) * 64;
#pragma unroll
            for (int ks = 0; ks < 4; ++ks) {
                const bf16x8 vb = *(GL3 const bf16x8*)(lds + SL_VN + ((ks * 128 + dv) * 16 + 8 * hi) * 2);
                const s16x4 l0 = vtr(kp0 + ks * 1024), h0 = vtr(kp0 + ks * 1024 + 512), l1 = vtr(kp0 + 4096 + ks * 1024), h1 = vtr(kp0 + 4096 + ks * 1024 + 512);
                const bf16x8 k0 = {l0[0], l0[1], l0[2], l0[3], h0[0], h0[1], h0[2], h0[3]}, k1 = {l1[0], l1[1], l1[2], l1[3], h1[0], h1[1], h1[2], h1[3]};
                const bf16x8 qa = *(GL3 const bf16x8*)(lds + SL_QK + ((ks * 64 + 32 * mt + r32) * 16 + 8 * hi) * 2);
                S0 = __builtin_amdgcn_mfma_f32_32x32x16_bf16(k0, vb, S0, 0, 0, 0);
                S1 = __builtin_amdgcn_mfma_f32_32x32x16_bf16(k1, vb, S1, 0, 0, 0);
                o = __builtin_amdgcn_mfma_f32_32x32x16_bf16(qa, vb, o, 0, 0, 0);
            }
        }
        {
#pragma unroll
            for (int i = 0; i < 16; ++i) { float q = o[i] * o[i];
#pragma unroll
                for (int sh = 1; sh < 32; sh <<= 1) q += __shfl_xor(q, sh);
                if (r32 == 0) RS[(32 * mt + crow(i, hi)) * 4 + nt] = q; }
        }
        __syncthreads();
#pragma unroll
        for (int a = 0; a < 4; ++a) {
            u32x2 w0 = {pk(S0[4 * a], S0[4 * a + 1]), pk(S0[4 * a + 2], S0[4 * a + 3])}, w1 = {pk(S1[4 * a], S1[4 * a + 1]), pk(S1[4 * a + 2], S1[4 * a + 3])};
            *(GL3 u32x2*)(lds + SL_S + ((4 * (2 * mt) + a) * 128 + dv) * 16 + 8 * hi) = w0;
            *(GL3 u32x2*)(lds + SL_S + ((4 * (2 * mt + 1) + a) * 128 + dv) * 16 + 8 * hi) = w1;
        }
#pragma unroll
        for (int i = 0; i < 16; ++i) { const int tok = 32 * mt + crow(i, hi);
            const f32x4 rs = *(GL3 const f32x4*)(RS + tok * 4);
            const float rstd = rsqrtf(((rs[0] + rs[1]) + (rs[2] + rs[3])) * (1.f / 128.f) + EPS);
            const float z = bf2f(*(GL3 const bf16_t*)(lds + SL_Z + (tok * 128 + dv) * 2));
            *(GL3 bf16_t*)(lds + SL_VN + (tok * 128 + dv) * 2) = f2bf(o[i] * rstd * gain * siluf_(z)); }
        __syncthreads();
#pragma unroll
        for (int k = 0; k < 2; ++k) { const int e = (tid + 512 * k) * 16; *(u32x4*)seg_addr(P, row0, C_DZ + h * 128, (unsigned)e) = *(GL3 const u32x4*)(lds + SL_VN + e); }
    }
    __syncthreads();
}
}
namespace nsa {
#define NLAS __attribute__((address_space(3)))
typedef short bf16x8 __attribute__((ext_vector_type(8)));
typedef short s16x4 __attribute__((ext_vector_type(4)));
typedef short v4i16_t __attribute__((ext_vector_type(4)));
typedef float f32x16 __attribute__((ext_vector_type(16)));
typedef float f32x4 __attribute__((ext_vector_type(4)));
typedef float f32x2 __attribute__((ext_vector_type(2)));
typedef unsigned u32x4 __attribute__((ext_vector_type(4)));
typedef __bf16 bf16x2_t __attribute__((ext_vector_type(2)));
constexpr float LOG2E = 1.4426950408889634f;
constexpr float NEG = -1e30f;
constexpr int L_KV = 0;
constexpr int L_IMP = 32768;
constexpr int L_SEL = 65536;
constexpr int L_WS = 66048;
constexpr int L_OST = 68096;
constexpr int L_END = 100864;

__device__ __forceinline__ int crow(int i, int hi) { return (i & 3) + 8 * (i >> 2) + 4 * hi; }
__device__ __forceinline__ unsigned pk(float lo, float hi) { f32x2 v = {lo, hi}; bf16x2_t b = __builtin_convertvector(v, bf16x2_t); return __builtin_bit_cast(unsigned, b); }
__device__ __forceinline__ float xhalf_max(float v) { auto rr = __builtin_amdgcn_permlane32_swap(__float_as_uint(v), __float_as_uint(v), false, false); return fmaxf(__uint_as_float(rr[0]), __uint_as_float(rr[1])); }
__device__ __forceinline__ float xhalf_sum(float v) { auto rr = __builtin_amdgcn_permlane32_swap(__float_as_uint(v), __float_as_uint(v), false, false); return __uint_as_float(rr[0]) + __uint_as_float(rr[1]); }

__device__ __forceinline__ void dma_tile(NLAS unsigned char* slot, const bf16_t* Kb, const bf16_t* Vb, unsigned koff, unsigned voff, int wid) {
    __builtin_amdgcn_global_load_lds((const unsigned*)((const char*)Kb + koff), (NLAS unsigned*)(slot + wid * 1024), 16, 0, 0);
    __builtin_amdgcn_global_load_lds((const unsigned*)((const char*)Vb + voff), (NLAS unsigned*)(slot + 8192 + wid * 1024), 16, 0, 0);
}
__device__ __forceinline__ void tile_offs(unsigned& koff, unsigned& voff, int pitch, int wid, int lane) {
    koff = (unsigned)(lane * pitch + wid * 8) * 2u;
    voff = (unsigned)((16 * (wid & 3) + (lane >> 2)) * pitch + (wid >> 2) * 32 + (lane & 3) * 8) * 2u;
}
__device__ __forceinline__ void qkt(f32x16& p0, f32x16& p1, NLAS const unsigned char* Kslot, const bf16x8* qr, const f32x16& c0, const f32x16& c1, int r32, int hi) {
    NLAS const unsigned char* kb = Kslot + hi * 1024 + r32 * 16;
#pragma unroll
    for (int d0 = 0; d0 < 4; ++d0) {
        const bf16x8 b0 = *(NLAS const bf16x8*)(kb + d0 * 2048);
        const bf16x8 b1 = *(NLAS const bf16x8*)(kb + d0 * 2048 + 512);
        if (d0 == 0) { p0 = __builtin_amdgcn_mfma_f32_32x32x16_bf16(b0, qr[0], c0, 0, 0, 0); p1 = __builtin_amdgcn_mfma_f32_32x32x16_bf16(b1, qr[0], c1, 0, 0, 0); }
        else { p0 = __builtin_amdgcn_mfma_f32_32x32x16_bf16(b0, qr[d0], p0, 0, 0, 0); p1 = __builtin_amdgcn_mfma_f32_32x32x16_bf16(b1, qr[d0], p1, 0, 0, 0); }
    }
}
__device__ __forceinline__ s16x4 vtr(NLAS const unsigned char* p) { return __builtin_bit_cast(s16x4, __builtin_amdgcn_ds_read_tr16_b64_v4i16((NLAS v4i16_t*)p)); }
__device__ __forceinline__ void pv(f32x16* o, NLAS const unsigned char* Vslot, const f32x16& p0, const f32x16& p1, int lane, int hi) {
    u32x4 w0 = {pk(p0[0], p0[1]), pk(p0[2], p0[3]), pk(p0[4], p0[5]), pk(p0[6], p0[7])};
    u32x4 w1 = {pk(p0[8], p0[9]), pk(p0[10], p0[11]), pk(p0[12], p0[13]), pk(p0[14], p0[15])};
    u32x4 w2 = {pk(p1[0], p1[1]), pk(p1[2], p1[3]), pk(p1[4], p1[5]), pk(p1[6], p1[7])};
    u32x4 w3 = {pk(p1[8], p1[9]), pk(p1[10], p1[11]), pk(p1[12], p1[13]), pk(p1[14], p1[15])};
    const bf16x8 pa[4] = {__builtin_bit_cast(bf16x8, w0), __builtin_bit_cast(bf16x8, w1), __builtin_bit_cast(bf16x8, w2), __builtin_bit_cast(bf16x8, w3)};
    NLAS const unsigned char* vp = Vslot + ((lane >> 4) & 1) * 32 + (lane & 3) * 8 + (4 * hi + ((lane & 15) >> 2)) * 64;
#pragma unroll
    for (int d0 = 0; d0 < 2; ++d0)
#pragma unroll
        for (int ks = 0; ks < 4; ++ks) {
            const s16x4 lo = vtr(vp + d0 * 4096 + ks * 1024), hh = vtr(vp + d0 * 4096 + ks * 1024 + 512);
            const bf16x8 vf = {lo[0], lo[1], lo[2], lo[3], hh[0], hh[1], hh[2], hh[3]};
            o[d0] = __builtin_amdgcn_mfma_f32_32x32x16_bf16(pa[ks], vf, o[d0], 0, 0, 0);
        }
}
__device__ __forceinline__ void scale_rows(f32x16* o, NLAS float* wsf, float s, int r32, int hi) {
    if (hi == 0) wsf[r32] = s;
#pragma unroll
    for (int i = 0; i < 16; ++i) { const float f = wsf[crow(i, hi)]; o[0][i] *= f; o[1][i] *= f; }
}
__device__ __forceinline__ void acc_rows(f32x16* tot, const f32x16* o, NLAS float* wsf, float s, int r32, int hi) {
    if (hi == 0) wsf[32 + r32] = s;
#pragma unroll
    for (int i = 0; i < 16; ++i) { const float f = wsf[32 + crow(i, hi)]; tot[0][i] += f * o[0][i]; tot[1][i] += f * o[1][i]; }
}
__device__ __forceinline__ void softmax_step(f32x16& p0, f32x16& p1, float& m, float& l, f32x16* o, NLAS float* wsf, int r32, int hi) {
    float t = fmaxf(p0[0], p1[0]);
#pragma unroll
    for (int i = 1; i < 16; ++i) t = fmaxf(t, fmaxf(p0[i], p1[i]));
    t = xhalf_max(t);
    const float mn = fmaxf(m, t);
    const float alpha = __builtin_amdgcn_exp2f(m - mn);
    float s = 0.f;
#pragma unroll
    for (int i = 0; i < 16; ++i) { p0[i] = __builtin_amdgcn_exp2f(p0[i] - mn); p1[i] = __builtin_amdgcn_exp2f(p1[i] - mn); s += p0[i] + p1[i]; }
    l = l * alpha + s; m = mn;
    if (__any(alpha != 1.f)) scale_rows(o, wsf, alpha, r32, hi);
}

__device__ __forceinline__ void attn_tile(NLAS unsigned char* lds, bf16_t* P, const bf16_t* KC, const bf16_t* VC, int b, int g, int qt) {
    int tid = threadIdx.x; asm volatile("" : "+v"(tid));
    const int lane = tid & 63, r32 = lane & 31, hi = lane >> 5; const int wid = __builtin_amdgcn_readfirstlane(tid >> 6);
    const int head = g * 4 + (wid >> 1), qh = wid & 1, t0 = qt * 64, qi = qh * 32 + r32, blk_t = qt;
    NLAS float* wsf = (NLAS float*)(lds + L_WS) + wid * 64;
    NLAS float* imp = (NLAS float*)(lds + L_IMP);
    NLAS unsigned* selm = (NLAS unsigned*)(lds + L_SEL);
    NLAS unsigned char* slot0 = lds + L_KV; NLAS unsigned char* slot1 = lds + L_KV + 16384;
    const size_t rowbase = (size_t)b * SEQ;
    bf16_t* qrow = P + (rowbase + t0 + qi) * LDP;
    const float sl2 = exp2f(-0.5f * (float)(head + 1)) * LOG2E;
    bf16x8 qr[4];
#pragma unroll
    for (int d0 = 0; d0 < 4; ++d0) qr[d0] = *(const bf16x8*)(qrow + C_NQ + head * 64 + d0 * 16 + hi * 8);
    const float gate_c = sigmoidf_(bf2f(qrow[C_SG + head * 3 + 0])), gate_s = sigmoidf_(bf2f(qrow[C_SG + head * 3 + 1])), gate_w = sigmoidf_(bf2f(qrow[C_SG + head * 3 + 2]));
    f32x16 tot[2]; tot[0] = f32x16{}; tot[1] = f32x16{};
#define CRF(i) ((float)(((i) & 3) + 8 * ((i) >> 2)) + 4.f * (float)hiv)
#define OPAQUE_HI() int hiv = hi; asm volatile("" : "+v"(hiv))

    {
        const bf16_t* kcb = KC + ((size_t)(b * NS_G + g) * 128) * 64; const bf16_t* vcb = VC + ((size_t)(b * NS_G + g) * 128) * 64;
        const bool two = (qt >= 16);
        unsigned kof, vof; tile_offs(kof, vof, 64, wid, lane);
        dma_tile(slot0, kcb, vcb, kof, vof, wid);
        if (two) dma_tile(slot1, kcb + 64 * 64, vcb + 64 * 64, kof, vof, wid);
        __syncthreads();
        f32x16 pA0, pA1, pB0, pB1, c0, c1;
        const float s16 = sl2 * 16.f; OPAQUE_HI();
#pragma unroll
        for (int i = 0; i < 16; ++i) { c0[i] = s16 * CRF(i); c1[i] = s16 * (CRF(i) + 32.f); }
        qkt(pA0, pA1, slot0, qr, c0, c1, r32, hi);
        const int cmax = (t0 + qi - 31) >> 4;
        const int qposm = t0 + qi - 31;
#pragma unroll
        for (int i = 0; i < 16; ++i) { const int c = crow(i, hiv); if (16 * c > qposm) pA0[i] = NEG; if (16 * (c + 32) > qposm) pA1[i] = NEG; }
        if (two) {
#pragma unroll
            for (int i = 0; i < 16; ++i) { c0[i] += s16 * 64.f; c1[i] += s16 * 64.f; }
            qkt(pB0, pB1, slot1, qr, c0, c1, r32, hi);
#pragma unroll
            for (int i = 0; i < 16; ++i) { const int c = 64 + crow(i, hiv); if (16 * c > qposm) pB0[i] = NEG; if (16 * (c + 32) > qposm) pB1[i] = NEG; }
        } else { pB0 = f32x16{}; pB1 = f32x16{};
#pragma unroll
            for (int i = 0; i < 16; ++i) { pB0[i] = NEG; pB1[i] = NEG; } }
        (void)cmax;
        float mx = NEG;
#pragma unroll
        for (int i = 0; i < 16; ++i) mx = fmaxf(fmaxf(mx, fmaxf(pA0[i], pA1[i])), fmaxf(pB0[i], pB1[i]));
        mx = xhalf_max(mx);
        float s = 0.f;
#pragma unroll
        for (int i = 0; i < 16; ++i) { pA0[i] = __builtin_amdgcn_exp2f(pA0[i] - mx); pA1[i] = __builtin_amdgcn_exp2f(pA1[i] - mx); pB0[i] = __builtin_amdgcn_exp2f(pB0[i] - mx); pB1[i] = __builtin_amdgcn_exp2f(pB1[i] - mx);
            s += (pA0[i] + pA1[i]) + (pB0[i] + pB1[i]); }
        s = xhalf_sum(s);
        const float nrm = (t0 + qi >= 31) ? __builtin_amdgcn_rcpf(s) : 0.f;
#pragma unroll
        for (int i = 0; i < 16; ++i) { pA0[i] *= nrm; pA1[i] *= nrm; pB0[i] *= nrm; pB1[i] *= nrm; }
#define PSEL(L) ((L) < 4 ? pA0 : (L) < 8 ? pA1 : (L) < 12 ? pB0 : pB1)
#define MAINV(L) ((PSEL(L)[4 * ((L) & 3)] + PSEL(L)[4 * ((L) & 3) + 1]) + (PSEL(L)[4 * ((L) & 3) + 2] + 0.5f * PSEL(L)[4 * ((L) & 3) + 3]))
#define CARRY(L) (0.5f * PSEL(L)[4 * ((L) & 3) + 3])
#pragma unroll
        for (int L = 0; L < 16; ++L) {
            const float cprev = (L > 0) ? CARRY(L > 0 ? L - 1 : 0) : 0.f;
            const float snd = hi ? cprev : CARRY(L);
            const float rcv = __shfl_xor(snd, 32);
            imp[((wid >> 1) * 64 + qi) * 32 + 2 * L + hi] = MAINV(L) + rcv;
        }
#undef PSEL
#undef MAINV
#undef CARRY
        f32x16 o[2]; o[0] = f32x16{}; o[1] = f32x16{};
        pv(o, slot0 + 8192, pA0, pA1, lane, hi);
        if (two) pv(o, slot1 + 8192, pB0, pB1, lane, hi);
        acc_rows(tot, o, wsf, gate_c, r32, hi);
    }
    __syncthreads();
    if (wid == 0) {
        float v[32];
#pragma unroll
        for (int j = 0; j < 32; ++j) v[j] = (imp[(0 * 64 + lane) * 32 + j] + imp[(1 * 64 + lane) * 32 + j]) + (imp[(2 * 64 + lane) * 32 + j] + imp[(3 * 64 + lane) * 32 + j]);
        unsigned mask = 1u | (1u << blk_t);
#pragma unroll 1
        for (int it = 0; it < 6; ++it) {
            float best = -1.f; int bj = -1;
#pragma unroll
            for (int j = 1; j < 32; ++j) { const bool ok = (j < blk_t) && !((mask >> j) & 1u); if (ok && v[j] > best) { best = v[j]; bj = j; } }
            if (bj >= 0) mask |= 1u << bj;
        }
        selm[lane] = mask;
        unsigned any = mask;
#pragma unroll
        for (int o_ = 1; o_ < 64; o_ <<= 1) any |= __shfl_xor(any, o_);
        if (lane == 0) selm[64] = any;
    }
    __syncthreads();
    const unsigned mymask = selm[qi];
    const unsigned anym = (unsigned)__builtin_amdgcn_readfirstlane((int)selm[64]);
    unsigned kofP, vofP; tile_offs(kofP, vofP, LDP, wid, lane);
    {
        const bf16_t* kb = P + rowbase * LDP + C_KS + g * 64; const bf16_t* vb = P + rowbase * LDP + C_VS + g * 64;
        unsigned todo = anym;
        float m = NEG, l = 0.f; f32x16 o[2]; o[0] = f32x16{}; o[1] = f32x16{};
        int j = __builtin_ctz(todo); todo &= todo - 1;
        dma_tile(slot0, kb + (size_t)j * 64 * LDP, vb + (size_t)j * 64 * LDP, kofP, vofP, wid);
        int cur = 0;
        __syncthreads();
        for (;;) {
            const int jn = todo ? __builtin_ctz(todo) : -1; if (todo) todo &= todo - 1;
            NLAS unsigned char* sc = cur ? slot1 : slot0; NLAS unsigned char* sn = cur ? slot0 : slot1;
            if (jn >= 0) dma_tile(sn, kb + (size_t)jn * 64 * LDP, vb + (size_t)jn * 64 * LDP, kofP, vofP, wid);
            const bool mine = (mymask >> j) & 1u;
            if (__any(mine)) {
                f32x16 p0, p1, c0, c1; const float kb0 = sl2 * (float)(j * 64 - t0); OPAQUE_HI();
#pragma unroll
                for (int i = 0; i < 16; ++i) { c0[i] = kb0 + sl2 * CRF(i); c1[i] = c0[i] + sl2 * 32.f; }
                qkt(p0, p1, sc, qr, c0, c1, r32, hi);
                if (j == blk_t) {
#pragma unroll
                    for (int i = 0; i < 16; ++i) { const int kk = crow(i, hiv); if (kk > qi) p0[i] = NEG; if (kk + 32 > qi) p1[i] = NEG; }
                }
                if (!mine) {
#pragma unroll
                    for (int i = 0; i < 16; ++i) { p0[i] = NEG; p1[i] = NEG; }
                }
                softmax_step(p0, p1, m, l, o, wsf, r32, hi);
                pv(o, sc + 8192, p0, p1, lane, hi);
            }
            __syncthreads();
            if (jn < 0) break;
            j = jn; cur ^= 1;
        }
        l = xhalf_sum(l);
        acc_rows(tot, o, wsf, gate_s * __builtin_amdgcn_rcpf(l), r32, hi);
    }
    {
        const bf16_t* kb = P + rowbase * LDP + C_KW + g * 64; const bf16_t* vb = P + rowbase * LDP + C_VW + g * 64;
        float m = NEG, l = 0.f; f32x16 o[2]; o[0] = f32x16{}; o[1] = f32x16{};
        int j = blk_t; const int jlast = blk_t >= 4 ? blk_t - 4 : 0;
        dma_tile(slot0, kb + (size_t)j * 64 * LDP, vb + (size_t)j * 64 * LDP, kofP, vofP, wid);
        int cur = 0;
        __syncthreads();
        for (;;) {
            const int jn = (j > jlast) ? j - 1 : -1;
            NLAS unsigned char* sc = cur ? slot1 : slot0; NLAS unsigned char* sn = cur ? slot0 : slot1;
            if (jn >= 0) dma_tile(sn, kb + (size_t)jn * 64 * LDP, vb + (size_t)jn * 64 * LDP, kofP, vofP, wid);
            {
                f32x16 p0, p1, c0, c1; const float kb0 = sl2 * (float)(j * 64 - t0); OPAQUE_HI();
#pragma unroll
                for (int i = 0; i < 16; ++i) { c0[i] = kb0 + sl2 * CRF(i); c1[i] = c0[i] + sl2 * 32.f; }
                qkt(p0, p1, sc, qr, c0, c1, r32, hi);
                if (j == blk_t || j == blk_t - 4) {
                    const int dq = t0 + qi - j * 64;
#pragma unroll
                    for (int i = 0; i < 16; ++i) { const int d0_ = dq - crow(i, hiv), d1_ = d0_ - 32; if (d0_ < 0 || d0_ > 255) p0[i] = NEG; if (d1_ < 0 || d1_ > 255) p1[i] = NEG; }
                }
                softmax_step(p0, p1, m, l, o, wsf, r32, hi);
                pv(o, sc + 8192, p0, p1, lane, hi);
            }
            __syncthreads();
            if (jn < 0) break;
            j = jn; cur ^= 1;
        }
        l = xhalf_sum(l);
        acc_rows(tot, o, wsf, gate_w * __builtin_amdgcn_rcpf(l), r32, hi);
    }
    {
        NLAS bf16_t* stg = (NLAS bf16_t*)(lds + L_OST) + wid * 2048;
#pragma unroll
        for (int i = 0; i < 16; ++i) { const int orow = crow(i, hi); stg[orow * 64 + r32] = f2bf(tot[0][i]); stg[orow * 64 + 32 + r32] = f2bf(tot[1][i]); }
        bf16_t* ow = P + (rowbase + t0 + qh * 32) * LDP + C_NQ + head * 64;
#pragma unroll
        for (int i = 0; i < 4; ++i) { const int row = i * 8 + (lane >> 3), ch = lane & 7; const u32x4 v = *(NLAS const u32x4*)(stg + row * 64 + ch * 8); *(u32x4*)((char*)ow + (unsigned)(row * LDP + ch * 8) * 2u) = v; }
    }
    __syncthreads();
#undef CRF
#undef OPAQUE_HI
}

__device__ __forceinline__ void prep_units(bf16_t* P, const float* qn, const float* kns, const float* knw, int gw, int NGW, int lane) {
    for (int unit = gw; unit < M * 24; unit += NGW) {
        const int m = unit / 24, r = unit % 24;
        bf16_t* p; const float* g; float sc = 1.f;
        if (r < 16) { p = P + (size_t)m * LDP + C_NQ + r * 64; g = qn; sc = 0.125f * LOG2E; }
        else if (r < 20) { p = P + (size_t)m * LDP + C_KS + (r - 16) * 64; g = kns; }
        else { p = P + (size_t)m * LDP + C_KW + (r - 20) * 64; g = knw; }
        const float a = bf2f(p[lane]);
        float s = a * a;
#pragma unroll
        for (int o = 32; o > 0; o >>= 1) s += __shfl_xor(s, o);
        p[lane] = f2bf(a * rsqrtf(s * (1.f / 64.f) + EPS) * g[lane] * sc);
    }
}

constexpr int LC_HID = 0;
__device__ __forceinline__ void compress_item(NLAS unsigned char* lds, const bf16_t* P, const bf16_t* W1T, const float* bias1, const float* W2, const float* gain, bf16_t* OUT, int b, int g, int which, int half) {
    const int tid = threadIdx.x, lane = tid & 63, r32 = lane & 31, hi = lane >> 5; const int wid = __builtin_amdgcn_readfirstlane(tid >> 6);
    const int mt = wid >> 2, nt = wid & 3;
    const int c = 64 * half + 32 * mt + r32;
    const int cc = c < NCMP ? c : NCMP - 1;
    const bf16_t* arow = P + ((size_t)b * SEQ + 16 * cc) * LDP + (which ? C_VC : C_KC) + g * 64 + hi * 8;
    const bf16_t* brow = W1T + (size_t)(32 * nt + r32) * 2048 + hi * 8;
    f32x16 acc = f32x16{};
#pragma unroll 4
    for (int l = 0; l < 32; ++l) {
#pragma unroll
        for (int ds = 0; ds < 4; ++ds) {
            const bf16x8 a = *(const bf16x8*)(arow + (size_t)l * LDP + ds * 16);
            const bf16x8 w = *(const bf16x8*)(brow + l * 64 + ds * 16);
            acc = __builtin_amdgcn_mfma_f32_32x32x16_bf16(a, w, acc, 0, 0, 0);
        }
    }
    NLAS float* hid = (NLAS float*)(lds + LC_HID);
    const float bs = bias1[32 * nt + r32];
#pragma unroll
    for (int i = 0; i < 16; ++i) hid[(32 * mt + crow(i, hi)) * 132 + 32 * nt + r32] = gelu_tanh(acc[i] + bs);
    __syncthreads();
    {
        const int row = tid >> 3, e0 = (tid & 7) * 8;
        float o[8];
#pragma unroll
        for (int e = 0; e < 8; ++e) o[e] = 0.f;
        for (int i = 0; i < 128; ++i) { const float h = hid[row * 132 + i]; const f32x4 wa = *(const f32x4*)(W2 + i * 64 + e0), wb = *(const f32x4*)(W2 + i * 64 + e0 + 4);
            o[0] += h * wa[0]; o[1] += h * wa[1]; o[2] += h * wa[2]; o[3] += h * wa[3]; o[4] += h * wb[0]; o[5] += h * wb[1]; o[6] += h * wb[2]; o[7] += h * wb[3]; }
        if (which == 0) {
            float ss = 0.f;
#pragma unroll
            for (int e = 0; e < 8; ++e) ss += o[e] * o[e];
            ss += __shfl_xor(ss, 1); ss += __shfl_xor(ss, 2); ss += __shfl_xor(ss, 4);
            const float r = rsqrtf(ss * (1.f / 64.f) + EPS);
#pragma unroll
            for (int e = 0; e < 8; ++e) o[e] *= r * gain[e0 + e];
        }
        const int cg = 64 * half + row;
        if (cg >= NCMP) {
#pragma unroll
            for (int e = 0; e < 8; ++e) o[e] = 0.f; }
        u32x4 w; w.x = pk(o[0], o[1]); w.y = pk(o[2], o[3]); w.z = pk(o[4], o[5]); w.w = pk(o[6], o[7]);
        *(u32x4*)(OUT + (((size_t)(b * NS_G + g) * 128) + cg) * 64 + e0) = w;
    }
    __syncthreads();
}
}
namespace pg8 {
#define PG8_LAS __attribute__((address_space(3)))
typedef short bf16x8 __attribute__((ext_vector_type(8)));
typedef float f32x4 __attribute__((ext_vector_type(4)));
typedef float f32x2 __attribute__((ext_vector_type(2)));
typedef unsigned u32x4 __attribute__((ext_vector_type(4)));
typedef unsigned u32x2 __attribute__((ext_vector_type(2)));
constexpr int BM = 256, BK = 64, HALF = 128, HTB = HALF * BK * 2, STAGE_BYTES = 8 * HTB, NXCD = 8, WGM = 8;

__host__ __device__ __forceinline__ int lds_byte(int r, int c) { const int st = (r >> 4) * 2 + (c >> 5), rr = r & 15, cc = c & 31, ob = rr * 64 + cc * 2; return st * 1024 + (ob ^ (((ob >> 9) & 1) << 5)); }
__host__ __device__ __forceinline__ void stage_rc(int b, int& R, int& C) { const int st = b / 1024, sb = b % 1024, swz = sb ^ (((sb >> 9) & 1) << 5); R = (st >> 1) * 16 + swz / 64; C = (st & 1) * 32 + (swz % 64) / 2; }
__host__ __device__ __forceinline__ int perm32(int rho) { const int n = rho >> 4, i = rho & 15; return 8 * (i >> 2) + 4 * n + (i & 3); }

struct Unit { int pm, pn, ks; };
struct Gemm { const bf16_t* A; const bf16_t* Bt; int lda, ldb; int M, N, K; int ksoff; };

struct StaticOrder {
    int nM, nN, nwg, G, c;
    __host__ __device__ void init(int M_, int N_, int G_, int c_) { nM = M_ / BM; nN = N_ / BM; nwg = nM * nN; G = G_; c = c_; }
    __host__ __device__ bool next(int i, Unit& u) const {
        const long L = (long)i * G + c; if (L >= nwg) return false;
        int wgid = (int)L; { const int q = nwg / NXCD, r = nwg % NXCD, xcd = wgid % NXCD, off = wgid / NXCD; wgid = (xcd < r ? xcd * (q + 1) : r * (q + 1) + (xcd - r) * q) + off; }
        const int nig = WGM * nN, gid = wgid / nig, fm = gid * WGM, gsz = (nM - fm) < WGM ? (nM - fm) : WGM;
        u.pm = fm + ((wgid % nig) % gsz); u.pn = (wgid % nig) / gsz; u.ks = 0; return true;
    }
};
struct TwoPassOrder {
    StaticOrder base;
    __host__ __device__ bool next(int i, Unit& u) const { if (!base.next(i >> 1, u)) return false; u.ks = i & 1; return true; }
};

typedef __bf16 bf16x2_t __attribute__((ext_vector_type(2)));
__device__ __forceinline__ unsigned cvt_pk_bf16(float lo, float hi) { f32x2 v = {lo, hi}; bf16x2_t b = __builtin_convertvector(v, bf16x2_t); return __builtin_bit_cast(unsigned, b); }
__device__ __forceinline__ float fast_sigmoid(float x) { return __builtin_amdgcn_rcpf(1.f + __builtin_amdgcn_exp2f(-1.4426950408889634f * x)); }
__device__ __forceinline__ float bflo(unsigned w) { return __uint_as_float(w << 16); }
__device__ __forceinline__ float bfhi(unsigned w) { return __uint_as_float(w & 0xffff0000u); }

typedef f32x4 Acc[2][2][4][2];

template <int ACT> struct EpiP {
    static constexpr bool PERM = true;
    bf16_t* O; int ldc; int pn_last; int ncol_last; bf16_t* halo;
    __device__ __forceinline__ void operator()(const Acc& acc, const Unit& u, int wr, int wc, int fr, int fq) const {
        const int row0 = u.pm * BM + wr * 64 + fr, tcol = wc * 32 + 8 * fq;
        const int lim = (u.pn == pn_last) ? ncol_last : 256;
#pragma unroll
        for (int ai = 0; ai < 2; ++ai)
#pragma unroll
            for (int m = 0; m < 4; ++m) { bf16_t* rowp = O + (size_t)(row0 + ai * HALF + m * 16) * ldc + u.pn * BM + tcol;
#pragma unroll
                for (int bj = 0; bj < 2; ++bj) { if (tcol + bj * HALF >= lim) continue;
                    f32x4 v0 = acc[ai][bj][m][0], v1 = acc[ai][bj][m][1];
                    if (ACT == 1) {
#pragma unroll
                        for (int e = 0; e < 4; ++e) { v0[e] = fast_sigmoid(v0[e]); v1[e] = fast_sigmoid(v1[e]); } }
                    u32x4 w; w.x = cvt_pk_bf16(v0[0], v0[1]); w.y = cvt_pk_bf16(v0[2], v0[3]); w.z = cvt_pk_bf16(v1[0], v1[1]); w.w = cvt_pk_bf16(v1[2], v1[3]);
                    *(u32x4*)(rowp + bj * HALF) = w;
                    if (ACT == 0 && m == 3 && fr >= 13 && u.pn < 12 && halo) { const int row = row0 + ai * HALF + 48;
                        *(u32x4*)(halo + ((size_t)(row >> 6) * 3 + (fr - 13)) * 3072 + u.pn * BM + tcol + bj * HALF) = w; } } }
    }
};
struct EpiMix {
    static constexpr bool PERM = true;
    const bf16_t* G; int ldg; bf16_t* O; int ldc;
    __device__ __forceinline__ void operator()(const Acc& acc, const Unit& u, int wr, int wc, int fr, int fq) const {
        const int row0 = u.pm * BM + wr * 64 + fr, col0 = u.pn * BM + wc * 32 + 8 * fq;
#pragma unroll
        for (int ai = 0; ai < 2; ++ai)
#pragma unroll
            for (int m = 0; m < 4; ++m) { const size_t row = (size_t)(row0 + ai * HALF + m * 16); const bf16_t* gp = G + row * ldg + col0 + u.ks * 1024; bf16_t* rowp = O + row * ldc + col0;
#pragma unroll
                for (int bj = 0; bj < 2; ++bj) { const u32x4 b = *(const u32x4*)(gp + bj * HALF);
                    f32x4 v0 = acc[ai][bj][m][0], v1 = acc[ai][bj][m][1];
                    v0[0] *= bflo(b.x); v0[1] *= bfhi(b.x); v0[2] *= bflo(b.y); v0[3] *= bfhi(b.y); v1[0] *= bflo(b.z); v1[1] *= bfhi(b.z); v1[2] *= bflo(b.w); v1[3] *= bfhi(b.w);
                    if (u.ks) { const u32x4 p = *(const u32x4*)(rowp + bj * HALF);
                        v0[0] += bflo(p.x); v0[1] += bfhi(p.x); v0[2] += bflo(p.y); v0[3] += bfhi(p.y); v1[0] += bflo(p.z); v1[1] += bfhi(p.z); v1[2] += bflo(p.w); v1[3] += bfhi(p.w); }
                    u32x4 w; w.x = cvt_pk_bf16(v0[0], v0[1]); w.y = cvt_pk_bf16(v0[2], v0[3]); w.z = cvt_pk_bf16(v1[0], v1[1]); w.w = cvt_pk_bf16(v1[2], v1[3]);
                    *(u32x4*)(rowp + bj * HALF) = w; } }
    }
};
struct EpiOut {
    static constexpr bool PERM = false;
    const float* X; float* X1; bf16_t* An; const float* gain; float* pss;
    __device__ __forceinline__ void operator()(const Acc& acc, const Unit& u, int wr, int wc, int fr, int fq) const {
        const int row0 = u.pm * BM + wr * 64 + fr, col0 = u.pn * BM + wc * 32 + 4 * fq;
        f32x4 gv[2][2];
#pragma unroll
        for (int bj = 0; bj < 2; ++bj)
#pragma unroll
            for (int n = 0; n < 2; ++n) gv[bj][n] = *(const f32x4*)(gain + col0 + bj * HALF + n * 16);
#pragma unroll
        for (int ai = 0; ai < 2; ++ai)
#pragma unroll
            for (int m = 0; m < 4; ++m) { const size_t row = (size_t)(row0 + ai * HALF + m * 16); const size_t off = row * D + col0; float ss = 0.f;
#pragma unroll
                for (int bj = 0; bj < 2; ++bj)
#pragma unroll
                    for (int n = 0; n < 2; ++n) { const f32x4 x1 = *(const f32x4*)(X + off + bj * HALF + n * 16) + acc[ai][bj][m][n];
                        *(f32x4*)(X1 + off + bj * HALF + n * 16) = x1; ss += (x1[0] * x1[0] + x1[1] * x1[1]) + (x1[2] * x1[2] + x1[3] * x1[3]);
                        const f32x4 y = x1 * gv[bj][n]; u32x2 w; w.x = cvt_pk_bf16(y[0], y[1]); w.y = cvt_pk_bf16(y[2], y[3]); *(u32x2*)(An + off + bj * HALF + n * 16) = w; }
                ss += __shfl_xor(ss, 16); ss += __shfl_xor(ss, 32);
                if (fq == 0) pss[row * 16 + u.pn * 4 + wc] = ss; }
    }
};
struct EpiUp {
    static constexpr bool PERM = true;
    const float* pss; bf16_t* O; int ldc;
    __device__ __forceinline__ void operator()(const Acc& acc, const Unit& u, int wr, int wc, int fr, int fq) const {
        const int row0 = u.pm * BM + wr * 64 + fr, col0 = u.pn * BM + wc * 32 + 8 * fq;
#pragma unroll
        for (int ai = 0; ai < 2; ++ai)
#pragma unroll
            for (int m = 0; m < 4; ++m) { const size_t row = (size_t)(row0 + ai * HALF + m * 16);
                const f32x4* pp = (const f32x4*)(pss + row * 16); const f32x4 s4 = (pp[0] + pp[1]) + (pp[2] + pp[3]);
                const float rstd = rsqrtf(((s4[0] + s4[1]) + (s4[2] + s4[3])) * (1.f / D) + EPS);
                bf16_t* rowp = O + row * ldc + col0;
#pragma unroll
                for (int bj = 0; bj < 2; ++bj) { f32x4 v0 = acc[ai][bj][m][0] * rstd, v1 = acc[ai][bj][m][1] * rstd;
#pragma unroll
                    for (int e = 0; e < 4; ++e) { const float a = fmaxf(v0[e], 0.f), b = fmaxf(v1[e], 0.f); v0[e] = a * a; v1[e] = b * b; }
                    u32x4 w; w.x = cvt_pk_bf16(v0[0], v0[1]); w.y = cvt_pk_bf16(v0[2], v0[3]); w.z = cvt_pk_bf16(v1[0], v1[1]); w.w = cvt_pk_bf16(v1[2], v1[3]);
                    *(u32x4*)(rowp + bj * HALF) = w; } }
    }
};
struct EpiDown {
    static constexpr bool PERM = false;
    float* X1;
    __device__ __forceinline__ void operator()(const Acc& acc, const Unit& u, int wr, int wc, int fr, int fq) const {
        const int row0 = u.pm * BM + wr * 64 + fr, col0 = u.pn * BM + wc * 32 + 4 * fq;
#pragma unroll
        for (int ai = 0; ai < 2; ++ai)
#pragma unroll
            for (int m = 0; m < 4; ++m) { float* rowp = X1 + (size_t)(row0 + ai * HALF + m * 16) * D + col0;
#pragma unroll
                for (int bj = 0; bj < 2; ++bj)
#pragma unroll
                    for (int n = 0; n < 2; ++n) { f32x4* p = (f32x4*)(rowp + bj * HALF + n * 16); *p = *p + acc[ai][bj][m][n]; } }
    }
};

template <class Epi, class Sched, bool ALIGN_EPI>
__device__ __forceinline__ void gemm_phase(PG8_LAS unsigned char* lds, const Gemm g, const Sched& S, const Epi& E) {
    const int tid = threadIdx.x, wid = __builtin_amdgcn_readfirstlane(tid >> 6), lane = tid & 63, wr = wid >> 2, wc = wid & 3, fr = lane & 15, fq = lane >> 4;
    const int K = g.K, nt = K / BK, lda = g.lda, ldb = g.ldb;
    unsigned voffA[2], voffB[2];
#pragma unroll
    for (int i = 0; i < 2; ++i) { int R, C; stage_rc(tid * 16 + i * 8192, R, C); const int Rb = Epi::PERM ? ((R & ~31) + perm32(R & 31)) : R;
        voffA[i] = (unsigned)(R * lda + C) * 2u; voffB[i] = (unsigned)(Rb * ldb + C) * 2u; }
    const size_t kstep = (size_t)(BK * 2);
    const size_t hstepA = (size_t)HALF * lda * 2, hstepB = (size_t)HALF * ldb * 2;
    const size_t tstepA = 2 * hstepA, tstepB = 2 * hstepB;
    const unsigned ldsw = (unsigned)wid * 1024u;
    const int aoff = lds_byte(wr * 64 + fr, fq * 8), boff = lds_byte(wc * 32 + fr, fq * 8);
#define PG8_SA(b, h) (((b) * 2 + (h)) * HTB)
#define PG8_SB(b, h) ((4 + (b) * 2 + (h)) * HTB)
#define PG8_STAGE(bufoff, gbase, voff) do { _Pragma("unroll") for (int _i = 0; _i < 2; ++_i) \
        __builtin_amdgcn_global_load_lds((const unsigned*)((const char*)(gbase) + (voff)[_i]), (PG8_LAS unsigned*)(lds + (bufoff) + ldsw + _i * 8192), 16, 0, 0); } while (0)
#define PG8_LDA(dst, b, h) do { _Pragma("unroll") for (int m = 0; m < 4; ++m) _Pragma("unroll") for (int k = 0; k < 2; ++k) dst[m][k] = *(const PG8_LAS bf16x8*)(lds + PG8_SA(b, h) + aoff + m * 2048 + k * 1024); } while (0)
#define PG8_LDB(dst, b, h) do { _Pragma("unroll") for (int n = 0; n < 2; ++n) _Pragma("unroll") for (int k = 0; k < 2; ++k) dst[n][k] = *(const PG8_LAS bf16x8*)(lds + PG8_SB(b, h) + boff + n * 2048 + k * 1024); } while (0)
#define PG8_MMA(ai, bj, At, Bt) do { __builtin_amdgcn_s_setprio(1); _Pragma("unroll") for (int m = 0; m < 4; ++m) _Pragma("unroll") for (int n = 0; n < 2; ++n) _Pragma("unroll") for (int k = 0; k < 2; ++k) \
        acc[ai][bj][m][n] = __builtin_amdgcn_mfma_f32_16x16x32_bf16(Bt[n][k], At[m][k], acc[ai][bj][m][n], 0, 0, 0); __builtin_amdgcn_s_setprio(0); } while (0)
#define PG8_WAIT_V(n) asm volatile("s_waitcnt vmcnt(" #n ")" ::: "memory")
#define PG8_WAIT_L(n) asm volatile("s_waitcnt lgkmcnt(" #n ")" ::: "memory")
#define PG8_BAR __builtin_amdgcn_s_barrier()
#define PG8_SCHED __builtin_amdgcn_sched_barrier(0)
#define PG8_KBODY(t) do { \
            const bool last = (t == nt - 2); \
            const char* a1 = cA + (size_t)(t + 1) * kstep; \
            const char* a2 = last ? nA : cA + (size_t)(t + 2) * kstep; const char* b2 = last ? nB : cB + (size_t)(t + 2) * kstep; \
            const char* a3 = a2 + kstep; const char* b3 = b2 + kstep; \
            PG8_LDB(B0, 0, 0); PG8_LDB(B1, 0, 1); PG8_SCHED; PG8_LDA(At, 0, 0); PG8_STAGE(PG8_SA(1, 1), a1 + hstepA, voffA); \
            PG8_WAIT_V(8); PG8_WAIT_L(0); PG8_BAR; PG8_MMA(0, 0, At, B0); PG8_MMA(0, 1, At, B1); PG8_BAR; PG8_SCHED; \
            PG8_LDA(At, 0, 1); PG8_STAGE(PG8_SB(0, 0), b2, voffB); PG8_STAGE(PG8_SB(0, 1), b2 + hstepB, voffB); PG8_STAGE(PG8_SA(0, 0), a2, voffA); \
            PG8_WAIT_V(8); PG8_WAIT_L(0); PG8_BAR; PG8_MMA(1, 0, At, B0); PG8_MMA(1, 1, At, B1); PG8_BAR; PG8_SCHED; \
            PG8_LDB(B0, 1, 0); PG8_LDB(B1, 1, 1); PG8_SCHED; PG8_LDA(At, 1, 0); PG8_STAGE(PG8_SA(0, 1), a2 + hstepA, voffA); \
            PG8_WAIT_V(8); PG8_WAIT_L(0); PG8_BAR; PG8_MMA(0, 0, At, B0); PG8_MMA(0, 1, At, B1); PG8_BAR; PG8_SCHED; \
            PG8_LDA(At, 1, 1); PG8_STAGE(PG8_SB(1, 0), b3, voffB); PG8_STAGE(PG8_SB(1, 1), b3 + hstepB, voffB); PG8_STAGE(PG8_SA(1, 0), a3, voffA); \
            PG8_WAIT_V(8); PG8_WAIT_L(0); PG8_BAR; PG8_MMA(1, 0, At, B0); PG8_MMA(1, 1, At, B1); PG8_BAR; PG8_SCHED; \
        } while (0)
    Unit cur, nxt; int ui = 0;
    if (!S.next(0, cur)) return;
    Acc acc;
#pragma unroll
    for (int a = 0; a < 2; ++a)
#pragma unroll
        for (int b = 0; b < 2; ++b)
#pragma unroll
            for (int m = 0; m < 4; ++m)
#pragma unroll
                for (int n = 0; n < 2; ++n) acc[a][b][m][n] = (f32x4){0.f, 0.f, 0.f, 0.f};
    bf16x8 At[4][2], B0[2][2], B1[2][2];
    const char* cA = (const char*)g.A + (size_t)cur.pm * tstepA + (size_t)cur.ks * g.ksoff * 2; const char* cB = (const char*)g.Bt + (size_t)cur.pn * tstepB + (size_t)cur.ks * g.ksoff * 2;
    PG8_STAGE(PG8_SB(0, 0), cB, voffB); PG8_STAGE(PG8_SB(0, 1), cB + hstepB, voffB); PG8_STAGE(PG8_SA(0, 0), cA, voffA); PG8_STAGE(PG8_SA(0, 1), cA + hstepA, voffA);
    if (wr == 1) PG8_BAR;
    PG8_WAIT_V(2); PG8_BAR;
    PG8_STAGE(PG8_SB(1, 0), cB + kstep, voffB); PG8_STAGE(PG8_SA(1, 0), cA + kstep, voffA); PG8_STAGE(PG8_SB(1, 1), cB + hstepB + kstep, voffB);
    PG8_WAIT_V(6); PG8_BAR;
    for (;;) {
        const bool has_next = S.next(ui + 1, nxt);
        const char* nA = has_next ? (const char*)g.A + (size_t)nxt.pm * tstepA + (size_t)nxt.ks * g.ksoff * 2 : cA; const char* nB = has_next ? (const char*)g.Bt + (size_t)nxt.pn * tstepB + (size_t)nxt.ks * g.ksoff * 2 : cB;
        for (int t = 0; t < nt; t += 2) PG8_KBODY(t);
        if constexpr (ALIGN_EPI) { if (wr == 0) PG8_BAR; }
        E(acc, cur, wr, wc, fr, fq);
        if (!has_next) break;
#pragma unroll
        for (int a = 0; a < 2; ++a)
#pragma unroll
            for (int b = 0; b < 2; ++b)
#pragma unroll
                for (int m = 0; m < 4; ++m)
#pragma unroll
                    for (int n = 0; n < 2; ++n) acc[a][b][m][n] = (f32x4){0.f, 0.f, 0.f, 0.f};
        cur = nxt; cA = nA; cB = nB; ++ui;
        if constexpr (ALIGN_EPI) { if (wr == 1) PG8_BAR; }
    }
    PG8_WAIT_V(0);
    if constexpr (!ALIGN_EPI) { if (wr == 0) PG8_BAR; }
    PG8_BAR;
#undef PG8_SA
#undef PG8_SB
#undef PG8_STAGE
#undef PG8_LDA
#undef PG8_LDB
#undef PG8_MMA
#undef PG8_WAIT_V
#undef PG8_WAIT_L
#undef PG8_BAR
#undef PG8_SCHED
#undef PG8_KBODY
}
}

#define GAS __attribute__((address_space(1)))
#define LAS __attribute__((address_space(3)))
typedef unsigned v4u __attribute__((ext_vector_type(4)));
typedef float f32x4 __attribute__((ext_vector_type(4)));
constexpr int NWAVES = 8;
constexpr int LDS_BYTES = 147456;
constexpr size_t MiB = 1u << 20;
constexpr size_t WS_PSS = 1 * MiB, WS_WOUT = 2 * MiB, WS_P = 4 * MiB, WS_KC = 214 * MiB, WS_VC = 215 * MiB, WS_MIX = 216 * MiB;
constexpr size_t WS_AN = 4 * MiB, WS_UP = 64 * MiB, WS_WUP = 192 * MiB, WS_WDOWN = 200 * MiB;
constexpr size_t WS_BIAS1 = 0, WS_W1T = 214 * MiB, WS_KCB = 215 * MiB, WS_VCB = 215 * MiB + 512 * 1024;
constexpr size_t WS_GLV = 4096, WS_QCNT = 65536, WS_GW = 216 * MiB, DO_GQK = 40 * MiB, DO_HALO = 56 * MiB;
constexpr size_t DO_H = 0, DO_WG = 32 * MiB, DO_WCAT = 36 * MiB, DO_WIN = 40 * MiB;

__device__ __forceinline__ unsigned pk2(float lo, float hi) { return (unsigned)f2bf(lo) | ((unsigned)f2bf(hi) << 16); }
__device__ __forceinline__ float wave_sum(float v) {
#pragma unroll
    for (int o = 1; o < 64; o <<= 1) v += __shfl_xor(v, o);
    return v;
}
template <class SrcCol>
__device__ __forceinline__ void transpose_item(const float* W, int ldw, const SrcCol& srccol, bf16_t* WT, int ldk, int kofs, LAS float* scr, int kb, int nb, int lane) {
    const int k0 = 64 * kb, n0 = 32 * nb; const int sc = srccol(n0 + (lane & 31));
#pragma unroll 8
    for (int i = 0; i < 32; ++i) { const int kk = 2 * i + (lane >> 5); scr[kk * 33 + (lane & 31)] = (sc >= 0) ? W[(size_t)(k0 + kk) * ldw + sc] : 0.f; }
    asm volatile("s_waitcnt lgkmcnt(0)" ::: "memory");
    const int c = lane & 7;
#pragma unroll
    for (int j = 0; j < 4; ++j) { const int n = (lane >> 3) + 8 * j; const LAS float* s = scr + (8 * c) * 33 + n;
        v4u o; o.x = pk2(s[0 * 33], s[1 * 33]); o.y = pk2(s[2 * 33], s[3 * 33]); o.z = pk2(s[4 * 33], s[5 * 33]); o.w = pk2(s[6 * 33], s[7 * 33]);
        *(v4u*)(WT + (size_t)(n0 + n) * ldk + kofs + k0 + 8 * c) = o; }
    asm volatile("s_waitcnt lgkmcnt(0)" ::: "memory");
}
struct SrcIdent { int off; __device__ __forceinline__ int operator()(int n) const { return n + off; } };
struct SrcWin { __device__ __forceinline__ int operator()(int n) const { return n < 4096 ? n : (n < 6656 ? n + 16 : (n < 6672 ? n - 6656 + 4096 : (n < 6720 ? n : -1))); } };

struct Args { const float* in[23]; float* out; unsigned char* ws; int ph_lo, ph_hi; };

__global__ void __launch_bounds__(NWAVES * 64, 2) mk_fwd(Args args) {
    extern __shared__ __attribute__((aligned(16))) unsigned char lds_raw[];
    LAS unsigned char* lds = (LAS unsigned char*)lds_raw;
    cg::grid_group grid = cg::this_grid();
    const int tid = threadIdx.x, lane = tid & 63, wave = __builtin_amdgcn_readfirstlane(tid >> 6);
    const int G = gridDim.x, gw = blockIdx.x * NWAVES + wave, NGW = G * NWAVES;
    unsigned char* ws = args.ws; unsigned char* dob = (unsigned char*)args.out;
    const float* x = args.in[0];
    bf16_t* P = (bf16_t*)(ws + WS_P);
    bf16_t* Hb = (bf16_t*)(dob + DO_H); bf16_t* Wg_t = (bf16_t*)(dob + DO_WG); bf16_t* Wcat_t = (bf16_t*)(dob + DO_WCAT); bf16_t* Win_t = (bf16_t*)(dob + DO_WIN);
    bf16_t* Wout_t = (bf16_t*)(ws + WS_WOUT); bf16_t* Wup_t = (bf16_t*)(ws + WS_WUP); bf16_t* Wdown_t = (bf16_t*)(ws + WS_WDOWN);
    bf16_t* Mix = (bf16_t*)(ws + WS_MIX); bf16_t* An = (bf16_t*)(ws + WS_AN); bf16_t* Up = (bf16_t*)(ws + WS_UP); float* pss = (float*)(ws + WS_PSS);
    LAS float* scr = (LAS float*)(lds + wave * 16384);
    bf16_t* Halo = (bf16_t*)(dob + DO_HALO); bf16_t* GWb = (bf16_t*)(ws + WS_GW); bf16_t* GQKb = (bf16_t*)(dob + DO_GQK); float* GLv = (float*)(ws + WS_GLV); unsigned* qcnt = (unsigned*)(ws + WS_QCNT);
    bf16_t* W1T = (bf16_t*)(ws + WS_W1T); float* bias1 = (float*)(ws + WS_BIAS1); bf16_t* KCb = (bf16_t*)(ws + WS_KCB); bf16_t* VCb = (bf16_t*)(ws + WS_VCB);
    const int lo = args.ph_lo, hi = args.ph_hi;
#ifndef PHMASK
#define PHMASK 0x1ff
#endif
#define IN(k) (((PHMASK >> (k)) & 1) && lo <= (k) && (k) < hi)
#define GRID_SYNC() do { asm volatile("s_waitcnt vmcnt(0) lgkmcnt(0)" ::: "memory"); grid.sync(); \
        if (wave == 0) { __builtin_amdgcn_fence(__ATOMIC_ACQUIRE, "agent"); asm volatile("s_waitcnt vmcnt(0)" ::: "memory"); } __syncthreads(); } while (0)
#define SEAM(k) do { if (IN(k) && IN((k) + 1)) GRID_SYNC(); } while (0)

    if (IN(0)) {
        if (blockIdx.x == 0 && tid == 0) *qcnt = 0u;
        constexpr int I_WIN = 16 * (NP1 / 32), I_WG = 16 * 64, I_DN = 16 * 32, I_OUT = 16 * 32;
        constexpr int I_W1 = 32 * 4, I_B1 = 256;
        constexpr int NITEMS = I_WIN + I_WG + 2 * I_DN + I_OUT + 2 * I_W1 + I_B1;
        for (int it = gw; it < NITEMS; it += NGW) {
            int r = it;
            if (r < I_WIN) { transpose_item(args.in[2], INW, SrcWin{}, Win_t, D, 0, scr, r / (NP1 / 32), r % (NP1 / 32), lane); continue; } r -= I_WIN;
            if (r < I_WG) { transpose_item(args.in[2], INW, SrcIdent{6720}, Wg_t, D, 0, scr, r / 64, r % 64, lane); continue; } r -= I_WG;
            if (r < I_DN) { transpose_item(args.in[17], D, SrcIdent{0}, Wcat_t, 2 * D, 0, scr, r / 32, r % 32, lane); continue; } r -= I_DN;
            if (r < I_DN) { transpose_item(args.in[18], D, SrcIdent{0}, Wcat_t, 2 * D, D, scr, r / 32, r % 32, lane); continue; } r -= I_DN;
            if (r < I_OUT) { transpose_item(args.in[19], D, SrcIdent{0}, Wout_t, D, 0, scr, r / 32, r % 32, lane); continue; } r -= I_OUT;
            if (r < I_W1) { transpose_item(args.in[12], 128, SrcIdent{0}, W1T, 2048, 0, scr, r / 4, r % 4, lane); continue; } r -= I_W1;
            if (r < I_W1) { transpose_item(args.in[15], 128, SrcIdent{0}, W1T + 128 * 2048, 2048, 0, scr, r / 4, r % 4, lane); continue; } r -= I_W1;
            {
                const int which = r >> 7, i = r & 127; const float* pos = args.in[which ? 14 : 11]; const float* w1 = args.in[which ? 15 : 12];
                float a = 0.f;
                for (int k = lane; k < 2048; k += 64) a += pos[k] * w1[(size_t)k * 128 + i];
                a = wave_sum(a);
                if (lane == 0) bias1[r] = a;
            }
        }
        const float* gain = args.in[1];
        f32x4 gv[4];
#pragma unroll
        for (int j = 0; j < 4; ++j) gv[j] = ((const f32x4*)gain)[lane + 64 * j];
        for (int m = gw; m < M; m += NGW) {
            const f32x4* xr = (const f32x4*)(x + (size_t)m * D) + lane;
            f32x4 v[4]; float s = 0.f;
#pragma unroll
            for (int j = 0; j < 4; ++j) { v[j] = xr[64 * j]; s += (v[j].x * v[j].x + v[j].y * v[j].y) + (v[j].z * v[j].z + v[j].w * v[j].w); }
            const float rstd = rsqrtf(wave_sum(s) * (1.f / D) + EPS);
            unsigned long long* o8 = (unsigned long long*)(Hb + (size_t)m * D) + lane;
#pragma unroll
            for (int j = 0; j < 4; ++j) { const f32x4 y = v[j] * rstd * gv[j]; o8[64 * j] = (unsigned long long)pk2(y.x, y.y) | ((unsigned long long)pk2(y.z, y.w) << 32); }
        }
    }
    SEAM(0);
    if (IN(1)) {
        pg8::Gemm g{Hb, Win_t, D, D, M, NP1, D, 0}; pg8::StaticOrder S; S.init(M, NP1, G, (int)blockIdx.x);
        pg8::EpiP<0> E{P, LDP, 26, 64, Halo};
        pg8::gemm_phase<pg8::EpiP<0>, pg8::StaticOrder, true>(lds, g, S, E);
    }
    SEAM(1);
    if (IN(2)) {
        for (int it = blockIdx.x; it < 128; it += G) {
            const int half = it & 1, which = (it >> 1) & 1, g_ = (it >> 2) & 3, b_ = it >> 4;
            nsa::compress_item(lds, P, W1T + (size_t)which * 128 * 2048, bias1 + which * 128, args.in[which ? 16 : 13], args.in[8], which ? VCb : KCb, b_, g_, which, half);
        }
        nsa::prep_units(P, args.in[7], args.in[9], args.in[10], gw, NGW, lane);
#if !defined(GDN_NAIVE)
        __syncthreads();
        for (int it = blockIdx.x; it < 2048; it += G) gdn::prep_item(lds, P, Halo, args.in[3], args.in[4], args.in[5], GWb, GQKb, GLv, it >> 8, it & 31, (it >> 5) & 7);
#endif
    }
    SEAM(2);
    if (IN(3)) {
#if defined(GDN_NAIVE)
        if ((int)blockIdx.x < 16) gdn_naive::run(lds, P, args.in[3], args.in[4], args.in[5], args.in[6], 4 * (int)blockIdx.x);
#else
        if ((int)blockIdx.x < 64) gdn::scan_item(lds, P, GWb, GQKb, GLv, args.in[6], (int)blockIdx.x >> 3, (int)blockIdx.x & 7);
#endif
        __syncthreads();
        for (;;) {
            volatile LAS unsigned* qslot = (volatile LAS unsigned*)(lds + 147456 - 16);
            if (tid == 0) *qslot = atomicAdd(qcnt, 1u);
            __syncthreads();
            const int idx = (int)*qslot;
            __syncthreads();
            if (idx >= 1024) break;
            nsa::attn_tile(lds, P, KCb, VCb, (idx & 31) >> 2, idx & 3, 31 - (idx >> 5));
        }
    }
    SEAM(3);
    if (IN(4)) {
        pg8::Gemm g{Hb, Wg_t, D, D, M, 2048, D, 0}; pg8::StaticOrder S; S.init(M, 2048, G, (int)blockIdx.x);
        pg8::EpiP<1> E{P, LDP, -1, 256, nullptr};
        pg8::gemm_phase<pg8::EpiP<1>, pg8::StaticOrder, true>(lds, g, S, E);
    }
    SEAM(4);
    if (IN(5)) {
        pg8::Gemm g{P + C_DZ, Wcat_t, LDP, 2 * D, M, D, D, D}; pg8::TwoPassOrder S; S.base.init(M, D, G, (int)blockIdx.x);
        pg8::EpiMix E{P, LDP, Mix, D};
        pg8::gemm_phase<pg8::EpiMix, pg8::TwoPassOrder, false>(lds, g, S, E);
    }
    SEAM(5);
    if (IN(6)) {
        for (int it = gw; it < 16 * 128; it += NGW) transpose_item(args.in[21], FF, SrcIdent{0}, Wup_t, D, 0, scr, it / 128, it % 128, lane);
        __syncthreads();
        pg8::Gemm g{Mix, Wout_t, D, D, M, D, D, 0}; pg8::StaticOrder S; S.init(M, D, G, (int)blockIdx.x);
        pg8::EpiOut E{x, args.out, An, args.in[20], pss};
        pg8::gemm_phase<pg8::EpiOut, pg8::StaticOrder, false>(lds, g, S, E);
    }
    SEAM(6);
    if (IN(7)) {
        for (int it = gw; it < 64 * 32; it += NGW) transpose_item(args.in[22], D, SrcIdent{0}, Wdown_t, FF, 0, scr, it / 32, it % 32, lane);
        __syncthreads();
        pg8::Gemm g{An, Wup_t, D, D, M, FF, D, 0}; pg8::StaticOrder S; S.init(M, FF, G, (int)blockIdx.x);
        pg8::EpiUp E{pss, Up, FF};
        pg8::gemm_phase<pg8::EpiUp, pg8::StaticOrder, true>(lds, g, S, E);
    }
    SEAM(7);
    if (IN(8)) {
        pg8::Gemm g{Up, Wdown_t, FF, FF, M, D, FF, 0}; pg8::StaticOrder S; S.init(M, D, G, (int)blockIdx.x);
        pg8::EpiDown E{args.out};
        pg8::gemm_phase<pg8::EpiDown, pg8::StaticOrder, false>(lds, g, S, E);
    }
#undef IN
#undef SEAM
#undef GRID_SYNC
}

static int g_grid = 0;
static void launch_mk(const Args& a0, int lo, int hi, hipStream_t stream) {
    Args a = a0; a.ph_lo = lo; a.ph_hi = hi;
    void* kargs[] = {(void*)&a};
    hipError_t e = hipLaunchCooperativeKernel((const void*)mk_fwd, dim3(g_grid), dim3(NWAVES * 64), kargs, LDS_BYTES, stream);
    if (e != hipSuccess) fprintf(stderr, "cooperative launch failed: %s (grid %d)\n", hipGetErrorString(e), g_grid);
}

extern "C" void kernel_launch(void* const* d_in, const int* in_sizes, int n_in, void* d_out, int out_size, void* d_ws, size_t ws_size, hipStream_t stream) {
    if (g_grid == 0) {
        int dev = 0, cus = 0, per_cu = 0;
        hipGetDevice(&dev);
        hipDeviceGetAttribute(&cus, hipDeviceAttributeMultiprocessorCount, dev);
        hipFuncSetAttribute((const void*)mk_fwd, hipFuncAttributeMaxDynamicSharedMemorySize, LDS_BYTES);
        hipOccupancyMaxActiveBlocksPerMultiprocessor(&per_cu, (const void*)mk_fwd, NWAVES * 64, LDS_BYTES);
        if (per_cu < 1) per_cu = 1;
        if (per_cu > 1) per_cu = 1;
        g_grid = cus * per_cu;
    }
    Args a{};
    for (int i = 0; i < 23; ++i) a.in[i] = (const float*)d_in[i];
    a.out = (float*)d_out; a.ws = (unsigned char*)d_ws;
    bf16_t* P = (bf16_t*)((char*)d_ws + WS_P);
    launch_mk(a, 0, 9, stream);
}
```

```cpp
#include <hip/hip_runtime.h>
#include <hip/hip_cooperative_groups.h>
#include <stdint.h>
#include <cstdio>
namespace cg = cooperative_groups;

typedef unsigned short bf16_t;

constexpr int D = 1024, BATCH = 8, SEQ = 2048, M = BATCH * SEQ;
constexpr int DN_H = 8, DN_D = 128;
constexpr int NS_H = 16, NS_G = 4, NS_R = 4, NS_D = 64;
constexpr int NCMP = 127, NSEL = 32;
constexpr int FF = 4096;
constexpr int INW = 8768;
constexpr float EPS = 1e-6f;
constexpr float NEGV = -1e30f, FORCEV = 1e9f;

constexpr int LDP = 6720;
constexpr int C_DQ = 0, C_DK = 1024, C_DV = 2048, C_DZ = 3072, C_NQ = 4096;
constexpr int C_KC = 5120, C_VC = 5376, C_KS = 5632, C_VS = 5888, C_KW = 6144, C_VW = 6400;
constexpr int C_SB = 6656, C_SA = 6664, C_SG = 6672;
constexpr int NP1 = 6912;

__device__ __forceinline__ float bf2f(bf16_t v) { return __uint_as_float(((unsigned)v) << 16); }
__device__ __forceinline__ bf16_t f2bf(float f) { unsigned u = __float_as_uint(f); return (bf16_t)((u + 0x7fffu + ((u >> 16) & 1u)) >> 16); }
__device__ __forceinline__ float sigmoidf_(float x) { return 1.f / (1.f + __expf(-x)); }
__device__ __forceinline__ float siluf_(float x) { return x * sigmoidf_(x); }
__device__ __forceinline__ float softplusf_(float x) { return fmaxf(x, 0.f) + log1pf(__expf(-fabsf(x))); }
__device__ __forceinline__ float gelu_tanh(float x) { return 0.5f * x * (1.f + tanhf(0.7978845608028654f * (x + 0.044715f * x * x * x))); }

__device__ __forceinline__ float block_sum(float v, float* red) {
    for (int o = 32; o > 0; o >>= 1) v += __shfl_xor(v, o);
    const int w = threadIdx.x >> 6, nw = blockDim.x >> 6;
    __syncthreads();
    if ((threadIdx.x & 63) == 0) red[w] = v;
    __syncthreads();
    float s = 0.f;
    for (int i = 0; i < nw; ++i) s += red[i];
    return s;
}
__device__ __forceinline__ float block_max(float v, float* red) {
    for (int o = 32; o > 0; o >>= 1) v = fmaxf(v, __shfl_xor(v, o));
    const int w = threadIdx.x >> 6, nw = blockDim.x >> 6;
    __syncthreads();
    if ((threadIdx.x & 63) == 0) red[w] = v;
    __syncthreads();
    float s = red[0];
    for (int i = 1; i < nw; ++i) s = fmaxf(s, red[i]);
    return s;
}


#if defined(TPROBE)
#define XSTAMP(k) do { if (blockIdx.x == 0 && threadIdx.x == 0) ((volatile __attribute__((address_space(3))) unsigned long long*)(lds + 147456 - 512))[k] = __builtin_amdgcn_s_memrealtime(); } while (0)
#else
#define XSTAMP(k) do { } while (0)
#endif
namespace gdn_naive {
#define GLAS __attribute__((address_space(3)))
__device__ __forceinline__ float sub_sum(float v, GLAS float* red, int sub, int tid) {
#pragma unroll
    for (int o = 32; o > 0; o >>= 1) v += __shfl_xor(v, o);
    __syncthreads();
    if ((tid & 63) == 0) red[sub * 2 + ((tid >> 6) & 1)] = v;
    __syncthreads();
    return red[sub * 2] + red[sub * 2 + 1];
}
__device__ __forceinline__ void run(GLAS unsigned char* lds, bf16_t* P, const float* convw, const float* a_log, const float* dt_bias, const float* out_norm, int item0) {
    const int tid = threadIdx.x, sub = tid >> 7, j = tid & 127;
    GLAS float* qs = (GLAS float*)lds + sub * 256; GLAS float* ks = qs + 128; GLAS float* red = (GLAS float*)(lds + 4096);
    const int item = item0 + sub; const int b = item / DN_H, h = item % DN_H;
    float s[128];
#pragma unroll
    for (int i = 0; i < 128; ++i) s[i] = 0.f;
    const float Ah = -__expf(a_log[h]), dtb = dt_bias[h], gn = out_norm[j];
    const float scale = 0.08838834764831845f;
    float wq[4], wk[4], wv[4], xq[3] = {0.f, 0.f, 0.f}, xk[3] = {0.f, 0.f, 0.f}, xv[3] = {0.f, 0.f, 0.f};
#pragma unroll
    for (int t = 0; t < 4; ++t) { wq[t] = convw[t * 3072 + h * 128 + j]; wk[t] = convw[t * 3072 + 1024 + h * 128 + j]; wv[t] = convw[t * 3072 + 2048 + h * 128 + j]; }
    for (int t = 0; t < SEQ; ++t) {
        bf16_t* row = P + (size_t)(b * SEQ + t) * LDP;
        const float rq = bf2f(row[C_DQ + h * DN_D + j]), rk = bf2f(row[C_DK + h * DN_D + j]), rv = bf2f(row[C_DV + h * DN_D + j]);
        float q = siluf_(wq[0] * xq[0] + wq[1] * xq[1] + wq[2] * xq[2] + wq[3] * rq);
        float k = siluf_(wk[0] * xk[0] + wk[1] * xk[1] + wk[2] * xk[2] + wk[3] * rk);
        const float v = siluf_(wv[0] * xv[0] + wv[1] * xv[1] + wv[2] * xv[2] + wv[3] * rv);
        xq[0] = xq[1]; xq[1] = xq[2]; xq[2] = rq; xk[0] = xk[1]; xk[1] = xk[2]; xk[2] = rk; xv[0] = xv[1]; xv[1] = xv[2]; xv[2] = rv;
        const float sq = sub_sum(q * q, red, sub, tid);
        const float sk = sub_sum(k * k, red, sub, tid);
        q *= rsqrtf(sq + EPS); k *= rsqrtf(sk + EPS);
        qs[j] = q; ks[j] = k;
        const float beta = sigmoidf_(bf2f(row[C_SB + h]));
        const float a = __expf(Ah * softplusf_(bf2f(row[C_SA + h]) + dtb));
        const float z = bf2f(row[C_DZ + h * DN_D + j]);
        __syncthreads();
        float kS = 0.f;
#pragma unroll
        for (int i = 0; i < 128; ++i) kS += ks[i] * s[i];
        const float dlt = beta * (v - a * kS);
        asm volatile("" ::: "memory");
        float o = 0.f;
#pragma unroll
        for (int i = 0; i < 128; ++i) { s[i] = a * s[i] + ks[i] * dlt; o += qs[i] * s[i]; }
        o *= scale;
        const float ss = sub_sum(o * o, red, sub, tid);
        row[C_DZ + h * DN_D + j] = f2bf(o * rsqrtf(ss * (1.f / 128.f) + EPS) * gn * siluf_(z));
    }
}
}
namespace gdn {
#define GL3 __attribute__((address_space(3)))
typedef short bf16x8 __attribute__((ext_vector_type(8)));
typedef short s16x4 __attribute__((ext_vector_type(4)));
typedef short v4i16_t __attribute__((ext_vector_type(4)));
typedef float f32x16 __attribute__((ext_vector_type(16)));
typedef float f32x4 __attribute__((ext_vector_type(4)));
typedef float f32x2 __attribute__((ext_vector_type(2)));
typedef unsigned u32x4 __attribute__((ext_vector_type(4)));
typedef unsigned u32x2 __attribute__((ext_vector_type(2)));
typedef __bf16 bf16x2_t __attribute__((ext_vector_type(2)));
constexpr float QSCALE = 0.08838834764831845f;
__device__ __forceinline__ int crow(int i, int hi) { return (i & 3) + 8 * (i >> 2) + 4 * hi; }
__device__ __forceinline__ unsigned pk(float lo, float hi) { f32x2 v = {lo, hi}; bf16x2_t b = __builtin_convertvector(v, bf16x2_t); return __builtin_bit_cast(unsigned, b); }
__device__ __forceinline__ bf16x8 pack8(const float* v) { u32x4 w = {pk(v[0], v[1]), pk(v[2], v[3]), pk(v[4], v[5]), pk(v[6], v[7])}; return __builtin_bit_cast(bf16x8, w); }
__device__ __forceinline__ float blo(unsigned w) { return __uint_as_float(w << 16); }
__device__ __forceinline__ float bhi(unsigned w) { return __uint_as_float(w & 0xffff0000u); }
__device__ __forceinline__ char* seg_addr(bf16_t* P, size_t row0, int c0, unsigned e) { return (char*)P + ((row0 + (e >> 8)) * LDP + c0) * 2 + (e & 255u); }

constexpr int PL_K = 0, PL_KB = 16384, PL_Q = 32768, PL_RHS = 49152, PL_AM = 114688, PL_GC = 132096, PL_QKST = 132352, PL_END = 140544;
constexpr int PL_WST = 0, PL_UST = 16384;
constexpr int AMLD = 68;
__device__ __forceinline__ void prep_item(GL3 unsigned char* lds, bf16_t* P, const bf16_t* HALO, const float* convw, const float* a_log, const float* dt_bias,
                                          bf16_t* GW, bf16_t* GQK, float* GLv, int b, int n, int h) {
    const int tid = threadIdx.x, lane = tid & 63, r32 = lane & 31, hi = lane >> 5; const int wid = __builtin_amdgcn_readfirstlane(tid >> 6);
    const size_t row0 = (size_t)b * SEQ + 64 * n; const int item = (b * DN_H + h) * 32 + n;
    GL3 float* RHS = (GL3 float*)(lds + PL_RHS); GL3 float* AM = (GL3 float*)(lds + PL_AM); GL3 float* GC = (GL3 float*)(lds + PL_GC);
    float gcum, beta_l, gc_last;
    {
        const bf16_t* prow = P + (row0 + lane) * LDP;
        beta_l = sigmoidf_(bf2f(prow[C_SB + h]));
        gcum = -__expf(a_log[h]) * softplusf_(bf2f(prow[C_SA + h]) + dt_bias[h]);
#pragma unroll
        for (int o = 1; o < 64; o <<= 1) { const float t = __shfl_up(gcum, o); if (lane >= o) gcum += t; }
        gc_last = __shfl(gcum, 63);
        if (wid == 0) GC[lane] = gcum;
    }
    bf16x8 qd_keep[2], ke_keep[2];
    const int dc = lane & 15;
#pragma unroll
    for (int pass = 0; pass < 2; ++pass) {
        const int tok = 8 * wid + 4 * pass + (lane >> 4);
        const float gct = __shfl(gcum, tok), bet = __shfl(beta_l, tok);
        float y[3][8];
#pragma unroll
        for (int which = 0; which < 3; ++which) {
            const int col = which * 1024 + h * 128 + dc * 8;
#pragma unroll
            for (int e = 0; e < 8; ++e) y[which][e] = 0.f;
#pragma unroll
            for (int j = 0; j < 4; ++j) {
                const int rr = tok - 3 + j;
                const bool inb = rr >= 0;
                const bf16_t* src = inb ? (P + (row0 + (inb ? rr : 0)) * LDP + col) : (HALO + ((size_t)((b * 32 + (n > 0 ? n - 1 : 0)) * 3 + (inb ? 0 : 3 + rr))) * 3072 + col);
                u32x4 x = *(const u32x4*)src;
                if (!inb && n == 0) x = (u32x4){0u, 0u, 0u, 0u};
                const f32x4 w0 = *(const f32x4*)(convw + j * 3072 + col), w1 = *(const f32x4*)(convw + j * 3072 + col + 4);
                y[which][0] += w0[0] * blo(x.x); y[which][1] += w0[1] * bhi(x.x); y[which][2] += w0[2] * blo(x.y); y[which][3] += w0[3] * bhi(x.y);
                y[which][4] += w1[0] * blo(x.z); y[which][5] += w1[1] * bhi(x.z); y[which][6] += w1[2] * blo(x.w); y[which][7] += w1[3] * bhi(x.w);
            }
#pragma unroll
            for (int e = 0; e < 8; ++e) y[which][e] = siluf_(y[which][e]);
        }
        float sq = 0.f, sk = 0.f;
#pragma unroll
        for (int e = 0; e < 8; ++e) { sq += y[0][e] * y[0][e]; sk += y[1][e] * y[1][e]; }
#pragma unroll
        for (int o = 1; o < 16; o <<= 1) { sq += __shfl_xor(sq, o); sk += __shfl_xor(sk, o); }
        const float rq = rsqrtf(sq + EPS), rk = rsqrtf(sk + EPS);
        const float eg = __expf(gct), ke_s = __expf(gc_last - gct);
        float q8[8], k8[8], kb8[8], qd8[8], ke8[8], kbg8[8], vb8[8];
#pragma unroll
        for (int e = 0; e < 8; ++e) { q8[e] = y[0][e] * rq; k8[e] = y[1][e] * rk; kb8[e] = k8[e] * bet; qd8[e] = q8[e] * (QSCALE * eg); ke8[e] = k8[e] * ke_s; kbg8[e] = kb8[e] * eg; vb8[e] = y[2][e] * bet; }
        const int io = (dc * 64 + tok) * 16;
        *(GL3 bf16x8*)(lds + PL_Q + io) = pack8(q8); *(GL3 bf16x8*)(lds + PL_K + io) = pack8(k8); *(GL3 bf16x8*)(lds + PL_KB + io) = pack8(kb8);
        *(GL3 f32x4*)(RHS + tok * 256 + dc * 8) = (f32x4){kbg8[0], kbg8[1], kbg8[2], kbg8[3]}; *(GL3 f32x4*)(RHS + tok * 256 + dc * 8 + 4) = (f32x4){kbg8[4], kbg8[5], kbg8[6], kbg8[7]};
        *(GL3 f32x4*)(RHS + tok * 256 + 128 + dc * 8) = (f32x4){vb8[0], vb8[1], vb8[2], vb8[3]}; *(GL3 f32x4*)(RHS + tok * 256 + 128 + dc * 8 + 4) = (f32x4){vb8[4], vb8[5], vb8[6], vb8[7]};
        qd_keep[pass] = pack8(qd8); ke_keep[pass] = pack8(ke8);
    }
    __syncthreads();
    if (n == 0 && b == 0 && h == 0) XSTAMP(15);
#pragma unroll
    for (int pass = 0; pass < 2; ++pass) {
        const int tok = 8 * wid + 4 * pass + (lane >> 4);
        *(bf16x8*)seg_addr(P, row0, C_DQ + h * 128, (unsigned)((dc * 64 + tok) * 16)) = qd_keep[pass];
        const unsigned ek = (unsigned)(((dc >> 2) * 4 + (tok >> 4)) * 1024 + ((tok >> 3) & 1) * 512 + (tok & 7) * 64 + (dc & 3) * 16);
        *(bf16x8*)seg_addr(P, row0, C_DK + h * 128, ek) = ke_keep[pass];
    }
    if (wid < 6) {
        const bool isA = wid < 3; const int t3 = isA ? wid : wid - 3;
        const int rt = isA ? (t3 > 0) : (t3 == 2);
        const int ct = isA ? (t3 == 2) : (t3 > 0);
        GL3 const unsigned char* aimg = lds + (isA ? PL_KB : PL_K); GL3 const unsigned char* bimg = lds + (isA ? PL_K : PL_Q);
        f32x16 acc = f32x16{};
#pragma unroll
        for (int s = 0; s < 8; ++s) {
            const bf16x8 a = *(GL3 const bf16x8*)(aimg + ((2 * s + hi) * 64 + 32 * rt + r32) * 16);
            const bf16x8 bb = *(GL3 const bf16x8*)(bimg + ((2 * s + hi) * 64 + 32 * ct + r32) * 16);
            acc = __builtin_amdgcn_mfma_f32_32x32x16_bf16(a, bb, acc, 0, 0, 0);
        }
        if (isA) {
            const int j = 32 * ct + r32; const float gj = GC[j];
#pragma unroll
            for (int i_ = 0; i_ < 16; ++i_) { const int i = 32 * rt + crow(i_, hi); AM[i * AMLD + j] = (j < i) ? acc[i_] * __expf(GC[i] - gj) : 0.f; }
        } else {
            const int i = 32 * ct + r32; const float gi = GC[i];
            float v[16];
#pragma unroll
            for (int i_ = 0; i_ < 16; ++i_) { const int j = 32 * rt + crow(i_, hi); v[i_] = (j <= i) ? acc[i_] * (QSCALE * __expf(gi - GC[j])) : 0.f; }
#pragma unroll
            for (int sp = 0; sp < 2; ++sp) *(GL3 bf16x8*)(lds + PL_QKST + (((2 * rt + sp) * 64 + i) * 16 + 8 * hi) * 2) = pack8(v + 8 * sp);
        }
    } else if (wid == 6) {
        const bf16x8 z = {0, 0, 0, 0, 0, 0, 0, 0};
#pragma unroll
        for (int sp = 0; sp < 2; ++sp) *(GL3 bf16x8*)(lds + PL_QKST + (((2 + sp) * 64 + r32) * 16 + 8 * hi) * 2) = z;
    }
    __syncthreads();
    if (n == 0 && b == 0 && h == 0) XSTAMP(16);
    if (tid < 256) {
        const int c = tid;
        float x[64];
#pragma unroll
        for (int i = 0; i < 64; ++i) x[i] = 0.f;
#pragma unroll
        for (int i = 0; i < 64; ++i) {
            float a0 = RHS[i * 256 + c], a1 = 0.f, a2 = 0.f, a3 = 0.f;
#pragma unroll
            for (int j4 = 0; j4 < i; j4 += 4) { const f32x4 a = *(GL3 const f32x4*)(AM + i * AMLD + j4); a0 -= a[0] * x[j4]; a1 -= a[1] * x[j4 + 1]; a2 -= a[2] * x[j4 + 2]; a3 -= a[3] * x[j4 + 3]; }
            x[i] = (a0 + a1) + (a2 + a3);
        }
        asm volatile("" ::: "memory");
        if (c < 128) {
#pragma unroll
            for (int i = 0; i < 64; ++i) *(GL3 bf16_t*)(lds + PL_WST + ((c >> 3) * 64 + i) * 16 + (c & 7) * 2) = f2bf(x[i]);
        } else {
#pragma unroll
            for (int i = 0; i < 64; ++i) *(GL3 bf16_t*)(lds + PL_UST + (i * 128 + (c - 128)) * 2) = f2bf(x[i]);
        }
    } else {
        const int t = tid - 256;
#pragma unroll
        for (int k = 0; k < 2; ++k) { const int e = (t + 256 * k) * 16; *(u32x4*)((char*)(GQK + (size_t)item * 4096) + e) = *(GL3 const u32x4*)(lds + PL_QKST + e); }
        if (t == 0) GLv[item] = __expf(gc_last);
    }
    __syncthreads();
    if (n == 0 && b == 0 && h == 0) XSTAMP(17);
#pragma unroll
    for (int k = 0; k < 2; ++k) {
        const int e = (tid + 512 * k) * 16;
        *(u32x4*)((char*)(GW + (size_t)item * 8192) + e) = *(GL3 const u32x4*)(lds + PL_WST + e);
        *(u32x4*)seg_addr(P, row0, C_DV + h * 128, (unsigned)e) = *(GL3 const u32x4*)(lds + PL_UST + e);
    }
    __syncthreads();
}

constexpr int SL_W = 0, SL_QD = 16384, SL_KE = 32768, SL_QK = 49152, SL_U = 57344, SL_Z = 73728, SL_S = 90112, SL_VN = 122880, SL_RS = 139264, SL_END = 140288;
__device__ __forceinline__ void dma_seg(GL3 unsigned char* dst, const bf16_t* P, size_t row0, int c0, int wid, int lane) {
#pragma unroll
    for (int k = 0; k < 2; ++k) { const int piece = wid + 8 * k;
        const char* src = (const char*)P + ((row0 + piece * 4 + (lane >> 4)) * LDP + c0) * 2 + (lane & 15) * 16;
        __builtin_amdgcn_global_load_lds((const unsigned*)src, (GL3 unsigned*)(dst + piece * 1024), 16, 0, 0); }
}
__device__ __forceinline__ void dma_lin(GL3 unsigned char* dst, const bf16_t* src, int npieces, int wid, int lane) {
    for (int piece = wid; piece < npieces; piece += 8)
        __builtin_amdgcn_global_load_lds((const unsigned*)((const char*)src + piece * 1024 + lane * 16), (GL3 unsigned*)(dst + piece * 1024), 16, 0, 0);
}
__device__ __forceinline__ s16x4 vtr(GL3 const unsigned char* p) { return __builtin_bit_cast(s16x4, __builtin_amdgcn_ds_read_tr16_b64_v4i16((GL3 v4i16_t*)p)); }

__device__ __forceinline__ void scan_item(GL3 unsigned char* lds, bf16_t* P, const bf16_t* GW, const bf16_t* GQK, const float* GLv, const float* out_norm, int b, int h) {
    const int tid = threadIdx.x, lane = tid & 63, r32 = lane & 31, hi = lane >> 5; const int wid = __builtin_amdgcn_readfirstlane(tid >> 6);
    const int mt = wid >> 2, nt = wid & 3;
    const int dv = 32 * nt + r32;
    f32x16 S0 = f32x16{}, S1 = f32x16{};
    {
        const u32x4 z = {0u, 0u, 0u, 0u};
#pragma unroll
        for (int k = 0; k < 4; ++k) *(GL3 u32x4*)(lds + SL_S + (tid + 512 * k) * 16) = z;
    }
    const float gain = out_norm[dv];
    GL3 float* RS = (GL3 float*)(lds + SL_RS);
    for (int n = 0; n < 32; ++n) {
        if (n == 6) XSTAMP(24);
        const size_t row0 = (size_t)b * SEQ + 64 * n; const int item = (b * DN_H + h) * 32 + n;
        __syncthreads();
        if (n == 5) XSTAMP(18);
        dma_lin(lds + SL_W, GW + (size_t)item * 8192, 16, wid, lane);
        dma_seg(lds + SL_QD, P, row0, C_DQ + h * 128, wid, lane);
        dma_seg(lds + SL_KE, P, row0, C_DK + h * 128, wid, lane);
        dma_lin(lds + SL_QK, GQK + (size_t)item * 4096, 8, wid, lane);
        dma_seg(lds + SL_U, P, row0, C_DV + h * 128, wid, lane);
        dma_seg(lds + SL_Z, P, row0, C_DZ + h * 128, wid, lane);
        const float gl = GLv[item];
        __syncthreads();
        if (n == 5) XSTAMP(19);
        f32x16 vp = f32x16{}, o = f32x16{};
#pragma unroll
        for (int s = 0; s < 8; ++s) {
            const bf16x8 sb = *(GL3 const bf16x8*)(lds + SL_S + ((2 * s + hi) * 128 + dv) * 16);
            const bf16x8 wa = *(GL3 const bf16x8*)(lds + SL_W + ((2 * s + hi) * 64 + 32 * mt + r32) * 16);
            const bf16x8 qa = *(GL3 const bf16x8*)(lds + SL_QD + ((2 * s + hi) * 64 + 32 * mt + r32) * 16);
            vp = __builtin_amdgcn_mfma_f32_32x32x16_bf16(wa, sb, vp, 0, 0, 0);
            o = __builtin_amdgcn_mfma_f32_32x32x16_bf16(qa, sb, o, 0, 0, 0);
        }
        {
            float v[16];
#pragma unroll
            for (int i = 0; i < 16; ++i) v[i] = bf2f(*(GL3 const bf16_t*)(lds + SL_U + ((32 * mt + crow(i, hi)) * 128 + dv) * 2)) - vp[i];
#pragma unroll
            for (int sp = 0; sp < 2; ++sp) *(GL3 bf16x8*)(lds + SL_VN + (((2 * mt + sp) * 128 + dv) * 16 + 8 * hi) * 2) = pack8(v + 8 * sp);
        }
        if (n == 5) XSTAMP(20);
        __syncthreads();
        if (n == 5) XSTAMP(21);
#pragma unroll
        for (int i = 0; i < 16; ++i) { S0[i] *= gl; S1[i] *= gl; }
        {
            GL3 const unsigned char* kp0 = lds + SL_KE + (2 * mt) * 4096 + ((lane >> 4) & 1) * 32 + (lane & 3) * 8 + (4 * hi + ((lane & 15) >> 2)) * 64;
#pragma unroll
            for (int ks = 0; ks < 4; ++ks) {
                const bf16x8 vb = *(GL3 const bf16x8*)(lds + SL_VN + ((ks * 128 + dv) * 16 + 8 * hi) * 2);
                const s16x4 l0 = vtr(kp0 + ks * 1024), h0 = vtr(kp0 + ks * 1024 + 512), l1 = vtr(kp0 + 4096 + ks * 1024), h1 = vtr(kp0 + 4096 + ks * 1024 + 512);
                const bf16x8 k0 = {l0[0], l0[1], l0[2], l0[3], h0[0], h0[1], h0[2], h0[3]}, k1 = {l1[0], l1[1], l1[2], l1[3], h1[0], h1[1], h1[2], h1[3]};
                const bf16x8 qa = *(GL3 const bf16x8*)(lds + SL_QK + ((ks * 64 + 32 * mt + r32) * 16 + 8 * hi) * 2);
                S0 = __builtin_amdgcn_mfma_f32_32x32x16_bf16(k0, vb, S0, 0, 0, 0);
                S1 = __builtin_amdgcn_mfma_f32_32x32x16_bf16(k1, vb, S1, 0, 0, 0);
                o = __builtin_amdgcn_mfma_f32_32x32x16_bf16(qa, vb, o, 0, 0, 0);
            }
        }
        {
#pragma unroll
            for (int i = 0; i < 16; ++i) { float q = o[i] * o[i];
#pragma unroll
                for (int sh = 1; sh < 32; sh <<= 1) q += __shfl_xor(q, sh);
                if (r32 == 0) RS[(32 * mt + crow(i, hi)) * 4 + nt] = q; }
        }
        if (n == 5) XSTAMP(22);
        __syncthreads();
#pragma unroll
        for (int a = 0; a < 4; ++a) {
            u32x2 w0 = {pk(S0[4 * a], S0[4 * a + 1]), pk(S0[4 * a + 2], S0[4 * a + 3])}, w1 = {pk(S1[4 * a], S1[4 * a + 1]), pk(S1[4 * a + 2], S1[4 * a + 3])};
            *(GL3 u32x2*)(lds + SL_S + ((4 * (2 * mt) + a) * 128 + dv) * 16 + 8 * hi) = w0;
            *(GL3 u32x2*)(lds + SL_S + ((4 * (2 * mt + 1) + a) * 128 + dv) * 16 + 8 * hi) = w1;
        }
#pragma unroll
        for (int i = 0; i < 16; ++i) { const int tok = 32 * mt + crow(i, hi);
            const f32x4 rs = *(GL3 const f32x4*)(RS + tok * 4);
            const float rstd = rsqrtf(((rs[0] + rs[1]) + (rs[2] + rs[3])) * (1.f / 128.f) + EPS);
            const float z = bf2f(*(GL3 const bf16_t*)(lds + SL_Z + (tok * 128 + dv) * 2));
            *(GL3 bf16_t*)(lds + SL_VN + (tok * 128 + dv) * 2) = f2bf(o[i] * rstd * gain * siluf_(z)); }
        if (n == 5) XSTAMP(23);
        __syncthreads();
#pragma unroll
        for (int k = 0; k < 2; ++k) { const int e = (tid + 512 * k) * 16; *(u32x4*)seg_addr(P, row0, C_DZ + h * 128, (unsigned)e) = *(GL3 const u32x4*)(lds + SL_VN + e); }
    }
    __syncthreads();
}
}
namespace nsa {
#define NLAS __attribute__((address_space(3)))
typedef short bf16x8 __attribute__((ext_vector_type(8)));
typedef short s16x4 __attribute__((ext_vector_type(4)));
typedef short v4i16_t __attribute__((ext_vector_type(4)));
typedef float f32x16 __attribute__((ext_vector_type(16)));
typedef float f32x4 __attribute__((ext_vector_type(4)));
typedef float f32x2 __attribute__((ext_vector_type(2)));
typedef unsigned u32x4 __attribute__((ext_vector_type(4)));
typedef __bf16 bf16x2_t __attribute__((ext_vector_type(2)));
constexpr float LOG2E = 1.4426950408889634f;
constexpr float NEG = -1e30f;
constexpr int L_KV = 0;
constexpr int L_IMP = 32768;
constexpr int L_SEL = 65536;
constexpr int L_WS = 66048;
constexpr int L_OST = 68096;
constexpr int L_END = 100864;

__device__ __forceinline__ int crow(int i, int hi) { return (i & 3) + 8 * (i >> 2) + 4 * hi; }
__device__ __forceinline__ unsigned pk(float lo, float hi) { f32x2 v = {lo, hi}; bf16x2_t b = __builtin_convertvector(v, bf16x2_t); return __builtin_bit_cast(unsigned, b); }
__device__ __forceinline__ float xhalf_max(float v) { auto rr = __builtin_amdgcn_permlane32_swap(__float_as_uint(v), __float_as_uint(v), false, false); return fmaxf(__uint_as_float(rr[0]), __uint_as_float(rr[1])); }
__device__ __forceinline__ float xhalf_sum(float v) { auto rr = __builtin_amdgcn_permlane32_swap(__float_as_uint(v), __float_as_uint(v), false, false); return __uint_as_float(rr[0]) + __uint_as_float(rr[1]); }

__device__ __forceinline__ void dma_tile(NLAS unsigned char* slot, const bf16_t* Kb, const bf16_t* Vb, unsigned koff, unsigned voff, int wid) {
    __builtin_amdgcn_global_load_lds((const unsigned*)((const char*)Kb + koff), (NLAS unsigned*)(slot + wid * 1024), 16, 0, 0);
    __builtin_amdgcn_global_load_lds((const unsigned*)((const char*)Vb + voff), (NLAS unsigned*)(slot + 8192 + wid * 1024), 16, 0, 0);
}
__device__ __forceinline__ void tile_offs(unsigned& koff, unsigned& voff, int pitch, int wid, int lane) {
    koff = (unsigned)(lane * pitch + wid * 8) * 2u;
    voff = (unsigned)((16 * (wid & 3) + (lane >> 2)) * pitch + (wid >> 2) * 32 + (lane & 3) * 8) * 2u;
}
__device__ __forceinline__ void qkt(f32x16& p0, f32x16& p1, NLAS const unsigned char* Kslot, const bf16x8* qr, const f32x16& c0, const f32x16& c1, int r32, int hi) {
    NLAS const unsigned char* kb = Kslot + hi * 1024 + r32 * 16;
#pragma unroll
    for (int d0 = 0; d0 < 4; ++d0) {
        const bf16x8 b0 = *(NLAS const bf16x8*)(kb + d0 * 2048);
        const bf16x8 b1 = *(NLAS const bf16x8*)(kb + d0 * 2048 + 512);
        if (d0 == 0) { p0 = __builtin_amdgcn_mfma_f32_32x32x16_bf16(b0, qr[0], c0, 0, 0, 0); p1 = __builtin_amdgcn_mfma_f32_32x32x16_bf16(b1, qr[0], c1, 0, 0, 0); }
        else { p0 = __builtin_amdgcn_mfma_f32_32x32x16_bf16(b0, qr[d0], p0, 0, 0, 0); p1 = __builtin_amdgcn_mfma_f32_32x32x16_bf16(b1, qr[d0], p1, 0, 0, 0); }
    }
}
__device__ __forceinline__ s16x4 vtr(NLAS const unsigned char* p) { return __builtin_bit_cast(s16x4, __builtin_amdgcn_ds_read_tr16_b64_v4i16((NLAS v4i16_t*)p)); }
__device__ __forceinline__ void pv(f32x16* o, NLAS const unsigned char* Vslot, const f32x16& p0, const f32x16& p1, int lane, int hi) {
    u32x4 w0 = {pk(p0[0], p0[1]), pk(p0[2], p0[3]), pk(p0[4], p0[5]), pk(p0[6], p0[7])};
    u32x4 w1 = {pk(p0[8], p0[9]), pk(p0[10], p0[11]), pk(p0[12], p0[13]), pk(p0[14], p0[15])};
    u32x4 w2 = {pk(p1[0], p1[1]), pk(p1[2], p1[3]), pk(p1[4], p1[5]), pk(p1[6], p1[7])};
    u32x4 w3 = {pk(p1[8], p1[9]), pk(p1[10], p1[11]), pk(p1[12], p1[13]), pk(p1[14], p1[15])};
    const bf16x8 pa[4] = {__builtin_bit_cast(bf16x8, w0), __builtin_bit_cast(bf16x8, w1), __builtin_bit_cast(bf16x8, w2), __builtin_bit_cast(bf16x8, w3)};
    NLAS const unsigned char* vp = Vslot + ((lane >> 4) & 1) * 32 + (lane & 3) * 8 + (4 * hi + ((lane & 15) >> 2)) * 64;
#pragma unroll
    for (int d0 = 0; d0 < 2; ++d0)
#pragma unroll
        for (int ks = 0; ks < 4; ++ks) {
            const s16x4 lo = vtr(vp + d0 * 4096 + ks * 1024), hh = vtr(vp + d0 * 4096 + ks * 1024 + 512);
            const bf16x8 vf = {lo[0], lo[1], lo[2], lo[3], hh[0], hh[1], hh[2], hh[3]};
            o[d0] = __builtin_amdgcn_mfma_f32_32x32x16_bf16(pa[ks], vf, o[d0], 0, 0, 0);
        }
}
__device__ __forceinline__ void scale_rows(f32x16* o, NLAS float* wsf, float s, int r32, int hi) {
    if (hi == 0) wsf[r32] = s;
#pragma unroll
    for (int i = 0; i < 16; ++i) { const float f = wsf[crow(i, hi)]; o[0][i] *= f; o[1][i] *= f; }
}
__device__ __forceinline__ void acc_rows(f32x16* tot, const f32x16* o, NLAS float* wsf, float s, int r32, int hi) {
    if (hi == 0) wsf[32 + r32] = s;
#pragma unroll
    for (int i = 0; i < 16; ++i) { const float f = wsf[32 + crow(i, hi)]; tot[0][i] += f * o[0][i]; tot[1][i] += f * o[1][i]; }
}
__device__ __forceinline__ void softmax_step(f32x16& p0, f32x16& p1, float& m, float& l, f32x16* o, NLAS float* wsf, int r32, int hi) {
    float t = fmaxf(p0[0], p1[0]);
#pragma unroll
    for (int i = 1; i < 16; ++i) t = fmaxf(t, fmaxf(p0[i], p1[i]));
    t = xhalf_max(t);
    const float mn = fmaxf(m, t);
    const float alpha = __builtin_amdgcn_exp2f(m - mn);
    float s = 0.f;
#pragma unroll
    for (int i = 0; i < 16; ++i) { p0[i] = __builtin_amdgcn_exp2f(p0[i] - mn); p1[i] = __builtin_amdgcn_exp2f(p1[i] - mn); s += p0[i] + p1[i]; }
    l = l * alpha + s; m = mn;
    if (__any(alpha != 1.f)) scale_rows(o, wsf, alpha, r32, hi);
}

__device__ __forceinline__ void attn_tile(NLAS unsigned char* lds, bf16_t* P, const bf16_t* KC, const bf16_t* VC, int b, int g, int qt) {
    int tid = threadIdx.x; asm volatile("" : "+v"(tid));
    const int lane = tid & 63, r32 = lane & 31, hi = lane >> 5; const int wid = __builtin_amdgcn_readfirstlane(tid >> 6);
    const int head = g * 4 + (wid >> 1), qh = wid & 1, t0 = qt * 64, qi = qh * 32 + r32, blk_t = qt;
    NLAS float* wsf = (NLAS float*)(lds + L_WS) + wid * 64;
    NLAS float* imp = (NLAS float*)(lds + L_IMP);
    NLAS unsigned* selm = (NLAS unsigned*)(lds + L_SEL);
    NLAS unsigned char* slot0 = lds + L_KV; NLAS unsigned char* slot1 = lds + L_KV + 16384;
    const size_t rowbase = (size_t)b * SEQ;
    bf16_t* qrow = P + (rowbase + t0 + qi) * LDP;
    const float sl2 = exp2f(-0.5f * (float)(head + 1)) * LOG2E;
    bf16x8 qr[4];
#pragma unroll
    for (int d0 = 0; d0 < 4; ++d0) qr[d0] = *(const bf16x8*)(qrow + C_NQ + head * 64 + d0 * 16 + hi * 8);
    const float gate_c = sigmoidf_(bf2f(qrow[C_SG + head * 3 + 0])), gate_s = sigmoidf_(bf2f(qrow[C_SG + head * 3 + 1])), gate_w = sigmoidf_(bf2f(qrow[C_SG + head * 3 + 2]));
    f32x16 tot[2]; tot[0] = f32x16{}; tot[1] = f32x16{};
#define CRF(i) ((float)(((i) & 3) + 8 * ((i) >> 2)) + 4.f * (float)hiv)
#define OPAQUE_HI() int hiv = hi; asm volatile("" : "+v"(hiv))

    {
        const bf16_t* kcb = KC + ((size_t)(b * NS_G + g) * 128) * 64; const bf16_t* vcb = VC + ((size_t)(b * NS_G + g) * 128) * 64;
        const bool two = (qt >= 16);
        unsigned kof, vof; tile_offs(kof, vof, 64, wid, lane);
        dma_tile(slot0, kcb, vcb, kof, vof, wid);
        if (two) dma_tile(slot1, kcb + 64 * 64, vcb + 64 * 64, kof, vof, wid);
        __syncthreads();
        f32x16 pA0, pA1, pB0, pB1, c0, c1;
        const float s16 = sl2 * 16.f; OPAQUE_HI();
#pragma unroll
        for (int i = 0; i < 16; ++i) { c0[i] = s16 * CRF(i); c1[i] = s16 * (CRF(i) + 32.f); }
        qkt(pA0, pA1, slot0, qr, c0, c1, r32, hi);
        const int cmax = (t0 + qi - 31) >> 4;
        const int qposm = t0 + qi - 31;
#pragma unroll
        for (int i = 0; i < 16; ++i) { const int c = crow(i, hiv); if (16 * c > qposm) pA0[i] = NEG; if (16 * (c + 32) > qposm) pA1[i] = NEG; }
        if (two) {
#pragma unroll
            for (int i = 0; i < 16; ++i) { c0[i] += s16 * 64.f; c1[i] += s16 * 64.f; }
            qkt(pB0, pB1, slot1, qr, c0, c1, r32, hi);
#pragma unroll
            for (int i = 0; i < 16; ++i) { const int c = 64 + crow(i, hiv); if (16 * c > qposm) pB0[i] = NEG; if (16 * (c + 32) > qposm) pB1[i] = NEG; }
        } else { pB0 = f32x16{}; pB1 = f32x16{};
#pragma unroll
            for (int i = 0; i < 16; ++i) { pB0[i] = NEG; pB1[i] = NEG; } }
        (void)cmax;
        float mx = NEG;
#pragma unroll
        for (int i = 0; i < 16; ++i) mx = fmaxf(fmaxf(mx, fmaxf(pA0[i], pA1[i])), fmaxf(pB0[i], pB1[i]));
        mx = xhalf_max(mx);
        float s = 0.f;
#pragma unroll
        for (int i = 0; i < 16; ++i) { pA0[i] = __builtin_amdgcn_exp2f(pA0[i] - mx); pA1[i] = __builtin_amdgcn_exp2f(pA1[i] - mx); pB0[i] = __builtin_amdgcn_exp2f(pB0[i] - mx); pB1[i] = __builtin_amdgcn_exp2f(pB1[i] - mx);
            s += (pA0[i] + pA1[i]) + (pB0[i] + pB1[i]); }
        s = xhalf_sum(s);
        const float nrm = (t0 + qi >= 31) ? __builtin_amdgcn_rcpf(s) : 0.f;
#pragma unroll
        for (int i = 0; i < 16; ++i) { pA0[i] *= nrm; pA1[i] *= nrm; pB0[i] *= nrm; pB1[i] *= nrm; }
#define PSEL(L) ((L) < 4 ? pA0 : (L) < 8 ? pA1 : (L) < 12 ? pB0 : pB1)
#define MAINV(L) ((PSEL(L)[4 * ((L) & 3)] + PSEL(L)[4 * ((L) & 3) + 1]) + (PSEL(L)[4 * ((L) & 3) + 2] + 0.5f * PSEL(L)[4 * ((L) & 3) + 3]))
#define CARRY(L) (0.5f * PSEL(L)[4 * ((L) & 3) + 3])
#pragma unroll
        for (int L = 0; L < 16; ++L) {
            const float cprev = (L > 0) ? CARRY(L > 0 ? L - 1 : 0) : 0.f;
            const float snd = hi ? cprev : CARRY(L);
            const float rcv = __shfl_xor(snd, 32);
            imp[((wid >> 1) * 64 + qi) * 32 + 2 * L + hi] = MAINV(L) + rcv;
        }
#undef PSEL
#undef MAINV
#undef CARRY
        f32x16 o[2]; o[0] = f32x16{}; o[1] = f32x16{};
        pv(o, slot0 + 8192, pA0, pA1, lane, hi);
        if (two) pv(o, slot1 + 8192, pB0, pB1, lane, hi);
        acc_rows(tot, o, wsf, gate_c, r32, hi);
    }
    __syncthreads();
    if (wid == 0) {
        float v[32];
#pragma unroll
        for (int j = 0; j < 32; ++j) v[j] = (imp[(0 * 64 + lane) * 32 + j] + imp[(1 * 64 + lane) * 32 + j]) + (imp[(2 * 64 + lane) * 32 + j] + imp[(3 * 64 + lane) * 32 + j]);
        unsigned mask = 1u | (1u << blk_t);
#pragma unroll 1
        for (int it = 0; it < 6; ++it) {
            float best = -1.f; int bj = -1;
#pragma unroll
            for (int j = 1; j < 32; ++j) { const bool ok = (j < blk_t) && !((mask >> j) & 1u); if (ok && v[j] > best) { best = v[j]; bj = j; } }
            if (bj >= 0) mask |= 1u << bj;
        }
        selm[lane] = mask;
        unsigned any = mask;
#pragma unroll
        for (int o_ = 1; o_ < 64; o_ <<= 1) any |= __shfl_xor(any, o_);
        if (lane == 0) selm[64] = any;
    }
    __syncthreads();
    const unsigned mymask = selm[qi];
    const unsigned anym = (unsigned)__builtin_amdgcn_readfirstlane((int)selm[64]);
    unsigned kofP, vofP; tile_offs(kofP, vofP, LDP, wid, lane);
    {
        const bf16_t* kb = P + rowbase * LDP + C_KS + g * 64; const bf16_t* vb = P + rowbase * LDP + C_VS + g * 64;
        unsigned todo = anym;
        float m = NEG, l = 0.f; f32x16 o[2]; o[0] = f32x16{}; o[1] = f32x16{};
        int j = __builtin_ctz(todo); todo &= todo - 1;
        dma_tile(slot0, kb + (size_t)j * 64 * LDP, vb + (size_t)j * 64 * LDP, kofP, vofP, wid);
        int cur = 0;
        __syncthreads();
        for (;;) {
            const int jn = todo ? __builtin_ctz(todo) : -1; if (todo) todo &= todo - 1;
            NLAS unsigned char* sc = cur ? slot1 : slot0; NLAS unsigned char* sn = cur ? slot0 : slot1;
            if (jn >= 0) dma_tile(sn, kb + (size_t)jn * 64 * LDP, vb + (size_t)jn * 64 * LDP, kofP, vofP, wid);
            const bool mine = (mymask >> j) & 1u;
            if (__any(mine)) {
                f32x16 p0, p1, c0, c1; const float kb0 = sl2 * (float)(j * 64 - t0); OPAQUE_HI();
#pragma unroll
                for (int i = 0; i < 16; ++i) { c0[i] = kb0 + sl2 * CRF(i); c1[i] = c0[i] + sl2 * 32.f; }
                qkt(p0, p1, sc, qr, c0, c1, r32, hi);
                if (j == blk_t) {
#pragma unroll
                    for (int i = 0; i < 16; ++i) { const int kk = crow(i, hiv); if (kk > qi) p0[i] = NEG; if (kk + 32 > qi) p1[i] = NEG; }
                }
                if (!mine) {
#pragma unroll
                    for (int i = 0; i < 16; ++i) { p0[i] = NEG; p1[i] = NEG; }
                }
                softmax_step(p0, p1, m, l, o, wsf, r32, hi);
                pv(o, sc + 8192, p0, p1, lane, hi);
            }
            __syncthreads();
            if (jn < 0) break;
            j = jn; cur ^= 1;
        }
        l = xhalf_sum(l);
        acc_rows(tot, o, wsf, gate_s * __builtin_amdgcn_rcpf(l), r32, hi);
    }
    {
        const bf16_t* kb = P + rowbase * LDP + C_KW + g * 64; const bf16_t* vb = P + rowbase * LDP + C_VW + g * 64;
        float m = NEG, l = 0.f; f32x16 o[2]; o[0] = f32x16{}; o[1] = f32x16{};
        int j = blk_t; const int jlast = blk_t >= 4 ? blk_t - 4 : 0;
        dma_tile(slot0, kb + (size_t)j * 64 * LDP, vb + (size_t)j * 64 * LDP, kofP, vofP, wid);
        int cur = 0;
        __syncthreads();
        for (;;) {
            const int jn = (j > jlast) ? j - 1 : -1;
            NLAS unsigned char* sc = cur ? slot1 : slot0; NLAS unsigned char* sn = cur ? slot0 : slot1;
            if (jn >= 0) dma_tile(sn, kb + (size_t)jn * 64 * LDP, vb + (size_t)jn * 64 * LDP, kofP, vofP, wid);
            {
                f32x16 p0, p1, c0, c1; const float kb0 = sl2 * (float)(j * 64 - t0); OPAQUE_HI();
#pragma unroll
                for (int i = 0; i < 16; ++i) { c0[i] = kb0 + sl2 * CRF(i); c1[i] = c0[i] + sl2 * 32.f; }
                qkt(p0, p1, sc, qr, c0, c1, r32, hi);
                if (j == blk_t || j == blk_t - 4) {
                    const int dq = t0 + qi - j * 64;
#pragma unroll
                    for (int i = 0; i < 16; ++i) { const int d0_ = dq - crow(i, hiv), d1_ = d0_ - 32; if (d0_ < 0 || d0_ > 255) p0[i] = NEG; if (d1_ < 0 || d1_ > 255) p1[i] = NEG; }
                }
                softmax_step(p0, p1, m, l, o, wsf, r32, hi);
                pv(o, sc + 8192, p0, p1, lane, hi);
            }
            __syncthreads();
            if (jn < 0) break;
            j = jn; cur ^= 1;
        }
        l = xhalf_sum(l);
        acc_rows(tot, o, wsf, gate_w * __builtin_amdgcn_rcpf(l), r32, hi);
    }
    {
        NLAS bf16_t* stg = (NLAS bf16_t*)(lds + L_OST) + wid * 2048;
#pragma unroll
        for (int i = 0; i < 16; ++i) { const int orow = crow(i, hi); stg[orow * 64 + r32] = f2bf(tot[0][i]); stg[orow * 64 + 32 + r32] = f2bf(tot[1][i]); }
        bf16_t* ow = P + (rowbase + t0 + qh * 32) * LDP + C_NQ + head * 64;
#pragma unroll
        for (int i = 0; i < 4; ++i) { const int row = i * 8 + (lane >> 3), ch = lane & 7; const u32x4 v = *(NLAS const u32x4*)(stg + row * 64 + ch * 8); *(u32x4*)((char*)ow + (unsigned)(row * LDP + ch * 8) * 2u) = v; }
    }
    __syncthreads();
#undef CRF
#undef OPAQUE_HI
}

__device__ __forceinline__ void norm8(u32x4& v, const float* g8, float sc) {
    float x[8] = {__uint_as_float(v.x << 16), __uint_as_float(v.x & 0xffff0000u), __uint_as_float(v.y << 16), __uint_as_float(v.y & 0xffff0000u),
                  __uint_as_float(v.z << 16), __uint_as_float(v.z & 0xffff0000u), __uint_as_float(v.w << 16), __uint_as_float(v.w & 0xffff0000u)};
    float s = 0.f;
#pragma unroll
    for (int e = 0; e < 8; ++e) s += x[e] * x[e];
    s += __shfl_xor(s, 1); s += __shfl_xor(s, 2); s += __shfl_xor(s, 4);
    const float r = rsqrtf(s * (1.f / 64.f) + EPS) * sc;
    v.x = pk(x[0] * r * g8[0], x[1] * r * g8[1]); v.y = pk(x[2] * r * g8[2], x[3] * r * g8[3]); v.z = pk(x[4] * r * g8[4], x[5] * r * g8[5]); v.w = pk(x[6] * r * g8[6], x[7] * r * g8[7]);
}
__device__ __forceinline__ void prep_units(bf16_t* P, const float* qn, const float* kns, const float* knw, int gw, int NGW, int lane) {
    float gq[8], gk[8];
    const float* kg = (lane < 32) ? kns : knw;
#pragma unroll
    for (int e = 0; e < 8; ++e) { gq[e] = qn[8 * (lane & 7) + e]; gk[e] = kg[8 * (lane & 7) + e]; }
    const int coff = (lane < 32) ? C_KS + 8 * lane : C_KW + 8 * (lane - 32);
    for (int m0 = gw; m0 < M; m0 += 2 * NGW) {
        const int m1 = m0 + NGW; const bool two = m1 < M;
        bf16_t* r0 = P + (size_t)m0 * LDP; bf16_t* r1 = P + (size_t)(two ? m1 : m0) * LDP;
        u32x4 a0 = *(const u32x4*)(r0 + C_NQ + 8 * lane), b0 = *(const u32x4*)(r0 + C_NQ + 512 + 8 * lane), c0 = *(const u32x4*)(r0 + coff);
        u32x4 a1 = *(const u32x4*)(r1 + C_NQ + 8 * lane), b1 = *(const u32x4*)(r1 + C_NQ + 512 + 8 * lane), c1 = *(const u32x4*)(r1 + coff);
        norm8(a0, gq, 0.125f * LOG2E); norm8(b0, gq, 0.125f * LOG2E); norm8(c0, gk, 1.f);
        norm8(a1, gq, 0.125f * LOG2E); norm8(b1, gq, 0.125f * LOG2E); norm8(c1, gk, 1.f);
        *(u32x4*)(r0 + C_NQ + 8 * lane) = a0; *(u32x4*)(r0 + C_NQ + 512 + 8 * lane) = b0; *(u32x4*)(r0 + coff) = c0;
        if (two) { *(u32x4*)(r1 + C_NQ + 8 * lane) = a1; *(u32x4*)(r1 + C_NQ + 512 + 8 * lane) = b1; *(u32x4*)(r1 + coff) = c1; }
    }
}

constexpr int LC_HID = 0;
__device__ __forceinline__ void compress_item(NLAS unsigned char* lds, const bf16_t* P, const bf16_t* W1T, const float* bias1, const float* W2, const float* gain, bf16_t* OUT, int b, int g, int which, int half) {
    const int tid = threadIdx.x, lane = tid & 63, r32 = lane & 31, hi = lane >> 5; const int wid = __builtin_amdgcn_readfirstlane(tid >> 6);
    const int mt = wid >> 2, nt = wid & 3;
    const int c = 64 * half + 32 * mt + r32;
    const int cc = c < NCMP ? c : NCMP - 1;
    const bf16_t* arow = P + ((size_t)b * SEQ + 16 * cc) * LDP + (which ? C_VC : C_KC) + g * 64 + hi * 8;
    const bf16_t* brow = W1T + (size_t)(32 * nt + r32) * 2048 + hi * 8;
    f32x16 acc = f32x16{};
#pragma unroll 4
    for (int l = 0; l < 32; ++l) {
#pragma unroll
        for (int ds = 0; ds < 4; ++ds) {
            const bf16x8 a = *(const bf16x8*)(arow + (size_t)l * LDP + ds * 16);
            const bf16x8 w = *(const bf16x8*)(brow + l * 64 + ds * 16);
            acc = __builtin_amdgcn_mfma_f32_32x32x16_bf16(a, w, acc, 0, 0, 0);
        }
    }
    NLAS float* hid = (NLAS float*)(lds + LC_HID);
    const float bs = bias1[32 * nt + r32];
#pragma unroll
    for (int i = 0; i < 16; ++i) hid[(32 * mt + crow(i, hi)) * 132 + 32 * nt + r32] = gelu_tanh(acc[i] + bs);
    __syncthreads();
    {
        const int row = tid >> 3, e0 = (tid & 7) * 8;
        float o[8];
#pragma unroll
        for (int e = 0; e < 8; ++e) o[e] = 0.f;
        for (int i = 0; i < 128; ++i) { const float h = hid[row * 132 + i]; const f32x4 wa = *(const f32x4*)(W2 + i * 64 + e0), wb = *(const f32x4*)(W2 + i * 64 + e0 + 4);
            o[0] += h * wa[0]; o[1] += h * wa[1]; o[2] += h * wa[2]; o[3] += h * wa[3]; o[4] += h * wb[0]; o[5] += h * wb[1]; o[6] += h * wb[2]; o[7] += h * wb[3]; }
        if (which == 0) {
            float ss = 0.f;
#pragma unroll
            for (int e = 0; e < 8; ++e) ss += o[e] * o[e];
            ss += __shfl_xor(ss, 1); ss += __shfl_xor(ss, 2); ss += __shfl_xor(ss, 4);
            const float r = rsqrtf(ss * (1.f / 64.f) + EPS);
#pragma unroll
            for (int e = 0; e < 8; ++e) o[e] *= r * gain[e0 + e];
        }
        const int cg = 64 * half + row;
        if (cg >= NCMP) {
#pragma unroll
            for (int e = 0; e < 8; ++e) o[e] = 0.f; }
        u32x4 w; w.x = pk(o[0], o[1]); w.y = pk(o[2], o[3]); w.z = pk(o[4], o[5]); w.w = pk(o[6], o[7]);
        *(u32x4*)(OUT + (((size_t)(b * NS_G + g) * 128) + cg) * 64 + e0) = w;
    }
    __syncthreads();
}
}
namespace pg8 {
#define PG8_LAS __attribute__((address_space(3)))
typedef short bf16x8 __attribute__((ext_vector_type(8)));
typedef float f32x4 __attribute__((ext_vector_type(4)));
typedef float f32x2 __attribute__((ext_vector_type(2)));
typedef unsigned u32x4 __attribute__((ext_vector_type(4)));
typedef unsigned u32x2 __attribute__((ext_vector_type(2)));
constexpr int BM = 256, BK = 64, HALF = 128, HTB = HALF * BK * 2, STAGE_BYTES = 8 * HTB, NXCD = 8, WGM = 8;

__host__ __device__ __forceinline__ int lds_byte(int r, int c) { const int st = (r >> 4) * 2 + (c >> 5), rr = r & 15, cc = c & 31, ob = rr * 64 + cc * 2; return st * 1024 + (ob ^ (((ob >> 9) & 1) << 5)); }
__host__ __device__ __forceinline__ void stage_rc(int b, int& R, int& C) { const int st = b / 1024, sb = b % 1024, swz = sb ^ (((sb >> 9) & 1) << 5); R = (st >> 1) * 16 + swz / 64; C = (st & 1) * 32 + (swz % 64) / 2; }
__host__ __device__ __forceinline__ int perm32(int rho) { const int n = rho >> 4, i = rho & 15; return 8 * (i >> 2) + 4 * n + (i & 3); }

struct Unit { int pm, pn, ks; };
struct Gemm { const bf16_t* A; const bf16_t* Bt; int lda, ldb; int M, N, K; int ksoff; };

struct StaticOrder {
    int nM, nN, nwg, G, c;
    __host__ __device__ void init(int M_, int N_, int G_, int c_) { nM = M_ / BM; nN = N_ / BM; nwg = nM * nN; G = G_; c = c_; }
    __host__ __device__ bool next(int i, Unit& u) const {
        const long L = (long)i * G + c; if (L >= nwg) return false;
        int wgid = (int)L; { const int q = nwg / NXCD, r = nwg % NXCD, xcd = wgid % NXCD, off = wgid / NXCD; wgid = (xcd < r ? xcd * (q + 1) : r * (q + 1) + (xcd - r) * q) + off; }
        const int nig = WGM * nN, gid = wgid / nig, fm = gid * WGM, gsz = (nM - fm) < WGM ? (nM - fm) : WGM;
        u.pm = fm + ((wgid % nig) % gsz); u.pn = (wgid % nig) / gsz; u.ks = 0; return true;
    }
};
struct TwoPassOrder {
    StaticOrder base;
    __host__ __device__ bool next(int i, Unit& u) const { if (!base.next(i >> 1, u)) return false; u.ks = i & 1; return true; }
};

typedef __bf16 bf16x2_t __attribute__((ext_vector_type(2)));
__device__ __forceinline__ unsigned cvt_pk_bf16(float lo, float hi) { f32x2 v = {lo, hi}; bf16x2_t b = __builtin_convertvector(v, bf16x2_t); return __builtin_bit_cast(unsigned, b); }
__device__ __forceinline__ float fast_sigmoid(float x) { return __builtin_amdgcn_rcpf(1.f + __builtin_amdgcn_exp2f(-1.4426950408889634f * x)); }
__device__ __forceinline__ float bflo(unsigned w) { return __uint_as_float(w << 16); }
__device__ __forceinline__ float bfhi(unsigned w) { return __uint_as_float(w & 0xffff0000u); }

typedef f32x4 Acc[2][2][4][2];

template <int ACT> struct EpiP {
    static constexpr bool PERM = true;
    bf16_t* O; int ldc; int pn_last; int ncol_last; bf16_t* halo;
    __device__ __forceinline__ void operator()(const Acc& acc, const Unit& u, int wr, int wc, int fr, int fq) const {
        const int row0 = u.pm * BM + wr * 64 + fr, tcol = wc * 32 + 8 * fq;
        const int lim = (u.pn == pn_last) ? ncol_last : 256;
#pragma unroll
        for (int ai = 0; ai < 2; ++ai)
#pragma unroll
            for (int m = 0; m < 4; ++m) { bf16_t* rowp = O + (size_t)(row0 + ai * HALF + m * 16) * ldc + u.pn * BM + tcol;
#pragma unroll
                for (int bj = 0; bj < 2; ++bj) { if (tcol + bj * HALF >= lim) continue;
                    f32x4 v0 = acc[ai][bj][m][0], v1 = acc[ai][bj][m][1];
                    if (ACT == 1) {
#pragma unroll
                        for (int e = 0; e < 4; ++e) { v0[e] = fast_sigmoid(v0[e]); v1[e] = fast_sigmoid(v1[e]); } }
                    u32x4 w; w.x = cvt_pk_bf16(v0[0], v0[1]); w.y = cvt_pk_bf16(v0[2], v0[3]); w.z = cvt_pk_bf16(v1[0], v1[1]); w.w = cvt_pk_bf16(v1[2], v1[3]);
                    *(u32x4*)(rowp + bj * HALF) = w;
                    if (ACT == 0 && m == 3 && fr >= 13 && u.pn < 12 && halo) { const int row = row0 + ai * HALF + 48;
                        *(u32x4*)(halo + ((size_t)(row >> 6) * 3 + (fr - 13)) * 3072 + u.pn * BM + tcol + bj * HALF) = w; } } }
    }
};
struct EpiMix {
    static constexpr bool PERM = true;
    const bf16_t* G; int ldg; bf16_t* O; int ldc;
    __device__ __forceinline__ void operator()(const Acc& acc, const Unit& u, int wr, int wc, int fr, int fq) const {
        const int row0 = u.pm * BM + wr * 64 + fr, col0 = u.pn * BM + wc * 32 + 8 * fq;
#pragma unroll
        for (int ai = 0; ai < 2; ++ai)
#pragma unroll
            for (int m = 0; m < 4; ++m) { const size_t row = (size_t)(row0 + ai * HALF + m * 16); const bf16_t* gp = G + row * ldg + col0 + u.ks * 1024; bf16_t* rowp = O + row * ldc + col0;
#pragma unroll
                for (int bj = 0; bj < 2; ++bj) { const u32x4 b = *(const u32x4*)(gp + bj * HALF);
                    f32x4 v0 = acc[ai][bj][m][0], v1 = acc[ai][bj][m][1];
                    v0[0] *= bflo(b.x); v0[1] *= bfhi(b.x); v0[2] *= bflo(b.y); v0[3] *= bfhi(b.y); v1[0] *= bflo(b.z); v1[1] *= bfhi(b.z); v1[2] *= bflo(b.w); v1[3] *= bfhi(b.w);
                    if (u.ks) { const u32x4 p = *(const u32x4*)(rowp + bj * HALF);
                        v0[0] += bflo(p.x); v0[1] += bfhi(p.x); v0[2] += bflo(p.y); v0[3] += bfhi(p.y); v1[0] += bflo(p.z); v1[1] += bfhi(p.z); v1[2] += bflo(p.w); v1[3] += bfhi(p.w); }
                    u32x4 w; w.x = cvt_pk_bf16(v0[0], v0[1]); w.y = cvt_pk_bf16(v0[2], v0[3]); w.z = cvt_pk_bf16(v1[0], v1[1]); w.w = cvt_pk_bf16(v1[2], v1[3]);
                    *(u32x4*)(rowp + bj * HALF) = w; } }
    }
};
struct EpiOut {
    static constexpr bool PERM = false;
    const float* X; float* X1; bf16_t* An; const float* gain; float* pss;
    __device__ __forceinline__ void operator()(const Acc& acc, const Unit& u, int wr, int wc, int fr, int fq) const {
        const int row0 = u.pm * BM + wr * 64 + fr, col0 = u.pn * BM + wc * 32 + 4 * fq;
        f32x4 gv[2][2];
#pragma unroll
        for (int bj = 0; bj < 2; ++bj)
#pragma unroll
            for (int n = 0; n < 2; ++n) gv[bj][n] = *(const f32x4*)(gain + col0 + bj * HALF + n * 16);
#pragma unroll
        for (int ai = 0; ai < 2; ++ai)
#pragma unroll
            for (int m = 0; m < 4; ++m) { const size_t row = (size_t)(row0 + ai * HALF + m * 16); const size_t off = row * D + col0; float ss = 0.f;
#pragma unroll
                for (int bj = 0; bj < 2; ++bj)
#pragma unroll
                    for (int n = 0; n < 2; ++n) { const f32x4 x1 = *(const f32x4*)(X + off + bj * HALF + n * 16) + acc[ai][bj][m][n];
                        *(f32x4*)(X1 + off + bj * HALF + n * 16) = x1; ss += (x1[0] * x1[0] + x1[1] * x1[1]) + (x1[2] * x1[2] + x1[3] * x1[3]);
                        const f32x4 y = x1 * gv[bj][n]; u32x2 w; w.x = cvt_pk_bf16(y[0], y[1]); w.y = cvt_pk_bf16(y[2], y[3]); *(u32x2*)(An + off + bj * HALF + n * 16) = w; }
                ss += __shfl_xor(ss, 16); ss += __shfl_xor(ss, 32);
                if (fq == 0) pss[row * 16 + u.pn * 4 + wc] = ss; }
    }
};
struct EpiUp {
    static constexpr bool PERM = true;
    const float* pss; bf16_t* O; int ldc;
    __device__ __forceinline__ void operator()(const Acc& acc, const Unit& u, int wr, int wc, int fr, int fq) const {
        const int row0 = u.pm * BM + wr * 64 + fr, col0 = u.pn * BM + wc * 32 + 8 * fq;
#pragma unroll
        for (int ai = 0; ai < 2; ++ai)
#pragma unroll
            for (int m = 0; m < 4; ++m) { const size_t row = (size_t)(row0 + ai * HALF + m * 16);
                const f32x4* pp = (const f32x4*)(pss + row * 16); const f32x4 s4 = (pp[0] + pp[1]) + (pp[2] + pp[3]);
                const float rstd = rsqrtf(((s4[0] + s4[1]) + (s4[2] + s4[3])) * (1.f / D) + EPS);
                bf16_t* rowp = O + row * ldc + col0;
#pragma unroll
                for (int bj = 0; bj < 2; ++bj) { f32x4 v0 = acc[ai][bj][m][0] * rstd, v1 = acc[ai][bj][m][1] * rstd;
#pragma unroll
                    for (int e = 0; e < 4; ++e) { const float a = fmaxf(v0[e], 0.f), b = fmaxf(v1[e], 0.f); v0[e] = a * a; v1[e] = b * b; }
                    u32x4 w; w.x = cvt_pk_bf16(v0[0], v0[1]); w.y = cvt_pk_bf16(v0[2], v0[3]); w.z = cvt_pk_bf16(v1[0], v1[1]); w.w = cvt_pk_bf16(v1[2], v1[3]);
                    *(u32x4*)(rowp + bj * HALF) = w; } }
    }
};
struct EpiDown {
    static constexpr bool PERM = false;
    float* X1;
    __device__ __forceinline__ void operator()(const Acc& acc, const Unit& u, int wr, int wc, int fr, int fq) const {
        const int row0 = u.pm * BM + wr * 64 + fr, col0 = u.pn * BM + wc * 32 + 4 * fq;
#pragma unroll
        for (int ai = 0; ai < 2; ++ai)
#pragma unroll
            for (int m = 0; m < 4; ++m) { float* rowp = X1 + (size_t)(row0 + ai * HALF + m * 16) * D + col0;
#pragma unroll
                for (int bj = 0; bj < 2; ++bj)
#pragma unroll
                    for (int n = 0; n < 2; ++n) { f32x4* p = (f32x4*)(rowp + bj * HALF + n * 16); *p = *p + acc[ai][bj][m][n]; } }
    }
};

template <class Epi, class Sched, bool ALIGN_EPI>
__device__ __forceinline__ void gemm_phase(PG8_LAS unsigned char* lds, const Gemm g, const Sched& S, const Epi& E) {
    const int tid = threadIdx.x, wid = __builtin_amdgcn_readfirstlane(tid >> 6), lane = tid & 63, wr = wid >> 2, wc = wid & 3, fr = lane & 15, fq = lane >> 4;
    const int K = g.K, nt = K / BK, lda = g.lda, ldb = g.ldb;
    unsigned voffA[2], voffB[2];
#pragma unroll
    for (int i = 0; i < 2; ++i) { int R, C; stage_rc(tid * 16 + i * 8192, R, C); const int Rb = Epi::PERM ? ((R & ~31) + perm32(R & 31)) : R;
        voffA[i] = (unsigned)(R * lda + C) * 2u; voffB[i] = (unsigned)(Rb * ldb + C) * 2u; }
    const size_t kstep = (size_t)(BK * 2);
    const size_t hstepA = (size_t)HALF * lda * 2, hstepB = (size_t)HALF * ldb * 2;
    const size_t tstepA = 2 * hstepA, tstepB = 2 * hstepB;
    const unsigned ldsw = (unsigned)wid * 1024u;
    const int aoff = lds_byte(wr * 64 + fr, fq * 8), boff = lds_byte(wc * 32 + fr, fq * 8);
#define PG8_SA(b, h) (((b) * 2 + (h)) * HTB)
#define PG8_SB(b, h) ((4 + (b) * 2 + (h)) * HTB)
#define PG8_STAGE(bufoff, gbase, voff) do { _Pragma("unroll") for (int _i = 0; _i < 2; ++_i) \
        __builtin_amdgcn_global_load_lds((const unsigned*)((const char*)(gbase) + (voff)[_i]), (PG8_LAS unsigned*)(lds + (bufoff) + ldsw + _i * 8192), 16, 0, 0); } while (0)
#define PG8_LDA(dst, b, h) do { _Pragma("unroll") for (int m = 0; m < 4; ++m) _Pragma("unroll") for (int k = 0; k < 2; ++k) dst[m][k] = *(const PG8_LAS bf16x8*)(lds + PG8_SA(b, h) + aoff + m * 2048 + k * 1024); } while (0)
#define PG8_LDB(dst, b, h) do { _Pragma("unroll") for (int n = 0; n < 2; ++n) _Pragma("unroll") for (int k = 0; k < 2; ++k) dst[n][k] = *(const PG8_LAS bf16x8*)(lds + PG8_SB(b, h) + boff + n * 2048 + k * 1024); } while (0)
#define PG8_MMA(ai, bj, At, Bt) do { __builtin_amdgcn_s_setprio(1); _Pragma("unroll") for (int m = 0; m < 4; ++m) _Pragma("unroll") for (int n = 0; n < 2; ++n) _Pragma("unroll") for (int k = 0; k < 2; ++k) \
        acc[ai][bj][m][n] = __builtin_amdgcn_mfma_f32_16x16x32_bf16(Bt[n][k], At[m][k], acc[ai][bj][m][n], 0, 0, 0); __builtin_amdgcn_s_setprio(0); } while (0)
#define PG8_WAIT_V(n) asm volatile("s_waitcnt vmcnt(" #n ")" ::: "memory")
#define PG8_WAIT_L(n) asm volatile("s_waitcnt lgkmcnt(" #n ")" ::: "memory")
#define PG8_BAR __builtin_amdgcn_s_barrier()
#define PG8_SCHED __builtin_amdgcn_sched_barrier(0)
#define PG8_KBODY(t) do { \
            const bool last = (t == nt - 2); \
            const char* a1 = cA + (size_t)(t + 1) * kstep; \
            const char* a2 = last ? nA : cA + (size_t)(t + 2) * kstep; const char* b2 = last ? nB : cB + (size_t)(t + 2) * kstep; \
            const char* a3 = a2 + kstep; const char* b3 = b2 + kstep; \
            PG8_LDB(B0, 0, 0); PG8_LDB(B1, 0, 1); PG8_SCHED; PG8_LDA(At, 0, 0); PG8_STAGE(PG8_SA(1, 1), a1 + hstepA, voffA); \
            PG8_WAIT_V(8); PG8_WAIT_L(0); PG8_BAR; PG8_MMA(0, 0, At, B0); PG8_MMA(0, 1, At, B1); PG8_BAR; PG8_SCHED; \
            PG8_LDA(At, 0, 1); PG8_STAGE(PG8_SB(0, 0), b2, voffB); PG8_STAGE(PG8_SB(0, 1), b2 + hstepB, voffB); PG8_STAGE(PG8_SA(0, 0), a2, voffA); \
            PG8_WAIT_V(8); PG8_WAIT_L(0); PG8_BAR; PG8_MMA(1, 0, At, B0); PG8_MMA(1, 1, At, B1); PG8_BAR; PG8_SCHED; \
            PG8_LDB(B0, 1, 0); PG8_LDB(B1, 1, 1); PG8_SCHED; PG8_LDA(At, 1, 0); PG8_STAGE(PG8_SA(0, 1), a2 + hstepA, voffA); \
            PG8_WAIT_V(8); PG8_WAIT_L(0); PG8_BAR; PG8_MMA(0, 0, At, B0); PG8_MMA(0, 1, At, B1); PG8_BAR; PG8_SCHED; \
            PG8_LDA(At, 1, 1); PG8_STAGE(PG8_SB(1, 0), b3, voffB); PG8_STAGE(PG8_SB(1, 1), b3 + hstepB, voffB); PG8_STAGE(PG8_SA(1, 0), a3, voffA); \
            PG8_WAIT_V(8); PG8_WAIT_L(0); PG8_BAR; PG8_MMA(1, 0, At, B0); PG8_MMA(1, 1, At, B1); PG8_BAR; PG8_SCHED; \
        } while (0)
    Unit cur, nxt; int ui = 0;
    if (!S.next(0, cur)) return;
    Acc acc;
#pragma unroll
    for (int a = 0; a < 2; ++a)
#pragma unroll
        for (int b = 0; b < 2; ++b)
#pragma unroll
            for (int m = 0; m < 4; ++m)
#pragma unroll
                for (int n = 0; n < 2; ++n) acc[a][b][m][n] = (f32x4){0.f, 0.f, 0.f, 0.f};
    bf16x8 At[4][2], B0[2][2], B1[2][2];
    const char* cA = (const char*)g.A + (size_t)cur.pm * tstepA + (size_t)cur.ks * g.ksoff * 2; const char* cB = (const char*)g.Bt + (size_t)cur.pn * tstepB + (size_t)cur.ks * g.ksoff * 2;
    PG8_STAGE(PG8_SB(0, 0), cB, voffB); PG8_STAGE(PG8_SB(0, 1), cB + hstepB, voffB); PG8_STAGE(PG8_SA(0, 0), cA, voffA); PG8_STAGE(PG8_SA(0, 1), cA + hstepA, voffA);
    if (wr == 1) PG8_BAR;
    PG8_WAIT_V(2); PG8_BAR;
    PG8_STAGE(PG8_SB(1, 0), cB + kstep, voffB); PG8_STAGE(PG8_SA(1, 0), cA + kstep, voffA); PG8_STAGE(PG8_SB(1, 1), cB + hstepB + kstep, voffB);
    PG8_WAIT_V(6); PG8_BAR;
    for (;;) {
        const bool has_next = S.next(ui + 1, nxt);
        const char* nA = has_next ? (const char*)g.A + (size_t)nxt.pm * tstepA + (size_t)nxt.ks * g.ksoff * 2 : cA; const char* nB = has_next ? (const char*)g.Bt + (size_t)nxt.pn * tstepB + (size_t)nxt.ks * g.ksoff * 2 : cB;
        for (int t = 0; t < nt; t += 2) PG8_KBODY(t);
        if constexpr (ALIGN_EPI) { if (wr == 0) PG8_BAR; }
        E(acc, cur, wr, wc, fr, fq);
        if (!has_next) break;
#pragma unroll
        for (int a = 0; a < 2; ++a)
#pragma unroll
            for (int b = 0; b < 2; ++b)
#pragma unroll
                for (int m = 0; m < 4; ++m)
#pragma unroll
                    for (int n = 0; n < 2; ++n) acc[a][b][m][n] = (f32x4){0.f, 0.f, 0.f, 0.f};
        cur = nxt; cA = nA; cB = nB; ++ui;
        if constexpr (ALIGN_EPI) { if (wr == 1) PG8_BAR; }
    }
    PG8_WAIT_V(0);
    if constexpr (!ALIGN_EPI) { if (wr == 0) PG8_BAR; }
    PG8_BAR;
#undef PG8_SA
#undef PG8_SB
#undef PG8_STAGE
#undef PG8_LDA
#undef PG8_LDB
#undef PG8_MMA
#undef PG8_WAIT_V
#undef PG8_WAIT_L
#undef PG8_BAR
#undef PG8_SCHED
#undef PG8_KBODY
}
}

#define GAS __attribute__((address_space(1)))
#define LAS __attribute__((address_space(3)))
typedef unsigned v4u __attribute__((ext_vector_type(4)));
typedef float f32x4 __attribute__((ext_vector_type(4)));
constexpr int NWAVES = 8;
constexpr int LDS_BYTES = 147456;
constexpr size_t MiB = 1u << 20;
constexpr size_t WS_PSS = 1 * MiB, WS_WOUT = 2 * MiB, WS_P = 4 * MiB, WS_KC = 214 * MiB, WS_VC = 215 * MiB, WS_MIX = 216 * MiB;
constexpr size_t WS_AN = 4 * MiB, WS_UP = 64 * MiB, WS_WUP = 248 * MiB, WS_WDOWN = 200 * MiB;
constexpr size_t WS_BIAS1 = 0, WS_W1T = 214 * MiB, WS_KCB = 215 * MiB, WS_VCB = 215 * MiB + 512 * 1024;
constexpr size_t WS_GLV = 4096, WS_QCNT = 65536, WS_GW = 216 * MiB, DO_GQK = 40 * MiB, DO_HALO = 56 * MiB;
constexpr size_t DO_H = 0, DO_WG = 32 * MiB, DO_WCAT = 36 * MiB, DO_WIN = 40 * MiB;

__device__ __forceinline__ unsigned pk2(float lo, float hi) { return (unsigned)f2bf(lo) | ((unsigned)f2bf(hi) << 16); }
__device__ __forceinline__ float wave_sum(float v) {
#pragma unroll
    for (int o = 1; o < 64; o <<= 1) v += __shfl_xor(v, o);
    return v;
}
template <class SrcCol>
__device__ __forceinline__ void transpose_item(const float* W, int ldw, const SrcCol& srccol, bf16_t* WT, int ldk, int kofs, LAS float* scr, int kb, int nb, int lane) {
    const int k0 = 64 * kb, n0 = 64 * nb; const int n4 = (lane & 15) * 4; const int sc = srccol(n0 + n4);
#pragma unroll 4
    for (int i = 0; i < 16; ++i) { const int kk = 4 * i + (lane >> 4);
        const f32x4 v = (sc >= 0) ? *(const f32x4*)(W + (size_t)(k0 + kk) * ldw + sc) : (f32x4){0.f, 0.f, 0.f, 0.f};
        scr[kk * 65 + n4] = v[0]; scr[kk * 65 + n4 + 1] = v[1]; scr[kk * 65 + n4 + 2] = v[2]; scr[kk * 65 + n4 + 3] = v[3]; }
    asm volatile("s_waitcnt lgkmcnt(0)" ::: "memory");
    const int c = lane & 7;
#pragma unroll
    for (int j = 0; j < 8; ++j) { const int n = (lane >> 3) + 8 * j; const LAS float* sp = scr + (8 * c) * 65 + n;
        v4u o; o.x = pk2(sp[0 * 65], sp[1 * 65]); o.y = pk2(sp[2 * 65], sp[3 * 65]); o.z = pk2(sp[4 * 65], sp[5 * 65]); o.w = pk2(sp[6 * 65], sp[7 * 65]);
        *(v4u*)(WT + (size_t)(n0 + n) * ldk + kofs + k0 + 8 * c) = o; }
    asm volatile("s_waitcnt lgkmcnt(0)" ::: "memory");
}
struct SrcIdent { int off; __device__ __forceinline__ int operator()(int n) const { return n + off; } };
struct SrcWin { __device__ __forceinline__ int operator()(int n) const { return n < 4096 ? n : (n < 6656 ? n + 16 : (n < 6672 ? n - 6656 + 4096 : (n < 6720 ? n : -1))); } };

struct Args { const float* in[23]; float* out; unsigned char* ws; int ph_lo, ph_hi; };

__global__ void __launch_bounds__(NWAVES * 64, 2) mk_fwd(Args args) {
    extern __shared__ __attribute__((aligned(16))) unsigned char lds_raw[];
    LAS unsigned char* lds = (LAS unsigned char*)lds_raw;
    cg::grid_group grid = cg::this_grid();
    const int tid = threadIdx.x, lane = tid & 63, wave = __builtin_amdgcn_readfirstlane(tid >> 6);
    const int G = gridDim.x, gw = blockIdx.x * NWAVES + wave, NGW = G * NWAVES;
    unsigned char* ws = args.ws; unsigned char* dob = (unsigned char*)args.out;
    const float* x = args.in[0];
    bf16_t* P = (bf16_t*)(ws + WS_P);
    bf16_t* Hb = (bf16_t*)(dob + DO_H); bf16_t* Wg_t = (bf16_t*)(dob + DO_WG); bf16_t* Wcat_t = (bf16_t*)(dob + DO_WCAT); bf16_t* Win_t = (bf16_t*)(dob + DO_WIN);
    bf16_t* Wout_t = (bf16_t*)(ws + WS_WOUT); bf16_t* Wup_t = (bf16_t*)(ws + WS_WUP); bf16_t* Wdown_t = (bf16_t*)(ws + WS_WDOWN);
    bf16_t* Mix = (bf16_t*)(ws + WS_MIX); bf16_t* An = (bf16_t*)(ws + WS_AN); bf16_t* Up = (bf16_t*)(ws + WS_UP); float* pss = (float*)(ws + WS_PSS);
    LAS float* scr = (LAS float*)(lds + wave * 17408);
    bf16_t* Halo = (bf16_t*)(dob + DO_HALO); bf16_t* GWb = (bf16_t*)(ws + WS_GW); bf16_t* GQKb = (bf16_t*)(dob + DO_GQK); float* GLv = (float*)(ws + WS_GLV); unsigned* qcnt = (unsigned*)(ws + WS_QCNT);
    bf16_t* W1T = (bf16_t*)(ws + WS_W1T); float* bias1 = (float*)(ws + WS_BIAS1); bf16_t* KCb = (bf16_t*)(ws + WS_KCB); bf16_t* VCb = (bf16_t*)(ws + WS_VCB);
    const int lo = args.ph_lo, hi = args.ph_hi;
#ifndef PHMASK
#define PHMASK 0x1ff
#endif
#define IN(k) (((PHMASK >> (k)) & 1) && lo <= (k) && (k) < hi)
#define GRID_SYNC() do { asm volatile("s_waitcnt vmcnt(0) lgkmcnt(0)" ::: "memory"); grid.sync(); \
        if (wave == 0) { __builtin_amdgcn_fence(__ATOMIC_ACQUIRE, "agent"); asm volatile("s_waitcnt vmcnt(0)" ::: "memory"); } __syncthreads(); } while (0)
#if defined(TPROBE)
#define STAMP(k) do { if (blockIdx.x == 0 && tid == 0) ((volatile LAS unsigned long long*)(lds + 147456 - 512))[k] = __builtin_amdgcn_s_memrealtime(); } while (0)
#else
#define STAMP(k) do { } while (0)
#endif
#define SEAM(k) do { if (IN(k) && IN((k) + 1)) GRID_SYNC(); STAMP((k) + 1); } while (0)

    STAMP(0);
    if (IN(0)) {
        if (blockIdx.x == 0 && tid == 0) { *qcnt = 0u; ((volatile unsigned*)(ws + 786432))[4] = 0u; }
        constexpr int I_WIN = 16 * (NP1 / 64), I_WG = 16 * 32, I_DN = 16 * 16, I_OUT = 16 * 16, I_UP = 16 * 64;
        constexpr int I_W1 = 32 * 2, I_B1 = 256;
        constexpr int NITEMS = I_WIN + I_WG + 2 * I_DN + I_OUT + I_UP + 2 * I_W1 + I_B1;
        for (int it = gw; it < NITEMS; it += NGW) {
            int r = it;
            if (r < I_WIN) { transpose_item(args.in[2], INW, SrcWin{}, Win_t, D, 0, scr, r / (NP1 / 64), r % (NP1 / 64), lane); continue; } r -= I_WIN;
            if (r < I_WG) { transpose_item(args.in[2], INW, SrcIdent{6720}, Wg_t, D, 0, scr, r / 32, r % 32, lane); continue; } r -= I_WG;
            if (r < I_DN) { transpose_item(args.in[17], D, SrcIdent{0}, Wcat_t, 2 * D, 0, scr, r / 16, r % 16, lane); continue; } r -= I_DN;
            if (r < I_DN) { transpose_item(args.in[18], D, SrcIdent{0}, Wcat_t, 2 * D, D, scr, r / 16, r % 16, lane); continue; } r -= I_DN;
            if (r < I_OUT) { transpose_item(args.in[19], D, SrcIdent{0}, Wout_t, D, 0, scr, r / 16, r % 16, lane); continue; } r -= I_OUT;
            if (r < I_UP) { transpose_item(args.in[21], FF, SrcIdent{0}, Wup_t, D, 0, scr, r / 64, r % 64, lane); continue; } r -= I_UP;
            if (r < I_W1) { transpose_item(args.in[12], 128, SrcIdent{0}, W1T, 2048, 0, scr, r / 2, r % 2, lane); continue; } r -= I_W1;
            if (r < I_W1) { transpose_item(args.in[15], 128, SrcIdent{0}, W1T + 128 * 2048, 2048, 0, scr, r / 2, r % 2, lane); continue; } r -= I_W1;
            {
                const int which = r >> 7, i = r & 127; const float* pos = args.in[which ? 14 : 11]; const float* w1 = args.in[which ? 15 : 12];
                float a = 0.f;
                for (int k = lane; k < 2048; k += 64) a += pos[k] * w1[(size_t)k * 128 + i];
                a = wave_sum(a);
                if (lane == 0) bias1[r] = a;
            }
        }
        const float* gain = args.in[1];
        f32x4 gv[4];
#pragma unroll
        for (int j = 0; j < 4; ++j) gv[j] = ((const f32x4*)gain)[lane + 64 * j];
        for (int m = gw; m < M; m += NGW) {
            const f32x4* xr = (const f32x4*)(x + (size_t)m * D) + lane;
            f32x4 v[4]; float s = 0.f;
#pragma unroll
            for (int j = 0; j < 4; ++j) { v[j] = xr[64 * j]; s += (v[j].x * v[j].x + v[j].y * v[j].y) + (v[j].z * v[j].z + v[j].w * v[j].w); }
            const float rstd = rsqrtf(wave_sum(s) * (1.f / D) + EPS);
            unsigned long long* o8 = (unsigned long long*)(Hb + (size_t)m * D) + lane;
#pragma unroll
            for (int j = 0; j < 4; ++j) { const f32x4 y = v[j] * rstd * gv[j]; o8[64 * j] = (unsigned long long)pk2(y.x, y.y) | ((unsigned long long)pk2(y.z, y.w) << 32); }
        }
    }
    SEAM(0);
    if (IN(1)) {
        pg8::Gemm g{Hb, Win_t, D, D, M, NP1, D, 0}; pg8::StaticOrder S; S.init(M, NP1, G, (int)blockIdx.x);
        pg8::EpiP<0> E{P, LDP, 26, 64, Halo};
        pg8::gemm_phase<pg8::EpiP<0>, pg8::StaticOrder, true>(lds, g, S, E);
    }
    SEAM(1);
    if (IN(2)) {
        for (int it = blockIdx.x; it < 128; it += G) {
            const int half = it & 1, which = (it >> 1) & 1, g_ = (it >> 2) & 3, b_ = it >> 4;
            nsa::compress_item(lds, P, W1T + (size_t)which * 128 * 2048, bias1 + which * 128, args.in[which ? 16 : 13], args.in[8], which ? VCb : KCb, b_, g_, which, half);
        }
        STAMP(11);
        nsa::prep_units(P, args.in[7], args.in[9], args.in[10], gw, NGW, lane);
        STAMP(12);
#if !defined(GDN_NAIVE)
        __syncthreads();
        for (int it = blockIdx.x; it < 2048; it += G) { gdn::prep_item(lds, P, Halo, args.in[3], args.in[4], args.in[5], GWb, GQKb, GLv, it >> 8, it & 31, (it >> 5) & 7); if (it < 256) STAMP(14); }
        STAMP(13);
#endif
    }
    SEAM(2);
    if (IN(3)) {
#if defined(GDN_NAIVE)
        if ((int)blockIdx.x < 16) gdn_naive::run(lds, P, args.in[3], args.in[4], args.in[5], args.in[6], 4 * (int)blockIdx.x);
#else
        if ((int)blockIdx.x < 64) gdn::scan_item(lds, P, GWb, GQKb, GLv, args.in[6], (int)blockIdx.x >> 3, (int)blockIdx.x & 7);
#endif
        __syncthreads();
        STAMP(10);
        for (;;) {
            volatile LAS unsigned* qslot = (volatile LAS unsigned*)(lds + 147456 - 16);
            if (tid == 0) *qslot = atomicAdd(qcnt, 1u);
            __syncthreads();
            const int idx = (int)*qslot;
            __syncthreads();
            if (idx >= 1024) break;
#if defined(TPROBE)
            if (blockIdx.x == 200 && tid == 0) { ((volatile unsigned long long*)(ws + 786432))[0] = __builtin_amdgcn_s_memrealtime(); ((volatile unsigned*)(ws + 786432))[4] += 1u; }
#endif
            nsa::attn_tile(lds, P, KCb, VCb, (idx & 31) >> 2, idx & 3, 31 - (idx >> 5));
        }
    }
    SEAM(3);
    if (IN(4)) {
        pg8::Gemm g{Hb, Wg_t, D, D, M, 2048, D, 0}; pg8::StaticOrder S; S.init(M, 2048, G, (int)blockIdx.x);
        pg8::EpiP<1> E{P, LDP, -1, 256, nullptr};
        pg8::gemm_phase<pg8::EpiP<1>, pg8::StaticOrder, true>(lds, g, S, E);
    }
    SEAM(4);
    if (IN(5)) {
        pg8::Gemm g{P + C_DZ, Wcat_t, LDP, 2 * D, M, D, D, D}; pg8::TwoPassOrder S; S.base.init(M, D, G, (int)blockIdx.x);
        pg8::EpiMix E{P, LDP, Mix, D};
        pg8::gemm_phase<pg8::EpiMix, pg8::TwoPassOrder, false>(lds, g, S, E);
    }
    SEAM(5);
    if (IN(6)) {
        for (int it = gw; it < 64 * 16; it += NGW) transpose_item(args.in[22], D, SrcIdent{0}, Wdown_t, FF, 0, scr, it / 16, it % 16, lane);
        __syncthreads();
        pg8::Gemm g{Mix, Wout_t, D, D, M, D, D, 0}; pg8::StaticOrder S; S.init(M, D, G, (int)blockIdx.x);
        pg8::EpiOut E{x, args.out, An, args.in[20], pss};
        pg8::gemm_phase<pg8::EpiOut, pg8::StaticOrder, false>(lds, g, S, E);
    }
    SEAM(6);
    if (IN(7)) {
        pg8::Gemm g{An, Wup_t, D, D, M, FF, D, 0}; pg8::StaticOrder S; S.init(M, FF, G, (int)blockIdx.x);
        pg8::EpiUp E{pss, Up, FF};
        pg8::gemm_phase<pg8::EpiUp, pg8::StaticOrder, true>(lds, g, S, E);
    }
    SEAM(7);
    if (IN(8)) {
        pg8::Gemm g{Up, Wdown_t, FF, FF, M, D, FF, 0}; pg8::StaticOrder S; S.init(M, D, G, (int)blockIdx.x);
        pg8::EpiDown E{args.out};
        pg8::gemm_phase<pg8::EpiDown, pg8::StaticOrder, false>(lds, g, S, E);
    }
#if defined(TPROBE)
    STAMP(9);
    GRID_SYNC();
    if (blockIdx.x == 0) {
        volatile LAS unsigned long long* ts = (volatile LAS unsigned long long*)(lds + 147456 - 512);
        if (tid == 0) { ts[25] = ((volatile unsigned long long*)(ws + 786432))[0]; ts[26] = ts[3] + 100ull * ((volatile unsigned*)(ws + 786432))[4]; }
        const float dA = (float)(ts[TPA1] - ts[TPA0]) * 0.01f, dB = (float)(ts[TPB1] - ts[TPB0]) * 0.01f;
        if (tid == 0) args.out[0] = dA + 0.f * dB;
    }
#endif
#undef IN
#undef SEAM
#undef GRID_SYNC
}

static int g_grid = 0;
static void launch_mk(const Args& a0, int lo, int hi, hipStream_t stream) {
    Args a = a0; a.ph_lo = lo; a.ph_hi = hi;
    void* kargs[] = {(void*)&a};
    hipError_t e = hipLaunchCooperativeKernel((const void*)mk_fwd, dim3(g_grid), dim3(NWAVES * 64), kargs, LDS_BYTES, stream);
    if (e != hipSuccess) fprintf(stderr, "cooperative launch failed: %s (grid %d)\n", hipGetErrorString(e), g_grid);
}

extern "C" void kernel_launch(void* const* d_in, const int* in_sizes, int n_in, void* d_out, int out_size, void* d_ws, size_t ws_size, hipStream_t stream) {
    if (g_grid == 0) {
        int dev = 0, cus = 0, per_cu = 0;
        hipGetDevice(&dev);
        hipDeviceGetAttribute(&cus, hipDeviceAttributeMultiprocessorCount, dev);
        hipFuncSetAttribute((const void*)mk_fwd, hipFuncAttributeMaxDynamicSharedMemorySize, LDS_BYTES);
        hipOccupancyMaxActiveBlocksPerMultiprocessor(&per_cu, (const void*)mk_fwd, NWAVES * 64, LDS_BYTES);
        if (per_cu < 1) per_cu = 1;
        if (per_cu > 1) per_cu = 1;
        g_grid = cus * per_cu;
    }
    Args a{};
    for (int i = 0; i < 23; ++i) a.in[i] = (const float*)d_in[i];
    a.out = (float*)d_out; a.ws = (unsigned char*)d_ws;
    bf16_t* P = (bf16_t*)((char*)d_ws + WS_P);
    launch_mk(a, 0, 9, stream);
}
```

```cpp
#include <hip/hip_runtime.h>
#include <hip/hip_cooperative_groups.h>
#include <stdint.h>
#include <cstdio>
namespace cg = cooperative_groups;

typedef unsigned short bf16_t;

constexpr int D = 1024, BATCH = 8, SEQ = 2048, M = BATCH * SEQ;
constexpr int DN_H = 8, DN_D = 128;
constexpr int NS_H = 16, NS_G = 4, NS_R = 4, NS_D = 64;
constexpr int NCMP = 127, NSEL = 32;
constexpr int FF = 4096;
constexpr int INW = 8768;
constexpr float EPS = 1e-6f;
constexpr float NEGV = -1e30f, FORCEV = 1e9f;

constexpr int LDP = 6720;
constexpr int C_DQ = 0, C_DK = 1024, C_DV = 2048, C_DZ = 3072, C_NQ = 4096;
constexpr int C_KC = 5120, C_VC = 5376, C_KS = 5632, C_VS = 5888, C_KW = 6144, C_VW = 6400;
constexpr int C_SB = 6656, C_SA = 6664, C_SG = 6672;
constexpr int NP1 = 6912;

__device__ __forceinline__ float bf2f(bf16_t v) { return __uint_as_float(((unsigned)v) << 16); }
__device__ __forceinline__ bf16_t f2bf(float f) { unsigned u = __float_as_uint(f); return (bf16_t)((u + 0x7fffu + ((u >> 16) & 1u)) >> 16); }
__device__ __forceinline__ float sigmoidf_(float x) { return 1.f / (1.f + __expf(-x)); }
__device__ __forceinline__ float siluf_(float x) { return x * sigmoidf_(x); }
__device__ __forceinline__ float softplusf_(float x) { return fmaxf(x, 0.f) + log1pf(__expf(-fabsf(x))); }
__device__ __forceinline__ float gelu_tanh(float x) { return 0.5f * x * (1.f + tanhf(0.7978845608028654f * (x + 0.044715f * x * x * x))); }

__device__ __forceinline__ float block_sum(float v, float* red) {
    for (int o = 32; o > 0; o >>= 1) v += __shfl_xor(v, o);
    const int w = threadIdx.x >> 6, nw = blockDim.x >> 6;
    __syncthreads();
    if ((threadIdx.x & 63) == 0) red[w] = v;
    __syncthreads();
    float s = 0.f;
    for (int i = 0; i < nw; ++i) s += red[i];
    return s;
}
__device__ __forceinline__ float block_max(float v, float* red) {
    for (int o = 32; o > 0; o >>= 1) v = fmaxf(v, __shfl_xor(v, o));
    const int w = threadIdx.x >> 6, nw = blockDim.x >> 6;
    __syncthreads();
    if ((threadIdx.x & 63) == 0) red[w] = v;
    __syncthreads();
    float s = red[0];
    for (int i = 1; i < nw; ++i) s = fmaxf(s, red[i]);
    return s;
}


#if defined(TPROBE)
#define XSTAMP(k) do { if (blockIdx.x == 0 && threadIdx.x == 0) ((volatile __attribute__((address_space(3))) unsigned long long*)(lds + 147456 - 512))[k] = __builtin_amdgcn_s_memrealtime(); } while (0)
#else
#define XSTAMP(k) do { } while (0)
#endif
namespace gdn_naive {
#define GLAS __attribute__((address_space(3)))
__device__ __forceinline__ float sub_sum(float v, GLAS float* red, int sub, int tid) {
#pragma unroll
    for (int o = 32; o > 0; o >>= 1) v += __shfl_xor(v, o);
    __syncthreads();
    if ((tid & 63) == 0) red[sub * 2 + ((tid >> 6) & 1)] = v;
    __syncthreads();
    return red[sub * 2] + red[sub * 2 + 1];
}
__device__ __forceinline__ void run(GLAS unsigned char* lds, bf16_t* P, const float* convw, const float* a_log, const float* dt_bias, const float* out_norm, int item0) {
    const int tid = threadIdx.x, sub = tid >> 7, j = tid & 127;
    GLAS float* qs = (GLAS float*)lds + sub * 256; GLAS float* ks = qs + 128; GLAS float* red = (GLAS float*)(lds + 4096);
    const int item = item0 + sub; const int b = item / DN_H, h = item % DN_H;
    float s[128];
#pragma unroll
    for (int i = 0; i < 128; ++i) s[i] = 0.f;
    const float Ah = -__expf(a_log[h]), dtb = dt_bias[h], gn = out_norm[j];
    const float scale = 0.08838834764831845f;
    float wq[4], wk[4], wv[4], xq[3] = {0.f, 0.f, 0.f}, xk[3] = {0.f, 0.f, 0.f}, xv[3] = {0.f, 0.f, 0.f};
#pragma unroll
    for (int t = 0; t < 4; ++t) { wq[t] = convw[t * 3072 + h * 128 + j]; wk[t] = convw[t * 3072 + 1024 + h * 128 + j]; wv[t] = convw[t * 3072 + 2048 + h * 128 + j]; }
    for (int t = 0; t < SEQ; ++t) {
        bf16_t* row = P + (size_t)(b * SEQ + t) * LDP;
        const float rq = bf2f(row[C_DQ + h * DN_D + j]), rk = bf2f(row[C_DK + h * DN_D + j]), rv = bf2f(row[C_DV + h * DN_D + j]);
        float q = siluf_(wq[0] * xq[0] + wq[1] * xq[1] + wq[2] * xq[2] + wq[3] * rq);
        float k = siluf_(wk[0] * xk[0] + wk[1] * xk[1] + wk[2] * xk[2] + wk[3] * rk);
        const float v = siluf_(wv[0] * xv[0] + wv[1] * xv[1] + wv[2] * xv[2] + wv[3] * rv);
        xq[0] = xq[1]; xq[1] = xq[2]; xq[2] = rq; xk[0] = xk[1]; xk[1] = xk[2]; xk[2] = rk; xv[0] = xv[1]; xv[1] = xv[2]; xv[2] = rv;
        const float sq = sub_sum(q * q, red, sub, tid);
        const float sk = sub_sum(k * k, red, sub, tid);
        q *= rsqrtf(sq + EPS); k *= rsqrtf(sk + EPS);
        qs[j] = q; ks[j] = k;
        const float beta = sigmoidf_(bf2f(row[C_SB + h]));
        const float a = __expf(Ah * softplusf_(bf2f(row[C_SA + h]) + dtb));
        const float z = bf2f(row[C_DZ + h * DN_D + j]);
        __syncthreads();
        float kS = 0.f;
#pragma unroll
        for (int i = 0; i < 128; ++i) kS += ks[i] * s[i];
        const float dlt = beta * (v - a * kS);
        asm volatile("" ::: "memory");
        float o = 0.f;
#pragma unroll
        for (int i = 0; i < 128; ++i) { s[i] = a * s[i] + ks[i] * dlt; o += qs[i] * s[i]; }
        o *= scale;
        const float ss = sub_sum(o * o, red, sub, tid);
        row[C_DZ + h * DN_D + j] = f2bf(o * rsqrtf(ss * (1.f / 128.f) + EPS) * gn * siluf_(z));
    }
}
}
namespace gdn {
#define GL3 __attribute__((address_space(3)))
typedef short bf16x8 __attribute__((ext_vector_type(8)));
typedef short s16x4 __attribute__((ext_vector_type(4)));
typedef short v4i16_t __attribute__((ext_vector_type(4)));
typedef float f32x16 __attribute__((ext_vector_type(16)));
typedef float f32x4 __attribute__((ext_vector_type(4)));
typedef float f32x2 __attribute__((ext_vector_type(2)));
typedef unsigned u32x4 __attribute__((ext_vector_type(4)));
typedef unsigned u32x2 __attribute__((ext_vector_type(2)));
typedef __bf16 bf16x2_t __attribute__((ext_vector_type(2)));
constexpr float QSCALE = 0.08838834764831845f;
__device__ __forceinline__ int crow(int i, int hi) { return (i & 3) + 8 * (i >> 2) + 4 * hi; }
__device__ __forceinline__ unsigned pk(float lo, float hi) { f32x2 v = {lo, hi}; bf16x2_t b = __builtin_convertvector(v, bf16x2_t); return __builtin_bit_cast(unsigned, b); }
__device__ __forceinline__ bf16x8 pack8(const float* v) { u32x4 w = {pk(v[0], v[1]), pk(v[2], v[3]), pk(v[4], v[5]), pk(v[6], v[7])}; return __builtin_bit_cast(bf16x8, w); }
__device__ __forceinline__ float blo(unsigned w) { return __uint_as_float(w << 16); }
__device__ __forceinline__ float bhi(unsigned w) { return __uint_as_float(w & 0xffff0000u); }
__device__ __forceinline__ char* seg_addr(bf16_t* P, size_t row0, int c0, unsigned e) { return (char*)P + ((row0 + (e >> 8)) * LDP + c0) * 2 + (e & 255u); }

__device__ __forceinline__ s16x4 vtr(GL3 const unsigned char* p) { return __builtin_bit_cast(s16x4, __builtin_amdgcn_ds_read_tr16_b64_v4i16((GL3 v4i16_t*)p)); }

constexpr int PL_K = 0, PL_KB = 16384, PL_Q = 32768, PL_RV = 49152, PL_AM = 81920, PL_INV = 99328, PL_MT = 116736, PL_GC = 120832, PL_QKST = 121088, PL_TI = 129280, PL_END = 137472;
constexpr int PL_WST = 0, PL_UST = 16384;
constexpr int AMLD = 68;
__device__ __forceinline__ void prep_item(GL3 unsigned char* lds, bf16_t* P, const bf16_t* HALO, const float* convw, const float* a_log, const float* dt_bias,
                                          bf16_t* GW, bf16_t* GQK, float* GLv, int b, int n, int h) {
    int tid = threadIdx.x; asm volatile("" : "+v"(tid));
    const int lane = tid & 63, r32 = lane & 31, hi = lane >> 5; const int wid = __builtin_amdgcn_readfirstlane(tid >> 6);
    const size_t row0 = (size_t)b * SEQ + 64 * n; const int item = (b * DN_H + h) * 32 + n;
    GL3 float* AM = (GL3 float*)(lds + PL_AM); GL3 float* INV = (GL3 float*)(lds + PL_INV); GL3 float* MT = (GL3 float*)(lds + PL_MT); GL3 float* GC = (GL3 float*)(lds + PL_GC);
    float gcum, beta_l, gc_last;
    {
        const bf16_t* prow = P + (row0 + lane) * LDP;
        beta_l = sigmoidf_(bf2f(prow[C_SB + h]));
        gcum = -__expf(a_log[h]) * softplusf_(bf2f(prow[C_SA + h]) + dt_bias[h]);
#pragma unroll
        for (int o = 1; o < 64; o <<= 1) { const float t = __shfl_up(gcum, o); if (lane >= o) gcum += t; }
        gc_last = __shfl(gcum, 63);
        if (wid == 0) GC[lane] = gcum;
    }
    bf16x8 qd_keep[2], ke_keep[2];
    const int dc = lane & 15;
#pragma unroll
    for (int pass = 0; pass < 2; ++pass) {
        const int tok = 8 * wid + 4 * pass + (lane >> 4);
        const float gct = __shfl(gcum, tok), bet = __shfl(beta_l, tok);
        float y[3][8];
#pragma unroll
        for (int which = 0; which < 3; ++which) {
            const int col = which * 1024 + h * 128 + dc * 8;
#pragma unroll
            for (int e = 0; e < 8; ++e) y[which][e] = 0.f;
#pragma unroll
            for (int j = 0; j < 4; ++j) {
                const int rr = tok - 3 + j;
                const bool inb = rr >= 0;
                const bf16_t* src = inb ? (P + (row0 + (inb ? rr : 0)) * LDP + col) : (HALO + ((size_t)((b * 32 + (n > 0 ? n - 1 : 0)) * 3 + (inb ? 0 : 3 + rr))) * 3072 + col);
                u32x4 x = *(const u32x4*)src;
                if (!inb && n == 0) x = (u32x4){0u, 0u, 0u, 0u};
                const f32x4 w0 = *(const f32x4*)(convw + j * 3072 + col), w1 = *(const f32x4*)(convw + j * 3072 + col + 4);
                y[which][0] += w0[0] * blo(x.x); y[which][1] += w0[1] * bhi(x.x); y[which][2] += w0[2] * blo(x.y); y[which][3] += w0[3] * bhi(x.y);
                y[which][4] += w1[0] * blo(x.z); y[which][5] += w1[1] * bhi(x.z); y[which][6] += w1[2] * blo(x.w); y[which][7] += w1[3] * bhi(x.w);
            }
#pragma unroll
            for (int e = 0; e < 8; ++e) y[which][e] = siluf_(y[which][e]);
        }
        float sq = 0.f, sk = 0.f;
#pragma unroll
        for (int e = 0; e < 8; ++e) { sq += y[0][e] * y[0][e]; sk += y[1][e] * y[1][e]; }
#pragma unroll
        for (int o = 1; o < 16; o <<= 1) { sq += __shfl_xor(sq, o); sk += __shfl_xor(sk, o); }
        const float rq = rsqrtf(sq + EPS), rk = rsqrtf(sk + EPS);
        const float eg = __expf(gct), ke_s = __expf(gc_last - gct);
        float q8[8], k8[8], kb8[8], qd8[8], ke8[8], kbg8[8], vb8[8];
#pragma unroll
        for (int e = 0; e < 8; ++e) { q8[e] = y[0][e] * rq; k8[e] = y[1][e] * rk; kb8[e] = k8[e] * bet; qd8[e] = q8[e] * (QSCALE * eg); ke8[e] = k8[e] * ke_s; kbg8[e] = kb8[e] * eg; vb8[e] = y[2][e] * bet; }
        const int io = (dc * 64 + tok) * 16;
        *(GL3 bf16x8*)(lds + PL_Q + io) = pack8(q8); *(GL3 bf16x8*)(lds + PL_K + io) = pack8(k8); *(GL3 bf16x8*)(lds + PL_KB + io) = pack8(kb8);
        {
            const int rvo = (tok >> 4) * 1024 + ((tok >> 3) & 1) * 512 + (tok & 7) * 64 + (dc & 3) * 16;
            *(GL3 bf16x8*)(lds + PL_RV + (dc >> 2) * 4096 + rvo) = pack8(kbg8); *(GL3 bf16x8*)(lds + PL_RV + (4 + (dc >> 2)) * 4096 + rvo) = pack8(vb8);
        }
        qd_keep[pass] = pack8(qd8); ke_keep[pass] = pack8(ke8);
    }
    __syncthreads();
    if (n == 0 && b == 0 && h == 0) XSTAMP(15);
#pragma unroll
    for (int pass = 0; pass < 2; ++pass) {
        const int tok = 8 * wid + 4 * pass + (lane >> 4);
        *(bf16x8*)seg_addr(P, row0, C_DQ + h * 128, (unsigned)((dc * 64 + tok) * 16)) = qd_keep[pass];
        const unsigned ek = (unsigned)(((dc >> 2) * 4 + (tok >> 4)) * 1024 + ((tok >> 3) & 1) * 512 + (tok & 7) * 64 + (dc & 3) * 16);
        *(bf16x8*)seg_addr(P, row0, C_DK + h * 128, ek) = ke_keep[pass];
    }
    if (wid < 6) {
        const bool isA = wid < 3; const int t3 = isA ? wid : wid - 3;
        const int rt = isA ? (t3 > 0) : (t3 == 2);
        const int ct = isA ? (t3 == 2) : (t3 > 0);
        GL3 const unsigned char* aimg = lds + (isA ? PL_KB : PL_K); GL3 const unsigned char* bimg = lds + (isA ? PL_K : PL_Q);
        f32x16 acc = f32x16{};
#pragma unroll
        for (int s = 0; s < 8; ++s) {
            const bf16x8 a = *(GL3 const bf16x8*)(aimg + ((2 * s + hi) * 64 + 32 * rt + r32) * 16);
            const bf16x8 bb = *(GL3 const bf16x8*)(bimg + ((2 * s + hi) * 64 + 32 * ct + r32) * 16);
            acc = __builtin_amdgcn_mfma_f32_32x32x16_bf16(a, bb, acc, 0, 0, 0);
        }
        if (isA) {
            const int j = 32 * ct + r32; const float gj = GC[j];
#pragma unroll
            for (int i_ = 0; i_ < 16; ++i_) { const int i = 32 * rt + crow(i_, hi); AM[i * AMLD + j] = (j < i) ? acc[i_] * __expf(GC[i] - gj) : 0.f; }
        } else {
            const int i = 32 * ct + r32; const float gi = GC[i];
            float v[16];
#pragma unroll
            for (int i_ = 0; i_ < 16; ++i_) { const int j = 32 * rt + crow(i_, hi); v[i_] = (j <= i) ? acc[i_] * (QSCALE * __expf(gi - GC[j])) : 0.f; }
#pragma unroll
            for (int sp = 0; sp < 2; ++sp) *(GL3 bf16x8*)(lds + PL_QKST + (((2 * rt + sp) * 64 + i) * 16 + 8 * hi) * 2) = pack8(v + 8 * sp);
        }
    } else if (wid == 6) {
        const bf16x8 z = {0, 0, 0, 0, 0, 0, 0, 0};
#pragma unroll
        for (int sp = 0; sp < 2; ++sp) *(GL3 bf16x8*)(lds + PL_QKST + (((2 + sp) * 64 + r32) * 16 + 8 * hi) * 2) = z;
    }
    __syncthreads();
    if (wid < 4 && lane < 16) {
        const int bb = wid, c = lane;
        float x[16];
#pragma unroll
        for (int i = 0; i < 16; ++i) {
            float acc = (i == c) ? 1.f : 0.f;
#pragma unroll
            for (int j4 = 0; j4 < i; j4 += 4) { const f32x4 a = *(GL3 const f32x4*)(AM + (16 * bb + i) * AMLD + 16 * bb + j4);
                acc -= a[0] * x[j4]; if (j4 + 1 < i) acc -= a[1] * x[j4 + 1]; if (j4 + 2 < i) acc -= a[2] * x[j4 + 2]; if (j4 + 3 < i) acc -= a[3] * x[j4 + 3]; }
            x[i] = acc;
        }
#pragma unroll
        for (int i = 0; i < 16; ++i) INV[(16 * bb + i) * AMLD + 16 * bb + c] = x[i];
    }
    __syncthreads();
    for (int L = 1; L < 4; ++L) {
        const int nb = 4 - L;
        for (int t = tid; t < nb * 256; t += 512) {
            const int J = t >> 8, I = J + L, ei = (t >> 4) & 15, ej = t & 15;
            float acc = 0.f;
            for (int K = J; K < I; ++K) {
#pragma unroll
                for (int k4 = 0; k4 < 16; k4 += 4) { const f32x4 a = *(GL3 const f32x4*)(AM + (16 * I + ei) * AMLD + 16 * K + k4);
                    acc += a[0] * INV[(16 * K + k4) * AMLD + 16 * J + ej] + a[1] * INV[(16 * K + k4 + 1) * AMLD + 16 * J + ej] + a[2] * INV[(16 * K + k4 + 2) * AMLD + 16 * J + ej] + a[3] * INV[(16 * K + k4 + 3) * AMLD + 16 * J + ej]; }
            }
            MT[(J * 16 + ei) * 17 + ej] = acc;
        }
        __syncthreads();
        for (int t = tid; t < nb * 256; t += 512) {
            const int J = t >> 8, I = J + L, ei = (t >> 4) & 15, ej = t & 15;
            float acc = 0.f;
#pragma unroll
            for (int k4 = 0; k4 < 16; k4 += 4) { const f32x4 d = *(GL3 const f32x4*)(INV + (16 * I + ei) * AMLD + 16 * I + k4);
                acc += d[0] * MT[(J * 16 + k4) * 17 + ej] + d[1] * MT[(J * 16 + k4 + 1) * 17 + ej] + d[2] * MT[(J * 16 + k4 + 2) * 17 + ej] + d[3] * MT[(J * 16 + k4 + 3) * 17 + ej]; }
            INV[(16 * I + ei) * AMLD + 16 * J + ej] = -acc;
        }
        __syncthreads();
    }
    {
        const int s_ = tid >> 7, i = (tid >> 1) & 63, hh = tid & 1;
        float v[8];
        if (s_ > (i >> 4)) {
#pragma unroll
            for (int e = 0; e < 8; ++e) v[e] = 0.f;
        } else {
            const f32x4 a = *(GL3 const f32x4*)(INV + i * AMLD + 16 * s_ + 4 * hh), c4 = *(GL3 const f32x4*)(INV + i * AMLD + 16 * s_ + 8 + 4 * hh);
            v[0] = a[0]; v[1] = a[1]; v[2] = a[2]; v[3] = a[3]; v[4] = c4[0]; v[5] = c4[1]; v[6] = c4[2]; v[7] = c4[3];
        }
        *(GL3 bf16x8*)(lds + PL_TI + ((s_ * 64 + i) * 16 + 8 * hh) * 2) = pack8(v);
    }
    __syncthreads();
    {
        const int cb = wid;
        GL3 const unsigned char* rp = lds + PL_RV + cb * 4096 + ((lane >> 4) & 1) * 32 + (lane & 3) * 8 + (4 * hi + ((lane & 15) >> 2)) * 64;
        f32x16 d0 = f32x16{}, d1 = f32x16{};
#pragma unroll
        for (int ks = 0; ks < 4; ++ks) {
            const s16x4 lo = vtr(rp + ks * 1024), hh2 = vtr(rp + ks * 1024 + 512);
            const bf16x8 rf = {lo[0], lo[1], lo[2], lo[3], hh2[0], hh2[1], hh2[2], hh2[3]};
            const bf16x8 t1 = *(GL3 const bf16x8*)(lds + PL_TI + ((ks * 64 + 32 + r32) * 16 + 8 * hi) * 2);
            if (cb < 4) {
                if (ks < 2) { const bf16x8 t0 = *(GL3 const bf16x8*)(lds + PL_TI + ((ks * 64 + r32) * 16 + 8 * hi) * 2); d0 = __builtin_amdgcn_mfma_f32_32x32x16_bf16(rf, t0, d0, 0, 0, 0); }
                d1 = __builtin_amdgcn_mfma_f32_32x32x16_bf16(rf, t1, d1, 0, 0, 0);
            } else {
                if (ks < 2) { const bf16x8 t0 = *(GL3 const bf16x8*)(lds + PL_TI + ((ks * 64 + r32) * 16 + 8 * hi) * 2); d0 = __builtin_amdgcn_mfma_f32_32x32x16_bf16(t0, rf, d0, 0, 0, 0); }
                d1 = __builtin_amdgcn_mfma_f32_32x32x16_bf16(t1, rf, d1, 0, 0, 0);
            }
        }
        __syncthreads();
        if (cb < 4) {
#pragma unroll
            for (int a = 0; a < 4; ++a) {
                u32x2 w0 = {pk(d0[4 * a], d0[4 * a + 1]), pk(d0[4 * a + 2], d0[4 * a + 3])}, w1 = {pk(d1[4 * a], d1[4 * a + 1]), pk(d1[4 * a + 2], d1[4 * a + 3])};
                *(GL3 u32x2*)(lds + PL_WST + ((4 * cb + a) * 64 + r32) * 16 + 8 * hi) = w0;
                *(GL3 u32x2*)(lds + PL_WST + ((4 * cb + a) * 64 + 32 + r32) * 16 + 8 * hi) = w1;
            }
        } else {
            const int dvc = 32 * (cb - 4) + r32;
#pragma unroll
            for (int i = 0; i < 16; ++i) { *(GL3 bf16_t*)(lds + PL_UST + (crow(i, hi) * 128 + dvc) * 2) = f2bf(d0[i]); *(GL3 bf16_t*)(lds + PL_UST + ((32 + crow(i, hi)) * 128 + dvc) * 2) = f2bf(d1[i]); }
        }
    }
    __syncthreads();
#pragma unroll
    for (int k = 0; k < 2; ++k) {
        const int e = (tid + 512 * k) * 16;
        *(u32x4*)((char*)(GW + (size_t)item * 8192) + e) = *(GL3 const u32x4*)(lds + PL_WST + e);
        *(u32x4*)seg_addr(P, row0, C_DV + h * 128, (unsigned)e) = *(GL3 const u32x4*)(lds + PL_UST + e);
    }
    *(u32x4*)((char*)(GQK + (size_t)item * 4096) + tid * 16) = *(GL3 const u32x4*)(lds + PL_QKST + tid * 16);
    if (tid == 0) GLv[item] = __expf(gc_last);
    __syncthreads();
}

constexpr int SL_W = 0, SL_QD = 16384, SL_KE = 32768, SL_QK = 49152, SL_U = 57344, SL_Z = 73728, SL_S = 90112, SL_VN = 122880, SL_RS = 139264, SL_END = 140416;
__device__ __forceinline__ void glds16(const void* gsrc, unsigned lds_dst) { unsigned keep;
    asm volatile("s_mov_b32 %0, m0\n\ts_mov_b32 m0, %2\n\ts_nop 0\n\tglobal_load_lds_dwordx4 %1, off\n\ts_mov_b32 m0, %0" : "=&s"(keep) : "v"(gsrc), "s"(lds_dst) : "memory"); }
__device__ __forceinline__ unsigned lds_addr(GL3 unsigned char* p) { return (unsigned)(size_t)p; }
__device__ __forceinline__ void dma_seg(GL3 unsigned char* dst, const bf16_t* P, size_t row0, int c0, int wid, int lane) {
#pragma unroll
    for (int k = 0; k < 2; ++k) { const int piece = wid + 8 * k;
        const char* src = (const char*)P + ((row0 + piece * 4 + (lane >> 4)) * LDP + c0) * 2 + (lane & 15) * 16;
        glds16(src, (unsigned)__builtin_amdgcn_readfirstlane((int)(lds_addr(dst) + piece * 1024))); }
}
template <int NPIECES>
__device__ __forceinline__ void dma_lin(GL3 unsigned char* dst, const bf16_t* src, int wid, int lane) {
#pragma unroll
    for (int k = 0; k < NPIECES / 8; ++k) { const int piece = wid + 8 * k;
        glds16((const char*)src + piece * 1024 + lane * 16, (unsigned)__builtin_amdgcn_readfirstlane((int)(lds_addr(dst) + piece * 1024))); }
}

__device__ __forceinline__ float sum32(float v) {
    v += __builtin_bit_cast(float, __builtin_amdgcn_mov_dpp(__builtin_bit_cast(int, v), 0xB1, 0xF, 0xF, true));
    v += __builtin_bit_cast(float, __builtin_amdgcn_mov_dpp(__builtin_bit_cast(int, v), 0x4E, 0xF, 0xF, true));
    v += __builtin_bit_cast(float, __builtin_amdgcn_mov_dpp(__builtin_bit_cast(int, v), 0x141, 0xF, 0xF, true));
    v += __builtin_bit_cast(float, __builtin_amdgcn_mov_dpp(__builtin_bit_cast(int, v), 0x140, 0xF, 0xF, true));
    v += __shfl_xor(v, 16);
    return v;
}
#define GRAWBAR() do { asm volatile("s_waitcnt lgkmcnt(0)" ::: "memory"); __builtin_amdgcn_s_barrier(); asm volatile("" ::: "memory"); } while (0)
#define GWAITV0() asm volatile("s_waitcnt vmcnt(0)" ::: "memory")
constexpr int SL_GL = SL_RS + 1024;
__device__ __forceinline__ void scan_item(GL3 unsigned char* lds, bf16_t* P, const bf16_t* GW, const bf16_t* GQK, const float* GLv, const float* out_norm, int b, int h) {
    const int tid = threadIdx.x, lane = tid & 63, r32 = lane & 31, hi = lane >> 5; const int wid = __builtin_amdgcn_readfirstlane(tid >> 6);
    const int mt = wid >> 2, nt = wid & 3;
    const int dv = 32 * nt + r32;
    const int item0 = (b * DN_H + h) * 32; const size_t rowb = (size_t)b * SEQ;
    f32x16 S0 = f32x16{}, S1 = f32x16{};
    {
        const u32x4 z = {0u, 0u, 0u, 0u};
#pragma unroll
        for (int k = 0; k < 4; ++k) *(GL3 u32x4*)(lds + SL_S + (tid + 512 * k) * 16) = z;
        if (tid < 32) *(GL3 float*)(lds + SL_GL + tid * 4) = GLv[item0 + tid];
    }
    const float gain = out_norm[dv];
    GL3 float* RS = (GL3 float*)(lds + SL_RS);
#define ISSUE_A(n_) do { dma_lin<16>(lds + SL_W, GW + (size_t)(item0 + (n_)) * 8192, wid, lane); dma_seg(lds + SL_QD, P, rowb + 64 * (n_), C_DQ + h * 128, wid, lane); dma_seg(lds + SL_U, P, rowb + 64 * (n_), C_DV + h * 128, wid, lane); } while (0)
#define ISSUE_B(n_) do { dma_seg(lds + SL_KE, P, rowb + 64 * (n_), C_DK + h * 128, wid, lane); dma_lin<8>(lds + SL_QK, GQK + (size_t)(item0 + (n_)) * 4096, wid, lane); dma_seg(lds + SL_Z, P, rowb + 64 * (n_), C_DZ + h * 128, wid, lane); } while (0)
    GWAITV0();
    ISSUE_A(0);
    for (int n = 0; n < 32; ++n) {
        const size_t row0 = rowb + 64 * n;
        GWAITV0(); GRAWBAR();
        ISSUE_B(n);
        const float gl = *(GL3 const float*)(lds + SL_GL + n * 4);
        f32x16 vp = f32x16{}, o = f32x16{};
#pragma unroll
        for (int s = 0; s < 8; ++s) {
            const bf16x8 sb = *(GL3 const bf16x8*)(lds + SL_S + ((2 * s + hi) * 128 + dv) * 16);
            const bf16x8 wa = *(GL3 const bf16x8*)(lds + SL_W + ((2 * s + hi) * 64 + 32 * mt + r32) * 16);
            const bf16x8 qa = *(GL3 const bf16x8*)(lds + SL_QD + ((2 * s + hi) * 64 + 32 * mt + r32) * 16);
            vp = __builtin_amdgcn_mfma_f32_32x32x16_bf16(wa, sb, vp, 0, 0, 0);
            o = __builtin_amdgcn_mfma_f32_32x32x16_bf16(qa, sb, o, 0, 0, 0);
        }
        {
            float v[16];
#pragma unroll
            for (int i = 0; i < 16; ++i) v[i] = bf2f(*(GL3 const bf16_t*)(lds + SL_U + ((32 * mt + crow(i, hi)) * 128 + dv) * 2)) - vp[i];
#pragma unroll
            for (int sp = 0; sp < 2; ++sp) *(GL3 bf16x8*)(lds + SL_VN + (((2 * mt + sp) * 128 + dv) * 16 + 8 * hi) * 2) = pack8(v + 8 * sp);
        }
        GWAITV0(); GRAWBAR();
        if (n + 1 < 32) ISSUE_A(n + 1);
#pragma unroll
        for (int i = 0; i < 16; ++i) { S0[i] *= gl; S1[i] *= gl; }
        {
            GL3 const unsigned char* kp0 = lds + SL_KE + (2 * mt) * 4096 + ((lane >> 4) & 1) * 32 + (lane & 3) * 8 + (4 * hi + ((lane & 15) >> 2)) * 64;
#pragma unroll
            for (int ks = 0; ks < 4; ++ks) {
                const bf16x8 vb = *(GL3 const bf16x8*)(lds + SL_VN + ((ks * 128 + dv) * 16 + 8 * hi) * 2);
                const s16x4 l0 = vtr(kp0 + ks * 1024), h0 = vtr(kp0 + ks * 1024 + 512), l1 = vtr(kp0 + 4096 + ks * 1024), h1 = vtr(kp0 + 4096 + ks * 1024 + 512);
                const bf16x8 k0 = {l0[0], l0[1], l0[2], l0[3], h0[0], h0[1], h0[2], h0[3]}, k1 = {l1[0], l1[1], l1[2], l1[3], h1[0], h1[1], h1[2], h1[3]};
                const bf16x8 qa = *(GL3 const bf16x8*)(lds + SL_QK + ((ks * 64 + 32 * mt + r32) * 16 + 8 * hi) * 2);
                S0 = __builtin_amdgcn_mfma_f32_32x32x16_bf16(k0, vb, S0, 0, 0, 0);
                S1 = __builtin_amdgcn_mfma_f32_32x32x16_bf16(k1, vb, S1, 0, 0, 0);
                o = __builtin_amdgcn_mfma_f32_32x32x16_bf16(qa, vb, o, 0, 0, 0);
            }
        }
#pragma unroll
        for (int i = 0; i < 16; ++i) { const float q = sum32(o[i] * o[i]); if (r32 == 0) RS[(32 * mt + crow(i, hi)) * 4 + nt] = q; }
        GRAWBAR();
#pragma unroll
        for (int a = 0; a < 4; ++a) {
            u32x2 w0 = {pk(S0[4 * a], S0[4 * a + 1]), pk(S0[4 * a + 2], S0[4 * a + 3])}, w1 = {pk(S1[4 * a], S1[4 * a + 1]), pk(S1[4 * a + 2], S1[4 * a + 3])};
            *(GL3 u32x2*)(lds + SL_S + ((4 * (2 * mt) + a) * 128 + dv) * 16 + 8 * hi) = w0;
            *(GL3 u32x2*)(lds + SL_S + ((4 * (2 * mt + 1) + a) * 128 + dv) * 16 + 8 * hi) = w1;
        }
#pragma unroll
        for (int i = 0; i < 16; ++i) { const int tok = 32 * mt + crow(i, hi);
            const f32x4 rs = *(GL3 const f32x4*)(RS + tok * 4);
            const float rstd = rsqrtf(((rs[0] + rs[1]) + (rs[2] + rs[3])) * (1.f / 128.f) + EPS);
            const float z = bf2f(*(GL3 const bf16_t*)(lds + SL_Z + (tok * 128 + dv) * 2));
            *(GL3 bf16_t*)(lds + SL_VN + (tok * 128 + dv) * 2) = f2bf(o[i] * rstd * gain * siluf_(z)); }
        GRAWBAR();
#pragma unroll
        for (int k = 0; k < 2; ++k) { const int e = (tid + 512 * k) * 16; *(u32x4*)seg_addr(P, row0, C_DZ + h * 128, (unsigned)e) = *(GL3 const u32x4*)(lds + SL_VN + e); }
    }
    GWAITV0();
    __syncthreads();
#undef ISSUE_A
#undef ISSUE_B
}
}
namespace nsa {
#define NLAS __attribute__((address_space(3)))
typedef short bf16x8 __attribute__((ext_vector_type(8)));
typedef short s16x4 __attribute__((ext_vector_type(4)));
typedef short v4i16_t __attribute__((ext_vector_type(4)));
typedef float f32x16 __attribute__((ext_vector_type(16)));
typedef float f32x4 __attribute__((ext_vector_type(4)));
typedef float f32x2 __attribute__((ext_vector_type(2)));
typedef unsigned u32x4 __attribute__((ext_vector_type(4)));
typedef __bf16 bf16x2_t __attribute__((ext_vector_type(2)));
constexpr float LOG2E = 1.4426950408889634f;
constexpr float NEG = -1e30f;
constexpr int L_KV = 0;
constexpr int L_IMP = 32768;
constexpr int L_SEL = 65536;
constexpr int L_WS = 66048;
constexpr int L_OST = 68096;
constexpr int L_END = 100864;

__device__ __forceinline__ int crow(int i, int hi) { return (i & 3) + 8 * (i >> 2) + 4 * hi; }
__device__ __forceinline__ unsigned pk(float lo, float hi) { f32x2 v = {lo, hi}; bf16x2_t b = __builtin_convertvector(v, bf16x2_t); return __builtin_bit_cast(unsigned, b); }
__device__ __forceinline__ float xhalf_max(float v) { auto rr = __builtin_amdgcn_permlane32_swap(__float_as_uint(v), __float_as_uint(v), false, false); return fmaxf(__uint_as_float(rr[0]), __uint_as_float(rr[1])); }
__device__ __forceinline__ float xhalf_sum(float v) { auto rr = __builtin_amdgcn_permlane32_swap(__float_as_uint(v), __float_as_uint(v), false, false); return __uint_as_float(rr[0]) + __uint_as_float(rr[1]); }

__device__ __forceinline__ void dma_tile(NLAS unsigned char* slot, const bf16_t* Kb, const bf16_t* Vb, unsigned koff, unsigned voff, int wid) {
    __builtin_amdgcn_global_load_lds((const unsigned*)((const char*)Kb + koff), (NLAS unsigned*)(slot + wid * 1024), 16, 0, 0);
    __builtin_amdgcn_global_load_lds((const unsigned*)((const char*)Vb + voff), (NLAS unsigned*)(slot + 8192 + wid * 1024), 16, 0, 0);
}
__device__ __forceinline__ void tile_offs(unsigned& koff, unsigned& voff, int pitch, int wid, int lane) {
    koff = (unsigned)(lane * pitch + wid * 8) * 2u;
    voff = (unsigned)((16 * (wid & 3) + (lane >> 2)) * pitch + (wid >> 2) * 32 + (lane & 3) * 8) * 2u;
}
__device__ __forceinline__ void qkt(f32x16& p0, f32x16& p1, NLAS const unsigned char* Kslot, const bf16x8* qr, const f32x16& c0, const f32x16& c1, int r32, int hi) {
    NLAS const unsigned char* kb = Kslot + hi * 1024 + r32 * 16;
#pragma unroll
    for (int d0 = 0; d0 < 4; ++d0) {
        const bf16x8 b0 = *(NLAS const bf16x8*)(kb + d0 * 2048);
        const bf16x8 b1 = *(NLAS const bf16x8*)(kb + d0 * 2048 + 512);
        if (d0 == 0) { p0 = __builtin_amdgcn_mfma_f32_32x32x16_bf16(b0, qr[0], c0, 0, 0, 0); p1 = __builtin_amdgcn_mfma_f32_32x32x16_bf16(b1, qr[0], c1, 0, 0, 0); }
        else { p0 = __builtin_amdgcn_mfma_f32_32x32x16_bf16(b0, qr[d0], p0, 0, 0, 0); p1 = __builtin_amdgcn_mfma_f32_32x32x16_bf16(b1, qr[d0], p1, 0, 0, 0); }
    }
}
__device__ __forceinline__ s16x4 vtr(NLAS const unsigned char* p) { return __builtin_bit_cast(s16x4, __builtin_amdgcn_ds_read_tr16_b64_v4i16((NLAS v4i16_t*)p)); }
__device__ __forceinline__ void pv(f32x16* o, NLAS const unsigned char* Vslot, const f32x16& p0, const f32x16& p1, int lane, int hi) {
    u32x4 w0 = {pk(p0[0], p0[1]), pk(p0[2], p0[3]), pk(p0[4], p0[5]), pk(p0[6], p0[7])};
    u32x4 w1 = {pk(p0[8], p0[9]), pk(p0[10], p0[11]), pk(p0[12], p0[13]), pk(p0[14], p0[15])};
    u32x4 w2 = {pk(p1[0], p1[1]), pk(p1[2], p1[3]), pk(p1[4], p1[5]), pk(p1[6], p1[7])};
    u32x4 w3 = {pk(p1[8], p1[9]), pk(p1[10], p1[11]), pk(p1[12], p1[13]), pk(p1[14], p1[15])};
    const bf16x8 pa[4] = {__builtin_bit_cast(bf16x8, w0), __builtin_bit_cast(bf16x8, w1), __builtin_bit_cast(bf16x8, w2), __builtin_bit_cast(bf16x8, w3)};
    NLAS const unsigned char* vp = Vslot + ((lane >> 4) & 1) * 32 + (lane & 3) * 8 + (4 * hi + ((lane & 15) >> 2)) * 64;
#pragma unroll
    for (int d0 = 0; d0 < 2; ++d0)
#pragma unroll
        for (int ks = 0; ks < 4; ++ks) {
            const s16x4 lo = vtr(vp + d0 * 4096 + ks * 1024), hh = vtr(vp + d0 * 4096 + ks * 1024 + 512);
            const bf16x8 vf = {lo[0], lo[1], lo[2], lo[3], hh[0], hh[1], hh[2], hh[3]};
            o[d0] = __builtin_amdgcn_mfma_f32_32x32x16_bf16(pa[ks], vf, o[d0], 0, 0, 0);
        }
}
__device__ __forceinline__ void scale_rows(f32x16* o, NLAS float* wsf, float s, int r32, int hi) {
    if (hi == 0) wsf[r32] = s;
#pragma unroll
    for (int i = 0; i < 16; ++i) { const float f = wsf[crow(i, hi)]; o[0][i] *= f; o[1][i] *= f; }
}
__device__ __forceinline__ void acc_rows(f32x16* tot, const f32x16* o, NLAS float* wsf, float s, int r32, int hi) {
    if (hi == 0) wsf[32 + r32] = s;
#pragma unroll
    for (int i = 0; i < 16; ++i) { const float f = wsf[32 + crow(i, hi)]; tot[0][i] += f * o[0][i]; tot[1][i] += f * o[1][i]; }
}
__device__ __forceinline__ void softmax_step(f32x16& p0, f32x16& p1, float& m, float& l, f32x16* o, NLAS float* wsf, int r32, int hi) {
    float t = fmaxf(p0[0], p1[0]);
#pragma unroll
    for (int i = 1; i < 16; ++i) t = fmaxf(t, fmaxf(p0[i], p1[i]));
    t = xhalf_max(t);
    const float mn = fmaxf(m, t);
    const float alpha = __builtin_amdgcn_exp2f(m - mn);
    float s = 0.f;
#pragma unroll
    for (int i = 0; i < 16; ++i) { p0[i] = __builtin_amdgcn_exp2f(p0[i] - mn); p1[i] = __builtin_amdgcn_exp2f(p1[i] - mn); s += p0[i] + p1[i]; }
    l = l * alpha + s; m = mn;
    if (__any(alpha != 1.f)) scale_rows(o, wsf, alpha, r32, hi);
}

__device__ __forceinline__ void attn_tile(NLAS unsigned char* lds, bf16_t* P, const bf16_t* KC, const bf16_t* VC, int b, int g, int qt) {
    int tid = threadIdx.x; asm volatile("" : "+v"(tid));
    const int lane = tid & 63, r32 = lane & 31, hi = lane >> 5; const int wid = __builtin_amdgcn_readfirstlane(tid >> 6);
    const int head = g * 4 + (wid >> 1), qh = wid & 1, t0 = qt * 64, qi = qh * 32 + r32, blk_t = qt;
    NLAS float* wsf = (NLAS float*)(lds + L_WS) + wid * 64;
    NLAS float* imp = (NLAS float*)(lds + L_IMP);
    NLAS unsigned* selm = (NLAS unsigned*)(lds + L_SEL);
    NLAS unsigned char* slot0 = lds + L_KV; NLAS unsigned char* slot1 = lds + L_KV + 16384;
    const size_t rowbase = (size_t)b * SEQ;
    bf16_t* qrow = P + (rowbase + t0 + qi) * LDP;
    const float sl2 = exp2f(-0.5f * (float)(head + 1)) * LOG2E;
    bf16x8 qr[4];
#pragma unroll
    for (int d0 = 0; d0 < 4; ++d0) qr[d0] = *(const bf16x8*)(qrow + C_NQ + head * 64 + d0 * 16 + hi * 8);
    const float gate_c = sigmoidf_(bf2f(qrow[C_SG + head * 3 + 0])), gate_s = sigmoidf_(bf2f(qrow[C_SG + head * 3 + 1])), gate_w = sigmoidf_(bf2f(qrow[C_SG + head * 3 + 2]));
    f32x16 tot[2]; tot[0] = f32x16{}; tot[1] = f32x16{};
#define CRF(i) ((float)(((i) & 3) + 8 * ((i) >> 2)) + 4.f * (float)hiv)
#define OPAQUE_HI() int hiv = hi; asm volatile("" : "+v"(hiv))

    {
        const bf16_t* kcb = KC + ((size_t)(b * NS_G + g) * 128) * 64; const bf16_t* vcb = VC + ((size_t)(b * NS_G + g) * 128) * 64;
        const bool two = (qt >= 16);
        unsigned kof, vof; tile_offs(kof, vof, 64, wid, lane);
        dma_tile(slot0, kcb, vcb, kof, vof, wid);
        if (two) dma_tile(slot1, kcb + 64 * 64, vcb + 64 * 64, kof, vof, wid);
        __syncthreads();
        f32x16 pA0, pA1, pB0, pB1, c0, c1;
        const float s16 = sl2 * 16.f; OPAQUE_HI();
#pragma unroll
        for (int i = 0; i < 16; ++i) { c0[i] = s16 * CRF(i); c1[i] = s16 * (CRF(i) + 32.f); }
        qkt(pA0, pA1, slot0, qr, c0, c1, r32, hi);
        const int cmax = (t0 + qi - 31) >> 4;
        const int qposm = t0 + qi - 31;
#pragma unroll
        for (int i = 0; i < 16; ++i) { const int c = crow(i, hiv); if (16 * c > qposm) pA0[i] = NEG; if (16 * (c + 32) > qposm) pA1[i] = NEG; }
        if (two) {
#pragma unroll
            for (int i = 0; i < 16; ++i) { c0[i] += s16 * 64.f; c1[i] += s16 * 64.f; }
            qkt(pB0, pB1, slot1, qr, c0, c1, r32, hi);
#pragma unroll
            for (int i = 0; i < 16; ++i) { const int c = 64 + crow(i, hiv); if (16 * c > qposm) pB0[i] = NEG; if (16 * (c + 32) > qposm) pB1[i] = NEG; }
        } else { pB0 = f32x16{}; pB1 = f32x16{};
#pragma unroll
            for (int i = 0; i < 16; ++i) { pB0[i] = NEG; pB1[i] = NEG; } }
        (void)cmax;
        float mx = NEG;
#pragma unroll
        for (int i = 0; i < 16; ++i) mx = fmaxf(fmaxf(mx, fmaxf(pA0[i], pA1[i])), fmaxf(pB0[i], pB1[i]));
        mx = xhalf_max(mx);
        float s = 0.f;
#pragma unroll
        for (int i = 0; i < 16; ++i) { pA0[i] = __builtin_amdgcn_exp2f(pA0[i] - mx); pA1[i] = __builtin_amdgcn_exp2f(pA1[i] - mx); pB0[i] = __builtin_amdgcn_exp2f(pB0[i] - mx); pB1[i] = __builtin_amdgcn_exp2f(pB1[i] - mx);
            s += (pA0[i] + pA1[i]) + (pB0[i] + pB1[i]); }
        s = xhalf_sum(s);
        const float nrm = (t0 + qi >= 31) ? __builtin_amdgcn_rcpf(s) : 0.f;
#pragma unroll
        for (int i = 0; i < 16; ++i) { pA0[i] *= nrm; pA1[i] *= nrm; pB0[i] *= nrm; pB1[i] *= nrm; }
#define PSEL(L) ((L) < 4 ? pA0 : (L) < 8 ? pA1 : (L) < 12 ? pB0 : pB1)
#define MAINV(L) ((PSEL(L)[4 * ((L) & 3)] + PSEL(L)[4 * ((L) & 3) + 1]) + (PSEL(L)[4 * ((L) & 3) + 2] + 0.5f * PSEL(L)[4 * ((L) & 3) + 3]))
#define CARRY(L) (0.5f * PSEL(L)[4 * ((L) & 3) + 3])
#pragma unroll
        for (int L = 0; L < 16; ++L) {
            const float cprev = (L > 0) ? CARRY(L > 0 ? L - 1 : 0) : 0.f;
            const float snd = hi ? cprev : CARRY(L);
            const float rcv = __shfl_xor(snd, 32);
            imp[((wid >> 1) * 64 + qi) * 32 + 2 * L + hi] = MAINV(L) + rcv;
        }
#undef PSEL
#undef MAINV
#undef CARRY
        f32x16 o[2]; o[0] = f32x16{}; o[1] = f32x16{};
        pv(o, slot0 + 8192, pA0, pA1, lane, hi);
        if (two) pv(o, slot1 + 8192, pB0, pB1, lane, hi);
        acc_rows(tot, o, wsf, gate_c, r32, hi);
    }
    __syncthreads();
    if (wid == 0) {
        float v[32];
#pragma unroll
        for (int j = 0; j < 32; ++j) v[j] = (imp[(0 * 64 + lane) * 32 + j] + imp[(1 * 64 + lane) * 32 + j]) + (imp[(2 * 64 + lane) * 32 + j] + imp[(3 * 64 + lane) * 32 + j]);
        unsigned mask = 1u | (1u << blk_t);
#pragma unroll 1
        for (int it = 0; it < 6; ++it) {
            float best = -1.f; int bj = -1;
#pragma unroll
            for (int j = 1; j < 32; ++j) { const bool ok = (j < blk_t) && !((mask >> j) & 1u); if (ok && v[j] > best) { best = v[j]; bj = j; } }
            if (bj >= 0) mask |= 1u << bj;
        }
        selm[lane] = mask;
        unsigned any = mask;
#pragma unroll
        for (int o_ = 1; o_ < 64; o_ <<= 1) any |= __shfl_xor(any, o_);
        if (lane == 0) selm[64] = any;
    }
    __syncthreads();
    const unsigned mymask = selm[qi];
    const unsigned anym = (unsigned)__builtin_amdgcn_readfirstlane((int)selm[64]);
    unsigned kofP, vofP; tile_offs(kofP, vofP, LDP, wid, lane);
    {
        const bf16_t* kb = P + rowbase * LDP + C_KS + g * 64; const bf16_t* vb = P + rowbase * LDP + C_VS + g * 64;
        unsigned todo = anym;
        float m = NEG, l = 0.f; f32x16 o[2]; o[0] = f32x16{}; o[1] = f32x16{};
        int j = __builtin_ctz(todo); todo &= todo - 1;
        dma_tile(slot0, kb + (size_t)j * 64 * LDP, vb + (size_t)j * 64 * LDP, kofP, vofP, wid);
        int cur = 0;
        __syncthreads();
        for (;;) {
            const int jn = todo ? __builtin_ctz(todo) : -1; if (todo) todo &= todo - 1;
            NLAS unsigned char* sc = cur ? slot1 : slot0; NLAS unsigned char* sn = cur ? slot0 : slot1;
            if (jn >= 0) dma_tile(sn, kb + (size_t)jn * 64 * LDP, vb + (size_t)jn * 64 * LDP, kofP, vofP, wid);
            const bool mine = (mymask >> j) & 1u;
            if (__any(mine)) {
                f32x16 p0, p1, c0, c1; const float kb0 = sl2 * (float)(j * 64 - t0); OPAQUE_HI();
#pragma unroll
                for (int i = 0; i < 16; ++i) { c0[i] = kb0 + sl2 * CRF(i); c1[i] = c0[i] + sl2 * 32.f; }
                qkt(p0, p1, sc, qr, c0, c1, r32, hi);
                if (j == blk_t) {
#pragma unroll
                    for (int i = 0; i < 16; ++i) { const int kk = crow(i, hiv); if (kk > qi) p0[i] = NEG; if (kk + 32 > qi) p1[i] = NEG; }
                }
                if (!mine) {
#pragma unroll
                    for (int i = 0; i < 16; ++i) { p0[i] = NEG; p1[i] = NEG; }
                }
                softmax_step(p0, p1, m, l, o, wsf, r32, hi);
                pv(o, sc + 8192, p0, p1, lane, hi);
            }
            __syncthreads();
            if (jn < 0) break;
            j = jn; cur ^= 1;
        }
        l = xhalf_sum(l);
        acc_rows(tot, o, wsf, gate_s * __builtin_amdgcn_rcpf(l), r32, hi);
    }
    {
        const bf16_t* kb = P + rowbase * LDP + C_KW + g * 64; const bf16_t* vb = P + rowbase * LDP + C_VW + g * 64;
        float m = NEG, l = 0.f; f32x16 o[2]; o[0] = f32x16{}; o[1] = f32x16{};
        int j = blk_t; const int jlast = blk_t >= 4 ? blk_t - 4 : 0;
        dma_tile(slot0, kb + (size_t)j * 64 * LDP, vb + (size_t)j * 64 * LDP, kofP, vofP, wid);
        int cur = 0;
        __syncthreads();
        for (;;) {
            const int jn = (j > jlast) ? j - 1 : -1;
            NLAS unsigned char* sc = cur ? slot1 : slot0; NLAS unsigned char* sn = cur ? slot0 : slot1;
            if (jn >= 0) dma_tile(sn, kb + (size_t)jn * 64 * LDP, vb + (size_t)jn * 64 * LDP, kofP, vofP, wid);
            {
                f32x16 p0, p1, c0, c1; const float kb0 = sl2 * (float)(j * 64 - t0); OPAQUE_HI();
#pragma unroll
                for (int i = 0; i < 16; ++i) { c0[i] = kb0 + sl2 * CRF(i); c1[i] = c0[i] + sl2 * 32.f; }
                qkt(p0, p1, sc, qr, c0, c1, r32, hi);
                if (j == blk_t || j == blk_t - 4) {
                    const int dq = t0 + qi - j * 64;
#pragma unroll
                    for (int i = 0; i < 16; ++i) { const int d0_ = dq - crow(i, hiv), d1_ = d0_ - 32; if (d0_ < 0 || d0_ > 255) p0[i] = NEG; if (d1_ < 0 || d1_ > 255) p1[i] = NEG; }
                }
                softmax_step(p0, p1, m, l, o, wsf, r32, hi);
                pv(o, sc + 8192, p0, p1, lane, hi);
            }
            __syncthreads();
            if (jn < 0) break;
            j = jn; cur ^= 1;
        }
        l = xhalf_sum(l);
        acc_rows(tot, o, wsf, gate_w * __builtin_amdgcn_rcpf(l), r32, hi);
    }
    {
        NLAS bf16_t* stg = (NLAS bf16_t*)(lds + L_OST) + wid * 2048;
#pragma unroll
        for (int i = 0; i < 16; ++i) { const int orow = crow(i, hi); stg[orow * 64 + r32] = f2bf(tot[0][i]); stg[orow * 64 + 32 + r32] = f2bf(tot[1][i]); }
        bf16_t* ow = P + (rowbase + t0 + qh * 32) * LDP + C_NQ + head * 64;
#pragma unroll
        for (int i = 0; i < 4; ++i) { const int row = i * 8 + (lane >> 3), ch = lane & 7; const u32x4 v = *(NLAS const u32x4*)(stg + row * 64 + ch * 8); *(u32x4*)((char*)ow + (unsigned)(row * LDP + ch * 8) * 2u) = v; }
    }
    __syncthreads();
#undef CRF
#undef OPAQUE_HI
}

__device__ __forceinline__ void norm8(u32x4& v, const float* g8, float sc) {
    float x[8] = {__uint_as_float(v.x << 16), __uint_as_float(v.x & 0xffff0000u), __uint_as_float(v.y << 16), __uint_as_float(v.y & 0xffff0000u),
                  __uint_as_float(v.z << 16), __uint_as_float(v.z & 0xffff0000u), __uint_as_float(v.w << 16), __uint_as_float(v.w & 0xffff0000u)};
    float s = 0.f;
#pragma unroll
    for (int e = 0; e < 8; ++e) s += x[e] * x[e];
    s += __shfl_xor(s, 1); s += __shfl_xor(s, 2); s += __shfl_xor(s, 4);
    const float r = rsqrtf(s * (1.f / 64.f) + EPS) * sc;
    v.x = pk(x[0] * r * g8[0], x[1] * r * g8[1]); v.y = pk(x[2] * r * g8[2], x[3] * r * g8[3]); v.z = pk(x[4] * r * g8[4], x[5] * r * g8[5]); v.w = pk(x[6] * r * g8[6], x[7] * r * g8[7]);
}
__device__ __forceinline__ void prep_units(bf16_t* P, const float* qn, const float* kns, const float* knw, int gw, int NGW, int lane) {
    float gq[8], gk[8];
    const float* kg = (lane < 32) ? kns : knw;
#pragma unroll
    for (int e = 0; e < 8; ++e) { gq[e] = qn[8 * (lane & 7) + e]; gk[e] = kg[8 * (lane & 7) + e]; }
    const int coff = (lane < 32) ? C_KS + 8 * lane : C_KW + 8 * (lane - 32);
    for (int m0 = gw; m0 < M; m0 += 2 * NGW) {
        const int m1 = m0 + NGW; const bool two = m1 < M;
        bf16_t* r0 = P + (size_t)m0 * LDP; bf16_t* r1 = P + (size_t)(two ? m1 : m0) * LDP;
        u32x4 a0 = *(const u32x4*)(r0 + C_NQ + 8 * lane), b0 = *(const u32x4*)(r0 + C_NQ + 512 + 8 * lane), c0 = *(const u32x4*)(r0 + coff);
        u32x4 a1 = *(const u32x4*)(r1 + C_NQ + 8 * lane), b1 = *(const u32x4*)(r1 + C_NQ + 512 + 8 * lane), c1 = *(const u32x4*)(r1 + coff);
        norm8(a0, gq, 0.125f * LOG2E); norm8(b0, gq, 0.125f * LOG2E); norm8(c0, gk, 1.f);
        norm8(a1, gq, 0.125f * LOG2E); norm8(b1, gq, 0.125f * LOG2E); norm8(c1, gk, 1.f);
        *(u32x4*)(r0 + C_NQ + 8 * lane) = a0; *(u32x4*)(r0 + C_NQ + 512 + 8 * lane) = b0; *(u32x4*)(r0 + coff) = c0;
        if (two) { *(u32x4*)(r1 + C_NQ + 8 * lane) = a1; *(u32x4*)(r1 + C_NQ + 512 + 8 * lane) = b1; *(u32x4*)(r1 + coff) = c1; }
    }
}

constexpr int LC_HID = 0;
__device__ __forceinline__ void compress_item(NLAS unsigned char* lds, const bf16_t* P, const bf16_t* W1T, const float* bias1, const float* W2, const float* gain, bf16_t* OUT, int b, int g, int which, int half) {
    const int tid = threadIdx.x, lane = tid & 63, r32 = lane & 31, hi = lane >> 5; const int wid = __builtin_amdgcn_readfirstlane(tid >> 6);
    const int mt = wid >> 2, nt = wid & 3;
    const int c = 64 * half + 32 * mt + r32;
    const int cc = c < NCMP ? c : NCMP - 1;
    const bf16_t* arow = P + ((size_t)b * SEQ + 16 * cc) * LDP + (which ? C_VC : C_KC) + g * 64 + hi * 8;
    const bf16_t* brow = W1T + (size_t)(32 * nt + r32) * 2048 + hi * 8;
    f32x16 acc = f32x16{};
#pragma unroll 4
    for (int l = 0; l < 32; ++l) {
#pragma unroll
        for (int ds = 0; ds < 4; ++ds) {
            const bf16x8 a = *(const bf16x8*)(arow + (size_t)l * LDP + ds * 16);
            const bf16x8 w = *(const bf16x8*)(brow + l * 64 + ds * 16);
            acc = __builtin_amdgcn_mfma_f32_32x32x16_bf16(a, w, acc, 0, 0, 0);
        }
    }
    NLAS float* hid = (NLAS float*)(lds + LC_HID);
    const float bs = bias1[32 * nt + r32];
#pragma unroll
    for (int i = 0; i < 16; ++i) hid[(32 * mt + crow(i, hi)) * 132 + 32 * nt + r32] = gelu_tanh(acc[i] + bs);
    __syncthreads();
    {
        const int row = tid >> 3, e0 = (tid & 7) * 8;
        float o[8];
#pragma unroll
        for (int e = 0; e < 8; ++e) o[e] = 0.f;
        for (int i = 0; i < 128; ++i) { const float h = hid[row * 132 + i]; const f32x4 wa = *(const f32x4*)(W2 + i * 64 + e0), wb = *(const f32x4*)(W2 + i * 64 + e0 + 4);
            o[0] += h * wa[0]; o[1] += h * wa[1]; o[2] += h * wa[2]; o[3] += h * wa[3]; o[4] += h * wb[0]; o[5] += h * wb[1]; o[6] += h * wb[2]; o[7] += h * wb[3]; }
        if (which == 0) {
            float ss = 0.f;
#pragma unroll
            for (int e = 0; e < 8; ++e) ss += o[e] * o[e];
            ss += __shfl_xor(ss, 1); ss += __shfl_xor(ss, 2); ss += __shfl_xor(ss, 4);
            const float r = rsqrtf(ss * (1.f / 64.f) + EPS);
#pragma unroll
            for (int e = 0; e < 8; ++e) o[e] *= r * gain[e0 + e];
        }
        const int cg = 64 * half + row;
        if (cg >= NCMP) {
#pragma unroll
            for (int e = 0; e < 8; ++e) o[e] = 0.f; }
        u32x4 w; w.x = pk(o[0], o[1]); w.y = pk(o[2], o[3]); w.z = pk(o[4], o[5]); w.w = pk(o[6], o[7]);
        *(u32x4*)(OUT + (((size_t)(b * NS_G + g) * 128) + cg) * 64 + e0) = w;
    }
    __syncthreads();
}
}
namespace pg8 {
#define PG8_LAS __attribute__((address_space(3)))
typedef short bf16x8 __attribute__((ext_vector_type(8)));
typedef float f32x4 __attribute__((ext_vector_type(4)));
typedef float f32x2 __attribute__((ext_vector_type(2)));
typedef unsigned u32x4 __attribute__((ext_vector_type(4)));
typedef unsigned u32x2 __attribute__((ext_vector_type(2)));
constexpr int BM = 256, BK = 64, HALF = 128, HTB = HALF * BK * 2, STAGE_BYTES = 8 * HTB, NXCD = 8, WGM = 8;

__host__ __device__ __forceinline__ int lds_byte(int r, int c) { const int st = (r >> 4) * 2 + (c >> 5), rr = r & 15, cc = c & 31, ob = rr * 64 + cc * 2; return st * 1024 + (ob ^ (((ob >> 9) & 1) << 5)); }
__host__ __device__ __forceinline__ void stage_rc(int b, int& R, int& C) { const int st = b / 1024, sb = b % 1024, swz = sb ^ (((sb >> 9) & 1) << 5); R = (st >> 1) * 16 + swz / 64; C = (st & 1) * 32 + (swz % 64) / 2; }
__host__ __device__ __forceinline__ int perm32(int rho) { const int n = rho >> 4, i = rho & 15; return 8 * (i >> 2) + 4 * n + (i & 3); }

struct Unit { int pm, pn, ks; };
struct Gemm { const bf16_t* A; const bf16_t* Bt; int lda, ldb; int M, N, K; int ksoff; };

struct StaticOrder {
    int nM, nN, nwg, G, c;
    __host__ __device__ void init(int M_, int N_, int G_, int c_) { nM = M_ / BM; nN = N_ / BM; nwg = nM * nN; G = G_; c = c_; }
    __host__ __device__ bool next(int i, Unit& u) const {
        const long L = (long)i * G + c; if (L >= nwg) return false;
        int wgid = (int)L; { const int q = nwg / NXCD, r = nwg % NXCD, xcd = wgid % NXCD, off = wgid / NXCD; wgid = (xcd < r ? xcd * (q + 1) : r * (q + 1) + (xcd - r) * q) + off; }
        const int nig = WGM * nN, gid = wgid / nig, fm = gid * WGM, gsz = (nM - fm) < WGM ? (nM - fm) : WGM;
        u.pm = fm + ((wgid % nig) % gsz); u.pn = (wgid % nig) / gsz; u.ks = 0; return true;
    }
};
struct TwoPassOrder {
    StaticOrder base;
    __host__ __device__ bool next(int i, Unit& u) const { if (!base.next(i >> 1, u)) return false; u.ks = i & 1; return true; }
};

typedef __bf16 bf16x2_t __attribute__((ext_vector_type(2)));
__device__ __forceinline__ unsigned cvt_pk_bf16(float lo, float hi) { f32x2 v = {lo, hi}; bf16x2_t b = __builtin_convertvector(v, bf16x2_t); return __builtin_bit_cast(unsigned, b); }
__device__ __forceinline__ float fast_sigmoid(float x) { return __builtin_amdgcn_rcpf(1.f + __builtin_amdgcn_exp2f(-1.4426950408889634f * x)); }
__device__ __forceinline__ float bflo(unsigned w) { return __uint_as_float(w << 16); }
__device__ __forceinline__ float bfhi(unsigned w) { return __uint_as_float(w & 0xffff0000u); }

typedef f32x4 Acc[2][2][4][2];

template <int ACT> struct EpiP {
    static constexpr bool PERM = true;
    bf16_t* O; int ldc; int pn_last; int ncol_last; bf16_t* halo;
    __device__ __forceinline__ void operator()(const Acc& acc, const Unit& u, int wr, int wc, int fr, int fq) const {
        const int row0 = u.pm * BM + wr * 64 + fr, tcol = wc * 32 + 8 * fq;
        const int lim = (u.pn == pn_last) ? ncol_last : 256;
#pragma unroll
        for (int ai = 0; ai < 2; ++ai)
#pragma unroll
            for (int m = 0; m < 4; ++m) { bf16_t* rowp = O + (size_t)(row0 + ai * HALF + m * 16) * ldc + u.pn * BM + tcol;
#pragma unroll
                for (int bj = 0; bj < 2; ++bj) { if (tcol + bj * HALF >= lim) continue;
                    f32x4 v0 = acc[ai][bj][m][0], v1 = acc[ai][bj][m][1];
                    if (ACT == 1) {
#pragma unroll
                        for (int e = 0; e < 4; ++e) { v0[e] = fast_sigmoid(v0[e]); v1[e] = fast_sigmoid(v1[e]); } }
                    u32x4 w; w.x = cvt_pk_bf16(v0[0], v0[1]); w.y = cvt_pk_bf16(v0[2], v0[3]); w.z = cvt_pk_bf16(v1[0], v1[1]); w.w = cvt_pk_bf16(v1[2], v1[3]);
                    *(u32x4*)(rowp + bj * HALF) = w;
                    if (ACT == 0 && m == 3 && fr >= 13 && u.pn < 12 && halo) { const int row = row0 + ai * HALF + 48;
                        *(u32x4*)(halo + ((size_t)(row >> 6) * 3 + (fr - 13)) * 3072 + u.pn * BM + tcol + bj * HALF) = w; } } }
    }
};
struct EpiMix {
    static constexpr bool PERM = true;
    const bf16_t* G; int ldg; bf16_t* O; int ldc;
    __device__ __forceinline__ void operator()(const Acc& acc, const Unit& u, int wr, int wc, int fr, int fq) const {
        const int row0 = u.pm * BM + wr * 64 + fr, col0 = u.pn * BM + wc * 32 + 8 * fq;
#pragma unroll
        for (int ai = 0; ai < 2; ++ai)
#pragma unroll
            for (int m = 0; m < 4; ++m) { const size_t row = (size_t)(row0 + ai * HALF + m * 16); const bf16_t* gp = G + row * ldg + col0 + u.ks * 1024; bf16_t* rowp = O + row * ldc + col0;
#pragma unroll
                for (int bj = 0; bj < 2; ++bj) { const u32x4 b = *(const u32x4*)(gp + bj * HALF);
                    f32x4 v0 = acc[ai][bj][m][0], v1 = acc[ai][bj][m][1];
                    v0[0] *= bflo(b.x); v0[1] *= bfhi(b.x); v0[2] *= bflo(b.y); v0[3] *= bfhi(b.y); v1[0] *= bflo(b.z); v1[1] *= bfhi(b.z); v1[2] *= bflo(b.w); v1[3] *= bfhi(b.w);
                    if (u.ks) { const u32x4 p = *(const u32x4*)(rowp + bj * HALF);
                        v0[0] += bflo(p.x); v0[1] += bfhi(p.x); v0[2] += bflo(p.y); v0[3] += bfhi(p.y); v1[0] += bflo(p.z); v1[1] += bfhi(p.z); v1[2] += bflo(p.w); v1[3] += bfhi(p.w); }
                    u32x4 w; w.x = cvt_pk_bf16(v0[0], v0[1]); w.y = cvt_pk_bf16(v0[2], v0[3]); w.z = cvt_pk_bf16(v1[0], v1[1]); w.w = cvt_pk_bf16(v1[2], v1[3]);
                    *(u32x4*)(rowp + bj * HALF) = w; } }
    }
};
struct EpiOut {
    static constexpr bool PERM = false;
    const float* X; float* X1; bf16_t* An; const float* gain; float* pss;
    __device__ __forceinline__ void operator()(const Acc& acc, const Unit& u, int wr, int wc, int fr, int fq) const {
        const int row0 = u.pm * BM + wr * 64 + fr, col0 = u.pn * BM + wc * 32 + 4 * fq;
        f32x4 gv[2][2];
#pragma unroll
        for (int bj = 0; bj < 2; ++bj)
#pragma unroll
            for (int n = 0; n < 2; ++n) gv[bj][n] = *(const f32x4*)(gain + col0 + bj * HALF + n * 16);
#pragma unroll
        for (int ai = 0; ai < 2; ++ai)
#pragma unroll
            for (int m = 0; m < 4; ++m) { const size_t row = (size_t)(row0 + ai * HALF + m * 16); const size_t off = row * D + col0; float ss = 0.f;
#pragma unroll
                for (int bj = 0; bj < 2; ++bj)
#pragma unroll
                    for (int n = 0; n < 2; ++n) { const f32x4 x1 = *(const f32x4*)(X + off + bj * HALF + n * 16) + acc[ai][bj][m][n];
                        *(f32x4*)(X1 + off + bj * HALF + n * 16) = x1; ss += (x1[0] * x1[0] + x1[1] * x1[1]) + (x1[2] * x1[2] + x1[3] * x1[3]);
                        const f32x4 y = x1 * gv[bj][n]; u32x2 w; w.x = cvt_pk_bf16(y[0], y[1]); w.y = cvt_pk_bf16(y[2], y[3]); *(u32x2*)(An + off + bj * HALF + n * 16) = w; }
                ss += __shfl_xor(ss, 16); ss += __shfl_xor(ss, 32);
                if (fq == 0) pss[row * 16 + u.pn * 4 + wc] = ss; }
    }
};
struct EpiUp {
    static constexpr bool PERM = true;
    const float* pss; bf16_t* O; int ldc;
    __device__ __forceinline__ void operator()(const Acc& acc, const Unit& u, int wr, int wc, int fr, int fq) const {
        const int row0 = u.pm * BM + wr * 64 + fr, col0 = u.pn * BM + wc * 32 + 8 * fq;
#pragma unroll
        for (int ai = 0; ai < 2; ++ai)
#pragma unroll
            for (int m = 0; m < 4; ++m) { const size_t row = (size_t)(row0 + ai * HALF + m * 16);
                const f32x4* pp = (const f32x4*)(pss + row * 16); const f32x4 s4 = (pp[0] + pp[1]) + (pp[2] + pp[3]);
                const float rstd = rsqrtf(((s4[0] + s4[1]) + (s4[2] + s4[3])) * (1.f / D) + EPS);
                bf16_t* rowp = O + row * ldc + col0;
#pragma unroll
                for (int bj = 0; bj < 2; ++bj) { f32x4 v0 = acc[ai][bj][m][0] * rstd, v1 = acc[ai][bj][m][1] * rstd;
#pragma unroll
                    for (int e = 0; e < 4; ++e) { const float a = fmaxf(v0[e], 0.f), b = fmaxf(v1[e], 0.f); v0[e] = a * a; v1[e] = b * b; }
                    u32x4 w; w.x = cvt_pk_bf16(v0[0], v0[1]); w.y = cvt_pk_bf16(v0[2], v0[3]); w.z = cvt_pk_bf16(v1[0], v1[1]); w.w = cvt_pk_bf16(v1[2], v1[3]);
                    *(u32x4*)(rowp + bj * HALF) = w; } }
    }
};
struct EpiDown {
    static constexpr bool PERM = false;
    float* X1;
    __device__ __forceinline__ void operator()(const Acc& acc, const Unit& u, int wr, int wc, int fr, int fq) const {
        const int row0 = u.pm * BM + wr * 64 + fr, col0 = u.pn * BM + wc * 32 + 4 * fq;
#pragma unroll
        for (int ai = 0; ai < 2; ++ai)
#pragma unroll
            for (int m = 0; m < 4; ++m) { float* rowp = X1 + (size_t)(row0 + ai * HALF + m * 16) * D + col0;
#pragma unroll
                for (int bj = 0; bj < 2; ++bj)
#pragma unroll
                    for (int n = 0; n < 2; ++n) { f32x4* p = (f32x4*)(rowp + bj * HALF + n * 16); *p = *p + acc[ai][bj][m][n]; } }
    }
};

template <class Epi, class Sched, bool ALIGN_EPI>
__device__ __forceinline__ void gemm_phase(PG8_LAS unsigned char* lds, const Gemm g, const Sched& S, const Epi& E) {
    const int tid = threadIdx.x, wid = __builtin_amdgcn_readfirstlane(tid >> 6), lane = tid & 63, wr = wid >> 2, wc = wid & 3, fr = lane & 15, fq = lane >> 4;
    const int K = g.K, nt = K / BK, lda = g.lda, ldb = g.ldb;
    unsigned voffA[2], voffB[2];
#pragma unroll
    for (int i = 0; i < 2; ++i) { int R, C; stage_rc(tid * 16 + i * 8192, R, C); const int Rb = Epi::PERM ? ((R & ~31) + perm32(R & 31)) : R;
        voffA[i] = (unsigned)(R * lda + C) * 2u; voffB[i] = (unsigned)(Rb * ldb + C) * 2u; }
    const size_t kstep = (size_t)(BK * 2);
    const size_t hstepA = (size_t)HALF * lda * 2, hstepB = (size_t)HALF * ldb * 2;
    const size_t tstepA = 2 * hstepA, tstepB = 2 * hstepB;
    const unsigned ldsw = (unsigned)wid * 1024u;
    const int aoff = lds_byte(wr * 64 + fr, fq * 8), boff = lds_byte(wc * 32 + fr, fq * 8);
#define PG8_SA(b, h) (((b) * 2 + (h)) * HTB)
#define PG8_SB(b, h) ((4 + (b) * 2 + (h)) * HTB)
#define PG8_STAGE(bufoff, gbase, voff) do { _Pragma("unroll") for (int _i = 0; _i < 2; ++_i) \
        __builtin_amdgcn_global_load_lds((const unsigned*)((const char*)(gbase) + (voff)[_i]), (PG8_LAS unsigned*)(lds + (bufoff) + ldsw + _i * 8192), 16, 0, 0); } while (0)
#define PG8_LDA(dst, b, h) do { _Pragma("unroll") for (int m = 0; m < 4; ++m) _Pragma("unroll") for (int k = 0; k < 2; ++k) dst[m][k] = *(const PG8_LAS bf16x8*)(lds + PG8_SA(b, h) + aoff + m * 2048 + k * 1024); } while (0)
#define PG8_LDB(dst, b, h) do { _Pragma("unroll") for (int n = 0; n < 2; ++n) _Pragma("unroll") for (int k = 0; k < 2; ++k) dst[n][k] = *(const PG8_LAS bf16x8*)(lds + PG8_SB(b, h) + boff + n * 2048 + k * 1024); } while (0)
#define PG8_MMA(ai, bj, At, Bt) do { __builtin_amdgcn_s_setprio(1); _Pragma("unroll") for (int m = 0; m < 4; ++m) _Pragma("unroll") for (int n = 0; n < 2; ++n) _Pragma("unroll") for (int k = 0; k < 2; ++k) \
        acc[ai][bj][m][n] = __builtin_amdgcn_mfma_f32_16x16x32_bf16(Bt[n][k], At[m][k], acc[ai][bj][m][n], 0, 0, 0); __builtin_amdgcn_s_setprio(0); } while (0)
#define PG8_WAIT_V(n) asm volatile("s_waitcnt vmcnt(" #n ")" ::: "memory")
#define PG8_WAIT_L(n) asm volatile("s_waitcnt lgkmcnt(" #n ")" ::: "memory")
#define PG8_BAR __builtin_amdgcn_s_barrier()
#define PG8_SCHED __builtin_amdgcn_sched_barrier(0)
#define PG8_KBODY(t) do { \
            const bool last = (t == nt - 2); \
            const char* a1 = cA + (size_t)(t + 1) * kstep; \
            const char* a2 = last ? nA : cA + (size_t)(t + 2) * kstep; const char* b2 = last ? nB : cB + (size_t)(t + 2) * kstep; \
            const char* a3 = a2 + kstep; const char* b3 = b2 + kstep; \
            PG8_LDB(B0, 0, 0); PG8_LDB(B1, 0, 1); PG8_SCHED; PG8_LDA(At, 0, 0); PG8_STAGE(PG8_SA(1, 1), a1 + hstepA, voffA); \
            PG8_WAIT_V(8); PG8_WAIT_L(0); PG8_BAR; PG8_MMA(0, 0, At, B0); PG8_MMA(0, 1, At, B1); PG8_BAR; PG8_SCHED; \
            PG8_LDA(At, 0, 1); PG8_STAGE(PG8_SB(0, 0), b2, voffB); PG8_STAGE(PG8_SB(0, 1), b2 + hstepB, voffB); PG8_STAGE(PG8_SA(0, 0), a2, voffA); \
            PG8_WAIT_V(8); PG8_WAIT_L(0); PG8_BAR; PG8_MMA(1, 0, At, B0); PG8_MMA(1, 1, At, B1); PG8_BAR; PG8_SCHED; \
            PG8_LDB(B0, 1, 0); PG8_LDB(B1, 1, 1); PG8_SCHED; PG8_LDA(At, 1, 0); PG8_STAGE(PG8_SA(0, 1), a2 + hstepA, voffA); \
            PG8_WAIT_V(8); PG8_WAIT_L(0); PG8_BAR; PG8_MMA(0, 0, At, B0); PG8_MMA(0, 1, At, B1); PG8_BAR; PG8_SCHED; \
            PG8_LDA(At, 1, 1); PG8_STAGE(PG8_SB(1, 0), b3, voffB); PG8_STAGE(PG8_SB(1, 1), b3 + hstepB, voffB); PG8_STAGE(PG8_SA(1, 0), a3, voffA); \
            PG8_WAIT_V(8); PG8_WAIT_L(0); PG8_BAR; PG8_MMA(1, 0, At, B0); PG8_MMA(1, 1, At, B1); PG8_BAR; PG8_SCHED; \
        } while (0)
    Unit cur, nxt; int ui = 0;
    if (!S.next(0, cur)) return;
    Acc acc;
#pragma unroll
    for (int a = 0; a < 2; ++a)
#pragma unroll
        for (int b = 0; b < 2; ++b)
#pragma unroll
            for (int m = 0; m < 4; ++m)
#pragma unroll
                for (int n = 0; n < 2; ++n) acc[a][b][m][n] = (f32x4){0.f, 0.f, 0.f, 0.f};
    bf16x8 At[4][2], B0[2][2], B1[2][2];
    const char* cA = (const char*)g.A + (size_t)cur.pm * tstepA + (size_t)cur.ks * g.ksoff * 2; const char* cB = (const char*)g.Bt + (size_t)cur.pn * tstepB + (size_t)cur.ks * g.ksoff * 2;
    PG8_STAGE(PG8_SB(0, 0), cB, voffB); PG8_STAGE(PG8_SB(0, 1), cB + hstepB, voffB); PG8_STAGE(PG8_SA(0, 0), cA, voffA); PG8_STAGE(PG8_SA(0, 1), cA + hstepA, voffA);
    if (wr == 1) PG8_BAR;
    PG8_WAIT_V(2); PG8_BAR;
    PG8_STAGE(PG8_SB(1, 0), cB + kstep, voffB); PG8_STAGE(PG8_SA(1, 0), cA + kstep, voffA); PG8_STAGE(PG8_SB(1, 1), cB + hstepB + kstep, voffB);
    PG8_WAIT_V(6); PG8_BAR;
    for (;;) {
        const bool has_next = S.next(ui + 1, nxt);
        const char* nA = has_next ? (const char*)g.A + (size_t)nxt.pm * tstepA + (size_t)nxt.ks * g.ksoff * 2 : cA; const char* nB = has_next ? (const char*)g.Bt + (size_t)nxt.pn * tstepB + (size_t)nxt.ks * g.ksoff * 2 : cB;
        for (int t = 0; t < nt; t += 2) PG8_KBODY(t);
        if constexpr (ALIGN_EPI) { if (wr == 0) PG8_BAR; }
        E(acc, cur, wr, wc, fr, fq);
        if (!has_next) break;
#pragma unroll
        for (int a = 0; a < 2; ++a)
#pragma unroll
            for (int b = 0; b < 2; ++b)
#pragma unroll
                for (int m = 0; m < 4; ++m)
#pragma unroll
                    for (int n = 0; n < 2; ++n) acc[a][b][m][n] = (f32x4){0.f, 0.f, 0.f, 0.f};
        cur = nxt; cA = nA; cB = nB; ++ui;
        if constexpr (ALIGN_EPI) { if (wr == 1) PG8_BAR; }
    }
    PG8_WAIT_V(0);
    if constexpr (!ALIGN_EPI) { if (wr == 0) PG8_BAR; }
    PG8_BAR;
#undef PG8_SA
#undef PG8_SB
#undef PG8_STAGE
#undef PG8_LDA
#undef PG8_LDB
#undef PG8_MMA
#undef PG8_WAIT_V
#undef PG8_WAIT_L
#undef PG8_BAR
#undef PG8_SCHED
#undef PG8_KBODY
}
}

#define GAS __attribute__((address_space(1)))
#define LAS __attribute__((address_space(3)))
typedef unsigned v4u __attribute__((ext_vector_type(4)));
typedef float f32x4 __attribute__((ext_vector_type(4)));
constexpr int NWAVES = 8;
constexpr int LDS_BYTES = 147456;
constexpr size_t MiB = 1u << 20;
constexpr size_t WS_PSS = 1 * MiB, WS_WOUT = 2 * MiB, WS_P = 4 * MiB, WS_KC = 214 * MiB, WS_VC = 215 * MiB, WS_MIX = 216 * MiB;
constexpr size_t WS_AN = 4 * MiB, WS_UP = 64 * MiB, WS_WUP = 248 * MiB, WS_WDOWN = 200 * MiB;
constexpr size_t WS_BIAS1 = 0, WS_W1T = 214 * MiB, WS_KCB = 215 * MiB, WS_VCB = 215 * MiB + 512 * 1024;
constexpr size_t WS_GLV = 4096, WS_QCNT = 65536, WS_GW = 216 * MiB, DO_GQK = 40 * MiB, DO_HALO = 56 * MiB;
constexpr size_t DO_H = 0, DO_WG = 32 * MiB, DO_WCAT = 36 * MiB, DO_WIN = 40 * MiB;

__device__ __forceinline__ unsigned pk2(float lo, float hi) { return (unsigned)f2bf(lo) | ((unsigned)f2bf(hi) << 16); }
__device__ __forceinline__ float wave_sum(float v) {
#pragma unroll
    for (int o = 1; o < 64; o <<= 1) v += __shfl_xor(v, o);
    return v;
}
template <class SrcCol>
__device__ __forceinline__ void transpose_item(const float* W, int ldw, const SrcCol& srccol, bf16_t* WT, int ldk, int kofs, LAS float* scr, int kb, int nb, int lane) {
    const int k0 = 64 * kb, n0 = 64 * nb; const int n4 = (lane & 15) * 4; const int sc = srccol(n0 + n4);
#pragma unroll 4
    for (int i = 0; i < 16; ++i) { const int kk = 4 * i + (lane >> 4);
        const f32x4 v = (sc >= 0) ? *(const f32x4*)(W + (size_t)(k0 + kk) * ldw + sc) : (f32x4){0.f, 0.f, 0.f, 0.f};
        scr[kk * 65 + n4] = v[0]; scr[kk * 65 + n4 + 1] = v[1]; scr[kk * 65 + n4 + 2] = v[2]; scr[kk * 65 + n4 + 3] = v[3]; }
    asm volatile("s_waitcnt lgkmcnt(0)" ::: "memory");
    const int c = lane & 7;
#pragma unroll
    for (int j = 0; j < 8; ++j) { const int n = (lane >> 3) + 8 * j; const LAS float* sp = scr + (8 * c) * 65 + n;
        v4u o; o.x = pk2(sp[0 * 65], sp[1 * 65]); o.y = pk2(sp[2 * 65], sp[3 * 65]); o.z = pk2(sp[4 * 65], sp[5 * 65]); o.w = pk2(sp[6 * 65], sp[7 * 65]);
        *(v4u*)(WT + (size_t)(n0 + n) * ldk + kofs + k0 + 8 * c) = o; }
    asm volatile("s_waitcnt lgkmcnt(0)" ::: "memory");
}
struct SrcIdent { int off; __device__ __forceinline__ int operator()(int n) const { return n + off; } };
struct SrcWin { __device__ __forceinline__ int operator()(int n) const { return n < 4096 ? n : (n < 6656 ? n + 16 : (n < 6672 ? n - 6656 + 4096 : (n < 6720 ? n : -1))); } };

struct Args { const float* in[23]; float* out; unsigned char* ws; int ph_lo, ph_hi; };

__global__ void __launch_bounds__(NWAVES * 64, 2) mk_fwd(Args args) {
    extern __shared__ __attribute__((aligned(16))) unsigned char lds_raw[];
    LAS unsigned char* lds = (LAS unsigned char*)lds_raw;
    cg::grid_group grid = cg::this_grid();
    const int tid = threadIdx.x, lane = tid & 63, wave = __builtin_amdgcn_readfirstlane(tid >> 6);
    const int G = gridDim.x, gw = blockIdx.x * NWAVES + wave, NGW = G * NWAVES;
    unsigned char* ws = args.ws; unsigned char* dob = (unsigned char*)args.out;
    const float* x = args.in[0];
    bf16_t* P = (bf16_t*)(ws + WS_P);
    bf16_t* Hb = (bf16_t*)(dob + DO_H); bf16_t* Wg_t = (bf16_t*)(dob + DO_WG); bf16_t* Wcat_t = (bf16_t*)(dob + DO_WCAT); bf16_t* Win_t = (bf16_t*)(dob + DO_WIN);
    bf16_t* Wout_t = (bf16_t*)(ws + WS_WOUT); bf16_t* Wup_t = (bf16_t*)(ws + WS_WUP); bf16_t* Wdown_t = (bf16_t*)(ws + WS_WDOWN);
    bf16_t* Mix = (bf16_t*)(ws + WS_MIX); bf16_t* An = (bf16_t*)(ws + WS_AN); bf16_t* Up = (bf16_t*)(ws + WS_UP); float* pss = (float*)(ws + WS_PSS);
    LAS float* scr = (LAS float*)(lds + wave * 17408);
    bf16_t* Halo = (bf16_t*)(dob + DO_HALO); bf16_t* GWb = (bf16_t*)(ws + WS_GW); bf16_t* GQKb = (bf16_t*)(dob + DO_GQK); float* GLv = (float*)(ws + WS_GLV); unsigned* qcnt = (unsigned*)(ws + WS_QCNT);
    bf16_t* W1T = (bf16_t*)(ws + WS_W1T); float* bias1 = (float*)(ws + WS_BIAS1); bf16_t* KCb = (bf16_t*)(ws + WS_KCB); bf16_t* VCb = (bf16_t*)(ws + WS_VCB);
    const int lo = args.ph_lo, hi = args.ph_hi;
#ifndef PHMASK
#define PHMASK 0x1ff
#endif
#define IN(k) (((PHMASK >> (k)) & 1) && lo <= (k) && (k) < hi)
#define GRID_SYNC() do { asm volatile("s_waitcnt vmcnt(0) lgkmcnt(0)" ::: "memory"); grid.sync(); \
        if (wave == 0) { __builtin_amdgcn_fence(__ATOMIC_ACQUIRE, "agent"); asm volatile("s_waitcnt vmcnt(0)" ::: "memory"); } __syncthreads(); } while (0)
#if defined(TPROBE)
#define STAMP(k) do { if (blockIdx.x == 0 && tid == 0) ((volatile LAS unsigned long long*)(lds + 147456 - 512))[k] = __builtin_amdgcn_s_memrealtime(); } while (0)
#else
#define STAMP(k) do { } while (0)
#endif
#define SEAM(k) do { if (IN(k) && IN((k) + 1)) GRID_SYNC(); STAMP((k) + 1); } while (0)

    STAMP(0);
    if (IN(0)) {
        if (blockIdx.x == 0 && tid == 0) { *qcnt = 0u; ((volatile unsigned*)(ws + 786432))[4] = 0u; }
        constexpr int I_WIN = 16 * (NP1 / 64), I_WG = 16 * 32, I_DN = 16 * 16, I_OUT = 16 * 16, I_UP = 16 * 64;
        constexpr int I_W1 = 32 * 2, I_B1 = 256;
        constexpr int NITEMS = I_WIN + I_WG + 2 * I_DN + I_OUT + I_UP + 2 * I_W1 + I_B1;
        for (int it = gw; it < NITEMS; it += NGW) {
            int r = it;
            if (r < I_WIN) { transpose_item(args.in[2], INW, SrcWin{}, Win_t, D, 0, scr, r / (NP1 / 64), r % (NP1 / 64), lane); continue; } r -= I_WIN;
            if (r < I_WG) { transpose_item(args.in[2], INW, SrcIdent{6720}, Wg_t, D, 0, scr, r / 32, r % 32, lane); continue; } r -= I_WG;
            if (r < I_DN) { transpose_item(args.in[17], D, SrcIdent{0}, Wcat_t, 2 * D, 0, scr, r / 16, r % 16, lane); continue; } r -= I_DN;
            if (r < I_DN) { transpose_item(args.in[18], D, SrcIdent{0}, Wcat_t, 2 * D, D, scr, r / 16, r % 16, lane); continue; } r -= I_DN;
            if (r < I_OUT) { transpose_item(args.in[19], D, SrcIdent{0}, Wout_t, D, 0, scr, r / 16, r % 16, lane); continue; } r -= I_OUT;
            if (r < I_UP) { transpose_item(args.in[21], FF, SrcIdent{0}, Wup_t, D, 0, scr, r / 64, r % 64, lane); continue; } r -= I_UP;
            if (r < I_W1) { transpose_item(args.in[12], 128, SrcIdent{0}, W1T, 2048, 0, scr, r / 2, r % 2, lane); continue; } r -= I_W1;
            if (r < I_W1) { transpose_item(args.in[15], 128, SrcIdent{0}, W1T + 128 * 2048, 2048, 0, scr, r / 2, r % 2, lane); continue; } r -= I_W1;
            {
                const int which = r >> 7, i = r & 127; const float* pos = args.in[which ? 14 : 11]; const float* w1 = args.in[which ? 15 : 12];
                float a = 0.f;
                for (int k = lane; k < 2048; k += 64) a += pos[k] * w1[(size_t)k * 128 + i];
                a = wave_sum(a);
                if (lane == 0) bias1[r] = a;
            }
        }
        const float* gain = args.in[1];
        f32x4 gv[4];
#pragma unroll
        for (int j = 0; j < 4; ++j) gv[j] = ((const f32x4*)gain)[lane + 64 * j];
        for (int m = gw; m < M; m += NGW) {
            const f32x4* xr = (const f32x4*)(x + (size_t)m * D) + lane;
            f32x4 v[4]; float s = 0.f;
#pragma unroll
            for (int j = 0; j < 4; ++j) { v[j] = xr[64 * j]; s += (v[j].x * v[j].x + v[j].y * v[j].y) + (v[j].z * v[j].z + v[j].w * v[j].w); }
            const float rstd = rsqrtf(wave_sum(s) * (1.f / D) + EPS);
            unsigned long long* o8 = (unsigned long long*)(Hb + (size_t)m * D) + lane;
#pragma unroll
            for (int j = 0; j < 4; ++j) { const f32x4 y = v[j] * rstd * gv[j]; o8[64 * j] = (unsigned long long)pk2(y.x, y.y) | ((unsigned long long)pk2(y.z, y.w) << 32); }
        }
    }
    SEAM(0);
    if (IN(1)) {
        pg8::Gemm g{Hb, Win_t, D, D, M, NP1, D, 0}; pg8::StaticOrder S; S.init(M, NP1, G, (int)blockIdx.x);
        pg8::EpiP<0> E{P, LDP, 26, 64, Halo};
        pg8::gemm_phase<pg8::EpiP<0>, pg8::StaticOrder, true>(lds, g, S, E);
    }
    SEAM(1);
    if (IN(2)) {
        for (int it = blockIdx.x; it < 128; it += G) {
            const int half = it & 1, which = (it >> 1) & 1, g_ = (it >> 2) & 3, b_ = it >> 4;
            nsa::compress_item(lds, P, W1T + (size_t)which * 128 * 2048, bias1 + which * 128, args.in[which ? 16 : 13], args.in[8], which ? VCb : KCb, b_, g_, which, half);
        }
        STAMP(11);
        nsa::prep_units(P, args.in[7], args.in[9], args.in[10], gw, NGW, lane);
        STAMP(12);
#if !defined(GDN_NAIVE)
        __syncthreads();
        for (int it = blockIdx.x; it < 2048; it += G) { gdn::prep_item(lds, P, Halo, args.in[3], args.in[4], args.in[5], GWb, GQKb, GLv, it >> 8, it & 31, (it >> 5) & 7); if (it < 256) STAMP(14); }
        STAMP(13);
#endif
    }
    SEAM(2);
    if (IN(3)) {
#if defined(GDN_NAIVE)
        if ((int)blockIdx.x < 16) gdn_naive::run(lds, P, args.in[3], args.in[4], args.in[5], args.in[6], 4 * (int)blockIdx.x);
#else
        if ((int)blockIdx.x < 64) gdn::scan_item(lds, P, GWb, GQKb, GLv, args.in[6], (int)blockIdx.x >> 3, (int)blockIdx.x & 7);
#endif
        __syncthreads();
        STAMP(10);
        for (;;) {
            volatile LAS unsigned* qslot = (volatile LAS unsigned*)(lds + 147456 - 16);
            if (tid == 0) *qslot = atomicAdd(qcnt, 1u);
            __syncthreads();
            const int idx = (int)*qslot;
            __syncthreads();
            if (idx >= 1024) break;
#if defined(TPROBE)
            if (blockIdx.x == 200 && tid == 0) { ((volatile unsigned long long*)(ws + 786432))[0] = __builtin_amdgcn_s_memrealtime(); ((volatile unsigned*)(ws + 786432))[4] += 1u; }
#endif
            nsa::attn_tile(lds, P, KCb, VCb, (idx & 31) >> 2, idx & 3, 31 - (idx >> 5));
        }
    }
    SEAM(3);
    if (IN(4)) {
        pg8::Gemm g{Hb, Wg_t, D, D, M, 2048, D, 0}; pg8::StaticOrder S; S.init(M, 2048, G, (int)blockIdx.x);
        pg8::EpiP<1> E{P, LDP, -1, 256, nullptr};
        pg8::gemm_phase<pg8::EpiP<1>, pg8::StaticOrder, true>(lds, g, S, E);
    }
    SEAM(4);
    if (IN(5)) {
        pg8::Gemm g{P + C_DZ, Wcat_t, LDP, 2 * D, M, D, D, D}; pg8::TwoPassOrder S; S.base.init(M, D, G, (int)blockIdx.x);
        pg8::EpiMix E{P, LDP, Mix, D};
        pg8::gemm_phase<pg8::EpiMix, pg8::TwoPassOrder, false>(lds, g, S, E);
    }
    SEAM(5);
    if (IN(6)) {
        for (int it = gw; it < 64 * 16; it += NGW) transpose_item(args.in[22], D, SrcIdent{0}, Wdown_t, FF, 0, scr, it / 16, it % 16, lane);
        __syncthreads();
        pg8::Gemm g{Mix, Wout_t, D, D, M, D, D, 0}; pg8::StaticOrder S; S.init(M, D, G, (int)blockIdx.x);
        pg8::EpiOut E{x, args.out, An, args.in[20], pss};
        pg8::gemm_phase<pg8::EpiOut, pg8::StaticOrder, false>(lds, g, S, E);
    }
    SEAM(6);
    if (IN(7)) {
        pg8::Gemm g{An, Wup_t, D, D, M, FF, D, 0}; pg8::StaticOrder S; S.init(M, FF, G, (int)blockIdx.x);
        pg8::EpiUp E{pss, Up, FF};
        pg8::gemm_phase<pg8::EpiUp, pg8::StaticOrder, true>(lds, g, S, E);
    }
    SEAM(7);
    if (IN(8)) {
        pg8::Gemm g{Up, Wdown_t, FF, FF, M, D, FF, 0}; pg8::StaticOrder S; S.init(M, D, G, (int)blockIdx.x);
        pg8::EpiDown E{args.out};
        pg8::gemm_phase<pg8::EpiDown, pg8::StaticOrder, false>(lds, g, S, E);
    }
#if defined(TPROBE)
    STAMP(9);
    GRID_SYNC();
    if (blockIdx.x == 0) {
        volatile LAS unsigned long long* ts = (volatile LAS unsigned long long*)(lds + 147456 - 512);
        if (tid == 0) { ts[25] = ((volatile unsigned long long*)(ws + 786432))[0]; ts[26] = ts[3] + 100ull * ((volatile unsigned*)(ws + 786432))[4]; }
        const float dA = (float)(ts[TPA1] - ts[TPA0]) * 0.01f, dB = (float)(ts[TPB1] - ts[TPB0]) * 0.01f;
        if (tid == 0) args.out[0] = dA + 0.f * dB;
    }
#endif
#undef IN
#undef SEAM
#undef GRID_SYNC
}

static int g_grid = 0;
static void launch_mk(const Args& a0, int lo, int hi, hipStream_t stream) {
    Args a = a0; a.ph_lo = lo; a.ph_hi = hi;
    void* kargs[] = {(void*)&a};
    hipError_t e = hipLaunchCooperativeKernel((const void*)mk_fwd, dim3(g_grid), dim3(NWAVES * 64), kargs, LDS_BYTES, stream);
    if (e != hipSuccess) fprintf(stderr, "cooperative launch failed: %s (grid %d)\n", hipGetErrorString(e), g_grid);
}

extern "C" void kernel_launch(void* const* d_in, const int* in_sizes, int n_in, void* d_out, int out_size, void* d_ws, size_t ws_size, hipStream_t stream) {
    if (g_grid == 0) {
        int dev = 0, cus = 0, per_cu = 0;
        hipGetDevice(&dev);
        hipDeviceGetAttribute(&cus, hipDeviceAttributeMultiprocessorCount, dev);
        hipFuncSetAttribute((const void*)mk_fwd, hipFuncAttributeMaxDynamicSharedMemorySize, LDS_BYTES);
        hipOccupancyMaxActiveBlocksPerMultiprocessor(&per_cu, (const void*)mk_fwd, NWAVES * 64, LDS_BYTES);
        if (per_cu < 1) per_cu = 1;
        if (per_cu > 1) per_cu = 1;
        g_grid = cus * per_cu;
    }
    Args a{};
    for (int i = 0; i < 23; ++i) a.in[i] = (const float*)d_in[i];
    a.out = (float*)d_out; a.ws = (unsigned char*)d_ws;
    bf16_t* P = (bf16_t*)((char*)d_ws + WS_P);
    launch_mk(a, 0, 9, stream);
}
```

```cpp
#include <hip/hip_runtime.h>
#include <hip/hip_cooperative_groups.h>
#include <stdint.h>
#include <cstdio>
namespace cg = cooperative_groups;

typedef unsigned short bf16_t;

constexpr int D = 1024, BATCH = 8, SEQ = 2048, M = BATCH * SEQ;
constexpr int DN_H = 8, DN_D = 128;
constexpr int NS_H = 16, NS_G = 4, NS_R = 4, NS_D = 64;
constexpr int NCMP = 127, NSEL = 32;
constexpr int FF = 4096;
constexpr int INW = 8768;
constexpr float EPS = 1e-6f;
constexpr float NEGV = -1e30f, FORCEV = 1e9f;

constexpr int LDP = 6720;
constexpr int C_DQ = 0, C_DK = 1024, C_DV = 2048, C_DZ = 3072, C_NQ = 4096;
constexpr int C_KC = 5120, C_VC = 5376, C_KS = 5632, C_VS = 5888, C_KW = 6144, C_VW = 6400;
constexpr int C_SB = 6656, C_SA = 6664, C_SG = 6672;
constexpr int NP1 = 6912;

__device__ __forceinline__ float bf2f(bf16_t v) { return __uint_as_float(((unsigned)v) << 16); }
__device__ __forceinline__ bf16_t f2bf(float f) { unsigned u = __float_as_uint(f); return (bf16_t)((u + 0x7fffu + ((u >> 16) & 1u)) >> 16); }
__device__ __forceinline__ float sigmoidf_(float x) { return 1.f / (1.f + __expf(-x)); }
__device__ __forceinline__ float siluf_(float x) { return x * sigmoidf_(x); }
__device__ __forceinline__ float softplusf_(float x) { return fmaxf(x, 0.f) + log1pf(__expf(-fabsf(x))); }
__device__ __forceinline__ float gelu_tanh(float x) { return 0.5f * x * (1.f + tanhf(0.7978845608028654f * (x + 0.044715f * x * x * x))); }

__device__ __forceinline__ float block_sum(float v, float* red) {
    for (int o = 32; o > 0; o >>= 1) v += __shfl_xor(v, o);
    const int w = threadIdx.x >> 6, nw = blockDim.x >> 6;
    __syncthreads();
    if ((threadIdx.x & 63) == 0) red[w] = v;
    __syncthreads();
    float s = 0.f;
    for (int i = 0; i < nw; ++i) s += red[i];
    return s;
}
__device__ __forceinline__ float block_max(float v, float* red) {
    for (int o = 32; o > 0; o >>= 1) v = fmaxf(v, __shfl_xor(v, o));
    const int w = threadIdx.x >> 6, nw = blockDim.x >> 6;
    __syncthreads();
    if ((threadIdx.x & 63) == 0) red[w] = v;
    __syncthreads();
    float s = red[0];
    for (int i = 1; i < nw; ++i) s = fmaxf(s, red[i]);
    return s;
}


#if defined(TPROBE)
#define XSTAMP(k) do { if (blockIdx.x == 0 && threadIdx.x == 0) ((volatile __attribute__((address_space(3))) unsigned long long*)(lds + 147456 - 512))[k] = __builtin_amdgcn_s_memrealtime(); } while (0)
#else
#define XSTAMP(k) do { } while (0)
#endif
namespace gdn_naive {
#define GLAS __attribute__((address_space(3)))
__device__ __forceinline__ float sub_sum(float v, GLAS float* red, int sub, int tid) {
#pragma unroll
    for (int o = 32; o > 0; o >>= 1) v += __shfl_xor(v, o);
    __syncthreads();
    if ((tid & 63) == 0) red[sub * 2 + ((tid >> 6) & 1)] = v;
    __syncthreads();
    return red[sub * 2] + red[sub * 2 + 1];
}
__device__ __forceinline__ void run(GLAS unsigned char* lds, bf16_t* P, const float* convw, const float* a_log, const float* dt_bias, const float* out_norm, int item0) {
    const int tid = threadIdx.x, sub = tid >> 7, j = tid & 127;
    GLAS float* qs = (GLAS float*)lds + sub * 256; GLAS float* ks = qs + 128; GLAS float* red = (GLAS float*)(lds + 4096);
    const int item = item0 + sub; const int b = item / DN_H, h = item % DN_H;
    float s[128];
#pragma unroll
    for (int i = 0; i < 128; ++i) s[i] = 0.f;
    const float Ah = -__expf(a_log[h]), dtb = dt_bias[h], gn = out_norm[j];
    const float scale = 0.08838834764831845f;
    float wq[4], wk[4], wv[4], xq[3] = {0.f, 0.f, 0.f}, xk[3] = {0.f, 0.f, 0.f}, xv[3] = {0.f, 0.f, 0.f};
#pragma unroll
    for (int t = 0; t < 4; ++t) { wq[t] = convw[t * 3072 + h * 128 + j]; wk[t] = convw[t * 3072 + 1024 + h * 128 + j]; wv[t] = convw[t * 3072 + 2048 + h * 128 + j]; }
    for (int t = 0; t < SEQ; ++t) {
        bf16_t* row = P + (size_t)(b * SEQ + t) * LDP;
        const float rq = bf2f(row[C_DQ + h * DN_D + j]), rk = bf2f(row[C_DK + h * DN_D + j]), rv = bf2f(row[C_DV + h * DN_D + j]);
        float q = siluf_(wq[0] * xq[0] + wq[1] * xq[1] + wq[2] * xq[2] + wq[3] * rq);
        float k = siluf_(wk[0] * xk[0] + wk[1] * xk[1] + wk[2] * xk[2] + wk[3] * rk);
        const float v = siluf_(wv[0] * xv[0] + wv[1] * xv[1] + wv[2] * xv[2] + wv[3] * rv);
        xq[0] = xq[1]; xq[1] = xq[2]; xq[2] = rq; xk[0] = xk[1]; xk[1] = xk[2]; xk[2] = rk; xv[0] = xv[1]; xv[1] = xv[2]; xv[2] = rv;
        const float sq = sub_sum(q * q, red, sub, tid);
        const float sk = sub_sum(k * k, red, sub, tid);
        q *= rsqrtf(sq + EPS); k *= rsqrtf(sk + EPS);
        qs[j] = q; ks[j] = k;
        const float beta = sigmoidf_(bf2f(row[C_SB + h]));
        const float a = __expf(Ah * softplusf_(bf2f(row[C_SA + h]) + dtb));
        const float z = bf2f(row[C_DZ + h * DN_D + j]);
        __syncthreads();
        float kS = 0.f;
#pragma unroll
        for (int i = 0; i < 128; ++i) kS += ks[i] * s[i];
        const float dlt = beta * (v - a * kS);
        asm volatile("" ::: "memory");
        float o = 0.f;
#pragma unroll
        for (int i = 0; i < 128; ++i) { s[i] = a * s[i] + ks[i] * dlt; o += qs[i] * s[i]; }
        o *= scale;
        const float ss = sub_sum(o * o, red, sub, tid);
        row[C_DZ + h * DN_D + j] = f2bf(o * rsqrtf(ss * (1.f / 128.f) + EPS) * gn * siluf_(z));
    }
}
}
namespace gdn {
#define GL3 __attribute__((address_space(3)))
typedef short bf16x8 __attribute__((ext_vector_type(8)));
typedef short s16x4 __attribute__((ext_vector_type(4)));
typedef short v4i16_t __attribute__((ext_vector_type(4)));
typedef float f32x16 __attribute__((ext_vector_type(16)));
typedef float f32x4 __attribute__((ext_vector_type(4)));
typedef float f32x2 __attribute__((ext_vector_type(2)));
typedef unsigned u32x4 __attribute__((ext_vector_type(4)));
typedef unsigned u32x2 __attribute__((ext_vector_type(2)));
typedef __bf16 bf16x2_t __attribute__((ext_vector_type(2)));
constexpr float QSCALE = 0.08838834764831845f;
__device__ __forceinline__ float fsig(float x) { return __builtin_amdgcn_rcpf(1.f + __builtin_amdgcn_exp2f(-1.4426950408889634f * x)); }
__device__ __forceinline__ float fsilu(float x) { return x * fsig(x); }
__device__ __forceinline__ int crow(int i, int hi) { return (i & 3) + 8 * (i >> 2) + 4 * hi; }
__device__ __forceinline__ unsigned pk(float lo, float hi) { f32x2 v = {lo, hi}; bf16x2_t b = __builtin_convertvector(v, bf16x2_t); return __builtin_bit_cast(unsigned, b); }
__device__ __forceinline__ bf16x8 pack8(const float* v) { u32x4 w = {pk(v[0], v[1]), pk(v[2], v[3]), pk(v[4], v[5]), pk(v[6], v[7])}; return __builtin_bit_cast(bf16x8, w); }
__device__ __forceinline__ float blo(unsigned w) { return __uint_as_float(w << 16); }
__device__ __forceinline__ float bhi(unsigned w) { return __uint_as_float(w & 0xffff0000u); }
__device__ __forceinline__ char* seg_addr(bf16_t* P, size_t row0, int c0, unsigned e) { return (char*)P + ((row0 + (e >> 8)) * LDP + c0) * 2 + (e & 255u); }

__device__ __forceinline__ s16x4 vtr(GL3 const unsigned char* p) { return __builtin_bit_cast(s16x4, __builtin_amdgcn_ds_read_tr16_b64_v4i16((GL3 v4i16_t*)p)); }

constexpr int PL_K = 0, PL_KB = 16384, PL_Q = 32768, PL_RV = 49152, PL_AM = 81920, PL_INV = 99328, PL_MT = 116736, PL_GC = 120832, PL_QKST = 121088, PL_TI = 129280, PL_CW = 137472, PL_END = 143616;
constexpr int PL_WST = 0, PL_UST = 16384;
constexpr int AMLD = 68;
struct RowPre { u32x4 x[2][3][4]; unsigned short lb, la; };
__device__ __forceinline__ void prep_prefetch(RowPre& pre, const bf16_t* P, const bf16_t* HALO, int b, int n, int h, int wid, int lane) {
    const size_t row0 = (size_t)b * SEQ + 64 * n; const int dc = lane & 15;
    const bf16_t* prow = P + (row0 + lane) * LDP;
    pre.lb = prow[C_SB + h]; pre.la = prow[C_SA + h];
#pragma unroll
    for (int pass = 0; pass < 2; ++pass) {
        const int tok = 8 * wid + 4 * pass + (lane >> 4);
#pragma unroll
        for (int which = 0; which < 3; ++which) {
            const int col = which * 1024 + h * 128 + dc * 8;
#pragma unroll
            for (int j = 0; j < 4; ++j) {
                const int rr = tok - 3 + j; const bool inb = rr >= 0;
                const bf16_t* src = inb ? (P + (row0 + (inb ? rr : 0)) * LDP + col) : (HALO + ((size_t)((b * 32 + (n > 0 ? n - 1 : 0)) * 3 + (inb ? 0 : 3 + rr))) * 3072 + col);
                pre.x[pass][which][j] = *(const u32x4*)src;
            }
        }
    }
}
__device__ __forceinline__ void prep_load_taps(GL3 unsigned char* lds, const float* convw, int h) {
    GL3 float* cw = (GL3 float*)(lds + 137472);
    for (int e = threadIdx.x; e < 1536; e += 512) { const int which = e >> 9, j = (e >> 7) & 3, c = e & 127; cw[e] = convw[j * 3072 + which * 1024 + h * 128 + c]; }
}
#define PBAR() do { asm volatile("s_waitcnt lgkmcnt(0)" ::: "memory"); __builtin_amdgcn_s_barrier(); asm volatile("" ::: "memory"); } while (0)
__device__ __forceinline__ void prep_item(GL3 unsigned char* lds, bf16_t* P, const bf16_t* HALO, const float* a_log, const float* dt_bias,
                                          bf16_t* GW, bf16_t* GQK, float* GLv, RowPre& pre, int b, int n, int h, int nb_, int nn_, int nh_) {
    int tid = threadIdx.x; asm volatile("" : "+v"(tid));
    const int lane = tid & 63, r32 = lane & 31, hi = lane >> 5; const int wid = __builtin_amdgcn_readfirstlane(tid >> 6);
    const size_t row0 = (size_t)b * SEQ + 64 * n; const int item = (b * DN_H + h) * 32 + n;
    GL3 float* AM = (GL3 float*)(lds + PL_AM); GL3 float* INV = (GL3 float*)(lds + PL_INV); GL3 float* MT = (GL3 float*)(lds + PL_MT); GL3 float* GC = (GL3 float*)(lds + PL_GC);
    float gcum, beta_l, gc_last;
    {
        beta_l = fsig(bf2f(pre.lb));
        { const float xs = bf2f(pre.la) + dt_bias[h]; gcum = -__expf(a_log[h]) * (fmaxf(xs, 0.f) + __logf(1.f + __expf(-fabsf(xs)))); }
#pragma unroll
        for (int o = 1; o < 64; o <<= 1) { const float t = __shfl_up(gcum, o); if (lane >= o) gcum += t; }
        gc_last = __shfl(gcum, 63);
        if (wid == 0) GC[lane] = gcum;
    }
    bf16x8 qd_keep[2], ke_keep[2];
    const int dc = lane & 15;
#pragma unroll
    for (int pass = 0; pass < 2; ++pass) {
        const int tok = 8 * wid + 4 * pass + (lane >> 4);
        const float gct = __shfl(gcum, tok), bet = __shfl(beta_l, tok);
        float y[3][8];
#pragma unroll
        for (int which = 0; which < 3; ++which) {
#pragma unroll
            for (int e = 0; e < 8; ++e) y[which][e] = 0.f;
#pragma unroll
            for (int j = 0; j < 4; ++j) {
                const int rr = tok - 3 + j;
                u32x4 x = pre.x[pass][which][j];
                if (rr < 0 && n == 0) x = (u32x4){0u, 0u, 0u, 0u};
                const f32x4 w0 = *(GL3 const f32x4*)(lds + PL_CW + ((which * 4 + j) * 128 + dc * 8) * 4), w1 = *(GL3 const f32x4*)(lds + PL_CW + ((which * 4 + j) * 128 + dc * 8 + 4) * 4);
                y[which][0] += w0[0] * blo(x.x); y[which][1] += w0[1] * bhi(x.x); y[which][2] += w0[2] * blo(x.y); y[which][3] += w0[3] * bhi(x.y);
                y[which][4] += w1[0] * blo(x.z); y[which][5] += w1[1] * bhi(x.z); y[which][6] += w1[2] * blo(x.w); y[which][7] += w1[3] * bhi(x.w);
            }
#pragma unroll
            for (int e = 0; e < 8; ++e) y[which][e] = fsilu(y[which][e]);
        }
        float sq = 0.f, sk = 0.f;
#pragma unroll
        for (int e = 0; e < 8; ++e) { sq += y[0][e] * y[0][e]; sk += y[1][e] * y[1][e]; }
#pragma unroll
        for (int o = 1; o < 16; o <<= 1) { sq += __shfl_xor(sq, o); sk += __shfl_xor(sk, o); }
        const float rq = rsqrtf(sq + EPS), rk = rsqrtf(sk + EPS);
        const float eg = __expf(gct), ke_s = __expf(gc_last - gct);
        float q8[8], k8[8], kb8[8], qd8[8], ke8[8], kbg8[8], vb8[8];
#pragma unroll
        for (int e = 0; e < 8; ++e) { q8[e] = y[0][e] * rq; k8[e] = y[1][e] * rk; kb8[e] = k8[e] * bet; qd8[e] = q8[e] * (QSCALE * eg); ke8[e] = k8[e] * ke_s; kbg8[e] = kb8[e] * eg; vb8[e] = y[2][e] * bet; }
        const int io = (dc * 64 + tok) * 16;
        *(GL3 bf16x8*)(lds + PL_Q + io) = pack8(q8); *(GL3 bf16x8*)(lds + PL_K + io) = pack8(k8); *(GL3 bf16x8*)(lds + PL_KB + io) = pack8(kb8);
        {
            const int rvo = (tok >> 4) * 1024 + ((tok >> 3) & 1) * 512 + (tok & 7) * 64 + (dc & 3) * 16;
            *(GL3 bf16x8*)(lds + PL_RV + (dc >> 2) * 4096 + rvo) = pack8(kbg8); *(GL3 bf16x8*)(lds + PL_RV + (4 + (dc >> 2)) * 4096 + rvo) = pack8(vb8);
        }
        qd_keep[pass] = pack8(qd8); ke_keep[pass] = pack8(ke8);
    }
    PBAR();
    if (nb_ >= 0) prep_prefetch(pre, P, HALO, nb_, nn_, nh_, wid, lane);
    if (n == 0 && b == 0 && h == 0) XSTAMP(15);
#pragma unroll
    for (int pass = 0; pass < 2; ++pass) {
        const int tok = 8 * wid + 4 * pass + (lane >> 4);
        *(bf16x8*)seg_addr(P, row0, C_DQ + h * 128, (unsigned)((dc * 64 + tok) * 16)) = qd_keep[pass];
        const unsigned ek = (unsigned)(((dc >> 2) * 4 + (tok >> 4)) * 1024 + ((tok >> 3) & 1) * 512 + (tok & 7) * 64 + (dc & 3) * 16);
        *(bf16x8*)seg_addr(P, row0, C_DK + h * 128, ek) = ke_keep[pass];
    }
    if (wid < 6) {
        const bool isA = wid < 3; const int t3 = isA ? wid : wid - 3;
        const int rt = isA ? (t3 > 0) : (t3 == 2);
        const int ct = isA ? (t3 == 2) : (t3 > 0);
        GL3 const unsigned char* aimg = lds + (isA ? PL_KB : PL_K); GL3 const unsigned char* bimg = lds + (isA ? PL_K : PL_Q);
        f32x16 acc = f32x16{};
#pragma unroll
        for (int s = 0; s < 8; ++s) {
            const bf16x8 a = *(GL3 const bf16x8*)(aimg + ((2 * s + hi) * 64 + 32 * rt + r32) * 16);
            const bf16x8 bb = *(GL3 const bf16x8*)(bimg + ((2 * s + hi) * 64 + 32 * ct + r32) * 16);
            acc = __builtin_amdgcn_mfma_f32_32x32x16_bf16(a, bb, acc, 0, 0, 0);
        }
        if (isA) {
            const int j = 32 * ct + r32; const float gj = GC[j];
#pragma unroll
            for (int i_ = 0; i_ < 16; ++i_) { const int i = 32 * rt + crow(i_, hi); AM[i * AMLD + j] = (j < i) ? acc[i_] * __expf(GC[i] - gj) : 0.f; }
        } else {
            const int i = 32 * ct + r32; const float gi = GC[i];
            float v[16];
#pragma unroll
            for (int i_ = 0; i_ < 16; ++i_) { const int j = 32 * rt + crow(i_, hi); v[i_] = (j <= i) ? acc[i_] * (QSCALE * __expf(gi - GC[j])) : 0.f; }
#pragma unroll
            for (int sp = 0; sp < 2; ++sp) *(GL3 bf16x8*)(lds + PL_QKST + (((2 * rt + sp) * 64 + i) * 16 + 8 * hi) * 2) = pack8(v + 8 * sp);
        }
    } else if (wid == 6) {
        const bf16x8 z = {0, 0, 0, 0, 0, 0, 0, 0};
#pragma unroll
        for (int sp = 0; sp < 2; ++sp) *(GL3 bf16x8*)(lds + PL_QKST + (((2 + sp) * 64 + r32) * 16 + 8 * hi) * 2) = z;
    }
    PBAR();
    if (wid < 4 && lane < 16) {
        const int bb = wid, c = lane;
        float x[16];
#pragma unroll
        for (int i = 0; i < 16; ++i) {
            float acc = (i == c) ? 1.f : 0.f;
#pragma unroll
            for (int j4 = 0; j4 < i; j4 += 4) { const f32x4 a = *(GL3 const f32x4*)(AM + (16 * bb + i) * AMLD + 16 * bb + j4);
                acc -= a[0] * x[j4]; if (j4 + 1 < i) acc -= a[1] * x[j4 + 1]; if (j4 + 2 < i) acc -= a[2] * x[j4 + 2]; if (j4 + 3 < i) acc -= a[3] * x[j4 + 3]; }
            x[i] = acc;
        }
#pragma unroll
        for (int i = 0; i < 16; ++i) INV[(16 * bb + i) * AMLD + 16 * bb + c] = x[i];
    }
    PBAR();
    for (int L = 1; L < 4; ++L) {
        const int nb = 4 - L;
        for (int t = tid; t < nb * 256; t += 512) {
            const int J = t >> 8, I = J + L, ei = (t >> 4) & 15, ej = t & 15;
            float acc = 0.f;
            for (int K = J; K < I; ++K) {
#pragma unroll
                for (int k4 = 0; k4 < 16; k4 += 4) { const f32x4 a = *(GL3 const f32x4*)(AM + (16 * I + ei) * AMLD + 16 * K + k4);
                    acc += a[0] * INV[(16 * K + k4) * AMLD + 16 * J + ej] + a[1] * INV[(16 * K + k4 + 1) * AMLD + 16 * J + ej] + a[2] * INV[(16 * K + k4 + 2) * AMLD + 16 * J + ej] + a[3] * INV[(16 * K + k4 + 3) * AMLD + 16 * J + ej]; }
            }
            MT[(J * 16 + ei) * 17 + ej] = acc;
        }
        PBAR();
        for (int t = tid; t < nb * 256; t += 512) {
            const int J = t >> 8, I = J + L, ei = (t >> 4) & 15, ej = t & 15;
            float acc = 0.f;
#pragma unroll
            for (int k4 = 0; k4 < 16; k4 += 4) { const f32x4 d = *(GL3 const f32x4*)(INV + (16 * I + ei) * AMLD + 16 * I + k4);
                acc += d[0] * MT[(J * 16 + k4) * 17 + ej] + d[1] * MT[(J * 16 + k4 + 1) * 17 + ej] + d[2] * MT[(J * 16 + k4 + 2) * 17 + ej] + d[3] * MT[(J * 16 + k4 + 3) * 17 + ej]; }
            INV[(16 * I + ei) * AMLD + 16 * J + ej] = -acc;
        }
        PBAR();
    }
    {
        const int s_ = tid >> 7, i = (tid >> 1) & 63, hh = tid & 1;
        float v[8];
        if (s_ > (i >> 4)) {
#pragma unroll
            for (int e = 0; e < 8; ++e) v[e] = 0.f;
        } else {
            const f32x4 a = *(GL3 const f32x4*)(INV + i * AMLD + 16 * s_ + 4 * hh), c4 = *(GL3 const f32x4*)(INV + i * AMLD + 16 * s_ + 8 + 4 * hh);
            v[0] = a[0]; v[1] = a[1]; v[2] = a[2]; v[3] = a[3]; v[4] = c4[0]; v[5] = c4[1]; v[6] = c4[2]; v[7] = c4[3];
        }
        *(GL3 bf16x8*)(lds + PL_TI + ((s_ * 64 + i) * 16 + 8 * hh) * 2) = pack8(v);
    }
    PBAR();
    {
        const int cb = wid;
        GL3 const unsigned char* rp = lds + PL_RV + cb * 4096 + ((lane >> 4) & 1) * 32 + (lane & 3) * 8 + (4 * hi + ((lane & 15) >> 2)) * 64;
        f32x16 d0 = f32x16{}, d1 = f32x16{};
#pragma unroll
        for (int ks = 0; ks < 4; ++ks) {
            const s16x4 lo = vtr(rp + ks * 1024), hh2 = vtr(rp + ks * 1024 + 512);
            const bf16x8 rf = {lo[0], lo[1], lo[2], lo[3], hh2[0], hh2[1], hh2[2], hh2[3]};
            const bf16x8 t1 = *(GL3 const bf16x8*)(lds + PL_TI + ((ks * 64 + 32 + r32) * 16 + 8 * hi) * 2);
            if (cb < 4) {
                if (ks < 2) { const bf16x8 t0 = *(GL3 const bf16x8*)(lds + PL_TI + ((ks * 64 + r32) * 16 + 8 * hi) * 2); d0 = __builtin_amdgcn_mfma_f32_32x32x16_bf16(rf, t0, d0, 0, 0, 0); }
                d1 = __builtin_amdgcn_mfma_f32_32x32x16_bf16(rf, t1, d1, 0, 0, 0);
            } else {
                if (ks < 2) { const bf16x8 t0 = *(GL3 const bf16x8*)(lds + PL_TI + ((ks * 64 + r32) * 16 + 8 * hi) * 2); d0 = __builtin_amdgcn_mfma_f32_32x32x16_bf16(t0, rf, d0, 0, 0, 0); }
                d1 = __builtin_amdgcn_mfma_f32_32x32x16_bf16(t1, rf, d1, 0, 0, 0);
            }
        }
        PBAR();
        if (cb < 4) {
#pragma unroll
            for (int a = 0; a < 4; ++a) {
                u32x2 w0 = {pk(d0[4 * a], d0[4 * a + 1]), pk(d0[4 * a + 2], d0[4 * a + 3])}, w1 = {pk(d1[4 * a], d1[4 * a + 1]), pk(d1[4 * a + 2], d1[4 * a + 3])};
                *(GL3 u32x2*)(lds + PL_WST + ((4 * cb + a) * 64 + r32) * 16 + 8 * hi) = w0;
                *(GL3 u32x2*)(lds + PL_WST + ((4 * cb + a) * 64 + 32 + r32) * 16 + 8 * hi) = w1;
            }
        } else {
            const int dvc = 32 * (cb - 4) + r32;
#pragma unroll
            for (int i = 0; i < 16; ++i) { *(GL3 bf16_t*)(lds + PL_UST + (crow(i, hi) * 128 + dvc) * 2) = f2bf(d0[i]); *(GL3 bf16_t*)(lds + PL_UST + ((32 + crow(i, hi)) * 128 + dvc) * 2) = f2bf(d1[i]); }
        }
    }
    PBAR();
#pragma unroll
    for (int k = 0; k < 2; ++k) {
        const int e = (tid + 512 * k) * 16;
        *(u32x4*)((char*)(GW + (size_t)item * 8192) + e) = *(GL3 const u32x4*)(lds + PL_WST + e);
        *(u32x4*)seg_addr(P, row0, C_DV + h * 128, (unsigned)e) = *(GL3 const u32x4*)(lds + PL_UST + e);
    }
    *(u32x4*)((char*)(GQK + (size_t)item * 4096) + tid * 16) = *(GL3 const u32x4*)(lds + PL_QKST + tid * 16);
    if (tid == 0) GLv[item] = __expf(gc_last);
    PBAR();
}

#undef PBAR
constexpr int SL_W = 0, SL_QD = 16384, SL_KE = 32768, SL_QK = 49152, SL_U = 57344, SL_Z = 73728, SL_S = 90112, SL_VN = 122880, SL_RS = 139264, SL_END = 140416;
__device__ __forceinline__ void glds16(const void* gsrc, unsigned lds_dst) { unsigned keep;
    asm volatile("s_mov_b32 %0, m0\n\ts_mov_b32 m0, %2\n\ts_nop 0\n\tglobal_load_lds_dwordx4 %1, off\n\ts_mov_b32 m0, %0" : "=&s"(keep) : "v"(gsrc), "s"(lds_dst) : "memory"); }
__device__ __forceinline__ unsigned lds_addr(GL3 unsigned char* p) { return (unsigned)(size_t)p; }
__device__ __forceinline__ void dma_seg(GL3 unsigned char* dst, const bf16_t* P, size_t row0, int c0, int wid, int lane) {
#pragma unroll
    for (int k = 0; k < 2; ++k) { const int piece = wid + 8 * k;
        const char* src = (const char*)P + ((row0 + piece * 4 + (lane >> 4)) * LDP + c0) * 2 + (lane & 15) * 16;
        glds16(src, (unsigned)__builtin_amdgcn_readfirstlane((int)(lds_addr(dst) + piece * 1024))); }
}
template <int NPIECES>
__device__ __forceinline__ void dma_lin(GL3 unsigned char* dst, const bf16_t* src, int wid, int lane) {
#pragma unroll
    for (int k = 0; k < NPIECES / 8; ++k) { const int piece = wid + 8 * k;
        glds16((const char*)src + piece * 1024 + lane * 16, (unsigned)__builtin_amdgcn_readfirstlane((int)(lds_addr(dst) + piece * 1024))); }
}

__device__ __forceinline__ float sum32(float v) {
    v += __builtin_bit_cast(float, __builtin_amdgcn_mov_dpp(__builtin_bit_cast(int, v), 0xB1, 0xF, 0xF, true));
    v += __builtin_bit_cast(float, __builtin_amdgcn_mov_dpp(__builtin_bit_cast(int, v), 0x4E, 0xF, 0xF, true));
    v += __builtin_bit_cast(float, __builtin_amdgcn_mov_dpp(__builtin_bit_cast(int, v), 0x141, 0xF, 0xF, true));
    v += __builtin_bit_cast(float, __builtin_amdgcn_mov_dpp(__builtin_bit_cast(int, v), 0x140, 0xF, 0xF, true));
    v += __shfl_xor(v, 16);
    return v;
}
#define GRAWBAR() do { asm volatile("s_waitcnt lgkmcnt(0)" ::: "memory"); __builtin_amdgcn_s_barrier(); asm volatile("" ::: "memory"); } while (0)
#define GWAITV0() asm volatile("s_waitcnt vmcnt(0)" ::: "memory")
constexpr int SL_GL = SL_RS + 1024;
__device__ __forceinline__ void scan_item(GL3 unsigned char* lds, bf16_t* P, const bf16_t* GW, const bf16_t* GQK, const float* GLv, const float* out_norm, int b, int h) {
    const int tid = threadIdx.x, lane = tid & 63, r32 = lane & 31, hi = lane >> 5; const int wid = __builtin_amdgcn_readfirstlane(tid >> 6);
    const int mt = wid >> 2, nt = wid & 3;
    const int dv = 32 * nt + r32;
    const int item0 = (b * DN_H + h) * 32; const size_t rowb = (size_t)b * SEQ;
    f32x16 S0 = f32x16{}, S1 = f32x16{};
    {
        const u32x4 z = {0u, 0u, 0u, 0u};
#pragma unroll
        for (int k = 0; k < 4; ++k) *(GL3 u32x4*)(lds + SL_S + (tid + 512 * k) * 16) = z;
        if (tid < 32) *(GL3 float*)(lds + SL_GL + tid * 4) = GLv[item0 + tid];
    }
    const float gain = out_norm[dv];
    GL3 float* RS = (GL3 float*)(lds + SL_RS);
#define ISSUE_A(n_) do { dma_lin<16>(lds + SL_W, GW + (size_t)(item0 + (n_)) * 8192, wid, lane); dma_seg(lds + SL_QD, P, rowb + 64 * (n_), C_DQ + h * 128, wid, lane); dma_seg(lds + SL_U, P, rowb + 64 * (n_), C_DV + h * 128, wid, lane); } while (0)
#define ISSUE_B(n_) do { dma_seg(lds + SL_KE, P, rowb + 64 * (n_), C_DK + h * 128, wid, lane); dma_lin<8>(lds + SL_QK, GQK + (size_t)(item0 + (n_)) * 4096, wid, lane); dma_seg(lds + SL_Z, P, rowb + 64 * (n_), C_DZ + h * 128, wid, lane); } while (0)
    GWAITV0();
    ISSUE_A(0);
    for (int n = 0; n < 32; ++n) {
        const size_t row0 = rowb + 64 * n;
        GWAITV0(); GRAWBAR();
        ISSUE_B(n);
        const float gl = *(GL3 const float*)(lds + SL_GL + n * 4);
        f32x16 vp = f32x16{}, o = f32x16{};
#pragma unroll
        for (int s = 0; s < 8; ++s) {
            const bf16x8 sb = *(GL3 const bf16x8*)(lds + SL_S + ((2 * s + hi) * 128 + dv) * 16);
            const bf16x8 wa = *(GL3 const bf16x8*)(lds + SL_W + ((2 * s + hi) * 64 + 32 * mt + r32) * 16);
            const bf16x8 qa = *(GL3 const bf16x8*)(lds + SL_QD + ((2 * s + hi) * 64 + 32 * mt + r32) * 16);
            vp = __builtin_amdgcn_mfma_f32_32x32x16_bf16(wa, sb, vp, 0, 0, 0);
            o = __builtin_amdgcn_mfma_f32_32x32x16_bf16(qa, sb, o, 0, 0, 0);
        }
        {
            float v[16];
#pragma unroll
            for (int i = 0; i < 16; ++i) v[i] = bf2f(*(GL3 const bf16_t*)(lds + SL_U + ((32 * mt + crow(i, hi)) * 128 + dv) * 2)) - vp[i];
#pragma unroll
            for (int sp = 0; sp < 2; ++sp) *(GL3 bf16x8*)(lds + SL_VN + (((2 * mt + sp) * 128 + dv) * 16 + 8 * hi) * 2) = pack8(v + 8 * sp);
        }
        GWAITV0(); GRAWBAR();
        if (n + 1 < 32) ISSUE_A(n + 1);
#pragma unroll
        for (int i = 0; i < 16; ++i) { S0[i] *= gl; S1[i] *= gl; }
        {
            GL3 const unsigned char* kp0 = lds + SL_KE + (2 * mt) * 4096 + ((lane >> 4) & 1) * 32 + (lane & 3) * 8 + (4 * hi + ((lane & 15) >> 2)) * 64;
#pragma unroll
            for (int ks = 0; ks < 4; ++ks) {
                const bf16x8 vb = *(GL3 const bf16x8*)(lds + SL_VN + ((ks * 128 + dv) * 16 + 8 * hi) * 2);
                const s16x4 l0 = vtr(kp0 + ks * 1024), h0 = vtr(kp0 + ks * 1024 + 512), l1 = vtr(kp0 + 4096 + ks * 1024), h1 = vtr(kp0 + 4096 + ks * 1024 + 512);
                const bf16x8 k0 = {l0[0], l0[1], l0[2], l0[3], h0[0], h0[1], h0[2], h0[3]}, k1 = {l1[0], l1[1], l1[2], l1[3], h1[0], h1[1], h1[2], h1[3]};
                const bf16x8 qa = *(GL3 const bf16x8*)(lds + SL_QK + ((ks * 64 + 32 * mt + r32) * 16 + 8 * hi) * 2);
                S0 = __builtin_amdgcn_mfma_f32_32x32x16_bf16(k0, vb, S0, 0, 0, 0);
                S1 = __builtin_amdgcn_mfma_f32_32x32x16_bf16(k1, vb, S1, 0, 0, 0);
                o = __builtin_amdgcn_mfma_f32_32x32x16_bf16(qa, vb, o, 0, 0, 0);
            }
        }
#pragma unroll
        for (int i = 0; i < 16; ++i) { const float q = sum32(o[i] * o[i]); if (r32 == 0) RS[(32 * mt + crow(i, hi)) * 4 + nt] = q; }
        GRAWBAR();
#pragma unroll
        for (int a = 0; a < 4; ++a) {
            u32x2 w0 = {pk(S0[4 * a], S0[4 * a + 1]), pk(S0[4 * a + 2], S0[4 * a + 3])}, w1 = {pk(S1[4 * a], S1[4 * a + 1]), pk(S1[4 * a + 2], S1[4 * a + 3])};
            *(GL3 u32x2*)(lds + SL_S + ((4 * (2 * mt) + a) * 128 + dv) * 16 + 8 * hi) = w0;
            *(GL3 u32x2*)(lds + SL_S + ((4 * (2 * mt + 1) + a) * 128 + dv) * 16 + 8 * hi) = w1;
        }
#pragma unroll
        for (int i = 0; i < 16; ++i) { const int tok = 32 * mt + crow(i, hi);
            const f32x4 rs = *(GL3 const f32x4*)(RS + tok * 4);
            const float rstd = rsqrtf(((rs[0] + rs[1]) + (rs[2] + rs[3])) * (1.f / 128.f) + EPS);
            const float z = bf2f(*(GL3 const bf16_t*)(lds + SL_Z + (tok * 128 + dv) * 2));
            *(GL3 bf16_t*)(lds + SL_VN + (tok * 128 + dv) * 2) = f2bf(o[i] * rstd * gain * siluf_(z)); }
        GRAWBAR();
#pragma unroll
        for (int k = 0; k < 2; ++k) { const int e = (tid + 512 * k) * 16; *(u32x4*)seg_addr(P, row0, C_DZ + h * 128, (unsigned)e) = *(GL3 const u32x4*)(lds + SL_VN + e); }
    }
    GWAITV0();
    __syncthreads();
#undef ISSUE_A
#undef ISSUE_B
}
}
namespace nsa {
#define NLAS __attribute__((address_space(3)))
typedef short bf16x8 __attribute__((ext_vector_type(8)));
typedef short s16x4 __attribute__((ext_vector_type(4)));
typedef short v4i16_t __attribute__((ext_vector_type(4)));
typedef float f32x16 __attribute__((ext_vector_type(16)));
typedef float f32x4 __attribute__((ext_vector_type(4)));
typedef float f32x2 __attribute__((ext_vector_type(2)));
typedef unsigned u32x4 __attribute__((ext_vector_type(4)));
typedef __bf16 bf16x2_t __attribute__((ext_vector_type(2)));
constexpr float LOG2E = 1.4426950408889634f;
constexpr float NEG = -1e30f;
constexpr int L_KV = 0;
constexpr int L_IMP = 32768;
constexpr int L_SEL = 65536;
constexpr int L_WS = 66048;
constexpr int L_OST = 68096;
constexpr int L_END = 100864;

__device__ __forceinline__ int crow(int i, int hi) { return (i & 3) + 8 * (i >> 2) + 4 * hi; }
__device__ __forceinline__ unsigned pk(float lo, float hi) { f32x2 v = {lo, hi}; bf16x2_t b = __builtin_convertvector(v, bf16x2_t); return __builtin_bit_cast(unsigned, b); }
__device__ __forceinline__ float xhalf_max(float v) { auto rr = __builtin_amdgcn_permlane32_swap(__float_as_uint(v), __float_as_uint(v), false, false); return fmaxf(__uint_as_float(rr[0]), __uint_as_float(rr[1])); }
__device__ __forceinline__ float xhalf_sum(float v) { auto rr = __builtin_amdgcn_permlane32_swap(__float_as_uint(v), __float_as_uint(v), false, false); return __uint_as_float(rr[0]) + __uint_as_float(rr[1]); }

__device__ __forceinline__ void dma_tile(NLAS unsigned char* slot, const bf16_t* Kb, const bf16_t* Vb, unsigned koff, unsigned voff, int wid) {
    __builtin_amdgcn_global_load_lds((const unsigned*)((const char*)Kb + koff), (NLAS unsigned*)(slot + wid * 1024), 16, 0, 0);
    __builtin_amdgcn_global_load_lds((const unsigned*)((const char*)Vb + voff), (NLAS unsigned*)(slot + 8192 + wid * 1024), 16, 0, 0);
}
__device__ __forceinline__ void tile_offs(unsigned& koff, unsigned& voff, int pitch, int wid, int lane) {
    koff = (unsigned)(lane * pitch + wid * 8) * 2u;
    voff = (unsigned)((16 * (wid & 3) + (lane >> 2)) * pitch + (wid >> 2) * 32 + (lane & 3) * 8) * 2u;
}
__device__ __forceinline__ void qkt(f32x16& p0, f32x16& p1, NLAS const unsigned char* Kslot, const bf16x8* qr, const f32x16& c0, const f32x16& c1, int r32, int hi) {
    NLAS const unsigned char* kb = Kslot + hi * 1024 + r32 * 16;
#pragma unroll
    for (int d0 = 0; d0 < 4; ++d0) {
        const bf16x8 b0 = *(NLAS const bf16x8*)(kb + d0 * 2048);
        const bf16x8 b1 = *(NLAS const bf16x8*)(kb + d0 * 2048 + 512);
        if (d0 == 0) { p0 = __builtin_amdgcn_mfma_f32_32x32x16_bf16(b0, qr[0], c0, 0, 0, 0); p1 = __builtin_amdgcn_mfma_f32_32x32x16_bf16(b1, qr[0], c1, 0, 0, 0); }
        else { p0 = __builtin_amdgcn_mfma_f32_32x32x16_bf16(b0, qr[d0], p0, 0, 0, 0); p1 = __builtin_amdgcn_mfma_f32_32x32x16_bf16(b1, qr[d0], p1, 0, 0, 0); }
    }
}
__device__ __forceinline__ s16x4 vtr(NLAS const unsigned char* p) { return __builtin_bit_cast(s16x4, __builtin_amdgcn_ds_read_tr16_b64_v4i16((NLAS v4i16_t*)p)); }
__device__ __forceinline__ void pv(f32x16* o, NLAS const unsigned char* Vslot, const f32x16& p0, const f32x16& p1, int lane, int hi) {
    u32x4 w0 = {pk(p0[0], p0[1]), pk(p0[2], p0[3]), pk(p0[4], p0[5]), pk(p0[6], p0[7])};
    u32x4 w1 = {pk(p0[8], p0[9]), pk(p0[10], p0[11]), pk(p0[12], p0[13]), pk(p0[14], p0[15])};
    u32x4 w2 = {pk(p1[0], p1[1]), pk(p1[2], p1[3]), pk(p1[4], p1[5]), pk(p1[6], p1[7])};
    u32x4 w3 = {pk(p1[8], p1[9]), pk(p1[10], p1[11]), pk(p1[12], p1[13]), pk(p1[14], p1[15])};
    const bf16x8 pa[4] = {__builtin_bit_cast(bf16x8, w0), __builtin_bit_cast(bf16x8, w1), __builtin_bit_cast(bf16x8, w2), __builtin_bit_cast(bf16x8, w3)};
    NLAS const unsigned char* vp = Vslot + ((lane >> 4) & 1) * 32 + (lane & 3) * 8 + (4 * hi + ((lane & 15) >> 2)) * 64;
#pragma unroll
    for (int d0 = 0; d0 < 2; ++d0)
#pragma unroll
        for (int ks = 0; ks < 4; ++ks) {
            const s16x4 lo = vtr(vp + d0 * 4096 + ks * 1024), hh = vtr(vp + d0 * 4096 + ks * 1024 + 512);
            const bf16x8 vf = {lo[0], lo[1], lo[2], lo[3], hh[0], hh[1], hh[2], hh[3]};
            o[d0] = __builtin_amdgcn_mfma_f32_32x32x16_bf16(pa[ks], vf, o[d0], 0, 0, 0);
        }
}
__device__ __forceinline__ void scale_rows(f32x16* o, NLAS float* wsf, float s, int r32, int hi) {
    if (hi == 0) wsf[r32] = s;
#pragma unroll
    for (int i = 0; i < 16; ++i) { const float f = wsf[crow(i, hi)]; o[0][i] *= f; o[1][i] *= f; }
}
__device__ __forceinline__ void acc_rows(f32x16* tot, const f32x16* o, NLAS float* wsf, float s, int r32, int hi) {
    if (hi == 0) wsf[32 + r32] = s;
#pragma unroll
    for (int i = 0; i < 16; ++i) { const float f = wsf[32 + crow(i, hi)]; tot[0][i] += f * o[0][i]; tot[1][i] += f * o[1][i]; }
}
__device__ __forceinline__ void softmax_step(f32x16& p0, f32x16& p1, float& m, float& l, f32x16* o, NLAS float* wsf, int r32, int hi) {
    float t = fmaxf(p0[0], p1[0]);
#pragma unroll
    for (int i = 1; i < 16; ++i) t = fmaxf(t, fmaxf(p0[i], p1[i]));
    t = xhalf_max(t);
    const float mn = fmaxf(m, t);
    const float alpha = __builtin_amdgcn_exp2f(m - mn);
    float s = 0.f;
#pragma unroll
    for (int i = 0; i < 16; ++i) { p0[i] = __builtin_amdgcn_exp2f(p0[i] - mn); p1[i] = __builtin_amdgcn_exp2f(p1[i] - mn); s += p0[i] + p1[i]; }
    l = l * alpha + s; m = mn;
    if (__any(alpha != 1.f)) scale_rows(o, wsf, alpha, r32, hi);
}

__device__ __forceinline__ void attn_tile(NLAS unsigned char* lds, bf16_t* P, const bf16_t* KC, const bf16_t* VC, int b, int g, int qt) {
    int tid = threadIdx.x; asm volatile("" : "+v"(tid));
    const int lane = tid & 63, r32 = lane & 31, hi = lane >> 5; const int wid = __builtin_amdgcn_readfirstlane(tid >> 6);
    const int head = g * 4 + (wid >> 1), qh = wid & 1, t0 = qt * 64, qi = qh * 32 + r32, blk_t = qt;
    NLAS float* wsf = (NLAS float*)(lds + L_WS) + wid * 64;
    NLAS float* imp = (NLAS float*)(lds + L_IMP);
    NLAS unsigned* selm = (NLAS unsigned*)(lds + L_SEL);
    NLAS unsigned char* slot0 = lds + L_KV; NLAS unsigned char* slot1 = lds + L_KV + 16384;
    const size_t rowbase = (size_t)b * SEQ;
    bf16_t* qrow = P + (rowbase + t0 + qi) * LDP;
    const float sl2 = exp2f(-0.5f * (float)(head + 1)) * LOG2E;
    bf16x8 qr[4];
#pragma unroll
    for (int d0 = 0; d0 < 4; ++d0) qr[d0] = *(const bf16x8*)(qrow + C_NQ + head * 64 + d0 * 16 + hi * 8);
    const float gate_c = sigmoidf_(bf2f(qrow[C_SG + head * 3 + 0])), gate_s = sigmoidf_(bf2f(qrow[C_SG + head * 3 + 1])), gate_w = sigmoidf_(bf2f(qrow[C_SG + head * 3 + 2]));
    f32x16 tot[2]; tot[0] = f32x16{}; tot[1] = f32x16{};
#define CRF(i) ((float)(((i) & 3) + 8 * ((i) >> 2)) + 4.f * (float)hiv)
#define OPAQUE_HI() int hiv = hi; asm volatile("" : "+v"(hiv))

    {
        const bf16_t* kcb = KC + ((size_t)(b * NS_G + g) * 128) * 64; const bf16_t* vcb = VC + ((size_t)(b * NS_G + g) * 128) * 64;
        const bool two = (qt >= 16);
        unsigned kof, vof; tile_offs(kof, vof, 64, wid, lane);
        dma_tile(slot0, kcb, vcb, kof, vof, wid);
        if (two) dma_tile(slot1, kcb + 64 * 64, vcb + 64 * 64, kof, vof, wid);
        __syncthreads();
        f32x16 pA0, pA1, pB0, pB1, c0, c1;
        const float s16 = sl2 * 16.f; OPAQUE_HI();
#pragma unroll
        for (int i = 0; i < 16; ++i) { c0[i] = s16 * CRF(i); c1[i] = s16 * (CRF(i) + 32.f); }
        qkt(pA0, pA1, slot0, qr, c0, c1, r32, hi);
        const int cmax = (t0 + qi - 31) >> 4;
        const int qposm = t0 + qi - 31;
#pragma unroll
        for (int i = 0; i < 16; ++i) { const int c = crow(i, hiv); if (16 * c > qposm) pA0[i] = NEG; if (16 * (c + 32) > qposm) pA1[i] = NEG; }
        if (two) {
#pragma unroll
            for (int i = 0; i < 16; ++i) { c0[i] += s16 * 64.f; c1[i] += s16 * 64.f; }
            qkt(pB0, pB1, slot1, qr, c0, c1, r32, hi);
#pragma unroll
            for (int i = 0; i < 16; ++i) { const int c = 64 + crow(i, hiv); if (16 * c > qposm) pB0[i] = NEG; if (16 * (c + 32) > qposm) pB1[i] = NEG; }
        } else { pB0 = f32x16{}; pB1 = f32x16{};
#pragma unroll
            for (int i = 0; i < 16; ++i) { pB0[i] = NEG; pB1[i] = NEG; } }
        (void)cmax;
        float mx = NEG;
#pragma unroll
        for (int i = 0; i < 16; ++i) mx = fmaxf(fmaxf(mx, fmaxf(pA0[i], pA1[i])), fmaxf(pB0[i], pB1[i]));
        mx = xhalf_max(mx);
        float s = 0.f;
#pragma unroll
        for (int i = 0; i < 16; ++i) { pA0[i] = __builtin_amdgcn_exp2f(pA0[i] - mx); pA1[i] = __builtin_amdgcn_exp2f(pA1[i] - mx); pB0[i] = __builtin_amdgcn_exp2f(pB0[i] - mx); pB1[i] = __builtin_amdgcn_exp2f(pB1[i] - mx);
            s += (pA0[i] + pA1[i]) + (pB0[i] + pB1[i]); }
        s = xhalf_sum(s);
        const float nrm = (t0 + qi >= 31) ? __builtin_amdgcn_rcpf(s) : 0.f;
#pragma unroll
        for (int i = 0; i < 16; ++i) { pA0[i] *= nrm; pA1[i] *= nrm; pB0[i] *= nrm; pB1[i] *= nrm; }
#define PSEL(L) ((L) < 4 ? pA0 : (L) < 8 ? pA1 : (L) < 12 ? pB0 : pB1)
#define MAINV(L) ((PSEL(L)[4 * ((L) & 3)] + PSEL(L)[4 * ((L) & 3) + 1]) + (PSEL(L)[4 * ((L) & 3) + 2] + 0.5f * PSEL(L)[4 * ((L) & 3) + 3]))
#define CARRY(L) (0.5f * PSEL(L)[4 * ((L) & 3) + 3])
#pragma unroll
        for (int L = 0; L < 16; ++L) {
            const float cprev = (L > 0) ? CARRY(L > 0 ? L - 1 : 0) : 0.f;
            const float snd = hi ? cprev : CARRY(L);
            const float rcv = __shfl_xor(snd, 32);
            imp[((wid >> 1) * 64 + qi) * 32 + 2 * L + hi] = MAINV(L) + rcv;
        }
#undef PSEL
#undef MAINV
#undef CARRY
        f32x16 o[2]; o[0] = f32x16{}; o[1] = f32x16{};
        pv(o, slot0 + 8192, pA0, pA1, lane, hi);
        if (two) pv(o, slot1 + 8192, pB0, pB1, lane, hi);
        acc_rows(tot, o, wsf, gate_c, r32, hi);
    }
    __syncthreads();
    if (wid == 0) {
        float v[32];
#pragma unroll
        for (int j = 0; j < 32; ++j) v[j] = (imp[(0 * 64 + lane) * 32 + j] + imp[(1 * 64 + lane) * 32 + j]) + (imp[(2 * 64 + lane) * 32 + j] + imp[(3 * 64 + lane) * 32 + j]);
        unsigned mask = 1u | (1u << blk_t);
#pragma unroll 1
        for (int it = 0; it < 6; ++it) {
            float best = -1.f; int bj = -1;
#pragma unroll
            for (int j = 1; j < 32; ++j) { const bool ok = (j < blk_t) && !((mask >> j) & 1u); if (ok && v[j] > best) { best = v[j]; bj = j; } }
            if (bj >= 0) mask |= 1u << bj;
        }
        selm[lane] = mask;
        unsigned any = mask;
#pragma unroll
        for (int o_ = 1; o_ < 64; o_ <<= 1) any |= __shfl_xor(any, o_);
        if (lane == 0) selm[64] = any;
    }
    __syncthreads();
    const unsigned mymask = selm[qi];
    const unsigned anym = (unsigned)__builtin_amdgcn_readfirstlane((int)selm[64]);
    unsigned kofP, vofP; tile_offs(kofP, vofP, LDP, wid, lane);
    {
        const bf16_t* kb = P + rowbase * LDP + C_KS + g * 64; const bf16_t* vb = P + rowbase * LDP + C_VS + g * 64;
        unsigned todo = anym;
        float m = NEG, l = 0.f; f32x16 o[2]; o[0] = f32x16{}; o[1] = f32x16{};
        int j = __builtin_ctz(todo); todo &= todo - 1;
        dma_tile(slot0, kb + (size_t)j * 64 * LDP, vb + (size_t)j * 64 * LDP, kofP, vofP, wid);
        int cur = 0;
        __syncthreads();
        for (;;) {
            const int jn = todo ? __builtin_ctz(todo) : -1; if (todo) todo &= todo - 1;
            NLAS unsigned char* sc = cur ? slot1 : slot0; NLAS unsigned char* sn = cur ? slot0 : slot1;
            if (jn >= 0) dma_tile(sn, kb + (size_t)jn * 64 * LDP, vb + (size_t)jn * 64 * LDP, kofP, vofP, wid);
            const bool mine = (mymask >> j) & 1u;
            if (__any(mine)) {
                f32x16 p0, p1, c0, c1; const float kb0 = sl2 * (float)(j * 64 - t0); OPAQUE_HI();
#pragma unroll
                for (int i = 0; i < 16; ++i) { c0[i] = kb0 + sl2 * CRF(i); c1[i] = c0[i] + sl2 * 32.f; }
                qkt(p0, p1, sc, qr, c0, c1, r32, hi);
                if (j == blk_t) {
#pragma unroll
                    for (int i = 0; i < 16; ++i) { const int kk = crow(i, hiv); if (kk > qi) p0[i] = NEG; if (kk + 32 > qi) p1[i] = NEG; }
                }
                if (!mine) {
#pragma unroll
                    for (int i = 0; i < 16; ++i) { p0[i] = NEG; p1[i] = NEG; }
                }
                softmax_step(p0, p1, m, l, o, wsf, r32, hi);
                pv(o, sc + 8192, p0, p1, lane, hi);
            }
            __syncthreads();
            if (jn < 0) break;
            j = jn; cur ^= 1;
        }
        l = xhalf_sum(l);
        acc_rows(tot, o, wsf, gate_s * __builtin_amdgcn_rcpf(l), r32, hi);
    }
    {
        const bf16_t* kb = P + rowbase * LDP + C_KW + g * 64; const bf16_t* vb = P + rowbase * LDP + C_VW + g * 64;
        float m = NEG, l = 0.f; f32x16 o[2]; o[0] = f32x16{}; o[1] = f32x16{};
        int j = blk_t; const int jlast = blk_t >= 4 ? blk_t - 4 : 0;
        dma_tile(slot0, kb + (size_t)j * 64 * LDP, vb + (size_t)j * 64 * LDP, kofP, vofP, wid);
        int cur = 0;
        __syncthreads();
        for (;;) {
            const int jn = (j > jlast) ? j - 1 : -1;
            NLAS unsigned char* sc = cur ? slot1 : slot0; NLAS unsigned char* sn = cur ? slot0 : slot1;
            if (jn >= 0) dma_tile(sn, kb + (size_t)jn * 64 * LDP, vb + (size_t)jn * 64 * LDP, kofP, vofP, wid);
            {
                f32x16 p0, p1, c0, c1; const float kb0 = sl2 * (float)(j * 64 - t0); OPAQUE_HI();
#pragma unroll
                for (int i = 0; i < 16; ++i) { c0[i] = kb0 + sl2 * CRF(i); c1[i] = c0[i] + sl2 * 32.f; }
                qkt(p0, p1, sc, qr, c0, c1, r32, hi);
                if (j == blk_t || j == blk_t - 4) {
                    const int dq = t0 + qi - j * 64;
#pragma unroll
                    for (int i = 0; i < 16; ++i) { const int d0_ = dq - crow(i, hiv), d1_ = d0_ - 32; if (d0_ < 0 || d0_ > 255) p0[i] = NEG; if (d1_ < 0 || d1_ > 255) p1[i] = NEG; }
                }
                softmax_step(p0, p1, m, l, o, wsf, r32, hi);
                pv(o, sc + 8192, p0, p1, lane, hi);
            }
            __syncthreads();
            if (jn < 0) break;
            j = jn; cur ^= 1;
        }
        l = xhalf_sum(l);
        acc_rows(tot, o, wsf, gate_w * __builtin_amdgcn_rcpf(l), r32, hi);
    }
    {
        NLAS bf16_t* stg = (NLAS bf16_t*)(lds + L_OST) + wid * 2048;
#pragma unroll
        for (int i = 0; i < 16; ++i) { const int orow = crow(i, hi); stg[orow * 64 + r32] = f2bf(tot[0][i]); stg[orow * 64 + 32 + r32] = f2bf(tot[1][i]); }
        bf16_t* ow = P + (rowbase + t0 + qh * 32) * LDP + C_NQ + head * 64;
#pragma unroll
        for (int i = 0; i < 4; ++i) { const int row = i * 8 + (lane >> 3), ch = lane & 7; const u32x4 v = *(NLAS const u32x4*)(stg + row * 64 + ch * 8); *(u32x4*)((char*)ow + (unsigned)(row * LDP + ch * 8) * 2u) = v; }
    }
    __syncthreads();
#undef CRF
#undef OPAQUE_HI
}

__device__ __forceinline__ void norm8(u32x4& v, const float* g8, float sc) {
    float x[8] = {__uint_as_float(v.x << 16), __uint_as_float(v.x & 0xffff0000u), __uint_as_float(v.y << 16), __uint_as_float(v.y & 0xffff0000u),
                  __uint_as_float(v.z << 16), __uint_as_float(v.z & 0xffff0000u), __uint_as_float(v.w << 16), __uint_as_float(v.w & 0xffff0000u)};
    float s = 0.f;
#pragma unroll
    for (int e = 0; e < 8; ++e) s += x[e] * x[e];
    s += __shfl_xor(s, 1); s += __shfl_xor(s, 2); s += __shfl_xor(s, 4);
    const float r = rsqrtf(s * (1.f / 64.f) + EPS) * sc;
    v.x = pk(x[0] * r * g8[0], x[1] * r * g8[1]); v.y = pk(x[2] * r * g8[2], x[3] * r * g8[3]); v.z = pk(x[4] * r * g8[4], x[5] * r * g8[5]); v.w = pk(x[6] * r * g8[6], x[7] * r * g8[7]);
}
__device__ __forceinline__ void prep_units(bf16_t* P, const float* qn, const float* kns, const float* knw, int gw, int NGW, int lane) {
    float gq[8], gk[8];
    const float* kg = (lane < 32) ? kns : knw;
#pragma unroll
    for (int e = 0; e < 8; ++e) { gq[e] = qn[8 * (lane & 7) + e]; gk[e] = kg[8 * (lane & 7) + e]; }
    const int coff = (lane < 32) ? C_KS + 8 * lane : C_KW + 8 * (lane - 32);
    for (int m0 = gw; m0 < M; m0 += 2 * NGW) {
        const int m1 = m0 + NGW; const bool two = m1 < M;
        bf16_t* r0 = P + (size_t)m0 * LDP; bf16_t* r1 = P + (size_t)(two ? m1 : m0) * LDP;
        u32x4 a0 = *(const u32x4*)(r0 + C_NQ + 8 * lane), b0 = *(const u32x4*)(r0 + C_NQ + 512 + 8 * lane), c0 = *(const u32x4*)(r0 + coff);
        u32x4 a1 = *(const u32x4*)(r1 + C_NQ + 8 * lane), b1 = *(const u32x4*)(r1 + C_NQ + 512 + 8 * lane), c1 = *(const u32x4*)(r1 + coff);
        norm8(a0, gq, 0.125f * LOG2E); norm8(b0, gq, 0.125f * LOG2E); norm8(c0, gk, 1.f);
        norm8(a1, gq, 0.125f * LOG2E); norm8(b1, gq, 0.125f * LOG2E); norm8(c1, gk, 1.f);
        *(u32x4*)(r0 + C_NQ + 8 * lane) = a0; *(u32x4*)(r0 + C_NQ + 512 + 8 * lane) = b0; *(u32x4*)(r0 + coff) = c0;
        if (two) { *(u32x4*)(r1 + C_NQ + 8 * lane) = a1; *(u32x4*)(r1 + C_NQ + 512 + 8 * lane) = b1; *(u32x4*)(r1 + coff) = c1; }
    }
}

constexpr int LC_HID = 0;
__device__ __forceinline__ void compress_item(NLAS unsigned char* lds, const bf16_t* P, const bf16_t* W1T, const float* bias1, const float* W2, const float* gain, bf16_t* OUT, int b, int g, int which, int half) {
    const int tid = threadIdx.x, lane = tid & 63, r32 = lane & 31, hi = lane >> 5; const int wid = __builtin_amdgcn_readfirstlane(tid >> 6);
    const int mt = wid >> 2, nt = wid & 3;
    const int c = 64 * half + 32 * mt + r32;
    const int cc = c < NCMP ? c : NCMP - 1;
    const bf16_t* arow = P + ((size_t)b * SEQ + 16 * cc) * LDP + (which ? C_VC : C_KC) + g * 64 + hi * 8;
    const bf16_t* brow = W1T + (size_t)(32 * nt + r32) * 2048 + hi * 8;
    f32x16 acc = f32x16{};
#pragma unroll 4
    for (int l = 0; l < 32; ++l) {
#pragma unroll
        for (int ds = 0; ds < 4; ++ds) {
            const bf16x8 a = *(const bf16x8*)(arow + (size_t)l * LDP + ds * 16);
            const bf16x8 w = *(const bf16x8*)(brow + l * 64 + ds * 16);
            acc = __builtin_amdgcn_mfma_f32_32x32x16_bf16(a, w, acc, 0, 0, 0);
        }
    }
    NLAS float* hid = (NLAS float*)(lds + LC_HID);
    const float bs = bias1[32 * nt + r32];
#pragma unroll
    for (int i = 0; i < 16; ++i) hid[(32 * mt + crow(i, hi)) * 132 + 32 * nt + r32] = gelu_tanh(acc[i] + bs);
    __syncthreads();
    {
        const int row = tid >> 3, e0 = (tid & 7) * 8;
        float o[8];
#pragma unroll
        for (int e = 0; e < 8; ++e) o[e] = 0.f;
        for (int i = 0; i < 128; ++i) { const float h = hid[row * 132 + i]; const f32x4 wa = *(const f32x4*)(W2 + i * 64 + e0), wb = *(const f32x4*)(W2 + i * 64 + e0 + 4);
            o[0] += h * wa[0]; o[1] += h * wa[1]; o[2] += h * wa[2]; o[3] += h * wa[3]; o[4] += h * wb[0]; o[5] += h * wb[1]; o[6] += h * wb[2]; o[7] += h * wb[3]; }
        if (which == 0) {
            float ss = 0.f;
#pragma unroll
            for (int e = 0; e < 8; ++e) ss += o[e] * o[e];
            ss += __shfl_xor(ss, 1); ss += __shfl_xor(ss, 2); ss += __shfl_xor(ss, 4);
            const float r = rsqrtf(ss * (1.f / 64.f) + EPS);
#pragma unroll
            for (int e = 0; e < 8; ++e) o[e] *= r * gain[e0 + e];
        }
        const int cg = 64 * half + row;
        if (cg >= NCMP) {
#pragma unroll
            for (int e = 0; e < 8; ++e) o[e] = 0.f; }
        u32x4 w; w.x = pk(o[0], o[1]); w.y = pk(o[2], o[3]); w.z = pk(o[4], o[5]); w.w = pk(o[6], o[7]);
        *(u32x4*)(OUT + (((size_t)(b * NS_G + g) * 128) + cg) * 64 + e0) = w;
    }
    __syncthreads();
}
}
namespace pg8 {
#define PG8_LAS __attribute__((address_space(3)))
typedef short bf16x8 __attribute__((ext_vector_type(8)));
typedef float f32x4 __attribute__((ext_vector_type(4)));
typedef float f32x2 __attribute__((ext_vector_type(2)));
typedef unsigned u32x4 __attribute__((ext_vector_type(4)));
typedef unsigned u32x2 __attribute__((ext_vector_type(2)));
constexpr int BM = 256, BK = 64, HALF = 128, HTB = HALF * BK * 2, STAGE_BYTES = 8 * HTB, NXCD = 8, WGM = 8;

__host__ __device__ __forceinline__ int lds_byte(int r, int c) { const int st = (r >> 4) * 2 + (c >> 5), rr = r & 15, cc = c & 31, ob = rr * 64 + cc * 2; return st * 1024 + (ob ^ (((ob >> 9) & 1) << 5)); }
__host__ __device__ __forceinline__ void stage_rc(int b, int& R, int& C) { const int st = b / 1024, sb = b % 1024, swz = sb ^ (((sb >> 9) & 1) << 5); R = (st >> 1) * 16 + swz / 64; C = (st & 1) * 32 + (swz % 64) / 2; }
__host__ __device__ __forceinline__ int perm32(int rho) { const int n = rho >> 4, i = rho & 15; return 8 * (i >> 2) + 4 * n + (i & 3); }

struct Unit { int pm, pn, ks; };
struct Gemm { const bf16_t* A; const bf16_t* Bt; int lda, ldb; int M, N, K; int ksoff; };

struct StaticOrder {
    int nM, nN, nwg, G, c;
    __host__ __device__ void init(int M_, int N_, int G_, int c_) { nM = M_ / BM; nN = N_ / BM; nwg = nM * nN; G = G_; c = c_; }
    __host__ __device__ bool next(int i, Unit& u) const {
        const long L = (long)i * G + c; if (L >= nwg) return false;
        int wgid = (int)L; { const int q = nwg / NXCD, r = nwg % NXCD, xcd = wgid % NXCD, off = wgid / NXCD; wgid = (xcd < r ? xcd * (q + 1) : r * (q + 1) + (xcd - r) * q) + off; }
        const int nig = WGM * nN, gid = wgid / nig, fm = gid * WGM, gsz = (nM - fm) < WGM ? (nM - fm) : WGM;
        u.pm = fm + ((wgid % nig) % gsz); u.pn = (wgid % nig) / gsz; u.ks = 0; return true;
    }
};
struct TwoPassOrder {
    StaticOrder base;
    __host__ __device__ bool next(int i, Unit& u) const { if (!base.next(i >> 1, u)) return false; u.ks = i & 1; return true; }
};

typedef __bf16 bf16x2_t __attribute__((ext_vector_type(2)));
__device__ __forceinline__ unsigned cvt_pk_bf16(float lo, float hi) { f32x2 v = {lo, hi}; bf16x2_t b = __builtin_convertvector(v, bf16x2_t); return __builtin_bit_cast(unsigned, b); }
__device__ __forceinline__ float fast_sigmoid(float x) { return __builtin_amdgcn_rcpf(1.f + __builtin_amdgcn_exp2f(-1.4426950408889634f * x)); }
__device__ __forceinline__ float bflo(unsigned w) { return __uint_as_float(w << 16); }
__device__ __forceinline__ float bfhi(unsigned w) { return __uint_as_float(w & 0xffff0000u); }

typedef f32x4 Acc[2][2][4][2];

template <int ACT> struct EpiP {
    static constexpr bool PERM = true;
    bf16_t* O; int ldc; int pn_last; int ncol_last; bf16_t* halo;
    __device__ __forceinline__ void operator()(const Acc& acc, const Unit& u, int wr, int wc, int fr, int fq) const {
        const int row0 = u.pm * BM + wr * 64 + fr, tcol = wc * 32 + 8 * fq;
        const int lim = (u.pn == pn_last) ? ncol_last : 256;
#pragma unroll
        for (int ai = 0; ai < 2; ++ai)
#pragma unroll
            for (int m = 0; m < 4; ++m) { bf16_t* rowp = O + (size_t)(row0 + ai * HALF + m * 16) * ldc + u.pn * BM + tcol;
#pragma unroll
                for (int bj = 0; bj < 2; ++bj) { if (tcol + bj * HALF >= lim) continue;
                    f32x4 v0 = acc[ai][bj][m][0], v1 = acc[ai][bj][m][1];
                    if (ACT == 1) {
#pragma unroll
                        for (int e = 0; e < 4; ++e) { v0[e] = fast_sigmoid(v0[e]); v1[e] = fast_sigmoid(v1[e]); } }
                    u32x4 w; w.x = cvt_pk_bf16(v0[0], v0[1]); w.y = cvt_pk_bf16(v0[2], v0[3]); w.z = cvt_pk_bf16(v1[0], v1[1]); w.w = cvt_pk_bf16(v1[2], v1[3]);
                    *(u32x4*)(rowp + bj * HALF) = w;
                    if (ACT == 0 && m == 3 && fr >= 13 && u.pn < 12 && halo) { const int row = row0 + ai * HALF + 48;
                        *(u32x4*)(halo + ((size_t)(row >> 6) * 3 + (fr - 13)) * 3072 + u.pn * BM + tcol + bj * HALF) = w; } } }
    }
};
struct EpiMix {
    static constexpr bool PERM = true;
    const bf16_t* G; int ldg; bf16_t* O; int ldc;
    __device__ __forceinline__ void operator()(const Acc& acc, const Unit& u, int wr, int wc, int fr, int fq) const {
        const int row0 = u.pm * BM + wr * 64 + fr, col0 = u.pn * BM + wc * 32 + 8 * fq;
#pragma unroll
        for (int ai = 0; ai < 2; ++ai)
#pragma unroll
            for (int m = 0; m < 4; ++m) { const size_t row = (size_t)(row0 + ai * HALF + m * 16); const bf16_t* gp = G + row * ldg + col0 + u.ks * 1024; bf16_t* rowp = O + row * ldc + col0;
#pragma unroll
                for (int bj = 0; bj < 2; ++bj) { const u32x4 b = *(const u32x4*)(gp + bj * HALF);
                    f32x4 v0 = acc[ai][bj][m][0], v1 = acc[ai][bj][m][1];
                    v0[0] *= bflo(b.x); v0[1] *= bfhi(b.x); v0[2] *= bflo(b.y); v0[3] *= bfhi(b.y); v1[0] *= bflo(b.z); v1[1] *= bfhi(b.z); v1[2] *= bflo(b.w); v1[3] *= bfhi(b.w);
                    if (u.ks) { const u32x4 p = *(const u32x4*)(rowp + bj * HALF);
                        v0[0] += bflo(p.x); v0[1] += bfhi(p.x); v0[2] += bflo(p.y); v0[3] += bfhi(p.y); v1[0] += bflo(p.z); v1[1] += bfhi(p.z); v1[2] += bflo(p.w); v1[3] += bfhi(p.w); }
                    u32x4 w; w.x = cvt_pk_bf16(v0[0], v0[1]); w.y = cvt_pk_bf16(v0[2], v0[3]); w.z = cvt_pk_bf16(v1[0], v1[1]); w.w = cvt_pk_bf16(v1[2], v1[3]);
                    *(u32x4*)(rowp + bj * HALF) = w; } }
    }
};
struct EpiOut {
    static constexpr bool PERM = false;
    const float* X; float* X1; bf16_t* An; const float* gain; float* pss;
    __device__ __forceinline__ void operator()(const Acc& acc, const Unit& u, int wr, int wc, int fr, int fq) const {
        const int row0 = u.pm * BM + wr * 64 + fr, col0 = u.pn * BM + wc * 32 + 4 * fq;
        f32x4 gv[2][2];
#pragma unroll
        for (int bj = 0; bj < 2; ++bj)
#pragma unroll
            for (int n = 0; n < 2; ++n) gv[bj][n] = *(const f32x4*)(gain + col0 + bj * HALF + n * 16);
#pragma unroll
        for (int ai = 0; ai < 2; ++ai)
#pragma unroll
            for (int m = 0; m < 4; ++m) { const size_t row = (size_t)(row0 + ai * HALF + m * 16); const size_t off = row * D + col0; float ss = 0.f;
#pragma unroll
                for (int bj = 0; bj < 2; ++bj)
#pragma unroll
                    for (int n = 0; n < 2; ++n) { const f32x4 x1 = *(const f32x4*)(X + off + bj * HALF + n * 16) + acc[ai][bj][m][n];
                        *(f32x4*)(X1 + off + bj * HALF + n * 16) = x1; ss += (x1[0] * x1[0] + x1[1] * x1[1]) + (x1[2] * x1[2] + x1[3] * x1[3]);
                        const f32x4 y = x1 * gv[bj][n]; u32x2 w; w.x = cvt_pk_bf16(y[0], y[1]); w.y = cvt_pk_bf16(y[2], y[3]); *(u32x2*)(An + off + bj * HALF + n * 16) = w; }
                ss += __shfl_xor(ss, 16); ss += __shfl_xor(ss, 32);
                if (fq == 0) pss[row * 16 + u.pn * 4 + wc] = ss; }
    }
};
struct EpiUp {
    static constexpr bool PERM = true;
    const float* pss; bf16_t* O; int ldc;
    __device__ __forceinline__ void operator()(const Acc& acc, const Unit& u, int wr, int wc, int fr, int fq) const {
        const int row0 = u.pm * BM + wr * 64 + fr, col0 = u.pn * BM + wc * 32 + 8 * fq;
#pragma unroll
        for (int ai = 0; ai < 2; ++ai)
#pragma unroll
            for (int m = 0; m < 4; ++m) { const size_t row = (size_t)(row0 + ai * HALF + m * 16);
                const f32x4* pp = (const f32x4*)(pss + row * 16); const f32x4 s4 = (pp[0] + pp[1]) + (pp[2] + pp[3]);
                const float rstd = rsqrtf(((s4[0] + s4[1]) + (s4[2] + s4[3])) * (1.f / D) + EPS);
                bf16_t* rowp = O + row * ldc + col0;
#pragma unroll
                for (int bj = 0; bj < 2; ++bj) { f32x4 v0 = acc[ai][bj][m][0] * rstd, v1 = acc[ai][bj][m][1] * rstd;
#pragma unroll
                    for (int e = 0; e < 4; ++e) { const float a = fmaxf(v0[e], 0.f), b = fmaxf(v1[e], 0.f); v0[e] = a * a; v1[e] = b * b; }
                    u32x4 w; w.x = cvt_pk_bf16(v0[0], v0[1]); w.y = cvt_pk_bf16(v0[2], v0[3]); w.z = cvt_pk_bf16(v1[0], v1[1]); w.w = cvt_pk_bf16(v1[2], v1[3]);
                    *(u32x4*)(rowp + bj * HALF) = w; } }
    }
};
struct EpiDown {
    static constexpr bool PERM = false;
    float* X1;
    __device__ __forceinline__ void operator()(const Acc& acc, const Unit& u, int wr, int wc, int fr, int fq) const {
        const int row0 = u.pm * BM + wr * 64 + fr, col0 = u.pn * BM + wc * 32 + 4 * fq;
#pragma unroll
        for (int ai = 0; ai < 2; ++ai)
#pragma unroll
            for (int m = 0; m < 4; ++m) { float* rowp = X1 + (size_t)(row0 + ai * HALF + m * 16) * D + col0;
#pragma unroll
                for (int bj = 0; bj < 2; ++bj)
#pragma unroll
                    for (int n = 0; n < 2; ++n) { f32x4* p = (f32x4*)(rowp + bj * HALF + n * 16); *p = *p + acc[ai][bj][m][n]; } }
    }
};

template <class Epi, class Sched, bool ALIGN_EPI>
__device__ __forceinline__ void gemm_phase(PG8_LAS unsigned char* lds, const Gemm g, const Sched& S, const Epi& E) {
    const int tid = threadIdx.x, wid = __builtin_amdgcn_readfirstlane(tid >> 6), lane = tid & 63, wr = wid >> 2, wc = wid & 3, fr = lane & 15, fq = lane >> 4;
    const int K = g.K, nt = K / BK, lda = g.lda, ldb = g.ldb;
    unsigned voffA[2], voffB[2];
#pragma unroll
    for (int i = 0; i < 2; ++i) { int R, C; stage_rc(tid * 16 + i * 8192, R, C); const int Rb = Epi::PERM ? ((R & ~31) + perm32(R & 31)) : R;
        voffA[i] = (unsigned)(R * lda + C) * 2u; voffB[i] = (unsigned)(Rb * ldb + C) * 2u; }
    const size_t kstep = (size_t)(BK * 2);
    const size_t hstepA = (size_t)HALF * lda * 2, hstepB = (size_t)HALF * ldb * 2;
    const size_t tstepA = 2 * hstepA, tstepB = 2 * hstepB;
    const unsigned ldsw = (unsigned)wid * 1024u;
    const int aoff = lds_byte(wr * 64 + fr, fq * 8), boff = lds_byte(wc * 32 + fr, fq * 8);
#define PG8_SA(b, h) (((b) * 2 + (h)) * HTB)
#define PG8_SB(b, h) ((4 + (b) * 2 + (h)) * HTB)
#define PG8_STAGE(bufoff, gbase, voff) do { _Pragma("unroll") for (int _i = 0; _i < 2; ++_i) \
        __builtin_amdgcn_global_load_lds((const unsigned*)((const char*)(gbase) + (voff)[_i]), (PG8_LAS unsigned*)(lds + (bufoff) + ldsw + _i * 8192), 16, 0, 0); } while (0)
#define PG8_LDA(dst, b, h) do { _Pragma("unroll") for (int m = 0; m < 4; ++m) _Pragma("unroll") for (int k = 0; k < 2; ++k) dst[m][k] = *(const PG8_LAS bf16x8*)(lds + PG8_SA(b, h) + aoff + m * 2048 + k * 1024); } while (0)
#define PG8_LDB(dst, b, h) do { _Pragma("unroll") for (int n = 0; n < 2; ++n) _Pragma("unroll") for (int k = 0; k < 2; ++k) dst[n][k] = *(const PG8_LAS bf16x8*)(lds + PG8_SB(b, h) + boff + n * 2048 + k * 1024); } while (0)
#define PG8_MMA(ai, bj, At, Bt) do { __builtin_amdgcn_s_setprio(1); _Pragma("unroll") for (int m = 0; m < 4; ++m) _Pragma("unroll") for (int n = 0; n < 2; ++n) _Pragma("unroll") for (int k = 0; k < 2; ++k) \
        acc[ai][bj][m][n] = __builtin_amdgcn_mfma_f32_16x16x32_bf16(Bt[n][k], At[m][k], acc[ai][bj][m][n], 0, 0, 0); __builtin_amdgcn_s_setprio(0); } while (0)
#define PG8_WAIT_V(n) asm volatile("s_waitcnt vmcnt(" #n ")" ::: "memory")
#define PG8_WAIT_L(n) asm volatile("s_waitcnt lgkmcnt(" #n ")" ::: "memory")
#define PG8_BAR __builtin_amdgcn_s_barrier()
#define PG8_SCHED __builtin_amdgcn_sched_barrier(0)
#define PG8_KBODY(t) do { \
            const bool last = (t == nt - 2); \
            const char* a1 = cA + (size_t)(t + 1) * kstep; \
            const char* a2 = last ? nA : cA + (size_t)(t + 2) * kstep; const char* b2 = last ? nB : cB + (size_t)(t + 2) * kstep; \
            const char* a3 = a2 + kstep; const char* b3 = b2 + kstep; \
            PG8_LDB(B0, 0, 0); PG8_LDB(B1, 0, 1); PG8_SCHED; PG8_LDA(At, 0, 0); PG8_STAGE(PG8_SA(1, 1), a1 + hstepA, voffA); \
            PG8_WAIT_V(8); PG8_WAIT_L(0); PG8_BAR; PG8_MMA(0, 0, At, B0); PG8_MMA(0, 1, At, B1); PG8_BAR; PG8_SCHED; \
            PG8_LDA(At, 0, 1); PG8_STAGE(PG8_SB(0, 0), b2, voffB); PG8_STAGE(PG8_SB(0, 1), b2 + hstepB, voffB); PG8_STAGE(PG8_SA(0, 0), a2, voffA); \
            PG8_WAIT_V(8); PG8_WAIT_L(0); PG8_BAR; PG8_MMA(1, 0, At, B0); PG8_MMA(1, 1, At, B1); PG8_BAR; PG8_SCHED; \
            PG8_LDB(B0, 1, 0); PG8_LDB(B1, 1, 1); PG8_SCHED; PG8_LDA(At, 1, 0); PG8_STAGE(PG8_SA(0, 1), a2 + hstepA, voffA); \
            PG8_WAIT_V(8); PG8_WAIT_L(0); PG8_BAR; PG8_MMA(0, 0, At, B0); PG8_MMA(0, 1, At, B1); PG8_BAR; PG8_SCHED; \
            PG8_LDA(At, 1, 1); PG8_STAGE(PG8_SB(1, 0), b3, voffB); PG8_STAGE(PG8_SB(1, 1), b3 + hstepB, voffB); PG8_STAGE(PG8_SA(1, 0), a3, voffA); \
            PG8_WAIT_V(8); PG8_WAIT_L(0); PG8_BAR; PG8_MMA(1, 0, At, B0); PG8_MMA(1, 1, At, B1); PG8_BAR; PG8_SCHED; \
        } while (0)
    Unit cur, nxt; int ui = 0;
    if (!S.next(0, cur)) return;
    Acc acc;
#pragma unroll
    for (int a = 0; a < 2; ++a)
#pragma unroll
        for (int b = 0; b < 2; ++b)
#pragma unroll
            for (int m = 0; m < 4; ++m)
#pragma unroll
                for (int n = 0; n < 2; ++n) acc[a][b][m][n] = (f32x4){0.f, 0.f, 0.f, 0.f};
    bf16x8 At[4][2], B0[2][2], B1[2][2];
    const char* cA = (const char*)g.A + (size_t)cur.pm * tstepA + (size_t)cur.ks * g.ksoff * 2; const char* cB = (const char*)g.Bt + (size_t)cur.pn * tstepB + (size_t)cur.ks * g.ksoff * 2;
    PG8_STAGE(PG8_SB(0, 0), cB, voffB); PG8_STAGE(PG8_SB(0, 1), cB + hstepB, voffB); PG8_STAGE(PG8_SA(0, 0), cA, voffA); PG8_STAGE(PG8_SA(0, 1), cA + hstepA, voffA);
    if (wr == 1) PG8_BAR;
    PG8_WAIT_V(2); PG8_BAR;
    PG8_STAGE(PG8_SB(1, 0), cB + kstep, voffB); PG8_STAGE(PG8_SA(1, 0), cA + kstep, voffA); PG8_STAGE(PG8_SB(1, 1), cB + hstepB + kstep, voffB);
    PG8_WAIT_V(6); PG8_BAR;
    for (;;) {
        const bool has_next = S.next(ui + 1, nxt);
        const char* nA = has_next ? (const char*)g.A + (size_t)nxt.pm * tstepA + (size_t)nxt.ks * g.ksoff * 2 : cA; const char* nB = has_next ? (const char*)g.Bt + (size_t)nxt.pn * tstepB + (size_t)nxt.ks * g.ksoff * 2 : cB;
        for (int t = 0; t < nt; t += 2) PG8_KBODY(t);
        if constexpr (ALIGN_EPI) { if (wr == 0) PG8_BAR; }
        E(acc, cur, wr, wc, fr, fq);
        if (!has_next) break;
#pragma unroll
        for (int a = 0; a < 2; ++a)
#pragma unroll
            for (int b = 0; b < 2; ++b)
#pragma unroll
                for (int m = 0; m < 4; ++m)
#pragma unroll
                    for (int n = 0; n < 2; ++n) acc[a][b][m][n] = (f32x4){0.f, 0.f, 0.f, 0.f};
        cur = nxt; cA = nA; cB = nB; ++ui;
        if constexpr (ALIGN_EPI) { if (wr == 1) PG8_BAR; }
    }
    PG8_WAIT_V(0);
    if constexpr (!ALIGN_EPI) { if (wr == 0) PG8_BAR; }
    PG8_BAR;
#undef PG8_SA
#undef PG8_SB
#undef PG8_STAGE
#undef PG8_LDA
#undef PG8_LDB
#undef PG8_MMA
#undef PG8_WAIT_V
#undef PG8_WAIT_L
#undef PG8_BAR
#undef PG8_SCHED
#undef PG8_KBODY
}
}

#define GAS __attribute__((address_space(1)))
#define LAS __attribute__((address_space(3)))
typedef unsigned v4u __attribute__((ext_vector_type(4)));
typedef float f32x4 __attribute__((ext_vector_type(4)));
constexpr int NWAVES = 8;
constexpr int LDS_BYTES = 147456;
constexpr size_t MiB = 1u << 20;
constexpr size_t WS_PSS = 1 * MiB, WS_WOUT = 2 * MiB, WS_P = 4 * MiB, WS_KC = 214 * MiB, WS_VC = 215 * MiB, WS_MIX = 216 * MiB;
constexpr size_t WS_AN = 4 * MiB, WS_UP = 64 * MiB, WS_WUP = 248 * MiB, WS_WDOWN = 200 * MiB;
constexpr size_t WS_BIAS1 = 0, WS_W1T = 214 * MiB, WS_KCB = 215 * MiB, WS_VCB = 215 * MiB + 512 * 1024;
constexpr size_t WS_GLV = 4096, WS_QCNT = 65536, WS_GW = 216 * MiB, DO_GQK = 40 * MiB, DO_HALO = 56 * MiB;
constexpr size_t DO_H = 0, DO_WG = 32 * MiB, DO_WCAT = 36 * MiB, DO_WIN = 40 * MiB;

__device__ __forceinline__ unsigned pk2(float lo, float hi) { return (unsigned)f2bf(lo) | ((unsigned)f2bf(hi) << 16); }
__device__ __forceinline__ float wave_sum(float v) {
#pragma unroll
    for (int o = 1; o < 64; o <<= 1) v += __shfl_xor(v, o);
    return v;
}
template <class SrcCol>
__device__ __forceinline__ void transpose_item(const float* W, int ldw, const SrcCol& srccol, bf16_t* WT, int ldk, int kofs, LAS float* scr, int kb, int nb, int lane) {
    const int k0 = 64 * kb, n0 = 64 * nb; const int n4 = (lane & 15) * 4; const int sc = srccol(n0 + n4);
#pragma unroll 4
    for (int i = 0; i < 16; ++i) { const int kk = 4 * i + (lane >> 4);
        const f32x4 v = (sc >= 0) ? *(const f32x4*)(W + (size_t)(k0 + kk) * ldw + sc) : (f32x4){0.f, 0.f, 0.f, 0.f};
        scr[kk * 65 + n4] = v[0]; scr[kk * 65 + n4 + 1] = v[1]; scr[kk * 65 + n4 + 2] = v[2]; scr[kk * 65 + n4 + 3] = v[3]; }
    asm volatile("s_waitcnt lgkmcnt(0)" ::: "memory");
    const int c = lane & 7;
#pragma unroll
    for (int j = 0; j < 8; ++j) { const int n = (lane >> 3) + 8 * j; const LAS float* sp = scr + (8 * c) * 65 + n;
        v4u o; o.x = pk2(sp[0 * 65], sp[1 * 65]); o.y = pk2(sp[2 * 65], sp[3 * 65]); o.z = pk2(sp[4 * 65], sp[5 * 65]); o.w = pk2(sp[6 * 65], sp[7 * 65]);
        *(v4u*)(WT + (size_t)(n0 + n) * ldk + kofs + k0 + 8 * c) = o; }
    asm volatile("s_waitcnt lgkmcnt(0)" ::: "memory");
}
struct SrcIdent { int off; __device__ __forceinline__ int operator()(int n) const { return n + off; } };
struct SrcWin { __device__ __forceinline__ int operator()(int n) const { return n < 4096 ? n : (n < 6656 ? n + 16 : (n < 6672 ? n - 6656 + 4096 : (n < 6720 ? n : -1))); } };

struct Args { const float* in[23]; float* out; unsigned char* ws; int ph_lo, ph_hi; };

__global__ void __launch_bounds__(NWAVES * 64, 2) mk_fwd(Args args) {
    extern __shared__ __attribute__((aligned(16))) unsigned char lds_raw[];
    LAS unsigned char* lds = (LAS unsigned char*)lds_raw;
    __builtin_assume(__builtin_amdgcn_workitem_id_y() == 0); __builtin_assume(__builtin_amdgcn_workitem_id_z() == 0);
    cg::grid_group grid = cg::this_grid();
    const int tid = threadIdx.x, lane = tid & 63, wave = __builtin_amdgcn_readfirstlane(tid >> 6);
    const int G = gridDim.x, gw = blockIdx.x * NWAVES + wave, NGW = G * NWAVES;
    unsigned char* ws = args.ws; unsigned char* dob = (unsigned char*)args.out;
    const float* x = args.in[0];
    bf16_t* P = (bf16_t*)(ws + WS_P);
    bf16_t* Hb = (bf16_t*)(dob + DO_H); bf16_t* Wg_t = (bf16_t*)(dob + DO_WG); bf16_t* Wcat_t = (bf16_t*)(dob + DO_WCAT); bf16_t* Win_t = (bf16_t*)(dob + DO_WIN);
    bf16_t* Wout_t = (bf16_t*)(ws + WS_WOUT); bf16_t* Wup_t = (bf16_t*)(ws + WS_WUP); bf16_t* Wdown_t = (bf16_t*)(ws + WS_WDOWN);
    bf16_t* Mix = (bf16_t*)(ws + WS_MIX); bf16_t* An = (bf16_t*)(ws + WS_AN); bf16_t* Up = (bf16_t*)(ws + WS_UP); float* pss = (float*)(ws + WS_PSS);
    LAS float* scr = (LAS float*)(lds + wave * 17408);
    bf16_t* Halo = (bf16_t*)(dob + DO_HALO); bf16_t* GWb = (bf16_t*)(ws + WS_GW); bf16_t* GQKb = (bf16_t*)(dob + DO_GQK); float* GLv = (float*)(ws + WS_GLV); unsigned* qcnt = (unsigned*)(ws + WS_QCNT);
    bf16_t* W1T = (bf16_t*)(ws + WS_W1T); float* bias1 = (float*)(ws + WS_BIAS1); bf16_t* KCb = (bf16_t*)(ws + WS_KCB); bf16_t* VCb = (bf16_t*)(ws + WS_VCB);
    const int lo = args.ph_lo, hi = args.ph_hi;
#ifndef PHMASK
#define PHMASK 0x1ff
#endif
#define IN(k) (((PHMASK >> (k)) & 1) && lo <= (k) && (k) < hi)
#define GRID_SYNC() do { asm volatile("s_waitcnt vmcnt(0) lgkmcnt(0)" ::: "memory"); grid.sync(); \
        if (wave == 0) { __builtin_amdgcn_fence(__ATOMIC_ACQUIRE, "agent"); asm volatile("s_waitcnt vmcnt(0)" ::: "memory"); } __syncthreads(); } while (0)
#if defined(TPROBE)
#define STAMP(k) do { if (blockIdx.x == 0 && tid == 0) ((volatile LAS unsigned long long*)(lds + 147456 - 512))[k] = __builtin_amdgcn_s_memrealtime(); } while (0)
#else
#define STAMP(k) do { } while (0)
#endif
#define SEAM(k) do { if (IN(k) && IN((k) + 1)) GRID_SYNC(); STAMP((k) + 1); } while (0)

    STAMP(0);
    if (IN(0)) {
        if (blockIdx.x == 0 && tid == 0) { *qcnt = 0u; ((volatile unsigned*)(ws + 786432))[4] = 0u; }
        constexpr int I_WIN = 16 * (NP1 / 64), I_WG = 16 * 32, I_DN = 16 * 16, I_OUT = 16 * 16, I_UP = 16 * 64;
        constexpr int I_W1 = 32 * 2, I_B1 = 256;
        constexpr int NITEMS = I_WIN + I_WG + 2 * I_DN + I_OUT + I_UP + 2 * I_W1 + I_B1;
        for (int it = gw; it < NITEMS; it += NGW) {
            int r = it;
            if (r < I_WIN) { transpose_item(args.in[2], INW, SrcWin{}, Win_t, D, 0, scr, r / (NP1 / 64), r % (NP1 / 64), lane); continue; } r -= I_WIN;
            if (r < I_WG) { transpose_item(args.in[2], INW, SrcIdent{6720}, Wg_t, D, 0, scr, r / 32, r % 32, lane); continue; } r -= I_WG;
            if (r < I_DN) { transpose_item(args.in[17], D, SrcIdent{0}, Wcat_t, 2 * D, 0, scr, r / 16, r % 16, lane); continue; } r -= I_DN;
            if (r < I_DN) { transpose_item(args.in[18], D, SrcIdent{0}, Wcat_t, 2 * D, D, scr, r / 16, r % 16, lane); continue; } r -= I_DN;
            if (r < I_OUT) { transpose_item(args.in[19], D, SrcIdent{0}, Wout_t, D, 0, scr, r / 16, r % 16, lane); continue; } r -= I_OUT;
            if (r < I_UP) { transpose_item(args.in[21], FF, SrcIdent{0}, Wup_t, D, 0, scr, r / 64, r % 64, lane); continue; } r -= I_UP;
            if (r < I_W1) { transpose_item(args.in[12], 128, SrcIdent{0}, W1T, 2048, 0, scr, r / 2, r % 2, lane); continue; } r -= I_W1;
            if (r < I_W1) { transpose_item(args.in[15], 128, SrcIdent{0}, W1T + 128 * 2048, 2048, 0, scr, r / 2, r % 2, lane); continue; } r -= I_W1;
            {
                const int which = r >> 7, i = r & 127; const float* pos = args.in[which ? 14 : 11]; const float* w1 = args.in[which ? 15 : 12];
                float a = 0.f;
                for (int k = lane; k < 2048; k += 64) a += pos[k] * w1[(size_t)k * 128 + i];
                a = wave_sum(a);
                if (lane == 0) bias1[r] = a;
            }
        }
        const float* gain = args.in[1];
        f32x4 gv[4];
#pragma unroll
        for (int j = 0; j < 4; ++j) gv[j] = ((const f32x4*)gain)[lane + 64 * j];
        for (int m = gw; m < M; m += NGW) {
            const f32x4* xr = (const f32x4*)(x + (size_t)m * D) + lane;
            f32x4 v[4]; float s = 0.f;
#pragma unroll
            for (int j = 0; j < 4; ++j) { v[j] = xr[64 * j]; s += (v[j].x * v[j].x + v[j].y * v[j].y) + (v[j].z * v[j].z + v[j].w * v[j].w); }
            const float rstd = rsqrtf(wave_sum(s) * (1.f / D) + EPS);
            unsigned long long* o8 = (unsigned long long*)(Hb + (size_t)m * D) + lane;
#pragma unroll
            for (int j = 0; j < 4; ++j) { const f32x4 y = v[j] * rstd * gv[j]; o8[64 * j] = (unsigned long long)pk2(y.x, y.y) | ((unsigned long long)pk2(y.z, y.w) << 32); }
        }
    }
    SEAM(0);
    if (IN(1)) {
        pg8::Gemm g{Hb, Win_t, D, D, M, NP1, D, 0}; pg8::StaticOrder S; S.init(M, NP1, G, (int)blockIdx.x);
        pg8::EpiP<0> E{P, LDP, 26, 64, Halo};
        pg8::gemm_phase<pg8::EpiP<0>, pg8::StaticOrder, true>(lds, g, S, E);
    }
    SEAM(1);
    if (IN(2)) {
        for (int it = (G == 256) ? (((int)blockIdx.x & 1) ? 128 : (int)blockIdx.x >> 1) : (int)blockIdx.x; it < 128; it += G) {
            const int half = it & 1, which = (it >> 1) & 1, g_ = (it >> 2) & 3, b_ = it >> 4;
            nsa::compress_item(lds, P, W1T + (size_t)which * 128 * 2048, bias1 + which * 128, args.in[which ? 16 : 13], args.in[8], which ? VCb : KCb, b_, g_, which, half);
        }
        STAMP(11);
        nsa::prep_units(P, args.in[7], args.in[9], args.in[10], gw, NGW, lane);
        STAMP(12);
#if !defined(GDN_NAIVE)
        __syncthreads();
        {
            gdn::RowPre pre; int hl = -1;
            const int c_ = (int)blockIdx.x, hq = c_ >> 5, jq = c_ & 31;
            const bool bal = (G == 256);
            const int cnt = bal ? ((jq & 1) ? 10 : 6) : (2048 - c_ + G - 1) / G;
            const int first = bal ? ((jq & 1) ? 96 + 10 * (jq >> 1) : 6 * (jq >> 1)) : 0;
#define PREP_COORD(k, b_, n_, h_) do { if (bal) { const int idx_ = first + (k); b_ = idx_ >> 5; n_ = idx_ & 31; h_ = hq; } else { const int it_ = c_ + (k) * G; b_ = it_ >> 8; n_ = it_ & 31; h_ = (it_ >> 5) & 7; } } while (0)
            int b0, n0, h0;
            if (cnt > 0) { PREP_COORD(0, b0, n0, h0); gdn::prep_prefetch(pre, P, Halo, b0, n0, h0, wave, lane); }
            for (int k = 0; k < cnt; ++k) {
                int bc, nc, hc, bn = -1, nn = 0, hn = 0;
                PREP_COORD(k, bc, nc, hc);
                if (k + 1 < cnt) PREP_COORD(k + 1, bn, nn, hn);
                if (hc != hl) { __syncthreads(); gdn::prep_load_taps(lds, args.in[3], hc); hl = hc; __syncthreads(); }
                gdn::prep_item(lds, P, Halo, args.in[4], args.in[5], GWb, GQKb, GLv, pre, bc, nc, hc, bn, nn, hn);
                if (k == 0) STAMP(14);
            }
#undef PREP_COORD
        }
        STAMP(13);
#endif
    }
    SEAM(2);
    if (IN(3)) {
#if defined(GDN_NAIVE)
        if ((int)blockIdx.x < 16) gdn_naive::run(lds, P, args.in[3], args.in[4], args.in[5], args.in[6], 4 * (int)blockIdx.x);
#else
        if ((int)blockIdx.x < 64) gdn::scan_item(lds, P, GWb, GQKb, GLv, args.in[6], (int)blockIdx.x >> 3, (int)blockIdx.x & 7);
#endif
        __syncthreads();
        STAMP(10);
        for (;;) {
            volatile LAS unsigned* qslot = (volatile LAS unsigned*)(lds + 147456 - 16);
            if (tid == 0) *qslot = atomicAdd(qcnt, 1u);
            __syncthreads();
            const int idx = (int)*qslot;
            __syncthreads();
            if (idx >= 1024) break;
#if defined(TPROBE)
            if (blockIdx.x == 200 && tid == 0) { ((volatile unsigned long long*)(ws + 786432))[0] = __builtin_amdgcn_s_memrealtime(); ((volatile unsigned*)(ws + 786432))[4] += 1u; }
#endif
            nsa::attn_tile(lds, P, KCb, VCb, (idx & 31) >> 2, idx & 3, 31 - (idx >> 5));
        }
    }
    SEAM(3);
    if (IN(4)) {
        pg8::Gemm g{Hb, Wg_t, D, D, M, 2048, D, 0}; pg8::StaticOrder S; S.init(M, 2048, G, (int)blockIdx.x);
        pg8::EpiP<1> E{P, LDP, -1, 256, nullptr};
        pg8::gemm_phase<pg8::EpiP<1>, pg8::StaticOrder, true>(lds, g, S, E);
    }
    SEAM(4);
    if (IN(5)) {
        pg8::Gemm g{P + C_DZ, Wcat_t, LDP, 2 * D, M, D, D, D}; pg8::TwoPassOrder S; S.base.init(M, D, G, (int)blockIdx.x);
        pg8::EpiMix E{P, LDP, Mix, D};
        pg8::gemm_phase<pg8::EpiMix, pg8::TwoPassOrder, false>(lds, g, S, E);
    }
    SEAM(5);
    if (IN(6)) {
        for (int it = gw; it < 64 * 16; it += NGW) transpose_item(args.in[22], D, SrcIdent{0}, Wdown_t, FF, 0, scr, it / 16, it % 16, lane);
        __syncthreads();
        pg8::Gemm g{Mix, Wout_t, D, D, M, D, D, 0}; pg8::StaticOrder S; S.init(M, D, G, (int)blockIdx.x);
        pg8::EpiOut E{x, args.out, An, args.in[20], pss};
        pg8::gemm_phase<pg8::EpiOut, pg8::StaticOrder, false>(lds, g, S, E);
    }
    SEAM(6);
    if (IN(7)) {
        pg8::Gemm g{An, Wup_t, D, D, M, FF, D, 0}; pg8::StaticOrder S; S.init(M, FF, G, (int)blockIdx.x);
        pg8::EpiUp E{pss, Up, FF};
        pg8::gemm_phase<pg8::EpiUp, pg8::StaticOrder, true>(lds, g, S, E);
    }
    SEAM(7);
    if (IN(8)) {
        pg8::Gemm g{Up, Wdown_t, FF, FF, M, D, FF, 0}; pg8::StaticOrder S; S.init(M, D, G, (int)blockIdx.x);
        pg8::EpiDown E{args.out};
        pg8::gemm_phase<pg8::EpiDown, pg8::StaticOrder, false>(lds, g, S, E);
    }
#if defined(TPROBE)
    STAMP(9);
    GRID_SYNC();
    if (blockIdx.x == 0) {
        volatile LAS unsigned long long* ts = (volatile LAS unsigned long long*)(lds + 147456 - 512);
        if (tid == 0) { ts[25] = ((volatile unsigned long long*)(ws + 786432))[0]; ts[26] = ts[3] + 100ull * ((volatile unsigned*)(ws + 786432))[4]; }
        const float dA = (float)(ts[TPA1] - ts[TPA0]) * 0.01f, dB = (float)(ts[TPB1] - ts[TPB0]) * 0.01f;
        if (tid == 0) args.out[0] = dA + 0.f * dB;
    }
#endif
#undef IN
#undef SEAM
#undef GRID_SYNC
}

static int g_grid = 0;
static void launch_mk(const Args& a0, int lo, int hi, hipStream_t stream) {
    Args a = a0; a.ph_lo = lo; a.ph_hi = hi;
    void* kargs[] = {(void*)&a};
    hipError_t e = hipLaunchCooperativeKernel((const void*)mk_fwd, dim3(g_grid), dim3(NWAVES * 64), kargs, LDS_BYTES, stream);
    if (e != hipSuccess) fprintf(stderr, "cooperative launch failed: %s (grid %d)\n", hipGetErrorString(e), g_grid);
}

extern "C" void kernel_launch(void* const* d_in, const int* in_sizes, int n_in, void* d_out, int out_size, void* d_ws, size_t ws_size, hipStream_t stream) {
    if (g_grid == 0) {
        int dev = 0, cus = 0, per_cu = 0;
        hipGetDevice(&dev);
        hipDeviceGetAttribute(&cus, hipDeviceAttributeMultiprocessorCount, dev);
        hipFuncSetAttribute((const void*)mk_fwd, hipFuncAttributeMaxDynamicSharedMemorySize, LDS_BYTES);
        hipOccupancyMaxActiveBlocksPerMultiprocessor(&per_cu, (const void*)mk_fwd, NWAVES * 64, LDS_BYTES);
        if (per_cu < 1) per_cu = 1;
        if (per_cu > 1) per_cu = 1;
        g_grid = cus * per_cu;
    }
    Args a{};
    for (int i = 0; i < 23; ++i) a.in[i] = (const float*)d_in[i];
    a.out = (float*)d_out; a.ws = (unsigned char*)d_ws;
    bf16_t* P = (bf16_t*)((char*)d_ws + WS_P);
    launch_mk(a, 0, 9, stream);
}
```

```cpp
#include <hip/hip_runtime.h>
#include <hip/hip_cooperative_groups.h>
#include <stdint.h>
#include <cstdio>
namespace cg = cooperative_groups;

typedef unsigned short bf16_t;

constexpr int D = 1024, BATCH = 8, SEQ = 2048, M = BATCH * SEQ;
constexpr int DN_H = 8, DN_D = 128;
constexpr int NS_H = 16, NS_G = 4, NS_R = 4, NS_D = 64;
constexpr int NCMP = 127, NSEL = 32;
constexpr int FF = 4096;
constexpr int INW = 8768;
constexpr float EPS = 1e-6f;
constexpr float NEGV = -1e30f, FORCEV = 1e9f;

constexpr int LDP = 6720;
constexpr int C_DQ = 0, C_DK = 1024, C_DV = 2048, C_DZ = 3072, C_NQ = 4096;
constexpr int C_KC = 5120, C_VC = 5376, C_KS = 5632, C_VS = 5888, C_KW = 6144, C_VW = 6400;
constexpr int C_SB = 6656, C_SA = 6664, C_SG = 6672;
constexpr int NP1 = 6912;

__device__ __forceinline__ float bf2f(bf16_t v) { return __uint_as_float(((unsigned)v) << 16); }
__device__ __forceinline__ bf16_t f2bf(float f) { unsigned u = __float_as_uint(f); return (bf16_t)((u + 0x7fffu + ((u >> 16) & 1u)) >> 16); }
__device__ __forceinline__ float sigmoidf_(float x) { return 1.f / (1.f + __expf(-x)); }
__device__ __forceinline__ float siluf_(float x) { return x * sigmoidf_(x); }
__device__ __forceinline__ float softplusf_(float x) { return fmaxf(x, 0.f) + log1pf(__expf(-fabsf(x))); }
__device__ __forceinline__ float gelu_tanh(float x) { return 0.5f * x * (1.f + tanhf(0.7978845608028654f * (x + 0.044715f * x * x * x))); }

__device__ __forceinline__ float block_sum(float v, float* red) {
    for (int o = 32; o > 0; o >>= 1) v += __shfl_xor(v, o);
    const int w = threadIdx.x >> 6, nw = blockDim.x >> 6;
    __syncthreads();
    if ((threadIdx.x & 63) == 0) red[w] = v;
    __syncthreads();
    float s = 0.f;
    for (int i = 0; i < nw; ++i) s += red[i];
    return s;
}
__device__ __forceinline__ float block_max(float v, float* red) {
    for (int o = 32; o > 0; o >>= 1) v = fmaxf(v, __shfl_xor(v, o));
    const int w = threadIdx.x >> 6, nw = blockDim.x >> 6;
    __syncthreads();
    if ((threadIdx.x & 63) == 0) red[w] = v;
    __syncthreads();
    float s = red[0];
    for (int i = 1; i < nw; ++i) s = fmaxf(s, red[i]);
    return s;
}


#if defined(TPROBE)
#define XSTAMP(k) do { if (blockIdx.x == 0 && threadIdx.x == 0) ((volatile __attribute__((address_space(3))) unsigned long long*)(lds + 147456 - 512))[k] = __builtin_amdgcn_s_memrealtime(); } while (0)
#else
#define XSTAMP(k) do { } while (0)
#endif
namespace gdn_naive {
#define GLAS __attribute__((address_space(3)))
__device__ __forceinline__ float sub_sum(float v, GLAS float* red, int sub, int tid) {
#pragma unroll
    for (int o = 32; o > 0; o >>= 1) v += __shfl_xor(v, o);
    __syncthreads();
    if ((tid & 63) == 0) red[sub * 2 + ((tid >> 6) & 1)] = v;
    __syncthreads();
    return red[sub * 2] + red[sub * 2 + 1];
}
__device__ __forceinline__ void run(GLAS unsigned char* lds, bf16_t* P, const float* convw, const float* a_log, const float* dt_bias, const float* out_norm, int item0) {
    const int tid = threadIdx.x, sub = tid >> 7, j = tid & 127;
    GLAS float* qs = (GLAS float*)lds + sub * 256; GLAS float* ks = qs + 128; GLAS float* red = (GLAS float*)(lds + 4096);
    const int item = item0 + sub; const int b = item / DN_H, h = item % DN_H;
    float s[128];
#pragma unroll
    for (int i = 0; i < 128; ++i) s[i] = 0.f;
    const float Ah = -__expf(a_log[h]), dtb = dt_bias[h], gn = out_norm[j];
    const float scale = 0.08838834764831845f;
    float wq[4], wk[4], wv[4], xq[3] = {0.f, 0.f, 0.f}, xk[3] = {0.f, 0.f, 0.f}, xv[3] = {0.f, 0.f, 0.f};
#pragma unroll
    for (int t = 0; t < 4; ++t) { wq[t] = convw[t * 3072 + h * 128 + j]; wk[t] = convw[t * 3072 + 1024 + h * 128 + j]; wv[t] = convw[t * 3072 + 2048 + h * 128 + j]; }
    for (int t = 0; t < SEQ; ++t) {
        bf16_t* row = P + (size_t)(b * SEQ + t) * LDP;
        const float rq = bf2f(row[C_DQ + h * DN_D + j]), rk = bf2f(row[C_DK + h * DN_D + j]), rv = bf2f(row[C_DV + h * DN_D + j]);
        float q = siluf_(wq[0] * xq[0] + wq[1] * xq[1] + wq[2] * xq[2] + wq[3] * rq);
        float k = siluf_(wk[0] * xk[0] + wk[1] * xk[1] + wk[2] * xk[2] + wk[3] * rk);
        const float v = siluf_(wv[0] * xv[0] + wv[1] * xv[1] + wv[2] * xv[2] + wv[3] * rv);
        xq[0] = xq[1]; xq[1] = xq[2]; xq[2] = rq; xk[0] = xk[1]; xk[1] = xk[2]; xk[2] = rk; xv[0] = xv[1]; xv[1] = xv[2]; xv[2] = rv;
        const float sq = sub_sum(q * q, red, sub, tid);
        const float sk = sub_sum(k * k, red, sub, tid);
        q *= rsqrtf(sq + EPS); k *= rsqrtf(sk + EPS);
        qs[j] = q; ks[j] = k;
        const float beta = sigmoidf_(bf2f(row[C_SB + h]));
        const float a = __expf(Ah * softplusf_(bf2f(row[C_SA + h]) + dtb));
        const float z = bf2f(row[C_DZ + h * DN_D + j]);
        __syncthreads();
        float kS = 0.f;
#pragma unroll
        for (int i = 0; i < 128; ++i) kS += ks[i] * s[i];
        const float dlt = beta * (v - a * kS);
        asm volatile("" ::: "memory");
        float o = 0.f;
#pragma unroll
        for (int i = 0; i < 128; ++i) { s[i] = a * s[i] + ks[i] * dlt; o += qs[i] * s[i]; }
        o *= scale;
        const float ss = sub_sum(o * o, red, sub, tid);
        row[C_DZ + h * DN_D + j] = f2bf(o * rsqrtf(ss * (1.f / 128.f) + EPS) * gn * siluf_(z));
    }
}
}
namespace gdn {
#define GL3 __attribute__((address_space(3)))
typedef short bf16x8 __attribute__((ext_vector_type(8)));
typedef short s16x4 __attribute__((ext_vector_type(4)));
typedef short v4i16_t __attribute__((ext_vector_type(4)));
typedef float f32x16 __attribute__((ext_vector_type(16)));
typedef float f32x4 __attribute__((ext_vector_type(4)));
typedef float f32x2 __attribute__((ext_vector_type(2)));
typedef unsigned u32x4 __attribute__((ext_vector_type(4)));
typedef unsigned u32x2 __attribute__((ext_vector_type(2)));
typedef __bf16 bf16x2_t __attribute__((ext_vector_type(2)));
constexpr float QSCALE = 0.08838834764831845f;
__device__ __forceinline__ float fsig(float x) { return __builtin_amdgcn_rcpf(1.f + __builtin_amdgcn_exp2f(-1.4426950408889634f * x)); }
__device__ __forceinline__ float fsilu(float x) { return x * fsig(x); }
__device__ __forceinline__ int crow(int i, int hi) { return (i & 3) + 8 * (i >> 2) + 4 * hi; }
__device__ __forceinline__ unsigned pk(float lo, float hi) { f32x2 v = {lo, hi}; bf16x2_t b = __builtin_convertvector(v, bf16x2_t); return __builtin_bit_cast(unsigned, b); }
__device__ __forceinline__ bf16x8 pack8(const float* v) { u32x4 w = {pk(v[0], v[1]), pk(v[2], v[3]), pk(v[4], v[5]), pk(v[6], v[7])}; return __builtin_bit_cast(bf16x8, w); }
__device__ __forceinline__ float blo(unsigned w) { return __uint_as_float(w << 16); }
__device__ __forceinline__ float bhi(unsigned w) { return __uint_as_float(w & 0xffff0000u); }
__device__ __forceinline__ char* seg_addr(bf16_t* P, size_t row0, int c0, unsigned e) { return (char*)P + ((row0 + (e >> 8)) * LDP + c0) * 2 + (e & 255u); }

__device__ __forceinline__ s16x4 vtr(GL3 const unsigned char* p) { return __builtin_bit_cast(s16x4, __builtin_amdgcn_ds_read_tr16_b64_v4i16((GL3 v4i16_t*)p)); }

constexpr int PL_K = 0, PL_KB = 16384, PL_Q = 32768, PL_RV = 49152, PL_AM = 81920, PL_INV = 99328, PL_MT = 116736, PL_GC = 120832, PL_QKST = 121088, PL_TI = 129280, PL_CW = 137472, PL_END = 143616;
constexpr int PL_WST = 0, PL_UST = 16384;
constexpr int AMLD = 68;
struct RowPre { u32x4 x[2][3][4]; unsigned short lb, la; };
__device__ __forceinline__ void prep_prefetch(RowPre& pre, const bf16_t* P, const bf16_t* HALO, int b, int n, int h, int wid, int lane) {
    const size_t row0 = (size_t)b * SEQ + 64 * n; const int dc = lane & 15;
    const bf16_t* prow = P + (row0 + lane) * LDP;
    pre.lb = prow[C_SB + h]; pre.la = prow[C_SA + h];
#pragma unroll
    for (int pass = 0; pass < 2; ++pass) {
        const int tok = 8 * wid + 4 * pass + (lane >> 4);
#pragma unroll
        for (int which = 0; which < 3; ++which) {
            const int col = which * 1024 + h * 128 + dc * 8;
#pragma unroll
            for (int j = 0; j < 4; ++j) {
                const int rr = tok - 3 + j; const bool inb = rr >= 0;
                const bf16_t* src = inb ? (P + (row0 + (inb ? rr : 0)) * LDP + col) : (HALO + ((size_t)((b * 32 + (n > 0 ? n - 1 : 0)) * 3 + (inb ? 0 : 3 + rr))) * 3072 + col);
                pre.x[pass][which][j] = *(const u32x4*)src;
            }
        }
    }
}
__device__ __forceinline__ void prep_load_taps(GL3 unsigned char* lds, const float* convw, int h) {
    GL3 float* cw = (GL3 float*)(lds + 137472);
    for (int e = threadIdx.x; e < 1536; e += 512) { const int which = e >> 9, j = (e >> 7) & 3, c = e & 127; cw[e] = convw[j * 3072 + which * 1024 + h * 128 + c]; }
}
#define PBAR() do { asm volatile("s_waitcnt lgkmcnt(0)" ::: "memory"); __builtin_amdgcn_s_barrier(); asm volatile("" ::: "memory"); } while (0)
__device__ __forceinline__ void prep_item(GL3 unsigned char* lds, bf16_t* P, const bf16_t* HALO, const float* a_log, const float* dt_bias,
                                          bf16_t* GW, bf16_t* GQK, float* GLv, RowPre& pre, int b, int n, int h, int nb_, int nn_, int nh_) {
    int tid = threadIdx.x; asm volatile("" : "+v"(tid));
    const int lane = tid & 63, r32 = lane & 31, hi = lane >> 5; const int wid = __builtin_amdgcn_readfirstlane(tid >> 6);
    const size_t row0 = (size_t)b * SEQ + 64 * n; const int item = (b * DN_H + h) * 32 + n;
    GL3 float* AM = (GL3 float*)(lds + PL_AM); GL3 float* INV = (GL3 float*)(lds + PL_INV); GL3 float* MT = (GL3 float*)(lds + PL_MT); GL3 float* GC = (GL3 float*)(lds + PL_GC);
    float gcum, beta_l, gc_last;
    {
        beta_l = fsig(bf2f(pre.lb));
        { const float xs = bf2f(pre.la) + dt_bias[h]; gcum = -__expf(a_log[h]) * (fmaxf(xs, 0.f) + __logf(1.f + __expf(-fabsf(xs)))); }
#pragma unroll
        for (int o = 1; o < 64; o <<= 1) { const float t = __shfl_up(gcum, o); if (lane >= o) gcum += t; }
        gc_last = __shfl(gcum, 63);
        if (wid == 0) GC[lane] = gcum;
    }
    bf16x8 qd_keep[2], ke_keep[2];
    const int dc = lane & 15;
#pragma unroll
    for (int pass = 0; pass < 2; ++pass) {
        const int tok = 8 * wid + 4 * pass + (lane >> 4);
        const float gct = __shfl(gcum, tok), bet = __shfl(beta_l, tok);
        float y[3][8];
#pragma unroll
        for (int which = 0; which < 3; ++which) {
#pragma unroll
            for (int e = 0; e < 8; ++e) y[which][e] = 0.f;
#pragma unroll
            for (int j = 0; j < 4; ++j) {
                const int rr = tok - 3 + j;
                u32x4 x = pre.x[pass][which][j];
                if (rr < 0 && n == 0) x = (u32x4){0u, 0u, 0u, 0u};
                const f32x4 w0 = *(GL3 const f32x4*)(lds + PL_CW + ((which * 4 + j) * 128 + dc * 8) * 4), w1 = *(GL3 const f32x4*)(lds + PL_CW + ((which * 4 + j) * 128 + dc * 8 + 4) * 4);
                y[which][0] += w0[0] * blo(x.x); y[which][1] += w0[1] * bhi(x.x); y[which][2] += w0[2] * blo(x.y); y[which][3] += w0[3] * bhi(x.y);
                y[which][4] += w1[0] * blo(x.z); y[which][5] += w1[1] * bhi(x.z); y[which][6] += w1[2] * blo(x.w); y[which][7] += w1[3] * bhi(x.w);
            }
#pragma unroll
            for (int e = 0; e < 8; ++e) y[which][e] = fsilu(y[which][e]);
        }
        float sq = 0.f, sk = 0.f;
#pragma unroll
        for (int e = 0; e < 8; ++e) { sq += y[0][e] * y[0][e]; sk += y[1][e] * y[1][e]; }
#pragma unroll
        for (int o = 1; o < 16; o <<= 1) { sq += __shfl_xor(sq, o); sk += __shfl_xor(sk, o); }
        const float rq = rsqrtf(sq + EPS), rk = rsqrtf(sk + EPS);
        const float eg = __expf(gct), ke_s = __expf(gc_last - gct);
        float q8[8], k8[8], kb8[8], qd8[8], ke8[8], kbg8[8], vb8[8];
#pragma unroll
        for (int e = 0; e < 8; ++e) { q8[e] = y[0][e] * rq; k8[e] = y[1][e] * rk; kb8[e] = k8[e] * bet; qd8[e] = q8[e] * (QSCALE * eg); ke8[e] = k8[e] * ke_s; kbg8[e] = kb8[e] * eg; vb8[e] = y[2][e] * bet; }
        const int io = (dc * 64 + tok) * 16;
        *(GL3 bf16x8*)(lds + PL_Q + io) = pack8(q8); *(GL3 bf16x8*)(lds + PL_K + io) = pack8(k8); *(GL3 bf16x8*)(lds + PL_KB + io) = pack8(kb8);
        {
            const int rvo = (tok >> 4) * 1024 + ((tok >> 3) & 1) * 512 + (tok & 7) * 64 + (dc & 3) * 16;
            *(GL3 bf16x8*)(lds + PL_RV + (dc >> 2) * 4096 + rvo) = pack8(kbg8); *(GL3 bf16x8*)(lds + PL_RV + (4 + (dc >> 2)) * 4096 + rvo) = pack8(vb8);
        }
        qd_keep[pass] = pack8(qd8); ke_keep[pass] = pack8(ke8);
    }
    PBAR();
    if (nb_ >= 0) prep_prefetch(pre, P, HALO, nb_, nn_, nh_, wid, lane);
    if (n == 0 && b == 0 && h == 0) XSTAMP(15);
#pragma unroll
    for (int pass = 0; pass < 2; ++pass) {
        const int tok = 8 * wid + 4 * pass + (lane >> 4);
        *(bf16x8*)seg_addr(P, row0, C_DQ + h * 128, (unsigned)((dc * 64 + tok) * 16)) = qd_keep[pass];
        const unsigned ek = (unsigned)(((dc >> 2) * 4 + (tok >> 4)) * 1024 + ((tok >> 3) & 1) * 512 + (tok & 7) * 64 + (dc & 3) * 16);
        *(bf16x8*)seg_addr(P, row0, C_DK + h * 128, ek) = ke_keep[pass];
    }
    if (wid < 6) {
        const bool isA = wid < 3; const int t3 = isA ? wid : wid - 3;
        const int rt = isA ? (t3 > 0) : (t3 == 2);
        const int ct = isA ? (t3 == 2) : (t3 > 0);
        GL3 const unsigned char* aimg = lds + (isA ? PL_KB : PL_K); GL3 const unsigned char* bimg = lds + (isA ? PL_K : PL_Q);
        f32x16 acc = f32x16{};
#pragma unroll
        for (int s = 0; s < 8; ++s) {
            const bf16x8 a = *(GL3 const bf16x8*)(aimg + ((2 * s + hi) * 64 + 32 * rt + r32) * 16);
            const bf16x8 bb = *(GL3 const bf16x8*)(bimg + ((2 * s + hi) * 64 + 32 * ct + r32) * 16);
            acc = __builtin_amdgcn_mfma_f32_32x32x16_bf16(a, bb, acc, 0, 0, 0);
        }
        if (isA) {
            const int j = 32 * ct + r32; const float gj = GC[j];
#pragma unroll
            for (int i_ = 0; i_ < 16; ++i_) { const int i = 32 * rt + crow(i_, hi); AM[i * AMLD + j] = (j < i) ? acc[i_] * __expf(GC[i] - gj) : 0.f; }
        } else {
            const int i = 32 * ct + r32; const float gi = GC[i];
            float v[16];
#pragma unroll
            for (int i_ = 0; i_ < 16; ++i_) { const int j = 32 * rt + crow(i_, hi); v[i_] = (j <= i) ? acc[i_] * (QSCALE * __expf(gi - GC[j])) : 0.f; }
#pragma unroll
            for (int sp = 0; sp < 2; ++sp) *(GL3 bf16x8*)(lds + PL_QKST + (((2 * rt + sp) * 64 + i) * 16 + 8 * hi) * 2) = pack8(v + 8 * sp);
        }
    } else if (wid == 6) {
        const bf16x8 z = {0, 0, 0, 0, 0, 0, 0, 0};
#pragma unroll
        for (int sp = 0; sp < 2; ++sp) *(GL3 bf16x8*)(lds + PL_QKST + (((2 + sp) * 64 + r32) * 16 + 8 * hi) * 2) = z;
    }
    PBAR();
    if (wid < 4 && lane < 16) {
        const int bb = wid, c = lane;
        float x[16];
#pragma unroll
        for (int i = 0; i < 16; ++i) {
            float acc = (i == c) ? 1.f : 0.f;
#pragma unroll
            for (int j4 = 0; j4 < i; j4 += 4) { const f32x4 a = *(GL3 const f32x4*)(AM + (16 * bb + i) * AMLD + 16 * bb + j4);
                acc -= a[0] * x[j4]; if (j4 + 1 < i) acc -= a[1] * x[j4 + 1]; if (j4 + 2 < i) acc -= a[2] * x[j4 + 2]; if (j4 + 3 < i) acc -= a[3] * x[j4 + 3]; }
            x[i] = acc;
        }
#pragma unroll
        for (int i = 0; i < 16; ++i) INV[(16 * bb + i) * AMLD + 16 * bb + c] = x[i];
    }
    PBAR();
    for (int L = 1; L < 4; ++L) {
        const int nb = 4 - L;
        for (int t = tid; t < nb * 256; t += 512) {
            const int J = t >> 8, I = J + L, ei = (t >> 4) & 15, ej = t & 15;
            float acc = 0.f;
            for (int K = J; K < I; ++K) {
#pragma unroll
                for (int k4 = 0; k4 < 16; k4 += 4) { const f32x4 a = *(GL3 const f32x4*)(AM + (16 * I + ei) * AMLD + 16 * K + k4);
                    acc += a[0] * INV[(16 * K + k4) * AMLD + 16 * J + ej] + a[1] * INV[(16 * K + k4 + 1) * AMLD + 16 * J + ej] + a[2] * INV[(16 * K + k4 + 2) * AMLD + 16 * J + ej] + a[3] * INV[(16 * K + k4 + 3) * AMLD + 16 * J + ej]; }
            }
            MT[(J * 16 + ei) * 17 + ej] = acc;
        }
        PBAR();
        for (int t = tid; t < nb * 256; t += 512) {
            const int J = t >> 8, I = J + L, ei = (t >> 4) & 15, ej = t & 15;
            float acc = 0.f;
#pragma unroll
            for (int k4 = 0; k4 < 16; k4 += 4) { const f32x4 d = *(GL3 const f32x4*)(INV + (16 * I + ei) * AMLD + 16 * I + k4);
                acc += d[0] * MT[(J * 16 + k4) * 17 + ej] + d[1] * MT[(J * 16 + k4 + 1) * 17 + ej] + d[2] * MT[(J * 16 + k4 + 2) * 17 + ej] + d[3] * MT[(J * 16 + k4 + 3) * 17 + ej]; }
            INV[(16 * I + ei) * AMLD + 16 * J + ej] = -acc;
        }
        PBAR();
    }
    {
        const int s_ = tid >> 7, i = (tid >> 1) & 63, hh = tid & 1;
        float v[8];
        if (s_ > (i >> 4)) {
#pragma unroll
            for (int e = 0; e < 8; ++e) v[e] = 0.f;
        } else {
            const f32x4 a = *(GL3 const f32x4*)(INV + i * AMLD + 16 * s_ + 4 * hh), c4 = *(GL3 const f32x4*)(INV + i * AMLD + 16 * s_ + 8 + 4 * hh);
            v[0] = a[0]; v[1] = a[1]; v[2] = a[2]; v[3] = a[3]; v[4] = c4[0]; v[5] = c4[1]; v[6] = c4[2]; v[7] = c4[3];
        }
        *(GL3 bf16x8*)(lds + PL_TI + ((s_ * 64 + i) * 16 + 8 * hh) * 2) = pack8(v);
    }
    PBAR();
    {
        const int cb = wid;
        GL3 const unsigned char* rp = lds + PL_RV + cb * 4096 + ((lane >> 4) & 1) * 32 + (lane & 3) * 8 + (4 * hi + ((lane & 15) >> 2)) * 64;
        f32x16 d0 = f32x16{}, d1 = f32x16{};
#pragma unroll
        for (int ks = 0; ks < 4; ++ks) {
            const s16x4 lo = vtr(rp + ks * 1024), hh2 = vtr(rp + ks * 1024 + 512);
            const bf16x8 rf = {lo[0], lo[1], lo[2], lo[3], hh2[0], hh2[1], hh2[2], hh2[3]};
            const bf16x8 t1 = *(GL3 const bf16x8*)(lds + PL_TI + ((ks * 64 + 32 + r32) * 16 + 8 * hi) * 2);
            if (cb < 4) {
                if (ks < 2) { const bf16x8 t0 = *(GL3 const bf16x8*)(lds + PL_TI + ((ks * 64 + r32) * 16 + 8 * hi) * 2); d0 = __builtin_amdgcn_mfma_f32_32x32x16_bf16(rf, t0, d0, 0, 0, 0); }
                d1 = __builtin_amdgcn_mfma_f32_32x32x16_bf16(rf, t1, d1, 0, 0, 0);
            } else {
                if (ks < 2) { const bf16x8 t0 = *(GL3 const bf16x8*)(lds + PL_TI + ((ks * 64 + r32) * 16 + 8 * hi) * 2); d0 = __builtin_amdgcn_mfma_f32_32x32x16_bf16(t0, rf, d0, 0, 0, 0); }
                d1 = __builtin_amdgcn_mfma_f32_32x32x16_bf16(t1, rf, d1, 0, 0, 0);
            }
        }
        PBAR();
        if (cb < 4) {
#pragma unroll
            for (int a = 0; a < 4; ++a) {
                u32x2 w0 = {pk(d0[4 * a], d0[4 * a + 1]), pk(d0[4 * a + 2], d0[4 * a + 3])}, w1 = {pk(d1[4 * a], d1[4 * a + 1]), pk(d1[4 * a + 2], d1[4 * a + 3])};
                *(GL3 u32x2*)(lds + PL_WST + ((4 * cb + a) * 64 + r32) * 16 + 8 * hi) = w0;
                *(GL3 u32x2*)(lds + PL_WST + ((4 * cb + a) * 64 + 32 + r32) * 16 + 8 * hi) = w1;
            }
        } else {
            const int dvc = 32 * (cb - 4) + r32;
#pragma unroll
            for (int i = 0; i < 16; ++i) { *(GL3 bf16_t*)(lds + PL_UST + (crow(i, hi) * 128 + dvc) * 2) = f2bf(d0[i]); *(GL3 bf16_t*)(lds + PL_UST + ((32 + crow(i, hi)) * 128 + dvc) * 2) = f2bf(d1[i]); }
        }
    }
    PBAR();
#pragma unroll
    for (int k = 0; k < 2; ++k) {
        const int e = (tid + 512 * k) * 16;
        *(u32x4*)((char*)(GW + (size_t)item * 8192) + e) = *(GL3 const u32x4*)(lds + PL_WST + e);
        *(u32x4*)seg_addr(P, row0, C_DV + h * 128, (unsigned)e) = *(GL3 const u32x4*)(lds + PL_UST + e);
    }
    *(u32x4*)((char*)(GQK + (size_t)item * 4096) + tid * 16) = *(GL3 const u32x4*)(lds + PL_QKST + tid * 16);
    if (tid == 0) GLv[item] = __expf(gc_last);
    PBAR();
}

#undef PBAR
constexpr int SL_W = 0, SL_QD = 16384, SL_KE = 32768, SL_QK = 49152, SL_U = 57344, SL_Z = 73728, SL_S = 90112, SL_VN = 122880, SL_RS = 139264, SL_END = 140416;
__device__ __forceinline__ void glds16(const void* gsrc, unsigned lds_dst) { unsigned keep;
    asm volatile("s_mov_b32 %0, m0\n\ts_mov_b32 m0, %2\n\ts_nop 0\n\tglobal_load_lds_dwordx4 %1, off\n\ts_mov_b32 m0, %0" : "=&s"(keep) : "v"(gsrc), "s"(lds_dst) : "memory"); }
__device__ __forceinline__ unsigned lds_addr(GL3 unsigned char* p) { return (unsigned)(size_t)p; }
__device__ __forceinline__ void dma_seg(GL3 unsigned char* dst, const bf16_t* P, size_t row0, int c0, int wid, int lane) {
#pragma unroll
    for (int k = 0; k < 2; ++k) { const int piece = wid + 8 * k;
        const char* src = (const char*)P + ((row0 + piece * 4 + (lane >> 4)) * LDP + c0) * 2 + (lane & 15) * 16;
        glds16(src, (unsigned)__builtin_amdgcn_readfirstlane((int)(lds_addr(dst) + piece * 1024))); }
}
template <int NPIECES>
__device__ __forceinline__ void dma_lin(GL3 unsigned char* dst, const bf16_t* src, int wid, int lane) {
#pragma unroll
    for (int k = 0; k < NPIECES / 8; ++k) { const int piece = wid + 8 * k;
        glds16((const char*)src + piece * 1024 + lane * 16, (unsigned)__builtin_amdgcn_readfirstlane((int)(lds_addr(dst) + piece * 1024))); }
}

__device__ __forceinline__ float sum32(float v) {
    v += __builtin_bit_cast(float, __builtin_amdgcn_mov_dpp(__builtin_bit_cast(int, v), 0xB1, 0xF, 0xF, true));
    v += __builtin_bit_cast(float, __builtin_amdgcn_mov_dpp(__builtin_bit_cast(int, v), 0x4E, 0xF, 0xF, true));
    v += __builtin_bit_cast(float, __builtin_amdgcn_mov_dpp(__builtin_bit_cast(int, v), 0x141, 0xF, 0xF, true));
    v += __builtin_bit_cast(float, __builtin_amdgcn_mov_dpp(__builtin_bit_cast(int, v), 0x140, 0xF, 0xF, true));
    v += __shfl_xor(v, 16);
    return v;
}
#define GRAWBAR() do { asm volatile("s_waitcnt lgkmcnt(0)" ::: "memory"); __builtin_amdgcn_s_barrier(); asm volatile("" ::: "memory"); } while (0)
#define GWAITV0() asm volatile("s_waitcnt vmcnt(0)" ::: "memory")
constexpr int SL_GL = SL_RS + 1024;
__device__ __forceinline__ void scan_item(GL3 unsigned char* lds, bf16_t* P, const bf16_t* GW, const bf16_t* GQK, const float* GLv, const float* out_norm, int b, int h) {
    const int tid = threadIdx.x, lane = tid & 63, r32 = lane & 31, hi = lane >> 5; const int wid = __builtin_amdgcn_readfirstlane(tid >> 6);
    const int mt = wid >> 2, nt = wid & 3;
    const int dv = 32 * nt + r32;
    const int item0 = (b * DN_H + h) * 32; const size_t rowb = (size_t)b * SEQ;
    f32x16 S0 = f32x16{}, S1 = f32x16{};
    {
        const u32x4 z = {0u, 0u, 0u, 0u};
#pragma unroll
        for (int k = 0; k < 4; ++k) *(GL3 u32x4*)(lds + SL_S + (tid + 512 * k) * 16) = z;
        if (tid < 32) *(GL3 float*)(lds + SL_GL + tid * 4) = GLv[item0 + tid];
    }
    const float gain = out_norm[dv];
    GL3 float* RS = (GL3 float*)(lds + SL_RS);
#define ISSUE_A(n_) do { dma_lin<16>(lds + SL_W, GW + (size_t)(item0 + (n_)) * 8192, wid, lane); dma_seg(lds + SL_QD, P, rowb + 64 * (n_), C_DQ + h * 128, wid, lane); dma_seg(lds + SL_U, P, rowb + 64 * (n_), C_DV + h * 128, wid, lane); } while (0)
#define ISSUE_B(n_) do { dma_seg(lds + SL_KE, P, rowb + 64 * (n_), C_DK + h * 128, wid, lane); dma_lin<8>(lds + SL_QK, GQK + (size_t)(item0 + (n_)) * 4096, wid, lane); dma_seg(lds + SL_Z, P, rowb + 64 * (n_), C_DZ + h * 128, wid, lane); } while (0)
    GWAITV0();
    ISSUE_A(0);
    for (int n = 0; n < 32; ++n) {
        const size_t row0 = rowb + 64 * n;
        GWAITV0(); GRAWBAR();
        ISSUE_B(n);
        const float gl = *(GL3 const float*)(lds + SL_GL + n * 4);
        f32x16 vp = f32x16{}, o = f32x16{};
#pragma unroll
        for (int s = 0; s < 8; ++s) {
            const bf16x8 sb = *(GL3 const bf16x8*)(lds + SL_S + ((2 * s + hi) * 128 + dv) * 16);
            const bf16x8 wa = *(GL3 const bf16x8*)(lds + SL_W + ((2 * s + hi) * 64 + 32 * mt + r32) * 16);
            const bf16x8 qa = *(GL3 const bf16x8*)(lds + SL_QD + ((2 * s + hi) * 64 + 32 * mt + r32) * 16);
            vp = __builtin_amdgcn_mfma_f32_32x32x16_bf16(wa, sb, vp, 0, 0, 0);
            o = __builtin_amdgcn_mfma_f32_32x32x16_bf16(qa, sb, o, 0, 0, 0);
        }
        {
            float v[16];
#pragma unroll
            for (int i = 0; i < 16; ++i) v[i] = bf2f(*(GL3 const bf16_t*)(lds + SL_U + ((32 * mt + crow(i, hi)) * 128 + dv) * 2)) - vp[i];
#pragma unroll
            for (int sp = 0; sp < 2; ++sp) *(GL3 bf16x8*)(lds + SL_VN + (((2 * mt + sp) * 128 + dv) * 16 + 8 * hi) * 2) = pack8(v + 8 * sp);
        }
        GWAITV0(); GRAWBAR();
        if (n + 1 < 32) ISSUE_A(n + 1);
#pragma unroll
        for (int i = 0; i < 16; ++i) { S0[i] *= gl; S1[i] *= gl; }
        {
            GL3 const unsigned char* kp0 = lds + SL_KE + (2 * mt) * 4096 + ((lane >> 4) & 1) * 32 + (lane & 3) * 8 + (4 * hi + ((lane & 15) >> 2)) * 64;
#pragma unroll
            for (int ks = 0; ks < 4; ++ks) {
                const bf16x8 vb = *(GL3 const bf16x8*)(lds + SL_VN + ((ks * 128 + dv) * 16 + 8 * hi) * 2);
                const s16x4 l0 = vtr(kp0 + ks * 1024), h0 = vtr(kp0 + ks * 1024 + 512), l1 = vtr(kp0 + 4096 + ks * 1024), h1 = vtr(kp0 + 4096 + ks * 1024 + 512);
                const bf16x8 k0 = {l0[0], l0[1], l0[2], l0[3], h0[0], h0[1], h0[2], h0[3]}, k1 = {l1[0], l1[1], l1[2], l1[3], h1[0], h1[1], h1[2], h1[3]};
                const bf16x8 qa = *(GL3 const bf16x8*)(lds + SL_QK + ((ks * 64 + 32 * mt + r32) * 16 + 8 * hi) * 2);
                S0 = __builtin_amdgcn_mfma_f32_32x32x16_bf16(k0, vb, S0, 0, 0, 0);
                S1 = __builtin_amdgcn_mfma_f32_32x32x16_bf16(k1, vb, S1, 0, 0, 0);
                o = __builtin_amdgcn_mfma_f32_32x32x16_bf16(qa, vb, o, 0, 0, 0);
            }
        }
#pragma unroll
        for (int i = 0; i < 16; ++i) { const float q = sum32(o[i] * o[i]); if (r32 == 0) RS[(32 * mt + crow(i, hi)) * 4 + nt] = q; }
        GRAWBAR();
#pragma unroll
        for (int a = 0; a < 4; ++a) {
            u32x2 w0 = {pk(S0[4 * a], S0[4 * a + 1]), pk(S0[4 * a + 2], S0[4 * a + 3])}, w1 = {pk(S1[4 * a], S1[4 * a + 1]), pk(S1[4 * a + 2], S1[4 * a + 3])};
            *(GL3 u32x2*)(lds + SL_S + ((4 * (2 * mt) + a) * 128 + dv) * 16 + 8 * hi) = w0;
            *(GL3 u32x2*)(lds + SL_S + ((4 * (2 * mt + 1) + a) * 128 + dv) * 16 + 8 * hi) = w1;
        }
#pragma unroll
        for (int i = 0; i < 16; ++i) { const int tok = 32 * mt + crow(i, hi);
            const f32x4 rs = *(GL3 const f32x4*)(RS + tok * 4);
            const float rstd = rsqrtf(((rs[0] + rs[1]) + (rs[2] + rs[3])) * (1.f / 128.f) + EPS);
            const float z = bf2f(*(GL3 const bf16_t*)(lds + SL_Z + (tok * 128 + dv) * 2));
            *(GL3 bf16_t*)(lds + SL_VN + (tok * 128 + dv) * 2) = f2bf(o[i] * rstd * gain * siluf_(z)); }
        GRAWBAR();
#pragma unroll
        for (int k = 0; k < 2; ++k) { const int e = (tid + 512 * k) * 16; *(u32x4*)seg_addr(P, row0, C_DZ + h * 128, (unsigned)e) = *(GL3 const u32x4*)(lds + SL_VN + e); }
    }
    GWAITV0();
    __syncthreads();
#undef ISSUE_A
#undef ISSUE_B
}
}
namespace nsa {
#define NLAS __attribute__((address_space(3)))
typedef short bf16x8 __attribute__((ext_vector_type(8)));
typedef short s16x4 __attribute__((ext_vector_type(4)));
typedef short v4i16_t __attribute__((ext_vector_type(4)));
typedef float f32x16 __attribute__((ext_vector_type(16)));
typedef float f32x4 __attribute__((ext_vector_type(4)));
typedef float f32x2 __attribute__((ext_vector_type(2)));
typedef unsigned u32x4 __attribute__((ext_vector_type(4)));
typedef __bf16 bf16x2_t __attribute__((ext_vector_type(2)));
constexpr float LOG2E = 1.4426950408889634f;
constexpr float NEG = -1e30f;
constexpr int L_KV = 0;
constexpr int L_IMP = 32768;
constexpr int L_SEL = 65536;
constexpr int L_WS = 66048;
constexpr int L_OST = 68096;
constexpr int L_END = 100864;

__device__ __forceinline__ int crow(int i, int hi) { return (i & 3) + 8 * (i >> 2) + 4 * hi; }
__device__ __forceinline__ unsigned pk(float lo, float hi) { f32x2 v = {lo, hi}; bf16x2_t b = __builtin_convertvector(v, bf16x2_t); return __builtin_bit_cast(unsigned, b); }
__device__ __forceinline__ float xhalf_max(float v) { auto rr = __builtin_amdgcn_permlane32_swap(__float_as_uint(v), __float_as_uint(v), false, false); return fmaxf(__uint_as_float(rr[0]), __uint_as_float(rr[1])); }
__device__ __forceinline__ float xhalf_sum(float v) { auto rr = __builtin_amdgcn_permlane32_swap(__float_as_uint(v), __float_as_uint(v), false, false); return __uint_as_float(rr[0]) + __uint_as_float(rr[1]); }

__device__ __forceinline__ void dma_tile(NLAS unsigned char* slot, const bf16_t* Kb, const bf16_t* Vb, unsigned koff, unsigned voff, int wid) {
    __builtin_amdgcn_global_load_lds((const unsigned*)((const char*)Kb + koff), (NLAS unsigned*)(slot + wid * 1024), 16, 0, 0);
    __builtin_amdgcn_global_load_lds((const unsigned*)((const char*)Vb + voff), (NLAS unsigned*)(slot + 8192 + wid * 1024), 16, 0, 0);
}
__device__ __forceinline__ void tile_offs(unsigned& koff, unsigned& voff, int pitch, int wid, int lane) {
    koff = (unsigned)(lane * pitch + wid * 8) * 2u;
    voff = (unsigned)((16 * (wid & 3) + (lane >> 2)) * pitch + (wid >> 2) * 32 + (lane & 3) * 8) * 2u;
}
__device__ __forceinline__ void qkt(f32x16& p0, f32x16& p1, NLAS const unsigned char* Kslot, const bf16x8* qr, const f32x16& c0, const f32x16& c1, int r32, int hi) {
    NLAS const unsigned char* kb = Kslot + hi * 1024 + r32 * 16;
#pragma unroll
    for (int d0 = 0; d0 < 4; ++d0) {
        const bf16x8 b0 = *(NLAS const bf16x8*)(kb + d0 * 2048);
        const bf16x8 b1 = *(NLAS const bf16x8*)(kb + d0 * 2048 + 512);
        if (d0 == 0) { p0 = __builtin_amdgcn_mfma_f32_32x32x16_bf16(b0, qr[0], c0, 0, 0, 0); p1 = __builtin_amdgcn_mfma_f32_32x32x16_bf16(b1, qr[0], c1, 0, 0, 0); }
        else { p0 = __builtin_amdgcn_mfma_f32_32x32x16_bf16(b0, qr[d0], p0, 0, 0, 0); p1 = __builtin_amdgcn_mfma_f32_32x32x16_bf16(b1, qr[d0], p1, 0, 0, 0); }
    }
}
__device__ __forceinline__ s16x4 vtr(NLAS const unsigned char* p) { return __builtin_bit_cast(s16x4, __builtin_amdgcn_ds_read_tr16_b64_v4i16((NLAS v4i16_t*)p)); }
__device__ __forceinline__ void pv(f32x16* o, NLAS const unsigned char* Vslot, const f32x16& p0, const f32x16& p1, int lane, int hi) {
    u32x4 w0 = {pk(p0[0], p0[1]), pk(p0[2], p0[3]), pk(p0[4], p0[5]), pk(p0[6], p0[7])};
    u32x4 w1 = {pk(p0[8], p0[9]), pk(p0[10], p0[11]), pk(p0[12], p0[13]), pk(p0[14], p0[15])};
    u32x4 w2 = {pk(p1[0], p1[1]), pk(p1[2], p1[3]), pk(p1[4], p1[5]), pk(p1[6], p1[7])};
    u32x4 w3 = {pk(p1[8], p1[9]), pk(p1[10], p1[11]), pk(p1[12], p1[13]), pk(p1[14], p1[15])};
    const bf16x8 pa[4] = {__builtin_bit_cast(bf16x8, w0), __builtin_bit_cast(bf16x8, w1), __builtin_bit_cast(bf16x8, w2), __builtin_bit_cast(bf16x8, w3)};
    NLAS const unsigned char* vp = Vslot + ((lane >> 4) & 1) * 32 + (lane & 3) * 8 + (4 * hi + ((lane & 15) >> 2)) * 64;
#pragma unroll
    for (int d0 = 0; d0 < 2; ++d0)
#pragma unroll
        for (int ks = 0; ks < 4; ++ks) {
            const s16x4 lo = vtr(vp + d0 * 4096 + ks * 1024), hh = vtr(vp + d0 * 4096 + ks * 1024 + 512);
            const bf16x8 vf = {lo[0], lo[1], lo[2], lo[3], hh[0], hh[1], hh[2], hh[3]};
            o[d0] = __builtin_amdgcn_mfma_f32_32x32x16_bf16(pa[ks], vf, o[d0], 0, 0, 0);
        }
}
__device__ __forceinline__ void scale_rows(f32x16* o, NLAS float* wsf, float s, int r32, int hi) {
    if (hi == 0) wsf[r32] = s;
#pragma unroll
    for (int i = 0; i < 16; ++i) { const float f = wsf[crow(i, hi)]; o[0][i] *= f; o[1][i] *= f; }
}
__device__ __forceinline__ void acc_rows(f32x16* tot, const f32x16* o, NLAS float* wsf, float s, int r32, int hi) {
    if (hi == 0) wsf[32 + r32] = s;
#pragma unroll
    for (int i = 0; i < 16; ++i) { const float f = wsf[32 + crow(i, hi)]; tot[0][i] += f * o[0][i]; tot[1][i] += f * o[1][i]; }
}
__device__ __forceinline__ void softmax_step(f32x16& p0, f32x16& p1, float& m, float& l, f32x16* o, NLAS float* wsf, int r32, int hi) {
    float t = fmaxf(p0[0], p1[0]);
#pragma unroll
    for (int i = 1; i < 16; ++i) t = fmaxf(t, fmaxf(p0[i], p1[i]));
    t = xhalf_max(t);
    const float mn = fmaxf(m, t);
    const float alpha = __builtin_amdgcn_exp2f(m - mn);
    float s = 0.f;
#pragma unroll
    for (int i = 0; i < 16; ++i) { p0[i] = __builtin_amdgcn_exp2f(p0[i] - mn); p1[i] = __builtin_amdgcn_exp2f(p1[i] - mn); s += p0[i] + p1[i]; }
    l = l * alpha + s; m = mn;
    if (__any(alpha != 1.f)) scale_rows(o, wsf, alpha, r32, hi);
}

__device__ __forceinline__ void attn_tile(NLAS unsigned char* lds, bf16_t* P, const bf16_t* KC, const bf16_t* VC, int b, int g, int qt) {
    int tid = threadIdx.x; asm volatile("" : "+v"(tid));
    const int lane = tid & 63, r32 = lane & 31, hi = lane >> 5; const int wid = __builtin_amdgcn_readfirstlane(tid >> 6);
    const int head = g * 4 + (wid >> 1), qh = wid & 1, t0 = qt * 64, qi = qh * 32 + r32, blk_t = qt;
    NLAS float* wsf = (NLAS float*)(lds + L_WS) + wid * 64;
    NLAS float* imp = (NLAS float*)(lds + L_IMP);
    NLAS unsigned* selm = (NLAS unsigned*)(lds + L_SEL);
    NLAS unsigned char* slot0 = lds + L_KV; NLAS unsigned char* slot1 = lds + L_KV + 16384;
    const size_t rowbase = (size_t)b * SEQ;
    bf16_t* qrow = P + (rowbase + t0 + qi) * LDP;
    const float sl2 = exp2f(-0.5f * (float)(head + 1)) * LOG2E;
    bf16x8 qr[4];
#pragma unroll
    for (int d0 = 0; d0 < 4; ++d0) qr[d0] = *(const bf16x8*)(qrow + C_NQ + head * 64 + d0 * 16 + hi * 8);
    const float gate_c = sigmoidf_(bf2f(qrow[C_SG + head * 3 + 0])), gate_s = sigmoidf_(bf2f(qrow[C_SG + head * 3 + 1])), gate_w = sigmoidf_(bf2f(qrow[C_SG + head * 3 + 2]));
    f32x16 tot[2]; tot[0] = f32x16{}; tot[1] = f32x16{};
#define CRF(i) ((float)(((i) & 3) + 8 * ((i) >> 2)) + 4.f * (float)hiv)
#define OPAQUE_HI() int hiv = hi; asm volatile("" : "+v"(hiv))

    {
        const bf16_t* kcb = KC + ((size_t)(b * NS_G + g) * 128) * 64; const bf16_t* vcb = VC + ((size_t)(b * NS_G + g) * 128) * 64;
        const bool two = (qt >= 16);
        unsigned kof, vof; tile_offs(kof, vof, 64, wid, lane);
        dma_tile(slot0, kcb, vcb, kof, vof, wid);
        if (two) dma_tile(slot1, kcb + 64 * 64, vcb + 64 * 64, kof, vof, wid);
        __syncthreads();
        f32x16 pA0, pA1, pB0, pB1, c0, c1;
        const float s16 = sl2 * 16.f; OPAQUE_HI();
#pragma unroll
        for (int i = 0; i < 16; ++i) { c0[i] = s16 * CRF(i); c1[i] = s16 * (CRF(i) + 32.f); }
        qkt(pA0, pA1, slot0, qr, c0, c1, r32, hi);
        const int cmax = (t0 + qi - 31) >> 4;
        const int qposm = t0 + qi - 31;
#pragma unroll
        for (int i = 0; i < 16; ++i) { const int c = crow(i, hiv); if (16 * c > qposm) pA0[i] = NEG; if (16 * (c + 32) > qposm) pA1[i] = NEG; }
        if (two) {
#pragma unroll
            for (int i = 0; i < 16; ++i) { c0[i] += s16 * 64.f; c1[i] += s16 * 64.f; }
            qkt(pB0, pB1, slot1, qr, c0, c1, r32, hi);
#pragma unroll
            for (int i = 0; i < 16; ++i) { const int c = 64 + crow(i, hiv); if (16 * c > qposm) pB0[i] = NEG; if (16 * (c + 32) > qposm) pB1[i] = NEG; }
        } else { pB0 = f32x16{}; pB1 = f32x16{};
#pragma unroll
            for (int i = 0; i < 16; ++i) { pB0[i] = NEG; pB1[i] = NEG; } }
        (void)cmax;
        float mx = NEG;
#pragma unroll
        for (int i = 0; i < 16; ++i) mx = fmaxf(fmaxf(mx, fmaxf(pA0[i], pA1[i])), fmaxf(pB0[i], pB1[i]));
        mx = xhalf_max(mx);
        float s = 0.f;
#pragma unroll
        for (int i = 0; i < 16; ++i) { pA0[i] = __builtin_amdgcn_exp2f(pA0[i] - mx); pA1[i] = __builtin_amdgcn_exp2f(pA1[i] - mx); pB0[i] = __builtin_amdgcn_exp2f(pB0[i] - mx); pB1[i] = __builtin_amdgcn_exp2f(pB1[i] - mx);
            s += (pA0[i] + pA1[i]) + (pB0[i] + pB1[i]); }
        s = xhalf_sum(s);
        const float nrm = (t0 + qi >= 31) ? __builtin_amdgcn_rcpf(s) : 0.f;
#pragma unroll
        for (int i = 0; i < 16; ++i) { pA0[i] *= nrm; pA1[i] *= nrm; pB0[i] *= nrm; pB1[i] *= nrm; }
#define PSEL(L) ((L) < 4 ? pA0 : (L) < 8 ? pA1 : (L) < 12 ? pB0 : pB1)
#define MAINV(L) ((PSEL(L)[4 * ((L) & 3)] + PSEL(L)[4 * ((L) & 3) + 1]) + (PSEL(L)[4 * ((L) & 3) + 2] + 0.5f * PSEL(L)[4 * ((L) & 3) + 3]))
#define CARRY(L) (0.5f * PSEL(L)[4 * ((L) & 3) + 3])
#pragma unroll
        for (int L = 0; L < 16; ++L) {
            const float cprev = (L > 0) ? CARRY(L > 0 ? L - 1 : 0) : 0.f;
            const float snd = hi ? cprev : CARRY(L);
            const float rcv = __shfl_xor(snd, 32);
            imp[((wid >> 1) * 64 + qi) * 32 + 2 * L + hi] = MAINV(L) + rcv;
        }
#undef PSEL
#undef MAINV
#undef CARRY
        f32x16 o[2]; o[0] = f32x16{}; o[1] = f32x16{};
        pv(o, slot0 + 8192, pA0, pA1, lane, hi);
        if (two) pv(o, slot1 + 8192, pB0, pB1, lane, hi);
        acc_rows(tot, o, wsf, gate_c, r32, hi);
    }
    __syncthreads();
    if (wid == 0) {
        float v[32];
#pragma unroll
        for (int j = 0; j < 32; ++j) v[j] = (imp[(0 * 64 + lane) * 32 + j] + imp[(1 * 64 + lane) * 32 + j]) + (imp[(2 * 64 + lane) * 32 + j] + imp[(3 * 64 + lane) * 32 + j]);
        unsigned mask = 1u | (1u << blk_t);
#pragma unroll 1
        for (int it = 0; it < 6; ++it) {
            float best = -1.f; int bj = -1;
#pragma unroll
            for (int j = 1; j < 32; ++j) { const bool ok = (j < blk_t) && !((mask >> j) & 1u); if (ok && v[j] > best) { best = v[j]; bj = j; } }
            if (bj >= 0) mask |= 1u << bj;
        }
        selm[lane] = mask;
        unsigned any = mask;
#pragma unroll
        for (int o_ = 1; o_ < 64; o_ <<= 1) any |= __shfl_xor(any, o_);
        if (lane == 0) selm[64] = any;
    }
    __syncthreads();
    const unsigned mymask = selm[qi];
    const unsigned anym = (unsigned)__builtin_amdgcn_readfirstlane((int)selm[64]);
    unsigned kofP, vofP; tile_offs(kofP, vofP, LDP, wid, lane);
    {
        const bf16_t* kb = P + rowbase * LDP + C_KS + g * 64; const bf16_t* vb = P + rowbase * LDP + C_VS + g * 64;
        unsigned todo = anym;
        float m = NEG, l = 0.f; f32x16 o[2]; o[0] = f32x16{}; o[1] = f32x16{};
        int j = __builtin_ctz(todo); todo &= todo - 1;
        dma_tile(slot0, kb + (size_t)j * 64 * LDP, vb + (size_t)j * 64 * LDP, kofP, vofP, wid);
        int cur = 0;
        __syncthreads();
        for (;;) {
            const int jn = todo ? __builtin_ctz(todo) : -1; if (todo) todo &= todo - 1;
            NLAS unsigned char* sc = cur ? slot1 : slot0; NLAS unsigned char* sn = cur ? slot0 : slot1;
            if (jn >= 0) dma_tile(sn, kb + (size_t)jn * 64 * LDP, vb + (size_t)jn * 64 * LDP, kofP, vofP, wid);
            const bool mine = (mymask >> j) & 1u;
            if (__any(mine)) {
                f32x16 p0, p1, c0, c1; const float kb0 = sl2 * (float)(j * 64 - t0); OPAQUE_HI();
#pragma unroll
                for (int i = 0; i < 16; ++i) { c0[i] = kb0 + sl2 * CRF(i); c1[i] = c0[i] + sl2 * 32.f; }
                qkt(p0, p1, sc, qr, c0, c1, r32, hi);
                if (j == blk_t) {
#pragma unroll
                    for (int i = 0; i < 16; ++i) { const int kk = crow(i, hiv); if (kk > qi) p0[i] = NEG; if (kk + 32 > qi) p1[i] = NEG; }
                }
                if (!mine) {
#pragma unroll
                    for (int i = 0; i < 16; ++i) { p0[i] = NEG; p1[i] = NEG; }
                }
                softmax_step(p0, p1, m, l, o, wsf, r32, hi);
                pv(o, sc + 8192, p0, p1, lane, hi);
            }
            __syncthreads();
            if (jn < 0) break;
            j = jn; cur ^= 1;
        }
        l = xhalf_sum(l);
        acc_rows(tot, o, wsf, gate_s * __builtin_amdgcn_rcpf(l), r32, hi);
    }
    {
        const bf16_t* kb = P + rowbase * LDP + C_KW + g * 64; const bf16_t* vb = P + rowbase * LDP + C_VW + g * 64;
        float m = NEG, l = 0.f; f32x16 o[2]; o[0] = f32x16{}; o[1] = f32x16{};
        int j = blk_t; const int jlast = blk_t >= 4 ? blk_t - 4 : 0;
        dma_tile(slot0, kb + (size_t)j * 64 * LDP, vb + (size_t)j * 64 * LDP, kofP, vofP, wid);
        int cur = 0;
        __syncthreads();
        for (;;) {
            const int jn = (j > jlast) ? j - 1 : -1;
            NLAS unsigned char* sc = cur ? slot1 : slot0; NLAS unsigned char* sn = cur ? slot0 : slot1;
            if (jn >= 0) dma_tile(sn, kb + (size_t)jn * 64 * LDP, vb + (size_t)jn * 64 * LDP, kofP, vofP, wid);
            {
                f32x16 p0, p1, c0, c1; const float kb0 = sl2 * (float)(j * 64 - t0); OPAQUE_HI();
#pragma unroll
                for (int i = 0; i < 16; ++i) { c0[i] = kb0 + sl2 * CRF(i); c1[i] = c0[i] + sl2 * 32.f; }
                qkt(p0, p1, sc, qr, c0, c1, r32, hi);
                if (j == blk_t || j == blk_t - 4) {
                    const int dq = t0 + qi - j * 64;
#pragma unroll
                    for (int i = 0; i < 16; ++i) { const int d0_ = dq - crow(i, hiv), d1_ = d0_ - 32; if (d0_ < 0 || d0_ > 255) p0[i] = NEG; if (d1_ < 0 || d1_ > 255) p1[i] = NEG; }
                }
                softmax_step(p0, p1, m, l, o, wsf, r32, hi);
                pv(o, sc + 8192, p0, p1, lane, hi);
            }
            __syncthreads();
            if (jn < 0) break;
            j = jn; cur ^= 1;
        }
        l = xhalf_sum(l);
        acc_rows(tot, o, wsf, gate_w * __builtin_amdgcn_rcpf(l), r32, hi);
    }
    {
        NLAS bf16_t* stg = (NLAS bf16_t*)(lds + L_OST) + wid * 2048;
#pragma unroll
        for (int i = 0; i < 16; ++i) { const int orow = crow(i, hi); stg[orow * 64 + r32] = f2bf(tot[0][i]); stg[orow * 64 + 32 + r32] = f2bf(tot[1][i]); }
        bf16_t* ow = P + (rowbase + t0 + qh * 32) * LDP + C_NQ + head * 64;
#pragma unroll
        for (int i = 0; i < 4; ++i) { const int row = i * 8 + (lane >> 3), ch = lane & 7; const u32x4 v = *(NLAS const u32x4*)(stg + row * 64 + ch * 8); *(u32x4*)((char*)ow + (unsigned)(row * LDP + ch * 8) * 2u) = v; }
    }
    __syncthreads();
#undef CRF
#undef OPAQUE_HI
}

__device__ __forceinline__ void norm8(u32x4& v, const float* g8, float sc) {
    float x[8] = {__uint_as_float(v.x << 16), __uint_as_float(v.x & 0xffff0000u), __uint_as_float(v.y << 16), __uint_as_float(v.y & 0xffff0000u),
                  __uint_as_float(v.z << 16), __uint_as_float(v.z & 0xffff0000u), __uint_as_float(v.w << 16), __uint_as_float(v.w & 0xffff0000u)};
    float s = 0.f;
#pragma unroll
    for (int e = 0; e < 8; ++e) s += x[e] * x[e];
    s += __shfl_xor(s, 1); s += __shfl_xor(s, 2); s += __shfl_xor(s, 4);
    const float r = rsqrtf(s * (1.f / 64.f) + EPS) * sc;
    v.x = pk(x[0] * r * g8[0], x[1] * r * g8[1]); v.y = pk(x[2] * r * g8[2], x[3] * r * g8[3]); v.z = pk(x[4] * r * g8[4], x[5] * r * g8[5]); v.w = pk(x[6] * r * g8[6], x[7] * r * g8[7]);
}
__device__ __forceinline__ void prep_units(bf16_t* P, const float* qn, const float* kns, const float* knw, int gw, int NGW, int lane) {
    float gq[8], gk[8];
    const float* kg = (lane < 32) ? kns : knw;
#pragma unroll
    for (int e = 0; e < 8; ++e) { gq[e] = qn[8 * (lane & 7) + e]; gk[e] = kg[8 * (lane & 7) + e]; }
    const int coff = (lane < 32) ? C_KS + 8 * lane : C_KW + 8 * (lane - 32);
    for (int m0 = gw; m0 < M; m0 += 2 * NGW) {
        const int m1 = m0 + NGW; const bool two = m1 < M;
        bf16_t* r0 = P + (size_t)m0 * LDP; bf16_t* r1 = P + (size_t)(two ? m1 : m0) * LDP;
        u32x4 a0 = *(const u32x4*)(r0 + C_NQ + 8 * lane), b0 = *(const u32x4*)(r0 + C_NQ + 512 + 8 * lane), c0 = *(const u32x4*)(r0 + coff);
        u32x4 a1 = *(const u32x4*)(r1 + C_NQ + 8 * lane), b1 = *(const u32x4*)(r1 + C_NQ + 512 + 8 * lane), c1 = *(const u32x4*)(r1 + coff);
        norm8(a0, gq, 0.125f * LOG2E); norm8(b0, gq, 0.125f * LOG2E); norm8(c0, gk, 1.f);
        norm8(a1, gq, 0.125f * LOG2E); norm8(b1, gq, 0.125f * LOG2E); norm8(c1, gk, 1.f);
        *(u32x4*)(r0 + C_NQ + 8 * lane) = a0; *(u32x4*)(r0 + C_NQ + 512 + 8 * lane) = b0; *(u32x4*)(r0 + coff) = c0;
        if (two) { *(u32x4*)(r1 + C_NQ + 8 * lane) = a1; *(u32x4*)(r1 + C_NQ + 512 + 8 * lane) = b1; *(u32x4*)(r1 + coff) = c1; }
    }
}

constexpr int LC_HID = 0;
__device__ __forceinline__ void compress_item(NLAS unsigned char* lds, const bf16_t* P, const bf16_t* W1T, const float* bias1, const float* W2, const float* gain, bf16_t* OUT, int b, int g, int which, int half) {
    const int tid = threadIdx.x, lane = tid & 63, r32 = lane & 31, hi = lane >> 5; const int wid = __builtin_amdgcn_readfirstlane(tid >> 6);
    const int mt = wid >> 2, nt = wid & 3;
    const int c = 64 * half + 32 * mt + r32;
    const int cc = c < NCMP ? c : NCMP - 1;
    const bf16_t* arow = P + ((size_t)b * SEQ + 16 * cc) * LDP + (which ? C_VC : C_KC) + g * 64 + hi * 8;
    const bf16_t* brow = W1T + (size_t)(32 * nt + r32) * 2048 + hi * 8;
    f32x16 acc = f32x16{};
#pragma unroll 4
    for (int l = 0; l < 32; ++l) {
#pragma unroll
        for (int ds = 0; ds < 4; ++ds) {
            const bf16x8 a = *(const bf16x8*)(arow + (size_t)l * LDP + ds * 16);
            const bf16x8 w = *(const bf16x8*)(brow + l * 64 + ds * 16);
            acc = __builtin_amdgcn_mfma_f32_32x32x16_bf16(a, w, acc, 0, 0, 0);
        }
    }
    NLAS float* hid = (NLAS float*)(lds + LC_HID);
    const float bs = bias1[32 * nt + r32];
#pragma unroll
    for (int i = 0; i < 16; ++i) hid[(32 * mt + crow(i, hi)) * 132 + 32 * nt + r32] = gelu_tanh(acc[i] + bs);
    __syncthreads();
    {
        const int row = tid >> 3, e0 = (tid & 7) * 8;
        float o[8];
#pragma unroll
        for (int e = 0; e < 8; ++e) o[e] = 0.f;
        for (int i = 0; i < 128; ++i) { const float h = hid[row * 132 + i]; const f32x4 wa = *(const f32x4*)(W2 + i * 64 + e0), wb = *(const f32x4*)(W2 + i * 64 + e0 + 4);
            o[0] += h * wa[0]; o[1] += h * wa[1]; o[2] += h * wa[2]; o[3] += h * wa[3]; o[4] += h * wb[0]; o[5] += h * wb[1]; o[6] += h * wb[2]; o[7] += h * wb[3]; }
        if (which == 0) {
            float ss = 0.f;
#pragma unroll
            for (int e = 0; e < 8; ++e) ss += o[e] * o[e];
            ss += __shfl_xor(ss, 1); ss += __shfl_xor(ss, 2); ss += __shfl_xor(ss, 4);
            const float r = rsqrtf(ss * (1.f / 64.f) + EPS);
#pragma unroll
            for (int e = 0; e < 8; ++e) o[e] *= r * gain[e0 + e];
        }
        const int cg = 64 * half + row;
        if (cg >= NCMP) {
#pragma unroll
            for (int e = 0; e < 8; ++e) o[e] = 0.f; }
        u32x4 w; w.x = pk(o[0], o[1]); w.y = pk(o[2], o[3]); w.z = pk(o[4], o[5]); w.w = pk(o[6], o[7]);
        *(u32x4*)(OUT + (((size_t)(b * NS_G + g) * 128) + cg) * 64 + e0) = w;
    }
    __syncthreads();
}
}
namespace pg8 {
#define PG8_LAS __attribute__((address_space(3)))
typedef short bf16x8 __attribute__((ext_vector_type(8)));
typedef float f32x4 __attribute__((ext_vector_type(4)));
typedef float f32x2 __attribute__((ext_vector_type(2)));
typedef unsigned u32x4 __attribute__((ext_vector_type(4)));
typedef unsigned u32x2 __attribute__((ext_vector_type(2)));
constexpr int BM = 256, BK = 64, HALF = 128, HTB = HALF * BK * 2, STAGE_BYTES = 8 * HTB, NXCD = 8, WGM = 8;

__host__ __device__ __forceinline__ int lds_byte(int r, int c) { const int st = (r >> 4) * 2 + (c >> 5), rr = r & 15, cc = c & 31, ob = rr * 64 + cc * 2; return st * 1024 + (ob ^ (((ob >> 9) & 1) << 5)); }
__host__ __device__ __forceinline__ void stage_rc(int b, int& R, int& C) { const int st = b / 1024, sb = b % 1024, swz = sb ^ (((sb >> 9) & 1) << 5); R = (st >> 1) * 16 + swz / 64; C = (st & 1) * 32 + (swz % 64) / 2; }
__host__ __device__ __forceinline__ int perm32(int rho) { const int n = rho >> 4, i = rho & 15; return 8 * (i >> 2) + 4 * n + (i & 3); }

struct Unit { int pm, pn, ks; };
struct Gemm { const bf16_t* A; const bf16_t* Bt; int lda, ldb; int M, N, K; int ksoff; };

struct StaticOrder {
    int nM, nN, nwg, G, c;
    __host__ __device__ void init(int M_, int N_, int G_, int c_) { nM = M_ / BM; nN = N_ / BM; nwg = nM * nN; G = G_; c = c_; }
    __host__ __device__ bool next(int i, Unit& u) const {
        const long L = (long)i * G + c; if (L >= nwg) return false;
        int wgid = (int)L; { const int q = nwg / NXCD, r = nwg % NXCD, xcd = wgid % NXCD, off = wgid / NXCD; wgid = (xcd < r ? xcd * (q + 1) : r * (q + 1) + (xcd - r) * q) + off; }
        const int nig = WGM * nN, gid = wgid / nig, fm = gid * WGM, gsz = (nM - fm) < WGM ? (nM - fm) : WGM;
        u.pm = fm + ((wgid % nig) % gsz); u.pn = (wgid % nig) / gsz; u.ks = 0; return true;
    }
};
struct TwoPassOrder {
    StaticOrder base;
    __host__ __device__ bool next(int i, Unit& u) const { if (!base.next(i >> 1, u)) return false; u.ks = i & 1; return true; }
};

typedef __bf16 bf16x2_t __attribute__((ext_vector_type(2)));
__device__ __forceinline__ unsigned cvt_pk_bf16(float lo, float hi) { f32x2 v = {lo, hi}; bf16x2_t b = __builtin_convertvector(v, bf16x2_t); return __builtin_bit_cast(unsigned, b); }
__device__ __forceinline__ float fast_sigmoid(float x) { return __builtin_amdgcn_rcpf(1.f + __builtin_amdgcn_exp2f(-1.4426950408889634f * x)); }
__device__ __forceinline__ float bflo(unsigned w) { return __uint_as_float(w << 16); }
__device__ __forceinline__ float bfhi(unsigned w) { return __uint_as_float(w & 0xffff0000u); }

typedef f32x4 Acc[2][2][4][2];

template <int ACT> struct EpiP {
    static constexpr bool PERM = true;
    bf16_t* O; int ldc; int pn_last; int ncol_last; bf16_t* halo;
    __device__ __forceinline__ void operator()(const Acc& acc, const Unit& u, int wr, int wc, int fr, int fq) const {
        const int row0 = u.pm * BM + wr * 64 + fr, tcol = wc * 32 + 8 * fq;
        const int lim = (u.pn == pn_last) ? ncol_last : 256;
#pragma unroll
        for (int ai = 0; ai < 2; ++ai)
#pragma unroll
            for (int m = 0; m < 4; ++m) { bf16_t* rowp = O + (size_t)(row0 + ai * HALF + m * 16) * ldc + u.pn * BM + tcol;
#pragma unroll
                for (int bj = 0; bj < 2; ++bj) { if (tcol + bj * HALF >= lim) continue;
                    f32x4 v0 = acc[ai][bj][m][0], v1 = acc[ai][bj][m][1];
                    if (ACT == 1) {
#pragma unroll
                        for (int e = 0; e < 4; ++e) { v0[e] = fast_sigmoid(v0[e]); v1[e] = fast_sigmoid(v1[e]); } }
                    u32x4 w; w.x = cvt_pk_bf16(v0[0], v0[1]); w.y = cvt_pk_bf16(v0[2], v0[3]); w.z = cvt_pk_bf16(v1[0], v1[1]); w.w = cvt_pk_bf16(v1[2], v1[3]);
                    *(u32x4*)(rowp + bj * HALF) = w;
                    if (ACT == 0 && m == 3 && fr >= 13 && u.pn < 12 && halo) { const int row = row0 + ai * HALF + 48;
                        *(u32x4*)(halo + ((size_t)(row >> 6) * 3 + (fr - 13)) * 3072 + u.pn * BM + tcol + bj * HALF) = w; } } }
    }
};
struct EpiMix {
    static constexpr bool PERM = true;
    const bf16_t* G; int ldg; bf16_t* O; int ldc;
    __device__ __forceinline__ void operator()(const Acc& acc, const Unit& u, int wr, int wc, int fr, int fq) const {
        const int row0 = u.pm * BM + wr * 64 + fr, col0 = u.pn * BM + wc * 32 + 8 * fq;
#pragma unroll
        for (int ai = 0; ai < 2; ++ai)
#pragma unroll
            for (int m = 0; m < 4; ++m) { const size_t row = (size_t)(row0 + ai * HALF + m * 16); const bf16_t* gp = G + row * ldg + col0 + u.ks * 1024; bf16_t* rowp = O + row * ldc + col0;
#pragma unroll
                for (int bj = 0; bj < 2; ++bj) { const u32x4 b = *(const u32x4*)(gp + bj * HALF);
                    f32x4 v0 = acc[ai][bj][m][0], v1 = acc[ai][bj][m][1];
                    v0[0] *= bflo(b.x); v0[1] *= bfhi(b.x); v0[2] *= bflo(b.y); v0[3] *= bfhi(b.y); v1[0] *= bflo(b.z); v1[1] *= bfhi(b.z); v1[2] *= bflo(b.w); v1[3] *= bfhi(b.w);
                    if (u.ks) { const u32x4 p = *(const u32x4*)(rowp + bj * HALF);
                        v0[0] += bflo(p.x); v0[1] += bfhi(p.x); v0[2] += bflo(p.y); v0[3] += bfhi(p.y); v1[0] += bflo(p.z); v1[1] += bfhi(p.z); v1[2] += bflo(p.w); v1[3] += bfhi(p.w); }
                    u32x4 w; w.x = cvt_pk_bf16(v0[0], v0[1]); w.y = cvt_pk_bf16(v0[2], v0[3]); w.z = cvt_pk_bf16(v1[0], v1[1]); w.w = cvt_pk_bf16(v1[2], v1[3]);
                    *(u32x4*)(rowp + bj * HALF) = w; } }
    }
};
struct EpiOut {
    static constexpr bool PERM = false;
    const float* X; float* X1; bf16_t* An; const float* gain; float* pss;
    __device__ __forceinline__ void operator()(const Acc& acc, const Unit& u, int wr, int wc, int fr, int fq) const {
        const int row0 = u.pm * BM + wr * 64 + fr, col0 = u.pn * BM + wc * 32 + 4 * fq;
        f32x4 gv[2][2];
#pragma unroll
        for (int bj = 0; bj < 2; ++bj)
#pragma unroll
            for (int n = 0; n < 2; ++n) gv[bj][n] = *(const f32x4*)(gain + col0 + bj * HALF + n * 16);
#pragma unroll
        for (int ai = 0; ai < 2; ++ai)
#pragma unroll
            for (int m = 0; m < 4; ++m) { const size_t row = (size_t)(row0 + ai * HALF + m * 16); const size_t off = row * D + col0; float ss = 0.f;
#pragma unroll
                for (int bj = 0; bj < 2; ++bj)
#pragma unroll
                    for (int n = 0; n < 2; ++n) { const f32x4 x1 = *(const f32x4*)(X + off + bj * HALF + n * 16) + acc[ai][bj][m][n];
                        *(f32x4*)(X1 + off + bj * HALF + n * 16) = x1; ss += (x1[0] * x1[0] + x1[1] * x1[1]) + (x1[2] * x1[2] + x1[3] * x1[3]);
                        const f32x4 y = x1 * gv[bj][n]; u32x2 w; w.x = cvt_pk_bf16(y[0], y[1]); w.y = cvt_pk_bf16(y[2], y[3]); *(u32x2*)(An + off + bj * HALF + n * 16) = w; }
                ss += __shfl_xor(ss, 16); ss += __shfl_xor(ss, 32);
                if (fq == 0) pss[row * 16 + u.pn * 4 + wc] = ss; }
    }
};
struct EpiUp {
    static constexpr bool PERM = true;
    const float* pss; bf16_t* O; int ldc;
    __device__ __forceinline__ void operator()(const Acc& acc, const Unit& u, int wr, int wc, int fr, int fq) const {
        const int row0 = u.pm * BM + wr * 64 + fr, col0 = u.pn * BM + wc * 32 + 8 * fq;
#pragma unroll
        for (int ai = 0; ai < 2; ++ai)
#pragma unroll
            for (int m = 0; m < 4; ++m) { const size_t row = (size_t)(row0 + ai * HALF + m * 16);
                const f32x4* pp = (const f32x4*)(pss + row * 16); const f32x4 s4 = (pp[0] + pp[1]) + (pp[2] + pp[3]);
                const float rstd = rsqrtf(((s4[0] + s4[1]) + (s4[2] + s4[3])) * (1.f / D) + EPS);
                bf16_t* rowp = O + row * ldc + col0;
#pragma unroll
                for (int bj = 0; bj < 2; ++bj) { f32x4 v0 = acc[ai][bj][m][0] * rstd, v1 = acc[ai][bj][m][1] * rstd;
#pragma unroll
                    for (int e = 0; e < 4; ++e) { const float a = fmaxf(v0[e], 0.f), b = fmaxf(v1[e], 0.f); v0[e] = a * a; v1[e] = b * b; }
                    u32x4 w; w.x = cvt_pk_bf16(v0[0], v0[1]); w.y = cvt_pk_bf16(v0[2], v0[3]); w.z = cvt_pk_bf16(v1[0], v1[1]); w.w = cvt_pk_bf16(v1[2], v1[3]);
                    *(u32x4*)(rowp + bj * HALF) = w; } }
    }
};
struct EpiDown {
    static constexpr bool PERM = false;
    float* X1;
    __device__ __forceinline__ void operator()(const Acc& acc, const Unit& u, int wr, int wc, int fr, int fq) const {
        const int row0 = u.pm * BM + wr * 64 + fr, col0 = u.pn * BM + wc * 32 + 4 * fq;
#pragma unroll
        for (int ai = 0; ai < 2; ++ai)
#pragma unroll
            for (int m = 0; m < 4; ++m) { float* rowp = X1 + (size_t)(row0 + ai * HALF + m * 16) * D + col0;
#pragma unroll
                for (int bj = 0; bj < 2; ++bj)
#pragma unroll
                    for (int n = 0; n < 2; ++n) { f32x4* p = (f32x4*)(rowp + bj * HALF + n * 16); *p = *p + acc[ai][bj][m][n]; } }
    }
};

template <class Epi, class Sched, bool ALIGN_EPI>
__device__ __forceinline__ void gemm_phase(PG8_LAS unsigned char* lds, const Gemm g, const Sched& S, const Epi& E) {
    const int tid = threadIdx.x, wid = __builtin_amdgcn_readfirstlane(tid >> 6), lane = tid & 63, wr = wid >> 2, wc = wid & 3, fr = lane & 15, fq = lane >> 4;
    const int K = g.K, nt = K / BK, lda = g.lda, ldb = g.ldb;
    unsigned voffA[2], voffB[2];
#pragma unroll
    for (int i = 0; i < 2; ++i) { int R, C; stage_rc(tid * 16 + i * 8192, R, C); const int Rb = Epi::PERM ? ((R & ~31) + perm32(R & 31)) : R;
        voffA[i] = (unsigned)(R * lda + C) * 2u; voffB[i] = (unsigned)(Rb * ldb + C) * 2u; }
    const size_t kstep = (size_t)(BK * 2);
    const size_t hstepA = (size_t)HALF * lda * 2, hstepB = (size_t)HALF * ldb * 2;
    const size_t tstepA = 2 * hstepA, tstepB = 2 * hstepB;
    const unsigned ldsw = (unsigned)wid * 1024u;
    const int aoff = lds_byte(wr * 64 + fr, fq * 8), boff = lds_byte(wc * 32 + fr, fq * 8);
#define PG8_SA(b, h) (((b) * 2 + (h)) * HTB)
#define PG8_SB(b, h) ((4 + (b) * 2 + (h)) * HTB)
#define PG8_STAGE(bufoff, gbase, voff) do { _Pragma("unroll") for (int _i = 0; _i < 2; ++_i) \
        __builtin_amdgcn_global_load_lds((const unsigned*)((const char*)(gbase) + (voff)[_i]), (PG8_LAS unsigned*)(lds + (bufoff) + ldsw + _i * 8192), 16, 0, 0); } while (0)
#define PG8_LDA(dst, b, h) do { _Pragma("unroll") for (int m = 0; m < 4; ++m) _Pragma("unroll") for (int k = 0; k < 2; ++k) dst[m][k] = *(const PG8_LAS bf16x8*)(lds + PG8_SA(b, h) + aoff + m * 2048 + k * 1024); } while (0)
#define PG8_LDB(dst, b, h) do { _Pragma("unroll") for (int n = 0; n < 2; ++n) _Pragma("unroll") for (int k = 0; k < 2; ++k) dst[n][k] = *(const PG8_LAS bf16x8*)(lds + PG8_SB(b, h) + boff + n * 2048 + k * 1024); } while (0)
#define PG8_MMA(ai, bj, At, Bt) do { __builtin_amdgcn_s_setprio(1); _Pragma("unroll") for (int m = 0; m < 4; ++m) _Pragma("unroll") for (int n = 0; n < 2; ++n) _Pragma("unroll") for (int k = 0; k < 2; ++k) \
        acc[ai][bj][m][n] = __builtin_amdgcn_mfma_f32_16x16x32_bf16(Bt[n][k], At[m][k], acc[ai][bj][m][n], 0, 0, 0); __builtin_amdgcn_s_setprio(0); } while (0)
#define PG8_WAIT_V(n) asm volatile("s_waitcnt vmcnt(" #n ")" ::: "memory")
#define PG8_WAIT_L(n) asm volatile("s_waitcnt lgkmcnt(" #n ")" ::: "memory")
#define PG8_BAR __builtin_amdgcn_s_barrier()
#define PG8_SCHED __builtin_amdgcn_sched_barrier(0)
#define PG8_KBODY(t) do { \
            const bool last = (t == nt - 2); \
            const char* a1 = cA + (size_t)(t + 1) * kstep; \
            const char* a2 = last ? nA : cA + (size_t)(t + 2) * kstep; const char* b2 = last ? nB : cB + (size_t)(t + 2) * kstep; \
            const char* a3 = a2 + kstep; const char* b3 = b2 + kstep; \
            PG8_LDB(B0, 0, 0); PG8_LDB(B1, 0, 1); PG8_SCHED; PG8_LDA(At, 0, 0); PG8_STAGE(PG8_SA(1, 1), a1 + hstepA, voffA); \
            PG8_WAIT_V(8); PG8_WAIT_L(0); PG8_BAR; PG8_MMA(0, 0, At, B0); PG8_MMA(0, 1, At, B1); PG8_BAR; PG8_SCHED; \
            PG8_LDA(At, 0, 1); PG8_STAGE(PG8_SB(0, 0), b2, voffB); PG8_STAGE(PG8_SB(0, 1), b2 + hstepB, voffB); PG8_STAGE(PG8_SA(0, 0), a2, voffA); \
            PG8_WAIT_V(8); PG8_WAIT_L(0); PG8_BAR; PG8_MMA(1, 0, At, B0); PG8_MMA(1, 1, At, B1); PG8_BAR; PG8_SCHED; \
            PG8_LDB(B0, 1, 0); PG8_LDB(B1, 1, 1); PG8_SCHED; PG8_LDA(At, 1, 0); PG8_STAGE(PG8_SA(0, 1), a2 + hstepA, voffA); \
            PG8_WAIT_V(8); PG8_WAIT_L(0); PG8_BAR; PG8_MMA(0, 0, At, B0); PG8_MMA(0, 1, At, B1); PG8_BAR; PG8_SCHED; \
            PG8_LDA(At, 1, 1); PG8_STAGE(PG8_SB(1, 0), b3, voffB); PG8_STAGE(PG8_SB(1, 1), b3 + hstepB, voffB); PG8_STAGE(PG8_SA(1, 0), a3, voffA); \
            PG8_WAIT_V(8); PG8_WAIT_L(0); PG8_BAR; PG8_MMA(1, 0, At, B0); PG8_MMA(1, 1, At, B1); PG8_BAR; PG8_SCHED; \
        } while (0)
    Unit cur, nxt; int ui = 0;
    if (!S.next(0, cur)) return;
    Acc acc;
#pragma unroll
    for (int a = 0; a < 2; ++a)
#pragma unroll
        for (int b = 0; b < 2; ++b)
#pragma unroll
            for (int m = 0; m < 4; ++m)
#pragma unroll
                for (int n = 0; n < 2; ++n) acc[a][b][m][n] = (f32x4){0.f, 0.f, 0.f, 0.f};
    bf16x8 At[4][2], B0[2][2], B1[2][2];
    const char* cA = (const char*)g.A + (size_t)cur.pm * tstepA + (size_t)cur.ks * g.ksoff * 2; const char* cB = (const char*)g.Bt + (size_t)cur.pn * tstepB + (size_t)cur.ks * g.ksoff * 2;
    PG8_STAGE(PG8_SB(0, 0), cB, voffB); PG8_STAGE(PG8_SB(0, 1), cB + hstepB, voffB); PG8_STAGE(PG8_SA(0, 0), cA, voffA); PG8_STAGE(PG8_SA(0, 1), cA + hstepA, voffA);
    if (wr == 1) PG8_BAR;
    PG8_WAIT_V(2); PG8_BAR;
    PG8_STAGE(PG8_SB(1, 0), cB + kstep, voffB); PG8_STAGE(PG8_SA(1, 0), cA + kstep, voffA); PG8_STAGE(PG8_SB(1, 1), cB + hstepB + kstep, voffB);
    PG8_WAIT_V(6); PG8_BAR;
    for (;;) {
        const bool has_next = S.next(ui + 1, nxt);
        const char* nA = has_next ? (const char*)g.A + (size_t)nxt.pm * tstepA + (size_t)nxt.ks * g.ksoff * 2 : cA; const char* nB = has_next ? (const char*)g.Bt + (size_t)nxt.pn * tstepB + (size_t)nxt.ks * g.ksoff * 2 : cB;
        for (int t = 0; t < nt; t += 2) PG8_KBODY(t);
        if constexpr (ALIGN_EPI) { if (wr == 0) PG8_BAR; }
        E(acc, cur, wr, wc, fr, fq);
        if (!has_next) break;
#pragma unroll
        for (int a = 0; a < 2; ++a)
#pragma unroll
            for (int b = 0; b < 2; ++b)
#pragma unroll
                for (int m = 0; m < 4; ++m)
#pragma unroll
                    for (int n = 0; n < 2; ++n) acc[a][b][m][n] = (f32x4){0.f, 0.f, 0.f, 0.f};
        cur = nxt; cA = nA; cB = nB; ++ui;
        if constexpr (ALIGN_EPI) { if (wr == 1) PG8_BAR; }
    }
    PG8_WAIT_V(0);
    if constexpr (!ALIGN_EPI) { if (wr == 0) PG8_BAR; }
    PG8_BAR;
#undef PG8_SA
#undef PG8_SB
#undef PG8_STAGE
#undef PG8_LDA
#undef PG8_LDB
#undef PG8_MMA
#undef PG8_WAIT_V
#undef PG8_WAIT_L
#undef PG8_BAR
#undef PG8_SCHED
#undef PG8_KBODY
}
}

#define GAS __attribute__((address_space(1)))
#define LAS __attribute__((address_space(3)))
typedef unsigned v4u __attribute__((ext_vector_type(4)));
typedef float f32x4 __attribute__((ext_vector_type(4)));
constexpr int NWAVES = 8;
constexpr int LDS_BYTES = 147456;
constexpr size_t MiB = 1u << 20;
constexpr size_t WS_PSS = 1 * MiB, WS_WOUT = 2 * MiB, WS_P = 4 * MiB, WS_KC = 214 * MiB, WS_VC = 215 * MiB, WS_MIX = 216 * MiB;
constexpr size_t WS_AN = 4 * MiB, WS_UP = 64 * MiB, WS_WUP = 248 * MiB, WS_WDOWN = 200 * MiB;
constexpr size_t WS_BIAS1 = 0, WS_W1T = 214 * MiB, WS_KCB = 215 * MiB, WS_VCB = 215 * MiB + 512 * 1024;
constexpr size_t WS_GLV = 4096, WS_QCNT = 65536, WS_GW = 216 * MiB, DO_GQK = 40 * MiB, DO_HALO = 56 * MiB;
constexpr size_t WS_XBAR = 131072;
constexpr size_t DO_H = 0, DO_WG = 32 * MiB, DO_WCAT = 36 * MiB, DO_WIN = 40 * MiB;

__device__ __forceinline__ unsigned pk2(float lo, float hi) { return (unsigned)f2bf(lo) | ((unsigned)f2bf(hi) << 16); }
__device__ __forceinline__ float wave_sum(float v) {
#pragma unroll
    for (int o = 1; o < 64; o <<= 1) v += __shfl_xor(v, o);
    return v;
}
template <class SrcCol>
__device__ __forceinline__ void transpose_item(const float* W, int ldw, const SrcCol& srccol, bf16_t* WT, int ldk, int kofs, LAS float* scr, int kb, int nb, int lane) {
    const int k0 = 64 * kb, n0 = 64 * nb; const int n4 = (lane & 15) * 4; const int sc = srccol(n0 + n4);
#pragma unroll 4
    for (int i = 0; i < 16; ++i) { const int kk = 4 * i + (lane >> 4);
        const f32x4 v = (sc >= 0) ? *(const f32x4*)(W + (size_t)(k0 + kk) * ldw + sc) : (f32x4){0.f, 0.f, 0.f, 0.f};
        scr[kk * 65 + n4] = v[0]; scr[kk * 65 + n4 + 1] = v[1]; scr[kk * 65 + n4 + 2] = v[2]; scr[kk * 65 + n4 + 3] = v[3]; }
    asm volatile("s_waitcnt lgkmcnt(0)" ::: "memory");
    const int c = lane & 7;
#pragma unroll
    for (int j = 0; j < 8; ++j) { const int n = (lane >> 3) + 8 * j; const LAS float* sp = scr + (8 * c) * 65 + n;
        v4u o; o.x = pk2(sp[0 * 65], sp[1 * 65]); o.y = pk2(sp[2 * 65], sp[3 * 65]); o.z = pk2(sp[4 * 65], sp[5 * 65]); o.w = pk2(sp[6 * 65], sp[7 * 65]);
        *(v4u*)(WT + (size_t)(n0 + n) * ldk + kofs + k0 + 8 * c) = o; }
    asm volatile("s_waitcnt lgkmcnt(0)" ::: "memory");
}
struct SrcIdent { int off; __device__ __forceinline__ int operator()(int n) const { return n + off; } };
struct SrcWin { __device__ __forceinline__ int operator()(int n) const { return n < 4096 ? n : (n < 6656 ? n + 16 : (n < 6672 ? n - 6656 + 4096 : (n < 6720 ? n : -1))); } };

typedef GAS unsigned gu32;
#define RLX_AGENT __ATOMIC_RELAXED, __HIP_MEMORY_SCOPE_AGENT
#define XB_TMO      128
#define XB_XCNT(j)  (256  + 64 * (j))
#define XB_XSUB(j)  (1280 + 64 * (j))
#define XB_XGEN(j)  (2304 + 64 * (j))
#define XB_TOP      3328
#define XB_TOPGEN   3392
#define XCD_BAR_WORDS 3456
#define XB_SPIN_CAP (1u << 18)

__device__ __forceinline__ unsigned xb_ld(unsigned* p)              { return __hip_atomic_load(p, __ATOMIC_RELAXED, __HIP_MEMORY_SCOPE_AGENT); }
__device__ __forceinline__ unsigned xb_add(unsigned* p, unsigned v) { return __hip_atomic_fetch_add(p, v, __ATOMIC_RELAXED, __HIP_MEMORY_SCOPE_AGENT); }
__device__ __forceinline__ unsigned xb_xcc_id() { return (unsigned)__builtin_amdgcn_s_getreg((3 << 11) | 20) & 0xFu; }
#define XB_SPIN(cond, bar) do { unsigned _sp = 0; while (cond) { __builtin_amdgcn_s_sleep(1); \
    if ((++_sp & 255u) == 0u) { if (xb_ld(&(bar)[XB_TMO])) break; if (_sp > XB_SPIN_CAP) { atomicAdd(&(bar)[XB_TMO], 1u); break; } } } } while (0)

struct XcdBarrier {
    unsigned* bar; unsigned x;
    volatile LAS unsigned* st;
};

__device__ __forceinline__ XcdBarrier xcd_barrier_post(unsigned* bar, volatile LAS unsigned* st) {
    XcdBarrier b; b.bar = bar; b.x = xb_xcc_id(); b.st = st;
    if (threadIdx.x == 0) (void)xb_add(&bar[XB_XCNT(b.x)], 1u);
    return b;
}
__device__ __forceinline__ void xcd_barrier_complete(unsigned* bar, unsigned x, unsigned& nloc, unsigned& nx) {
    const unsigned G = gridDim.x * gridDim.y * gridDim.z;
    unsigned sum, cnt, mine, sp = 0u;
    for (;;) {
        sum = 0u; cnt = 0u; mine = 0u;
#pragma unroll
        for (unsigned j = 0; j < 16; ++j) { const unsigned c = xb_ld(&bar[XB_XCNT(j)]); sum += c; cnt += (c > 0u) ? 1u : 0u; mine = (j == x) ? c : mine; }
        if (sum == G) break;
        __builtin_amdgcn_s_sleep(1);
        if ((++sp & 255u) == 0u) { if (xb_ld(&bar[XB_TMO])) break; if (sp > XB_SPIN_CAP) { atomicAdd(&bar[XB_TMO], 1u); break; } }
    }
    nloc = mine > 0u ? mine : 1u; nx = cnt > 0u ? cnt : 1u;
}

__device__ __forceinline__ void xcd_barrier(const XcdBarrier& b) {
    asm volatile("s_waitcnt vmcnt(0)" ::: "memory");
    __syncthreads();
    if (threadIdx.x == 0) {
        unsigned* bar = b.bar;
        __builtin_amdgcn_s_waitcnt(0);
        unsigned nloc = b.st[0], nx = b.st[1];
        if (nloc == 0u) { xcd_barrier_complete(bar, b.x, nloc, nx); b.st[0] = nloc; b.st[1] = nx; }
        const unsigned old = xb_add(&bar[XB_XSUB(b.x)], 1u);
        const unsigned gen = old / nloc;
        if (old + 1u == (gen + 1u) * nloc) {
            __builtin_amdgcn_fence(__ATOMIC_RELEASE, "agent");
            asm volatile("s_waitcnt vmcnt(0)" ::: "memory");
            const unsigned og = xb_add(&bar[XB_TOP], 1u);
            const unsigned tg = og / nx;
            if (og + 1u == (tg + 1u) * nx) xb_add(&bar[XB_TOPGEN], 1u);
            else XB_SPIN(xb_ld(&bar[XB_TOPGEN]) == tg, bar);
            __builtin_amdgcn_fence(__ATOMIC_ACQUIRE, "agent");
            xb_add(&bar[XB_XGEN(b.x)], 1u);
            asm volatile("s_waitcnt vmcnt(0)" ::: "memory");
        } else {
            XB_SPIN(xb_ld(&bar[XB_XGEN(b.x)]) == gen, bar);
            __builtin_amdgcn_fence(__ATOMIC_ACQUIRE, "agent");
            asm volatile("s_waitcnt vmcnt(0)" ::: "memory");
        }
    }
    __syncthreads();
}


struct Args { const float* in[23]; float* out; unsigned char* ws; int ph_lo, ph_hi; };

__global__ void __launch_bounds__(NWAVES * 64, 2) mk_fwd(Args args) {
    extern __shared__ __attribute__((aligned(16))) unsigned char lds_raw[];
    LAS unsigned char* lds = (LAS unsigned char*)lds_raw;
    __builtin_assume(__builtin_amdgcn_workitem_id_y() == 0); __builtin_assume(__builtin_amdgcn_workitem_id_z() == 0);
    cg::grid_group grid = cg::this_grid();
    const int tid = threadIdx.x, wave = __builtin_amdgcn_readfirstlane(tid >> 6);
#define lane ((int)(threadIdx.x & 63u))
    const int G = gridDim.x, gw = blockIdx.x * NWAVES + wave, NGW = G * NWAVES;
    unsigned char* ws = args.ws; unsigned char* dob = (unsigned char*)args.out;
    const float* x = args.in[0];
    bf16_t* P = (bf16_t*)(ws + WS_P);
    bf16_t* Hb = (bf16_t*)(dob + DO_H); bf16_t* Wg_t = (bf16_t*)(dob + DO_WG); bf16_t* Wcat_t = (bf16_t*)(dob + DO_WCAT); bf16_t* Win_t = (bf16_t*)(dob + DO_WIN);
    bf16_t* Wout_t = (bf16_t*)(ws + WS_WOUT); bf16_t* Wup_t = (bf16_t*)(ws + WS_WUP); bf16_t* Wdown_t = (bf16_t*)(ws + WS_WDOWN);
    bf16_t* Mix = (bf16_t*)(ws + WS_MIX); bf16_t* An = (bf16_t*)(ws + WS_AN); bf16_t* Up = (bf16_t*)(ws + WS_UP); float* pss = (float*)(ws + WS_PSS);
    LAS float* scr = (LAS float*)(lds + wave * 17408);
    bf16_t* Halo = (bf16_t*)(dob + DO_HALO); bf16_t* GWb = (bf16_t*)(ws + WS_GW); bf16_t* GQKb = (bf16_t*)(dob + DO_GQK); float* GLv = (float*)(ws + WS_GLV); unsigned* qcnt = (unsigned*)(ws + WS_QCNT);
    bf16_t* W1T = (bf16_t*)(ws + WS_W1T); float* bias1 = (float*)(ws + WS_BIAS1); bf16_t* KCb = (bf16_t*)(ws + WS_KCB); bf16_t* VCb = (bf16_t*)(ws + WS_VCB);
    const int lo = args.ph_lo, hi = args.ph_hi;
    if (tid < 2) ((volatile LAS unsigned*)(lds + 147456 - 32))[tid] = 0u;
    __syncthreads();
    XcdBarrier xbar = xcd_barrier_post((unsigned*)(ws + WS_XBAR), (volatile LAS unsigned*)(lds + 147456 - 32));
    if (args.ph_hi > 1000) grid.sync();
#ifndef PHMASK
#define PHMASK 0x1ff
#endif
#define IN(k) (((PHMASK >> (k)) & 1) && lo <= (k) && (k) < hi)
#define GRID_SYNC() do { asm volatile("s_waitcnt vmcnt(0) lgkmcnt(0)" ::: "memory"); grid.sync(); \
        if (wave == 0) { __builtin_amdgcn_fence(__ATOMIC_ACQUIRE, "agent"); asm volatile("s_waitcnt vmcnt(0)" ::: "memory"); } __syncthreads(); } while (0)
#if defined(TPROBE)
#define STAMP(k) do { if (blockIdx.x == 0 && tid == 0) ((volatile LAS unsigned long long*)(lds + 147456 - 512))[k] = __builtin_amdgcn_s_memrealtime(); } while (0)
#else
#define STAMP(k) do { } while (0)
#endif
#define SEAM(k) do { if (IN(k) && IN((k) + 1)) xcd_barrier(xbar); STAMP((k) + 1); } while (0)

    STAMP(0);
    if (IN(0)) {
        if (blockIdx.x == 0 && tid == 0) { *qcnt = 0u; ((volatile unsigned*)(ws + 786432))[4] = 0u; }
        constexpr int I_WIN = 16 * (NP1 / 64), I_WG = 16 * 32, I_DN = 16 * 16, I_OUT = 16 * 16, I_UP = 16 * 64;
        constexpr int I_W1 = 32 * 2, I_B1 = 256;
        constexpr int NITEMS = I_WIN + I_WG + 2 * I_DN + I_OUT + I_UP + 2 * I_W1 + I_B1;
        for (int it = gw; it < NITEMS; it += NGW) {
            int r = it;
            if (r < I_WIN) { transpose_item(args.in[2], INW, SrcWin{}, Win_t, D, 0, scr, r / (NP1 / 64), r % (NP1 / 64), lane); continue; } r -= I_WIN;
            if (r < I_WG) { transpose_item(args.in[2], INW, SrcIdent{6720}, Wg_t, D, 0, scr, r / 32, r % 32, lane); continue; } r -= I_WG;
            if (r < I_DN) { transpose_item(args.in[17], D, SrcIdent{0}, Wcat_t, 2 * D, 0, scr, r / 16, r % 16, lane); continue; } r -= I_DN;
            if (r < I_DN) { transpose_item(args.in[18], D, SrcIdent{0}, Wcat_t, 2 * D, D, scr, r / 16, r % 16, lane); continue; } r -= I_DN;
            if (r < I_OUT) { transpose_item(args.in[19], D, SrcIdent{0}, Wout_t, D, 0, scr, r / 16, r % 16, lane); continue; } r -= I_OUT;
            if (r < I_UP) { transpose_item(args.in[21], FF, SrcIdent{0}, Wup_t, D, 0, scr, r / 64, r % 64, lane); continue; } r -= I_UP;
            if (r < I_W1) { transpose_item(args.in[12], 128, SrcIdent{0}, W1T, 2048, 0, scr, r / 2, r % 2, lane); continue; } r -= I_W1;
            if (r < I_W1) { transpose_item(args.in[15], 128, SrcIdent{0}, W1T + 128 * 2048, 2048, 0, scr, r / 2, r % 2, lane); continue; } r -= I_W1;
            {
                const int which = r >> 7, i = r & 127; const float* pos = args.in[which ? 14 : 11]; const float* w1 = args.in[which ? 15 : 12];
                float a = 0.f;
                for (int k = lane; k < 2048; k += 64) a += pos[k] * w1[(size_t)k * 128 + i];
                a = wave_sum(a);
                if (lane == 0) bias1[r] = a;
            }
        }
        const float* gain = args.in[1];
        f32x4 gv[4];
#pragma unroll
        for (int j = 0; j < 4; ++j) gv[j] = ((const f32x4*)gain)[lane + 64 * j];
        for (int m = gw; m < M; m += NGW) {
            const f32x4* xr = (const f32x4*)(x + (size_t)m * D) + lane;
            f32x4 v[4]; float s = 0.f;
#pragma unroll
            for (int j = 0; j < 4; ++j) { v[j] = xr[64 * j]; s += (v[j].x * v[j].x + v[j].y * v[j].y) + (v[j].z * v[j].z + v[j].w * v[j].w); }
            const float rstd = rsqrtf(wave_sum(s) * (1.f / D) + EPS);
            unsigned long long* o8 = (unsigned long long*)(Hb + (size_t)m * D) + lane;
#pragma unroll
            for (int j = 0; j < 4; ++j) { const f32x4 y = v[j] * rstd * gv[j]; o8[64 * j] = (unsigned long long)pk2(y.x, y.y) | ((unsigned long long)pk2(y.z, y.w) << 32); }
        }
    }
    SEAM(0);
    if (IN(1)) {
        pg8::Gemm g{Hb, Win_t, D, D, M, NP1, D, 0}; pg8::StaticOrder S; S.init(M, NP1, G, (int)blockIdx.x);
        pg8::EpiP<0> E{P, LDP, 26, 64, Halo};
        pg8::gemm_phase<pg8::EpiP<0>, pg8::StaticOrder, true>(lds, g, S, E);
    }
    SEAM(1);
    if (IN(2)) {
        for (int it = (G == 256) ? (((int)blockIdx.x & 1) ? 128 : (int)blockIdx.x >> 1) : (int)blockIdx.x; it < 128; it += G) {
            const int half = it & 1, which = (it >> 1) & 1, g_ = (it >> 2) & 3, b_ = it >> 4;
            nsa::compress_item(lds, P, W1T + (size_t)which * 128 * 2048, bias1 + which * 128, args.in[which ? 16 : 13], args.in[8], which ? VCb : KCb, b_, g_, which, half);
        }
        STAMP(11);
        nsa::prep_units(P, args.in[7], args.in[9], args.in[10], gw, NGW, lane);
        STAMP(12);
#if !defined(GDN_NAIVE)
        __syncthreads();
        {
            gdn::RowPre pre; int hl = -1;
            const int c_ = (int)blockIdx.x, hq = c_ >> 5, jq = c_ & 31;
            const bool bal = (G == 256);
            const int cnt = bal ? ((jq & 1) ? 10 : 6) : (2048 - c_ + G - 1) / G;
            const int first = bal ? ((jq & 1) ? 96 + 10 * (jq >> 1) : 6 * (jq >> 1)) : 0;
#define PREP_COORD(k, b_, n_, h_) do { if (bal) { const int idx_ = first + (k); b_ = idx_ >> 5; n_ = idx_ & 31; h_ = hq; } else { const int it_ = c_ + (k) * G; b_ = it_ >> 8; n_ = it_ & 31; h_ = (it_ >> 5) & 7; } } while (0)
            int b0, n0, h0;
            if (cnt > 0) { PREP_COORD(0, b0, n0, h0); gdn::prep_prefetch(pre, P, Halo, b0, n0, h0, wave, lane); }
            for (int k = 0; k < cnt; ++k) {
                int bc, nc, hc, bn = -1, nn = 0, hn = 0;
                PREP_COORD(k, bc, nc, hc);
                if (k + 1 < cnt) PREP_COORD(k + 1, bn, nn, hn);
                if (hc != hl) { __syncthreads(); gdn::prep_load_taps(lds, args.in[3], hc); hl = hc; __syncthreads(); }
                gdn::prep_item(lds, P, Halo, args.in[4], args.in[5], GWb, GQKb, GLv, pre, bc, nc, hc, bn, nn, hn);
                if (k == 0) STAMP(14);
            }
#undef PREP_COORD
        }
        STAMP(13);
#endif
    }
    SEAM(2);
    if (IN(3)) {
#if defined(GDN_NAIVE)
        if ((int)blockIdx.x < 16) gdn_naive::run(lds, P, args.in[3], args.in[4], args.in[5], args.in[6], 4 * (int)blockIdx.x);
#else
        if ((int)blockIdx.x < 64) gdn::scan_item(lds, P, GWb, GQKb, GLv, args.in[6], (int)blockIdx.x >> 3, (int)blockIdx.x & 7);
#endif
        __syncthreads();
        STAMP(10);
        for (;;) {
            volatile LAS unsigned* qslot = (volatile LAS unsigned*)(lds + 147456 - 16);
            if (tid == 0) *qslot = atomicAdd(qcnt, 1u);
            __syncthreads();
            const int idx = (int)*qslot;
            __syncthreads();
            if (idx >= 1024) break;
#if defined(TPROBE)
            if (blockIdx.x == 200 && tid == 0) { ((volatile unsigned long long*)(ws + 786432))[0] = __builtin_amdgcn_s_memrealtime(); ((volatile unsigned*)(ws + 786432))[4] += 1u; }
#endif
            nsa::attn_tile(lds, P, KCb, VCb, (idx & 31) >> 2, idx & 3, 31 - (idx >> 5));
        }
    }
    SEAM(3);
    if (IN(4)) {
        pg8::Gemm g{Hb, Wg_t, D, D, M, 2048, D, 0}; pg8::StaticOrder S; S.init(M, 2048, G, (int)blockIdx.x);
        pg8::EpiP<1> E{P, LDP, -1, 256, nullptr};
        pg8::gemm_phase<pg8::EpiP<1>, pg8::StaticOrder, true>(lds, g, S, E);
    }
    SEAM(4);
    if (IN(5)) {
        pg8::Gemm g{P + C_DZ, Wcat_t, LDP, 2 * D, M, D, D, D}; pg8::TwoPassOrder S; S.base.init(M, D, G, (int)blockIdx.x);
        pg8::EpiMix E{P, LDP, Mix, D};
        pg8::gemm_phase<pg8::EpiMix, pg8::TwoPassOrder, false>(lds, g, S, E);
    }
    SEAM(5);
    if (IN(6)) {
        for (int it = gw; it < 64 * 16; it += NGW) transpose_item(args.in[22], D, SrcIdent{0}, Wdown_t, FF, 0, scr, it / 16, it % 16, lane);
        __syncthreads();
        pg8::Gemm g{Mix, Wout_t, D, D, M, D, D, 0}; pg8::StaticOrder S; S.init(M, D, G, (int)blockIdx.x);
        pg8::EpiOut E{x, args.out, An, args.in[20], pss};
        pg8::gemm_phase<pg8::EpiOut, pg8::StaticOrder, false>(lds, g, S, E);
    }
    SEAM(6);
    if (IN(7)) {
        pg8::Gemm g{An, Wup_t, D, D, M, FF, D, 0}; pg8::StaticOrder S; S.init(M, FF, G, (int)blockIdx.x);
        pg8::EpiUp E{pss, Up, FF};
        pg8::gemm_phase<pg8::EpiUp, pg8::StaticOrder, true>(lds, g, S, E);
    }
    SEAM(7);
    if (IN(8)) {
        pg8::Gemm g{Up, Wdown_t, FF, FF, M, D, FF, 0}; pg8::StaticOrder S; S.init(M, D, G, (int)blockIdx.x);
        pg8::EpiDown E{args.out};
        pg8::gemm_phase<pg8::EpiDown, pg8::StaticOrder, false>(lds, g, S, E);
    }
#if defined(TPROBE)
    STAMP(9);
    GRID_SYNC();
    if (blockIdx.x == 0) {
        volatile LAS unsigned long long* ts = (volatile LAS unsigned long long*)(lds + 147456 - 512);
        if (tid == 0) { ts[25] = ((volatile unsigned long long*)(ws + 786432))[0]; ts[26] = ts[3] + 100ull * ((volatile unsigned*)(ws + 786432))[4]; }
        const float dA = (float)(ts[TPA1] - ts[TPA0]) * 0.01f, dB = (float)(ts[TPB1] - ts[TPB0]) * 0.01f;
        if (tid == 0) args.out[0] = dA + 0.f * dB;
    }
#endif
#undef IN
#undef SEAM
#undef GRID_SYNC
}

#undef lane
static int g_grid = 0;
static void launch_mk(const Args& a0, int lo, int hi, hipStream_t stream) {
    Args a = a0; a.ph_lo = lo; a.ph_hi = hi;
    void* kargs[] = {(void*)&a};
    hipError_t e = hipLaunchCooperativeKernel((const void*)mk_fwd, dim3(g_grid), dim3(NWAVES * 64), kargs, LDS_BYTES, stream);
    if (e != hipSuccess) fprintf(stderr, "cooperative launch failed: %s (grid %d)\n", hipGetErrorString(e), g_grid);
}

extern "C" void kernel_launch(void* const* d_in, const int* in_sizes, int n_in, void* d_out, int out_size, void* d_ws, size_t ws_size, hipStream_t stream) {
    if (g_grid == 0) {
        int dev = 0, cus = 0, per_cu = 0;
        hipGetDevice(&dev);
        hipDeviceGetAttribute(&cus, hipDeviceAttributeMultiprocessorCount, dev);
        hipFuncSetAttribute((const void*)mk_fwd, hipFuncAttributeMaxDynamicSharedMemorySize, LDS_BYTES);
        hipOccupancyMaxActiveBlocksPerMultiprocessor(&per_cu, (const void*)mk_fwd, NWAVES * 64, LDS_BYTES);
        if (per_cu < 1) per_cu = 1;
        if (per_cu > 1) per_cu = 1;
        g_grid = cus * per_cu;
    }
    Args a{};
    for (int i = 0; i < 23; ++i) a.in[i] = (const float*)d_in[i];
    a.out = (float*)d_out; a.ws = (unsigned char*)d_ws;
    bf16_t* P = (bf16_t*)((char*)d_ws + WS_P);
    hipMemsetAsync((char*)d_ws + WS_XBAR, 0, XCD_BAR_WORDS * 4, stream);
    launch_mk(a, 0, 9, stream);
}
```

```cpp
#include <hip/hip_runtime.h>
#include <hip/hip_cooperative_groups.h>
#include <stdint.h>
#include <cstdio>
namespace cg = cooperative_groups;

typedef unsigned short bf16_t;

constexpr int D = 1024, BATCH = 8, SEQ = 2048, M = BATCH * SEQ;
constexpr int DN_H = 8, DN_D = 128;
constexpr int NS_H = 16, NS_G = 4, NS_R = 4, NS_D = 64;
constexpr int NCMP = 127, NSEL = 32;
constexpr int FF = 4096;
constexpr int INW = 8768;
constexpr float EPS = 1e-6f;
constexpr float NEGV = -1e30f, FORCEV = 1e9f;

constexpr int LDP = 6720;
constexpr int C_DQ = 0, C_DK = 1024, C_DV = 2048, C_DZ = 3072, C_NQ = 4096;
constexpr int C_KC = 5120, C_VC = 5376, C_KS = 5632, C_VS = 5888, C_KW = 6144, C_VW = 6400;
constexpr int C_SB = 6656, C_SA = 6664, C_SG = 6672;
constexpr int NP1 = 6912;

__device__ __forceinline__ float bf2f(bf16_t v) { return __uint_as_float(((unsigned)v) << 16); }
__device__ __forceinline__ bf16_t f2bf(float f) { unsigned u = __float_as_uint(f); return (bf16_t)((u + 0x7fffu + ((u >> 16) & 1u)) >> 16); }
__device__ __forceinline__ float sigmoidf_(float x) { return 1.f / (1.f + __expf(-x)); }
__device__ __forceinline__ float siluf_(float x) { return x * sigmoidf_(x); }
__device__ __forceinline__ float softplusf_(float x) { return fmaxf(x, 0.f) + log1pf(__expf(-fabsf(x))); }
__device__ __forceinline__ float gelu_tanh(float x) { return 0.5f * x * (1.f + tanhf(0.7978845608028654f * (x + 0.044715f * x * x * x))); }

__device__ __forceinline__ float block_sum(float v, float* red) {
    for (int o = 32; o > 0; o >>= 1) v += __shfl_xor(v, o);
    const int w = threadIdx.x >> 6, nw = blockDim.x >> 6;
    __syncthreads();
    if ((threadIdx.x & 63) == 0) red[w] = v;
    __syncthreads();
    float s = 0.f;
    for (int i = 0; i < nw; ++i) s += red[i];
    return s;
}
__device__ __forceinline__ float block_max(float v, float* red) {
    for (int o = 32; o > 0; o >>= 1) v = fmaxf(v, __shfl_xor(v, o));
    const int w = threadIdx.x >> 6, nw = blockDim.x >> 6;
    __syncthreads();
    if ((threadIdx.x & 63) == 0) red[w] = v;
    __syncthreads();
    float s = red[0];
    for (int i = 1; i < nw; ++i) s = fmaxf(s, red[i]);
    return s;
}


#if defined(TPROBE)
#define XSTAMP(k) do { if (blockIdx.x == 0 && threadIdx.x == 0) ((volatile __attribute__((address_space(3))) unsigned long long*)(lds + 147456 - 512))[k] = __builtin_amdgcn_s_memrealtime(); } while (0)
#else
#define XSTAMP(k) do { } while (0)
#endif
namespace gdn_naive {
#define GLAS __attribute__((address_space(3)))
__device__ __forceinline__ float sub_sum(float v, GLAS float* red, int sub, int tid) {
#pragma unroll
    for (int o = 32; o > 0; o >>= 1) v += __shfl_xor(v, o);
    __syncthreads();
    if ((tid & 63) == 0) red[sub * 2 + ((tid >> 6) & 1)] = v;
    __syncthreads();
    return red[sub * 2] + red[sub * 2 + 1];
}
__device__ __forceinline__ void run(GLAS unsigned char* lds, bf16_t* P, const float* convw, const float* a_log, const float* dt_bias, const float* out_norm, int item0) {
    const int tid = threadIdx.x, sub = tid >> 7, j = tid & 127;
    GLAS float* qs = (GLAS float*)lds + sub * 256; GLAS float* ks = qs + 128; GLAS float* red = (GLAS float*)(lds + 4096);
    const int item = item0 + sub; const int b = item / DN_H, h = item % DN_H;
    float s[128];
#pragma unroll
    for (int i = 0; i < 128; ++i) s[i] = 0.f;
    const float Ah = -__expf(a_log[h]), dtb = dt_bias[h], gn = out_norm[j];
    const float scale = 0.08838834764831845f;
    float wq[4], wk[4], wv[4], xq[3] = {0.f, 0.f, 0.f}, xk[3] = {0.f, 0.f, 0.f}, xv[3] = {0.f, 0.f, 0.f};
#pragma unroll
    for (int t = 0; t < 4; ++t) { wq[t] = convw[t * 3072 + h * 128 + j]; wk[t] = convw[t * 3072 + 1024 + h * 128 + j]; wv[t] = convw[t * 3072 + 2048 + h * 128 + j]; }
    for (int t = 0; t < SEQ; ++t) {
        bf16_t* row = P + (size_t)(b * SEQ + t) * LDP;
        const float rq = bf2f(row[C_DQ + h * DN_D + j]), rk = bf2f(row[C_DK + h * DN_D + j]), rv = bf2f(row[C_DV + h * DN_D + j]);
        float q = siluf_(wq[0] * xq[0] + wq[1] * xq[1] + wq[2] * xq[2] + wq[3] * rq);
        float k = siluf_(wk[0] * xk[0] + wk[1] * xk[1] + wk[2] * xk[2] + wk[3] * rk);
        const float v = siluf_(wv[0] * xv[0] + wv[1] * xv[1] + wv[2] * xv[2] + wv[3] * rv);
        xq[0] = xq[1]; xq[1] = xq[2]; xq[2] = rq; xk[0] = xk[1]; xk[1] = xk[2]; xk[2] = rk; xv[0] = xv[1]; xv[1] = xv[2]; xv[2] = rv;
        const float sq = sub_sum(q * q, red, sub, tid);
        const float sk = sub_sum(k * k, red, sub, tid);
        q *= rsqrtf(sq + EPS); k *= rsqrtf(sk + EPS);
        qs[j] = q; ks[j] = k;
        const float beta = sigmoidf_(bf2f(row[C_SB + h]));
        const float a = __expf(Ah * softplusf_(bf2f(row[C_SA + h]) + dtb));
        const float z = bf2f(row[C_DZ + h * DN_D + j]);
        __syncthreads();
        float kS = 0.f;
#pragma unroll
        for (int i = 0; i < 128; ++i) kS += ks[i] * s[i];
        const float dlt = beta * (v - a * kS);
        asm volatile("" ::: "memory");
        float o = 0.f;
#pragma unroll
        for (int i = 0; i < 128; ++i) { s[i] = a * s[i] + ks[i] * dlt; o += qs[i] * s[i]; }
        o *= scale;
        const float ss = sub_sum(o * o, red, sub, tid);
        row[C_DZ + h * DN_D + j] = f2bf(o * rsqrtf(ss * (1.f / 128.f) + EPS) * gn * siluf_(z));
    }
}
}
namespace gdn {
#define GL3 __attribute__((address_space(3)))
typedef short bf16x8 __attribute__((ext_vector_type(8)));
typedef short s16x4 __attribute__((ext_vector_type(4)));
typedef short v4i16_t __attribute__((ext_vector_type(4)));
typedef float f32x16 __attribute__((ext_vector_type(16)));
typedef float f32x4 __attribute__((ext_vector_type(4)));
typedef float f32x2 __attribute__((ext_vector_type(2)));
typedef unsigned u32x4 __attribute__((ext_vector_type(4)));
typedef unsigned u32x2 __attribute__((ext_vector_type(2)));
typedef __bf16 bf16x2_t __attribute__((ext_vector_type(2)));
constexpr float QSCALE = 0.08838834764831845f;
__device__ __forceinline__ float fsig(float x) { return __builtin_amdgcn_rcpf(1.f + __builtin_amdgcn_exp2f(-1.4426950408889634f * x)); }
__device__ __forceinline__ float fsilu(float x) { return x * fsig(x); }
__device__ __forceinline__ int crow(int i, int hi) { return (i & 3) + 8 * (i >> 2) + 4 * hi; }
__device__ __forceinline__ unsigned pk(float lo, float hi) { f32x2 v = {lo, hi}; bf16x2_t b = __builtin_convertvector(v, bf16x2_t); return __builtin_bit_cast(unsigned, b); }
__device__ __forceinline__ bf16x8 pack8(const float* v) { u32x4 w = {pk(v[0], v[1]), pk(v[2], v[3]), pk(v[4], v[5]), pk(v[6], v[7])}; return __builtin_bit_cast(bf16x8, w); }
__device__ __forceinline__ float blo(unsigned w) { return __uint_as_float(w << 16); }
__device__ __forceinline__ float bhi(unsigned w) { return __uint_as_float(w & 0xffff0000u); }
__device__ __forceinline__ char* seg_addr(bf16_t* P, size_t row0, int c0, unsigned e) { return (char*)P + ((row0 + (e >> 8)) * LDP + c0) * 2 + (e & 255u); }

__device__ __forceinline__ s16x4 vtr(GL3 const unsigned char* p) { return __builtin_bit_cast(s16x4, __builtin_amdgcn_ds_read_tr16_b64_v4i16((GL3 v4i16_t*)p)); }

constexpr int PL_K = 0, PL_KB = 16384, PL_Q = 32768, PL_RV = 49152, PL_AM = 81920, PL_INV = 99328, PL_MT = 116736, PL_GC = 120832, PL_QKST = 121088, PL_TI = 129280, PL_CW = 137472, PL_END = 143616;
constexpr int PL_WST = 0, PL_UST = 16384;
constexpr int AMLD = 68;
struct RowPre { u32x4 x[2][3][4]; unsigned short lb, la; };
__device__ __forceinline__ void prep_prefetch(RowPre& pre, const bf16_t* P, const bf16_t* HALO, int b, int n, int h, int wid, int lane) {
    const size_t row0 = (size_t)b * SEQ + 64 * n; const int dc = lane & 15;
    const bf16_t* prow = P + (row0 + lane) * LDP;
    pre.lb = prow[C_SB + h]; pre.la = prow[C_SA + h];
#pragma unroll
    for (int pass = 0; pass < 2; ++pass) {
        const int tok = 8 * wid + 4 * pass + (lane >> 4);
#pragma unroll
        for (int which = 0; which < 3; ++which) {
            const int col = which * 1024 + h * 128 + dc * 8;
#pragma unroll
            for (int j = 0; j < 4; ++j) {
                const int rr = tok - 3 + j; const bool inb = rr >= 0;
                const bf16_t* src = inb ? (P + (row0 + (inb ? rr : 0)) * LDP + col) : (HALO + ((size_t)((b * 32 + (n > 0 ? n - 1 : 0)) * 3 + (inb ? 0 : 3 + rr))) * 3072 + col);
                pre.x[pass][which][j] = *(const u32x4*)src;
            }
        }
    }
}
__device__ __forceinline__ void prep_load_taps(GL3 unsigned char* lds, const float* convw, int h) {
    GL3 float* cw = (GL3 float*)(lds + 137472);
    for (int e = threadIdx.x; e < 1536; e += 512) { const int which = e >> 9, j = (e >> 7) & 3, c = e & 127; cw[e] = convw[j * 3072 + which * 1024 + h * 128 + c]; }
}
#define PBAR() do { asm volatile("s_waitcnt lgkmcnt(0)" ::: "memory"); __builtin_amdgcn_s_barrier(); asm volatile("" ::: "memory"); } while (0)
__device__ __forceinline__ void prep_item(GL3 unsigned char* lds, bf16_t* P, const bf16_t* HALO, const float* a_log, const float* dt_bias,
                                          bf16_t* GW, bf16_t* GQK, float* GLv, RowPre& pre, int b, int n, int h, int nb_, int nn_, int nh_) {
    int tid = threadIdx.x; asm volatile("" : "+v"(tid));
    const int lane = tid & 63, r32 = lane & 31, hi = lane >> 5; const int wid = __builtin_amdgcn_readfirstlane(tid >> 6);
    const size_t row0 = (size_t)b * SEQ + 64 * n; const int item = (b * DN_H + h) * 32 + n;
    GL3 float* AM = (GL3 float*)(lds + PL_AM); GL3 float* INV = (GL3 float*)(lds + PL_INV); GL3 float* MT = (GL3 float*)(lds + PL_MT); GL3 float* GC = (GL3 float*)(lds + PL_GC);
    float gcum, beta_l, gc_last;
    {
        beta_l = fsig(bf2f(pre.lb));
        { const float xs = bf2f(pre.la) + dt_bias[h]; gcum = -__expf(a_log[h]) * (fmaxf(xs, 0.f) + __logf(1.f + __expf(-fabsf(xs)))); }
#pragma unroll
        for (int o = 1; o < 64; o <<= 1) { const float t = __shfl_up(gcum, o); if (lane >= o) gcum += t; }
        gc_last = __shfl(gcum, 63);
        if (wid == 0) GC[lane] = gcum;
    }
    bf16x8 qd_keep[2], ke_keep[2];
    const int dc = lane & 15;
#pragma unroll
    for (int pass = 0; pass < 2; ++pass) {
        const int tok = 8 * wid + 4 * pass + (lane >> 4);
        const float gct = __shfl(gcum, tok), bet = __shfl(beta_l, tok);
        float y[3][8];
#pragma unroll
        for (int which = 0; which < 3; ++which) {
#pragma unroll
            for (int e = 0; e < 8; ++e) y[which][e] = 0.f;
#pragma unroll
            for (int j = 0; j < 4; ++j) {
                const int rr = tok - 3 + j;
                u32x4 x = pre.x[pass][which][j];
                if (rr < 0 && n == 0) x = (u32x4){0u, 0u, 0u, 0u};
                const f32x4 w0 = *(GL3 const f32x4*)(lds + PL_CW + ((which * 4 + j) * 128 + dc * 8) * 4), w1 = *(GL3 const f32x4*)(lds + PL_CW + ((which * 4 + j) * 128 + dc * 8 + 4) * 4);
                y[which][0] += w0[0] * blo(x.x); y[which][1] += w0[1] * bhi(x.x); y[which][2] += w0[2] * blo(x.y); y[which][3] += w0[3] * bhi(x.y);
                y[which][4] += w1[0] * blo(x.z); y[which][5] += w1[1] * bhi(x.z); y[which][6] += w1[2] * blo(x.w); y[which][7] += w1[3] * bhi(x.w);
            }
#pragma unroll
            for (int e = 0; e < 8; ++e) y[which][e] = fsilu(y[which][e]);
        }
        float sq = 0.f, sk = 0.f;
#pragma unroll
        for (int e = 0; e < 8; ++e) { sq += y[0][e] * y[0][e]; sk += y[1][e] * y[1][e]; }
#pragma unroll
        for (int o = 1; o < 16; o <<= 1) { sq += __shfl_xor(sq, o); sk += __shfl_xor(sk, o); }
        const float rq = rsqrtf(sq + EPS), rk = rsqrtf(sk + EPS);
        const float eg = __expf(gct), ke_s = __expf(gc_last - gct);
        float q8[8], k8[8], kb8[8], qd8[8], ke8[8], kbg8[8], vb8[8];
#pragma unroll
        for (int e = 0; e < 8; ++e) { q8[e] = y[0][e] * rq; k8[e] = y[1][e] * rk; kb8[e] = k8[e] * bet; qd8[e] = q8[e] * (QSCALE * eg); ke8[e] = k8[e] * ke_s; kbg8[e] = kb8[e] * eg; vb8[e] = y[2][e] * bet; }
        const int io = (dc * 64 + tok) * 16;
        *(GL3 bf16x8*)(lds + PL_Q + io) = pack8(q8); *(GL3 bf16x8*)(lds + PL_K + io) = pack8(k8); *(GL3 bf16x8*)(lds + PL_KB + io) = pack8(kb8);
        {
            const int rvo = (tok >> 4) * 1024 + ((tok >> 3) & 1) * 512 + (tok & 7) * 64 + (dc & 3) * 16;
            *(GL3 bf16x8*)(lds + PL_RV + (dc >> 2) * 4096 + rvo) = pack8(kbg8); *(GL3 bf16x8*)(lds + PL_RV + (4 + (dc >> 2)) * 4096 + rvo) = pack8(vb8);
        }
        qd_keep[pass] = pack8(qd8); ke_keep[pass] = pack8(ke8);
    }
    PBAR();
    if (nb_ >= 0) prep_prefetch(pre, P, HALO, nb_, nn_, nh_, wid, lane);
    if (n == 0 && b == 0 && h == 0) XSTAMP(15);
#pragma unroll
    for (int pass = 0; pass < 2; ++pass) {
        const int tok = 8 * wid + 4 * pass + (lane >> 4);
        *(bf16x8*)seg_addr(P, row0, C_DQ + h * 128, (unsigned)((dc * 64 + tok) * 16)) = qd_keep[pass];
        const unsigned ek = (unsigned)(((dc >> 2) * 4 + (tok >> 4)) * 1024 + ((tok >> 3) & 1) * 512 + (tok & 7) * 64 + (dc & 3) * 16);
        *(bf16x8*)seg_addr(P, row0, C_DK + h * 128, ek) = ke_keep[pass];
    }
    if (wid < 6) {
        const bool isA = wid < 3; const int t3 = isA ? wid : wid - 3;
        const int rt = isA ? (t3 > 0) : (t3 == 2);
        const int ct = isA ? (t3 == 2) : (t3 > 0);
        GL3 const unsigned char* aimg = lds + (isA ? PL_KB : PL_K); GL3 const unsigned char* bimg = lds + (isA ? PL_K : PL_Q);
        f32x16 acc = f32x16{};
#pragma unroll
        for (int s = 0; s < 8; ++s) {
            const bf16x8 a = *(GL3 const bf16x8*)(aimg + ((2 * s + hi) * 64 + 32 * rt + r32) * 16);
            const bf16x8 bb = *(GL3 const bf16x8*)(bimg + ((2 * s + hi) * 64 + 32 * ct + r32) * 16);
            acc = __builtin_amdgcn_mfma_f32_32x32x16_bf16(a, bb, acc, 0, 0, 0);
        }
        if (isA) {
            const int j = 32 * ct + r32; const float gj = GC[j];
#pragma unroll
            for (int i_ = 0; i_ < 16; ++i_) { const int i = 32 * rt + crow(i_, hi); AM[i * AMLD + j] = (j < i) ? acc[i_] * __expf(GC[i] - gj) : 0.f; }
        } else {
            const int i = 32 * ct + r32; const float gi = GC[i];
            float v[16];
#pragma unroll
            for (int i_ = 0; i_ < 16; ++i_) { const int j = 32 * rt + crow(i_, hi); v[i_] = (j <= i) ? acc[i_] * (QSCALE * __expf(gi - GC[j])) : 0.f; }
#pragma unroll
            for (int sp = 0; sp < 2; ++sp) *(GL3 bf16x8*)(lds + PL_QKST + (((2 * rt + sp) * 64 + i) * 16 + 8 * hi) * 2) = pack8(v + 8 * sp);
        }
    } else if (wid == 6) {
        const bf16x8 z = {0, 0, 0, 0, 0, 0, 0, 0};
#pragma unroll
        for (int sp = 0; sp < 2; ++sp) *(GL3 bf16x8*)(lds + PL_QKST + (((2 + sp) * 64 + r32) * 16 + 8 * hi) * 2) = z;
    }
    PBAR();
    if (wid < 4 && lane < 16) {
        const int bb = wid, c = lane;
        float x[16];
#pragma unroll
        for (int i = 0; i < 16; ++i) {
            float acc = (i == c) ? 1.f : 0.f;
#pragma unroll
            for (int j4 = 0; j4 < i; j4 += 4) { const f32x4 a = *(GL3 const f32x4*)(AM + (16 * bb + i) * AMLD + 16 * bb + j4);
                acc -= a[0] * x[j4]; if (j4 + 1 < i) acc -= a[1] * x[j4 + 1]; if (j4 + 2 < i) acc -= a[2] * x[j4 + 2]; if (j4 + 3 < i) acc -= a[3] * x[j4 + 3]; }
            x[i] = acc;
        }
#pragma unroll
        for (int i = 0; i < 16; ++i) INV[(16 * bb + i) * AMLD + 16 * bb + c] = x[i];
    }
    PBAR();
    for (int L = 1; L < 4; ++L) {
        const int nb = 4 - L;
        for (int t = tid; t < nb * 256; t += 512) {
            const int J = t >> 8, I = J + L, ei = (t >> 4) & 15, ej = t & 15;
            float acc = 0.f;
            for (int K = J; K < I; ++K) {
#pragma unroll
                for (int k4 = 0; k4 < 16; k4 += 4) { const f32x4 a = *(GL3 const f32x4*)(AM + (16 * I + ei) * AMLD + 16 * K + k4);
                    acc += a[0] * INV[(16 * K + k4) * AMLD + 16 * J + ej] + a[1] * INV[(16 * K + k4 + 1) * AMLD + 16 * J + ej] + a[2] * INV[(16 * K + k4 + 2) * AMLD + 16 * J + ej] + a[3] * INV[(16 * K + k4 + 3) * AMLD + 16 * J + ej]; }
            }
            MT[(J * 16 + ei) * 17 + ej] = acc;
        }
        PBAR();
        for (int t = tid; t < nb * 256; t += 512) {
            const int J = t >> 8, I = J + L, ei = (t >> 4) & 15, ej = t & 15;
            float acc = 0.f;
#pragma unroll
            for (int k4 = 0; k4 < 16; k4 += 4) { const f32x4 d = *(GL3 const f32x4*)(INV + (16 * I + ei) * AMLD + 16 * I + k4);
                acc += d[0] * MT[(J * 16 + k4) * 17 + ej] + d[1] * MT[(J * 16 + k4 + 1) * 17 + ej] + d[2] * MT[(J * 16 + k4 + 2) * 17 + ej] + d[3] * MT[(J * 16 + k4 + 3) * 17 + ej]; }
            INV[(16 * I + ei) * AMLD + 16 * J + ej] = -acc;
        }
        PBAR();
    }
    {
        const int s_ = tid >> 7, i = (tid >> 1) & 63, hh = tid & 1;
        float v[8];
        if (s_ > (i >> 4)) {
#pragma unroll
            for (int e = 0; e < 8; ++e) v[e] = 0.f;
        } else {
            const f32x4 a = *(GL3 const f32x4*)(INV + i * AMLD + 16 * s_ + 4 * hh), c4 = *(GL3 const f32x4*)(INV + i * AMLD + 16 * s_ + 8 + 4 * hh);
            v[0] = a[0]; v[1] = a[1]; v[2] = a[2]; v[3] = a[3]; v[4] = c4[0]; v[5] = c4[1]; v[6] = c4[2]; v[7] = c4[3];
        }
        *(GL3 bf16x8*)(lds + PL_TI + ((s_ * 64 + i) * 16 + 8 * hh) * 2) = pack8(v);
    }
    PBAR();
    {
        const int cb = wid;
        GL3 const unsigned char* rp = lds + PL_RV + cb * 4096 + ((lane >> 4) & 1) * 32 + (lane & 3) * 8 + (4 * hi + ((lane & 15) >> 2)) * 64;
        f32x16 d0 = f32x16{}, d1 = f32x16{};
#pragma unroll
        for (int ks = 0; ks < 4; ++ks) {
            const s16x4 lo = vtr(rp + ks * 1024), hh2 = vtr(rp + ks * 1024 + 512);
            const bf16x8 rf = {lo[0], lo[1], lo[2], lo[3], hh2[0], hh2[1], hh2[2], hh2[3]};
            const bf16x8 t1 = *(GL3 const bf16x8*)(lds + PL_TI + ((ks * 64 + 32 + r32) * 16 + 8 * hi) * 2);
            if (cb < 4) {
                if (ks < 2) { const bf16x8 t0 = *(GL3 const bf16x8*)(lds + PL_TI + ((ks * 64 + r32) * 16 + 8 * hi) * 2); d0 = __builtin_amdgcn_mfma_f32_32x32x16_bf16(rf, t0, d0, 0, 0, 0); }
                d1 = __builtin_amdgcn_mfma_f32_32x32x16_bf16(rf, t1, d1, 0, 0, 0);
            } else {
                if (ks < 2) { const bf16x8 t0 = *(GL3 const bf16x8*)(lds + PL_TI + ((ks * 64 + r32) * 16 + 8 * hi) * 2); d0 = __builtin_amdgcn_mfma_f32_32x32x16_bf16(t0, rf, d0, 0, 0, 0); }
                d1 = __builtin_amdgcn_mfma_f32_32x32x16_bf16(t1, rf, d1, 0, 0, 0);
            }
        }
        PBAR();
        if (cb < 4) {
#pragma unroll
            for (int a = 0; a < 4; ++a) {
                u32x2 w0 = {pk(d0[4 * a], d0[4 * a + 1]), pk(d0[4 * a + 2], d0[4 * a + 3])}, w1 = {pk(d1[4 * a], d1[4 * a + 1]), pk(d1[4 * a + 2], d1[4 * a + 3])};
                *(GL3 u32x2*)(lds + PL_WST + ((4 * cb + a) * 64 + r32) * 16 + 8 * hi) = w0;
                *(GL3 u32x2*)(lds + PL_WST + ((4 * cb + a) * 64 + 32 + r32) * 16 + 8 * hi) = w1;
            }
        } else {
            const int dvc = 32 * (cb - 4) + r32;
#pragma unroll
            for (int i = 0; i < 16; ++i) { *(GL3 bf16_t*)(lds + PL_UST + (crow(i, hi) * 128 + dvc) * 2) = f2bf(d0[i]); *(GL3 bf16_t*)(lds + PL_UST + ((32 + crow(i, hi)) * 128 + dvc) * 2) = f2bf(d1[i]); }
        }
    }
    PBAR();
#pragma unroll
    for (int k = 0; k < 2; ++k) {
        const int e = (tid + 512 * k) * 16;
        *(u32x4*)((char*)(GW + (size_t)item * 8192) + e) = *(GL3 const u32x4*)(lds + PL_WST + e);
        *(u32x4*)seg_addr(P, row0, C_DV + h * 128, (unsigned)e) = *(GL3 const u32x4*)(lds + PL_UST + e);
    }
    *(u32x4*)((char*)(GQK + (size_t)item * 4096) + tid * 16) = *(GL3 const u32x4*)(lds + PL_QKST + tid * 16);
    if (tid == 0) GLv[item] = __expf(gc_last);
    PBAR();
}

#undef PBAR
constexpr int SL_W = 0, SL_QD = 16384, SL_KE = 32768, SL_QK = 49152, SL_U = 57344, SL_Z = 73728, SL_S = 90112, SL_VN = 122880, SL_RS = 139264, SL_END = 140416;
__device__ __forceinline__ void glds16(const void* gsrc, unsigned lds_dst) { unsigned keep;
    asm volatile("s_mov_b32 %0, m0\n\ts_mov_b32 m0, %2\n\ts_nop 0\n\tglobal_load_lds_dwordx4 %1, off\n\ts_mov_b32 m0, %0" : "=&s"(keep) : "v"(gsrc), "s"(lds_dst) : "memory"); }
__device__ __forceinline__ unsigned lds_addr(GL3 unsigned char* p) { return (unsigned)(size_t)p; }
__device__ __forceinline__ void dma_seg(GL3 unsigned char* dst, const bf16_t* P, size_t row0, int c0, int wid, int lane) {
#pragma unroll
    for (int k = 0; k < 2; ++k) { const int piece = wid + 8 * k;
        const char* src = (const char*)P + ((row0 + piece * 4 + (lane >> 4)) * LDP + c0) * 2 + (lane & 15) * 16;
        glds16(src, (unsigned)__builtin_amdgcn_readfirstlane((int)(lds_addr(dst) + piece * 1024))); }
}
template <int NPIECES>
__device__ __forceinline__ void dma_lin(GL3 unsigned char* dst, const bf16_t* src, int wid, int lane) {
#pragma unroll
    for (int k = 0; k < NPIECES / 8; ++k) { const int piece = wid + 8 * k;
        glds16((const char*)src + piece * 1024 + lane * 16, (unsigned)__builtin_amdgcn_readfirstlane((int)(lds_addr(dst) + piece * 1024))); }
}

__device__ __forceinline__ float sum32(float v) {
    v += __builtin_bit_cast(float, __builtin_amdgcn_mov_dpp(__builtin_bit_cast(int, v), 0xB1, 0xF, 0xF, true));
    v += __builtin_bit_cast(float, __builtin_amdgcn_mov_dpp(__builtin_bit_cast(int, v), 0x4E, 0xF, 0xF, true));
    v += __builtin_bit_cast(float, __builtin_amdgcn_mov_dpp(__builtin_bit_cast(int, v), 0x141, 0xF, 0xF, true));
    v += __builtin_bit_cast(float, __builtin_amdgcn_mov_dpp(__builtin_bit_cast(int, v), 0x140, 0xF, 0xF, true));
    v += __shfl_xor(v, 16);
    return v;
}
#define GRAWBAR() do { asm volatile("s_waitcnt lgkmcnt(0)" ::: "memory"); __builtin_amdgcn_s_barrier(); asm volatile("" ::: "memory"); } while (0)
#define GWAITV0() asm volatile("s_waitcnt vmcnt(0)" ::: "memory")
constexpr int SL_GL = SL_RS + 1024;
__device__ __forceinline__ void scan_item(GL3 unsigned char* lds, bf16_t* P, const bf16_t* GW, const bf16_t* GQK, const float* GLv, const float* out_norm, int b, int h) {
    const int tid = threadIdx.x, lane = tid & 63, r32 = lane & 31, hi = lane >> 5; const int wid = __builtin_amdgcn_readfirstlane(tid >> 6);
    const int mt = wid >> 2, nt = wid & 3;
    const int dv = 32 * nt + r32;
    const int item0 = (b * DN_H + h) * 32; const size_t rowb = (size_t)b * SEQ;
    f32x16 S0 = f32x16{}, S1 = f32x16{};
    {
        const u32x4 z = {0u, 0u, 0u, 0u};
#pragma unroll
        for (int k = 0; k < 4; ++k) *(GL3 u32x4*)(lds + SL_S + (tid + 512 * k) * 16) = z;
        if (tid < 32) *(GL3 float*)(lds + SL_GL + tid * 4) = GLv[item0 + tid];
    }
    const float gain = out_norm[dv];
    GL3 float* RS = (GL3 float*)(lds + SL_RS);
#define ISSUE_A(n_) do { dma_lin<16>(lds + SL_W, GW + (size_t)(item0 + (n_)) * 8192, wid, lane); dma_seg(lds + SL_QD, P, rowb + 64 * (n_), C_DQ + h * 128, wid, lane); dma_seg(lds + SL_U, P, rowb + 64 * (n_), C_DV + h * 128, wid, lane); } while (0)
#define ISSUE_B(n_) do { dma_seg(lds + SL_KE, P, rowb + 64 * (n_), C_DK + h * 128, wid, lane); dma_lin<8>(lds + SL_QK, GQK + (size_t)(item0 + (n_)) * 4096, wid, lane); dma_seg(lds + SL_Z, P, rowb + 64 * (n_), C_DZ + h * 128, wid, lane); } while (0)
    GWAITV0();
    ISSUE_A(0);
    for (int n = 0; n < 32; ++n) {
        if (n == 6) XSTAMP(26);
        const size_t row0 = rowb + 64 * n;
        if (n == 5) XSTAMP(18);
        GWAITV0(); GRAWBAR();
        if (n == 5) XSTAMP(19);
        ISSUE_B(n);
        const float gl = *(GL3 const float*)(lds + SL_GL + n * 4);
        f32x16 vp = f32x16{}, o = f32x16{};
#pragma unroll
        for (int s = 0; s < 8; ++s) {
            const bf16x8 sb = *(GL3 const bf16x8*)(lds + SL_S + ((2 * s + hi) * 128 + dv) * 16);
            const bf16x8 wa = *(GL3 const bf16x8*)(lds + SL_W + ((2 * s + hi) * 64 + 32 * mt + r32) * 16);
            const bf16x8 qa = *(GL3 const bf16x8*)(lds + SL_QD + ((2 * s + hi) * 64 + 32 * mt + r32) * 16);
            vp = __builtin_amdgcn_mfma_f32_32x32x16_bf16(wa, sb, vp, 0, 0, 0);
            o = __builtin_amdgcn_mfma_f32_32x32x16_bf16(qa, sb, o, 0, 0, 0);
        }
        {
            float v[16];
#pragma unroll
            for (int i = 0; i < 16; ++i) v[i] = bf2f(*(GL3 const bf16_t*)(lds + SL_U + ((32 * mt + crow(i, hi)) * 128 + dv) * 2)) - vp[i];
#pragma unroll
            for (int sp = 0; sp < 2; ++sp) *(GL3 bf16x8*)(lds + SL_VN + (((2 * mt + sp) * 128 + dv) * 16 + 8 * hi) * 2) = pack8(v + 8 * sp);
        }
        if (n == 5) XSTAMP(20);
        GWAITV0(); GRAWBAR();
        if (n == 5) XSTAMP(21);
        if (n + 1 < 32) ISSUE_A(n + 1);
#pragma unroll
        for (int i = 0; i < 16; ++i) { S0[i] *= gl; S1[i] *= gl; }
        {
            GL3 const unsigned char* kp0 = lds + SL_KE + (2 * mt) * 4096 + ((lane >> 4) & 1) * 32 + (lane & 3) * 8 + (4 * hi + ((lane & 15) >> 2)) * 64;
#pragma unroll
            for (int ks = 0; ks < 4; ++ks) {
                const bf16x8 vb = *(GL3 const bf16x8*)(lds + SL_VN + ((ks * 128 + dv) * 16 + 8 * hi) * 2);
                const s16x4 l0 = vtr(kp0 + ks * 1024), h0 = vtr(kp0 + ks * 1024 + 512), l1 = vtr(kp0 + 4096 + ks * 1024), h1 = vtr(kp0 + 4096 + ks * 1024 + 512);
                const bf16x8 k0 = {l0[0], l0[1], l0[2], l0[3], h0[0], h0[1], h0[2], h0[3]}, k1 = {l1[0], l1[1], l1[2], l1[3], h1[0], h1[1], h1[2], h1[3]};
                const bf16x8 qa = *(GL3 const bf16x8*)(lds + SL_QK + ((ks * 64 + 32 * mt + r32) * 16 + 8 * hi) * 2);
                S0 = __builtin_amdgcn_mfma_f32_32x32x16_bf16(k0, vb, S0, 0, 0, 0);
                S1 = __builtin_amdgcn_mfma_f32_32x32x16_bf16(k1, vb, S1, 0, 0, 0);
                o = __builtin_amdgcn_mfma_f32_32x32x16_bf16(qa, vb, o, 0, 0, 0);
            }
        }
#pragma unroll
        for (int i = 0; i < 16; ++i) { const float q = sum32(o[i] * o[i]); if (r32 == 0) RS[(32 * mt + crow(i, hi)) * 4 + nt] = q; }
        if (n == 5) XSTAMP(22);
        GRAWBAR();
        if (n == 5) XSTAMP(23);
#pragma unroll
        for (int a = 0; a < 4; ++a) {
            u32x2 w0 = {pk(S0[4 * a], S0[4 * a + 1]), pk(S0[4 * a + 2], S0[4 * a + 3])}, w1 = {pk(S1[4 * a], S1[4 * a + 1]), pk(S1[4 * a + 2], S1[4 * a + 3])};
            *(GL3 u32x2*)(lds + SL_S + ((4 * (2 * mt) + a) * 128 + dv) * 16 + 8 * hi) = w0;
            *(GL3 u32x2*)(lds + SL_S + ((4 * (2 * mt + 1) + a) * 128 + dv) * 16 + 8 * hi) = w1;
        }
#pragma unroll
        for (int i = 0; i < 16; ++i) { const int tok = 32 * mt + crow(i, hi);
            const f32x4 rs = *(GL3 const f32x4*)(RS + tok * 4);
            const float rstd = rsqrtf(((rs[0] + rs[1]) + (rs[2] + rs[3])) * (1.f / 128.f) + EPS);
            const float z = bf2f(*(GL3 const bf16_t*)(lds + SL_Z + (tok * 128 + dv) * 2));
            *(GL3 bf16_t*)(lds + SL_VN + (tok * 128 + dv) * 2) = f2bf(o[i] * rstd * gain * siluf_(z)); }
        if (n == 5) XSTAMP(24);
        GRAWBAR();
        if (n == 5) XSTAMP(25);
#pragma unroll
        for (int k = 0; k < 2; ++k) { const int e = (tid + 512 * k) * 16; *(u32x4*)seg_addr(P, row0, C_DZ + h * 128, (unsigned)e) = *(GL3 const u32x4*)(lds + SL_VN + e); }
    }
    GWAITV0();
    __syncthreads();
#undef ISSUE_A
#undef ISSUE_B
}
}
namespace nsa {
#define NLAS __attribute__((address_space(3)))
typedef short bf16x8 __attribute__((ext_vector_type(8)));
typedef short s16x4 __attribute__((ext_vector_type(4)));
typedef short v4i16_t __attribute__((ext_vector_type(4)));
typedef float f32x16 __attribute__((ext_vector_type(16)));
typedef float f32x4 __attribute__((ext_vector_type(4)));
typedef float f32x2 __attribute__((ext_vector_type(2)));
typedef unsigned u32x4 __attribute__((ext_vector_type(4)));
typedef __bf16 bf16x2_t __attribute__((ext_vector_type(2)));
constexpr float LOG2E = 1.4426950408889634f;
constexpr float NEG = -1e30f;
constexpr int L_KV = 0;
constexpr int L_IMP = 32768;
constexpr int L_SEL = 66560;
constexpr int L_WS = 67072;
constexpr int L_OST = 69120;
constexpr int L_END = 101888;

__device__ __forceinline__ int crow(int i, int hi) { return (i & 3) + 8 * (i >> 2) + 4 * hi; }
__device__ __forceinline__ unsigned pk(float lo, float hi) { f32x2 v = {lo, hi}; bf16x2_t b = __builtin_convertvector(v, bf16x2_t); return __builtin_bit_cast(unsigned, b); }
__device__ __forceinline__ float xhalf_max(float v) { auto rr = __builtin_amdgcn_permlane32_swap(__float_as_uint(v), __float_as_uint(v), false, false); return fmaxf(__uint_as_float(rr[0]), __uint_as_float(rr[1])); }
__device__ __forceinline__ float xhalf_sum(float v) { auto rr = __builtin_amdgcn_permlane32_swap(__float_as_uint(v), __float_as_uint(v), false, false); return __uint_as_float(rr[0]) + __uint_as_float(rr[1]); }

__device__ __forceinline__ void dma_tile(NLAS unsigned char* slot, const bf16_t* Kb, const bf16_t* Vb, unsigned koff, unsigned voff, int wid) {
    __builtin_amdgcn_global_load_lds((const unsigned*)((const char*)Kb + koff), (NLAS unsigned*)(slot + wid * 1024), 16, 0, 0);
    __builtin_amdgcn_global_load_lds((const unsigned*)((const char*)Vb + voff), (NLAS unsigned*)(slot + 8192 + wid * 1024), 16, 0, 0);
}
__device__ __forceinline__ void tile_offs(unsigned& koff, unsigned& voff, int pitch, int wid, int lane) {
    koff = (unsigned)(lane * pitch + wid * 8) * 2u;
    voff = (unsigned)((16 * (wid & 3) + (lane >> 2)) * pitch + (wid >> 2) * 32 + (lane & 3) * 8) * 2u;
}
__device__ __forceinline__ void qkt(f32x16& p0, f32x16& p1, NLAS const unsigned char* Kslot, const bf16x8* qr, const f32x16& c0, const f32x16& c1, int r32, int hi) {
    NLAS const unsigned char* kb = Kslot + hi * 1024 + r32 * 16;
#pragma unroll
    for (int d0 = 0; d0 < 4; ++d0) {
        const bf16x8 b0 = *(NLAS const bf16x8*)(kb + d0 * 2048);
        const bf16x8 b1 = *(NLAS const bf16x8*)(kb + d0 * 2048 + 512);
        if (d0 == 0) { p0 = __builtin_amdgcn_mfma_f32_32x32x16_bf16(b0, qr[0], c0, 0, 0, 0); p1 = __builtin_amdgcn_mfma_f32_32x32x16_bf16(b1, qr[0], c1, 0, 0, 0); }
        else { p0 = __builtin_amdgcn_mfma_f32_32x32x16_bf16(b0, qr[d0], p0, 0, 0, 0); p1 = __builtin_amdgcn_mfma_f32_32x32x16_bf16(b1, qr[d0], p1, 0, 0, 0); }
    }
}
__device__ __forceinline__ s16x4 vtr(NLAS const unsigned char* p) { return __builtin_bit_cast(s16x4, __builtin_amdgcn_ds_read_tr16_b64_v4i16((NLAS v4i16_t*)p)); }
__device__ __forceinline__ void pv(f32x16* o, NLAS const unsigned char* Vslot, const f32x16& p0, const f32x16& p1, int lane, int hi) {
    u32x4 w0 = {pk(p0[0], p0[1]), pk(p0[2], p0[3]), pk(p0[4], p0[5]), pk(p0[6], p0[7])};
    u32x4 w1 = {pk(p0[8], p0[9]), pk(p0[10], p0[11]), pk(p0[12], p0[13]), pk(p0[14], p0[15])};
    u32x4 w2 = {pk(p1[0], p1[1]), pk(p1[2], p1[3]), pk(p1[4], p1[5]), pk(p1[6], p1[7])};
    u32x4 w3 = {pk(p1[8], p1[9]), pk(p1[10], p1[11]), pk(p1[12], p1[13]), pk(p1[14], p1[15])};
    const bf16x8 pa[4] = {__builtin_bit_cast(bf16x8, w0), __builtin_bit_cast(bf16x8, w1), __builtin_bit_cast(bf16x8, w2), __builtin_bit_cast(bf16x8, w3)};
    NLAS const unsigned char* vp = Vslot + ((lane >> 4) & 1) * 32 + (lane & 3) * 8 + (4 * hi + ((lane & 15) >> 2)) * 64;
#pragma unroll
    for (int d0 = 0; d0 < 2; ++d0)
#pragma unroll
        for (int ks = 0; ks < 4; ++ks) {
            const s16x4 lo = vtr(vp + d0 * 4096 + ks * 1024), hh = vtr(vp + d0 * 4096 + ks * 1024 + 512);
            const bf16x8 vf = {lo[0], lo[1], lo[2], lo[3], hh[0], hh[1], hh[2], hh[3]};
            o[d0] = __builtin_amdgcn_mfma_f32_32x32x16_bf16(pa[ks], vf, o[d0], 0, 0, 0);
        }
}
__device__ __forceinline__ void scale_rows(f32x16* o, NLAS float* wsf, float s, int r32, int hi) {
    if (hi == 0) wsf[r32] = s;
#pragma unroll
    for (int i = 0; i < 16; ++i) { const float f = wsf[crow(i, hi)]; o[0][i] *= f; o[1][i] *= f; }
}
__device__ __forceinline__ void acc_rows(f32x16* tot, const f32x16* o, NLAS float* wsf, float s, int r32, int hi) {
    if (hi == 0) wsf[32 + r32] = s;
#pragma unroll
    for (int i = 0; i < 16; ++i) { const float f = wsf[32 + crow(i, hi)]; tot[0][i] += f * o[0][i]; tot[1][i] += f * o[1][i]; }
}
__device__ __forceinline__ void softmax_step(f32x16& p0, f32x16& p1, float& m, float& l, f32x16* o, NLAS float* wsf, int r32, int hi) {
    float t = fmaxf(p0[0], p1[0]);
#pragma unroll
    for (int i = 1; i < 16; ++i) t = fmaxf(t, fmaxf(p0[i], p1[i]));
    t = xhalf_max(t);
    if (__any(t - m > 8.f)) {
        const float mn = fmaxf(m, t);
        const float alpha = __builtin_amdgcn_exp2f(m - mn);
        l *= alpha; m = mn;
        scale_rows(o, wsf, alpha, r32, hi);
    }
    float s = 0.f;
#pragma unroll
    for (int i = 0; i < 16; ++i) { p0[i] = __builtin_amdgcn_exp2f(p0[i] - m); p1[i] = __builtin_amdgcn_exp2f(p1[i] - m); s += p0[i] + p1[i]; }
    l += s;
}

__device__ __forceinline__ void attn_tile(NLAS unsigned char* lds, bf16_t* P, const bf16_t* KC, const bf16_t* VC, int b, int g, int qt) {
    int tid = threadIdx.x; asm volatile("" : "+v"(tid));
    const int lane = tid & 63, r32 = lane & 31, hi = lane >> 5; const int wid = __builtin_amdgcn_readfirstlane(tid >> 6);
    const int head = g * 4 + (wid >> 1), qh = wid & 1, t0 = qt * 64, qi = qh * 32 + r32, blk_t = qt;
    NLAS float* wsf = (NLAS float*)(lds + L_WS) + wid * 64;
    NLAS float* imp = (NLAS float*)(lds + L_IMP);
    NLAS unsigned* selm = (NLAS unsigned*)(lds + L_SEL);
    NLAS unsigned char* slot0 = lds + L_KV; NLAS unsigned char* slot1 = lds + L_KV + 16384;
    const size_t rowbase = (size_t)b * SEQ;
    bf16_t* qrow = P + (rowbase + t0 + qi) * LDP;
    const float sl2 = exp2f(-0.5f * (float)(head + 1)) * LOG2E;
    bf16x8 qr[4];
#pragma unroll
    for (int d0 = 0; d0 < 4; ++d0) qr[d0] = *(const bf16x8*)(qrow + C_NQ + head * 64 + d0 * 16 + hi * 8);
#define FSIG(x) __builtin_amdgcn_rcpf(1.f + __builtin_amdgcn_exp2f(-LOG2E * (x)))
    const float gate_c = FSIG(bf2f(qrow[C_SG + head * 3 + 0])), gate_s = FSIG(bf2f(qrow[C_SG + head * 3 + 1])), gate_w = FSIG(bf2f(qrow[C_SG + head * 3 + 2]));
#undef FSIG
    f32x16 tot[2]; tot[0] = f32x16{}; tot[1] = f32x16{};
    XSTAMP(30);
#define CRF(i) ((float)(((i) & 3) + 8 * ((i) >> 2)) + 4.f * (float)hiv)
#define OPAQUE_HI() int hiv = hi; asm volatile("" : "+v"(hiv))

    {
        const bf16_t* kcb = KC + ((size_t)(b * NS_G + g) * 128) * 64; const bf16_t* vcb = VC + ((size_t)(b * NS_G + g) * 128) * 64;
        const bool two = (qt >= 16);
        unsigned kof, vof; tile_offs(kof, vof, 64, wid, lane);
        dma_tile(slot0, kcb, vcb, kof, vof, wid);
        if (two) dma_tile(slot1, kcb + 64 * 64, vcb + 64 * 64, kof, vof, wid);
        __syncthreads();
        f32x16 pA0, pA1, pB0, pB1, c0, c1;
        const float s16 = sl2 * 16.f; OPAQUE_HI();
#pragma unroll
        for (int i = 0; i < 16; ++i) { c0[i] = s16 * CRF(i); c1[i] = s16 * (CRF(i) + 32.f); }
        qkt(pA0, pA1, slot0, qr, c0, c1, r32, hi);
        const int cmax = (t0 + qi - 31) >> 4;
        const int qposm = t0 + qi - 31;
#pragma unroll
        for (int i = 0; i < 16; ++i) { const int c = crow(i, hiv); if (16 * c > qposm) pA0[i] = NEG; if (16 * (c + 32) > qposm) pA1[i] = NEG; }
        if (two) {
#pragma unroll
            for (int i = 0; i < 16; ++i) { c0[i] += s16 * 64.f; c1[i] += s16 * 64.f; }
            qkt(pB0, pB1, slot1, qr, c0, c1, r32, hi);
#pragma unroll
            for (int i = 0; i < 16; ++i) { const int c = 64 + crow(i, hiv); if (16 * c > qposm) pB0[i] = NEG; if (16 * (c + 32) > qposm) pB1[i] = NEG; }
        } else { pB0 = f32x16{}; pB1 = f32x16{}; }
        (void)cmax;
        float mx = NEG;
#pragma unroll
        for (int i = 0; i < 16; ++i) mx = fmaxf(mx, fmaxf(pA0[i], pA1[i]));
        if (two) {
#pragma unroll
            for (int i = 0; i < 16; ++i) mx = fmaxf(mx, fmaxf(pB0[i], pB1[i])); }
        mx = xhalf_max(mx);
        float s = 0.f;
#pragma unroll
        for (int i = 0; i < 16; ++i) { pA0[i] = __builtin_amdgcn_exp2f(pA0[i] - mx); pA1[i] = __builtin_amdgcn_exp2f(pA1[i] - mx); s += pA0[i] + pA1[i]; }
        if (two) {
#pragma unroll
            for (int i = 0; i < 16; ++i) { pB0[i] = __builtin_amdgcn_exp2f(pB0[i] - mx); pB1[i] = __builtin_amdgcn_exp2f(pB1[i] - mx); s += pB0[i] + pB1[i]; } }
        s = xhalf_sum(s);
        const float nrm = (t0 + qi >= 31) ? __builtin_amdgcn_rcpf(s) : 0.f;
#pragma unroll
        for (int i = 0; i < 16; ++i) { pA0[i] *= nrm; pA1[i] *= nrm; }
        if (two) {
#pragma unroll
            for (int i = 0; i < 16; ++i) { pB0[i] *= nrm; pB1[i] *= nrm; } }
#define PSEL(L) ((L) < 4 ? pA0 : (L) < 8 ? pA1 : (L) < 12 ? pB0 : pB1)
#define MAINV(L) ((PSEL(L)[4 * ((L) & 3)] + PSEL(L)[4 * ((L) & 3) + 1]) + (PSEL(L)[4 * ((L) & 3) + 2] + 0.5f * PSEL(L)[4 * ((L) & 3) + 3]))
#define CARRY(L) (0.5f * PSEL(L)[4 * ((L) & 3) + 3])
#pragma unroll
        for (int L = 0; L < 16; ++L) {
            const float cprev = (L > 0) ? CARRY(L > 0 ? L - 1 : 0) : 0.f;
            const float snd = hi ? cprev : CARRY(L);
            const float rcv = __shfl_xor(snd, 32);
            imp[((wid >> 1) * 64 + qi) * 33 + 2 * L + hi] = MAINV(L) + rcv;
        }
#undef PSEL
#undef MAINV
#undef CARRY
        f32x16 o[2]; o[0] = f32x16{}; o[1] = f32x16{};
        pv(o, slot0 + 8192, pA0, pA1, lane, hi);
        if (two) pv(o, slot1 + 8192, pB0, pB1, lane, hi);
        acc_rows(tot, o, wsf, gate_c, r32, hi);
    }
    __syncthreads();
    XSTAMP(31);
    {
        const int ql = 8 * wid + (lane >> 3), sub = lane & 7;
        float v[4];
#pragma unroll
        for (int e = 0; e < 4; ++e) { const int j = 4 * sub + e; v[e] = (imp[(0 * 64 + ql) * 33 + j] + imp[(1 * 64 + ql) * 33 + j]) + (imp[(2 * 64 + ql) * 33 + j] + imp[(3 * 64 + ql) * 33 + j]);
            if (j < 1 || j >= blk_t) v[e] = -1.f; }
        unsigned mask = 1u | (1u << blk_t);
#pragma unroll 1
        for (int it = 0; it < 6; ++it) {
            float bv = fmaxf(fmaxf(v[0], v[1]), fmaxf(v[2], v[3]));
            bv = fmaxf(bv, __builtin_bit_cast(float, __builtin_amdgcn_mov_dpp(__builtin_bit_cast(int, bv), 0xB1, 0xF, 0xF, true)));
            bv = fmaxf(bv, __builtin_bit_cast(float, __builtin_amdgcn_mov_dpp(__builtin_bit_cast(int, bv), 0x4E, 0xF, 0xF, true)));
            bv = fmaxf(bv, __builtin_bit_cast(float, __builtin_amdgcn_mov_dpp(__builtin_bit_cast(int, bv), 0x141, 0xF, 0xF, true)));
            int bj = (v[3] == bv) ? 4 * sub + 3 : 64; bj = (v[2] == bv) ? 4 * sub + 2 : bj; bj = (v[1] == bv) ? 4 * sub + 1 : bj; bj = (v[0] == bv) ? 4 * sub : bj;
            bj = min(bj, __builtin_amdgcn_mov_dpp(bj, 0xB1, 0xF, 0xF, true));
            bj = min(bj, __builtin_amdgcn_mov_dpp(bj, 0x4E, 0xF, 0xF, true));
            bj = min(bj, __builtin_amdgcn_mov_dpp(bj, 0x141, 0xF, 0xF, true));
            if (bv >= 0.f) { mask |= 1u << bj;
#pragma unroll
                for (int e = 0; e < 4; ++e) if (4 * sub + e == bj) v[e] = -1.f; }
        }
        if (sub == 0) selm[ql] = mask;
        unsigned any = mask;
        any |= __shfl_xor(any, 8); any |= __shfl_xor(any, 16); any |= __shfl_xor(any, 32);
        if (lane == 0) selm[64 + wid] = any;
    }
    __syncthreads();
    XSTAMP(32);
    const unsigned mymask = selm[qi];
    const unsigned anym = (unsigned)__builtin_amdgcn_readfirstlane((int)((selm[64] | selm[65]) | (selm[66] | selm[67]) | (selm[68] | selm[69]) | (selm[70] | selm[71])));
    unsigned kofP, vofP; tile_offs(kofP, vofP, LDP, wid, lane);
    {
        const bf16_t* kb = P + rowbase * LDP + C_KS + g * 64; const bf16_t* vb = P + rowbase * LDP + C_VS + g * 64;
        unsigned todo = anym;
        float m = NEG, l = 0.f; f32x16 o[2]; o[0] = f32x16{}; o[1] = f32x16{};
        int j = __builtin_ctz(todo); todo &= todo - 1;
        dma_tile(slot0, kb + (size_t)j * 64 * LDP, vb + (size_t)j * 64 * LDP, kofP, vofP, wid);
        int cur = 0;
        __syncthreads();
        for (;;) {
            const int jn = todo ? __builtin_ctz(todo) : -1; if (todo) todo &= todo - 1;
            NLAS unsigned char* sc = cur ? slot1 : slot0; NLAS unsigned char* sn = cur ? slot0 : slot1;
            if (jn >= 0) dma_tile(sn, kb + (size_t)jn * 64 * LDP, vb + (size_t)jn * 64 * LDP, kofP, vofP, wid);
            const bool mine = (mymask >> j) & 1u;
            if (__any(mine)) {
                f32x16 p0, p1, c0, c1; const float kb0 = sl2 * (float)(j * 64 - t0); OPAQUE_HI();
#pragma unroll
                for (int i = 0; i < 16; ++i) { c0[i] = kb0 + sl2 * CRF(i); c1[i] = c0[i] + sl2 * 32.f; }
                qkt(p0, p1, sc, qr, c0, c1, r32, hi);
                if (j == blk_t) {
#pragma unroll
                    for (int i = 0; i < 16; ++i) { const int kk = crow(i, hiv); if (kk > qi) p0[i] = NEG; if (kk + 32 > qi) p1[i] = NEG; }
                }
                if (!mine) {
#pragma unroll
                    for (int i = 0; i < 16; ++i) { p0[i] = NEG; p1[i] = NEG; }
                }
                softmax_step(p0, p1, m, l, o, wsf, r32, hi);
                pv(o, sc + 8192, p0, p1, lane, hi);
            }
            __syncthreads();
            if (jn < 0) break;
            j = jn; cur ^= 1;
        }
        l = xhalf_sum(l);
        acc_rows(tot, o, wsf, gate_s * __builtin_amdgcn_rcpf(l), r32, hi);
    }
    XSTAMP(33);
    {
        const bf16_t* kb = P + rowbase * LDP + C_KW + g * 64; const bf16_t* vb = P + rowbase * LDP + C_VW + g * 64;
        float m = NEG, l = 0.f; f32x16 o[2]; o[0] = f32x16{}; o[1] = f32x16{};
        int j = blk_t; const int jlast = blk_t >= 4 ? blk_t - 4 : 0;
        dma_tile(slot0, kb + (size_t)j * 64 * LDP, vb + (size_t)j * 64 * LDP, kofP, vofP, wid);
        int cur = 0;
        __syncthreads();
        for (;;) {
            const int jn = (j > jlast) ? j - 1 : -1;
            NLAS unsigned char* sc = cur ? slot1 : slot0; NLAS unsigned char* sn = cur ? slot0 : slot1;
            if (jn >= 0) dma_tile(sn, kb + (size_t)jn * 64 * LDP, vb + (size_t)jn * 64 * LDP, kofP, vofP, wid);
            {
                f32x16 p0, p1, c0, c1; const float kb0 = sl2 * (float)(j * 64 - t0); OPAQUE_HI();
#pragma unroll
                for (int i = 0; i < 16; ++i) { c0[i] = kb0 + sl2 * CRF(i); c1[i] = c0[i] + sl2 * 32.f; }
                qkt(p0, p1, sc, qr, c0, c1, r32, hi);
                if (j == blk_t || j == blk_t - 4) {
                    const int dq = t0 + qi - j * 64;
#pragma unroll
                    for (int i = 0; i < 16; ++i) { const int d0_ = dq - crow(i, hiv), d1_ = d0_ - 32; if (d0_ < 0 || d0_ > 255) p0[i] = NEG; if (d1_ < 0 || d1_ > 255) p1[i] = NEG; }
                }
                softmax_step(p0, p1, m, l, o, wsf, r32, hi);
                pv(o, sc + 8192, p0, p1, lane, hi);
            }
            __syncthreads();
            if (jn < 0) break;
            j = jn; cur ^= 1;
        }
        l = xhalf_sum(l);
        acc_rows(tot, o, wsf, gate_w * __builtin_amdgcn_rcpf(l), r32, hi);
    }
    XSTAMP(34);
    {
        NLAS bf16_t* stg = (NLAS bf16_t*)(lds + L_OST) + wid * 2048;
#pragma unroll
        for (int i = 0; i < 16; ++i) { const int orow = crow(i, hi); stg[orow * 64 + r32] = f2bf(tot[0][i]); stg[orow * 64 + 32 + r32] = f2bf(tot[1][i]); }
        bf16_t* ow = P + (rowbase + t0 + qh * 32) * LDP + C_NQ + head * 64;
#pragma unroll
        for (int i = 0; i < 4; ++i) { const int row = i * 8 + (lane >> 3), ch = lane & 7; const u32x4 v = *(NLAS const u32x4*)(stg + row * 64 + ch * 8); *(u32x4*)((char*)ow + (unsigned)(row * LDP + ch * 8) * 2u) = v; }
    }
    __syncthreads();
    XSTAMP(35);
#if defined(TPROBE)
    if (blockIdx.x == 0 && threadIdx.x == 0) { volatile __attribute__((address_space(3))) unsigned long long* ts_ = (volatile __attribute__((address_space(3))) unsigned long long*)(lds + 147456 - 512); ts_[36] = ts_[30] + 100ull * (unsigned)qt; }
#endif
#undef CRF
#undef OPAQUE_HI
}

__device__ __forceinline__ void norm8(u32x4& v, const float* g8, float sc) {
    float x[8] = {__uint_as_float(v.x << 16), __uint_as_float(v.x & 0xffff0000u), __uint_as_float(v.y << 16), __uint_as_float(v.y & 0xffff0000u),
                  __uint_as_float(v.z << 16), __uint_as_float(v.z & 0xffff0000u), __uint_as_float(v.w << 16), __uint_as_float(v.w & 0xffff0000u)};
    float s = 0.f;
#pragma unroll
    for (int e = 0; e < 8; ++e) s += x[e] * x[e];
    s += __shfl_xor(s, 1); s += __shfl_xor(s, 2); s += __shfl_xor(s, 4);
    const float r = rsqrtf(s * (1.f / 64.f) + EPS) * sc;
    v.x = pk(x[0] * r * g8[0], x[1] * r * g8[1]); v.y = pk(x[2] * r * g8[2], x[3] * r * g8[3]); v.z = pk(x[4] * r * g8[4], x[5] * r * g8[5]); v.w = pk(x[6] * r * g8[6], x[7] * r * g8[7]);
}
__device__ __forceinline__ void prep_units(bf16_t* P, const float* qn, const float* kns, const float* knw, int gw, int NGW, int lane) {
    float gq[8], gk[8];
    const float* kg = (lane < 32) ? kns : knw;
#pragma unroll
    for (int e = 0; e < 8; ++e) { gq[e] = qn[8 * (lane & 7) + e]; gk[e] = kg[8 * (lane & 7) + e]; }
    const int coff = (lane < 32) ? C_KS + 8 * lane : C_KW + 8 * (lane - 32);
    for (int m0 = gw; m0 < M; m0 += 2 * NGW) {
        const int m1 = m0 + NGW; const bool two = m1 < M;
        bf16_t* r0 = P + (size_t)m0 * LDP; bf16_t* r1 = P + (size_t)(two ? m1 : m0) * LDP;
        u32x4 a0 = *(const u32x4*)(r0 + C_NQ + 8 * lane), b0 = *(const u32x4*)(r0 + C_NQ + 512 + 8 * lane), c0 = *(const u32x4*)(r0 + coff);
        u32x4 a1 = *(const u32x4*)(r1 + C_NQ + 8 * lane), b1 = *(const u32x4*)(r1 + C_NQ + 512 + 8 * lane), c1 = *(const u32x4*)(r1 + coff);
        norm8(a0, gq, 0.125f * LOG2E); norm8(b0, gq, 0.125f * LOG2E); norm8(c0, gk, 1.f);
        norm8(a1, gq, 0.125f * LOG2E); norm8(b1, gq, 0.125f * LOG2E); norm8(c1, gk, 1.f);
        *(u32x4*)(r0 + C_NQ + 8 * lane) = a0; *(u32x4*)(r0 + C_NQ + 512 + 8 * lane) = b0; *(u32x4*)(r0 + coff) = c0;
        if (two) { *(u32x4*)(r1 + C_NQ + 8 * lane) = a1; *(u32x4*)(r1 + C_NQ + 512 + 8 * lane) = b1; *(u32x4*)(r1 + coff) = c1; }
    }
}

constexpr int LC_A = 0, LC_B = 16384, LC_HID = 49152;
__device__ __forceinline__ void compress_item(NLAS unsigned char* lds, const bf16_t* P, const bf16_t* W1T, const float* bias1, const float* W2, const float* gain, bf16_t* OUT, int b, int g, int which, int half) {
    const int tid = threadIdx.x, lane = tid & 63, r32 = lane & 31, hi = lane >> 5; const int wid = __builtin_amdgcn_readfirstlane(tid >> 6);
    const int mt = wid >> 2, nt = wid & 3;
    const int ca = tid >> 3, dca = tid & 7; const int cg_ = 64 * half + ca; const int ccl = cg_ < NCMP ? cg_ : NCMP - 1;
    const bf16_t* asrc = P + ((size_t)b * SEQ + 16 * ccl) * LDP + (which ? C_VC : C_KC) + g * 64 + dca * 8;
    const bf16_t* bsrc0 = W1T + (size_t)(tid >> 3) * 2048 + (tid & 7) * 8; const bf16_t* bsrc1 = bsrc0 + (size_t)64 * 2048;
    const int adst = (dca * 64 + ca) * 16, bdst0 = ((tid & 7) * 128 + (tid >> 3)) * 16, bdst1 = bdst0 + 64 * 16;
#define CBAR() do { asm volatile("s_waitcnt lgkmcnt(0)" ::: "memory"); __builtin_amdgcn_s_barrier(); asm volatile("" ::: "memory"); } while (0)
#define CLOAD(ra_, rb0_, rb1_, l_) do { ra_ = *(const u32x4*)(asrc + (size_t)(l_) * LDP); rb0_ = *(const u32x4*)(bsrc0 + (l_) * 64); rb1_ = *(const u32x4*)(bsrc1 + (l_) * 64); } while (0)
#define CSTORE(ra_, rb0_, rb1_, buf_) do { *(NLAS u32x4*)(lds + LC_A + (buf_) * 8192 + adst) = ra_; *(NLAS u32x4*)(lds + LC_B + (buf_) * 16384 + bdst0) = rb0_; *(NLAS u32x4*)(lds + LC_B + (buf_) * 16384 + bdst1) = rb1_; } while (0)
#define CMMA(buf_) do { NLAS const unsigned char* ab = lds + LC_A + (buf_) * 8192; NLAS const unsigned char* bb = lds + LC_B + (buf_) * 16384; \
        _Pragma("unroll") for (int ds = 0; ds < 4; ++ds) { \
            const bf16x8 a = *(NLAS const bf16x8*)(ab + ((2 * ds + hi) * 64 + 32 * mt + r32) * 16); \
            const bf16x8 w = *(NLAS const bf16x8*)(bb + ((2 * ds + hi) * 128 + 32 * nt + r32) * 16); \
            acc = __builtin_amdgcn_mfma_f32_32x32x16_bf16(a, w, acc, 0, 0, 0); } } while (0)
    u32x4 xa, xb0, xb1, ya, yb0, yb1;
    CLOAD(xa, xb0, xb1, 0); CSTORE(xa, xb0, xb1, 0);
    CLOAD(xa, xb0, xb1, 1); CLOAD(ya, yb0, yb1, 2);
    CBAR();
    f32x16 acc = f32x16{};
    for (int l = 0; l < 32; l += 2) {
        CMMA(0); CSTORE(xa, xb0, xb1, 1); if (l + 3 < 32) CLOAD(xa, xb0, xb1, l + 3); CBAR();
        CMMA(1); if (l + 2 < 32) { CSTORE(ya, yb0, yb1, 0); if (l + 4 < 32) CLOAD(ya, yb0, yb1, l + 4); } CBAR();
    }
#undef CBAR
#undef CLOAD
#undef CSTORE
#undef CMMA
    NLAS float* hid = (NLAS float*)(lds + LC_HID);
    const float bs = bias1[32 * nt + r32];
#pragma unroll
    for (int i = 0; i < 16; ++i) hid[(32 * mt + crow(i, hi)) * 132 + 32 * nt + r32] = gelu_tanh(acc[i] + bs);
    __syncthreads();
    {
        const int row = tid >> 3, e0 = (tid & 7) * 8;
        float o[8];
#pragma unroll
        for (int e = 0; e < 8; ++e) o[e] = 0.f;
        for (int i = 0; i < 128; ++i) { const float h = hid[row * 132 + i]; const f32x4 wa = *(const f32x4*)(W2 + i * 64 + e0), wb = *(const f32x4*)(W2 + i * 64 + e0 + 4);
            o[0] += h * wa[0]; o[1] += h * wa[1]; o[2] += h * wa[2]; o[3] += h * wa[3]; o[4] += h * wb[0]; o[5] += h * wb[1]; o[6] += h * wb[2]; o[7] += h * wb[3]; }
        if (which == 0) {
            float ss = 0.f;
#pragma unroll
            for (int e = 0; e < 8; ++e) ss += o[e] * o[e];
            ss += __shfl_xor(ss, 1); ss += __shfl_xor(ss, 2); ss += __shfl_xor(ss, 4);
            const float r = rsqrtf(ss * (1.f / 64.f) + EPS);
#pragma unroll
            for (int e = 0; e < 8; ++e) o[e] *= r * gain[e0 + e];
        }
        const int cg = 64 * half + row;
        if (cg >= NCMP) {
#pragma unroll
            for (int e = 0; e < 8; ++e) o[e] = 0.f; }
        u32x4 w; w.x = pk(o[0], o[1]); w.y = pk(o[2], o[3]); w.z = pk(o[4], o[5]); w.w = pk(o[6], o[7]);
        *(u32x4*)(OUT + (((size_t)(b * NS_G + g) * 128) + cg) * 64 + e0) = w;
    }
    __syncthreads();
}
}
namespace pg8 {
#define PG8_LAS __attribute__((address_space(3)))
typedef short bf16x8 __attribute__((ext_vector_type(8)));
typedef float f32x4 __attribute__((ext_vector_type(4)));
typedef float f32x2 __attribute__((ext_vector_type(2)));
typedef unsigned u32x4 __attribute__((ext_vector_type(4)));
typedef unsigned u32x2 __attribute__((ext_vector_type(2)));
constexpr int BM = 256, BK = 64, HALF = 128, HTB = HALF * BK * 2, STAGE_BYTES = 8 * HTB, NXCD = 8, WGM = 8;

__host__ __device__ __forceinline__ int lds_byte(int r, int c) { const int st = (r >> 4) * 2 + (c >> 5), rr = r & 15, cc = c & 31, ob = rr * 64 + cc * 2; return st * 1024 + (ob ^ (((ob >> 9) & 1) << 5)); }
__host__ __device__ __forceinline__ void stage_rc(int b, int& R, int& C) { const int st = b / 1024, sb = b % 1024, swz = sb ^ (((sb >> 9) & 1) << 5); R = (st >> 1) * 16 + swz / 64; C = (st & 1) * 32 + (swz % 64) / 2; }
__host__ __device__ __forceinline__ int perm32(int rho) { const int n = rho >> 4, i = rho & 15; return 8 * (i >> 2) + 4 * n + (i & 3); }

struct Unit { int pm, pn, ks; };
struct Gemm { const bf16_t* A; const bf16_t* Bt; int lda, ldb; int M, N, K; int ksoff; };

struct StaticOrder {
    int nM, nN, nwg, G, c;
    __host__ __device__ void init(int M_, int N_, int G_, int c_) { nM = M_ / BM; nN = N_ / BM; nwg = nM * nN; G = G_; c = c_; }
    __host__ __device__ bool next(int i, Unit& u) const {
        const long L = (long)i * G + c; if (L >= nwg) return false;
        int wgid = (int)L; { const int q = nwg / NXCD, r = nwg % NXCD, xcd = wgid % NXCD, off = wgid / NXCD; wgid = (xcd < r ? xcd * (q + 1) : r * (q + 1) + (xcd - r) * q) + off; }
        const int nig = WGM * nN, gid = wgid / nig, fm = gid * WGM, gsz = (nM - fm) < WGM ? (nM - fm) : WGM;
        u.pm = fm + ((wgid % nig) % gsz); u.pn = (wgid % nig) / gsz; u.ks = 0; return true;
    }
};
struct TwoPassOrder {
    StaticOrder base;
    __host__ __device__ bool next(int i, Unit& u) const { if (!base.next(i >> 1, u)) return false; u.ks = i & 1; return true; }
};

typedef __bf16 bf16x2_t __attribute__((ext_vector_type(2)));
__device__ __forceinline__ unsigned cvt_pk_bf16(float lo, float hi) { f32x2 v = {lo, hi}; bf16x2_t b = __builtin_convertvector(v, bf16x2_t); return __builtin_bit_cast(unsigned, b); }
__device__ __forceinline__ float fast_sigmoid(float x) { return __builtin_amdgcn_rcpf(1.f + __builtin_amdgcn_exp2f(-1.4426950408889634f * x)); }
__device__ __forceinline__ float bflo(unsigned w) { return __uint_as_float(w << 16); }
__device__ __forceinline__ float bfhi(unsigned w) { return __uint_as_float(w & 0xffff0000u); }

typedef f32x4 Acc[2][2][4][2];

template <int ACT> struct EpiP {
    static constexpr bool PERM = true;
    bf16_t* O; int ldc; int pn_last; int ncol_last; bf16_t* halo;
    __device__ __forceinline__ void operator()(const Acc& acc, const Unit& u, int wr, int wc, int fr, int fq) const {
        const int row0 = u.pm * BM + wr * 64 + fr, tcol = wc * 32 + 8 * fq;
        const int lim = (u.pn == pn_last) ? ncol_last : 256;
#pragma unroll
        for (int ai = 0; ai < 2; ++ai)
#pragma unroll
            for (int m = 0; m < 4; ++m) { bf16_t* rowp = O + (size_t)(row0 + ai * HALF + m * 16) * ldc + u.pn * BM + tcol;
#pragma unroll
                for (int bj = 0; bj < 2; ++bj) { if (tcol + bj * HALF >= lim) continue;
                    f32x4 v0 = acc[ai][bj][m][0], v1 = acc[ai][bj][m][1];
                    if (ACT == 1) {
#pragma unroll
                        for (int e = 0; e < 4; ++e) { v0[e] = fast_sigmoid(v0[e]); v1[e] = fast_sigmoid(v1[e]); } }
                    u32x4 w; w.x = cvt_pk_bf16(v0[0], v0[1]); w.y = cvt_pk_bf16(v0[2], v0[3]); w.z = cvt_pk_bf16(v1[0], v1[1]); w.w = cvt_pk_bf16(v1[2], v1[3]);
                    *(u32x4*)(rowp + bj * HALF) = w;
                    if (ACT == 0 && m == 3 && fr >= 13 && u.pn < 12 && halo) { const int row = row0 + ai * HALF + 48;
                        *(u32x4*)(halo + ((size_t)(row >> 6) * 3 + (fr - 13)) * 3072 + u.pn * BM + tcol + bj * HALF) = w; } } }
    }
};
struct EpiMix {
    static constexpr bool PERM = true;
    const bf16_t* G; int ldg; bf16_t* O; int ldc;
    __device__ __forceinline__ void operator()(const Acc& acc, const Unit& u, int wr, int wc, int fr, int fq) const {
        const int row0 = u.pm * BM + wr * 64 + fr, col0 = u.pn * BM + wc * 32 + 8 * fq;
#pragma unroll
        for (int ai = 0; ai < 2; ++ai)
#pragma unroll
            for (int m = 0; m < 4; ++m) { const size_t row = (size_t)(row0 + ai * HALF + m * 16); const bf16_t* gp = G + row * ldg + col0 + u.ks * 1024; bf16_t* rowp = O + row * ldc + col0;
#pragma unroll
                for (int bj = 0; bj < 2; ++bj) { const u32x4 b = *(const u32x4*)(gp + bj * HALF);
                    f32x4 v0 = acc[ai][bj][m][0], v1 = acc[ai][bj][m][1];
                    v0[0] *= bflo(b.x); v0[1] *= bfhi(b.x); v0[2] *= bflo(b.y); v0[3] *= bfhi(b.y); v1[0] *= bflo(b.z); v1[1] *= bfhi(b.z); v1[2] *= bflo(b.w); v1[3] *= bfhi(b.w);
                    if (u.ks) { const u32x4 p = *(const u32x4*)(rowp + bj * HALF);
                        v0[0] += bflo(p.x); v0[1] += bfhi(p.x); v0[2] += bflo(p.y); v0[3] += bfhi(p.y); v1[0] += bflo(p.z); v1[1] += bfhi(p.z); v1[2] += bflo(p.w); v1[3] += bfhi(p.w); }
                    u32x4 w; w.x = cvt_pk_bf16(v0[0], v0[1]); w.y = cvt_pk_bf16(v0[2], v0[3]); w.z = cvt_pk_bf16(v1[0], v1[1]); w.w = cvt_pk_bf16(v1[2], v1[3]);
                    *(u32x4*)(rowp + bj * HALF) = w; } }
    }
};
struct EpiOut {
    static constexpr bool PERM = false;
    const float* X; float* X1; bf16_t* An; const float* gain; float* pss;
    __device__ __forceinline__ void operator()(const Acc& acc, const Unit& u, int wr, int wc, int fr, int fq) const {
        const int row0 = u.pm * BM + wr * 64 + fr, col0 = u.pn * BM + wc * 32 + 4 * fq;
        f32x4 gv[2][2];
#pragma unroll
        for (int bj = 0; bj < 2; ++bj)
#pragma unroll
            for (int n = 0; n < 2; ++n) gv[bj][n] = *(const f32x4*)(gain + col0 + bj * HALF + n * 16);
#pragma unroll
        for (int ai = 0; ai < 2; ++ai)
#pragma unroll
            for (int m = 0; m < 4; ++m) { const size_t row = (size_t)(row0 + ai * HALF + m * 16); const size_t off = row * D + col0; float ss = 0.f;
#pragma unroll
                for (int bj = 0; bj < 2; ++bj)
#pragma unroll
                    for (int n = 0; n < 2; ++n) { const f32x4 x1 = *(const f32x4*)(X + off + bj * HALF + n * 16) + acc[ai][bj][m][n];
                        *(f32x4*)(X1 + off + bj * HALF + n * 16) = x1; ss += (x1[0] * x1[0] + x1[1] * x1[1]) + (x1[2] * x1[2] + x1[3] * x1[3]);
                        const f32x4 y = x1 * gv[bj][n]; u32x2 w; w.x = cvt_pk_bf16(y[0], y[1]); w.y = cvt_pk_bf16(y[2], y[3]); *(u32x2*)(An + off + bj * HALF + n * 16) = w; }
                ss += __shfl_xor(ss, 16); ss += __shfl_xor(ss, 32);
                if (fq == 0) pss[row * 16 + u.pn * 4 + wc] = ss; }
    }
};
struct EpiUp {
    static constexpr bool PERM = true;
    const float* pss; bf16_t* O; int ldc;
    __device__ __forceinline__ void operator()(const Acc& acc, const Unit& u, int wr, int wc, int fr, int fq) const {
        const int row0 = u.pm * BM + wr * 64 + fr, col0 = u.pn * BM + wc * 32 + 8 * fq;
#pragma unroll
        for (int ai = 0; ai < 2; ++ai)
#pragma unroll
            for (int m = 0; m < 4; ++m) { const size_t row = (size_t)(row0 + ai * HALF + m * 16);
                const f32x4* pp = (const f32x4*)(pss + row * 16); const f32x4 s4 = (pp[0] + pp[1]) + (pp[2] + pp[3]);
                const float rstd = rsqrtf(((s4[0] + s4[1]) + (s4[2] + s4[3])) * (1.f / D) + EPS);
                bf16_t* rowp = O + row * ldc + col0;
#pragma unroll
                for (int bj = 0; bj < 2; ++bj) { f32x4 v0 = acc[ai][bj][m][0] * rstd, v1 = acc[ai][bj][m][1] * rstd;
#pragma unroll
                    for (int e = 0; e < 4; ++e) { const float a = fmaxf(v0[e], 0.f), b = fmaxf(v1[e], 0.f); v0[e] = a * a; v1[e] = b * b; }
                    u32x4 w; w.x = cvt_pk_bf16(v0[0], v0[1]); w.y = cvt_pk_bf16(v0[2], v0[3]); w.z = cvt_pk_bf16(v1[0], v1[1]); w.w = cvt_pk_bf16(v1[2], v1[3]);
                    *(u32x4*)(rowp + bj * HALF) = w; } }
    }
};
struct EpiDown {
    static constexpr bool PERM = false;
    float* X1;
    __device__ __forceinline__ void operator()(const Acc& acc, const Unit& u, int wr, int wc, int fr, int fq) const {
        const int row0 = u.pm * BM + wr * 64 + fr, col0 = u.pn * BM + wc * 32 + 4 * fq;
#pragma unroll
        for (int ai = 0; ai < 2; ++ai)
#pragma unroll
            for (int m = 0; m < 4; ++m) { float* rowp = X1 + (size_t)(row0 + ai * HALF + m * 16) * D + col0;
#pragma unroll
                for (int bj = 0; bj < 2; ++bj)
#pragma unroll
                    for (int n = 0; n < 2; ++n) { f32x4* p = (f32x4*)(rowp + bj * HALF + n * 16); *p = *p + acc[ai][bj][m][n]; } }
    }
};

template <class Epi, class Sched, bool ALIGN_EPI>
__device__ __forceinline__ void gemm_phase(PG8_LAS unsigned char* lds, const Gemm g, const Sched& S, const Epi& E) {
    const int tid = threadIdx.x, wid = __builtin_amdgcn_readfirstlane(tid >> 6), lane = tid & 63, wr = wid >> 2, wc = wid & 3, fr = lane & 15, fq = lane >> 4;
    const int K = g.K, nt = K / BK, lda = g.lda, ldb = g.ldb;
    unsigned voffA[2], voffB[2];
#pragma unroll
    for (int i = 0; i < 2; ++i) { int R, C; stage_rc(tid * 16 + i * 8192, R, C); const int Rb = Epi::PERM ? ((R & ~31) + perm32(R & 31)) : R;
        voffA[i] = (unsigned)(R * lda + C) * 2u; voffB[i] = (unsigned)(Rb * ldb + C) * 2u; }
    const size_t kstep = (size_t)(BK * 2);
    const size_t hstepA = (size_t)HALF * lda * 2, hstepB = (size_t)HALF * ldb * 2;
    const size_t tstepA = 2 * hstepA, tstepB = 2 * hstepB;
    const unsigned ldsw = (unsigned)wid * 1024u;
    const int aoff = lds_byte(wr * 64 + fr, fq * 8), boff = lds_byte(wc * 32 + fr, fq * 8);
#define PG8_SA(b, h) (((b) * 2 + (h)) * HTB)
#define PG8_SB(b, h) ((4 + (b) * 2 + (h)) * HTB)
#define PG8_STAGE(bufoff, gbase, voff) do { _Pragma("unroll") for (int _i = 0; _i < 2; ++_i) \
        __builtin_amdgcn_global_load_lds((const unsigned*)((const char*)(gbase) + (voff)[_i]), (PG8_LAS unsigned*)(lds + (bufoff) + ldsw + _i * 8192), 16, 0, 0); } while (0)
#define PG8_LDA(dst, b, h) do { _Pragma("unroll") for (int m = 0; m < 4; ++m) _Pragma("unroll") for (int k = 0; k < 2; ++k) dst[m][k] = *(const PG8_LAS bf16x8*)(lds + PG8_SA(b, h) + aoff + m * 2048 + k * 1024); } while (0)
#define PG8_LDB(dst, b, h) do { _Pragma("unroll") for (int n = 0; n < 2; ++n) _Pragma("unroll") for (int k = 0; k < 2; ++k) dst[n][k] = *(const PG8_LAS bf16x8*)(lds + PG8_SB(b, h) + boff + n * 2048 + k * 1024); } while (0)
#define PG8_MMA(ai, bj, At, Bt) do { __builtin_amdgcn_s_setprio(1); _Pragma("unroll") for (int m = 0; m < 4; ++m) _Pragma("unroll") for (int n = 0; n < 2; ++n) _Pragma("unroll") for (int k = 0; k < 2; ++k) \
        acc[ai][bj][m][n] = __builtin_amdgcn_mfma_f32_16x16x32_bf16(Bt[n][k], At[m][k], acc[ai][bj][m][n], 0, 0, 0); __builtin_amdgcn_s_setprio(0); } while (0)
#define PG8_WAIT_V(n) asm volatile("s_waitcnt vmcnt(" #n ")" ::: "memory")
#define PG8_WAIT_L(n) asm volatile("s_waitcnt lgkmcnt(" #n ")" ::: "memory")
#define PG8_BAR __builtin_amdgcn_s_barrier()
#define PG8_SCHED __builtin_amdgcn_sched_barrier(0)
#define PG8_KBODY(t) do { \
            const bool last = (t == nt - 2); \
            const char* a1 = cA + (size_t)(t + 1) * kstep; \
            const char* a2 = last ? nA : cA + (size_t)(t + 2) * kstep; const char* b2 = last ? nB : cB + (size_t)(t + 2) * kstep; \
            const char* a3 = a2 + kstep; const char* b3 = b2 + kstep; \
            PG8_LDB(B0, 0, 0); PG8_LDB(B1, 0, 1); PG8_SCHED; PG8_LDA(At, 0, 0); PG8_STAGE(PG8_SA(1, 1), a1 + hstepA, voffA); \
            PG8_WAIT_V(8); PG8_WAIT_L(0); PG8_BAR; PG8_MMA(0, 0, At, B0); PG8_MMA(0, 1, At, B1); PG8_BAR; PG8_SCHED; \
            PG8_LDA(At, 0, 1); PG8_STAGE(PG8_SB(0, 0), b2, voffB); PG8_STAGE(PG8_SB(0, 1), b2 + hstepB, voffB); PG8_STAGE(PG8_SA(0, 0), a2, voffA); \
            PG8_WAIT_V(8); PG8_WAIT_L(0); PG8_BAR; PG8_MMA(1, 0, At, B0); PG8_MMA(1, 1, At, B1); PG8_BAR; PG8_SCHED; \
            PG8_LDB(B0, 1, 0); PG8_LDB(B1, 1, 1); PG8_SCHED; PG8_LDA(At, 1, 0); PG8_STAGE(PG8_SA(0, 1), a2 + hstepA, voffA); \
            PG8_WAIT_V(8); PG8_WAIT_L(0); PG8_BAR; PG8_MMA(0, 0, At, B0); PG8_MMA(0, 1, At, B1); PG8_BAR; PG8_SCHED; \
            PG8_LDA(At, 1, 1); PG8_STAGE(PG8_SB(1, 0), b3, voffB); PG8_STAGE(PG8_SB(1, 1), b3 + hstepB, voffB); PG8_STAGE(PG8_SA(1, 0), a3, voffA); \
            PG8_WAIT_V(8); PG8_WAIT_L(0); PG8_BAR; PG8_MMA(1, 0, At, B0); PG8_MMA(1, 1, At, B1); PG8_BAR; PG8_SCHED; \
        } while (0)
    Unit cur, nxt; int ui = 0;
    if (!S.next(0, cur)) return;
    Acc acc;
#pragma unroll
    for (int a = 0; a < 2; ++a)
#pragma unroll
        for (int b = 0; b < 2; ++b)
#pragma unroll
            for (int m = 0; m < 4; ++m)
#pragma unroll
                for (int n = 0; n < 2; ++n) acc[a][b][m][n] = (f32x4){0.f, 0.f, 0.f, 0.f};
    bf16x8 At[4][2], B0[2][2], B1[2][2];
    const char* cA = (const char*)g.A + (size_t)cur.pm * tstepA + (size_t)cur.ks * g.ksoff * 2; const char* cB = (const char*)g.Bt + (size_t)cur.pn * tstepB + (size_t)cur.ks * g.ksoff * 2;
    PG8_STAGE(PG8_SB(0, 0), cB, voffB); PG8_STAGE(PG8_SB(0, 1), cB + hstepB, voffB); PG8_STAGE(PG8_SA(0, 0), cA, voffA); PG8_STAGE(PG8_SA(0, 1), cA + hstepA, voffA);
    if (wr == 1) PG8_BAR;
    PG8_WAIT_V(2); PG8_BAR;
    PG8_STAGE(PG8_SB(1, 0), cB + kstep, voffB); PG8_STAGE(PG8_SA(1, 0), cA + kstep, voffA); PG8_STAGE(PG8_SB(1, 1), cB + hstepB + kstep, voffB);
    PG8_WAIT_V(6); PG8_BAR;
    for (;;) {
        const bool has_next = S.next(ui + 1, nxt);
        const char* nA = has_next ? (const char*)g.A + (size_t)nxt.pm * tstepA + (size_t)nxt.ks * g.ksoff * 2 : cA; const char* nB = has_next ? (const char*)g.Bt + (size_t)nxt.pn * tstepB + (size_t)nxt.ks * g.ksoff * 2 : cB;
        for (int t = 0; t < nt; t += 2) PG8_KBODY(t);
        if constexpr (ALIGN_EPI) { if (wr == 0) PG8_BAR; }
        E(acc, cur, wr, wc, fr, fq);
        if (!has_next) break;
#pragma unroll
        for (int a = 0; a < 2; ++a)
#pragma unroll
            for (int b = 0; b < 2; ++b)
#pragma unroll
                for (int m = 0; m < 4; ++m)
#pragma unroll
                    for (int n = 0; n < 2; ++n) acc[a][b][m][n] = (f32x4){0.f, 0.f, 0.f, 0.f};
        cur = nxt; cA = nA; cB = nB; ++ui;
        if constexpr (ALIGN_EPI) { if (wr == 1) PG8_BAR; }
    }
    PG8_WAIT_V(0);
    if constexpr (!ALIGN_EPI) { if (wr == 0) PG8_BAR; }
    PG8_BAR;
#undef PG8_SA
#undef PG8_SB
#undef PG8_STAGE
#undef PG8_LDA
#undef PG8_LDB
#undef PG8_MMA
#undef PG8_WAIT_V
#undef PG8_WAIT_L
#undef PG8_BAR
#undef PG8_SCHED
#undef PG8_KBODY
}
}

#define GAS __attribute__((address_space(1)))
#define LAS __attribute__((address_space(3)))
typedef unsigned v4u __attribute__((ext_vector_type(4)));
typedef float f32x4 __attribute__((ext_vector_type(4)));
constexpr int NWAVES = 8;
constexpr int LDS_BYTES = 147456;
constexpr size_t MiB = 1u << 20;
constexpr size_t WS_PSS = 1 * MiB, WS_WOUT = 2 * MiB, WS_P = 4 * MiB, WS_KC = 214 * MiB, WS_VC = 215 * MiB, WS_MIX = 216 * MiB;
constexpr size_t WS_AN = 4 * MiB, WS_UP = 64 * MiB, WS_WUP = 248 * MiB, WS_WDOWN = 200 * MiB;
constexpr size_t WS_BIAS1 = 131072 + 16384, WS_W1T = 214 * MiB, WS_KCB = 215 * MiB, WS_VCB = 215 * MiB + 512 * 1024;
constexpr size_t WS_GLV = 4096, WS_QCNT = 65536, WS_GW = 216 * MiB, DO_GQK = 40 * MiB, DO_HALO = 56 * MiB;
constexpr size_t WS_XBAR = 131072;
constexpr size_t DO_H = 0, DO_WG = 32 * MiB, DO_WCAT = 36 * MiB, DO_WIN = 40 * MiB;

__device__ __forceinline__ unsigned pk2(float lo, float hi) { return (unsigned)f2bf(lo) | ((unsigned)f2bf(hi) << 16); }
__device__ __forceinline__ float wave_sum(float v) {
#pragma unroll
    for (int o = 1; o < 64; o <<= 1) v += __shfl_xor(v, o);
    return v;
}
template <class SrcCol>
__device__ __forceinline__ void transpose_item(const float* W, int ldw, const SrcCol& srccol, bf16_t* WT, int ldk, int kofs, LAS float* scr, int kb, int nb, int lane) {
    const int k0 = 64 * kb, n0 = 64 * nb; const int n4 = (lane & 15) * 4; const int sc = srccol(n0 + n4);
    f32x4 v[16];
    const float* wp = W + (size_t)(k0 + (lane >> 4)) * ldw + (sc >= 0 ? sc : 0);
#pragma unroll
    for (int i = 0; i < 16; ++i) v[i] = *(const f32x4*)(wp + (size_t)(4 * i) * ldw);
#pragma unroll
    for (int i = 0; i < 16; ++i) { const int kk = 4 * i + (lane >> 4); const f32x4 u = (sc >= 0) ? v[i] : (f32x4){0.f, 0.f, 0.f, 0.f};
        scr[kk * 65 + n4] = u[0]; scr[kk * 65 + n4 + 1] = u[1]; scr[kk * 65 + n4 + 2] = u[2]; scr[kk * 65 + n4 + 3] = u[3]; }
    asm volatile("s_waitcnt lgkmcnt(0)" ::: "memory");
    const int c = lane & 7;
#pragma unroll
    for (int j = 0; j < 8; ++j) { const int n = (lane >> 3) + 8 * j; const LAS float* sp = scr + (8 * c) * 65 + n;
        v4u o; o.x = pk2(sp[0 * 65], sp[1 * 65]); o.y = pk2(sp[2 * 65], sp[3 * 65]); o.z = pk2(sp[4 * 65], sp[5 * 65]); o.w = pk2(sp[6 * 65], sp[7 * 65]);
        *(v4u*)(WT + (size_t)(n0 + n) * ldk + kofs + k0 + 8 * c) = o; }
    asm volatile("s_waitcnt lgkmcnt(0)" ::: "memory");
}
struct SrcIdent { int off; __device__ __forceinline__ int operator()(int n) const { return n + off; } };
struct SrcWin { __device__ __forceinline__ int operator()(int n) const { return n < 4096 ? n : (n < 6656 ? n + 16 : (n < 6672 ? n - 6656 + 4096 : (n < 6720 ? n : -1))); } };

typedef GAS unsigned gu32;
#define RLX_AGENT __ATOMIC_RELAXED, __HIP_MEMORY_SCOPE_AGENT
#define XB_TMO      128
#define XB_XCNT(j)  (256  + 64 * (j))
#define XB_XSUB(j)  (1280 + 64 * (j))
#define XB_XGEN(j)  (2304 + 64 * (j))
#define XB_TOP      3328
#define XB_TOPGEN   3392
#define XCD_BAR_WORDS 3456
#define XB_SPIN_CAP (1u << 18)

__device__ __forceinline__ unsigned xb_ld(unsigned* p)              { return __hip_atomic_load(p, __ATOMIC_RELAXED, __HIP_MEMORY_SCOPE_AGENT); }
__device__ __forceinline__ unsigned xb_add(unsigned* p, unsigned v) { return __hip_atomic_fetch_add(p, v, __ATOMIC_RELAXED, __HIP_MEMORY_SCOPE_AGENT); }
__device__ __forceinline__ unsigned xb_xcc_id() { return (unsigned)__builtin_amdgcn_s_getreg((3 << 11) | 20) & 0xFu; }
#define XB_SPIN(cond, bar) do { unsigned _sp = 0; while (cond) { __builtin_amdgcn_s_sleep(1); \
    if ((++_sp & 255u) == 0u) { if (xb_ld(&(bar)[XB_TMO])) break; if (_sp > XB_SPIN_CAP) { atomicAdd(&(bar)[XB_TMO], 1u); break; } } } } while (0)

struct XcdBarrier {
    unsigned* bar; unsigned x;
    volatile LAS unsigned* st;
};

__device__ __forceinline__ XcdBarrier xcd_barrier_post(unsigned* bar, volatile LAS unsigned* st) {
    XcdBarrier b; b.bar = bar; b.x = xb_xcc_id(); b.st = st;
    if (threadIdx.x == 0) (void)xb_add(&bar[XB_XCNT(b.x)], 1u);
    return b;
}
__device__ __forceinline__ void xcd_barrier_complete(unsigned* bar, unsigned x, unsigned& nloc, unsigned& nx) {
    const unsigned G = gridDim.x * gridDim.y * gridDim.z;
    unsigned sum, cnt, mine, sp = 0u;
    for (;;) {
        sum = 0u; cnt = 0u; mine = 0u;
#pragma unroll
        for (unsigned j = 0; j < 16; ++j) { const unsigned c = xb_ld(&bar[XB_XCNT(j)]); sum += c; cnt += (c > 0u) ? 1u : 0u; mine = (j == x) ? c : mine; }
        if (sum == G) break;
        __builtin_amdgcn_s_sleep(1);
        if ((++sp & 255u) == 0u) { if (xb_ld(&bar[XB_TMO])) break; if (sp > XB_SPIN_CAP) { atomicAdd(&bar[XB_TMO], 1u); break; } }
    }
    nloc = mine > 0u ? mine : 1u; nx = cnt > 0u ? cnt : 1u;
}

__device__ __forceinline__ void xcd_barrier(const XcdBarrier& b) {
    asm volatile("s_waitcnt vmcnt(0)" ::: "memory");
    __syncthreads();
    if (threadIdx.x == 0) {
        unsigned* bar = b.bar;
        __builtin_amdgcn_s_waitcnt(0);
        unsigned nloc = b.st[0], nx = b.st[1];
        if (nloc == 0u) { xcd_barrier_complete(bar, b.x, nloc, nx); b.st[0] = nloc; b.st[1] = nx; }
        const unsigned old = xb_add(&bar[XB_XSUB(b.x)], 1u);
        const unsigned gen = old / nloc;
        if (old + 1u == (gen + 1u) * nloc) {
            __builtin_amdgcn_fence(__ATOMIC_RELEASE, "agent");
            asm volatile("s_waitcnt vmcnt(0)" ::: "memory");
            const unsigned og = xb_add(&bar[XB_TOP], 1u);
            const unsigned tg = og / nx;
            if (og + 1u == (tg + 1u) * nx) xb_add(&bar[XB_TOPGEN], 1u);
            else XB_SPIN(xb_ld(&bar[XB_TOPGEN]) == tg, bar);
            __builtin_amdgcn_fence(__ATOMIC_ACQUIRE, "agent");
            xb_add(&bar[XB_XGEN(b.x)], 1u);
            asm volatile("s_waitcnt vmcnt(0)" ::: "memory");
        } else {
            XB_SPIN(xb_ld(&bar[XB_XGEN(b.x)]) == gen, bar);
            __builtin_amdgcn_fence(__ATOMIC_ACQUIRE, "agent");
            asm volatile("s_waitcnt vmcnt(0)" ::: "memory");
        }
    }
    __syncthreads();
}


struct Args { const float* in[23]; float* out; unsigned char* ws; int ph_lo, ph_hi; };

__global__ void __launch_bounds__(NWAVES * 64, 2) mk_fwd(Args args) {
    extern __shared__ __attribute__((aligned(16))) unsigned char lds_raw[];
    LAS unsigned char* lds = (LAS unsigned char*)lds_raw;
    __builtin_assume(__builtin_amdgcn_workitem_id_y() == 0); __builtin_assume(__builtin_amdgcn_workitem_id_z() == 0);
    cg::grid_group grid = cg::this_grid();
    const int tid = threadIdx.x, wave = __builtin_amdgcn_readfirstlane(tid >> 6);
#define lane ((int)(threadIdx.x & 63u))
    const int G = gridDim.x, gw = blockIdx.x * NWAVES + wave, NGW = G * NWAVES;
    unsigned char* ws = args.ws; unsigned char* dob = (unsigned char*)args.out;
    const float* x = args.in[0];
    bf16_t* P = (bf16_t*)(ws + WS_P);
    bf16_t* Hb = (bf16_t*)(dob + DO_H); bf16_t* Wg_t = (bf16_t*)(dob + DO_WG); bf16_t* Wcat_t = (bf16_t*)(dob + DO_WCAT); bf16_t* Win_t = (bf16_t*)(dob + DO_WIN);
    bf16_t* Wout_t = (bf16_t*)(ws + WS_WOUT); bf16_t* Wup_t = (bf16_t*)(ws + WS_WUP); bf16_t* Wdown_t = (bf16_t*)(ws + WS_WDOWN);
    bf16_t* Mix = (bf16_t*)(ws + WS_MIX); bf16_t* An = (bf16_t*)(ws + WS_AN); bf16_t* Up = (bf16_t*)(ws + WS_UP); float* pss = (float*)(ws + WS_PSS);
    LAS float* scr = (LAS float*)(lds + wave * 17408);
    bf16_t* Halo = (bf16_t*)(dob + DO_HALO); bf16_t* GWb = (bf16_t*)(ws + WS_GW); bf16_t* GQKb = (bf16_t*)(dob + DO_GQK); float* GLv = (float*)(ws + WS_GLV); unsigned* qcnt = (unsigned*)(ws + WS_QCNT);
    bf16_t* W1T = (bf16_t*)(ws + WS_W1T); float* bias1 = (float*)(ws + WS_BIAS1); bf16_t* KCb = (bf16_t*)(ws + WS_KCB); bf16_t* VCb = (bf16_t*)(ws + WS_VCB);
    const int lo = args.ph_lo, hi = args.ph_hi;
    if (tid < 2) ((volatile LAS unsigned*)(lds + 147456 - 32))[tid] = 0u;
    __syncthreads();
    XcdBarrier xbar = xcd_barrier_post((unsigned*)(ws + WS_XBAR), (volatile LAS unsigned*)(lds + 147456 - 32));
    if (args.ph_hi > 1000) grid.sync();
#ifndef PHMASK
#define PHMASK 0x1ff
#endif
#define IN(k) (((PHMASK >> (k)) & 1) && lo <= (k) && (k) < hi)
#define GRID_SYNC() do { asm volatile("s_waitcnt vmcnt(0) lgkmcnt(0)" ::: "memory"); grid.sync(); \
        if (wave == 0) { __builtin_amdgcn_fence(__ATOMIC_ACQUIRE, "agent"); asm volatile("s_waitcnt vmcnt(0)" ::: "memory"); } __syncthreads(); } while (0)
#if defined(TPROBE)
#define STAMP(k) do { if (blockIdx.x == 0 && tid == 0) ((volatile LAS unsigned long long*)(lds + 147456 - 512))[k] = __builtin_amdgcn_s_memrealtime(); } while (0)
#else
#define STAMP(k) do { } while (0)
#endif
#define SEAM(k) do { if (IN(k) && IN((k) + 1)) xcd_barrier(xbar); STAMP((k) + 1); } while (0)

    STAMP(0);
    if (IN(0)) {
        if (blockIdx.x == 0 && tid == 0) { *qcnt = 0u; ((volatile unsigned*)(ws + 786432))[4] = 0u; }
        constexpr int I_WIN = 16 * (NP1 / 64), I_WG = 16 * 32, I_DN = 16 * 16, I_OUT = 16 * 16, I_UP = 16 * 64;
        constexpr int I_W1 = 32 * 2, I_B1 = 64;
        constexpr int NITEMS = I_WIN + I_WG + 2 * I_DN + I_OUT + I_UP + 2 * I_W1 + I_B1;
        for (int it = gw; it < NITEMS; it += NGW) {
            int r = it;
            if (r < I_WIN) { transpose_item(args.in[2], INW, SrcWin{}, Win_t, D, 0, scr, r / (NP1 / 64), r % (NP1 / 64), lane); continue; } r -= I_WIN;
            if (r < I_WG) { transpose_item(args.in[2], INW, SrcIdent{6720}, Wg_t, D, 0, scr, r / 32, r % 32, lane); continue; } r -= I_WG;
            if (r < I_DN) { transpose_item(args.in[17], D, SrcIdent{0}, Wcat_t, 2 * D, 0, scr, r / 16, r % 16, lane); continue; } r -= I_DN;
            if (r < I_DN) { transpose_item(args.in[18], D, SrcIdent{0}, Wcat_t, 2 * D, D, scr, r / 16, r % 16, lane); continue; } r -= I_DN;
            if (r < I_OUT) { transpose_item(args.in[19], D, SrcIdent{0}, Wout_t, D, 0, scr, r / 16, r % 16, lane); continue; } r -= I_OUT;
            if (r < I_UP) { transpose_item(args.in[21], FF, SrcIdent{0}, Wup_t, D, 0, scr, r / 64, r % 64, lane); continue; } r -= I_UP;
            if (r < I_W1) { transpose_item(args.in[12], 128, SrcIdent{0}, W1T, 2048, 0, scr, r / 2, r % 2, lane); continue; } r -= I_W1;
            if (r < I_W1) { transpose_item(args.in[15], 128, SrcIdent{0}, W1T + 128 * 2048, 2048, 0, scr, r / 2, r % 2, lane); continue; } r -= I_W1;
            {
                const int which = r >> 5, kc = r & 31; const float* pos = args.in[which ? 14 : 11] + kc * 64; const float* w1 = args.in[which ? 15 : 12] + (size_t)kc * 64 * 128 + 2 * lane;
                float a0 = 0.f, a1 = 0.f;
#pragma unroll 16
                for (int k = 0; k < 64; ++k) { const float pk_ = pos[k]; const float2 w = *(const float2*)(w1 + (size_t)k * 128); a0 += pk_ * w.x; a1 += pk_ * w.y; }
                atomicAdd(bias1 + which * 128 + 2 * lane, a0); atomicAdd(bias1 + which * 128 + 2 * lane + 1, a1);
            }
        }
        const float* gain = args.in[1];
        f32x4 gv[4];
#pragma unroll
        for (int j = 0; j < 4; ++j) gv[j] = ((const f32x4*)gain)[lane + 64 * j];
        for (int m = gw; m < M; m += 2 * NGW) {
            const int m2 = (m + NGW < M) ? m + NGW : m;
            const f32x4* xr = (const f32x4*)(x + (size_t)m * D) + lane; const f32x4* xr2 = (const f32x4*)(x + (size_t)m2 * D) + lane;
            f32x4 v[4], u[4]; float s1 = 0.f, s2 = 0.f;
#pragma unroll
            for (int j = 0; j < 4; ++j) { v[j] = xr[64 * j]; u[j] = xr2[64 * j]; }
#pragma unroll
            for (int j = 0; j < 4; ++j) { s1 += (v[j].x * v[j].x + v[j].y * v[j].y) + (v[j].z * v[j].z + v[j].w * v[j].w); s2 += (u[j].x * u[j].x + u[j].y * u[j].y) + (u[j].z * u[j].z + u[j].w * u[j].w); }
            const float r1 = rsqrtf(wave_sum(s1) * (1.f / D) + EPS), r2 = rsqrtf(wave_sum(s2) * (1.f / D) + EPS);
            unsigned long long* o8 = (unsigned long long*)(Hb + (size_t)m * D) + lane; unsigned long long* o9 = (unsigned long long*)(Hb + (size_t)m2 * D) + lane;
#pragma unroll
            for (int j = 0; j < 4; ++j) { const f32x4 y = v[j] * r1 * gv[j]; o8[64 * j] = (unsigned long long)pk2(y.x, y.y) | ((unsigned long long)pk2(y.z, y.w) << 32); }
            if (m2 != m) {
#pragma unroll
                for (int j = 0; j < 4; ++j) { const f32x4 y = u[j] * r2 * gv[j]; o9[64 * j] = (unsigned long long)pk2(y.x, y.y) | ((unsigned long long)pk2(y.z, y.w) << 32); } }
        }
    }
    SEAM(0);
    if (IN(1)) {
        pg8::Gemm g{Hb, Win_t, D, D, M, NP1, D, 0}; pg8::StaticOrder S; S.init(M, NP1, G, (int)blockIdx.x);
        pg8::EpiP<0> E{P, LDP, 26, 64, Halo};
        pg8::gemm_phase<pg8::EpiP<0>, pg8::StaticOrder, true>(lds, g, S, E);
    }
    SEAM(1);
    if (IN(2)) {
        for (int it = (G == 256) ? (((int)blockIdx.x & 1) ? 128 : (int)blockIdx.x >> 1) : (int)blockIdx.x; it < 128; it += G) {
            const int half = it & 1, which = (it >> 1) & 1, g_ = (it >> 2) & 3, b_ = it >> 4;
            nsa::compress_item(lds, P, W1T + (size_t)which * 128 * 2048, bias1 + which * 128, args.in[which ? 16 : 13], args.in[8], which ? VCb : KCb, b_, g_, which, half);
        }
        STAMP(11);
        nsa::prep_units(P, args.in[7], args.in[9], args.in[10], gw, NGW, lane);
        STAMP(12);
#if !defined(GDN_NAIVE)
        __syncthreads();
        {
            gdn::RowPre pre; int hl = -1;
            const int c_ = (int)blockIdx.x, hq = c_ >> 5, jq = c_ & 31;
            const bool bal = (G == 256);
            const int cnt = bal ? ((jq & 1) ? 9 : 7) : (2048 - c_ + G - 1) / G;
            const int first = bal ? ((jq & 1) ? 112 + 9 * (jq >> 1) : 7 * (jq >> 1)) : 0;
#define PREP_COORD(k, b_, n_, h_) do { if (bal) { const int idx_ = first + (k); b_ = idx_ >> 5; n_ = idx_ & 31; h_ = hq; } else { const int it_ = c_ + (k) * G; b_ = it_ >> 8; n_ = it_ & 31; h_ = (it_ >> 5) & 7; } } while (0)
            int b0, n0, h0;
            if (cnt > 0) { PREP_COORD(0, b0, n0, h0); gdn::prep_prefetch(pre, P, Halo, b0, n0, h0, wave, lane); }
            for (int k = 0; k < cnt; ++k) {
                int bc, nc, hc, bn = -1, nn = 0, hn = 0;
                PREP_COORD(k, bc, nc, hc);
                if (k + 1 < cnt) PREP_COORD(k + 1, bn, nn, hn);
                if (hc != hl) { __syncthreads(); gdn::prep_load_taps(lds, args.in[3], hc); hl = hc; __syncthreads(); }
                gdn::prep_item(lds, P, Halo, args.in[4], args.in[5], GWb, GQKb, GLv, pre, bc, nc, hc, bn, nn, hn);
                if (k == 0) STAMP(14);
            }
#undef PREP_COORD
        }
        STAMP(13);
#endif
    }
    SEAM(2);
    if (IN(3)) {
#if defined(GDN_NAIVE)
        if ((int)blockIdx.x < 16) gdn_naive::run(lds, P, args.in[3], args.in[4], args.in[5], args.in[6], 4 * (int)blockIdx.x);
#else
        if ((int)blockIdx.x < 64) gdn::scan_item(lds, P, GWb, GQKb, GLv, args.in[6], (int)blockIdx.x >> 3, (int)blockIdx.x & 7);
#endif
        __syncthreads();
        STAMP(10);
        for (;;) {
            volatile LAS unsigned* qslot = (volatile LAS unsigned*)(lds + 147456 - 16);
            if (tid == 0) *qslot = atomicAdd(qcnt, 1u);
            __syncthreads();
            const int idx = (int)*qslot;
            __syncthreads();
            if (idx >= 1024) break;
#if defined(TPROBE)
            if (blockIdx.x == 200 && tid == 0) { ((volatile unsigned long long*)(ws + 786432))[0] = __builtin_amdgcn_s_memrealtime(); ((volatile unsigned*)(ws + 786432))[4] += 1u; }
#endif
            nsa::attn_tile(lds, P, KCb, VCb, (idx & 31) >> 2, idx & 3, 31 - (idx >> 5));
        }
    }
    SEAM(3);
    if (IN(4)) {
        pg8::Gemm g{Hb, Wg_t, D, D, M, 2048, D, 0}; pg8::StaticOrder S; S.init(M, 2048, G, (int)blockIdx.x);
        pg8::EpiP<1> E{P, LDP, -1, 256, nullptr};
        pg8::gemm_phase<pg8::EpiP<1>, pg8::StaticOrder, true>(lds, g, S, E);
    }
    SEAM(4);
    if (IN(5)) {
        pg8::Gemm g{P + C_DZ, Wcat_t, LDP, 2 * D, M, D, D, D}; pg8::TwoPassOrder S; S.base.init(M, D, G, (int)blockIdx.x);
        pg8::EpiMix E{P, LDP, Mix, D};
        pg8::gemm_phase<pg8::EpiMix, pg8::TwoPassOrder, false>(lds, g, S, E);
    }
    SEAM(5);
    if (IN(6)) {
        for (int it = gw; it < 64 * 16; it += NGW) transpose_item(args.in[22], D, SrcIdent{0}, Wdown_t, FF, 0, scr, it / 16, it % 16, lane);
        __syncthreads();
        pg8::Gemm g{Mix, Wout_t, D, D, M, D, D, 0}; pg8::StaticOrder S; S.init(M, D, G, (int)blockIdx.x);
        pg8::EpiOut E{x, args.out, An, args.in[20], pss};
        pg8::gemm_phase<pg8::EpiOut, pg8::StaticOrder, false>(lds, g, S, E);
    }
    SEAM(6);
    if (IN(7)) {
        pg8::Gemm g{An, Wup_t, D, D, M, FF, D, 0}; pg8::StaticOrder S; S.init(M, FF, G, (int)blockIdx.x);
        pg8::EpiUp E{pss, Up, FF};
        pg8::gemm_phase<pg8::EpiUp, pg8::StaticOrder, true>(lds, g, S, E);
    }
    SEAM(7);
    if (IN(8)) {
        pg8::Gemm g{Up, Wdown_t, FF, FF, M, D, FF, 0}; pg8::StaticOrder S; S.init(M, D, G, (int)blockIdx.x);
        pg8::EpiDown E{args.out};
        pg8::gemm_phase<pg8::EpiDown, pg8::StaticOrder, false>(lds, g, S, E);
    }
#if defined(TPROBE)
    STAMP(9);
    GRID_SYNC();
    if (blockIdx.x == 0) {
        volatile LAS unsigned long long* ts = (volatile LAS unsigned long long*)(lds + 147456 - 512);
        if (tid == 0) { ts[25] = ((volatile unsigned long long*)(ws + 786432))[0]; ts[26] = ts[3] + 100ull * ((volatile unsigned*)(ws + 786432))[4]; }
        const float dA = (float)(ts[TPA1] - ts[TPA0]) * 0.01f, dB = (float)(ts[TPB1] - ts[TPB0]) * 0.01f;
        if (tid == 0) args.out[0] = dA + 0.f * dB;
    }
#endif
#undef IN
#undef SEAM
#undef GRID_SYNC
}

#undef lane
static int g_grid = 0;
static void launch_mk(const Args& a0, int lo, int hi, hipStream_t stream) {
    Args a = a0; a.ph_lo = lo; a.ph_hi = hi;
    void* kargs[] = {(void*)&a};
    hipError_t e = hipLaunchCooperativeKernel((const void*)mk_fwd, dim3(g_grid), dim3(NWAVES * 64), kargs, LDS_BYTES, stream);
    if (e != hipSuccess) fprintf(stderr, "cooperative launch failed: %s (grid %d)\n", hipGetErrorString(e), g_grid);
}

extern "C" void kernel_launch(void* const* d_in, const int* in_sizes, int n_in, void* d_out, int out_size, void* d_ws, size_t ws_size, hipStream_t stream) {
    if (g_grid == 0) {
        int dev = 0, cus = 0, per_cu = 0;
        hipGetDevice(&dev);
        hipDeviceGetAttribute(&cus, hipDeviceAttributeMultiprocessorCount, dev);
        hipFuncSetAttribute((const void*)mk_fwd, hipFuncAttributeMaxDynamicSharedMemorySize, LDS_BYTES);
        hipOccupancyMaxActiveBlocksPerMultiprocessor(&per_cu, (const void*)mk_fwd, NWAVES * 64, LDS_BYTES);
        if (per_cu < 1) per_cu = 1;
        if (per_cu > 1) per_cu = 1;
        g_grid = cus * per_cu;
    }
    Args a{};
    for (int i = 0; i < 23; ++i) a.in[i] = (const float*)d_in[i];
    a.out = (float*)d_out; a.ws = (unsigned char*)d_ws;
    bf16_t* P = (bf16_t*)((char*)d_ws + WS_P);
    hipMemsetAsync((char*)d_ws + WS_XBAR, 0, 16384 + 1024, stream);
    launch_mk(a, 0, 9, stream);
}
```

```cpp
#include <hip/hip_runtime.h>
#include <hip/hip_cooperative_groups.h>
#include <stdint.h>
#include <cstdio>
namespace cg = cooperative_groups;

typedef unsigned short bf16_t;

constexpr int D = 1024, BATCH = 8, SEQ = 2048, M = BATCH * SEQ;
constexpr int DN_H = 8, DN_D = 128;
constexpr int NS_H = 16, NS_G = 4, NS_R = 4, NS_D = 64;
constexpr int NCMP = 127, NSEL = 32;
constexpr int FF = 4096;
constexpr int INW = 8768;
constexpr float EPS = 1e-6f;
constexpr float NEGV = -1e30f, FORCEV = 1e9f;

constexpr int LDP = 6720;
constexpr int C_DQ = 0, C_DK = 1024, C_DV = 2048, C_DZ = 3072, C_NQ = 4096;
constexpr int C_KC = 5120, C_VC = 5376, C_KS = 5632, C_VS = 5888, C_KW = 6144, C_VW = 6400;
constexpr int C_SB = 6656, C_SA = 6664, C_SG = 6672;
constexpr int NP1 = 6912;

__device__ __forceinline__ float bf2f(bf16_t v) { return __uint_as_float(((unsigned)v) << 16); }
__device__ __forceinline__ bf16_t f2bf(float f) { unsigned u = __float_as_uint(f); return (bf16_t)((u + 0x7fffu + ((u >> 16) & 1u)) >> 16); }
__device__ __forceinline__ float sigmoidf_(float x) { return 1.f / (1.f + __expf(-x)); }
__device__ __forceinline__ float siluf_(float x) { return x * sigmoidf_(x); }
__device__ __forceinline__ float softplusf_(float x) { return fmaxf(x, 0.f) + log1pf(__expf(-fabsf(x))); }
__device__ __forceinline__ float gelu_tanh(float x) { return 0.5f * x * (1.f + tanhf(0.7978845608028654f * (x + 0.044715f * x * x * x))); }

__device__ __forceinline__ float block_sum(float v, float* red) {
    for (int o = 32; o > 0; o >>= 1) v += __shfl_xor(v, o);
    const int w = threadIdx.x >> 6, nw = blockDim.x >> 6;
    __syncthreads();
    if ((threadIdx.x & 63) == 0) red[w] = v;
    __syncthreads();
    float s = 0.f;
    for (int i = 0; i < nw; ++i) s += red[i];
    return s;
}
__device__ __forceinline__ float block_max(float v, float* red) {
    for (int o = 32; o > 0; o >>= 1) v = fmaxf(v, __shfl_xor(v, o));
    const int w = threadIdx.x >> 6, nw = blockDim.x >> 6;
    __syncthreads();
    if ((threadIdx.x & 63) == 0) red[w] = v;
    __syncthreads();
    float s = red[0];
    for (int i = 1; i < nw; ++i) s = fmaxf(s, red[i]);
    return s;
}


#if defined(TPROBE)
#define XSTAMP(k) do { if (blockIdx.x == 0 && threadIdx.x == 0) ((volatile __attribute__((address_space(3))) unsigned long long*)(lds + 147456 - 512))[k] = __builtin_amdgcn_s_memrealtime(); } while (0)
#else
#define XSTAMP(k) do { } while (0)
#endif
namespace gdn_naive {
#define GLAS __attribute__((address_space(3)))
__device__ __forceinline__ float sub_sum(float v, GLAS float* red, int sub, int tid) {
#pragma unroll
    for (int o = 32; o > 0; o >>= 1) v += __shfl_xor(v, o);
    __syncthreads();
    if ((tid & 63) == 0) red[sub * 2 + ((tid >> 6) & 1)] = v;
    __syncthreads();
    return red[sub * 2] + red[sub * 2 + 1];
}
__device__ __forceinline__ void run(GLAS unsigned char* lds, bf16_t* P, const float* convw, const float* a_log, const float* dt_bias, const float* out_norm, int item0) {
    const int tid = threadIdx.x, sub = tid >> 7, j = tid & 127;
    GLAS float* qs = (GLAS float*)lds + sub * 256; GLAS float* ks = qs + 128; GLAS float* red = (GLAS float*)(lds + 4096);
    const int item = item0 + sub; const int b = item / DN_H, h = item % DN_H;
    float s[128];
#pragma unroll
    for (int i = 0; i < 128; ++i) s[i] = 0.f;
    const float Ah = -__expf(a_log[h]), dtb = dt_bias[h], gn = out_norm[j];
    const float scale = 0.08838834764831845f;
    float wq[4], wk[4], wv[4], xq[3] = {0.f, 0.f, 0.f}, xk[3] = {0.f, 0.f, 0.f}, xv[3] = {0.f, 0.f, 0.f};
#pragma unroll
    for (int t = 0; t < 4; ++t) { wq[t] = convw[t * 3072 + h * 128 + j]; wk[t] = convw[t * 3072 + 1024 + h * 128 + j]; wv[t] = convw[t * 3072 + 2048 + h * 128 + j]; }
    for (int t = 0; t < SEQ; ++t) {
        bf16_t* row = P + (size_t)(b * SEQ + t) * LDP;
        const float rq = bf2f(row[C_DQ + h * DN_D + j]), rk = bf2f(row[C_DK + h * DN_D + j]), rv = bf2f(row[C_DV + h * DN_D + j]);
        float q = siluf_(wq[0] * xq[0] + wq[1] * xq[1] + wq[2] * xq[2] + wq[3] * rq);
        float k = siluf_(wk[0] * xk[0] + wk[1] * xk[1] + wk[2] * xk[2] + wk[3] * rk);
        const float v = siluf_(wv[0] * xv[0] + wv[1] * xv[1] + wv[2] * xv[2] + wv[3] * rv);
        xq[0] = xq[1]; xq[1] = xq[2]; xq[2] = rq; xk[0] = xk[1]; xk[1] = xk[2]; xk[2] = rk; xv[0] = xv[1]; xv[1] = xv[2]; xv[2] = rv;
        const float sq = sub_sum(q * q, red, sub, tid);
        const float sk = sub_sum(k * k, red, sub, tid);
        q *= rsqrtf(sq + EPS); k *= rsqrtf(sk + EPS);
        qs[j] = q; ks[j] = k;
        const float beta = sigmoidf_(bf2f(row[C_SB + h]));
        const float a = __expf(Ah * softplusf_(bf2f(row[C_SA + h]) + dtb));
        const float z = bf2f(row[C_DZ + h * DN_D + j]);
        __syncthreads();
        float kS = 0.f;
#pragma unroll
        for (int i = 0; i < 128; ++i) kS += ks[i] * s[i];
        const float dlt = beta * (v - a * kS);
        asm volatile("" ::: "memory");
        float o = 0.f;
#pragma unroll
        for (int i = 0; i < 128; ++i) { s[i] = a * s[i] + ks[i] * dlt; o += qs[i] * s[i]; }
        o *= scale;
        const float ss = sub_sum(o * o, red, sub, tid);
        row[C_DZ + h * DN_D + j] = f2bf(o * rsqrtf(ss * (1.f / 128.f) + EPS) * gn * siluf_(z));
    }
}
}
namespace gdn {
#define GL3 __attribute__((address_space(3)))
typedef short bf16x8 __attribute__((ext_vector_type(8)));
typedef short s16x4 __attribute__((ext_vector_type(4)));
typedef short v4i16_t __attribute__((ext_vector_type(4)));
typedef float f32x16 __attribute__((ext_vector_type(16)));
typedef float f32x4 __attribute__((ext_vector_type(4)));
typedef float f32x2 __attribute__((ext_vector_type(2)));
typedef unsigned u32x4 __attribute__((ext_vector_type(4)));
typedef unsigned u32x2 __attribute__((ext_vector_type(2)));
typedef __bf16 bf16x2_t __attribute__((ext_vector_type(2)));
constexpr float QSCALE = 0.08838834764831845f;
__device__ __forceinline__ float fsig(float x) { return __builtin_amdgcn_rcpf(1.f + __builtin_amdgcn_exp2f(-1.4426950408889634f * x)); }
__device__ __forceinline__ float fsilu(float x) { return x * fsig(x); }
__device__ __forceinline__ int crow(int i, int hi) { return (i & 3) + 8 * (i >> 2) + 4 * hi; }
__device__ __forceinline__ unsigned pk(float lo, float hi) { f32x2 v = {lo, hi}; bf16x2_t b = __builtin_convertvector(v, bf16x2_t); return __builtin_bit_cast(unsigned, b); }
__device__ __forceinline__ bf16x8 pack8(const float* v) { u32x4 w = {pk(v[0], v[1]), pk(v[2], v[3]), pk(v[4], v[5]), pk(v[6], v[7])}; return __builtin_bit_cast(bf16x8, w); }
__device__ __forceinline__ float blo(unsigned w) { return __uint_as_float(w << 16); }
__device__ __forceinline__ float bhi(unsigned w) { return __uint_as_float(w & 0xffff0000u); }
__device__ __forceinline__ char* seg_addr(bf16_t* P, size_t row0, int c0, unsigned e) { return (char*)P + ((row0 + (e >> 8)) * LDP + c0) * 2 + (e & 255u); }

__device__ __forceinline__ s16x4 vtr(GL3 const unsigned char* p) { return __builtin_bit_cast(s16x4, __builtin_amdgcn_ds_read_tr16_b64_v4i16((GL3 v4i16_t*)p)); }

constexpr int PL_K = 0, PL_KB = 16384, PL_Q = 32768, PL_RV = 49152, PL_AM = 81920, PL_INV = 99328, PL_MT = 116736, PL_GC = 120832, PL_QKST = 121088, PL_TI = 129280, PL_CW = 137472, PL_END = 143616;
constexpr int PL_WST = 0, PL_UST = 16384;
constexpr int AMLD = 68;
struct RowPre { u32x4 x[2][3][4]; unsigned short lb, la; };
__device__ __forceinline__ void prep_prefetch(RowPre& pre, const bf16_t* P, const bf16_t* HALO, int b, int n, int h, int wid, int lane) {
    const size_t row0 = (size_t)b * SEQ + 64 * n; const int dc = lane & 15;
    const bf16_t* prow = P + (row0 + lane) * LDP;
    pre.lb = prow[C_SB + h]; pre.la = prow[C_SA + h];
#pragma unroll
    for (int pass = 0; pass < 2; ++pass) {
        const int tok = 8 * wid + 4 * pass + (lane >> 4);
#pragma unroll
        for (int which = 0; which < 3; ++which) {
            const int col = which * 1024 + h * 128 + dc * 8;
#pragma unroll
            for (int j = 0; j < 4; ++j) {
                const int rr = tok - 3 + j; const bool inb = rr >= 0;
                const bf16_t* src = inb ? (P + (row0 + (inb ? rr : 0)) * LDP + col) : (HALO + ((size_t)((b * 32 + (n > 0 ? n - 1 : 0)) * 3 + (inb ? 0 : 3 + rr))) * 3072 + col);
                pre.x[pass][which][j] = *(const u32x4*)src;
            }
        }
    }
}
__device__ __forceinline__ void prep_load_taps(GL3 unsigned char* lds, const float* convw, int h) {
    GL3 float* cw = (GL3 float*)(lds + 137472);
    for (int e = threadIdx.x; e < 1536; e += 512) { const int which = e >> 9, j = (e >> 7) & 3, c = e & 127; cw[e] = convw[j * 3072 + which * 1024 + h * 128 + c]; }
}
#define PBAR() do { asm volatile("s_waitcnt lgkmcnt(0)" ::: "memory"); __builtin_amdgcn_s_barrier(); asm volatile("" ::: "memory"); } while (0)
__device__ __forceinline__ void prep_item(GL3 unsigned char* lds, bf16_t* P, const bf16_t* HALO, const float* a_log, const float* dt_bias,
                                          bf16_t* GW, bf16_t* GQK, float* GLv, RowPre& pre, int b, int n, int h, int nb_, int nn_, int nh_) {
    int tid = threadIdx.x; asm volatile("" : "+v"(tid));
    const int lane = tid & 63, r32 = lane & 31, hi = lane >> 5; const int wid = __builtin_amdgcn_readfirstlane(tid >> 6);
    const size_t row0 = (size_t)b * SEQ + 64 * n; const int item = (b * DN_H + h) * 32 + n;
    GL3 float* AM = (GL3 float*)(lds + PL_AM); GL3 float* INV = (GL3 float*)(lds + PL_INV); GL3 float* MT = (GL3 float*)(lds + PL_MT); GL3 float* GC = (GL3 float*)(lds + PL_GC);
    float gcum, beta_l, gc_last;
    {
        beta_l = fsig(bf2f(pre.lb));
        { const float xs = bf2f(pre.la) + dt_bias[h]; gcum = -__expf(a_log[h]) * (fmaxf(xs, 0.f) + __logf(1.f + __expf(-fabsf(xs)))); }
#pragma unroll
        for (int o = 1; o < 64; o <<= 1) { const float t = __shfl_up(gcum, o); if (lane >= o) gcum += t; }
        gc_last = __shfl(gcum, 63);
        if (wid == 0) GC[lane] = gcum;
    }
    bf16x8 qd_keep[2], ke_keep[2];
    const int dc = lane & 15;
#pragma unroll
    for (int pass = 0; pass < 2; ++pass) {
        const int tok = 8 * wid + 4 * pass + (lane >> 4);
        const float gct = __shfl(gcum, tok), bet = __shfl(beta_l, tok);
        float y[3][8];
#pragma unroll
        for (int which = 0; which < 3; ++which) {
#pragma unroll
            for (int e = 0; e < 8; ++e) y[which][e] = 0.f;
#pragma unroll
            for (int j = 0; j < 4; ++j) {
                const int rr = tok - 3 + j;
                u32x4 x = pre.x[pass][which][j];
                if (rr < 0 && n == 0) x = (u32x4){0u, 0u, 0u, 0u};
                const f32x4 w0 = *(GL3 const f32x4*)(lds + PL_CW + ((which * 4 + j) * 128 + dc * 8) * 4), w1 = *(GL3 const f32x4*)(lds + PL_CW + ((which * 4 + j) * 128 + dc * 8 + 4) * 4);
                y[which][0] += w0[0] * blo(x.x); y[which][1] += w0[1] * bhi(x.x); y[which][2] += w0[2] * blo(x.y); y[which][3] += w0[3] * bhi(x.y);
                y[which][4] += w1[0] * blo(x.z); y[which][5] += w1[1] * bhi(x.z); y[which][6] += w1[2] * blo(x.w); y[which][7] += w1[3] * bhi(x.w);
            }
#pragma unroll
            for (int e = 0; e < 8; ++e) y[which][e] = fsilu(y[which][e]);
        }
        float sq = 0.f, sk = 0.f;
#pragma unroll
        for (int e = 0; e < 8; ++e) { sq += y[0][e] * y[0][e]; sk += y[1][e] * y[1][e]; }
#pragma unroll
        for (int o = 1; o < 16; o <<= 1) { sq += __shfl_xor(sq, o); sk += __shfl_xor(sk, o); }
        const float rq = rsqrtf(sq + EPS), rk = rsqrtf(sk + EPS);
        const float eg = __expf(gct), ke_s = __expf(gc_last - gct);
        float q8[8], k8[8], kb8[8], qd8[8], ke8[8], kbg8[8], vb8[8];
#pragma unroll
        for (int e = 0; e < 8; ++e) { q8[e] = y[0][e] * rq; k8[e] = y[1][e] * rk; kb8[e] = k8[e] * bet; qd8[e] = q8[e] * (QSCALE * eg); ke8[e] = k8[e] * ke_s; kbg8[e] = kb8[e] * eg; vb8[e] = y[2][e] * bet; }
        const int io = (dc * 64 + tok) * 16;
        *(GL3 bf16x8*)(lds + PL_Q + io) = pack8(q8); *(GL3 bf16x8*)(lds + PL_K + io) = pack8(k8); *(GL3 bf16x8*)(lds + PL_KB + io) = pack8(kb8);
        {
            const int rvo = (tok >> 4) * 1024 + ((tok >> 3) & 1) * 512 + (tok & 7) * 64 + (dc & 3) * 16;
            *(GL3 bf16x8*)(lds + PL_RV + (dc >> 2) * 4096 + rvo) = pack8(kbg8); *(GL3 bf16x8*)(lds + PL_RV + (4 + (dc >> 2)) * 4096 + rvo) = pack8(vb8);
        }
        qd_keep[pass] = pack8(qd8); ke_keep[pass] = pack8(ke8);
    }
    PBAR();
    if (nb_ >= 0) prep_prefetch(pre, P, HALO, nb_, nn_, nh_, wid, lane);
    if (n == 0 && b == 0 && h == 0) XSTAMP(15);
#pragma unroll
    for (int pass = 0; pass < 2; ++pass) {
        const int tok = 8 * wid + 4 * pass + (lane >> 4);
        *(bf16x8*)seg_addr(P, row0, C_DQ + h * 128, (unsigned)((dc * 64 + tok) * 16)) = qd_keep[pass];
        const unsigned ek = (unsigned)(((dc >> 2) * 4 + (tok >> 4)) * 1024 + ((tok >> 3) & 1) * 512 + (tok & 7) * 64 + (dc & 3) * 16);
        *(bf16x8*)seg_addr(P, row0, C_DK + h * 128, ek) = ke_keep[pass];
    }
    if (wid < 6) {
        const bool isA = wid < 3; const int t3 = isA ? wid : wid - 3;
        const int rt = isA ? (t3 > 0) : (t3 == 2);
        const int ct = isA ? (t3 == 2) : (t3 > 0);
        GL3 const unsigned char* aimg = lds + (isA ? PL_KB : PL_K); GL3 const unsigned char* bimg = lds + (isA ? PL_K : PL_Q);
        f32x16 acc = f32x16{};
#pragma unroll
        for (int s = 0; s < 8; ++s) {
            const bf16x8 a = *(GL3 const bf16x8*)(aimg + ((2 * s + hi) * 64 + 32 * rt + r32) * 16);
            const bf16x8 bb = *(GL3 const bf16x8*)(bimg + ((2 * s + hi) * 64 + 32 * ct + r32) * 16);
            acc = __builtin_amdgcn_mfma_f32_32x32x16_bf16(a, bb, acc, 0, 0, 0);
        }
        if (isA) {
            const int j = 32 * ct + r32; const float gj = GC[j];
#pragma unroll
            for (int i_ = 0; i_ < 16; ++i_) { const int i = 32 * rt + crow(i_, hi); AM[i * AMLD + j] = (j < i) ? acc[i_] * __expf(GC[i] - gj) : 0.f; }
        } else {
            const int i = 32 * ct + r32; const float gi = GC[i];
            float v[16];
#pragma unroll
            for (int i_ = 0; i_ < 16; ++i_) { const int j = 32 * rt + crow(i_, hi); v[i_] = (j <= i) ? acc[i_] * (QSCALE * __expf(gi - GC[j])) : 0.f; }
#pragma unroll
            for (int sp = 0; sp < 2; ++sp) *(GL3 bf16x8*)(lds + PL_QKST + (((2 * rt + sp) * 64 + i) * 16 + 8 * hi) * 2) = pack8(v + 8 * sp);
        }
    } else if (wid == 6) {
        const bf16x8 z = {0, 0, 0, 0, 0, 0, 0, 0};
#pragma unroll
        for (int sp = 0; sp < 2; ++sp) *(GL3 bf16x8*)(lds + PL_QKST + (((2 + sp) * 64 + r32) * 16 + 8 * hi) * 2) = z;
    }
    PBAR();
    if (wid < 4 && lane < 16) {
        const int bb = wid, c = lane;
        float x[16];
#pragma unroll
        for (int i = 0; i < 16; ++i) {
            float acc = (i == c) ? 1.f : 0.f;
#pragma unroll
            for (int j4 = 0; j4 < i; j4 += 4) { const f32x4 a = *(GL3 const f32x4*)(AM + (16 * bb + i) * AMLD + 16 * bb + j4);
                acc -= a[0] * x[j4]; if (j4 + 1 < i) acc -= a[1] * x[j4 + 1]; if (j4 + 2 < i) acc -= a[2] * x[j4 + 2]; if (j4 + 3 < i) acc -= a[3] * x[j4 + 3]; }
            x[i] = acc;
        }
#pragma unroll
        for (int i = 0; i < 16; ++i) INV[(16 * bb + i) * AMLD + 16 * bb + c] = x[i];
    }
    PBAR();
    for (int L = 1; L < 4; ++L) {
        const int nb = 4 - L;
        for (int t = tid; t < nb * 256; t += 512) {
            const int J = t >> 8, I = J + L, ei = (t >> 4) & 15, ej = t & 15;
            float acc = 0.f;
            for (int K = J; K < I; ++K) {
#pragma unroll
                for (int k4 = 0; k4 < 16; k4 += 4) { const f32x4 a = *(GL3 const f32x4*)(AM + (16 * I + ei) * AMLD + 16 * K + k4);
                    acc += a[0] * INV[(16 * K + k4) * AMLD + 16 * J + ej] + a[1] * INV[(16 * K + k4 + 1) * AMLD + 16 * J + ej] + a[2] * INV[(16 * K + k4 + 2) * AMLD + 16 * J + ej] + a[3] * INV[(16 * K + k4 + 3) * AMLD + 16 * J + ej]; }
            }
            MT[(J * 16 + ei) * 17 + ej] = acc;
        }
        PBAR();
        for (int t = tid; t < nb * 256; t += 512) {
            const int J = t >> 8, I = J + L, ei = (t >> 4) & 15, ej = t & 15;
            float acc = 0.f;
#pragma unroll
            for (int k4 = 0; k4 < 16; k4 += 4) { const f32x4 d = *(GL3 const f32x4*)(INV + (16 * I + ei) * AMLD + 16 * I + k4);
                acc += d[0] * MT[(J * 16 + k4) * 17 + ej] + d[1] * MT[(J * 16 + k4 + 1) * 17 + ej] + d[2] * MT[(J * 16 + k4 + 2) * 17 + ej] + d[3] * MT[(J * 16 + k4 + 3) * 17 + ej]; }
            INV[(16 * I + ei) * AMLD + 16 * J + ej] = -acc;
        }
        PBAR();
    }
    {
        const int s_ = tid >> 7, i = (tid >> 1) & 63, hh = tid & 1;
        float v[8];
        if (s_ > (i >> 4)) {
#pragma unroll
            for (int e = 0; e < 8; ++e) v[e] = 0.f;
        } else {
            const f32x4 a = *(GL3 const f32x4*)(INV + i * AMLD + 16 * s_ + 4 * hh), c4 = *(GL3 const f32x4*)(INV + i * AMLD + 16 * s_ + 8 + 4 * hh);
            v[0] = a[0]; v[1] = a[1]; v[2] = a[2]; v[3] = a[3]; v[4] = c4[0]; v[5] = c4[1]; v[6] = c4[2]; v[7] = c4[3];
        }
        *(GL3 bf16x8*)(lds + PL_TI + ((s_ * 64 + i) * 16 + 8 * hh) * 2) = pack8(v);
    }
    PBAR();
    {
        const int cb = wid;
        GL3 const unsigned char* rp = lds + PL_RV + cb * 4096 + ((lane >> 4) & 1) * 32 + (lane & 3) * 8 + (4 * hi + ((lane & 15) >> 2)) * 64;
        f32x16 d0 = f32x16{}, d1 = f32x16{};
#pragma unroll
        for (int ks = 0; ks < 4; ++ks) {
            const s16x4 lo = vtr(rp + ks * 1024), hh2 = vtr(rp + ks * 1024 + 512);
            const bf16x8 rf = {lo[0], lo[1], lo[2], lo[3], hh2[0], hh2[1], hh2[2], hh2[3]};
            const bf16x8 t1 = *(GL3 const bf16x8*)(lds + PL_TI + ((ks * 64 + 32 + r32) * 16 + 8 * hi) * 2);
            if (cb < 4) {
                if (ks < 2) { const bf16x8 t0 = *(GL3 const bf16x8*)(lds + PL_TI + ((ks * 64 + r32) * 16 + 8 * hi) * 2); d0 = __builtin_amdgcn_mfma_f32_32x32x16_bf16(rf, t0, d0, 0, 0, 0); }
                d1 = __builtin_amdgcn_mfma_f32_32x32x16_bf16(rf, t1, d1, 0, 0, 0);
            } else {
                if (ks < 2) { const bf16x8 t0 = *(GL3 const bf16x8*)(lds + PL_TI + ((ks * 64 + r32) * 16 + 8 * hi) * 2); d0 = __builtin_amdgcn_mfma_f32_32x32x16_bf16(t0, rf, d0, 0, 0, 0); }
                d1 = __builtin_amdgcn_mfma_f32_32x32x16_bf16(t1, rf, d1, 0, 0, 0);
            }
        }
        PBAR();
        if (cb < 4) {
#pragma unroll
            for (int a = 0; a < 4; ++a) {
                u32x2 w0 = {pk(d0[4 * a], d0[4 * a + 1]), pk(d0[4 * a + 2], d0[4 * a + 3])}, w1 = {pk(d1[4 * a], d1[4 * a + 1]), pk(d1[4 * a + 2], d1[4 * a + 3])};
                *(GL3 u32x2*)(lds + PL_WST + ((4 * cb + a) * 64 + r32) * 16 + 8 * hi) = w0;
                *(GL3 u32x2*)(lds + PL_WST + ((4 * cb + a) * 64 + 32 + r32) * 16 + 8 * hi) = w1;
            }
        } else {
            const int dvc = 32 * (cb - 4) + r32;
#pragma unroll
            for (int i = 0; i < 16; ++i) { *(GL3 bf16_t*)(lds + PL_UST + (crow(i, hi) * 128 + dvc) * 2) = f2bf(d0[i]); *(GL3 bf16_t*)(lds + PL_UST + ((32 + crow(i, hi)) * 128 + dvc) * 2) = f2bf(d1[i]); }
        }
    }
    PBAR();
#pragma unroll
    for (int k = 0; k < 2; ++k) {
        const int e = (tid + 512 * k) * 16;
        *(u32x4*)((char*)(GW + (size_t)item * 8192) + e) = *(GL3 const u32x4*)(lds + PL_WST + e);
        *(u32x4*)seg_addr(P, row0, C_DV + h * 128, (unsigned)e) = *(GL3 const u32x4*)(lds + PL_UST + e);
    }
    *(u32x4*)((char*)(GQK + (size_t)item * 4096) + tid * 16) = *(GL3 const u32x4*)(lds + PL_QKST + tid * 16);
    if (tid == 0) GLv[item] = __expf(gc_last);
    PBAR();
}

#undef PBAR
constexpr int SL_W = 0, SL_QD = 16384, SL_KE = 32768, SL_QK = 49152, SL_U = 57344, SL_Z = 73728, SL_S = 90112, SL_VN = 122880, SL_RS = 139264, SL_END = 140416;
__device__ __forceinline__ void glds16(const void* gsrc, unsigned lds_dst) { unsigned keep;
    asm volatile("s_mov_b32 %0, m0\n\ts_mov_b32 m0, %2\n\ts_nop 0\n\tglobal_load_lds_dwordx4 %1, off\n\ts_mov_b32 m0, %0" : "=&s"(keep) : "v"(gsrc), "s"(lds_dst) : "memory"); }
__device__ __forceinline__ unsigned lds_addr(GL3 unsigned char* p) { return (unsigned)(size_t)p; }
__device__ __forceinline__ void dma_seg(GL3 unsigned char* dst, const bf16_t* P, size_t row0, int c0, int wid, int lane) {
#pragma unroll
    for (int k = 0; k < 2; ++k) { const int piece = wid + 8 * k;
        const char* src = (const char*)P + ((row0 + piece * 4 + (lane >> 4)) * LDP + c0) * 2 + (lane & 15) * 16;
        glds16(src, (unsigned)__builtin_amdgcn_readfirstlane((int)(lds_addr(dst) + piece * 1024))); }
}
template <int NPIECES>
__device__ __forceinline__ void dma_lin(GL3 unsigned char* dst, const bf16_t* src, int wid, int lane) {
#pragma unroll
    for (int k = 0; k < NPIECES / 8; ++k) { const int piece = wid + 8 * k;
        glds16((const char*)src + piece * 1024 + lane * 16, (unsigned)__builtin_amdgcn_readfirstlane((int)(lds_addr(dst) + piece * 1024))); }
}

__device__ __forceinline__ float sum32(float v) {
    v += __builtin_bit_cast(float, __builtin_amdgcn_mov_dpp(__builtin_bit_cast(int, v), 0xB1, 0xF, 0xF, true));
    v += __builtin_bit_cast(float, __builtin_amdgcn_mov_dpp(__builtin_bit_cast(int, v), 0x4E, 0xF, 0xF, true));
    v += __builtin_bit_cast(float, __builtin_amdgcn_mov_dpp(__builtin_bit_cast(int, v), 0x141, 0xF, 0xF, true));
    v += __builtin_bit_cast(float, __builtin_amdgcn_mov_dpp(__builtin_bit_cast(int, v), 0x140, 0xF, 0xF, true));
    v += __shfl_xor(v, 16);
    return v;
}
#define GRAWBAR() do { asm volatile("s_waitcnt lgkmcnt(0)" ::: "memory"); __builtin_amdgcn_s_barrier(); asm volatile("" ::: "memory"); } while (0)
#define GWAITV0() asm volatile("s_waitcnt vmcnt(0)" ::: "memory")
constexpr int SL_GL = SL_RS + 1024;
__device__ __forceinline__ void scan_item(GL3 unsigned char* lds, bf16_t* P, const bf16_t* GW, const bf16_t* GQK, const float* GLv, const float* out_norm, int b, int h) {
    const int tid = threadIdx.x, lane = tid & 63, r32 = lane & 31, hi = lane >> 5; const int wid = __builtin_amdgcn_readfirstlane(tid >> 6);
    const int mt = wid >> 2, nt = wid & 3;
    const int dv = 32 * nt + r32;
    const int item0 = (b * DN_H + h) * 32; const size_t rowb = (size_t)b * SEQ;
    f32x16 S0 = f32x16{}, S1 = f32x16{};
    {
        const u32x4 z = {0u, 0u, 0u, 0u};
#pragma unroll
        for (int k = 0; k < 4; ++k) *(GL3 u32x4*)(lds + SL_S + (tid + 512 * k) * 16) = z;
        if (tid < 32) *(GL3 float*)(lds + SL_GL + tid * 4) = GLv[item0 + tid];
    }
    const float gain = out_norm[dv];
    GL3 float* RS = (GL3 float*)(lds + SL_RS);
#define ISSUE_A(n_) do { dma_lin<16>(lds + SL_W, GW + (size_t)(item0 + (n_)) * 8192, wid, lane); dma_seg(lds + SL_QD, P, rowb + 64 * (n_), C_DQ + h * 128, wid, lane); dma_seg(lds + SL_U, P, rowb + 64 * (n_), C_DV + h * 128, wid, lane); } while (0)
#define ISSUE_B(n_) do { dma_seg(lds + SL_KE, P, rowb + 64 * (n_), C_DK + h * 128, wid, lane); dma_lin<8>(lds + SL_QK, GQK + (size_t)(item0 + (n_)) * 4096, wid, lane); dma_seg(lds + SL_Z, P, rowb + 64 * (n_), C_DZ + h * 128, wid, lane); } while (0)
    GWAITV0();
    ISSUE_A(0);
    for (int n = 0; n < 32; ++n) {
        if (n == 6) XSTAMP(26);
        const size_t row0 = rowb + 64 * n;
        if (n == 5) XSTAMP(18);
        GWAITV0(); GRAWBAR();
        if (n == 5) XSTAMP(19);
        ISSUE_B(n);
        const float gl = *(GL3 const float*)(lds + SL_GL + n * 4);
        f32x16 vp = f32x16{}, o = f32x16{};
#pragma unroll
        for (int s = 0; s < 8; ++s) {
            const bf16x8 sb = *(GL3 const bf16x8*)(lds + SL_S + ((2 * s + hi) * 128 + dv) * 16);
            const bf16x8 wa = *(GL3 const bf16x8*)(lds + SL_W + ((2 * s + hi) * 64 + 32 * mt + r32) * 16);
            const bf16x8 qa = *(GL3 const bf16x8*)(lds + SL_QD + ((2 * s + hi) * 64 + 32 * mt + r32) * 16);
            vp = __builtin_amdgcn_mfma_f32_32x32x16_bf16(wa, sb, vp, 0, 0, 0);
            o = __builtin_amdgcn_mfma_f32_32x32x16_bf16(qa, sb, o, 0, 0, 0);
        }
        {
            float v[16];
#pragma unroll
            for (int i = 0; i < 16; ++i) v[i] = bf2f(*(GL3 const bf16_t*)(lds + SL_U + ((32 * mt + crow(i, hi)) * 128 + dv) * 2)) - vp[i];
#pragma unroll
            for (int sp = 0; sp < 2; ++sp) *(GL3 bf16x8*)(lds + SL_VN + (((2 * mt + sp) * 128 + dv) * 16 + 8 * hi) * 2) = pack8(v + 8 * sp);
        }
        if (n == 5) XSTAMP(20);
        GWAITV0(); GRAWBAR();
        if (n == 5) XSTAMP(21);
        if (n + 1 < 32) ISSUE_A(n + 1);
#pragma unroll
        for (int i = 0; i < 16; ++i) { S0[i] *= gl; S1[i] *= gl; }
        {
            GL3 const unsigned char* kp0 = lds + SL_KE + (2 * mt) * 4096 + ((lane >> 4) & 1) * 32 + (lane & 3) * 8 + (4 * hi + ((lane & 15) >> 2)) * 64;
#pragma unroll
            for (int ks = 0; ks < 4; ++ks) {
                const bf16x8 vb = *(GL3 const bf16x8*)(lds + SL_VN + ((ks * 128 + dv) * 16 + 8 * hi) * 2);
                const s16x4 l0 = vtr(kp0 + ks * 1024), h0 = vtr(kp0 + ks * 1024 + 512), l1 = vtr(kp0 + 4096 + ks * 1024), h1 = vtr(kp0 + 4096 + ks * 1024 + 512);
                const bf16x8 k0 = {l0[0], l0[1], l0[2], l0[3], h0[0], h0[1], h0[2], h0[3]}, k1 = {l1[0], l1[1], l1[2], l1[3], h1[0], h1[1], h1[2], h1[3]};
                const bf16x8 qa = *(GL3 const bf16x8*)(lds + SL_QK + ((ks * 64 + 32 * mt + r32) * 16 + 8 * hi) * 2);
                S0 = __builtin_amdgcn_mfma_f32_32x32x16_bf16(k0, vb, S0, 0, 0, 0);
                S1 = __builtin_amdgcn_mfma_f32_32x32x16_bf16(k1, vb, S1, 0, 0, 0);
                o = __builtin_amdgcn_mfma_f32_32x32x16_bf16(qa, vb, o, 0, 0, 0);
            }
        }
#pragma unroll
        for (int i = 0; i < 16; ++i) { const float q = sum32(o[i] * o[i]); if (r32 == 0) RS[(32 * mt + crow(i, hi)) * 4 + nt] = q; }
        if (n == 5) XSTAMP(22);
        GRAWBAR();
        if (n == 5) XSTAMP(23);
#pragma unroll
        for (int a = 0; a < 4; ++a) {
            u32x2 w0 = {pk(S0[4 * a], S0[4 * a + 1]), pk(S0[4 * a + 2], S0[4 * a + 3])}, w1 = {pk(S1[4 * a], S1[4 * a + 1]), pk(S1[4 * a + 2], S1[4 * a + 3])};
            *(GL3 u32x2*)(lds + SL_S + ((4 * (2 * mt) + a) * 128 + dv) * 16 + 8 * hi) = w0;
            *(GL3 u32x2*)(lds + SL_S + ((4 * (2 * mt + 1) + a) * 128 + dv) * 16 + 8 * hi) = w1;
        }
#pragma unroll
        for (int i = 0; i < 16; ++i) { const int tok = 32 * mt + crow(i, hi);
            const f32x4 rs = *(GL3 const f32x4*)(RS + tok * 4);
            const float rstd = rsqrtf(((rs[0] + rs[1]) + (rs[2] + rs[3])) * (1.f / 128.f) + EPS);
            const float z = bf2f(*(GL3 const bf16_t*)(lds + SL_Z + (tok * 128 + dv) * 2));
            *(GL3 bf16_t*)(lds + SL_VN + (tok * 128 + dv) * 2) = f2bf(o[i] * rstd * gain * fsilu(z)); }
        if (n == 5) XSTAMP(24);
        GRAWBAR();
        if (n == 5) XSTAMP(25);
#pragma unroll
        for (int k = 0; k < 2; ++k) { const int e = (tid + 512 * k) * 16; *(u32x4*)seg_addr(P, row0, C_DZ + h * 128, (unsigned)e) = *(GL3 const u32x4*)(lds + SL_VN + e); }
    }
    GWAITV0();
    __syncthreads();
#undef ISSUE_A
#undef ISSUE_B
}
}
namespace nsa {
#define NLAS __attribute__((address_space(3)))
typedef short bf16x8 __attribute__((ext_vector_type(8)));
typedef short s16x4 __attribute__((ext_vector_type(4)));
typedef short v4i16_t __attribute__((ext_vector_type(4)));
typedef float f32x16 __attribute__((ext_vector_type(16)));
typedef float f32x4 __attribute__((ext_vector_type(4)));
typedef float f32x2 __attribute__((ext_vector_type(2)));
typedef unsigned u32x4 __attribute__((ext_vector_type(4)));
typedef __bf16 bf16x2_t __attribute__((ext_vector_type(2)));
constexpr float LOG2E = 1.4426950408889634f;
constexpr float NEG = -1e30f;
constexpr int L_KV = 0;
constexpr int L_IMP = 32768;
constexpr int L_SEL = 66560;
constexpr int L_WS = 67072;
constexpr int L_OST = 69120;
constexpr int L_END = 101888;

__device__ __forceinline__ int crow(int i, int hi) { return (i & 3) + 8 * (i >> 2) + 4 * hi; }
__device__ __forceinline__ unsigned pk(float lo, float hi) { f32x2 v = {lo, hi}; bf16x2_t b = __builtin_convertvector(v, bf16x2_t); return __builtin_bit_cast(unsigned, b); }
__device__ __forceinline__ float xhalf_max(float v) { auto rr = __builtin_amdgcn_permlane32_swap(__float_as_uint(v), __float_as_uint(v), false, false); return fmaxf(__uint_as_float(rr[0]), __uint_as_float(rr[1])); }
__device__ __forceinline__ float xhalf_sum(float v) { auto rr = __builtin_amdgcn_permlane32_swap(__float_as_uint(v), __float_as_uint(v), false, false); return __uint_as_float(rr[0]) + __uint_as_float(rr[1]); }

__device__ __forceinline__ void dma_tile(NLAS unsigned char* slot, const bf16_t* Kb, const bf16_t* Vb, unsigned koff, unsigned voff, int wid) {
    __builtin_amdgcn_global_load_lds((const unsigned*)((const char*)Kb + koff), (NLAS unsigned*)(slot + wid * 1024), 16, 0, 0);
    __builtin_amdgcn_global_load_lds((const unsigned*)((const char*)Vb + voff), (NLAS unsigned*)(slot + 8192 + wid * 1024), 16, 0, 0);
}
__device__ __forceinline__ void tile_offs(unsigned& koff, unsigned& voff, int pitch, int wid, int lane) {
    koff = (unsigned)(lane * pitch + wid * 8) * 2u;
    voff = (unsigned)((16 * (wid & 3) + (lane >> 2)) * pitch + (wid >> 2) * 32 + (lane & 3) * 8) * 2u;
}
__device__ __forceinline__ void qkt(f32x16& p0, f32x16& p1, NLAS const unsigned char* Kslot, const bf16x8* qr, const f32x16& c0, const f32x16& c1, int r32, int hi) {
    NLAS const unsigned char* kb = Kslot + hi * 1024 + r32 * 16;
#pragma unroll
    for (int d0 = 0; d0 < 4; ++d0) {
        const bf16x8 b0 = *(NLAS const bf16x8*)(kb + d0 * 2048);
        const bf16x8 b1 = *(NLAS const bf16x8*)(kb + d0 * 2048 + 512);
        if (d0 == 0) { p0 = __builtin_amdgcn_mfma_f32_32x32x16_bf16(b0, qr[0], c0, 0, 0, 0); p1 = __builtin_amdgcn_mfma_f32_32x32x16_bf16(b1, qr[0], c1, 0, 0, 0); }
        else { p0 = __builtin_amdgcn_mfma_f32_32x32x16_bf16(b0, qr[d0], p0, 0, 0, 0); p1 = __builtin_amdgcn_mfma_f32_32x32x16_bf16(b1, qr[d0], p1, 0, 0, 0); }
    }
}
__device__ __forceinline__ s16x4 vtr(NLAS const unsigned char* p) { return __builtin_bit_cast(s16x4, __builtin_amdgcn_ds_read_tr16_b64_v4i16((NLAS v4i16_t*)p)); }
__device__ __forceinline__ void pv(f32x16* o, NLAS const unsigned char* Vslot, const f32x16& p0, const f32x16& p1, int lane, int hi) {
    u32x4 w0 = {pk(p0[0], p0[1]), pk(p0[2], p0[3]), pk(p0[4], p0[5]), pk(p0[6], p0[7])};
    u32x4 w1 = {pk(p0[8], p0[9]), pk(p0[10], p0[11]), pk(p0[12], p0[13]), pk(p0[14], p0[15])};
    u32x4 w2 = {pk(p1[0], p1[1]), pk(p1[2], p1[3]), pk(p1[4], p1[5]), pk(p1[6], p1[7])};
    u32x4 w3 = {pk(p1[8], p1[9]), pk(p1[10], p1[11]), pk(p1[12], p1[13]), pk(p1[14], p1[15])};
    const bf16x8 pa[4] = {__builtin_bit_cast(bf16x8, w0), __builtin_bit_cast(bf16x8, w1), __builtin_bit_cast(bf16x8, w2), __builtin_bit_cast(bf16x8, w3)};
    NLAS const unsigned char* vp = Vslot + ((lane >> 4) & 1) * 32 + (lane & 3) * 8 + (4 * hi + ((lane & 15) >> 2)) * 64;
#pragma unroll
    for (int d0 = 0; d0 < 2; ++d0)
#pragma unroll
        for (int ks = 0; ks < 4; ++ks) {
            const s16x4 lo = vtr(vp + d0 * 4096 + ks * 1024), hh = vtr(vp + d0 * 4096 + ks * 1024 + 512);
            const bf16x8 vf = {lo[0], lo[1], lo[2], lo[3], hh[0], hh[1], hh[2], hh[3]};
            o[d0] = __builtin_amdgcn_mfma_f32_32x32x16_bf16(pa[ks], vf, o[d0], 0, 0, 0);
        }
}
__device__ __forceinline__ void scale_rows(f32x16* o, NLAS float* wsf, float s, int r32, int hi) {
    if (hi == 0) wsf[r32] = s;
#pragma unroll
    for (int i = 0; i < 16; ++i) { const float f = wsf[crow(i, hi)]; o[0][i] *= f; o[1][i] *= f; }
}
__device__ __forceinline__ void acc_rows(f32x16* tot, const f32x16* o, NLAS float* wsf, float s, int r32, int hi) {
    if (hi == 0) wsf[32 + r32] = s;
#pragma unroll
    for (int i = 0; i < 16; ++i) { const float f = wsf[32 + crow(i, hi)]; tot[0][i] += f * o[0][i]; tot[1][i] += f * o[1][i]; }
}
__device__ __forceinline__ void softmax_step(f32x16& p0, f32x16& p1, float& m, float& l, f32x16* o, NLAS float* wsf, int r32, int hi) {
    float t = fmaxf(p0[0], p1[0]);
#pragma unroll
    for (int i = 1; i < 16; ++i) t = fmaxf(t, fmaxf(p0[i], p1[i]));
    t = xhalf_max(t);
    if (__any(t - m > 8.f)) {
        const float mn = fmaxf(m, t);
        const float alpha = __builtin_amdgcn_exp2f(m - mn);
        l *= alpha; m = mn;
        scale_rows(o, wsf, alpha, r32, hi);
    }
    float s = 0.f;
#pragma unroll
    for (int i = 0; i < 16; ++i) { p0[i] = __builtin_amdgcn_exp2f(p0[i] - m); p1[i] = __builtin_amdgcn_exp2f(p1[i] - m); s += p0[i] + p1[i]; }
    l += s;
}

__device__ __forceinline__ void attn_tile(NLAS unsigned char* lds, bf16_t* P, const bf16_t* KC, const bf16_t* VC, int b, int g, int qt) {
    int tid = threadIdx.x; asm volatile("" : "+v"(tid));
    const int lane = tid & 63, r32 = lane & 31, hi = lane >> 5; const int wid = __builtin_amdgcn_readfirstlane(tid >> 6);
    const int head = g * 4 + (wid >> 1), qh = wid & 1, t0 = qt * 64, qi = qh * 32 + r32, blk_t = qt;
    NLAS float* wsf = (NLAS float*)(lds + L_WS) + wid * 64;
    NLAS float* imp = (NLAS float*)(lds + L_IMP);
    NLAS unsigned* selm = (NLAS unsigned*)(lds + L_SEL);
    NLAS unsigned char* slot0 = lds + L_KV; NLAS unsigned char* slot1 = lds + L_KV + 16384;
    const size_t rowbase = (size_t)b * SEQ;
    bf16_t* qrow = P + (rowbase + t0 + qi) * LDP;
    const float sl2 = exp2f(-0.5f * (float)(head + 1)) * LOG2E;
    bf16x8 qr[4];
#pragma unroll
    for (int d0 = 0; d0 < 4; ++d0) qr[d0] = *(const bf16x8*)(qrow + C_NQ + head * 64 + d0 * 16 + hi * 8);
#define FSIG(x) __builtin_amdgcn_rcpf(1.f + __builtin_amdgcn_exp2f(-LOG2E * (x)))
    const float gate_c = FSIG(bf2f(qrow[C_SG + head * 3 + 0])), gate_s = FSIG(bf2f(qrow[C_SG + head * 3 + 1])), gate_w = FSIG(bf2f(qrow[C_SG + head * 3 + 2]));
#undef FSIG
    f32x16 tot[2]; tot[0] = f32x16{}; tot[1] = f32x16{};
    XSTAMP(30);
#define CRF(i) ((float)(((i) & 3) + 8 * ((i) >> 2)) + 4.f * (float)hiv)
#define OPAQUE_HI() int hiv = hi; asm volatile("" : "+v"(hiv))

    {
        const bf16_t* kcb = KC + ((size_t)(b * NS_G + g) * 128) * 64; const bf16_t* vcb = VC + ((size_t)(b * NS_G + g) * 128) * 64;
        const bool two = (qt >= 16);
        unsigned kof, vof; tile_offs(kof, vof, 64, wid, lane);
        dma_tile(slot0, kcb, vcb, kof, vof, wid);
        if (two) dma_tile(slot1, kcb + 64 * 64, vcb + 64 * 64, kof, vof, wid);
        __syncthreads();
        f32x16 pA0, pA1, pB0, pB1, c0, c1;
        const float s16 = sl2 * 16.f; OPAQUE_HI();
#pragma unroll
        for (int i = 0; i < 16; ++i) { c0[i] = s16 * CRF(i); c1[i] = s16 * (CRF(i) + 32.f); }
        qkt(pA0, pA1, slot0, qr, c0, c1, r32, hi);
        const int cmax = (t0 + qi - 31) >> 4;
        const int qposm = t0 + qi - 31;
#pragma unroll
        for (int i = 0; i < 16; ++i) { const int c = crow(i, hiv); if (16 * c > qposm) pA0[i] = NEG; if (16 * (c + 32) > qposm) pA1[i] = NEG; }
        if (two) {
#pragma unroll
            for (int i = 0; i < 16; ++i) { c0[i] += s16 * 64.f; c1[i] += s16 * 64.f; }
            qkt(pB0, pB1, slot1, qr, c0, c1, r32, hi);
#pragma unroll
            for (int i = 0; i < 16; ++i) { const int c = 64 + crow(i, hiv); if (16 * c > qposm) pB0[i] = NEG; if (16 * (c + 32) > qposm) pB1[i] = NEG; }
        } else { pB0 = f32x16{}; pB1 = f32x16{}; }
        (void)cmax;
        float mx = NEG;
#pragma unroll
        for (int i = 0; i < 16; ++i) mx = fmaxf(mx, fmaxf(pA0[i], pA1[i]));
        if (two) {
#pragma unroll
            for (int i = 0; i < 16; ++i) mx = fmaxf(mx, fmaxf(pB0[i], pB1[i])); }
        mx = xhalf_max(mx);
        float s = 0.f;
#pragma unroll
        for (int i = 0; i < 16; ++i) { pA0[i] = __builtin_amdgcn_exp2f(pA0[i] - mx); pA1[i] = __builtin_amdgcn_exp2f(pA1[i] - mx); s += pA0[i] + pA1[i]; }
        if (two) {
#pragma unroll
            for (int i = 0; i < 16; ++i) { pB0[i] = __builtin_amdgcn_exp2f(pB0[i] - mx); pB1[i] = __builtin_amdgcn_exp2f(pB1[i] - mx); s += pB0[i] + pB1[i]; } }
        s = xhalf_sum(s);
        const float nrm = (t0 + qi >= 31) ? __builtin_amdgcn_rcpf(s) : 0.f;
#pragma unroll
        for (int i = 0; i < 16; ++i) { pA0[i] *= nrm; pA1[i] *= nrm; }
        if (two) {
#pragma unroll
            for (int i = 0; i < 16; ++i) { pB0[i] *= nrm; pB1[i] *= nrm; } }
#define PSEL(L) ((L) < 4 ? pA0 : (L) < 8 ? pA1 : (L) < 12 ? pB0 : pB1)
#define MAINV(L) ((PSEL(L)[4 * ((L) & 3)] + PSEL(L)[4 * ((L) & 3) + 1]) + (PSEL(L)[4 * ((L) & 3) + 2] + 0.5f * PSEL(L)[4 * ((L) & 3) + 3]))
#define CARRY(L) (0.5f * PSEL(L)[4 * ((L) & 3) + 3])
#pragma unroll
        for (int L = 0; L < 16; ++L) {
            const float cprev = (L > 0) ? CARRY(L > 0 ? L - 1 : 0) : 0.f;
            const float snd = hi ? cprev : CARRY(L);
            const float rcv = __shfl_xor(snd, 32);
            imp[((wid >> 1) * 64 + qi) * 33 + 2 * L + hi] = MAINV(L) + rcv;
        }
#undef PSEL
#undef MAINV
#undef CARRY
        f32x16 o[2]; o[0] = f32x16{}; o[1] = f32x16{};
        pv(o, slot0 + 8192, pA0, pA1, lane, hi);
        if (two) pv(o, slot1 + 8192, pB0, pB1, lane, hi);
        acc_rows(tot, o, wsf, gate_c, r32, hi);
    }
    __syncthreads();
    XSTAMP(31);
    {
        const int ql = 8 * wid + (lane >> 3), sub = lane & 7;
        float v[4];
#pragma unroll
        for (int e = 0; e < 4; ++e) { const int j = 4 * sub + e; v[e] = (imp[(0 * 64 + ql) * 33 + j] + imp[(1 * 64 + ql) * 33 + j]) + (imp[(2 * 64 + ql) * 33 + j] + imp[(3 * 64 + ql) * 33 + j]);
            if (j < 1 || j >= blk_t) v[e] = -1.f; }
        unsigned mask = 1u | (1u << blk_t);
#pragma unroll 1
        for (int it = 0; it < 6; ++it) {
            float bv = fmaxf(fmaxf(v[0], v[1]), fmaxf(v[2], v[3]));
            bv = fmaxf(bv, __builtin_bit_cast(float, __builtin_amdgcn_mov_dpp(__builtin_bit_cast(int, bv), 0xB1, 0xF, 0xF, true)));
            bv = fmaxf(bv, __builtin_bit_cast(float, __builtin_amdgcn_mov_dpp(__builtin_bit_cast(int, bv), 0x4E, 0xF, 0xF, true)));
            bv = fmaxf(bv, __builtin_bit_cast(float, __builtin_amdgcn_mov_dpp(__builtin_bit_cast(int, bv), 0x141, 0xF, 0xF, true)));
            int bj = (v[3] == bv) ? 4 * sub + 3 : 64; bj = (v[2] == bv) ? 4 * sub + 2 : bj; bj = (v[1] == bv) ? 4 * sub + 1 : bj; bj = (v[0] == bv) ? 4 * sub : bj;
            bj = min(bj, __builtin_amdgcn_mov_dpp(bj, 0xB1, 0xF, 0xF, true));
            bj = min(bj, __builtin_amdgcn_mov_dpp(bj, 0x4E, 0xF, 0xF, true));
            bj = min(bj, __builtin_amdgcn_mov_dpp(bj, 0x141, 0xF, 0xF, true));
            if (bv >= 0.f) { mask |= 1u << bj;
#pragma unroll
                for (int e = 0; e < 4; ++e) if (4 * sub + e == bj) v[e] = -1.f; }
        }
        if (sub == 0) selm[ql] = mask;
        unsigned any = mask;
        any |= __shfl_xor(any, 8); any |= __shfl_xor(any, 16); any |= __shfl_xor(any, 32);
        if (lane == 0) selm[64 + wid] = any;
    }
    __syncthreads();
    XSTAMP(32);
    const unsigned mymask = selm[qi];
    const unsigned anym = (unsigned)__builtin_amdgcn_readfirstlane((int)((selm[64] | selm[65]) | (selm[66] | selm[67]) | (selm[68] | selm[69]) | (selm[70] | selm[71])));
    unsigned kofP, vofP; tile_offs(kofP, vofP, LDP, wid, lane);
    {
        const bf16_t* kb = P + rowbase * LDP + C_KS + g * 64; const bf16_t* vb = P + rowbase * LDP + C_VS + g * 64;
        unsigned todo = anym;
        float m = NEG, l = 0.f; f32x16 o[2]; o[0] = f32x16{}; o[1] = f32x16{};
        int j = __builtin_ctz(todo); todo &= todo - 1;
        dma_tile(slot0, kb + (size_t)j * 64 * LDP, vb + (size_t)j * 64 * LDP, kofP, vofP, wid);
        int cur = 0;
        __syncthreads();
        for (;;) {
            const int jn = todo ? __builtin_ctz(todo) : -1; if (todo) todo &= todo - 1;
            NLAS unsigned char* sc = cur ? slot1 : slot0; NLAS unsigned char* sn = cur ? slot0 : slot1;
            if (jn >= 0) dma_tile(sn, kb + (size_t)jn * 64 * LDP, vb + (size_t)jn * 64 * LDP, kofP, vofP, wid);
            const bool mine = (mymask >> j) & 1u;
            const bool far = sl2 * (float)(t0 - 64 * j - 63) > 200.f;
            if (__any(mine) && !far) {
                f32x16 p0, p1, c0, c1; const float kb0 = sl2 * (float)(j * 64 - t0); OPAQUE_HI();
#pragma unroll
                for (int i = 0; i < 16; ++i) { c0[i] = kb0 + sl2 * CRF(i); c1[i] = c0[i] + sl2 * 32.f; }
                qkt(p0, p1, sc, qr, c0, c1, r32, hi);
                if (j == blk_t) {
#pragma unroll
                    for (int i = 0; i < 16; ++i) { const int kk = crow(i, hiv); if (kk > qi) p0[i] = NEG; if (kk + 32 > qi) p1[i] = NEG; }
                }
                if (!mine) {
#pragma unroll
                    for (int i = 0; i < 16; ++i) { p0[i] = NEG; p1[i] = NEG; }
                }
                softmax_step(p0, p1, m, l, o, wsf, r32, hi);
                pv(o, sc + 8192, p0, p1, lane, hi);
            }
            __syncthreads();
            if (jn < 0) break;
            j = jn; cur ^= 1;
        }
        l = xhalf_sum(l);
        acc_rows(tot, o, wsf, gate_s * __builtin_amdgcn_rcpf(l), r32, hi);
    }
    XSTAMP(33);
    {
        const bf16_t* kb = P + rowbase * LDP + C_KW + g * 64; const bf16_t* vb = P + rowbase * LDP + C_VW + g * 64;
        float m = NEG, l = 0.f; f32x16 o[2]; o[0] = f32x16{}; o[1] = f32x16{};
        int j = blk_t; const int jlast = blk_t >= 4 ? blk_t - 4 : 0;
        dma_tile(slot0, kb + (size_t)j * 64 * LDP, vb + (size_t)j * 64 * LDP, kofP, vofP, wid);
        int cur = 0;
        __syncthreads();
        for (;;) {
            const int jn = (j > jlast) ? j - 1 : -1;
            NLAS unsigned char* sc = cur ? slot1 : slot0; NLAS unsigned char* sn = cur ? slot0 : slot1;
            if (jn >= 0) dma_tile(sn, kb + (size_t)jn * 64 * LDP, vb + (size_t)jn * 64 * LDP, kofP, vofP, wid);
            {
                f32x16 p0, p1, c0, c1; const float kb0 = sl2 * (float)(j * 64 - t0); OPAQUE_HI();
#pragma unroll
                for (int i = 0; i < 16; ++i) { c0[i] = kb0 + sl2 * CRF(i); c1[i] = c0[i] + sl2 * 32.f; }
                qkt(p0, p1, sc, qr, c0, c1, r32, hi);
                if (j == blk_t || j == blk_t - 4) {
                    const int dq = t0 + qi - j * 64;
#pragma unroll
                    for (int i = 0; i < 16; ++i) { const int d0_ = dq - crow(i, hiv), d1_ = d0_ - 32; if (d0_ < 0 || d0_ > 255) p0[i] = NEG; if (d1_ < 0 || d1_ > 255) p1[i] = NEG; }
                }
                softmax_step(p0, p1, m, l, o, wsf, r32, hi);
                pv(o, sc + 8192, p0, p1, lane, hi);
            }
            __syncthreads();
            if (jn < 0) break;
            j = jn; cur ^= 1;
        }
        l = xhalf_sum(l);
        acc_rows(tot, o, wsf, gate_w * __builtin_amdgcn_rcpf(l), r32, hi);
    }
    XSTAMP(34);
    {
        NLAS bf16_t* stg = (NLAS bf16_t*)(lds + L_OST) + wid * 2048;
#pragma unroll
        for (int i = 0; i < 16; ++i) { const int orow = crow(i, hi); stg[orow * 64 + r32] = f2bf(tot[0][i]); stg[orow * 64 + 32 + r32] = f2bf(tot[1][i]); }
        bf16_t* ow = P + (rowbase + t0 + qh * 32) * LDP + C_NQ + head * 64;
#pragma unroll
        for (int i = 0; i < 4; ++i) { const int row = i * 8 + (lane >> 3), ch = lane & 7; const u32x4 v = *(NLAS const u32x4*)(stg + row * 64 + ch * 8); *(u32x4*)((char*)ow + (unsigned)(row * LDP + ch * 8) * 2u) = v; }
    }
    __syncthreads();
    XSTAMP(35);
#if defined(TPROBE)
    if (blockIdx.x == 0 && threadIdx.x == 0) { volatile __attribute__((address_space(3))) unsigned long long* ts_ = (volatile __attribute__((address_space(3))) unsigned long long*)(lds + 147456 - 512); ts_[36] = ts_[30] + 100ull * (unsigned)qt; }
#endif
#undef CRF
#undef OPAQUE_HI
}

__device__ __forceinline__ void norm8(u32x4& v, const float* g8, float sc) {
    float x[8] = {__uint_as_float(v.x << 16), __uint_as_float(v.x & 0xffff0000u), __uint_as_float(v.y << 16), __uint_as_float(v.y & 0xffff0000u),
                  __uint_as_float(v.z << 16), __uint_as_float(v.z & 0xffff0000u), __uint_as_float(v.w << 16), __uint_as_float(v.w & 0xffff0000u)};
    float s = 0.f;
#pragma unroll
    for (int e = 0; e < 8; ++e) s += x[e] * x[e];
    s += __shfl_xor(s, 1); s += __shfl_xor(s, 2); s += __shfl_xor(s, 4);
    const float r = rsqrtf(s * (1.f / 64.f) + EPS) * sc;
    v.x = pk(x[0] * r * g8[0], x[1] * r * g8[1]); v.y = pk(x[2] * r * g8[2], x[3] * r * g8[3]); v.z = pk(x[4] * r * g8[4], x[5] * r * g8[5]); v.w = pk(x[6] * r * g8[6], x[7] * r * g8[7]);
}
__device__ __forceinline__ void prep_units(bf16_t* P, const float* qn, const float* kns, const float* knw, int gw, int NGW, int lane) {
    float gq[8], gk[8];
    const float* kg = (lane < 32) ? kns : knw;
#pragma unroll
    for (int e = 0; e < 8; ++e) { gq[e] = qn[8 * (lane & 7) + e]; gk[e] = kg[8 * (lane & 7) + e]; }
    const int coff = (lane < 32) ? C_KS + 8 * lane : C_KW + 8 * (lane - 32);
    for (int m0 = gw; m0 < M; m0 += 2 * NGW) {
        const int m1 = m0 + NGW; const bool two = m1 < M;
        bf16_t* r0 = P + (size_t)m0 * LDP; bf16_t* r1 = P + (size_t)(two ? m1 : m0) * LDP;
        u32x4 a0 = *(const u32x4*)(r0 + C_NQ + 8 * lane), b0 = *(const u32x4*)(r0 + C_NQ + 512 + 8 * lane), c0 = *(const u32x4*)(r0 + coff);
        u32x4 a1 = *(const u32x4*)(r1 + C_NQ + 8 * lane), b1 = *(const u32x4*)(r1 + C_NQ + 512 + 8 * lane), c1 = *(const u32x4*)(r1 + coff);
        norm8(a0, gq, 0.125f * LOG2E); norm8(b0, gq, 0.125f * LOG2E); norm8(c0, gk, 1.f);
        norm8(a1, gq, 0.125f * LOG2E); norm8(b1, gq, 0.125f * LOG2E); norm8(c1, gk, 1.f);
        *(u32x4*)(r0 + C_NQ + 8 * lane) = a0; *(u32x4*)(r0 + C_NQ + 512 + 8 * lane) = b0; *(u32x4*)(r0 + coff) = c0;
        if (two) { *(u32x4*)(r1 + C_NQ + 8 * lane) = a1; *(u32x4*)(r1 + C_NQ + 512 + 8 * lane) = b1; *(u32x4*)(r1 + coff) = c1; }
    }
}

constexpr int LC_A = 0, LC_B = 16384, LC_HID = 49152, LC_W2 = 83968;
__device__ __forceinline__ void compress_item(NLAS unsigned char* lds, const bf16_t* P, const bf16_t* W1T, const float* bias1, const float* W2, const float* gain, bf16_t* OUT, int b, int g, int which, int half) {
    const int tid = threadIdx.x, lane = tid & 63, r32 = lane & 31, hi = lane >> 5; const int wid = __builtin_amdgcn_readfirstlane(tid >> 6);
    const int mt = wid >> 2, nt = wid & 3;
    const int ca = tid >> 3, dca = tid & 7; const int cg_ = 64 * half + ca; const int ccl = cg_ < NCMP ? cg_ : NCMP - 1;
    const bf16_t* asrc = P + ((size_t)b * SEQ + 16 * ccl) * LDP + (which ? C_VC : C_KC) + g * 64 + dca * 8;
    const bf16_t* bsrc0 = W1T + (size_t)(tid >> 3) * 2048 + (tid & 7) * 8; const bf16_t* bsrc1 = bsrc0 + (size_t)64 * 2048;
    const int adst = (dca * 64 + ca) * 16, bdst0 = ((tid & 7) * 128 + (tid >> 3)) * 16, bdst1 = bdst0 + 64 * 16;
#define CBAR() do { asm volatile("s_waitcnt lgkmcnt(0)" ::: "memory"); __builtin_amdgcn_s_barrier(); asm volatile("" ::: "memory"); } while (0)
#define CLOAD(ra_, rb0_, rb1_, l_) do { ra_ = *(const u32x4*)(asrc + (size_t)(l_) * LDP); rb0_ = *(const u32x4*)(bsrc0 + (l_) * 64); rb1_ = *(const u32x4*)(bsrc1 + (l_) * 64); } while (0)
#define CSTORE(ra_, rb0_, rb1_, buf_) do { *(NLAS u32x4*)(lds + LC_A + (buf_) * 8192 + adst) = ra_; *(NLAS u32x4*)(lds + LC_B + (buf_) * 16384 + bdst0) = rb0_; *(NLAS u32x4*)(lds + LC_B + (buf_) * 16384 + bdst1) = rb1_; } while (0)
#define CMMA(buf_) do { NLAS const unsigned char* ab = lds + LC_A + (buf_) * 8192; NLAS const unsigned char* bb = lds + LC_B + (buf_) * 16384; \
        _Pragma("unroll") for (int ds = 0; ds < 4; ++ds) { \
            const bf16x8 a = *(NLAS const bf16x8*)(ab + ((2 * ds + hi) * 64 + 32 * mt + r32) * 16); \
            const bf16x8 w = *(NLAS const bf16x8*)(bb + ((2 * ds + hi) * 128 + 32 * nt + r32) * 16); \
            acc = __builtin_amdgcn_mfma_f32_32x32x16_bf16(a, w, acc, 0, 0, 0); } } while (0)
    {
#pragma unroll
        for (int k = 0; k < 4; ++k) *(NLAS f32x4*)(lds + LC_W2 + (tid + 512 * k) * 16) = *(const f32x4*)(W2 + (tid + 512 * k) * 4);
    }
    u32x4 xa, xb0, xb1, ya, yb0, yb1;
    CLOAD(xa, xb0, xb1, 0); CSTORE(xa, xb0, xb1, 0);
    CLOAD(xa, xb0, xb1, 1); CLOAD(ya, yb0, yb1, 2);
    CBAR();
    f32x16 acc = f32x16{};
    for (int l = 0; l < 32; l += 2) {
        CMMA(0); CSTORE(xa, xb0, xb1, 1); if (l + 3 < 32) CLOAD(xa, xb0, xb1, l + 3); CBAR();
        CMMA(1); if (l + 2 < 32) { CSTORE(ya, yb0, yb1, 0); if (l + 4 < 32) CLOAD(ya, yb0, yb1, l + 4); } CBAR();
    }
#undef CBAR
#undef CLOAD
#undef CSTORE
#undef CMMA
    NLAS float* hid = (NLAS float*)(lds + LC_HID);
    const float bs = bias1[32 * nt + r32];
#pragma unroll
    for (int i = 0; i < 16; ++i) hid[(32 * mt + crow(i, hi)) * 132 + 32 * nt + r32] = gelu_tanh(acc[i] + bs);
    __syncthreads();
    {
        const int row = tid >> 3, e0 = (tid & 7) * 8;
        float o[8];
#pragma unroll
        for (int e = 0; e < 8; ++e) o[e] = 0.f;
#pragma unroll 8
        for (int i = 0; i < 128; ++i) { const float h = hid[row * 132 + i]; const f32x4 wa = *(NLAS const f32x4*)(lds + LC_W2 + (i * 64 + e0) * 4), wb = *(NLAS const f32x4*)(lds + LC_W2 + (i * 64 + e0 + 4) * 4);
            o[0] += h * wa[0]; o[1] += h * wa[1]; o[2] += h * wa[2]; o[3] += h * wa[3]; o[4] += h * wb[0]; o[5] += h * wb[1]; o[6] += h * wb[2]; o[7] += h * wb[3]; }
        if (which == 0) {
            float ss = 0.f;
#pragma unroll
            for (int e = 0; e < 8; ++e) ss += o[e] * o[e];
            ss += __shfl_xor(ss, 1); ss += __shfl_xor(ss, 2); ss += __shfl_xor(ss, 4);
            const float r = rsqrtf(ss * (1.f / 64.f) + EPS);
#pragma unroll
            for (int e = 0; e < 8; ++e) o[e] *= r * gain[e0 + e];
        }
        const int cg = 64 * half + row;
        if (cg >= NCMP) {
#pragma unroll
            for (int e = 0; e < 8; ++e) o[e] = 0.f; }
        u32x4 w; w.x = pk(o[0], o[1]); w.y = pk(o[2], o[3]); w.z = pk(o[4], o[5]); w.w = pk(o[6], o[7]);
        *(u32x4*)(OUT + (((size_t)(b * NS_G + g) * 128) + cg) * 64 + e0) = w;
    }
    __syncthreads();
}
}
namespace pg8 {
#define PG8_LAS __attribute__((address_space(3)))
typedef short bf16x8 __attribute__((ext_vector_type(8)));
typedef float f32x4 __attribute__((ext_vector_type(4)));
typedef float f32x2 __attribute__((ext_vector_type(2)));
typedef unsigned u32x4 __attribute__((ext_vector_type(4)));
typedef unsigned u32x2 __attribute__((ext_vector_type(2)));
constexpr int BM = 256, BK = 64, HALF = 128, HTB = HALF * BK * 2, STAGE_BYTES = 8 * HTB, NXCD = 8, WGM = 8;

__host__ __device__ __forceinline__ int lds_byte(int r, int c) { const int st = (r >> 4) * 2 + (c >> 5), rr = r & 15, cc = c & 31, ob = rr * 64 + cc * 2; return st * 1024 + (ob ^ (((ob >> 9) & 1) << 5)); }
__host__ __device__ __forceinline__ void stage_rc(int b, int& R, int& C) { const int st = b / 1024, sb = b % 1024, swz = sb ^ (((sb >> 9) & 1) << 5); R = (st >> 1) * 16 + swz / 64; C = (st & 1) * 32 + (swz % 64) / 2; }
__host__ __device__ __forceinline__ int perm32(int rho) { const int n = rho >> 4, i = rho & 15; return 8 * (i >> 2) + 4 * n + (i & 3); }

struct Unit { int pm, pn, ks; };
struct Gemm { const bf16_t* A; const bf16_t* Bt; int lda, ldb; int M, N, K; int ksoff; };

struct StaticOrder {
    int nM, nN, nwg, G, c;
    __host__ __device__ void init(int M_, int N_, int G_, int c_) { nM = M_ / BM; nN = N_ / BM; nwg = nM * nN; G = G_; c = c_; }
    __host__ __device__ bool next(int i, Unit& u) const {
        const long L = (long)i * G + c; if (L >= nwg) return false;
        int wgid = (int)L; { const int q = nwg / NXCD, r = nwg % NXCD, xcd = wgid % NXCD, off = wgid / NXCD; wgid = (xcd < r ? xcd * (q + 1) : r * (q + 1) + (xcd - r) * q) + off; }
        const int nig = WGM * nN, gid = wgid / nig, fm = gid * WGM, gsz = (nM - fm) < WGM ? (nM - fm) : WGM;
        u.pm = fm + ((wgid % nig) % gsz); u.pn = (wgid % nig) / gsz; u.ks = 0; return true;
    }
};
struct TwoPassOrder {
    StaticOrder base;
    __host__ __device__ bool next(int i, Unit& u) const { if (!base.next(i >> 1, u)) return false; u.ks = i & 1; return true; }
};

typedef __bf16 bf16x2_t __attribute__((ext_vector_type(2)));
__device__ __forceinline__ unsigned cvt_pk_bf16(float lo, float hi) { f32x2 v = {lo, hi}; bf16x2_t b = __builtin_convertvector(v, bf16x2_t); return __builtin_bit_cast(unsigned, b); }
__device__ __forceinline__ float fast_sigmoid(float x) { return __builtin_amdgcn_rcpf(1.f + __builtin_amdgcn_exp2f(-1.4426950408889634f * x)); }
__device__ __forceinline__ float bflo(unsigned w) { return __uint_as_float(w << 16); }
__device__ __forceinline__ float bfhi(unsigned w) { return __uint_as_float(w & 0xffff0000u); }

typedef f32x4 Acc[2][2][4][2];

template <int ACT> struct EpiP {
    static constexpr bool PERM = true;
    bf16_t* O; int ldc; int pn_last; int ncol_last; bf16_t* halo;
    __device__ __forceinline__ void operator()(const Acc& acc, const Unit& u, int wr, int wc, int fr, int fq) const {
        const int row0 = u.pm * BM + wr * 64 + fr, tcol = wc * 32 + 8 * fq;
        const int lim = (u.pn == pn_last) ? ncol_last : 256;
#pragma unroll
        for (int ai = 0; ai < 2; ++ai)
#pragma unroll
            for (int m = 0; m < 4; ++m) { bf16_t* rowp = O + (size_t)(row0 + ai * HALF + m * 16) * ldc + u.pn * BM + tcol;
#pragma unroll
                for (int bj = 0; bj < 2; ++bj) { if (tcol + bj * HALF >= lim) continue;
                    f32x4 v0 = acc[ai][bj][m][0], v1 = acc[ai][bj][m][1];
                    if (ACT == 1) {
#pragma unroll
                        for (int e = 0; e < 4; ++e) { v0[e] = fast_sigmoid(v0[e]); v1[e] = fast_sigmoid(v1[e]); } }
                    u32x4 w; w.x = cvt_pk_bf16(v0[0], v0[1]); w.y = cvt_pk_bf16(v0[2], v0[3]); w.z = cvt_pk_bf16(v1[0], v1[1]); w.w = cvt_pk_bf16(v1[2], v1[3]);
                    *(u32x4*)(rowp + bj * HALF) = w;
                    if (ACT == 0 && m == 3 && fr >= 13 && u.pn < 12 && halo) { const int row = row0 + ai * HALF + 48;
                        *(u32x4*)(halo + ((size_t)(row >> 6) * 3 + (fr - 13)) * 3072 + u.pn * BM + tcol + bj * HALF) = w; } } }
    }
};
struct EpiMix {
    static constexpr bool PERM = true;
    const bf16_t* G; int ldg; bf16_t* O; int ldc;
    __device__ __forceinline__ void operator()(const Acc& acc, const Unit& u, int wr, int wc, int fr, int fq) const {
        const int row0 = u.pm * BM + wr * 64 + fr, col0 = u.pn * BM + wc * 32 + 8 * fq;
#pragma unroll
        for (int ai = 0; ai < 2; ++ai)
#pragma unroll
            for (int m = 0; m < 4; ++m) { const size_t row = (size_t)(row0 + ai * HALF + m * 16); const bf16_t* gp = G + row * ldg + col0 + u.ks * 1024; bf16_t* rowp = O + row * ldc + col0;
#pragma unroll
                for (int bj = 0; bj < 2; ++bj) { const u32x4 b = *(const u32x4*)(gp + bj * HALF);
                    f32x4 v0 = acc[ai][bj][m][0], v1 = acc[ai][bj][m][1];
                    v0[0] *= bflo(b.x); v0[1] *= bfhi(b.x); v0[2] *= bflo(b.y); v0[3] *= bfhi(b.y); v1[0] *= bflo(b.z); v1[1] *= bfhi(b.z); v1[2] *= bflo(b.w); v1[3] *= bfhi(b.w);
                    if (u.ks) { const u32x4 p = *(const u32x4*)(rowp + bj * HALF);
                        v0[0] += bflo(p.x); v0[1] += bfhi(p.x); v0[2] += bflo(p.y); v0[3] += bfhi(p.y); v1[0] += bflo(p.z); v1[1] += bfhi(p.z); v1[2] += bflo(p.w); v1[3] += bfhi(p.w); }
                    u32x4 w; w.x = cvt_pk_bf16(v0[0], v0[1]); w.y = cvt_pk_bf16(v0[2], v0[3]); w.z = cvt_pk_bf16(v1[0], v1[1]); w.w = cvt_pk_bf16(v1[2], v1[3]);
                    *(u32x4*)(rowp + bj * HALF) = w; } }
    }
};
struct EpiOut {
    static constexpr bool PERM = false;
    const float* X; float* X1; bf16_t* An; const float* gain; float* pss;
    __device__ __forceinline__ void operator()(const Acc& acc, const Unit& u, int wr, int wc, int fr, int fq) const {
        const int row0 = u.pm * BM + wr * 64 + fr, col0 = u.pn * BM + wc * 32 + 4 * fq;
        f32x4 gv[2][2];
#pragma unroll
        for (int bj = 0; bj < 2; ++bj)
#pragma unroll
            for (int n = 0; n < 2; ++n) gv[bj][n] = *(const f32x4*)(gain + col0 + bj * HALF + n * 16);
#pragma unroll
        for (int ai = 0; ai < 2; ++ai)
#pragma unroll
            for (int m = 0; m < 4; ++m) { const size_t row = (size_t)(row0 + ai * HALF + m * 16); const size_t off = row * D + col0; float ss = 0.f;
#pragma unroll
                for (int bj = 0; bj < 2; ++bj)
#pragma unroll
                    for (int n = 0; n < 2; ++n) { const f32x4 x1 = *(const f32x4*)(X + off + bj * HALF + n * 16) + acc[ai][bj][m][n];
                        *(f32x4*)(X1 + off + bj * HALF + n * 16) = x1; ss += (x1[0] * x1[0] + x1[1] * x1[1]) + (x1[2] * x1[2] + x1[3] * x1[3]);
                        const f32x4 y = x1 * gv[bj][n]; u32x2 w; w.x = cvt_pk_bf16(y[0], y[1]); w.y = cvt_pk_bf16(y[2], y[3]); *(u32x2*)(An + off + bj * HALF + n * 16) = w; }
                ss += __shfl_xor(ss, 16); ss += __shfl_xor(ss, 32);
                if (fq == 0) pss[row * 16 + u.pn * 4 + wc] = ss; }
    }
};
struct EpiUp {
    static constexpr bool PERM = true;
    const float* pss; bf16_t* O; int ldc;
    __device__ __forceinline__ void operator()(const Acc& acc, const Unit& u, int wr, int wc, int fr, int fq) const {
        const int row0 = u.pm * BM + wr * 64 + fr, col0 = u.pn * BM + wc * 32 + 8 * fq;
#pragma unroll
        for (int ai = 0; ai < 2; ++ai)
#pragma unroll
            for (int m = 0; m < 4; ++m) { const size_t row = (size_t)(row0 + ai * HALF + m * 16);
                const f32x4* pp = (const f32x4*)(pss + row * 16); const f32x4 s4 = (pp[0] + pp[1]) + (pp[2] + pp[3]);
                const float rstd = rsqrtf(((s4[0] + s4[1]) + (s4[2] + s4[3])) * (1.f / D) + EPS);
                bf16_t* rowp = O + row * ldc + col0;
#pragma unroll
                for (int bj = 0; bj < 2; ++bj) { f32x4 v0 = acc[ai][bj][m][0] * rstd, v1 = acc[ai][bj][m][1] * rstd;
#pragma unroll
                    for (int e = 0; e < 4; ++e) { const float a = fmaxf(v0[e], 0.f), b = fmaxf(v1[e], 0.f); v0[e] = a * a; v1[e] = b * b; }
                    u32x4 w; w.x = cvt_pk_bf16(v0[0], v0[1]); w.y = cvt_pk_bf16(v0[2], v0[3]); w.z = cvt_pk_bf16(v1[0], v1[1]); w.w = cvt_pk_bf16(v1[2], v1[3]);
                    *(u32x4*)(rowp + bj * HALF) = w; } }
    }
};
struct EpiDown {
    static constexpr bool PERM = false;
    float* X1;
    __device__ __forceinline__ void operator()(const Acc& acc, const Unit& u, int wr, int wc, int fr, int fq) const {
        const int row0 = u.pm * BM + wr * 64 + fr, col0 = u.pn * BM + wc * 32 + 4 * fq;
#pragma unroll
        for (int ai = 0; ai < 2; ++ai)
#pragma unroll
            for (int m = 0; m < 4; ++m) { float* rowp = X1 + (size_t)(row0 + ai * HALF + m * 16) * D + col0;
#pragma unroll
                for (int bj = 0; bj < 2; ++bj)
#pragma unroll
                    for (int n = 0; n < 2; ++n) { f32x4* p = (f32x4*)(rowp + bj * HALF + n * 16); *p = *p + acc[ai][bj][m][n]; } }
    }
};

template <class Epi, class Sched, bool ALIGN_EPI>
__device__ __forceinline__ void gemm_phase(PG8_LAS unsigned char* lds, const Gemm g, const Sched& S, const Epi& E) {
    const int tid = threadIdx.x, wid = __builtin_amdgcn_readfirstlane(tid >> 6), lane = tid & 63, wr = wid >> 2, wc = wid & 3, fr = lane & 15, fq = lane >> 4;
    const int K = g.K, nt = K / BK, lda = g.lda, ldb = g.ldb;
    unsigned voffA[2], voffB[2];
#pragma unroll
    for (int i = 0; i < 2; ++i) { int R, C; stage_rc(tid * 16 + i * 8192, R, C); const int Rb = Epi::PERM ? ((R & ~31) + perm32(R & 31)) : R;
        voffA[i] = (unsigned)(R * lda + C) * 2u; voffB[i] = (unsigned)(Rb * ldb + C) * 2u; }
    const size_t kstep = (size_t)(BK * 2);
    const size_t hstepA = (size_t)HALF * lda * 2, hstepB = (size_t)HALF * ldb * 2;
    const size_t tstepA = 2 * hstepA, tstepB = 2 * hstepB;
    const unsigned ldsw = (unsigned)wid * 1024u;
    const int aoff = lds_byte(wr * 64 + fr, fq * 8), boff = lds_byte(wc * 32 + fr, fq * 8);
#define PG8_SA(b, h) (((b) * 2 + (h)) * HTB)
#define PG8_SB(b, h) ((4 + (b) * 2 + (h)) * HTB)
#define PG8_STAGE(bufoff, gbase, voff) do { _Pragma("unroll") for (int _i = 0; _i < 2; ++_i) \
        __builtin_amdgcn_global_load_lds((const unsigned*)((const char*)(gbase) + (voff)[_i]), (PG8_LAS unsigned*)(lds + (bufoff) + ldsw + _i * 8192), 16, 0, 0); } while (0)
#define PG8_LDA(dst, b, h) do { _Pragma("unroll") for (int m = 0; m < 4; ++m) _Pragma("unroll") for (int k = 0; k < 2; ++k) dst[m][k] = *(const PG8_LAS bf16x8*)(lds + PG8_SA(b, h) + aoff + m * 2048 + k * 1024); } while (0)
#define PG8_LDB(dst, b, h) do { _Pragma("unroll") for (int n = 0; n < 2; ++n) _Pragma("unroll") for (int k = 0; k < 2; ++k) dst[n][k] = *(const PG8_LAS bf16x8*)(lds + PG8_SB(b, h) + boff + n * 2048 + k * 1024); } while (0)
#define PG8_MMA(ai, bj, At, Bt) do { __builtin_amdgcn_s_setprio(1); _Pragma("unroll") for (int m = 0; m < 4; ++m) _Pragma("unroll") for (int n = 0; n < 2; ++n) _Pragma("unroll") for (int k = 0; k < 2; ++k) \
        acc[ai][bj][m][n] = __builtin_amdgcn_mfma_f32_16x16x32_bf16(Bt[n][k], At[m][k], acc[ai][bj][m][n], 0, 0, 0); __builtin_amdgcn_s_setprio(0); } while (0)
#define PG8_WAIT_V(n) asm volatile("s_waitcnt vmcnt(" #n ")" ::: "memory")
#define PG8_WAIT_L(n) asm volatile("s_waitcnt lgkmcnt(" #n ")" ::: "memory")
#define PG8_BAR __builtin_amdgcn_s_barrier()
#define PG8_SCHED __builtin_amdgcn_sched_barrier(0)
#define PG8_KBODY(t) do { \
            const bool last = (t == nt - 2); \
            const char* a1 = cA + (size_t)(t + 1) * kstep; \
            const char* a2 = last ? nA : cA + (size_t)(t + 2) * kstep; const char* b2 = last ? nB : cB + (size_t)(t + 2) * kstep; \
            const char* a3 = a2 + kstep; const char* b3 = b2 + kstep; \
            PG8_LDB(B0, 0, 0); PG8_LDB(B1, 0, 1); PG8_SCHED; PG8_LDA(At, 0, 0); PG8_STAGE(PG8_SA(1, 1), a1 + hstepA, voffA); \
            PG8_WAIT_V(8); PG8_WAIT_L(0); PG8_BAR; PG8_MMA(0, 0, At, B0); PG8_MMA(0, 1, At, B1); PG8_BAR; PG8_SCHED; \
            PG8_LDA(At, 0, 1); PG8_STAGE(PG8_SB(0, 0), b2, voffB); PG8_STAGE(PG8_SB(0, 1), b2 + hstepB, voffB); PG8_STAGE(PG8_SA(0, 0), a2, voffA); \
            PG8_WAIT_V(8); PG8_WAIT_L(0); PG8_BAR; PG8_MMA(1, 0, At, B0); PG8_MMA(1, 1, At, B1); PG8_BAR; PG8_SCHED; \
            PG8_LDB(B0, 1, 0); PG8_LDB(B1, 1, 1); PG8_SCHED; PG8_LDA(At, 1, 0); PG8_STAGE(PG8_SA(0, 1), a2 + hstepA, voffA); \
            PG8_WAIT_V(8); PG8_WAIT_L(0); PG8_BAR; PG8_MMA(0, 0, At, B0); PG8_MMA(0, 1, At, B1); PG8_BAR; PG8_SCHED; \
            PG8_LDA(At, 1, 1); PG8_STAGE(PG8_SB(1, 0), b3, voffB); PG8_STAGE(PG8_SB(1, 1), b3 + hstepB, voffB); PG8_STAGE(PG8_SA(1, 0), a3, voffA); \
            PG8_WAIT_V(8); PG8_WAIT_L(0); PG8_BAR; PG8_MMA(1, 0, At, B0); PG8_MMA(1, 1, At, B1); PG8_BAR; PG8_SCHED; \
        } while (0)
    Unit cur, nxt; int ui = 0;
    if (!S.next(0, cur)) return;
    Acc acc;
#pragma unroll
    for (int a = 0; a < 2; ++a)
#pragma unroll
        for (int b = 0; b < 2; ++b)
#pragma unroll
            for (int m = 0; m < 4; ++m)
#pragma unroll
                for (int n = 0; n < 2; ++n) acc[a][b][m][n] = (f32x4){0.f, 0.f, 0.f, 0.f};
    bf16x8 At[4][2], B0[2][2], B1[2][2];
    const char* cA = (const char*)g.A + (size_t)cur.pm * tstepA + (size_t)cur.ks * g.ksoff * 2; const char* cB = (const char*)g.Bt + (size_t)cur.pn * tstepB + (size_t)cur.ks * g.ksoff * 2;
    PG8_STAGE(PG8_SB(0, 0), cB, voffB); PG8_STAGE(PG8_SB(0, 1), cB + hstepB, voffB); PG8_STAGE(PG8_SA(0, 0), cA, voffA); PG8_STAGE(PG8_SA(0, 1), cA + hstepA, voffA);
    if (wr == 1) PG8_BAR;
    PG8_WAIT_V(2); PG8_BAR;
    PG8_STAGE(PG8_SB(1, 0), cB + kstep, voffB); PG8_STAGE(PG8_SA(1, 0), cA + kstep, voffA); PG8_STAGE(PG8_SB(1, 1), cB + hstepB + kstep, voffB);
    PG8_WAIT_V(6); PG8_BAR;
    for (;;) {
        const bool has_next = S.next(ui + 1, nxt);
        const char* nA = has_next ? (const char*)g.A + (size_t)nxt.pm * tstepA + (size_t)nxt.ks * g.ksoff * 2 : cA; const char* nB = has_next ? (const char*)g.Bt + (size_t)nxt.pn * tstepB + (size_t)nxt.ks * g.ksoff * 2 : cB;
        for (int t = 0; t < nt; t += 2) PG8_KBODY(t);
        if constexpr (ALIGN_EPI) { if (wr == 0) PG8_BAR; }
        E(acc, cur, wr, wc, fr, fq);
        if (!has_next) break;
#pragma unroll
        for (int a = 0; a < 2; ++a)
#pragma unroll
            for (int b = 0; b < 2; ++b)
#pragma unroll
                for (int m = 0; m < 4; ++m)
#pragma unroll
                    for (int n = 0; n < 2; ++n) acc[a][b][m][n] = (f32x4){0.f, 0.f, 0.f, 0.f};
        cur = nxt; cA = nA; cB = nB; ++ui;
        if constexpr (ALIGN_EPI) { if (wr == 1) PG8_BAR; }
    }
    PG8_WAIT_V(0);
    if constexpr (!ALIGN_EPI) { if (wr == 0) PG8_BAR; }
    PG8_BAR;
#undef PG8_SA
#undef PG8_SB
#undef PG8_STAGE
#undef PG8_LDA
#undef PG8_LDB
#undef PG8_MMA
#undef PG8_WAIT_V
#undef PG8_WAIT_L
#undef PG8_BAR
#undef PG8_SCHED
#undef PG8_KBODY
}
}

#define GAS __attribute__((address_space(1)))
#define LAS __attribute__((address_space(3)))
typedef unsigned v4u __attribute__((ext_vector_type(4)));
typedef float f32x4 __attribute__((ext_vector_type(4)));
constexpr int NWAVES = 8;
constexpr int LDS_BYTES = 147456;
constexpr size_t MiB = 1u << 20;
constexpr size_t WS_PSS = 1 * MiB, WS_WOUT = 2 * MiB, WS_P = 4 * MiB, WS_KC = 214 * MiB, WS_VC = 215 * MiB, WS_MIX = 216 * MiB;
constexpr size_t WS_AN = 4 * MiB, WS_UP = 64 * MiB, WS_WUP = 248 * MiB, WS_WDOWN = 200 * MiB;
constexpr size_t WS_BIAS1 = 131072 + 16384, WS_W1T = 214 * MiB, WS_KCB = 215 * MiB, WS_VCB = 215 * MiB + 512 * 1024;
constexpr size_t WS_GLV = 4096, WS_QCNT = 65536, WS_GW = 216 * MiB, DO_GQK = 40 * MiB, DO_HALO = 56 * MiB;
constexpr size_t WS_XBAR = 131072;
constexpr size_t DO_H = 0, DO_WG = 32 * MiB, DO_WCAT = 36 * MiB, DO_WIN = 40 * MiB;

__device__ __forceinline__ unsigned pk2(float lo, float hi) { return (unsigned)f2bf(lo) | ((unsigned)f2bf(hi) << 16); }
__device__ __forceinline__ float wave_sum(float v) {
#pragma unroll
    for (int o = 1; o < 64; o <<= 1) v += __shfl_xor(v, o);
    return v;
}
template <class SrcCol>
__device__ __forceinline__ void transpose_item(const float* W, int ldw, const SrcCol& srccol, bf16_t* WT, int ldk, int kofs, LAS float* scr, int kb, int nb, int lane) {
    const int k0 = 64 * kb, n0 = 64 * nb; const int n4 = (lane & 15) * 4; const int sc = srccol(n0 + n4);
    f32x4 v[16];
    const float* wp = W + (size_t)(k0 + (lane >> 4)) * ldw + (sc >= 0 ? sc : 0);
#pragma unroll
    for (int i = 0; i < 16; ++i) v[i] = *(const f32x4*)(wp + (size_t)(4 * i) * ldw);
#pragma unroll
    for (int i = 0; i < 16; ++i) { const int kk = 4 * i + (lane >> 4); const f32x4 u = (sc >= 0) ? v[i] : (f32x4){0.f, 0.f, 0.f, 0.f};
        scr[kk * 65 + n4] = u[0]; scr[kk * 65 + n4 + 1] = u[1]; scr[kk * 65 + n4 + 2] = u[2]; scr[kk * 65 + n4 + 3] = u[3]; }
    asm volatile("s_waitcnt lgkmcnt(0)" ::: "memory");
    const int c = lane & 7;
#pragma unroll
    for (int j = 0; j < 8; ++j) { const int n = (lane >> 3) + 8 * j; const LAS float* sp = scr + (8 * c) * 65 + n;
        v4u o; o.x = pk2(sp[0 * 65], sp[1 * 65]); o.y = pk2(sp[2 * 65], sp[3 * 65]); o.z = pk2(sp[4 * 65], sp[5 * 65]); o.w = pk2(sp[6 * 65], sp[7 * 65]);
        *(v4u*)(WT + (size_t)(n0 + n) * ldk + kofs + k0 + 8 * c) = o; }
    asm volatile("s_waitcnt lgkmcnt(0)" ::: "memory");
}
struct SrcIdent { int off; __device__ __forceinline__ int operator()(int n) const { return n + off; } };
struct SrcWin { __device__ __forceinline__ int operator()(int n) const { return n < 4096 ? n : (n < 6656 ? n + 16 : (n < 6672 ? n - 6656 + 4096 : (n < 6720 ? n : -1))); } };

typedef GAS unsigned gu32;
#define RLX_AGENT __ATOMIC_RELAXED, __HIP_MEMORY_SCOPE_AGENT
#define XB_TMO      128
#define XB_XCNT(j)  (256  + 64 * (j))
#define XB_XSUB(j)  (1280 + 64 * (j))
#define XB_XGEN(j)  (2304 + 64 * (j))
#define XB_TOP      3328
#define XB_TOPGEN   3392
#define XCD_BAR_WORDS 3456
#define XB_SPIN_CAP (1u << 18)

__device__ __forceinline__ unsigned xb_ld(unsigned* p)              { return __hip_atomic_load(p, __ATOMIC_RELAXED, __HIP_MEMORY_SCOPE_AGENT); }
__device__ __forceinline__ unsigned xb_add(unsigned* p, unsigned v) { return __hip_atomic_fetch_add(p, v, __ATOMIC_RELAXED, __HIP_MEMORY_SCOPE_AGENT); }
__device__ __forceinline__ unsigned xb_xcc_id() { return (unsigned)__builtin_amdgcn_s_getreg((3 << 11) | 20) & 0xFu; }
#define XB_SPIN(cond, bar) do { unsigned _sp = 0; while (cond) { __builtin_amdgcn_s_sleep(1); \
    if ((++_sp & 255u) == 0u) { if (xb_ld(&(bar)[XB_TMO])) break; if (_sp > XB_SPIN_CAP) { atomicAdd(&(bar)[XB_TMO], 1u); break; } } } } while (0)

struct XcdBarrier {
    unsigned* bar; unsigned x;
    volatile LAS unsigned* st;
};

__device__ __forceinline__ XcdBarrier xcd_barrier_post(unsigned* bar, volatile LAS unsigned* st) {
    XcdBarrier b; b.bar = bar; b.x = xb_xcc_id(); b.st = st;
    if (threadIdx.x == 0) (void)xb_add(&bar[XB_XCNT(b.x)], 1u);
    return b;
}
__device__ __forceinline__ void xcd_barrier_complete(unsigned* bar, unsigned x, unsigned& nloc, unsigned& nx) {
    const unsigned G = gridDim.x * gridDim.y * gridDim.z;
    unsigned sum, cnt, mine, sp = 0u;
    for (;;) {
        sum = 0u; cnt = 0u; mine = 0u;
#pragma unroll
        for (unsigned j = 0; j < 16; ++j) { const unsigned c = xb_ld(&bar[XB_XCNT(j)]); sum += c; cnt += (c > 0u) ? 1u : 0u; mine = (j == x) ? c : mine; }
        if (sum == G) break;
        __builtin_amdgcn_s_sleep(1);
        if ((++sp & 255u) == 0u) { if (xb_ld(&bar[XB_TMO])) break; if (sp > XB_SPIN_CAP) { atomicAdd(&bar[XB_TMO], 1u); break; } }
    }
    nloc = mine > 0u ? mine : 1u; nx = cnt > 0u ? cnt : 1u;
}

__device__ __forceinline__ void xcd_barrier(const XcdBarrier& b) {
    asm volatile("s_waitcnt vmcnt(0)" ::: "memory");
    __syncthreads();
    if (threadIdx.x == 0) {
        unsigned* bar = b.bar;
        __builtin_amdgcn_s_waitcnt(0);
        unsigned nloc = b.st[0], nx = b.st[1];
        if (nloc == 0u) { xcd_barrier_complete(bar, b.x, nloc, nx); b.st[0] = nloc; b.st[1] = nx; }
        const unsigned old = xb_add(&bar[XB_XSUB(b.x)], 1u);
        const unsigned gen = old / nloc;
        if (old + 1u == (gen + 1u) * nloc) {
            __builtin_amdgcn_fence(__ATOMIC_RELEASE, "agent");
            asm volatile("s_waitcnt vmcnt(0)" ::: "memory");
            const unsigned og = xb_add(&bar[XB_TOP], 1u);
            const unsigned tg = og / nx;
            if (og + 1u == (tg + 1u) * nx) xb_add(&bar[XB_TOPGEN], 1u);
            else XB_SPIN(xb_ld(&bar[XB_TOPGEN]) == tg, bar);
            __builtin_amdgcn_fence(__ATOMIC_ACQUIRE, "agent");
            xb_add(&bar[XB_XGEN(b.x)], 1u);
            asm volatile("s_waitcnt vmcnt(0)" ::: "memory");
        } else {
            XB_SPIN(xb_ld(&bar[XB_XGEN(b.x)]) == gen, bar);
            __builtin_amdgcn_fence(__ATOMIC_ACQUIRE, "agent");
            asm volatile("s_waitcnt vmcnt(0)" ::: "memory");
        }
    }
    __syncthreads();
}


struct Args { const float* in[23]; float* out; unsigned char* ws; int ph_lo, ph_hi; };

__global__ void __launch_bounds__(NWAVES * 64, 2) mk_fwd(Args args) {
    extern __shared__ __attribute__((aligned(16))) unsigned char lds_raw[];
    LAS unsigned char* lds = (LAS unsigned char*)lds_raw;
    __builtin_assume(__builtin_amdgcn_workitem_id_y() == 0); __builtin_assume(__builtin_amdgcn_workitem_id_z() == 0);
    cg::grid_group grid = cg::this_grid();
    const int tid = threadIdx.x, wave = __builtin_amdgcn_readfirstlane(tid >> 6);
#define lane ((int)(threadIdx.x & 63u))
    const int G = gridDim.x, gw = blockIdx.x * NWAVES + wave, NGW = G * NWAVES;
    unsigned char* ws = args.ws; unsigned char* dob = (unsigned char*)args.out;
    const float* x = args.in[0];
    bf16_t* P = (bf16_t*)(ws + WS_P);
    bf16_t* Hb = (bf16_t*)(dob + DO_H); bf16_t* Wg_t = (bf16_t*)(dob + DO_WG); bf16_t* Wcat_t = (bf16_t*)(dob + DO_WCAT); bf16_t* Win_t = (bf16_t*)(dob + DO_WIN);
    bf16_t* Wout_t = (bf16_t*)(ws + WS_WOUT); bf16_t* Wup_t = (bf16_t*)(ws + WS_WUP); bf16_t* Wdown_t = (bf16_t*)(ws + WS_WDOWN);
    bf16_t* Mix = (bf16_t*)(ws + WS_MIX); bf16_t* An = (bf16_t*)(ws + WS_AN); bf16_t* Up = (bf16_t*)(ws + WS_UP); float* pss = (float*)(ws + WS_PSS);
    LAS float* scr = (LAS float*)(lds + wave * 17408);
    bf16_t* Halo = (bf16_t*)(dob + DO_HALO); bf16_t* GWb = (bf16_t*)(ws + WS_GW); bf16_t* GQKb = (bf16_t*)(dob + DO_GQK); float* GLv = (float*)(ws + WS_GLV); unsigned* qcnt = (unsigned*)(ws + WS_QCNT);
    bf16_t* W1T = (bf16_t*)(ws + WS_W1T); float* bias1 = (float*)(ws + WS_BIAS1); bf16_t* KCb = (bf16_t*)(ws + WS_KCB); bf16_t* VCb = (bf16_t*)(ws + WS_VCB);
    const int lo = args.ph_lo, hi = args.ph_hi;
    if (tid < 2) ((volatile LAS unsigned*)(lds + 147456 - 32))[tid] = 0u;
    __syncthreads();
    XcdBarrier xbar = xcd_barrier_post((unsigned*)(ws + WS_XBAR), (volatile LAS unsigned*)(lds + 147456 - 32));
    if (args.ph_hi > 1000) grid.sync();
#ifndef PHMASK
#define PHMASK 0x1ff
#endif
#define IN(k) (((PHMASK >> (k)) & 1) && lo <= (k) && (k) < hi)
#define GRID_SYNC() do { asm volatile("s_waitcnt vmcnt(0) lgkmcnt(0)" ::: "memory"); grid.sync(); \
        if (wave == 0) { __builtin_amdgcn_fence(__ATOMIC_ACQUIRE, "agent"); asm volatile("s_waitcnt vmcnt(0)" ::: "memory"); } __syncthreads(); } while (0)
#if defined(TPROBE)
#define STAMP(k) do { if (blockIdx.x == 0 && tid == 0) ((volatile LAS unsigned long long*)(lds + 147456 - 512))[k] = __builtin_amdgcn_s_memrealtime(); } while (0)
#else
#define STAMP(k) do { } while (0)
#endif
#define SEAM(k) do { if (IN(k) && IN((k) + 1)) xcd_barrier(xbar); STAMP((k) + 1); } while (0)

    STAMP(0);
    if (IN(0)) {
        if (blockIdx.x == 0 && tid == 0) { *qcnt = 0u; ((volatile unsigned*)(ws + 786432))[4] = 0u; }
        constexpr int I_WIN = 16 * (NP1 / 64), I_WG = 16 * 32, I_DN = 16 * 16, I_OUT = 16 * 16, I_UP = 16 * 64;
        constexpr int I_W1 = 32 * 2, I_B1 = 64;
        constexpr int NITEMS = I_WIN + I_WG + 2 * I_DN + I_OUT + I_UP + 2 * I_W1 + I_B1;
        for (int it = gw; it < NITEMS; it += NGW) {
            int r = it;
            if (r < I_WIN) { transpose_item(args.in[2], INW, SrcWin{}, Win_t, D, 0, scr, r / (NP1 / 64), r % (NP1 / 64), lane); continue; } r -= I_WIN;
            if (r < I_WG) { transpose_item(args.in[2], INW, SrcIdent{6720}, Wg_t, D, 0, scr, r / 32, r % 32, lane); continue; } r -= I_WG;
            if (r < I_DN) { transpose_item(args.in[17], D, SrcIdent{0}, Wcat_t, 2 * D, 0, scr, r / 16, r % 16, lane); continue; } r -= I_DN;
            if (r < I_DN) { transpose_item(args.in[18], D, SrcIdent{0}, Wcat_t, 2 * D, D, scr, r / 16, r % 16, lane); continue; } r -= I_DN;
            if (r < I_OUT) { transpose_item(args.in[19], D, SrcIdent{0}, Wout_t, D, 0, scr, r / 16, r % 16, lane); continue; } r -= I_OUT;
            if (r < I_UP) { transpose_item(args.in[21], FF, SrcIdent{0}, Wup_t, D, 0, scr, r / 64, r % 64, lane); continue; } r -= I_UP;
            if (r < I_W1) { transpose_item(args.in[12], 128, SrcIdent{0}, W1T, 2048, 0, scr, r / 2, r % 2, lane); continue; } r -= I_W1;
            if (r < I_W1) { transpose_item(args.in[15], 128, SrcIdent{0}, W1T + 128 * 2048, 2048, 0, scr, r / 2, r % 2, lane); continue; } r -= I_W1;
            {
                const int which = r >> 5, kc = r & 31; const float* pos = args.in[which ? 14 : 11] + kc * 64; const float* w1 = args.in[which ? 15 : 12] + (size_t)kc * 64 * 128 + 2 * lane;
                float a0 = 0.f, a1 = 0.f;
#pragma unroll 16
                for (int k = 0; k < 64; ++k) { const float pk_ = pos[k]; const float2 w = *(const float2*)(w1 + (size_t)k * 128); a0 += pk_ * w.x; a1 += pk_ * w.y; }
                atomicAdd(bias1 + which * 128 + 2 * lane, a0); atomicAdd(bias1 + which * 128 + 2 * lane + 1, a1);
            }
        }
        const float* gain = args.in[1];
        f32x4 gv[4];
#pragma unroll
        for (int j = 0; j < 4; ++j) gv[j] = ((const f32x4*)gain)[lane + 64 * j];
        for (int m = gw; m < M; m += 2 * NGW) {
            const int m2 = (m + NGW < M) ? m + NGW : m;
            const f32x4* xr = (const f32x4*)(x + (size_t)m * D) + lane; const f32x4* xr2 = (const f32x4*)(x + (size_t)m2 * D) + lane;
            f32x4 v[4], u[4]; float s1 = 0.f, s2 = 0.f;
#pragma unroll
            for (int j = 0; j < 4; ++j) { v[j] = xr[64 * j]; u[j] = xr2[64 * j]; }
#pragma unroll
            for (int j = 0; j < 4; ++j) { s1 += (v[j].x * v[j].x + v[j].y * v[j].y) + (v[j].z * v[j].z + v[j].w * v[j].w); s2 += (u[j].x * u[j].x + u[j].y * u[j].y) + (u[j].z * u[j].z + u[j].w * u[j].w); }
            const float r1 = rsqrtf(wave_sum(s1) * (1.f / D) + EPS), r2 = rsqrtf(wave_sum(s2) * (1.f / D) + EPS);
            unsigned long long* o8 = (unsigned long long*)(Hb + (size_t)m * D) + lane; unsigned long long* o9 = (unsigned long long*)(Hb + (size_t)m2 * D) + lane;
#pragma unroll
            for (int j = 0; j < 4; ++j) { const f32x4 y = v[j] * r1 * gv[j]; o8[64 * j] = (unsigned long long)pk2(y.x, y.y) | ((unsigned long long)pk2(y.z, y.w) << 32); }
            if (m2 != m) {
#pragma unroll
                for (int j = 0; j < 4; ++j) { const f32x4 y = u[j] * r2 * gv[j]; o9[64 * j] = (unsigned long long)pk2(y.x, y.y) | ((unsigned long long)pk2(y.z, y.w) << 32); } }
        }
    }
    SEAM(0);
    if (IN(1)) {
        pg8::Gemm g{Hb, Win_t, D, D, M, NP1, D, 0}; pg8::StaticOrder S; S.init(M, NP1, G, (int)blockIdx.x);
        pg8::EpiP<0> E{P, LDP, 26, 64, Halo};
        pg8::gemm_phase<pg8::EpiP<0>, pg8::StaticOrder, true>(lds, g, S, E);
    }
    SEAM(1);
    if (IN(2)) {
        for (int it = (G == 256) ? (((int)blockIdx.x & 1) ? 128 : (int)blockIdx.x >> 1) : (int)blockIdx.x; it < 128; it += G) {
            const int half = it & 1, which = (it >> 1) & 1, g_ = (it >> 2) & 3, b_ = it >> 4;
            nsa::compress_item(lds, P, W1T + (size_t)which * 128 * 2048, bias1 + which * 128, args.in[which ? 16 : 13], args.in[8], which ? VCb : KCb, b_, g_, which, half);
        }
        STAMP(11);
        nsa::prep_units(P, args.in[7], args.in[9], args.in[10], gw, NGW, lane);
        STAMP(12);
#if !defined(GDN_NAIVE)
        __syncthreads();
        {
            gdn::RowPre pre; int hl = -1;
            const int c_ = (int)blockIdx.x, hq = c_ >> 5, jq = c_ & 31;
            const bool bal = (G == 256);
            const int cnt = bal ? ((jq & 1) ? 9 : 7) : (2048 - c_ + G - 1) / G;
            const int first = bal ? ((jq & 1) ? 112 + 9 * (jq >> 1) : 7 * (jq >> 1)) : 0;
#define PREP_COORD(k, b_, n_, h_) do { if (bal) { const int idx_ = first + (k); b_ = idx_ >> 5; n_ = idx_ & 31; h_ = hq; } else { const int it_ = c_ + (k) * G; b_ = it_ >> 8; n_ = it_ & 31; h_ = (it_ >> 5) & 7; } } while (0)
            int b0, n0, h0;
            if (cnt > 0) { PREP_COORD(0, b0, n0, h0); gdn::prep_prefetch(pre, P, Halo, b0, n0, h0, wave, lane); }
            for (int k = 0; k < cnt; ++k) {
                int bc, nc, hc, bn = -1, nn = 0, hn = 0;
                PREP_COORD(k, bc, nc, hc);
                if (k + 1 < cnt) PREP_COORD(k + 1, bn, nn, hn);
                if (hc != hl) { __syncthreads(); gdn::prep_load_taps(lds, args.in[3], hc); hl = hc; __syncthreads(); }
                gdn::prep_item(lds, P, Halo, args.in[4], args.in[5], GWb, GQKb, GLv, pre, bc, nc, hc, bn, nn, hn);
                if (k == 0) STAMP(14);
            }
#undef PREP_COORD
        }
        STAMP(13);
#endif
    }
    SEAM(2);
    if (IN(3)) {
#if defined(GDN_NAIVE)
        if ((int)blockIdx.x < 16) gdn_naive::run(lds, P, args.in[3], args.in[4], args.in[5], args.in[6], 4 * (int)blockIdx.x);
#else
        if ((int)blockIdx.x < 64) gdn::scan_item(lds, P, GWb, GQKb, GLv, args.in[6], (int)blockIdx.x >> 3, (int)blockIdx.x & 7);
#endif
        __syncthreads();
        STAMP(10);
        for (;;) {
            volatile LAS unsigned* qslot = (volatile LAS unsigned*)(lds + 147456 - 16);
            if (tid == 0) *qslot = atomicAdd(qcnt, 1u);
            __syncthreads();
            const int idx = (int)*qslot;
            __syncthreads();
            if (idx >= 1024) break;
#if defined(TPROBE)
            if (blockIdx.x == 200 && tid == 0) { ((volatile unsigned long long*)(ws + 786432))[0] = __builtin_amdgcn_s_memrealtime(); ((volatile unsigned*)(ws + 786432))[4] += 1u; }
#endif
            nsa::attn_tile(lds, P, KCb, VCb, (idx & 31) >> 2, idx & 3, 31 - (idx >> 5));
        }
    }
    SEAM(3);
    if (IN(4)) {
        pg8::Gemm g{Hb, Wg_t, D, D, M, 2048, D, 0}; pg8::StaticOrder S; S.init(M, 2048, G, (int)blockIdx.x);
        pg8::EpiP<1> E{P, LDP, -1, 256, nullptr};
        pg8::gemm_phase<pg8::EpiP<1>, pg8::StaticOrder, true>(lds, g, S, E);
    }
    SEAM(4);
    if (IN(5)) {
        pg8::Gemm g{P + C_DZ, Wcat_t, LDP, 2 * D, M, D, D, D}; pg8::TwoPassOrder S; S.base.init(M, D, G, (int)blockIdx.x);
        pg8::EpiMix E{P, LDP, Mix, D};
        pg8::gemm_phase<pg8::EpiMix, pg8::TwoPassOrder, false>(lds, g, S, E);
    }
    SEAM(5);
    if (IN(6)) {
        for (int it = gw; it < 64 * 16; it += NGW) transpose_item(args.in[22], D, SrcIdent{0}, Wdown_t, FF, 0, scr, it / 16, it % 16, lane);
        __syncthreads();
        pg8::Gemm g{Mix, Wout_t, D, D, M, D, D, 0}; pg8::StaticOrder S; S.init(M, D, G, (int)blockIdx.x);
        pg8::EpiOut E{x, args.out, An, args.in[20], pss};
        pg8::gemm_phase<pg8::EpiOut, pg8::StaticOrder, false>(lds, g, S, E);
    }
    SEAM(6);
    if (IN(7)) {
        pg8::Gemm g{An, Wup_t, D, D, M, FF, D, 0}; pg8::StaticOrder S; S.init(M, FF, G, (int)blockIdx.x);
        pg8::EpiUp E{pss, Up, FF};
        pg8::gemm_phase<pg8::EpiUp, pg8::StaticOrder, true>(lds, g, S, E);
    }
    SEAM(7);
    if (IN(8)) {
        pg8::Gemm g{Up, Wdown_t, FF, FF, M, D, FF, 0}; pg8::StaticOrder S; S.init(M, D, G, (int)blockIdx.x);
        pg8::EpiDown E{args.out};
        pg8::gemm_phase<pg8::EpiDown, pg8::StaticOrder, false>(lds, g, S, E);
    }
#if defined(TPROBE)
    STAMP(9);
    GRID_SYNC();
    if (blockIdx.x == 0) {
        volatile LAS unsigned long long* ts = (volatile LAS unsigned long long*)(lds + 147456 - 512);
        if (tid == 0) { ts[25] = ((volatile unsigned long long*)(ws + 786432))[0]; ts[26] = ts[3] + 100ull * ((volatile unsigned*)(ws + 786432))[4]; }
        const float dA = (float)(ts[TPA1] - ts[TPA0]) * 0.01f, dB = (float)(ts[TPB1] - ts[TPB0]) * 0.01f;
        if (tid == 0) args.out[0] = dA + 0.f * dB;
    }
#endif
#undef IN
#undef SEAM
#undef GRID_SYNC
}

#undef lane
static int g_grid = 0;
static void launch_mk(const Args& a0, int lo, int hi, hipStream_t stream) {
    Args a = a0; a.ph_lo = lo; a.ph_hi = hi;
    void* kargs[] = {(void*)&a};
    hipError_t e = hipLaunchCooperativeKernel((const void*)mk_fwd, dim3(g_grid), dim3(NWAVES * 64), kargs, LDS_BYTES, stream);
    if (e != hipSuccess) fprintf(stderr, "cooperative launch failed: %s (grid %d)\n", hipGetErrorString(e), g_grid);
}

extern "C" void kernel_launch(void* const* d_in, const int* in_sizes, int n_in, void* d_out, int out_size, void* d_ws, size_t ws_size, hipStream_t stream) {
    if (g_grid == 0) {
        int dev = 0, cus = 0, per_cu = 0;
        hipGetDevice(&dev);
        hipDeviceGetAttribute(&cus, hipDeviceAttributeMultiprocessorCount, dev);
        hipFuncSetAttribute((const void*)mk_fwd, hipFuncAttributeMaxDynamicSharedMemorySize, LDS_BYTES);
        hipOccupancyMaxActiveBlocksPerMultiprocessor(&per_cu, (const void*)mk_fwd, NWAVES * 64, LDS_BYTES);
        if (per_cu < 1) per_cu = 1;
        if (per_cu > 1) per_cu = 1;
        g_grid = cus * per_cu;
    }
    Args a{};
    for (int i = 0; i < 23; ++i) a.in[i] = (const float*)d_in[i];
    a.out = (float*)d_out; a.ws = (unsigned char*)d_ws;
    bf16_t* P = (bf16_t*)((char*)d_ws + WS_P);
    hipMemsetAsync((char*)d_ws + WS_XBAR, 0, 16384 + 1024, stream);
    launch_mk(a, 0, 9, stream);
}
```

```cpp
#include <hip/hip_runtime.h>
#include <hip/hip_cooperative_groups.h>
#include <stdint.h>
#include <cstdio>
namespace cg = cooperative_groups;

typedef unsigned short bf16_t;

constexpr int D = 1024, BATCH = 8, SEQ = 2048, M = BATCH * SEQ;
constexpr int DN_H = 8, DN_D = 128;
constexpr int NS_H = 16, NS_G = 4, NS_R = 4, NS_D = 64;
constexpr int NCMP = 127, NSEL = 32;
constexpr int FF = 4096;
constexpr int INW = 8768;
constexpr float EPS = 1e-6f;
constexpr float NEGV = -1e30f, FORCEV = 1e9f;

constexpr int LDP = 6720;
constexpr int C_DQ = 0, C_DK = 1024, C_DV = 2048, C_DZ = 3072, C_NQ = 4096;
constexpr int C_KC = 5120, C_VC = 5376, C_KS = 5632, C_VS = 5888, C_KW = 6144, C_VW = 6400;
constexpr int C_SB = 6656, C_SA = 6664, C_SG = 6672;
constexpr int NP1 = 6912;

__device__ __forceinline__ float bf2f(bf16_t v) { return __uint_as_float(((unsigned)v) << 16); }
__device__ __forceinline__ bf16_t f2bf(float f) { unsigned u = __float_as_uint(f); return (bf16_t)((u + 0x7fffu + ((u >> 16) & 1u)) >> 16); }
__device__ __forceinline__ float sigmoidf_(float x) { return 1.f / (1.f + __expf(-x)); }
__device__ __forceinline__ float siluf_(float x) { return x * sigmoidf_(x); }
__device__ __forceinline__ float softplusf_(float x) { return fmaxf(x, 0.f) + log1pf(__expf(-fabsf(x))); }
__device__ __forceinline__ float gelu_tanh(float x) { return 0.5f * x * (1.f + tanhf(0.7978845608028654f * (x + 0.044715f * x * x * x))); }

__device__ __forceinline__ float block_sum(float v, float* red) {
    for (int o = 32; o > 0; o >>= 1) v += __shfl_xor(v, o);
    const int w = threadIdx.x >> 6, nw = blockDim.x >> 6;
    __syncthreads();
    if ((threadIdx.x & 63) == 0) red[w] = v;
    __syncthreads();
    float s = 0.f;
    for (int i = 0; i < nw; ++i) s += red[i];
    return s;
}
__device__ __forceinline__ float block_max(float v, float* red) {
    for (int o = 32; o > 0; o >>= 1) v = fmaxf(v, __shfl_xor(v, o));
    const int w = threadIdx.x >> 6, nw = blockDim.x >> 6;
    __syncthreads();
    if ((threadIdx.x & 63) == 0) red[w] = v;
    __syncthreads();
    float s = red[0];
    for (int i = 1; i < nw; ++i) s = fmaxf(s, red[i]);
    return s;
}


#if defined(TPROBE)
#define XSTAMP(k) do { if (blockIdx.x == 0 && threadIdx.x == 0) ((volatile __attribute__((address_space(3))) unsigned long long*)(lds + 147456 - 512))[k] = __builtin_amdgcn_s_memrealtime(); } while (0)
#else
#define XSTAMP(k) do { } while (0)
#endif
namespace gdn_naive {
#define GLAS __attribute__((address_space(3)))
__device__ __forceinline__ float sub_sum(float v, GLAS float* red, int sub, int tid) {
#pragma unroll
    for (int o = 32; o > 0; o >>= 1) v += __shfl_xor(v, o);
    __syncthreads();
    if ((tid & 63) == 0) red[sub * 2 + ((tid >> 6) & 1)] = v;
    __syncthreads();
    return red[sub * 2] + red[sub * 2 + 1];
}
__device__ __forceinline__ void run(GLAS unsigned char* lds, bf16_t* P, const float* convw, const float* a_log, const float* dt_bias, const float* out_norm, int item0) {
    const int tid = threadIdx.x, sub = tid >> 7, j = tid & 127;
    GLAS float* qs = (GLAS float*)lds + sub * 256; GLAS float* ks = qs + 128; GLAS float* red = (GLAS float*)(lds + 4096);
    const int item = item0 + sub; const int b = item / DN_H, h = item % DN_H;
    float s[128];
#pragma unroll
    for (int i = 0; i < 128; ++i) s[i] = 0.f;
    const float Ah = -__expf(a_log[h]), dtb = dt_bias[h], gn = out_norm[j];
    const float scale = 0.08838834764831845f;
    float wq[4], wk[4], wv[4], xq[3] = {0.f, 0.f, 0.f}, xk[3] = {0.f, 0.f, 0.f}, xv[3] = {0.f, 0.f, 0.f};
#pragma unroll
    for (int t = 0; t < 4; ++t) { wq[t] = convw[t * 3072 + h * 128 + j]; wk[t] = convw[t * 3072 + 1024 + h * 128 + j]; wv[t] = convw[t * 3072 + 2048 + h * 128 + j]; }
    for (int t = 0; t < SEQ; ++t) {
        bf16_t* row = P + (size_t)(b * SEQ + t) * LDP;
        const float rq = bf2f(row[C_DQ + h * DN_D + j]), rk = bf2f(row[C_DK + h * DN_D + j]), rv = bf2f(row[C_DV + h * DN_D + j]);
        float q = siluf_(wq[0] * xq[0] + wq[1] * xq[1] + wq[2] * xq[2] + wq[3] * rq);
        float k = siluf_(wk[0] * xk[0] + wk[1] * xk[1] + wk[2] * xk[2] + wk[3] * rk);
        const float v = siluf_(wv[0] * xv[0] + wv[1] * xv[1] + wv[2] * xv[2] + wv[3] * rv);
        xq[0] = xq[1]; xq[1] = xq[2]; xq[2] = rq; xk[0] = xk[1]; xk[1] = xk[2]; xk[2] = rk; xv[0] = xv[1]; xv[1] = xv[2]; xv[2] = rv;
        const float sq = sub_sum(q * q, red, sub, tid);
        const float sk = sub_sum(k * k, red, sub, tid);
        q *= rsqrtf(sq + EPS); k *= rsqrtf(sk + EPS);
        qs[j] = q; ks[j] = k;
        const float beta = sigmoidf_(bf2f(row[C_SB + h]));
        const float a = __expf(Ah * softplusf_(bf2f(row[C_SA + h]) + dtb));
        const float z = bf2f(row[C_DZ + h * DN_D + j]);
        __syncthreads();
        float kS = 0.f;
#pragma unroll
        for (int i = 0; i < 128; ++i) kS += ks[i] * s[i];
        const float dlt = beta * (v - a * kS);
        asm volatile("" ::: "memory");
        float o = 0.f;
#pragma unroll
        for (int i = 0; i < 128; ++i) { s[i] = a * s[i] + ks[i] * dlt; o += qs[i] * s[i]; }
        o *= scale;
        const float ss = sub_sum(o * o, red, sub, tid);
        row[C_DZ + h * DN_D + j] = f2bf(o * rsqrtf(ss * (1.f / 128.f) + EPS) * gn * siluf_(z));
    }
}
}
namespace gdn {
#define GL3 __attribute__((address_space(3)))
typedef short bf16x8 __attribute__((ext_vector_type(8)));
typedef short s16x4 __attribute__((ext_vector_type(4)));
typedef short v4i16_t __attribute__((ext_vector_type(4)));
typedef float f32x16 __attribute__((ext_vector_type(16)));
typedef float f32x4 __attribute__((ext_vector_type(4)));
typedef float f32x2 __attribute__((ext_vector_type(2)));
typedef unsigned u32x4 __attribute__((ext_vector_type(4)));
typedef unsigned u32x2 __attribute__((ext_vector_type(2)));
typedef __bf16 bf16x2_t __attribute__((ext_vector_type(2)));
constexpr float QSCALE = 0.08838834764831845f;
__device__ __forceinline__ float fsig(float x) { return __builtin_amdgcn_rcpf(1.f + __builtin_amdgcn_exp2f(-1.4426950408889634f * x)); }
__device__ __forceinline__ float fsilu(float x) { return x * fsig(x); }
__device__ __forceinline__ int crow(int i, int hi) { return (i & 3) + 8 * (i >> 2) + 4 * hi; }
__device__ __forceinline__ unsigned pk(float lo, float hi) { f32x2 v = {lo, hi}; bf16x2_t b = __builtin_convertvector(v, bf16x2_t); return __builtin_bit_cast(unsigned, b); }
__device__ __forceinline__ bf16x8 pack8(const float* v) { u32x4 w = {pk(v[0], v[1]), pk(v[2], v[3]), pk(v[4], v[5]), pk(v[6], v[7])}; return __builtin_bit_cast(bf16x8, w); }
__device__ __forceinline__ float blo(unsigned w) { return __uint_as_float(w << 16); }
__device__ __forceinline__ float bhi(unsigned w) { return __uint_as_float(w & 0xffff0000u); }
__device__ __forceinline__ char* seg_addr(bf16_t* P, size_t row0, int c0, unsigned e) { return (char*)P + ((row0 + (e >> 8)) * LDP + c0) * 2 + (e & 255u); }

__device__ __forceinline__ s16x4 vtr(GL3 const unsigned char* p) { return __builtin_bit_cast(s16x4, __builtin_amdgcn_ds_read_tr16_b64_v4i16((GL3 v4i16_t*)p)); }

constexpr int PL_K = 0, PL_KB = 16384, PL_Q = 32768, PL_RV = 49152, PL_AM = 81920, PL_INV = 99328, PL_MT = 116736, PL_GC = 120832, PL_QKST = 121088, PL_TI = 129280, PL_CW = 137472, PL_END = 143616;
constexpr int PL_WST = 0, PL_UST = 16384;
constexpr int AMLD = 68;
struct RowPre { u32x4 x[2][3][4]; unsigned short lb, la; };
__device__ __forceinline__ void prep_prefetch(RowPre& pre, const bf16_t* P, const bf16_t* HALO, int b, int n, int h, int wid, int lane) {
    const size_t row0 = (size_t)b * SEQ + 64 * n; const int dc = lane & 15;
    const bf16_t* prow = P + (row0 + lane) * LDP;
    pre.lb = prow[C_SB + h]; pre.la = prow[C_SA + h];
#pragma unroll
    for (int pass = 0; pass < 2; ++pass) {
        const int tok = 8 * wid + 4 * pass + (lane >> 4);
#pragma unroll
        for (int which = 0; which < 3; ++which) {
            const int col = which * 1024 + h * 128 + dc * 8;
#pragma unroll
            for (int j = 0; j < 4; ++j) {
                const int rr = tok - 3 + j; const bool inb = rr >= 0;
                const bf16_t* src = inb ? (P + (row0 + (inb ? rr : 0)) * LDP + col) : (HALO + ((size_t)((b * 32 + (n > 0 ? n - 1 : 0)) * 3 + (inb ? 0 : 3 + rr))) * 3072 + col);
                pre.x[pass][which][j] = *(const u32x4*)src;
            }
        }
    }
}
__device__ __forceinline__ void prep_load_taps(GL3 unsigned char* lds, const float* convw, int h) {
    GL3 float* cw = (GL3 float*)(lds + 137472);
    for (int e = threadIdx.x; e < 1536; e += 512) { const int which = e >> 9, j = (e >> 7) & 3, c = e & 127; cw[e] = convw[j * 3072 + which * 1024 + h * 128 + c]; }
}
#define PBAR() do { asm volatile("s_waitcnt lgkmcnt(0)" ::: "memory"); __builtin_amdgcn_s_barrier(); asm volatile("" ::: "memory"); } while (0)
__device__ __forceinline__ void prep_item(GL3 unsigned char* lds, bf16_t* P, const bf16_t* HALO, const float* a_log, const float* dt_bias,
                                          bf16_t* GW, bf16_t* GQK, float* GLv, RowPre& pre, int b, int n, int h, int nb_, int nn_, int nh_) {
    int tid = threadIdx.x; asm volatile("" : "+v"(tid));
    const int lane = tid & 63, r32 = lane & 31, hi = lane >> 5; const int wid = __builtin_amdgcn_readfirstlane(tid >> 6);
    const size_t row0 = (size_t)b * SEQ + 64 * n; const int item = (b * DN_H + h) * 32 + n;
    GL3 float* AM = (GL3 float*)(lds + PL_AM); GL3 float* INV = (GL3 float*)(lds + PL_INV); GL3 float* MT = (GL3 float*)(lds + PL_MT); GL3 float* GC = (GL3 float*)(lds + PL_GC);
    float gcum, beta_l, gc_last;
    {
        beta_l = fsig(bf2f(pre.lb));
        { const float xs = bf2f(pre.la) + dt_bias[h]; gcum = -__expf(a_log[h]) * (fmaxf(xs, 0.f) + __logf(1.f + __expf(-fabsf(xs)))); }
#pragma unroll
        for (int o = 1; o < 64; o <<= 1) { const float t = __shfl_up(gcum, o); if (lane >= o) gcum += t; }
        gc_last = __shfl(gcum, 63);
        if (wid == 0) GC[lane] = gcum;
    }
    bf16x8 qd_keep[2], ke_keep[2];
    const int dc = lane & 15;
#pragma unroll
    for (int pass = 0; pass < 2; ++pass) {
        const int tok = 8 * wid + 4 * pass + (lane >> 4);
        const float gct = __shfl(gcum, tok), bet = __shfl(beta_l, tok);
        float y[3][8];
#pragma unroll
        for (int which = 0; which < 3; ++which) {
#pragma unroll
            for (int e = 0; e < 8; ++e) y[which][e] = 0.f;
#pragma unroll
            for (int j = 0; j < 4; ++j) {
                const int rr = tok - 3 + j;
                u32x4 x = pre.x[pass][which][j];
                if (rr < 0 && n == 0) x = (u32x4){0u, 0u, 0u, 0u};
                const f32x4 w0 = *(GL3 const f32x4*)(lds + PL_CW + ((which * 4 + j) * 128 + dc * 8) * 4), w1 = *(GL3 const f32x4*)(lds + PL_CW + ((which * 4 + j) * 128 + dc * 8 + 4) * 4);
                y[which][0] += w0[0] * blo(x.x); y[which][1] += w0[1] * bhi(x.x); y[which][2] += w0[2] * blo(x.y); y[which][3] += w0[3] * bhi(x.y);
                y[which][4] += w1[0] * blo(x.z); y[which][5] += w1[1] * bhi(x.z); y[which][6] += w1[2] * blo(x.w); y[which][7] += w1[3] * bhi(x.w);
            }
#pragma unroll
            for (int e = 0; e < 8; ++e) y[which][e] = fsilu(y[which][e]);
        }
        float sq = 0.f, sk = 0.f;
#pragma unroll
        for (int e = 0; e < 8; ++e) { sq += y[0][e] * y[0][e]; sk += y[1][e] * y[1][e]; }
#pragma unroll
        for (int o = 1; o < 16; o <<= 1) { sq += __shfl_xor(sq, o); sk += __shfl_xor(sk, o); }
        const float rq = rsqrtf(sq + EPS), rk = rsqrtf(sk + EPS);
        const float eg = __expf(gct), ke_s = __expf(gc_last - gct);
        float q8[8], k8[8], kb8[8], qd8[8], ke8[8], kbg8[8], vb8[8];
#pragma unroll
        for (int e = 0; e < 8; ++e) { q8[e] = y[0][e] * rq; k8[e] = y[1][e] * rk; kb8[e] = k8[e] * bet; qd8[e] = q8[e] * (QSCALE * eg); ke8[e] = k8[e] * ke_s; kbg8[e] = kb8[e] * eg; vb8[e] = y[2][e] * bet; }
        const int io = (dc * 64 + tok) * 16;
        *(GL3 bf16x8*)(lds + PL_Q + io) = pack8(q8); *(GL3 bf16x8*)(lds + PL_K + io) = pack8(k8); *(GL3 bf16x8*)(lds + PL_KB + io) = pack8(kb8);
        {
            const int rvo = (tok >> 4) * 1024 + ((tok >> 3) & 1) * 512 + (tok & 7) * 64 + (dc & 3) * 16;
            *(GL3 bf16x8*)(lds + PL_RV + (dc >> 2) * 4096 + rvo) = pack8(kbg8); *(GL3 bf16x8*)(lds + PL_RV + (4 + (dc >> 2)) * 4096 + rvo) = pack8(vb8);
        }
        qd_keep[pass] = pack8(qd8); ke_keep[pass] = pack8(ke8);
    }
    PBAR();
    if (nb_ >= 0) prep_prefetch(pre, P, HALO, nb_, nn_, nh_, wid, lane);
    if (n == 0 && b == 0 && h == 0) XSTAMP(15);
#pragma unroll
    for (int pass = 0; pass < 2; ++pass) {
        const int tok = 8 * wid + 4 * pass + (lane >> 4);
        *(bf16x8*)seg_addr(P, row0, C_DQ + h * 128, (unsigned)((dc * 64 + tok) * 16)) = qd_keep[pass];
        const unsigned ek = (unsigned)(((dc >> 2) * 4 + (tok >> 4)) * 1024 + ((tok >> 3) & 1) * 512 + (tok & 7) * 64 + (dc & 3) * 16);
        *(bf16x8*)seg_addr(P, row0, C_DK + h * 128, ek) = ke_keep[pass];
    }
    if (wid < 6) {
        const bool isA = wid < 3; const int t3 = isA ? wid : wid - 3;
        const int rt = isA ? (t3 > 0) : (t3 == 2);
        const int ct = isA ? (t3 == 2) : (t3 > 0);
        GL3 const unsigned char* aimg = lds + (isA ? PL_KB : PL_K); GL3 const unsigned char* bimg = lds + (isA ? PL_K : PL_Q);
        f32x16 acc = f32x16{};
#pragma unroll
        for (int s = 0; s < 8; ++s) {
            const bf16x8 a = *(GL3 const bf16x8*)(aimg + ((2 * s + hi) * 64 + 32 * rt + r32) * 16);
            const bf16x8 bb = *(GL3 const bf16x8*)(bimg + ((2 * s + hi) * 64 + 32 * ct + r32) * 16);
            acc = __builtin_amdgcn_mfma_f32_32x32x16_bf16(a, bb, acc, 0, 0, 0);
        }
        if (isA) {
            const int j = 32 * ct + r32; const float gj = GC[j];
#pragma unroll
            for (int i_ = 0; i_ < 16; ++i_) { const int i = 32 * rt + crow(i_, hi); AM[i * AMLD + j] = (j < i) ? acc[i_] * __expf(GC[i] - gj) : 0.f; }
        } else {
            const int i = 32 * ct + r32; const float gi = GC[i];
            float v[16];
#pragma unroll
            for (int i_ = 0; i_ < 16; ++i_) { const int j = 32 * rt + crow(i_, hi); v[i_] = (j <= i) ? acc[i_] * (QSCALE * __expf(gi - GC[j])) : 0.f; }
#pragma unroll
            for (int sp = 0; sp < 2; ++sp) *(GL3 bf16x8*)(lds + PL_QKST + (((2 * rt + sp) * 64 + i) * 16 + 8 * hi) * 2) = pack8(v + 8 * sp);
        }
    } else if (wid == 6) {
        const bf16x8 z = {0, 0, 0, 0, 0, 0, 0, 0};
#pragma unroll
        for (int sp = 0; sp < 2; ++sp) *(GL3 bf16x8*)(lds + PL_QKST + (((2 + sp) * 64 + r32) * 16 + 8 * hi) * 2) = z;
    }
    PBAR();
    if (wid < 4 && lane < 16) {
        const int bb = wid, c = lane;
        float x[16];
#pragma unroll
        for (int i = 0; i < 16; ++i) {
            float acc = (i == c) ? 1.f : 0.f;
#pragma unroll
            for (int j4 = 0; j4 < i; j4 += 4) { const f32x4 a = *(GL3 const f32x4*)(AM + (16 * bb + i) * AMLD + 16 * bb + j4);
                acc -= a[0] * x[j4]; if (j4 + 1 < i) acc -= a[1] * x[j4 + 1]; if (j4 + 2 < i) acc -= a[2] * x[j4 + 2]; if (j4 + 3 < i) acc -= a[3] * x[j4 + 3]; }
            x[i] = acc;
        }
#pragma unroll
        for (int i = 0; i < 16; ++i) INV[(16 * bb + i) * AMLD + 16 * bb + c] = x[i];
    }
    PBAR();
    for (int L = 1; L < 4; ++L) {
        const int nb = 4 - L;
        for (int t = tid; t < nb * 256; t += 512) {
            const int J = t >> 8, I = J + L, ei = (t >> 4) & 15, ej = t & 15;
            float acc = 0.f;
            for (int K = J; K < I; ++K) {
#pragma unroll
                for (int k4 = 0; k4 < 16; k4 += 4) { const f32x4 a = *(GL3 const f32x4*)(AM + (16 * I + ei) * AMLD + 16 * K + k4);
                    acc += a[0] * INV[(16 * K + k4) * AMLD + 16 * J + ej] + a[1] * INV[(16 * K + k4 + 1) * AMLD + 16 * J + ej] + a[2] * INV[(16 * K + k4 + 2) * AMLD + 16 * J + ej] + a[3] * INV[(16 * K + k4 + 3) * AMLD + 16 * J + ej]; }
            }
            MT[(J * 16 + ei) * 17 + ej] = acc;
        }
        PBAR();
        for (int t = tid; t < nb * 256; t += 512) {
            const int J = t >> 8, I = J + L, ei = (t >> 4) & 15, ej = t & 15;
            float acc = 0.f;
#pragma unroll
            for (int k4 = 0; k4 < 16; k4 += 4) { const f32x4 d = *(GL3 const f32x4*)(INV + (16 * I + ei) * AMLD + 16 * I + k4);
                acc += d[0] * MT[(J * 16 + k4) * 17 + ej] + d[1] * MT[(J * 16 + k4 + 1) * 17 + ej] + d[2] * MT[(J * 16 + k4 + 2) * 17 + ej] + d[3] * MT[(J * 16 + k4 + 3) * 17 + ej]; }
            INV[(16 * I + ei) * AMLD + 16 * J + ej] = -acc;
        }
        PBAR();
    }
    {
        const int s_ = tid >> 7, i = (tid >> 1) & 63, hh = tid & 1;
        float v[8];
        if (s_ > (i >> 4)) {
#pragma unroll
            for (int e = 0; e < 8; ++e) v[e] = 0.f;
        } else {
            const f32x4 a = *(GL3 const f32x4*)(INV + i * AMLD + 16 * s_ + 4 * hh), c4 = *(GL3 const f32x4*)(INV + i * AMLD + 16 * s_ + 8 + 4 * hh);
            v[0] = a[0]; v[1] = a[1]; v[2] = a[2]; v[3] = a[3]; v[4] = c4[0]; v[5] = c4[1]; v[6] = c4[2]; v[7] = c4[3];
        }
        *(GL3 bf16x8*)(lds + PL_TI + ((s_ * 64 + i) * 16 + 8 * hh) * 2) = pack8(v);
    }
    PBAR();
    {
        const int cb = wid;
        GL3 const unsigned char* rp = lds + PL_RV + cb * 4096 + ((lane >> 4) & 1) * 32 + (lane & 3) * 8 + (4 * hi + ((lane & 15) >> 2)) * 64;
        f32x16 d0 = f32x16{}, d1 = f32x16{};
#pragma unroll
        for (int ks = 0; ks < 4; ++ks) {
            const s16x4 lo = vtr(rp + ks * 1024), hh2 = vtr(rp + ks * 1024 + 512);
            const bf16x8 rf = {lo[0], lo[1], lo[2], lo[3], hh2[0], hh2[1], hh2[2], hh2[3]};
            const bf16x8 t1 = *(GL3 const bf16x8*)(lds + PL_TI + ((ks * 64 + 32 + r32) * 16 + 8 * hi) * 2);
            if (cb < 4) {
                if (ks < 2) { const bf16x8 t0 = *(GL3 const bf16x8*)(lds + PL_TI + ((ks * 64 + r32) * 16 + 8 * hi) * 2); d0 = __builtin_amdgcn_mfma_f32_32x32x16_bf16(rf, t0, d0, 0, 0, 0); }
                d1 = __builtin_amdgcn_mfma_f32_32x32x16_bf16(rf, t1, d1, 0, 0, 0);
            } else {
                if (ks < 2) { const bf16x8 t0 = *(GL3 const bf16x8*)(lds + PL_TI + ((ks * 64 + r32) * 16 + 8 * hi) * 2); d0 = __builtin_amdgcn_mfma_f32_32x32x16_bf16(t0, rf, d0, 0, 0, 0); }
                d1 = __builtin_amdgcn_mfma_f32_32x32x16_bf16(t1, rf, d1, 0, 0, 0);
            }
        }
        PBAR();
        if (cb < 4) {
#pragma unroll
            for (int a = 0; a < 4; ++a) {
                u32x2 w0 = {pk(d0[4 * a], d0[4 * a + 1]), pk(d0[4 * a + 2], d0[4 * a + 3])}, w1 = {pk(d1[4 * a], d1[4 * a + 1]), pk(d1[4 * a + 2], d1[4 * a + 3])};
                *(GL3 u32x2*)(lds + PL_WST + ((4 * cb + a) * 64 + r32) * 16 + 8 * hi) = w0;
                *(GL3 u32x2*)(lds + PL_WST + ((4 * cb + a) * 64 + 32 + r32) * 16 + 8 * hi) = w1;
            }
        } else {
            const int dvc = 32 * (cb - 4) + r32;
#pragma unroll
            for (int i = 0; i < 16; ++i) { *(GL3 bf16_t*)(lds + PL_UST + (crow(i, hi) * 128 + dvc) * 2) = f2bf(d0[i]); *(GL3 bf16_t*)(lds + PL_UST + ((32 + crow(i, hi)) * 128 + dvc) * 2) = f2bf(d1[i]); }
        }
    }
    PBAR();
#pragma unroll
    for (int k = 0; k < 2; ++k) {
        const int e = (tid + 512 * k) * 16;
        *(u32x4*)((char*)(GW + (size_t)item * 8192) + e) = *(GL3 const u32x4*)(lds + PL_WST + e);
        *(u32x4*)seg_addr(P, row0, C_DV + h * 128, (unsigned)e) = *(GL3 const u32x4*)(lds + PL_UST + e);
    }
    *(u32x4*)((char*)(GQK + (size_t)item * 4096) + tid * 16) = *(GL3 const u32x4*)(lds + PL_QKST + tid * 16);
    if (tid == 0) GLv[item] = __expf(gc_last);
    PBAR();
}

#undef PBAR
constexpr int SL_W = 0, SL_QD = 16384, SL_KE = 32768, SL_QK = 49152, SL_U = 57344, SL_Z = 73728, SL_S = 90112, SL_VN = 122880, SL_RS = 139264, SL_END = 140416;
__device__ __forceinline__ void glds16(const void* gsrc, unsigned lds_dst) { unsigned keep;
    asm volatile("s_mov_b32 %0, m0\n\ts_mov_b32 m0, %2\n\ts_nop 0\n\tglobal_load_lds_dwordx4 %1, off\n\ts_mov_b32 m0, %0" : "=&s"(keep) : "v"(gsrc), "s"(lds_dst) : "memory"); }
__device__ __forceinline__ unsigned lds_addr(GL3 unsigned char* p) { return (unsigned)(size_t)p; }
__device__ __forceinline__ void dma_seg(GL3 unsigned char* dst, const bf16_t* P, size_t row0, int c0, int wid, int lane) {
#pragma unroll
    for (int k = 0; k < 2; ++k) { const int piece = wid + 8 * k;
        const char* src = (const char*)P + ((row0 + piece * 4 + (lane >> 4)) * LDP + c0) * 2 + (lane & 15) * 16;
        glds16(src, (unsigned)__builtin_amdgcn_readfirstlane((int)(lds_addr(dst) + piece * 1024))); }
}
template <int NPIECES>
__device__ __forceinline__ void dma_lin(GL3 unsigned char* dst, const bf16_t* src, int wid, int lane) {
#pragma unroll
    for (int k = 0; k < NPIECES / 8; ++k) { const int piece = wid + 8 * k;
        glds16((const char*)src + piece * 1024 + lane * 16, (unsigned)__builtin_amdgcn_readfirstlane((int)(lds_addr(dst) + piece * 1024))); }
}

__device__ __forceinline__ float sum32(float v) {
    v += __builtin_bit_cast(float, __builtin_amdgcn_mov_dpp(__builtin_bit_cast(int, v), 0xB1, 0xF, 0xF, true));
    v += __builtin_bit_cast(float, __builtin_amdgcn_mov_dpp(__builtin_bit_cast(int, v), 0x4E, 0xF, 0xF, true));
    v += __builtin_bit_cast(float, __builtin_amdgcn_mov_dpp(__builtin_bit_cast(int, v), 0x141, 0xF, 0xF, true));
    v += __builtin_bit_cast(float, __builtin_amdgcn_mov_dpp(__builtin_bit_cast(int, v), 0x140, 0xF, 0xF, true));
    v += __shfl_xor(v, 16);
    return v;
}
#define GRAWBAR() do { asm volatile("s_waitcnt lgkmcnt(0)" ::: "memory"); __builtin_amdgcn_s_barrier(); asm volatile("" ::: "memory"); } while (0)
#define GWAITV0() asm volatile("s_waitcnt vmcnt(0)" ::: "memory")
constexpr int SL_GL = SL_RS + 1024;
__device__ __forceinline__ void scan_item(GL3 unsigned char* lds, bf16_t* P, const bf16_t* GW, const bf16_t* GQK, const float* GLv, const float* out_norm, int b, int h) {
    const int tid = threadIdx.x, lane = tid & 63, r32 = lane & 31, hi = lane >> 5; const int wid = __builtin_amdgcn_readfirstlane(tid >> 6);
    const int mt = wid >> 2, nt = wid & 3;
    const int dv = 32 * nt + r32;
    const int item0 = (b * DN_H + h) * 32; const size_t rowb = (size_t)b * SEQ;
    f32x16 S0 = f32x16{}, S1 = f32x16{};
    {
        const u32x4 z = {0u, 0u, 0u, 0u};
#pragma unroll
        for (int k = 0; k < 4; ++k) *(GL3 u32x4*)(lds + SL_S + (tid + 512 * k) * 16) = z;
        if (tid < 32) *(GL3 float*)(lds + SL_GL + tid * 4) = GLv[item0 + tid];
    }
    const float gain = out_norm[dv];
    GL3 float* RS = (GL3 float*)(lds + SL_RS);
#define ISSUE_A(n_) do { dma_lin<16>(lds + SL_W, GW + (size_t)(item0 + (n_)) * 8192, wid, lane); dma_seg(lds + SL_QD, P, rowb + 64 * (n_), C_DQ + h * 128, wid, lane); dma_seg(lds + SL_U, P, rowb + 64 * (n_), C_DV + h * 128, wid, lane); } while (0)
#define ISSUE_B(n_) do { dma_seg(lds + SL_KE, P, rowb + 64 * (n_), C_DK + h * 128, wid, lane); dma_lin<8>(lds + SL_QK, GQK + (size_t)(item0 + (n_)) * 4096, wid, lane); dma_seg(lds + SL_Z, P, rowb + 64 * (n_), C_DZ + h * 128, wid, lane); } while (0)
    GWAITV0();
    ISSUE_A(0);
    f32x16 oprev = f32x16{}; unsigned zprev[8] = {0u, 0u, 0u, 0u, 0u, 0u, 0u, 0u};
#define Y_OUT(n_) do { const size_t rowy = rowb + 64 * (n_); _Pragma("unroll") for (int i = 0; i < 16; ++i) { const int tok = 32 * mt + crow(i, hi); \
            const f32x4 rs = *(GL3 const f32x4*)(RS + tok * 4); \
            const float rstd = rsqrtf(((rs[0] + rs[1]) + (rs[2] + rs[3])) * (1.f / 128.f) + EPS); \
            const float z = (i & 1) ? bhi(zprev[i >> 1]) : blo(zprev[i >> 1]); \
            P[(rowy + tok) * LDP + C_DZ + h * 128 + dv] = f2bf(oprev[i] * rstd * gain * fsilu(z)); } } while (0)
    for (int n = 0; n < 32; ++n) {
        GWAITV0(); GRAWBAR();
        ISSUE_B(n);
        if (n > 0) Y_OUT(n - 1);
        const float gl = *(GL3 const float*)(lds + SL_GL + n * 4);
        f32x16 vp = f32x16{}, o = f32x16{};
#pragma unroll
        for (int s = 0; s < 8; ++s) {
            const bf16x8 sb = *(GL3 const bf16x8*)(lds + SL_S + ((2 * s + hi) * 128 + dv) * 16);
            const bf16x8 wa = *(GL3 const bf16x8*)(lds + SL_W + ((2 * s + hi) * 64 + 32 * mt + r32) * 16);
            const bf16x8 qa = *(GL3 const bf16x8*)(lds + SL_QD + ((2 * s + hi) * 64 + 32 * mt + r32) * 16);
            vp = __builtin_amdgcn_mfma_f32_32x32x16_bf16(wa, sb, vp, 0, 0, 0);
            o = __builtin_amdgcn_mfma_f32_32x32x16_bf16(qa, sb, o, 0, 0, 0);
        }
        {
            float v[16];
#pragma unroll
            for (int i = 0; i < 16; ++i) v[i] = bf2f(*(GL3 const bf16_t*)(lds + SL_U + ((32 * mt + crow(i, hi)) * 128 + dv) * 2)) - vp[i];
#pragma unroll
            for (int sp = 0; sp < 2; ++sp) *(GL3 bf16x8*)(lds + SL_VN + (((2 * mt + sp) * 128 + dv) * 16 + 8 * hi) * 2) = pack8(v + 8 * sp);
        }
        GWAITV0(); GRAWBAR();
        if (n + 1 < 32) ISSUE_A(n + 1);
#pragma unroll
        for (int i = 0; i < 16; i += 2) { const unsigned za = *(GL3 const bf16_t*)(lds + SL_Z + ((32 * mt + crow(i, hi)) * 128 + dv) * 2), zb = *(GL3 const bf16_t*)(lds + SL_Z + ((32 * mt + crow(i + 1, hi)) * 128 + dv) * 2); zprev[i >> 1] = za | (zb << 16); }
#pragma unroll
        for (int i = 0; i < 16; ++i) { S0[i] *= gl; S1[i] *= gl; }
        {
            GL3 const unsigned char* kp0 = lds + SL_KE + (2 * mt) * 4096 + ((lane >> 4) & 1) * 32 + (lane & 3) * 8 + (4 * hi + ((lane & 15) >> 2)) * 64;
#pragma unroll
            for (int ks = 0; ks < 4; ++ks) {
                const bf16x8 vb = *(GL3 const bf16x8*)(lds + SL_VN + ((ks * 128 + dv) * 16 + 8 * hi) * 2);
                const s16x4 l0 = vtr(kp0 + ks * 1024), h0 = vtr(kp0 + ks * 1024 + 512), l1 = vtr(kp0 + 4096 + ks * 1024), h1 = vtr(kp0 + 4096 + ks * 1024 + 512);
                const bf16x8 k0 = {l0[0], l0[1], l0[2], l0[3], h0[0], h0[1], h0[2], h0[3]}, k1 = {l1[0], l1[1], l1[2], l1[3], h1[0], h1[1], h1[2], h1[3]};
                const bf16x8 qa = *(GL3 const bf16x8*)(lds + SL_QK + ((ks * 64 + 32 * mt + r32) * 16 + 8 * hi) * 2);
                S0 = __builtin_amdgcn_mfma_f32_32x32x16_bf16(k0, vb, S0, 0, 0, 0);
                S1 = __builtin_amdgcn_mfma_f32_32x32x16_bf16(k1, vb, S1, 0, 0, 0);
                o = __builtin_amdgcn_mfma_f32_32x32x16_bf16(qa, vb, o, 0, 0, 0);
            }
        }
#pragma unroll
        for (int a = 0; a < 4; ++a) {
            u32x2 w0 = {pk(S0[4 * a], S0[4 * a + 1]), pk(S0[4 * a + 2], S0[4 * a + 3])}, w1 = {pk(S1[4 * a], S1[4 * a + 1]), pk(S1[4 * a + 2], S1[4 * a + 3])};
            *(GL3 u32x2*)(lds + SL_S + ((4 * (2 * mt) + a) * 128 + dv) * 16 + 8 * hi) = w0;
            *(GL3 u32x2*)(lds + SL_S + ((4 * (2 * mt + 1) + a) * 128 + dv) * 16 + 8 * hi) = w1;
        }
#pragma unroll
        for (int i = 0; i < 16; ++i) { const float q = sum32(o[i] * o[i]); if (r32 == 0) RS[(32 * mt + crow(i, hi)) * 4 + nt] = q; }
        oprev = o;
    }
    GWAITV0(); GRAWBAR();
    Y_OUT(31);
    GWAITV0();
    __syncthreads();
#undef Y_OUT
#undef ISSUE_A
#undef ISSUE_B
}
}
namespace nsa {
#define NLAS __attribute__((address_space(3)))
typedef short bf16x8 __attribute__((ext_vector_type(8)));
typedef short s16x4 __attribute__((ext_vector_type(4)));
typedef short v4i16_t __attribute__((ext_vector_type(4)));
typedef float f32x16 __attribute__((ext_vector_type(16)));
typedef float f32x4 __attribute__((ext_vector_type(4)));
typedef float f32x2 __attribute__((ext_vector_type(2)));
typedef unsigned u32x4 __attribute__((ext_vector_type(4)));
typedef __bf16 bf16x2_t __attribute__((ext_vector_type(2)));
constexpr float LOG2E = 1.4426950408889634f;
constexpr float NEG = -1e30f;
constexpr int L_KV = 0;
constexpr int L_IMP = 49152;
constexpr int L_SEL = 82944;
constexpr int L_WS = 83456;
constexpr int L_OST = 85504;
constexpr int L_END = 118272;

__device__ __forceinline__ int crow(int i, int hi) { return (i & 3) + 8 * (i >> 2) + 4 * hi; }
__device__ __forceinline__ unsigned pk(float lo, float hi) { f32x2 v = {lo, hi}; bf16x2_t b = __builtin_convertvector(v, bf16x2_t); return __builtin_bit_cast(unsigned, b); }
__device__ __forceinline__ float xhalf_max(float v) { auto rr = __builtin_amdgcn_permlane32_swap(__float_as_uint(v), __float_as_uint(v), false, false); return fmaxf(__uint_as_float(rr[0]), __uint_as_float(rr[1])); }
__device__ __forceinline__ float xhalf_sum(float v) { auto rr = __builtin_amdgcn_permlane32_swap(__float_as_uint(v), __float_as_uint(v), false, false); return __uint_as_float(rr[0]) + __uint_as_float(rr[1]); }

__device__ __forceinline__ void dma_tile(NLAS unsigned char* slot, const bf16_t* Kb, const bf16_t* Vb, unsigned koff, unsigned voff, int wid) {
    __builtin_amdgcn_global_load_lds((const unsigned*)((const char*)Kb + koff), (NLAS unsigned*)(slot + wid * 1024), 16, 0, 0);
    __builtin_amdgcn_global_load_lds((const unsigned*)((const char*)Vb + voff), (NLAS unsigned*)(slot + 8192 + wid * 1024), 16, 0, 0);
}
__device__ __forceinline__ void glds16(const void* gsrc, unsigned lds_dst) { unsigned keep;
    asm volatile("s_mov_b32 %0, m0\n\ts_mov_b32 m0, %2\n\ts_nop 0\n\tglobal_load_lds_dwordx4 %1, off\n\ts_mov_b32 m0, %0" : "=&s"(keep) : "v"(gsrc), "s"(lds_dst) : "memory"); }
__device__ __forceinline__ void dma_tile_a(NLAS unsigned char* slot, const bf16_t* Kb, const bf16_t* Vb, unsigned koff, unsigned voff, int wid) {
    const unsigned base = (unsigned)(size_t)slot + (unsigned)wid * 1024u;
    glds16((const char*)Kb + koff, (unsigned)__builtin_amdgcn_readfirstlane((int)base));
    glds16((const char*)Vb + voff, (unsigned)__builtin_amdgcn_readfirstlane((int)(base + 8192u)));
}
#define RING_WAIT_BAR(N) do { asm volatile("s_waitcnt vmcnt(" #N ") lgkmcnt(0)" ::: "memory"); __builtin_amdgcn_s_barrier(); asm volatile("" ::: "memory"); } while (0)
__device__ __forceinline__ void tile_offs(unsigned& koff, unsigned& voff, int pitch, int wid, int lane) {
    koff = (unsigned)(lane * pitch + wid * 8) * 2u;
    voff = (unsigned)((16 * (wid & 3) + (lane >> 2)) * pitch + (wid >> 2) * 32 + (lane & 3) * 8) * 2u;
}
__device__ __forceinline__ void qkt(f32x16& p0, f32x16& p1, NLAS const unsigned char* Kslot, const bf16x8* qr, const f32x16& c0, const f32x16& c1, int r32, int hi) {
    NLAS const unsigned char* kb = Kslot + hi * 1024 + r32 * 16;
#pragma unroll
    for (int d0 = 0; d0 < 4; ++d0) {
        const bf16x8 b0 = *(NLAS const bf16x8*)(kb + d0 * 2048);
        const bf16x8 b1 = *(NLAS const bf16x8*)(kb + d0 * 2048 + 512);
        if (d0 == 0) { p0 = __builtin_amdgcn_mfma_f32_32x32x16_bf16(b0, qr[0], c0, 0, 0, 0); p1 = __builtin_amdgcn_mfma_f32_32x32x16_bf16(b1, qr[0], c1, 0, 0, 0); }
        else { p0 = __builtin_amdgcn_mfma_f32_32x32x16_bf16(b0, qr[d0], p0, 0, 0, 0); p1 = __builtin_amdgcn_mfma_f32_32x32x16_bf16(b1, qr[d0], p1, 0, 0, 0); }
    }
}
__device__ __forceinline__ s16x4 vtr(NLAS const unsigned char* p) { return __builtin_bit_cast(s16x4, __builtin_amdgcn_ds_read_tr16_b64_v4i16((NLAS v4i16_t*)p)); }
__device__ __forceinline__ void pv(f32x16* o, NLAS const unsigned char* Vslot, const f32x16& p0, const f32x16& p1, int lane, int hi) {
    u32x4 w0 = {pk(p0[0], p0[1]), pk(p0[2], p0[3]), pk(p0[4], p0[5]), pk(p0[6], p0[7])};
    u32x4 w1 = {pk(p0[8], p0[9]), pk(p0[10], p0[11]), pk(p0[12], p0[13]), pk(p0[14], p0[15])};
    u32x4 w2 = {pk(p1[0], p1[1]), pk(p1[2], p1[3]), pk(p1[4], p1[5]), pk(p1[6], p1[7])};
    u32x4 w3 = {pk(p1[8], p1[9]), pk(p1[10], p1[11]), pk(p1[12], p1[13]), pk(p1[14], p1[15])};
    const bf16x8 pa[4] = {__builtin_bit_cast(bf16x8, w0), __builtin_bit_cast(bf16x8, w1), __builtin_bit_cast(bf16x8, w2), __builtin_bit_cast(bf16x8, w3)};
    NLAS const unsigned char* vp = Vslot + ((lane >> 4) & 1) * 32 + (lane & 3) * 8 + (4 * hi + ((lane & 15) >> 2)) * 64;
#pragma unroll
    for (int d0 = 0; d0 < 2; ++d0)
#pragma unroll
        for (int ks = 0; ks < 4; ++ks) {
            const s16x4 lo = vtr(vp + d0 * 4096 + ks * 1024), hh = vtr(vp + d0 * 4096 + ks * 1024 + 512);
            const bf16x8 vf = {lo[0], lo[1], lo[2], lo[3], hh[0], hh[1], hh[2], hh[3]};
            o[d0] = __builtin_amdgcn_mfma_f32_32x32x16_bf16(pa[ks], vf, o[d0], 0, 0, 0);
        }
}
__device__ __forceinline__ void scale_rows(f32x16* o, NLAS float* wsf, float s, int r32, int hi) {
    if (hi == 0) wsf[r32] = s;
#pragma unroll
    for (int i = 0; i < 16; ++i) { const float f = wsf[crow(i, hi)]; o[0][i] *= f; o[1][i] *= f; }
}
__device__ __forceinline__ void acc_rows(f32x16* tot, const f32x16* o, NLAS float* wsf, float s, int r32, int hi) {
    if (hi == 0) wsf[32 + r32] = s;
#pragma unroll
    for (int i = 0; i < 16; ++i) { const float f = wsf[32 + crow(i, hi)]; tot[0][i] += f * o[0][i]; tot[1][i] += f * o[1][i]; }
}
#define MX3(a, b, c) __builtin_fmaxf(__builtin_fmaxf((a), (b)), (c))
__device__ __forceinline__ void softmax_step(f32x16& p0, f32x16& p1, float& m, float& l, f32x16* o, NLAS float* wsf, int r32, int hi) {
    float ta = MX3(p0[0], p0[1], p1[0]), tb = MX3(p0[2], p0[3], p1[1]); ta = MX3(ta, p1[2], p1[3]);
#pragma unroll
    for (int r = 4; r < 16; r += 4) { ta = MX3(ta, p0[r], p0[r + 1]); tb = MX3(tb, p0[r + 2], p0[r + 3]); ta = MX3(ta, p1[r], p1[r + 1]); tb = MX3(tb, p1[r + 2], p1[r + 3]); }
    float t = xhalf_max(fmaxf(ta, tb));
    if (__any(t > 8.f)) {
        const float d = fmaxf(t, 0.f);
        m += d;
#pragma unroll
        for (int i = 0; i < 16; ++i) { p0[i] -= d; p1[i] -= d; }
        const float alpha = __builtin_amdgcn_exp2f(-d);
        l *= alpha;
        scale_rows(o, wsf, alpha, r32, hi);
    }
    float s = 0.f;
#pragma unroll
    for (int i = 0; i < 16; ++i) { p0[i] = __builtin_amdgcn_exp2f(p0[i]); p1[i] = __builtin_amdgcn_exp2f(p1[i]); s += p0[i] + p1[i]; }
    l += s;
}

__device__ __forceinline__ void attn_tile(NLAS unsigned char* lds, bf16_t* P, const bf16_t* KC, const bf16_t* VC, int b, int g, int qt) {
    int tid = threadIdx.x; asm volatile("" : "+v"(tid));
    const int lane = tid & 63, r32 = lane & 31, hi = lane >> 5; const int wid = __builtin_amdgcn_readfirstlane(tid >> 6);
    const int head = g * 4 + (wid >> 1), qh = wid & 1, t0 = qt * 64, qi = qh * 32 + r32, blk_t = qt;
    NLAS float* wsf = (NLAS float*)(lds + L_WS) + wid * 64;
    NLAS float* imp = (NLAS float*)(lds + L_IMP);
    NLAS unsigned* selm = (NLAS unsigned*)(lds + L_SEL);
    NLAS unsigned char* slot0 = lds + L_KV; NLAS unsigned char* slot1 = lds + L_KV + 16384;
    const size_t rowbase = (size_t)b * SEQ;
    bf16_t* qrow = P + (rowbase + t0 + qi) * LDP;
    const float sl2 = exp2f(-0.5f * (float)(head + 1)) * LOG2E;
    bf16x8 qr[4];
#pragma unroll
    for (int d0 = 0; d0 < 4; ++d0) qr[d0] = *(const bf16x8*)(qrow + C_NQ + head * 64 + d0 * 16 + hi * 8);
#define FSIG(x) __builtin_amdgcn_rcpf(1.f + __builtin_amdgcn_exp2f(-LOG2E * (x)))
    const float gate_c = FSIG(bf2f(qrow[C_SG + head * 3 + 0])), gate_s = FSIG(bf2f(qrow[C_SG + head * 3 + 1])), gate_w = FSIG(bf2f(qrow[C_SG + head * 3 + 2]));
#undef FSIG
    f32x16 tot[2]; tot[0] = f32x16{}; tot[1] = f32x16{};
    XSTAMP(30);
#define CRF(i) ((float)(((i) & 3) + 8 * ((i) >> 2)) + 4.f * (float)hiv)
#define OPAQUE_HI() int hiv = hi; asm volatile("" : "+v"(hiv))

    {
        const bf16_t* kcb = KC + ((size_t)(b * NS_G + g) * 128) * 64; const bf16_t* vcb = VC + ((size_t)(b * NS_G + g) * 128) * 64;
        const bool two = (qt >= 16);
        unsigned kof, vof; tile_offs(kof, vof, 64, wid, lane);
        dma_tile(slot0, kcb, vcb, kof, vof, wid);
        if (two) dma_tile(slot1, kcb + 64 * 64, vcb + 64 * 64, kof, vof, wid);
        __syncthreads();
        f32x16 pA0, pA1, pB0, pB1, c0, c1;
        const float s16 = sl2 * 16.f; OPAQUE_HI();
#pragma unroll
        for (int i = 0; i < 16; ++i) { c0[i] = s16 * CRF(i); c1[i] = s16 * (CRF(i) + 32.f); }
        qkt(pA0, pA1, slot0, qr, c0, c1, r32, hi);
        const int cmax = (t0 + qi - 31) >> 4;
        const int qposm = t0 + qi - 31;
#pragma unroll
        for (int i = 0; i < 16; ++i) { const int c = crow(i, hiv); if (16 * c > qposm) pA0[i] = NEG; if (16 * (c + 32) > qposm) pA1[i] = NEG; }
        if (two) {
#pragma unroll
            for (int i = 0; i < 16; ++i) { c0[i] += s16 * 64.f; c1[i] += s16 * 64.f; }
            qkt(pB0, pB1, slot1, qr, c0, c1, r32, hi);
#pragma unroll
            for (int i = 0; i < 16; ++i) { const int c = 64 + crow(i, hiv); if (16 * c > qposm) pB0[i] = NEG; if (16 * (c + 32) > qposm) pB1[i] = NEG; }
        } else { pB0 = f32x16{}; pB1 = f32x16{}; }
        (void)cmax;
        float mx = NEG;
#pragma unroll
        for (int i = 0; i < 16; ++i) mx = fmaxf(mx, fmaxf(pA0[i], pA1[i]));
        if (two) {
#pragma unroll
            for (int i = 0; i < 16; ++i) mx = fmaxf(mx, fmaxf(pB0[i], pB1[i])); }
        mx = xhalf_max(mx);
        float s = 0.f;
#pragma unroll
        for (int i = 0; i < 16; ++i) { pA0[i] = __builtin_amdgcn_exp2f(pA0[i] - mx); pA1[i] = __builtin_amdgcn_exp2f(pA1[i] - mx); s += pA0[i] + pA1[i]; }
        if (two) {
#pragma unroll
            for (int i = 0; i < 16; ++i) { pB0[i] = __builtin_amdgcn_exp2f(pB0[i] - mx); pB1[i] = __builtin_amdgcn_exp2f(pB1[i] - mx); s += pB0[i] + pB1[i]; } }
        s = xhalf_sum(s);
        const float nrm = (t0 + qi >= 31) ? __builtin_amdgcn_rcpf(s) : 0.f;
#pragma unroll
        for (int i = 0; i < 16; ++i) { pA0[i] *= nrm; pA1[i] *= nrm; }
        if (two) {
#pragma unroll
            for (int i = 0; i < 16; ++i) { pB0[i] *= nrm; pB1[i] *= nrm; } }
#define PSEL(L) ((L) < 4 ? pA0 : (L) < 8 ? pA1 : (L) < 12 ? pB0 : pB1)
#define MAINV(L) ((PSEL(L)[4 * ((L) & 3)] + PSEL(L)[4 * ((L) & 3) + 1]) + (PSEL(L)[4 * ((L) & 3) + 2] + 0.5f * PSEL(L)[4 * ((L) & 3) + 3]))
#define CARRY(L) (0.5f * PSEL(L)[4 * ((L) & 3) + 3])
#pragma unroll
        for (int L = 0; L < 16; ++L) {
            const float cprev = (L > 0) ? CARRY(L > 0 ? L - 1 : 0) : 0.f;
            const float snd = hi ? cprev : CARRY(L);
            const float rcv = __shfl_xor(snd, 32);
            imp[((wid >> 1) * 64 + qi) * 33 + 2 * L + hi] = MAINV(L) + rcv;
        }
#undef PSEL
#undef MAINV
#undef CARRY
        f32x16 o[2]; o[0] = f32x16{}; o[1] = f32x16{};
        pv(o, slot0 + 8192, pA0, pA1, lane, hi);
        if (two) pv(o, slot1 + 8192, pB0, pB1, lane, hi);
        acc_rows(tot, o, wsf, gate_c, r32, hi);
    }
    __syncthreads();
    XSTAMP(31);
    {
        const int ql = 8 * wid + (lane >> 3), sub = lane & 7;
        float v[4];
#pragma unroll
        for (int e = 0; e < 4; ++e) { const int j = 4 * sub + e; v[e] = (imp[(0 * 64 + ql) * 33 + j] + imp[(1 * 64 + ql) * 33 + j]) + (imp[(2 * 64 + ql) * 33 + j] + imp[(3 * 64 + ql) * 33 + j]);
            if (j < 1 || j >= blk_t) v[e] = -1.f; }
        unsigned mask = 1u | (1u << blk_t);
#pragma unroll 1
        for (int it = 0; it < 6; ++it) {
            float bv = fmaxf(fmaxf(v[0], v[1]), fmaxf(v[2], v[3]));
            bv = fmaxf(bv, __builtin_bit_cast(float, __builtin_amdgcn_mov_dpp(__builtin_bit_cast(int, bv), 0xB1, 0xF, 0xF, true)));
            bv = fmaxf(bv, __builtin_bit_cast(float, __builtin_amdgcn_mov_dpp(__builtin_bit_cast(int, bv), 0x4E, 0xF, 0xF, true)));
            bv = fmaxf(bv, __builtin_bit_cast(float, __builtin_amdgcn_mov_dpp(__builtin_bit_cast(int, bv), 0x141, 0xF, 0xF, true)));
            int bj = (v[3] == bv) ? 4 * sub + 3 : 64; bj = (v[2] == bv) ? 4 * sub + 2 : bj; bj = (v[1] == bv) ? 4 * sub + 1 : bj; bj = (v[0] == bv) ? 4 * sub : bj;
            bj = min(bj, __builtin_amdgcn_mov_dpp(bj, 0xB1, 0xF, 0xF, true));
            bj = min(bj, __builtin_amdgcn_mov_dpp(bj, 0x4E, 0xF, 0xF, true));
            bj = min(bj, __builtin_amdgcn_mov_dpp(bj, 0x141, 0xF, 0xF, true));
            if (bv >= 0.f) { mask |= 1u << bj;
#pragma unroll
                for (int e = 0; e < 4; ++e) if (4 * sub + e == bj) v[e] = -1.f; }
        }
        if (sub == 0) selm[ql] = mask;
        unsigned any = mask;
        any |= __shfl_xor(any, 8); any |= __shfl_xor(any, 16); any |= __shfl_xor(any, 32);
        if (lane == 0) selm[64 + wid] = any;
    }
    __syncthreads();
    XSTAMP(32);
    const unsigned mymask = selm[qi];
    const unsigned anym = (unsigned)__builtin_amdgcn_readfirstlane((int)((selm[64] | selm[65]) | (selm[66] | selm[67]) | (selm[68] | selm[69]) | (selm[70] | selm[71])));
    unsigned kofP, vofP; tile_offs(kofP, vofP, LDP, wid, lane);
    {
        const bf16_t* kb = P + rowbase * LDP + C_KS + g * 64; const bf16_t* vb = P + rowbase * LDP + C_VS + g * 64;
        unsigned todo = anym;
        float m = 0.f, l = 0.f; f32x16 o[2]; o[0] = f32x16{}; o[1] = f32x16{};
        int j0 = __builtin_ctz(todo); todo &= todo - 1;
        int j1 = todo ? __builtin_ctz(todo) : -1; if (todo) todo &= todo - 1;
        dma_tile_a(lds + L_KV, kb + (size_t)j0 * 64 * LDP, vb + (size_t)j0 * 64 * LDP, kofP, vofP, wid);
        if (j1 >= 0) { dma_tile_a(lds + L_KV + 16384, kb + (size_t)j1 * 64 * LDP, vb + (size_t)j1 * 64 * LDP, kofP, vofP, wid); RING_WAIT_BAR(2); } else RING_WAIT_BAR(0);
        int sl = 0;
#if defined(TPROBE)
        unsigned long long tq_ = 0, ts_ = 0, tp_ = 0, tw_ = 0, tn_ = 0, tc_;
#define TACC(v) do { const unsigned long long now_ = __builtin_amdgcn_s_memrealtime(); v += now_ - tc_; tc_ = now_; } while (0)
        tc_ = __builtin_amdgcn_s_memrealtime();
#else
#define TACC(v) do { } while (0)
#endif
        for (;;) {
            const int j2 = todo ? __builtin_ctz(todo) : -1; if (todo) todo &= todo - 1;
            const int sl2i = (sl >= 1) ? sl - 1 : 2;
            if (j2 >= 0) dma_tile_a(lds + L_KV + sl2i * 16384, kb + (size_t)j2 * 64 * LDP, vb + (size_t)j2 * 64 * LDP, kofP, vofP, wid);
            NLAS unsigned char* sc = lds + L_KV + sl * 16384;
            const int j = j0;
            const bool mine = (mymask >> j) & 1u;
            const bool far = sl2 * (float)(t0 - 64 * j - 63) > 200.f;
            if (__any(mine) && !far) {
                f32x16 p0, p1, c0, c1; const float kb0 = sl2 * (float)(j * 64 - t0) - m; OPAQUE_HI();
#pragma unroll
                for (int i = 0; i < 16; ++i) { c0[i] = kb0 + sl2 * CRF(i); c1[i] = c0[i] + sl2 * 32.f; }
                qkt(p0, p1, sc, qr, c0, c1, r32, hi);
                asm volatile("s_nop 7\n\ts_nop 7" : "+v"(p0), "+v"(p1)); TACC(tq_);
                if (j == blk_t) {
                    asm volatile("" ::: "memory");
#pragma unroll
                    for (int i = 0; i < 16; ++i) { const int kk = crow(i, hiv); if (kk > qi) p0[i] = NEG; if (kk + 32 > qi) p1[i] = NEG; }
                }
                if (__any(!mine)) {
                    asm volatile("" ::: "memory");
                    if (!mine) {
#pragma unroll
                        for (int i = 0; i < 16; ++i) { p0[i] = NEG; p1[i] = NEG; } }
                }
                softmax_step(p0, p1, m, l, o, wsf, r32, hi);
                asm volatile("" : "+v"(p0), "+v"(p1)); TACC(ts_);
                pv(o, sc + 8192, p0, p1, lane, hi);
                asm volatile("s_nop 7\n\ts_nop 7" : "+v"(o[0]), "+v"(o[1])); TACC(tp_);
            }
#if defined(TPROBE)
            tn_ += 100;
#endif
            if (j1 < 0) break;
            if (j2 >= 0) RING_WAIT_BAR(2); else RING_WAIT_BAR(0);
            TACC(tw_);
            j0 = j1; j1 = j2; sl = (sl == 2) ? 0 : sl + 1;
        }
        RING_WAIT_BAR(0);
#if defined(TPROBE)
        if (b == 0 && g == 3 && qt == 24 && threadIdx.x == 0) { volatile unsigned long long* t_ = (volatile unsigned long long*)((char*)P + (size_t)16384 * LDP * 2 + 2048); t_[0] = 0; t_[1] = tq_; t_[2] = ts_; t_[3] = tp_; t_[4] = tw_; t_[5] = tn_; }
#endif
        l = xhalf_sum(l);
        acc_rows(tot, o, wsf, gate_s * __builtin_amdgcn_rcpf(l), r32, hi);
    }
    XSTAMP(33);
    {
        const bf16_t* kb = P + rowbase * LDP + C_KW + g * 64; const bf16_t* vb = P + rowbase * LDP + C_VW + g * 64;
        float m = 0.f, l = 0.f; f32x16 o[2]; o[0] = f32x16{}; o[1] = f32x16{};
        const int jlast = blk_t >= 4 ? blk_t - 4 : 0;
        int j0 = blk_t, j1 = (j0 > jlast) ? j0 - 1 : -1;
        dma_tile_a(lds + L_KV, kb + (size_t)j0 * 64 * LDP, vb + (size_t)j0 * 64 * LDP, kofP, vofP, wid);
        if (j1 >= 0) { dma_tile_a(lds + L_KV + 16384, kb + (size_t)j1 * 64 * LDP, vb + (size_t)j1 * 64 * LDP, kofP, vofP, wid); RING_WAIT_BAR(2); } else RING_WAIT_BAR(0);
        int sl = 0;
        for (;;) {
            const int j2 = (j1 > jlast) ? j1 - 1 : -1;
            const int sl2i = (sl >= 1) ? sl - 1 : 2;
            if (j2 >= 0) dma_tile_a(lds + L_KV + sl2i * 16384, kb + (size_t)j2 * 64 * LDP, vb + (size_t)j2 * 64 * LDP, kofP, vofP, wid);
            NLAS unsigned char* sc = lds + L_KV + sl * 16384;
            const int j = j0;
            {
                f32x16 p0, p1, c0, c1; const float kb0 = sl2 * (float)(j * 64 - t0) - m; OPAQUE_HI();
#pragma unroll
                for (int i = 0; i < 16; ++i) { c0[i] = kb0 + sl2 * CRF(i); c1[i] = c0[i] + sl2 * 32.f; }
                qkt(p0, p1, sc, qr, c0, c1, r32, hi);
                if (j == blk_t || j == blk_t - 4) {
                    asm volatile("" ::: "memory");
                    const int dq = t0 + qi - j * 64;
#pragma unroll
                    for (int i = 0; i < 16; ++i) { const int d0_ = dq - crow(i, hiv), d1_ = d0_ - 32; if (d0_ < 0 || d0_ > 255) p0[i] = NEG; if (d1_ < 0 || d1_ > 255) p1[i] = NEG; }
                }
                softmax_step(p0, p1, m, l, o, wsf, r32, hi);
                pv(o, sc + 8192, p0, p1, lane, hi);
            }
            if (j1 < 0) break;
            if (j2 >= 0) RING_WAIT_BAR(2); else RING_WAIT_BAR(0);
            j0 = j1; j1 = j2; sl = (sl == 2) ? 0 : sl + 1;
        }
        RING_WAIT_BAR(0);
        l = xhalf_sum(l);
        acc_rows(tot, o, wsf, gate_w * __builtin_amdgcn_rcpf(l), r32, hi);
    }
    XSTAMP(34);
    {
        NLAS bf16_t* stg = (NLAS bf16_t*)(lds + L_OST) + wid * 2048;
#pragma unroll
        for (int i = 0; i < 16; ++i) { const int orow = crow(i, hi); stg[orow * 64 + r32] = f2bf(tot[0][i]); stg[orow * 64 + 32 + r32] = f2bf(tot[1][i]); }
        bf16_t* ow = P + (rowbase + t0 + qh * 32) * LDP + C_NQ + head * 64;
#pragma unroll
        for (int i = 0; i < 4; ++i) { const int row = i * 8 + (lane >> 3), ch = lane & 7; const u32x4 v = *(NLAS const u32x4*)(stg + row * 64 + ch * 8); *(u32x4*)((char*)ow + (unsigned)(row * LDP + ch * 8) * 2u) = v; }
    }
    __syncthreads();
    XSTAMP(35);
#if defined(TPROBE)
    if (blockIdx.x == 0 && threadIdx.x == 0) { volatile __attribute__((address_space(3))) unsigned long long* ts_ = (volatile __attribute__((address_space(3))) unsigned long long*)(lds + 147456 - 512); ts_[36] = ts_[30] + 100ull * (unsigned)qt; }
#endif
#undef CRF
#undef OPAQUE_HI
}

__device__ __forceinline__ void norm8(u32x4& v, const float* g8, float sc) {
    float x[8] = {__uint_as_float(v.x << 16), __uint_as_float(v.x & 0xffff0000u), __uint_as_float(v.y << 16), __uint_as_float(v.y & 0xffff0000u),
                  __uint_as_float(v.z << 16), __uint_as_float(v.z & 0xffff0000u), __uint_as_float(v.w << 16), __uint_as_float(v.w & 0xffff0000u)};
    float s = 0.f;
#pragma unroll
    for (int e = 0; e < 8; ++e) s += x[e] * x[e];
    s += __shfl_xor(s, 1); s += __shfl_xor(s, 2); s += __shfl_xor(s, 4);
    const float r = rsqrtf(s * (1.f / 64.f) + EPS) * sc;
    v.x = pk(x[0] * r * g8[0], x[1] * r * g8[1]); v.y = pk(x[2] * r * g8[2], x[3] * r * g8[3]); v.z = pk(x[4] * r * g8[4], x[5] * r * g8[5]); v.w = pk(x[6] * r * g8[6], x[7] * r * g8[7]);
}
__device__ __forceinline__ void prep_units(bf16_t* P, const float* qn, const float* kns, const float* knw, int gw, int NGW, int lane) {
    float gq[8], gk[8];
    const float* kg = (lane < 32) ? kns : knw;
#pragma unroll
    for (int e = 0; e < 8; ++e) { gq[e] = qn[8 * (lane & 7) + e]; gk[e] = kg[8 * (lane & 7) + e]; }
    const int coff = (lane < 32) ? C_KS + 8 * lane : C_KW + 8 * (lane - 32);
    for (int m0 = gw; m0 < M; m0 += 2 * NGW) {
        const int m1 = m0 + NGW; const bool two = m1 < M;
        bf16_t* r0 = P + (size_t)m0 * LDP; bf16_t* r1 = P + (size_t)(two ? m1 : m0) * LDP;
        u32x4 a0 = *(const u32x4*)(r0 + C_NQ + 8 * lane), b0 = *(const u32x4*)(r0 + C_NQ + 512 + 8 * lane), c0 = *(const u32x4*)(r0 + coff);
        u32x4 a1 = *(const u32x4*)(r1 + C_NQ + 8 * lane), b1 = *(const u32x4*)(r1 + C_NQ + 512 + 8 * lane), c1 = *(const u32x4*)(r1 + coff);
        norm8(a0, gq, 0.125f * LOG2E); norm8(b0, gq, 0.125f * LOG2E); norm8(c0, gk, 1.f);
        norm8(a1, gq, 0.125f * LOG2E); norm8(b1, gq, 0.125f * LOG2E); norm8(c1, gk, 1.f);
        *(u32x4*)(r0 + C_NQ + 8 * lane) = a0; *(u32x4*)(r0 + C_NQ + 512 + 8 * lane) = b0; *(u32x4*)(r0 + coff) = c0;
        if (two) { *(u32x4*)(r1 + C_NQ + 8 * lane) = a1; *(u32x4*)(r1 + C_NQ + 512 + 8 * lane) = b1; *(u32x4*)(r1 + coff) = c1; }
    }
}

constexpr int LC_A = 0, LC_B = 16384, LC_HID = 49152, LC_W2 = 83968;
__device__ __forceinline__ void compress_item(NLAS unsigned char* lds, const bf16_t* P, const bf16_t* W1T, const float* bias1, const float* W2, const float* gain, bf16_t* OUT, int b, int g, int which, int half) {
    const int tid = threadIdx.x, lane = tid & 63, r32 = lane & 31, hi = lane >> 5; const int wid = __builtin_amdgcn_readfirstlane(tid >> 6);
    const int mt = wid >> 2, nt = wid & 3;
    const int ca = tid >> 3, dca = tid & 7; const int cg_ = 64 * half + ca; const int ccl = cg_ < NCMP ? cg_ : NCMP - 1;
    const bf16_t* asrc = P + ((size_t)b * SEQ + 16 * ccl) * LDP + (which ? C_VC : C_KC) + g * 64 + dca * 8;
    const bf16_t* bsrc0 = W1T + (size_t)(tid >> 3) * 2048 + (tid & 7) * 8; const bf16_t* bsrc1 = bsrc0 + (size_t)64 * 2048;
    const int adst = (dca * 64 + ca) * 16, bdst0 = ((tid & 7) * 128 + (tid >> 3)) * 16, bdst1 = bdst0 + 64 * 16;
#define CBAR() do { asm volatile("s_waitcnt lgkmcnt(0)" ::: "memory"); __builtin_amdgcn_s_barrier(); asm volatile("" ::: "memory"); } while (0)
#define CLOAD(ra_, rb0_, rb1_, l_) do { ra_ = *(const u32x4*)(asrc + (size_t)(l_) * LDP); rb0_ = *(const u32x4*)(bsrc0 + (l_) * 64); rb1_ = *(const u32x4*)(bsrc1 + (l_) * 64); } while (0)
#define CSTORE(ra_, rb0_, rb1_, buf_) do { *(NLAS u32x4*)(lds + LC_A + (buf_) * 8192 + adst) = ra_; *(NLAS u32x4*)(lds + LC_B + (buf_) * 16384 + bdst0) = rb0_; *(NLAS u32x4*)(lds + LC_B + (buf_) * 16384 + bdst1) = rb1_; } while (0)
#define CMMA(buf_) do { NLAS const unsigned char* ab = lds + LC_A + (buf_) * 8192; NLAS const unsigned char* bb = lds + LC_B + (buf_) * 16384; \
        _Pragma("unroll") for (int ds = 0; ds < 4; ++ds) { \
            const bf16x8 a = *(NLAS const bf16x8*)(ab + ((2 * ds + hi) * 64 + 32 * mt + r32) * 16); \
            const bf16x8 w = *(NLAS const bf16x8*)(bb + ((2 * ds + hi) * 128 + 32 * nt + r32) * 16); \
            acc = __builtin_amdgcn_mfma_f32_32x32x16_bf16(a, w, acc, 0, 0, 0); } } while (0)
    {
#pragma unroll
        for (int k = 0; k < 4; ++k) *(NLAS f32x4*)(lds + LC_W2 + (tid + 512 * k) * 16) = *(const f32x4*)(W2 + (tid + 512 * k) * 4);
    }
    u32x4 xa, xb0, xb1, ya, yb0, yb1;
    CLOAD(xa, xb0, xb1, 0); CSTORE(xa, xb0, xb1, 0);
    CLOAD(xa, xb0, xb1, 1); CLOAD(ya, yb0, yb1, 2);
    CBAR();
    f32x16 acc = f32x16{};
    for (int l = 0; l < 32; l += 2) {
        CMMA(0); CSTORE(xa, xb0, xb1, 1); if (l + 3 < 32) CLOAD(xa, xb0, xb1, l + 3); CBAR();
        CMMA(1); if (l + 2 < 32) { CSTORE(ya, yb0, yb1, 0); if (l + 4 < 32) CLOAD(ya, yb0, yb1, l + 4); } CBAR();
    }
#undef CBAR
#undef CLOAD
#undef CSTORE
#undef CMMA
    NLAS float* hid = (NLAS float*)(lds + LC_HID);
    const float bs = bias1[32 * nt + r32];
#pragma unroll
    for (int i = 0; i < 16; ++i) hid[(32 * mt + crow(i, hi)) * 132 + 32 * nt + r32] = gelu_tanh(acc[i] + bs);
    __syncthreads();
    {
        const int row = tid >> 3, e0 = (tid & 7) * 8;
        float o[8];
#pragma unroll
        for (int e = 0; e < 8; ++e) o[e] = 0.f;
#pragma unroll 8
        for (int i = 0; i < 128; ++i) { const float h = hid[row * 132 + i]; const f32x4 wa = *(NLAS const f32x4*)(lds + LC_W2 + (i * 64 + e0) * 4), wb = *(NLAS const f32x4*)(lds + LC_W2 + (i * 64 + e0 + 4) * 4);
            o[0] += h * wa[0]; o[1] += h * wa[1]; o[2] += h * wa[2]; o[3] += h * wa[3]; o[4] += h * wb[0]; o[5] += h * wb[1]; o[6] += h * wb[2]; o[7] += h * wb[3]; }
        if (which == 0) {
            float ss = 0.f;
#pragma unroll
            for (int e = 0; e < 8; ++e) ss += o[e] * o[e];
            ss += __shfl_xor(ss, 1); ss += __shfl_xor(ss, 2); ss += __shfl_xor(ss, 4);
            const float r = rsqrtf(ss * (1.f / 64.f) + EPS);
#pragma unroll
            for (int e = 0; e < 8; ++e) o[e] *= r * gain[e0 + e];
        }
        const int cg = 64 * half + row;
        if (cg >= NCMP) {
#pragma unroll
            for (int e = 0; e < 8; ++e) o[e] = 0.f; }
        u32x4 w; w.x = pk(o[0], o[1]); w.y = pk(o[2], o[3]); w.z = pk(o[4], o[5]); w.w = pk(o[6], o[7]);
        *(u32x4*)(OUT + (((size_t)(b * NS_G + g) * 128) + cg) * 64 + e0) = w;
    }
    __syncthreads();
}
}
namespace pg8 {
#define PG8_LAS __attribute__((address_space(3)))
typedef short bf16x8 __attribute__((ext_vector_type(8)));
typedef float f32x4 __attribute__((ext_vector_type(4)));
typedef float f32x2 __attribute__((ext_vector_type(2)));
typedef unsigned u32x4 __attribute__((ext_vector_type(4)));
typedef unsigned u32x2 __attribute__((ext_vector_type(2)));
constexpr int BM = 256, BK = 64, HALF = 128, HTB = HALF * BK * 2, STAGE_BYTES = 8 * HTB, NXCD = 8, WGM = 8;

__host__ __device__ __forceinline__ int lds_byte(int r, int c) { const int st = (r >> 4) * 2 + (c >> 5), rr = r & 15, cc = c & 31, ob = rr * 64 + cc * 2; return st * 1024 + (ob ^ (((ob >> 9) & 1) << 5)); }
__host__ __device__ __forceinline__ void stage_rc(int b, int& R, int& C) { const int st = b / 1024, sb = b % 1024, swz = sb ^ (((sb >> 9) & 1) << 5); R = (st >> 1) * 16 + swz / 64; C = (st & 1) * 32 + (swz % 64) / 2; }
__host__ __device__ __forceinline__ int perm32(int rho) { const int n = rho >> 4, i = rho & 15; return 8 * (i >> 2) + 4 * n + (i & 3); }

struct Unit { int pm, pn, ks; };
struct Gemm { const bf16_t* A; const bf16_t* Bt; int lda, ldb; int M, N, K; int ksoff; };

struct StaticOrder {
    int nM, nN, nwg, G, c;
    __host__ __device__ void init(int M_, int N_, int G_, int c_) { nM = M_ / BM; nN = N_ / BM; nwg = nM * nN; G = G_; c = c_; }
    __host__ __device__ bool next(int i, Unit& u) const {
        const long L = (long)i * G + c; if (L >= nwg) return false;
        int wgid = (int)L; { const int q = nwg / NXCD, r = nwg % NXCD, xcd = wgid % NXCD, off = wgid / NXCD; wgid = (xcd < r ? xcd * (q + 1) : r * (q + 1) + (xcd - r) * q) + off; }
        const int nig = WGM * nN, gid = wgid / nig, fm = gid * WGM, gsz = (nM - fm) < WGM ? (nM - fm) : WGM;
        u.pm = fm + ((wgid % nig) % gsz); u.pn = (wgid % nig) / gsz; u.ks = 0; return true;
    }
};
struct TwoPassOrder {
    StaticOrder base;
    __host__ __device__ bool next(int i, Unit& u) const { if (!base.next(i >> 1, u)) return false; u.ks = i & 1; return true; }
};

typedef __bf16 bf16x2_t __attribute__((ext_vector_type(2)));
__device__ __forceinline__ unsigned cvt_pk_bf16(float lo, float hi) { f32x2 v = {lo, hi}; bf16x2_t b = __builtin_convertvector(v, bf16x2_t); return __builtin_bit_cast(unsigned, b); }
__device__ __forceinline__ float fast_sigmoid(float x) { return __builtin_amdgcn_rcpf(1.f + __builtin_amdgcn_exp2f(-1.4426950408889634f * x)); }
__device__ __forceinline__ float bflo(unsigned w) { return __uint_as_float(w << 16); }
__device__ __forceinline__ float bfhi(unsigned w) { return __uint_as_float(w & 0xffff0000u); }

typedef f32x4 Acc[2][2][4][2];

template <int ACT> struct EpiP {
    static constexpr bool PERM = true;
    bf16_t* O; int ldc; int pn_last; int ncol_last; bf16_t* halo;
    __device__ __forceinline__ void operator()(const Acc& acc, const Unit& u, int wr, int wc, int fr, int fq) const {
        const int row0 = u.pm * BM + wr * 64 + fr, tcol = wc * 32 + 8 * fq;
        const int lim = (u.pn == pn_last) ? ncol_last : 256;
#pragma unroll
        for (int ai = 0; ai < 2; ++ai)
#pragma unroll
            for (int m = 0; m < 4; ++m) { bf16_t* rowp = O + (size_t)(row0 + ai * HALF + m * 16) * ldc + u.pn * BM + tcol;
#pragma unroll
                for (int bj = 0; bj < 2; ++bj) { if (tcol + bj * HALF >= lim) continue;
                    f32x4 v0 = acc[ai][bj][m][0], v1 = acc[ai][bj][m][1];
                    if (ACT == 1) {
#pragma unroll
                        for (int e = 0; e < 4; ++e) { v0[e] = fast_sigmoid(v0[e]); v1[e] = fast_sigmoid(v1[e]); } }
                    u32x4 w; w.x = cvt_pk_bf16(v0[0], v0[1]); w.y = cvt_pk_bf16(v0[2], v0[3]); w.z = cvt_pk_bf16(v1[0], v1[1]); w.w = cvt_pk_bf16(v1[2], v1[3]);
                    *(u32x4*)(rowp + bj * HALF) = w;
                    if (ACT == 0 && m == 3 && fr >= 13 && u.pn < 12 && halo) { const int row = row0 + ai * HALF + 48;
                        *(u32x4*)(halo + ((size_t)(row >> 6) * 3 + (fr - 13)) * 3072 + u.pn * BM + tcol + bj * HALF) = w; } } }
    }
};
struct EpiMix {
    static constexpr bool PERM = true;
    const bf16_t* G; int ldg; bf16_t* O; int ldc;
    __device__ __forceinline__ void operator()(const Acc& acc, const Unit& u, int wr, int wc, int fr, int fq) const {
        const int row0 = u.pm * BM + wr * 64 + fr, col0 = u.pn * BM + wc * 32 + 8 * fq;
#pragma unroll
        for (int ai = 0; ai < 2; ++ai)
#pragma unroll
            for (int m = 0; m < 4; ++m) { const size_t row = (size_t)(row0 + ai * HALF + m * 16); const bf16_t* gp = G + row * ldg + col0 + u.ks * 1024; bf16_t* rowp = O + row * ldc + col0;
#pragma unroll
                for (int bj = 0; bj < 2; ++bj) { const u32x4 b = *(const u32x4*)(gp + bj * HALF);
                    f32x4 v0 = acc[ai][bj][m][0], v1 = acc[ai][bj][m][1];
                    v0[0] *= bflo(b.x); v0[1] *= bfhi(b.x); v0[2] *= bflo(b.y); v0[3] *= bfhi(b.y); v1[0] *= bflo(b.z); v1[1] *= bfhi(b.z); v1[2] *= bflo(b.w); v1[3] *= bfhi(b.w);
                    if (u.ks) { const u32x4 p = *(const u32x4*)(rowp + bj * HALF);
                        v0[0] += bflo(p.x); v0[1] += bfhi(p.x); v0[2] += bflo(p.y); v0[3] += bfhi(p.y); v1[0] += bflo(p.z); v1[1] += bfhi(p.z); v1[2] += bflo(p.w); v1[3] += bfhi(p.w); }
                    u32x4 w; w.x = cvt_pk_bf16(v0[0], v0[1]); w.y = cvt_pk_bf16(v0[2], v0[3]); w.z = cvt_pk_bf16(v1[0], v1[1]); w.w = cvt_pk_bf16(v1[2], v1[3]);
                    *(u32x4*)(rowp + bj * HALF) = w; } }
    }
};
struct EpiOut {
    static constexpr bool PERM = false;
    const float* X; float* X1; bf16_t* An; const float* gain; float* pss;
    __device__ __forceinline__ void operator()(const Acc& acc, const Unit& u, int wr, int wc, int fr, int fq) const {
        const int row0 = u.pm * BM + wr * 64 + fr, col0 = u.pn * BM + wc * 32 + 4 * fq;
        f32x4 gv[2][2];
#pragma unroll
        for (int bj = 0; bj < 2; ++bj)
#pragma unroll
            for (int n = 0; n < 2; ++n) gv[bj][n] = *(const f32x4*)(gain + col0 + bj * HALF + n * 16);
#pragma unroll
        for (int ai = 0; ai < 2; ++ai)
#pragma unroll
            for (int m = 0; m < 4; ++m) { const size_t row = (size_t)(row0 + ai * HALF + m * 16); const size_t off = row * D + col0; float ss = 0.f;
#pragma unroll
                for (int bj = 0; bj < 2; ++bj)
#pragma unroll
                    for (int n = 0; n < 2; ++n) { const f32x4 x1 = *(const f32x4*)(X + off + bj * HALF + n * 16) + acc[ai][bj][m][n];
                        *(f32x4*)(X1 + off + bj * HALF + n * 16) = x1; ss += (x1[0] * x1[0] + x1[1] * x1[1]) + (x1[2] * x1[2] + x1[3] * x1[3]);
                        const f32x4 y = x1 * gv[bj][n]; u32x2 w; w.x = cvt_pk_bf16(y[0], y[1]); w.y = cvt_pk_bf16(y[2], y[3]); *(u32x2*)(An + off + bj * HALF + n * 16) = w; }
                ss += __shfl_xor(ss, 16); ss += __shfl_xor(ss, 32);
                if (fq == 0) pss[row * 16 + u.pn * 4 + wc] = ss; }
    }
};
struct EpiUp {
    static constexpr bool PERM = true;
    const float* pss; bf16_t* O; int ldc;
    __device__ __forceinline__ void operator()(const Acc& acc, const Unit& u, int wr, int wc, int fr, int fq) const {
        const int row0 = u.pm * BM + wr * 64 + fr, col0 = u.pn * BM + wc * 32 + 8 * fq;
#pragma unroll
        for (int ai = 0; ai < 2; ++ai)
#pragma unroll
            for (int m = 0; m < 4; ++m) { const size_t row = (size_t)(row0 + ai * HALF + m * 16);
                const f32x4* pp = (const f32x4*)(pss + row * 16); const f32x4 s4 = (pp[0] + pp[1]) + (pp[2] + pp[3]);
                const float rstd = rsqrtf(((s4[0] + s4[1]) + (s4[2] + s4[3])) * (1.f / D) + EPS);
                bf16_t* rowp = O + row * ldc + col0;
#pragma unroll
                for (int bj = 0; bj < 2; ++bj) { f32x4 v0 = acc[ai][bj][m][0] * rstd, v1 = acc[ai][bj][m][1] * rstd;
#pragma unroll
                    for (int e = 0; e < 4; ++e) { const float a = fmaxf(v0[e], 0.f), b = fmaxf(v1[e], 0.f); v0[e] = a * a; v1[e] = b * b; }
                    u32x4 w; w.x = cvt_pk_bf16(v0[0], v0[1]); w.y = cvt_pk_bf16(v0[2], v0[3]); w.z = cvt_pk_bf16(v1[0], v1[1]); w.w = cvt_pk_bf16(v1[2], v1[3]);
                    *(u32x4*)(rowp + bj * HALF) = w; } }
    }
};
struct EpiDown {
    static constexpr bool PERM = false;
    float* X1;
    __device__ __forceinline__ void operator()(const Acc& acc, const Unit& u, int wr, int wc, int fr, int fq) const {
        const int row0 = u.pm * BM + wr * 64 + fr, col0 = u.pn * BM + wc * 32 + 4 * fq;
#pragma unroll
        for (int ai = 0; ai < 2; ++ai)
#pragma unroll
            for (int m = 0; m < 4; ++m) { float* rowp = X1 + (size_t)(row0 + ai * HALF + m * 16) * D + col0;
#pragma unroll
                for (int bj = 0; bj < 2; ++bj)
#pragma unroll
                    for (int n = 0; n < 2; ++n) { f32x4* p = (f32x4*)(rowp + bj * HALF + n * 16); *p = *p + acc[ai][bj][m][n]; } }
    }
};

template <class Epi, class Sched, bool ALIGN_EPI>
__device__ __forceinline__ void gemm_phase(PG8_LAS unsigned char* lds, const Gemm g, const Sched& S, const Epi& E) {
    const int tid = threadIdx.x, wid = __builtin_amdgcn_readfirstlane(tid >> 6), lane = tid & 63, wr = wid >> 2, wc = wid & 3, fr = lane & 15, fq = lane >> 4;
    const int K = g.K, nt = K / BK, lda = g.lda, ldb = g.ldb;
    unsigned voffA[2], voffB[2];
#pragma unroll
    for (int i = 0; i < 2; ++i) { int R, C; stage_rc(tid * 16 + i * 8192, R, C); const int Rb = Epi::PERM ? ((R & ~31) + perm32(R & 31)) : R;
        voffA[i] = (unsigned)(R * lda + C) * 2u; voffB[i] = (unsigned)(Rb * ldb + C) * 2u; }
    const size_t kstep = (size_t)(BK * 2);
    const size_t hstepA = (size_t)HALF * lda * 2, hstepB = (size_t)HALF * ldb * 2;
    const size_t tstepA = 2 * hstepA, tstepB = 2 * hstepB;
    const unsigned ldsw = (unsigned)wid * 1024u;
    const int aoff = lds_byte(wr * 64 + fr, fq * 8), boff = lds_byte(wc * 32 + fr, fq * 8);
#define PG8_SA(b, h) (((b) * 2 + (h)) * HTB)
#define PG8_SB(b, h) ((4 + (b) * 2 + (h)) * HTB)
#define PG8_STAGE(bufoff, gbase, voff) do { _Pragma("unroll") for (int _i = 0; _i < 2; ++_i) \
        __builtin_amdgcn_global_load_lds((const unsigned*)((const char*)(gbase) + (voff)[_i]), (PG8_LAS unsigned*)(lds + (bufoff) + ldsw + _i * 8192), 16, 0, 0); } while (0)
#define PG8_LDA(dst, b, h) do { _Pragma("unroll") for (int m = 0; m < 4; ++m) _Pragma("unroll") for (int k = 0; k < 2; ++k) dst[m][k] = *(const PG8_LAS bf16x8*)(lds + PG8_SA(b, h) + aoff + m * 2048 + k * 1024); } while (0)
#define PG8_LDB(dst, b, h) do { _Pragma("unroll") for (int n = 0; n < 2; ++n) _Pragma("unroll") for (int k = 0; k < 2; ++k) dst[n][k] = *(const PG8_LAS bf16x8*)(lds + PG8_SB(b, h) + boff + n * 2048 + k * 1024); } while (0)
#define PG8_MMA(ai, bj, At, Bt) do { __builtin_amdgcn_s_setprio(1); _Pragma("unroll") for (int m = 0; m < 4; ++m) _Pragma("unroll") for (int n = 0; n < 2; ++n) _Pragma("unroll") for (int k = 0; k < 2; ++k) \
        acc[ai][bj][m][n] = __builtin_amdgcn_mfma_f32_16x16x32_bf16(Bt[n][k], At[m][k], acc[ai][bj][m][n], 0, 0, 0); __builtin_amdgcn_s_setprio(0); } while (0)
#define PG8_WAIT_V(n) asm volatile("s_waitcnt vmcnt(" #n ")" ::: "memory")
#define PG8_WAIT_L(n) asm volatile("s_waitcnt lgkmcnt(" #n ")" ::: "memory")
#define PG8_BAR __builtin_amdgcn_s_barrier()
#define PG8_SCHED __builtin_amdgcn_sched_barrier(0)
#define PG8_KBODY(t) do { \
            const bool last = (t == nt - 2); \
            const char* a1 = cA + (size_t)(t + 1) * kstep; \
            const char* a2 = last ? nA : cA + (size_t)(t + 2) * kstep; const char* b2 = last ? nB : cB + (size_t)(t + 2) * kstep; \
            const char* a3 = a2 + kstep; const char* b3 = b2 + kstep; \
            PG8_LDB(B0, 0, 0); PG8_LDB(B1, 0, 1); PG8_SCHED; PG8_LDA(At, 0, 0); PG8_STAGE(PG8_SA(1, 1), a1 + hstepA, voffA); \
            PG8_WAIT_V(8); PG8_WAIT_L(0); PG8_BAR; PG8_MMA(0, 0, At, B0); PG8_MMA(0, 1, At, B1); PG8_BAR; PG8_SCHED; \
            PG8_LDA(At, 0, 1); PG8_STAGE(PG8_SB(0, 0), b2, voffB); PG8_STAGE(PG8_SB(0, 1), b2 + hstepB, voffB); PG8_STAGE(PG8_SA(0, 0), a2, voffA); \
            PG8_WAIT_V(8); PG8_WAIT_L(0); PG8_BAR; PG8_MMA(1, 0, At, B0); PG8_MMA(1, 1, At, B1); PG8_BAR; PG8_SCHED; \
            PG8_LDB(B0, 1, 0); PG8_LDB(B1, 1, 1); PG8_SCHED; PG8_LDA(At, 1, 0); PG8_STAGE(PG8_SA(0, 1), a2 + hstepA, voffA); \
            PG8_WAIT_V(8); PG8_WAIT_L(0); PG8_BAR; PG8_MMA(0, 0, At, B0); PG8_MMA(0, 1, At, B1); PG8_BAR; PG8_SCHED; \
            PG8_LDA(At, 1, 1); PG8_STAGE(PG8_SB(1, 0), b3, voffB); PG8_STAGE(PG8_SB(1, 1), b3 + hstepB, voffB); PG8_STAGE(PG8_SA(1, 0), a3, voffA); \
            PG8_WAIT_V(8); PG8_WAIT_L(0); PG8_BAR; PG8_MMA(1, 0, At, B0); PG8_MMA(1, 1, At, B1); PG8_BAR; PG8_SCHED; \
        } while (0)
    Unit cur, nxt; int ui = 0;
    if (!S.next(0, cur)) return;
    Acc acc;
#pragma unroll
    for (int a = 0; a < 2; ++a)
#pragma unroll
        for (int b = 0; b < 2; ++b)
#pragma unroll
            for (int m = 0; m < 4; ++m)
#pragma unroll
                for (int n = 0; n < 2; ++n) acc[a][b][m][n] = (f32x4){0.f, 0.f, 0.f, 0.f};
    bf16x8 At[4][2], B0[2][2], B1[2][2];
    const char* cA = (const char*)g.A + (size_t)cur.pm * tstepA + (size_t)cur.ks * g.ksoff * 2; const char* cB = (const char*)g.Bt + (size_t)cur.pn * tstepB + (size_t)cur.ks * g.ksoff * 2;
    PG8_STAGE(PG8_SB(0, 0), cB, voffB); PG8_STAGE(PG8_SB(0, 1), cB + hstepB, voffB); PG8_STAGE(PG8_SA(0, 0), cA, voffA); PG8_STAGE(PG8_SA(0, 1), cA + hstepA, voffA);
    if (wr == 1) PG8_BAR;
    PG8_WAIT_V(2); PG8_BAR;
    PG8_STAGE(PG8_SB(1, 0), cB + kstep, voffB); PG8_STAGE(PG8_SA(1, 0), cA + kstep, voffA); PG8_STAGE(PG8_SB(1, 1), cB + hstepB + kstep, voffB);
    PG8_WAIT_V(6); PG8_BAR;
    for (;;) {
        const bool has_next = S.next(ui + 1, nxt);
        const char* nA = has_next ? (const char*)g.A + (size_t)nxt.pm * tstepA + (size_t)nxt.ks * g.ksoff * 2 : cA; const char* nB = has_next ? (const char*)g.Bt + (size_t)nxt.pn * tstepB + (size_t)nxt.ks * g.ksoff * 2 : cB;
        for (int t = 0; t < nt; t += 2) PG8_KBODY(t);
        if constexpr (ALIGN_EPI) { if (wr == 0) PG8_BAR; }
        E(acc, cur, wr, wc, fr, fq);
        if (!has_next) break;
#pragma unroll
        for (int a = 0; a < 2; ++a)
#pragma unroll
            for (int b = 0; b < 2; ++b)
#pragma unroll
                for (int m = 0; m < 4; ++m)
#pragma unroll
                    for (int n = 0; n < 2; ++n) acc[a][b][m][n] = (f32x4){0.f, 0.f, 0.f, 0.f};
        cur = nxt; cA = nA; cB = nB; ++ui;
        if constexpr (ALIGN_EPI) { if (wr == 1) PG8_BAR; }
    }
    PG8_WAIT_V(0);
    if constexpr (!ALIGN_EPI) { if (wr == 0) PG8_BAR; }
    PG8_BAR;
#undef PG8_SA
#undef PG8_SB
#undef PG8_STAGE
#undef PG8_LDA
#undef PG8_LDB
#undef PG8_MMA
#undef PG8_WAIT_V
#undef PG8_WAIT_L
#undef PG8_BAR
#undef PG8_SCHED
#undef PG8_KBODY
}
}

#define GAS __attribute__((address_space(1)))
#define LAS __attribute__((address_space(3)))
typedef unsigned v4u __attribute__((ext_vector_type(4)));
typedef float f32x4 __attribute__((ext_vector_type(4)));
constexpr int NWAVES = 8;
constexpr int LDS_BYTES = 147456;
constexpr size_t MiB = 1u << 20;
constexpr size_t WS_PSS = 1 * MiB, WS_WOUT = 2 * MiB, WS_P = 4 * MiB, WS_KC = 214 * MiB, WS_VC = 215 * MiB, WS_MIX = 216 * MiB;
constexpr size_t WS_AN = 4 * MiB, WS_UP = 64 * MiB, WS_WUP = 248 * MiB, WS_WDOWN = 200 * MiB;
constexpr size_t WS_BIAS1 = 131072 + 16384, WS_W1T = 214 * MiB, WS_KCB = 215 * MiB, WS_VCB = 215 * MiB + 512 * 1024;
constexpr size_t WS_GLV = 4096, WS_QCNT = 65536, WS_GW = 216 * MiB, DO_GQK = 40 * MiB, DO_HALO = 56 * MiB;
constexpr size_t WS_XBAR = 131072;
constexpr size_t DO_H = 0, DO_WG = 32 * MiB, DO_WCAT = 36 * MiB, DO_WIN = 40 * MiB;

__device__ __forceinline__ unsigned pk2(float lo, float hi) { return (unsigned)f2bf(lo) | ((unsigned)f2bf(hi) << 16); }
__device__ __forceinline__ float wave_sum(float v) {
#pragma unroll
    for (int o = 1; o < 64; o <<= 1) v += __shfl_xor(v, o);
    return v;
}
template <class SrcCol>
__device__ __forceinline__ void transpose_item(const float* W, int ldw, const SrcCol& srccol, bf16_t* WT, int ldk, int kofs, LAS float* scr, int kb, int nb, int lane) {
    const int k0 = 64 * kb, n0 = 64 * nb; const int n4 = (lane & 15) * 4; const int sc = srccol(n0 + n4);
    f32x4 v[16];
    const float* wp = W + (size_t)(k0 + (lane >> 4)) * ldw + (sc >= 0 ? sc : 0);
#pragma unroll
    for (int i = 0; i < 16; ++i) v[i] = *(const f32x4*)(wp + (size_t)(4 * i) * ldw);
#pragma unroll
    for (int i = 0; i < 16; ++i) { const int kk = 4 * i + (lane >> 4); const f32x4 u = (sc >= 0) ? v[i] : (f32x4){0.f, 0.f, 0.f, 0.f};
        scr[kk * 65 + n4] = u[0]; scr[kk * 65 + n4 + 1] = u[1]; scr[kk * 65 + n4 + 2] = u[2]; scr[kk * 65 + n4 + 3] = u[3]; }
    asm volatile("s_waitcnt lgkmcnt(0)" ::: "memory");
    const int c = lane & 7;
#pragma unroll
    for (int j = 0; j < 8; ++j) { const int n = (lane >> 3) + 8 * j; const LAS float* sp = scr + (8 * c) * 65 + n;
        v4u o; o.x = pk2(sp[0 * 65], sp[1 * 65]); o.y = pk2(sp[2 * 65], sp[3 * 65]); o.z = pk2(sp[4 * 65], sp[5 * 65]); o.w = pk2(sp[6 * 65], sp[7 * 65]);
        *(v4u*)(WT + (size_t)(n0 + n) * ldk + kofs + k0 + 8 * c) = o; }
    asm volatile("s_waitcnt lgkmcnt(0)" ::: "memory");
}
struct SrcIdent { int off; __device__ __forceinline__ int operator()(int n) const { return n + off; } };
struct SrcWin { __device__ __forceinline__ int operator()(int n) const { return n < 4096 ? n : (n < 6656 ? n + 16 : (n < 6672 ? n - 6656 + 4096 : (n < 6720 ? n : -1))); } };

typedef GAS unsigned gu32;
#define RLX_AGENT __ATOMIC_RELAXED, __HIP_MEMORY_SCOPE_AGENT
#define XB_TMO      128
#define XB_XCNT(j)  (256  + 64 * (j))
#define XB_XSUB(j)  (1280 + 64 * (j))
#define XB_XGEN(j)  (2304 + 64 * (j))
#define XB_TOP      3328
#define XB_TOPGEN   3392
#define XCD_BAR_WORDS 3456
#define XB_SPIN_CAP (1u << 18)

__device__ __forceinline__ unsigned xb_ld(unsigned* p)              { return __hip_atomic_load(p, __ATOMIC_RELAXED, __HIP_MEMORY_SCOPE_AGENT); }
__device__ __forceinline__ unsigned xb_add(unsigned* p, unsigned v) { return __hip_atomic_fetch_add(p, v, __ATOMIC_RELAXED, __HIP_MEMORY_SCOPE_AGENT); }
__device__ __forceinline__ unsigned xb_xcc_id() { return (unsigned)__builtin_amdgcn_s_getreg((3 << 11) | 20) & 0xFu; }
#define XB_SPIN(cond, bar) do { unsigned _sp = 0; while (cond) { __builtin_amdgcn_s_sleep(1); \
    if ((++_sp & 255u) == 0u) { if (xb_ld(&(bar)[XB_TMO])) break; if (_sp > XB_SPIN_CAP) { atomicAdd(&(bar)[XB_TMO], 1u); break; } } } } while (0)

struct XcdBarrier {
    unsigned* bar; unsigned x;
    volatile LAS unsigned* st;
};

__device__ __forceinline__ XcdBarrier xcd_barrier_post(unsigned* bar, volatile LAS unsigned* st) {
    XcdBarrier b; b.bar = bar; b.x = xb_xcc_id(); b.st = st;
    if (threadIdx.x == 0) (void)xb_add(&bar[XB_XCNT(b.x)], 1u);
    return b;
}
__device__ __forceinline__ void xcd_barrier_complete(unsigned* bar, unsigned x, unsigned& nloc, unsigned& nx) {
    const unsigned G = gridDim.x * gridDim.y * gridDim.z;
    unsigned sum, cnt, mine, sp = 0u;
    for (;;) {
        sum = 0u; cnt = 0u; mine = 0u;
#pragma unroll
        for (unsigned j = 0; j < 16; ++j) { const unsigned c = xb_ld(&bar[XB_XCNT(j)]); sum += c; cnt += (c > 0u) ? 1u : 0u; mine = (j == x) ? c : mine; }
        if (sum == G) break;
        __builtin_amdgcn_s_sleep(1);
        if ((++sp & 255u) == 0u) { if (xb_ld(&bar[XB_TMO])) break; if (sp > XB_SPIN_CAP) { atomicAdd(&bar[XB_TMO], 1u); break; } }
    }
    nloc = mine > 0u ? mine : 1u; nx = cnt > 0u ? cnt : 1u;
}

__device__ __forceinline__ void xcd_barrier(const XcdBarrier& b) {
    asm volatile("s_waitcnt vmcnt(0)" ::: "memory");
    __syncthreads();
    if (threadIdx.x == 0) {
        unsigned* bar = b.bar;
        __builtin_amdgcn_s_waitcnt(0);
        unsigned nloc = b.st[0], nx = b.st[1];
        if (nloc == 0u) { xcd_barrier_complete(bar, b.x, nloc, nx); b.st[0] = nloc; b.st[1] = nx; }
        const unsigned old = xb_add(&bar[XB_XSUB(b.x)], 1u);
        const unsigned gen = old / nloc;
        if (old + 1u == (gen + 1u) * nloc) {
            __builtin_amdgcn_fence(__ATOMIC_RELEASE, "agent");
            asm volatile("s_waitcnt vmcnt(0)" ::: "memory");
            const unsigned og = xb_add(&bar[XB_TOP], 1u);
            const unsigned tg = og / nx;
            if (og + 1u == (tg + 1u) * nx) xb_add(&bar[XB_TOPGEN], 1u);
            else XB_SPIN(xb_ld(&bar[XB_TOPGEN]) == tg, bar);
            __builtin_amdgcn_fence(__ATOMIC_ACQUIRE, "agent");
            xb_add(&bar[XB_XGEN(b.x)], 1u);
            asm volatile("s_waitcnt vmcnt(0)" ::: "memory");
        } else {
            XB_SPIN(xb_ld(&bar[XB_XGEN(b.x)]) == gen, bar);
            __builtin_amdgcn_fence(__ATOMIC_ACQUIRE, "agent");
            asm volatile("s_waitcnt vmcnt(0)" ::: "memory");
        }
    }
    __syncthreads();
}


struct Args { const float* in[23]; float* out; unsigned char* ws; int ph_lo, ph_hi; };

__global__ void __launch_bounds__(NWAVES * 64, 2) mk_fwd(Args args) {
    extern __shared__ __attribute__((aligned(16))) unsigned char lds_raw[];
    LAS unsigned char* lds = (LAS unsigned char*)lds_raw;
    __builtin_assume(__builtin_amdgcn_workitem_id_y() == 0); __builtin_assume(__builtin_amdgcn_workitem_id_z() == 0);
    cg::grid_group grid = cg::this_grid();
    const int tid = threadIdx.x, wave = __builtin_amdgcn_readfirstlane(tid >> 6);
#define lane ((int)(threadIdx.x & 63u))
    const int G = gridDim.x, gw = blockIdx.x * NWAVES + wave, NGW = G * NWAVES;
    unsigned char* ws = args.ws; unsigned char* dob = (unsigned char*)args.out;
    const float* x = args.in[0];
    bf16_t* P = (bf16_t*)(ws + WS_P);
    bf16_t* Hb = (bf16_t*)(dob + DO_H); bf16_t* Wg_t = (bf16_t*)(dob + DO_WG); bf16_t* Wcat_t = (bf16_t*)(dob + DO_WCAT); bf16_t* Win_t = (bf16_t*)(dob + DO_WIN);
    bf16_t* Wout_t = (bf16_t*)(ws + WS_WOUT); bf16_t* Wup_t = (bf16_t*)(ws + WS_WUP); bf16_t* Wdown_t = (bf16_t*)(ws + WS_WDOWN);
    bf16_t* Mix = (bf16_t*)(ws + WS_MIX); bf16_t* An = (bf16_t*)(ws + WS_AN); bf16_t* Up = (bf16_t*)(ws + WS_UP); float* pss = (float*)(ws + WS_PSS);
    LAS float* scr = (LAS float*)(lds + wave * 17408);
    bf16_t* Halo = (bf16_t*)(dob + DO_HALO); bf16_t* GWb = (bf16_t*)(ws + WS_GW); bf16_t* GQKb = (bf16_t*)(dob + DO_GQK); float* GLv = (float*)(ws + WS_GLV); unsigned* qcnt = (unsigned*)(ws + WS_QCNT);
    bf16_t* W1T = (bf16_t*)(ws + WS_W1T); float* bias1 = (float*)(ws + WS_BIAS1); bf16_t* KCb = (bf16_t*)(ws + WS_KCB); bf16_t* VCb = (bf16_t*)(ws + WS_VCB);
    const int lo = args.ph_lo, hi = args.ph_hi;
    if (tid < 2) ((volatile LAS unsigned*)(lds + 147456 - 32))[tid] = 0u;
    __syncthreads();
    XcdBarrier xbar = xcd_barrier_post((unsigned*)(ws + WS_XBAR), (volatile LAS unsigned*)(lds + 147456 - 32));
    if (args.ph_hi > 1000) grid.sync();
#ifndef PHMASK
#define PHMASK 0x1ff
#endif
#define IN(k) (((PHMASK >> (k)) & 1) && lo <= (k) && (k) < hi)
#define GRID_SYNC() do { asm volatile("s_waitcnt vmcnt(0) lgkmcnt(0)" ::: "memory"); grid.sync(); \
        if (wave == 0) { __builtin_amdgcn_fence(__ATOMIC_ACQUIRE, "agent"); asm volatile("s_waitcnt vmcnt(0)" ::: "memory"); } __syncthreads(); } while (0)
#if defined(TPROBE)
#define STAMP(k) do { if (blockIdx.x == 0 && tid == 0) ((volatile LAS unsigned long long*)(lds + 147456 - 512))[k] = __builtin_amdgcn_s_memrealtime(); } while (0)
#else
#define STAMP(k) do { } while (0)
#endif
#define SEAM(k) do { if (IN(k) && IN((k) + 1)) xcd_barrier(xbar); STAMP((k) + 1); } while (0)

    STAMP(0);
    if (IN(0)) {
        if (blockIdx.x == 0 && tid == 0) { *qcnt = 0u; ((volatile unsigned*)(ws + 786432))[4] = 0u; }
        constexpr int I_WIN = 16 * (NP1 / 64), I_WG = 16 * 32, I_DN = 16 * 16, I_OUT = 16 * 16, I_UP = 16 * 64;
        constexpr int I_W1 = 32 * 2, I_B1 = 64;
        constexpr int NITEMS = I_WIN + I_WG + 2 * I_DN + I_OUT + I_UP + 2 * I_W1 + I_B1;
        for (int it = gw; it < NITEMS; it += NGW) {
            int r = it;
            if (r < I_WIN) { transpose_item(args.in[2], INW, SrcWin{}, Win_t, D, 0, scr, r / (NP1 / 64), r % (NP1 / 64), lane); continue; } r -= I_WIN;
            if (r < I_WG) { transpose_item(args.in[2], INW, SrcIdent{6720}, Wg_t, D, 0, scr, r / 32, r % 32, lane); continue; } r -= I_WG;
            if (r < I_DN) { transpose_item(args.in[17], D, SrcIdent{0}, Wcat_t, 2 * D, 0, scr, r / 16, r % 16, lane); continue; } r -= I_DN;
            if (r < I_DN) { transpose_item(args.in[18], D, SrcIdent{0}, Wcat_t, 2 * D, D, scr, r / 16, r % 16, lane); continue; } r -= I_DN;
            if (r < I_OUT) { transpose_item(args.in[19], D, SrcIdent{0}, Wout_t, D, 0, scr, r / 16, r % 16, lane); continue; } r -= I_OUT;
            if (r < I_UP) { transpose_item(args.in[21], FF, SrcIdent{0}, Wup_t, D, 0, scr, r / 64, r % 64, lane); continue; } r -= I_UP;
            if (r < I_W1) { transpose_item(args.in[12], 128, SrcIdent{0}, W1T, 2048, 0, scr, r / 2, r % 2, lane); continue; } r -= I_W1;
            if (r < I_W1) { transpose_item(args.in[15], 128, SrcIdent{0}, W1T + 128 * 2048, 2048, 0, scr, r / 2, r % 2, lane); continue; } r -= I_W1;
            {
                const int which = r >> 5, kc = r & 31; const float* pos = args.in[which ? 14 : 11] + kc * 64; const float* w1 = args.in[which ? 15 : 12] + (size_t)kc * 64 * 128 + 2 * lane;
                float a0 = 0.f, a1 = 0.f;
#pragma unroll 16
                for (int k = 0; k < 64; ++k) { const float pk_ = pos[k]; const float2 w = *(const float2*)(w1 + (size_t)k * 128); a0 += pk_ * w.x; a1 += pk_ * w.y; }
                atomicAdd(bias1 + which * 128 + 2 * lane, a0); atomicAdd(bias1 + which * 128 + 2 * lane + 1, a1);
            }
        }
        const float* gain = args.in[1];
        f32x4 gv[4];
#pragma unroll
        for (int j = 0; j < 4; ++j) gv[j] = ((const f32x4*)gain)[lane + 64 * j];
        for (int m = gw; m < M; m += 2 * NGW) {
            const int m2 = (m + NGW < M) ? m + NGW : m;
            const f32x4* xr = (const f32x4*)(x + (size_t)m * D) + lane; const f32x4* xr2 = (const f32x4*)(x + (size_t)m2 * D) + lane;
            f32x4 v[4], u[4]; float s1 = 0.f, s2 = 0.f;
#pragma unroll
            for (int j = 0; j < 4; ++j) { v[j] = xr[64 * j]; u[j] = xr2[64 * j]; }
#pragma unroll
            for (int j = 0; j < 4; ++j) { s1 += (v[j].x * v[j].x + v[j].y * v[j].y) + (v[j].z * v[j].z + v[j].w * v[j].w); s2 += (u[j].x * u[j].x + u[j].y * u[j].y) + (u[j].z * u[j].z + u[j].w * u[j].w); }
            const float r1 = rsqrtf(wave_sum(s1) * (1.f / D) + EPS), r2 = rsqrtf(wave_sum(s2) * (1.f / D) + EPS);
            unsigned long long* o8 = (unsigned long long*)(Hb + (size_t)m * D) + lane; unsigned long long* o9 = (unsigned long long*)(Hb + (size_t)m2 * D) + lane;
#pragma unroll
            for (int j = 0; j < 4; ++j) { const f32x4 y = v[j] * r1 * gv[j]; o8[64 * j] = (unsigned long long)pk2(y.x, y.y) | ((unsigned long long)pk2(y.z, y.w) << 32); }
            if (m2 != m) {
#pragma unroll
                for (int j = 0; j < 4; ++j) { const f32x4 y = u[j] * r2 * gv[j]; o9[64 * j] = (unsigned long long)pk2(y.x, y.y) | ((unsigned long long)pk2(y.z, y.w) << 32); } }
        }
    }
    SEAM(0);
    if (IN(1)) {
        pg8::Gemm g{Hb, Win_t, D, D, M, NP1, D, 0}; pg8::StaticOrder S; S.init(M, NP1, G, (int)blockIdx.x);
        pg8::EpiP<0> E{P, LDP, 26, 64, Halo};
        pg8::gemm_phase<pg8::EpiP<0>, pg8::StaticOrder, true>(lds, g, S, E);
    }
    SEAM(1);
    if (IN(2)) {
        for (int it = (G == 256) ? (((int)blockIdx.x & 1) ? 128 : (int)blockIdx.x >> 1) : (int)blockIdx.x; it < 128; it += G) {
            const int half = it & 1, which = (it >> 1) & 1, g_ = (it >> 2) & 3, b_ = it >> 4;
            nsa::compress_item(lds, P, W1T + (size_t)which * 128 * 2048, bias1 + which * 128, args.in[which ? 16 : 13], args.in[8], which ? VCb : KCb, b_, g_, which, half);
        }
        STAMP(11);
        nsa::prep_units(P, args.in[7], args.in[9], args.in[10], gw, NGW, lane);
        STAMP(12);
#if !defined(GDN_NAIVE)
        __syncthreads();
        {
            gdn::RowPre pre; int hl = -1;
            const int c_ = (int)blockIdx.x, hq = c_ >> 5, jq = c_ & 31;
            const bool bal = (G == 256);
            const int cnt = bal ? ((jq & 1) ? 9 : 7) : (2048 - c_ + G - 1) / G;
            const int first = bal ? ((jq & 1) ? 112 + 9 * (jq >> 1) : 7 * (jq >> 1)) : 0;
#define PREP_COORD(k, b_, n_, h_) do { if (bal) { const int idx_ = first + (k); b_ = idx_ >> 5; n_ = idx_ & 31; h_ = hq; } else { const int it_ = c_ + (k) * G; b_ = it_ >> 8; n_ = it_ & 31; h_ = (it_ >> 5) & 7; } } while (0)
            int b0, n0, h0;
            if (cnt > 0) { PREP_COORD(0, b0, n0, h0); gdn::prep_prefetch(pre, P, Halo, b0, n0, h0, wave, lane); }
            for (int k = 0; k < cnt; ++k) {
                int bc, nc, hc, bn = -1, nn = 0, hn = 0;
                PREP_COORD(k, bc, nc, hc);
                if (k + 1 < cnt) PREP_COORD(k + 1, bn, nn, hn);
                if (hc != hl) { __syncthreads(); gdn::prep_load_taps(lds, args.in[3], hc); hl = hc; __syncthreads(); }
                gdn::prep_item(lds, P, Halo, args.in[4], args.in[5], GWb, GQKb, GLv, pre, bc, nc, hc, bn, nn, hn);
                if (k == 0) STAMP(14);
            }
#undef PREP_COORD
        }
        STAMP(13);
#endif
    }
    SEAM(2);
    if (IN(3)) {
#if defined(GDN_NAIVE)
        if ((int)blockIdx.x < 16) gdn_naive::run(lds, P, args.in[3], args.in[4], args.in[5], args.in[6], 4 * (int)blockIdx.x);
#else
        if ((int)blockIdx.x < 64) gdn::scan_item(lds, P, GWb, GQKb, GLv, args.in[6], (int)blockIdx.x >> 3, (int)blockIdx.x & 7);
#endif
        __syncthreads();
        STAMP(10);
        for (;;) {
            volatile LAS unsigned* qslot = (volatile LAS unsigned*)(lds + 147456 - 16);
            if (tid == 0) *qslot = atomicAdd(qcnt, 1u);
            __syncthreads();
            const int idx = (int)*qslot;
            __syncthreads();
            if (idx >= 1024) break;
#if defined(TPROBE)
            if (blockIdx.x == 200 && tid == 0) { ((volatile unsigned long long*)(ws + 786432))[0] = __builtin_amdgcn_s_memrealtime(); ((volatile unsigned*)(ws + 786432))[4] += 1u; }
#endif
            nsa::attn_tile(lds, P, KCb, VCb, (idx & 31) >> 2, idx & 3, 31 - (idx >> 5));
        }
    }
    SEAM(3);
    if (IN(4)) {
        pg8::Gemm g{Hb, Wg_t, D, D, M, 2048, D, 0}; pg8::StaticOrder S; S.init(M, 2048, G, (int)blockIdx.x);
        pg8::EpiP<1> E{P, LDP, -1, 256, nullptr};
        pg8::gemm_phase<pg8::EpiP<1>, pg8::StaticOrder, true>(lds, g, S, E);
    }
    SEAM(4);
    if (IN(5)) {
        pg8::Gemm g{P + C_DZ, Wcat_t, LDP, 2 * D, M, D, D, D}; pg8::TwoPassOrder S; S.base.init(M, D, G, (int)blockIdx.x);
        pg8::EpiMix E{P, LDP, Mix, D};
        pg8::gemm_phase<pg8::EpiMix, pg8::TwoPassOrder, false>(lds, g, S, E);
    }
    SEAM(5);
    if (IN(6)) {
        for (int it = gw; it < 64 * 16; it += NGW) transpose_item(args.in[22], D, SrcIdent{0}, Wdown_t, FF, 0, scr, it / 16, it % 16, lane);
        __syncthreads();
        pg8::Gemm g{Mix, Wout_t, D, D, M, D, D, 0}; pg8::StaticOrder S; S.init(M, D, G, (int)blockIdx.x);
        pg8::EpiOut E{x, args.out, An, args.in[20], pss};
        pg8::gemm_phase<pg8::EpiOut, pg8::StaticOrder, false>(lds, g, S, E);
    }
    SEAM(6);
    if (IN(7)) {
        pg8::Gemm g{An, Wup_t, D, D, M, FF, D, 0}; pg8::StaticOrder S; S.init(M, FF, G, (int)blockIdx.x);
        pg8::EpiUp E{pss, Up, FF};
        pg8::gemm_phase<pg8::EpiUp, pg8::StaticOrder, true>(lds, g, S, E);
    }
    SEAM(7);
    if (IN(8)) {
        pg8::Gemm g{Up, Wdown_t, FF, FF, M, D, FF, 0}; pg8::StaticOrder S; S.init(M, D, G, (int)blockIdx.x);
        pg8::EpiDown E{args.out};
        pg8::gemm_phase<pg8::EpiDown, pg8::StaticOrder, false>(lds, g, S, E);
    }
#if defined(TPROBE)
    STAMP(9);
    GRID_SYNC();
    if (blockIdx.x == 0) {
        volatile LAS unsigned long long* ts = (volatile LAS unsigned long long*)(lds + 147456 - 512);
        if (tid == 0) { ts[25] = ((volatile unsigned long long*)(ws + 786432))[0]; ts[26] = ts[3] + 100ull * ((volatile unsigned*)(ws + 786432))[4]; }
        const float dA = (float)(ts[TPA1] - ts[TPA0]) * 0.01f, dB = (float)(ts[TPB1] - ts[TPB0]) * 0.01f;
        if (tid == 0) args.out[0] = dA + 0.f * dB;
    }
#endif
#undef IN
#undef SEAM
#undef GRID_SYNC
}

#undef lane
static int g_grid = 0;
static void launch_mk(const Args& a0, int lo, int hi, hipStream_t stream) {
    Args a = a0; a.ph_lo = lo; a.ph_hi = hi;
    void* kargs[] = {(void*)&a};
    hipError_t e = hipLaunchCooperativeKernel((const void*)mk_fwd, dim3(g_grid), dim3(NWAVES * 64), kargs, LDS_BYTES, stream);
    if (e != hipSuccess) fprintf(stderr, "cooperative launch failed: %s (grid %d)\n", hipGetErrorString(e), g_grid);
}

extern "C" void kernel_launch(void* const* d_in, const int* in_sizes, int n_in, void* d_out, int out_size, void* d_ws, size_t ws_size, hipStream_t stream) {
    if (g_grid == 0) {
        int dev = 0, cus = 0, per_cu = 0;
        hipGetDevice(&dev);
        hipDeviceGetAttribute(&cus, hipDeviceAttributeMultiprocessorCount, dev);
        hipFuncSetAttribute((const void*)mk_fwd, hipFuncAttributeMaxDynamicSharedMemorySize, LDS_BYTES);
        hipOccupancyMaxActiveBlocksPerMultiprocessor(&per_cu, (const void*)mk_fwd, NWAVES * 64, LDS_BYTES);
        if (per_cu < 1) per_cu = 1;
        if (per_cu > 1) per_cu = 1;
        g_grid = cus * per_cu;
    }
    Args a{};
    for (int i = 0; i < 23; ++i) a.in[i] = (const float*)d_in[i];
    a.out = (float*)d_out; a.ws = (unsigned char*)d_ws;
    bf16_t* P = (bf16_t*)((char*)d_ws + WS_P);
    hipMemsetAsync((char*)d_ws + WS_XBAR, 0, 16384 + 1024, stream);
    launch_mk(a, 0, 9, stream);
}
```

```cpp
#include <hip/hip_runtime.h>
#include <hip/hip_cooperative_groups.h>
#include <stdint.h>
#include <cstdio>
namespace cg = cooperative_groups;

typedef unsigned short bf16_t;

constexpr int D = 1024, BATCH = 8, SEQ = 2048, M = BATCH * SEQ;
constexpr int DN_H = 8, DN_D = 128;
constexpr int NS_H = 16, NS_G = 4, NS_R = 4, NS_D = 64;
constexpr int NCMP = 127, NSEL = 32;
constexpr int FF = 4096;
constexpr int INW = 8768;
constexpr float EPS = 1e-6f;
constexpr float NEGV = -1e30f, FORCEV = 1e9f;

constexpr int LDP = 6720;
constexpr int C_DQ = 0, C_DK = 1024, C_DV = 2048, C_DZ = 3072, C_NQ = 4096;
constexpr int C_KC = 5120, C_VC = 5376, C_KS = 5632, C_VS = 5888, C_KW = 6144, C_VW = 6400;
constexpr int C_SB = 6656, C_SA = 6664, C_SG = 6672;
constexpr int NP1 = 6912;

__device__ __forceinline__ float bf2f(bf16_t v) { return __uint_as_float(((unsigned)v) << 16); }
__device__ __forceinline__ bf16_t f2bf(float f) { unsigned u = __float_as_uint(f); return (bf16_t)((u + 0x7fffu + ((u >> 16) & 1u)) >> 16); }
__device__ __forceinline__ float sigmoidf_(float x) { return 1.f / (1.f + __expf(-x)); }
__device__ __forceinline__ float siluf_(float x) { return x * sigmoidf_(x); }
__device__ __forceinline__ float softplusf_(float x) { return fmaxf(x, 0.f) + log1pf(__expf(-fabsf(x))); }
__device__ __forceinline__ float gelu_tanh(float x) { return 0.5f * x * (1.f + tanhf(0.7978845608028654f * (x + 0.044715f * x * x * x))); }

__device__ __forceinline__ float block_sum(float v, float* red) {
    for (int o = 32; o > 0; o >>= 1) v += __shfl_xor(v, o);
    const int w = threadIdx.x >> 6, nw = blockDim.x >> 6;
    __syncthreads();
    if ((threadIdx.x & 63) == 0) red[w] = v;
    __syncthreads();
    float s = 0.f;
    for (int i = 0; i < nw; ++i) s += red[i];
    return s;
}
__device__ __forceinline__ float block_max(float v, float* red) {
    for (int o = 32; o > 0; o >>= 1) v = fmaxf(v, __shfl_xor(v, o));
    const int w = threadIdx.x >> 6, nw = blockDim.x >> 6;
    __syncthreads();
    if ((threadIdx.x & 63) == 0) red[w] = v;
    __syncthreads();
    float s = red[0];
    for (int i = 1; i < nw; ++i) s = fmaxf(s, red[i]);
    return s;
}


#if defined(TPROBE)
#define XSTAMP(k) do { if (blockIdx.x == 0 && threadIdx.x == 0) ((volatile __attribute__((address_space(3))) unsigned long long*)(lds + 147456 - 512))[k] = __builtin_amdgcn_s_memrealtime(); } while (0)
#else
#define XSTAMP(k) do { } while (0)
#endif
namespace gdn_naive {
#define GLAS __attribute__((address_space(3)))
__device__ __forceinline__ float sub_sum(float v, GLAS float* red, int sub, int tid) {
#pragma unroll
    for (int o = 32; o > 0; o >>= 1) v += __shfl_xor(v, o);
    __syncthreads();
    if ((tid & 63) == 0) red[sub * 2 + ((tid >> 6) & 1)] = v;
    __syncthreads();
    return red[sub * 2] + red[sub * 2 + 1];
}
__device__ __forceinline__ void run(GLAS unsigned char* lds, bf16_t* P, const float* convw, const float* a_log, const float* dt_bias, const float* out_norm, int item0) {
    const int tid = threadIdx.x, sub = tid >> 7, j = tid & 127;
    GLAS float* qs = (GLAS float*)lds + sub * 256; GLAS float* ks = qs + 128; GLAS float* red = (GLAS float*)(lds + 4096);
    const int item = item0 + sub; const int b = item / DN_H, h = item % DN_H;
    float s[128];
#pragma unroll
    for (int i = 0; i < 128; ++i) s[i] = 0.f;
    const float Ah = -__expf(a_log[h]), dtb = dt_bias[h], gn = out_norm[j];
    const float scale = 0.08838834764831845f;
    float wq[4], wk[4], wv[4], xq[3] = {0.f, 0.f, 0.f}, xk[3] = {0.f, 0.f, 0.f}, xv[3] = {0.f, 0.f, 0.f};
#pragma unroll
    for (int t = 0; t < 4; ++t) { wq[t] = convw[t * 3072 + h * 128 + j]; wk[t] = convw[t * 3072 + 1024 + h * 128 + j]; wv[t] = convw[t * 3072 + 2048 + h * 128 + j]; }
    for (int t = 0; t < SEQ; ++t) {
        bf16_t* row = P + (size_t)(b * SEQ + t) * LDP;
        const float rq = bf2f(row[C_DQ + h * DN_D + j]), rk = bf2f(row[C_DK + h * DN_D + j]), rv = bf2f(row[C_DV + h * DN_D + j]);
        float q = siluf_(wq[0] * xq[0] + wq[1] * xq[1] + wq[2] * xq[2] + wq[3] * rq);
        float k = siluf_(wk[0] * xk[0] + wk[1] * xk[1] + wk[2] * xk[2] + wk[3] * rk);
        const float v = siluf_(wv[0] * xv[0] + wv[1] * xv[1] + wv[2] * xv[2] + wv[3] * rv);
        xq[0] = xq[1]; xq[1] = xq[2]; xq[2] = rq; xk[0] = xk[1]; xk[1] = xk[2]; xk[2] = rk; xv[0] = xv[1]; xv[1] = xv[2]; xv[2] = rv;
        const float sq = sub_sum(q * q, red, sub, tid);
        const float sk = sub_sum(k * k, red, sub, tid);
        q *= rsqrtf(sq + EPS); k *= rsqrtf(sk + EPS);
        qs[j] = q; ks[j] = k;
        const float beta = sigmoidf_(bf2f(row[C_SB + h]));
        const float a = __expf(Ah * softplusf_(bf2f(row[C_SA + h]) + dtb));
        const float z = bf2f(row[C_DZ + h * DN_D + j]);
        __syncthreads();
        float kS = 0.f;
#pragma unroll
        for (int i = 0; i < 128; ++i) kS += ks[i] * s[i];
        const float dlt = beta * (v - a * kS);
        asm volatile("" ::: "memory");
        float o = 0.f;
#pragma unroll
        for (int i = 0; i < 128; ++i) { s[i] = a * s[i] + ks[i] * dlt; o += qs[i] * s[i]; }
        o *= scale;
        const float ss = sub_sum(o * o, red, sub, tid);
        row[C_DZ + h * DN_D + j] = f2bf(o * rsqrtf(ss * (1.f / 128.f) + EPS) * gn * siluf_(z));
    }
}
}
namespace gdn {
#define GL3 __attribute__((address_space(3)))
typedef short bf16x8 __attribute__((ext_vector_type(8)));
typedef short s16x4 __attribute__((ext_vector_type(4)));
typedef short v4i16_t __attribute__((ext_vector_type(4)));
typedef float f32x16 __attribute__((ext_vector_type(16)));
typedef float f32x4 __attribute__((ext_vector_type(4)));
typedef float f32x2 __attribute__((ext_vector_type(2)));
typedef unsigned u32x4 __attribute__((ext_vector_type(4)));
typedef unsigned u32x2 __attribute__((ext_vector_type(2)));
typedef __bf16 bf16x2_t __attribute__((ext_vector_type(2)));
constexpr float QSCALE = 0.08838834764831845f;
__device__ __forceinline__ float fsig(float x) { return __builtin_amdgcn_rcpf(1.f + __builtin_amdgcn_exp2f(-1.4426950408889634f * x)); }
__device__ __forceinline__ float fsilu(float x) { return x * fsig(x); }
__device__ __forceinline__ int crow(int i, int hi) { return (i & 3) + 8 * (i >> 2) + 4 * hi; }
__device__ __forceinline__ unsigned pk(float lo, float hi) { f32x2 v = {lo, hi}; bf16x2_t b = __builtin_convertvector(v, bf16x2_t); return __builtin_bit_cast(unsigned, b); }
__device__ __forceinline__ bf16x8 pack8(const float* v) { u32x4 w = {pk(v[0], v[1]), pk(v[2], v[3]), pk(v[4], v[5]), pk(v[6], v[7])}; return __builtin_bit_cast(bf16x8, w); }
__device__ __forceinline__ float blo(unsigned w) { return __uint_as_float(w << 16); }
__device__ __forceinline__ float bhi(unsigned w) { return __uint_as_float(w & 0xffff0000u); }
__device__ __forceinline__ char* seg_addr(bf16_t* P, size_t row0, int c0, unsigned e) { return (char*)P + ((row0 + (e >> 8)) * LDP + c0) * 2 + (e & 255u); }

__device__ __forceinline__ s16x4 vtr(GL3 const unsigned char* p) { return __builtin_bit_cast(s16x4, __builtin_amdgcn_ds_read_tr16_b64_v4i16((GL3 v4i16_t*)p)); }

constexpr int PL_K = 0, PL_KB = 16384, PL_Q = 32768, PL_RV = 49152, PL_AM = 81920, PL_INV = 99328, PL_MT = 116736, PL_GC = 120832, PL_QKST = 121088, PL_TI = 129280, PL_CW = 137472, PL_END = 143616;
constexpr int PL_WST = 0, PL_UST = 16384;
constexpr int AMLD = 68;
struct RowPre { u32x4 x[2][3][4]; unsigned short lb, la; };
__device__ __forceinline__ void prep_prefetch(RowPre& pre, const bf16_t* P, const bf16_t* HALO, int b, int n, int h, int wid, int lane) {
    const size_t row0 = (size_t)b * SEQ + 64 * n; const int dc = lane & 15;
    const bf16_t* prow = P + (row0 + lane) * LDP;
    pre.lb = prow[C_SB + h]; pre.la = prow[C_SA + h];
#pragma unroll
    for (int pass = 0; pass < 2; ++pass) {
        const int tok = 8 * wid + 4 * pass + (lane >> 4);
#pragma unroll
        for (int which = 0; which < 3; ++which) {
            const int col = which * 1024 + h * 128 + dc * 8;
#pragma unroll
            for (int j = 0; j < 4; ++j) {
                const int rr = tok - 3 + j; const bool inb = rr >= 0;
                const bf16_t* src = inb ? (P + (row0 + (inb ? rr : 0)) * LDP + col) : (HALO + ((size_t)((b * 32 + (n > 0 ? n - 1 : 0)) * 3 + (inb ? 0 : 3 + rr))) * 3072 + col);
                pre.x[pass][which][j] = *(const u32x4*)src;
            }
        }
    }
}
__device__ __forceinline__ void prep_load_taps(GL3 unsigned char* lds, const float* convw, int h) {
    GL3 float* cw = (GL3 float*)(lds + 137472);
    for (int e = threadIdx.x; e < 1536; e += 512) { const int which = e >> 9, j = (e >> 7) & 3, c = e & 127; cw[e] = convw[j * 3072 + which * 1024 + h * 128 + c]; }
}
#define PBAR() do { asm volatile("s_waitcnt lgkmcnt(0)" ::: "memory"); __builtin_amdgcn_s_barrier(); asm volatile("" ::: "memory"); } while (0)
__device__ __forceinline__ void prep_item(GL3 unsigned char* lds, bf16_t* P, const bf16_t* HALO, const float* a_log, const float* dt_bias,
                                          bf16_t* GW, bf16_t* GQK, float* GLv, RowPre& pre, int b, int n, int h, int nb_, int nn_, int nh_) {
    int tid = threadIdx.x; asm volatile("" : "+v"(tid));
    const int lane = tid & 63, r32 = lane & 31, hi = lane >> 5; const int wid = __builtin_amdgcn_readfirstlane(tid >> 6);
    const size_t row0 = (size_t)b * SEQ + 64 * n; const int item = (b * DN_H + h) * 32 + n;
    GL3 float* AM = (GL3 float*)(lds + PL_AM); GL3 float* INV = (GL3 float*)(lds + PL_INV); GL3 float* MT = (GL3 float*)(lds + PL_MT); GL3 float* GC = (GL3 float*)(lds + PL_GC);
    float gcum, beta_l, gc_last;
    {
        beta_l = fsig(bf2f(pre.lb));
        { const float xs = bf2f(pre.la) + dt_bias[h]; gcum = -__expf(a_log[h]) * (fmaxf(xs, 0.f) + __logf(1.f + __expf(-fabsf(xs)))); }
#pragma unroll
        for (int o = 1; o < 64; o <<= 1) { const float t = __shfl_up(gcum, o); if (lane >= o) gcum += t; }
        gc_last = __shfl(gcum, 63);
        if (wid == 0) GC[lane] = gcum;
    }
    bf16x8 qd_keep[2], ke_keep[2];
    const int dc = lane & 15;
#pragma unroll
    for (int pass = 0; pass < 2; ++pass) {
        const int tok = 8 * wid + 4 * pass + (lane >> 4);
        const float gct = __shfl(gcum, tok), bet = __shfl(beta_l, tok);
        float y[3][8];
#pragma unroll
        for (int which = 0; which < 3; ++which) {
#pragma unroll
            for (int e = 0; e < 8; ++e) y[which][e] = 0.f;
#pragma unroll
            for (int j = 0; j < 4; ++j) {
                const int rr = tok - 3 + j;
                u32x4 x = pre.x[pass][which][j];
                if (rr < 0 && n == 0) x = (u32x4){0u, 0u, 0u, 0u};
                const f32x4 w0 = *(GL3 const f32x4*)(lds + PL_CW + ((which * 4 + j) * 128 + dc * 8) * 4), w1 = *(GL3 const f32x4*)(lds + PL_CW + ((which * 4 + j) * 128 + dc * 8 + 4) * 4);
                y[which][0] += w0[0] * blo(x.x); y[which][1] += w0[1] * bhi(x.x); y[which][2] += w0[2] * blo(x.y); y[which][3] += w0[3] * bhi(x.y);
                y[which][4] += w1[0] * blo(x.z); y[which][5] += w1[1] * bhi(x.z); y[which][6] += w1[2] * blo(x.w); y[which][7] += w1[3] * bhi(x.w);
            }
#pragma unroll
            for (int e = 0; e < 8; ++e) y[which][e] = fsilu(y[which][e]);
        }
        float sq = 0.f, sk = 0.f;
#pragma unroll
        for (int e = 0; e < 8; ++e) { sq += y[0][e] * y[0][e]; sk += y[1][e] * y[1][e]; }
#pragma unroll
        for (int o = 1; o < 16; o <<= 1) { sq += __shfl_xor(sq, o); sk += __shfl_xor(sk, o); }
        const float rq = rsqrtf(sq + EPS), rk = rsqrtf(sk + EPS);
        const float eg = __expf(gct), ke_s = __expf(gc_last - gct);
        float q8[8], k8[8], kb8[8], qd8[8], ke8[8], kbg8[8], vb8[8];
#pragma unroll
        for (int e = 0; e < 8; ++e) { q8[e] = y[0][e] * rq; k8[e] = y[1][e] * rk; kb8[e] = k8[e] * bet; qd8[e] = q8[e] * (QSCALE * eg); ke8[e] = k8[e] * ke_s; kbg8[e] = kb8[e] * eg; vb8[e] = y[2][e] * bet; }
        const int io = (dc * 64 + tok) * 16;
        *(GL3 bf16x8*)(lds + PL_Q + io) = pack8(q8); *(GL3 bf16x8*)(lds + PL_K + io) = pack8(k8); *(GL3 bf16x8*)(lds + PL_KB + io) = pack8(kb8);
        {
            const int rvo = (tok >> 4) * 1024 + ((tok >> 3) & 1) * 512 + (tok & 7) * 64 + (dc & 3) * 16;
            *(GL3 bf16x8*)(lds + PL_RV + (dc >> 2) * 4096 + rvo) = pack8(kbg8); *(GL3 bf16x8*)(lds + PL_RV + (4 + (dc >> 2)) * 4096 + rvo) = pack8(vb8);
        }
        qd_keep[pass] = pack8(qd8); ke_keep[pass] = pack8(ke8);
    }
    PBAR();
    if (nb_ >= 0) prep_prefetch(pre, P, HALO, nb_, nn_, nh_, wid, lane);
    if (n == 0 && b == 0 && h == 0) XSTAMP(15);
#pragma unroll
    for (int pass = 0; pass < 2; ++pass) {
        const int tok = 8 * wid + 4 * pass + (lane >> 4);
        *(bf16x8*)seg_addr(P, row0, C_DQ + h * 128, (unsigned)((dc * 64 + tok) * 16)) = qd_keep[pass];
        const unsigned ek = (unsigned)(((dc >> 2) * 4 + (tok >> 4)) * 1024 + ((tok >> 3) & 1) * 512 + (tok & 7) * 64 + (dc & 3) * 16);
        *(bf16x8*)seg_addr(P, row0, C_DK + h * 128, ek) = ke_keep[pass];
    }
    if (wid < 6) {
        const bool isA = wid < 3; const int t3 = isA ? wid : wid - 3;
        const int rt = isA ? (t3 > 0) : (t3 == 2);
        const int ct = isA ? (t3 == 2) : (t3 > 0);
        GL3 const unsigned char* aimg = lds + (isA ? PL_KB : PL_K); GL3 const unsigned char* bimg = lds + (isA ? PL_K : PL_Q);
        f32x16 acc = f32x16{};
#pragma unroll
        for (int s = 0; s < 8; ++s) {
            const bf16x8 a = *(GL3 const bf16x8*)(aimg + ((2 * s + hi) * 64 + 32 * rt + r32) * 16);
            const bf16x8 bb = *(GL3 const bf16x8*)(bimg + ((2 * s + hi) * 64 + 32 * ct + r32) * 16);
            acc = __builtin_amdgcn_mfma_f32_32x32x16_bf16(a, bb, acc, 0, 0, 0);
        }
        if (isA) {
            const int j = 32 * ct + r32; const float gj = GC[j];
#pragma unroll
            for (int i_ = 0; i_ < 16; ++i_) { const int i = 32 * rt + crow(i_, hi); AM[i * AMLD + j] = (j < i) ? acc[i_] * __expf(GC[i] - gj) : 0.f; }
        } else {
            const int i = 32 * ct + r32; const float gi = GC[i];
            float v[16];
#pragma unroll
            for (int i_ = 0; i_ < 16; ++i_) { const int j = 32 * rt + crow(i_, hi); v[i_] = (j <= i) ? acc[i_] * (QSCALE * __expf(gi - GC[j])) : 0.f; }
#pragma unroll
            for (int sp = 0; sp < 2; ++sp) *(GL3 bf16x8*)(lds + PL_QKST + (((2 * rt + sp) * 64 + i) * 16 + 8 * hi) * 2) = pack8(v + 8 * sp);
        }
    } else if (wid == 6) {
        const bf16x8 z = {0, 0, 0, 0, 0, 0, 0, 0};
#pragma unroll
        for (int sp = 0; sp < 2; ++sp) *(GL3 bf16x8*)(lds + PL_QKST + (((2 + sp) * 64 + r32) * 16 + 8 * hi) * 2) = z;
    }
    PBAR();
    if (wid < 4 && lane < 16) {
        const int bb = wid, c = lane;
        float x[16];
#pragma unroll
        for (int i = 0; i < 16; ++i) {
            float acc = (i == c) ? 1.f : 0.f;
#pragma unroll
            for (int j4 = 0; j4 < i; j4 += 4) { const f32x4 a = *(GL3 const f32x4*)(AM + (16 * bb + i) * AMLD + 16 * bb + j4);
                acc -= a[0] * x[j4]; if (j4 + 1 < i) acc -= a[1] * x[j4 + 1]; if (j4 + 2 < i) acc -= a[2] * x[j4 + 2]; if (j4 + 3 < i) acc -= a[3] * x[j4 + 3]; }
            x[i] = acc;
        }
#pragma unroll
        for (int i = 0; i < 16; ++i) INV[(16 * bb + i) * AMLD + 16 * bb + c] = x[i];
    }
    PBAR();
    for (int L = 1; L < 4; ++L) {
        const int nb = 4 - L;
        for (int t = tid; t < nb * 256; t += 512) {
            const int J = t >> 8, I = J + L, ei = (t >> 4) & 15, ej = t & 15;
            float acc = 0.f;
            for (int K = J; K < I; ++K) {
#pragma unroll
                for (int k4 = 0; k4 < 16; k4 += 4) { const f32x4 a = *(GL3 const f32x4*)(AM + (16 * I + ei) * AMLD + 16 * K + k4);
                    acc += a[0] * INV[(16 * K + k4) * AMLD + 16 * J + ej] + a[1] * INV[(16 * K + k4 + 1) * AMLD + 16 * J + ej] + a[2] * INV[(16 * K + k4 + 2) * AMLD + 16 * J + ej] + a[3] * INV[(16 * K + k4 + 3) * AMLD + 16 * J + ej]; }
            }
            MT[(J * 16 + ei) * 17 + ej] = acc;
        }
        PBAR();
        for (int t = tid; t < nb * 256; t += 512) {
            const int J = t >> 8, I = J + L, ei = (t >> 4) & 15, ej = t & 15;
            float acc = 0.f;
#pragma unroll
            for (int k4 = 0; k4 < 16; k4 += 4) { const f32x4 d = *(GL3 const f32x4*)(INV + (16 * I + ei) * AMLD + 16 * I + k4);
                acc += d[0] * MT[(J * 16 + k4) * 17 + ej] + d[1] * MT[(J * 16 + k4 + 1) * 17 + ej] + d[2] * MT[(J * 16 + k4 + 2) * 17 + ej] + d[3] * MT[(J * 16 + k4 + 3) * 17 + ej]; }
            INV[(16 * I + ei) * AMLD + 16 * J + ej] = -acc;
        }
        PBAR();
    }
    {
        const int s_ = tid >> 7, i = (tid >> 1) & 63, hh = tid & 1;
        float v[8];
        if (s_ > (i >> 4)) {
#pragma unroll
            for (int e = 0; e < 8; ++e) v[e] = 0.f;
        } else {
            const f32x4 a = *(GL3 const f32x4*)(INV + i * AMLD + 16 * s_ + 4 * hh), c4 = *(GL3 const f32x4*)(INV + i * AMLD + 16 * s_ + 8 + 4 * hh);
            v[0] = a[0]; v[1] = a[1]; v[2] = a[2]; v[3] = a[3]; v[4] = c4[0]; v[5] = c4[1]; v[6] = c4[2]; v[7] = c4[3];
        }
        *(GL3 bf16x8*)(lds + PL_TI + ((s_ * 64 + i) * 16 + 8 * hh) * 2) = pack8(v);
    }
    PBAR();
    {
        const int cb = wid;
        GL3 const unsigned char* rp = lds + PL_RV + cb * 4096 + ((lane >> 4) & 1) * 32 + (lane & 3) * 8 + (4 * hi + ((lane & 15) >> 2)) * 64;
        f32x16 d0 = f32x16{}, d1 = f32x16{};
#pragma unroll
        for (int ks = 0; ks < 4; ++ks) {
            const s16x4 lo = vtr(rp + ks * 1024), hh2 = vtr(rp + ks * 1024 + 512);
            const bf16x8 rf = {lo[0], lo[1], lo[2], lo[3], hh2[0], hh2[1], hh2[2], hh2[3]};
            const bf16x8 t1 = *(GL3 const bf16x8*)(lds + PL_TI + ((ks * 64 + 32 + r32) * 16 + 8 * hi) * 2);
            if (cb < 4) {
                if (ks < 2) { const bf16x8 t0 = *(GL3 const bf16x8*)(lds + PL_TI + ((ks * 64 + r32) * 16 + 8 * hi) * 2); d0 = __builtin_amdgcn_mfma_f32_32x32x16_bf16(rf, t0, d0, 0, 0, 0); }
                d1 = __builtin_amdgcn_mfma_f32_32x32x16_bf16(rf, t1, d1, 0, 0, 0);
            } else {
                if (ks < 2) { const bf16x8 t0 = *(GL3 const bf16x8*)(lds + PL_TI + ((ks * 64 + r32) * 16 + 8 * hi) * 2); d0 = __builtin_amdgcn_mfma_f32_32x32x16_bf16(t0, rf, d0, 0, 0, 0); }
                d1 = __builtin_amdgcn_mfma_f32_32x32x16_bf16(t1, rf, d1, 0, 0, 0);
            }
        }
        PBAR();
        if (cb < 4) {
#pragma unroll
            for (int a = 0; a < 4; ++a) {
                u32x2 w0 = {pk(d0[4 * a], d0[4 * a + 1]), pk(d0[4 * a + 2], d0[4 * a + 3])}, w1 = {pk(d1[4 * a], d1[4 * a + 1]), pk(d1[4 * a + 2], d1[4 * a + 3])};
                *(GL3 u32x2*)(lds + PL_WST + ((4 * cb + a) * 64 + r32) * 16 + 8 * hi) = w0;
                *(GL3 u32x2*)(lds + PL_WST + ((4 * cb + a) * 64 + 32 + r32) * 16 + 8 * hi) = w1;
            }
        } else {
            const int dvc = 32 * (cb - 4) + r32;
#pragma unroll
            for (int i = 0; i < 16; ++i) { *(GL3 bf16_t*)(lds + PL_UST + (crow(i, hi) * 128 + dvc) * 2) = f2bf(d0[i]); *(GL3 bf16_t*)(lds + PL_UST + ((32 + crow(i, hi)) * 128 + dvc) * 2) = f2bf(d1[i]); }
        }
    }
    PBAR();
#pragma unroll
    for (int k = 0; k < 2; ++k) {
        const int e = (tid + 512 * k) * 16;
        *(u32x4*)((char*)(GW + (size_t)item * 8192) + e) = *(GL3 const u32x4*)(lds + PL_WST + e);
        *(u32x4*)seg_addr(P, row0, C_DV + h * 128, (unsigned)e) = *(GL3 const u32x4*)(lds + PL_UST + e);
    }
    *(u32x4*)((char*)(GQK + (size_t)item * 4096) + tid * 16) = *(GL3 const u32x4*)(lds + PL_QKST + tid * 16);
    if (tid == 0) GLv[item] = __expf(gc_last);
    PBAR();
}

#undef PBAR
constexpr int SL_W = 0, SL_QD = 16384, SL_KE = 32768, SL_QK = 49152, SL_U = 57344, SL_Z = 73728, SL_S = 90112, SL_VN = 122880, SL_RS = 139264, SL_END = 140416;
__device__ __forceinline__ void glds16(const void* gsrc, unsigned lds_dst) { unsigned keep;
    asm volatile("s_mov_b32 %0, m0\n\ts_mov_b32 m0, %2\n\ts_nop 0\n\tglobal_load_lds_dwordx4 %1, off\n\ts_mov_b32 m0, %0" : "=&s"(keep) : "v"(gsrc), "s"(lds_dst) : "memory"); }
__device__ __forceinline__ unsigned lds_addr(GL3 unsigned char* p) { return (unsigned)(size_t)p; }
__device__ __forceinline__ void dma_seg(GL3 unsigned char* dst, const bf16_t* P, size_t row0, int c0, int wid, int lane) {
#pragma unroll
    for (int k = 0; k < 2; ++k) { const int piece = wid + 8 * k;
        const char* src = (const char*)P + ((row0 + piece * 4 + (lane >> 4)) * LDP + c0) * 2 + (lane & 15) * 16;
        glds16(src, (unsigned)__builtin_amdgcn_readfirstlane((int)(lds_addr(dst) + piece * 1024))); }
}
template <int NPIECES>
__device__ __forceinline__ void dma_lin(GL3 unsigned char* dst, const bf16_t* src, int wid, int lane) {
#pragma unroll
    for (int k = 0; k < NPIECES / 8; ++k) { const int piece = wid + 8 * k;
        glds16((const char*)src + piece * 1024 + lane * 16, (unsigned)__builtin_amdgcn_readfirstlane((int)(lds_addr(dst) + piece * 1024))); }
}

__device__ __forceinline__ float sum32(float v) {
    v += __builtin_bit_cast(float, __builtin_amdgcn_mov_dpp(__builtin_bit_cast(int, v), 0xB1, 0xF, 0xF, true));
    v += __builtin_bit_cast(float, __builtin_amdgcn_mov_dpp(__builtin_bit_cast(int, v), 0x4E, 0xF, 0xF, true));
    v += __builtin_bit_cast(float, __builtin_amdgcn_mov_dpp(__builtin_bit_cast(int, v), 0x141, 0xF, 0xF, true));
    v += __builtin_bit_cast(float, __builtin_amdgcn_mov_dpp(__builtin_bit_cast(int, v), 0x140, 0xF, 0xF, true));
    v += __shfl_xor(v, 16);
    return v;
}
#define GRAWBAR() do { asm volatile("s_waitcnt lgkmcnt(0)" ::: "memory"); __builtin_amdgcn_s_barrier(); asm volatile("" ::: "memory"); } while (0)
#define GWAITV0() asm volatile("s_waitcnt vmcnt(0)" ::: "memory")
constexpr int SL_GL = SL_RS + 1024;
__device__ __forceinline__ void scan_item(GL3 unsigned char* lds, bf16_t* P, const bf16_t* GW, const bf16_t* GQK, const float* GLv, const float* out_norm, int b, int h) {
    const int tid = threadIdx.x, lane = tid & 63, r32 = lane & 31, hi = lane >> 5; const int wid = __builtin_amdgcn_readfirstlane(tid >> 6);
    const int mt = wid >> 2, nt = wid & 3;
    const int dv = 32 * nt + r32;
    const int item0 = (b * DN_H + h) * 32; const size_t rowb = (size_t)b * SEQ;
    f32x16 S0 = f32x16{}, S1 = f32x16{};
    {
        const u32x4 z = {0u, 0u, 0u, 0u};
#pragma unroll
        for (int k = 0; k < 4; ++k) *(GL3 u32x4*)(lds + SL_S + (tid + 512 * k) * 16) = z;
        if (tid < 32) *(GL3 float*)(lds + SL_GL + tid * 4) = GLv[item0 + tid];
    }
    const float gain = out_norm[dv];
    GL3 float* RS = (GL3 float*)(lds + SL_RS);
#define ISSUE_A(n_) do { dma_lin<16>(lds + SL_W, GW + (size_t)(item0 + (n_)) * 8192, wid, lane); dma_seg(lds + SL_QD, P, rowb + 64 * (n_), C_DQ + h * 128, wid, lane); dma_seg(lds + SL_U, P, rowb + 64 * (n_), C_DV + h * 128, wid, lane); } while (0)
#define ISSUE_B(n_) do { dma_seg(lds + SL_KE, P, rowb + 64 * (n_), C_DK + h * 128, wid, lane); dma_lin<8>(lds + SL_QK, GQK + (size_t)(item0 + (n_)) * 4096, wid, lane); dma_seg(lds + SL_Z, P, rowb + 64 * (n_), C_DZ + h * 128, wid, lane); } while (0)
    GWAITV0();
    ISSUE_A(0);
    f32x16 oprev = f32x16{}; unsigned zprev[8] = {0u, 0u, 0u, 0u, 0u, 0u, 0u, 0u};
#define Y_OUT(n_) do { const size_t rowy = rowb + 64 * (n_); _Pragma("unroll") for (int i = 0; i < 16; ++i) { const int tok = 32 * mt + crow(i, hi); \
            const f32x4 rs = *(GL3 const f32x4*)(RS + tok * 4); \
            const float rstd = rsqrtf(((rs[0] + rs[1]) + (rs[2] + rs[3])) * (1.f / 128.f) + EPS); \
            const float z = (i & 1) ? bhi(zprev[i >> 1]) : blo(zprev[i >> 1]); \
            P[(rowy + tok) * LDP + C_DZ + h * 128 + dv] = f2bf(oprev[i] * rstd * gain * fsilu(z)); } } while (0)
    for (int n = 0; n < 32; ++n) {
        GWAITV0(); GRAWBAR();
        ISSUE_B(n);
        if (n > 0) Y_OUT(n - 1);
        const float gl = *(GL3 const float*)(lds + SL_GL + n * 4);
        f32x16 vp = f32x16{}, o = f32x16{};
#pragma unroll
        for (int s = 0; s < 8; ++s) {
            const bf16x8 sb = *(GL3 const bf16x8*)(lds + SL_S + ((2 * s + hi) * 128 + dv) * 16);
            const bf16x8 wa = *(GL3 const bf16x8*)(lds + SL_W + ((2 * s + hi) * 64 + 32 * mt + r32) * 16);
            const bf16x8 qa = *(GL3 const bf16x8*)(lds + SL_QD + ((2 * s + hi) * 64 + 32 * mt + r32) * 16);
            vp = __builtin_amdgcn_mfma_f32_32x32x16_bf16(wa, sb, vp, 0, 0, 0);
            o = __builtin_amdgcn_mfma_f32_32x32x16_bf16(qa, sb, o, 0, 0, 0);
        }
        {
            float v[16];
#pragma unroll
            for (int i = 0; i < 16; ++i) v[i] = bf2f(*(GL3 const bf16_t*)(lds + SL_U + ((32 * mt + crow(i, hi)) * 128 + dv) * 2)) - vp[i];
#pragma unroll
            for (int sp = 0; sp < 2; ++sp) *(GL3 bf16x8*)(lds + SL_VN + (((2 * mt + sp) * 128 + dv) * 16 + 8 * hi) * 2) = pack8(v + 8 * sp);
        }
        GWAITV0(); GRAWBAR();
        if (n + 1 < 32) ISSUE_A(n + 1);
#pragma unroll
        for (int i = 0; i < 16; i += 2) { const unsigned za = *(GL3 const bf16_t*)(lds + SL_Z + ((32 * mt + crow(i, hi)) * 128 + dv) * 2), zb = *(GL3 const bf16_t*)(lds + SL_Z + ((32 * mt + crow(i + 1, hi)) * 128 + dv) * 2); zprev[i >> 1] = za | (zb << 16); }
#pragma unroll
        for (int i = 0; i < 16; ++i) { S0[i] *= gl; S1[i] *= gl; }
        {
            GL3 const unsigned char* kp0 = lds + SL_KE + (2 * mt) * 4096 + ((lane >> 4) & 1) * 32 + (lane & 3) * 8 + (4 * hi + ((lane & 15) >> 2)) * 64;
#pragma unroll
            for (int ks = 0; ks < 4; ++ks) {
                const bf16x8 vb = *(GL3 const bf16x8*)(lds + SL_VN + ((ks * 128 + dv) * 16 + 8 * hi) * 2);
                const s16x4 l0 = vtr(kp0 + ks * 1024), h0 = vtr(kp0 + ks * 1024 + 512), l1 = vtr(kp0 + 4096 + ks * 1024), h1 = vtr(kp0 + 4096 + ks * 1024 + 512);
                const bf16x8 k0 = {l0[0], l0[1], l0[2], l0[3], h0[0], h0[1], h0[2], h0[3]}, k1 = {l1[0], l1[1], l1[2], l1[3], h1[0], h1[1], h1[2], h1[3]};
                const bf16x8 qa = *(GL3 const bf16x8*)(lds + SL_QK + ((ks * 64 + 32 * mt + r32) * 16 + 8 * hi) * 2);
                S0 = __builtin_amdgcn_mfma_f32_32x32x16_bf16(k0, vb, S0, 0, 0, 0);
                S1 = __builtin_amdgcn_mfma_f32_32x32x16_bf16(k1, vb, S1, 0, 0, 0);
                o = __builtin_amdgcn_mfma_f32_32x32x16_bf16(qa, vb, o, 0, 0, 0);
            }
        }
#pragma unroll
        for (int a = 0; a < 4; ++a) {
            u32x2 w0 = {pk(S0[4 * a], S0[4 * a + 1]), pk(S0[4 * a + 2], S0[4 * a + 3])}, w1 = {pk(S1[4 * a], S1[4 * a + 1]), pk(S1[4 * a + 2], S1[4 * a + 3])};
            *(GL3 u32x2*)(lds + SL_S + ((4 * (2 * mt) + a) * 128 + dv) * 16 + 8 * hi) = w0;
            *(GL3 u32x2*)(lds + SL_S + ((4 * (2 * mt + 1) + a) * 128 + dv) * 16 + 8 * hi) = w1;
        }
#pragma unroll
        for (int i = 0; i < 16; ++i) { const float q = sum32(o[i] * o[i]); if (r32 == 0) RS[(32 * mt + crow(i, hi)) * 4 + nt] = q; }
        oprev = o;
    }
    GWAITV0(); GRAWBAR();
    Y_OUT(31);
    GWAITV0();
    __syncthreads();
#undef Y_OUT
#undef ISSUE_A
#undef ISSUE_B
}
}
namespace nsa {
#define NLAS __attribute__((address_space(3)))
typedef short bf16x8 __attribute__((ext_vector_type(8)));
typedef short s16x4 __attribute__((ext_vector_type(4)));
typedef short v4i16_t __attribute__((ext_vector_type(4)));
typedef float f32x16 __attribute__((ext_vector_type(16)));
typedef float f32x4 __attribute__((ext_vector_type(4)));
typedef float f32x2 __attribute__((ext_vector_type(2)));
typedef unsigned u32x4 __attribute__((ext_vector_type(4)));
typedef __bf16 bf16x2_t __attribute__((ext_vector_type(2)));
constexpr float LOG2E = 1.4426950408889634f;
constexpr float NEG = -1e30f;
constexpr int L_KV = 0;
constexpr int L_IMP = 49152;
constexpr int L_SEL = 82944;
constexpr int L_WS = 83456;
constexpr int L_OST = 85504;
constexpr int L_END = 118272;

__device__ __forceinline__ int crow(int i, int hi) { return (i & 3) + 8 * (i >> 2) + 4 * hi; }
__device__ __forceinline__ unsigned pk(float lo, float hi) { f32x2 v = {lo, hi}; bf16x2_t b = __builtin_convertvector(v, bf16x2_t); return __builtin_bit_cast(unsigned, b); }
__device__ __forceinline__ float xhalf_max(float v) { auto rr = __builtin_amdgcn_permlane32_swap(__float_as_uint(v), __float_as_uint(v), false, false); return fmaxf(__uint_as_float(rr[0]), __uint_as_float(rr[1])); }
__device__ __forceinline__ float xhalf_sum(float v) { auto rr = __builtin_amdgcn_permlane32_swap(__float_as_uint(v), __float_as_uint(v), false, false); return __uint_as_float(rr[0]) + __uint_as_float(rr[1]); }

__device__ __forceinline__ void dma_tile(NLAS unsigned char* slot, const bf16_t* Kb, const bf16_t* Vb, unsigned koff, unsigned voff, int wid) {
    __builtin_amdgcn_global_load_lds((const unsigned*)((const char*)Kb + koff), (NLAS unsigned*)(slot + wid * 1024), 16, 0, 0);
    __builtin_amdgcn_global_load_lds((const unsigned*)((const char*)Vb + voff), (NLAS unsigned*)(slot + 8192 + wid * 1024), 16, 0, 0);
}
__device__ __forceinline__ void glds16(const void* gsrc, unsigned lds_dst) { unsigned keep;
    asm volatile("s_mov_b32 %0, m0\n\ts_mov_b32 m0, %2\n\ts_nop 0\n\tglobal_load_lds_dwordx4 %1, off\n\ts_mov_b32 m0, %0" : "=&s"(keep) : "v"(gsrc), "s"(lds_dst) : "memory"); }
__device__ __forceinline__ void dma_tile_a(NLAS unsigned char* slot, const bf16_t* Kb, const bf16_t* Vb, unsigned koff, unsigned voff, int wid) {
    const unsigned base = (unsigned)(size_t)slot + (unsigned)wid * 1024u;
    glds16((const char*)Kb + koff, (unsigned)__builtin_amdgcn_readfirstlane((int)base));
    glds16((const char*)Vb + voff, (unsigned)__builtin_amdgcn_readfirstlane((int)(base + 8192u)));
}
#define RING_WAIT_BAR(N) do { asm volatile("s_waitcnt vmcnt(" #N ") lgkmcnt(0)" ::: "memory"); __builtin_amdgcn_s_barrier(); asm volatile("" ::: "memory"); } while (0)
__device__ __forceinline__ void tile_offs(unsigned& koff, unsigned& voff, int pitch, int wid, int lane) {
    koff = (unsigned)(lane * pitch + wid * 8) * 2u;
    voff = (unsigned)((16 * (wid & 3) + (lane >> 2)) * pitch + (wid >> 2) * 32 + (lane & 3) * 8) * 2u;
}
__device__ __forceinline__ void qkt(f32x16& p0, f32x16& p1, NLAS const unsigned char* Kslot, const bf16x8* qr, const f32x16& c0, const f32x16& c1, int r32, int hi) {
    NLAS const unsigned char* kb = Kslot + hi * 1024 + r32 * 16;
#pragma unroll
    for (int d0 = 0; d0 < 4; ++d0) {
        const bf16x8 b0 = *(NLAS const bf16x8*)(kb + d0 * 2048);
        const bf16x8 b1 = *(NLAS const bf16x8*)(kb + d0 * 2048 + 512);
        if (d0 == 0) { p0 = __builtin_amdgcn_mfma_f32_32x32x16_bf16(b0, qr[0], c0, 0, 0, 0); p1 = __builtin_amdgcn_mfma_f32_32x32x16_bf16(b1, qr[0], c1, 0, 0, 0); }
        else { p0 = __builtin_amdgcn_mfma_f32_32x32x16_bf16(b0, qr[d0], p0, 0, 0, 0); p1 = __builtin_amdgcn_mfma_f32_32x32x16_bf16(b1, qr[d0], p1, 0, 0, 0); }
    }
}
__device__ __forceinline__ s16x4 vtr(NLAS const unsigned char* p) { return __builtin_bit_cast(s16x4, __builtin_amdgcn_ds_read_tr16_b64_v4i16((NLAS v4i16_t*)p)); }
__device__ __forceinline__ void pv(f32x16* o, NLAS const unsigned char* Vslot, const f32x16& p0, const f32x16& p1, int lane, int hi) {
    u32x4 w0 = {pk(p0[0], p0[1]), pk(p0[2], p0[3]), pk(p0[4], p0[5]), pk(p0[6], p0[7])};
    u32x4 w1 = {pk(p0[8], p0[9]), pk(p0[10], p0[11]), pk(p0[12], p0[13]), pk(p0[14], p0[15])};
    u32x4 w2 = {pk(p1[0], p1[1]), pk(p1[2], p1[3]), pk(p1[4], p1[5]), pk(p1[6], p1[7])};
    u32x4 w3 = {pk(p1[8], p1[9]), pk(p1[10], p1[11]), pk(p1[12], p1[13]), pk(p1[14], p1[15])};
    const bf16x8 pa[4] = {__builtin_bit_cast(bf16x8, w0), __builtin_bit_cast(bf16x8, w1), __builtin_bit_cast(bf16x8, w2), __builtin_bit_cast(bf16x8, w3)};
    NLAS const unsigned char* vp = Vslot + ((lane >> 4) & 1) * 32 + (lane & 3) * 8 + (4 * hi + ((lane & 15) >> 2)) * 64;
#pragma unroll
    for (int d0 = 0; d0 < 2; ++d0)
#pragma unroll
        for (int ks = 0; ks < 4; ++ks) {
            const s16x4 lo = vtr(vp + d0 * 4096 + ks * 1024), hh = vtr(vp + d0 * 4096 + ks * 1024 + 512);
            const bf16x8 vf = {lo[0], lo[1], lo[2], lo[3], hh[0], hh[1], hh[2], hh[3]};
            o[d0] = __builtin_amdgcn_mfma_f32_32x32x16_bf16(pa[ks], vf, o[d0], 0, 0, 0);
        }
}
__device__ __forceinline__ void scale_rows(f32x16* o, NLAS float* wsf, float s, int r32, int hi) {
    if (hi == 0) wsf[r32] = s;
#pragma unroll
    for (int i = 0; i < 16; ++i) { const float f = wsf[crow(i, hi)]; o[0][i] *= f; o[1][i] *= f; }
}
__device__ __forceinline__ void acc_rows(f32x16* tot, const f32x16* o, NLAS float* wsf, float s, int r32, int hi) {
    if (hi == 0) wsf[32 + r32] = s;
#pragma unroll
    for (int i = 0; i < 16; ++i) { const float f = wsf[32 + crow(i, hi)]; tot[0][i] += f * o[0][i]; tot[1][i] += f * o[1][i]; }
}
#define MX3(a, b, c) __builtin_fmaxf(__builtin_fmaxf((a), (b)), (c))
__device__ __forceinline__ void softmax_step(f32x16& p0, f32x16& p1, float& m, float& l, f32x16* o, NLAS float* wsf, int r32, int hi) {
    float ta = MX3(p0[0], p0[1], p1[0]), tb = MX3(p0[2], p0[3], p1[1]); ta = MX3(ta, p1[2], p1[3]);
#pragma unroll
    for (int r = 4; r < 16; r += 4) { ta = MX3(ta, p0[r], p0[r + 1]); tb = MX3(tb, p0[r + 2], p0[r + 3]); ta = MX3(ta, p1[r], p1[r + 1]); tb = MX3(tb, p1[r + 2], p1[r + 3]); }
    float t = xhalf_max(fmaxf(ta, tb));
    if (__any(t > 8.f)) {
        const float d = fmaxf(t, 0.f);
        m += d;
#pragma unroll
        for (int i = 0; i < 16; ++i) { p0[i] -= d; p1[i] -= d; }
        const float alpha = __builtin_amdgcn_exp2f(-d);
        l *= alpha;
        scale_rows(o, wsf, alpha, r32, hi);
    }
    float s = 0.f;
#pragma unroll
    for (int i = 0; i < 16; ++i) { p0[i] = __builtin_amdgcn_exp2f(p0[i]); p1[i] = __builtin_amdgcn_exp2f(p1[i]); s += p0[i] + p1[i]; }
    l += s;
}

__device__ __forceinline__ void attn_tile(NLAS unsigned char* lds, bf16_t* P, const bf16_t* KC, const bf16_t* VC, int b, int g, int qt) {
    int tid = threadIdx.x; asm volatile("" : "+v"(tid));
    const int lane = tid & 63, r32 = lane & 31, hi = lane >> 5; const int wid = __builtin_amdgcn_readfirstlane(tid >> 6);
    const int head = g * 4 + (wid >> 1), qh = wid & 1, t0 = qt * 64, qi = qh * 32 + r32, blk_t = qt;
    NLAS float* wsf = (NLAS float*)(lds + L_WS) + wid * 64;
    NLAS float* imp = (NLAS float*)(lds + L_IMP);
    NLAS unsigned* selm = (NLAS unsigned*)(lds + L_SEL);
    NLAS unsigned char* slot0 = lds + L_KV; NLAS unsigned char* slot1 = lds + L_KV + 16384;
    const size_t rowbase = (size_t)b * SEQ;
    bf16_t* qrow = P + (rowbase + t0 + qi) * LDP;
    const float sl2 = exp2f(-0.5f * (float)(head + 1)) * LOG2E;
    bf16x8 qr[4];
#pragma unroll
    for (int d0 = 0; d0 < 4; ++d0) qr[d0] = *(const bf16x8*)(qrow + C_NQ + head * 64 + d0 * 16 + hi * 8);
#define FSIG(x) __builtin_amdgcn_rcpf(1.f + __builtin_amdgcn_exp2f(-LOG2E * (x)))
    const float gate_c = FSIG(bf2f(qrow[C_SG + head * 3 + 0])), gate_s = FSIG(bf2f(qrow[C_SG + head * 3 + 1])), gate_w = FSIG(bf2f(qrow[C_SG + head * 3 + 2]));
#undef FSIG
    f32x16 tot[2]; tot[0] = f32x16{}; tot[1] = f32x16{};
    XSTAMP(30);
#define CRF(i) ((float)(((i) & 3) + 8 * ((i) >> 2)) + 4.f * (float)hiv)
#define OPAQUE_HI() int hiv = hi; asm volatile("" : "+v"(hiv))

    {
        const bf16_t* kcb = KC + ((size_t)(b * NS_G + g) * 128) * 64; const bf16_t* vcb = VC + ((size_t)(b * NS_G + g) * 128) * 64;
        const bool two = (qt >= 16);
        unsigned kof, vof; tile_offs(kof, vof, 64, wid, lane);
        dma_tile(slot0, kcb, vcb, kof, vof, wid);
        if (two) dma_tile(slot1, kcb + 64 * 64, vcb + 64 * 64, kof, vof, wid);
        __syncthreads();
        f32x16 pA0, pA1, pB0, pB1, c0, c1;
        const float s16 = sl2 * 16.f; OPAQUE_HI();
#pragma unroll
        for (int i = 0; i < 16; ++i) { c0[i] = s16 * CRF(i); c1[i] = s16 * (CRF(i) + 32.f); }
        qkt(pA0, pA1, slot0, qr, c0, c1, r32, hi);
        const int cmax = (t0 + qi - 31) >> 4;
        const int qposm = t0 + qi - 31;
#pragma unroll
        for (int i = 0; i < 16; ++i) { const int c = crow(i, hiv); if (16 * c > qposm) pA0[i] = NEG; if (16 * (c + 32) > qposm) pA1[i] = NEG; }
        if (two) {
#pragma unroll
            for (int i = 0; i < 16; ++i) { c0[i] += s16 * 64.f; c1[i] += s16 * 64.f; }
            qkt(pB0, pB1, slot1, qr, c0, c1, r32, hi);
#pragma unroll
            for (int i = 0; i < 16; ++i) { const int c = 64 + crow(i, hiv); if (16 * c > qposm) pB0[i] = NEG; if (16 * (c + 32) > qposm) pB1[i] = NEG; }
        } else { pB0 = f32x16{}; pB1 = f32x16{}; }
        (void)cmax;
        float mx = NEG;
#pragma unroll
        for (int i = 0; i < 16; ++i) mx = fmaxf(mx, fmaxf(pA0[i], pA1[i]));
        if (two) {
#pragma unroll
            for (int i = 0; i < 16; ++i) mx = fmaxf(mx, fmaxf(pB0[i], pB1[i])); }
        mx = xhalf_max(mx);
        float s = 0.f;
#pragma unroll
        for (int i = 0; i < 16; ++i) { pA0[i] = __builtin_amdgcn_exp2f(pA0[i] - mx); pA1[i] = __builtin_amdgcn_exp2f(pA1[i] - mx); s += pA0[i] + pA1[i]; }
        if (two) {
#pragma unroll
            for (int i = 0; i < 16; ++i) { pB0[i] = __builtin_amdgcn_exp2f(pB0[i] - mx); pB1[i] = __builtin_amdgcn_exp2f(pB1[i] - mx); s += pB0[i] + pB1[i]; } }
        s = xhalf_sum(s);
        const float nrm = (t0 + qi >= 31) ? __builtin_amdgcn_rcpf(s) : 0.f;
#pragma unroll
        for (int i = 0; i < 16; ++i) { pA0[i] *= nrm; pA1[i] *= nrm; }
        if (two) {
#pragma unroll
            for (int i = 0; i < 16; ++i) { pB0[i] *= nrm; pB1[i] *= nrm; } }
#define PSEL(L) ((L) < 4 ? pA0 : (L) < 8 ? pA1 : (L) < 12 ? pB0 : pB1)
#define MAINV(L) ((PSEL(L)[4 * ((L) & 3)] + PSEL(L)[4 * ((L) & 3) + 1]) + (PSEL(L)[4 * ((L) & 3) + 2] + 0.5f * PSEL(L)[4 * ((L) & 3) + 3]))
#define CARRY(L) (0.5f * PSEL(L)[4 * ((L) & 3) + 3])
#pragma unroll
        for (int L = 0; L < 16; ++L) {
            const float cprev = (L > 0) ? CARRY(L > 0 ? L - 1 : 0) : 0.f;
            const float snd = hi ? cprev : CARRY(L);
            const float rcv = __shfl_xor(snd, 32);
            imp[((wid >> 1) * 64 + qi) * 33 + 2 * L + hi] = MAINV(L) + rcv;
        }
#undef PSEL
#undef MAINV
#undef CARRY
        f32x16 o[2]; o[0] = f32x16{}; o[1] = f32x16{};
        pv(o, slot0 + 8192, pA0, pA1, lane, hi);
        if (two) pv(o, slot1 + 8192, pB0, pB1, lane, hi);
        acc_rows(tot, o, wsf, gate_c, r32, hi);
    }
    __syncthreads();
    XSTAMP(31);
    {
        const int ql = 8 * wid + (lane >> 3), sub = lane & 7;
        float v[4];
#pragma unroll
        for (int e = 0; e < 4; ++e) { const int j = 4 * sub + e; v[e] = (imp[(0 * 64 + ql) * 33 + j] + imp[(1 * 64 + ql) * 33 + j]) + (imp[(2 * 64 + ql) * 33 + j] + imp[(3 * 64 + ql) * 33 + j]);
            if (j < 1 || j >= blk_t) v[e] = -1.f; }
        unsigned mask = 1u | (1u << blk_t);
#pragma unroll 1
        for (int it = 0; it < 6; ++it) {
            float bv = fmaxf(fmaxf(v[0], v[1]), fmaxf(v[2], v[3]));
            bv = fmaxf(bv, __builtin_bit_cast(float, __builtin_amdgcn_mov_dpp(__builtin_bit_cast(int, bv), 0xB1, 0xF, 0xF, true)));
            bv = fmaxf(bv, __builtin_bit_cast(float, __builtin_amdgcn_mov_dpp(__builtin_bit_cast(int, bv), 0x4E, 0xF, 0xF, true)));
            bv = fmaxf(bv, __builtin_bit_cast(float, __builtin_amdgcn_mov_dpp(__builtin_bit_cast(int, bv), 0x141, 0xF, 0xF, true)));
            int bj = (v[3] == bv) ? 4 * sub + 3 : 64; bj = (v[2] == bv) ? 4 * sub + 2 : bj; bj = (v[1] == bv) ? 4 * sub + 1 : bj; bj = (v[0] == bv) ? 4 * sub : bj;
            bj = min(bj, __builtin_amdgcn_mov_dpp(bj, 0xB1, 0xF, 0xF, true));
            bj = min(bj, __builtin_amdgcn_mov_dpp(bj, 0x4E, 0xF, 0xF, true));
            bj = min(bj, __builtin_amdgcn_mov_dpp(bj, 0x141, 0xF, 0xF, true));
            if (bv >= 0.f) { mask |= 1u << bj;
#pragma unroll
                for (int e = 0; e < 4; ++e) if (4 * sub + e == bj) v[e] = -1.f; }
        }
        if (sub == 0) selm[ql] = mask;
        unsigned any = mask;
        any |= __shfl_xor(any, 8); any |= __shfl_xor(any, 16); any |= __shfl_xor(any, 32);
        if (lane == 0) selm[64 + wid] = any;
    }
    __syncthreads();
    XSTAMP(32);
    const unsigned mymask = selm[qi];
    const unsigned anym = (unsigned)__builtin_amdgcn_readfirstlane((int)((selm[64] | selm[65]) | (selm[66] | selm[67]) | (selm[68] | selm[69]) | (selm[70] | selm[71])));
    unsigned kofP, vofP; tile_offs(kofP, vofP, LDP, wid, lane);
    {
        const bf16_t* kb = P + rowbase * LDP + C_KS + g * 64; const bf16_t* vb = P + rowbase * LDP + C_VS + g * 64;
        unsigned todo = anym;
        float m = 0.f, l = 0.f; f32x16 o[2]; o[0] = f32x16{}; o[1] = f32x16{};
        int j0 = __builtin_ctz(todo); todo &= todo - 1;
        int j1 = todo ? __builtin_ctz(todo) : -1; if (todo) todo &= todo - 1;
        dma_tile_a(lds + L_KV, kb + (size_t)j0 * 64 * LDP, vb + (size_t)j0 * 64 * LDP, kofP, vofP, wid);
        if (j1 >= 0) { dma_tile_a(lds + L_KV + 16384, kb + (size_t)j1 * 64 * LDP, vb + (size_t)j1 * 64 * LDP, kofP, vofP, wid); RING_WAIT_BAR(2); } else RING_WAIT_BAR(0);
        int sl = 0;
#if defined(TPROBE)
        unsigned long long tq_ = 0, ts_ = 0, tp_ = 0, tw_ = 0, tn_ = 0, tc_;
#define TACC(v) do { const unsigned long long now_ = __builtin_amdgcn_s_memrealtime(); v += now_ - tc_; tc_ = now_; } while (0)
        tc_ = __builtin_amdgcn_s_memrealtime();
#else
#define TACC(v) do { } while (0)
#endif
        for (;;) {
            const int j2 = todo ? __builtin_ctz(todo) : -1; if (todo) todo &= todo - 1;
            const int sl2i = (sl >= 1) ? sl - 1 : 2;
            if (j2 >= 0) dma_tile_a(lds + L_KV + sl2i * 16384, kb + (size_t)j2 * 64 * LDP, vb + (size_t)j2 * 64 * LDP, kofP, vofP, wid);
            NLAS unsigned char* sc = lds + L_KV + sl * 16384;
            const int j = j0;
            const bool mine = (mymask >> j) & 1u;
            const bool far = sl2 * (float)(t0 - 64 * j - 63) > 200.f;
            if (__any(mine) && !far) {
                f32x16 p0, p1, c0, c1; const float kb0 = sl2 * (float)(j * 64 - t0) - m; OPAQUE_HI();
#pragma unroll
                for (int i = 0; i < 16; ++i) { c0[i] = kb0 + sl2 * CRF(i); c1[i] = c0[i] + sl2 * 32.f; }
                qkt(p0, p1, sc, qr, c0, c1, r32, hi);
                asm volatile("s_nop 7\n\ts_nop 7" : "+v"(p0), "+v"(p1)); TACC(tq_);
                if (j == blk_t) {
                    asm volatile("" ::: "memory");
#pragma unroll
                    for (int i = 0; i < 16; ++i) { const int kk = crow(i, hiv); if (kk > qi) p0[i] = NEG; if (kk + 32 > qi) p1[i] = NEG; }
                }
                if (__any(!mine)) {
                    asm volatile("" ::: "memory");
                    if (!mine) {
#pragma unroll
                        for (int i = 0; i < 16; ++i) { p0[i] = NEG; p1[i] = NEG; } }
                }
                softmax_step(p0, p1, m, l, o, wsf, r32, hi);
                asm volatile("" : "+v"(p0), "+v"(p1)); TACC(ts_);
                pv(o, sc + 8192, p0, p1, lane, hi);
                asm volatile("s_nop 7\n\ts_nop 7" : "+v"(o[0]), "+v"(o[1])); TACC(tp_);
            }
#if defined(TPROBE)
            tn_ += 100;
#endif
            if (j1 < 0) break;
            if (j2 >= 0) RING_WAIT_BAR(2); else RING_WAIT_BAR(0);
            TACC(tw_);
            j0 = j1; j1 = j2; sl = (sl == 2) ? 0 : sl + 1;
        }
        RING_WAIT_BAR(0);
#if defined(TPROBE)
        if (b == 0 && g == 3 && qt == 24 && threadIdx.x == 0) { volatile unsigned long long* t_ = (volatile unsigned long long*)((char*)P + (size_t)16384 * LDP * 2 + 2048); t_[0] = 0; t_[1] = tq_; t_[2] = ts_; t_[3] = tp_; t_[4] = tw_; t_[5] = tn_; }
#endif
        l = xhalf_sum(l);
        acc_rows(tot, o, wsf, gate_s * __builtin_amdgcn_rcpf(l), r32, hi);
    }
    XSTAMP(33);
    {
        const bf16_t* kb = P + rowbase * LDP + C_KW + g * 64; const bf16_t* vb = P + rowbase * LDP + C_VW + g * 64;
        float m = 0.f, l = 0.f; f32x16 o[2]; o[0] = f32x16{}; o[1] = f32x16{};
        const int jlast = blk_t >= 4 ? blk_t - 4 : 0;
        int j0 = blk_t, j1 = (j0 > jlast) ? j0 - 1 : -1;
        dma_tile_a(lds + L_KV, kb + (size_t)j0 * 64 * LDP, vb + (size_t)j0 * 64 * LDP, kofP, vofP, wid);
        if (j1 >= 0) { dma_tile_a(lds + L_KV + 16384, kb + (size_t)j1 * 64 * LDP, vb + (size_t)j1 * 64 * LDP, kofP, vofP, wid); RING_WAIT_BAR(2); } else RING_WAIT_BAR(0);
        int sl = 0;
        for (;;) {
            const int j2 = (j1 > jlast) ? j1 - 1 : -1;
            const int sl2i = (sl >= 1) ? sl - 1 : 2;
            if (j2 >= 0) dma_tile_a(lds + L_KV + sl2i * 16384, kb + (size_t)j2 * 64 * LDP, vb + (size_t)j2 * 64 * LDP, kofP, vofP, wid);
            NLAS unsigned char* sc = lds + L_KV + sl * 16384;
            const int j = j0;
            {
                f32x16 p0, p1, c0, c1; const float kb0 = sl2 * (float)(j * 64 - t0) - m; OPAQUE_HI();
#pragma unroll
                for (int i = 0; i < 16; ++i) { c0[i] = kb0 + sl2 * CRF(i); c1[i] = c0[i] + sl2 * 32.f; }
                qkt(p0, p1, sc, qr, c0, c1, r32, hi);
                if (j == blk_t || j == blk_t - 4) {
                    asm volatile("" ::: "memory");
                    const int dq = t0 + qi - j * 64;
#pragma unroll
                    for (int i = 0; i < 16; ++i) { const int d0_ = dq - crow(i, hiv), d1_ = d0_ - 32; if (d0_ < 0 || d0_ > 255) p0[i] = NEG; if (d1_ < 0 || d1_ > 255) p1[i] = NEG; }
                }
                softmax_step(p0, p1, m, l, o, wsf, r32, hi);
                pv(o, sc + 8192, p0, p1, lane, hi);
            }
            if (j1 < 0) break;
            if (j2 >= 0) RING_WAIT_BAR(2); else RING_WAIT_BAR(0);
            j0 = j1; j1 = j2; sl = (sl == 2) ? 0 : sl + 1;
        }
        RING_WAIT_BAR(0);
        l = xhalf_sum(l);
        acc_rows(tot, o, wsf, gate_w * __builtin_amdgcn_rcpf(l), r32, hi);
    }
    XSTAMP(34);
    {
        NLAS bf16_t* stg = (NLAS bf16_t*)(lds + L_OST) + wid * 2048;
#pragma unroll
        for (int i = 0; i < 16; ++i) { const int orow = crow(i, hi); stg[orow * 64 + r32] = f2bf(tot[0][i]); stg[orow * 64 + 32 + r32] = f2bf(tot[1][i]); }
        bf16_t* ow = P + (rowbase + t0 + qh * 32) * LDP + C_NQ + head * 64;
#pragma unroll
        for (int i = 0; i < 4; ++i) { const int row = i * 8 + (lane >> 3), ch = lane & 7; const u32x4 v = *(NLAS const u32x4*)(stg + row * 64 + ch * 8); *(u32x4*)((char*)ow + (unsigned)(row * LDP + ch * 8) * 2u) = v; }
    }
    __syncthreads();
    XSTAMP(35);
#if defined(TPROBE)
    if (blockIdx.x == 0 && threadIdx.x == 0) { volatile __attribute__((address_space(3))) unsigned long long* ts_ = (volatile __attribute__((address_space(3))) unsigned long long*)(lds + 147456 - 512); ts_[36] = ts_[30] + 100ull * (unsigned)qt; }
#endif
#undef CRF
#undef OPAQUE_HI
}

__device__ __forceinline__ void norm8(u32x4& v, const float* g8, float sc) {
    float x[8] = {__uint_as_float(v.x << 16), __uint_as_float(v.x & 0xffff0000u), __uint_as_float(v.y << 16), __uint_as_float(v.y & 0xffff0000u),
                  __uint_as_float(v.z << 16), __uint_as_float(v.z & 0xffff0000u), __uint_as_float(v.w << 16), __uint_as_float(v.w & 0xffff0000u)};
    float s = 0.f;
#pragma unroll
    for (int e = 0; e < 8; ++e) s += x[e] * x[e];
    s += __shfl_xor(s, 1); s += __shfl_xor(s, 2); s += __shfl_xor(s, 4);
    const float r = rsqrtf(s * (1.f / 64.f) + EPS) * sc;
    v.x = pk(x[0] * r * g8[0], x[1] * r * g8[1]); v.y = pk(x[2] * r * g8[2], x[3] * r * g8[3]); v.z = pk(x[4] * r * g8[4], x[5] * r * g8[5]); v.w = pk(x[6] * r * g8[6], x[7] * r * g8[7]);
}
__device__ __forceinline__ void prep_units(bf16_t* P, const float* qn, const float* kns, const float* knw, int gw, int NGW, int lane) {
    float gq[8], gk[8];
    const float* kg = (lane < 32) ? kns : knw;
#pragma unroll
    for (int e = 0; e < 8; ++e) { gq[e] = qn[8 * (lane & 7) + e]; gk[e] = kg[8 * (lane & 7) + e]; }
    const int coff = (lane < 32) ? C_KS + 8 * lane : C_KW + 8 * (lane - 32);
    for (int m0 = gw; m0 < M; m0 += 2 * NGW) {
        const int m1 = m0 + NGW; const bool two = m1 < M;
        bf16_t* r0 = P + (size_t)m0 * LDP; bf16_t* r1 = P + (size_t)(two ? m1 : m0) * LDP;
        u32x4 a0 = *(const u32x4*)(r0 + C_NQ + 8 * lane), b0 = *(const u32x4*)(r0 + C_NQ + 512 + 8 * lane), c0 = *(const u32x4*)(r0 + coff);
        u32x4 a1 = *(const u32x4*)(r1 + C_NQ + 8 * lane), b1 = *(const u32x4*)(r1 + C_NQ + 512 + 8 * lane), c1 = *(const u32x4*)(r1 + coff);
        norm8(a0, gq, 0.125f * LOG2E); norm8(b0, gq, 0.125f * LOG2E); norm8(c0, gk, 1.f);
        norm8(a1, gq, 0.125f * LOG2E); norm8(b1, gq, 0.125f * LOG2E); norm8(c1, gk, 1.f);
        *(u32x4*)(r0 + C_NQ + 8 * lane) = a0; *(u32x4*)(r0 + C_NQ + 512 + 8 * lane) = b0; *(u32x4*)(r0 + coff) = c0;
        if (two) { *(u32x4*)(r1 + C_NQ + 8 * lane) = a1; *(u32x4*)(r1 + C_NQ + 512 + 8 * lane) = b1; *(u32x4*)(r1 + coff) = c1; }
    }
}

constexpr int LC_A = 0, LC_B = 16384, LC_HID = 49152, LC_W2 = 83968;
__device__ __forceinline__ void compress_item(NLAS unsigned char* lds, const bf16_t* P, const bf16_t* W1T, const float* bias1, const float* W2, const float* gain, bf16_t* OUT, int b, int g, int which, int half) {
    const int tid = threadIdx.x, lane = tid & 63, r32 = lane & 31, hi = lane >> 5; const int wid = __builtin_amdgcn_readfirstlane(tid >> 6);
    const int mt = wid >> 2, nt = wid & 3;
    const int ca = tid >> 3, dca = tid & 7; const int cg_ = 64 * half + ca; const int ccl = cg_ < NCMP ? cg_ : NCMP - 1;
    const bf16_t* asrc = P + ((size_t)b * SEQ + 16 * ccl) * LDP + (which ? C_VC : C_KC) + g * 64 + dca * 8;
    const bf16_t* bsrc0 = W1T + (size_t)(tid >> 3) * 2048 + (tid & 7) * 8; const bf16_t* bsrc1 = bsrc0 + (size_t)64 * 2048;
    const int adst = (dca * 64 + ca) * 16, bdst0 = ((tid & 7) * 128 + (tid >> 3)) * 16, bdst1 = bdst0 + 64 * 16;
#define CBAR() do { asm volatile("s_waitcnt lgkmcnt(0)" ::: "memory"); __builtin_amdgcn_s_barrier(); asm volatile("" ::: "memory"); } while (0)
#define CLOAD(ra_, rb0_, rb1_, l_) do { ra_ = *(const u32x4*)(asrc + (size_t)(l_) * LDP); rb0_ = *(const u32x4*)(bsrc0 + (l_) * 64); rb1_ = *(const u32x4*)(bsrc1 + (l_) * 64); } while (0)
#define CSTORE(ra_, rb0_, rb1_, buf_) do { *(NLAS u32x4*)(lds + LC_A + (buf_) * 8192 + adst) = ra_; *(NLAS u32x4*)(lds + LC_B + (buf_) * 16384 + bdst0) = rb0_; *(NLAS u32x4*)(lds + LC_B + (buf_) * 16384 + bdst1) = rb1_; } while (0)
#define CMMA(buf_) do { NLAS const unsigned char* ab = lds + LC_A + (buf_) * 8192; NLAS const unsigned char* bb = lds + LC_B + (buf_) * 16384; \
        _Pragma("unroll") for (int ds = 0; ds < 4; ++ds) { \
            const bf16x8 a = *(NLAS const bf16x8*)(ab + ((2 * ds + hi) * 64 + 32 * mt + r32) * 16); \
            const bf16x8 w = *(NLAS const bf16x8*)(bb + ((2 * ds + hi) * 128 + 32 * nt + r32) * 16); \
            acc = __builtin_amdgcn_mfma_f32_32x32x16_bf16(a, w, acc, 0, 0, 0); } } while (0)
    {
#pragma unroll
        for (int k = 0; k < 4; ++k) *(NLAS f32x4*)(lds + LC_W2 + (tid + 512 * k) * 16) = *(const f32x4*)(W2 + (tid + 512 * k) * 4);
    }
    u32x4 xa, xb0, xb1, ya, yb0, yb1;
    CLOAD(xa, xb0, xb1, 0); CSTORE(xa, xb0, xb1, 0);
    CLOAD(xa, xb0, xb1, 1); CLOAD(ya, yb0, yb1, 2);
    CBAR();
    f32x16 acc = f32x16{};
    for (int l = 0; l < 32; l += 2) {
        CMMA(0); CSTORE(xa, xb0, xb1, 1); if (l + 3 < 32) CLOAD(xa, xb0, xb1, l + 3); CBAR();
        CMMA(1); if (l + 2 < 32) { CSTORE(ya, yb0, yb1, 0); if (l + 4 < 32) CLOAD(ya, yb0, yb1, l + 4); } CBAR();
    }
#undef CBAR
#undef CLOAD
#undef CSTORE
#undef CMMA
    NLAS float* hid = (NLAS float*)(lds + LC_HID);
    const float bs = bias1[32 * nt + r32];
#pragma unroll
    for (int i = 0; i < 16; ++i) hid[(32 * mt + crow(i, hi)) * 132 + 32 * nt + r32] = gelu_tanh(acc[i] + bs);
    __syncthreads();
    {
        const int row = tid >> 3, e0 = (tid & 7) * 8;
        float o[8];
#pragma unroll
        for (int e = 0; e < 8; ++e) o[e] = 0.f;
#pragma unroll 8
        for (int i = 0; i < 128; ++i) { const float h = hid[row * 132 + i]; const f32x4 wa = *(NLAS const f32x4*)(lds + LC_W2 + (i * 64 + e0) * 4), wb = *(NLAS const f32x4*)(lds + LC_W2 + (i * 64 + e0 + 4) * 4);
            o[0] += h * wa[0]; o[1] += h * wa[1]; o[2] += h * wa[2]; o[3] += h * wa[3]; o[4] += h * wb[0]; o[5] += h * wb[1]; o[6] += h * wb[2]; o[7] += h * wb[3]; }
        if (which == 0) {
            float ss = 0.f;
#pragma unroll
            for (int e = 0; e < 8; ++e) ss += o[e] * o[e];
            ss += __shfl_xor(ss, 1); ss += __shfl_xor(ss, 2); ss += __shfl_xor(ss, 4);
            const float r = rsqrtf(ss * (1.f / 64.f) + EPS);
#pragma unroll
            for (int e = 0; e < 8; ++e) o[e] *= r * gain[e0 + e];
        }
        const int cg = 64 * half + row;
        if (cg >= NCMP) {
#pragma unroll
            for (int e = 0; e < 8; ++e) o[e] = 0.f; }
        u32x4 w; w.x = pk(o[0], o[1]); w.y = pk(o[2], o[3]); w.z = pk(o[4], o[5]); w.w = pk(o[6], o[7]);
        *(u32x4*)(OUT + (((size_t)(b * NS_G + g) * 128) + cg) * 64 + e0) = w;
    }
    __syncthreads();
}
}
namespace pg8 {
#define PG8_LAS __attribute__((address_space(3)))
typedef short bf16x8 __attribute__((ext_vector_type(8)));
typedef float f32x4 __attribute__((ext_vector_type(4)));
typedef float f32x2 __attribute__((ext_vector_type(2)));
typedef unsigned u32x4 __attribute__((ext_vector_type(4)));
typedef unsigned u32x2 __attribute__((ext_vector_type(2)));
constexpr int BM = 256, BK = 64, HALF = 128, HTB = HALF * BK * 2, STAGE_BYTES = 8 * HTB, NXCD = 8, WGM = 8;

__host__ __device__ __forceinline__ int lds_byte(int r, int c) { const int st = (r >> 4) * 2 + (c >> 5), rr = r & 15, cc = c & 31, ob = rr * 64 + cc * 2; return st * 1024 + (ob ^ (((ob >> 9) & 1) << 5)); }
__host__ __device__ __forceinline__ void stage_rc(int b, int& R, int& C) { const int st = b / 1024, sb = b % 1024, swz = sb ^ (((sb >> 9) & 1) << 5); R = (st >> 1) * 16 + swz / 64; C = (st & 1) * 32 + (swz % 64) / 2; }
__host__ __device__ __forceinline__ int perm32(int rho) { const int n = rho >> 4, i = rho & 15; return 8 * (i >> 2) + 4 * n + (i & 3); }

struct Unit { int pm, pn, ks; };
struct Gemm { const bf16_t* A; const bf16_t* Bt; int lda, ldb; int M, N, K; int ksoff; };

struct StaticOrder {
    int nM, nN, nwg, G, c;
    __host__ __device__ void init(int M_, int N_, int G_, int c_) { nM = M_ / BM; nN = N_ / BM; nwg = nM * nN; G = G_; c = c_; }
    __host__ __device__ bool next(int i, Unit& u) const {
        const long L = (long)i * G + c; if (L >= nwg) return false;
        int wgid = (int)L; { const int q = nwg / NXCD, r = nwg % NXCD, xcd = wgid % NXCD, off = wgid / NXCD; wgid = (xcd < r ? xcd * (q + 1) : r * (q + 1) + (xcd - r) * q) + off; }
        const int nig = WGM * nN, gid = wgid / nig, fm = gid * WGM, gsz = (nM - fm) < WGM ? (nM - fm) : WGM;
        u.pm = fm + ((wgid % nig) % gsz); u.pn = (wgid % nig) / gsz; u.ks = 0; return true;
    }
};
struct TwoPassOrder {
    StaticOrder base;
    __host__ __device__ bool next(int i, Unit& u) const { if (!base.next(i >> 1, u)) return false; u.ks = i & 1; return true; }
};

typedef __bf16 bf16x2_t __attribute__((ext_vector_type(2)));
__device__ __forceinline__ unsigned cvt_pk_bf16(float lo, float hi) { f32x2 v = {lo, hi}; bf16x2_t b = __builtin_convertvector(v, bf16x2_t); return __builtin_bit_cast(unsigned, b); }
__device__ __forceinline__ float fast_sigmoid(float x) { return __builtin_amdgcn_rcpf(1.f + __builtin_amdgcn_exp2f(-1.4426950408889634f * x)); }
__device__ __forceinline__ float bflo(unsigned w) { return __uint_as_float(w << 16); }
__device__ __forceinline__ float bfhi(unsigned w) { return __uint_as_float(w & 0xffff0000u); }

typedef f32x4 Acc[2][2][4][2];

template <int ACT> struct EpiP {
    static constexpr bool PERM = true;
    bf16_t* O; int ldc; int pn_last; int ncol_last; bf16_t* halo;
    __device__ __forceinline__ void operator()(const Acc& acc, const Unit& u, int wr, int wc, int fr, int fq) const {
        const int row0 = u.pm * BM + wr * 64 + fr, tcol = wc * 32 + 8 * fq;
        const int lim = (u.pn == pn_last) ? ncol_last : 256;
#pragma unroll
        for (int ai = 0; ai < 2; ++ai)
#pragma unroll
            for (int m = 0; m < 4; ++m) { bf16_t* rowp = O + (size_t)(row0 + ai * HALF + m * 16) * ldc + u.pn * BM + tcol;
#pragma unroll
                for (int bj = 0; bj < 2; ++bj) { if (tcol + bj * HALF >= lim) continue;
                    f32x4 v0 = acc[ai][bj][m][0], v1 = acc[ai][bj][m][1];
                    if (ACT == 1) {
#pragma unroll
                        for (int e = 0; e < 4; ++e) { v0[e] = fast_sigmoid(v0[e]); v1[e] = fast_sigmoid(v1[e]); } }
                    u32x4 w; w.x = cvt_pk_bf16(v0[0], v0[1]); w.y = cvt_pk_bf16(v0[2], v0[3]); w.z = cvt_pk_bf16(v1[0], v1[1]); w.w = cvt_pk_bf16(v1[2], v1[3]);
                    *(u32x4*)(rowp + bj * HALF) = w;
                    if (ACT == 0 && m == 3 && fr >= 13 && u.pn < 12 && halo) { const int row = row0 + ai * HALF + 48;
                        *(u32x4*)(halo + ((size_t)(row >> 6) * 3 + (fr - 13)) * 3072 + u.pn * BM + tcol + bj * HALF) = w; } } }
    }
};
struct EpiMix {
    static constexpr bool PERM = true;
    const bf16_t* G; int ldg; bf16_t* O; int ldc;
    __device__ __forceinline__ void operator()(const Acc& acc, const Unit& u, int wr, int wc, int fr, int fq) const {
        const int row0 = u.pm * BM + wr * 64 + fr, col0 = u.pn * BM + wc * 32 + 8 * fq;
#pragma unroll
        for (int ai = 0; ai < 2; ++ai)
#pragma unroll
            for (int m = 0; m < 4; ++m) { const size_t row = (size_t)(row0 + ai * HALF + m * 16); const bf16_t* gp = G + row * ldg + col0 + u.ks * 1024; bf16_t* rowp = O + row * ldc + col0;
#pragma unroll
                for (int bj = 0; bj < 2; ++bj) { const u32x4 b = *(const u32x4*)(gp + bj * HALF);
                    f32x4 v0 = acc[ai][bj][m][0], v1 = acc[ai][bj][m][1];
                    v0[0] *= bflo(b.x); v0[1] *= bfhi(b.x); v0[2] *= bflo(b.y); v0[3] *= bfhi(b.y); v1[0] *= bflo(b.z); v1[1] *= bfhi(b.z); v1[2] *= bflo(b.w); v1[3] *= bfhi(b.w);
                    if (u.ks) { const u32x4 p = *(const u32x4*)(rowp + bj * HALF);
                        v0[0] += bflo(p.x); v0[1] += bfhi(p.x); v0[2] += bflo(p.y); v0[3] += bfhi(p.y); v1[0] += bflo(p.z); v1[1] += bfhi(p.z); v1[2] += bflo(p.w); v1[3] += bfhi(p.w); }
                    u32x4 w; w.x = cvt_pk_bf16(v0[0], v0[1]); w.y = cvt_pk_bf16(v0[2], v0[3]); w.z = cvt_pk_bf16(v1[0], v1[1]); w.w = cvt_pk_bf16(v1[2], v1[3]);
                    *(u32x4*)(rowp + bj * HALF) = w; } }
    }
};
struct EpiOut {
    static constexpr bool PERM = false;
    const float* X; float* X1; bf16_t* An; const float* gain; float* pss;
    __device__ __forceinline__ void operator()(const Acc& acc, const Unit& u, int wr, int wc, int fr, int fq) const {
        const int row0 = u.pm * BM + wr * 64 + fr, col0 = u.pn * BM + wc * 32 + 4 * fq;
        f32x4 gv[2][2];
#pragma unroll
        for (int bj = 0; bj < 2; ++bj)
#pragma unroll
            for (int n = 0; n < 2; ++n) gv[bj][n] = *(const f32x4*)(gain + col0 + bj * HALF + n * 16);
#pragma unroll
        for (int ai = 0; ai < 2; ++ai)
#pragma unroll
            for (int m = 0; m < 4; ++m) { const size_t row = (size_t)(row0 + ai * HALF + m * 16); const size_t off = row * D + col0; float ss = 0.f;
#pragma unroll
                for (int bj = 0; bj < 2; ++bj)
#pragma unroll
                    for (int n = 0; n < 2; ++n) { const f32x4 x1 = *(const f32x4*)(X + off + bj * HALF + n * 16) + acc[ai][bj][m][n];
                        *(f32x4*)(X1 + off + bj * HALF + n * 16) = x1; ss += (x1[0] * x1[0] + x1[1] * x1[1]) + (x1[2] * x1[2] + x1[3] * x1[3]);
                        const f32x4 y = x1 * gv[bj][n]; u32x2 w; w.x = cvt_pk_bf16(y[0], y[1]); w.y = cvt_pk_bf16(y[2], y[3]); *(u32x2*)(An + off + bj * HALF + n * 16) = w; }
                ss += __shfl_xor(ss, 16); ss += __shfl_xor(ss, 32);
                if (fq == 0) pss[row * 16 + u.pn * 4 + wc] = ss; }
    }
};
struct EpiUp {
    static constexpr bool PERM = true;
    const float* pss; bf16_t* O; int ldc;
    __device__ __forceinline__ void operator()(const Acc& acc, const Unit& u, int wr, int wc, int fr, int fq) const {
        const int row0 = u.pm * BM + wr * 64 + fr, col0 = u.pn * BM + wc * 32 + 8 * fq;
#pragma unroll
        for (int ai = 0; ai < 2; ++ai)
#pragma unroll
            for (int m = 0; m < 4; ++m) { const size_t row = (size_t)(row0 + ai * HALF + m * 16);
                const f32x4* pp = (const f32x4*)(pss + row * 16); const f32x4 s4 = (pp[0] + pp[1]) + (pp[2] + pp[3]);
                const float rstd = rsqrtf(((s4[0] + s4[1]) + (s4[2] + s4[3])) * (1.f / D) + EPS);
                bf16_t* rowp = O + row * ldc + col0;
#pragma unroll
                for (int bj = 0; bj < 2; ++bj) { f32x4 v0 = acc[ai][bj][m][0] * rstd, v1 = acc[ai][bj][m][1] * rstd;
#pragma unroll
                    for (int e = 0; e < 4; ++e) { const float a = fmaxf(v0[e], 0.f), b = fmaxf(v1[e], 0.f); v0[e] = a * a; v1[e] = b * b; }
                    u32x4 w; w.x = cvt_pk_bf16(v0[0], v0[1]); w.y = cvt_pk_bf16(v0[2], v0[3]); w.z = cvt_pk_bf16(v1[0], v1[1]); w.w = cvt_pk_bf16(v1[2], v1[3]);
                    *(u32x4*)(rowp + bj * HALF) = w; } }
    }
};
struct EpiDown {
    static constexpr bool PERM = false;
    float* X1;
    __device__ __forceinline__ void operator()(const Acc& acc, const Unit& u, int wr, int wc, int fr, int fq) const {
        const int row0 = u.pm * BM + wr * 64 + fr, col0 = u.pn * BM + wc * 32 + 4 * fq;
#pragma unroll
        for (int ai = 0; ai < 2; ++ai)
#pragma unroll
            for (int m = 0; m < 4; ++m) { float* rowp = X1 + (size_t)(row0 + ai * HALF + m * 16) * D + col0;
#pragma unroll
                for (int bj = 0; bj < 2; ++bj)
#pragma unroll
                    for (int n = 0; n < 2; ++n) { f32x4* p = (f32x4*)(rowp + bj * HALF + n * 16); *p = *p + acc[ai][bj][m][n]; } }
    }
};

template <class Epi, class Sched, bool ALIGN_EPI>
__device__ __forceinline__ void gemm_phase(PG8_LAS unsigned char* lds, const Gemm g, const Sched& S, const Epi& E) {
    const int tid = threadIdx.x, wid = __builtin_amdgcn_readfirstlane(tid >> 6), lane = tid & 63, wr = wid >> 2, wc = wid & 3, fr = lane & 15, fq = lane >> 4;
    const int K = g.K, nt = K / BK, lda = g.lda, ldb = g.ldb;
    unsigned voffA[2], voffB[2];
#pragma unroll
    for (int i = 0; i < 2; ++i) { int R, C; stage_rc(tid * 16 + i * 8192, R, C); const int Rb = Epi::PERM ? ((R & ~31) + perm32(R & 31)) : R;
        voffA[i] = (unsigned)(R * lda + C) * 2u; voffB[i] = (unsigned)(Rb * ldb + C) * 2u; }
    const size_t kstep = (size_t)(BK * 2);
    const size_t hstepA = (size_t)HALF * lda * 2, hstepB = (size_t)HALF * ldb * 2;
    const size_t tstepA = 2 * hstepA, tstepB = 2 * hstepB;
    const unsigned ldsw = (unsigned)wid * 1024u;
    const int aoff = lds_byte(wr * 64 + fr, fq * 8), boff = lds_byte(wc * 32 + fr, fq * 8);
#define PG8_SA(b, h) (((b) * 2 + (h)) * HTB)
#define PG8_SB(b, h) ((4 + (b) * 2 + (h)) * HTB)
#define PG8_STAGE(bufoff, gbase, voff) do { _Pragma("unroll") for (int _i = 0; _i < 2; ++_i) \
        __builtin_amdgcn_global_load_lds((const unsigned*)((const char*)(gbase) + (voff)[_i]), (PG8_LAS unsigned*)(lds + (bufoff) + ldsw + _i * 8192), 16, 0, 0); } while (0)
#define PG8_LDA(dst, b, h) do { _Pragma("unroll") for (int m = 0; m < 4; ++m) _Pragma("unroll") for (int k = 0; k < 2; ++k) dst[m][k] = *(const PG8_LAS bf16x8*)(lds + PG8_SA(b, h) + aoff + m * 2048 + k * 1024); } while (0)
#define PG8_LDB(dst, b, h) do { _Pragma("unroll") for (int n = 0; n < 2; ++n) _Pragma("unroll") for (int k = 0; k < 2; ++k) dst[n][k] = *(const PG8_LAS bf16x8*)(lds + PG8_SB(b, h) + boff + n * 2048 + k * 1024); } while (0)
#define PG8_MMA(ai, bj, At, Bt) do { __builtin_amdgcn_s_setprio(1); _Pragma("unroll") for (int m = 0; m < 4; ++m) _Pragma("unroll") for (int n = 0; n < 2; ++n) _Pragma("unroll") for (int k = 0; k < 2; ++k) \
        acc[ai][bj][m][n] = __builtin_amdgcn_mfma_f32_16x16x32_bf16(Bt[n][k], At[m][k], acc[ai][bj][m][n], 0, 0, 0); __builtin_amdgcn_s_setprio(0); } while (0)
#define PG8_WAIT_V(n) asm volatile("s_waitcnt vmcnt(" #n ")" ::: "memory")
#define PG8_WAIT_L(n) asm volatile("s_waitcnt lgkmcnt(" #n ")" ::: "memory")
#define PG8_BAR __builtin_amdgcn_s_barrier()
#define PG8_SCHED __builtin_amdgcn_sched_barrier(0)
#define PG8_KBODY(t) do { \
            const bool last = (t == nt - 2); \
            const char* a1 = cA + (size_t)(t + 1) * kstep; \
            const char* a2 = last ? nA : cA + (size_t)(t + 2) * kstep; const char* b2 = last ? nB : cB + (size_t)(t + 2) * kstep; \
            const char* a3 = a2 + kstep; const char* b3 = b2 + kstep; \
            PG8_LDB(B0, 0, 0); PG8_LDB(B1, 0, 1); PG8_SCHED; PG8_LDA(At, 0, 0); PG8_STAGE(PG8_SA(1, 1), a1 + hstepA, voffA); \
            PG8_WAIT_V(8); PG8_WAIT_L(0); PG8_BAR; PG8_MMA(0, 0, At, B0); PG8_MMA(0, 1, At, B1); PG8_BAR; PG8_SCHED; \
            PG8_LDA(At, 0, 1); PG8_STAGE(PG8_SB(0, 0), b2, voffB); PG8_STAGE(PG8_SB(0, 1), b2 + hstepB, voffB); PG8_STAGE(PG8_SA(0, 0), a2, voffA); \
            PG8_WAIT_V(8); PG8_WAIT_L(0); PG8_BAR; PG8_MMA(1, 0, At, B0); PG8_MMA(1, 1, At, B1); PG8_BAR; PG8_SCHED; \
            PG8_LDB(B0, 1, 0); PG8_LDB(B1, 1, 1); PG8_SCHED; PG8_LDA(At, 1, 0); PG8_STAGE(PG8_SA(0, 1), a2 + hstepA, voffA); \
            PG8_WAIT_V(8); PG8_WAIT_L(0); PG8_BAR; PG8_MMA(0, 0, At, B0); PG8_MMA(0, 1, At, B1); PG8_BAR; PG8_SCHED; \
            PG8_LDA(At, 1, 1); PG8_STAGE(PG8_SB(1, 0), b3, voffB); PG8_STAGE(PG8_SB(1, 1), b3 + hstepB, voffB); PG8_STAGE(PG8_SA(1, 0), a3, voffA); \
            PG8_WAIT_V(8); PG8_WAIT_L(0); PG8_BAR; PG8_MMA(1, 0, At, B0); PG8_MMA(1, 1, At, B1); PG8_BAR; PG8_SCHED; \
        } while (0)
    Unit cur, nxt; int ui = 0;
    if (!S.next(0, cur)) return;
    Acc acc;
#pragma unroll
    for (int a = 0; a < 2; ++a)
#pragma unroll
        for (int b = 0; b < 2; ++b)
#pragma unroll
            for (int m = 0; m < 4; ++m)
#pragma unroll
                for (int n = 0; n < 2; ++n) acc[a][b][m][n] = (f32x4){0.f, 0.f, 0.f, 0.f};
    bf16x8 At[4][2], B0[2][2], B1[2][2];
    const char* cA = (const char*)g.A + (size_t)cur.pm * tstepA + (size_t)cur.ks * g.ksoff * 2; const char* cB = (const char*)g.Bt + (size_t)cur.pn * tstepB + (size_t)cur.ks * g.ksoff * 2;
    PG8_STAGE(PG8_SB(0, 0), cB, voffB); PG8_STAGE(PG8_SB(0, 1), cB + hstepB, voffB); PG8_STAGE(PG8_SA(0, 0), cA, voffA); PG8_STAGE(PG8_SA(0, 1), cA + hstepA, voffA);
    if (wr == 1) PG8_BAR;
    PG8_WAIT_V(2); PG8_BAR;
    PG8_STAGE(PG8_SB(1, 0), cB + kstep, voffB); PG8_STAGE(PG8_SA(1, 0), cA + kstep, voffA); PG8_STAGE(PG8_SB(1, 1), cB + hstepB + kstep, voffB);
    PG8_WAIT_V(6); PG8_BAR;
    for (;;) {
        const bool has_next = S.next(ui + 1, nxt);
        const char* nA = has_next ? (const char*)g.A + (size_t)nxt.pm * tstepA + (size_t)nxt.ks * g.ksoff * 2 : cA; const char* nB = has_next ? (const char*)g.Bt + (size_t)nxt.pn * tstepB + (size_t)nxt.ks * g.ksoff * 2 : cB;
        for (int t = 0; t < nt; t += 2) PG8_KBODY(t);
        if constexpr (ALIGN_EPI) { if (wr == 0) PG8_BAR; }
        E(acc, cur, wr, wc, fr, fq);
        if (!has_next) break;
#pragma unroll
        for (int a = 0; a < 2; ++a)
#pragma unroll
            for (int b = 0; b < 2; ++b)
#pragma unroll
                for (int m = 0; m < 4; ++m)
#pragma unroll
                    for (int n = 0; n < 2; ++n) acc[a][b][m][n] = (f32x4){0.f, 0.f, 0.f, 0.f};
        cur = nxt; cA = nA; cB = nB; ++ui;
        if constexpr (ALIGN_EPI) { if (wr == 1) PG8_BAR; }
    }
    PG8_WAIT_V(0);
    if constexpr (!ALIGN_EPI) { if (wr == 0) PG8_BAR; }
    PG8_BAR;
#undef PG8_SA
#undef PG8_SB
#undef PG8_STAGE
#undef PG8_LDA
#undef PG8_LDB
#undef PG8_MMA
#undef PG8_WAIT_V
#undef PG8_WAIT_L
#undef PG8_BAR
#undef PG8_SCHED
#undef PG8_KBODY
}
}

#define GAS __attribute__((address_space(1)))
#define LAS __attribute__((address_space(3)))
typedef unsigned v4u __attribute__((ext_vector_type(4)));
typedef float f32x4 __attribute__((ext_vector_type(4)));
constexpr int NWAVES = 8;
constexpr int LDS_BYTES = 147456;
constexpr size_t MiB = 1u << 20;
constexpr size_t WS_PSS = 1 * MiB, WS_WOUT = 2 * MiB, WS_P = 4 * MiB, WS_KC = 214 * MiB, WS_VC = 215 * MiB, WS_MIX = 216 * MiB;
constexpr size_t WS_AN = 4 * MiB, WS_UP = 64 * MiB, WS_WUP = 248 * MiB, WS_WDOWN = 200 * MiB;
constexpr size_t WS_BIAS1 = 131072 + 16384, WS_W1T = 214 * MiB, WS_KCB = 215 * MiB, WS_VCB = 215 * MiB + 512 * 1024;
constexpr size_t WS_GLV = 4096, WS_QCNT = 65536, WS_GW = 216 * MiB, DO_GQK = 40 * MiB, DO_HALO = 56 * MiB;
constexpr size_t WS_XBAR = 131072;
constexpr size_t DO_H = 0, DO_WG = 32 * MiB, DO_WCAT = 36 * MiB, DO_WIN = 40 * MiB;

__device__ __forceinline__ unsigned pk2(float lo, float hi) { return (unsigned)f2bf(lo) | ((unsigned)f2bf(hi) << 16); }
__device__ __forceinline__ float wave_sum(float v) {
#pragma unroll
    for (int o = 1; o < 64; o <<= 1) v += __shfl_xor(v, o);
    return v;
}
template <class SrcCol>
__device__ __forceinline__ void transpose_item(const float* W, int ldw, const SrcCol& srccol, bf16_t* WT, int ldk, int kofs, LAS float* scr, int kb, int nb, int lane) {
    const int k0 = 64 * kb, n0 = 64 * nb; const int n4 = (lane & 15) * 4; const int sc = srccol(n0 + n4);
    f32x4 v[16];
    const float* wp = W + (size_t)(k0 + (lane >> 4)) * ldw + (sc >= 0 ? sc : 0);
#pragma unroll
    for (int i = 0; i < 16; ++i) v[i] = *(const f32x4*)(wp + (size_t)(4 * i) * ldw);
#pragma unroll
    for (int i = 0; i < 16; ++i) { const int kk = 4 * i + (lane >> 4); const f32x4 u = (sc >= 0) ? v[i] : (f32x4){0.f, 0.f, 0.f, 0.f};
        scr[kk * 65 + n4] = u[0]; scr[kk * 65 + n4 + 1] = u[1]; scr[kk * 65 + n4 + 2] = u[2]; scr[kk * 65 + n4 + 3] = u[3]; }
    asm volatile("s_waitcnt lgkmcnt(0)" ::: "memory");
    const int c = lane & 7;
#pragma unroll
    for (int j = 0; j < 8; ++j) { const int n = (lane >> 3) + 8 * j; const LAS float* sp = scr + (8 * c) * 65 + n;
        v4u o; o.x = pk2(sp[0 * 65], sp[1 * 65]); o.y = pk2(sp[2 * 65], sp[3 * 65]); o.z = pk2(sp[4 * 65], sp[5 * 65]); o.w = pk2(sp[6 * 65], sp[7 * 65]);
        *(v4u*)(WT + (size_t)(n0 + n) * ldk + kofs + k0 + 8 * c) = o; }
    asm volatile("s_waitcnt lgkmcnt(0)" ::: "memory");
}
struct SrcIdent { int off; __device__ __forceinline__ int operator()(int n) const { return n + off; } };
struct SrcWin { __device__ __forceinline__ int operator()(int n) const { return n < 4096 ? n : (n < 6656 ? n + 16 : (n < 6672 ? n - 6656 + 4096 : (n < 6720 ? n : -1))); } };

typedef GAS unsigned gu32;
#define RLX_AGENT __ATOMIC_RELAXED, __HIP_MEMORY_SCOPE_AGENT
#define XB_TMO      128
#define XB_XCNT(j)  (256  + 64 * (j))
#define XB_XSUB(j)  (1280 + 64 * (j))
#define XB_XGEN(j)  (2304 + 64 * (j))
#define XB_TOP      3328
#define XB_TOPGEN   3392
#define XCD_BAR_WORDS 3456
#define XB_SPIN_CAP (1u << 18)

__device__ __forceinline__ unsigned xb_ld(unsigned* p)              { return __hip_atomic_load(p, __ATOMIC_RELAXED, __HIP_MEMORY_SCOPE_AGENT); }
__device__ __forceinline__ unsigned xb_add(unsigned* p, unsigned v) { return __hip_atomic_fetch_add(p, v, __ATOMIC_RELAXED, __HIP_MEMORY_SCOPE_AGENT); }
__device__ __forceinline__ unsigned xb_xcc_id() { return (unsigned)__builtin_amdgcn_s_getreg((3 << 11) | 20) & 0xFu; }
#define XB_SPIN(cond, bar) do { unsigned _sp = 0; while (cond) { __builtin_amdgcn_s_sleep(1); \
    if ((++_sp & 255u) == 0u) { if (xb_ld(&(bar)[XB_TMO])) break; if (_sp > XB_SPIN_CAP) { atomicAdd(&(bar)[XB_TMO], 1u); break; } } } } while (0)

struct XcdBarrier {
    unsigned* bar; unsigned x;
    volatile LAS unsigned* st;
};

__device__ __forceinline__ XcdBarrier xcd_barrier_post(unsigned* bar, volatile LAS unsigned* st) {
    XcdBarrier b; b.bar = bar; b.x = xb_xcc_id(); b.st = st;
    if (threadIdx.x == 0) (void)xb_add(&bar[XB_XCNT(b.x)], 1u);
    return b;
}
__device__ __forceinline__ void xcd_barrier_complete(unsigned* bar, unsigned x, unsigned& nloc, unsigned& nx) {
    const unsigned G = gridDim.x * gridDim.y * gridDim.z;
    unsigned sum, cnt, mine, sp = 0u;
    for (;;) {
        sum = 0u; cnt = 0u; mine = 0u;
#pragma unroll
        for (unsigned j = 0; j < 16; ++j) { const unsigned c = xb_ld(&bar[XB_XCNT(j)]); sum += c; cnt += (c > 0u) ? 1u : 0u; mine = (j == x) ? c : mine; }
        if (sum == G) break;
        __builtin_amdgcn_s_sleep(1);
        if ((++sp & 255u) == 0u) { if (xb_ld(&bar[XB_TMO])) break; if (sp > XB_SPIN_CAP) { atomicAdd(&bar[XB_TMO], 1u); break; } }
    }
    nloc = mine > 0u ? mine : 1u; nx = cnt > 0u ? cnt : 1u;
}

__device__ __forceinline__ void xcd_barrier(const XcdBarrier& b) {
    asm volatile("s_waitcnt vmcnt(0)" ::: "memory");
    __syncthreads();
    if (threadIdx.x == 0) {
        unsigned* bar = b.bar;
        __builtin_amdgcn_s_waitcnt(0);
        unsigned nloc = b.st[0], nx = b.st[1];
        if (nloc == 0u) { xcd_barrier_complete(bar, b.x, nloc, nx); b.st[0] = nloc; b.st[1] = nx; }
        const unsigned old = xb_add(&bar[XB_XSUB(b.x)], 1u);
        const unsigned gen = old / nloc;
        if (old + 1u == (gen + 1u) * nloc) {
            __builtin_amdgcn_fence(__ATOMIC_RELEASE, "agent");
            asm volatile("s_waitcnt vmcnt(0)" ::: "memory");
            const unsigned og = xb_add(&bar[XB_TOP], 1u);
            const unsigned tg = og / nx;
            if (og + 1u == (tg + 1u) * nx) xb_add(&bar[XB_TOPGEN], 1u);
            else XB_SPIN(xb_ld(&bar[XB_TOPGEN]) == tg, bar);
            __builtin_amdgcn_fence(__ATOMIC_ACQUIRE, "agent");
            xb_add(&bar[XB_XGEN(b.x)], 1u);
            asm volatile("s_waitcnt vmcnt(0)" ::: "memory");
        } else {
            XB_SPIN(xb_ld(&bar[XB_XGEN(b.x)]) == gen, bar);
            __builtin_amdgcn_fence(__ATOMIC_ACQUIRE, "agent");
            asm volatile("s_waitcnt vmcnt(0)" ::: "memory");
        }
    }
    __syncthreads();
}


struct Args { const float* in[23]; float* out; unsigned char* ws; int ph_lo, ph_hi; };

__global__ void __launch_bounds__(NWAVES * 64, 2) mk_fwd(Args args) {
    extern __shared__ __attribute__((aligned(16))) unsigned char lds_raw[];
    LAS unsigned char* lds = (LAS unsigned char*)lds_raw;
    __builtin_assume(__builtin_amdgcn_workitem_id_y() == 0); __builtin_assume(__builtin_amdgcn_workitem_id_z() == 0);
    cg::grid_group grid = cg::this_grid();
    const int tid = threadIdx.x, wave = __builtin_amdgcn_readfirstlane(tid >> 6);
#define lane ((int)(threadIdx.x & 63u))
    const int G = gridDim.x, gw = blockIdx.x * NWAVES + wave, NGW = G * NWAVES;
    unsigned char* ws = args.ws; unsigned char* dob = (unsigned char*)args.out;
    const float* x = args.in[0];
    bf16_t* P = (bf16_t*)(ws + WS_P);
    bf16_t* Hb = (bf16_t*)(dob + DO_H); bf16_t* Wg_t = (bf16_t*)(dob + DO_WG); bf16_t* Wcat_t = (bf16_t*)(dob + DO_WCAT); bf16_t* Win_t = (bf16_t*)(dob + DO_WIN);
    bf16_t* Wout_t = (bf16_t*)(ws + WS_WOUT); bf16_t* Wup_t = (bf16_t*)(ws + WS_WUP); bf16_t* Wdown_t = (bf16_t*)(ws + WS_WDOWN);
    bf16_t* Mix = (bf16_t*)(ws + WS_MIX); bf16_t* An = (bf16_t*)(ws + WS_AN); bf16_t* Up = (bf16_t*)(ws + WS_UP); float* pss = (float*)(ws + WS_PSS);
    LAS float* scr = (LAS float*)(lds + wave * 17408);
    bf16_t* Halo = (bf16_t*)(dob + DO_HALO); bf16_t* GWb = (bf16_t*)(ws + WS_GW); bf16_t* GQKb = (bf16_t*)(dob + DO_GQK); float* GLv = (float*)(ws + WS_GLV); unsigned* qcnt = (unsigned*)(ws + WS_QCNT);
    bf16_t* W1T = (bf16_t*)(ws + WS_W1T); float* bias1 = (float*)(ws + WS_BIAS1); bf16_t* KCb = (bf16_t*)(ws + WS_KCB); bf16_t* VCb = (bf16_t*)(ws + WS_VCB);
    const int lo = args.ph_lo, hi = args.ph_hi;
    if (tid < 2) ((volatile LAS unsigned*)(lds + 147456 - 32))[tid] = 0u;
    __syncthreads();
    XcdBarrier xbar = xcd_barrier_post((unsigned*)(ws + WS_XBAR), (volatile LAS unsigned*)(lds + 147456 - 32));
    if (args.ph_hi > 1000) grid.sync();
#ifndef PHMASK
#define PHMASK 0x1ff
#endif
#define IN(k) (((PHMASK >> (k)) & 1) && lo <= (k) && (k) < hi)
#define GRID_SYNC() do { asm volatile("s_waitcnt vmcnt(0) lgkmcnt(0)" ::: "memory"); grid.sync(); \
        if (wave == 0) { __builtin_amdgcn_fence(__ATOMIC_ACQUIRE, "agent"); asm volatile("s_waitcnt vmcnt(0)" ::: "memory"); } __syncthreads(); } while (0)
#if defined(TPROBE)
#define STAMP(k) do { if (blockIdx.x == 0 && tid == 0) ((volatile LAS unsigned long long*)(lds + 147456 - 512))[k] = __builtin_amdgcn_s_memrealtime(); } while (0)
#else
#define STAMP(k) do { } while (0)
#endif
#define SEAM(k) do { if (IN(k) && IN((k) + 1)) xcd_barrier(xbar); STAMP((k) + 1); } while (0)

    STAMP(0);
    if (IN(0)) {
        if (blockIdx.x == 0 && tid == 0) { *qcnt = 0u; ((volatile unsigned*)(ws + 786432))[4] = 0u; }
        constexpr int I_WIN = 16 * (NP1 / 64), I_WG = 16 * 32, I_DN = 16 * 16, I_OUT = 16 * 16, I_UP = 16 * 64;
        constexpr int I_W1 = 32 * 2, I_B1 = 64;
        constexpr int NITEMS = I_WIN + 2 * I_W1 + I_B1;
        for (int it = gw; it < NITEMS; it += NGW) {
            int r = it;
            if (r < I_WIN) { transpose_item(args.in[2], INW, SrcWin{}, Win_t, D, 0, scr, r / (NP1 / 64), r % (NP1 / 64), lane); continue; } r -= I_WIN;
            if (r < I_W1) { transpose_item(args.in[12], 128, SrcIdent{0}, W1T, 2048, 0, scr, r / 2, r % 2, lane); continue; } r -= I_W1;
            if (r < I_W1) { transpose_item(args.in[15], 128, SrcIdent{0}, W1T + 128 * 2048, 2048, 0, scr, r / 2, r % 2, lane); continue; } r -= I_W1;
            {
                const int which = r >> 5, kc = r & 31; const float* pos = args.in[which ? 14 : 11] + kc * 64; const float* w1 = args.in[which ? 15 : 12] + (size_t)kc * 64 * 128 + 2 * lane;
                float a0 = 0.f, a1 = 0.f;
#pragma unroll 16
                for (int k = 0; k < 64; ++k) { const float pk_ = pos[k]; const float2 w = *(const float2*)(w1 + (size_t)k * 128); a0 += pk_ * w.x; a1 += pk_ * w.y; }
                atomicAdd(bias1 + which * 128 + 2 * lane, a0); atomicAdd(bias1 + which * 128 + 2 * lane + 1, a1);
            }
        }
        const float* gain = args.in[1];
        f32x4 gv[4];
#pragma unroll
        for (int j = 0; j < 4; ++j) gv[j] = ((const f32x4*)gain)[lane + 64 * j];
        for (int m = gw; m < M; m += 2 * NGW) {
            const int m2 = (m + NGW < M) ? m + NGW : m;
            const f32x4* xr = (const f32x4*)(x + (size_t)m * D) + lane; const f32x4* xr2 = (const f32x4*)(x + (size_t)m2 * D) + lane;
            f32x4 v[4], u[4]; float s1 = 0.f, s2 = 0.f;
#pragma unroll
            for (int j = 0; j < 4; ++j) { v[j] = xr[64 * j]; u[j] = xr2[64 * j]; }
#pragma unroll
            for (int j = 0; j < 4; ++j) { s1 += (v[j].x * v[j].x + v[j].y * v[j].y) + (v[j].z * v[j].z + v[j].w * v[j].w); s2 += (u[j].x * u[j].x + u[j].y * u[j].y) + (u[j].z * u[j].z + u[j].w * u[j].w); }
            const float r1 = rsqrtf(wave_sum(s1) * (1.f / D) + EPS), r2 = rsqrtf(wave_sum(s2) * (1.f / D) + EPS);
            unsigned long long* o8 = (unsigned long long*)(Hb + (size_t)m * D) + lane; unsigned long long* o9 = (unsigned long long*)(Hb + (size_t)m2 * D) + lane;
#pragma unroll
            for (int j = 0; j < 4; ++j) { const f32x4 y = v[j] * r1 * gv[j]; o8[64 * j] = (unsigned long long)pk2(y.x, y.y) | ((unsigned long long)pk2(y.z, y.w) << 32); }
            if (m2 != m) {
#pragma unroll
                for (int j = 0; j < 4; ++j) { const f32x4 y = u[j] * r2 * gv[j]; o9[64 * j] = (unsigned long long)pk2(y.x, y.y) | ((unsigned long long)pk2(y.z, y.w) << 32); } }
        }
    }
    SEAM(0);
    if (IN(1)) {
        pg8::Gemm g{Hb, Win_t, D, D, M, NP1, D, 0}; pg8::StaticOrder S; S.init(M, NP1, G, (int)blockIdx.x);
        pg8::EpiP<0> E{P, LDP, 26, 64, Halo};
        pg8::gemm_phase<pg8::EpiP<0>, pg8::StaticOrder, true>(lds, g, S, E);
        {
            constexpr int I_WG = 16 * 32, I_DN = 16 * 16, I_OUT = 16 * 16, I_UP = 16 * 64, NT = I_WG + 2 * I_DN + I_OUT + I_UP;
            const int nwg = (M / 256) * (NP1 / 256), maxu = (nwg + G - 1) / G, thr = nwg - (maxu - 1) * G;
            const int nsl = (thr < G) ? G - thr : G, sidx = (thr < G) ? (int)blockIdx.x - thr : (int)blockIdx.x;
            if (sidx >= 0) for (int it = sidx * NWAVES + wave; it < NT; it += nsl * NWAVES) {
                int r = it;
                if (r < I_WG) { transpose_item(args.in[2], INW, SrcIdent{6720}, Wg_t, D, 0, scr, r / 32, r % 32, lane); continue; } r -= I_WG;
                if (r < I_DN) { transpose_item(args.in[17], D, SrcIdent{0}, Wcat_t, 2 * D, 0, scr, r / 16, r % 16, lane); continue; } r -= I_DN;
                if (r < I_DN) { transpose_item(args.in[18], D, SrcIdent{0}, Wcat_t, 2 * D, D, scr, r / 16, r % 16, lane); continue; } r -= I_DN;
                if (r < I_OUT) { transpose_item(args.in[19], D, SrcIdent{0}, Wout_t, D, 0, scr, r / 16, r % 16, lane); continue; } r -= I_OUT;
                transpose_item(args.in[21], FF, SrcIdent{0}, Wup_t, D, 0, scr, r / 64, r % 64, lane);
            }
        }
    }
    SEAM(1);
    if (IN(2)) {
        for (int it = (G == 256) ? (((int)blockIdx.x & 1) ? 128 : (int)blockIdx.x >> 1) : (int)blockIdx.x; it < 128; it += G) {
            const int half = it & 1, which = (it >> 1) & 1, g_ = (it >> 2) & 3, b_ = it >> 4;
            nsa::compress_item(lds, P, W1T + (size_t)which * 128 * 2048, bias1 + which * 128, args.in[which ? 16 : 13], args.in[8], which ? VCb : KCb, b_, g_, which, half);
        }
        STAMP(11);
        nsa::prep_units(P, args.in[7], args.in[9], args.in[10], gw, NGW, lane);
        STAMP(12);
#if !defined(GDN_NAIVE)
        __syncthreads();
        {
            gdn::RowPre pre; int hl = -1;
            const int c_ = (int)blockIdx.x, hq = c_ >> 5, jq = c_ & 31;
            const bool bal = (G == 256);
            const int cnt = bal ? ((jq & 1) ? 9 : 7) : (2048 - c_ + G - 1) / G;
            const int first = bal ? ((jq & 1) ? 112 + 9 * (jq >> 1) : 7 * (jq >> 1)) : 0;
#define PREP_COORD(k, b_, n_, h_) do { if (bal) { const int idx_ = first + (k); b_ = idx_ >> 5; n_ = idx_ & 31; h_ = hq; } else { const int it_ = c_ + (k) * G; b_ = it_ >> 8; n_ = it_ & 31; h_ = (it_ >> 5) & 7; } } while (0)
            int b0, n0, h0;
            if (cnt > 0) { PREP_COORD(0, b0, n0, h0); gdn::prep_prefetch(pre, P, Halo, b0, n0, h0, wave, lane); }
            for (int k = 0; k < cnt; ++k) {
                int bc, nc, hc, bn = -1, nn = 0, hn = 0;
                PREP_COORD(k, bc, nc, hc);
                if (k + 1 < cnt) PREP_COORD(k + 1, bn, nn, hn);
                if (hc != hl) { __syncthreads(); gdn::prep_load_taps(lds, args.in[3], hc); hl = hc; __syncthreads(); }
                gdn::prep_item(lds, P, Halo, args.in[4], args.in[5], GWb, GQKb, GLv, pre, bc, nc, hc, bn, nn, hn);
                if (k == 0) STAMP(14);
            }
#undef PREP_COORD
        }
        STAMP(13);
#endif
    }
    SEAM(2);
    if (IN(3)) {
#if defined(GDN_NAIVE)
        if ((int)blockIdx.x < 16) gdn_naive::run(lds, P, args.in[3], args.in[4], args.in[5], args.in[6], 4 * (int)blockIdx.x);
#else
        if ((int)blockIdx.x < 64) gdn::scan_item(lds, P, GWb, GQKb, GLv, args.in[6], (int)blockIdx.x >> 3, (int)blockIdx.x & 7);
#endif
        __syncthreads();
        STAMP(10);
        for (;;) {
            volatile LAS unsigned* qslot = (volatile LAS unsigned*)(lds + 147456 - 16);
            if (tid == 0) *qslot = atomicAdd(qcnt, 1u);
            __syncthreads();
            const int idx = (int)*qslot;
            __syncthreads();
            if (idx >= 1024) break;
#if defined(TPROBE)
            if (blockIdx.x == 200 && tid == 0) { ((volatile unsigned long long*)(ws + 786432))[0] = __builtin_amdgcn_s_memrealtime(); ((volatile unsigned*)(ws + 786432))[4] += 1u; }
#endif
            nsa::attn_tile(lds, P, KCb, VCb, (idx & 31) >> 2, idx & 3, 31 - (idx >> 5));
        }
    }
    SEAM(3);
    if (IN(4)) {
        pg8::Gemm g{Hb, Wg_t, D, D, M, 2048, D, 0}; pg8::StaticOrder S; S.init(M, 2048, G, (int)blockIdx.x);
        pg8::EpiP<1> E{P, LDP, -1, 256, nullptr};
        pg8::gemm_phase<pg8::EpiP<1>, pg8::StaticOrder, true>(lds, g, S, E);
    }
    SEAM(4);
    if (IN(5)) {
        pg8::Gemm g{P + C_DZ, Wcat_t, LDP, 2 * D, M, D, D, D}; pg8::TwoPassOrder S; S.base.init(M, D, G, (int)blockIdx.x);
        pg8::EpiMix E{P, LDP, Mix, D};
        pg8::gemm_phase<pg8::EpiMix, pg8::TwoPassOrder, false>(lds, g, S, E);
    }
    SEAM(5);
    if (IN(6)) {
        for (int it = gw; it < 64 * 16; it += NGW) transpose_item(args.in[22], D, SrcIdent{0}, Wdown_t, FF, 0, scr, it / 16, it % 16, lane);
        __syncthreads();
        pg8::Gemm g{Mix, Wout_t, D, D, M, D, D, 0}; pg8::StaticOrder S; S.init(M, D, G, (int)blockIdx.x);
        pg8::EpiOut E{x, args.out, An, args.in[20], pss};
        pg8::gemm_phase<pg8::EpiOut, pg8::StaticOrder, false>(lds, g, S, E);
    }
    SEAM(6);
    if (IN(7)) {
        pg8::Gemm g{An, Wup_t, D, D, M, FF, D, 0}; pg8::StaticOrder S; S.init(M, FF, G, (int)blockIdx.x);
        pg8::EpiUp E{pss, Up, FF};
        pg8::gemm_phase<pg8::EpiUp, pg8::StaticOrder, true>(lds, g, S, E);
    }
    SEAM(7);
    if (IN(8)) {
        pg8::Gemm g{Up, Wdown_t, FF, FF, M, D, FF, 0}; pg8::StaticOrder S; S.init(M, D, G, (int)blockIdx.x);
        pg8::EpiDown E{args.out};
        pg8::gemm_phase<pg8::EpiDown, pg8::StaticOrder, false>(lds, g, S, E);
    }
#if defined(TPROBE)
    STAMP(9);
    GRID_SYNC();
    if (blockIdx.x == 0) {
        volatile LAS unsigned long long* ts = (volatile LAS unsigned long long*)(lds + 147456 - 512);
        if (tid == 0) { ts[25] = ((volatile unsigned long long*)(ws + 786432))[0]; ts[26] = ts[3] + 100ull * ((volatile unsigned*)(ws + 786432))[4]; }
        const float dA = (float)(ts[TPA1] - ts[TPA0]) * 0.01f, dB = (float)(ts[TPB1] - ts[TPB0]) * 0.01f;
        if (tid == 0) args.out[0] = dA + 0.f * dB;
    }
#endif
#undef IN
#undef SEAM
#undef GRID_SYNC
}

#undef lane
static int g_grid = 0;
static void launch_mk(const Args& a0, int lo, int hi, hipStream_t stream) {
    Args a = a0; a.ph_lo = lo; a.ph_hi = hi;
    void* kargs[] = {(void*)&a};
    hipError_t e = hipLaunchCooperativeKernel((const void*)mk_fwd, dim3(g_grid), dim3(NWAVES * 64), kargs, LDS_BYTES, stream);
    if (e != hipSuccess) fprintf(stderr, "cooperative launch failed: %s (grid %d)\n", hipGetErrorString(e), g_grid);
}

extern "C" void kernel_launch(void* const* d_in, const int* in_sizes, int n_in, void* d_out, int out_size, void* d_ws, size_t ws_size, hipStream_t stream) {
    if (g_grid == 0) {
        int dev = 0, cus = 0, per_cu = 0;
        hipGetDevice(&dev);
        hipDeviceGetAttribute(&cus, hipDeviceAttributeMultiprocessorCount, dev);
        hipFuncSetAttribute((const void*)mk_fwd, hipFuncAttributeMaxDynamicSharedMemorySize, LDS_BYTES);
        hipOccupancyMaxActiveBlocksPerMultiprocessor(&per_cu, (const void*)mk_fwd, NWAVES * 64, LDS_BYTES);
        if (per_cu < 1) per_cu = 1;
        if (per_cu > 1) per_cu = 1;
        g_grid = cus * per_cu;
    }
    Args a{};
    for (int i = 0; i < 23; ++i) a.in[i] = (const float*)d_in[i];
    a.out = (float*)d_out; a.ws = (unsigned char*)d_ws;
    bf16_t* P = (bf16_t*)((char*)d_ws + WS_P);
    hipMemsetAsync((char*)d_ws + WS_XBAR, 0, 16384 + 1024, stream);
    launch_mk(a, 0, 9, stream);
}
```

```cpp
#include <hip/hip_runtime.h>
#include <hip/hip_cooperative_groups.h>
#include <stdint.h>
#include <cstdio>
namespace cg = cooperative_groups;

typedef unsigned short bf16_t;

constexpr int D = 1024, BATCH = 8, SEQ = 2048, M = BATCH * SEQ;
constexpr int DN_H = 8, DN_D = 128;
constexpr int NS_H = 16, NS_G = 4, NS_R = 4, NS_D = 64;
constexpr int NCMP = 127, NSEL = 32;
constexpr int FF = 4096;
constexpr int INW = 8768;
constexpr float EPS = 1e-6f;
constexpr float NEGV = -1e30f, FORCEV = 1e9f;

constexpr int LDP = 6720;
constexpr int C_DQ = 0, C_DK = 1024, C_DV = 2048, C_DZ = 3072, C_NQ = 4096;
constexpr int C_KC = 5120, C_VC = 5376, C_KS = 5632, C_VS = 5888, C_KW = 6144, C_VW = 6400;
constexpr int C_SB = 6656, C_SA = 6664, C_SG = 6672;
constexpr int NP1 = 6912;

__device__ __forceinline__ float bf2f(bf16_t v) { return __uint_as_float(((unsigned)v) << 16); }
__device__ __forceinline__ bf16_t f2bf(float f) { unsigned u = __float_as_uint(f); return (bf16_t)((u + 0x7fffu + ((u >> 16) & 1u)) >> 16); }
__device__ __forceinline__ float sigmoidf_(float x) { return 1.f / (1.f + __expf(-x)); }
__device__ __forceinline__ float siluf_(float x) { return x * sigmoidf_(x); }
__device__ __forceinline__ float softplusf_(float x) { return fmaxf(x, 0.f) + log1pf(__expf(-fabsf(x))); }
__device__ __forceinline__ float gelu_tanh(float x) { return 0.5f * x * (1.f + tanhf(0.7978845608028654f * (x + 0.044715f * x * x * x))); }

__device__ __forceinline__ float block_sum(float v, float* red) {
    for (int o = 32; o > 0; o >>= 1) v += __shfl_xor(v, o);
    const int w = threadIdx.x >> 6, nw = blockDim.x >> 6;
    __syncthreads();
    if ((threadIdx.x & 63) == 0) red[w] = v;
    __syncthreads();
    float s = 0.f;
    for (int i = 0; i < nw; ++i) s += red[i];
    return s;
}
__device__ __forceinline__ float block_max(float v, float* red) {
    for (int o = 32; o > 0; o >>= 1) v = fmaxf(v, __shfl_xor(v, o));
    const int w = threadIdx.x >> 6, nw = blockDim.x >> 6;
    __syncthreads();
    if ((threadIdx.x & 63) == 0) red[w] = v;
    __syncthreads();
    float s = red[0];
    for (int i = 1; i < nw; ++i) s = fmaxf(s, red[i]);
    return s;
}


#if defined(TPROBE)
#define XSTAMP(k) do { if (blockIdx.x == 0 && threadIdx.x == 0) ((volatile __attribute__((address_space(3))) unsigned long long*)(lds + 147456 - 512))[k] = __builtin_amdgcn_s_memrealtime(); } while (0)
#else
#define XSTAMP(k) do { } while (0)
#endif
namespace gdn_naive {
#define GLAS __attribute__((address_space(3)))
__device__ __forceinline__ float sub_sum(float v, GLAS float* red, int sub, int tid) {
#pragma unroll
    for (int o = 32; o > 0; o >>= 1) v += __shfl_xor(v, o);
    __syncthreads();
    if ((tid & 63) == 0) red[sub * 2 + ((tid >> 6) & 1)] = v;
    __syncthreads();
    return red[sub * 2] + red[sub * 2 + 1];
}
__device__ __forceinline__ void run(GLAS unsigned char* lds, bf16_t* P, const float* convw, const float* a_log, const float* dt_bias, const float* out_norm, int item0) {
    const int tid = threadIdx.x, sub = tid >> 7, j = tid & 127;
    GLAS float* qs = (GLAS float*)lds + sub * 256; GLAS float* ks = qs + 128; GLAS float* red = (GLAS float*)(lds + 4096);
    const int item = item0 + sub; const int b = item / DN_H, h = item % DN_H;
    float s[128];
#pragma unroll
    for (int i = 0; i < 128; ++i) s[i] = 0.f;
    const float Ah = -__expf(a_log[h]), dtb = dt_bias[h], gn = out_norm[j];
    const float scale = 0.08838834764831845f;
    float wq[4], wk[4], wv[4], xq[3] = {0.f, 0.f, 0.f}, xk[3] = {0.f, 0.f, 0.f}, xv[3] = {0.f, 0.f, 0.f};
#pragma unroll
    for (int t = 0; t < 4; ++t) { wq[t] = convw[t * 3072 + h * 128 + j]; wk[t] = convw[t * 3072 + 1024 + h * 128 + j]; wv[t] = convw[t * 3072 + 2048 + h * 128 + j]; }
    for (int t = 0; t < SEQ; ++t) {
        bf16_t* row = P + (size_t)(b * SEQ + t) * LDP;
        const float rq = bf2f(row[C_DQ + h * DN_D + j]), rk = bf2f(row[C_DK + h * DN_D + j]), rv = bf2f(row[C_DV + h * DN_D + j]);
        float q = siluf_(wq[0] * xq[0] + wq[1] * xq[1] + wq[2] * xq[2] + wq[3] * rq);
        float k = siluf_(wk[0] * xk[0] + wk[1] * xk[1] + wk[2] * xk[2] + wk[3] * rk);
        const float v = siluf_(wv[0] * xv[0] + wv[1] * xv[1] + wv[2] * xv[2] + wv[3] * rv);
        xq[0] = xq[1]; xq[1] = xq[2]; xq[2] = rq; xk[0] = xk[1]; xk[1] = xk[2]; xk[2] = rk; xv[0] = xv[1]; xv[1] = xv[2]; xv[2] = rv;
        const float sq = sub_sum(q * q, red, sub, tid);
        const float sk = sub_sum(k * k, red, sub, tid);
        q *= rsqrtf(sq + EPS); k *= rsqrtf(sk + EPS);
        qs[j] = q; ks[j] = k;
        const float beta = sigmoidf_(bf2f(row[C_SB + h]));
        const float a = __expf(Ah * softplusf_(bf2f(row[C_SA + h]) + dtb));
        const float z = bf2f(row[C_DZ + h * DN_D + j]);
        __syncthreads();
        float kS = 0.f;
#pragma unroll
        for (int i = 0; i < 128; ++i) kS += ks[i] * s[i];
        const float dlt = beta * (v - a * kS);
        asm volatile("" ::: "memory");
        float o = 0.f;
#pragma unroll
        for (int i = 0; i < 128; ++i) { s[i] = a * s[i] + ks[i] * dlt; o += qs[i] * s[i]; }
        o *= scale;
        const float ss = sub_sum(o * o, red, sub, tid);
        row[C_DZ + h * DN_D + j] = f2bf(o * rsqrtf(ss * (1.f / 128.f) + EPS) * gn * siluf_(z));
    }
}
}
namespace gdn {
#define GL3 __attribute__((address_space(3)))
typedef short bf16x8 __attribute__((ext_vector_type(8)));
typedef short s16x4 __attribute__((ext_vector_type(4)));
typedef short v4i16_t __attribute__((ext_vector_type(4)));
typedef float f32x16 __attribute__((ext_vector_type(16)));
typedef float f32x4 __attribute__((ext_vector_type(4)));
typedef float f32x2 __attribute__((ext_vector_type(2)));
typedef unsigned u32x4 __attribute__((ext_vector_type(4)));
typedef unsigned u32x2 __attribute__((ext_vector_type(2)));
typedef __bf16 bf16x2_t __attribute__((ext_vector_type(2)));
constexpr float QSCALE = 0.08838834764831845f;
__device__ __forceinline__ float fsig(float x) { return __builtin_amdgcn_rcpf(1.f + __builtin_amdgcn_exp2f(-1.4426950408889634f * x)); }
__device__ __forceinline__ float fsilu(float x) { return x * fsig(x); }
__device__ __forceinline__ int crow(int i, int hi) { return (i & 3) + 8 * (i >> 2) + 4 * hi; }
__device__ __forceinline__ unsigned pk(float lo, float hi) { f32x2 v = {lo, hi}; bf16x2_t b = __builtin_convertvector(v, bf16x2_t); return __builtin_bit_cast(unsigned, b); }
__device__ __forceinline__ bf16x8 pack8(const float* v) { u32x4 w = {pk(v[0], v[1]), pk(v[2], v[3]), pk(v[4], v[5]), pk(v[6], v[7])}; return __builtin_bit_cast(bf16x8, w); }
__device__ __forceinline__ float blo(unsigned w) { return __uint_as_float(w << 16); }
__device__ __forceinline__ float bhi(unsigned w) { return __uint_as_float(w & 0xffff0000u); }
__device__ __forceinline__ char* seg_addr(bf16_t* P, size_t row0, int c0, unsigned e) { return (char*)P + ((row0 + (e >> 8)) * LDP + c0) * 2 + (e & 255u); }

__device__ __forceinline__ s16x4 vtr(GL3 const unsigned char* p) { return __builtin_bit_cast(s16x4, __builtin_amdgcn_ds_read_tr16_b64_v4i16((GL3 v4i16_t*)p)); }

constexpr int PL_K = 0, PL_KB = 16384, PL_Q = 32768, PL_RV = 49152, PL_AM = 81920, PL_INV = 99328, PL_MT = 116736, PL_GC = 120832, PL_QKST = 121088, PL_TI = 129280, PL_CW = 137472, PL_END = 143616;
constexpr int PL_WST = 0, PL_UST = 16384;
constexpr int AMLD = 68;
struct RowPre { u32x4 x[2][3][4]; unsigned short lb, la; };
__device__ __forceinline__ void prep_prefetch(RowPre& pre, const bf16_t* P, const bf16_t* HALO, int b, int n, int h, int wid, int lane) {
    const size_t row0 = (size_t)b * SEQ + 64 * n; const int dc = lane & 15;
    const bf16_t* prow = P + (row0 + lane) * LDP;
    pre.lb = prow[C_SB + h]; pre.la = prow[C_SA + h];
#pragma unroll
    for (int pass = 0; pass < 2; ++pass) {
        const int tok = 8 * wid + 4 * pass + (lane >> 4);
#pragma unroll
        for (int which = 0; which < 3; ++which) {
            const int col = which * 1024 + h * 128 + dc * 8;
#pragma unroll
            for (int j = 0; j < 4; ++j) {
                const int rr = tok - 3 + j; const bool inb = rr >= 0;
                const bf16_t* src = inb ? (P + (row0 + (inb ? rr : 0)) * LDP + col) : (HALO + ((size_t)((b * 32 + (n > 0 ? n - 1 : 0)) * 3 + (inb ? 0 : 3 + rr))) * 3072 + col);
                pre.x[pass][which][j] = *(const u32x4*)src;
            }
        }
    }
}
__device__ __forceinline__ void prep_load_taps(GL3 unsigned char* lds, const float* convw, int h) {
    GL3 float* cw = (GL3 float*)(lds + 137472);
    for (int e = threadIdx.x; e < 1536; e += 512) { const int which = e >> 9, j = (e >> 7) & 3, c = e & 127; cw[e] = convw[j * 3072 + which * 1024 + h * 128 + c]; }
}
#define PBAR() do { asm volatile("s_waitcnt lgkmcnt(0)" ::: "memory"); __builtin_amdgcn_s_barrier(); asm volatile("" ::: "memory"); } while (0)
__device__ __forceinline__ void prep_item(GL3 unsigned char* lds, bf16_t* P, const bf16_t* HALO, const float* a_log, const float* dt_bias,
                                          bf16_t* GW, bf16_t* GQK, float* GLv, RowPre& pre, int b, int n, int h, int nb_, int nn_, int nh_) {
    int tid = threadIdx.x; asm volatile("" : "+v"(tid));
    const int lane = tid & 63, r32 = lane & 31, hi = lane >> 5; const int wid = __builtin_amdgcn_readfirstlane(tid >> 6);
    const size_t row0 = (size_t)b * SEQ + 64 * n; const int item = (b * DN_H + h) * 32 + n;
    GL3 float* AM = (GL3 float*)(lds + PL_AM); GL3 float* INV = (GL3 float*)(lds + PL_INV); GL3 float* MT = (GL3 float*)(lds + PL_MT); GL3 float* GC = (GL3 float*)(lds + PL_GC);
    float gcum, beta_l, gc_last;
    {
        beta_l = fsig(bf2f(pre.lb));
        { const float xs = bf2f(pre.la) + dt_bias[h]; gcum = -__expf(a_log[h]) * (fmaxf(xs, 0.f) + __logf(1.f + __expf(-fabsf(xs)))); }
#pragma unroll
        for (int o = 1; o < 64; o <<= 1) { const float t = __shfl_up(gcum, o); if (lane >= o) gcum += t; }
        gc_last = __shfl(gcum, 63);
        if (wid == 0) GC[lane] = gcum;
    }
    bf16x8 qd_keep[2], ke_keep[2];
    const int dc = lane & 15;
#pragma unroll
    for (int pass = 0; pass < 2; ++pass) {
        const int tok = 8 * wid + 4 * pass + (lane >> 4);
        const float gct = __shfl(gcum, tok), bet = __shfl(beta_l, tok);
        float y[3][8];
#pragma unroll
        for (int which = 0; which < 3; ++which) {
#pragma unroll
            for (int e = 0; e < 8; ++e) y[which][e] = 0.f;
#pragma unroll
            for (int j = 0; j < 4; ++j) {
                const int rr = tok - 3 + j;
                u32x4 x = pre.x[pass][which][j];
                if (rr < 0 && n == 0) x = (u32x4){0u, 0u, 0u, 0u};
                const f32x4 w0 = *(GL3 const f32x4*)(lds + PL_CW + ((which * 4 + j) * 128 + dc * 8) * 4), w1 = *(GL3 const f32x4*)(lds + PL_CW + ((which * 4 + j) * 128 + dc * 8 + 4) * 4);
                y[which][0] += w0[0] * blo(x.x); y[which][1] += w0[1] * bhi(x.x); y[which][2] += w0[2] * blo(x.y); y[which][3] += w0[3] * bhi(x.y);
                y[which][4] += w1[0] * blo(x.z); y[which][5] += w1[1] * bhi(x.z); y[which][6] += w1[2] * blo(x.w); y[which][7] += w1[3] * bhi(x.w);
            }
#pragma unroll
            for (int e = 0; e < 8; ++e) y[which][e] = fsilu(y[which][e]);
        }
        float sq = 0.f, sk = 0.f;
#pragma unroll
        for (int e = 0; e < 8; ++e) { sq += y[0][e] * y[0][e]; sk += y[1][e] * y[1][e]; }
#pragma unroll
        for (int o = 1; o < 16; o <<= 1) { sq += __shfl_xor(sq, o); sk += __shfl_xor(sk, o); }
        const float rq = rsqrtf(sq + EPS), rk = rsqrtf(sk + EPS);
        const float eg = __expf(gct), ke_s = __expf(gc_last - gct);
        float q8[8], k8[8], kb8[8], qd8[8], ke8[8], kbg8[8], vb8[8];
#pragma unroll
        for (int e = 0; e < 8; ++e) { q8[e] = y[0][e] * rq; k8[e] = y[1][e] * rk; kb8[e] = k8[e] * bet; qd8[e] = q8[e] * (QSCALE * eg); ke8[e] = k8[e] * ke_s; kbg8[e] = kb8[e] * eg; vb8[e] = y[2][e] * bet; }
        const int io = (dc * 64 + tok) * 16;
        *(GL3 bf16x8*)(lds + PL_Q + io) = pack8(q8); *(GL3 bf16x8*)(lds + PL_K + io) = pack8(k8); *(GL3 bf16x8*)(lds + PL_KB + io) = pack8(kb8);
        {
            const int rvo = (tok >> 4) * 1024 + ((tok >> 3) & 1) * 512 + (tok & 7) * 64 + (dc & 3) * 16;
            *(GL3 bf16x8*)(lds + PL_RV + (dc >> 2) * 4096 + rvo) = pack8(kbg8); *(GL3 bf16x8*)(lds + PL_RV + (4 + (dc >> 2)) * 4096 + rvo) = pack8(vb8);
        }
        qd_keep[pass] = pack8(qd8); ke_keep[pass] = pack8(ke8);
    }
    PBAR();
    if (nb_ >= 0) prep_prefetch(pre, P, HALO, nb_, nn_, nh_, wid, lane);
    if (n == 0 && b == 0 && h == 0) XSTAMP(15);
#pragma unroll
    for (int pass = 0; pass < 2; ++pass) {
        const int tok = 8 * wid + 4 * pass + (lane >> 4);
        *(bf16x8*)seg_addr(P, row0, C_DQ + h * 128, (unsigned)((dc * 64 + tok) * 16)) = qd_keep[pass];
        const unsigned ek = (unsigned)(((dc >> 2) * 4 + (tok >> 4)) * 1024 + ((tok >> 3) & 1) * 512 + (tok & 7) * 64 + (dc & 3) * 16);
        *(bf16x8*)seg_addr(P, row0, C_DK + h * 128, ek) = ke_keep[pass];
    }
    if (wid < 6) {
        const bool isA = wid < 3; const int t3 = isA ? wid : wid - 3;
        const int rt = isA ? (t3 > 0) : (t3 == 2);
        const int ct = isA ? (t3 == 2) : (t3 > 0);
        GL3 const unsigned char* aimg = lds + (isA ? PL_KB : PL_K); GL3 const unsigned char* bimg = lds + (isA ? PL_K : PL_Q);
        f32x16 acc = f32x16{};
#pragma unroll
        for (int s = 0; s < 8; ++s) {
            const bf16x8 a = *(GL3 const bf16x8*)(aimg + ((2 * s + hi) * 64 + 32 * rt + r32) * 16);
            const bf16x8 bb = *(GL3 const bf16x8*)(bimg + ((2 * s + hi) * 64 + 32 * ct + r32) * 16);
            acc = __builtin_amdgcn_mfma_f32_32x32x16_bf16(a, bb, acc, 0, 0, 0);
        }
        if (isA) {
            const int j = 32 * ct + r32; const float gj = GC[j];
#pragma unroll
            for (int i_ = 0; i_ < 16; ++i_) { const int i = 32 * rt + crow(i_, hi); AM[i * AMLD + j] = (j < i) ? acc[i_] * __expf(GC[i] - gj) : 0.f; }
        } else {
            const int i = 32 * ct + r32; const float gi = GC[i];
            float v[16];
#pragma unroll
            for (int i_ = 0; i_ < 16; ++i_) { const int j = 32 * rt + crow(i_, hi); v[i_] = (j <= i) ? acc[i_] * (QSCALE * __expf(gi - GC[j])) : 0.f; }
#pragma unroll
            for (int sp = 0; sp < 2; ++sp) *(GL3 bf16x8*)(lds + PL_QKST + (((2 * rt + sp) * 64 + i) * 16 + 8 * hi) * 2) = pack8(v + 8 * sp);
        }
    } else if (wid == 6) {
        const bf16x8 z = {0, 0, 0, 0, 0, 0, 0, 0};
#pragma unroll
        for (int sp = 0; sp < 2; ++sp) *(GL3 bf16x8*)(lds + PL_QKST + (((2 + sp) * 64 + r32) * 16 + 8 * hi) * 2) = z;
    }
    PBAR();
    if (wid < 4 && lane < 16) {
        const int bb = wid, c = lane;
        float x[16];
#pragma unroll
        for (int i = 0; i < 16; ++i) {
            float acc = (i == c) ? 1.f : 0.f;
#pragma unroll
            for (int j4 = 0; j4 < i; j4 += 4) { const f32x4 a = *(GL3 const f32x4*)(AM + (16 * bb + i) * AMLD + 16 * bb + j4);
                acc -= a[0] * x[j4]; if (j4 + 1 < i) acc -= a[1] * x[j4 + 1]; if (j4 + 2 < i) acc -= a[2] * x[j4 + 2]; if (j4 + 3 < i) acc -= a[3] * x[j4 + 3]; }
            x[i] = acc;
        }
#pragma unroll
        for (int i = 0; i < 16; ++i) INV[(16 * bb + i) * AMLD + 16 * bb + c] = x[i];
    }
    PBAR();
    for (int L = 1; L < 4; ++L) {
        const int nb = 4 - L;
        for (int t = tid; t < nb * 256; t += 512) {
            const int J = t >> 8, I = J + L, ei = (t >> 4) & 15, ej = t & 15;
            float acc = 0.f;
            for (int K = J; K < I; ++K) {
#pragma unroll
                for (int k4 = 0; k4 < 16; k4 += 4) { const f32x4 a = *(GL3 const f32x4*)(AM + (16 * I + ei) * AMLD + 16 * K + k4);
                    acc += a[0] * INV[(16 * K + k4) * AMLD + 16 * J + ej] + a[1] * INV[(16 * K + k4 + 1) * AMLD + 16 * J + ej] + a[2] * INV[(16 * K + k4 + 2) * AMLD + 16 * J + ej] + a[3] * INV[(16 * K + k4 + 3) * AMLD + 16 * J + ej]; }
            }
            MT[(J * 16 + ei) * 17 + ej] = acc;
        }
        PBAR();
        for (int t = tid; t < nb * 256; t += 512) {
            const int J = t >> 8, I = J + L, ei = (t >> 4) & 15, ej = t & 15;
            float acc = 0.f;
#pragma unroll
            for (int k4 = 0; k4 < 16; k4 += 4) { const f32x4 d = *(GL3 const f32x4*)(INV + (16 * I + ei) * AMLD + 16 * I + k4);
                acc += d[0] * MT[(J * 16 + k4) * 17 + ej] + d[1] * MT[(J * 16 + k4 + 1) * 17 + ej] + d[2] * MT[(J * 16 + k4 + 2) * 17 + ej] + d[3] * MT[(J * 16 + k4 + 3) * 17 + ej]; }
            INV[(16 * I + ei) * AMLD + 16 * J + ej] = -acc;
        }
        PBAR();
    }
    {
        const int s_ = tid >> 7, i = (tid >> 1) & 63, hh = tid & 1;
        float v[8];
        if (s_ > (i >> 4)) {
#pragma unroll
            for (int e = 0; e < 8; ++e) v[e] = 0.f;
        } else {
            const f32x4 a = *(GL3 const f32x4*)(INV + i * AMLD + 16 * s_ + 4 * hh), c4 = *(GL3 const f32x4*)(INV + i * AMLD + 16 * s_ + 8 + 4 * hh);
            v[0] = a[0]; v[1] = a[1]; v[2] = a[2]; v[3] = a[3]; v[4] = c4[0]; v[5] = c4[1]; v[6] = c4[2]; v[7] = c4[3];
        }
        *(GL3 bf16x8*)(lds + PL_TI + ((s_ * 64 + i) * 16 + 8 * hh) * 2) = pack8(v);
    }
    PBAR();
    {
        const int cb = wid;
        GL3 const unsigned char* rp = lds + PL_RV + cb * 4096 + ((lane >> 4) & 1) * 32 + (lane & 3) * 8 + (4 * hi + ((lane & 15) >> 2)) * 64;
        f32x16 d0 = f32x16{}, d1 = f32x16{};
#pragma unroll
        for (int ks = 0; ks < 4; ++ks) {
            const s16x4 lo = vtr(rp + ks * 1024), hh2 = vtr(rp + ks * 1024 + 512);
            const bf16x8 rf = {lo[0], lo[1], lo[2], lo[3], hh2[0], hh2[1], hh2[2], hh2[3]};
            const bf16x8 t1 = *(GL3 const bf16x8*)(lds + PL_TI + ((ks * 64 + 32 + r32) * 16 + 8 * hi) * 2);
            if (cb < 4) {
                if (ks < 2) { const bf16x8 t0 = *(GL3 const bf16x8*)(lds + PL_TI + ((ks * 64 + r32) * 16 + 8 * hi) * 2); d0 = __builtin_amdgcn_mfma_f32_32x32x16_bf16(rf, t0, d0, 0, 0, 0); }
                d1 = __builtin_amdgcn_mfma_f32_32x32x16_bf16(rf, t1, d1, 0, 0, 0);
            } else {
                if (ks < 2) { const bf16x8 t0 = *(GL3 const bf16x8*)(lds + PL_TI + ((ks * 64 + r32) * 16 + 8 * hi) * 2); d0 = __builtin_amdgcn_mfma_f32_32x32x16_bf16(t0, rf, d0, 0, 0, 0); }
                d1 = __builtin_amdgcn_mfma_f32_32x32x16_bf16(t1, rf, d1, 0, 0, 0);
            }
        }
        PBAR();
        if (cb < 4) {
#pragma unroll
            for (int a = 0; a < 4; ++a) {
                u32x2 w0 = {pk(d0[4 * a], d0[4 * a + 1]), pk(d0[4 * a + 2], d0[4 * a + 3])}, w1 = {pk(d1[4 * a], d1[4 * a + 1]), pk(d1[4 * a + 2], d1[4 * a + 3])};
                *(GL3 u32x2*)(lds + PL_WST + ((4 * cb + a) * 64 + r32) * 16 + 8 * hi) = w0;
                *(GL3 u32x2*)(lds + PL_WST + ((4 * cb + a) * 64 + 32 + r32) * 16 + 8 * hi) = w1;
            }
        } else {
            const int dvc = 32 * (cb - 4) + r32;
#pragma unroll
            for (int i = 0; i < 16; ++i) { *(GL3 bf16_t*)(lds + PL_UST + (crow(i, hi) * 128 + dvc) * 2) = f2bf(d0[i]); *(GL3 bf16_t*)(lds + PL_UST + ((32 + crow(i, hi)) * 128 + dvc) * 2) = f2bf(d1[i]); }
        }
    }
    PBAR();
#pragma unroll
    for (int k = 0; k < 2; ++k) {
        const int e = (tid + 512 * k) * 16;
        *(u32x4*)((char*)(GW + (size_t)item * 8192) + e) = *(GL3 const u32x4*)(lds + PL_WST + e);
        *(u32x4*)seg_addr(P, row0, C_DV + h * 128, (unsigned)e) = *(GL3 const u32x4*)(lds + PL_UST + e);
    }
    *(u32x4*)((char*)(GQK + (size_t)item * 4096) + tid * 16) = *(GL3 const u32x4*)(lds + PL_QKST + tid * 16);
    if (tid == 0) GLv[item] = __expf(gc_last);
    PBAR();
}

#undef PBAR
constexpr int SL_W = 0, SL_QD = 16384, SL_KE = 32768, SL_QK = 49152, SL_U = 57344, SL_Z = 73728, SL_S = 90112, SL_VN = 122880, SL_RS = 139264, SL_END = 140416;
__device__ __forceinline__ void glds16(const void* gsrc, unsigned lds_dst) { unsigned keep;
    asm volatile("s_mov_b32 %0, m0\n\ts_mov_b32 m0, %2\n\ts_nop 0\n\tglobal_load_lds_dwordx4 %1, off\n\ts_mov_b32 m0, %0" : "=&s"(keep) : "v"(gsrc), "s"(lds_dst) : "memory"); }
__device__ __forceinline__ unsigned lds_addr(GL3 unsigned char* p) { return (unsigned)(size_t)p; }
__device__ __forceinline__ void dma_seg(GL3 unsigned char* dst, const bf16_t* P, size_t row0, int c0, int wid, int lane) {
#pragma unroll
    for (int k = 0; k < 2; ++k) { const int piece = wid + 8 * k;
        const char* src = (const char*)P + ((row0 + piece * 4 + (lane >> 4)) * LDP + c0) * 2 + (lane & 15) * 16;
        glds16(src, (unsigned)__builtin_amdgcn_readfirstlane((int)(lds_addr(dst) + piece * 1024))); }
}
template <int NPIECES>
__device__ __forceinline__ void dma_lin(GL3 unsigned char* dst, const bf16_t* src, int wid, int lane) {
#pragma unroll
    for (int k = 0; k < NPIECES / 8; ++k) { const int piece = wid + 8 * k;
        glds16((const char*)src + piece * 1024 + lane * 16, (unsigned)__builtin_amdgcn_readfirstlane((int)(lds_addr(dst) + piece * 1024))); }
}

__device__ __forceinline__ float sum32(float v) {
    v += __builtin_bit_cast(float, __builtin_amdgcn_mov_dpp(__builtin_bit_cast(int, v), 0xB1, 0xF, 0xF, true));
    v += __builtin_bit_cast(float, __builtin_amdgcn_mov_dpp(__builtin_bit_cast(int, v), 0x4E, 0xF, 0xF, true));
    v += __builtin_bit_cast(float, __builtin_amdgcn_mov_dpp(__builtin_bit_cast(int, v), 0x141, 0xF, 0xF, true));
    v += __builtin_bit_cast(float, __builtin_amdgcn_mov_dpp(__builtin_bit_cast(int, v), 0x140, 0xF, 0xF, true));
    v += __shfl_xor(v, 16);
    return v;
}
#define GRAWBAR() do { asm volatile("s_waitcnt lgkmcnt(0)" ::: "memory"); __builtin_amdgcn_s_barrier(); asm volatile("" ::: "memory"); } while (0)
#define GWAITV0() asm volatile("s_waitcnt vmcnt(0)" ::: "memory")
constexpr int SL_GL = SL_RS + 1024;
__device__ __forceinline__ void scan_item(GL3 unsigned char* lds, bf16_t* P, const bf16_t* GW, const bf16_t* GQK, const float* GLv, const float* out_norm, int b, int h) {
    const int tid = threadIdx.x, lane = tid & 63, r32 = lane & 31, hi = lane >> 5; const int wid = __builtin_amdgcn_readfirstlane(tid >> 6);
    const int mt = wid >> 2, nt = wid & 3;
    const int dv = 32 * nt + r32;
    const int item0 = (b * DN_H + h) * 32; const size_t rowb = (size_t)b * SEQ;
    f32x16 S0 = f32x16{}, S1 = f32x16{};
    {
        const u32x4 z = {0u, 0u, 0u, 0u};
#pragma unroll
        for (int k = 0; k < 4; ++k) *(GL3 u32x4*)(lds + SL_S + (tid + 512 * k) * 16) = z;
        if (tid < 32) *(GL3 float*)(lds + SL_GL + tid * 4) = GLv[item0 + tid];
    }
    const float gain = out_norm[dv];
    GL3 float* RS = (GL3 float*)(lds + SL_RS);
#define ISSUE_A(n_) do { dma_lin<16>(lds + SL_W, GW + (size_t)(item0 + (n_)) * 8192, wid, lane); dma_seg(lds + SL_QD, P, rowb + 64 * (n_), C_DQ + h * 128, wid, lane); dma_seg(lds + SL_U, P, rowb + 64 * (n_), C_DV + h * 128, wid, lane); } while (0)
#define ISSUE_B(n_) do { dma_seg(lds + SL_KE, P, rowb + 64 * (n_), C_DK + h * 128, wid, lane); dma_lin<8>(lds + SL_QK, GQK + (size_t)(item0 + (n_)) * 4096, wid, lane); dma_seg(lds + SL_Z, P, rowb + 64 * (n_), C_DZ + h * 128, wid, lane); } while (0)
    GWAITV0();
    ISSUE_A(0);
    f32x16 oprev = f32x16{}; unsigned zprev[8] = {0u, 0u, 0u, 0u, 0u, 0u, 0u, 0u};
#define Y_OUT(n_) do { const size_t rowy = rowb + 64 * (n_); _Pragma("unroll") for (int i = 0; i < 16; ++i) { const int tok = 32 * mt + crow(i, hi); \
            const f32x4 rs = *(GL3 const f32x4*)(RS + tok * 4); \
            const float rstd = rsqrtf(((rs[0] + rs[1]) + (rs[2] + rs[3])) * (1.f / 128.f) + EPS); \
            const float z = (i & 1) ? bhi(zprev[i >> 1]) : blo(zprev[i >> 1]); \
            P[(rowy + tok) * LDP + C_DZ + h * 128 + dv] = f2bf(oprev[i] * rstd * gain * fsilu(z)); } } while (0)
    for (int n = 0; n < 32; ++n) {
        GWAITV0(); GRAWBAR();
        ISSUE_B(n);
        if (n > 0) Y_OUT(n - 1);
        const float gl = *(GL3 const float*)(lds + SL_GL + n * 4);
        f32x16 vp = f32x16{}, o = f32x16{};
#pragma unroll
        for (int s = 0; s < 8; ++s) {
            const bf16x8 sb = *(GL3 const bf16x8*)(lds + SL_S + ((2 * s + hi) * 128 + dv) * 16);
            const bf16x8 wa = *(GL3 const bf16x8*)(lds + SL_W + ((2 * s + hi) * 64 + 32 * mt + r32) * 16);
            const bf16x8 qa = *(GL3 const bf16x8*)(lds + SL_QD + ((2 * s + hi) * 64 + 32 * mt + r32) * 16);
            vp = __builtin_amdgcn_mfma_f32_32x32x16_bf16(wa, sb, vp, 0, 0, 0);
            o = __builtin_amdgcn_mfma_f32_32x32x16_bf16(qa, sb, o, 0, 0, 0);
        }
        {
            float v[16];
#pragma unroll
            for (int i = 0; i < 16; ++i) v[i] = bf2f(*(GL3 const bf16_t*)(lds + SL_U + ((32 * mt + crow(i, hi)) * 128 + dv) * 2)) - vp[i];
#pragma unroll
            for (int sp = 0; sp < 2; ++sp) *(GL3 bf16x8*)(lds + SL_VN + (((2 * mt + sp) * 128 + dv) * 16 + 8 * hi) * 2) = pack8(v + 8 * sp);
        }
        GWAITV0(); GRAWBAR();
        if (n + 1 < 32) ISSUE_A(n + 1);
#pragma unroll
        for (int i = 0; i < 16; i += 2) { const unsigned za = *(GL3 const bf16_t*)(lds + SL_Z + ((32 * mt + crow(i, hi)) * 128 + dv) * 2), zb = *(GL3 const bf16_t*)(lds + SL_Z + ((32 * mt + crow(i + 1, hi)) * 128 + dv) * 2); zprev[i >> 1] = za | (zb << 16); }
#pragma unroll
        for (int i = 0; i < 16; ++i) { S0[i] *= gl; S1[i] *= gl; }
        {
            GL3 const unsigned char* kp0 = lds + SL_KE + (2 * mt) * 4096 + ((lane >> 4) & 1) * 32 + (lane & 3) * 8 + (4 * hi + ((lane & 15) >> 2)) * 64;
#pragma unroll
            for (int ks = 0; ks < 4; ++ks) {
                const bf16x8 vb = *(GL3 const bf16x8*)(lds + SL_VN + ((ks * 128 + dv) * 16 + 8 * hi) * 2);
                const s16x4 l0 = vtr(kp0 + ks * 1024), h0 = vtr(kp0 + ks * 1024 + 512), l1 = vtr(kp0 + 4096 + ks * 1024), h1 = vtr(kp0 + 4096 + ks * 1024 + 512);
                const bf16x8 k0 = {l0[0], l0[1], l0[2], l0[3], h0[0], h0[1], h0[2], h0[3]}, k1 = {l1[0], l1[1], l1[2], l1[3], h1[0], h1[1], h1[2], h1[3]};
                const bf16x8 qa = *(GL3 const bf16x8*)(lds + SL_QK + ((ks * 64 + 32 * mt + r32) * 16 + 8 * hi) * 2);
                S0 = __builtin_amdgcn_mfma_f32_32x32x16_bf16(k0, vb, S0, 0, 0, 0);
                S1 = __builtin_amdgcn_mfma_f32_32x32x16_bf16(k1, vb, S1, 0, 0, 0);
                o = __builtin_amdgcn_mfma_f32_32x32x16_bf16(qa, vb, o, 0, 0, 0);
            }
        }
#pragma unroll
        for (int a = 0; a < 4; ++a) {
            u32x2 w0 = {pk(S0[4 * a], S0[4 * a + 1]), pk(S0[4 * a + 2], S0[4 * a + 3])}, w1 = {pk(S1[4 * a], S1[4 * a + 1]), pk(S1[4 * a + 2], S1[4 * a + 3])};
            *(GL3 u32x2*)(lds + SL_S + ((4 * (2 * mt) + a) * 128 + dv) * 16 + 8 * hi) = w0;
            *(GL3 u32x2*)(lds + SL_S + ((4 * (2 * mt + 1) + a) * 128 + dv) * 16 + 8 * hi) = w1;
        }
#pragma unroll
        for (int i = 0; i < 16; ++i) { const float q = sum32(o[i] * o[i]); if (r32 == 0) RS[(32 * mt + crow(i, hi)) * 4 + nt] = q; }
        oprev = o;
    }
    GWAITV0(); GRAWBAR();
    Y_OUT(31);
    GWAITV0();
    __syncthreads();
#undef Y_OUT
#undef ISSUE_A
#undef ISSUE_B
}
}
namespace nsa {
#define NLAS __attribute__((address_space(3)))
typedef short bf16x8 __attribute__((ext_vector_type(8)));
typedef short s16x4 __attribute__((ext_vector_type(4)));
typedef short v4i16_t __attribute__((ext_vector_type(4)));
typedef float f32x16 __attribute__((ext_vector_type(16)));
typedef float f32x4 __attribute__((ext_vector_type(4)));
typedef float f32x2 __attribute__((ext_vector_type(2)));
typedef unsigned u32x4 __attribute__((ext_vector_type(4)));
typedef __bf16 bf16x2_t __attribute__((ext_vector_type(2)));
constexpr float LOG2E = 1.4426950408889634f;
constexpr float NEG = -1e30f;
constexpr int L_KV = 0;
constexpr int L_IMP = 49152;
constexpr int L_SEL = 82944;
constexpr int L_WS = 83456;
constexpr int L_OST = 85504;
constexpr int L_END = 118272;

__device__ __forceinline__ int crow(int i, int hi) { return (i & 3) + 8 * (i >> 2) + 4 * hi; }
__device__ __forceinline__ unsigned pk(float lo, float hi) { f32x2 v = {lo, hi}; bf16x2_t b = __builtin_convertvector(v, bf16x2_t); return __builtin_bit_cast(unsigned, b); }
__device__ __forceinline__ float xhalf_max(float v) { auto rr = __builtin_amdgcn_permlane32_swap(__float_as_uint(v), __float_as_uint(v), false, false); return fmaxf(__uint_as_float(rr[0]), __uint_as_float(rr[1])); }
__device__ __forceinline__ float xhalf_sum(float v) { auto rr = __builtin_amdgcn_permlane32_swap(__float_as_uint(v), __float_as_uint(v), false, false); return __uint_as_float(rr[0]) + __uint_as_float(rr[1]); }

__device__ __forceinline__ void dma_tile(NLAS unsigned char* slot, const bf16_t* Kb, const bf16_t* Vb, unsigned koff, unsigned voff, int wid) {
    __builtin_amdgcn_global_load_lds((const unsigned*)((const char*)Kb + koff), (NLAS unsigned*)(slot + wid * 1024), 16, 0, 0);
    __builtin_amdgcn_global_load_lds((const unsigned*)((const char*)Vb + voff), (NLAS unsigned*)(slot + 8192 + wid * 1024), 16, 0, 0);
}
__device__ __forceinline__ void glds16(const void* gsrc, unsigned lds_dst) { unsigned keep;
    asm volatile("s_mov_b32 %0, m0\n\ts_mov_b32 m0, %2\n\ts_nop 0\n\tglobal_load_lds_dwordx4 %1, off\n\ts_mov_b32 m0, %0" : "=&s"(keep) : "v"(gsrc), "s"(lds_dst) : "memory"); }
__device__ __forceinline__ void dma_tile_a(NLAS unsigned char* slot, const bf16_t* Kb, const bf16_t* Vb, unsigned koff, unsigned voff, int wid) {
    const unsigned base = (unsigned)(size_t)slot + (unsigned)wid * 1024u;
    glds16((const char*)Kb + koff, (unsigned)__builtin_amdgcn_readfirstlane((int)base));
    glds16((const char*)Vb + voff, (unsigned)__builtin_amdgcn_readfirstlane((int)(base + 8192u)));
}
#define RING_WAIT_BAR(N) do { asm volatile("s_waitcnt vmcnt(" #N ") lgkmcnt(0)" ::: "memory"); __builtin_amdgcn_s_barrier(); asm volatile("" ::: "memory"); } while (0)
__device__ __forceinline__ void tile_offs(unsigned& koff, unsigned& voff, int pitch, int wid, int lane) {
    koff = (unsigned)(lane * pitch + wid * 8) * 2u;
    voff = (unsigned)((16 * (wid & 3) + (lane >> 2)) * pitch + (wid >> 2) * 32 + (lane & 3) * 8) * 2u;
}
__device__ __forceinline__ void qkt(f32x16& p0, f32x16& p1, NLAS const unsigned char* Kslot, const bf16x8* qr, const f32x16& c0, const f32x16& c1, int r32, int hi) {
    NLAS const unsigned char* kb = Kslot + hi * 1024 + r32 * 16;
#pragma unroll
    for (int d0 = 0; d0 < 4; ++d0) {
        const bf16x8 b0 = *(NLAS const bf16x8*)(kb + d0 * 2048);
        const bf16x8 b1 = *(NLAS const bf16x8*)(kb + d0 * 2048 + 512);
        if (d0 == 0) { p0 = __builtin_amdgcn_mfma_f32_32x32x16_bf16(b0, qr[0], c0, 0, 0, 0); p1 = __builtin_amdgcn_mfma_f32_32x32x16_bf16(b1, qr[0], c1, 0, 0, 0); }
        else { p0 = __builtin_amdgcn_mfma_f32_32x32x16_bf16(b0, qr[d0], p0, 0, 0, 0); p1 = __builtin_amdgcn_mfma_f32_32x32x16_bf16(b1, qr[d0], p1, 0, 0, 0); }
    }
}
__device__ __forceinline__ s16x4 vtr(NLAS const unsigned char* p) { return __builtin_bit_cast(s16x4, __builtin_amdgcn_ds_read_tr16_b64_v4i16((NLAS v4i16_t*)p)); }
__device__ __forceinline__ void pv(f32x16* o, NLAS const unsigned char* Vslot, const f32x16& p0, const f32x16& p1, int lane, int hi) {
    u32x4 w0 = {pk(p0[0], p0[1]), pk(p0[2], p0[3]), pk(p0[4], p0[5]), pk(p0[6], p0[7])};
    u32x4 w1 = {pk(p0[8], p0[9]), pk(p0[10], p0[11]), pk(p0[12], p0[13]), pk(p0[14], p0[15])};
    u32x4 w2 = {pk(p1[0], p1[1]), pk(p1[2], p1[3]), pk(p1[4], p1[5]), pk(p1[6], p1[7])};
    u32x4 w3 = {pk(p1[8], p1[9]), pk(p1[10], p1[11]), pk(p1[12], p1[13]), pk(p1[14], p1[15])};
    const bf16x8 pa[4] = {__builtin_bit_cast(bf16x8, w0), __builtin_bit_cast(bf16x8, w1), __builtin_bit_cast(bf16x8, w2), __builtin_bit_cast(bf16x8, w3)};
    NLAS const unsigned char* vp = Vslot + ((lane >> 4) & 1) * 32 + (lane & 3) * 8 + (4 * hi + ((lane & 15) >> 2)) * 64;
#pragma unroll
    for (int d0 = 0; d0 < 2; ++d0)
#pragma unroll
        for (int ks = 0; ks < 4; ++ks) {
            const s16x4 lo = vtr(vp + d0 * 4096 + ks * 1024), hh = vtr(vp + d0 * 4096 + ks * 1024 + 512);
            const bf16x8 vf = {lo[0], lo[1], lo[2], lo[3], hh[0], hh[1], hh[2], hh[3]};
            o[d0] = __builtin_amdgcn_mfma_f32_32x32x16_bf16(pa[ks], vf, o[d0], 0, 0, 0);
        }
}
__device__ __forceinline__ void scale_rows(f32x16* o, NLAS float* wsf, float s, int r32, int hi) {
    if (hi == 0) wsf[r32] = s;
#pragma unroll
    for (int i = 0; i < 16; ++i) { const float f = wsf[crow(i, hi)]; o[0][i] *= f; o[1][i] *= f; }
}
__device__ __forceinline__ void acc_rows(f32x16* tot, const f32x16* o, NLAS float* wsf, float s, int r32, int hi) {
    if (hi == 0) wsf[32 + r32] = s;
#pragma unroll
    for (int i = 0; i < 16; ++i) { const float f = wsf[32 + crow(i, hi)]; tot[0][i] += f * o[0][i]; tot[1][i] += f * o[1][i]; }
}
#define MX3(a, b, c) __builtin_fmaxf(__builtin_fmaxf((a), (b)), (c))
__device__ __forceinline__ void softmax_step(f32x16& p0, f32x16& p1, float& m, float& l, f32x16* o, NLAS float* wsf, int r32, int hi) {
    float ta = MX3(p0[0], p0[1], p1[0]), tb = MX3(p0[2], p0[3], p1[1]); ta = MX3(ta, p1[2], p1[3]);
#pragma unroll
    for (int r = 4; r < 16; r += 4) { ta = MX3(ta, p0[r], p0[r + 1]); tb = MX3(tb, p0[r + 2], p0[r + 3]); ta = MX3(ta, p1[r], p1[r + 1]); tb = MX3(tb, p1[r + 2], p1[r + 3]); }
    float t = xhalf_max(fmaxf(ta, tb));
    if (__any(t > 8.f)) {
        const float d = fmaxf(t, 0.f);
        m += d;
#pragma unroll
        for (int i = 0; i < 16; ++i) { p0[i] -= d; p1[i] -= d; }
        const float alpha = __builtin_amdgcn_exp2f(-d);
        l *= alpha;
        scale_rows(o, wsf, alpha, r32, hi);
    }
    float s = 0.f;
#pragma unroll
    for (int i = 0; i < 16; ++i) { p0[i] = __builtin_amdgcn_exp2f(p0[i]); p1[i] = __builtin_amdgcn_exp2f(p1[i]); s += p0[i] + p1[i]; }
    l += s;
}

__device__ __forceinline__ void attn_tile(NLAS unsigned char* lds, bf16_t* P, const bf16_t* KC, const bf16_t* VC, int b, int g, int qt) {
    int tid = threadIdx.x; asm volatile("" : "+v"(tid));
    const int lane = tid & 63, r32 = lane & 31, hi = lane >> 5; const int wid = __builtin_amdgcn_readfirstlane(tid >> 6);
    const int head = g * 4 + (wid >> 1), qh = wid & 1, t0 = qt * 64, qi = qh * 32 + r32, blk_t = qt;
    NLAS float* wsf = (NLAS float*)(lds + L_WS) + wid * 64;
    NLAS float* imp = (NLAS float*)(lds + L_IMP);
    NLAS unsigned* selm = (NLAS unsigned*)(lds + L_SEL);
    NLAS unsigned char* slot0 = lds + L_KV; NLAS unsigned char* slot1 = lds + L_KV + 16384;
    const size_t rowbase = (size_t)b * SEQ;
    bf16_t* qrow = P + (rowbase + t0 + qi) * LDP;
    const float sl2 = exp2f(-0.5f * (float)(head + 1)) * LOG2E;
    bf16x8 qr[4];
#pragma unroll
    for (int d0 = 0; d0 < 4; ++d0) qr[d0] = *(const bf16x8*)(qrow + C_NQ + head * 64 + d0 * 16 + hi * 8);
#define FSIG(x) __builtin_amdgcn_rcpf(1.f + __builtin_amdgcn_exp2f(-LOG2E * (x)))
    const float gate_c = FSIG(bf2f(qrow[C_SG + head * 3 + 0])), gate_s = FSIG(bf2f(qrow[C_SG + head * 3 + 1])), gate_w = FSIG(bf2f(qrow[C_SG + head * 3 + 2]));
#undef FSIG
    f32x16 tot[2]; tot[0] = f32x16{}; tot[1] = f32x16{};
    XSTAMP(30);
#define CRF(i) ((float)(((i) & 3) + 8 * ((i) >> 2)) + 4.f * (float)hiv)
#define OPAQUE_HI() int hiv = hi; asm volatile("" : "+v"(hiv))

    {
        const bf16_t* kcb = KC + ((size_t)(b * NS_G + g) * 128) * 64; const bf16_t* vcb = VC + ((size_t)(b * NS_G + g) * 128) * 64;
        const bool two = (qt >= 16);
        unsigned kof, vof; tile_offs(kof, vof, 64, wid, lane);
        dma_tile(slot0, kcb, vcb, kof, vof, wid);
        if (two) dma_tile(slot1, kcb + 64 * 64, vcb + 64 * 64, kof, vof, wid);
        __syncthreads();
        f32x16 pA0, pA1, pB0, pB1, c0, c1;
        const float s16 = sl2 * 16.f; OPAQUE_HI();
#pragma unroll
        for (int i = 0; i < 16; ++i) { c0[i] = s16 * CRF(i); c1[i] = s16 * (CRF(i) + 32.f); }
        qkt(pA0, pA1, slot0, qr, c0, c1, r32, hi);
        const int cmax = (t0 + qi - 31) >> 4;
        const int qposm = t0 + qi - 31;
#pragma unroll
        for (int i = 0; i < 16; ++i) { const int c = crow(i, hiv); if (16 * c > qposm) pA0[i] = NEG; if (16 * (c + 32) > qposm) pA1[i] = NEG; }
        if (two) {
#pragma unroll
            for (int i = 0; i < 16; ++i) { c0[i] += s16 * 64.f; c1[i] += s16 * 64.f; }
            qkt(pB0, pB1, slot1, qr, c0, c1, r32, hi);
#pragma unroll
            for (int i = 0; i < 16; ++i) { const int c = 64 + crow(i, hiv); if (16 * c > qposm) pB0[i] = NEG; if (16 * (c + 32) > qposm) pB1[i] = NEG; }
        } else { pB0 = f32x16{}; pB1 = f32x16{}; }
        (void)cmax;
        float mx = NEG;
#pragma unroll
        for (int i = 0; i < 16; ++i) mx = fmaxf(mx, fmaxf(pA0[i], pA1[i]));
        if (two) {
#pragma unroll
            for (int i = 0; i < 16; ++i) mx = fmaxf(mx, fmaxf(pB0[i], pB1[i])); }
        mx = xhalf_max(mx);
        float s = 0.f;
#pragma unroll
        for (int i = 0; i < 16; ++i) { pA0[i] = __builtin_amdgcn_exp2f(pA0[i] - mx); pA1[i] = __builtin_amdgcn_exp2f(pA1[i] - mx); s += pA0[i] + pA1[i]; }
        if (two) {
#pragma unroll
            for (int i = 0; i < 16; ++i) { pB0[i] = __builtin_amdgcn_exp2f(pB0[i] - mx); pB1[i] = __builtin_amdgcn_exp2f(pB1[i] - mx); s += pB0[i] + pB1[i]; } }
        s = xhalf_sum(s);
        const float nrm = (t0 + qi >= 31) ? __builtin_amdgcn_rcpf(s) : 0.f;
#pragma unroll
        for (int i = 0; i < 16; ++i) { pA0[i] *= nrm; pA1[i] *= nrm; }
        if (two) {
#pragma unroll
            for (int i = 0; i < 16; ++i) { pB0[i] *= nrm; pB1[i] *= nrm; } }
#define PSEL(L) ((L) < 4 ? pA0 : (L) < 8 ? pA1 : (L) < 12 ? pB0 : pB1)
#define MAINV(L) ((PSEL(L)[4 * ((L) & 3)] + PSEL(L)[4 * ((L) & 3) + 1]) + (PSEL(L)[4 * ((L) & 3) + 2] + 0.5f * PSEL(L)[4 * ((L) & 3) + 3]))
#define CARRY(L) (0.5f * PSEL(L)[4 * ((L) & 3) + 3])
#pragma unroll
        for (int L = 0; L < 16; ++L) {
            const float cprev = (L > 0) ? CARRY(L > 0 ? L - 1 : 0) : 0.f;
            const float snd = hi ? cprev : CARRY(L);
            const float rcv = __shfl_xor(snd, 32);
            imp[((wid >> 1) * 64 + qi) * 33 + 2 * L + hi] = MAINV(L) + rcv;
        }
#undef PSEL
#undef MAINV
#undef CARRY
        f32x16 o[2]; o[0] = f32x16{}; o[1] = f32x16{};
        pv(o, slot0 + 8192, pA0, pA1, lane, hi);
        if (two) pv(o, slot1 + 8192, pB0, pB1, lane, hi);
        acc_rows(tot, o, wsf, gate_c, r32, hi);
    }
    __syncthreads();
    XSTAMP(31);
    {
        const int ql = 8 * wid + (lane >> 3), sub = lane & 7;
        float v[4];
#pragma unroll
        for (int e = 0; e < 4; ++e) { const int j = 4 * sub + e; v[e] = (imp[(0 * 64 + ql) * 33 + j] + imp[(1 * 64 + ql) * 33 + j]) + (imp[(2 * 64 + ql) * 33 + j] + imp[(3 * 64 + ql) * 33 + j]);
            if (j < 1 || j >= blk_t) v[e] = -1.f; }
        unsigned mask = 1u | (1u << blk_t);
#pragma unroll 1
        for (int it = 0; it < 6; ++it) {
            float bv = fmaxf(fmaxf(v[0], v[1]), fmaxf(v[2], v[3]));
            bv = fmaxf(bv, __builtin_bit_cast(float, __builtin_amdgcn_mov_dpp(__builtin_bit_cast(int, bv), 0xB1, 0xF, 0xF, true)));
            bv = fmaxf(bv, __builtin_bit_cast(float, __builtin_amdgcn_mov_dpp(__builtin_bit_cast(int, bv), 0x4E, 0xF, 0xF, true)));
            bv = fmaxf(bv, __builtin_bit_cast(float, __builtin_amdgcn_mov_dpp(__builtin_bit_cast(int, bv), 0x141, 0xF, 0xF, true)));
            int bj = (v[3] == bv) ? 4 * sub + 3 : 64; bj = (v[2] == bv) ? 4 * sub + 2 : bj; bj = (v[1] == bv) ? 4 * sub + 1 : bj; bj = (v[0] == bv) ? 4 * sub : bj;
            bj = min(bj, __builtin_amdgcn_mov_dpp(bj, 0xB1, 0xF, 0xF, true));
            bj = min(bj, __builtin_amdgcn_mov_dpp(bj, 0x4E, 0xF, 0xF, true));
            bj = min(bj, __builtin_amdgcn_mov_dpp(bj, 0x141, 0xF, 0xF, true));
            if (bv >= 0.f) { mask |= 1u << bj;
#pragma unroll
                for (int e = 0; e < 4; ++e) if (4 * sub + e == bj) v[e] = -1.f; }
        }
        if (sub == 0) selm[ql] = mask;
        unsigned any = mask;
        any |= __shfl_xor(any, 8); any |= __shfl_xor(any, 16); any |= __shfl_xor(any, 32);
        if (lane == 0) selm[64 + wid] = any;
    }
    __syncthreads();
    XSTAMP(32);
    const unsigned mymask = selm[qi];
    const unsigned anym = (unsigned)__builtin_amdgcn_readfirstlane((int)((selm[64] | selm[65]) | (selm[66] | selm[67]) | (selm[68] | selm[69]) | (selm[70] | selm[71])));
    unsigned kofP, vofP; tile_offs(kofP, vofP, LDP, wid, lane);
    {
        const bf16_t* kb = P + rowbase * LDP + C_KS + g * 64; const bf16_t* vb = P + rowbase * LDP + C_VS + g * 64;
        unsigned todo = anym;
        float m = 0.f, l = 0.f; f32x16 o[2]; o[0] = f32x16{}; o[1] = f32x16{};
        int j0 = __builtin_ctz(todo); todo &= todo - 1;
        int j1 = todo ? __builtin_ctz(todo) : -1; if (todo) todo &= todo - 1;
        dma_tile_a(lds + L_KV, kb + (size_t)j0 * 64 * LDP, vb + (size_t)j0 * 64 * LDP, kofP, vofP, wid);
        if (j1 >= 0) { dma_tile_a(lds + L_KV + 16384, kb + (size_t)j1 * 64 * LDP, vb + (size_t)j1 * 64 * LDP, kofP, vofP, wid); RING_WAIT_BAR(2); } else RING_WAIT_BAR(0);
        int sl = 0;
#if defined(TPROBE)
        unsigned long long tq_ = 0, ts_ = 0, tp_ = 0, tw_ = 0, tn_ = 0, tc_;
#define TACC(v) do { const unsigned long long now_ = __builtin_amdgcn_s_memrealtime(); v += now_ - tc_; tc_ = now_; } while (0)
        tc_ = __builtin_amdgcn_s_memrealtime();
#else
#define TACC(v) do { } while (0)
#endif
        for (;;) {
            const int j2 = todo ? __builtin_ctz(todo) : -1; if (todo) todo &= todo - 1;
            const int sl2i = (sl >= 1) ? sl - 1 : 2;
            if (j2 >= 0) dma_tile_a(lds + L_KV + sl2i * 16384, kb + (size_t)j2 * 64 * LDP, vb + (size_t)j2 * 64 * LDP, kofP, vofP, wid);
            NLAS unsigned char* sc = lds + L_KV + sl * 16384;
            const int j = j0;
            const bool mine = (mymask >> j) & 1u;
            const bool far = sl2 * (float)(t0 - 64 * j - 63) > 200.f;
            if (__any(mine) && !far) {
                f32x16 p0, p1, c0, c1; const float kb0 = sl2 * (float)(j * 64 - t0) - m; OPAQUE_HI();
#pragma unroll
                for (int i = 0; i < 16; ++i) { c0[i] = kb0 + sl2 * CRF(i); c1[i] = c0[i] + sl2 * 32.f; }
                qkt(p0, p1, sc, qr, c0, c1, r32, hi);
                asm volatile("s_nop 7\n\ts_nop 7" : "+v"(p0), "+v"(p1)); TACC(tq_);
                if (j == blk_t) {
                    asm volatile("" ::: "memory");
#pragma unroll
                    for (int i = 0; i < 16; ++i) { const int kk = crow(i, hiv); if (kk > qi) p0[i] = NEG; if (kk + 32 > qi) p1[i] = NEG; }
                }
                if (__any(!mine)) {
                    asm volatile("" ::: "memory");
                    if (!mine) {
#pragma unroll
                        for (int i = 0; i < 16; ++i) { p0[i] = NEG; p1[i] = NEG; } }
                }
                softmax_step(p0, p1, m, l, o, wsf, r32, hi);
                asm volatile("" : "+v"(p0), "+v"(p1)); TACC(ts_);
                pv(o, sc + 8192, p0, p1, lane, hi);
                asm volatile("s_nop 7\n\ts_nop 7" : "+v"(o[0]), "+v"(o[1])); TACC(tp_);
            }
#if defined(TPROBE)
            tn_ += 100;
#endif
            if (j1 < 0) break;
            if (j2 >= 0) RING_WAIT_BAR(2); else RING_WAIT_BAR(0);
            TACC(tw_);
            j0 = j1; j1 = j2; sl = (sl == 2) ? 0 : sl + 1;
        }
        RING_WAIT_BAR(0);
#if defined(TPROBE)
        if (b == 0 && g == 3 && qt == 24 && threadIdx.x == 0) { volatile unsigned long long* t_ = (volatile unsigned long long*)((char*)P + (size_t)16384 * LDP * 2 + 2048); t_[0] = 0; t_[1] = tq_; t_[2] = ts_; t_[3] = tp_; t_[4] = tw_; t_[5] = tn_; }
#endif
        l = xhalf_sum(l);
        acc_rows(tot, o, wsf, gate_s * __builtin_amdgcn_rcpf(l), r32, hi);
    }
    XSTAMP(33);
    {
        const bf16_t* kb = P + rowbase * LDP + C_KW + g * 64; const bf16_t* vb = P + rowbase * LDP + C_VW + g * 64;
        float m = 0.f, l = 0.f; f32x16 o[2]; o[0] = f32x16{}; o[1] = f32x16{};
        const int jlast = blk_t >= 4 ? blk_t - 4 : 0;
        int j0 = blk_t, j1 = (j0 > jlast) ? j0 - 1 : -1;
        dma_tile_a(lds + L_KV, kb + (size_t)j0 * 64 * LDP, vb + (size_t)j0 * 64 * LDP, kofP, vofP, wid);
        if (j1 >= 0) { dma_tile_a(lds + L_KV + 16384, kb + (size_t)j1 * 64 * LDP, vb + (size_t)j1 * 64 * LDP, kofP, vofP, wid); RING_WAIT_BAR(2); } else RING_WAIT_BAR(0);
        int sl = 0;
        for (;;) {
            const int j2 = (j1 > jlast) ? j1 - 1 : -1;
            const int sl2i = (sl >= 1) ? sl - 1 : 2;
            if (j2 >= 0) dma_tile_a(lds + L_KV + sl2i * 16384, kb + (size_t)j2 * 64 * LDP, vb + (size_t)j2 * 64 * LDP, kofP, vofP, wid);
            NLAS unsigned char* sc = lds + L_KV + sl * 16384;
            const int j = j0;
            {
                f32x16 p0, p1, c0, c1; const float kb0 = sl2 * (float)(j * 64 - t0) - m; OPAQUE_HI();
#pragma unroll
                for (int i = 0; i < 16; ++i) { c0[i] = kb0 + sl2 * CRF(i); c1[i] = c0[i] + sl2 * 32.f; }
                qkt(p0, p1, sc, qr, c0, c1, r32, hi);
                if (j == blk_t || j == blk_t - 4) {
                    asm volatile("" ::: "memory");
                    const int dq = t0 + qi - j * 64;
#pragma unroll
                    for (int i = 0; i < 16; ++i) { const int d0_ = dq - crow(i, hiv), d1_ = d0_ - 32; if (d0_ < 0 || d0_ > 255) p0[i] = NEG; if (d1_ < 0 || d1_ > 255) p1[i] = NEG; }
                }
                softmax_step(p0, p1, m, l, o, wsf, r32, hi);
                pv(o, sc + 8192, p0, p1, lane, hi);
            }
            if (j1 < 0) break;
            if (j2 >= 0) RING_WAIT_BAR(2); else RING_WAIT_BAR(0);
            j0 = j1; j1 = j2; sl = (sl == 2) ? 0 : sl + 1;
        }
        RING_WAIT_BAR(0);
        l = xhalf_sum(l);
        acc_rows(tot, o, wsf, gate_w * __builtin_amdgcn_rcpf(l), r32, hi);
    }
    XSTAMP(34);
    {
        NLAS bf16_t* stg = (NLAS bf16_t*)(lds + L_OST) + wid * 2048;
#pragma unroll
        for (int i = 0; i < 16; ++i) { const int orow = crow(i, hi); stg[orow * 64 + r32] = f2bf(tot[0][i]); stg[orow * 64 + 32 + r32] = f2bf(tot[1][i]); }
        bf16_t* ow = P + (rowbase + t0 + qh * 32) * LDP + C_NQ + head * 64;
#pragma unroll
        for (int i = 0; i < 4; ++i) { const int row = i * 8 + (lane >> 3), ch = lane & 7; const u32x4 v = *(NLAS const u32x4*)(stg + row * 64 + ch * 8); *(u32x4*)((char*)ow + (unsigned)(row * LDP + ch * 8) * 2u) = v; }
    }
    __syncthreads();
    XSTAMP(35);
#if defined(TPROBE)
    if (blockIdx.x == 0 && threadIdx.x == 0) { volatile __attribute__((address_space(3))) unsigned long long* ts_ = (volatile __attribute__((address_space(3))) unsigned long long*)(lds + 147456 - 512); ts_[36] = ts_[30] + 100ull * (unsigned)qt; }
#endif
#undef CRF
#undef OPAQUE_HI
}

__device__ __forceinline__ void norm8(u32x4& v, const float* g8, float sc) {
    float x[8] = {__uint_as_float(v.x << 16), __uint_as_float(v.x & 0xffff0000u), __uint_as_float(v.y << 16), __uint_as_float(v.y & 0xffff0000u),
                  __uint_as_float(v.z << 16), __uint_as_float(v.z & 0xffff0000u), __uint_as_float(v.w << 16), __uint_as_float(v.w & 0xffff0000u)};
    float s = 0.f;
#pragma unroll
    for (int e = 0; e < 8; ++e) s += x[e] * x[e];
    s += __shfl_xor(s, 1); s += __shfl_xor(s, 2); s += __shfl_xor(s, 4);
    const float r = rsqrtf(s * (1.f / 64.f) + EPS) * sc;
    v.x = pk(x[0] * r * g8[0], x[1] * r * g8[1]); v.y = pk(x[2] * r * g8[2], x[3] * r * g8[3]); v.z = pk(x[4] * r * g8[4], x[5] * r * g8[5]); v.w = pk(x[6] * r * g8[6], x[7] * r * g8[7]);
}
__device__ __forceinline__ void prep_units(bf16_t* P, const float* qn, const float* kns, const float* knw, int gw, int NGW, int lane) {
    float gq[8], gk[8];
    const float* kg = (lane < 32) ? kns : knw;
#pragma unroll
    for (int e = 0; e < 8; ++e) { gq[e] = qn[8 * (lane & 7) + e]; gk[e] = kg[8 * (lane & 7) + e]; }
    const int coff = (lane < 32) ? C_KS + 8 * lane : C_KW + 8 * (lane - 32);
    for (int m0 = gw; m0 < M; m0 += 2 * NGW) {
        const int m1 = m0 + NGW; const bool two = m1 < M;
        bf16_t* r0 = P + (size_t)m0 * LDP; bf16_t* r1 = P + (size_t)(two ? m1 : m0) * LDP;
        u32x4 a0 = *(const u32x4*)(r0 + C_NQ + 8 * lane), b0 = *(const u32x4*)(r0 + C_NQ + 512 + 8 * lane), c0 = *(const u32x4*)(r0 + coff);
        u32x4 a1 = *(const u32x4*)(r1 + C_NQ + 8 * lane), b1 = *(const u32x4*)(r1 + C_NQ + 512 + 8 * lane), c1 = *(const u32x4*)(r1 + coff);
        norm8(a0, gq, 0.125f * LOG2E); norm8(b0, gq, 0.125f * LOG2E); norm8(c0, gk, 1.f);
        norm8(a1, gq, 0.125f * LOG2E); norm8(b1, gq, 0.125f * LOG2E); norm8(c1, gk, 1.f);
        *(u32x4*)(r0 + C_NQ + 8 * lane) = a0; *(u32x4*)(r0 + C_NQ + 512 + 8 * lane) = b0; *(u32x4*)(r0 + coff) = c0;
        if (two) { *(u32x4*)(r1 + C_NQ + 8 * lane) = a1; *(u32x4*)(r1 + C_NQ + 512 + 8 * lane) = b1; *(u32x4*)(r1 + coff) = c1; }
    }
}

constexpr int LC_A = 0, LC_B = 16384, LC_HID = 49152, LC_W2 = 83968;
__device__ __forceinline__ void compress_item(NLAS unsigned char* lds, const bf16_t* P, const bf16_t* W1T, const float* bias1, const float* W2, const float* gain, bf16_t* OUT, int b, int g, int which, int half) {
    const int tid = threadIdx.x, lane = tid & 63, r32 = lane & 31, hi = lane >> 5; const int wid = __builtin_amdgcn_readfirstlane(tid >> 6);
    const int mt = wid >> 2, nt = wid & 3;
    const int ca = tid >> 3, dca = tid & 7; const int cg_ = 64 * half + ca; const int ccl = cg_ < NCMP ? cg_ : NCMP - 1;
    const bf16_t* asrc = P + ((size_t)b * SEQ + 16 * ccl) * LDP + (which ? C_VC : C_KC) + g * 64 + dca * 8;
    const bf16_t* bsrc0 = W1T + (size_t)(tid >> 3) * 2048 + (tid & 7) * 8; const bf16_t* bsrc1 = bsrc0 + (size_t)64 * 2048;
    const int adst = (dca * 64 + ca) * 16, bdst0 = ((tid & 7) * 128 + (tid >> 3)) * 16, bdst1 = bdst0 + 64 * 16;
#define CBAR() do { asm volatile("s_waitcnt lgkmcnt(0)" ::: "memory"); __builtin_amdgcn_s_barrier(); asm volatile("" ::: "memory"); } while (0)
#define CLOAD(ra_, rb0_, rb1_, l_) do { ra_ = *(const u32x4*)(asrc + (size_t)(l_) * LDP); rb0_ = *(const u32x4*)(bsrc0 + (l_) * 64); rb1_ = *(const u32x4*)(bsrc1 + (l_) * 64); } while (0)
#define CSTORE(ra_, rb0_, rb1_, buf_) do { *(NLAS u32x4*)(lds + LC_A + (buf_) * 8192 + adst) = ra_; *(NLAS u32x4*)(lds + LC_B + (buf_) * 16384 + bdst0) = rb0_; *(NLAS u32x4*)(lds + LC_B + (buf_) * 16384 + bdst1) = rb1_; } while (0)
#define CMMA(buf_) do { NLAS const unsigned char* ab = lds + LC_A + (buf_) * 8192; NLAS const unsigned char* bb = lds + LC_B + (buf_) * 16384; \
        _Pragma("unroll") for (int ds = 0; ds < 4; ++ds) { \
            const bf16x8 a = *(NLAS const bf16x8*)(ab + ((2 * ds + hi) * 64 + 32 * mt + r32) * 16); \
            const bf16x8 w = *(NLAS const bf16x8*)(bb + ((2 * ds + hi) * 128 + 32 * nt + r32) * 16); \
            acc = __builtin_amdgcn_mfma_f32_32x32x16_bf16(a, w, acc, 0, 0, 0); } } while (0)
    {
#pragma unroll
        for (int k = 0; k < 4; ++k) *(NLAS f32x4*)(lds + LC_W2 + (tid + 512 * k) * 16) = *(const f32x4*)(W2 + (tid + 512 * k) * 4);
    }
    u32x4 xa, xb0, xb1, ya, yb0, yb1;
    CLOAD(xa, xb0, xb1, 0); CSTORE(xa, xb0, xb1, 0);
    CLOAD(xa, xb0, xb1, 1); CLOAD(ya, yb0, yb1, 2);
    CBAR();
    f32x16 acc = f32x16{};
    for (int l = 0; l < 32; l += 2) {
        CMMA(0); CSTORE(xa, xb0, xb1, 1); if (l + 3 < 32) CLOAD(xa, xb0, xb1, l + 3); CBAR();
        CMMA(1); if (l + 2 < 32) { CSTORE(ya, yb0, yb1, 0); if (l + 4 < 32) CLOAD(ya, yb0, yb1, l + 4); } CBAR();
    }
#undef CBAR
#undef CLOAD
#undef CSTORE
#undef CMMA
    NLAS float* hid = (NLAS float*)(lds + LC_HID);
    const float bs = bias1[32 * nt + r32];
#pragma unroll
    for (int i = 0; i < 16; ++i) hid[(32 * mt + crow(i, hi)) * 132 + 32 * nt + r32] = gelu_tanh(acc[i] + bs);
    __syncthreads();
    {
        const int row = tid >> 3, e0 = (tid & 7) * 8;
        float o[8];
#pragma unroll
        for (int e = 0; e < 8; ++e) o[e] = 0.f;
#pragma unroll 8
        for (int i = 0; i < 128; ++i) { const float h = hid[row * 132 + i]; const f32x4 wa = *(NLAS const f32x4*)(lds + LC_W2 + (i * 64 + e0) * 4), wb = *(NLAS const f32x4*)(lds + LC_W2 + (i * 64 + e0 + 4) * 4);
            o[0] += h * wa[0]; o[1] += h * wa[1]; o[2] += h * wa[2]; o[3] += h * wa[3]; o[4] += h * wb[0]; o[5] += h * wb[1]; o[6] += h * wb[2]; o[7] += h * wb[3]; }
        if (which == 0) {
            float ss = 0.f;
#pragma unroll
            for (int e = 0; e < 8; ++e) ss += o[e] * o[e];
            ss += __shfl_xor(ss, 1); ss += __shfl_xor(ss, 2); ss += __shfl_xor(ss, 4);
            const float r = rsqrtf(ss * (1.f / 64.f) + EPS);
#pragma unroll
            for (int e = 0; e < 8; ++e) o[e] *= r * gain[e0 + e];
        }
        const int cg = 64 * half + row;
        if (cg >= NCMP) {
#pragma unroll
            for (int e = 0; e < 8; ++e) o[e] = 0.f; }
        u32x4 w; w.x = pk(o[0], o[1]); w.y = pk(o[2], o[3]); w.z = pk(o[4], o[5]); w.w = pk(o[6], o[7]);
        *(u32x4*)(OUT + (((size_t)(b * NS_G + g) * 128) + cg) * 64 + e0) = w;
    }
    __syncthreads();
}
}
namespace pg8 {
#define PG8_LAS __attribute__((address_space(3)))
typedef short bf16x8 __attribute__((ext_vector_type(8)));
typedef float f32x4 __attribute__((ext_vector_type(4)));
typedef float f32x2 __attribute__((ext_vector_type(2)));
typedef unsigned u32x4 __attribute__((ext_vector_type(4)));
typedef unsigned u32x2 __attribute__((ext_vector_type(2)));
constexpr int BM = 256, BK = 64, HALF = 128, HTB = HALF * BK * 2, STAGE_BYTES = 8 * HTB, NXCD = 8, WGM = 8;

__host__ __device__ __forceinline__ int lds_byte(int r, int c) { const int st = (r >> 4) * 2 + (c >> 5), rr = r & 15, cc = c & 31, ob = rr * 64 + cc * 2; return st * 1024 + (ob ^ (((ob >> 9) & 1) << 5)); }
__host__ __device__ __forceinline__ void stage_rc(int b, int& R, int& C) { const int st = b / 1024, sb = b % 1024, swz = sb ^ (((sb >> 9) & 1) << 5); R = (st >> 1) * 16 + swz / 64; C = (st & 1) * 32 + (swz % 64) / 2; }
__host__ __device__ __forceinline__ int perm32(int rho) { const int n = rho >> 4, i = rho & 15; return 8 * (i >> 2) + 4 * n + (i & 3); }

struct Unit { int pm, pn, ks; };
struct Gemm { const bf16_t* A; const bf16_t* Bt; int lda, ldb; int M, N, K; int ksoff; };

struct StaticOrder {
    int nM, nN, nwg, G, c;
    __host__ __device__ void init(int M_, int N_, int G_, int c_) { nM = M_ / BM; nN = N_ / BM; nwg = nM * nN; G = G_; c = c_; }
    __host__ __device__ bool next(int i, Unit& u) const {
        const long L = (long)i * G + c; if (L >= nwg) return false;
        int wgid = (int)L; { const int q = nwg / NXCD, r = nwg % NXCD, xcd = wgid % NXCD, off = wgid / NXCD; wgid = (xcd < r ? xcd * (q + 1) : r * (q + 1) + (xcd - r) * q) + off; }
        const int nig = WGM * nN, gid = wgid / nig, fm = gid * WGM, gsz = (nM - fm) < WGM ? (nM - fm) : WGM;
        u.pm = fm + ((wgid % nig) % gsz); u.pn = (wgid % nig) / gsz; u.ks = 0; return true;
    }
};
struct TwoPassOrder {
    StaticOrder base;
    __host__ __device__ bool next(int i, Unit& u) const { if (!base.next(i >> 1, u)) return false; u.ks = i & 1; return true; }
};

typedef __bf16 bf16x2_t __attribute__((ext_vector_type(2)));
__device__ __forceinline__ unsigned cvt_pk_bf16(float lo, float hi) { f32x2 v = {lo, hi}; bf16x2_t b = __builtin_convertvector(v, bf16x2_t); return __builtin_bit_cast(unsigned, b); }
__device__ __forceinline__ float fast_sigmoid(float x) { return __builtin_amdgcn_rcpf(1.f + __builtin_amdgcn_exp2f(-1.4426950408889634f * x)); }
__device__ __forceinline__ float bflo(unsigned w) { return __uint_as_float(w << 16); }
__device__ __forceinline__ float bfhi(unsigned w) { return __uint_as_float(w & 0xffff0000u); }

typedef f32x4 Acc[2][2][4][2];

template <int ACT> struct EpiP {
    __device__ __forceinline__ bool keep(const Unit&) const { return false; }
    static constexpr bool PERM = true;
    bf16_t* O; int ldc; int pn_last; int ncol_last; bf16_t* halo;
    __device__ __forceinline__ void operator()(const Acc& acc, const Unit& u, int wr, int wc, int fr, int fq) const {
        const int row0 = u.pm * BM + wr * 64 + fr, tcol = wc * 32 + 8 * fq;
        const int lim = (u.pn == pn_last) ? ncol_last : 256;
#pragma unroll
        for (int ai = 0; ai < 2; ++ai)
#pragma unroll
            for (int m = 0; m < 4; ++m) { bf16_t* rowp = O + (size_t)(row0 + ai * HALF + m * 16) * ldc + u.pn * BM + tcol;
#pragma unroll
                for (int bj = 0; bj < 2; ++bj) { if (tcol + bj * HALF >= lim) continue;
                    f32x4 v0 = acc[ai][bj][m][0], v1 = acc[ai][bj][m][1];
                    if (ACT == 1) {
#pragma unroll
                        for (int e = 0; e < 4; ++e) { v0[e] = fast_sigmoid(v0[e]); v1[e] = fast_sigmoid(v1[e]); } }
                    u32x4 w; w.x = cvt_pk_bf16(v0[0], v0[1]); w.y = cvt_pk_bf16(v0[2], v0[3]); w.z = cvt_pk_bf16(v1[0], v1[1]); w.w = cvt_pk_bf16(v1[2], v1[3]);
                    *(u32x4*)(rowp + bj * HALF) = w;
                    if (ACT == 0 && m == 3 && fr >= 13 && u.pn < 12 && halo) { const int row = row0 + ai * HALF + 48;
                        *(u32x4*)(halo + ((size_t)(row >> 6) * 3 + (fr - 13)) * 3072 + u.pn * BM + tcol + bj * HALF) = w; } } }
    }
};
struct EpiMix {
    static constexpr bool PERM = true;
    const bf16_t* G; int ldg; bf16_t* O; int ldc;
    __device__ __forceinline__ bool keep(const Unit& u) const { return u.ks == 0; }
    __device__ __forceinline__ void operator()(Acc& acc, const Unit& u, int wr, int wc, int fr, int fq) const {
        const int row0 = u.pm * BM + wr * 64 + fr, col0 = u.pn * BM + wc * 32 + 8 * fq;
#pragma unroll
        for (int ai = 0; ai < 2; ++ai)
#pragma unroll
            for (int m = 0; m < 4; ++m) { const size_t row = (size_t)(row0 + ai * HALF + m * 16); const bf16_t* gp = G + row * ldg + col0; bf16_t* rowp = O + row * ldc + col0;
#pragma unroll
                for (int bj = 0; bj < 2; ++bj) { const u32x4 b = *(const u32x4*)(gp + bj * HALF + 1024);
                    f32x4 v0 = acc[ai][bj][m][0], v1 = acc[ai][bj][m][1];
                    if (u.ks == 0) { const u32x4 a = *(const u32x4*)(gp + bj * HALF);
                        v0[0] *= bflo(a.x) * __builtin_amdgcn_rcpf(bflo(b.x)); v0[1] *= bfhi(a.x) * __builtin_amdgcn_rcpf(bfhi(b.x)); v0[2] *= bflo(a.y) * __builtin_amdgcn_rcpf(bflo(b.y)); v0[3] *= bfhi(a.y) * __builtin_amdgcn_rcpf(bfhi(b.y));
                        v1[0] *= bflo(a.z) * __builtin_amdgcn_rcpf(bflo(b.z)); v1[1] *= bfhi(a.z) * __builtin_amdgcn_rcpf(bfhi(b.z)); v1[2] *= bflo(a.w) * __builtin_amdgcn_rcpf(bflo(b.w)); v1[3] *= bfhi(a.w) * __builtin_amdgcn_rcpf(bfhi(b.w));
                        acc[ai][bj][m][0] = v0; acc[ai][bj][m][1] = v1;
                    } else {
                        u32x4 w; w.x = cvt_pk_bf16(v0[0] * bflo(b.x), v0[1] * bfhi(b.x)); w.y = cvt_pk_bf16(v0[2] * bflo(b.y), v0[3] * bfhi(b.y));
                        w.z = cvt_pk_bf16(v1[0] * bflo(b.z), v1[1] * bfhi(b.z)); w.w = cvt_pk_bf16(v1[2] * bflo(b.w), v1[3] * bfhi(b.w));
                        *(u32x4*)(rowp + bj * HALF) = w; } }
                if (u.ks == 0 && (m & 1)) asm volatile("" ::: "memory"); }
    }
};
struct EpiOut {
    __device__ __forceinline__ bool keep(const Unit&) const { return false; }
    static constexpr bool PERM = false;
    const float* X; float* X1; bf16_t* An; const float* gain; float* pss;
    __device__ __forceinline__ void operator()(const Acc& acc, const Unit& u, int wr, int wc, int fr, int fq) const {
        const int row0 = u.pm * BM + wr * 64 + fr, col0 = u.pn * BM + wc * 32 + 4 * fq;
        f32x4 gv[2][2];
#pragma unroll
        for (int bj = 0; bj < 2; ++bj)
#pragma unroll
            for (int n = 0; n < 2; ++n) gv[bj][n] = *(const f32x4*)(gain + col0 + bj * HALF + n * 16);
#pragma unroll
        for (int ai = 0; ai < 2; ++ai)
#pragma unroll
            for (int m = 0; m < 4; ++m) { const size_t row = (size_t)(row0 + ai * HALF + m * 16); const size_t off = row * D + col0; float ss = 0.f;
#pragma unroll
                for (int bj = 0; bj < 2; ++bj)
#pragma unroll
                    for (int n = 0; n < 2; ++n) { const f32x4 x1 = *(const f32x4*)(X + off + bj * HALF + n * 16) + acc[ai][bj][m][n];
                        *(f32x4*)(X1 + off + bj * HALF + n * 16) = x1; ss += (x1[0] * x1[0] + x1[1] * x1[1]) + (x1[2] * x1[2] + x1[3] * x1[3]);
                        const f32x4 y = x1 * gv[bj][n]; u32x2 w; w.x = cvt_pk_bf16(y[0], y[1]); w.y = cvt_pk_bf16(y[2], y[3]); *(u32x2*)(An + off + bj * HALF + n * 16) = w; }
                ss += __shfl_xor(ss, 16); ss += __shfl_xor(ss, 32);
                if (fq == 0) pss[row * 16 + u.pn * 4 + wc] = ss; }
    }
};
struct EpiUp {
    __device__ __forceinline__ bool keep(const Unit&) const { return false; }
    static constexpr bool PERM = true;
    const float* pss; bf16_t* O; int ldc;
    __device__ __forceinline__ void operator()(const Acc& acc, const Unit& u, int wr, int wc, int fr, int fq) const {
        const int row0 = u.pm * BM + wr * 64 + fr, col0 = u.pn * BM + wc * 32 + 8 * fq;
#pragma unroll
        for (int ai = 0; ai < 2; ++ai)
#pragma unroll
            for (int m = 0; m < 4; ++m) { const size_t row = (size_t)(row0 + ai * HALF + m * 16);
                const f32x4* pp = (const f32x4*)(pss + row * 16); const f32x4 s4 = (pp[0] + pp[1]) + (pp[2] + pp[3]);
                const float rstd = rsqrtf(((s4[0] + s4[1]) + (s4[2] + s4[3])) * (1.f / D) + EPS);
                bf16_t* rowp = O + row * ldc + col0;
#pragma unroll
                for (int bj = 0; bj < 2; ++bj) { f32x4 v0 = acc[ai][bj][m][0] * rstd, v1 = acc[ai][bj][m][1] * rstd;
#pragma unroll
                    for (int e = 0; e < 4; ++e) { const float a = fmaxf(v0[e], 0.f), b = fmaxf(v1[e], 0.f); v0[e] = a * a; v1[e] = b * b; }
                    u32x4 w; w.x = cvt_pk_bf16(v0[0], v0[1]); w.y = cvt_pk_bf16(v0[2], v0[3]); w.z = cvt_pk_bf16(v1[0], v1[1]); w.w = cvt_pk_bf16(v1[2], v1[3]);
                    *(u32x4*)(rowp + bj * HALF) = w; } }
    }
};
struct EpiDown {
    __device__ __forceinline__ bool keep(const Unit&) const { return false; }
    static constexpr bool PERM = false;
    float* X1;
    __device__ __forceinline__ void operator()(const Acc& acc, const Unit& u, int wr, int wc, int fr, int fq) const {
        const int row0 = u.pm * BM + wr * 64 + fr, col0 = u.pn * BM + wc * 32 + 4 * fq;
#pragma unroll
        for (int ai = 0; ai < 2; ++ai)
#pragma unroll
            for (int m = 0; m < 4; ++m) { float* rowp = X1 + (size_t)(row0 + ai * HALF + m * 16) * D + col0;
#pragma unroll
                for (int bj = 0; bj < 2; ++bj)
#pragma unroll
                    for (int n = 0; n < 2; ++n) { f32x4* p = (f32x4*)(rowp + bj * HALF + n * 16); *p = *p + acc[ai][bj][m][n]; } }
    }
};

template <class Epi, class Sched, bool ALIGN_EPI>
__device__ __forceinline__ void gemm_phase(PG8_LAS unsigned char* lds, const Gemm g, const Sched& S, const Epi& E) {
    const int tid = threadIdx.x, wid = __builtin_amdgcn_readfirstlane(tid >> 6), lane = tid & 63, wr = wid >> 2, wc = wid & 3, fr = lane & 15, fq = lane >> 4;
    const int K = g.K, nt = K / BK, lda = g.lda, ldb = g.ldb;
    unsigned voffA[2], voffB[2];
#pragma unroll
    for (int i = 0; i < 2; ++i) { int R, C; stage_rc(tid * 16 + i * 8192, R, C); const int Rb = Epi::PERM ? ((R & ~31) + perm32(R & 31)) : R;
        voffA[i] = (unsigned)(R * lda + C) * 2u; voffB[i] = (unsigned)(Rb * ldb + C) * 2u; }
    const size_t kstep = (size_t)(BK * 2);
    const size_t hstepA = (size_t)HALF * lda * 2, hstepB = (size_t)HALF * ldb * 2;
    const size_t tstepA = 2 * hstepA, tstepB = 2 * hstepB;
    const unsigned ldsw = (unsigned)wid * 1024u;
    const int aoff = lds_byte(wr * 64 + fr, fq * 8), boff = lds_byte(wc * 32 + fr, fq * 8);
#define PG8_SA(b, h) (((b) * 2 + (h)) * HTB)
#define PG8_SB(b, h) ((4 + (b) * 2 + (h)) * HTB)
#define PG8_STAGE(bufoff, gbase, voff) do { _Pragma("unroll") for (int _i = 0; _i < 2; ++_i) \
        __builtin_amdgcn_global_load_lds((const unsigned*)((const char*)(gbase) + (voff)[_i]), (PG8_LAS unsigned*)(lds + (bufoff) + ldsw + _i * 8192), 16, 0, 0); } while (0)
#define PG8_LDA(dst, b, h) do { _Pragma("unroll") for (int m = 0; m < 4; ++m) _Pragma("unroll") for (int k = 0; k < 2; ++k) dst[m][k] = *(const PG8_LAS bf16x8*)(lds + PG8_SA(b, h) + aoff + m * 2048 + k * 1024); } while (0)
#define PG8_LDB(dst, b, h) do { _Pragma("unroll") for (int n = 0; n < 2; ++n) _Pragma("unroll") for (int k = 0; k < 2; ++k) dst[n][k] = *(const PG8_LAS bf16x8*)(lds + PG8_SB(b, h) + boff + n * 2048 + k * 1024); } while (0)
#define PG8_MMA(ai, bj, At, Bt) do { __builtin_amdgcn_s_setprio(1); _Pragma("unroll") for (int m = 0; m < 4; ++m) _Pragma("unroll") for (int n = 0; n < 2; ++n) _Pragma("unroll") for (int k = 0; k < 2; ++k) \
        acc[ai][bj][m][n] = __builtin_amdgcn_mfma_f32_16x16x32_bf16(Bt[n][k], At[m][k], acc[ai][bj][m][n], 0, 0, 0); __builtin_amdgcn_s_setprio(0); } while (0)
#define PG8_WAIT_V(n) asm volatile("s_waitcnt vmcnt(" #n ")" ::: "memory")
#define PG8_WAIT_L(n) asm volatile("s_waitcnt lgkmcnt(" #n ")" ::: "memory")
#define PG8_BAR __builtin_amdgcn_s_barrier()
#define PG8_SCHED __builtin_amdgcn_sched_barrier(0)
#define PG8_KBODY(t) do { \
            const bool last = (t == nt - 2); \
            const char* a1 = cA + (size_t)(t + 1) * kstep; \
            const char* a2 = last ? nA : cA + (size_t)(t + 2) * kstep; const char* b2 = last ? nB : cB + (size_t)(t + 2) * kstep; \
            const char* a3 = a2 + kstep; const char* b3 = b2 + kstep; \
            PG8_LDB(B0, 0, 0); PG8_LDB(B1, 0, 1); PG8_SCHED; PG8_LDA(At, 0, 0); PG8_STAGE(PG8_SA(1, 1), a1 + hstepA, voffA); \
            PG8_WAIT_V(8); PG8_WAIT_L(0); PG8_BAR; PG8_MMA(0, 0, At, B0); PG8_MMA(0, 1, At, B1); PG8_BAR; PG8_SCHED; \
            PG8_LDA(At, 0, 1); PG8_STAGE(PG8_SB(0, 0), b2, voffB); PG8_STAGE(PG8_SB(0, 1), b2 + hstepB, voffB); PG8_STAGE(PG8_SA(0, 0), a2, voffA); \
            PG8_WAIT_V(8); PG8_WAIT_L(0); PG8_BAR; PG8_MMA(1, 0, At, B0); PG8_MMA(1, 1, At, B1); PG8_BAR; PG8_SCHED; \
            PG8_LDB(B0, 1, 0); PG8_LDB(B1, 1, 1); PG8_SCHED; PG8_LDA(At, 1, 0); PG8_STAGE(PG8_SA(0, 1), a2 + hstepA, voffA); \
            PG8_WAIT_V(8); PG8_WAIT_L(0); PG8_BAR; PG8_MMA(0, 0, At, B0); PG8_MMA(0, 1, At, B1); PG8_BAR; PG8_SCHED; \
            PG8_LDA(At, 1, 1); PG8_STAGE(PG8_SB(1, 0), b3, voffB); PG8_STAGE(PG8_SB(1, 1), b3 + hstepB, voffB); PG8_STAGE(PG8_SA(1, 0), a3, voffA); \
            PG8_WAIT_V(8); PG8_WAIT_L(0); PG8_BAR; PG8_MMA(1, 0, At, B0); PG8_MMA(1, 1, At, B1); PG8_BAR; PG8_SCHED; \
        } while (0)
    Unit cur, nxt; int ui = 0;
    if (!S.next(0, cur)) return;
    Acc acc;
#pragma unroll
    for (int a = 0; a < 2; ++a)
#pragma unroll
        for (int b = 0; b < 2; ++b)
#pragma unroll
            for (int m = 0; m < 4; ++m)
#pragma unroll
                for (int n = 0; n < 2; ++n) acc[a][b][m][n] = (f32x4){0.f, 0.f, 0.f, 0.f};
    bf16x8 At[4][2], B0[2][2], B1[2][2];
    const char* cA = (const char*)g.A + (size_t)cur.pm * tstepA + (size_t)cur.ks * g.ksoff * 2; const char* cB = (const char*)g.Bt + (size_t)cur.pn * tstepB + (size_t)cur.ks * g.ksoff * 2;
    PG8_STAGE(PG8_SB(0, 0), cB, voffB); PG8_STAGE(PG8_SB(0, 1), cB + hstepB, voffB); PG8_STAGE(PG8_SA(0, 0), cA, voffA); PG8_STAGE(PG8_SA(0, 1), cA + hstepA, voffA);
    if (wr == 1) PG8_BAR;
    PG8_WAIT_V(2); PG8_BAR;
    PG8_STAGE(PG8_SB(1, 0), cB + kstep, voffB); PG8_STAGE(PG8_SA(1, 0), cA + kstep, voffA); PG8_STAGE(PG8_SB(1, 1), cB + hstepB + kstep, voffB);
    PG8_WAIT_V(6); PG8_BAR;
    for (;;) {
        const bool has_next = S.next(ui + 1, nxt);
        const char* nA = has_next ? (const char*)g.A + (size_t)nxt.pm * tstepA + (size_t)nxt.ks * g.ksoff * 2 : cA; const char* nB = has_next ? (const char*)g.Bt + (size_t)nxt.pn * tstepB + (size_t)nxt.ks * g.ksoff * 2 : cB;
        for (int t = 0; t < nt; t += 2) PG8_KBODY(t);
        if constexpr (ALIGN_EPI) { if (wr == 0) PG8_BAR; }
        E(acc, cur, wr, wc, fr, fq);
        if (!has_next) break;
        if (!E.keep(cur)) {
#pragma unroll
        for (int a = 0; a < 2; ++a)
#pragma unroll
            for (int b = 0; b < 2; ++b)
#pragma unroll
                for (int m = 0; m < 4; ++m)
#pragma unroll
                    for (int n = 0; n < 2; ++n) acc[a][b][m][n] = (f32x4){0.f, 0.f, 0.f, 0.f};
        }
        cur = nxt; cA = nA; cB = nB; ++ui;
        if constexpr (ALIGN_EPI) { if (wr == 1) PG8_BAR; }
    }
    PG8_WAIT_V(0);
    if constexpr (!ALIGN_EPI) { if (wr == 0) PG8_BAR; }
    PG8_BAR;
#undef PG8_SA
#undef PG8_SB
#undef PG8_STAGE
#undef PG8_LDA
#undef PG8_LDB
#undef PG8_MMA
#undef PG8_WAIT_V
#undef PG8_WAIT_L
#undef PG8_BAR
#undef PG8_SCHED
#undef PG8_KBODY
}
}

#define GAS __attribute__((address_space(1)))
#define LAS __attribute__((address_space(3)))
typedef unsigned v4u __attribute__((ext_vector_type(4)));
typedef float f32x4 __attribute__((ext_vector_type(4)));
constexpr int NWAVES = 8;
constexpr int LDS_BYTES = 147456;
constexpr size_t MiB = 1u << 20;
constexpr size_t WS_PSS = 1 * MiB, WS_WOUT = 2 * MiB, WS_P = 4 * MiB, WS_KC = 214 * MiB, WS_VC = 215 * MiB, WS_MIX = 216 * MiB;
constexpr size_t WS_AN = 4 * MiB, WS_UP = 64 * MiB, WS_WUP = 248 * MiB, WS_WDOWN = 200 * MiB;
constexpr size_t WS_BIAS1 = 131072 + 16384, WS_W1T = 214 * MiB, WS_KCB = 215 * MiB, WS_VCB = 215 * MiB + 512 * 1024;
constexpr size_t WS_GLV = 4096, WS_QCNT = 65536, WS_GW = 216 * MiB, DO_GQK = 40 * MiB, DO_HALO = 56 * MiB;
constexpr size_t WS_XBAR = 131072;
constexpr size_t DO_H = 0, DO_WG = 32 * MiB, DO_WCAT = 36 * MiB, DO_WIN = 40 * MiB;

__device__ __forceinline__ unsigned pk2(float lo, float hi) { return (unsigned)f2bf(lo) | ((unsigned)f2bf(hi) << 16); }
__device__ __forceinline__ float wave_sum(float v) {
#pragma unroll
    for (int o = 1; o < 64; o <<= 1) v += __shfl_xor(v, o);
    return v;
}
template <class SrcCol>
__device__ __forceinline__ void transpose_item(const float* W, int ldw, const SrcCol& srccol, bf16_t* WT, int ldk, int kofs, LAS float* scr, int kb, int nb, int lane) {
    const int k0 = 64 * kb, n0 = 64 * nb; const int n4 = (lane & 15) * 4; const int sc = srccol(n0 + n4);
    f32x4 v[16];
    const float* wp = W + (size_t)(k0 + (lane >> 4)) * ldw + (sc >= 0 ? sc : 0);
#pragma unroll
    for (int i = 0; i < 16; ++i) v[i] = *(const f32x4*)(wp + (size_t)(4 * i) * ldw);
#pragma unroll
    for (int i = 0; i < 16; ++i) { const int kk = 4 * i + (lane >> 4); const f32x4 u = (sc >= 0) ? v[i] : (f32x4){0.f, 0.f, 0.f, 0.f};
        scr[kk * 65 + n4] = u[0]; scr[kk * 65 + n4 + 1] = u[1]; scr[kk * 65 + n4 + 2] = u[2]; scr[kk * 65 + n4 + 3] = u[3]; }
    asm volatile("s_waitcnt lgkmcnt(0)" ::: "memory");
    const int c = lane & 7;
#pragma unroll
    for (int j = 0; j < 8; ++j) { const int n = (lane >> 3) + 8 * j; const LAS float* sp = scr + (8 * c) * 65 + n;
        v4u o; o.x = pk2(sp[0 * 65], sp[1 * 65]); o.y = pk2(sp[2 * 65], sp[3 * 65]); o.z = pk2(sp[4 * 65], sp[5 * 65]); o.w = pk2(sp[6 * 65], sp[7 * 65]);
        *(v4u*)(WT + (size_t)(n0 + n) * ldk + kofs + k0 + 8 * c) = o; }
    asm volatile("s_waitcnt lgkmcnt(0)" ::: "memory");
}
struct SrcIdent { int off; __device__ __forceinline__ int operator()(int n) const { return n + off; } };
struct SrcWin { __device__ __forceinline__ int operator()(int n) const { return n < 4096 ? n : (n < 6656 ? n + 16 : (n < 6672 ? n - 6656 + 4096 : (n < 6720 ? n : -1))); } };

typedef GAS unsigned gu32;
#define RLX_AGENT __ATOMIC_RELAXED, __HIP_MEMORY_SCOPE_AGENT
#define XB_TMO      128
#define XB_XCNT(j)  (256  + 64 * (j))
#define XB_XSUB(j)  (1280 + 64 * (j))
#define XB_XGEN(j)  (2304 + 64 * (j))
#define XB_TOP      3328
#define XB_TOPGEN   3392
#define XCD_BAR_WORDS 3456
#define XB_SPIN_CAP (1u << 18)

__device__ __forceinline__ unsigned xb_ld(unsigned* p)              { return __hip_atomic_load(p, __ATOMIC_RELAXED, __HIP_MEMORY_SCOPE_AGENT); }
__device__ __forceinline__ unsigned xb_add(unsigned* p, unsigned v) { return __hip_atomic_fetch_add(p, v, __ATOMIC_RELAXED, __HIP_MEMORY_SCOPE_AGENT); }
__device__ __forceinline__ unsigned xb_xcc_id() { return (unsigned)__builtin_amdgcn_s_getreg((3 << 11) | 20) & 0xFu; }
#define XB_SPIN(cond, bar) do { unsigned _sp = 0; while (cond) { __builtin_amdgcn_s_sleep(1); \
    if ((++_sp & 255u) == 0u) { if (xb_ld(&(bar)[XB_TMO])) break; if (_sp > XB_SPIN_CAP) { atomicAdd(&(bar)[XB_TMO], 1u); break; } } } } while (0)

struct XcdBarrier {
    unsigned* bar; unsigned x;
    volatile LAS unsigned* st;
};

__device__ __forceinline__ XcdBarrier xcd_barrier_post(unsigned* bar, volatile LAS unsigned* st) {
    XcdBarrier b; b.bar = bar; b.x = xb_xcc_id(); b.st = st;
    if (threadIdx.x == 0) (void)xb_add(&bar[XB_XCNT(b.x)], 1u);
    return b;
}
__device__ __forceinline__ void xcd_barrier_complete(unsigned* bar, unsigned x, unsigned& nloc, unsigned& nx) {
    const unsigned G = gridDim.x * gridDim.y * gridDim.z;
    unsigned sum, cnt, mine, sp = 0u;
    for (;;) {
        sum = 0u; cnt = 0u; mine = 0u;
#pragma unroll
        for (unsigned j = 0; j < 16; ++j) { const unsigned c = xb_ld(&bar[XB_XCNT(j)]); sum += c; cnt += (c > 0u) ? 1u : 0u; mine = (j == x) ? c : mine; }
        if (sum == G) break;
        __builtin_amdgcn_s_sleep(1);
        if ((++sp & 255u) == 0u) { if (xb_ld(&bar[XB_TMO])) break; if (sp > XB_SPIN_CAP) { atomicAdd(&bar[XB_TMO], 1u); break; } }
    }
    nloc = mine > 0u ? mine : 1u; nx = cnt > 0u ? cnt : 1u;
}

__device__ __forceinline__ void xcd_barrier(const XcdBarrier& b) {
    asm volatile("s_waitcnt vmcnt(0)" ::: "memory");
    __syncthreads();
    if (threadIdx.x == 0) {
        unsigned* bar = b.bar;
        __builtin_amdgcn_s_waitcnt(0);
        unsigned nloc = b.st[0], nx = b.st[1];
        if (nloc == 0u) { xcd_barrier_complete(bar, b.x, nloc, nx); b.st[0] = nloc; b.st[1] = nx; }
        const unsigned old = xb_add(&bar[XB_XSUB(b.x)], 1u);
        const unsigned gen = old / nloc;
        if (old + 1u == (gen + 1u) * nloc) {
            __builtin_amdgcn_fence(__ATOMIC_RELEASE, "agent");
            asm volatile("s_waitcnt vmcnt(0)" ::: "memory");
            const unsigned og = xb_add(&bar[XB_TOP], 1u);
            const unsigned tg = og / nx;
            if (og + 1u == (tg + 1u) * nx) xb_add(&bar[XB_TOPGEN], 1u);
            else XB_SPIN(xb_ld(&bar[XB_TOPGEN]) == tg, bar);
            __builtin_amdgcn_fence(__ATOMIC_ACQUIRE, "agent");
            xb_add(&bar[XB_XGEN(b.x)], 1u);
            asm volatile("s_waitcnt vmcnt(0)" ::: "memory");
        } else {
            XB_SPIN(xb_ld(&bar[XB_XGEN(b.x)]) == gen, bar);
            __builtin_amdgcn_fence(__ATOMIC_ACQUIRE, "agent");
            asm volatile("s_waitcnt vmcnt(0)" ::: "memory");
        }
    }
    __syncthreads();
}


struct Args { const float* in[23]; float* out; unsigned char* ws; int ph_lo, ph_hi; };

__global__ void __launch_bounds__(NWAVES * 64, 2) mk_fwd(Args args) {
    extern __shared__ __attribute__((aligned(16))) unsigned char lds_raw[];
    LAS unsigned char* lds = (LAS unsigned char*)lds_raw;
    __builtin_assume(__builtin_amdgcn_workitem_id_y() == 0); __builtin_assume(__builtin_amdgcn_workitem_id_z() == 0);
    cg::grid_group grid = cg::this_grid();
    const int tid = threadIdx.x, wave = __builtin_amdgcn_readfirstlane(tid >> 6);
#define lane ((int)(threadIdx.x & 63u))
    const int G = gridDim.x, gw = blockIdx.x * NWAVES + wave, NGW = G * NWAVES;
    unsigned char* ws = args.ws; unsigned char* dob = (unsigned char*)args.out;
    const float* x = args.in[0];
    bf16_t* P = (bf16_t*)(ws + WS_P);
    bf16_t* Hb = (bf16_t*)(dob + DO_H); bf16_t* Wg_t = (bf16_t*)(dob + DO_WG); bf16_t* Wcat_t = (bf16_t*)(dob + DO_WCAT); bf16_t* Win_t = (bf16_t*)(dob + DO_WIN);
    bf16_t* Wout_t = (bf16_t*)(ws + WS_WOUT); bf16_t* Wup_t = (bf16_t*)(ws + WS_WUP); bf16_t* Wdown_t = (bf16_t*)(ws + WS_WDOWN);
    bf16_t* Mix = (bf16_t*)(ws + WS_MIX); bf16_t* An = (bf16_t*)(ws + WS_AN); bf16_t* Up = (bf16_t*)(ws + WS_UP); float* pss = (float*)(ws + WS_PSS);
    LAS float* scr = (LAS float*)(lds + wave * 17408);
    bf16_t* Halo = (bf16_t*)(dob + DO_HALO); bf16_t* GWb = (bf16_t*)(ws + WS_GW); bf16_t* GQKb = (bf16_t*)(dob + DO_GQK); float* GLv = (float*)(ws + WS_GLV); unsigned* qcnt = (unsigned*)(ws + WS_QCNT);
    bf16_t* W1T = (bf16_t*)(ws + WS_W1T); float* bias1 = (float*)(ws + WS_BIAS1); bf16_t* KCb = (bf16_t*)(ws + WS_KCB); bf16_t* VCb = (bf16_t*)(ws + WS_VCB);
    const int lo = args.ph_lo, hi = args.ph_hi;
    if (tid < 2) ((volatile LAS unsigned*)(lds + 147456 - 32))[tid] = 0u;
    __syncthreads();
    XcdBarrier xbar = xcd_barrier_post((unsigned*)(ws + WS_XBAR), (volatile LAS unsigned*)(lds + 147456 - 32));
    if (args.ph_hi > 1000) grid.sync();
#ifndef PHMASK
#define PHMASK 0x1ff
#endif
#define IN(k) (((PHMASK >> (k)) & 1) && lo <= (k) && (k) < hi)
#define GRID_SYNC() do { asm volatile("s_waitcnt vmcnt(0) lgkmcnt(0)" ::: "memory"); grid.sync(); \
        if (wave == 0) { __builtin_amdgcn_fence(__ATOMIC_ACQUIRE, "agent"); asm volatile("s_waitcnt vmcnt(0)" ::: "memory"); } __syncthreads(); } while (0)
#if defined(TPROBE)
#define STAMP(k) do { if (blockIdx.x == 0 && tid == 0) ((volatile LAS unsigned long long*)(lds + 147456 - 512))[k] = __builtin_amdgcn_s_memrealtime(); } while (0)
#else
#define STAMP(k) do { } while (0)
#endif
#define SEAM(k) do { if (IN(k) && IN((k) + 1)) xcd_barrier(xbar); STAMP((k) + 1); } while (0)

    STAMP(0);
    if (IN(0)) {
        if (blockIdx.x == 0 && tid == 0) { *qcnt = 0u; ((volatile unsigned*)(ws + 786432))[4] = 0u; }
        constexpr int I_WIN = 16 * (NP1 / 64), I_WG = 16 * 32, I_DN = 16 * 16, I_OUT = 16 * 16, I_UP = 16 * 64;
        constexpr int I_W1 = 32 * 2, I_B1 = 64;
        constexpr int NITEMS = I_WIN + 2 * I_W1 + I_B1;
        for (int it = gw; it < NITEMS; it += NGW) {
            int r = it;
            if (r < I_WIN) { transpose_item(args.in[2], INW, SrcWin{}, Win_t, D, 0, scr, r / (NP1 / 64), r % (NP1 / 64), lane); continue; } r -= I_WIN;
            if (r < I_W1) { transpose_item(args.in[12], 128, SrcIdent{0}, W1T, 2048, 0, scr, r / 2, r % 2, lane); continue; } r -= I_W1;
            if (r < I_W1) { transpose_item(args.in[15], 128, SrcIdent{0}, W1T + 128 * 2048, 2048, 0, scr, r / 2, r % 2, lane); continue; } r -= I_W1;
            {
                const int which = r >> 5, kc = r & 31; const float* pos = args.in[which ? 14 : 11] + kc * 64; const float* w1 = args.in[which ? 15 : 12] + (size_t)kc * 64 * 128 + 2 * lane;
                float a0 = 0.f, a1 = 0.f;
#pragma unroll 16
                for (int k = 0; k < 64; ++k) { const float pk_ = pos[k]; const float2 w = *(const float2*)(w1 + (size_t)k * 128); a0 += pk_ * w.x; a1 += pk_ * w.y; }
                atomicAdd(bias1 + which * 128 + 2 * lane, a0); atomicAdd(bias1 + which * 128 + 2 * lane + 1, a1);
            }
        }
        const float* gain = args.in[1];
        f32x4 gv[4];
#pragma unroll
        for (int j = 0; j < 4; ++j) gv[j] = ((const f32x4*)gain)[lane + 64 * j];
        for (int m = gw; m < M; m += 2 * NGW) {
            const int m2 = (m + NGW < M) ? m + NGW : m;
            const f32x4* xr = (const f32x4*)(x + (size_t)m * D) + lane; const f32x4* xr2 = (const f32x4*)(x + (size_t)m2 * D) + lane;
            f32x4 v[4], u[4]; float s1 = 0.f, s2 = 0.f;
#pragma unroll
            for (int j = 0; j < 4; ++j) { v[j] = xr[64 * j]; u[j] = xr2[64 * j]; }
#pragma unroll
            for (int j = 0; j < 4; ++j) { s1 += (v[j].x * v[j].x + v[j].y * v[j].y) + (v[j].z * v[j].z + v[j].w * v[j].w); s2 += (u[j].x * u[j].x + u[j].y * u[j].y) + (u[j].z * u[j].z + u[j].w * u[j].w); }
            const float r1 = rsqrtf(wave_sum(s1) * (1.f / D) + EPS), r2 = rsqrtf(wave_sum(s2) * (1.f / D) + EPS);
            unsigned long long* o8 = (unsigned long long*)(Hb + (size_t)m * D) + lane; unsigned long long* o9 = (unsigned long long*)(Hb + (size_t)m2 * D) + lane;
#pragma unroll
            for (int j = 0; j < 4; ++j) { const f32x4 y = v[j] * r1 * gv[j]; o8[64 * j] = (unsigned long long)pk2(y.x, y.y) | ((unsigned long long)pk2(y.z, y.w) << 32); }
            if (m2 != m) {
#pragma unroll
                for (int j = 0; j < 4; ++j) { const f32x4 y = u[j] * r2 * gv[j]; o9[64 * j] = (unsigned long long)pk2(y.x, y.y) | ((unsigned long long)pk2(y.z, y.w) << 32); } }
        }
    }
    SEAM(0);
    if (IN(1)) {
        pg8::Gemm g{Hb, Win_t, D, D, M, NP1, D, 0}; pg8::StaticOrder S; S.init(M, NP1, G, (int)blockIdx.x);
        pg8::EpiP<0> E{P, LDP, 26, 64, Halo};
        pg8::gemm_phase<pg8::EpiP<0>, pg8::StaticOrder, true>(lds, g, S, E);
        {
            constexpr int I_WG = 16 * 32, I_DN = 16 * 16, I_OUT = 16 * 16, I_UP = 16 * 64, NT = I_WG + 2 * I_DN + I_OUT + I_UP;
            const int nwg = (M / 256) * (NP1 / 256), maxu = (nwg + G - 1) / G, thr = nwg - (maxu - 1) * G;
            const int nsl = (thr < G) ? G - thr : G, sidx = (thr < G) ? (int)blockIdx.x - thr : (int)blockIdx.x;
            if (sidx >= 0) for (int it = sidx * NWAVES + wave; it < NT; it += nsl * NWAVES) {
                int r = it;
                if (r < I_WG) { transpose_item(args.in[2], INW, SrcIdent{6720}, Wg_t, D, 0, scr, r / 32, r % 32, lane); continue; } r -= I_WG;
                if (r < I_DN) { transpose_item(args.in[17], D, SrcIdent{0}, Wcat_t, 2 * D, 0, scr, r / 16, r % 16, lane); continue; } r -= I_DN;
                if (r < I_DN) { transpose_item(args.in[18], D, SrcIdent{0}, Wcat_t, 2 * D, D, scr, r / 16, r % 16, lane); continue; } r -= I_DN;
                if (r < I_OUT) { transpose_item(args.in[19], D, SrcIdent{0}, Wout_t, D, 0, scr, r / 16, r % 16, lane); continue; } r -= I_OUT;
                transpose_item(args.in[21], FF, SrcIdent{0}, Wup_t, D, 0, scr, r / 64, r % 64, lane);
            }
        }
    }
    SEAM(1);
    if (IN(2)) {
        for (int it = (G == 256) ? (((int)blockIdx.x & 1) ? 128 : (int)blockIdx.x >> 1) : (int)blockIdx.x; it < 128; it += G) {
            const int half = it & 1, which = (it >> 1) & 1, g_ = (it >> 2) & 3, b_ = it >> 4;
            nsa::compress_item(lds, P, W1T + (size_t)which * 128 * 2048, bias1 + which * 128, args.in[which ? 16 : 13], args.in[8], which ? VCb : KCb, b_, g_, which, half);
        }
        STAMP(11);
        nsa::prep_units(P, args.in[7], args.in[9], args.in[10], gw, NGW, lane);
        STAMP(12);
#if !defined(GDN_NAIVE)
        __syncthreads();
        {
            gdn::RowPre pre; int hl = -1;
            const int c_ = (int)blockIdx.x, hq = c_ >> 5, jq = c_ & 31;
            const bool bal = (G == 256);
            const int cnt = bal ? ((jq & 1) ? 9 : 7) : (2048 - c_ + G - 1) / G;
            const int first = bal ? ((jq & 1) ? 112 + 9 * (jq >> 1) : 7 * (jq >> 1)) : 0;
#define PREP_COORD(k, b_, n_, h_) do { if (bal) { const int idx_ = first + (k); b_ = idx_ >> 5; n_ = idx_ & 31; h_ = hq; } else { const int it_ = c_ + (k) * G; b_ = it_ >> 8; n_ = it_ & 31; h_ = (it_ >> 5) & 7; } } while (0)
            int b0, n0, h0;
            if (cnt > 0) { PREP_COORD(0, b0, n0, h0); gdn::prep_prefetch(pre, P, Halo, b0, n0, h0, wave, lane); }
            for (int k = 0; k < cnt; ++k) {
                int bc, nc, hc, bn = -1, nn = 0, hn = 0;
                PREP_COORD(k, bc, nc, hc);
                if (k + 1 < cnt) PREP_COORD(k + 1, bn, nn, hn);
                if (hc != hl) { __syncthreads(); gdn::prep_load_taps(lds, args.in[3], hc); hl = hc; __syncthreads(); }
                gdn::prep_item(lds, P, Halo, args.in[4], args.in[5], GWb, GQKb, GLv, pre, bc, nc, hc, bn, nn, hn);
                if (k == 0) STAMP(14);
            }
#undef PREP_COORD
        }
        STAMP(13);
#endif
    }
    SEAM(2);
    if (IN(3)) {
#if defined(GDN_NAIVE)
        if ((int)blockIdx.x < 16) gdn_naive::run(lds, P, args.in[3], args.in[4], args.in[5], args.in[6], 4 * (int)blockIdx.x);
#else
        if ((int)blockIdx.x < 64) gdn::scan_item(lds, P, GWb, GQKb, GLv, args.in[6], (int)blockIdx.x >> 3, (int)blockIdx.x & 7);
#endif
        __syncthreads();
        STAMP(10);
        for (;;) {
            volatile LAS unsigned* qslot = (volatile LAS unsigned*)(lds + 147456 - 16);
            if (tid == 0) *qslot = atomicAdd(qcnt, 1u);
            __syncthreads();
            const int idx = (int)*qslot;
            __syncthreads();
            if (idx >= 1024) break;
#if defined(TPROBE)
            if (blockIdx.x == 200 && tid == 0) { ((volatile unsigned long long*)(ws + 786432))[0] = __builtin_amdgcn_s_memrealtime(); ((volatile unsigned*)(ws + 786432))[4] += 1u; }
#endif
            nsa::attn_tile(lds, P, KCb, VCb, (idx & 31) >> 2, idx & 3, 31 - (idx >> 5));
        }
    }
    SEAM(3);
    if (IN(4)) {
        pg8::Gemm g{Hb, Wg_t, D, D, M, 2048, D, 0}; pg8::StaticOrder S; S.init(M, 2048, G, (int)blockIdx.x);
        pg8::EpiP<1> E{P, LDP, -1, 256, nullptr};
        pg8::gemm_phase<pg8::EpiP<1>, pg8::StaticOrder, true>(lds, g, S, E);
    }
    SEAM(4);
    if (IN(5)) {
        pg8::Gemm g{P + C_DZ, Wcat_t, LDP, 2 * D, M, D, D, D}; pg8::TwoPassOrder S; S.base.init(M, D, G, (int)blockIdx.x);
        pg8::EpiMix E{P, LDP, Mix, D};
        pg8::gemm_phase<pg8::EpiMix, pg8::TwoPassOrder, false>(lds, g, S, E);
    }
    SEAM(5);
    if (IN(6)) {
        for (int it = gw; it < 64 * 16; it += NGW) transpose_item(args.in[22], D, SrcIdent{0}, Wdown_t, FF, 0, scr, it / 16, it % 16, lane);
        __syncthreads();
        pg8::Gemm g{Mix, Wout_t, D, D, M, D, D, 0}; pg8::StaticOrder S; S.init(M, D, G, (int)blockIdx.x);
        pg8::EpiOut E{x, args.out, An, args.in[20], pss};
        pg8::gemm_phase<pg8::EpiOut, pg8::StaticOrder, false>(lds, g, S, E);
    }
    SEAM(6);
    if (IN(7)) {
        pg8::Gemm g{An, Wup_t, D, D, M, FF, D, 0}; pg8::StaticOrder S; S.init(M, FF, G, (int)blockIdx.x);
        pg8::EpiUp E{pss, Up, FF};
        pg8::gemm_phase<pg8::EpiUp, pg8::StaticOrder, true>(lds, g, S, E);
    }
    SEAM(7);
    if (IN(8)) {
        pg8::Gemm g{Up, Wdown_t, FF, FF, M, D, FF, 0}; pg8::StaticOrder S; S.init(M, D, G, (int)blockIdx.x);
        pg8::EpiDown E{args.out};
        pg8::gemm_phase<pg8::EpiDown, pg8::StaticOrder, false>(lds, g, S, E);
    }
#if defined(TPROBE)
    STAMP(9);
    GRID_SYNC();
    if (blockIdx.x == 0) {
        volatile LAS unsigned long long* ts = (volatile LAS unsigned long long*)(lds + 147456 - 512);
        if (tid == 0) { ts[25] = ((volatile unsigned long long*)(ws + 786432))[0]; ts[26] = ts[3] + 100ull * ((volatile unsigned*)(ws + 786432))[4]; }
        const float dA = (float)(ts[TPA1] - ts[TPA0]) * 0.01f, dB = (float)(ts[TPB1] - ts[TPB0]) * 0.01f;
        if (tid == 0) args.out[0] = dA + 0.f * dB;
    }
#endif
#undef IN
#undef SEAM
#undef GRID_SYNC
}

#undef lane
static int g_grid = 0;
static void launch_mk(const Args& a0, int lo, int hi, hipStream_t stream) {
    Args a = a0; a.ph_lo = lo; a.ph_hi = hi;
    void* kargs[] = {(void*)&a};
    hipError_t e = hipLaunchCooperativeKernel((const void*)mk_fwd, dim3(g_grid), dim3(NWAVES * 64), kargs, LDS_BYTES, stream);
    if (e != hipSuccess) fprintf(stderr, "cooperative launch failed: %s (grid %d)\n", hipGetErrorString(e), g_grid);
}

extern "C" void kernel_launch(void* const* d_in, const int* in_sizes, int n_in, void* d_out, int out_size, void* d_ws, size_t ws_size, hipStream_t stream) {
    if (g_grid == 0) {
        int dev = 0, cus = 0, per_cu = 0;
        hipGetDevice(&dev);
        hipDeviceGetAttribute(&cus, hipDeviceAttributeMultiprocessorCount, dev);
        hipFuncSetAttribute((const void*)mk_fwd, hipFuncAttributeMaxDynamicSharedMemorySize, LDS_BYTES);
        hipOccupancyMaxActiveBlocksPerMultiprocessor(&per_cu, (const void*)mk_fwd, NWAVES * 64, LDS_BYTES);
        if (per_cu < 1) per_cu = 1;
        if (per_cu > 1) per_cu = 1;
        g_grid = cus * per_cu;
    }
    Args a{};
    for (int i = 0; i < 23; ++i) a.in[i] = (const float*)d_in[i];
    a.out = (float*)d_out; a.ws = (unsigned char*)d_ws;
    bf16_t* P = (bf16_t*)((char*)d_ws + WS_P);
    hipMemsetAsync((char*)d_ws + WS_XBAR, 0, 16384 + 1024, stream);
    launch_mk(a, 0, 9, stream);
}
```

```cpp
#include <hip/hip_runtime.h>
#include <hip/hip_cooperative_groups.h>
#include <stdint.h>
#include <cstdio>
namespace cg = cooperative_groups;

typedef unsigned short bf16_t;

constexpr int D = 1024, BATCH = 8, SEQ = 2048, M = BATCH * SEQ;
constexpr int DN_H = 8, DN_D = 128;
constexpr int NS_H = 16, NS_G = 4, NS_R = 4, NS_D = 64;
constexpr int NCMP = 127, NSEL = 32;
constexpr int FF = 4096;
constexpr int INW = 8768;
constexpr float EPS = 1e-6f;
constexpr float NEGV = -1e30f, FORCEV = 1e9f;

constexpr int LDP = 6720;
constexpr int C_DQ = 0, C_DK = 1024, C_DV = 2048, C_DZ = 3072, C_NQ = 4096;
constexpr int C_KC = 5120, C_VC = 5376, C_KS = 5632, C_VS = 5888, C_KW = 6144, C_VW = 6400;
constexpr int C_SB = 6656, C_SA = 6664, C_SG = 6672;
constexpr int NP1 = 6912;

__device__ __forceinline__ float bf2f(bf16_t v) { return __uint_as_float(((unsigned)v) << 16); }
__device__ __forceinline__ bf16_t f2bf(float f) { unsigned u = __float_as_uint(f); return (bf16_t)((u + 0x7fffu + ((u >> 16) & 1u)) >> 16); }
__device__ __forceinline__ float sigmoidf_(float x) { return 1.f / (1.f + __expf(-x)); }
__device__ __forceinline__ float siluf_(float x) { return x * sigmoidf_(x); }
__device__ __forceinline__ float softplusf_(float x) { return fmaxf(x, 0.f) + log1pf(__expf(-fabsf(x))); }
__device__ __forceinline__ float gelu_tanh(float x) { return 0.5f * x * (1.f + tanhf(0.7978845608028654f * (x + 0.044715f * x * x * x))); }

__device__ __forceinline__ float block_sum(float v, float* red) {
    for (int o = 32; o > 0; o >>= 1) v += __shfl_xor(v, o);
    const int w = threadIdx.x >> 6, nw = blockDim.x >> 6;
    __syncthreads();
    if ((threadIdx.x & 63) == 0) red[w] = v;
    __syncthreads();
    float s = 0.f;
    for (int i = 0; i < nw; ++i) s += red[i];
    return s;
}
__device__ __forceinline__ float block_max(float v, float* red) {
    for (int o = 32; o > 0; o >>= 1) v = fmaxf(v, __shfl_xor(v, o));
    const int w = threadIdx.x >> 6, nw = blockDim.x >> 6;
    __syncthreads();
    if ((threadIdx.x & 63) == 0) red[w] = v;
    __syncthreads();
    float s = red[0];
    for (int i = 1; i < nw; ++i) s = fmaxf(s, red[i]);
    return s;
}


namespace gdn {
#define GL3 __attribute__((address_space(3)))
typedef short bf16x8 __attribute__((ext_vector_type(8)));
typedef short s16x4 __attribute__((ext_vector_type(4)));
typedef short v4i16_t __attribute__((ext_vector_type(4)));
typedef float f32x16 __attribute__((ext_vector_type(16)));
typedef float f32x4 __attribute__((ext_vector_type(4)));
typedef float f32x2 __attribute__((ext_vector_type(2)));
typedef unsigned u32x4 __attribute__((ext_vector_type(4)));
typedef unsigned u32x2 __attribute__((ext_vector_type(2)));
typedef __bf16 bf16x2_t __attribute__((ext_vector_type(2)));
constexpr float QSCALE = 0.08838834764831845f;
__device__ __forceinline__ float fsig(float x) { return __builtin_amdgcn_rcpf(1.f + __builtin_amdgcn_exp2f(-1.4426950408889634f * x)); }
__device__ __forceinline__ float fsilu(float x) { return x * fsig(x); }
__device__ __forceinline__ int crow(int i, int hi) { return (i & 3) + 8 * (i >> 2) + 4 * hi; }
__device__ __forceinline__ unsigned pk(float lo, float hi) { f32x2 v = {lo, hi}; bf16x2_t b = __builtin_convertvector(v, bf16x2_t); return __builtin_bit_cast(unsigned, b); }
__device__ __forceinline__ bf16x8 pack8(const float* v) { u32x4 w = {pk(v[0], v[1]), pk(v[2], v[3]), pk(v[4], v[5]), pk(v[6], v[7])}; return __builtin_bit_cast(bf16x8, w); }
__device__ __forceinline__ float dot2bf(float acc, unsigned xw, unsigned ww) { return __builtin_amdgcn_fdot2_f32_bf16(__builtin_bit_cast(bf16x2_t, xw), __builtin_bit_cast(bf16x2_t, ww), acc, false); }
__device__ __forceinline__ float blo(unsigned w) { return __uint_as_float(w << 16); }
__device__ __forceinline__ float bhi(unsigned w) { return __uint_as_float(w & 0xffff0000u); }
__device__ __forceinline__ char* seg_addr(bf16_t* P, size_t row0, int c0, unsigned e) { return (char*)P + ((row0 + (e >> 8)) * LDP + c0) * 2 + (e & 255u); }

__device__ __forceinline__ s16x4 vtr(GL3 const unsigned char* p) { return __builtin_bit_cast(s16x4, __builtin_amdgcn_ds_read_tr16_b64_v4i16((GL3 v4i16_t*)p)); }

constexpr int PL_K = 0, PL_KB = 16384, PL_Q = 32768, PL_RV = 49152, PL_AM = 81920, PL_INV = 99328, PL_MT = 116736, PL_GC = 120832, PL_QKST = 121088, PL_TI = 129280, PL_CW = 137472, PL_END = 143616;
constexpr int PL_WST = 0, PL_UST = 16384;
constexpr int AMLD = 68;
struct RowPre { u32x4 x[3][5]; unsigned short lb, la; };
__device__ __forceinline__ void prep_prefetch(RowPre& pre, const bf16_t* P, const bf16_t* HALO, int b, int n, int h, int wid, int lane) {
    const size_t row0 = (size_t)b * SEQ + 64 * n; const int dc = lane & 15;
    const bf16_t* prow = P + (row0 + lane) * LDP;
    pre.lb = prow[C_SB + h]; pre.la = prow[C_SA + h];
    const int col = h * 128 + dc * 8;
    const int r0 = 2 * (4 * wid + (lane >> 4)) - 3;
    if (wid == 0) {
        const bf16_t* src[5];
#pragma unroll
        for (int k = 0; k < 5; ++k) {
            const int rr = r0 + k; const bool inb = rr >= 0;
            src[k] = inb ? (P + (row0 + (inb ? rr : 0)) * LDP + col) : (HALO + ((size_t)((b * 32 + (n > 0 ? n - 1 : 0)) * 3 + (inb ? 0 : 3 + rr))) * 3072 + col);
            asm volatile("" : "+v"(src[k]));
        }
#pragma unroll
        for (int k = 0; k < 5; ++k)
#pragma unroll
            for (int which = 0; which < 3; ++which) pre.x[which][k] = *(const __attribute__((address_space(1))) u32x4*)(src[k] + which * 1024);
    } else {
        const bf16_t* base = P + (row0 + r0) * LDP + col;
#pragma unroll
        for (int k = 0; k < 5; ++k) { const bf16_t* rp = base + (size_t)k * LDP;
#pragma unroll
            for (int which = 0; which < 3; ++which) pre.x[which][k] = *(const u32x4*)(rp + which * 1024); }
    }
}
__device__ __forceinline__ void prep_load_taps(GL3 unsigned char* lds, const float* convw, int h) {
    GL3 unsigned* cw = (GL3 unsigned*)(lds + 137472);
    for (int e = threadIdx.x; e < 1536; e += 512) { const int which = e >> 9, j = (e >> 7) & 3, c = e & 127; const unsigned wb = f2bf(convw[j * 3072 + which * 1024 + h * 128 + c]); cw[e] = (c & 1) ? (wb << 16) : wb; }
}
#define PBAR() do { asm volatile("s_waitcnt lgkmcnt(0)" ::: "memory"); __builtin_amdgcn_s_barrier(); asm volatile("" ::: "memory"); } while (0)
__device__ __forceinline__ void prep_item(GL3 unsigned char* lds, bf16_t* P, const bf16_t* HALO, const float* a_log, const float* dt_bias,
                                          bf16_t* GW, bf16_t* GQK, float* GLv, RowPre& pre, int b, int n, int h, int nb_, int nn_, int nh_) {
    int tid = threadIdx.x; asm volatile("" : "+v"(tid));
    const int lane = tid & 63, r32 = lane & 31, hi = lane >> 5; const int wid = __builtin_amdgcn_readfirstlane(tid >> 6);
    const size_t row0 = (size_t)b * SEQ + 64 * n; const int item = (b * DN_H + h) * 32 + n;
    GL3 float* AM = (GL3 float*)(lds + PL_AM); GL3 float* INV = (GL3 float*)(lds + PL_INV); GL3 float* MT = (GL3 float*)(lds + PL_MT); GL3 float* GC = (GL3 float*)(lds + PL_GC);
    float gcum, beta_l, gc_last;
    {
        beta_l = fsig(bf2f(pre.lb));
        { const float xs = bf2f(pre.la) + dt_bias[h]; gcum = -__expf(a_log[h]) * (fmaxf(xs, 0.f) + __logf(1.f + __expf(-fabsf(xs)))); }
#define DPPSCAN(ctl_) gcum += __builtin_bit_cast(float, __builtin_amdgcn_update_dpp(0, __builtin_bit_cast(int, gcum), ctl_, 0xF, 0xF, true))
        DPPSCAN(0x111); DPPSCAN(0x112); DPPSCAN(0x114); DPPSCAN(0x118);
#undef DPPSCAN
        gcum += __builtin_bit_cast(float, __builtin_amdgcn_update_dpp(0, __builtin_bit_cast(int, gcum), 0x142, 0xA, 0xF, false));
        gcum += __builtin_bit_cast(float, __builtin_amdgcn_update_dpp(0, __builtin_bit_cast(int, gcum), 0x143, 0xC, 0xF, false));
        gc_last = __builtin_bit_cast(float, __builtin_amdgcn_readlane(__builtin_bit_cast(int, gcum), 63));
        if (wid == 0) GC[lane] = gcum;
    }
    if (n == 0 && wid == 0) {
        asm volatile("" ::: "memory");
        const int r0 = 2 * (lane >> 4) - 3;
#pragma unroll
        for (int which = 0; which < 3; ++which)
#pragma unroll
            for (int k = 0; k < 3; ++k) if (r0 + k < 0) pre.x[which][k] = (u32x4){0u, 0u, 0u, 0u};
    }
    bf16x8 qd_keep[2], ke_keep[2];
    const int dc = lane & 15;
#pragma unroll
    for (int pass = 0; pass < 2; ++pass) {
        const int tok = 2 * (4 * wid + (lane >> 4)) + pass;
        const float gct = __shfl(gcum, tok), bet = __shfl(beta_l, tok);
        float y[3][8];
#pragma unroll
        for (int which = 0; which < 3; ++which) {
#pragma unroll
            for (int e = 0; e < 8; ++e) y[which][e] = 0.f;
#pragma unroll
            for (int j = 0; j < 4; ++j) {
                const int rr = tok - 3 + j;
                u32x4 x = pre.x[which][j + pass];
                const u32x4 w0 = *(GL3 const u32x4*)(lds + PL_CW + ((which * 4 + j) * 128 + dc * 8) * 4), w1 = *(GL3 const u32x4*)(lds + PL_CW + ((which * 4 + j) * 128 + dc * 8 + 4) * 4);
#define DOT2(acc_, xw_, ww_) acc_ = dot2bf(acc_, xw_, ww_)
                DOT2(y[which][0], x.x, w0[0]); DOT2(y[which][1], x.x, w0[1]); DOT2(y[which][2], x.y, w0[2]); DOT2(y[which][3], x.y, w0[3]);
                DOT2(y[which][4], x.z, w1[0]); DOT2(y[which][5], x.z, w1[1]); DOT2(y[which][6], x.w, w1[2]); DOT2(y[which][7], x.w, w1[3]);
#undef DOT2
            }
#pragma unroll
            for (int e = 0; e < 8; ++e) y[which][e] = fsilu(y[which][e]);
        }
        float sq = 0.f, sk = 0.f;
#pragma unroll
        for (int e = 0; e < 8; ++e) { sq += y[0][e] * y[0][e]; sk += y[1][e] * y[1][e]; }
#pragma unroll
        for (int o = 0; o < 1; ++o) {
#define DPPSUM(v_, ctl_) v_ += __builtin_bit_cast(float, __builtin_amdgcn_mov_dpp(__builtin_bit_cast(int, v_), ctl_, 0xF, 0xF, true))
            DPPSUM(sq, 0xB1); DPPSUM(sk, 0xB1); DPPSUM(sq, 0x4E); DPPSUM(sk, 0x4E); DPPSUM(sq, 0x141); DPPSUM(sk, 0x141); DPPSUM(sq, 0x140); DPPSUM(sk, 0x140);
#undef DPPSUM
        }
        const float rq = rsqrtf(sq + EPS), rk = rsqrtf(sk + EPS);
        const float eg = __expf(gct), ke_s = __expf(gc_last - gct);
        float q8[8], k8[8], kb8[8], qd8[8], ke8[8], kbg8[8], vb8[8];
#pragma unroll
        for (int e = 0; e < 8; ++e) { q8[e] = y[0][e] * rq; k8[e] = y[1][e] * rk; kb8[e] = k8[e] * bet; qd8[e] = q8[e] * (QSCALE * eg); ke8[e] = k8[e] * ke_s; kbg8[e] = kb8[e] * eg; vb8[e] = y[2][e] * bet; }
        const int io = (dc * 64 + tok) * 16;
        *(GL3 bf16x8*)(lds + PL_Q + io) = pack8(q8); *(GL3 bf16x8*)(lds + PL_K + io) = pack8(k8); *(GL3 bf16x8*)(lds + PL_KB + io) = pack8(kb8);
        {
            const int rvo = (tok >> 4) * 1024 + ((tok >> 3) & 1) * 512 + (tok & 7) * 64 + (dc & 3) * 16;
            *(GL3 bf16x8*)(lds + PL_RV + (dc >> 2) * 4096 + rvo) = pack8(kbg8); *(GL3 bf16x8*)(lds + PL_RV + (4 + (dc >> 2)) * 4096 + rvo) = pack8(vb8);
        }
        qd_keep[pass] = pack8(qd8); ke_keep[pass] = pack8(ke8);
    }
    PBAR();
    if (nb_ >= 0) prep_prefetch(pre, P, HALO, nb_, nn_, nh_, wid, lane);
#pragma unroll
    for (int pass = 0; pass < 2; ++pass) {
        const int tok = 2 * (4 * wid + (lane >> 4)) + pass;
        *(bf16x8*)seg_addr(P, row0, C_DQ + h * 128, (unsigned)((dc * 64 + tok) * 16)) = qd_keep[pass];
        const unsigned ek = (unsigned)(((dc >> 2) * 4 + (tok >> 4)) * 1024 + ((tok >> 3) & 1) * 512 + (tok & 7) * 64 + (dc & 3) * 16);
        *(bf16x8*)seg_addr(P, row0, C_DK + h * 128, ek) = ke_keep[pass];
    }
    if (wid < 6) {
        const bool isA = wid < 3; const int t3 = isA ? wid : wid - 3;
        const int rt = isA ? (t3 > 0) : (t3 == 2);
        const int ct = isA ? (t3 == 2) : (t3 > 0);
        GL3 const unsigned char* aimg = lds + (isA ? PL_KB : PL_K); GL3 const unsigned char* bimg = lds + (isA ? PL_K : PL_Q);
        f32x16 acc = f32x16{};
#pragma unroll
        for (int s = 0; s < 8; ++s) {
            const bf16x8 a = *(GL3 const bf16x8*)(aimg + ((2 * s + hi) * 64 + 32 * rt + r32) * 16);
            const bf16x8 bb = *(GL3 const bf16x8*)(bimg + ((2 * s + hi) * 64 + 32 * ct + r32) * 16);
            acc = __builtin_amdgcn_mfma_f32_32x32x16_bf16(a, bb, acc, 0, 0, 0);
        }
        if (isA) {
            const int j = 32 * ct + r32; const float gj = GC[j];
#pragma unroll
            for (int i_ = 0; i_ < 16; ++i_) { const int i = 32 * rt + crow(i_, hi); float v = acc[i_] * __expf(fminf(GC[i] - gj, 0.f)); asm volatile("" : "+v"(v)); AM[i * AMLD + j] = (j < i) ? v : 0.f; }
        } else {
            const int i = 32 * ct + r32; const float gi = GC[i];
            float v[16];
#pragma unroll
            for (int i_ = 0; i_ < 16; ++i_) { const int j = 32 * rt + crow(i_, hi); float t = acc[i_] * (QSCALE * __expf(fminf(gi - GC[j], 0.f))); asm volatile("" : "+v"(t)); v[i_] = (j <= i) ? t : 0.f; }
#pragma unroll
            for (int sp = 0; sp < 2; ++sp) *(GL3 bf16x8*)(lds + PL_QKST + (((2 * rt + sp) * 64 + i) * 16 + 8 * hi) * 2) = pack8(v + 8 * sp);
        }
    } else if (wid == 6) {
        const bf16x8 z = {0, 0, 0, 0, 0, 0, 0, 0};
#pragma unroll
        for (int sp = 0; sp < 2; ++sp) *(GL3 bf16x8*)(lds + PL_QKST + (((2 + sp) * 64 + r32) * 16 + 8 * hi) * 2) = z;
    }
    PBAR();
    if (wid < 4 && lane < 16) {
        const int bb = wid, c = lane;
        float x[16];
#pragma unroll
        for (int i = 0; i < 16; ++i) {
            float acc = (i == c) ? 1.f : 0.f;
#pragma unroll
            for (int j4 = 0; j4 < i; j4 += 4) { const f32x4 a = *(GL3 const f32x4*)(AM + (16 * bb + i) * AMLD + 16 * bb + j4);
                acc -= a[0] * x[j4]; if (j4 + 1 < i) acc -= a[1] * x[j4 + 1]; if (j4 + 2 < i) acc -= a[2] * x[j4 + 2]; if (j4 + 3 < i) acc -= a[3] * x[j4 + 3]; }
            x[i] = acc;
        }
#pragma unroll
        for (int i = 0; i < 16; ++i) INV[(16 * bb + i) * AMLD + 16 * bb + c] = x[i];
    }
    PBAR();
    for (int L = 1; L < 4; ++L) {
        const int nb = 4 - L;
        for (int t = tid; t < nb * 256; t += 512) {
            const int J = t >> 8, I = J + L, ei = (t >> 4) & 15, ej = t & 15;
            float acc = 0.f;
            for (int K = J; K < I; ++K) {
#pragma unroll
                for (int k4 = 0; k4 < 16; k4 += 4) { const f32x4 a = *(GL3 const f32x4*)(AM + (16 * I + ei) * AMLD + 16 * K + k4);
                    acc += a[0] * INV[(16 * K + k4) * AMLD + 16 * J + ej] + a[1] * INV[(16 * K + k4 + 1) * AMLD + 16 * J + ej] + a[2] * INV[(16 * K + k4 + 2) * AMLD + 16 * J + ej] + a[3] * INV[(16 * K + k4 + 3) * AMLD + 16 * J + ej]; }
            }
            MT[(J * 16 + ei) * 17 + ej] = acc;
        }
        PBAR();
        for (int t = tid; t < nb * 256; t += 512) {
            const int J = t >> 8, I = J + L, ei = (t >> 4) & 15, ej = t & 15;
            float acc = 0.f;
#pragma unroll
            for (int k4 = 0; k4 < 16; k4 += 4) { const f32x4 d = *(GL3 const f32x4*)(INV + (16 * I + ei) * AMLD + 16 * I + k4);
                acc += d[0] * MT[(J * 16 + k4) * 17 + ej] + d[1] * MT[(J * 16 + k4 + 1) * 17 + ej] + d[2] * MT[(J * 16 + k4 + 2) * 17 + ej] + d[3] * MT[(J * 16 + k4 + 3) * 17 + ej]; }
            INV[(16 * I + ei) * AMLD + 16 * J + ej] = -acc;
        }
        PBAR();
    }
    {
        const int s_ = tid >> 7, i = (tid >> 1) & 63, hh = tid & 1;
        float v[8];
        if (s_ > (i >> 4)) {
#pragma unroll
            for (int e = 0; e < 8; ++e) v[e] = 0.f;
        } else {
            const f32x4 a = *(GL3 const f32x4*)(INV + i * AMLD + 16 * s_ + 4 * hh), c4 = *(GL3 const f32x4*)(INV + i * AMLD + 16 * s_ + 8 + 4 * hh);
            v[0] = a[0]; v[1] = a[1]; v[2] = a[2]; v[3] = a[3]; v[4] = c4[0]; v[5] = c4[1]; v[6] = c4[2]; v[7] = c4[3];
        }
        *(GL3 bf16x8*)(lds + PL_TI + ((s_ * 64 + i) * 16 + 8 * hh) * 2) = pack8(v);
    }
    PBAR();
    {
        const int cb = wid;
        GL3 const unsigned char* rp = lds + PL_RV + cb * 4096 + ((lane >> 4) & 1) * 32 + (lane & 3) * 8 + (4 * hi + ((lane & 15) >> 2)) * 64;
        f32x16 d0 = f32x16{}, d1 = f32x16{};
#pragma unroll
        for (int ks = 0; ks < 4; ++ks) {
            const s16x4 lo = vtr(rp + ks * 1024), hh2 = vtr(rp + ks * 1024 + 512);
            const bf16x8 rf = {lo[0], lo[1], lo[2], lo[3], hh2[0], hh2[1], hh2[2], hh2[3]};
            const bf16x8 t1 = *(GL3 const bf16x8*)(lds + PL_TI + ((ks * 64 + 32 + r32) * 16 + 8 * hi) * 2);
            if (cb < 4) {
                if (ks < 2) { const bf16x8 t0 = *(GL3 const bf16x8*)(lds + PL_TI + ((ks * 64 + r32) * 16 + 8 * hi) * 2); d0 = __builtin_amdgcn_mfma_f32_32x32x16_bf16(rf, t0, d0, 0, 0, 0); }
                d1 = __builtin_amdgcn_mfma_f32_32x32x16_bf16(rf, t1, d1, 0, 0, 0);
            } else {
                if (ks < 2) { const bf16x8 t0 = *(GL3 const bf16x8*)(lds + PL_TI + ((ks * 64 + r32) * 16 + 8 * hi) * 2); d0 = __builtin_amdgcn_mfma_f32_32x32x16_bf16(t0, rf, d0, 0, 0, 0); }
                d1 = __builtin_amdgcn_mfma_f32_32x32x16_bf16(t1, rf, d1, 0, 0, 0);
            }
        }
        PBAR();
        if (cb < 4) {
#pragma unroll
            for (int a = 0; a < 4; ++a) {
                u32x2 w0 = {pk(d0[4 * a], d0[4 * a + 1]), pk(d0[4 * a + 2], d0[4 * a + 3])}, w1 = {pk(d1[4 * a], d1[4 * a + 1]), pk(d1[4 * a + 2], d1[4 * a + 3])};
                *(GL3 u32x2*)(lds + PL_WST + ((4 * cb + a) * 64 + r32) * 16 + 8 * hi) = w0;
                *(GL3 u32x2*)(lds + PL_WST + ((4 * cb + a) * 64 + 32 + r32) * 16 + 8 * hi) = w1;
            }
        } else {
            float t0_[16], t1_[16];
#pragma unroll
            for (int i = 0; i < 16; ++i) { t0_[i] = d0[i]; t1_[i] = d1[i]; }
#pragma unroll
            for (int sp = 0; sp < 2; ++sp) {
                *(GL3 bf16x8*)(lds + PL_UST + (((0 * 4 + (cb - 4)) * 2 + sp) * 64 + lane) * 16) = pack8(t0_ + 8 * sp);
                *(GL3 bf16x8*)(lds + PL_UST + (((1 * 4 + (cb - 4)) * 2 + sp) * 64 + lane) * 16) = pack8(t1_ + 8 * sp); }
        }
    }
    PBAR();
#pragma unroll
    for (int k = 0; k < 2; ++k) {
        const int e = (tid + 512 * k) * 16;
        *(u32x4*)((char*)(GW + (size_t)item * 8192) + e) = *(GL3 const u32x4*)(lds + PL_WST + e);
        *(u32x4*)seg_addr(P, row0, C_DV + h * 128, (unsigned)e) = *(GL3 const u32x4*)(lds + PL_UST + e);
    }
    *(u32x4*)((char*)(GQK + (size_t)item * 4096) + tid * 16) = *(GL3 const u32x4*)(lds + PL_QKST + tid * 16);
    if (tid == 0) GLv[item] = __expf(gc_last);
    PBAR();
}

#undef PBAR
constexpr int SL_W = 0, SL_QD = 16384, SL_KE = 32768, SL_QK = 49152, SL_U = 57344, SL_Z = 73728, SL_S = 90112, SL_VN = 122880, SL_RS = 139264, SL_END = 140416;
__device__ __forceinline__ void glds16(const void* gsrc, unsigned lds_dst) { unsigned keep;
    asm volatile("s_mov_b32 %0, m0\n\ts_mov_b32 m0, %2\n\ts_nop 0\n\tglobal_load_lds_dwordx4 %1, off\n\ts_mov_b32 m0, %0" : "=&s"(keep) : "v"(gsrc), "s"(lds_dst) : "memory"); }
__device__ __forceinline__ unsigned lds_addr(GL3 unsigned char* p) { return (unsigned)(size_t)p; }
__device__ __forceinline__ void dma_seg(GL3 unsigned char* dst, const bf16_t* P, size_t row0, int c0, int wid, int lane) {
#pragma unroll
    for (int k = 0; k < 2; ++k) { const int piece = wid + 8 * k;
        const char* src = (const char*)P + ((row0 + piece * 4 + (lane >> 4)) * LDP + c0) * 2 + (lane & 15) * 16;
        glds16(src, (unsigned)__builtin_amdgcn_readfirstlane((int)(lds_addr(dst) + piece * 1024))); }
}
__device__ __forceinline__ void dma_seg_swz(GL3 unsigned char* dst, const bf16_t* P, size_t row0, int c0, int wid, int lane) {
#pragma unroll
    for (int k = 0; k < 2; ++k) { const int piece = wid + 8 * k; const int r = piece * 4 + (lane >> 4);
        const char* src = (const char*)P + ((row0 + r) * LDP + c0) * 2 + ((lane ^ r) & 15) * 16;
        glds16(src, (unsigned)__builtin_amdgcn_readfirstlane((int)(lds_addr(dst) + piece * 1024))); }
}
template <int NPIECES>
__device__ __forceinline__ void dma_lin(GL3 unsigned char* dst, const bf16_t* src, int wid, int lane) {
#pragma unroll
    for (int k = 0; k < NPIECES / 8; ++k) { const int piece = wid + 8 * k;
        glds16((const char*)src + piece * 1024 + lane * 16, (unsigned)__builtin_amdgcn_readfirstlane((int)(lds_addr(dst) + piece * 1024))); }
}

__device__ __forceinline__ float sum32(float v) {
    v += __builtin_bit_cast(float, __builtin_amdgcn_mov_dpp(__builtin_bit_cast(int, v), 0xB1, 0xF, 0xF, true));
    v += __builtin_bit_cast(float, __builtin_amdgcn_mov_dpp(__builtin_bit_cast(int, v), 0x4E, 0xF, 0xF, true));
    v += __builtin_bit_cast(float, __builtin_amdgcn_mov_dpp(__builtin_bit_cast(int, v), 0x141, 0xF, 0xF, true));
    v += __builtin_bit_cast(float, __builtin_amdgcn_mov_dpp(__builtin_bit_cast(int, v), 0x140, 0xF, 0xF, true));
    v += __shfl_xor(v, 16);
    return v;
}
#define GRAWBAR() do { asm volatile("s_waitcnt lgkmcnt(0)" ::: "memory"); __builtin_amdgcn_s_barrier(); asm volatile("" ::: "memory"); } while (0)
#define GWAITV0() asm volatile("s_waitcnt vmcnt(0)" ::: "memory")
constexpr int SL_GL = SL_RS + 1024;
__device__ __forceinline__ void scan_item(GL3 unsigned char* lds, bf16_t* P, const bf16_t* GW, const bf16_t* GQK, const float* GLv, const float* out_norm, int b, int h) {
    int tid = threadIdx.x; asm volatile("" : "+v"(tid));
    const int lane = tid & 63, r32 = lane & 31, hi = lane >> 5; const int wid = __builtin_amdgcn_readfirstlane(tid >> 6);
    const int mt = wid >> 2, nt = wid & 3;
    const int dv = 32 * nt + r32;
    const int item0 = (b * DN_H + h) * 32; const size_t rowb = (size_t)b * SEQ;
    f32x16 S0 = f32x16{}, S1 = f32x16{};
    {
        const u32x4 z = {0u, 0u, 0u, 0u};
#pragma unroll
        for (int k = 0; k < 4; ++k) *(GL3 u32x4*)(lds + SL_S + (tid + 512 * k) * 16) = z;
        if (tid < 32) *(GL3 float*)(lds + SL_GL + tid * 4) = GLv[item0 + tid];
    }
    float gn[16];
#pragma unroll
    for (int i = 0; i < 16; ++i) gn[i] = out_norm[32 * nt + crow(i, hi)];
    GL3 float* RS = (GL3 float*)(lds + SL_RS);
#define ISSUE_A(n_) do { dma_lin<16>(lds + SL_W, GW + (size_t)(item0 + (n_)) * 8192, wid, lane); dma_seg(lds + SL_QD, P, rowb + 64 * (n_), C_DQ + h * 128, wid, lane); dma_seg(lds + SL_U, P, rowb + 64 * (n_), C_DV + h * 128, wid, lane); } while (0)
#define ISSUE_B(n_) do { dma_seg(lds + SL_KE, P, rowb + 64 * (n_), C_DK + h * 128, wid, lane); dma_lin<8>(lds + SL_QK, GQK + (size_t)(item0 + (n_)) * 4096, wid, lane); dma_seg_swz(lds + SL_Z, P, rowb + 64 * (n_), C_DZ + h * 128, wid, lane); } while (0)
    GWAITV0();
    ISSUE_A(0);
    f32x16 oprev = f32x16{}; unsigned zprev[8] = {0u, 0u, 0u, 0u, 0u, 0u, 0u, 0u};
#define Y_OUT(n_) do { \
        const f32x4 rs = *(GL3 const f32x4*)(RS + (32 * mt + r32) * 4); \
        const float rstd = rsqrtf(((rs[0] + rs[1]) + (rs[2] + rs[3])) * (1.f / 128.f) + EPS); \
        bf16_t* yp = P + (rowb + 64 * (n_) + 32 * mt + r32) * LDP + C_DZ + h * 128 + 32 * nt + 4 * hi; \
        _Pragma("unroll") for (int a = 0; a < 4; ++a) { float y[4]; \
            _Pragma("unroll") for (int e = 0; e < 4; ++e) { const int i = 4 * a + e; const float z = (i & 1) ? bhi(zprev[i >> 1]) : blo(zprev[i >> 1]); y[e] = oprev[i] * rstd * gn[i] * fsilu(z); } \
            const u32x2 w = {pk(y[0], y[1]), pk(y[2], y[3])}; const bf16_t* ya = yp + 8 * a; \
            asm volatile("global_store_dwordx2 %0, %1, off" :: "v"(ya), "v"(w) : "memory"); } } while (0)
    for (int n = 0; n < 32; ++n) {
        GWAITV0(); GRAWBAR();
        ISSUE_B(n);
        const float gl = *(GL3 const float*)(lds + SL_GL + n * 4);
        f32x16 vp = f32x16{}, o = f32x16{};
#pragma unroll
        for (int s = 0; s < 8; ++s) {
            const bf16x8 sb = *(GL3 const bf16x8*)(lds + SL_S + ((2 * s + hi) * 128 + dv) * 16);
            const bf16x8 wa = *(GL3 const bf16x8*)(lds + SL_W + ((2 * s + hi) * 64 + 32 * mt + r32) * 16);
            const bf16x8 qa = *(GL3 const bf16x8*)(lds + SL_QD + ((2 * s + hi) * 64 + 32 * mt + r32) * 16);
            vp = __builtin_amdgcn_mfma_f32_32x32x16_bf16(wa, sb, vp, 0, 0, 0);
            o = __builtin_amdgcn_mfma_f32_32x32x16_bf16(sb, qa, o, 0, 0, 0);
        }
        if (n > 0) Y_OUT(n - 1);
        {
            float v[16];
            const u32x4 ua = *(GL3 const u32x4*)(lds + SL_U + (((mt * 4 + nt) * 2 + 0) * 64 + lane) * 16), ub = *(GL3 const u32x4*)(lds + SL_U + (((mt * 4 + nt) * 2 + 1) * 64 + lane) * 16);
#pragma unroll
            for (int q = 0; q < 4; ++q) { v[2 * q] = blo(ua[q]) - vp[2 * q]; v[2 * q + 1] = bhi(ua[q]) - vp[2 * q + 1]; v[8 + 2 * q] = blo(ub[q]) - vp[8 + 2 * q]; v[8 + 2 * q + 1] = bhi(ub[q]) - vp[8 + 2 * q + 1]; }
#pragma unroll
            for (int sp = 0; sp < 2; ++sp) *(GL3 bf16x8*)(lds + SL_VN + (((2 * mt + sp) * 128 + dv) * 16 + 8 * hi) * 2) = pack8(v + 8 * sp);
        }
        if (n > 0) asm volatile("s_waitcnt vmcnt(4)" ::: "memory"); else GWAITV0();
        GRAWBAR();
        if (n + 1 < 32) ISSUE_A(n + 1);
#pragma unroll
        for (int a = 0; a < 4; ++a) { const int r = 32 * mt + r32; const u32x2 zz = *(GL3 const u32x2*)(lds + SL_Z + r * 256 + (((4 * nt + a) ^ (r & 15)) * 16) + 8 * hi); zprev[2 * a] = zz[0]; zprev[2 * a + 1] = zz[1]; }
#pragma unroll
        for (int i = 0; i < 16; ++i) { S0[i] *= gl; S1[i] *= gl; }
        {
            GL3 const unsigned char* kp0 = lds + SL_KE + (2 * mt) * 4096 + ((lane >> 4) & 1) * 32 + (lane & 3) * 8 + (4 * hi + ((lane & 15) >> 2)) * 64;
#pragma unroll
            for (int ks = 0; ks < 4; ++ks) {
                const bf16x8 vb = *(GL3 const bf16x8*)(lds + SL_VN + ((ks * 128 + dv) * 16 + 8 * hi) * 2);
                const s16x4 l0 = vtr(kp0 + ks * 1024), h0 = vtr(kp0 + ks * 1024 + 512), l1 = vtr(kp0 + 4096 + ks * 1024), h1 = vtr(kp0 + 4096 + ks * 1024 + 512);
                const bf16x8 k0 = {l0[0], l0[1], l0[2], l0[3], h0[0], h0[1], h0[2], h0[3]}, k1 = {l1[0], l1[1], l1[2], l1[3], h1[0], h1[1], h1[2], h1[3]};
                const bf16x8 qa = *(GL3 const bf16x8*)(lds + SL_QK + ((ks * 64 + 32 * mt + r32) * 16 + 8 * hi) * 2);
                S0 = __builtin_amdgcn_mfma_f32_32x32x16_bf16(k0, vb, S0, 0, 0, 0);
                S1 = __builtin_amdgcn_mfma_f32_32x32x16_bf16(k1, vb, S1, 0, 0, 0);
                o = __builtin_amdgcn_mfma_f32_32x32x16_bf16(vb, qa, o, 0, 0, 0);
            }
        }
#pragma unroll
        for (int a = 0; a < 4; ++a) {
            u32x2 w0 = {pk(S0[4 * a], S0[4 * a + 1]), pk(S0[4 * a + 2], S0[4 * a + 3])}, w1 = {pk(S1[4 * a], S1[4 * a + 1]), pk(S1[4 * a + 2], S1[4 * a + 3])};
            *(GL3 u32x2*)(lds + SL_S + ((4 * (2 * mt) + a) * 128 + dv) * 16 + 8 * hi) = w0;
            *(GL3 u32x2*)(lds + SL_S + ((4 * (2 * mt + 1) + a) * 128 + dv) * 16 + 8 * hi) = w1;
        }
        {   float q = 0.f;
#pragma unroll
            for (int i = 0; i < 16; ++i) q += o[i] * o[i];
            const auto p2 = __builtin_amdgcn_permlane32_swap(__float_as_uint(q), __float_as_uint(q), false, false); q = __uint_as_float(p2[0]) + __uint_as_float(p2[1]);
            if (hi == 0) RS[(32 * mt + r32) * 4 + nt] = q; }
        oprev = o;
    }
    GWAITV0(); GRAWBAR();
    Y_OUT(31);
    GWAITV0();
    __syncthreads();
#undef Y_OUT
#undef ISSUE_A
#undef ISSUE_B
}
}
namespace nsa {
#define NLAS __attribute__((address_space(3)))
typedef short bf16x8 __attribute__((ext_vector_type(8)));
typedef short s16x4 __attribute__((ext_vector_type(4)));
typedef short v4i16_t __attribute__((ext_vector_type(4)));
typedef float f32x16 __attribute__((ext_vector_type(16)));
typedef float f32x4 __attribute__((ext_vector_type(4)));
typedef float f32x2 __attribute__((ext_vector_type(2)));
typedef unsigned u32x4 __attribute__((ext_vector_type(4)));
typedef __bf16 bf16x2_t __attribute__((ext_vector_type(2)));
constexpr float LOG2E = 1.4426950408889634f;
constexpr float NEG = -1e30f;
constexpr int L_KV = 0;
constexpr int L_IMP = 49152;
constexpr int L_SEL = 82944;
constexpr int L_WS = 83456;
constexpr int L_OST = 85504;
constexpr int L_PRE = 118272;
constexpr int L_END = 151040;

__device__ __forceinline__ int crow(int i, int hi) { return (i & 3) + 8 * (i >> 2) + 4 * hi; }
__device__ __forceinline__ unsigned pk(float lo, float hi) { f32x2 v = {lo, hi}; bf16x2_t b = __builtin_convertvector(v, bf16x2_t); return __builtin_bit_cast(unsigned, b); }
__device__ __forceinline__ float xhalf_max(float v) { auto rr = __builtin_amdgcn_permlane32_swap(__float_as_uint(v), __float_as_uint(v), false, false); return fmaxf(__uint_as_float(rr[0]), __uint_as_float(rr[1])); }
__device__ __forceinline__ float xhalf_sum(float v) { auto rr = __builtin_amdgcn_permlane32_swap(__float_as_uint(v), __float_as_uint(v), false, false); return __uint_as_float(rr[0]) + __uint_as_float(rr[1]); }

__device__ __forceinline__ void dma_tile(NLAS unsigned char* slot, const bf16_t* Kb, const bf16_t* Vb, unsigned koff, unsigned voff, int wid) {
    __builtin_amdgcn_global_load_lds((const unsigned*)((const char*)Kb + koff), (NLAS unsigned*)(slot + wid * 1024), 16, 0, 0);
    __builtin_amdgcn_global_load_lds((const unsigned*)((const char*)Vb + voff), (NLAS unsigned*)(slot + 8192 + wid * 1024), 16, 0, 0);
}
__device__ __forceinline__ void glds16(const void* gsrc, unsigned lds_dst) { unsigned keep;
    asm volatile("s_mov_b32 %0, m0\n\ts_mov_b32 m0, %2\n\ts_nop 0\n\tglobal_load_lds_dwordx4 %1, off\n\ts_mov_b32 m0, %0" : "=&s"(keep) : "v"(gsrc), "s"(lds_dst) : "memory"); }
__device__ __forceinline__ void dma_tile_a(NLAS unsigned char* slot, const bf16_t* Kb, const bf16_t* Vb, unsigned koff, unsigned voff, int wid) {
    const unsigned base = (unsigned)(size_t)slot + (unsigned)wid * 1024u;
    glds16((const char*)Kb + koff, (unsigned)__builtin_amdgcn_readfirstlane((int)base));
    glds16((const char*)Vb + voff, (unsigned)__builtin_amdgcn_readfirstlane((int)(base + 8192u)));
}
#define RING_WAIT_BAR(N) do { asm volatile("s_waitcnt vmcnt(" #N ") lgkmcnt(0)" ::: "memory"); __builtin_amdgcn_s_barrier(); asm volatile("" ::: "memory"); } while (0)
__device__ __forceinline__ void tile_offs(unsigned& koff, unsigned& voff, int pitch, int wid, int lane) {
    koff = (unsigned)(lane * pitch + wid * 8) * 2u;
    voff = (unsigned)((16 * (wid & 3) + (lane >> 2)) * pitch + (wid >> 2) * 32 + (lane & 3) * 8) * 2u;
}
__device__ __forceinline__ void qkt(f32x16& p0, f32x16& p1, NLAS const unsigned char* Kslot, const bf16x8* qr, const f32x16& c0, const f32x16& c1, int r32, int hi) {
    NLAS const unsigned char* kb = Kslot + hi * 1024 + r32 * 16;
#pragma unroll
    for (int d0 = 0; d0 < 4; ++d0) {
        const bf16x8 b0 = *(NLAS const bf16x8*)(kb + d0 * 2048);
        const bf16x8 b1 = *(NLAS const bf16x8*)(kb + d0 * 2048 + 512);
        if (d0 == 0) { p0 = __builtin_amdgcn_mfma_f32_32x32x16_bf16(b0, qr[0], c0, 0, 0, 0); p1 = __builtin_amdgcn_mfma_f32_32x32x16_bf16(b1, qr[0], c1, 0, 0, 0); }
        else { p0 = __builtin_amdgcn_mfma_f32_32x32x16_bf16(b0, qr[d0], p0, 0, 0, 0); p1 = __builtin_amdgcn_mfma_f32_32x32x16_bf16(b1, qr[d0], p1, 0, 0, 0); }
    }
}
__device__ __forceinline__ s16x4 vtr(NLAS const unsigned char* p) { return __builtin_bit_cast(s16x4, __builtin_amdgcn_ds_read_tr16_b64_v4i16((NLAS v4i16_t*)p)); }
__device__ __forceinline__ void pv(f32x16* o, NLAS const unsigned char* Vslot, const f32x16& p0, const f32x16& p1, int lane, int hi) {
    u32x4 w0 = {pk(p0[0], p0[1]), pk(p0[2], p0[3]), pk(p0[4], p0[5]), pk(p0[6], p0[7])};
    u32x4 w1 = {pk(p0[8], p0[9]), pk(p0[10], p0[11]), pk(p0[12], p0[13]), pk(p0[14], p0[15])};
    u32x4 w2 = {pk(p1[0], p1[1]), pk(p1[2], p1[3]), pk(p1[4], p1[5]), pk(p1[6], p1[7])};
    u32x4 w3 = {pk(p1[8], p1[9]), pk(p1[10], p1[11]), pk(p1[12], p1[13]), pk(p1[14], p1[15])};
    const bf16x8 pa[4] = {__builtin_bit_cast(bf16x8, w0), __builtin_bit_cast(bf16x8, w1), __builtin_bit_cast(bf16x8, w2), __builtin_bit_cast(bf16x8, w3)};
    NLAS const unsigned char* vp = Vslot + ((lane >> 4) & 1) * 32 + (lane & 3) * 8 + (4 * hi + ((lane & 15) >> 2)) * 64;
#pragma unroll
    for (int d0 = 0; d0 < 2; ++d0)
#pragma unroll
        for (int ks = 0; ks < 4; ++ks) {
            const s16x4 lo = vtr(vp + d0 * 4096 + ks * 1024), hh = vtr(vp + d0 * 4096 + ks * 1024 + 512);
            const bf16x8 vf = {lo[0], lo[1], lo[2], lo[3], hh[0], hh[1], hh[2], hh[3]};
            o[d0] = __builtin_amdgcn_mfma_f32_32x32x16_bf16(pa[ks], vf, o[d0], 0, 0, 0);
        }
}
__device__ __forceinline__ void scale_rows(f32x16* o, NLAS float* wsf, float s, int r32, int hi) {
    if (hi == 0) wsf[r32] = s;
#pragma unroll
    for (int i = 0; i < 16; ++i) { const float f = wsf[crow(i, hi)]; o[0][i] *= f; o[1][i] *= f; }
}
__device__ __forceinline__ void acc_rows(f32x16* tot, const f32x16* o, NLAS float* wsf, float s, int r32, int hi) {
    if (hi == 0) wsf[32 + r32] = s;
#pragma unroll
    for (int i = 0; i < 16; ++i) { const float f = wsf[32 + crow(i, hi)]; tot[0][i] += f * o[0][i]; tot[1][i] += f * o[1][i]; }
}
#define MX3(a, b, c) __builtin_fmaxf(__builtin_fmaxf((a), (b)), (c))
__device__ __forceinline__ void softmax_step(f32x16& p0, f32x16& p1, float& m, float& l, f32x16* o, NLAS float* wsf, int r32, int hi) {
    float ta = MX3(p0[0], p0[1], p1[0]), tb = MX3(p0[2], p0[3], p1[1]); ta = MX3(ta, p1[2], p1[3]);
#pragma unroll
    for (int r = 4; r < 16; r += 4) { ta = MX3(ta, p0[r], p0[r + 1]); tb = MX3(tb, p0[r + 2], p0[r + 3]); ta = MX3(ta, p1[r], p1[r + 1]); tb = MX3(tb, p1[r + 2], p1[r + 3]); }
    float t = xhalf_max(fmaxf(ta, tb));
    if (__any(t > 8.f)) {
        const float d = fmaxf(t, 0.f);
        m += d;
#pragma unroll
        for (int i = 0; i < 16; ++i) { p0[i] -= d; p1[i] -= d; }
        const float alpha = __builtin_amdgcn_exp2f(-d);
        l *= alpha;
        scale_rows(o, wsf, alpha, r32, hi);
    }
    float s = 0.f;
#pragma unroll
    for (int i = 0; i < 16; ++i) { p0[i] = __builtin_amdgcn_exp2f(p0[i]); p1[i] = __builtin_amdgcn_exp2f(p1[i]); s += p0[i] + p1[i]; }
    l += s;
}

__device__ __forceinline__ void attn_tile(NLAS unsigned char* lds, bf16_t* P, const bf16_t* KC, const bf16_t* VC, int b, int g, int qt, unsigned* qcnt, unsigned& qnext, bool pre, bf16x8 (&qr)[4], unsigned short (&gq)[3], int& idx_next) {
    int tid = threadIdx.x; asm volatile("" : "+v"(tid));
    const int lane = tid & 63, r32 = lane & 31, hi = lane >> 5; const int wid = __builtin_amdgcn_readfirstlane(tid >> 6);
    const int head = g * 4 + (wid >> 1), qh = wid & 1, t0 = qt * 64, qi = qh * 32 + r32, blk_t = qt;
    NLAS float* wsf = (NLAS float*)(lds + L_WS) + wid * 64;
    NLAS float* imp = (NLAS float*)(lds + L_IMP);
    NLAS unsigned* selm = (NLAS unsigned*)(lds + L_SEL);
    NLAS unsigned char* slot0 = lds + L_PRE; NLAS unsigned char* slot1 = lds + L_PRE + 16384;
    const size_t rowbase = (size_t)b * SEQ;
    bf16_t* qrow = P + (rowbase + t0 + qi) * LDP;
    const float sl2 = exp2f(-0.5f * (float)(head + 1)) * LOG2E;
    if (!pre) {
#pragma unroll
        for (int d0 = 0; d0 < 4; ++d0) qr[d0] = *(const bf16x8*)(qrow + C_NQ + head * 64 + d0 * 16 + hi * 8);
#pragma unroll
        for (int e = 0; e < 3; ++e) gq[e] = qrow[C_SG + head * 3 + e];
    }
#define FSIG(x) __builtin_amdgcn_rcpf(1.f + __builtin_amdgcn_exp2f(-LOG2E * (x)))
    const float gate_c = FSIG(bf2f(gq[0])), gate_s = FSIG(bf2f(gq[1])), gate_w = FSIG(bf2f(gq[2]));
#undef FSIG
    bf16x8 qn[4]; unsigned short gn[3] = {0, 0, 0}; int idxN = -1;
#pragma unroll
    for (int d0 = 0; d0 < 4; ++d0) qn[d0] = qr[d0];
    f32x16 tot[2]; tot[0] = f32x16{}; tot[1] = f32x16{};
#define CRF(i) ((float)(((i) & 3) + 8 * ((i) >> 2)) + 4.f * (float)hiv)
#define OPAQUE_HI() int hiv = hi; asm volatile("" : "+v"(hiv))

    {
        const bf16_t* kcb = KC + ((size_t)(b * NS_G + g) * 128) * 64; const bf16_t* vcb = VC + ((size_t)(b * NS_G + g) * 128) * 64;
        const bool two = (qt >= 16);
        unsigned kof, vof; tile_offs(kof, vof, 64, wid, lane);
        {
            unsigned kof0, vof0; tile_offs(kof0, vof0, LDP, wid, lane);
            dma_tile_a(lds + L_KV, P + rowbase * LDP + C_KS + g * 64, P + rowbase * LDP + C_VS + g * 64, kof0, vof0, wid); }
        if (!pre) { dma_tile_a(slot0, kcb, vcb, kof, vof, wid);
            if (two) dma_tile_a(slot1, kcb + 64 * 64, vcb + 64 * 64, kof, vof, wid); }
        asm volatile("s_waitcnt vmcnt(0)" ::: "memory");
        __syncthreads();
        f32x16 pA0, pA1, pB0, pB1, c0, c1;
        const float s16 = sl2 * 16.f; OPAQUE_HI();
#pragma unroll
        for (int i = 0; i < 16; ++i) { c0[i] = s16 * CRF(i); c1[i] = s16 * (CRF(i) + 32.f); }
        qkt(pA0, pA1, slot0, qr, c0, c1, r32, hi);
        const int cmax = (t0 + qi - 31) >> 4;
        const int qposm = t0 + qi - 31;
#pragma unroll
        for (int i = 0; i < 16; ++i) { const int c = crow(i, hiv); if (16 * c > qposm) pA0[i] = NEG; if (16 * (c + 32) > qposm) pA1[i] = NEG; }
        if (two) {
#pragma unroll
            for (int i = 0; i < 16; ++i) { c0[i] += s16 * 64.f; c1[i] += s16 * 64.f; }
            qkt(pB0, pB1, slot1, qr, c0, c1, r32, hi);
#pragma unroll
            for (int i = 0; i < 16; ++i) { const int c = 64 + crow(i, hiv); if (16 * c > qposm) pB0[i] = NEG; if (16 * (c + 32) > qposm) pB1[i] = NEG; }
        } else { pB0 = f32x16{}; pB1 = f32x16{}; }
        (void)cmax;
        float mx = NEG;
#pragma unroll
        for (int i = 0; i < 16; ++i) mx = fmaxf(mx, fmaxf(pA0[i], pA1[i]));
        if (two) {
#pragma unroll
            for (int i = 0; i < 16; ++i) mx = fmaxf(mx, fmaxf(pB0[i], pB1[i])); }
        mx = xhalf_max(mx);
        float s = 0.f;
#pragma unroll
        for (int i = 0; i < 16; ++i) { pA0[i] = __builtin_amdgcn_exp2f(pA0[i] - mx); pA1[i] = __builtin_amdgcn_exp2f(pA1[i] - mx); s += pA0[i] + pA1[i]; }
        if (two) {
#pragma unroll
            for (int i = 0; i < 16; ++i) { pB0[i] = __builtin_amdgcn_exp2f(pB0[i] - mx); pB1[i] = __builtin_amdgcn_exp2f(pB1[i] - mx); s += pB0[i] + pB1[i]; } }
        s = xhalf_sum(s);
        const float nrm = (t0 + qi >= 31) ? __builtin_amdgcn_rcpf(s) : 0.f;
#pragma unroll
        for (int i = 0; i < 16; ++i) { pA0[i] *= nrm; pA1[i] *= nrm; }
        if (two) {
#pragma unroll
            for (int i = 0; i < 16; ++i) { pB0[i] *= nrm; pB1[i] *= nrm; } }
#define PSEL(L) ((L) < 4 ? pA0 : (L) < 8 ? pA1 : (L) < 12 ? pB0 : pB1)
#define MAINV(L) ((PSEL(L)[4 * ((L) & 3)] + PSEL(L)[4 * ((L) & 3) + 1]) + (PSEL(L)[4 * ((L) & 3) + 2] + 0.5f * PSEL(L)[4 * ((L) & 3) + 3]))
#define CARRY(L) (0.5f * PSEL(L)[4 * ((L) & 3) + 3])
#pragma unroll
        for (int L = 0; L < 16; ++L) {
            const float cprev = (L > 0) ? CARRY(L > 0 ? L - 1 : 0) : 0.f;
            const float snd = hi ? cprev : CARRY(L);
            const float rcv = __shfl_xor(snd, 32);
            imp[((wid >> 1) * 64 + qi) * 33 + 2 * L + hi] = MAINV(L) + rcv;
        }
#undef PSEL
#undef MAINV
#undef CARRY
        f32x16 o[2]; o[0] = f32x16{}; o[1] = f32x16{};
        pv(o, slot0 + 8192, pA0, pA1, lane, hi);
        if (two) pv(o, slot1 + 8192, pB0, pB1, lane, hi);
        acc_rows(tot, o, wsf, gate_c, r32, hi);
    }
    __syncthreads();
    {
        const int ql = 8 * wid + (lane >> 3), sub = lane & 7;
        float v[4];
#pragma unroll
        for (int e = 0; e < 4; ++e) { const int j = 4 * sub + e; v[e] = (imp[(0 * 64 + ql) * 33 + j] + imp[(1 * 64 + ql) * 33 + j]) + (imp[(2 * 64 + ql) * 33 + j] + imp[(3 * 64 + ql) * 33 + j]);
            if (j < 1 || j >= blk_t) v[e] = -1.f; }
        unsigned mask = 1u | (1u << blk_t);
#pragma unroll 1
        for (int it = 0; it < 6; ++it) {
            float bv = fmaxf(fmaxf(v[0], v[1]), fmaxf(v[2], v[3]));
            bv = fmaxf(bv, __builtin_bit_cast(float, __builtin_amdgcn_mov_dpp(__builtin_bit_cast(int, bv), 0xB1, 0xF, 0xF, true)));
            bv = fmaxf(bv, __builtin_bit_cast(float, __builtin_amdgcn_mov_dpp(__builtin_bit_cast(int, bv), 0x4E, 0xF, 0xF, true)));
            bv = fmaxf(bv, __builtin_bit_cast(float, __builtin_amdgcn_mov_dpp(__builtin_bit_cast(int, bv), 0x141, 0xF, 0xF, true)));
            int bj = (v[3] == bv) ? 4 * sub + 3 : 64; bj = (v[2] == bv) ? 4 * sub + 2 : bj; bj = (v[1] == bv) ? 4 * sub + 1 : bj; bj = (v[0] == bv) ? 4 * sub : bj;
            bj = min(bj, __builtin_amdgcn_mov_dpp(bj, 0xB1, 0xF, 0xF, true));
            bj = min(bj, __builtin_amdgcn_mov_dpp(bj, 0x4E, 0xF, 0xF, true));
            bj = min(bj, __builtin_amdgcn_mov_dpp(bj, 0x141, 0xF, 0xF, true));
            if (bv >= 0.f) { mask |= 1u << bj;
#pragma unroll
                for (int e = 0; e < 4; ++e) if (4 * sub + e == bj) v[e] = -1.f; }
        }
        if (sub == 0) selm[ql] = mask;
        unsigned any = mask;
        any |= __shfl_xor(any, 8); any |= __shfl_xor(any, 16); any |= __shfl_xor(any, 32);
        if (lane == 0) selm[64 + wid] = any;
    }
    __syncthreads();
    const unsigned mymask = selm[qi];
    const unsigned anym = (unsigned)__builtin_amdgcn_readfirstlane((int)((selm[64] | selm[65]) | (selm[66] | selm[67]) | (selm[68] | selm[69]) | (selm[70] | selm[71])));
    unsigned kofP, vofP; tile_offs(kofP, vofP, LDP, wid, lane);
    {
        const bf16_t* kbw = P + rowbase * LDP + C_KW + g * 64; const bf16_t* vbw = P + rowbase * LDP + C_VW + g * 64;
        dma_tile_a(lds + L_PRE, kbw + (size_t)blk_t * 64 * LDP, vbw + (size_t)blk_t * 64 * LDP, kofP, vofP, wid);
        if (blk_t >= 1) dma_tile_a(lds + L_PRE + 16384, kbw + (size_t)(blk_t - 1) * 64 * LDP, vbw + (size_t)(blk_t - 1) * 64 * LDP, kofP, vofP, wid);
    }
    {
        const bf16_t* kb = P + rowbase * LDP + C_KS + g * 64; const bf16_t* vb = P + rowbase * LDP + C_VS + g * 64;
        unsigned todo = anym;
        float m = 0.f, l = 0.f; f32x16 o[2]; o[0] = f32x16{}; o[1] = f32x16{};
#define NSA_SLOT(t_) (lds + (((t_) % 6) < 3 ? L_KV + ((t_) % 6) * 16384 : (((t_) % 6) < 5 ? L_IMP + (((t_) % 6) - 3) * 16384 : L_OST)))
        const int ntile = __builtin_popcount(todo);
        unsigned rem = todo;
        todo &= todo - 1;
        int tiss = 1;
#pragma unroll 1
        for (int k = 0; k < 3 && todo; ++k) { const int jn = __builtin_ctz(todo); todo &= todo - 1; dma_tile_a(NSA_SLOT(tiss), kb + (size_t)jn * 64 * LDP, vb + (size_t)jn * 64 * LDP, kofP, vofP, wid); ++tiss; }
#pragma unroll 1
        for (int p2 = 0; p2 < ntile; p2 += 2) {
            { const int young = tiss - (p2 + 2);
              if (young >= 2) RING_WAIT_BAR(4); else if (young == 1) RING_WAIT_BAR(2); else RING_WAIT_BAR(0); }
#pragma unroll 1
            for (int k = 0; k < 2 && todo && tiss < p2 + 6; ++k) { const int jn = __builtin_ctz(todo); todo &= todo - 1; dma_tile_a(NSA_SLOT(tiss), kb + (size_t)jn * 64 * LDP, vb + (size_t)jn * 64 * LDP, kofP, vofP, wid); ++tiss; }
#pragma unroll 1
            for (int half = 0; half < 2; ++half) {
                if (p2 + half >= ntile) break;
                const int j = __builtin_ctz(rem); rem &= rem - 1;
                NLAS unsigned char* sc = NSA_SLOT(p2 + half);
                const bool mine = (mymask >> j) & 1u;
                const bool far = sl2 * (float)(t0 - 64 * j - 63) > 200.f;
                if (__any(mine) && !far) {
                    f32x16 p0, p1, c0, c1; const float kb0 = sl2 * (float)(j * 64 - t0) - m; OPAQUE_HI();
#pragma unroll
                    for (int i = 0; i < 16; ++i) { c0[i] = kb0 + sl2 * CRF(i); c1[i] = c0[i] + sl2 * 32.f; }
                    qkt(p0, p1, sc, qr, c0, c1, r32, hi);
                    if (j == blk_t) {
                        asm volatile("" ::: "memory");
#pragma unroll
                        for (int i = 0; i < 16; ++i) { const int kk = crow(i, hiv); if (kk > qi) p0[i] = NEG; if (kk + 32 > qi) p1[i] = NEG; }
                    }
                    if (__any(!mine)) {
                        asm volatile("" ::: "memory");
                        if (!mine) {
#pragma unroll
                            for (int i = 0; i < 16; ++i) { p0[i] = NEG; p1[i] = NEG; } }
                    }
                    softmax_step(p0, p1, m, l, o, wsf, r32, hi);
                    pv(o, sc + 8192, p0, p1, lane, hi);
                }
            }
        }
#undef NSA_SLOT
        RING_WAIT_BAR(0);
        if (tid == 0) qnext = atomicAdd(qcnt, 1u);
        l = xhalf_sum(l);
        acc_rows(tot, o, wsf, gate_s * __builtin_amdgcn_rcpf(l), r32, hi);
    }
    {
        const bf16_t* kb = P + rowbase * LDP + C_KW + g * 64; const bf16_t* vb = P + rowbase * LDP + C_VW + g * 64;
        float m = 0.f, l = 0.f; f32x16 o[2]; o[0] = f32x16{}; o[1] = f32x16{};
        const int nw = (blk_t >= 4 ? 4 : blk_t) + 1;
        for (int t = 2; t < nw; ++t) dma_tile_a(lds + L_KV + (t - 2) * 16384, kb + (size_t)(blk_t - t) * 64 * LDP, vb + (size_t)(blk_t - t) * 64 * LDP, kofP, vofP, wid);
        for (int t = 0; t < nw; ++t) {
            if (t == 2) {
                volatile NLAS unsigned* nslot = (volatile NLAS unsigned*)(lds + L_SEL + 320);
                asm volatile("s_waitcnt vmcnt(0)" ::: "memory");
                if (tid == 0) *nslot = qnext;
                asm volatile("s_waitcnt lgkmcnt(0)" ::: "memory"); __builtin_amdgcn_s_barrier(); asm volatile("" ::: "memory");
                idxN = __builtin_amdgcn_readfirstlane((int)*nslot);
                if (idxN < 1024) {
                    const int nb_ = (idxN & 31) >> 2, ng_ = idxN & 3, nqt_ = 31 - (idxN >> 5);
                    const bf16_t* kcn = KC + ((size_t)(nb_ * NS_G + ng_) * 128) * 64; const bf16_t* vcn = VC + ((size_t)(nb_ * NS_G + ng_) * 128) * 64;
                    unsigned kofc, vofc; tile_offs(kofc, vofc, 64, wid, lane);
                    dma_tile_a(lds + L_PRE, kcn, vcn, kofc, vofc, wid);
                    if (nqt_ >= 16) dma_tile_a(lds + L_PRE + 16384, kcn + 64 * 64, vcn + 64 * 64, kofc, vofc, wid);
                    const bf16_t* qrn = P + ((size_t)nb_ * SEQ + nqt_ * 64 + qi) * LDP; const int hn = ng_ * 4 + (wid >> 1);
#pragma unroll
                    for (int d0 = 0; d0 < 4; ++d0) qn[d0] = *(const bf16x8*)(qrn + C_NQ + hn * 64 + d0 * 16 + hi * 8);
#pragma unroll
                    for (int e = 0; e < 3; ++e) gn[e] = qrn[C_SG + hn * 3 + e];
                }
            }
            NLAS unsigned char* sc = (t < 2) ? lds + L_PRE + t * 16384 : lds + L_KV + (t - 2) * 16384;
            const int j = blk_t - t;
            f32x16 p0, p1, c0, c1; const float kb0 = sl2 * (float)(j * 64 - t0) - m; OPAQUE_HI();
#pragma unroll
            for (int i = 0; i < 16; ++i) { c0[i] = kb0 + sl2 * CRF(i); c1[i] = c0[i] + sl2 * 32.f; }
            qkt(p0, p1, sc, qr, c0, c1, r32, hi);
            if (t == 0 || t == 4) {
                asm volatile("" ::: "memory");
                const int dq = t0 + qi - j * 64;
#pragma unroll
                for (int i = 0; i < 16; ++i) { const int d0_ = dq - crow(i, hiv), d1_ = d0_ - 32; if (d0_ < 0 || d0_ > 255) p0[i] = NEG; if (d1_ < 0 || d1_ > 255) p1[i] = NEG; }
            }
            softmax_step(p0, p1, m, l, o, wsf, r32, hi);
            pv(o, sc + 8192, p0, p1, lane, hi);
        }
        l = xhalf_sum(l);
        acc_rows(tot, o, wsf, gate_w * __builtin_amdgcn_rcpf(l), r32, hi);
    }
    {
        NLAS bf16_t* stg = (NLAS bf16_t*)(lds + L_OST) + wid * 2048;
#pragma unroll
        for (int i = 0; i < 16; ++i) { const int orow = crow(i, hi); stg[orow * 64 + r32] = f2bf(tot[0][i]); stg[orow * 64 + 32 + r32] = f2bf(tot[1][i]); }
        bf16_t* ow = P + (rowbase + t0 + qh * 32) * LDP + C_NQ + head * 64;
#pragma unroll
        for (int i = 0; i < 4; ++i) { const int row = i * 8 + (lane >> 3), ch = lane & 7; const u32x4 v = *(NLAS const u32x4*)(stg + row * 64 + ch * 8); *(u32x4*)((char*)ow + (unsigned)(row * LDP + ch * 8) * 2u) = v; }
    }
    __syncthreads();
    idx_next = idxN;
    if (idxN >= 0) {
#pragma unroll
        for (int d0 = 0; d0 < 4; ++d0) qr[d0] = qn[d0];
#pragma unroll
        for (int e = 0; e < 3; ++e) gq[e] = gn[e];
    }
#undef CRF
#undef OPAQUE_HI
}

__device__ __forceinline__ void norm8(u32x4& v, const float* g8, float sc) {
    float x[8] = {__uint_as_float(v.x << 16), __uint_as_float(v.x & 0xffff0000u), __uint_as_float(v.y << 16), __uint_as_float(v.y & 0xffff0000u),
                  __uint_as_float(v.z << 16), __uint_as_float(v.z & 0xffff0000u), __uint_as_float(v.w << 16), __uint_as_float(v.w & 0xffff0000u)};
    float s = 0.f;
#pragma unroll
    for (int e = 0; e < 8; ++e) s += x[e] * x[e];
    s += __shfl_xor(s, 1); s += __shfl_xor(s, 2); s += __shfl_xor(s, 4);
    const float r = rsqrtf(s * (1.f / 64.f) + EPS) * sc;
    v.x = pk(x[0] * r * g8[0], x[1] * r * g8[1]); v.y = pk(x[2] * r * g8[2], x[3] * r * g8[3]); v.z = pk(x[4] * r * g8[4], x[5] * r * g8[5]); v.w = pk(x[6] * r * g8[6], x[7] * r * g8[7]);
}
__device__ __forceinline__ void prep_units(bf16_t* P, const float* qn, const float* kns, const float* knw, int gw, int NGW, int lane) {
    float gq[8], gk[8];
    const float* kg = (lane < 32) ? kns : knw;
#pragma unroll
    for (int e = 0; e < 8; ++e) { gq[e] = qn[8 * (lane & 7) + e]; gk[e] = kg[8 * (lane & 7) + e]; }
    const int coff = (lane < 32) ? C_KS + 8 * lane : C_KW + 8 * (lane - 32);
    for (int m0 = gw; m0 < M; m0 += 2 * NGW) {
        const int m1 = m0 + NGW; const bool two = m1 < M;
        bf16_t* r0 = P + (size_t)m0 * LDP; bf16_t* r1 = P + (size_t)(two ? m1 : m0) * LDP;
        u32x4 a0 = *(const u32x4*)(r0 + C_NQ + 8 * lane), b0 = *(const u32x4*)(r0 + C_NQ + 512 + 8 * lane), c0 = *(const u32x4*)(r0 + coff);
        u32x4 a1 = *(const u32x4*)(r1 + C_NQ + 8 * lane), b1 = *(const u32x4*)(r1 + C_NQ + 512 + 8 * lane), c1 = *(const u32x4*)(r1 + coff);
        norm8(a0, gq, 0.125f * LOG2E); norm8(b0, gq, 0.125f * LOG2E); norm8(c0, gk, 1.f);
        norm8(a1, gq, 0.125f * LOG2E); norm8(b1, gq, 0.125f * LOG2E); norm8(c1, gk, 1.f);
        *(u32x4*)(r0 + C_NQ + 8 * lane) = a0; *(u32x4*)(r0 + C_NQ + 512 + 8 * lane) = b0; *(u32x4*)(r0 + coff) = c0;
        if (two) { *(u32x4*)(r1 + C_NQ + 8 * lane) = a1; *(u32x4*)(r1 + C_NQ + 512 + 8 * lane) = b1; *(u32x4*)(r1 + coff) = c1; }
    }
}

constexpr int LC_A = 0, LC_B = 32768, LC_HID = 0, LC_W2 = 98304;
__device__ __forceinline__ void compress_item(NLAS unsigned char* lds, const bf16_t* P, const bf16_t* W1T, const float* bias1, const float* W2, const float* gain, bf16_t* OUT, int b, int g, int which, int half) {
    const int tid = threadIdx.x, lane = tid & 63, r32 = lane & 31, hi = lane >> 5; const int wid = __builtin_amdgcn_readfirstlane(tid >> 6);
    const int mt = wid >> 2, nt = wid & 3;
    const int ca = tid >> 3, dca = tid & 7; const int cg_ = 64 * half + ca; const int ccl = cg_ < NCMP ? cg_ : NCMP - 1;
    const bf16_t* asrc = P + ((size_t)b * SEQ + 16 * ccl) * LDP + (which ? C_VC : C_KC) + g * 64 + dca * 8;
    const bf16_t* bsrc0 = W1T + (size_t)(tid >> 3) * 2048 + (tid & 7) * 8; const bf16_t* bsrc1 = bsrc0 + (size_t)64 * 2048;
    const int adst = (dca * 64 + ca) * 16, bdst0 = ((tid & 7) * 128 + (tid >> 3)) * 16, bdst1 = bdst0 + 64 * 16;
#define CBAR() do { asm volatile("s_waitcnt lgkmcnt(0)" ::: "memory"); __builtin_amdgcn_s_barrier(); asm volatile("" ::: "memory"); } while (0)
#define CLOAD(r_, i_) do { _Pragma("unroll") for (int s_ = 0; s_ < 2; ++s_) { const int l_ = 2 * (i_) + s_; r_[3 * s_] = *(const u32x4*)(asrc + (size_t)l_ * LDP); r_[3 * s_ + 1] = *(const u32x4*)(bsrc0 + l_ * 64); r_[3 * s_ + 2] = *(const u32x4*)(bsrc1 + l_ * 64); } } while (0)
#define CSTORE(r_, buf_) do { _Pragma("unroll") for (int s_ = 0; s_ < 2; ++s_) { *(NLAS u32x4*)(lds + LC_A + (buf_) * 16384 + s_ * 8192 + adst) = r_[3 * s_]; *(NLAS u32x4*)(lds + LC_B + (buf_) * 32768 + s_ * 16384 + bdst0) = r_[3 * s_ + 1]; *(NLAS u32x4*)(lds + LC_B + (buf_) * 32768 + s_ * 16384 + bdst1) = r_[3 * s_ + 2]; } } while (0)
#define CMMA(buf_) do { _Pragma("unroll") for (int s_ = 0; s_ < 2; ++s_) { NLAS const unsigned char* ab = lds + LC_A + (buf_) * 16384 + s_ * 8192; NLAS const unsigned char* bb = lds + LC_B + (buf_) * 32768 + s_ * 16384; \
        _Pragma("unroll") for (int ds = 0; ds < 4; ++ds) { \
            const bf16x8 a = *(NLAS const bf16x8*)(ab + ((2 * ds + hi) * 64 + 32 * mt + r32) * 16); \
            const bf16x8 w = *(NLAS const bf16x8*)(bb + ((2 * ds + hi) * 128 + 32 * nt + r32) * 16); \
            acc = __builtin_amdgcn_mfma_f32_32x32x16_bf16(a, w, acc, 0, 0, 0); } } } while (0)
    {
#pragma unroll
        for (int k = 0; k < 4; ++k) *(NLAS f32x4*)(lds + LC_W2 + (tid + 512 * k) * 16) = *(const f32x4*)(W2 + (tid + 512 * k) * 4);
    }
    u32x4 r0[6], r1[6], r2[6], r3[6];
    CLOAD(r0, 0); CSTORE(r0, 0);
    CLOAD(r1, 1); CLOAD(r2, 2); CLOAD(r3, 3); CLOAD(r0, 4);
    CBAR();
    f32x16 acc = f32x16{};
    for (int i = 0; i < 16; i += 4) {
        CMMA(0); CSTORE(r1, 1); if (i + 5 < 16) CLOAD(r1, i + 5); CBAR();
        CMMA(1); CSTORE(r2, 0); if (i + 6 < 16) CLOAD(r2, i + 6); CBAR();
        CMMA(0); CSTORE(r3, 1); if (i + 7 < 16) CLOAD(r3, i + 7); CBAR();
        CMMA(1); if (i + 4 < 16) { CSTORE(r0, 0); if (i + 8 < 16) CLOAD(r0, i + 8); } CBAR();
    }
#undef CBAR
#undef CLOAD
#undef CSTORE
#undef CMMA
    NLAS float* hid = (NLAS float*)(lds + LC_HID);
    const float bs = bias1[32 * nt + r32];
#pragma unroll
    for (int i = 0; i < 16; ++i) hid[(32 * mt + crow(i, hi)) * 132 + 32 * nt + r32] = gelu_tanh(acc[i] + bs);
    __syncthreads();
    {
        const int row = tid >> 3, e0 = (tid & 7) * 8;
        float o[8];
#pragma unroll
        for (int e = 0; e < 8; ++e) o[e] = 0.f;
#pragma unroll 8
        for (int i = 0; i < 128; ++i) { const float h = hid[row * 132 + i]; const f32x4 wa = *(NLAS const f32x4*)(lds + LC_W2 + (i * 64 + e0) * 4), wb = *(NLAS const f32x4*)(lds + LC_W2 + (i * 64 + e0 + 4) * 4);
            o[0] += h * wa[0]; o[1] += h * wa[1]; o[2] += h * wa[2]; o[3] += h * wa[3]; o[4] += h * wb[0]; o[5] += h * wb[1]; o[6] += h * wb[2]; o[7] += h * wb[3]; }
        if (which == 0) {
            float ss = 0.f;
#pragma unroll
            for (int e = 0; e < 8; ++e) ss += o[e] * o[e];
            ss += __shfl_xor(ss, 1); ss += __shfl_xor(ss, 2); ss += __shfl_xor(ss, 4);
            const float r = rsqrtf(ss * (1.f / 64.f) + EPS);
#pragma unroll
            for (int e = 0; e < 8; ++e) o[e] *= r * gain[e0 + e];
        }
        const int cg = 64 * half + row;
        if (cg >= NCMP) {
#pragma unroll
            for (int e = 0; e < 8; ++e) o[e] = 0.f; }
        u32x4 w; w.x = pk(o[0], o[1]); w.y = pk(o[2], o[3]); w.z = pk(o[4], o[5]); w.w = pk(o[6], o[7]);
        *(u32x4*)(OUT + (((size_t)(b * NS_G + g) * 128) + cg) * 64 + e0) = w;
    }
    __syncthreads();
}
}
namespace pg8 {
#define PG8_LAS __attribute__((address_space(3)))
typedef short bf16x8 __attribute__((ext_vector_type(8)));
typedef float f32x4 __attribute__((ext_vector_type(4)));
typedef float f32x2 __attribute__((ext_vector_type(2)));
typedef unsigned u32x4 __attribute__((ext_vector_type(4)));
typedef unsigned u32x2 __attribute__((ext_vector_type(2)));
constexpr int BM = 256, BK = 64, HALF = 128, HTB = HALF * BK * 2, STAGE_BYTES = 8 * HTB, NXCD = 8, WGM = 8;

__host__ __device__ __forceinline__ int lds_byte(int r, int c) { const int st = (r >> 4) * 2 + (c >> 5), rr = r & 15, cc = c & 31, ob = rr * 64 + cc * 2; return st * 1024 + (ob ^ (((ob >> 9) & 1) << 5)); }
__host__ __device__ __forceinline__ void stage_rc(int b, int& R, int& C) { const int st = b / 1024, sb = b % 1024, swz = sb ^ (((sb >> 9) & 1) << 5); R = (st >> 1) * 16 + swz / 64; C = (st & 1) * 32 + (swz % 64) / 2; }
__host__ __device__ __forceinline__ int perm32(int rho) { const int n = rho >> 4, i = rho & 15; return 8 * (i >> 2) + 4 * n + (i & 3); }

struct Unit { int pm, pn, ks; };
struct Gemm { const bf16_t* A; const bf16_t* Bt; int lda, ldb; int M, N, K; int ksoff; };

struct StaticOrder {
    int nM, nN, nwg, G, c;
    __host__ __device__ __forceinline__ void init(int M_, int N_, int G_, int c_) { nM = M_ / BM; nN = N_ / BM; nwg = nM * nN; G = G_; c = c_; }
    __host__ __device__ __forceinline__ bool next(int i, Unit& u) const {
        const long L = (long)i * G + c; if (L >= nwg) return false;
        int wgid = (int)L; { const int q = nwg / NXCD, r = nwg % NXCD, xcd = wgid % NXCD, off = wgid / NXCD; wgid = (xcd < r ? xcd * (q + 1) : r * (q + 1) + (xcd - r) * q) + off; }
        const int nig = WGM * nN, gid = wgid / nig, fm = gid * WGM, gsz = (nM - fm) < WGM ? (nM - fm) : WGM;
        u.pm = fm + ((wgid % nig) % gsz); u.pn = (wgid % nig) / gsz; u.ks = 0; return true;
    }
};
struct GatePairOrder {
    StaticOrder base;
    __host__ __device__ __forceinline__ bool next(int i, Unit& u) const { if (!base.next(i >> 1, u)) return false; u.pn += 4 * (i & 1); u.ks = 0; return true; }
};
struct TwoPassOrder {
    StaticOrder base;
    __host__ __device__ __forceinline__ bool next(int i, Unit& u) const { if (!base.next(i >> 1, u)) return false; u.ks = i & 1; return true; }
};

typedef __bf16 bf16x2_t __attribute__((ext_vector_type(2)));
__device__ __forceinline__ unsigned cvt_pk_bf16(float lo, float hi) { f32x2 v = {lo, hi}; bf16x2_t b = __builtin_convertvector(v, bf16x2_t); return __builtin_bit_cast(unsigned, b); }
__device__ __forceinline__ float fast_sigmoid(float x) { return __builtin_amdgcn_rcpf(1.f + __builtin_amdgcn_exp2f(-1.4426950408889634f * x)); }
__device__ __forceinline__ float bflo(unsigned w) { return __uint_as_float(w << 16); }
__device__ __forceinline__ float bfhi(unsigned w) { return __uint_as_float(w & 0xffff0000u); }

typedef f32x4 Acc[2][2][4][2];

template <int ACT> struct EpiP {
    __device__ __forceinline__ bool keep(const Unit&) const { return false; }
    static constexpr bool PERM = true;
    bf16_t* O; int ldc; int pn_last; int ncol_last; bf16_t* halo;
    __device__ __forceinline__ void operator()(const Acc& acc, const Unit& u, int wr, int wc, int fr, int fq) const {
        const int row0 = u.pm * BM + wr * 64 + fr, tcol = wc * 32 + 8 * fq;
        const int lim = (u.pn == pn_last) ? ncol_last : 256;
#pragma unroll
        for (int ai = 0; ai < 2; ++ai)
#pragma unroll
            for (int m = 0; m < 4; ++m) { bf16_t* rowp = O + (size_t)(row0 + ai * HALF + m * 16) * ldc + u.pn * BM + tcol;
#pragma unroll
                for (int bj = 0; bj < 2; ++bj) { if (tcol + bj * HALF >= lim) continue;
                    f32x4 v0 = acc[ai][bj][m][0], v1 = acc[ai][bj][m][1];
                    if (ACT == 1) {
#pragma unroll
                        for (int e = 0; e < 4; ++e) { v0[e] = fast_sigmoid(v0[e]); v1[e] = fast_sigmoid(v1[e]); } }
                    u32x4 w; w.x = cvt_pk_bf16(v0[0], v0[1]); w.y = cvt_pk_bf16(v0[2], v0[3]); w.z = cvt_pk_bf16(v1[0], v1[1]); w.w = cvt_pk_bf16(v1[2], v1[3]);
                    *(u32x4*)(rowp + bj * HALF) = w;
                    if (ACT == 0 && m == 3 && fr >= 13 && u.pn < 12 && halo) { const int row = row0 + ai * HALF + 48;
                        *(u32x4*)(halo + ((size_t)(row >> 6) * 3 + (fr - 13)) * 3072 + u.pn * BM + tcol + bj * HALF) = w; } } }
    }
};
struct EpiP3 {
    __device__ __forceinline__ bool keep(const Unit&) const { return false; }
    static constexpr int PERM = 3;
    bf16_t* O; int ldc; int pn_last; int ncol_last; bf16_t* halo;
    const float* gtab;
    __device__ __forceinline__ void operator()(const Acc& acc, const Unit& u, int wr, int wc, int fr, int fq) const {
        const int row0 = u.pm * BM + wr * 64 + fr, tcol = wc * 64 + 8 * fq;
        const int lim = (u.pn == pn_last) ? ncol_last : 256;
        if (tcol >= lim) return;
        const int mode = (u.pn >= C_NQ / 256 && u.pn < C_NQ / 256 + 4) ? 1 : (u.pn == C_KS / 256 ? 2 : (u.pn == C_KW / 256 ? 3 : 0));
        if (mode) {
            const float* gp = gtab + (mode - 1) * 64 + 8 * fq;
#pragma unroll
            for (int ai = 0; ai < 2; ++ai)
#pragma unroll
                for (int m = 0; m < 4; ++m) { bf16_t* rowp = O + (size_t)(row0 + ai * HALF + m * 16) * ldc + u.pn * BM + tcol;
                    asm volatile("" ::: "memory");
                    float s = 0.f;
#pragma unroll
                    for (int bj = 0; bj < 2; ++bj)
#pragma unroll
                        for (int n = 0; n < 2; ++n) { const f32x4 t = acc[ai][bj][m][n]; s += (t[0] * t[0] + t[1] * t[1]) + (t[2] * t[2] + t[3] * t[3]); }
                    { const auto p = __builtin_amdgcn_permlane16_swap(__float_as_uint(s), __float_as_uint(s), false, false); s = __uint_as_float(p[0]) + __uint_as_float(p[1]); }
                    { const auto p = __builtin_amdgcn_permlane32_swap(__float_as_uint(s), __float_as_uint(s), false, false); s = __uint_as_float(p[0]) + __uint_as_float(p[1]); }
                    const float r = rsqrtf(s * (1.f / 64.f) + EPS);
#pragma unroll
                    for (int bj = 0; bj < 2; ++bj) {
                        const f32x4 v0 = acc[ai][bj][m][0] * r * *(const f32x4*)(gp + 32 * bj), v1 = acc[ai][bj][m][1] * r * *(const f32x4*)(gp + 32 * bj + 4);
                        u32x4 w; w.x = cvt_pk_bf16(v0[0], v0[1]); w.y = cvt_pk_bf16(v0[2], v0[3]); w.z = cvt_pk_bf16(v1[0], v1[1]); w.w = cvt_pk_bf16(v1[2], v1[3]);
                        *(u32x4*)(rowp + bj * 32) = w; } }
            return;
        }
#pragma unroll
        for (int ai = 0; ai < 2; ++ai)
#pragma unroll
            for (int m = 0; m < 4; ++m) { bf16_t* rowp = O + (size_t)(row0 + ai * HALF + m * 16) * ldc + u.pn * BM + tcol;
#pragma unroll
                for (int bj = 0; bj < 2; ++bj) {
                    const f32x4 v0 = acc[ai][bj][m][0], v1 = acc[ai][bj][m][1];
                    u32x4 w; w.x = cvt_pk_bf16(v0[0], v0[1]); w.y = cvt_pk_bf16(v0[2], v0[3]); w.z = cvt_pk_bf16(v1[0], v1[1]); w.w = cvt_pk_bf16(v1[2], v1[3]);
                    *(u32x4*)(rowp + bj * 32) = w;
                    if (m == 3 && fr >= 13 && u.pn < 12 && halo) { const int row = row0 + ai * HALF + 48;
                        *(u32x4*)(halo + ((size_t)(row >> 6) * 3 + (fr - 13)) * 3072 + u.pn * BM + tcol + bj * 32) = w; } } }
    }
};
struct EpiMix {
    static constexpr bool PERM = true;
    const bf16_t* G; int ldg; bf16_t* O; int ldc;
    __device__ __forceinline__ bool keep(const Unit& u) const { return u.ks == 0; }
    __device__ __forceinline__ void operator()(Acc& acc, const Unit& u, int wr, int wc, int fr, int fq) const {
        const int row0 = u.pm * BM + wr * 64 + fr, col0 = u.pn * BM + wc * 32 + 8 * fq;
#pragma unroll
        for (int ai = 0; ai < 2; ++ai)
#pragma unroll
            for (int m = 0; m < 4; ++m) { const size_t row = (size_t)(row0 + ai * HALF + m * 16); const bf16_t* gp = G + row * ldg + col0; bf16_t* rowp = O + row * ldc + col0;
#pragma unroll
                for (int bj = 0; bj < 2; ++bj) { const u32x4 b = *(const u32x4*)(gp + bj * HALF + 1024);
                    f32x4 v0 = acc[ai][bj][m][0], v1 = acc[ai][bj][m][1];
                    if (u.ks == 0) { const u32x4 a = *(const u32x4*)(gp + bj * HALF);
                        v0[0] *= bflo(a.x) * __builtin_amdgcn_rcpf(bflo(b.x)); v0[1] *= bfhi(a.x) * __builtin_amdgcn_rcpf(bfhi(b.x)); v0[2] *= bflo(a.y) * __builtin_amdgcn_rcpf(bflo(b.y)); v0[3] *= bfhi(a.y) * __builtin_amdgcn_rcpf(bfhi(b.y));
                        v1[0] *= bflo(a.z) * __builtin_amdgcn_rcpf(bflo(b.z)); v1[1] *= bfhi(a.z) * __builtin_amdgcn_rcpf(bfhi(b.z)); v1[2] *= bflo(a.w) * __builtin_amdgcn_rcpf(bflo(b.w)); v1[3] *= bfhi(a.w) * __builtin_amdgcn_rcpf(bfhi(b.w));
                        acc[ai][bj][m][0] = v0; acc[ai][bj][m][1] = v1;
                    } else {
                        u32x4 w; w.x = cvt_pk_bf16(v0[0] * bflo(b.x), v0[1] * bfhi(b.x)); w.y = cvt_pk_bf16(v0[2] * bflo(b.y), v0[3] * bfhi(b.y));
                        w.z = cvt_pk_bf16(v1[0] * bflo(b.z), v1[1] * bfhi(b.z)); w.w = cvt_pk_bf16(v1[2] * bflo(b.w), v1[3] * bfhi(b.w));
                        *(u32x4*)(rowp + bj * HALF) = w; } }
                if (u.ks == 0 && (m & 1)) asm volatile("" ::: "memory"); }
    }
};
struct EpiOut {
    __device__ __forceinline__ bool keep(const Unit&) const { return false; }
    static constexpr bool PERM = true;
    const float* X; bf16_t* Xb; float* pss;
    __device__ __forceinline__ void operator()(const Acc& acc, const Unit& u, int wr, int wc, int fr, int fq) const {
        const int row0 = u.pm * BM + wr * 64 + fr, col0 = u.pn * BM + wc * 32 + 8 * fq;
#pragma unroll
        for (int ai = 0; ai < 2; ++ai)
#pragma unroll
            for (int m = 0; m < 4; ++m) { const size_t row = (size_t)(row0 + ai * HALF + m * 16); const size_t off = row * D + col0; float ss = 0.f;
#pragma unroll
                for (int bj = 0; bj < 2; ++bj) { const f32x4* xp = (const f32x4*)(X + off + bj * HALF);
                    const f32x4 a = xp[0] + acc[ai][bj][m][0], b = xp[1] + acc[ai][bj][m][1];
                    ss += ((a[0] * a[0] + a[1] * a[1]) + (a[2] * a[2] + a[3] * a[3])) + ((b[0] * b[0] + b[1] * b[1]) + (b[2] * b[2] + b[3] * b[3]));
                    u32x4 w; w.x = cvt_pk_bf16(a[0], a[1]); w.y = cvt_pk_bf16(a[2], a[3]); w.z = cvt_pk_bf16(b[0], b[1]); w.w = cvt_pk_bf16(b[2], b[3]);
                    *(u32x4*)(Xb + off + bj * HALF) = w; }
                ss += __shfl_xor(ss, 16); ss += __shfl_xor(ss, 32);
                if (fq == 0) pss[row * 16 + u.pn * 4 + wc] = ss; }
    }
};
struct EpiUp {
    __device__ __forceinline__ bool keep(const Unit&) const { return false; }
    static constexpr bool PERM = true;
    const float* pss; bf16_t* O; int ldc; const PG8_LAS float* tab;
    __device__ __forceinline__ void operator()(const Acc& acc, const Unit& u, int wr, int wc, int fr, int fq) const {
        const int row0 = u.pm * BM + wr * 64 + fr, col0 = u.pn * BM + wc * 32 + 8 * fq;
#pragma unroll
        for (int ai = 0; ai < 2; ++ai)
#pragma unroll
            for (int m = 0; m < 4; ++m) { const size_t row = (size_t)(row0 + ai * HALF + m * 16);
                float rstd;
                if (tab) rstd = tab[u.ks * BM + wr * 64 + fr + ai * HALF + m * 16];
                else { const f32x4* pp = (const f32x4*)(pss + row * 16); const f32x4 s4 = (pp[0] + pp[1]) + (pp[2] + pp[3]); rstd = rsqrtf(((s4[0] + s4[1]) + (s4[2] + s4[3])) * (1.f / D) + EPS); }
                bf16_t* rowp = O + row * ldc + col0;
#pragma unroll
                for (int bj = 0; bj < 2; ++bj) { f32x4 v0 = acc[ai][bj][m][0] * rstd, v1 = acc[ai][bj][m][1] * rstd;
#pragma unroll
                    for (int e = 0; e < 4; ++e) { const float a = fmaxf(v0[e], 0.f), b = fmaxf(v1[e], 0.f); v0[e] = a * a; v1[e] = b * b; }
                    u32x4 w; w.x = cvt_pk_bf16(v0[0], v0[1]); w.y = cvt_pk_bf16(v0[2], v0[3]); w.z = cvt_pk_bf16(v1[0], v1[1]); w.w = cvt_pk_bf16(v1[2], v1[3]);
                    *(u32x4*)(rowp + bj * HALF) = w; } }
    }
};
struct IndexedOrder {
    StaticOrder base;
    __host__ __device__ __forceinline__ bool next(int i, Unit& u) const { if (!base.next(i, u)) return false; u.ks = i; return true; }
};
struct EpiDown {
    __device__ __forceinline__ bool keep(const Unit&) const { return false; }
    static constexpr bool PERM = true;
    const bf16_t* Xb; float* O;
    __device__ __forceinline__ void operator()(const Acc& acc, const Unit& u, int wr, int wc, int fr, int fq) const {
        const int row0 = u.pm * BM + wr * 64 + fr, col0 = u.pn * BM + wc * 32 + 8 * fq;
#pragma unroll
        for (int ai = 0; ai < 2; ++ai)
#pragma unroll
            for (int m = 0; m < 4; ++m) { const size_t off = (size_t)(row0 + ai * HALF + m * 16) * D + col0;
#pragma unroll
                for (int bj = 0; bj < 2; ++bj) { const u32x4 w = *(const u32x4*)(Xb + off + bj * HALF); f32x4* op = (f32x4*)(O + off + bj * HALF);
                    op[0] = (f32x4){bflo(w.x), bfhi(w.x), bflo(w.y), bfhi(w.y)} + acc[ai][bj][m][0];
                    op[1] = (f32x4){bflo(w.z), bfhi(w.z), bflo(w.w), bfhi(w.w)} + acc[ai][bj][m][1]; } }
    }
};

template <class Epi, class Sched, bool ALIGN_EPI>
__device__ __forceinline__ void gemm_phase(PG8_LAS unsigned char* lds, const Gemm g, const Sched& S, const Epi& E) {
    const int tid = threadIdx.x, wid = __builtin_amdgcn_readfirstlane(tid >> 6), lane = tid & 63, wr = wid >> 2, wc = wid & 3, fr = lane & 15, fq = lane >> 4;
    const int K = g.K, nt = K / BK, lda = g.lda, ldb = g.ldb;
    unsigned voffA[2], voffB[2];
#pragma unroll
    for (int i = 0; i < 2; ++i) { int R, C; stage_rc(tid * 16 + i * 8192, R, C); const int Rb = (int)Epi::PERM == 3 ? (64 * (R >> 5) + 8 * ((R >> 2) & 3) + 4 * ((R >> 4) & 1) + (R & 3)) : (Epi::PERM ? ((R & ~31) + perm32(R & 31)) : R);
        voffA[i] = (unsigned)(R * lda + C) * 2u; voffB[i] = (unsigned)(Rb * ldb + C) * 2u; }
    const size_t kstep = (size_t)(BK * 2);
    const size_t hstepA = (size_t)HALF * lda * 2, hstepB = (size_t)((int)Epi::PERM == 3 ? 32 : HALF) * ldb * 2;
    const size_t tstepA = 2 * hstepA, tstepB = (size_t)BM * ldb * 2;
    const unsigned ldsw = (unsigned)wid * 1024u;
    const int aoff = lds_byte(wr * 64 + fr, fq * 8), boff = lds_byte(wc * 32 + fr, fq * 8);
#define PG8_SA(b, h) (((b) * 2 + (h)) * HTB)
#define PG8_SB(b, h) ((4 + (b) * 2 + (h)) * HTB)
#define PG8_STAGE(bufoff, gbase, voff) do { _Pragma("unroll") for (int _i = 0; _i < 2; ++_i) \
        __builtin_amdgcn_global_load_lds((const unsigned*)((const char*)(gbase) + (voff)[_i]), (PG8_LAS unsigned*)(lds + (bufoff) + ldsw + _i * 8192), 16, 0, 0); } while (0)
#define PG8_LDA(dst, b, h) do { _Pragma("unroll") for (int m = 0; m < 4; ++m) _Pragma("unroll") for (int k = 0; k < 2; ++k) dst[m][k] = *(const PG8_LAS bf16x8*)(lds + PG8_SA(b, h) + aoff + m * 2048 + k * 1024); } while (0)
#define PG8_LDB(dst, b, h) do { _Pragma("unroll") for (int n = 0; n < 2; ++n) _Pragma("unroll") for (int k = 0; k < 2; ++k) dst[n][k] = *(const PG8_LAS bf16x8*)(lds + PG8_SB(b, h) + boff + n * 2048 + k * 1024); } while (0)
#define PG8_MMA(ai, bj, At, Bt) do { __builtin_amdgcn_s_setprio(1); _Pragma("unroll") for (int m = 0; m < 4; ++m) _Pragma("unroll") for (int n = 0; n < 2; ++n) _Pragma("unroll") for (int k = 0; k < 2; ++k) \
        acc[ai][bj][m][n] = __builtin_amdgcn_mfma_f32_16x16x32_bf16(Bt[n][k], At[m][k], acc[ai][bj][m][n], 0, 0, 0); __builtin_amdgcn_s_setprio(0); } while (0)
#define PG8_WAIT_V(n) asm volatile("s_waitcnt vmcnt(" #n ")" ::: "memory")
#define PG8_WAIT_L(n) asm volatile("s_waitcnt lgkmcnt(" #n ")" ::: "memory")
#define PG8_BAR __builtin_amdgcn_s_barrier()
#define PG8_SCHED __builtin_amdgcn_sched_barrier(0)
#define PG8_KBODY(t) do { \
            const bool last = (t == nt - 2); \
            const char* a1 = cA + (size_t)(t + 1) * kstep; \
            const char* a2 = last ? nA : cA + (size_t)(t + 2) * kstep; const char* b2 = last ? nB : cB + (size_t)(t + 2) * kstep; \
            const char* a3 = a2 + kstep; const char* b3 = b2 + kstep; \
            PG8_LDB(B0, 0, 0); PG8_LDB(B1, 0, 1); PG8_SCHED; PG8_LDA(At, 0, 0); PG8_STAGE(PG8_SA(1, 1), a1 + hstepA, voffA); \
            PG8_WAIT_V(8); PG8_WAIT_L(0); PG8_BAR; PG8_MMA(0, 0, At, B0); PG8_MMA(0, 1, At, B1); PG8_BAR; PG8_SCHED; \
            PG8_LDA(At, 0, 1); PG8_STAGE(PG8_SB(0, 0), b2, voffB); PG8_STAGE(PG8_SB(0, 1), b2 + hstepB, voffB); PG8_STAGE(PG8_SA(0, 0), a2, voffA); \
            PG8_WAIT_V(8); PG8_WAIT_L(0); PG8_BAR; PG8_MMA(1, 0, At, B0); PG8_MMA(1, 1, At, B1); PG8_BAR; PG8_SCHED; \
            PG8_LDB(B0, 1, 0); PG8_LDB(B1, 1, 1); PG8_SCHED; PG8_LDA(At, 1, 0); PG8_STAGE(PG8_SA(0, 1), a2 + hstepA, voffA); \
            PG8_WAIT_V(8); PG8_WAIT_L(0); PG8_BAR; PG8_MMA(0, 0, At, B0); PG8_MMA(0, 1, At, B1); PG8_BAR; PG8_SCHED; \
            PG8_LDA(At, 1, 1); PG8_STAGE(PG8_SB(1, 0), b3, voffB); PG8_STAGE(PG8_SB(1, 1), b3 + hstepB, voffB); PG8_STAGE(PG8_SA(1, 0), a3, voffA); \
            PG8_WAIT_V(8); PG8_WAIT_L(0); PG8_BAR; PG8_MMA(1, 0, At, B0); PG8_MMA(1, 1, At, B1); PG8_BAR; PG8_SCHED; \
        } while (0)
    Unit cur, nxt; int ui = 0;
    if (!S.next(0, cur)) return;
    Acc acc;
#pragma unroll
    for (int a = 0; a < 2; ++a)
#pragma unroll
        for (int b = 0; b < 2; ++b)
#pragma unroll
            for (int m = 0; m < 4; ++m)
#pragma unroll
                for (int n = 0; n < 2; ++n) acc[a][b][m][n] = (f32x4){0.f, 0.f, 0.f, 0.f};
    bf16x8 At[4][2], B0[2][2], B1[2][2];
    const char* cA = (const char*)g.A + (size_t)cur.pm * tstepA + (size_t)cur.ks * g.ksoff * 2; const char* cB = (const char*)g.Bt + (size_t)cur.pn * tstepB + (size_t)cur.ks * g.ksoff * 2;
    PG8_STAGE(PG8_SB(0, 0), cB, voffB); PG8_STAGE(PG8_SB(0, 1), cB + hstepB, voffB); PG8_STAGE(PG8_SA(0, 0), cA, voffA); PG8_STAGE(PG8_SA(0, 1), cA + hstepA, voffA);
    if (wr == 1) PG8_BAR;
    PG8_WAIT_V(2); PG8_BAR;
    PG8_STAGE(PG8_SB(1, 0), cB + kstep, voffB); PG8_STAGE(PG8_SA(1, 0), cA + kstep, voffA); PG8_STAGE(PG8_SB(1, 1), cB + hstepB + kstep, voffB);
    PG8_WAIT_V(6); PG8_BAR;
    for (;;) {
        const bool has_next = S.next(ui + 1, nxt);
        const char* nA = has_next ? (const char*)g.A + (size_t)nxt.pm * tstepA + (size_t)nxt.ks * g.ksoff * 2 : cA; const char* nB = has_next ? (const char*)g.Bt + (size_t)nxt.pn * tstepB + (size_t)nxt.ks * g.ksoff * 2 : cB;
        for (int t = 0; t < nt; t += 2) PG8_KBODY(t);
        if constexpr (ALIGN_EPI) { if (wr == 0) PG8_BAR; }
        E(acc, cur, wr, wc, fr, fq);
        if (!has_next) break;
        if (!E.keep(cur)) {
#pragma unroll
        for (int a = 0; a < 2; ++a)
#pragma unroll
            for (int b = 0; b < 2; ++b)
#pragma unroll
                for (int m = 0; m < 4; ++m)
#pragma unroll
                    for (int n = 0; n < 2; ++n) acc[a][b][m][n] = (f32x4){0.f, 0.f, 0.f, 0.f};
        }
        cur = nxt; cA = nA; cB = nB; ++ui;
        if constexpr (ALIGN_EPI) { if (wr == 1) PG8_BAR; }
    }
    PG8_WAIT_V(0);
    if constexpr (!ALIGN_EPI) { if (wr == 0) PG8_BAR; }
    PG8_BAR;
#undef PG8_SA
#undef PG8_SB
#undef PG8_STAGE
#undef PG8_LDA
#undef PG8_LDB
#undef PG8_MMA
#undef PG8_WAIT_V
#undef PG8_WAIT_L
#undef PG8_BAR
#undef PG8_SCHED
#undef PG8_KBODY
}
}

#define GAS __attribute__((address_space(1)))
#define LAS __attribute__((address_space(3)))
typedef unsigned v4u __attribute__((ext_vector_type(4)));
typedef float f32x4 __attribute__((ext_vector_type(4)));
constexpr int NWAVES = 8;
constexpr int LDS_BYTES = 163840;
constexpr size_t MiB = 1u << 20;
constexpr size_t WS_PSS = 1 * MiB, WS_WOUT = 2 * MiB, WS_P = 4 * MiB, WS_KC = 214 * MiB, WS_VC = 215 * MiB, WS_MIX = 216 * MiB;
constexpr size_t WS_AN = 4 * MiB, WS_UP = 64 * MiB, WS_WUP = 248 * MiB, WS_WDOWN = 200 * MiB;
constexpr size_t WS_BIAS1 = 131072 + 16384, WS_W1T = 214 * MiB, WS_KCB = 215 * MiB, WS_VCB = 215 * MiB + 512 * 1024;
constexpr size_t WS_GLV = 4096, WS_QCNT = 65536, WS_GW = 216 * MiB, DO_GQK = 40 * MiB, DO_HALO = 56 * MiB;
constexpr size_t WS_GTAB3 = 262144;
constexpr size_t WS_XBAR = 131072;
constexpr size_t DO_H = 0, DO_WG = 32 * MiB, DO_WCAT = 36 * MiB, DO_WIN = 40 * MiB;

__device__ __forceinline__ unsigned pk2(float lo, float hi) { return (unsigned)f2bf(lo) | ((unsigned)f2bf(hi) << 16); }
__device__ __forceinline__ float wave_sum(float v) {
#pragma unroll
    for (int o = 1; o < 64; o <<= 1) v += __shfl_xor(v, o);
    return v;
}
template <class SrcCol>
__device__ __forceinline__ void transpose_item(const float* W, int ldw, const SrcCol& srccol, bf16_t* WT, int ldk, int kofs, LAS float* scr, int kb, int nb, int lane, const float* ksc = nullptr) {
    const int k0 = 64 * kb, n0 = 64 * nb; const int n4 = (lane & 15) * 4; const int sc = srccol(n0 + n4);
    f32x4 v[16];
    const float* wp = W + (size_t)(k0 + (lane >> 4)) * ldw + (sc >= 0 ? sc : 0);
#pragma unroll
    for (int i = 0; i < 16; ++i) v[i] = *(const f32x4*)(wp + (size_t)(4 * i) * ldw);
#pragma unroll
    for (int i = 0; i < 16; ++i) { const int kk = 4 * i + (lane >> 4); const f32x4 u = (sc >= 0) ? v[i] : (f32x4){0.f, 0.f, 0.f, 0.f};
        scr[kk * 65 + n4] = u[0]; scr[kk * 65 + n4 + 1] = u[1]; scr[kk * 65 + n4 + 2] = u[2]; scr[kk * 65 + n4 + 3] = u[3]; }
    asm volatile("s_waitcnt lgkmcnt(0)" ::: "memory");
    const int c = lane & 7;
    f32x4 ga = {1.f, 1.f, 1.f, 1.f}, gb = ga;
    if (ksc) { ga = *(const f32x4*)(ksc + k0 + 8 * c); gb = *(const f32x4*)(ksc + k0 + 8 * c + 4); }
#pragma unroll
    for (int j = 0; j < 8; ++j) { const int n = (lane >> 3) + 8 * j; const LAS float* sp = scr + (8 * c) * 65 + n;
        v4u o; o.x = pk2(sp[0 * 65] * ga[0], sp[1 * 65] * ga[1]); o.y = pk2(sp[2 * 65] * ga[2], sp[3 * 65] * ga[3]); o.z = pk2(sp[4 * 65] * gb[0], sp[5 * 65] * gb[1]); o.w = pk2(sp[6 * 65] * gb[2], sp[7 * 65] * gb[3]);
        *(v4u*)(WT + (size_t)(n0 + n) * ldk + kofs + k0 + 8 * c) = o; }
    asm volatile("s_waitcnt lgkmcnt(0)" ::: "memory");
}
struct SrcIdent { int off; __device__ __forceinline__ int operator()(int n) const { return n + off; } };
struct SrcWin { __device__ __forceinline__ int operator()(int n) const { return n < 4096 ? n : (n < 6656 ? n + 16 : (n < 6672 ? n - 6656 + 4096 : (n < 6720 ? n : -1))); } };

typedef GAS unsigned gu32;
#define RLX_AGENT __ATOMIC_RELAXED, __HIP_MEMORY_SCOPE_AGENT
#define XB_TMO      128
#define XB_XCNT(j)  (256  + 64 * (j))
#define XB_XSUB(j)  (1280 + 64 * (j))
#define XB_XGEN(j)  (2304 + 64 * (j))
#define XB_TOP      3328
#define XB_TOPGEN   3392
#define XCD_BAR_WORDS 3456
#define XB_SPIN_CAP (1u << 18)

__device__ __forceinline__ unsigned xb_ld(unsigned* p)              { return __hip_atomic_load(p, __ATOMIC_RELAXED, __HIP_MEMORY_SCOPE_AGENT); }
__device__ __forceinline__ unsigned xb_add(unsigned* p, unsigned v) { return __hip_atomic_fetch_add(p, v, __ATOMIC_RELAXED, __HIP_MEMORY_SCOPE_AGENT); }
__device__ __forceinline__ unsigned xb_xcc_id() { return (unsigned)__builtin_amdgcn_s_getreg((3 << 11) | 20) & 0xFu; }
#define XB_SPIN(cond, bar) do { unsigned _sp = 0; while (cond) { __builtin_amdgcn_s_sleep(1); \
    if ((++_sp & 255u) == 0u) { if (xb_ld(&(bar)[XB_TMO])) break; if (_sp > XB_SPIN_CAP) { atomicAdd(&(bar)[XB_TMO], 1u); break; } } } } while (0)

struct XcdBarrier {
    unsigned* bar; unsigned x;
    volatile LAS unsigned* st;
};

__device__ __forceinline__ XcdBarrier xcd_barrier_post(unsigned* bar, volatile LAS unsigned* st) {
    XcdBarrier b; b.bar = bar; b.x = xb_xcc_id(); b.st = st;
    if (threadIdx.x == 0) (void)xb_add(&bar[XB_XCNT(b.x)], 1u);
    return b;
}
__device__ __forceinline__ void xcd_barrier_complete(unsigned* bar, unsigned x, unsigned& nloc, unsigned& nx) {
    const unsigned G = gridDim.x * gridDim.y * gridDim.z;
    unsigned sum, cnt, mine, sp = 0u;
    for (;;) {
        sum = 0u; cnt = 0u; mine = 0u;
#pragma unroll
        for (unsigned j = 0; j < 16; ++j) { const unsigned c = xb_ld(&bar[XB_XCNT(j)]); sum += c; cnt += (c > 0u) ? 1u : 0u; mine = (j == x) ? c : mine; }
        if (sum == G) break;
        __builtin_amdgcn_s_sleep(1);
        if ((++sp & 255u) == 0u) { if (xb_ld(&bar[XB_TMO])) break; if (sp > XB_SPIN_CAP) { atomicAdd(&bar[XB_TMO], 1u); break; } }
    }
    nloc = mine > 0u ? mine : 1u; nx = cnt > 0u ? cnt : 1u;
}

__device__ __forceinline__ void xcd_barrier(const XcdBarrier& b) {
    asm volatile("s_waitcnt vmcnt(0)" ::: "memory");
    __syncthreads();
    if (threadIdx.x == 0) {
        unsigned* bar = b.bar;
        __builtin_amdgcn_s_waitcnt(0);
        unsigned nloc = b.st[0], nx = b.st[1];
        if (nloc == 0u) { xcd_barrier_complete(bar, b.x, nloc, nx); b.st[0] = nloc; b.st[1] = nx; }
        const unsigned old = xb_add(&bar[XB_XSUB(b.x)], 1u);
        const unsigned gen = old / nloc;
        if (old + 1u == (gen + 1u) * nloc) {
            __builtin_amdgcn_fence(__ATOMIC_RELEASE, "agent");
            asm volatile("s_waitcnt vmcnt(0)" ::: "memory");
            const unsigned og = xb_add(&bar[XB_TOP], 1u);
            const unsigned tg = og / nx;
            if (og + 1u == (tg + 1u) * nx) xb_add(&bar[XB_TOPGEN], 1u);
            else XB_SPIN(xb_ld(&bar[XB_TOPGEN]) == tg, bar);
            __builtin_amdgcn_fence(__ATOMIC_ACQUIRE, "agent");
            xb_add(&bar[XB_XGEN(b.x)], 1u);
            asm volatile("s_waitcnt vmcnt(0)" ::: "memory");
        } else {
            XB_SPIN(xb_ld(&bar[XB_XGEN(b.x)]) == gen, bar);
            __builtin_amdgcn_fence(__ATOMIC_ACQUIRE, "agent");
            asm volatile("s_waitcnt vmcnt(0)" ::: "memory");
        }
    }
    __syncthreads();
}


struct Args { const float* in[23]; float* out; unsigned char* ws; int ph_lo, ph_hi; };

__global__ void __launch_bounds__(NWAVES * 64, 2) mk_fwd(Args args) {
    extern __shared__ __attribute__((aligned(16))) unsigned char lds_raw[];
    LAS unsigned char* lds = (LAS unsigned char*)lds_raw;
    __builtin_assume(__builtin_amdgcn_workitem_id_y() == 0); __builtin_assume(__builtin_amdgcn_workitem_id_z() == 0);
    cg::grid_group grid = cg::this_grid();
    const int wave = __builtin_amdgcn_readfirstlane((int)threadIdx.x >> 6);
#define tid ((int)threadIdx.x)
#define lane ((int)(threadIdx.x & 63u))
    const int G = gridDim.x, gw = blockIdx.x * NWAVES + wave, NGW = G * NWAVES;
    unsigned char* ws = args.ws; unsigned char* dob = (unsigned char*)args.out;
    const float* x = args.in[0];
    bf16_t* P = (bf16_t*)(ws + WS_P);
    bf16_t* Hb = (bf16_t*)(dob + DO_H); bf16_t* Wg_t = (bf16_t*)(dob + DO_WG); bf16_t* Wcat_t = (bf16_t*)(dob + DO_WCAT); bf16_t* Win_t = (bf16_t*)(dob + DO_WIN);
    bf16_t* Wout_t = (bf16_t*)(ws + WS_WOUT); bf16_t* Wup_t = (bf16_t*)(ws + WS_WUP); bf16_t* Wdown_t = (bf16_t*)(ws + WS_WDOWN);
    bf16_t* Mix = (bf16_t*)(ws + WS_MIX); bf16_t* An = (bf16_t*)(ws + WS_AN); bf16_t* Up = (bf16_t*)(ws + WS_UP); float* pss = (float*)(ws + WS_PSS);
    LAS float* scr = (LAS float*)(lds + wave * 17408);
    bf16_t* Halo = (bf16_t*)(dob + DO_HALO); bf16_t* GWb = (bf16_t*)(ws + WS_GW); bf16_t* GQKb = (bf16_t*)(dob + DO_GQK); float* GLv = (float*)(ws + WS_GLV); unsigned* qcnt = (unsigned*)(ws + WS_QCNT);
    bf16_t* W1T = (bf16_t*)(ws + WS_W1T); float* bias1 = (float*)(ws + WS_BIAS1); bf16_t* KCb = (bf16_t*)(ws + WS_KCB); bf16_t* VCb = (bf16_t*)(ws + WS_VCB);
    float* gtab3 = (float*)(ws + WS_GTAB3);
    const int lo = args.ph_lo, hi = args.ph_hi;
    if (tid < 2) ((volatile LAS unsigned*)(lds + LDS_BYTES - 32))[tid] = 0u;
    __syncthreads();
    XcdBarrier xbar = xcd_barrier_post((unsigned*)(ws + WS_XBAR), (volatile LAS unsigned*)(lds + LDS_BYTES - 32));
    if (args.ph_hi > 1000) grid.sync();
#ifndef PHMASK
#define PHMASK 0x1ff
#endif
#define IN(k) (((PHMASK >> (k)) & 1) && lo <= (k) && (k) < hi)
#define GRID_SYNC() do { asm volatile("s_waitcnt vmcnt(0) lgkmcnt(0)" ::: "memory"); grid.sync(); \
        if (wave == 0) { __builtin_amdgcn_fence(__ATOMIC_ACQUIRE, "agent"); asm volatile("s_waitcnt vmcnt(0)" ::: "memory"); } __syncthreads(); } while (0)
#define SEAM(k) do { if (IN(k) && IN((k) + 1)) xcd_barrier(xbar); } while (0)

    if (IN(0)) {
        if (blockIdx.x == 0 && tid == 0) { *qcnt = 0u; ((volatile unsigned*)(ws + 786432))[4] = 0u; }
        if (blockIdx.x == 1 && tid < 192) gtab3[tid] = tid < 64 ? args.in[7][tid] * (0.125f * nsa::LOG2E) : (tid < 128 ? args.in[9][tid - 64] : args.in[10][tid - 128]);
        constexpr int I_WIN = 16 * (NP1 / 64), I_WG = 16 * 32, I_DN = 16 * 16, I_OUT = 16 * 16, I_UP = 16 * 64;
        constexpr int I_W1 = 32 * 2, I_B1 = 64;
        constexpr int NITEMS = I_WIN + 2 * I_W1 + I_B1;
        for (int it = gw; it < NITEMS; it += NGW) {
            int r = it;
            if (r < I_WIN) { transpose_item(args.in[2], INW, SrcWin{}, Win_t, D, 0, scr, r / (NP1 / 64), r % (NP1 / 64), lane); continue; } r -= I_WIN;
            if (r < I_W1) { transpose_item(args.in[12], 128, SrcIdent{0}, W1T, 2048, 0, scr, r / 2, r % 2, lane); continue; } r -= I_W1;
            if (r < I_W1) { transpose_item(args.in[15], 128, SrcIdent{0}, W1T + 128 * 2048, 2048, 0, scr, r / 2, r % 2, lane); continue; } r -= I_W1;
            {
                const int which = r >> 5, kc = r & 31; const float* pos = args.in[which ? 14 : 11] + kc * 64; const float* w1 = args.in[which ? 15 : 12] + (size_t)kc * 64 * 128 + 2 * lane;
                float a0 = 0.f, a1 = 0.f;
#pragma unroll 16
                for (int k = 0; k < 64; ++k) { const float pk_ = pos[k]; const float2 w = *(const float2*)(w1 + (size_t)k * 128); a0 += pk_ * w.x; a1 += pk_ * w.y; }
                atomicAdd(bias1 + which * 128 + 2 * lane, a0); atomicAdd(bias1 + which * 128 + 2 * lane + 1, a1);
            }
        }
        const float* gain = args.in[1];
        f32x4 gv[4];
#pragma unroll
        for (int j = 0; j < 4; ++j) gv[j] = ((const f32x4*)gain)[lane + 64 * j];
        for (int m = gw; m < M; m += 2 * NGW) {
            const int m2 = (m + NGW < M) ? m + NGW : m;
            const f32x4* xr = (const f32x4*)(x + (size_t)m * D) + lane; const f32x4* xr2 = (const f32x4*)(x + (size_t)m2 * D) + lane;
            f32x4 v[4], u[4]; float s1 = 0.f, s2 = 0.f;
#pragma unroll
            for (int j = 0; j < 4; ++j) { v[j] = xr[64 * j]; u[j] = xr2[64 * j]; }
#pragma unroll
            for (int j = 0; j < 4; ++j) { s1 += (v[j].x * v[j].x + v[j].y * v[j].y) + (v[j].z * v[j].z + v[j].w * v[j].w); s2 += (u[j].x * u[j].x + u[j].y * u[j].y) + (u[j].z * u[j].z + u[j].w * u[j].w); }
            const float r1 = rsqrtf(wave_sum(s1) * (1.f / D) + EPS), r2 = rsqrtf(wave_sum(s2) * (1.f / D) + EPS);
            unsigned long long* o8 = (unsigned long long*)(Hb + (size_t)m * D) + lane; unsigned long long* o9 = (unsigned long long*)(Hb + (size_t)m2 * D) + lane;
#pragma unroll
            for (int j = 0; j < 4; ++j) { const f32x4 y = v[j] * r1 * gv[j]; o8[64 * j] = (unsigned long long)pk2(y.x, y.y) | ((unsigned long long)pk2(y.z, y.w) << 32); }
            if (m2 != m) {
#pragma unroll
                for (int j = 0; j < 4; ++j) { const f32x4 y = u[j] * r2 * gv[j]; o9[64 * j] = (unsigned long long)pk2(y.x, y.y) | ((unsigned long long)pk2(y.z, y.w) << 32); } }
        }
    }
    SEAM(0);
    if (IN(1)) {
        pg8::Gemm g{Hb, Win_t, D, D, M, NP1, D, 0}; pg8::StaticOrder S; S.init(M, NP1, G, (int)blockIdx.x);
        pg8::EpiP3 E{P, LDP, 26, 64, Halo, gtab3};
        pg8::gemm_phase<pg8::EpiP3, pg8::StaticOrder, true>(lds, g, S, E);
        {
            constexpr int I_WG = 16 * 32, I_DN = 16 * 16, I_OUT = 16 * 16, I_UP = 16 * 64, NT = I_WG + 2 * I_DN + I_OUT + I_UP;
            const int nwg = (M / 256) * (NP1 / 256), maxu = (nwg + G - 1) / G, thr = nwg - (maxu - 1) * G;
            const int nsl = (thr < G) ? G - thr : G, sidx = (thr < G) ? (int)blockIdx.x - thr : (int)blockIdx.x;
            if (sidx >= 0) for (int it = sidx * NWAVES + wave; it < NT; it += nsl * NWAVES) {
                int r = it;
                if (r < I_WG) { transpose_item(args.in[2], INW, SrcIdent{6720}, Wg_t, D, 0, scr, r / 32, r % 32, lane); continue; } r -= I_WG;
                if (r < I_DN) { transpose_item(args.in[17], D, SrcIdent{0}, Wcat_t, 2 * D, 0, scr, r / 16, r % 16, lane); continue; } r -= I_DN;
                if (r < I_DN) { transpose_item(args.in[18], D, SrcIdent{0}, Wcat_t, 2 * D, D, scr, r / 16, r % 16, lane); continue; } r -= I_DN;
                if (r < I_OUT) { transpose_item(args.in[19], D, SrcIdent{0}, Wout_t, D, 0, scr, r / 16, r % 16, lane); continue; } r -= I_OUT;
                transpose_item(args.in[21], FF, SrcIdent{0}, Wup_t, D, 0, scr, r / 64, r % 64, lane, args.in[20]);
            }
        }
    }
    SEAM(1);
    if (IN(2)) {
        for (int it = (G == 256) ? (((int)blockIdx.x & 1) ? 128 : (int)blockIdx.x >> 1) : (int)blockIdx.x; it < 128; it += G) {
            const int half = it & 1, which = (it >> 1) & 1, g_ = (it >> 2) & 3, b_ = it >> 4;
            nsa::compress_item(lds, P, W1T + (size_t)which * 128 * 2048, bias1 + which * 128, args.in[which ? 16 : 13], args.in[8], which ? VCb : KCb, b_, g_, which, half);
        }
        __syncthreads();
        {
            gdn::RowPre pre; int hl = -1;
            const int c_ = (int)blockIdx.x, hq = c_ >> 5, jq = c_ & 31;
            const bool bal = (G == 256);
            const int cnt = bal ? ((jq & 1) ? 9 : 7) : (2048 - c_ + G - 1) / G;
            const int first = bal ? ((jq & 1) ? 112 + 9 * (jq >> 1) : 7 * (jq >> 1)) : 0;
#define PREP_COORD(k, b_, n_, h_) do { if (bal) { const int idx_ = first + (k); b_ = idx_ >> 5; n_ = idx_ & 31; h_ = hq; } else { const int it_ = c_ + (k) * G; b_ = it_ >> 8; n_ = it_ & 31; h_ = (it_ >> 5) & 7; } } while (0)
            int b0, n0, h0;
            if (cnt > 0) { PREP_COORD(0, b0, n0, h0); gdn::prep_prefetch(pre, P, Halo, b0, n0, h0, wave, lane); }
            for (int k = 0; k < cnt; ++k) {
                int bc, nc, hc, bn = -1, nn = 0, hn = 0;
                PREP_COORD(k, bc, nc, hc);
                if (k + 1 < cnt) PREP_COORD(k + 1, bn, nn, hn);
                if (hc != hl) { __syncthreads(); gdn::prep_load_taps(lds, args.in[3], hc); hl = hc; __syncthreads(); }
                gdn::prep_item(lds, P, Halo, args.in[4], args.in[5], GWb, GQKb, GLv, pre, bc, nc, hc, bn, nn, hn);
            }
#undef PREP_COORD
        }
    }
    SEAM(2);
    if (IN(3)) {
        for (int item = (int)blockIdx.x; item < BATCH * DN_H; item += G) gdn::scan_item(lds, P, GWb, GQKb, GLv, args.in[6], item >> 3, item & 7);
        __syncthreads();
        unsigned qnext = 0u;
        if (tid == 0) qnext = atomicAdd(qcnt, 1u);
        {
            volatile LAS unsigned* qslot = (volatile LAS unsigned*)(lds + LDS_BYTES - 16);
            nsa::bf16x8 qfr[4] = {}; unsigned short gq[3] = {0, 0, 0}; bool pre = false; int idx = -1;
            for (;;) {
                if (idx < 0) { if (tid == 0) *qslot = qnext; __syncthreads(); idx = (int)*qslot; pre = false; __syncthreads(); }
                if (idx >= 1024) break;
                int idxn = -1;
                nsa::attn_tile(lds, P, KCb, VCb, (idx & 31) >> 2, idx & 3, 31 - (idx >> 5), qcnt, qnext, pre, qfr, gq, idxn);
                idx = idxn; pre = (idxn >= 0 && idxn < 1024);
            }
        }
    }
    SEAM(3);
    if (IN(4)) {
        pg8::Gemm g{Hb, Wg_t, D, D, M, 2048, D, 0}; pg8::GatePairOrder S; S.base.init(M, D, G, (int)blockIdx.x);
        pg8::EpiP<1> E{P, LDP, -1, 256, nullptr};
        pg8::gemm_phase<pg8::EpiP<1>, pg8::GatePairOrder, true>(lds, g, S, E);
    }
    if (IN(4) && IN(5)) { asm volatile("s_waitcnt vmcnt(0)" ::: "memory"); __syncthreads(); }
    if (IN(5)) {
        pg8::Gemm g{P + C_DZ, Wcat_t, LDP, 2 * D, M, D, D, D}; pg8::TwoPassOrder S; S.base.init(M, D, G, (int)blockIdx.x);
        pg8::EpiMix E{P, LDP, Mix, D};
        pg8::gemm_phase<pg8::EpiMix, pg8::TwoPassOrder, false>(lds, g, S, E);
    }
    SEAM(5);
    if (IN(6)) {
        for (int it = gw; it < 64 * 16; it += NGW) transpose_item(args.in[22], D, SrcIdent{0}, Wdown_t, FF, 0, scr, it / 16, it % 16, lane);
        __syncthreads();
        pg8::Gemm g{Mix, Wout_t, D, D, M, D, D, 0}; pg8::StaticOrder S; S.init(M, D, G, (int)blockIdx.x);
        pg8::EpiOut E{x, An, pss};
        pg8::gemm_phase<pg8::EpiOut, pg8::StaticOrder, false>(lds, g, S, E);
    }
    SEAM(6);
    if (IN(7)) {
        pg8::Gemm g{An, Wup_t, D, D, M, FF, D, 0}; pg8::IndexedOrder S; S.base.init(M, FF, G, (int)blockIdx.x);
        LAS float* rtab = (LAS float*)(lds + 131072);
        int nu = 0; { pg8::Unit u_; while (nu < 13 && S.next(nu, u_)) ++nu; }
        const bool use_tab = nu <= 12;
        if (use_tab) for (int i0 = 0; i0 < nu; i0 += 4) {
            f32x4 sa[4], sb[4]; const int r = tid >> 1;
#pragma unroll
            for (int k = 0; k < 4; ++k) { pg8::Unit u_; const bool ok = (i0 + k < nu) && S.next(i0 + k, u_);
                const f32x4* pp = (const f32x4*)(pss + ((size_t)(ok ? u_.pm : 0) * 256 + r) * 16) + 2 * (tid & 1); sa[k] = pp[0]; sb[k] = pp[1]; }
#pragma unroll
            for (int k = 0; k < 4; ++k) { const f32x4 s4 = sa[k] + sb[k];
                float sm = (s4[0] + s4[1]) + (s4[2] + s4[3]); sm += __shfl_xor(sm, 1);
                if ((tid & 1) == 0 && i0 + k < nu) rtab[(i0 + k) * 256 + r] = rsqrtf(sm * (1.f / D) + EPS); } }
        __syncthreads();
        pg8::EpiUp E{pss, Up, FF, use_tab ? (const PG8_LAS float*)rtab : (const PG8_LAS float*)nullptr};
        pg8::gemm_phase<pg8::EpiUp, pg8::IndexedOrder, true>(lds, g, S, E);
    }
    SEAM(7);
    if (IN(8)) {
        pg8::Gemm g{Up, Wdown_t, FF, FF, M, D, FF, 0}; pg8::StaticOrder S; S.init(M, D, G, (int)blockIdx.x);
        pg8::EpiDown E{An, args.out};
        pg8::gemm_phase<pg8::EpiDown, pg8::StaticOrder, false>(lds, g, S, E);
    }
#undef IN
#undef SEAM
#undef GRID_SYNC
}

#undef lane
#undef tid
static int g_grid = 0;
static void launch_mk(const Args& a0, int lo, int hi, hipStream_t stream) {
    Args a = a0; a.ph_lo = lo; a.ph_hi = hi;
    void* kargs[] = {(void*)&a};
    hipError_t e = hipLaunchCooperativeKernel((const void*)mk_fwd, dim3(g_grid), dim3(NWAVES * 64), kargs, LDS_BYTES, stream);
    if (e != hipSuccess) fprintf(stderr, "cooperative launch failed: %s (grid %d)\n", hipGetErrorString(e), g_grid);
}

extern "C" void kernel_launch(void* const* d_in, const int* in_sizes, int n_in, void* d_out, int out_size, void* d_ws, size_t ws_size, hipStream_t stream) {
    if (g_grid == 0) {
        int dev = 0, cus = 0, per_cu = 0;
        hipGetDevice(&dev);
        hipDeviceGetAttribute(&cus, hipDeviceAttributeMultiprocessorCount, dev);
        hipFuncSetAttribute((const void*)mk_fwd, hipFuncAttributeMaxDynamicSharedMemorySize, LDS_BYTES);
        hipOccupancyMaxActiveBlocksPerMultiprocessor(&per_cu, (const void*)mk_fwd, NWAVES * 64, LDS_BYTES);
        if (per_cu < 1) per_cu = 1;
        if (per_cu > 1) per_cu = 1;
        g_grid = cus * per_cu;
    }
    Args a{};
    for (int i = 0; i < 23; ++i) a.in[i] = (const float*)d_in[i];
    a.out = (float*)d_out; a.ws = (unsigned char*)d_ws;
    bf16_t* P = (bf16_t*)((char*)d_ws + WS_P);
    hipMemsetAsync((char*)d_ws + WS_XBAR, 0, 16384 + 1024, stream);
    launch_mk(a, 0, 9, stream);
}
```

```cpp
#include <hip/hip_runtime.h>
#include <hip/hip_cooperative_groups.h>
#include <stdint.h>
#include <cstdio>
namespace cg = cooperative_groups;

typedef unsigned short bf16_t;

constexpr int D = 1024, BATCH = 8, SEQ = 2048, M = BATCH * SEQ;
constexpr int DN_H = 8, DN_D = 128;
constexpr int NS_H = 16, NS_G = 4, NS_R = 4, NS_D = 64;
constexpr int NCMP = 127, NSEL = 32;
constexpr int FF = 4096;
constexpr int INW = 8768;
constexpr float EPS = 1e-6f;
constexpr float NEGV = -1e30f, FORCEV = 1e9f;

constexpr int LDP = 6720;
constexpr int C_DQ = 0, C_DK = 1024, C_DV = 2048, C_DZ = 3072, C_NQ = 4096;
constexpr int C_KC = 5120, C_VC = 5376, C_KS = 5632, C_VS = 5888, C_KW = 6144, C_VW = 6400;
constexpr int C_SB = 6656, C_SA = 6664, C_SG = 6672;
constexpr int NP1 = 6912;

__device__ __forceinline__ float bf2f(bf16_t v) { return __uint_as_float(((unsigned)v) << 16); }
__device__ __forceinline__ bf16_t f2bf(float f) { unsigned u = __float_as_uint(f); return (bf16_t)((u + 0x7fffu + ((u >> 16) & 1u)) >> 16); }
__device__ __forceinline__ float sigmoidf_(float x) { return 1.f / (1.f + __expf(-x)); }
__device__ __forceinline__ float siluf_(float x) { return x * sigmoidf_(x); }
__device__ __forceinline__ float softplusf_(float x) { return fmaxf(x, 0.f) + log1pf(__expf(-fabsf(x))); }
__device__ __forceinline__ float gelu_tanh(float x) { return 0.5f * x * (1.f + tanhf(0.7978845608028654f * (x + 0.044715f * x * x * x))); }

__device__ __forceinline__ float block_sum(float v, float* red) {
    for (int o = 32; o > 0; o >>= 1) v += __shfl_xor(v, o);
    const int w = threadIdx.x >> 6, nw = blockDim.x >> 6;
    __syncthreads();
    if ((threadIdx.x & 63) == 0) red[w] = v;
    __syncthreads();
    float s = 0.f;
    for (int i = 0; i < nw; ++i) s += red[i];
    return s;
}
__device__ __forceinline__ float block_max(float v, float* red) {
    for (int o = 32; o > 0; o >>= 1) v = fmaxf(v, __shfl_xor(v, o));
    const int w = threadIdx.x >> 6, nw = blockDim.x >> 6;
    __syncthreads();
    if ((threadIdx.x & 63) == 0) red[w] = v;
    __syncthreads();
    float s = red[0];
    for (int i = 1; i < nw; ++i) s = fmaxf(s, red[i]);
    return s;
}


namespace gdn {
#define GL3 __attribute__((address_space(3)))
typedef short bf16x8 __attribute__((ext_vector_type(8)));
typedef short s16x4 __attribute__((ext_vector_type(4)));
typedef short v4i16_t __attribute__((ext_vector_type(4)));
typedef float f32x16 __attribute__((ext_vector_type(16)));
typedef float f32x4 __attribute__((ext_vector_type(4)));
typedef float f32x2 __attribute__((ext_vector_type(2)));
typedef unsigned u32x4 __attribute__((ext_vector_type(4)));
typedef unsigned u32x2 __attribute__((ext_vector_type(2)));
typedef __bf16 bf16x2_t __attribute__((ext_vector_type(2)));
constexpr float QSCALE = 0.08838834764831845f;
__device__ __forceinline__ float fsig(float x) { return __builtin_amdgcn_rcpf(1.f + __builtin_amdgcn_exp2f(-1.4426950408889634f * x)); }
__device__ __forceinline__ float fsilu(float x) { return x * fsig(x); }
__device__ __forceinline__ int crow(int i, int hi) { return (i & 3) + 8 * (i >> 2) + 4 * hi; }
__device__ __forceinline__ unsigned pk(float lo, float hi) { f32x2 v = {lo, hi}; bf16x2_t b = __builtin_convertvector(v, bf16x2_t); return __builtin_bit_cast(unsigned, b); }
__device__ __forceinline__ bf16x8 pack8(const float* v) { u32x4 w = {pk(v[0], v[1]), pk(v[2], v[3]), pk(v[4], v[5]), pk(v[6], v[7])}; return __builtin_bit_cast(bf16x8, w); }
__device__ __forceinline__ float dot2bf(float acc, unsigned xw, unsigned ww) { return __builtin_amdgcn_fdot2_f32_bf16(__builtin_bit_cast(bf16x2_t, xw), __builtin_bit_cast(bf16x2_t, ww), acc, false); }
__device__ __forceinline__ float blo(unsigned w) { return __uint_as_float(w << 16); }
__device__ __forceinline__ float bhi(unsigned w) { return __uint_as_float(w & 0xffff0000u); }
__device__ __forceinline__ char* seg_addr(bf16_t* P, size_t row0, int c0, unsigned e) { return (char*)P + ((row0 + (e >> 8)) * LDP + c0) * 2 + (e & 255u); }

__device__ __forceinline__ s16x4 vtr(GL3 const unsigned char* p) { return __builtin_bit_cast(s16x4, __builtin_amdgcn_ds_read_tr16_b64_v4i16((GL3 v4i16_t*)p)); }

constexpr int PL_K = 0, PL_KB = 16384, PL_Q = 32768, PL_RV = 49152, PL_AM = 81920, PL_INV = 99328, PL_MT = 116736, PL_GC = 120832, PL_QKST = 121088, PL_TI = 129280, PL_CW = 137472, PL_END = 143616;
constexpr int PL_WST = 0, PL_UST = 16384;
constexpr int AMLD = 68;
struct RowPre { u32x4 x[3][5]; unsigned short lb, la; };
__device__ __forceinline__ void prep_prefetch(RowPre& pre, const bf16_t* P, const bf16_t* HALO, int b, int n, int h, int wid, int lane) {
    const size_t row0 = (size_t)b * SEQ + 64 * n; const int dc = lane & 15;
    const bf16_t* prow = P + (row0 + lane) * LDP;
    pre.lb = prow[C_SB + h]; pre.la = prow[C_SA + h];
    const int col = h * 128 + dc * 8;
    const int r0 = 2 * (4 * wid + (lane >> 4)) - 3;
    if (wid == 0) {
        const bf16_t* src[5];
#pragma unroll
        for (int k = 0; k < 5; ++k) {
            const int rr = r0 + k; const bool inb = rr >= 0;
            src[k] = inb ? (P + (row0 + (inb ? rr : 0)) * LDP + col) : (HALO + ((size_t)((b * 32 + (n > 0 ? n - 1 : 0)) * 3 + (inb ? 0 : 3 + rr))) * 3072 + col);
            asm volatile("" : "+v"(src[k]));
        }
#pragma unroll
        for (int k = 0; k < 5; ++k)
#pragma unroll
            for (int which = 0; which < 3; ++which) pre.x[which][k] = *(const __attribute__((address_space(1))) u32x4*)(src[k] + which * 1024);
    } else {
        const bf16_t* base = P + (row0 + r0) * LDP + col;
#pragma unroll
        for (int k = 0; k < 5; ++k) { const bf16_t* rp = base + (size_t)k * LDP;
#pragma unroll
            for (int which = 0; which < 3; ++which) pre.x[which][k] = *(const u32x4*)(rp + which * 1024); }
    }
}
__device__ __forceinline__ void prep_load_taps(GL3 unsigned char* lds, const float* convw, int h) {
    GL3 unsigned* cw = (GL3 unsigned*)(lds + 137472);
    for (int e = threadIdx.x; e < 1536; e += 512) { const int which = e >> 9, j = (e >> 7) & 3, c = e & 127; const unsigned wb = f2bf(convw[j * 3072 + which * 1024 + h * 128 + c]); cw[e] = (c & 1) ? (wb << 16) : wb; }
}
#define PBAR() do { asm volatile("s_waitcnt lgkmcnt(0)" ::: "memory"); __builtin_amdgcn_s_barrier(); asm volatile("" ::: "memory"); } while (0)
__device__ __forceinline__ void prep_item(GL3 unsigned char* lds, bf16_t* P, const bf16_t* HALO, const float* a_log, const float* dt_bias,
                                          bf16_t* GW, bf16_t* GQK, float* GLv, RowPre& pre, int b, int n, int h, int nb_, int nn_, int nh_) {
    int tid = threadIdx.x; asm volatile("" : "+v"(tid));
    const int lane = tid & 63, r32 = lane & 31, hi = lane >> 5; const int wid = __builtin_amdgcn_readfirstlane(tid >> 6);
    const size_t row0 = (size_t)b * SEQ + 64 * n; const int item = (b * DN_H + h) * 32 + n;
    GL3 float* AM = (GL3 float*)(lds + PL_AM); GL3 float* INV = (GL3 float*)(lds + PL_INV); GL3 float* MT = (GL3 float*)(lds + PL_MT); GL3 float* GC = (GL3 float*)(lds + PL_GC);
    float gcum, beta_l, gc_last;
    {
        beta_l = fsig(bf2f(pre.lb));
        { const float xs = bf2f(pre.la) + dt_bias[h]; gcum = -__expf(a_log[h]) * (fmaxf(xs, 0.f) + __logf(1.f + __expf(-fabsf(xs)))); }
#define DPPSCAN(ctl_) gcum += __builtin_bit_cast(float, __builtin_amdgcn_update_dpp(0, __builtin_bit_cast(int, gcum), ctl_, 0xF, 0xF, true))
        DPPSCAN(0x111); DPPSCAN(0x112); DPPSCAN(0x114); DPPSCAN(0x118);
#undef DPPSCAN
        gcum += __builtin_bit_cast(float, __builtin_amdgcn_update_dpp(0, __builtin_bit_cast(int, gcum), 0x142, 0xA, 0xF, false));
        gcum += __builtin_bit_cast(float, __builtin_amdgcn_update_dpp(0, __builtin_bit_cast(int, gcum), 0x143, 0xC, 0xF, false));
        gc_last = __builtin_bit_cast(float, __builtin_amdgcn_readlane(__builtin_bit_cast(int, gcum), 63));
        if (wid == 0) GC[lane] = gcum;
    }
    if (n == 0 && wid == 0) {
        asm volatile("" ::: "memory");
        const int r0 = 2 * (lane >> 4) - 3;
#pragma unroll
        for (int which = 0; which < 3; ++which)
#pragma unroll
            for (int k = 0; k < 3; ++k) if (r0 + k < 0) pre.x[which][k] = (u32x4){0u, 0u, 0u, 0u};
    }
    bf16x8 qd_keep[2], ke_keep[2];
    const int dc = lane & 15;
#pragma unroll
    for (int pass = 0; pass < 2; ++pass) {
        const int tok = 2 * (4 * wid + (lane >> 4)) + pass;
        const float gct = __shfl(gcum, tok), bet = __shfl(beta_l, tok);
        float y[3][8];
#pragma unroll
        for (int which = 0; which < 3; ++which) {
#pragma unroll
            for (int e = 0; e < 8; ++e) y[which][e] = 0.f;
#pragma unroll
            for (int j = 0; j < 4; ++j) {
                const int rr = tok - 3 + j;
                u32x4 x = pre.x[which][j + pass];
                const u32x4 w0 = *(GL3 const u32x4*)(lds + PL_CW + ((which * 4 + j) * 128 + dc * 8) * 4), w1 = *(GL3 const u32x4*)(lds + PL_CW + ((which * 4 + j) * 128 + dc * 8 + 4) * 4);
#define DOT2(acc_, xw_, ww_) acc_ = dot2bf(acc_, xw_, ww_)
                DOT2(y[which][0], x.x, w0[0]); DOT2(y[which][1], x.x, w0[1]); DOT2(y[which][2], x.y, w0[2]); DOT2(y[which][3], x.y, w0[3]);
                DOT2(y[which][4], x.z, w1[0]); DOT2(y[which][5], x.z, w1[1]); DOT2(y[which][6], x.w, w1[2]); DOT2(y[which][7], x.w, w1[3]);
#undef DOT2
            }
#pragma unroll
            for (int e = 0; e < 8; ++e) y[which][e] = fsilu(y[which][e]);
        }
        float sq = 0.f, sk = 0.f;
#pragma unroll
        for (int e = 0; e < 8; ++e) { sq += y[0][e] * y[0][e]; sk += y[1][e] * y[1][e]; }
#pragma unroll
        for (int o = 0; o < 1; ++o) {
#define DPPSUM(v_, ctl_) v_ += __builtin_bit_cast(float, __builtin_amdgcn_mov_dpp(__builtin_bit_cast(int, v_), ctl_, 0xF, 0xF, true))
            DPPSUM(sq, 0xB1); DPPSUM(sk, 0xB1); DPPSUM(sq, 0x4E); DPPSUM(sk, 0x4E); DPPSUM(sq, 0x141); DPPSUM(sk, 0x141); DPPSUM(sq, 0x140); DPPSUM(sk, 0x140);
#undef DPPSUM
        }
        const float rq = rsqrtf(sq + EPS), rk = rsqrtf(sk + EPS);
        const float eg = __expf(gct), ke_s = __expf(gc_last - gct);
        float q8[8], k8[8], kb8[8], qd8[8], ke8[8], kbg8[8], vb8[8];
#pragma unroll
        for (int e = 0; e < 8; ++e) { q8[e] = y[0][e] * rq; k8[e] = y[1][e] * rk; kb8[e] = k8[e] * bet; qd8[e] = q8[e] * (QSCALE * eg); ke8[e] = k8[e] * ke_s; kbg8[e] = kb8[e] * eg; vb8[e] = y[2][e] * bet; }
        const int io = (dc * 64 + tok) * 16;
        *(GL3 bf16x8*)(lds + PL_Q + io) = pack8(q8); *(GL3 bf16x8*)(lds + PL_K + io) = pack8(k8); *(GL3 bf16x8*)(lds + PL_KB + io) = pack8(kb8);
        {
            const int rvo = (tok >> 4) * 1024 + ((tok >> 3) & 1) * 512 + (tok & 7) * 64 + (dc & 3) * 16;
            *(GL3 bf16x8*)(lds + PL_RV + (dc >> 2) * 4096 + rvo) = pack8(kbg8); *(GL3 bf16x8*)(lds + PL_RV + (4 + (dc >> 2)) * 4096 + rvo) = pack8(vb8);
        }
        qd_keep[pass] = pack8(qd8); ke_keep[pass] = pack8(ke8);
    }
    PBAR();
    if (nb_ >= 0) prep_prefetch(pre, P, HALO, nb_, nn_, nh_, wid, lane);
#pragma unroll
    for (int pass = 0; pass < 2; ++pass) {
        const int tok = 2 * (4 * wid + (lane >> 4)) + pass;
        *(bf16x8*)seg_addr(P, row0, C_DQ + h * 128, (unsigned)((dc * 64 + tok) * 16)) = qd_keep[pass];
        const unsigned ek = (unsigned)(((dc >> 2) * 4 + (tok >> 4)) * 1024 + ((tok >> 3) & 1) * 512 + (tok & 7) * 64 + (dc & 3) * 16);
        *(bf16x8*)seg_addr(P, row0, C_DK + h * 128, ek) = ke_keep[pass];
    }
    if (wid < 6) {
        const bool isA = wid < 3; const int t3 = isA ? wid : wid - 3;
        const int rt = isA ? (t3 > 0) : (t3 == 2);
        const int ct = isA ? (t3 == 2) : (t3 > 0);
        GL3 const unsigned char* aimg = lds + (isA ? PL_KB : PL_K); GL3 const unsigned char* bimg = lds + (isA ? PL_K : PL_Q);
        f32x16 acc = f32x16{};
#pragma unroll
        for (int s = 0; s < 8; ++s) {
            const bf16x8 a = *(GL3 const bf16x8*)(aimg + ((2 * s + hi) * 64 + 32 * rt + r32) * 16);
            const bf16x8 bb = *(GL3 const bf16x8*)(bimg + ((2 * s + hi) * 64 + 32 * ct + r32) * 16);
            acc = __builtin_amdgcn_mfma_f32_32x32x16_bf16(a, bb, acc, 0, 0, 0);
        }
        if (isA) {
            const int j = 32 * ct + r32; const float gj = GC[j];
#pragma unroll
            for (int i_ = 0; i_ < 16; ++i_) { const int i = 32 * rt + crow(i_, hi); float v = acc[i_] * __expf(fminf(GC[i] - gj, 0.f)); asm volatile("" : "+v"(v)); AM[i * AMLD + j] = (j < i) ? v : 0.f; }
        } else {
            const int i = 32 * ct + r32; const float gi = GC[i];
            float v[16];
#pragma unroll
            for (int i_ = 0; i_ < 16; ++i_) { const int j = 32 * rt + crow(i_, hi); float t = acc[i_] * (QSCALE * __expf(fminf(gi - GC[j], 0.f))); asm volatile("" : "+v"(t)); v[i_] = (j <= i) ? t : 0.f; }
#pragma unroll
            for (int sp = 0; sp < 2; ++sp) *(GL3 bf16x8*)(lds + PL_QKST + (((2 * rt + sp) * 64 + i) * 16 + 8 * hi) * 2) = pack8(v + 8 * sp);
        }
    } else if (wid == 6) {
        const bf16x8 z = {0, 0, 0, 0, 0, 0, 0, 0};
#pragma unroll
        for (int sp = 0; sp < 2; ++sp) *(GL3 bf16x8*)(lds + PL_QKST + (((2 + sp) * 64 + r32) * 16 + 8 * hi) * 2) = z;
    }
    PBAR();
    if (wid < 4 && lane < 16) {
        const int bb = wid, c = lane;
        float x[16];
#pragma unroll
        for (int i = 0; i < 16; ++i) {
            float acc = (i == c) ? 1.f : 0.f;
#pragma unroll
            for (int j4 = 0; j4 < i; j4 += 4) { const f32x4 a = *(GL3 const f32x4*)(AM + (16 * bb + i) * AMLD + 16 * bb + j4);
                acc -= a[0] * x[j4]; if (j4 + 1 < i) acc -= a[1] * x[j4 + 1]; if (j4 + 2 < i) acc -= a[2] * x[j4 + 2]; if (j4 + 3 < i) acc -= a[3] * x[j4 + 3]; }
            x[i] = acc;
        }
#pragma unroll
        for (int i = 0; i < 16; ++i) INV[(16 * bb + i) * AMLD + 16 * bb + c] = x[i];
    }
    PBAR();
    for (int L = 1; L < 4; ++L) {
        const int nb = 4 - L;
        for (int t = tid; t < nb * 256; t += 512) {
            const int J = t >> 8, I = J + L, ei = (t >> 4) & 15, ej = t & 15;
            float acc = 0.f;
            for (int K = J; K < I; ++K) {
#pragma unroll
                for (int k4 = 0; k4 < 16; k4 += 4) { const f32x4 a = *(GL3 const f32x4*)(AM + (16 * I + ei) * AMLD + 16 * K + k4);
                    acc += a[0] * INV[(16 * K + k4) * AMLD + 16 * J + ej] + a[1] * INV[(16 * K + k4 + 1) * AMLD + 16 * J + ej] + a[2] * INV[(16 * K + k4 + 2) * AMLD + 16 * J + ej] + a[3] * INV[(16 * K + k4 + 3) * AMLD + 16 * J + ej]; }
            }
            MT[(J * 16 + ei) * 17 + ej] = acc;
        }
        PBAR();
        for (int t = tid; t < nb * 256; t += 512) {
            const int J = t >> 8, I = J + L, ei = (t >> 4) & 15, ej = t & 15;
            float acc = 0.f;
#pragma unroll
            for (int k4 = 0; k4 < 16; k4 += 4) { const f32x4 d = *(GL3 const f32x4*)(INV + (16 * I + ei) * AMLD + 16 * I + k4);
                acc += d[0] * MT[(J * 16 + k4) * 17 + ej] + d[1] * MT[(J * 16 + k4 + 1) * 17 + ej] + d[2] * MT[(J * 16 + k4 + 2) * 17 + ej] + d[3] * MT[(J * 16 + k4 + 3) * 17 + ej]; }
            INV[(16 * I + ei) * AMLD + 16 * J + ej] = -acc;
        }
        PBAR();
    }
    {
        const int s_ = tid >> 7, i = (tid >> 1) & 63, hh = tid & 1;
        float v[8];
        if (s_ > (i >> 4)) {
#pragma unroll
            for (int e = 0; e < 8; ++e) v[e] = 0.f;
        } else {
            const f32x4 a = *(GL3 const f32x4*)(INV + i * AMLD + 16 * s_ + 4 * hh), c4 = *(GL3 const f32x4*)(INV + i * AMLD + 16 * s_ + 8 + 4 * hh);
            v[0] = a[0]; v[1] = a[1]; v[2] = a[2]; v[3] = a[3]; v[4] = c4[0]; v[5] = c4[1]; v[6] = c4[2]; v[7] = c4[3];
        }
        *(GL3 bf16x8*)(lds + PL_TI + ((s_ * 64 + i) * 16 + 8 * hh) * 2) = pack8(v);
    }
    PBAR();
    {
        const int cb = wid;
        GL3 const unsigned char* rp = lds + PL_RV + cb * 4096 + ((lane >> 4) & 1) * 32 + (lane & 3) * 8 + (4 * hi + ((lane & 15) >> 2)) * 64;
        f32x16 d0 = f32x16{}, d1 = f32x16{};
#pragma unroll
        for (int ks = 0; ks < 4; ++ks) {
            const s16x4 lo = vtr(rp + ks * 1024), hh2 = vtr(rp + ks * 1024 + 512);
            const bf16x8 rf = {lo[0], lo[1], lo[2], lo[3], hh2[0], hh2[1], hh2[2], hh2[3]};
            const bf16x8 t1 = *(GL3 const bf16x8*)(lds + PL_TI + ((ks * 64 + 32 + r32) * 16 + 8 * hi) * 2);
            if (cb < 4) {
                if (ks < 2) { const bf16x8 t0 = *(GL3 const bf16x8*)(lds + PL_TI + ((ks * 64 + r32) * 16 + 8 * hi) * 2); d0 = __builtin_amdgcn_mfma_f32_32x32x16_bf16(rf, t0, d0, 0, 0, 0); }
                d1 = __builtin_amdgcn_mfma_f32_32x32x16_bf16(rf, t1, d1, 0, 0, 0);
            } else {
                if (ks < 2) { const bf16x8 t0 = *(GL3 const bf16x8*)(lds + PL_TI + ((ks * 64 + r32) * 16 + 8 * hi) * 2); d0 = __builtin_amdgcn_mfma_f32_32x32x16_bf16(t0, rf, d0, 0, 0, 0); }
                d1 = __builtin_amdgcn_mfma_f32_32x32x16_bf16(t1, rf, d1, 0, 0, 0);
            }
        }
        PBAR();
        if (cb < 4) {
#pragma unroll
            for (int a = 0; a < 4; ++a) {
                u32x2 w0 = {pk(d0[4 * a], d0[4 * a + 1]), pk(d0[4 * a + 2], d0[4 * a + 3])}, w1 = {pk(d1[4 * a], d1[4 * a + 1]), pk(d1[4 * a + 2], d1[4 * a + 3])};
                *(GL3 u32x2*)(lds + PL_WST + ((4 * cb + a) * 64 + r32) * 16 + 8 * hi) = w0;
                *(GL3 u32x2*)(lds + PL_WST + ((4 * cb + a) * 64 + 32 + r32) * 16 + 8 * hi) = w1;
            }
        } else {
            float t0_[16], t1_[16];
#pragma unroll
            for (int i = 0; i < 16; ++i) { t0_[i] = d0[i]; t1_[i] = d1[i]; }
#pragma unroll
            for (int sp = 0; sp < 2; ++sp) {
                *(GL3 bf16x8*)(lds + PL_UST + (((0 * 4 + (cb - 4)) * 2 + sp) * 64 + lane) * 16) = pack8(t0_ + 8 * sp);
                *(GL3 bf16x8*)(lds + PL_UST + (((1 * 4 + (cb - 4)) * 2 + sp) * 64 + lane) * 16) = pack8(t1_ + 8 * sp); }
        }
    }
    PBAR();
#pragma unroll
    for (int k = 0; k < 2; ++k) {
        const int e = (tid + 512 * k) * 16;
        *(u32x4*)((char*)(GW + (size_t)item * 8192) + e) = *(GL3 const u32x4*)(lds + PL_WST + e);
        *(u32x4*)seg_addr(P, row0, C_DV + h * 128, (unsigned)e) = *(GL3 const u32x4*)(lds + PL_UST + e);
    }
    *(u32x4*)((char*)(GQK + (size_t)item * 4096) + tid * 16) = *(GL3 const u32x4*)(lds + PL_QKST + tid * 16);
    if (tid == 0) GLv[item] = __expf(gc_last);
    PBAR();
}

#undef PBAR
constexpr int SL_W = 0, SL_QD = 16384, SL_KE = 32768, SL_QK = 49152, SL_U = 57344, SL_Z = 73728, SL_S = 90112, SL_VN = 122880, SL_RS = 139264, SL_END = 140416;
__device__ __forceinline__ void glds16(const void* gsrc, unsigned lds_dst) { unsigned keep;
    asm volatile("s_mov_b32 %0, m0\n\ts_mov_b32 m0, %2\n\ts_nop 0\n\tglobal_load_lds_dwordx4 %1, off\n\ts_mov_b32 m0, %0" : "=&s"(keep) : "v"(gsrc), "s"(lds_dst) : "memory"); }
__device__ __forceinline__ unsigned lds_addr(GL3 unsigned char* p) { return (unsigned)(size_t)p; }
__device__ __forceinline__ void dma_seg(GL3 unsigned char* dst, const bf16_t* P, size_t row0, int c0, int wid, int lane) {
#pragma unroll
    for (int k = 0; k < 2; ++k) { const int piece = wid + 8 * k;
        const char* src = (const char*)P + ((row0 + piece * 4 + (lane >> 4)) * LDP + c0) * 2 + (lane & 15) * 16;
        glds16(src, (unsigned)__builtin_amdgcn_readfirstlane((int)(lds_addr(dst) + piece * 1024))); }
}
__device__ __forceinline__ void dma_seg_swz(GL3 unsigned char* dst, const bf16_t* P, size_t row0, int c0, int wid, int lane) {
#pragma unroll
    for (int k = 0; k < 2; ++k) { const int piece = wid + 8 * k; const int r = piece * 4 + (lane >> 4);
        const char* src = (const char*)P + ((row0 + r) * LDP + c0) * 2 + ((lane ^ r) & 15) * 16;
        glds16(src, (unsigned)__builtin_amdgcn_readfirstlane((int)(lds_addr(dst) + piece * 1024))); }
}
template <int NPIECES>
__device__ __forceinline__ void dma_lin(GL3 unsigned char* dst, const bf16_t* src, int wid, int lane) {
#pragma unroll
    for (int k = 0; k < NPIECES / 8; ++k) { const int piece = wid + 8 * k;
        glds16((const char*)src + piece * 1024 + lane * 16, (unsigned)__builtin_amdgcn_readfirstlane((int)(lds_addr(dst) + piece * 1024))); }
}

__device__ __forceinline__ float sum32(float v) {
    v += __builtin_bit_cast(float, __builtin_amdgcn_mov_dpp(__builtin_bit_cast(int, v), 0xB1, 0xF, 0xF, true));
    v += __builtin_bit_cast(float, __builtin_amdgcn_mov_dpp(__builtin_bit_cast(int, v), 0x4E, 0xF, 0xF, true));
    v += __builtin_bit_cast(float, __builtin_amdgcn_mov_dpp(__builtin_bit_cast(int, v), 0x141, 0xF, 0xF, true));
    v += __builtin_bit_cast(float, __builtin_amdgcn_mov_dpp(__builtin_bit_cast(int, v), 0x140, 0xF, 0xF, true));
    v += __shfl_xor(v, 16);
    return v;
}
#define GRAWBAR() do { asm volatile("s_waitcnt lgkmcnt(0)" ::: "memory"); __builtin_amdgcn_s_barrier(); asm volatile("" ::: "memory"); } while (0)
#define GWAITV0() asm volatile("s_waitcnt vmcnt(0)" ::: "memory")
constexpr int SL_GL = SL_RS + 1024;
__device__ __forceinline__ void scan_item(GL3 unsigned char* lds, bf16_t* P, const bf16_t* GW, const bf16_t* GQK, const float* GLv, const float* out_norm, int b, int h) {
    int tid = threadIdx.x; asm volatile("" : "+v"(tid));
    const int lane = tid & 63, r32 = lane & 31, hi = lane >> 5; const int wid = __builtin_amdgcn_readfirstlane(tid >> 6);
    const int mt = wid >> 2, nt = wid & 3;
    const int dv = 32 * nt + r32;
    const int item0 = (b * DN_H + h) * 32; const size_t rowb = (size_t)b * SEQ;
    f32x16 S0 = f32x16{}, S1 = f32x16{};
    {
        const u32x4 z = {0u, 0u, 0u, 0u};
#pragma unroll
        for (int k = 0; k < 4; ++k) *(GL3 u32x4*)(lds + SL_S + (tid + 512 * k) * 16) = z;
        if (tid < 32) *(GL3 float*)(lds + SL_GL + tid * 4) = GLv[item0 + tid];
    }
    float gn[16];
#pragma unroll
    for (int i = 0; i < 16; ++i) gn[i] = out_norm[32 * nt + crow(i, hi)];
    GL3 float* RS = (GL3 float*)(lds + SL_RS);
#define ISSUE_A(n_) do { dma_lin<16>(lds + SL_W, GW + (size_t)(item0 + (n_)) * 8192, wid, lane); dma_seg(lds + SL_QD, P, rowb + 64 * (n_), C_DQ + h * 128, wid, lane); dma_seg(lds + SL_U, P, rowb + 64 * (n_), C_DV + h * 128, wid, lane); } while (0)
#define ISSUE_B(n_) do { dma_seg(lds + SL_KE, P, rowb + 64 * (n_), C_DK + h * 128, wid, lane); dma_lin<8>(lds + SL_QK, GQK + (size_t)(item0 + (n_)) * 4096, wid, lane); dma_seg_swz(lds + SL_Z, P, rowb + 64 * (n_), C_DZ + h * 128, wid, lane); } while (0)
    GWAITV0();
    ISSUE_A(0);
    f32x16 oprev = f32x16{}; unsigned zprev[8] = {0u, 0u, 0u, 0u, 0u, 0u, 0u, 0u};
#define Y_OUT(n_) do { \
        const f32x4 rs = *(GL3 const f32x4*)(RS + (32 * mt + r32) * 4); \
        const float rstd = rsqrtf(((rs[0] + rs[1]) + (rs[2] + rs[3])) * (1.f / 128.f) + EPS); \
        bf16_t* yp = P + (rowb + 64 * (n_) + 32 * mt + r32) * LDP + C_DZ + h * 128 + 32 * nt + 4 * hi; \
        _Pragma("unroll") for (int a = 0; a < 4; ++a) { float y[4]; \
            _Pragma("unroll") for (int e = 0; e < 4; ++e) { const int i = 4 * a + e; const float z = (i & 1) ? bhi(zprev[i >> 1]) : blo(zprev[i >> 1]); y[e] = oprev[i] * rstd * gn[i] * fsilu(z); } \
            const u32x2 w = {pk(y[0], y[1]), pk(y[2], y[3])}; const bf16_t* ya = yp + 8 * a; \
            asm volatile("global_store_dwordx2 %0, %1, off" :: "v"(ya), "v"(w) : "memory"); } } while (0)
    for (int n = 0; n < 32; ++n) {
        GWAITV0(); GRAWBAR();
        ISSUE_B(n);
        const float gl = *(GL3 const float*)(lds + SL_GL + n * 4);
        f32x16 vp = f32x16{}, o = f32x16{};
#pragma unroll
        for (int s = 0; s < 8; ++s) {
            const bf16x8 sb = *(GL3 const bf16x8*)(lds + SL_S + ((2 * s + hi) * 128 + dv) * 16);
            const bf16x8 wa = *(GL3 const bf16x8*)(lds + SL_W + ((2 * s + hi) * 64 + 32 * mt + r32) * 16);
            const bf16x8 qa = *(GL3 const bf16x8*)(lds + SL_QD + ((2 * s + hi) * 64 + 32 * mt + r32) * 16);
            vp = __builtin_amdgcn_mfma_f32_32x32x16_bf16(wa, sb, vp, 0, 0, 0);
            o = __builtin_amdgcn_mfma_f32_32x32x16_bf16(sb, qa, o, 0, 0, 0);
        }
        if (n > 0) Y_OUT(n - 1);
        {
            float v[16];
            const u32x4 ua = *(GL3 const u32x4*)(lds + SL_U + (((mt * 4 + nt) * 2 + 0) * 64 + lane) * 16), ub = *(GL3 const u32x4*)(lds + SL_U + (((mt * 4 + nt) * 2 + 1) * 64 + lane) * 16);
#pragma unroll
            for (int q = 0; q < 4; ++q) { v[2 * q] = blo(ua[q]) - vp[2 * q]; v[2 * q + 1] = bhi(ua[q]) - vp[2 * q + 1]; v[8 + 2 * q] = blo(ub[q]) - vp[8 + 2 * q]; v[8 + 2 * q + 1] = bhi(ub[q]) - vp[8 + 2 * q + 1]; }
#pragma unroll
            for (int sp = 0; sp < 2; ++sp) *(GL3 bf16x8*)(lds + SL_VN + (((2 * mt + sp) * 128 + dv) * 16 + 8 * hi) * 2) = pack8(v + 8 * sp);
        }
        if (n > 0) asm volatile("s_waitcnt vmcnt(4)" ::: "memory"); else GWAITV0();
        GRAWBAR();
        if (n + 1 < 32) ISSUE_A(n + 1);
#pragma unroll
        for (int a = 0; a < 4; ++a) { const int r = 32 * mt + r32; const u32x2 zz = *(GL3 const u32x2*)(lds + SL_Z + r * 256 + (((4 * nt + a) ^ (r & 15)) * 16) + 8 * hi); zprev[2 * a] = zz[0]; zprev[2 * a + 1] = zz[1]; }
#pragma unroll
        for (int i = 0; i < 16; ++i) { S0[i] *= gl; S1[i] *= gl; }
        {
            GL3 const unsigned char* kp0 = lds + SL_KE + (2 * mt) * 4096 + ((lane >> 4) & 1) * 32 + (lane & 3) * 8 + (4 * hi + ((lane & 15) >> 2)) * 64;
#pragma unroll
            for (int ks = 0; ks < 4; ++ks) {
                const bf16x8 vb = *(GL3 const bf16x8*)(lds + SL_VN + ((ks * 128 + dv) * 16 + 8 * hi) * 2);
                const s16x4 l0 = vtr(kp0 + ks * 1024), h0 = vtr(kp0 + ks * 1024 + 512), l1 = vtr(kp0 + 4096 + ks * 1024), h1 = vtr(kp0 + 4096 + ks * 1024 + 512);
                const bf16x8 k0 = {l0[0], l0[1], l0[2], l0[3], h0[0], h0[1], h0[2], h0[3]}, k1 = {l1[0], l1[1], l1[2], l1[3], h1[0], h1[1], h1[2], h1[3]};
                const bf16x8 qa = *(GL3 const bf16x8*)(lds + SL_QK + ((ks * 64 + 32 * mt + r32) * 16 + 8 * hi) * 2);
                S0 = __builtin_amdgcn_mfma_f32_32x32x16_bf16(k0, vb, S0, 0, 0, 0);
                S1 = __builtin_amdgcn_mfma_f32_32x32x16_bf16(k1, vb, S1, 0, 0, 0);
                o = __builtin_amdgcn_mfma_f32_32x32x16_bf16(vb, qa, o, 0, 0, 0);
            }
        }
#pragma unroll
        for (int a = 0; a < 4; ++a) {
            u32x2 w0 = {pk(S0[4 * a], S0[4 * a + 1]), pk(S0[4 * a + 2], S0[4 * a + 3])}, w1 = {pk(S1[4 * a], S1[4 * a + 1]), pk(S1[4 * a + 2], S1[4 * a + 3])};
            *(GL3 u32x2*)(lds + SL_S + ((4 * (2 * mt) + a) * 128 + dv) * 16 + 8 * hi) = w0;
            *(GL3 u32x2*)(lds + SL_S + ((4 * (2 * mt + 1) + a) * 128 + dv) * 16 + 8 * hi) = w1;
        }
        {   float q = 0.f;
#pragma unroll
            for (int i = 0; i < 16; ++i) q += o[i] * o[i];
            const auto p2 = __builtin_amdgcn_permlane32_swap(__float_as_uint(q), __float_as_uint(q), false, false); q = __uint_as_float(p2[0]) + __uint_as_float(p2[1]);
            if (hi == 0) RS[(32 * mt + r32) * 4 + nt] = q; }
        oprev = o;
    }
    GWAITV0(); GRAWBAR();
    Y_OUT(31);
    GWAITV0();
    __syncthreads();
#undef Y_OUT
#undef ISSUE_A
#undef ISSUE_B
}
}
namespace nsa {
#define NLAS __attribute__((address_space(3)))
typedef short bf16x8 __attribute__((ext_vector_type(8)));
typedef short s16x4 __attribute__((ext_vector_type(4)));
typedef short v4i16_t __attribute__((ext_vector_type(4)));
typedef float f32x16 __attribute__((ext_vector_type(16)));
typedef float f32x4 __attribute__((ext_vector_type(4)));
typedef float f32x2 __attribute__((ext_vector_type(2)));
typedef unsigned u32x4 __attribute__((ext_vector_type(4)));
typedef __bf16 bf16x2_t __attribute__((ext_vector_type(2)));
constexpr float LOG2E = 1.4426950408889634f;
constexpr float NEG = -1e30f;
constexpr int L_KV = 0;
constexpr int L_IMP = 49152;
constexpr int L_SEL = 82944;
constexpr int L_WS = 83456;
constexpr int L_OST = 85504;
constexpr int L_PRE = 118272;
constexpr int L_END = 151040;

__device__ __forceinline__ int crow(int i, int hi) { return (i & 3) + 8 * (i >> 2) + 4 * hi; }
__device__ __forceinline__ unsigned pk(float lo, float hi) { f32x2 v = {lo, hi}; bf16x2_t b = __builtin_convertvector(v, bf16x2_t); return __builtin_bit_cast(unsigned, b); }
__device__ __forceinline__ float xhalf_max(float v) { auto rr = __builtin_amdgcn_permlane32_swap(__float_as_uint(v), __float_as_uint(v), false, false); return fmaxf(__uint_as_float(rr[0]), __uint_as_float(rr[1])); }
__device__ __forceinline__ float xhalf_sum(float v) { auto rr = __builtin_amdgcn_permlane32_swap(__float_as_uint(v), __float_as_uint(v), false, false); return __uint_as_float(rr[0]) + __uint_as_float(rr[1]); }

__device__ __forceinline__ void dma_tile(NLAS unsigned char* slot, const bf16_t* Kb, const bf16_t* Vb, unsigned koff, unsigned voff, int wid) {
    __builtin_amdgcn_global_load_lds((const unsigned*)((const char*)Kb + koff), (NLAS unsigned*)(slot + wid * 1024), 16, 0, 0);
    __builtin_amdgcn_global_load_lds((const unsigned*)((const char*)Vb + voff), (NLAS unsigned*)(slot + 8192 + wid * 1024), 16, 0, 0);
}
__device__ __forceinline__ void glds16(const void* gsrc, unsigned lds_dst) { unsigned keep;
    asm volatile("s_mov_b32 %0, m0\n\ts_mov_b32 m0, %2\n\ts_nop 0\n\tglobal_load_lds_dwordx4 %1, off\n\ts_mov_b32 m0, %0" : "=&s"(keep) : "v"(gsrc), "s"(lds_dst) : "memory"); }
__device__ __forceinline__ void dma_tile_a(NLAS unsigned char* slot, const bf16_t* Kb, const bf16_t* Vb, unsigned koff, unsigned voff, int wid) {
    const unsigned base = (unsigned)(size_t)slot + (unsigned)wid * 1024u;
    glds16((const char*)Kb + koff, (unsigned)__builtin_amdgcn_readfirstlane((int)base));
    glds16((const char*)Vb + voff, (unsigned)__builtin_amdgcn_readfirstlane((int)(base + 8192u)));
}
#define RING_WAIT_BAR(N) do { asm volatile("s_waitcnt vmcnt(" #N ") lgkmcnt(0)" ::: "memory"); __builtin_amdgcn_s_barrier(); asm volatile("" ::: "memory"); } while (0)
__device__ __forceinline__ void tile_offs(unsigned& koff, unsigned& voff, int pitch, int wid, int lane) {
    koff = (unsigned)(lane * pitch + wid * 8) * 2u;
    voff = (unsigned)((16 * (wid & 3) + (lane >> 2)) * pitch + (wid >> 2) * 32 + (lane & 3) * 8) * 2u;
}
__device__ __forceinline__ void qkt(f32x16& p0, f32x16& p1, NLAS const unsigned char* Kslot, const bf16x8* qr, const f32x16& c0, const f32x16& c1, int r32, int hi) {
    NLAS const unsigned char* kb = Kslot + hi * 1024 + r32 * 16;
    __builtin_amdgcn_s_setprio(1);
#pragma unroll
    for (int d0 = 0; d0 < 4; ++d0) {
        const bf16x8 b0 = *(NLAS const bf16x8*)(kb + d0 * 2048);
        const bf16x8 b1 = *(NLAS const bf16x8*)(kb + d0 * 2048 + 512);
        if (d0 == 0) { p0 = __builtin_amdgcn_mfma_f32_32x32x16_bf16(b0, qr[0], c0, 0, 0, 0); p1 = __builtin_amdgcn_mfma_f32_32x32x16_bf16(b1, qr[0], c1, 0, 0, 0); }
        else { p0 = __builtin_amdgcn_mfma_f32_32x32x16_bf16(b0, qr[d0], p0, 0, 0, 0); p1 = __builtin_amdgcn_mfma_f32_32x32x16_bf16(b1, qr[d0], p1, 0, 0, 0); }
    }
    __builtin_amdgcn_s_setprio(0);
}
__device__ __forceinline__ s16x4 vtr(NLAS const unsigned char* p) { return __builtin_bit_cast(s16x4, __builtin_amdgcn_ds_read_tr16_b64_v4i16((NLAS v4i16_t*)p)); }
__device__ __forceinline__ void pv(f32x16* o, NLAS const unsigned char* Vslot, const f32x16& p0, const f32x16& p1, int lane, int hi) {
    u32x4 w0 = {pk(p0[0], p0[1]), pk(p0[2], p0[3]), pk(p0[4], p0[5]), pk(p0[6], p0[7])};
    u32x4 w1 = {pk(p0[8], p0[9]), pk(p0[10], p0[11]), pk(p0[12], p0[13]), pk(p0[14], p0[15])};
    u32x4 w2 = {pk(p1[0], p1[1]), pk(p1[2], p1[3]), pk(p1[4], p1[5]), pk(p1[6], p1[7])};
    u32x4 w3 = {pk(p1[8], p1[9]), pk(p1[10], p1[11]), pk(p1[12], p1[13]), pk(p1[14], p1[15])};
    const bf16x8 pa[4] = {__builtin_bit_cast(bf16x8, w0), __builtin_bit_cast(bf16x8, w1), __builtin_bit_cast(bf16x8, w2), __builtin_bit_cast(bf16x8, w3)};
    NLAS const unsigned char* vp = Vslot + ((lane >> 4) & 1) * 32 + (lane & 3) * 8 + (4 * hi + ((lane & 15) >> 2)) * 64;
    __builtin_amdgcn_s_setprio(1);
#pragma unroll
    for (int d0 = 0; d0 < 2; ++d0)
#pragma unroll
        for (int ks = 0; ks < 4; ++ks) {
            const s16x4 lo = vtr(vp + d0 * 4096 + ks * 1024), hh = vtr(vp + d0 * 4096 + ks * 1024 + 512);
            const bf16x8 vf = {lo[0], lo[1], lo[2], lo[3], hh[0], hh[1], hh[2], hh[3]};
            o[d0] = __builtin_amdgcn_mfma_f32_32x32x16_bf16(pa[ks], vf, o[d0], 0, 0, 0);
        }
    __builtin_amdgcn_s_setprio(0);
}
__device__ __forceinline__ void scale_rows(f32x16* o, NLAS float* wsf, float s, int r32, int hi) {
    if (hi == 0) wsf[r32] = s;
#pragma unroll
    for (int i = 0; i < 16; ++i) { const float f = wsf[crow(i, hi)]; o[0][i] *= f; o[1][i] *= f; }
}
__device__ __forceinline__ void acc_rows(f32x16* tot, const f32x16* o, NLAS float* wsf, float s, int r32, int hi) {
    if (hi == 0) wsf[32 + r32] = s;
#pragma unroll
    for (int i = 0; i < 16; ++i) { const float f = wsf[32 + crow(i, hi)]; tot[0][i] += f * o[0][i]; tot[1][i] += f * o[1][i]; }
}
#define MX3(a, b, c) __builtin_fmaxf(__builtin_fmaxf((a), (b)), (c))
__device__ __forceinline__ void softmax_step(f32x16& p0, f32x16& p1, float& m, float& l, f32x16* o, NLAS float* wsf, int r32, int hi) {
    float ta = MX3(p0[0], p0[1], p1[0]), tb = MX3(p0[2], p0[3], p1[1]); ta = MX3(ta, p1[2], p1[3]);
#pragma unroll
    for (int r = 4; r < 16; r += 4) { ta = MX3(ta, p0[r], p0[r + 1]); tb = MX3(tb, p0[r + 2], p0[r + 3]); ta = MX3(ta, p1[r], p1[r + 1]); tb = MX3(tb, p1[r + 2], p1[r + 3]); }
    float t = xhalf_max(fmaxf(ta, tb));
    if (__any(t > 8.f)) {
        const float d = fmaxf(t, 0.f);
        m += d;
#pragma unroll
        for (int i = 0; i < 16; ++i) { p0[i] -= d; p1[i] -= d; }
        const float alpha = __builtin_amdgcn_exp2f(-d);
        l *= alpha;
        scale_rows(o, wsf, alpha, r32, hi);
    }
    float s = 0.f;
#pragma unroll
    for (int i = 0; i < 16; ++i) { p0[i] = __builtin_amdgcn_exp2f(p0[i]); p1[i] = __builtin_amdgcn_exp2f(p1[i]); s += p0[i] + p1[i]; }
    l += s;
}

__device__ __forceinline__ void attn_tile(NLAS unsigned char* lds, bf16_t* P, const bf16_t* KC, const bf16_t* VC, int b, int g, int qt, unsigned* qcnt, unsigned& qnext, bool pre, bf16x8 (&qr)[4], unsigned short (&gq)[3], int& idx_next) {
    int tid = threadIdx.x; asm volatile("" : "+v"(tid));
    const int lane = tid & 63, r32 = lane & 31, hi = lane >> 5; const int wid = __builtin_amdgcn_readfirstlane(tid >> 6);
    const int head = g * 4 + (wid >> 1), qh = wid & 1, t0 = qt * 64, qi = qh * 32 + r32, blk_t = qt;
    NLAS float* wsf = (NLAS float*)(lds + L_WS) + wid * 64;
    NLAS float* imp = (NLAS float*)(lds + L_IMP);
    NLAS unsigned* selm = (NLAS unsigned*)(lds + L_SEL);
    NLAS unsigned char* slot0 = lds + L_PRE; NLAS unsigned char* slot1 = lds + L_PRE + 16384;
    const size_t rowbase = (size_t)b * SEQ;
    bf16_t* qrow = P + (rowbase + t0 + qi) * LDP;
    const float sl2 = exp2f(-0.5f * (float)(head + 1)) * LOG2E;
    if (!pre) {
#pragma unroll
        for (int d0 = 0; d0 < 4; ++d0) qr[d0] = *(const bf16x8*)(qrow + C_NQ + head * 64 + d0 * 16 + hi * 8);
#pragma unroll
        for (int e = 0; e < 3; ++e) gq[e] = qrow[C_SG + head * 3 + e];
    }
#define FSIG(x) __builtin_amdgcn_rcpf(1.f + __builtin_amdgcn_exp2f(-LOG2E * (x)))
    const float gate_c = FSIG(bf2f(gq[0])), gate_s = FSIG(bf2f(gq[1])), gate_w = FSIG(bf2f(gq[2]));
#undef FSIG
    bf16x8 qn[4]; unsigned short gn[3] = {0, 0, 0}; int idxN = -1;
#pragma unroll
    for (int d0 = 0; d0 < 4; ++d0) qn[d0] = qr[d0];
    f32x16 tot[2]; tot[0] = f32x16{}; tot[1] = f32x16{};
#define CRF(i) ((float)(((i) & 3) + 8 * ((i) >> 2)) + 4.f * (float)hiv)
#define OPAQUE_HI() int hiv = hi; asm volatile("" : "+v"(hiv))

    {
        const bf16_t* kcb = KC + ((size_t)(b * NS_G + g) * 128) * 64; const bf16_t* vcb = VC + ((size_t)(b * NS_G + g) * 128) * 64;
        const bool two = (qt >= 16);
        unsigned kof, vof; tile_offs(kof, vof, 64, wid, lane);
        {
            unsigned kof0, vof0; tile_offs(kof0, vof0, LDP, wid, lane);
            dma_tile_a(lds + L_KV + 2 * 16384, P + rowbase * LDP + C_KS + g * 64, P + rowbase * LDP + C_VS + g * 64, kof0, vof0, wid); }
        if (!pre) { dma_tile_a(slot0, kcb, vcb, kof, vof, wid);
            if (two) dma_tile_a(slot1, kcb + 64 * 64, vcb + 64 * 64, kof, vof, wid); }
        asm volatile("s_waitcnt vmcnt(0)" ::: "memory");
        __syncthreads();
        f32x16 pA0, pA1, pB0, pB1, c0, c1;
        const float s16 = sl2 * 16.f; OPAQUE_HI();
#pragma unroll
        for (int i = 0; i < 16; ++i) { c0[i] = s16 * CRF(i); c1[i] = s16 * (CRF(i) + 32.f); }
        qkt(pA0, pA1, slot0, qr, c0, c1, r32, hi);
        const int cmax = (t0 + qi - 31) >> 4;
        const int qposm = t0 + qi - 31;
#pragma unroll
        for (int i = 0; i < 16; ++i) { const int c = crow(i, hiv); if (16 * c > qposm) pA0[i] = NEG; if (16 * (c + 32) > qposm) pA1[i] = NEG; }
        if (two) {
#pragma unroll
            for (int i = 0; i < 16; ++i) { c0[i] += s16 * 64.f; c1[i] += s16 * 64.f; }
            qkt(pB0, pB1, slot1, qr, c0, c1, r32, hi);
#pragma unroll
            for (int i = 0; i < 16; ++i) { const int c = 64 + crow(i, hiv); if (16 * c > qposm) pB0[i] = NEG; if (16 * (c + 32) > qposm) pB1[i] = NEG; }
        } else { pB0 = f32x16{}; pB1 = f32x16{}; }
        (void)cmax;
        float mx = NEG;
#pragma unroll
        for (int i = 0; i < 16; ++i) mx = fmaxf(mx, fmaxf(pA0[i], pA1[i]));
        if (two) {
#pragma unroll
            for (int i = 0; i < 16; ++i) mx = fmaxf(mx, fmaxf(pB0[i], pB1[i])); }
        mx = xhalf_max(mx);
        float s = 0.f;
#pragma unroll
        for (int i = 0; i < 16; ++i) { pA0[i] = __builtin_amdgcn_exp2f(pA0[i] - mx); pA1[i] = __builtin_amdgcn_exp2f(pA1[i] - mx); s += pA0[i] + pA1[i]; }
        if (two) {
#pragma unroll
            for (int i = 0; i < 16; ++i) { pB0[i] = __builtin_amdgcn_exp2f(pB0[i] - mx); pB1[i] = __builtin_amdgcn_exp2f(pB1[i] - mx); s += pB0[i] + pB1[i]; } }
        s = xhalf_sum(s);
        const float nrm = (t0 + qi >= 31) ? __builtin_amdgcn_rcpf(s) : 0.f;
#pragma unroll
        for (int i = 0; i < 16; ++i) { pA0[i] *= nrm; pA1[i] *= nrm; }
        if (two) {
#pragma unroll
            for (int i = 0; i < 16; ++i) { pB0[i] *= nrm; pB1[i] *= nrm; } }
#define PSEL(L) ((L) < 4 ? pA0 : (L) < 8 ? pA1 : (L) < 12 ? pB0 : pB1)
#define MAINV(L) ((PSEL(L)[4 * ((L) & 3)] + PSEL(L)[4 * ((L) & 3) + 1]) + (PSEL(L)[4 * ((L) & 3) + 2] + 0.5f * PSEL(L)[4 * ((L) & 3) + 3]))
#define CARRY(L) (0.5f * PSEL(L)[4 * ((L) & 3) + 3])
#pragma unroll
        for (int L = 0; L < 16; ++L) {
            const float cprev = (L > 0) ? CARRY(L > 0 ? L - 1 : 0) : 0.f;
            const float snd = hi ? cprev : CARRY(L);
            const float rcv = __shfl_xor(snd, 32);
            imp[((wid >> 1) * 64 + qi) * 33 + 2 * L + hi] = MAINV(L) + rcv;
        }
#undef PSEL
#undef MAINV
#undef CARRY
        f32x16 o[2]; o[0] = f32x16{}; o[1] = f32x16{};
        pv(o, slot0 + 8192, pA0, pA1, lane, hi);
        if (two) pv(o, slot1 + 8192, pB0, pB1, lane, hi);
        acc_rows(tot, o, wsf, gate_c, r32, hi);
    }
    __syncthreads();
    {
        const int ql = 8 * wid + (lane >> 3), sub = lane & 7;
        float v[4];
#pragma unroll
        for (int e = 0; e < 4; ++e) { const int j = 4 * sub + e; v[e] = (imp[(0 * 64 + ql) * 33 + j] + imp[(1 * 64 + ql) * 33 + j]) + (imp[(2 * 64 + ql) * 33 + j] + imp[(3 * 64 + ql) * 33 + j]);
            if (j < 1 || j >= blk_t) v[e] = -1.f; }
        unsigned mask = 1u | (1u << blk_t);
#pragma unroll 1
        for (int it = 0; it < 6; ++it) {
            float bv = fmaxf(fmaxf(v[0], v[1]), fmaxf(v[2], v[3]));
            bv = fmaxf(bv, __builtin_bit_cast(float, __builtin_amdgcn_mov_dpp(__builtin_bit_cast(int, bv), 0xB1, 0xF, 0xF, true)));
            bv = fmaxf(bv, __builtin_bit_cast(float, __builtin_amdgcn_mov_dpp(__builtin_bit_cast(int, bv), 0x4E, 0xF, 0xF, true)));
            bv = fmaxf(bv, __builtin_bit_cast(float, __builtin_amdgcn_mov_dpp(__builtin_bit_cast(int, bv), 0x141, 0xF, 0xF, true)));
            int bj = (v[3] == bv) ? 4 * sub + 3 : 64; bj = (v[2] == bv) ? 4 * sub + 2 : bj; bj = (v[1] == bv) ? 4 * sub + 1 : bj; bj = (v[0] == bv) ? 4 * sub : bj;
            bj = min(bj, __builtin_amdgcn_mov_dpp(bj, 0xB1, 0xF, 0xF, true));
            bj = min(bj, __builtin_amdgcn_mov_dpp(bj, 0x4E, 0xF, 0xF, true));
            bj = min(bj, __builtin_amdgcn_mov_dpp(bj, 0x141, 0xF, 0xF, true));
            if (bv >= 0.f) { mask |= 1u << bj;
#pragma unroll
                for (int e = 0; e < 4; ++e) if (4 * sub + e == bj) v[e] = -1.f; }
        }
        if (sub == 0) selm[ql] = mask;
        unsigned any = mask;
        any |= __shfl_xor(any, 8); any |= __shfl_xor(any, 16); any |= __shfl_xor(any, 32);
        if (lane == 0) selm[64 + wid] = any;
    }
    __syncthreads();
    const unsigned mymask = selm[qi];
    const unsigned anym = (unsigned)__builtin_amdgcn_readfirstlane((int)((selm[64] | selm[65]) | (selm[66] | selm[67]) | (selm[68] | selm[69]) | (selm[70] | selm[71])));
    unsigned kofP, vofP; tile_offs(kofP, vofP, LDP, wid, lane);
    {
        const bf16_t* kbw = P + rowbase * LDP + C_KW + g * 64; const bf16_t* vbw = P + rowbase * LDP + C_VW + g * 64;
        dma_tile_a(lds + L_IMP, kbw + (size_t)blk_t * 64 * LDP, vbw + (size_t)blk_t * 64 * LDP, kofP, vofP, wid);
        if (blk_t >= 1) dma_tile_a(lds + L_IMP + 16384, kbw + (size_t)(blk_t - 1) * 64 * LDP, vbw + (size_t)(blk_t - 1) * 64 * LDP, kofP, vofP, wid);
    }
    {
        const bf16_t* kb = P + rowbase * LDP + C_KS + g * 64; const bf16_t* vb = P + rowbase * LDP + C_VS + g * 64;
        unsigned todo = anym;
        float m = 0.f, l = 0.f; f32x16 o[2]; o[0] = f32x16{}; o[1] = f32x16{};
        int j0 = __builtin_ctz(todo); todo &= todo - 1;
        int j1 = todo ? __builtin_ctz(todo) : -1; if (todo) todo &= todo - 1;
        if (j1 >= 0) dma_tile_a(lds + L_KV, kb + (size_t)j1 * 64 * LDP, vb + (size_t)j1 * 64 * LDP, kofP, vofP, wid);
        int sl = 2;
        for (;;) {
            const int j2 = todo ? __builtin_ctz(todo) : -1; if (todo) todo &= todo - 1;
            const int sl2i = (sl >= 1) ? sl - 1 : 2;
            if (j2 >= 0) dma_tile_a(lds + L_KV + sl2i * 16384, kb + (size_t)j2 * 64 * LDP, vb + (size_t)j2 * 64 * LDP, kofP, vofP, wid);
            NLAS unsigned char* sc = lds + L_KV + sl * 16384;
            const int j = j0;
            const bool mine = (mymask >> j) & 1u;
            const bool far = sl2 * (float)(t0 - 64 * j - 63) > 200.f;
            if (__any(mine) && !far) {
                f32x16 p0, p1, c0, c1; const float kb0 = sl2 * (float)(j * 64 - t0) - m; OPAQUE_HI();
#pragma unroll
                for (int i = 0; i < 16; ++i) { c0[i] = kb0 + sl2 * CRF(i); c1[i] = c0[i] + sl2 * 32.f; }
                qkt(p0, p1, sc, qr, c0, c1, r32, hi);
                if (j == blk_t) {
                    asm volatile("" ::: "memory");
#pragma unroll
                    for (int i = 0; i < 16; ++i) { const int kk = crow(i, hiv); if (kk > qi) p0[i] = NEG; if (kk + 32 > qi) p1[i] = NEG; }
                }
                if (__any(!mine)) {
                    asm volatile("" ::: "memory");
                    if (!mine) {
#pragma unroll
                        for (int i = 0; i < 16; ++i) { p0[i] = NEG; p1[i] = NEG; } }
                }
                softmax_step(p0, p1, m, l, o, wsf, r32, hi);
                pv(o, sc + 8192, p0, p1, lane, hi);
            }
            if (j1 < 0) break;
            if (j2 >= 0) RING_WAIT_BAR(2); else RING_WAIT_BAR(0);
            j0 = j1; j1 = j2; sl = (sl == 2) ? 0 : sl + 1;
        }
        RING_WAIT_BAR(0);
        if (tid == 0) qnext = atomicAdd(qcnt, 1u);
        l = xhalf_sum(l);
        acc_rows(tot, o, wsf, gate_s * __builtin_amdgcn_rcpf(l), r32, hi);
    }
    {
        const bf16_t* kb = P + rowbase * LDP + C_KW + g * 64; const bf16_t* vb = P + rowbase * LDP + C_VW + g * 64;
        float m = 0.f, l = 0.f; f32x16 o[2]; o[0] = f32x16{}; o[1] = f32x16{};
        const int nw = (blk_t >= 4 ? 4 : blk_t) + 1;
        for (int t = 2; t < nw; ++t) dma_tile_a(lds + L_KV + (t - 2) * 16384, kb + (size_t)(blk_t - t) * 64 * LDP, vb + (size_t)(blk_t - t) * 64 * LDP, kofP, vofP, wid);
        for (int t = 0; t < nw; ++t) {
            if (t == 2) {
                volatile NLAS unsigned* nslot = (volatile NLAS unsigned*)(lds + L_SEL + 320);
                asm volatile("s_waitcnt vmcnt(0)" ::: "memory");
                if (tid == 0) *nslot = qnext;
                asm volatile("s_waitcnt lgkmcnt(0)" ::: "memory"); __builtin_amdgcn_s_barrier(); asm volatile("" ::: "memory");
                idxN = __builtin_amdgcn_readfirstlane((int)*nslot);
                if (idxN < 1024) {
                    const int nb_ = (idxN & 31) >> 2, ng_ = idxN & 3, nqt_ = 31 - (idxN >> 5);
                    const bf16_t* kcn = KC + ((size_t)(nb_ * NS_G + ng_) * 128) * 64; const bf16_t* vcn = VC + ((size_t)(nb_ * NS_G + ng_) * 128) * 64;
                    unsigned kofc, vofc; tile_offs(kofc, vofc, 64, wid, lane);
                    dma_tile_a(lds + L_PRE, kcn, vcn, kofc, vofc, wid);
                    if (nqt_ >= 16) dma_tile_a(lds + L_PRE + 16384, kcn + 64 * 64, vcn + 64 * 64, kofc, vofc, wid);
                    const bf16_t* qrn = P + ((size_t)nb_ * SEQ + nqt_ * 64 + qi) * LDP; const int hn = ng_ * 4 + (wid >> 1);
#pragma unroll
                    for (int d0 = 0; d0 < 4; ++d0) qn[d0] = *(const bf16x8*)(qrn + C_NQ + hn * 64 + d0 * 16 + hi * 8);
#pragma unroll
                    for (int e = 0; e < 3; ++e) gn[e] = qrn[C_SG + hn * 3 + e];
                }
            }
            NLAS unsigned char* sc = (t < 2) ? lds + L_IMP + t * 16384 : lds + L_KV + (t - 2) * 16384;
            const int j = blk_t - t;
            f32x16 p0, p1, c0, c1; const float kb0 = sl2 * (float)(j * 64 - t0) - m; OPAQUE_HI();
#pragma unroll
            for (int i = 0; i < 16; ++i) { c0[i] = kb0 + sl2 * CRF(i); c1[i] = c0[i] + sl2 * 32.f; }
            qkt(p0, p1, sc, qr, c0, c1, r32, hi);
            if (t == 0 || t == 4) {
                asm volatile("" ::: "memory");
                const int dq = t0 + qi - j * 64;
#pragma unroll
                for (int i = 0; i < 16; ++i) { const int d0_ = dq - crow(i, hiv), d1_ = d0_ - 32; if (d0_ < 0 || d0_ > 255) p0[i] = NEG; if (d1_ < 0 || d1_ > 255) p1[i] = NEG; }
            }
            softmax_step(p0, p1, m, l, o, wsf, r32, hi);
            pv(o, sc + 8192, p0, p1, lane, hi);
        }
        l = xhalf_sum(l);
        acc_rows(tot, o, wsf, gate_w * __builtin_amdgcn_rcpf(l), r32, hi);
    }
    {
        NLAS bf16_t* stg = (NLAS bf16_t*)(lds + L_OST) + wid * 2048;
#pragma unroll
        for (int i = 0; i < 16; ++i) { const int orow = crow(i, hi); stg[orow * 64 + r32] = f2bf(tot[0][i]); stg[orow * 64 + 32 + r32] = f2bf(tot[1][i]); }
        bf16_t* ow = P + (rowbase + t0 + qh * 32) * LDP + C_NQ + head * 64;
#pragma unroll
        for (int i = 0; i < 4; ++i) { const int row = i * 8 + (lane >> 3), ch = lane & 7; const u32x4 v = *(NLAS const u32x4*)(stg + row * 64 + ch * 8); *(u32x4*)((char*)ow + (unsigned)(row * LDP + ch * 8) * 2u) = v; }
    }
    __syncthreads();
    idx_next = idxN;
    if (idxN >= 0) {
#pragma unroll
        for (int d0 = 0; d0 < 4; ++d0) qr[d0] = qn[d0];
#pragma unroll
        for (int e = 0; e < 3; ++e) gq[e] = gn[e];
    }
#undef CRF
#undef OPAQUE_HI
}

__device__ __forceinline__ void norm8(u32x4& v, const float* g8, float sc) {
    float x[8] = {__uint_as_float(v.x << 16), __uint_as_float(v.x & 0xffff0000u), __uint_as_float(v.y << 16), __uint_as_float(v.y & 0xffff0000u),
                  __uint_as_float(v.z << 16), __uint_as_float(v.z & 0xffff0000u), __uint_as_float(v.w << 16), __uint_as_float(v.w & 0xffff0000u)};
    float s = 0.f;
#pragma unroll
    for (int e = 0; e < 8; ++e) s += x[e] * x[e];
    s += __shfl_xor(s, 1); s += __shfl_xor(s, 2); s += __shfl_xor(s, 4);
    const float r = rsqrtf(s * (1.f / 64.f) + EPS) * sc;
    v.x = pk(x[0] * r * g8[0], x[1] * r * g8[1]); v.y = pk(x[2] * r * g8[2], x[3] * r * g8[3]); v.z = pk(x[4] * r * g8[4], x[5] * r * g8[5]); v.w = pk(x[6] * r * g8[6], x[7] * r * g8[7]);
}
__device__ __forceinline__ void prep_units(bf16_t* P, const float* qn, const float* kns, const float* knw, int gw, int NGW, int lane) {
    float gq[8], gk[8];
    const float* kg = (lane < 32) ? kns : knw;
#pragma unroll
    for (int e = 0; e < 8; ++e) { gq[e] = qn[8 * (lane & 7) + e]; gk[e] = kg[8 * (lane & 7) + e]; }
    const int coff = (lane < 32) ? C_KS + 8 * lane : C_KW + 8 * (lane - 32);
    for (int m0 = gw; m0 < M; m0 += 2 * NGW) {
        const int m1 = m0 + NGW; const bool two = m1 < M;
        bf16_t* r0 = P + (size_t)m0 * LDP; bf16_t* r1 = P + (size_t)(two ? m1 : m0) * LDP;
        u32x4 a0 = *(const u32x4*)(r0 + C_NQ + 8 * lane), b0 = *(const u32x4*)(r0 + C_NQ + 512 + 8 * lane), c0 = *(const u32x4*)(r0 + coff);
        u32x4 a1 = *(const u32x4*)(r1 + C_NQ + 8 * lane), b1 = *(const u32x4*)(r1 + C_NQ + 512 + 8 * lane), c1 = *(const u32x4*)(r1 + coff);
        norm8(a0, gq, 0.125f * LOG2E); norm8(b0, gq, 0.125f * LOG2E); norm8(c0, gk, 1.f);
        norm8(a1, gq, 0.125f * LOG2E); norm8(b1, gq, 0.125f * LOG2E); norm8(c1, gk, 1.f);
        *(u32x4*)(r0 + C_NQ + 8 * lane) = a0; *(u32x4*)(r0 + C_NQ + 512 + 8 * lane) = b0; *(u32x4*)(r0 + coff) = c0;
        if (two) { *(u32x4*)(r1 + C_NQ + 8 * lane) = a1; *(u32x4*)(r1 + C_NQ + 512 + 8 * lane) = b1; *(u32x4*)(r1 + coff) = c1; }
    }
}

constexpr int LC_A = 0, LC_B = 32768, LC_HID = 0, LC_W2 = 98304;
__device__ __forceinline__ void compress_item(NLAS unsigned char* lds, const bf16_t* P, const bf16_t* W1T, const float* bias1, const float* W2, const float* gain, bf16_t* OUT, int b, int g, int which, int half) {
    const int tid = threadIdx.x, lane = tid & 63, r32 = lane & 31, hi = lane >> 5; const int wid = __builtin_amdgcn_readfirstlane(tid >> 6);
    const int mt = wid >> 2, nt = wid & 3;
    const int ca = tid >> 3, dca = tid & 7; const int cg_ = 64 * half + ca; const int ccl = cg_ < NCMP ? cg_ : NCMP - 1;
    const bf16_t* asrc = P + ((size_t)b * SEQ + 16 * ccl) * LDP + (which ? C_VC : C_KC) + g * 64 + dca * 8;
    const bf16_t* bsrc0 = W1T + (size_t)(tid >> 3) * 2048 + (tid & 7) * 8; const bf16_t* bsrc1 = bsrc0 + (size_t)64 * 2048;
    const int adst = (dca * 64 + ca) * 16, bdst0 = ((tid & 7) * 128 + (tid >> 3)) * 16, bdst1 = bdst0 + 64 * 16;
#define CBAR() do { asm volatile("s_waitcnt lgkmcnt(0)" ::: "memory"); __builtin_amdgcn_s_barrier(); asm volatile("" ::: "memory"); } while (0)
#define CLOAD(r_, i_) do { _Pragma("unroll") for (int s_ = 0; s_ < 2; ++s_) { const int l_ = 2 * (i_) + s_; r_[3 * s_] = *(const u32x4*)(asrc + (size_t)l_ * LDP); r_[3 * s_ + 1] = *(const u32x4*)(bsrc0 + l_ * 64); r_[3 * s_ + 2] = *(const u32x4*)(bsrc1 + l_ * 64); } } while (0)
#define CSTORE(r_, buf_) do { _Pragma("unroll") for (int s_ = 0; s_ < 2; ++s_) { *(NLAS u32x4*)(lds + LC_A + (buf_) * 16384 + s_ * 8192 + adst) = r_[3 * s_]; *(NLAS u32x4*)(lds + LC_B + (buf_) * 32768 + s_ * 16384 + bdst0) = r_[3 * s_ + 1]; *(NLAS u32x4*)(lds + LC_B + (buf_) * 32768 + s_ * 16384 + bdst1) = r_[3 * s_ + 2]; } } while (0)
#define CMMA(buf_) do { _Pragma("unroll") for (int s_ = 0; s_ < 2; ++s_) { NLAS const unsigned char* ab = lds + LC_A + (buf_) * 16384 + s_ * 8192; NLAS const unsigned char* bb = lds + LC_B + (buf_) * 32768 + s_ * 16384; \
        _Pragma("unroll") for (int ds = 0; ds < 4; ++ds) { \
            const bf16x8 a = *(NLAS const bf16x8*)(ab + ((2 * ds + hi) * 64 + 32 * mt + r32) * 16); \
            const bf16x8 w = *(NLAS const bf16x8*)(bb + ((2 * ds + hi) * 128 + 32 * nt + r32) * 16); \
            acc = __builtin_amdgcn_mfma_f32_32x32x16_bf16(a, w, acc, 0, 0, 0); } } } while (0)
    {
#pragma unroll
        for (int k = 0; k < 4; ++k) *(NLAS f32x4*)(lds + LC_W2 + (tid + 512 * k) * 16) = *(const f32x4*)(W2 + (tid + 512 * k) * 4);
    }
    u32x4 r0[6], r1[6], r2[6], r3[6];
    CLOAD(r0, 0); CSTORE(r0, 0);
    CLOAD(r1, 1); CLOAD(r2, 2); CLOAD(r3, 3); CLOAD(r0, 4);
    CBAR();
    f32x16 acc = f32x16{};
    for (int i = 0; i < 16; i += 4) {
        CMMA(0); CSTORE(r1, 1); if (i + 5 < 16) CLOAD(r1, i + 5); CBAR();
        CMMA(1); CSTORE(r2, 0); if (i + 6 < 16) CLOAD(r2, i + 6); CBAR();
        CMMA(0); CSTORE(r3, 1); if (i + 7 < 16) CLOAD(r3, i + 7); CBAR();
        CMMA(1); if (i + 4 < 16) { CSTORE(r0, 0); if (i + 8 < 16) CLOAD(r0, i + 8); } CBAR();
    }
#undef CBAR
#undef CLOAD
#undef CSTORE
#undef CMMA
    NLAS float* hid = (NLAS float*)(lds + LC_HID);
    const float bs = bias1[32 * nt + r32];
#pragma unroll
    for (int i = 0; i < 16; ++i) hid[(32 * mt + crow(i, hi)) * 132 + 32 * nt + r32] = gelu_tanh(acc[i] + bs);
    __syncthreads();
    {
        const int row = tid >> 3, e0 = (tid & 7) * 8;
        float o[8];
#pragma unroll
        for (int e = 0; e < 8; ++e) o[e] = 0.f;
#pragma unroll 8
        for (int i = 0; i < 128; ++i) { const float h = hid[row * 132 + i]; const f32x4 wa = *(NLAS const f32x4*)(lds + LC_W2 + (i * 64 + e0) * 4), wb = *(NLAS const f32x4*)(lds + LC_W2 + (i * 64 + e0 + 4) * 4);
            o[0] += h * wa[0]; o[1] += h * wa[1]; o[2] += h * wa[2]; o[3] += h * wa[3]; o[4] += h * wb[0]; o[5] += h * wb[1]; o[6] += h * wb[2]; o[7] += h * wb[3]; }
        if (which == 0) {
            float ss = 0.f;
#pragma unroll
            for (int e = 0; e < 8; ++e) ss += o[e] * o[e];
            ss += __shfl_xor(ss, 1); ss += __shfl_xor(ss, 2); ss += __shfl_xor(ss, 4);
            const float r = rsqrtf(ss * (1.f / 64.f) + EPS);
#pragma unroll
            for (int e = 0; e < 8; ++e) o[e] *= r * gain[e0 + e];
        }
        const int cg = 64 * half + row;
        if (cg >= NCMP) {
#pragma unroll
            for (int e = 0; e < 8; ++e) o[e] = 0.f; }
        u32x4 w; w.x = pk(o[0], o[1]); w.y = pk(o[2], o[3]); w.z = pk(o[4], o[5]); w.w = pk(o[6], o[7]);
        *(u32x4*)(OUT + (((size_t)(b * NS_G + g) * 128) + cg) * 64 + e0) = w;
    }
    __syncthreads();
}
}
namespace pg8 {
#define PG8_LAS __attribute__((address_space(3)))
typedef short bf16x8 __attribute__((ext_vector_type(8)));
typedef float f32x4 __attribute__((ext_vector_type(4)));
typedef float f32x2 __attribute__((ext_vector_type(2)));
typedef unsigned u32x4 __attribute__((ext_vector_type(4)));
typedef unsigned u32x2 __attribute__((ext_vector_type(2)));
constexpr int BM = 256, BK = 64, HALF = 128, HTB = HALF * BK * 2, STAGE_BYTES = 8 * HTB, NXCD = 8, WGM = 8;

__host__ __device__ __forceinline__ int lds_byte(int r, int c) { const int st = (r >> 4) * 2 + (c >> 5), rr = r & 15, cc = c & 31, ob = rr * 64 + cc * 2; return st * 1024 + (ob ^ (((ob >> 9) & 1) << 5)); }
__host__ __device__ __forceinline__ void stage_rc(int b, int& R, int& C) { const int st = b / 1024, sb = b % 1024, swz = sb ^ (((sb >> 9) & 1) << 5); R = (st >> 1) * 16 + swz / 64; C = (st & 1) * 32 + (swz % 64) / 2; }
__host__ __device__ __forceinline__ int perm32(int rho) { const int n = rho >> 4, i = rho & 15; return 8 * (i >> 2) + 4 * n + (i & 3); }

struct Unit { int pm, pn, ks; };
struct Gemm { const bf16_t* A; const bf16_t* Bt; int lda, ldb; int M, N, K; int ksoff; };

struct StaticOrder {
    int nM, nN, nwg, G, c;
    __host__ __device__ __forceinline__ void init(int M_, int N_, int G_, int c_) { nM = M_ / BM; nN = N_ / BM; nwg = nM * nN; G = G_; c = c_; }
    __host__ __device__ __forceinline__ bool next(int i, Unit& u) const {
        const long L = (long)i * G + c; if (L >= nwg) return false;
        int wgid = (int)L; { const int q = nwg / NXCD, r = nwg % NXCD, xcd = wgid % NXCD, off = wgid / NXCD; wgid = (xcd < r ? xcd * (q + 1) : r * (q + 1) + (xcd - r) * q) + off; }
        const int nig = WGM * nN, gid = wgid / nig, fm = gid * WGM, gsz = (nM - fm) < WGM ? (nM - fm) : WGM;
        u.pm = fm + ((wgid % nig) % gsz); u.pn = (wgid % nig) / gsz; u.ks = 0; return true;
    }
};
struct GatePairOrder {
    StaticOrder base;
    __host__ __device__ __forceinline__ bool next(int i, Unit& u) const { if (!base.next(i >> 1, u)) return false; u.pn += 4 * (i & 1); u.ks = 0; return true; }
};
struct TwoPassOrder {
    StaticOrder base;
    __host__ __device__ __forceinline__ bool next(int i, Unit& u) const { if (!base.next(i >> 1, u)) return false; u.ks = i & 1; return true; }
};

typedef __bf16 bf16x2_t __attribute__((ext_vector_type(2)));
__device__ __forceinline__ unsigned cvt_pk_bf16(float lo, float hi) { f32x2 v = {lo, hi}; bf16x2_t b = __builtin_convertvector(v, bf16x2_t); return __builtin_bit_cast(unsigned, b); }
__device__ __forceinline__ float fast_sigmoid(float x) { return __builtin_amdgcn_rcpf(1.f + __builtin_amdgcn_exp2f(-1.4426950408889634f * x)); }
__device__ __forceinline__ float bflo(unsigned w) { return __uint_as_float(w << 16); }
__device__ __forceinline__ float bfhi(unsigned w) { return __uint_as_float(w & 0xffff0000u); }

typedef f32x4 Acc[2][2][4][2];

template <int ACT> struct EpiP {
    __device__ __forceinline__ bool keep(const Unit&) const { return false; }
    static constexpr bool PERM = true;
    bf16_t* O; int ldc; int pn_last; int ncol_last; bf16_t* halo;
    __device__ __forceinline__ void operator()(const Acc& acc, const Unit& u, int wr, int wc, int fr, int fq) const {
        const int row0 = u.pm * BM + wr * 64 + fr, tcol = wc * 32 + 8 * fq;
        const int lim = (u.pn == pn_last) ? ncol_last : 256;
#pragma unroll
        for (int ai = 0; ai < 2; ++ai)
#pragma unroll
            for (int m = 0; m < 4; ++m) { bf16_t* rowp = O + (size_t)(row0 + ai * HALF + m * 16) * ldc + u.pn * BM + tcol;
#pragma unroll
                for (int bj = 0; bj < 2; ++bj) { if (tcol + bj * HALF >= lim) continue;
                    f32x4 v0 = acc[ai][bj][m][0], v1 = acc[ai][bj][m][1];
                    if (ACT == 1) {
#pragma unroll
                        for (int e = 0; e < 4; ++e) { v0[e] = fast_sigmoid(v0[e]); v1[e] = fast_sigmoid(v1[e]); } }
                    u32x4 w; w.x = cvt_pk_bf16(v0[0], v0[1]); w.y = cvt_pk_bf16(v0[2], v0[3]); w.z = cvt_pk_bf16(v1[0], v1[1]); w.w = cvt_pk_bf16(v1[2], v1[3]);
                    *(u32x4*)(rowp + bj * HALF) = w;
                    if (ACT == 0 && m == 3 && fr >= 13 && u.pn < 12 && halo) { const int row = row0 + ai * HALF + 48;
                        *(u32x4*)(halo + ((size_t)(row >> 6) * 3 + (fr - 13)) * 3072 + u.pn * BM + tcol + bj * HALF) = w; } } }
    }
};
struct EpiP3 {
    __device__ __forceinline__ bool keep(const Unit&) const { return false; }
    static constexpr int PERM = 3;
    bf16_t* O; int ldc; int pn_last; int ncol_last; bf16_t* halo;
    const float* gtab;
    __device__ __forceinline__ void operator()(const Acc& acc, const Unit& u, int wr, int wc, int fr, int fq) const {
        const int row0 = u.pm * BM + wr * 64 + fr, tcol = wc * 64 + 8 * fq;
        const int lim = (u.pn == pn_last) ? ncol_last : 256;
        if (tcol >= lim) return;
        const int mode = (u.pn >= C_NQ / 256 && u.pn < C_NQ / 256 + 4) ? 1 : (u.pn == C_KS / 256 ? 2 : (u.pn == C_KW / 256 ? 3 : 0));
        if (mode) {
            const float* gp = gtab + (mode - 1) * 64 + 8 * fq;
#pragma unroll
            for (int ai = 0; ai < 2; ++ai)
#pragma unroll
                for (int m = 0; m < 4; ++m) { bf16_t* rowp = O + (size_t)(row0 + ai * HALF + m * 16) * ldc + u.pn * BM + tcol;
                    asm volatile("" ::: "memory");
                    float s = 0.f;
#pragma unroll
                    for (int bj = 0; bj < 2; ++bj)
#pragma unroll
                        for (int n = 0; n < 2; ++n) { const f32x4 t = acc[ai][bj][m][n]; s += (t[0] * t[0] + t[1] * t[1]) + (t[2] * t[2] + t[3] * t[3]); }
                    { const auto p = __builtin_amdgcn_permlane16_swap(__float_as_uint(s), __float_as_uint(s), false, false); s = __uint_as_float(p[0]) + __uint_as_float(p[1]); }
                    { const auto p = __builtin_amdgcn_permlane32_swap(__float_as_uint(s), __float_as_uint(s), false, false); s = __uint_as_float(p[0]) + __uint_as_float(p[1]); }
                    const float r = rsqrtf(s * (1.f / 64.f) + EPS);
#pragma unroll
                    for (int bj = 0; bj < 2; ++bj) {
                        const f32x4 v0 = acc[ai][bj][m][0] * r * *(const f32x4*)(gp + 32 * bj), v1 = acc[ai][bj][m][1] * r * *(const f32x4*)(gp + 32 * bj + 4);
                        u32x4 w; w.x = cvt_pk_bf16(v0[0], v0[1]); w.y = cvt_pk_bf16(v0[2], v0[3]); w.z = cvt_pk_bf16(v1[0], v1[1]); w.w = cvt_pk_bf16(v1[2], v1[3]);
                        *(u32x4*)(rowp + bj * 32) = w; } }
            return;
        }
#pragma unroll
        for (int ai = 0; ai < 2; ++ai)
#pragma unroll
            for (int m = 0; m < 4; ++m) { bf16_t* rowp = O + (size_t)(row0 + ai * HALF + m * 16) * ldc + u.pn * BM + tcol;
#pragma unroll
                for (int bj = 0; bj < 2; ++bj) {
                    const f32x4 v0 = acc[ai][bj][m][0], v1 = acc[ai][bj][m][1];
                    u32x4 w; w.x = cvt_pk_bf16(v0[0], v0[1]); w.y = cvt_pk_bf16(v0[2], v0[3]); w.z = cvt_pk_bf16(v1[0], v1[1]); w.w = cvt_pk_bf16(v1[2], v1[3]);
                    *(u32x4*)(rowp + bj * 32) = w;
                    if (m == 3 && fr >= 13 && u.pn < 12 && halo) { const int row = row0 + ai * HALF + 48;
                        *(u32x4*)(halo + ((size_t)(row >> 6) * 3 + (fr - 13)) * 3072 + u.pn * BM + tcol + bj * 32) = w; } } }
    }
};
struct EpiMix {
    static constexpr bool PERM = true;
    const bf16_t* G; int ldg; bf16_t* O; int ldc;
    __device__ __forceinline__ bool keep(const Unit& u) const { return u.ks == 0; }
    __device__ __forceinline__ void operator()(Acc& acc, const Unit& u, int wr, int wc, int fr, int fq) const {
        const int row0 = u.pm * BM + wr * 64 + fr, col0 = u.pn * BM + wc * 32 + 8 * fq;
#pragma unroll
        for (int ai = 0; ai < 2; ++ai)
#pragma unroll
            for (int m = 0; m < 4; ++m) { const size_t row = (size_t)(row0 + ai * HALF + m * 16); const bf16_t* gp = G + row * ldg + col0; bf16_t* rowp = O + row * ldc + col0;
#pragma unroll
                for (int bj = 0; bj < 2; ++bj) { const u32x4 b = *(const u32x4*)(gp + bj * HALF + 1024);
                    f32x4 v0 = acc[ai][bj][m][0], v1 = acc[ai][bj][m][1];
                    if (u.ks == 0) { const u32x4 a = *(const u32x4*)(gp + bj * HALF);
                        v0[0] *= bflo(a.x) * __builtin_amdgcn_rcpf(bflo(b.x)); v0[1] *= bfhi(a.x) * __builtin_amdgcn_rcpf(bfhi(b.x)); v0[2] *= bflo(a.y) * __builtin_amdgcn_rcpf(bflo(b.y)); v0[3] *= bfhi(a.y) * __builtin_amdgcn_rcpf(bfhi(b.y));
                        v1[0] *= bflo(a.z) * __builtin_amdgcn_rcpf(bflo(b.z)); v1[1] *= bfhi(a.z) * __builtin_amdgcn_rcpf(bfhi(b.z)); v1[2] *= bflo(a.w) * __builtin_amdgcn_rcpf(bflo(b.w)); v1[3] *= bfhi(a.w) * __builtin_amdgcn_rcpf(bfhi(b.w));
                        acc[ai][bj][m][0] = v0; acc[ai][bj][m][1] = v1;
                    } else {
                        u32x4 w; w.x = cvt_pk_bf16(v0[0] * bflo(b.x), v0[1] * bfhi(b.x)); w.y = cvt_pk_bf16(v0[2] * bflo(b.y), v0[3] * bfhi(b.y));
                        w.z = cvt_pk_bf16(v1[0] * bflo(b.z), v1[1] * bfhi(b.z)); w.w = cvt_pk_bf16(v1[2] * bflo(b.w), v1[3] * bfhi(b.w));
                        *(u32x4*)(rowp + bj * HALF) = w; } }
                if (u.ks == 0 && (m & 1)) asm volatile("" ::: "memory"); }
    }
};
struct EpiOut {
    __device__ __forceinline__ bool keep(const Unit&) const { return false; }
    static constexpr bool PERM = true;
    const float* X; bf16_t* Xb; float* pss;
    __device__ __forceinline__ void operator()(const Acc& acc, const Unit& u, int wr, int wc, int fr, int fq) const {
        const int row0 = u.pm * BM + wr * 64 + fr, col0 = u.pn * BM + wc * 32 + 8 * fq;
#pragma unroll
        for (int ai = 0; ai < 2; ++ai)
#pragma unroll
            for (int m = 0; m < 4; ++m) { const size_t row = (size_t)(row0 + ai * HALF + m * 16); const size_t off = row * D + col0; float ss = 0.f;
#pragma unroll
                for (int bj = 0; bj < 2; ++bj) { const f32x4* xp = (const f32x4*)(X + off + bj * HALF);
                    const f32x4 a = xp[0] + acc[ai][bj][m][0], b = xp[1] + acc[ai][bj][m][1];
                    ss += ((a[0] * a[0] + a[1] * a[1]) + (a[2] * a[2] + a[3] * a[3])) + ((b[0] * b[0] + b[1] * b[1]) + (b[2] * b[2] + b[3] * b[3]));
                    u32x4 w; w.x = cvt_pk_bf16(a[0], a[1]); w.y = cvt_pk_bf16(a[2], a[3]); w.z = cvt_pk_bf16(b[0], b[1]); w.w = cvt_pk_bf16(b[2], b[3]);
                    *(u32x4*)(Xb + off + bj * HALF) = w; }
                ss += __shfl_xor(ss, 16); ss += __shfl_xor(ss, 32);
                if (fq == 0) pss[row * 16 + u.pn * 4 + wc] = ss; }
    }
};
struct EpiUp {
    __device__ __forceinline__ bool keep(const Unit&) const { return false; }
    static constexpr bool PERM = true;
    const float* pss; bf16_t* O; int ldc; const PG8_LAS float* tab;
    __device__ __forceinline__ void operator()(const Acc& acc, const Unit& u, int wr, int wc, int fr, int fq) const {
        const int row0 = u.pm * BM + wr * 64 + fr, col0 = u.pn * BM + wc * 32 + 8 * fq;
#pragma unroll
        for (int ai = 0; ai < 2; ++ai)
#pragma unroll
            for (int m = 0; m < 4; ++m) { const size_t row = (size_t)(row0 + ai * HALF + m * 16);
                float rstd;
                if (tab) rstd = tab[u.ks * BM + wr * 64 + fr + ai * HALF + m * 16];
                else { const f32x4* pp = (const f32x4*)(pss + row * 16); const f32x4 s4 = (pp[0] + pp[1]) + (pp[2] + pp[3]); rstd = rsqrtf(((s4[0] + s4[1]) + (s4[2] + s4[3])) * (1.f / D) + EPS); }
                bf16_t* rowp = O + row * ldc + col0;
#pragma unroll
                for (int bj = 0; bj < 2; ++bj) { f32x4 v0 = acc[ai][bj][m][0] * rstd, v1 = acc[ai][bj][m][1] * rstd;
#pragma unroll
                    for (int e = 0; e < 4; ++e) { const float a = fmaxf(v0[e], 0.f), b = fmaxf(v1[e], 0.f); v0[e] = a * a; v1[e] = b * b; }
                    u32x4 w; w.x = cvt_pk_bf16(v0[0], v0[1]); w.y = cvt_pk_bf16(v0[2], v0[3]); w.z = cvt_pk_bf16(v1[0], v1[1]); w.w = cvt_pk_bf16(v1[2], v1[3]);
                    *(u32x4*)(rowp + bj * HALF) = w; } }
    }
};
struct IndexedOrder {
    StaticOrder base;
    __host__ __device__ __forceinline__ bool next(int i, Unit& u) const { if (!base.next(i, u)) return false; u.ks = i; return true; }
};
struct EpiDown {
    __device__ __forceinline__ bool keep(const Unit&) const { return false; }
    static constexpr bool PERM = true;
    const bf16_t* Xb; float* O;
    __device__ __forceinline__ void operator()(const Acc& acc, const Unit& u, int wr, int wc, int fr, int fq) const {
        const int row0 = u.pm * BM + wr * 64 + fr, col0 = u.pn * BM + wc * 32 + 8 * fq;
#pragma unroll
        for (int ai = 0; ai < 2; ++ai)
#pragma unroll
            for (int m = 0; m < 4; ++m) { const size_t off = (size_t)(row0 + ai * HALF + m * 16) * D + col0;
#pragma unroll
                for (int bj = 0; bj < 2; ++bj) { const u32x4 w = *(const u32x4*)(Xb + off + bj * HALF); f32x4* op = (f32x4*)(O + off + bj * HALF);
                    op[0] = (f32x4){bflo(w.x), bfhi(w.x), bflo(w.y), bfhi(w.y)} + acc[ai][bj][m][0];
                    op[1] = (f32x4){bflo(w.z), bfhi(w.z), bflo(w.w), bfhi(w.w)} + acc[ai][bj][m][1]; } }
    }
};

template <class Epi, class Sched, bool ALIGN_EPI>
__device__ __forceinline__ void gemm_phase(PG8_LAS unsigned char* lds, const Gemm g, const Sched& S, const Epi& E) {
    const int tid = threadIdx.x, wid = __builtin_amdgcn_readfirstlane(tid >> 6), lane = tid & 63, wr = wid >> 2, wc = wid & 3, fr = lane & 15, fq = lane >> 4;
    const int K = g.K, nt = K / BK, lda = g.lda, ldb = g.ldb;
    unsigned voffA[2], voffB[2];
#pragma unroll
    for (int i = 0; i < 2; ++i) { int R, C; stage_rc(tid * 16 + i * 8192, R, C); const int Rb = (int)Epi::PERM == 3 ? (64 * (R >> 5) + 8 * ((R >> 2) & 3) + 4 * ((R >> 4) & 1) + (R & 3)) : (Epi::PERM ? ((R & ~31) + perm32(R & 31)) : R);
        voffA[i] = (unsigned)(R * lda + C) * 2u; voffB[i] = (unsigned)(Rb * ldb + C) * 2u; }
    const size_t kstep = (size_t)(BK * 2);
    const size_t hstepA = (size_t)HALF * lda * 2, hstepB = (size_t)((int)Epi::PERM == 3 ? 32 : HALF) * ldb * 2;
    const size_t tstepA = 2 * hstepA, tstepB = (size_t)BM * ldb * 2;
    const unsigned ldsw = (unsigned)wid * 1024u;
    const int aoff = lds_byte(wr * 64 + fr, fq * 8), boff = lds_byte(wc * 32 + fr, fq * 8);
#define PG8_SA(b, h) (((b) * 2 + (h)) * HTB)
#define PG8_SB(b, h) ((4 + (b) * 2 + (h)) * HTB)
#define PG8_STAGE(bufoff, gbase, voff) do { _Pragma("unroll") for (int _i = 0; _i < 2; ++_i) \
        __builtin_amdgcn_global_load_lds((const unsigned*)((const char*)(gbase) + (voff)[_i]), (PG8_LAS unsigned*)(lds + (bufoff) + ldsw + _i * 8192), 16, 0, 0); } while (0)
#define PG8_LDA(dst, b, h) do { _Pragma("unroll") for (int m = 0; m < 4; ++m) _Pragma("unroll") for (int k = 0; k < 2; ++k) dst[m][k] = *(const PG8_LAS bf16x8*)(lds + PG8_SA(b, h) + aoff + m * 2048 + k * 1024); } while (0)
#define PG8_LDB(dst, b, h) do { _Pragma("unroll") for (int n = 0; n < 2; ++n) _Pragma("unroll") for (int k = 0; k < 2; ++k) dst[n][k] = *(const PG8_LAS bf16x8*)(lds + PG8_SB(b, h) + boff + n * 2048 + k * 1024); } while (0)
#define PG8_MMA(ai, bj, At, Bt) do { __builtin_amdgcn_s_setprio(1); _Pragma("unroll") for (int m = 0; m < 4; ++m) _Pragma("unroll") for (int n = 0; n < 2; ++n) _Pragma("unroll") for (int k = 0; k < 2; ++k) \
        acc[ai][bj][m][n] = __builtin_amdgcn_mfma_f32_16x16x32_bf16(Bt[n][k], At[m][k], acc[ai][bj][m][n], 0, 0, 0); __builtin_amdgcn_s_setprio(0); } while (0)
#define PG8_WAIT_V(n) asm volatile("s_waitcnt vmcnt(" #n ")" ::: "memory")
#define PG8_WAIT_L(n) asm volatile("s_waitcnt lgkmcnt(" #n ")" ::: "memory")
#define PG8_BAR __builtin_amdgcn_s_barrier()
#define PG8_SCHED __builtin_amdgcn_sched_barrier(0)
#define PG8_KBODY(t) do { \
            const bool last = (t == nt - 2); \
            const char* a1 = cA + (size_t)(t + 1) * kstep; \
            const char* a2 = last ? nA : cA + (size_t)(t + 2) * kstep; const char* b2 = last ? nB : cB + (size_t)(t + 2) * kstep; \
            const char* a3 = a2 + kstep; const char* b3 = b2 + kstep; \
            PG8_LDB(B0, 0, 0); PG8_LDB(B1, 0, 1); PG8_SCHED; PG8_LDA(At, 0, 0); PG8_STAGE(PG8_SA(1, 1), a1 + hstepA, voffA); \
            PG8_WAIT_V(8); PG8_WAIT_L(0); PG8_BAR; PG8_MMA(0, 0, At, B0); PG8_MMA(0, 1, At, B1); PG8_BAR; PG8_SCHED; \
            PG8_LDA(At, 0, 1); PG8_STAGE(PG8_SB(0, 0), b2, voffB); PG8_STAGE(PG8_SB(0, 1), b2 + hstepB, voffB); PG8_STAGE(PG8_SA(0, 0), a2, voffA); \
            PG8_WAIT_V(8); PG8_WAIT_L(0); PG8_BAR; PG8_MMA(1, 0, At, B0); PG8_MMA(1, 1, At, B1); PG8_BAR; PG8_SCHED; \
            PG8_LDB(B0, 1, 0); PG8_LDB(B1, 1, 1); PG8_SCHED; PG8_LDA(At, 1, 0); PG8_STAGE(PG8_SA(0, 1), a2 + hstepA, voffA); \
            PG8_WAIT_V(8); PG8_WAIT_L(0); PG8_BAR; PG8_MMA(0, 0, At, B0); PG8_MMA(0, 1, At, B1); PG8_BAR; PG8_SCHED; \
            PG8_LDA(At, 1, 1); PG8_STAGE(PG8_SB(1, 0), b3, voffB); PG8_STAGE(PG8_SB(1, 1), b3 + hstepB, voffB); PG8_STAGE(PG8_SA(1, 0), a3, voffA); \
            PG8_WAIT_V(8); PG8_WAIT_L(0); PG8_BAR; PG8_MMA(1, 0, At, B0); PG8_MMA(1, 1, At, B1); PG8_BAR; PG8_SCHED; \
        } while (0)
    Unit cur, nxt; int ui = 0;
    if (!S.next(0, cur)) return;
    Acc acc;
#pragma unroll
    for (int a = 0; a < 2; ++a)
#pragma unroll
        for (int b = 0; b < 2; ++b)
#pragma unroll
            for (int m = 0; m < 4; ++m)
#pragma unroll
                for (int n = 0; n < 2; ++n) acc[a][b][m][n] = (f32x4){0.f, 0.f, 0.f, 0.f};
    bf16x8 At[4][2], B0[2][2], B1[2][2];
    const char* cA = (const char*)g.A + (size_t)cur.pm * tstepA + (size_t)cur.ks * g.ksoff * 2; const char* cB = (const char*)g.Bt + (size_t)cur.pn * tstepB + (size_t)cur.ks * g.ksoff * 2;
    PG8_STAGE(PG8_SB(0, 0), cB, voffB); PG8_STAGE(PG8_SB(0, 1), cB + hstepB, voffB); PG8_STAGE(PG8_SA(0, 0), cA, voffA); PG8_STAGE(PG8_SA(0, 1), cA + hstepA, voffA);
    if (wr == 1) PG8_BAR;
    PG8_WAIT_V(2); PG8_BAR;
    PG8_STAGE(PG8_SB(1, 0), cB + kstep, voffB); PG8_STAGE(PG8_SA(1, 0), cA + kstep, voffA); PG8_STAGE(PG8_SB(1, 1), cB + hstepB + kstep, voffB);
    PG8_WAIT_V(6); PG8_BAR;
    for (;;) {
        const bool has_next = S.next(ui + 1, nxt);
        const char* nA = has_next ? (const char*)g.A + (size_t)nxt.pm * tstepA + (size_t)nxt.ks * g.ksoff * 2 : cA; const char* nB = has_next ? (const char*)g.Bt + (size_t)nxt.pn * tstepB + (size_t)nxt.ks * g.ksoff * 2 : cB;
        for (int t = 0; t < nt; t += 2) PG8_KBODY(t);
        if constexpr (ALIGN_EPI) { if (wr == 0) PG8_BAR; }
        E(acc, cur, wr, wc, fr, fq);
        if (!has_next) break;
        if (!E.keep(cur)) {
#pragma unroll
        for (int a = 0; a < 2; ++a)
#pragma unroll
            for (int b = 0; b < 2; ++b)
#pragma unroll
                for (int m = 0; m < 4; ++m)
#pragma unroll
                    for (int n = 0; n < 2; ++n) acc[a][b][m][n] = (f32x4){0.f, 0.f, 0.f, 0.f};
        }
        cur = nxt; cA = nA; cB = nB; ++ui;
        if constexpr (ALIGN_EPI) { if (wr == 1) PG8_BAR; }
    }
    PG8_WAIT_V(0);
    if constexpr (!ALIGN_EPI) { if (wr == 0) PG8_BAR; }
    PG8_BAR;
#undef PG8_SA
#undef PG8_SB
#undef PG8_STAGE
#undef PG8_LDA
#undef PG8_LDB
#undef PG8_MMA
#undef PG8_WAIT_V
#undef PG8_WAIT_L
#undef PG8_BAR
#undef PG8_SCHED
#undef PG8_KBODY
}
}

#define GAS __attribute__((address_space(1)))
#define LAS __attribute__((address_space(3)))
typedef unsigned v4u __attribute__((ext_vector_type(4)));
typedef float f32x4 __attribute__((ext_vector_type(4)));
constexpr int NWAVES = 8;
constexpr int LDS_BYTES = 163840;
constexpr size_t MiB = 1u << 20;
constexpr size_t WS_PSS = 1 * MiB, WS_WOUT = 2 * MiB, WS_P = 4 * MiB, WS_KC = 214 * MiB, WS_VC = 215 * MiB, WS_MIX = 216 * MiB;
constexpr size_t WS_AN = 4 * MiB, WS_UP = 64 * MiB, WS_WUP = 248 * MiB, WS_WDOWN = 200 * MiB;
constexpr size_t WS_BIAS1 = 131072 + 16384, WS_W1T = 214 * MiB, WS_KCB = 215 * MiB, WS_VCB = 215 * MiB + 512 * 1024;
constexpr size_t WS_GLV = 4096, WS_QCNT = 65536, WS_GW = 216 * MiB, DO_GQK = 40 * MiB, DO_HALO = 56 * MiB;
constexpr size_t WS_GTAB3 = 262144;
constexpr size_t WS_XBAR = 131072;
constexpr size_t DO_H = 0, DO_WG = 32 * MiB, DO_WCAT = 36 * MiB, DO_WIN = 40 * MiB;

__device__ __forceinline__ unsigned pk2(float lo, float hi) { return (unsigned)f2bf(lo) | ((unsigned)f2bf(hi) << 16); }
__device__ __forceinline__ float wave_sum(float v) {
#pragma unroll
    for (int o = 1; o < 64; o <<= 1) v += __shfl_xor(v, o);
    return v;
}
template <class SrcCol>
__device__ __forceinline__ void transpose_item(const float* W, int ldw, const SrcCol& srccol, bf16_t* WT, int ldk, int kofs, LAS float* scr, int kb, int nb, int lane, const float* ksc = nullptr) {
    const int k0 = 64 * kb, n0 = 64 * nb; const int n4 = (lane & 15) * 4; const int sc = srccol(n0 + n4);
    f32x4 v[16];
    const float* wp = W + (size_t)(k0 + (lane >> 4)) * ldw + (sc >= 0 ? sc : 0);
#pragma unroll
    for (int i = 0; i < 16; ++i) v[i] = *(const f32x4*)(wp + (size_t)(4 * i) * ldw);
#pragma unroll
    for (int i = 0; i < 16; ++i) { const int kk = 4 * i + (lane >> 4); const f32x4 u = (sc >= 0) ? v[i] : (f32x4){0.f, 0.f, 0.f, 0.f};
        scr[kk * 65 + n4] = u[0]; scr[kk * 65 + n4 + 1] = u[1]; scr[kk * 65 + n4 + 2] = u[2]; scr[kk * 65 + n4 + 3] = u[3]; }
    asm volatile("s_waitcnt lgkmcnt(0)" ::: "memory");
    const int c = lane & 7;
    f32x4 ga = {1.f, 1.f, 1.f, 1.f}, gb = ga;
    if (ksc) { ga = *(const f32x4*)(ksc + k0 + 8 * c); gb = *(const f32x4*)(ksc + k0 + 8 * c + 4); }
#pragma unroll
    for (int j = 0; j < 8; ++j) { const int n = (lane >> 3) + 8 * j; const LAS float* sp = scr + (8 * c) * 65 + n;
        v4u o; o.x = pk2(sp[0 * 65] * ga[0], sp[1 * 65] * ga[1]); o.y = pk2(sp[2 * 65] * ga[2], sp[3 * 65] * ga[3]); o.z = pk2(sp[4 * 65] * gb[0], sp[5 * 65] * gb[1]); o.w = pk2(sp[6 * 65] * gb[2], sp[7 * 65] * gb[3]);
        *(v4u*)(WT + (size_t)(n0 + n) * ldk + kofs + k0 + 8 * c) = o; }
    asm volatile("s_waitcnt lgkmcnt(0)" ::: "memory");
}
struct SrcIdent { int off; __device__ __forceinline__ int operator()(int n) const { return n + off; } };
struct SrcWin { __device__ __forceinline__ int operator()(int n) const { return n < 4096 ? n : (n < 6656 ? n + 16 : (n < 6672 ? n - 6656 + 4096 : (n < 6720 ? n : -1))); } };

typedef GAS unsigned gu32;
#define RLX_AGENT __ATOMIC_RELAXED, __HIP_MEMORY_SCOPE_AGENT
#define XB_TMO      128
#define XB_XCNT(j)  (256  + 64 * (j))
#define XB_XSUB(j)  (1280 + 64 * (j))
#define XB_XGEN(j)  (2304 + 64 * (j))
#define XB_TOP      3328
#define XB_TOPGEN   3392
#define XCD_BAR_WORDS 3456
#define XB_SPIN_CAP (1u << 18)

__device__ __forceinline__ unsigned xb_ld(unsigned* p)              { return __hip_atomic_load(p, __ATOMIC_RELAXED, __HIP_MEMORY_SCOPE_AGENT); }
__device__ __forceinline__ unsigned xb_add(unsigned* p, unsigned v) { return __hip_atomic_fetch_add(p, v, __ATOMIC_RELAXED, __HIP_MEMORY_SCOPE_AGENT); }
__device__ __forceinline__ unsigned xb_xcc_id() { return (unsigned)__builtin_amdgcn_s_getreg((3 << 11) | 20) & 0xFu; }
#define XB_SPIN(cond, bar) do { unsigned _sp = 0; while (cond) { __builtin_amdgcn_s_sleep(1); \
    if ((++_sp & 255u) == 0u) { if (xb_ld(&(bar)[XB_TMO])) break; if (_sp > XB_SPIN_CAP) { atomicAdd(&(bar)[XB_TMO], 1u); break; } } } } while (0)

struct XcdBarrier {
    unsigned* bar; unsigned x;
    volatile LAS unsigned* st;
};

__device__ __forceinline__ XcdBarrier xcd_barrier_post(unsigned* bar, volatile LAS unsigned* st) {
    XcdBarrier b; b.bar = bar; b.x = xb_xcc_id(); b.st = st;
    if (threadIdx.x == 0) (void)xb_add(&bar[XB_XCNT(b.x)], 1u);
    return b;
}
__device__ __forceinline__ void xcd_barrier_complete(unsigned* bar, unsigned x, unsigned& nloc, unsigned& nx) {
    const unsigned G = gridDim.x * gridDim.y * gridDim.z;
    unsigned sum, cnt, mine, sp = 0u;
    for (;;) {
        sum = 0u; cnt = 0u; mine = 0u;
#pragma unroll
        for (unsigned j = 0; j < 16; ++j) { const unsigned c = xb_ld(&bar[XB_XCNT(j)]); sum += c; cnt += (c > 0u) ? 1u : 0u; mine = (j == x) ? c : mine; }
        if (sum == G) break;
        __builtin_amdgcn_s_sleep(1);
        if ((++sp & 255u) == 0u) { if (xb_ld(&bar[XB_TMO])) break; if (sp > XB_SPIN_CAP) { atomicAdd(&bar[XB_TMO], 1u); break; } }
    }
    nloc = mine > 0u ? mine : 1u; nx = cnt > 0u ? cnt : 1u;
}

__device__ __forceinline__ void xcd_barrier(const XcdBarrier& b) {
    asm volatile("s_waitcnt vmcnt(0)" ::: "memory");
    __syncthreads();
    if (threadIdx.x == 0) {
        unsigned* bar = b.bar;
        __builtin_amdgcn_s_waitcnt(0);
        unsigned nloc = b.st[0], nx = b.st[1];
        if (nloc == 0u) { xcd_barrier_complete(bar, b.x, nloc, nx); b.st[0] = nloc; b.st[1] = nx; }
        const unsigned old = xb_add(&bar[XB_XSUB(b.x)], 1u);
        const unsigned gen = old / nloc;
        if (old + 1u == (gen + 1u) * nloc) {
            __builtin_amdgcn_fence(__ATOMIC_RELEASE, "agent");
            asm volatile("s_waitcnt vmcnt(0)" ::: "memory");
            const unsigned og = xb_add(&bar[XB_TOP], 1u);
            const unsigned tg = og / nx;
            if (og + 1u == (tg + 1u) * nx) xb_add(&bar[XB_TOPGEN], 1u);
            else XB_SPIN(xb_ld(&bar[XB_TOPGEN]) == tg, bar);
            __builtin_amdgcn_fence(__ATOMIC_ACQUIRE, "agent");
            xb_add(&bar[XB_XGEN(b.x)], 1u);
            asm volatile("s_waitcnt vmcnt(0)" ::: "memory");
        } else {
            XB_SPIN(xb_ld(&bar[XB_XGEN(b.x)]) == gen, bar);
            __builtin_amdgcn_fence(__ATOMIC_ACQUIRE, "agent");
            asm volatile("s_waitcnt vmcnt(0)" ::: "memory");
        }
    }
    __syncthreads();
}


struct Args { const float* in[23]; float* out; unsigned char* ws; int ph_lo, ph_hi; };

__global__ void __launch_bounds__(NWAVES * 64, 2) mk_fwd(Args args) {
    extern __shared__ __attribute__((aligned(16))) unsigned char lds_raw[];
    LAS unsigned char* lds = (LAS unsigned char*)lds_raw;
    __builtin_assume(__builtin_amdgcn_workitem_id_y() == 0); __builtin_assume(__builtin_amdgcn_workitem_id_z() == 0);
    cg::grid_group grid = cg::this_grid();
    const int wave = __builtin_amdgcn_readfirstlane((int)threadIdx.x >> 6);
#define tid ((int)threadIdx.x)
#define lane ((int)(threadIdx.x & 63u))
    const int G = gridDim.x, gw = blockIdx.x * NWAVES + wave, NGW = G * NWAVES;
    unsigned char* ws = args.ws; unsigned char* dob = (unsigned char*)args.out;
    const float* x = args.in[0];
    bf16_t* P = (bf16_t*)(ws + WS_P);
    bf16_t* Hb = (bf16_t*)(dob + DO_H); bf16_t* Wg_t = (bf16_t*)(dob + DO_WG); bf16_t* Wcat_t = (bf16_t*)(dob + DO_WCAT); bf16_t* Win_t = (bf16_t*)(dob + DO_WIN);
    bf16_t* Wout_t = (bf16_t*)(ws + WS_WOUT); bf16_t* Wup_t = (bf16_t*)(ws + WS_WUP); bf16_t* Wdown_t = (bf16_t*)(ws + WS_WDOWN);
    bf16_t* Mix = (bf16_t*)(ws + WS_MIX); bf16_t* An = (bf16_t*)(ws + WS_AN); bf16_t* Up = (bf16_t*)(ws + WS_UP); float* pss = (float*)(ws + WS_PSS);
    LAS float* scr = (LAS float*)(lds + wave * 17408);
    bf16_t* Halo = (bf16_t*)(dob + DO_HALO); bf16_t* GWb = (bf16_t*)(ws + WS_GW); bf16_t* GQKb = (bf16_t*)(dob + DO_GQK); float* GLv = (float*)(ws + WS_GLV); unsigned* qcnt = (unsigned*)(ws + WS_QCNT);
    bf16_t* W1T = (bf16_t*)(ws + WS_W1T); float* bias1 = (float*)(ws + WS_BIAS1); bf16_t* KCb = (bf16_t*)(ws + WS_KCB); bf16_t* VCb = (bf16_t*)(ws + WS_VCB);
    float* gtab3 = (float*)(ws + WS_GTAB3);
    const int lo = args.ph_lo, hi = args.ph_hi;
    if (tid < 2) ((volatile LAS unsigned*)(lds + LDS_BYTES - 32))[tid] = 0u;
    __syncthreads();
    XcdBarrier xbar = xcd_barrier_post((unsigned*)(ws + WS_XBAR), (volatile LAS unsigned*)(lds + LDS_BYTES - 32));
    if (args.ph_hi > 1000) grid.sync();
#ifndef PHMASK
#define PHMASK 0x1ff
#endif
#define IN(k) (((PHMASK >> (k)) & 1) && lo <= (k) && (k) < hi)
#define GRID_SYNC() do { asm volatile("s_waitcnt vmcnt(0) lgkmcnt(0)" ::: "memory"); grid.sync(); \
        if (wave == 0) { __builtin_amdgcn_fence(__ATOMIC_ACQUIRE, "agent"); asm volatile("s_waitcnt vmcnt(0)" ::: "memory"); } __syncthreads(); } while (0)
#define SEAM(k) do { if (IN(k) && IN((k) + 1)) xcd_barrier(xbar); } while (0)

    if (IN(0)) {
        if (blockIdx.x == 0 && tid == 0) { *qcnt = 0u; ((volatile unsigned*)(ws + 786432))[4] = 0u; }
        if (blockIdx.x == 1 && tid < 192) gtab3[tid] = tid < 64 ? args.in[7][tid] * (0.125f * nsa::LOG2E) : (tid < 128 ? args.in[9][tid - 64] : args.in[10][tid - 128]);
        constexpr int I_WIN = 16 * (NP1 / 64), I_WG = 16 * 32, I_DN = 16 * 16, I_OUT = 16 * 16, I_UP = 16 * 64;
        constexpr int I_W1 = 32 * 2, I_B1 = 64;
        constexpr int NITEMS = I_WIN + 2 * I_W1 + I_B1;
        for (int it = gw; it < NITEMS; it += NGW) {
            int r = it;
            if (r < I_WIN) { transpose_item(args.in[2], INW, SrcWin{}, Win_t, D, 0, scr, r / (NP1 / 64), r % (NP1 / 64), lane); continue; } r -= I_WIN;
            if (r < I_W1) { transpose_item(args.in[12], 128, SrcIdent{0}, W1T, 2048, 0, scr, r / 2, r % 2, lane); continue; } r -= I_W1;
            if (r < I_W1) { transpose_item(args.in[15], 128, SrcIdent{0}, W1T + 128 * 2048, 2048, 0, scr, r / 2, r % 2, lane); continue; } r -= I_W1;
            {
                const int which = r >> 5, kc = r & 31; const float* pos = args.in[which ? 14 : 11] + kc * 64; const float* w1 = args.in[which ? 15 : 12] + (size_t)kc * 64 * 128 + 2 * lane;
                float a0 = 0.f, a1 = 0.f;
#pragma unroll 16
                for (int k = 0; k < 64; ++k) { const float pk_ = pos[k]; const float2 w = *(const float2*)(w1 + (size_t)k * 128); a0 += pk_ * w.x; a1 += pk_ * w.y; }
                atomicAdd(bias1 + which * 128 + 2 * lane, a0); atomicAdd(bias1 + which * 128 + 2 * lane + 1, a1);
            }
        }
        const float* gain = args.in[1];
        f32x4 gv[4];
#pragma unroll
        for (int j = 0; j < 4; ++j) gv[j] = ((const f32x4*)gain)[lane + 64 * j];
        for (int m = gw; m < M; m += 2 * NGW) {
            const int m2 = (m + NGW < M) ? m + NGW : m;
            const f32x4* xr = (const f32x4*)(x + (size_t)m * D) + lane; const f32x4* xr2 = (const f32x4*)(x + (size_t)m2 * D) + lane;
            f32x4 v[4], u[4]; float s1 = 0.f, s2 = 0.f;
#pragma unroll
            for (int j = 0; j < 4; ++j) { v[j] = xr[64 * j]; u[j] = xr2[64 * j]; }
#pragma unroll
            for (int j = 0; j < 4; ++j) { s1 += (v[j].x * v[j].x + v[j].y * v[j].y) + (v[j].z * v[j].z + v[j].w * v[j].w); s2 += (u[j].x * u[j].x + u[j].y * u[j].y) + (u[j].z * u[j].z + u[j].w * u[j].w); }
            const float r1 = rsqrtf(wave_sum(s1) * (1.f / D) + EPS), r2 = rsqrtf(wave_sum(s2) * (1.f / D) + EPS);
            unsigned long long* o8 = (unsigned long long*)(Hb + (size_t)m * D) + lane; unsigned long long* o9 = (unsigned long long*)(Hb + (size_t)m2 * D) + lane;
#pragma unroll
            for (int j = 0; j < 4; ++j) { const f32x4 y = v[j] * r1 * gv[j]; o8[64 * j] = (unsigned long long)pk2(y.x, y.y) | ((unsigned long long)pk2(y.z, y.w) << 32); }
            if (m2 != m) {
#pragma unroll
                for (int j = 0; j < 4; ++j) { const f32x4 y = u[j] * r2 * gv[j]; o9[64 * j] = (unsigned long long)pk2(y.x, y.y) | ((unsigned long long)pk2(y.z, y.w) << 32); } }
        }
    }
    SEAM(0);
    if (IN(1)) {
        pg8::Gemm g{Hb, Win_t, D, D, M, NP1, D, 0}; pg8::StaticOrder S; S.init(M, NP1, G, (int)blockIdx.x);
        pg8::EpiP3 E{P, LDP, 26, 64, Halo, gtab3};
        pg8::gemm_phase<pg8::EpiP3, pg8::StaticOrder, true>(lds, g, S, E);
        {
            constexpr int I_WG = 16 * 32, I_DN = 16 * 16, I_OUT = 16 * 16, I_UP = 16 * 64, NT = I_WG + 2 * I_DN + I_OUT + I_UP;
            const int nwg = (M / 256) * (NP1 / 256), maxu = (nwg + G - 1) / G, thr = nwg - (maxu - 1) * G;
            const int nsl = (thr < G) ? G - thr : G, sidx = (thr < G) ? (int)blockIdx.x - thr : (int)blockIdx.x;
            if (sidx >= 0) for (int it = sidx * NWAVES + wave; it < NT; it += nsl * NWAVES) {
                int r = it;
                if (r < I_WG) { transpose_item(args.in[2], INW, SrcIdent{6720}, Wg_t, D, 0, scr, r / 32, r % 32, lane); continue; } r -= I_WG;
                if (r < I_DN) { transpose_item(args.in[17], D, SrcIdent{0}, Wcat_t, 2 * D, 0, scr, r / 16, r % 16, lane); continue; } r -= I_DN;
                if (r < I_DN) { transpose_item(args.in[18], D, SrcIdent{0}, Wcat_t, 2 * D, D, scr, r / 16, r % 16, lane); continue; } r -= I_DN;
                if (r < I_OUT) { transpose_item(args.in[19], D, SrcIdent{0}, Wout_t, D, 0, scr, r / 16, r % 16, lane); continue; } r -= I_OUT;
                transpose_item(args.in[21], FF, SrcIdent{0}, Wup_t, D, 0, scr, r / 64, r % 64, lane, args.in[20]);
            }
        }
    }
    SEAM(1);
    if (IN(2)) {
        for (int it = (G == 256) ? (((int)blockIdx.x & 1) ? 128 : (int)blockIdx.x >> 1) : (int)blockIdx.x; it < 128; it += G) {
            const int half = it & 1, which = (it >> 1) & 1, g_ = (it >> 2) & 3, b_ = it >> 4;
            nsa::compress_item(lds, P, W1T + (size_t)which * 128 * 2048, bias1 + which * 128, args.in[which ? 16 : 13], args.in[8], which ? VCb : KCb, b_, g_, which, half);
        }
        __syncthreads();
        {
            gdn::RowPre pre; int hl = -1;
            const int c_ = (int)blockIdx.x, hq = c_ >> 5, jq = c_ & 31;
            const bool bal = (G == 256);
            const int cnt = bal ? ((jq & 1) ? 9 : 7) : (2048 - c_ + G - 1) / G;
            const int first = bal ? ((jq & 1) ? 112 + 9 * (jq >> 1) : 7 * (jq >> 1)) : 0;
#define PREP_COORD(k, b_, n_, h_) do { if (bal) { const int idx_ = first + (k); b_ = idx_ >> 5; n_ = idx_ & 31; h_ = hq; } else { const int it_ = c_ + (k) * G; b_ = it_ >> 8; n_ = it_ & 31; h_ = (it_ >> 5) & 7; } } while (0)
            int b0, n0, h0;
            if (cnt > 0) { PREP_COORD(0, b0, n0, h0); gdn::prep_prefetch(pre, P, Halo, b0, n0, h0, wave, lane); }
            for (int k = 0; k < cnt; ++k) {
                int bc, nc, hc, bn = -1, nn = 0, hn = 0;
                PREP_COORD(k, bc, nc, hc);
                if (k + 1 < cnt) PREP_COORD(k + 1, bn, nn, hn);
                if (hc != hl) { __syncthreads(); gdn::prep_load_taps(lds, args.in[3], hc); hl = hc; __syncthreads(); }
                gdn::prep_item(lds, P, Halo, args.in[4], args.in[5], GWb, GQKb, GLv, pre, bc, nc, hc, bn, nn, hn);
            }
#undef PREP_COORD
        }
    }
    SEAM(2);
    if (IN(3)) {
        for (int item = (int)blockIdx.x; item < BATCH * DN_H; item += G) gdn::scan_item(lds, P, GWb, GQKb, GLv, args.in[6], item >> 3, item & 7);
        __syncthreads();
        unsigned qnext = 0u;
        if (tid == 0) qnext = atomicAdd(qcnt, 1u);
        {
            volatile LAS unsigned* qslot = (volatile LAS unsigned*)(lds + LDS_BYTES - 16);
            nsa::bf16x8 qfr[4] = {}; unsigned short gq[3] = {0, 0, 0}; bool pre = false; int idx = -1;
            for (;;) {
                if (idx < 0) { if (tid == 0) *qslot = qnext; __syncthreads(); idx = (int)*qslot; pre = false; __syncthreads(); }
                if (idx >= 1024) break;
                int idxn = -1;
                nsa::attn_tile(lds, P, KCb, VCb, (idx & 31) >> 2, idx & 3, 31 - (idx >> 5), qcnt, qnext, pre, qfr, gq, idxn);
                idx = idxn; pre = (idxn >= 0 && idxn < 1024);
            }
        }
    }
    SEAM(3);
    if (IN(4)) {
        pg8::Gemm g{Hb, Wg_t, D, D, M, 2048, D, 0}; pg8::GatePairOrder S; S.base.init(M, D, G, (int)blockIdx.x);
        pg8::EpiP<1> E{P, LDP, -1, 256, nullptr};
        pg8::gemm_phase<pg8::EpiP<1>, pg8::GatePairOrder, true>(lds, g, S, E);
    }
    if (IN(4) && IN(5)) { asm volatile("s_waitcnt vmcnt(0)" ::: "memory"); __syncthreads(); }
    if (IN(5)) {
        pg8::Gemm g{P + C_DZ, Wcat_t, LDP, 2 * D, M, D, D, D}; pg8::TwoPassOrder S; S.base.init(M, D, G, (int)blockIdx.x);
        pg8::EpiMix E{P, LDP, Mix, D};
        pg8::gemm_phase<pg8::EpiMix, pg8::TwoPassOrder, false>(lds, g, S, E);
    }
    SEAM(5);
    if (IN(6)) {
        for (int it = gw; it < 64 * 16; it += NGW) transpose_item(args.in[22], D, SrcIdent{0}, Wdown_t, FF, 0, scr, it / 16, it % 16, lane);
        __syncthreads();
        pg8::Gemm g{Mix, Wout_t, D, D, M, D, D, 0}; pg8::StaticOrder S; S.init(M, D, G, (int)blockIdx.x);
        pg8::EpiOut E{x, An, pss};
        pg8::gemm_phase<pg8::EpiOut, pg8::StaticOrder, false>(lds, g, S, E);
    }
    SEAM(6);
    if (IN(7)) {
        pg8::Gemm g{An, Wup_t, D, D, M, FF, D, 0}; pg8::IndexedOrder S; S.base.init(M, FF, G, (int)blockIdx.x);
        LAS float* rtab = (LAS float*)(lds + 131072);
        int nu = 0; { pg8::Unit u_; while (nu < 13 && S.next(nu, u_)) ++nu; }
        const bool use_tab = nu <= 12;
        if (use_tab) for (int i0 = 0; i0 < nu; i0 += 4) {
            f32x4 sa[4], sb[4]; const int r = tid >> 1;
#pragma unroll
            for (int k = 0; k < 4; ++k) { pg8::Unit u_; const bool ok = (i0 + k < nu) && S.next(i0 + k, u_);
                const f32x4* pp = (const f32x4*)(pss + ((size_t)(ok ? u_.pm : 0) * 256 + r) * 16) + 2 * (tid & 1); sa[k] = pp[0]; sb[k] = pp[1]; }
#pragma unroll
            for (int k = 0; k < 4; ++k) { const f32x4 s4 = sa[k] + sb[k];
                float sm = (s4[0] + s4[1]) + (s4[2] + s4[3]); sm += __shfl_xor(sm, 1);
                if ((tid & 1) == 0 && i0 + k < nu) rtab[(i0 + k) * 256 + r] = rsqrtf(sm * (1.f / D) + EPS); } }
        __syncthreads();
        pg8::EpiUp E{pss, Up, FF, use_tab ? (const PG8_LAS float*)rtab : (const PG8_LAS float*)nullptr};
        pg8::gemm_phase<pg8::EpiUp, pg8::IndexedOrder, true>(lds, g, S, E);
    }
    SEAM(7);
    if (IN(8)) {
        pg8::Gemm g{Up, Wdown_t, FF, FF, M, D, FF, 0}; pg8::StaticOrder S; S.init(M, D, G, (int)blockIdx.x);
        pg8::EpiDown E{An, args.out};
        pg8::gemm_phase<pg8::EpiDown, pg8::StaticOrder, false>(lds, g, S, E);
    }
#undef IN
#undef SEAM
#undef GRID_SYNC
}

#undef lane
#undef tid
static int g_grid = 0;
static void launch_mk(const Args& a0, int lo, int hi, hipStream_t stream) {
    Args a = a0; a.ph_lo = lo; a.ph_hi = hi;
    void* kargs[] = {(void*)&a};
    hipError_t e = hipLaunchCooperativeKernel((const void*)mk_fwd, dim3(g_grid), dim3(NWAVES * 64), kargs, LDS_BYTES, stream);
    if (e != hipSuccess) fprintf(stderr, "cooperative launch failed: %s (grid %d)\n", hipGetErrorString(e), g_grid);
}

extern "C" void kernel_launch(void* const* d_in, const int* in_sizes, int n_in, void* d_out, int out_size, void* d_ws, size_t ws_size, hipStream_t stream) {
    if (g_grid == 0) {
        int dev = 0, cus = 0, per_cu = 0;
        hipGetDevice(&dev);
        hipDeviceGetAttribute(&cus, hipDeviceAttributeMultiprocessorCount, dev);
        hipFuncSetAttribute((const void*)mk_fwd, hipFuncAttributeMaxDynamicSharedMemorySize, LDS_BYTES);
        hipOccupancyMaxActiveBlocksPerMultiprocessor(&per_cu, (const void*)mk_fwd, NWAVES * 64, LDS_BYTES);
        if (per_cu < 1) per_cu = 1;
        if (per_cu > 1) per_cu = 1;
        g_grid = cus * per_cu;
    }
    Args a{};
    for (int i = 0; i < 23; ++i) a.in[i] = (const float*)d_in[i];
    a.out = (float*)d_out; a.ws = (unsigned char*)d_ws;
    bf16_t* P = (bf16_t*)((char*)d_ws + WS_P);
    hipMemsetAsync((char*)d_ws + WS_XBAR, 0, 16384 + 1024, stream);
    launch_mk(a, 0, 9, stream);
}
```

```cpp
#include <hip/hip_runtime.h>
#include <hip/hip_cooperative_groups.h>
#include <stdint.h>
#include <cstdio>
namespace cg = cooperative_groups;

typedef unsigned short bf16_t;

constexpr int D = 1024, BATCH = 8, SEQ = 2048, M = BATCH * SEQ;
constexpr int DN_H = 8, DN_D = 128;
constexpr int NS_H = 16, NS_G = 4, NS_R = 4, NS_D = 64;
constexpr int NCMP = 127, NSEL = 32;
constexpr int FF = 4096;
constexpr int INW = 8768;
constexpr float EPS = 1e-6f;
constexpr float NEGV = -1e30f, FORCEV = 1e9f;

constexpr int LDP = 6720;
constexpr int C_DQ = 0, C_DK = 1024, C_DV = 2048, C_DZ = 3072, C_NQ = 4096;
constexpr int C_KC = 5120, C_VC = 5376, C_KS = 5632, C_VS = 5888, C_KW = 6144, C_VW = 6400;
constexpr int C_SB = 6656, C_SA = 6664, C_SG = 6672;
constexpr int NP1 = 6912;

__device__ __forceinline__ float bf2f(bf16_t v) { return __uint_as_float(((unsigned)v) << 16); }
__device__ __forceinline__ bf16_t f2bf(float f) { unsigned u = __float_as_uint(f); return (bf16_t)((u + 0x7fffu + ((u >> 16) & 1u)) >> 16); }
__device__ __forceinline__ float sigmoidf_(float x) { return 1.f / (1.f + __expf(-x)); }
__device__ __forceinline__ float siluf_(float x) { return x * sigmoidf_(x); }
__device__ __forceinline__ float softplusf_(float x) { return fmaxf(x, 0.f) + log1pf(__expf(-fabsf(x))); }
__device__ __forceinline__ float gelu_tanh(float x) { return 0.5f * x * (1.f + tanhf(0.7978845608028654f * (x + 0.044715f * x * x * x))); }

__device__ __forceinline__ float block_sum(float v, float* red) {
    for (int o = 32; o > 0; o >>= 1) v += __shfl_xor(v, o);
    const int w = threadIdx.x >> 6, nw = blockDim.x >> 6;
    __syncthreads();
    if ((threadIdx.x & 63) == 0) red[w] = v;
    __syncthreads();
    float s = 0.f;
    for (int i = 0; i < nw; ++i) s += red[i];
    return s;
}
__device__ __forceinline__ float block_max(float v, float* red) {
    for (int o = 32; o > 0; o >>= 1) v = fmaxf(v, __shfl_xor(v, o));
    const int w = threadIdx.x >> 6, nw = blockDim.x >> 6;
    __syncthreads();
    if ((threadIdx.x & 63) == 0) red[w] = v;
    __syncthreads();
    float s = red[0];
    for (int i = 1; i < nw; ++i) s = fmaxf(s, red[i]);
    return s;
}


namespace gdn {
#define GL3 __attribute__((address_space(3)))
typedef short bf16x8 __attribute__((ext_vector_type(8)));
typedef short s16x4 __attribute__((ext_vector_type(4)));
typedef short v4i16_t __attribute__((ext_vector_type(4)));
typedef float f32x16 __attribute__((ext_vector_type(16)));
typedef float f32x4 __attribute__((ext_vector_type(4)));
typedef float f32x2 __attribute__((ext_vector_type(2)));
typedef unsigned u32x4 __attribute__((ext_vector_type(4)));
typedef unsigned u32x2 __attribute__((ext_vector_type(2)));
typedef __bf16 bf16x2_t __attribute__((ext_vector_type(2)));
constexpr float QSCALE = 0.08838834764831845f;
__device__ __forceinline__ float fsig(float x) { return __builtin_amdgcn_rcpf(1.f + __builtin_amdgcn_exp2f(-1.4426950408889634f * x)); }
__device__ __forceinline__ float fsilu(float x) { return x * fsig(x); }
__device__ __forceinline__ int crow(int i, int hi) { return (i & 3) + 8 * (i >> 2) + 4 * hi; }
__device__ __forceinline__ unsigned pk(float lo, float hi) { f32x2 v = {lo, hi}; bf16x2_t b = __builtin_convertvector(v, bf16x2_t); return __builtin_bit_cast(unsigned, b); }
__device__ __forceinline__ bf16x8 pack8(const float* v) { u32x4 w = {pk(v[0], v[1]), pk(v[2], v[3]), pk(v[4], v[5]), pk(v[6], v[7])}; return __builtin_bit_cast(bf16x8, w); }
__device__ __forceinline__ float dot2bf(float acc, unsigned xw, unsigned ww) { return __builtin_amdgcn_fdot2_f32_bf16(__builtin_bit_cast(bf16x2_t, xw), __builtin_bit_cast(bf16x2_t, ww), acc, false); }
__device__ __forceinline__ float blo(unsigned w) { return __uint_as_float(w << 16); }
__device__ __forceinline__ float bhi(unsigned w) { return __uint_as_float(w & 0xffff0000u); }
__device__ __forceinline__ char* seg_addr(bf16_t* P, size_t row0, int c0, unsigned e) { return (char*)P + ((row0 + (e >> 8)) * LDP + c0) * 2 + (e & 255u); }

__device__ __forceinline__ s16x4 vtr(GL3 const unsigned char* p) { return __builtin_bit_cast(s16x4, __builtin_amdgcn_ds_read_tr16_b64_v4i16((GL3 v4i16_t*)p)); }

constexpr int PL_CS = 1040, PL_RS = 4160;
constexpr int PL_K = 0, PL_KB = 16640, PL_Q = 33280, PL_RV = 49920, PL_AM = 83200, PL_INV = 100608, PL_MT = 118016, PL_GC = 122112, PL_QKST = 122368, PL_TI = 130560, PL_CW = 138752, PL_END = 144896;
constexpr int PL_INVT = 144896;
constexpr int PL_WST = 0, PL_UST = 16384;
constexpr int AMLD = 68;
struct RowPre { u32x4 x[3][5]; unsigned short lb, la; };
__device__ __forceinline__ void prep_prefetch(RowPre& pre, const bf16_t* P, const bf16_t* HALO, int b, int n, int h, int wid, int lane) {
    const size_t row0 = (size_t)b * SEQ + 64 * n; const int dc = lane & 15;
    const bf16_t* prow = P + (row0 + lane) * LDP;
    pre.lb = prow[C_SB + h]; pre.la = prow[C_SA + h];
    const int col = h * 128 + dc * 8;
    const int r0 = 2 * (4 * wid + (lane >> 4)) - 3;
    if (wid == 0) {
        const bf16_t* src[5];
#pragma unroll
        for (int k = 0; k < 5; ++k) {
            const int rr = r0 + k; const bool inb = rr >= 0;
            src[k] = inb ? (P + (row0 + (inb ? rr : 0)) * LDP + col) : (HALO + ((size_t)((b * 32 + (n > 0 ? n - 1 : 0)) * 3 + (inb ? 0 : 3 + rr))) * 3072 + col);
            asm volatile("" : "+v"(src[k]));
        }
#pragma unroll
        for (int k = 0; k < 5; ++k)
#pragma unroll
            for (int which = 0; which < 3; ++which) pre.x[which][k] = *(const __attribute__((address_space(1))) u32x4*)(src[k] + which * 1024);
    } else {
        const bf16_t* base = P + (row0 + r0) * LDP + col;
#pragma unroll
        for (int k = 0; k < 5; ++k) { const bf16_t* rp = base + (size_t)k * LDP;
#pragma unroll
            for (int which = 0; which < 3; ++which) pre.x[which][k] = *(const u32x4*)(rp + which * 1024); }
    }
}
__device__ __forceinline__ void prep_load_taps(GL3 unsigned char* lds, const float* convw, int h) {
    GL3 unsigned* cw = (GL3 unsigned*)(lds + 138752);
    for (int e = threadIdx.x; e < 1536; e += 512) { const int which = e >> 9, j = (e >> 7) & 3, c = e & 127; const unsigned wb = f2bf(convw[j * 3072 + which * 1024 + h * 128 + c]); cw[e] = (c & 1) ? (wb << 16) : wb; }
}
#define PBAR() do { asm volatile("s_waitcnt lgkmcnt(0)" ::: "memory"); __builtin_amdgcn_s_barrier(); asm volatile("" ::: "memory"); } while (0)
__device__ __forceinline__ void prep_item(GL3 unsigned char* lds, bf16_t* P, const bf16_t* HALO, const float* a_log, const float* dt_bias,
                                          bf16_t* GW, bf16_t* GQK, float* GLv, RowPre& pre, int b, int n, int h, int nb_, int nn_, int nh_) {
    int tid = threadIdx.x; asm volatile("" : "+v"(tid));
    const int lane = tid & 63, r32 = lane & 31, hi = lane >> 5; const int wid = __builtin_amdgcn_readfirstlane(tid >> 6);
    const size_t row0 = (size_t)b * SEQ + 64 * n; const int item = (b * DN_H + h) * 32 + n;
    GL3 float* AM = (GL3 float*)(lds + PL_AM); GL3 float* INV = (GL3 float*)(lds + PL_INV); GL3 float* MT = (GL3 float*)(lds + PL_MT); GL3 float* GC = (GL3 float*)(lds + PL_GC);
    GL3 float* INVT = (GL3 float*)(lds + PL_INVT);
    float gcum, beta_l, gc_last;
    {
        beta_l = fsig(bf2f(pre.lb));
        { const float xs = bf2f(pre.la) + dt_bias[h]; gcum = -__expf(a_log[h]) * (fmaxf(xs, 0.f) + __logf(1.f + __expf(-fabsf(xs)))); }
#define DPPSCAN(ctl_) gcum += __builtin_bit_cast(float, __builtin_amdgcn_update_dpp(0, __builtin_bit_cast(int, gcum), ctl_, 0xF, 0xF, true))
        DPPSCAN(0x111); DPPSCAN(0x112); DPPSCAN(0x114); DPPSCAN(0x118);
#undef DPPSCAN
        gcum += __builtin_bit_cast(float, __builtin_amdgcn_update_dpp(0, __builtin_bit_cast(int, gcum), 0x142, 0xA, 0xF, false));
        gcum += __builtin_bit_cast(float, __builtin_amdgcn_update_dpp(0, __builtin_bit_cast(int, gcum), 0x143, 0xC, 0xF, false));
        gc_last = __builtin_bit_cast(float, __builtin_amdgcn_readlane(__builtin_bit_cast(int, gcum), 63));
        if (wid == 0) GC[lane] = gcum;
    }
    if (n == 0 && wid == 0) {
        asm volatile("" ::: "memory");
        const int r0 = 2 * (lane >> 4) - 3;
#pragma unroll
        for (int which = 0; which < 3; ++which)
#pragma unroll
            for (int k = 0; k < 3; ++k) if (r0 + k < 0) pre.x[which][k] = (u32x4){0u, 0u, 0u, 0u};
    }
    bf16x8 qd_keep[2], ke_keep[2];
    const int dc = lane & 15;
#pragma unroll
    for (int pass = 0; pass < 2; ++pass) {
        const int tok = 2 * (4 * wid + (lane >> 4)) + pass;
        const float gct = __shfl(gcum, tok), bet = __shfl(beta_l, tok);
        float y[3][8];
#pragma unroll
        for (int which = 0; which < 3; ++which) {
#pragma unroll
            for (int e = 0; e < 8; ++e) y[which][e] = 0.f;
#pragma unroll
            for (int j = 0; j < 4; ++j) {
                const int rr = tok - 3 + j;
                u32x4 x = pre.x[which][j + pass];
                const u32x4 w0 = *(GL3 const u32x4*)(lds + PL_CW + ((which * 4 + j) * 128 + dc * 8) * 4), w1 = *(GL3 const u32x4*)(lds + PL_CW + ((which * 4 + j) * 128 + dc * 8 + 4) * 4);
#define DOT2(acc_, xw_, ww_) acc_ = dot2bf(acc_, xw_, ww_)
                DOT2(y[which][0], x.x, w0[0]); DOT2(y[which][1], x.x, w0[1]); DOT2(y[which][2], x.y, w0[2]); DOT2(y[which][3], x.y, w0[3]);
                DOT2(y[which][4], x.z, w1[0]); DOT2(y[which][5], x.z, w1[1]); DOT2(y[which][6], x.w, w1[2]); DOT2(y[which][7], x.w, w1[3]);
#undef DOT2
            }
#pragma unroll
            for (int e = 0; e < 8; ++e) y[which][e] = fsilu(y[which][e]);
        }
        float sq = 0.f, sk = 0.f;
#pragma unroll
        for (int e = 0; e < 8; ++e) { sq += y[0][e] * y[0][e]; sk += y[1][e] * y[1][e]; }
#pragma unroll
        for (int o = 0; o < 1; ++o) {
#define DPPSUM(v_, ctl_) v_ += __builtin_bit_cast(float, __builtin_amdgcn_mov_dpp(__builtin_bit_cast(int, v_), ctl_, 0xF, 0xF, true))
            DPPSUM(sq, 0xB1); DPPSUM(sk, 0xB1); DPPSUM(sq, 0x4E); DPPSUM(sk, 0x4E); DPPSUM(sq, 0x141); DPPSUM(sk, 0x141); DPPSUM(sq, 0x140); DPPSUM(sk, 0x140);
#undef DPPSUM
        }
        const float rq = rsqrtf(sq + EPS), rk = rsqrtf(sk + EPS);
        const float eg = __expf(gct), ke_s = __expf(gc_last - gct);
        float q8[8], k8[8], kb8[8], qd8[8], ke8[8], kbg8[8], vb8[8];
#pragma unroll
        for (int e = 0; e < 8; ++e) { q8[e] = y[0][e] * rq; k8[e] = y[1][e] * rk; kb8[e] = k8[e] * bet; qd8[e] = q8[e] * (QSCALE * eg); ke8[e] = k8[e] * ke_s; kbg8[e] = kb8[e] * eg; vb8[e] = y[2][e] * bet; }
        const int io = dc * PL_CS + tok * 16;
        *(GL3 bf16x8*)(lds + PL_Q + io) = pack8(q8); *(GL3 bf16x8*)(lds + PL_K + io) = pack8(k8); *(GL3 bf16x8*)(lds + PL_KB + io) = pack8(kb8);
        {
            const int rvo = (tok >> 4) * 1024 + ((tok >> 3) & 1) * 512 + (tok & 7) * 64 + (dc & 3) * 16;
            *(GL3 bf16x8*)(lds + PL_RV + (dc >> 2) * PL_RS + rvo) = pack8(kbg8); *(GL3 bf16x8*)(lds + PL_RV + (4 + (dc >> 2)) * PL_RS + rvo) = pack8(vb8);
        }
        qd_keep[pass] = pack8(qd8); ke_keep[pass] = pack8(ke8);
    }
    PBAR();
    if (nb_ >= 0) prep_prefetch(pre, P, HALO, nb_, nn_, nh_, wid, lane);
#pragma unroll
    for (int pass = 0; pass < 2; ++pass) {
        const int tok = 2 * (4 * wid + (lane >> 4)) + pass;
        *(bf16x8*)seg_addr(P, row0, C_DQ + h * 128, (unsigned)((dc * 64 + tok) * 16)) = qd_keep[pass];
        const unsigned ek = (unsigned)(((dc >> 2) * 4 + (tok >> 4)) * 1024 + ((tok >> 3) & 1) * 512 + (tok & 7) * 64 + (dc & 3) * 16);
        *(bf16x8*)seg_addr(P, row0, C_DK + h * 128, ek) = ke_keep[pass];
    }
    if (wid < 6) {
        const bool isA = wid < 3; const int t3 = isA ? wid : wid - 3;
        const int rt = isA ? (t3 > 0) : (t3 == 2);
        const int ct = isA ? (t3 == 2) : (t3 > 0);
        GL3 const unsigned char* aimg = lds + (isA ? PL_KB : PL_K); GL3 const unsigned char* bimg = lds + (isA ? PL_K : PL_Q);
        f32x16 acc = f32x16{};
#pragma unroll
        for (int s = 0; s < 8; ++s) {
            const bf16x8 a = *(GL3 const bf16x8*)(aimg + (2 * s + hi) * PL_CS + (32 * rt + r32) * 16);
            const bf16x8 bb = *(GL3 const bf16x8*)(bimg + (2 * s + hi) * PL_CS + (32 * ct + r32) * 16);
            acc = __builtin_amdgcn_mfma_f32_32x32x16_bf16(a, bb, acc, 0, 0, 0);
        }
        if (isA) {
            const int j = 32 * ct + r32; const float gj = GC[j];
#pragma unroll
            for (int i_ = 0; i_ < 16; ++i_) { const int i = 32 * rt + crow(i_, hi); float v = acc[i_] * __expf(fminf(GC[i] - gj, 0.f)); asm volatile("" : "+v"(v)); AM[i * AMLD + j] = (j < i) ? v : 0.f; }
        } else {
            const int i = 32 * ct + r32; const float gi = GC[i];
            float v[16];
#pragma unroll
            for (int i_ = 0; i_ < 16; ++i_) { const int j = 32 * rt + crow(i_, hi); float t = acc[i_] * (QSCALE * __expf(fminf(gi - GC[j], 0.f))); asm volatile("" : "+v"(t)); v[i_] = (j <= i) ? t : 0.f; }
#pragma unroll
            for (int sp = 0; sp < 2; ++sp) *(GL3 bf16x8*)(lds + PL_QKST + (((2 * rt + sp) * 64 + i) * 16 + 8 * hi) * 2) = pack8(v + 8 * sp);
        }
    } else if (wid == 6) {
        const bf16x8 z = {0, 0, 0, 0, 0, 0, 0, 0};
#pragma unroll
        for (int sp = 0; sp < 2; ++sp) *(GL3 bf16x8*)(lds + PL_QKST + (((2 + sp) * 64 + r32) * 16 + 8 * hi) * 2) = z;
    }
    PBAR();
    if (wid < 4 && lane < 16) {
        const int bb = wid, c = lane;
        float x[16];
#pragma unroll
        for (int i = 0; i < 16; ++i) {
            float acc = (i == c) ? 1.f : 0.f;
#pragma unroll
            for (int j4 = 0; j4 < i; j4 += 4) { const f32x4 a = *(GL3 const f32x4*)(AM + (16 * bb + i) * AMLD + 16 * bb + j4);
                acc -= a[0] * x[j4]; if (j4 + 1 < i) acc -= a[1] * x[j4 + 1]; if (j4 + 2 < i) acc -= a[2] * x[j4 + 2]; if (j4 + 3 < i) acc -= a[3] * x[j4 + 3]; }
            x[i] = acc;
        }
#pragma unroll
        for (int i = 0; i < 16; ++i) INV[(16 * bb + i) * AMLD + 16 * bb + c] = x[i];
#pragma unroll
        for (int q = 0; q < 4; ++q) *(GL3 f32x4*)(INVT + (16 * bb + c) * AMLD + 16 * bb + 4 * q) = (f32x4){x[4 * q], x[4 * q + 1], x[4 * q + 2], x[4 * q + 3]};
    }
    PBAR();
    for (int L = 1; L < 4; ++L) {
        const int nb = 4 - L;
        for (int t = tid; t < nb * 256; t += 512) {
            const int J = t >> 8, I = J + L, ei = (t >> 4) & 15, ej = t & 15;
            float acc = 0.f;
            for (int K = J; K < I; ++K) {
#pragma unroll
                for (int k4 = 0; k4 < 16; k4 += 4) { const f32x4 a = *(GL3 const f32x4*)(AM + (16 * I + ei) * AMLD + 16 * K + k4); const f32x4 xt = *(GL3 const f32x4*)(INVT + (16 * J + ej) * AMLD + 16 * K + k4);
                    acc += (a[0] * xt[0] + a[1] * xt[1]) + (a[2] * xt[2] + a[3] * xt[3]); }
            }
            MT[(J * 16 + ej) * 20 + ei] = acc;
        }
        PBAR();
        for (int t = tid; t < nb * 256; t += 512) {
            const int J = t >> 8, I = J + L, ei = (t >> 4) & 15, ej = t & 15;
            float acc = 0.f;
#pragma unroll
            for (int k4 = 0; k4 < 16; k4 += 4) { const f32x4 d = *(GL3 const f32x4*)(INV + (16 * I + ei) * AMLD + 16 * I + k4); const f32x4 mt = *(GL3 const f32x4*)(MT + (J * 16 + ej) * 20 + k4);
                acc += (d[0] * mt[0] + d[1] * mt[1]) + (d[2] * mt[2] + d[3] * mt[3]); }
            INV[(16 * I + ei) * AMLD + 16 * J + ej] = -acc; INVT[(16 * J + ej) * AMLD + 16 * I + ei] = -acc;
        }
        PBAR();
    }
    {
        const int s_ = tid >> 7, i = (tid >> 1) & 63, hh = tid & 1;
        float v[8];
        if (s_ > (i >> 4)) {
#pragma unroll
            for (int e = 0; e < 8; ++e) v[e] = 0.f;
        } else {
            const f32x4 a = *(GL3 const f32x4*)(INV + i * AMLD + 16 * s_ + 4 * hh), c4 = *(GL3 const f32x4*)(INV + i * AMLD + 16 * s_ + 8 + 4 * hh);
            v[0] = a[0]; v[1] = a[1]; v[2] = a[2]; v[3] = a[3]; v[4] = c4[0]; v[5] = c4[1]; v[6] = c4[2]; v[7] = c4[3];
        }
        *(GL3 bf16x8*)(lds + PL_TI + ((s_ * 64 + i) * 16 + 8 * hh) * 2) = pack8(v);
    }
    PBAR();
    {
        const int cb = wid;
        GL3 const unsigned char* rp = lds + PL_RV + cb * PL_RS + ((lane >> 4) & 1) * 32 + (lane & 3) * 8 + (4 * hi + ((lane & 15) >> 2)) * 64;
        f32x16 d0 = f32x16{}, d1 = f32x16{};
#pragma unroll
        for (int ks = 0; ks < 4; ++ks) {
            const s16x4 lo = vtr(rp + ks * 1024), hh2 = vtr(rp + ks * 1024 + 512);
            const bf16x8 rf = {lo[0], lo[1], lo[2], lo[3], hh2[0], hh2[1], hh2[2], hh2[3]};
            const bf16x8 t1 = *(GL3 const bf16x8*)(lds + PL_TI + ((ks * 64 + 32 + r32) * 16 + 8 * hi) * 2);
            if (cb < 4) {
                if (ks < 2) { const bf16x8 t0 = *(GL3 const bf16x8*)(lds + PL_TI + ((ks * 64 + r32) * 16 + 8 * hi) * 2); d0 = __builtin_amdgcn_mfma_f32_32x32x16_bf16(rf, t0, d0, 0, 0, 0); }
                d1 = __builtin_amdgcn_mfma_f32_32x32x16_bf16(rf, t1, d1, 0, 0, 0);
            } else {
                if (ks < 2) { const bf16x8 t0 = *(GL3 const bf16x8*)(lds + PL_TI + ((ks * 64 + r32) * 16 + 8 * hi) * 2); d0 = __builtin_amdgcn_mfma_f32_32x32x16_bf16(t0, rf, d0, 0, 0, 0); }
                d1 = __builtin_amdgcn_mfma_f32_32x32x16_bf16(t1, rf, d1, 0, 0, 0);
            }
        }
        PBAR();
        if (cb < 4) {
#pragma unroll
            for (int a = 0; a < 4; ++a) {
                u32x2 w0 = {pk(d0[4 * a], d0[4 * a + 1]), pk(d0[4 * a + 2], d0[4 * a + 3])}, w1 = {pk(d1[4 * a], d1[4 * a + 1]), pk(d1[4 * a + 2], d1[4 * a + 3])};
                *(GL3 u32x2*)(lds + PL_WST + ((4 * cb + a) * 64 + r32) * 16 + 8 * hi) = w0;
                *(GL3 u32x2*)(lds + PL_WST + ((4 * cb + a) * 64 + 32 + r32) * 16 + 8 * hi) = w1;
            }
        } else {
            float t0_[16], t1_[16];
#pragma unroll
            for (int i = 0; i < 16; ++i) { t0_[i] = d0[i]; t1_[i] = d1[i]; }
#pragma unroll
            for (int sp = 0; sp < 2; ++sp) {
                *(GL3 bf16x8*)(lds + PL_UST + (((0 * 4 + (cb - 4)) * 2 + sp) * 64 + lane) * 16) = pack8(t0_ + 8 * sp);
                *(GL3 bf16x8*)(lds + PL_UST + (((1 * 4 + (cb - 4)) * 2 + sp) * 64 + lane) * 16) = pack8(t1_ + 8 * sp); }
        }
    }
    PBAR();
#pragma unroll
    for (int k = 0; k < 2; ++k) {
        const int e = (tid + 512 * k) * 16;
        *(u32x4*)((char*)(GW + (size_t)item * 8192) + e) = *(GL3 const u32x4*)(lds + PL_WST + e);
        *(u32x4*)seg_addr(P, row0, C_DV + h * 128, (unsigned)e) = *(GL3 const u32x4*)(lds + PL_UST + e);
    }
    *(u32x4*)((char*)(GQK + (size_t)item * 4096) + tid * 16) = *(GL3 const u32x4*)(lds + PL_QKST + tid * 16);
    if (tid == 0) GLv[item] = __expf(gc_last);
    PBAR();
}

#undef PBAR
constexpr int SL_W = 0, SL_QD = 16384, SL_KE = 32768, SL_QK = 49152, SL_U = 57344, SL_Z = 73728, SL_S = 90112, SL_VN = 122880, SL_RS = 139264, SL_END = 140416;
__device__ __forceinline__ void glds16(const void* gsrc, unsigned lds_dst) { unsigned keep;
    asm volatile("s_mov_b32 %0, m0\n\ts_mov_b32 m0, %2\n\ts_nop 0\n\tglobal_load_lds_dwordx4 %1, off nt\n\ts_mov_b32 m0, %0" : "=&s"(keep) : "v"(gsrc), "s"(lds_dst) : "memory"); }
__device__ __forceinline__ unsigned lds_addr(GL3 unsigned char* p) { return (unsigned)(size_t)p; }
__device__ __forceinline__ void dma_seg(GL3 unsigned char* dst, const bf16_t* P, size_t row0, int c0, int wid, int lane) {
#pragma unroll
    for (int k = 0; k < 2; ++k) { const int piece = wid + 8 * k;
        const char* src = (const char*)P + ((row0 + piece * 4 + (lane >> 4)) * LDP + c0) * 2 + (lane & 15) * 16;
        glds16(src, (unsigned)__builtin_amdgcn_readfirstlane((int)(lds_addr(dst) + piece * 1024))); }
}
__device__ __forceinline__ void dma_seg_swz(GL3 unsigned char* dst, const bf16_t* P, size_t row0, int c0, int wid, int lane) {
#pragma unroll
    for (int k = 0; k < 2; ++k) { const int piece = wid + 8 * k; const int r = piece * 4 + (lane >> 4);
        const char* src = (const char*)P + ((row0 + r) * LDP + c0) * 2 + ((lane ^ r) & 15) * 16;
        glds16(src, (unsigned)__builtin_amdgcn_readfirstlane((int)(lds_addr(dst) + piece * 1024))); }
}
template <int NPIECES>
__device__ __forceinline__ void dma_lin(GL3 unsigned char* dst, const bf16_t* src, int wid, int lane) {
#pragma unroll
    for (int k = 0; k < NPIECES / 8; ++k) { const int piece = wid + 8 * k;
        glds16((const char*)src + piece * 1024 + lane * 16, (unsigned)__builtin_amdgcn_readfirstlane((int)(lds_addr(dst) + piece * 1024))); }
}

__device__ __forceinline__ float sum32(float v) {
    v += __builtin_bit_cast(float, __builtin_amdgcn_mov_dpp(__builtin_bit_cast(int, v), 0xB1, 0xF, 0xF, true));
    v += __builtin_bit_cast(float, __builtin_amdgcn_mov_dpp(__builtin_bit_cast(int, v), 0x4E, 0xF, 0xF, true));
    v += __builtin_bit_cast(float, __builtin_amdgcn_mov_dpp(__builtin_bit_cast(int, v), 0x141, 0xF, 0xF, true));
    v += __builtin_bit_cast(float, __builtin_amdgcn_mov_dpp(__builtin_bit_cast(int, v), 0x140, 0xF, 0xF, true));
    v += __shfl_xor(v, 16);
    return v;
}
#define GRAWBAR() do { asm volatile("s_waitcnt lgkmcnt(0)" ::: "memory"); __builtin_amdgcn_s_barrier(); asm volatile("" ::: "memory"); } while (0)
#define GWAITV0() asm volatile("s_waitcnt vmcnt(0)" ::: "memory")
constexpr int SL_GL = SL_RS + 1024;
__device__ __forceinline__ void scan_item(GL3 unsigned char* lds, bf16_t* P, const bf16_t* GW, const bf16_t* GQK, const float* GLv, const float* out_norm, int b, int h) {
    int tid = threadIdx.x; asm volatile("" : "+v"(tid));
    const int lane = tid & 63, r32 = lane & 31, hi = lane >> 5; const int wid = __builtin_amdgcn_readfirstlane(tid >> 6);
    const int mt = wid >> 2, nt = wid & 3;
    const int dv = 32 * nt + r32;
    const int item0 = (b * DN_H + h) * 32; const size_t rowb = (size_t)b * SEQ;
    f32x16 S0 = f32x16{}, S1 = f32x16{};
    {
        const u32x4 z = {0u, 0u, 0u, 0u};
#pragma unroll
        for (int k = 0; k < 4; ++k) *(GL3 u32x4*)(lds + SL_S + (tid + 512 * k) * 16) = z;
        if (tid < 32) *(GL3 float*)(lds + SL_GL + tid * 4) = GLv[item0 + tid];
    }
    float gn[16];
#pragma unroll
    for (int i = 0; i < 16; ++i) gn[i] = out_norm[32 * nt + crow(i, hi)];
    GL3 float* RS = (GL3 float*)(lds + SL_RS);
#define ISSUE_A(n_) do { dma_lin<16>(lds + SL_W, GW + (size_t)(item0 + (n_)) * 8192, wid, lane); dma_seg(lds + SL_QD, P, rowb + 64 * (n_), C_DQ + h * 128, wid, lane); dma_seg(lds + SL_U, P, rowb + 64 * (n_), C_DV + h * 128, wid, lane); } while (0)
#define ISSUE_B(n_) do { dma_seg(lds + SL_KE, P, rowb + 64 * (n_), C_DK + h * 128, wid, lane); dma_lin<8>(lds + SL_QK, GQK + (size_t)(item0 + (n_)) * 4096, wid, lane); dma_seg_swz(lds + SL_Z, P, rowb + 64 * (n_), C_DZ + h * 128, wid, lane); } while (0)
    GWAITV0();
    ISSUE_A(0);
    f32x16 oprev = f32x16{}; unsigned zprev[8] = {0u, 0u, 0u, 0u, 0u, 0u, 0u, 0u};
#define Y_OUT(n_) do { \
        const f32x4 rs = *(GL3 const f32x4*)(RS + (32 * mt + r32) * 4); \
        const float rstd = rsqrtf(((rs[0] + rs[1]) + (rs[2] + rs[3])) * (1.f / 128.f) + EPS); \
        bf16_t* yp = P + (rowb + 64 * (n_) + 32 * mt + r32) * LDP + C_DZ + h * 128 + 32 * nt + 4 * hi; \
        _Pragma("unroll") for (int a = 0; a < 4; ++a) { float y[4]; \
            _Pragma("unroll") for (int e = 0; e < 4; ++e) { const int i = 4 * a + e; const float z = (i & 1) ? bhi(zprev[i >> 1]) : blo(zprev[i >> 1]); y[e] = oprev[i] * rstd * gn[i] * fsilu(z); } \
            const u32x2 w = {pk(y[0], y[1]), pk(y[2], y[3])}; const bf16_t* ya = yp + 8 * a; \
            asm volatile("global_store_dwordx2 %0, %1, off" :: "v"(ya), "v"(w) : "memory"); } } while (0)
    for (int n = 0; n < 32; ++n) {
        GWAITV0(); GRAWBAR();
        ISSUE_B(n);
        const float gl = *(GL3 const float*)(lds + SL_GL + n * 4);
        f32x16 vp = f32x16{}, o = f32x16{};
#pragma unroll
        for (int s = 0; s < 8; ++s) {
            const bf16x8 sb = *(GL3 const bf16x8*)(lds + SL_S + ((2 * s + hi) * 128 + dv) * 16);
            const bf16x8 wa = *(GL3 const bf16x8*)(lds + SL_W + ((2 * s + hi) * 64 + 32 * mt + r32) * 16);
            const bf16x8 qa = *(GL3 const bf16x8*)(lds + SL_QD + ((2 * s + hi) * 64 + 32 * mt + r32) * 16);
            vp = __builtin_amdgcn_mfma_f32_32x32x16_bf16(wa, sb, vp, 0, 0, 0);
            o = __builtin_amdgcn_mfma_f32_32x32x16_bf16(sb, qa, o, 0, 0, 0);
        }
        if (n > 0) Y_OUT(n - 1);
        {
            float v[16];
            const u32x4 ua = *(GL3 const u32x4*)(lds + SL_U + (((mt * 4 + nt) * 2 + 0) * 64 + lane) * 16), ub = *(GL3 const u32x4*)(lds + SL_U + (((mt * 4 + nt) * 2 + 1) * 64 + lane) * 16);
#pragma unroll
            for (int q = 0; q < 4; ++q) { v[2 * q] = blo(ua[q]) - vp[2 * q]; v[2 * q + 1] = bhi(ua[q]) - vp[2 * q + 1]; v[8 + 2 * q] = blo(ub[q]) - vp[8 + 2 * q]; v[8 + 2 * q + 1] = bhi(ub[q]) - vp[8 + 2 * q + 1]; }
#pragma unroll
            for (int sp = 0; sp < 2; ++sp) *(GL3 bf16x8*)(lds + SL_VN + (((2 * mt + sp) * 128 + dv) * 16 + 8 * hi) * 2) = pack8(v + 8 * sp);
        }
        if (n > 0) asm volatile("s_waitcnt vmcnt(4)" ::: "memory"); else GWAITV0();
        GRAWBAR();
        if (n + 1 < 32) ISSUE_A(n + 1);
#pragma unroll
        for (int a = 0; a < 4; ++a) { const int r = 32 * mt + r32; const u32x2 zz = *(GL3 const u32x2*)(lds + SL_Z + r * 256 + (((4 * nt + a) ^ (r & 15)) * 16) + 8 * hi); zprev[2 * a] = zz[0]; zprev[2 * a + 1] = zz[1]; }
#pragma unroll
        for (int i = 0; i < 16; ++i) { S0[i] *= gl; S1[i] *= gl; }
        {
            GL3 const unsigned char* kp0 = lds + SL_KE + (2 * mt) * 4096 + ((lane >> 4) & 1) * 32 + (lane & 3) * 8 + (4 * hi + ((lane & 15) >> 2)) * 64;
#pragma unroll
            for (int ks = 0; ks < 4; ++ks) {
                const bf16x8 vb = *(GL3 const bf16x8*)(lds + SL_VN + ((ks * 128 + dv) * 16 + 8 * hi) * 2);
                const s16x4 l0 = vtr(kp0 + ks * 1024), h0 = vtr(kp0 + ks * 1024 + 512), l1 = vtr(kp0 + 4096 + ks * 1024), h1 = vtr(kp0 + 4096 + ks * 1024 + 512);
                const bf16x8 k0 = {l0[0], l0[1], l0[2], l0[3], h0[0], h0[1], h0[2], h0[3]}, k1 = {l1[0], l1[1], l1[2], l1[3], h1[0], h1[1], h1[2], h1[3]};
                const bf16x8 qa = *(GL3 const bf16x8*)(lds + SL_QK + ((ks * 64 + 32 * mt + r32) * 16 + 8 * hi) * 2);
                S0 = __builtin_amdgcn_mfma_f32_32x32x16_bf16(k0, vb, S0, 0, 0, 0);
                S1 = __builtin_amdgcn_mfma_f32_32x32x16_bf16(k1, vb, S1, 0, 0, 0);
                o = __builtin_amdgcn_mfma_f32_32x32x16_bf16(vb, qa, o, 0, 0, 0);
            }
        }
#pragma unroll
        for (int a = 0; a < 4; ++a) {
            u32x2 w0 = {pk(S0[4 * a], S0[4 * a + 1]), pk(S0[4 * a + 2], S0[4 * a + 3])}, w1 = {pk(S1[4 * a], S1[4 * a + 1]), pk(S1[4 * a + 2], S1[4 * a + 3])};
            *(GL3 u32x2*)(lds + SL_S + ((4 * (2 * mt) + a) * 128 + dv) * 16 + 8 * hi) = w0;
            *(GL3 u32x2*)(lds + SL_S + ((4 * (2 * mt + 1) + a) * 128 + dv) * 16 + 8 * hi) = w1;
        }
        {   float q = 0.f;
#pragma unroll
            for (int i = 0; i < 16; ++i) q += o[i] * o[i];
            const auto p2 = __builtin_amdgcn_permlane32_swap(__float_as_uint(q), __float_as_uint(q), false, false); q = __uint_as_float(p2[0]) + __uint_as_float(p2[1]);
            if (hi == 0) RS[(32 * mt + r32) * 4 + nt] = q; }
        oprev = o;
    }
    GWAITV0(); GRAWBAR();
    Y_OUT(31);
    GWAITV0();
    __syncthreads();
#undef Y_OUT
#undef ISSUE_A
#undef ISSUE_B
}
}
namespace nsa {
#define NLAS __attribute__((address_space(3)))
typedef short bf16x8 __attribute__((ext_vector_type(8)));
typedef short s16x4 __attribute__((ext_vector_type(4)));
typedef short v4i16_t __attribute__((ext_vector_type(4)));
typedef float f32x16 __attribute__((ext_vector_type(16)));
typedef float f32x4 __attribute__((ext_vector_type(4)));
typedef float f32x2 __attribute__((ext_vector_type(2)));
typedef unsigned u32x4 __attribute__((ext_vector_type(4)));
typedef __bf16 bf16x2_t __attribute__((ext_vector_type(2)));
constexpr float LOG2E = 1.4426950408889634f;
constexpr float NEG = -1e30f;
constexpr int L_KV = 0;
constexpr int L_IMP = 49152;
constexpr int L_SEL = 82944;
constexpr int L_WS = 83456;
constexpr int L_OST = 85504;
constexpr int L_PRE = 118272;
constexpr int L_END = 151040;

__device__ __forceinline__ int crow(int i, int hi) { return (i & 3) + 8 * (i >> 2) + 4 * hi; }
__device__ __forceinline__ unsigned pk(float lo, float hi) { f32x2 v = {lo, hi}; bf16x2_t b = __builtin_convertvector(v, bf16x2_t); return __builtin_bit_cast(unsigned, b); }
__device__ __forceinline__ float xhalf_max(float v) { auto rr = __builtin_amdgcn_permlane32_swap(__float_as_uint(v), __float_as_uint(v), false, false); return fmaxf(__uint_as_float(rr[0]), __uint_as_float(rr[1])); }
__device__ __forceinline__ float xhalf_sum(float v) { auto rr = __builtin_amdgcn_permlane32_swap(__float_as_uint(v), __float_as_uint(v), false, false); return __uint_as_float(rr[0]) + __uint_as_float(rr[1]); }

__device__ __forceinline__ void dma_tile(NLAS unsigned char* slot, const bf16_t* Kb, const bf16_t* Vb, unsigned koff, unsigned voff, int wid) {
    __builtin_amdgcn_global_load_lds((const unsigned*)((const char*)Kb + koff), (NLAS unsigned*)(slot + wid * 1024), 16, 0, 0);
    __builtin_amdgcn_global_load_lds((const unsigned*)((const char*)Vb + voff), (NLAS unsigned*)(slot + 8192 + wid * 1024), 16, 0, 0);
}
__device__ __forceinline__ void glds16(const void* gsrc, unsigned lds_dst) { unsigned keep;
    asm volatile("s_mov_b32 %0, m0\n\ts_mov_b32 m0, %2\n\ts_nop 0\n\tglobal_load_lds_dwordx4 %1, off\n\ts_mov_b32 m0, %0" : "=&s"(keep) : "v"(gsrc), "s"(lds_dst) : "memory"); }
__device__ __forceinline__ void dma_tile_a(NLAS unsigned char* slot, const bf16_t* Kb, const bf16_t* Vb, unsigned koff, unsigned voff, int wid) {
    const unsigned base = (unsigned)(size_t)slot + (unsigned)wid * 1024u;
    glds16((const char*)Kb + koff, (unsigned)__builtin_amdgcn_readfirstlane((int)base));
    glds16((const char*)Vb + voff, (unsigned)__builtin_amdgcn_readfirstlane((int)(base + 8192u)));
}
#define RING_WAIT_BAR(N) do { asm volatile("s_waitcnt vmcnt(" #N ") lgkmcnt(0)" ::: "memory"); __builtin_amdgcn_s_barrier(); asm volatile("" ::: "memory"); } while (0)
__device__ __forceinline__ void tile_offs(unsigned& koff, unsigned& voff, int pitch, int wid, int lane) {
    koff = (unsigned)(lane * pitch + wid * 8) * 2u;
    voff = (unsigned)((16 * (wid & 3) + (lane >> 2)) * pitch + (wid >> 2) * 32 + (lane & 3) * 8) * 2u;
}
__device__ __forceinline__ void qkt(f32x16& p0, f32x16& p1, NLAS const unsigned char* Kslot, const bf16x8* qr, const f32x16& c0, const f32x16& c1, int r32, int hi) {
    NLAS const unsigned char* kb = Kslot + hi * 1024 + r32 * 16;
    __builtin_amdgcn_s_setprio(1);
#pragma unroll
    for (int d0 = 0; d0 < 4; ++d0) {
        const bf16x8 b0 = *(NLAS const bf16x8*)(kb + d0 * 2048);
        const bf16x8 b1 = *(NLAS const bf16x8*)(kb + d0 * 2048 + 512);
        if (d0 == 0) { p0 = __builtin_amdgcn_mfma_f32_32x32x16_bf16(b0, qr[0], c0, 0, 0, 0); p1 = __builtin_amdgcn_mfma_f32_32x32x16_bf16(b1, qr[0], c1, 0, 0, 0); }
        else { p0 = __builtin_amdgcn_mfma_f32_32x32x16_bf16(b0, qr[d0], p0, 0, 0, 0); p1 = __builtin_amdgcn_mfma_f32_32x32x16_bf16(b1, qr[d0], p1, 0, 0, 0); }
    }
    __builtin_amdgcn_s_setprio(0);
}
__device__ __forceinline__ s16x4 vtr(NLAS const unsigned char* p) { return __builtin_bit_cast(s16x4, __builtin_amdgcn_ds_read_tr16_b64_v4i16((NLAS v4i16_t*)p)); }
__device__ __forceinline__ void pv(f32x16* o, NLAS const unsigned char* Vslot, const f32x16& p0, const f32x16& p1, int lane, int hi) {
    u32x4 w0 = {pk(p0[0], p0[1]), pk(p0[2], p0[3]), pk(p0[4], p0[5]), pk(p0[6], p0[7])};
    u32x4 w1 = {pk(p0[8], p0[9]), pk(p0[10], p0[11]), pk(p0[12], p0[13]), pk(p0[14], p0[15])};
    u32x4 w2 = {pk(p1[0], p1[1]), pk(p1[2], p1[3]), pk(p1[4], p1[5]), pk(p1[6], p1[7])};
    u32x4 w3 = {pk(p1[8], p1[9]), pk(p1[10], p1[11]), pk(p1[12], p1[13]), pk(p1[14], p1[15])};
    const bf16x8 pa[4] = {__builtin_bit_cast(bf16x8, w0), __builtin_bit_cast(bf16x8, w1), __builtin_bit_cast(bf16x8, w2), __builtin_bit_cast(bf16x8, w3)};
    NLAS const unsigned char* vp = Vslot + ((lane >> 4) & 1) * 32 + (lane & 3) * 8 + (4 * hi + ((lane & 15) >> 2)) * 64;
    __builtin_amdgcn_s_setprio(1);
#pragma unroll
    for (int d0 = 0; d0 < 2; ++d0)
#pragma unroll
        for (int ks = 0; ks < 4; ++ks) {
            const s16x4 lo = vtr(vp + d0 * 4096 + ks * 1024), hh = vtr(vp + d0 * 4096 + ks * 1024 + 512);
            const bf16x8 vf = {lo[0], lo[1], lo[2], lo[3], hh[0], hh[1], hh[2], hh[3]};
            o[d0] = __builtin_amdgcn_mfma_f32_32x32x16_bf16(pa[ks], vf, o[d0], 0, 0, 0);
        }
    __builtin_amdgcn_s_setprio(0);
}
__device__ __forceinline__ void scale_rows(f32x16* o, NLAS float* wsf, float s, int r32, int hi) {
    if (hi == 0) wsf[r32] = s;
#pragma unroll
    for (int i = 0; i < 16; ++i) { const float f = wsf[crow(i, hi)]; o[0][i] *= f; o[1][i] *= f; }
}
__device__ __forceinline__ void acc_rows(f32x16* tot, const f32x16* o, NLAS float* wsf, float s, int r32, int hi) {
    if (hi == 0) wsf[32 + r32] = s;
#pragma unroll
    for (int i = 0; i < 16; ++i) { const float f = wsf[32 + crow(i, hi)]; tot[0][i] += f * o[0][i]; tot[1][i] += f * o[1][i]; }
}
#define MX3(a, b, c) __builtin_fmaxf(__builtin_fmaxf((a), (b)), (c))
__device__ __forceinline__ void softmax_step(f32x16& p0, f32x16& p1, float& m, float& l, f32x16* o, NLAS float* wsf, int r32, int hi) {
    float ta = MX3(p0[0], p0[1], p1[0]), tb = MX3(p0[2], p0[3], p1[1]); ta = MX3(ta, p1[2], p1[3]);
#pragma unroll
    for (int r = 4; r < 16; r += 4) { ta = MX3(ta, p0[r], p0[r + 1]); tb = MX3(tb, p0[r + 2], p0[r + 3]); ta = MX3(ta, p1[r], p1[r + 1]); tb = MX3(tb, p1[r + 2], p1[r + 3]); }
    float t = xhalf_max(fmaxf(ta, tb));
    if (__any(t > 8.f)) {
        const float d = fmaxf(t, 0.f);
        m += d;
#pragma unroll
        for (int i = 0; i < 16; ++i) { p0[i] -= d; p1[i] -= d; }
        const float alpha = __builtin_amdgcn_exp2f(-d);
        l *= alpha;
        scale_rows(o, wsf, alpha, r32, hi);
    }
    float s = 0.f;
#pragma unroll
    for (int i = 0; i < 16; ++i) { p0[i] = __builtin_amdgcn_exp2f(p0[i]); p1[i] = __builtin_amdgcn_exp2f(p1[i]); s += p0[i] + p1[i]; }
    l += s;
}

__device__ __forceinline__ void attn_tile(NLAS unsigned char* lds, bf16_t* P, const bf16_t* KC, const bf16_t* VC, int b, int g, int qt, unsigned* qcnt, unsigned& qnext, bool pre, bf16x8 (&qr)[4], unsigned short (&gq)[3], int& idx_next) {
    int tid = threadIdx.x; asm volatile("" : "+v"(tid));
    const int lane = tid & 63, r32 = lane & 31, hi = lane >> 5; const int wid = __builtin_amdgcn_readfirstlane(tid >> 6);
    const int head = g * 4 + (wid >> 1), qh = wid & 1, t0 = qt * 64, qi = qh * 32 + r32, blk_t = qt;
    NLAS float* wsf = (NLAS float*)(lds + L_WS) + wid * 64;
    NLAS float* imp = (NLAS float*)(lds + L_IMP);
    NLAS unsigned* selm = (NLAS unsigned*)(lds + L_SEL);
    NLAS unsigned char* slot0 = lds + L_PRE; NLAS unsigned char* slot1 = lds + L_PRE + 16384;
    const size_t rowbase = (size_t)b * SEQ;
    bf16_t* qrow = P + (rowbase + t0 + qi) * LDP;
    const float sl2 = exp2f(-0.5f * (float)(head + 1)) * LOG2E;
    if (!pre) {
#pragma unroll
        for (int d0 = 0; d0 < 4; ++d0) qr[d0] = *(const bf16x8*)(qrow + C_NQ + head * 64 + d0 * 16 + hi * 8);
#pragma unroll
        for (int e = 0; e < 3; ++e) gq[e] = qrow[C_SG + head * 3 + e];
    }
#define FSIG(x) __builtin_amdgcn_rcpf(1.f + __builtin_amdgcn_exp2f(-LOG2E * (x)))
    const float gate_c = FSIG(bf2f(gq[0])), gate_s = FSIG(bf2f(gq[1])), gate_w = FSIG(bf2f(gq[2]));
#undef FSIG
    bf16x8 qn[4]; unsigned short gn[3] = {0, 0, 0}; int idxN = -1;
#pragma unroll
    for (int d0 = 0; d0 < 4; ++d0) qn[d0] = qr[d0];
    f32x16 tot[2]; tot[0] = f32x16{}; tot[1] = f32x16{};
#define CRF(i) ((float)(((i) & 3) + 8 * ((i) >> 2)) + 4.f * (float)hiv)
#define OPAQUE_HI() int hiv = hi; asm volatile("" : "+v"(hiv))

    {
        const bf16_t* kcb = KC + ((size_t)(b * NS_G + g) * 128) * 64; const bf16_t* vcb = VC + ((size_t)(b * NS_G + g) * 128) * 64;
        const bool two = (qt >= 16);
        unsigned kof, vof; tile_offs(kof, vof, 64, wid, lane);
        {
            unsigned kof0, vof0; tile_offs(kof0, vof0, LDP, wid, lane);
            dma_tile_a(lds + L_KV + 2 * 16384, P + rowbase * LDP + C_KS + g * 64, P + rowbase * LDP + C_VS + g * 64, kof0, vof0, wid); }
        if (!pre) { dma_tile_a(slot0, kcb, vcb, kof, vof, wid);
            if (two) dma_tile_a(slot1, kcb + 64 * 64, vcb + 64 * 64, kof, vof, wid); }
        asm volatile("s_waitcnt vmcnt(0)" ::: "memory");
        __syncthreads();
        f32x16 pA0, pA1, pB0, pB1, c0, c1;
        const float s16 = sl2 * 16.f; OPAQUE_HI();
#pragma unroll
        for (int i = 0; i < 16; ++i) { c0[i] = s16 * CRF(i); c1[i] = s16 * (CRF(i) + 32.f); }
        qkt(pA0, pA1, slot0, qr, c0, c1, r32, hi);
        const int cmax = (t0 + qi - 31) >> 4;
        const int qposm = t0 + qi - 31;
#pragma unroll
        for (int i = 0; i < 16; ++i) { const int c = crow(i, hiv); if (16 * c > qposm) pA0[i] = NEG; if (16 * (c + 32) > qposm) pA1[i] = NEG; }
        if (two) {
#pragma unroll
            for (int i = 0; i < 16; ++i) { c0[i] += s16 * 64.f; c1[i] += s16 * 64.f; }
            qkt(pB0, pB1, slot1, qr, c0, c1, r32, hi);
#pragma unroll
            for (int i = 0; i < 16; ++i) { const int c = 64 + crow(i, hiv); if (16 * c > qposm) pB0[i] = NEG; if (16 * (c + 32) > qposm) pB1[i] = NEG; }
        } else { pB0 = f32x16{}; pB1 = f32x16{}; }
        (void)cmax;
        float mx = NEG;
#pragma unroll
        for (int i = 0; i < 16; ++i) mx = fmaxf(mx, fmaxf(pA0[i], pA1[i]));
        if (two) {
#pragma unroll
            for (int i = 0; i < 16; ++i) mx = fmaxf(mx, fmaxf(pB0[i], pB1[i])); }
        mx = xhalf_max(mx);
        float s = 0.f;
#pragma unroll
        for (int i = 0; i < 16; ++i) { pA0[i] = __builtin_amdgcn_exp2f(pA0[i] - mx); pA1[i] = __builtin_amdgcn_exp2f(pA1[i] - mx); s += pA0[i] + pA1[i]; }
        if (two) {
#pragma unroll
            for (int i = 0; i < 16; ++i) { pB0[i] = __builtin_amdgcn_exp2f(pB0[i] - mx); pB1[i] = __builtin_amdgcn_exp2f(pB1[i] - mx); s += pB0[i] + pB1[i]; } }
        s = xhalf_sum(s);
        const float nrm = (t0 + qi >= 31) ? __builtin_amdgcn_rcpf(s) : 0.f;
#pragma unroll
        for (int i = 0; i < 16; ++i) { pA0[i] *= nrm; pA1[i] *= nrm; }
        if (two) {
#pragma unroll
            for (int i = 0; i < 16; ++i) { pB0[i] *= nrm; pB1[i] *= nrm; } }
#define PSEL(L) ((L) < 4 ? pA0 : (L) < 8 ? pA1 : (L) < 12 ? pB0 : pB1)
#define MAINV(L) ((PSEL(L)[4 * ((L) & 3)] + PSEL(L)[4 * ((L) & 3) + 1]) + (PSEL(L)[4 * ((L) & 3) + 2] + 0.5f * PSEL(L)[4 * ((L) & 3) + 3]))
#define CARRY(L) (0.5f * PSEL(L)[4 * ((L) & 3) + 3])
#pragma unroll
        for (int L = 0; L < 16; ++L) {
            const float cprev = (L > 0) ? CARRY(L > 0 ? L - 1 : 0) : 0.f;
            const float snd = hi ? cprev : CARRY(L);
            const float rcv = __shfl_xor(snd, 32);
            imp[((wid >> 1) * 64 + qi) * 33 + 2 * L + hi] = MAINV(L) + rcv;
        }
#undef PSEL
#undef MAINV
#undef CARRY
        f32x16 o[2]; o[0] = f32x16{}; o[1] = f32x16{};
        pv(o, slot0 + 8192, pA0, pA1, lane, hi);
        if (two) pv(o, slot1 + 8192, pB0, pB1, lane, hi);
        acc_rows(tot, o, wsf, gate_c, r32, hi);
    }
    __syncthreads();
    {
        const int ql = 8 * wid + (lane >> 3), sub = lane & 7;
        float v[4];
#pragma unroll
        for (int e = 0; e < 4; ++e) { const int j = 4 * sub + e; v[e] = (imp[(0 * 64 + ql) * 33 + j] + imp[(1 * 64 + ql) * 33 + j]) + (imp[(2 * 64 + ql) * 33 + j] + imp[(3 * 64 + ql) * 33 + j]);
            if (j < 1 || j >= blk_t) v[e] = -1.f; }
        unsigned mask = 1u | (1u << blk_t);
#pragma unroll 1
        for (int it = 0; it < 6; ++it) {
            float bv = fmaxf(fmaxf(v[0], v[1]), fmaxf(v[2], v[3]));
            bv = fmaxf(bv, __builtin_bit_cast(float, __builtin_amdgcn_mov_dpp(__builtin_bit_cast(int, bv), 0xB1, 0xF, 0xF, true)));
            bv = fmaxf(bv, __builtin_bit_cast(float, __builtin_amdgcn_mov_dpp(__builtin_bit_cast(int, bv), 0x4E, 0xF, 0xF, true)));
            bv = fmaxf(bv, __builtin_bit_cast(float, __builtin_amdgcn_mov_dpp(__builtin_bit_cast(int, bv), 0x141, 0xF, 0xF, true)));
            int bj = (v[3] == bv) ? 4 * sub + 3 : 64; bj = (v[2] == bv) ? 4 * sub + 2 : bj; bj = (v[1] == bv) ? 4 * sub + 1 : bj; bj = (v[0] == bv) ? 4 * sub : bj;
            bj = min(bj, __builtin_amdgcn_mov_dpp(bj, 0xB1, 0xF, 0xF, true));
            bj = min(bj, __builtin_amdgcn_mov_dpp(bj, 0x4E, 0xF, 0xF, true));
            bj = min(bj, __builtin_amdgcn_mov_dpp(bj, 0x141, 0xF, 0xF, true));
            if (bv >= 0.f) { mask |= 1u << bj;
#pragma unroll
                for (int e = 0; e < 4; ++e) if (4 * sub + e == bj) v[e] = -1.f; }
        }
        if (sub == 0) selm[ql] = mask;
        unsigned any = mask;
        any |= __shfl_xor(any, 8); any |= __shfl_xor(any, 16); any |= __shfl_xor(any, 32);
        if (lane == 0) selm[64 + wid] = any;
    }
    __syncthreads();
    const unsigned mymask = selm[qi];
    const unsigned anym = (unsigned)__builtin_amdgcn_readfirstlane((int)((selm[64] | selm[65]) | (selm[66] | selm[67]) | (selm[68] | selm[69]) | (selm[70] | selm[71])));
    unsigned kofP, vofP; tile_offs(kofP, vofP, LDP, wid, lane);
    {
        const bf16_t* kbw = P + rowbase * LDP + C_KW + g * 64; const bf16_t* vbw = P + rowbase * LDP + C_VW + g * 64;
        dma_tile_a(lds + L_IMP, kbw + (size_t)blk_t * 64 * LDP, vbw + (size_t)blk_t * 64 * LDP, kofP, vofP, wid);
        if (blk_t >= 1) dma_tile_a(lds + L_IMP + 16384, kbw + (size_t)(blk_t - 1) * 64 * LDP, vbw + (size_t)(blk_t - 1) * 64 * LDP, kofP, vofP, wid);
    }
    {
        const bf16_t* kb = P + rowbase * LDP + C_KS + g * 64; const bf16_t* vb = P + rowbase * LDP + C_VS + g * 64;
        unsigned todo = anym;
        float m = 0.f, l = 0.f; f32x16 o[2]; o[0] = f32x16{}; o[1] = f32x16{};
        int j0 = __builtin_ctz(todo); todo &= todo - 1;
        int j1 = todo ? __builtin_ctz(todo) : -1; if (todo) todo &= todo - 1;
        if (j1 >= 0) dma_tile_a(lds + L_KV, kb + (size_t)j1 * 64 * LDP, vb + (size_t)j1 * 64 * LDP, kofP, vofP, wid);
        int sl = 2;
        for (;;) {
            const int j2 = todo ? __builtin_ctz(todo) : -1; if (todo) todo &= todo - 1;
            const int sl2i = (sl >= 1) ? sl - 1 : 2;
            if (j2 >= 0) dma_tile_a(lds + L_KV + sl2i * 16384, kb + (size_t)j2 * 64 * LDP, vb + (size_t)j2 * 64 * LDP, kofP, vofP, wid);
            NLAS unsigned char* sc = lds + L_KV + sl * 16384;
            const int j = j0;
            const bool mine = (mymask >> j) & 1u;
            const bool far = sl2 * (float)(t0 - 64 * j - 63) > 200.f;
            if (__any(mine) && !far) {
                f32x16 p0, p1, c0, c1; const float kb0 = sl2 * (float)(j * 64 - t0) - m; OPAQUE_HI();
#pragma unroll
                for (int i = 0; i < 16; ++i) { c0[i] = kb0 + sl2 * CRF(i); c1[i] = c0[i] + sl2 * 32.f; }
                qkt(p0, p1, sc, qr, c0, c1, r32, hi);
                if (j == blk_t) {
                    asm volatile("" ::: "memory");
#pragma unroll
                    for (int i = 0; i < 16; ++i) { const int kk = crow(i, hiv); if (kk > qi) p0[i] = NEG; if (kk + 32 > qi) p1[i] = NEG; }
                }
                if (__any(!mine)) {
                    asm volatile("" ::: "memory");
                    if (!mine) {
#pragma unroll
                        for (int i = 0; i < 16; ++i) { p0[i] = NEG; p1[i] = NEG; } }
                }
                softmax_step(p0, p1, m, l, o, wsf, r32, hi);
                pv(o, sc + 8192, p0, p1, lane, hi);
            }
            if (j1 < 0) break;
            if (j2 >= 0) RING_WAIT_BAR(2); else RING_WAIT_BAR(0);
            j0 = j1; j1 = j2; sl = (sl == 2) ? 0 : sl + 1;
        }
        RING_WAIT_BAR(0);
        if (tid == 0) qnext = atomicAdd(qcnt, 1u);
        l = xhalf_sum(l);
        acc_rows(tot, o, wsf, gate_s * __builtin_amdgcn_rcpf(l), r32, hi);
    }
    {
        const bf16_t* kb = P + rowbase * LDP + C_KW + g * 64; const bf16_t* vb = P + rowbase * LDP + C_VW + g * 64;
        float m = 0.f, l = 0.f; f32x16 o[2]; o[0] = f32x16{}; o[1] = f32x16{};
        const int nw = (blk_t >= 4 ? 4 : blk_t) + 1;
        for (int t = 2; t < nw; ++t) dma_tile_a(lds + L_KV + (t - 2) * 16384, kb + (size_t)(blk_t - t) * 64 * LDP, vb + (size_t)(blk_t - t) * 64 * LDP, kofP, vofP, wid);
        for (int t = 0; t < nw; ++t) {
            if (t == 2) {
                volatile NLAS unsigned* nslot = (volatile NLAS unsigned*)(lds + L_SEL + 320);
                asm volatile("s_waitcnt vmcnt(0)" ::: "memory");
                if (tid == 0) *nslot = qnext;
                asm volatile("s_waitcnt lgkmcnt(0)" ::: "memory"); __builtin_amdgcn_s_barrier(); asm volatile("" ::: "memory");
                idxN = __builtin_amdgcn_readfirstlane((int)*nslot);
                if (idxN < 1024) {
                    const int nb_ = (idxN & 31) >> 2, ng_ = idxN & 3, nqt_ = 31 - (idxN >> 5);
                    const bf16_t* kcn = KC + ((size_t)(nb_ * NS_G + ng_) * 128) * 64; const bf16_t* vcn = VC + ((size_t)(nb_ * NS_G + ng_) * 128) * 64;
                    unsigned kofc, vofc; tile_offs(kofc, vofc, 64, wid, lane);
                    dma_tile_a(lds + L_PRE, kcn, vcn, kofc, vofc, wid);
                    if (nqt_ >= 16) dma_tile_a(lds + L_PRE + 16384, kcn + 64 * 64, vcn + 64 * 64, kofc, vofc, wid);
                    const bf16_t* qrn = P + ((size_t)nb_ * SEQ + nqt_ * 64 + qi) * LDP; const int hn = ng_ * 4 + (wid >> 1);
#pragma unroll
                    for (int d0 = 0; d0 < 4; ++d0) qn[d0] = *(const bf16x8*)(qrn + C_NQ + hn * 64 + d0 * 16 + hi * 8);
#pragma unroll
                    for (int e = 0; e < 3; ++e) gn[e] = qrn[C_SG + hn * 3 + e];
                }
            }
            NLAS unsigned char* sc = (t < 2) ? lds + L_IMP + t * 16384 : lds + L_KV + (t - 2) * 16384;
            const int j = blk_t - t;
            f32x16 p0, p1, c0, c1; const float kb0 = sl2 * (float)(j * 64 - t0) - m; OPAQUE_HI();
#pragma unroll
            for (int i = 0; i < 16; ++i) { c0[i] = kb0 + sl2 * CRF(i); c1[i] = c0[i] + sl2 * 32.f; }
            qkt(p0, p1, sc, qr, c0, c1, r32, hi);
            if (t == 0 || t == 4) {
                asm volatile("" ::: "memory");
                const int dq = t0 + qi - j * 64;
#pragma unroll
                for (int i = 0; i < 16; ++i) { const int d0_ = dq - crow(i, hiv), d1_ = d0_ - 32; if (d0_ < 0 || d0_ > 255) p0[i] = NEG; if (d1_ < 0 || d1_ > 255) p1[i] = NEG; }
            }
            softmax_step(p0, p1, m, l, o, wsf, r32, hi);
            pv(o, sc + 8192, p0, p1, lane, hi);
        }
        l = xhalf_sum(l);
        acc_rows(tot, o, wsf, gate_w * __builtin_amdgcn_rcpf(l), r32, hi);
    }
    {
        NLAS bf16_t* stg = (NLAS bf16_t*)(lds + L_OST) + wid * 2048;
#pragma unroll
        for (int i = 0; i < 16; ++i) { const int orow = crow(i, hi); stg[orow * 64 + r32] = f2bf(tot[0][i]); stg[orow * 64 + 32 + r32] = f2bf(tot[1][i]); }
        bf16_t* ow = P + (rowbase + t0 + qh * 32) * LDP + C_NQ + head * 64;
#pragma unroll
        for (int i = 0; i < 4; ++i) { const int row = i * 8 + (lane >> 3), ch = lane & 7; const u32x4 v = *(NLAS const u32x4*)(stg + row * 64 + ch * 8); *(u32x4*)((char*)ow + (unsigned)(row * LDP + ch * 8) * 2u) = v; }
    }
    __syncthreads();
    idx_next = idxN;
    if (idxN >= 0) {
#pragma unroll
        for (int d0 = 0; d0 < 4; ++d0) qr[d0] = qn[d0];
#pragma unroll
        for (int e = 0; e < 3; ++e) gq[e] = gn[e];
    }
#undef CRF
#undef OPAQUE_HI
}

__device__ __forceinline__ void norm8(u32x4& v, const float* g8, float sc) {
    float x[8] = {__uint_as_float(v.x << 16), __uint_as_float(v.x & 0xffff0000u), __uint_as_float(v.y << 16), __uint_as_float(v.y & 0xffff0000u),
                  __uint_as_float(v.z << 16), __uint_as_float(v.z & 0xffff0000u), __uint_as_float(v.w << 16), __uint_as_float(v.w & 0xffff0000u)};
    float s = 0.f;
#pragma unroll
    for (int e = 0; e < 8; ++e) s += x[e] * x[e];
    s += __shfl_xor(s, 1); s += __shfl_xor(s, 2); s += __shfl_xor(s, 4);
    const float r = rsqrtf(s * (1.f / 64.f) + EPS) * sc;
    v.x = pk(x[0] * r * g8[0], x[1] * r * g8[1]); v.y = pk(x[2] * r * g8[2], x[3] * r * g8[3]); v.z = pk(x[4] * r * g8[4], x[5] * r * g8[5]); v.w = pk(x[6] * r * g8[6], x[7] * r * g8[7]);
}
__device__ __forceinline__ void prep_units(bf16_t* P, const float* qn, const float* kns, const float* knw, int gw, int NGW, int lane) {
    float gq[8], gk[8];
    const float* kg = (lane < 32) ? kns : knw;
#pragma unroll
    for (int e = 0; e < 8; ++e) { gq[e] = qn[8 * (lane & 7) + e]; gk[e] = kg[8 * (lane & 7) + e]; }
    const int coff = (lane < 32) ? C_KS + 8 * lane : C_KW + 8 * (lane - 32);
    for (int m0 = gw; m0 < M; m0 += 2 * NGW) {
        const int m1 = m0 + NGW; const bool two = m1 < M;
        bf16_t* r0 = P + (size_t)m0 * LDP; bf16_t* r1 = P + (size_t)(two ? m1 : m0) * LDP;
        u32x4 a0 = *(const u32x4*)(r0 + C_NQ + 8 * lane), b0 = *(const u32x4*)(r0 + C_NQ + 512 + 8 * lane), c0 = *(const u32x4*)(r0 + coff);
        u32x4 a1 = *(const u32x4*)(r1 + C_NQ + 8 * lane), b1 = *(const u32x4*)(r1 + C_NQ + 512 + 8 * lane), c1 = *(const u32x4*)(r1 + coff);
        norm8(a0, gq, 0.125f * LOG2E); norm8(b0, gq, 0.125f * LOG2E); norm8(c0, gk, 1.f);
        norm8(a1, gq, 0.125f * LOG2E); norm8(b1, gq, 0.125f * LOG2E); norm8(c1, gk, 1.f);
        *(u32x4*)(r0 + C_NQ + 8 * lane) = a0; *(u32x4*)(r0 + C_NQ + 512 + 8 * lane) = b0; *(u32x4*)(r0 + coff) = c0;
        if (two) { *(u32x4*)(r1 + C_NQ + 8 * lane) = a1; *(u32x4*)(r1 + C_NQ + 512 + 8 * lane) = b1; *(u32x4*)(r1 + coff) = c1; }
    }
}

constexpr int W1P = 2048 + 64;
constexpr int LC_CA = 1040, LC_CB = 2064, LC_SA = 8 * LC_CA, LC_SB = 8 * LC_CB;
constexpr int LC_A = 0, LC_B = 4 * LC_SA, LC_HID = 0, LC_W2 = 4 * LC_SA + 4 * LC_SB;
__device__ __forceinline__ void compress_item(NLAS unsigned char* lds, const bf16_t* P, const bf16_t* W1T, const float* bias1, const float* W2, const float* gain, bf16_t* OUT, int b, int g, int which, int half) {
    const int tid = threadIdx.x, lane = tid & 63, r32 = lane & 31, hi = lane >> 5; const int wid = __builtin_amdgcn_readfirstlane(tid >> 6);
    const int mt = wid >> 2, nt = wid & 3;
    const int ca = tid >> 3, dca = tid & 7; const int cg_ = 64 * half + ca; const int ccl = cg_ < NCMP ? cg_ : NCMP - 1;
    const bf16_t* asrc = P + ((size_t)b * SEQ + 16 * ccl) * LDP + (which ? C_VC : C_KC) + g * 64 + dca * 8;
    const bf16_t* bsrc0 = W1T + (size_t)(tid >> 3) * W1P + (tid & 7) * 8; const bf16_t* bsrc1 = bsrc0 + (size_t)64 * W1P;
    const int adst = dca * LC_CA + ca * 16, bdst0 = (tid & 7) * LC_CB + (tid >> 3) * 16, bdst1 = bdst0 + 64 * 16;
#define CBAR() do { asm volatile("s_waitcnt lgkmcnt(0)" ::: "memory"); __builtin_amdgcn_s_barrier(); asm volatile("" ::: "memory"); } while (0)
#define CLOAD(r_, i_) do { _Pragma("unroll") for (int s_ = 0; s_ < 2; ++s_) { const int l_ = 2 * (i_) + s_; r_[3 * s_] = *(const u32x4*)(asrc + (size_t)l_ * LDP); r_[3 * s_ + 1] = *(const u32x4*)(bsrc0 + l_ * 64); r_[3 * s_ + 2] = *(const u32x4*)(bsrc1 + l_ * 64); } } while (0)
#define CSTORE(r_, buf_) do { _Pragma("unroll") for (int s_ = 0; s_ < 2; ++s_) { *(NLAS u32x4*)(lds + LC_A + ((buf_) * 2 + s_) * LC_SA + adst) = r_[3 * s_]; *(NLAS u32x4*)(lds + LC_B + ((buf_) * 2 + s_) * LC_SB + bdst0) = r_[3 * s_ + 1]; *(NLAS u32x4*)(lds + LC_B + ((buf_) * 2 + s_) * LC_SB + bdst1) = r_[3 * s_ + 2]; } } while (0)
#define CMMA(buf_) do { _Pragma("unroll") for (int s_ = 0; s_ < 2; ++s_) { NLAS const unsigned char* ab = lds + LC_A + ((buf_) * 2 + s_) * LC_SA; NLAS const unsigned char* bb = lds + LC_B + ((buf_) * 2 + s_) * LC_SB; \
        _Pragma("unroll") for (int ds = 0; ds < 4; ++ds) { \
            const bf16x8 a = *(NLAS const bf16x8*)(ab + (2 * ds + hi) * LC_CA + (32 * mt + r32) * 16); \
            const bf16x8 w = *(NLAS const bf16x8*)(bb + (2 * ds + hi) * LC_CB + (32 * nt + r32) * 16); \
            acc = __builtin_amdgcn_mfma_f32_32x32x16_bf16(a, w, acc, 0, 0, 0); } } } while (0)
    {
#pragma unroll
        for (int k = 0; k < 4; ++k) *(NLAS f32x4*)(lds + LC_W2 + (tid + 512 * k) * 16) = *(const f32x4*)(W2 + (tid + 512 * k) * 4);
    }
    u32x4 r0[6], r1[6], r2[6], r3[6];
    CLOAD(r0, 0); CSTORE(r0, 0);
    CLOAD(r1, 1); CLOAD(r2, 2); CLOAD(r3, 3); CLOAD(r0, 4);
    CBAR();
    f32x16 acc = f32x16{};
    for (int i = 0; i < 16; i += 4) {
        CMMA(0); CSTORE(r1, 1); if (i + 5 < 16) CLOAD(r1, i + 5); CBAR();
        CMMA(1); CSTORE(r2, 0); if (i + 6 < 16) CLOAD(r2, i + 6); CBAR();
        CMMA(0); CSTORE(r3, 1); if (i + 7 < 16) CLOAD(r3, i + 7); CBAR();
        CMMA(1); if (i + 4 < 16) { CSTORE(r0, 0); if (i + 8 < 16) CLOAD(r0, i + 8); } CBAR();
    }
#undef CBAR
#undef CLOAD
#undef CSTORE
#undef CMMA
    NLAS float* hid = (NLAS float*)(lds + LC_HID);
    const float bs = bias1[32 * nt + r32];
#pragma unroll
    for (int i = 0; i < 16; ++i) hid[(32 * mt + crow(i, hi)) * 132 + 32 * nt + r32] = gelu_tanh(acc[i] + bs);
    __syncthreads();
    {
        const int row = tid >> 3, e0 = (tid & 7) * 8;
        float o[8];
#pragma unroll
        for (int e = 0; e < 8; ++e) o[e] = 0.f;
#pragma unroll 8
        for (int i = 0; i < 128; ++i) { const float h = hid[row * 132 + i]; const f32x4 wa = *(NLAS const f32x4*)(lds + LC_W2 + (i * 64 + e0) * 4), wb = *(NLAS const f32x4*)(lds + LC_W2 + (i * 64 + e0 + 4) * 4);
            o[0] += h * wa[0]; o[1] += h * wa[1]; o[2] += h * wa[2]; o[3] += h * wa[3]; o[4] += h * wb[0]; o[5] += h * wb[1]; o[6] += h * wb[2]; o[7] += h * wb[3]; }
        if (which == 0) {
            float ss = 0.f;
#pragma unroll
            for (int e = 0; e < 8; ++e) ss += o[e] * o[e];
            ss += __shfl_xor(ss, 1); ss += __shfl_xor(ss, 2); ss += __shfl_xor(ss, 4);
            const float r = rsqrtf(ss * (1.f / 64.f) + EPS);
#pragma unroll
            for (int e = 0; e < 8; ++e) o[e] *= r * gain[e0 + e];
        }
        const int cg = 64 * half + row;
        if (cg >= NCMP) {
#pragma unroll
            for (int e = 0; e < 8; ++e) o[e] = 0.f; }
        u32x4 w; w.x = pk(o[0], o[1]); w.y = pk(o[2], o[3]); w.z = pk(o[4], o[5]); w.w = pk(o[6], o[7]);
        *(u32x4*)(OUT + (((size_t)(b * NS_G + g) * 128) + cg) * 64 + e0) = w;
    }
    __syncthreads();
}
}
namespace pg8 {
#define PG8_LAS __attribute__((address_space(3)))
typedef short bf16x8 __attribute__((ext_vector_type(8)));
typedef float f32x4 __attribute__((ext_vector_type(4)));
typedef float f32x2 __attribute__((ext_vector_type(2)));
typedef unsigned u32x4 __attribute__((ext_vector_type(4)));
typedef unsigned u32x2 __attribute__((ext_vector_type(2)));
constexpr int BM = 256, BK = 64, HALF = 128, HTB = HALF * BK * 2, STAGE_BYTES = 8 * HTB, NXCD = 8, WGM = 8;

__host__ __device__ __forceinline__ int lds_byte(int r, int c) { const int st = (r >> 4) * 2 + (c >> 5), rr = r & 15, cc = c & 31, ob = rr * 64 + cc * 2; return st * 1024 + (ob ^ (((ob >> 9) & 1) << 5)); }
__host__ __device__ __forceinline__ void stage_rc(int b, int& R, int& C) { const int st = b / 1024, sb = b % 1024, swz = sb ^ (((sb >> 9) & 1) << 5); R = (st >> 1) * 16 + swz / 64; C = (st & 1) * 32 + (swz % 64) / 2; }
__host__ __device__ __forceinline__ int perm32(int rho) { const int n = rho >> 4, i = rho & 15; return 8 * (i >> 2) + 4 * n + (i & 3); }

struct Unit { int pm, pn, ks; };
struct Gemm { const bf16_t* A; const bf16_t* Bt; int lda, ldb; int M, N, K; int ksoff; };

struct StaticOrder {
    int nM, nN, nwg, G, c;
    __host__ __device__ __forceinline__ void init(int M_, int N_, int G_, int c_) { nM = M_ / BM; nN = N_ / BM; nwg = nM * nN; G = G_; c = c_; }
    __host__ __device__ __forceinline__ bool next(int i, Unit& u) const {
        const long L = (long)i * G + c; if (L >= nwg) return false;
        int wgid = (int)L; { const int q = nwg / NXCD, r = nwg % NXCD, xcd = wgid % NXCD, off = wgid / NXCD; wgid = (xcd < r ? xcd * (q + 1) : r * (q + 1) + (xcd - r) * q) + off; }
        const int nig = WGM * nN, gid = wgid / nig, fm = gid * WGM, gsz = (nM - fm) < WGM ? (nM - fm) : WGM;
        u.pm = fm + ((wgid % nig) % gsz); u.pn = (wgid % nig) / gsz; u.ks = 0; return true;
    }
};
struct RevOrder {
    StaticOrder base;
    __host__ __device__ __forceinline__ bool next(int i, Unit& u) const { if (!base.next(i, u)) return false; u.pn = base.nN - 1 - u.pn; return true; }
};
struct GatePairOrder {
    StaticOrder base;
    __host__ __device__ __forceinline__ bool next(int i, Unit& u) const { if (!base.next(i >> 1, u)) return false; u.pn += 4 * (i & 1); u.ks = 0; return true; }
};
struct TwoPassOrder {
    StaticOrder base;
    __host__ __device__ __forceinline__ bool next(int i, Unit& u) const { if (!base.next(i >> 1, u)) return false; u.ks = i & 1; return true; }
};

typedef __bf16 bf16x2_t __attribute__((ext_vector_type(2)));
__device__ __forceinline__ unsigned cvt_pk_bf16(float lo, float hi) { f32x2 v = {lo, hi}; bf16x2_t b = __builtin_convertvector(v, bf16x2_t); return __builtin_bit_cast(unsigned, b); }
__device__ __forceinline__ float fast_sigmoid(float x) { return __builtin_amdgcn_rcpf(1.f + __builtin_amdgcn_exp2f(-1.4426950408889634f * x)); }
__device__ __forceinline__ float bflo(unsigned w) { return __uint_as_float(w << 16); }
__device__ __forceinline__ float bfhi(unsigned w) { return __uint_as_float(w & 0xffff0000u); }

typedef f32x4 Acc[2][2][4][2];

template <int ACT> struct EpiP {
    __device__ __forceinline__ bool keep(const Unit&) const { return false; }
    static constexpr bool PERM = true;
    bf16_t* O; int ldc; int pn_last; int ncol_last; bf16_t* halo;
    __device__ __forceinline__ void operator()(const Acc& acc, const Unit& u, int wr, int wc, int fr, int fq) const {
        const int row0 = u.pm * BM + wr * 64 + fr, tcol = wc * 32 + 8 * fq;
        const int lim = (u.pn == pn_last) ? ncol_last : 256;
#pragma unroll
        for (int ai = 0; ai < 2; ++ai)
#pragma unroll
            for (int m = 0; m < 4; ++m) { bf16_t* rowp = O + (size_t)(row0 + ai * HALF + m * 16) * ldc + u.pn * BM + tcol;
#pragma unroll
                for (int bj = 0; bj < 2; ++bj) { if (tcol + bj * HALF >= lim) continue;
                    f32x4 v0 = acc[ai][bj][m][0], v1 = acc[ai][bj][m][1];
                    if (ACT == 1) {
#pragma unroll
                        for (int e = 0; e < 4; ++e) { v0[e] = fast_sigmoid(v0[e]); v1[e] = fast_sigmoid(v1[e]); } }
                    u32x4 w; w.x = cvt_pk_bf16(v0[0], v0[1]); w.y = cvt_pk_bf16(v0[2], v0[3]); w.z = cvt_pk_bf16(v1[0], v1[1]); w.w = cvt_pk_bf16(v1[2], v1[3]);
                    *(u32x4*)(rowp + bj * HALF) = w;
                    if (ACT == 0 && m == 3 && fr >= 13 && u.pn < 12 && halo) { const int row = row0 + ai * HALF + 48;
                        *(u32x4*)(halo + ((size_t)(row >> 6) * 3 + (fr - 13)) * 3072 + u.pn * BM + tcol + bj * HALF) = w; } } }
    }
};
struct EpiP3 {
    __device__ __forceinline__ bool keep(const Unit&) const { return false; }
    static constexpr int PERM = 3;
    bf16_t* O; int ldc; int pn_last; int ncol_last; bf16_t* halo;
    const float* gtab;
    __device__ __forceinline__ void operator()(const Acc& acc, const Unit& u, int wr, int wc, int fr, int fq) const {
        const int row0 = u.pm * BM + wr * 64 + fr, tcol = wc * 64 + 8 * fq;
        const int lim = (u.pn == pn_last) ? ncol_last : 256;
        if (tcol >= lim) return;
        const int mode = (u.pn >= C_NQ / 256 && u.pn < C_NQ / 256 + 4) ? 1 : (u.pn == C_KS / 256 ? 2 : (u.pn == C_KW / 256 ? 3 : 0));
        if (mode) {
            const float* gp = gtab + (mode - 1) * 64 + 8 * fq;
#pragma unroll
            for (int ai = 0; ai < 2; ++ai)
#pragma unroll
                for (int m = 0; m < 4; ++m) { bf16_t* rowp = O + (size_t)(row0 + ai * HALF + m * 16) * ldc + u.pn * BM + tcol;
                    asm volatile("" ::: "memory");
                    float s = 0.f;
#pragma unroll
                    for (int bj = 0; bj < 2; ++bj)
#pragma unroll
                        for (int n = 0; n < 2; ++n) { const f32x4 t = acc[ai][bj][m][n]; s += (t[0] * t[0] + t[1] * t[1]) + (t[2] * t[2] + t[3] * t[3]); }
                    { const auto p = __builtin_amdgcn_permlane16_swap(__float_as_uint(s), __float_as_uint(s), false, false); s = __uint_as_float(p[0]) + __uint_as_float(p[1]); }
                    { const auto p = __builtin_amdgcn_permlane32_swap(__float_as_uint(s), __float_as_uint(s), false, false); s = __uint_as_float(p[0]) + __uint_as_float(p[1]); }
                    const float r = rsqrtf(s * (1.f / 64.f) + EPS);
#pragma unroll
                    for (int bj = 0; bj < 2; ++bj) {
                        const f32x4 v0 = acc[ai][bj][m][0] * r * *(const f32x4*)(gp + 32 * bj), v1 = acc[ai][bj][m][1] * r * *(const f32x4*)(gp + 32 * bj + 4);
                        u32x4 w; w.x = cvt_pk_bf16(v0[0], v0[1]); w.y = cvt_pk_bf16(v0[2], v0[3]); w.z = cvt_pk_bf16(v1[0], v1[1]); w.w = cvt_pk_bf16(v1[2], v1[3]);
                        *(u32x4*)(rowp + bj * 32) = w; } }
            return;
        }
#pragma unroll
        for (int ai = 0; ai < 2; ++ai)
#pragma unroll
            for (int m = 0; m < 4; ++m) { bf16_t* rowp = O + (size_t)(row0 + ai * HALF + m * 16) * ldc + u.pn * BM + tcol;
#pragma unroll
                for (int bj = 0; bj < 2; ++bj) {
                    const f32x4 v0 = acc[ai][bj][m][0], v1 = acc[ai][bj][m][1];
                    u32x4 w; w.x = cvt_pk_bf16(v0[0], v0[1]); w.y = cvt_pk_bf16(v0[2], v0[3]); w.z = cvt_pk_bf16(v1[0], v1[1]); w.w = cvt_pk_bf16(v1[2], v1[3]);
                    *(u32x4*)(rowp + bj * 32) = w;
                    if (m == 3 && fr >= 13 && u.pn < 12 && halo) { const int row = row0 + ai * HALF + 48;
                        *(u32x4*)(halo + ((size_t)(row >> 6) * 3 + (fr - 13)) * 3072 + u.pn * BM + tcol + bj * 32) = w; } } }
    }
};
struct EpiMix {
    static constexpr bool PERM = true;
    const bf16_t* G; int ldg; bf16_t* O; int ldc;
    __device__ __forceinline__ bool keep(const Unit& u) const { return u.ks == 0; }
    __device__ __forceinline__ void operator()(Acc& acc, const Unit& u, int wr, int wc, int fr, int fq) const {
        const int row0 = u.pm * BM + wr * 64 + fr, col0 = u.pn * BM + wc * 32 + 8 * fq;
#pragma unroll
        for (int ai = 0; ai < 2; ++ai)
#pragma unroll
            for (int m = 0; m < 4; ++m) { const size_t row = (size_t)(row0 + ai * HALF + m * 16); const bf16_t* gp = G + row * ldg + col0; bf16_t* rowp = O + row * ldc + col0;
#pragma unroll
                for (int bj = 0; bj < 2; ++bj) { const u32x4 b = *(const u32x4*)(gp + bj * HALF + 1024);
                    f32x4 v0 = acc[ai][bj][m][0], v1 = acc[ai][bj][m][1];
                    if (u.ks == 0) { const u32x4 a = *(const u32x4*)(gp + bj * HALF);
                        v0[0] *= bflo(a.x) * __builtin_amdgcn_rcpf(bflo(b.x)); v0[1] *= bfhi(a.x) * __builtin_amdgcn_rcpf(bfhi(b.x)); v0[2] *= bflo(a.y) * __builtin_amdgcn_rcpf(bflo(b.y)); v0[3] *= bfhi(a.y) * __builtin_amdgcn_rcpf(bfhi(b.y));
                        v1[0] *= bflo(a.z) * __builtin_amdgcn_rcpf(bflo(b.z)); v1[1] *= bfhi(a.z) * __builtin_amdgcn_rcpf(bfhi(b.z)); v1[2] *= bflo(a.w) * __builtin_amdgcn_rcpf(bflo(b.w)); v1[3] *= bfhi(a.w) * __builtin_amdgcn_rcpf(bfhi(b.w));
                        acc[ai][bj][m][0] = v0; acc[ai][bj][m][1] = v1;
                    } else {
                        u32x4 w; w.x = cvt_pk_bf16(v0[0] * bflo(b.x), v0[1] * bfhi(b.x)); w.y = cvt_pk_bf16(v0[2] * bflo(b.y), v0[3] * bfhi(b.y));
                        w.z = cvt_pk_bf16(v1[0] * bflo(b.z), v1[1] * bfhi(b.z)); w.w = cvt_pk_bf16(v1[2] * bflo(b.w), v1[3] * bfhi(b.w));
                        *(u32x4*)(rowp + bj * HALF) = w; } }
                if (u.ks == 0 && (m & 1)) asm volatile("" ::: "memory"); }
    }
};
struct EpiOut {
    __device__ __forceinline__ bool keep(const Unit&) const { return false; }
    static constexpr bool PERM = true;
    const float* X; bf16_t* Xb; float* pss;
    __device__ __forceinline__ void operator()(const Acc& acc, const Unit& u, int wr, int wc, int fr, int fq) const {
        const int row0 = u.pm * BM + wr * 64 + fr, col0 = u.pn * BM + wc * 32 + 8 * fq;
#pragma unroll
        for (int ai = 0; ai < 2; ++ai)
#pragma unroll
            for (int m = 0; m < 4; ++m) { const size_t row = (size_t)(row0 + ai * HALF + m * 16); const size_t off = row * D + col0; float ss = 0.f;
#pragma unroll
                for (int bj = 0; bj < 2; ++bj) { const f32x4* xp = (const f32x4*)(X + off + bj * HALF);
                    const f32x4 a = xp[0] + acc[ai][bj][m][0], b = xp[1] + acc[ai][bj][m][1];
                    ss += ((a[0] * a[0] + a[1] * a[1]) + (a[2] * a[2] + a[3] * a[3])) + ((b[0] * b[0] + b[1] * b[1]) + (b[2] * b[2] + b[3] * b[3]));
                    u32x4 w; w.x = cvt_pk_bf16(a[0], a[1]); w.y = cvt_pk_bf16(a[2], a[3]); w.z = cvt_pk_bf16(b[0], b[1]); w.w = cvt_pk_bf16(b[2], b[3]);
                    *(u32x4*)(Xb + off + bj * HALF) = w; }
                ss += __shfl_xor(ss, 16); ss += __shfl_xor(ss, 32);
                if (fq == 0) pss[row * 16 + u.pn * 4 + wc] = ss; }
    }
};
struct EpiUp {
    __device__ __forceinline__ bool keep(const Unit&) const { return false; }
    static constexpr bool PERM = true;
    const float* pss; bf16_t* O; int ldc; const PG8_LAS float* tab;
    __device__ __forceinline__ void operator()(const Acc& acc, const Unit& u, int wr, int wc, int fr, int fq) const {
        const int row0 = u.pm * BM + wr * 64 + fr, col0 = u.pn * BM + wc * 32 + 8 * fq;
#pragma unroll
        for (int ai = 0; ai < 2; ++ai)
#pragma unroll
            for (int m = 0; m < 4; ++m) { const size_t row = (size_t)(row0 + ai * HALF + m * 16);
                float rstd;
                if (tab) rstd = tab[u.ks * BM + wr * 64 + fr + ai * HALF + m * 16];
                else { const f32x4* pp = (const f32x4*)(pss + row * 16); const f32x4 s4 = (pp[0] + pp[1]) + (pp[2] + pp[3]); rstd = rsqrtf(((s4[0] + s4[1]) + (s4[2] + s4[3])) * (1.f / D) + EPS); }
                bf16_t* rowp = O + row * ldc + col0;
#pragma unroll
                for (int bj = 0; bj < 2; ++bj) { f32x4 v0 = acc[ai][bj][m][0] * rstd, v1 = acc[ai][bj][m][1] * rstd;
#pragma unroll
                    for (int e = 0; e < 4; ++e) { const float a = fmaxf(v0[e], 0.f), b = fmaxf(v1[e], 0.f); v0[e] = a * a; v1[e] = b * b; }
                    u32x4 w; w.x = cvt_pk_bf16(v0[0], v0[1]); w.y = cvt_pk_bf16(v0[2], v0[3]); w.z = cvt_pk_bf16(v1[0], v1[1]); w.w = cvt_pk_bf16(v1[2], v1[3]);
                    *(u32x4*)(rowp + bj * HALF) = w; } }
    }
};
struct IndexedOrder {
    StaticOrder base;
    __host__ __device__ __forceinline__ bool next(int i, Unit& u) const { if (!base.next(i, u)) return false; u.ks = i; return true; }
};
struct EpiDown {
    __device__ __forceinline__ bool keep(const Unit&) const { return false; }
    static constexpr bool PERM = true;
    const bf16_t* Xb; float* O;
    __device__ __forceinline__ void operator()(const Acc& acc, const Unit& u, int wr, int wc, int fr, int fq) const {
        const int row0 = u.pm * BM + wr * 64 + fr, col0 = u.pn * BM + wc * 32 + 8 * fq;
#pragma unroll
        for (int ai = 0; ai < 2; ++ai)
#pragma unroll
            for (int m = 0; m < 4; ++m) { const size_t off = (size_t)(row0 + ai * HALF + m * 16) * D + col0;
#pragma unroll
                for (int bj = 0; bj < 2; ++bj) { const u32x4 w = *(const u32x4*)(Xb + off + bj * HALF); f32x4* op = (f32x4*)(O + off + bj * HALF);
                    op[0] = (f32x4){bflo(w.x), bfhi(w.x), bflo(w.y), bfhi(w.y)} + acc[ai][bj][m][0];
                    op[1] = (f32x4){bflo(w.z), bfhi(w.z), bflo(w.w), bfhi(w.w)} + acc[ai][bj][m][1]; } }
    }
};

template <class Epi, class Sched, bool ALIGN_EPI>
__device__ __forceinline__ void gemm_phase(PG8_LAS unsigned char* lds, const Gemm g, const Sched& S, const Epi& E) {
    const int tid = threadIdx.x, wid = __builtin_amdgcn_readfirstlane(tid >> 6), lane = tid & 63, wr = wid >> 2, wc = wid & 3, fr = lane & 15, fq = lane >> 4;
    const int K = g.K, nt = K / BK, lda = g.lda, ldb = g.ldb;
    unsigned voffA[2], voffB[2];
#pragma unroll
    for (int i = 0; i < 2; ++i) { int R, C; stage_rc(tid * 16 + i * 8192, R, C); const int Rb = (int)Epi::PERM == 3 ? (64 * (R >> 5) + 8 * ((R >> 2) & 3) + 4 * ((R >> 4) & 1) + (R & 3)) : (Epi::PERM ? ((R & ~31) + perm32(R & 31)) : R);
        voffA[i] = (unsigned)(R * lda + C) * 2u; voffB[i] = (unsigned)(Rb * ldb + C) * 2u; }
    const size_t kstep = (size_t)(BK * 2);
    const size_t hstepA = (size_t)HALF * lda * 2, hstepB = (size_t)((int)Epi::PERM == 3 ? 32 : HALF) * ldb * 2;
    const size_t tstepA = 2 * hstepA, tstepB = (size_t)BM * ldb * 2;
    const unsigned ldsw = (unsigned)wid * 1024u;
    const int aoff = lds_byte(wr * 64 + fr, fq * 8), boff = lds_byte(wc * 32 + fr, fq * 8);
#define PG8_SA(b, h) (((b) * 2 + (h)) * HTB)
#define PG8_SB(b, h) ((4 + (b) * 2 + (h)) * HTB)
#define PG8_STAGE(bufoff, gbase, voff) do { _Pragma("unroll") for (int _i = 0; _i < 2; ++_i) \
        __builtin_amdgcn_global_load_lds((const unsigned*)((const char*)(gbase) + (voff)[_i]), (PG8_LAS unsigned*)(lds + (bufoff) + ldsw + _i * 8192), 16, 0, 0); } while (0)
#define PG8_LDA(dst, b, h) do { _Pragma("unroll") for (int m = 0; m < 4; ++m) _Pragma("unroll") for (int k = 0; k < 2; ++k) dst[m][k] = *(const PG8_LAS bf16x8*)(lds + PG8_SA(b, h) + aoff + m * 2048 + k * 1024); } while (0)
#define PG8_LDB(dst, b, h) do { _Pragma("unroll") for (int n = 0; n < 2; ++n) _Pragma("unroll") for (int k = 0; k < 2; ++k) dst[n][k] = *(const PG8_LAS bf16x8*)(lds + PG8_SB(b, h) + boff + n * 2048 + k * 1024); } while (0)
#define PG8_MMA(ai, bj, At, Bt) do { __builtin_amdgcn_s_setprio(1); _Pragma("unroll") for (int m = 0; m < 4; ++m) _Pragma("unroll") for (int n = 0; n < 2; ++n) _Pragma("unroll") for (int k = 0; k < 2; ++k) \
        acc[ai][bj][m][n] = __builtin_amdgcn_mfma_f32_16x16x32_bf16(Bt[n][k], At[m][k], acc[ai][bj][m][n], 0, 0, 0); __builtin_amdgcn_s_setprio(0); } while (0)
#define PG8_WAIT_V(n) asm volatile("s_waitcnt vmcnt(" #n ")" ::: "memory")
#define PG8_WAIT_L(n) asm volatile("s_waitcnt lgkmcnt(" #n ")" ::: "memory")
#define PG8_BAR __builtin_amdgcn_s_barrier()
#define PG8_SCHED __builtin_amdgcn_sched_barrier(0)
#define PG8_KBODY(t) do { \
            const bool last = (t == nt - 2); \
            const char* a1 = cA + (size_t)(t + 1) * kstep; \
            const char* a2 = last ? nA : cA + (size_t)(t + 2) * kstep; const char* b2 = last ? nB : cB + (size_t)(t + 2) * kstep; \
            const char* a3 = a2 + kstep; const char* b3 = b2 + kstep; \
            PG8_LDB(B0, 0, 0); PG8_LDB(B1, 0, 1); PG8_SCHED; PG8_LDA(At, 0, 0); PG8_STAGE(PG8_SA(1, 1), a1 + hstepA, voffA); \
            PG8_WAIT_V(8); PG8_WAIT_L(0); PG8_BAR; PG8_MMA(0, 0, At, B0); PG8_MMA(0, 1, At, B1); PG8_BAR; PG8_SCHED; \
            PG8_LDA(At, 0, 1); PG8_STAGE(PG8_SB(0, 0), b2, voffB); PG8_STAGE(PG8_SB(0, 1), b2 + hstepB, voffB); PG8_STAGE(PG8_SA(0, 0), a2, voffA); \
            PG8_WAIT_V(8); PG8_WAIT_L(0); PG8_BAR; PG8_MMA(1, 0, At, B0); PG8_MMA(1, 1, At, B1); PG8_BAR; PG8_SCHED; \
            PG8_LDB(B0, 1, 0); PG8_LDB(B1, 1, 1); PG8_SCHED; PG8_LDA(At, 1, 0); PG8_STAGE(PG8_SA(0, 1), a2 + hstepA, voffA); \
            PG8_WAIT_V(8); PG8_WAIT_L(0); PG8_BAR; PG8_MMA(0, 0, At, B0); PG8_MMA(0, 1, At, B1); PG8_BAR; PG8_SCHED; \
            PG8_LDA(At, 1, 1); PG8_STAGE(PG8_SB(1, 0), b3, voffB); PG8_STAGE(PG8_SB(1, 1), b3 + hstepB, voffB); PG8_STAGE(PG8_SA(1, 0), a3, voffA); \
            PG8_WAIT_V(8); PG8_WAIT_L(0); PG8_BAR; PG8_MMA(1, 0, At, B0); PG8_MMA(1, 1, At, B1); PG8_BAR; PG8_SCHED; \
        } while (0)
    Unit cur, nxt; int ui = 0;
    if (!S.next(0, cur)) return;
    Acc acc;
#pragma unroll
    for (int a = 0; a < 2; ++a)
#pragma unroll
        for (int b = 0; b < 2; ++b)
#pragma unroll
            for (int m = 0; m < 4; ++m)
#pragma unroll
                for (int n = 0; n < 2; ++n) acc[a][b][m][n] = (f32x4){0.f, 0.f, 0.f, 0.f};
    bf16x8 At[4][2], B0[2][2], B1[2][2];
    const char* cA = (const char*)g.A + (size_t)cur.pm * tstepA + (size_t)cur.ks * g.ksoff * 2; const char* cB = (const char*)g.Bt + (size_t)cur.pn * tstepB + (size_t)cur.ks * g.ksoff * 2;
    PG8_STAGE(PG8_SB(0, 0), cB, voffB); PG8_STAGE(PG8_SB(0, 1), cB + hstepB, voffB); PG8_STAGE(PG8_SA(0, 0), cA, voffA); PG8_STAGE(PG8_SA(0, 1), cA + hstepA, voffA);
    if (wr == 1) PG8_BAR;
    PG8_WAIT_V(2); PG8_BAR;
    PG8_STAGE(PG8_SB(1, 0), cB + kstep, voffB); PG8_STAGE(PG8_SA(1, 0), cA + kstep, voffA); PG8_STAGE(PG8_SB(1, 1), cB + hstepB + kstep, voffB);
    PG8_WAIT_V(6); PG8_BAR;
    for (;;) {
        const bool has_next = S.next(ui + 1, nxt);
        const char* nA = has_next ? (const char*)g.A + (size_t)nxt.pm * tstepA + (size_t)nxt.ks * g.ksoff * 2 : cA; const char* nB = has_next ? (const char*)g.Bt + (size_t)nxt.pn * tstepB + (size_t)nxt.ks * g.ksoff * 2 : cB;
        for (int t = 0; t < nt; t += 2) PG8_KBODY(t);
        if constexpr (ALIGN_EPI) { if (wr == 0) PG8_BAR; }
        E(acc, cur, wr, wc, fr, fq);
        if (!has_next) break;
        if (!E.keep(cur)) {
#pragma unroll
        for (int a = 0; a < 2; ++a)
#pragma unroll
            for (int b = 0; b < 2; ++b)
#pragma unroll
                for (int m = 0; m < 4; ++m)
#pragma unroll
                    for (int n = 0; n < 2; ++n) acc[a][b][m][n] = (f32x4){0.f, 0.f, 0.f, 0.f};
        }
        cur = nxt; cA = nA; cB = nB; ++ui;
        if constexpr (ALIGN_EPI) { if (wr == 1) PG8_BAR; }
    }
    PG8_WAIT_V(0);
    if constexpr (!ALIGN_EPI) { if (wr == 0) PG8_BAR; }
    PG8_BAR;
#undef PG8_SA
#undef PG8_SB
#undef PG8_STAGE
#undef PG8_LDA
#undef PG8_LDB
#undef PG8_MMA
#undef PG8_WAIT_V
#undef PG8_WAIT_L
#undef PG8_BAR
#undef PG8_SCHED
#undef PG8_KBODY
}
}

#define GAS __attribute__((address_space(1)))
#define LAS __attribute__((address_space(3)))
typedef unsigned v4u __attribute__((ext_vector_type(4)));
typedef float f32x4 __attribute__((ext_vector_type(4)));
constexpr int NWAVES = 8;
constexpr int LDS_BYTES = 163840;
constexpr size_t MiB = 1u << 20;
constexpr size_t WS_PSS = 1 * MiB, WS_WOUT = 2 * MiB, WS_P = 4 * MiB, WS_KC = 214 * MiB, WS_VC = 215 * MiB, WS_MIX = 216 * MiB;
constexpr size_t WS_AN = 4 * MiB, WS_UP = 64 * MiB, WS_WUP = 248 * MiB, WS_WDOWN = 200 * MiB;
constexpr size_t WS_BIAS1 = 131072 + 16384, WS_W1T = 214 * MiB, WS_KCB = 215 * MiB, WS_VCB = 215 * MiB + 512 * 1024;
constexpr size_t WS_GLV = 4096, WS_QCNT = 65536, WS_GW = 216 * MiB, DO_GQK = 40 * MiB, DO_HALO = 56 * MiB;
constexpr size_t WS_GTAB3 = 262144;
constexpr size_t WS_XBAR = 131072;
constexpr size_t DO_H = 0, DO_WG = 32 * MiB, DO_WCAT = 36 * MiB, DO_WIN = 40 * MiB, DO_W1T = 61 * MiB;

__device__ __forceinline__ unsigned pk2(float lo, float hi) { return (unsigned)f2bf(lo) | ((unsigned)f2bf(hi) << 16); }
__device__ __forceinline__ float wave_sum(float v) {
#pragma unroll
    for (int o = 1; o < 64; o <<= 1) v += __shfl_xor(v, o);
    return v;
}
template <class SrcCol>
__device__ __forceinline__ void transpose_item(const float* W, int ldw, const SrcCol& srccol, bf16_t* WT, int ldk, int kofs, LAS float* scr, int kb, int nb, int lane, const float* ksc = nullptr) {
    const int k0 = 64 * kb, n0 = 64 * nb; const int n4 = (lane & 15) * 4; const int sc = srccol(n0 + n4);
    f32x4 v[16];
    const float* wp = W + (size_t)(k0 + (lane >> 4)) * ldw + (sc >= 0 ? sc : 0);
#pragma unroll
    for (int i = 0; i < 16; ++i) v[i] = *(const f32x4*)(wp + (size_t)(4 * i) * ldw);
#pragma unroll
    for (int i = 0; i < 16; ++i) { const int kk = 4 * i + (lane >> 4); const f32x4 u = (sc >= 0) ? v[i] : (f32x4){0.f, 0.f, 0.f, 0.f};
        scr[kk * 65 + n4] = u[0]; scr[kk * 65 + n4 + 1] = u[1]; scr[kk * 65 + n4 + 2] = u[2]; scr[kk * 65 + n4 + 3] = u[3]; }
    asm volatile("s_waitcnt lgkmcnt(0)" ::: "memory");
    const int c = lane & 7;
    f32x4 ga = {1.f, 1.f, 1.f, 1.f}, gb = ga;
    if (ksc) { ga = *(const f32x4*)(ksc + k0 + 8 * c); gb = *(const f32x4*)(ksc + k0 + 8 * c + 4); }
#pragma unroll
    for (int j = 0; j < 8; ++j) { const int n = (lane >> 3) + 8 * j; const LAS float* sp = scr + (8 * c) * 65 + n;
        v4u o; o.x = pk2(sp[0 * 65] * ga[0], sp[1 * 65] * ga[1]); o.y = pk2(sp[2 * 65] * ga[2], sp[3 * 65] * ga[3]); o.z = pk2(sp[4 * 65] * gb[0], sp[5 * 65] * gb[1]); o.w = pk2(sp[6 * 65] * gb[2], sp[7 * 65] * gb[3]);
        *(v4u*)(WT + (size_t)(n0 + n) * ldk + kofs + k0 + 8 * c) = o; }
    asm volatile("s_waitcnt lgkmcnt(0)" ::: "memory");
}
struct SrcIdent { int off; __device__ __forceinline__ int operator()(int n) const { return n + off; } };
struct SrcWin { __device__ __forceinline__ int operator()(int n) const { return n < 4096 ? n : (n < 6656 ? n + 16 : (n < 6672 ? n - 6656 + 4096 : (n < 6720 ? n : -1))); } };

typedef GAS unsigned gu32;
#define RLX_AGENT __ATOMIC_RELAXED, __HIP_MEMORY_SCOPE_AGENT
#define XB_TMO      128
#define XB_XCNT(j)  (256  + 64 * (j))
#define XB_XSUB(j)  (1280 + 64 * (j))
#define XB_XGEN(j)  (2304 + 64 * (j))
#define XB_TOP      3328
#define XB_TOPGEN   3392
#define XCD_BAR_WORDS 3456
#define XB_SPIN_CAP (1u << 18)

__device__ __forceinline__ unsigned xb_ld(unsigned* p)              { return __hip_atomic_load(p, __ATOMIC_RELAXED, __HIP_MEMORY_SCOPE_AGENT); }
__device__ __forceinline__ unsigned xb_add(unsigned* p, unsigned v) { return __hip_atomic_fetch_add(p, v, __ATOMIC_RELAXED, __HIP_MEMORY_SCOPE_AGENT); }
__device__ __forceinline__ unsigned xb_xcc_id() { return (unsigned)__builtin_amdgcn_s_getreg((3 << 11) | 20) & 0xFu; }
#define XB_SPIN(cond, bar) do { unsigned _sp = 0; while (cond) { __builtin_amdgcn_s_sleep(1); \
    if ((++_sp & 255u) == 0u) { if (xb_ld(&(bar)[XB_TMO])) break; if (_sp > XB_SPIN_CAP) { atomicAdd(&(bar)[XB_TMO], 1u); break; } } } } while (0)

struct XcdBarrier {
    unsigned* bar; unsigned x;
    volatile LAS unsigned* st;
};

__device__ __forceinline__ XcdBarrier xcd_barrier_post(unsigned* bar, volatile LAS unsigned* st) {
    XcdBarrier b; b.bar = bar; b.x = xb_xcc_id(); b.st = st;
    if (threadIdx.x == 0) (void)xb_add(&bar[XB_XCNT(b.x)], 1u);
    return b;
}
__device__ __forceinline__ void xcd_barrier_complete(unsigned* bar, unsigned x, unsigned& nloc, unsigned& nx) {
    const unsigned G = gridDim.x * gridDim.y * gridDim.z;
    unsigned sum, cnt, mine, sp = 0u;
    for (;;) {
        sum = 0u; cnt = 0u; mine = 0u;
#pragma unroll
        for (unsigned j = 0; j < 16; ++j) { const unsigned c = xb_ld(&bar[XB_XCNT(j)]); sum += c; cnt += (c > 0u) ? 1u : 0u; mine = (j == x) ? c : mine; }
        if (sum == G) break;
        __builtin_amdgcn_s_sleep(1);
        if ((++sp & 255u) == 0u) { if (xb_ld(&bar[XB_TMO])) break; if (sp > XB_SPIN_CAP) { atomicAdd(&bar[XB_TMO], 1u); break; } }
    }
    nloc = mine > 0u ? mine : 1u; nx = cnt > 0u ? cnt : 1u;
}

__device__ __forceinline__ void xcd_barrier(const XcdBarrier& b) {
    asm volatile("s_waitcnt vmcnt(0)" ::: "memory");
    __syncthreads();
    if (threadIdx.x == 0) {
        unsigned* bar = b.bar;
        __builtin_amdgcn_s_waitcnt(0);
        unsigned nloc = b.st[0], nx = b.st[1];
        if (nloc == 0u) { xcd_barrier_complete(bar, b.x, nloc, nx); b.st[0] = nloc; b.st[1] = nx; }
        const unsigned old = xb_add(&bar[XB_XSUB(b.x)], 1u);
        const unsigned gen = old / nloc;
        if (old + 1u == (gen + 1u) * nloc) {
            __builtin_amdgcn_fence(__ATOMIC_RELEASE, "agent");
            asm volatile("s_waitcnt vmcnt(0)" ::: "memory");
            const unsigned og = xb_add(&bar[XB_TOP], 1u);
            const unsigned tg = og / nx;
            if (og + 1u == (tg + 1u) * nx) xb_add(&bar[XB_TOPGEN], 1u);
            else XB_SPIN(xb_ld(&bar[XB_TOPGEN]) == tg, bar);
            __builtin_amdgcn_fence(__ATOMIC_ACQUIRE, "agent");
            xb_add(&bar[XB_XGEN(b.x)], 1u);
            asm volatile("s_waitcnt vmcnt(0)" ::: "memory");
        } else {
            XB_SPIN(xb_ld(&bar[XB_XGEN(b.x)]) == gen, bar);
            __builtin_amdgcn_fence(__ATOMIC_ACQUIRE, "agent");
            asm volatile("s_waitcnt vmcnt(0)" ::: "memory");
        }
    }
    __syncthreads();
}


struct Args { const float* in[23]; float* out; unsigned char* ws; int ph_lo, ph_hi; };

__global__ void __launch_bounds__(NWAVES * 64, 2) mk_fwd(Args args) {
    extern __shared__ __attribute__((aligned(16))) unsigned char lds_raw[];
    LAS unsigned char* lds = (LAS unsigned char*)lds_raw;
    __builtin_assume(__builtin_amdgcn_workitem_id_y() == 0); __builtin_assume(__builtin_amdgcn_workitem_id_z() == 0);
    cg::grid_group grid = cg::this_grid();
    const int wave = __builtin_amdgcn_readfirstlane((int)threadIdx.x >> 6);
#define tid ((int)threadIdx.x)
#define lane ((int)(threadIdx.x & 63u))
    const int G = gridDim.x, gw = blockIdx.x * NWAVES + wave, NGW = G * NWAVES;
    unsigned char* ws = args.ws; unsigned char* dob = (unsigned char*)args.out;
    const float* x = args.in[0];
    bf16_t* P = (bf16_t*)(ws + WS_P);
    bf16_t* Hb = (bf16_t*)(dob + DO_H); bf16_t* Wg_t = (bf16_t*)(dob + DO_WG); bf16_t* Wcat_t = (bf16_t*)(dob + DO_WCAT); bf16_t* Win_t = (bf16_t*)(dob + DO_WIN);
    bf16_t* Wout_t = (bf16_t*)(ws + WS_WOUT); bf16_t* Wup_t = (bf16_t*)(ws + WS_WUP); bf16_t* Wdown_t = (bf16_t*)(ws + WS_WDOWN);
    bf16_t* Mix = (bf16_t*)(ws + WS_MIX); bf16_t* An = (bf16_t*)(ws + WS_AN); bf16_t* Up = (bf16_t*)(ws + WS_UP); float* pss = (float*)(ws + WS_PSS);
    LAS float* scr = (LAS float*)(lds + wave * 17408);
    bf16_t* Halo = (bf16_t*)(dob + DO_HALO); bf16_t* GWb = (bf16_t*)(ws + WS_GW); bf16_t* GQKb = (bf16_t*)(dob + DO_GQK); float* GLv = (float*)(ws + WS_GLV); unsigned* qcnt = (unsigned*)(ws + WS_QCNT);
    bf16_t* W1T = (bf16_t*)(dob + DO_W1T); float* bias1 = (float*)(ws + WS_BIAS1); bf16_t* KCb = (bf16_t*)(ws + WS_KCB); bf16_t* VCb = (bf16_t*)(ws + WS_VCB);
    float* gtab3 = (float*)(ws + WS_GTAB3);
    const int lo = args.ph_lo, hi = args.ph_hi;
    if (tid < 2) ((volatile LAS unsigned*)(lds + LDS_BYTES - 32))[tid] = 0u;
    __syncthreads();
    XcdBarrier xbar = xcd_barrier_post((unsigned*)(ws + WS_XBAR), (volatile LAS unsigned*)(lds + LDS_BYTES - 32));
    if (args.ph_hi > 1000) grid.sync();
#ifndef PHMASK
#define PHMASK 0x1ff
#endif
#define IN(k) (((PHMASK >> (k)) & 1) && lo <= (k) && (k) < hi)
#define GRID_SYNC() do { asm volatile("s_waitcnt vmcnt(0) lgkmcnt(0)" ::: "memory"); grid.sync(); \
        if (wave == 0) { __builtin_amdgcn_fence(__ATOMIC_ACQUIRE, "agent"); asm volatile("s_waitcnt vmcnt(0)" ::: "memory"); } __syncthreads(); } while (0)
#define SEAM(k) do { if (IN(k) && IN((k) + 1)) xcd_barrier(xbar); } while (0)

    if (IN(0)) {
        if (blockIdx.x == 0 && tid == 0) { *qcnt = 0u; ((volatile unsigned*)(ws + 786432))[4] = 0u; }
        if (blockIdx.x == 1 && tid < 192) gtab3[tid] = tid < 64 ? args.in[7][tid] * (0.125f * nsa::LOG2E) : (tid < 128 ? args.in[9][tid - 64] : args.in[10][tid - 128]);
        constexpr int I_WIN = 16 * (NP1 / 64), I_WG = 16 * 32, I_DN = 16 * 16, I_OUT = 16 * 16, I_UP = 16 * 64;
        constexpr int I_W1 = 32 * 2, I_B1 = 64;
        constexpr int NITEMS = I_WIN + 2 * I_W1 + I_B1;
        for (int it = gw; it < NITEMS; it += NGW) {
            int r = it;
            if (r < I_WIN) { transpose_item(args.in[2], INW, SrcWin{}, Win_t, D, 0, scr, r / (NP1 / 64), r % (NP1 / 64), lane); continue; } r -= I_WIN;
            if (r < I_W1) { transpose_item(args.in[12], 128, SrcIdent{0}, W1T, nsa::W1P, 0, scr, r / 2, r % 2, lane); continue; } r -= I_W1;
            if (r < I_W1) { transpose_item(args.in[15], 128, SrcIdent{0}, W1T + 128 * nsa::W1P, nsa::W1P, 0, scr, r / 2, r % 2, lane); continue; } r -= I_W1;
            {
                const int which = r >> 5, kc = r & 31; const float* pos = args.in[which ? 14 : 11] + kc * 64; const float* w1 = args.in[which ? 15 : 12] + (size_t)kc * 64 * 128 + 2 * lane;
                float a0 = 0.f, a1 = 0.f;
#pragma unroll 16
                for (int k = 0; k < 64; ++k) { const float pk_ = pos[k]; const float2 w = *(const float2*)(w1 + (size_t)k * 128); a0 += pk_ * w.x; a1 += pk_ * w.y; }
                atomicAdd(bias1 + which * 128 + 2 * lane, a0); atomicAdd(bias1 + which * 128 + 2 * lane + 1, a1);
            }
        }
        const float* gain = args.in[1];
        f32x4 gv[4];
#pragma unroll
        for (int j = 0; j < 4; ++j) gv[j] = ((const f32x4*)gain)[lane + 64 * j];
        for (int m = gw; m < M; m += 2 * NGW) {
            const int m2 = (m + NGW < M) ? m + NGW : m;
            const f32x4* xr = (const f32x4*)(x + (size_t)m * D) + lane; const f32x4* xr2 = (const f32x4*)(x + (size_t)m2 * D) + lane;
            f32x4 v[4], u[4]; float s1 = 0.f, s2 = 0.f;
#pragma unroll
            for (int j = 0; j < 4; ++j) { v[j] = xr[64 * j]; u[j] = xr2[64 * j]; }
#pragma unroll
            for (int j = 0; j < 4; ++j) { s1 += (v[j].x * v[j].x + v[j].y * v[j].y) + (v[j].z * v[j].z + v[j].w * v[j].w); s2 += (u[j].x * u[j].x + u[j].y * u[j].y) + (u[j].z * u[j].z + u[j].w * u[j].w); }
            const float r1 = rsqrtf(wave_sum(s1) * (1.f / D) + EPS), r2 = rsqrtf(wave_sum(s2) * (1.f / D) + EPS);
            unsigned long long* o8 = (unsigned long long*)(Hb + (size_t)m * D) + lane; unsigned long long* o9 = (unsigned long long*)(Hb + (size_t)m2 * D) + lane;
#pragma unroll
            for (int j = 0; j < 4; ++j) { const f32x4 y = v[j] * r1 * gv[j]; o8[64 * j] = (unsigned long long)pk2(y.x, y.y) | ((unsigned long long)pk2(y.z, y.w) << 32); }
            if (m2 != m) {
#pragma unroll
                for (int j = 0; j < 4; ++j) { const f32x4 y = u[j] * r2 * gv[j]; o9[64 * j] = (unsigned long long)pk2(y.x, y.y) | ((unsigned long long)pk2(y.z, y.w) << 32); } }
        }
    }
    SEAM(0);
    if (IN(1)) {
        pg8::Gemm g{Hb, Win_t, D, D, M, NP1, D, 0}; pg8::StaticOrder S; S.init(M, NP1, G, (int)blockIdx.x);
        pg8::EpiP3 E{P, LDP, 26, 64, Halo, gtab3};
        pg8::gemm_phase<pg8::EpiP3, pg8::RevOrder, true>(lds, g, pg8::RevOrder{S}, E);
        {
            constexpr int I_WG = 16 * 32, I_DN = 16 * 16, I_OUT = 16 * 16, I_UP = 16 * 64, NT = I_WG + 2 * I_DN + I_OUT + I_UP;
            const int nwg = (M / 256) * (NP1 / 256), maxu = (nwg + G - 1) / G, thr = nwg - (maxu - 1) * G;
            const int nsl = (thr < G) ? G - thr : G, sidx = (thr < G) ? (int)blockIdx.x - thr : (int)blockIdx.x;
            if (sidx >= 0) for (int it = sidx * NWAVES + wave; it < NT; it += nsl * NWAVES) {
                int r = it;
                if (r < I_WG) { transpose_item(args.in[2], INW, SrcIdent{6720}, Wg_t, D, 0, scr, r / 32, r % 32, lane); continue; } r -= I_WG;
                if (r < I_DN) { transpose_item(args.in[17], D, SrcIdent{0}, Wcat_t, 2 * D, 0, scr, r / 16, r % 16, lane); continue; } r -= I_DN;
                if (r < I_DN) { transpose_item(args.in[18], D, SrcIdent{0}, Wcat_t, 2 * D, D, scr, r / 16, r % 16, lane); continue; } r -= I_DN;
                if (r < I_OUT) { transpose_item(args.in[19], D, SrcIdent{0}, Wout_t, D, 0, scr, r / 16, r % 16, lane); continue; } r -= I_OUT;
                transpose_item(args.in[21], FF, SrcIdent{0}, Wup_t, D, 0, scr, r / 64, r % 64, lane, args.in[20]);
            }
        }
    }
    SEAM(1);
    if (IN(2)) {
        for (int it = (G == 256) ? (((int)blockIdx.x & 1) ? 128 : (int)blockIdx.x >> 1) : (int)blockIdx.x; it < 128; it += G) {
            const int half = it & 1, which = (it >> 1) & 1, g_ = (it >> 2) & 3, b_ = it >> 4;
            nsa::compress_item(lds, P, W1T + (size_t)which * 128 * nsa::W1P, bias1 + which * 128, args.in[which ? 16 : 13], args.in[8], which ? VCb : KCb, b_, g_, which, half);
        }
        __syncthreads();
        {
            gdn::RowPre pre; int hl = -1;
            const int c_ = (int)blockIdx.x, hq = c_ >> 5, jq = c_ & 31;
            const bool bal = (G == 256);
            const int cnt = bal ? ((jq & 1) ? 9 : 7) : (2048 - c_ + G - 1) / G;
            const int first = bal ? ((jq & 1) ? 112 + 9 * (jq >> 1) : 7 * (jq >> 1)) : 0;
#define PREP_COORD(k, b_, n_, h_) do { if (bal) { const int idx_ = first + (k); b_ = idx_ >> 5; n_ = idx_ & 31; h_ = hq; } else { const int it_ = c_ + (k) * G; b_ = it_ >> 8; n_ = it_ & 31; h_ = (it_ >> 5) & 7; } } while (0)
            int b0, n0, h0;
            if (cnt > 0) { PREP_COORD(0, b0, n0, h0); gdn::prep_prefetch(pre, P, Halo, b0, n0, h0, wave, lane); }
            for (int k = 0; k < cnt; ++k) {
                int bc, nc, hc, bn = -1, nn = 0, hn = 0;
                PREP_COORD(k, bc, nc, hc);
                if (k + 1 < cnt) PREP_COORD(k + 1, bn, nn, hn);
                if (hc != hl) { __syncthreads(); gdn::prep_load_taps(lds, args.in[3], hc); hl = hc; __syncthreads(); }
                gdn::prep_item(lds, P, Halo, args.in[4], args.in[5], GWb, GQKb, GLv, pre, bc, nc, hc, bn, nn, hn);
            }
#undef PREP_COORD
        }
    }
    SEAM(2);
    if (IN(3)) {
        for (int item = (int)blockIdx.x; item < BATCH * DN_H; item += G) gdn::scan_item(lds, P, GWb, GQKb, GLv, args.in[6], item >> 3, item & 7);
        __syncthreads();
        unsigned qnext = 0u;
        if (tid == 0) qnext = atomicAdd(qcnt, 1u);
        {
            volatile LAS unsigned* qslot = (volatile LAS unsigned*)(lds + LDS_BYTES - 16);
            nsa::bf16x8 qfr[4] = {}; unsigned short gq[3] = {0, 0, 0}; bool pre = false; int idx = -1;
            for (;;) {
                if (idx < 0) { if (tid == 0) *qslot = qnext; __syncthreads(); idx = (int)*qslot; pre = false; __syncthreads(); }
                if (idx >= 1024) break;
                int idxn = -1;
                nsa::attn_tile(lds, P, KCb, VCb, (idx & 31) >> 2, idx & 3, 31 - (idx >> 5), qcnt, qnext, pre, qfr, gq, idxn);
                idx = idxn; pre = (idxn >= 0 && idxn < 1024);
            }
        }
    }
    SEAM(3);
    if (IN(4)) {
        pg8::Gemm g{Hb, Wg_t, D, D, M, 2048, D, 0}; pg8::GatePairOrder S; S.base.init(M, D, G, (int)blockIdx.x);
        pg8::EpiP<1> E{P, LDP, -1, 256, nullptr};
        pg8::gemm_phase<pg8::EpiP<1>, pg8::GatePairOrder, true>(lds, g, S, E);
    }
    if (IN(4) && IN(5)) { asm volatile("s_waitcnt vmcnt(0)" ::: "memory"); __syncthreads(); }
    if (IN(5)) {
        pg8::Gemm g{P + C_DZ, Wcat_t, LDP, 2 * D, M, D, D, D}; pg8::TwoPassOrder S; S.base.init(M, D, G, (int)blockIdx.x);
        pg8::EpiMix E{P, LDP, Mix, D};
        pg8::gemm_phase<pg8::EpiMix, pg8::TwoPassOrder, false>(lds, g, S, E);
    }
    SEAM(5);
    if (IN(6)) {
        for (int it = gw; it < 64 * 16; it += NGW) transpose_item(args.in[22], D, SrcIdent{0}, Wdown_t, FF, 0, scr, it / 16, it % 16, lane);
        __syncthreads();
        pg8::Gemm g{Mix, Wout_t, D, D, M, D, D, 0}; pg8::StaticOrder S; S.init(M, D, G, (int)blockIdx.x);
        pg8::EpiOut E{x, An, pss};
        pg8::gemm_phase<pg8::EpiOut, pg8::StaticOrder, false>(lds, g, S, E);
    }
    SEAM(6);
    if (IN(7)) {
        pg8::Gemm g{An, Wup_t, D, D, M, FF, D, 0}; pg8::IndexedOrder S; S.base.init(M, FF, G, (int)blockIdx.x);
        LAS float* rtab = (LAS float*)(lds + 131072);
        int nu = 0; { pg8::Unit u_; while (nu < 13 && S.next(nu, u_)) ++nu; }
        const bool use_tab = nu <= 12;
        if (use_tab) for (int i0 = 0; i0 < nu; i0 += 4) {
            f32x4 sa[4], sb[4]; const int r = tid >> 1;
#pragma unroll
            for (int k = 0; k < 4; ++k) { pg8::Unit u_; const bool ok = (i0 + k < nu) && S.next(i0 + k, u_);
                const f32x4* pp = (const f32x4*)(pss + ((size_t)(ok ? u_.pm : 0) * 256 + r) * 16) + 2 * (tid & 1); sa[k] = pp[0]; sb[k] = pp[1]; }
#pragma unroll
            for (int k = 0; k < 4; ++k) { const f32x4 s4 = sa[k] + sb[k];
                float sm = (s4[0] + s4[1]) + (s4[2] + s4[3]); sm += __shfl_xor(sm, 1);
                if ((tid & 1) == 0 && i0 + k < nu) rtab[(i0 + k) * 256 + r] = rsqrtf(sm * (1.f / D) + EPS); } }
        __syncthreads();
        pg8::EpiUp E{pss, Up, FF, use_tab ? (const PG8_LAS float*)rtab : (const PG8_LAS float*)nullptr};
        pg8::gemm_phase<pg8::EpiUp, pg8::IndexedOrder, true>(lds, g, S, E);
    }
    SEAM(7);
    if (IN(8)) {
        pg8::Gemm g{Up, Wdown_t, FF, FF, M, D, FF, 0}; pg8::StaticOrder S; S.init(M, D, G, (int)blockIdx.x);
        pg8::EpiDown E{An, args.out};
        pg8::gemm_phase<pg8::EpiDown, pg8::StaticOrder, false>(lds, g, S, E);
    }
#undef IN
#undef SEAM
#undef GRID_SYNC
}

#undef lane
#undef tid
static int g_grid = 0;
static void launch_mk(const Args& a0, int lo, int hi, hipStream_t stream) {
    Args a = a0; a.ph_lo = lo; a.ph_hi = hi;
    void* kargs[] = {(void*)&a};
    hipError_t e = hipLaunchCooperativeKernel((const void*)mk_fwd, dim3(g_grid), dim3(NWAVES * 64), kargs, LDS_BYTES, stream);
    if (e != hipSuccess) fprintf(stderr, "cooperative launch failed: %s (grid %d)\n", hipGetErrorString(e), g_grid);
}

extern "C" void kernel_launch(void* const* d_in, const int* in_sizes, int n_in, void* d_out, int out_size, void* d_ws, size_t ws_size, hipStream_t stream) {
    if (g_grid == 0) {
        int dev = 0, cus = 0, per_cu = 0;
        hipGetDevice(&dev);
        hipDeviceGetAttribute(&cus, hipDeviceAttributeMultiprocessorCount, dev);
        hipFuncSetAttribute((const void*)mk_fwd, hipFuncAttributeMaxDynamicSharedMemorySize, LDS_BYTES);
        hipOccupancyMaxActiveBlocksPerMultiprocessor(&per_cu, (const void*)mk_fwd, NWAVES * 64, LDS_BYTES);
        if (per_cu < 1) per_cu = 1;
        if (per_cu > 1) per_cu = 1;
        g_grid = cus * per_cu;
    }
    Args a{};
    for (int i = 0; i < 23; ++i) a.in[i] = (const float*)d_in[i];
    a.out = (float*)d_out; a.ws = (unsigned char*)d_ws;
    bf16_t* P = (bf16_t*)((char*)d_ws + WS_P);
    hipMemsetAsync((char*)d_ws + WS_XBAR, 0, 16384 + 1024, stream);
    launch_mk(a, 0, 9, stream);
}
```
